# Optimizing an MI355X kernel written in HIP

```python
import math
import jax, jax.numpy as jnp
from jax import lax
import numpy as np

D_MODEL = 1024
BATCH = 8
SEQ = 4096
DEPTH = 2

HEAD_DIM = 64
NSA_HEADS = 8
NSA_KV_HEADS = 2
NSA_GROUP = NSA_HEADS // NSA_KV_HEADS
CMP_LEN = 32
CMP_STRIDE = 16
CMP_HIDDEN = 256
SEL_BLOCK = 64
SEL_TOPN = 16
NSA_WINDOW = 512
SEL_QBLK = 64
FORCE_SCORE = 1e4
DIL_PAIRS = ((128, 1), (512, 4), (2048, 16))
N_DIL_GROUPS = 3
DIL_HEADS_PER_GROUP = 4
DIL_HEADS = N_DIL_GROUPS * DIL_HEADS_PER_GROUP
QBLK = 128
NUM_BUCKETS = 32
REL_MAX_DIST = 2048
N_BIAS_HEADS = NSA_HEADS + DIL_HEADS
N_EXPERT_GROUPS = 4
EXPERTS_PER_GROUP = 8
N_EXPERTS = N_EXPERT_GROUPS * EXPERTS_PER_GROUP
TOPK_IN_GROUP = 2
D_EXPERT = 512
MOE_ROW_BLOCK = 256
RMS_EPS = 1e-6
NSA_Q_W = NSA_HEADS * HEAD_DIM
NSA_KV_W = 3 * 2 * NSA_KV_HEADS * HEAD_DIM
NSA_GATE_W = 3 * NSA_HEADS
DIL_QKV_W = 3 * DIL_HEADS * HEAD_DIM
MERGE_W = 2 * D_MODEL
IN_W = NSA_Q_W + NSA_KV_W + NSA_GATE_W + DIL_QKV_W + MERGE_W
IN_SPLITS = (NSA_Q_W, NSA_Q_W + NSA_KV_W, NSA_Q_W + NSA_KV_W + NSA_GATE_W,
             NSA_Q_W + NSA_KV_W + NSA_GATE_W + DIL_QKV_W)
NSA_OUT_W = NSA_HEADS * HEAD_DIM
DIL_OUT_W = DIL_HEADS_PER_GROUP * HEAD_DIM

kernel_name = "hybrid_nsa_dilated_hmoe_adaln"


def rmsnorm(x, g):
    xf = x.astype(jnp.float32)
    y = xf * lax.rsqrt(jnp.mean(xf * xf, axis=-1, keepdims=True) + RMS_EPS)
    return (y * g.astype(jnp.float32)).astype(x.dtype)


def t5_bucket(dist):
    dist = jnp.maximum(dist, 0)
    max_exact = NUM_BUCKETS // 2
    df = jnp.maximum(dist, 1).astype(jnp.float32)
    large = max_exact + (jnp.log(df / max_exact) / math.log(REL_MAX_DIST / max_exact)
                         * (NUM_BUCKETS - max_exact)).astype(jnp.int32)
    large = jnp.minimum(large, NUM_BUCKETS - 1)
    return jnp.where(dist < max_exact, dist, large)


def banded_attention(q, k, v, window, tbl, dist_scale):
    B, L, Hk, G, dh = q.shape
    nb = -(-L // QBLK)
    Lp = nb * QBLK
    P = -(-window // QBLK) * QBLK
    q = jnp.pad(q, ((0, 0), (0, Lp - L), (0, 0), (0, 0), (0, 0)))
    k = jnp.pad(k, ((0, 0), (P, Lp - L), (0, 0), (0, 0)))
    v = jnp.pad(v, ((0, 0), (P, Lp - L), (0, 0), (0, 0)))
    scale = dh ** -0.5

    def step(i):
        qs = i * QBLK
        qb = lax.dynamic_slice_in_dim(q, qs, QBLK, axis=1)
        kb = lax.dynamic_slice_in_dim(k, qs, QBLK + P, axis=1)
        vb = lax.dynamic_slice_in_dim(v, qs, QBLK + P, axis=1)
        s = jnp.einsum('bqhgd,bkhd->bhgqk', qb, kb).astype(jnp.float32) * scale
        tq = qs + jnp.arange(QBLK)
        tk = qs - P + jnp.arange(QBLK + P)
        dist = tq[:, None] - tk[None, :]
        valid = (dist >= 0) & (dist <= window) & (tk[None, :] >= 0)
        bias = jnp.transpose(tbl[t5_bucket(dist * dist_scale)], (2, 3, 0, 1)).astype(jnp.float32)
        s = jnp.where(valid, s + bias, -jnp.inf)
        m = jnp.max(s, axis=-1, keepdims=True)
        p = jnp.exp(s - m)
        den = jnp.sum(p, axis=-1, keepdims=True)
        o = jnp.einsum('bhgqk,bkhd->bqhgd', (p / den).astype(vb.dtype), vb)
        return o, (m + jnp.log(den))[..., 0]

    o, lse = lax.map(step, jnp.arange(nb))
    o = jnp.moveaxis(o, 0, 1).reshape(B, Lp, Hk, G, dh)[:, :L]
    lse = jnp.transpose(lse, (1, 0, 4, 2, 3)).reshape(B, Lp, Hk, G)[:, :L]
    return o, lse


def compress_blocks(k, pos, w1, w2):
    B, S, Hk, dh = k.shape
    nc = (S - CMP_LEN) // CMP_STRIDE + 1
    idx = jnp.arange(nc)[:, None] * CMP_STRIDE + jnp.arange(CMP_LEN)[None, :]
    blk = k[:, idx] + pos[None, None, :, None, :]
    blk = blk.transpose(0, 1, 3, 2, 4).reshape(B, nc, Hk, CMP_LEN * dh)
    return jax.nn.gelu(blk @ w1) @ w2


def nsa_compressed_selected(q, kc, vc, ks, vs, tbl):
    B, S, Hk, G, dh = q.shape
    nc = kc.shape[1]
    n_sel = S // SEL_BLOCK
    n_top = min(SEL_TOPN, n_sel)
    scale = dh ** -0.5
    c_start = jnp.arange(nc) * CMP_STRIDE
    c_end = c_start + CMP_LEN - 1
    s_start = jnp.arange(n_sel) * SEL_BLOCK
    overlap = jnp.clip(jnp.minimum(c_start[:, None] + CMP_LEN, s_start[None, :] + SEL_BLOCK)
                       - jnp.maximum(c_start[:, None], s_start[None, :]), 0).astype(jnp.float32) / CMP_STRIDE
    ks_blk = ks.transpose(0, 2, 1, 3).reshape(B, Hk, n_sel, SEL_BLOCK, dh)
    vs_blk = vs.transpose(0, 2, 1, 3).reshape(B, Hk, n_sel, SEL_BLOCK, dh)
    tbl_h = jnp.transpose(tbl, (1, 0, 2))
    bi = jnp.arange(B)[:, None, None, None]
    hi = jnp.arange(Hk)[None, :, None, None]
    blk_ids = jnp.arange(n_sel)

    def step(i):
        qs = i * SEL_QBLK
        qb = lax.dynamic_slice_in_dim(q, qs, SEL_QBLK, axis=1)
        t = qs + jnp.arange(SEL_QBLK)
        sc = jnp.einsum('bqhgd,bchd->bhgqc', qb, kc).astype(jnp.float32) * scale
        dist_c = t[:, None] - c_end[None, :]
        bias_c = jnp.transpose(tbl[t5_bucket(dist_c)], (2, 3, 0, 1)).astype(jnp.float32)
        sc = jnp.where(dist_c >= 0, sc + bias_c, -jnp.inf)
        m = jnp.max(sc, axis=-1, keepdims=True)
        m = jnp.where(jnp.isfinite(m), m, 0.0)
        pc = jnp.exp(sc - m)
        den = jnp.sum(pc, axis=-1, keepdims=True)
        pc = pc / jnp.where(den > 0, den, 1.0)
        o_c = jnp.einsum('bhgqc,bchd->bqhgd', pc.astype(vc.dtype), vc)
        imp = jnp.einsum('bhgqc,cn->bhqn', pc, overlap)
        jq = t // SEL_BLOCK
        forced = (blk_ids[None] == 0) | (blk_ids[None] == jq[:, None]) | (blk_ids[None] == jq[:, None] - 1)
        future = blk_ids[None] > jq[:, None]
        score = jnp.where(forced, FORCE_SCORE, jnp.where(future, -1.0, imp))
        _, idx = lax.top_k(score, n_top)
        ksel = ks_blk[bi, hi, idx].reshape(B, Hk, SEL_QBLK, n_top * SEL_BLOCK, dh)
        vsel = vs_blk[bi, hi, idx].reshape(B, Hk, SEL_QBLK, n_top * SEL_BLOCK, dh)
        pos = (idx[..., None] * SEL_BLOCK + jnp.arange(SEL_BLOCK)).reshape(B, Hk, SEL_QBLK, n_top * SEL_BLOCK)
        dist = t[None, None, :, None] - pos
        bias_s = jnp.moveaxis(tbl_h[hi, t5_bucket(dist)], -1, 2).astype(jnp.float32)
        ss = jnp.einsum('bqhgd,bhqkd->bhgqk', qb, ksel).astype(jnp.float32) * scale
        ss = jnp.where((dist >= 0)[:, :, None], ss + bias_s, -jnp.inf)
        ps = jax.nn.softmax(ss, axis=-1)
        o_s = jnp.einsum('bhgqk,bhqkd->bqhgd', ps.astype(vsel.dtype), vsel)
        return o_c, o_s

    o_c, o_s = lax.map(step, jnp.arange(S // SEL_QBLK))
    o_c = jnp.moveaxis(o_c, 0, 1).reshape(B, S, Hk, G, dh)
    o_s = jnp.moveaxis(o_s, 0, 1).reshape(B, S, Hk, G, dh)
    return o_c, o_s


def dilated_attention(q, k, v, tbl):
    B, S = q.shape[0], q.shape[1]
    outs, lses = [], []
    for g, (window, d) in enumerate(DIL_PAIRS):
        def sub(a):
            return a.reshape(B, S // d, d, *a.shape[2:]).swapaxes(1, 2).reshape(B * d, S // d, *a.shape[2:])
        o, lse = banded_attention(sub(q[:, :, g])[:, :, :, None], sub(k[:, :, g]), sub(v[:, :, g]),
                                  window // d, tbl[:, g, :, None], d)
        H, dh = o.shape[2], o.shape[4]
        outs.append(o[:, :, :, 0].reshape(B, d, S // d, H, dh).swapaxes(1, 2).reshape(B, S, H, dh))
        lses.append(lse[..., 0].reshape(B, d, S // d, H).swapaxes(1, 2).reshape(B, S, H))
    w = jax.nn.softmax(jnp.stack(lses, axis=0), axis=0)
    return jnp.sum(w[..., None] * jnp.stack(outs, axis=0).astype(jnp.float32), axis=0)


def hybrid_mixer(h, w_in, cmp_pos, cmp_w1, cmp_w2, w_up_nsa, w_up_dil, w_o, rel_bias):
    B, S, D = h.shape
    proj = h @ w_in
    q_n, kv_n, gate_n, qkv_d, merge = jnp.split(proj, IN_SPLITS, axis=-1)
    q_n = q_n.reshape(B, S, NSA_KV_HEADS, NSA_GROUP, HEAD_DIM)
    kv_n = kv_n.reshape(B, S, 3, 2, NSA_KV_HEADS, HEAD_DIM)
    gate_n = jax.nn.sigmoid(gate_n.astype(jnp.float32)).reshape(B, S, 3, NSA_KV_HEADS, NSA_GROUP)
    tbl_n = rel_bias[:, :NSA_HEADS].reshape(NUM_BUCKETS, NSA_KV_HEADS, NSA_GROUP)
    tbl_d = rel_bias[:, NSA_HEADS:].reshape(NUM_BUCKETS, N_DIL_GROUPS, DIL_HEADS_PER_GROUP)
    kc = compress_blocks(kv_n[:, :, 0, 0], cmp_pos[0], cmp_w1[0], cmp_w2[0])
    vc = compress_blocks(kv_n[:, :, 0, 1], cmp_pos[1], cmp_w1[1], cmp_w2[1])
    o_c, o_s = nsa_compressed_selected(q_n, kc, vc, kv_n[:, :, 1, 0], kv_n[:, :, 1, 1], tbl_n)
    o_w, _ = banded_attention(q_n, kv_n[:, :, 2, 0], kv_n[:, :, 2, 1], NSA_WINDOW, tbl_n, 1)
    o_nsa = (gate_n[:, :, 0, ..., None] * o_c + gate_n[:, :, 1, ..., None] * o_s
             + gate_n[:, :, 2, ..., None] * o_w).reshape(B, S, NSA_OUT_W).astype(h.dtype)
    qkv_d = qkv_d.reshape(B, S, 3, N_DIL_GROUPS, DIL_HEADS_PER_GROUP, HEAD_DIM)
    o_dil = dilated_attention(qkv_d[:, :, 0], qkv_d[:, :, 1], qkv_d[:, :, 2], tbl_d)
    o_dil = o_dil.reshape(B, S, DIL_OUT_W).astype(h.dtype)
    g_m = jax.nn.sigmoid(merge.astype(jnp.float32)).reshape(B, S, 2, D)
    merged = g_m[:, :, 0] * (o_nsa @ w_up_nsa) + g_m[:, :, 1] * (o_dil @ w_up_dil)
    return merged.astype(h.dtype) @ w_o


def hierarchical_moe(h, wg, bg, we, be, w1, w3, w2):
    B, S, D = h.shape
    T = B * S
    hf = h.reshape(T, D)
    lg = (hf @ wg).astype(jnp.float32) + bg.astype(jnp.float32)
    grp = jnp.argmax(lg, axis=-1)
    p_grp = jnp.take_along_axis(jax.nn.softmax(lg, axis=-1), grp[:, None], axis=-1)
    le = ((hf @ we).astype(jnp.float32) + be.astype(jnp.float32)).reshape(T, N_EXPERT_GROUPS, EXPERTS_PER_GROUP)
    le = jnp.take_along_axis(le, grp[:, None, None], axis=1)[:, 0]
    top_v, top_i = lax.top_k(le, TOPK_IN_GROUP)
    wts = jax.nn.softmax(top_v, axis=-1) * p_grp
    eid = (grp[:, None] * EXPERTS_PER_GROUP + top_i).astype(jnp.int32)
    N = T * TOPK_IN_GROUP
    e_flat = eid.reshape(-1)
    tok = jnp.repeat(jnp.arange(T, dtype=jnp.int32), TOPK_IN_GROUP)
    w_flat = wts.reshape(-1)
    order = jnp.argsort(e_flat)
    e_s, tok_s, w_s = e_flat[order], tok[order], w_flat[order]
    counts = jnp.bincount(e_flat, length=N_EXPERTS)
    pcounts = (counts + MOE_ROW_BLOCK - 1) // MOE_ROW_BLOCK * MOE_ROW_BLOCK
    pend = jnp.cumsum(pcounts)
    pstart = pend - pcounts
    start = jnp.cumsum(counts) - counts
    dest = pstart[e_s] + (jnp.arange(N) - start[e_s])
    nb = -(-N // MOE_ROW_BLOCK) + N_EXPERTS
    n_pad = nb * MOE_ROW_BLOCK
    xs = jnp.zeros((n_pad, D), h.dtype).at[dest].set(hf[tok_s])
    blk_e = jnp.clip(jnp.searchsorted(pend, jnp.arange(nb) * MOE_ROW_BLOCK, side='right'), 0, N_EXPERTS - 1)

    def expert_block(args):
        xb, e = args
        return (jax.nn.silu(xb @ w1[e]) * (xb @ w3[e])) @ w2[e]

    ys = lax.map(expert_block, (xs.reshape(nb, MOE_ROW_BLOCK, D), blk_e)).reshape(n_pad, D)
    out = jnp.zeros((T, D), h.dtype).at[tok_s].add((w_s[:, None] * ys[dest]).astype(h.dtype))
    return out.reshape(B, S, D)


def setup_inputs(seed: int = 0) -> dict:
    key = jax.random.key(seed)
    ks = jax.random.split(key, 24)

    def nrm(k, shape, s):
        return jax.random.normal(k, shape, jnp.float32) * s

    return {
        "x": nrm(ks[0], (BATCH, SEQ, D_MODEL), 1.0),
        "c": nrm(ks[1], (BATCH, D_MODEL), 1.0),
        "rel_bias": nrm(ks[2], (NUM_BUCKETS, N_BIAS_HEADS), 0.2),
        "ada_w": nrm(ks[3], (DEPTH, D_MODEL, 6 * D_MODEL), D_MODEL ** -0.5),
        "ada_b": nrm(ks[4], (DEPTH, 6 * D_MODEL), 0.01),
        "norm1": 1.0 + nrm(ks[5], (DEPTH, D_MODEL), 0.02),
        "norm2": 1.0 + nrm(ks[6], (DEPTH, D_MODEL), 0.02),
        "w_in": nrm(ks[7], (DEPTH, D_MODEL, IN_W), D_MODEL ** -0.5),
        "cmp_pos": nrm(ks[8], (DEPTH, 2, CMP_LEN, HEAD_DIM), 0.1),
        "cmp_w1": nrm(ks[9], (DEPTH, 2, CMP_LEN * HEAD_DIM, CMP_HIDDEN), (CMP_LEN * HEAD_DIM) ** -0.5),
        "cmp_w2": nrm(ks[10], (DEPTH, 2, CMP_HIDDEN, HEAD_DIM), CMP_HIDDEN ** -0.5),
        "w_up_nsa": nrm(ks[11], (DEPTH, NSA_OUT_W, D_MODEL), NSA_OUT_W ** -0.5),
        "w_up_dil": nrm(ks[12], (DEPTH, DIL_OUT_W, D_MODEL), DIL_OUT_W ** -0.5),
        "w_o": nrm(ks[13], (DEPTH, D_MODEL, D_MODEL), D_MODEL ** -0.5),
        "router_wg": nrm(ks[14], (DEPTH, D_MODEL, N_EXPERT_GROUPS), D_MODEL ** -0.5),
        "router_bg": nrm(ks[15], (DEPTH, N_EXPERT_GROUPS), 0.01),
        "router_we": nrm(ks[16], (DEPTH, D_MODEL, N_EXPERTS), D_MODEL ** -0.5),
        "router_be": nrm(ks[17], (DEPTH, N_EXPERTS), 0.01),
        "exp_w1": nrm(ks[18], (DEPTH, N_EXPERTS, D_MODEL, D_EXPERT), D_MODEL ** -0.5),
        "exp_w3": nrm(ks[19], (DEPTH, N_EXPERTS, D_MODEL, D_EXPERT), D_MODEL ** -0.5),
        "exp_w2": nrm(ks[20], (DEPTH, N_EXPERTS, D_EXPERT, D_MODEL), D_EXPERT ** -0.5),
        "norm_f": 1.0 + nrm(ks[21], (D_MODEL,), 0.02),
    }


def reference(x, c, rel_bias, ada_w, ada_b, norm1, norm2, w_in, cmp_pos, cmp_w1, cmp_w2,
              w_up_nsa, w_up_dil, w_o, router_wg, router_bg, router_we, router_be,
              exp_w1, exp_w3, exp_w2, norm_f):
    cond = jax.nn.silu(c)
    for l in range(DEPTH):
        mod = (cond @ ada_w[l] + ada_b[l])[:, None, :]
        sh1, sc1, g1, sh2, sc2, g2 = jnp.split(mod, 6, axis=-1)
        h = (rmsnorm(x, norm1[l]) * (1 + sc1) + sh1).astype(x.dtype)
        x = x + g1 * hybrid_mixer(h, w_in[l], cmp_pos[l], cmp_w1[l], cmp_w2[l],
                                  w_up_nsa[l], w_up_dil[l], w_o[l], rel_bias)
        h = (rmsnorm(x, norm2[l]) * (1 + sc2) + sh2).astype(x.dtype)
        x = x + g2 * hierarchical_moe(h, router_wg[l], router_bg[l], router_we[l], router_be[l],
                                      exp_w1[l], exp_w3[l], exp_w2[l])
    return rmsnorm(x, norm_f)
```

```cpp
#include <hip/hip_runtime.h>
#include <cstdint>
#include <cstdio>

#define GAS __attribute__((address_space(1)))
#define LAS __attribute__((address_space(3)))
typedef unsigned short bf16_t;
typedef short bf16x8 __attribute__((ext_vector_type(8)));
typedef short s16x4 __attribute__((ext_vector_type(4)));
typedef float f32x4 __attribute__((ext_vector_type(4)));
typedef float f32x2 __attribute__((ext_vector_type(2)));
typedef float f32x16 __attribute__((ext_vector_type(16)));
typedef unsigned u32x4 __attribute__((ext_vector_type(4)));
typedef unsigned u32x2 __attribute__((ext_vector_type(2)));
typedef __bf16 bf16x2_t __attribute__((ext_vector_type(2)));

constexpr int NB = 8, SEQ = 4096, DM = 1024, T = NB * SEQ;
constexpr int LDQ = 3584;
constexpr int NIN = 5888;
constexpr int INW = 5656;
constexpr float LOG2E = 1.4426950408889634f;
constexpr float C2 = 0.125f * LOG2E;
constexpr int NWAVES = 8, NTHR = 512;
constexpr float RMS_EPS = 1e-6f;
constexpr int NPHASE = 22;

constexpr size_t MiB = 1u << 20;
constexpr size_t WS_CTL = 0, CTL_ZERO_BYTES = MiB;
constexpr size_t WS_MOD = 1 * MiB;
constexpr size_t WS_CB1 = WS_MOD + 400 * 1024;
constexpr size_t WS_CW2T = WS_MOD + 512 * 1024;
constexpr size_t WS_CNTBLK = WS_MOD + 768 * 1024;
constexpr size_t WS_TILEE = WS_MOD + 832 * 1024;
constexpr size_t WS_WINT = 4 * MiB;
constexpr size_t WS_CW1T = 27 * MiB;
constexpr size_t WS_WUNT = 31 * MiB;
constexpr size_t WS_WUDT = 33 * MiB;
constexpr size_t WS_WOT = 34 * MiB;
constexpr size_t WS_E13T = 38 * MiB;
constexpr size_t WS_E2T = 102 * MiB;
constexpr size_t WS_A = 134 * MiB;
constexpr size_t WS_XS = WS_A;
constexpr size_t WS_ACT = WS_A + 144 * MiB;
constexpr size_t WS_MERGED = WS_A;
constexpr size_t WS_MG = 359 * MiB;
constexpr size_t WS_H2 = WS_MG;
constexpr size_t WS_REC = WS_MG + 64 * MiB;
constexpr size_t WS_DEST = WS_MG + 65 * MiB;
constexpr size_t WS_B = 487 * MiB;
constexpr size_t WS_H = WS_B;
constexpr size_t WS_ONSA = WS_B;
constexpr size_t WS_ODP = WS_B + 32 * MiB;
constexpr size_t WS_LSE = WS_B + 80 * MiB;
constexpr size_t WS_ODIL = WS_B + 82 * MiB;
constexpr size_t WS_GN = WS_B + 98 * MiB;
constexpr size_t WS_KC = WS_B + 102 * MiB;
constexpr size_t WS_HID = WS_B + 103 * MiB;
constexpr size_t WS_END = WS_B + 107 * MiB;

constexpr int CW_TMO = 0, CW_BAR = 4096;

constexpr int LDS_MISC = 147456;
constexpr int LDS_BYTES = 147456 + 4096;

__device__ __forceinline__ unsigned cvt_pk_bf16(float lo, float hi) { f32x2 v = {lo, hi}; bf16x2_t b = __builtin_convertvector(v, bf16x2_t); return __builtin_bit_cast(unsigned, b); }
__device__ __forceinline__ float bf_lo(unsigned w) { return __uint_as_float(w << 16); }
__device__ __forceinline__ float bf_hi(unsigned w) { return __uint_as_float(w & 0xffff0000u); }
__device__ __forceinline__ float sigmoidf_(float x) { return __builtin_amdgcn_rcpf(1.0f + __builtin_amdgcn_exp2f(-x * LOG2E)); }
__device__ __forceinline__ int lane_id_fresh() { unsigned ones = ~0u; asm volatile("" : "+s"(ones)); return (int)__builtin_amdgcn_mbcnt_hi(ones, __builtin_amdgcn_mbcnt_lo(ones, 0u)); }
template <int X> __device__ __forceinline__ float swz_xor_f(float v) { return __int_as_float(__builtin_amdgcn_ds_swizzle(__float_as_int(v), (X << 10) | 0x1f)); }
template <int X> __device__ __forceinline__ unsigned swz_xor_u(unsigned v) { return (unsigned)__builtin_amdgcn_ds_swizzle((int)v, (X << 10) | 0x1f); }
__device__ __forceinline__ float wave_sum(float v) {
    v += swz_xor_f<1>(v); v += swz_xor_f<2>(v); v += swz_xor_f<4>(v); v += swz_xor_f<8>(v); v += swz_xor_f<16>(v);
    auto rr = __builtin_amdgcn_permlane32_swap(__float_as_uint(v), __float_as_uint(v), false, false);
    return __uint_as_float(rr[0]) + __uint_as_float(rr[1]);
}
__device__ __forceinline__ int bperm_i(int srclane, int v) { return __builtin_amdgcn_ds_bpermute(srclane << 2, v); }
#define LDS_WAIT() asm volatile("s_waitcnt lgkmcnt(0)" ::: "memory")
#define VM_WAIT() asm volatile("s_waitcnt vmcnt(0)" ::: "memory")

#define XB_TMO      128
#define XB_XCNT(j)  (256  + 64 * (j))
#define XB_XSUB(j)  (1280 + 64 * (j))
#define XB_XGEN(j)  (2304 + 64 * (j))
#define XB_TOP      3328
#define XB_TOPGEN   3392
#define XCD_BAR_WORDS 3456
#define XB_SPIN_CAP (1u << 20)
__device__ __forceinline__ unsigned xb_ld(unsigned* p)              { return __hip_atomic_load(p, __ATOMIC_RELAXED, __HIP_MEMORY_SCOPE_AGENT); }
__device__ __forceinline__ unsigned xb_add(unsigned* p, unsigned v) { return __hip_atomic_fetch_add(p, v, __ATOMIC_RELAXED, __HIP_MEMORY_SCOPE_AGENT); }
__device__ __forceinline__ unsigned xb_xcc_id() { return (unsigned)__builtin_amdgcn_s_getreg((3 << 11) | 20) & 0xFu; }
#define XB_SPIN(cond, bar) do { unsigned _sp = 0; while (cond) { __builtin_amdgcn_s_sleep(1); \
    if ((++_sp & 255u) == 0u) { if (xb_ld(&(bar)[XB_TMO])) break; if (_sp > XB_SPIN_CAP) { atomicAdd(&(bar)[XB_TMO], 1u); break; } } } } while (0)
struct XcdBarrier { unsigned* bar; unsigned x; volatile LAS unsigned* st; };
__device__ __forceinline__ XcdBarrier xcd_barrier_post(unsigned* bar, volatile LAS unsigned* st) {
    XcdBarrier b; b.bar = bar; b.x = xb_xcc_id(); b.st = st;
    if (threadIdx.x == 0) (void)xb_add(&bar[XB_XCNT(b.x)], 1u);
    return b;
}
__device__ __forceinline__ void xcd_barrier_complete(unsigned* bar, unsigned x, unsigned& nloc, unsigned& nx) {
    const unsigned G = gridDim.x * gridDim.y * gridDim.z;
    unsigned sum, cnt, mine, sp = 0u;
    for (;;) {
        sum = 0u; cnt = 0u; mine = 0u;
#pragma unroll
        for (unsigned j = 0; j < 16; ++j) { const unsigned c = xb_ld(&bar[XB_XCNT(j)]); sum += c; cnt += (c > 0u) ? 1u : 0u; mine = (j == x) ? c : mine; }
        if (sum == G) break;
        __builtin_amdgcn_s_sleep(1);
        if ((++sp & 255u) == 0u) { if (xb_ld(&bar[XB_TMO])) break; if (sp > XB_SPIN_CAP) { atomicAdd(&bar[XB_TMO], 1u); break; } }
    }
    nloc = mine > 0u ? mine : 1u; nx = cnt > 0u ? cnt : 1u;
}
__device__ __forceinline__ void xcd_barrier(const XcdBarrier& b, const bool leader_thread) {
    asm volatile("s_waitcnt vmcnt(0)" ::: "memory");
    __syncthreads();
    if (leader_thread) {
        unsigned* bar = b.bar;
        __builtin_amdgcn_s_waitcnt(0);
        unsigned nloc = b.st[0], nx = b.st[1];
        if (nloc == 0u) { xcd_barrier_complete(bar, b.x, nloc, nx); b.st[0] = nloc; b.st[1] = nx; }
        const unsigned old = xb_add(&bar[XB_XSUB(b.x)], 1u);
        const unsigned gen = old / nloc;
        if (old + 1u == (gen + 1u) * nloc) {
            __builtin_amdgcn_fence(__ATOMIC_RELEASE, "agent");
            asm volatile("s_waitcnt vmcnt(0)" ::: "memory");
            const unsigned og = xb_add(&bar[XB_TOP], 1u);
            const unsigned tg = og / nx;
            if (og + 1u == (tg + 1u) * nx) xb_add(&bar[XB_TOPGEN], 1u);
            else XB_SPIN(xb_ld(&bar[XB_TOPGEN]) == tg, bar);
            __builtin_amdgcn_fence(__ATOMIC_ACQUIRE, "agent");
            xb_add(&bar[XB_XGEN(b.x)], 1u);
            asm volatile("s_waitcnt vmcnt(0)" ::: "memory");
        } else {
            XB_SPIN(xb_ld(&bar[XB_XGEN(b.x)]) == gen, bar);
            __builtin_amdgcn_fence(__ATOMIC_ACQUIRE, "agent");
            asm volatile("s_waitcnt vmcnt(0)" ::: "memory");
        }
    }
    __syncthreads();
}

namespace pg8 {
constexpr int BM = 256, BK = 64, HALF = 128, HTB = HALF * BK * 2, STAGE_BYTES = 8 * HTB;
__device__ __forceinline__ int lds_byte(int r, int c) { const int st = (r >> 4) * 2 + (c >> 5), rr = r & 15, cc = c & 31, ob = rr * 64 + cc * 2; return st * 1024 + (ob ^ (((ob >> 9) & 1) << 5)); }
__device__ __forceinline__ void stage_rc(int b, int& R, int& C) { const int st = b / 1024, sb = b % 1024, swz = sb ^ (((sb >> 9) & 1) << 5); R = (st >> 1) * 16 + swz / 64; C = (st & 1) * 32 + (swz % 64) / 2; }
__device__ __forceinline__ int perm32(int rho) { const int n = rho >> 4, i = rho & 15; return 8 * (i >> 2) + 4 * n + (i & 3); }

struct Unit { const char* A; const char* B; int pm, pn; };
struct Gemm { unsigned lda, ldb, kstepA; int K; };

template <class Epi, class Sched, bool ALIGN_EPI>
__device__ __forceinline__ void gemm_phase(LAS unsigned char* lds, const int tid, const Gemm g, const Sched& S, const Epi& E) {
    const int wid = __builtin_amdgcn_readfirstlane(tid >> 6), lane = tid & 63, wr = wid >> 2, wc = wid & 3, fr = lane & 15, fq = lane >> 4;
    const int nt = g.K / BK;
    unsigned voffA[2], voffB[2];
#pragma unroll
    for (int i = 0; i < 2; ++i) { int R, C; stage_rc(tid * 16 + i * 8192, R, C); const int Rb = Epi::PERM ? ((R & ~31) + perm32(R & 31)) : R;
        voffA[i] = (unsigned)R * g.lda + (unsigned)C * 2u; voffB[i] = (unsigned)Rb * g.ldb + (unsigned)C * 2u; }
    const size_t kstepA = (size_t)g.kstepA, kstepB = (size_t)(BK * 2);
    const size_t hstepA = (size_t)HALF * g.lda, hstepB = (size_t)HALF * g.ldb;
    const unsigned ldsw = (unsigned)wid * 1024u;
    const int aoff = lds_byte(wr * 64 + fr, fq * 8), boff = lds_byte(wc * 32 + fr, fq * 8);
#define PG8_SA(b, h) (((b) * 2 + (h)) * HTB)
#define PG8_SB(b, h) ((4 + (b) * 2 + (h)) * HTB)
#define PG8_STAGE(bufoff, gbase, voff) do { _Pragma("unroll") for (int _i = 0; _i < 2; ++_i) \
        __builtin_amdgcn_global_load_lds((const unsigned*)((const char*)(gbase) + (voff)[_i]), (LAS unsigned*)(lds + (bufoff) + ldsw + _i * 8192), 16, 0, 0); } while (0)
#define PG8_LDA(dst, b, h) do { _Pragma("unroll") for (int m = 0; m < 4; ++m) _Pragma("unroll") for (int k = 0; k < 2; ++k) dst[m][k] = *(const LAS bf16x8*)(lds + PG8_SA(b, h) + aoff + m * 2048 + k * 1024); } while (0)
#define PG8_LDB(dst, b, h) do { _Pragma("unroll") for (int n = 0; n < 2; ++n) _Pragma("unroll") for (int k = 0; k < 2; ++k) dst[n][k] = *(const LAS bf16x8*)(lds + PG8_SB(b, h) + boff + n * 2048 + k * 1024); } while (0)
#define PG8_MMA(ai, bj, At, Bt) do { __builtin_amdgcn_s_setprio(1); _Pragma("unroll") for (int m = 0; m < 4; ++m) _Pragma("unroll") for (int n = 0; n < 2; ++n) _Pragma("unroll") for (int k = 0; k < 2; ++k) \
        acc[ai][bj][m][n] = __builtin_amdgcn_mfma_f32_16x16x32_bf16(Bt[n][k], At[m][k], acc[ai][bj][m][n], 0, 0, 0); __builtin_amdgcn_s_setprio(0); } while (0)
#define PG8_WAIT_V(n) asm volatile("s_waitcnt vmcnt(" #n ")" ::: "memory")
#define PG8_WAIT_L(n) asm volatile("s_waitcnt lgkmcnt(" #n ")" ::: "memory")
#define PG8_BAR __builtin_amdgcn_s_barrier()
#define PG8_SCHED __builtin_amdgcn_sched_barrier(0)
    Unit cur, nxt; int ui = 0;
    if (!S.next(0, cur)) return;
    f32x4 acc[2][2][4][2];
#pragma unroll
    for (int a = 0; a < 2; ++a)
#pragma unroll
        for (int b = 0; b < 2; ++b)
#pragma unroll
            for (int m = 0; m < 4; ++m)
#pragma unroll
                for (int n = 0; n < 2; ++n) acc[a][b][m][n] = (f32x4){0.f, 0.f, 0.f, 0.f};
    bf16x8 At[4][2], B0[2][2], B1[2][2];
    const char* cA = cur.A; const char* cB = cur.B;
    PG8_STAGE(PG8_SB(0, 0), cB, voffB); PG8_STAGE(PG8_SB(0, 1), cB + hstepB, voffB); PG8_STAGE(PG8_SA(0, 0), cA, voffA); PG8_STAGE(PG8_SA(0, 1), cA + hstepA, voffA);
    if (wr == 1) PG8_BAR;
    PG8_WAIT_V(2); PG8_BAR;
    PG8_STAGE(PG8_SB(1, 0), cB + kstepB, voffB); PG8_STAGE(PG8_SA(1, 0), cA + kstepA, voffA); PG8_STAGE(PG8_SB(1, 1), cB + hstepB + kstepB, voffB);
    PG8_WAIT_V(6); PG8_BAR;
    for (;;) {
        const bool has_next = S.next(ui + 1, nxt);
        const char* nA = has_next ? nxt.A : cA; const char* nB = has_next ? nxt.B : cB;
        for (int t = 0; t < nt; t += 2) {
            const bool last = (t == nt - 2);
            const char* a1 = cA + (size_t)(t + 1) * kstepA;
            const char* a2 = last ? nA : cA + (size_t)(t + 2) * kstepA; const char* b2 = last ? nB : cB + (size_t)(t + 2) * kstepB;
            const char* a3 = a2 + kstepA; const char* b3 = b2 + kstepB;
            PG8_LDB(B0, 0, 0); PG8_LDB(B1, 0, 1); PG8_SCHED; PG8_LDA(At, 0, 0); PG8_STAGE(PG8_SA(1, 1), a1 + hstepA, voffA);
            PG8_WAIT_V(8); PG8_WAIT_L(0); PG8_BAR; PG8_MMA(0, 0, At, B0); PG8_MMA(0, 1, At, B1); PG8_BAR; PG8_SCHED;
            PG8_LDA(At, 0, 1); PG8_STAGE(PG8_SB(0, 0), b2, voffB); PG8_STAGE(PG8_SB(0, 1), b2 + hstepB, voffB); PG8_STAGE(PG8_SA(0, 0), a2, voffA);
            PG8_WAIT_V(8); PG8_WAIT_L(0); PG8_BAR; PG8_MMA(1, 0, At, B0); PG8_MMA(1, 1, At, B1); PG8_BAR; PG8_SCHED;
            PG8_LDB(B0, 1, 0); PG8_LDB(B1, 1, 1); PG8_SCHED; PG8_LDA(At, 1, 0); PG8_STAGE(PG8_SA(0, 1), a2 + hstepA, voffA);
            PG8_WAIT_V(8); PG8_WAIT_L(0); PG8_BAR; PG8_MMA(0, 0, At, B0); PG8_MMA(0, 1, At, B1); PG8_BAR; PG8_SCHED;
            PG8_LDA(At, 1, 1); PG8_STAGE(PG8_SB(1, 0), b3, voffB); PG8_STAGE(PG8_SB(1, 1), b3 + hstepB, voffB); PG8_STAGE(PG8_SA(1, 0), a3, voffA);
            PG8_WAIT_V(8); PG8_WAIT_L(0); PG8_BAR; PG8_MMA(1, 0, At, B0); PG8_MMA(1, 1, At, B1); PG8_BAR; PG8_SCHED;
        }
        if constexpr (ALIGN_EPI) { if (wr == 0) PG8_BAR; }
        if constexpr (!Epi::AFTER_DRAIN) { E(acc, cur, wr, wc, fr, fq); }
        if (!has_next) break;
#pragma unroll
        for (int a = 0; a < 2; ++a)
#pragma unroll
            for (int b = 0; b < 2; ++b)
#pragma unroll
                for (int m = 0; m < 4; ++m)
#pragma unroll
                    for (int n = 0; n < 2; ++n) acc[a][b][m][n] = (f32x4){0.f, 0.f, 0.f, 0.f};
        cur = nxt; cA = nA; cB = nB; ++ui;
        if constexpr (ALIGN_EPI) { if (wr == 1) PG8_BAR; }
    }
    PG8_WAIT_V(0);
    if constexpr (!ALIGN_EPI) { if (wr == 0) PG8_BAR; }
    PG8_BAR;
    if constexpr (Epi::AFTER_DRAIN) { E.fused(acc, cur, wr, wc, fr, fq, wid, lane); }
#undef PG8_SA
#undef PG8_SB
#undef PG8_STAGE
#undef PG8_LDA
#undef PG8_LDB
#undef PG8_MMA
#undef PG8_WAIT_V
#undef PG8_WAIT_L
#undef PG8_BAR
#undef PG8_SCHED
}

struct DenseOrder {
    int nM, nN, nwg, G, c; const char* A; const char* B; size_t tA, tB;
    __device__ __forceinline__ void init(int M, int N, int G_, int c_, const void* A_, unsigned lda, const void* B_, unsigned ldb) {
        nM = M / BM; nN = N / BM; nwg = nM * nN; G = G_; c = c_; A = (const char*)A_; B = (const char*)B_; tA = (size_t)BM * lda; tB = (size_t)BM * ldb; }
    __device__ __forceinline__ bool next(int i, Unit& u) const {
        const long L = (long)i * G + c; if (L >= nwg) return false;
        int wgid = (int)L; { const int q = nwg / 8, r = nwg % 8, xcd = wgid % 8, off = wgid / 8; wgid = (xcd < r ? xcd * (q + 1) : r * (q + 1) + (xcd - r) * q) + off; }
        const int nig = 8 * nN, gid = wgid / nig, fm = gid * 8, gsz = (nM - fm) < 8 ? (nM - fm) : 8;
        u.pm = fm + ((wgid % nig) % gsz); u.pn = (wgid % nig) / gsz;
        u.A = A + (size_t)u.pm * tA; u.B = B + (size_t)u.pn * tB; return true;
    }
};
}

struct Args {
    const float* x; const float* c; const float* rel_bias; const float* ada_w; const float* ada_b; const float* norm1; const float* norm2; const float* w_in;
    const float* cmp_pos; const float* cmp_w1; const float* cmp_w2; const float* w_up_nsa; const float* w_up_dil; const float* w_o;
    const float* router_wg; const float* router_bg; const float* router_we; const float* router_be; const float* exp_w1; const float* exp_w3; const float* exp_w2; const float* norm_f;
    float* out; unsigned char* ws; int ph_lo, ph_hi, use_bar, pad;
};

typedef f32x4 AccT[2][2][4][2];
struct EpiInProj {
    static constexpr bool PERM = true, AFTER_DRAIN = false;
    bf16_t* QKV; bf16_t* MG; float* GN;
    __device__ __forceinline__ void operator()(const AccT& acc, const pg8::Unit& u, int wr, int wc, int fr, int fq) const {
        const int pn = u.pn; const int row0 = u.pm * 256 + wr * 64 + fr;
        if (pn < 14) {
            const float sc = (pn < 2 || (pn >= 5 && pn < 8)) ? C2 : 1.0f;
            const int col0 = pn * 256 + wc * 32 + 8 * fq;
#pragma unroll
            for (int ai = 0; ai < 2; ++ai)
#pragma unroll
                for (int m = 0; m < 4; ++m) { bf16_t* rowp = QKV + (size_t)(row0 + ai * 128 + m * 16) * LDQ + col0;
#pragma unroll
                    for (int bj = 0; bj < 2; ++bj) { const f32x4 v0 = acc[ai][bj][m][0] * sc, v1 = acc[ai][bj][m][1] * sc; u32x4 w;
                        w.x = cvt_pk_bf16(v0[0], v0[1]); w.y = cvt_pk_bf16(v0[2], v0[3]); w.z = cvt_pk_bf16(v1[0], v1[1]); w.w = cvt_pk_bf16(v1[2], v1[3]);
                        *(u32x4*)(rowp + bj * 128) = w; } }
        } else if (pn < 22) {
            const int col0 = (pn - 14) * 256 + wc * 32 + 8 * fq;
#pragma unroll
            for (int ai = 0; ai < 2; ++ai)
#pragma unroll
                for (int m = 0; m < 4; ++m) { bf16_t* rowp = MG + (size_t)(row0 + ai * 128 + m * 16) * 2048 + col0;
#pragma unroll
                    for (int bj = 0; bj < 2; ++bj) { const f32x4 v0 = acc[ai][bj][m][0], v1 = acc[ai][bj][m][1]; u32x4 w;
                        w.x = cvt_pk_bf16(sigmoidf_(v0[0]), sigmoidf_(v0[1])); w.y = cvt_pk_bf16(sigmoidf_(v0[2]), sigmoidf_(v0[3]));
                        w.z = cvt_pk_bf16(sigmoidf_(v1[0]), sigmoidf_(v1[1])); w.w = cvt_pk_bf16(sigmoidf_(v1[2]), sigmoidf_(v1[3]));
                        *(u32x4*)(rowp + bj * 128) = w; } }
        } else {
            if (wc == 0 && fq < 3) {
#pragma unroll
                for (int ai = 0; ai < 2; ++ai)
#pragma unroll
                    for (int m = 0; m < 4; ++m) { float* rowp = GN + (size_t)(row0 + ai * 128 + m * 16) * 32 + 8 * fq;
                        const f32x4 v0 = acc[ai][0][m][0], v1 = acc[ai][0][m][1];
                        *(f32x4*)(rowp) = (f32x4){sigmoidf_(v0[0]), sigmoidf_(v0[1]), sigmoidf_(v0[2]), sigmoidf_(v0[3])};
                        *(f32x4*)(rowp + 4) = (f32x4){sigmoidf_(v1[0]), sigmoidf_(v1[1]), sigmoidf_(v1[2]), sigmoidf_(v1[3])}; }
            }
        }
    }
};
template <int PASS> struct EpiUp {
    static constexpr bool PERM = true, AFTER_DRAIN = false;
    bf16_t* MERGED; const bf16_t* MG;
    __device__ __forceinline__ void operator()(const AccT& acc, const pg8::Unit& u, int wr, int wc, int fr, int fq) const {
        const int row0 = u.pm * 256 + wr * 64 + fr; const int col0 = u.pn * 256 + wc * 32 + 8 * fq;
#pragma unroll
        for (int ai = 0; ai < 2; ++ai)
#pragma unroll
            for (int m = 0; m < 4; ++m) { const size_t row = (size_t)(row0 + ai * 128 + m * 16);
#pragma unroll
                for (int bj = 0; bj < 2; ++bj) {
                    const u32x4 gw = *(const u32x4*)(MG + row * 2048 + PASS * 1024 + col0 + bj * 128);
                    bf16_t* op = MERGED + row * 1024 + col0 + bj * 128;
                    const f32x4 v0 = acc[ai][bj][m][0], v1 = acc[ai][bj][m][1];
                    float r[8] = {v0[0] * bf_lo(gw.x), v0[1] * bf_hi(gw.x), v0[2] * bf_lo(gw.y), v0[3] * bf_hi(gw.y), v1[0] * bf_lo(gw.z), v1[1] * bf_hi(gw.z), v1[2] * bf_lo(gw.w), v1[3] * bf_hi(gw.w)};
                    if (PASS == 1) { const u32x4 ow = *(const u32x4*)op;
                        r[0] += bf_lo(ow.x); r[1] += bf_hi(ow.x); r[2] += bf_lo(ow.y); r[3] += bf_hi(ow.y); r[4] += bf_lo(ow.z); r[5] += bf_hi(ow.z); r[6] += bf_lo(ow.w); r[7] += bf_hi(ow.w); }
                    u32x4 w; w.x = cvt_pk_bf16(r[0], r[1]); w.y = cvt_pk_bf16(r[2], r[3]); w.z = cvt_pk_bf16(r[4], r[5]); w.w = cvt_pk_bf16(r[6], r[7]);
                    *(u32x4*)op = w; }
                asm volatile("" ::: "memory"); }
    }
};
struct EpiOut {
    static constexpr bool PERM = true, AFTER_DRAIN = false;
    const float* xin; float* xout; const float* g1;
    __device__ __forceinline__ void operator()(const AccT& acc, const pg8::Unit& u, int wr, int wc, int fr, int fq) const {
        const int row0 = u.pm * 256 + wr * 64 + fr; const int col0 = u.pn * 256 + wc * 32 + 8 * fq; const int b = u.pm >> 4;
        f32x4 gv[2][2];
#pragma unroll
        for (int bj = 0; bj < 2; ++bj)
#pragma unroll
            for (int n = 0; n < 2; ++n) gv[bj][n] = *(const f32x4*)(g1 + (size_t)b * 6144 + col0 + bj * 128 + 4 * n);
#pragma unroll
        for (int ai = 0; ai < 2; ++ai)
#pragma unroll
            for (int m = 0; m < 4; ++m) { const size_t off = (size_t)(row0 + ai * 128 + m * 16) * 1024 + col0;
#pragma unroll
                for (int bj = 0; bj < 2; ++bj)
#pragma unroll
                    for (int n = 0; n < 2; ++n) { const f32x4 xv = *(const f32x4*)(xin + off + bj * 128 + 4 * n);
                        *(f32x4*)(xout + off + bj * 128 + 4 * n) = xv + gv[bj][n] * acc[ai][bj][m][n]; }
                asm volatile("" ::: "memory"); }
    }
};
struct EpiMoe1 {
    static constexpr bool PERM = true, AFTER_DRAIN = false;
    bf16_t* ACT;
    __device__ __forceinline__ void operator()(const AccT& acc, const pg8::Unit& u, int wr, int wc, int fr, int fq) const {
        const int row0 = u.pm * 256 + wr * 64 + fr; const int col0 = u.pn * 128 + wc * 32 + 8 * fq;
#pragma unroll
        for (int ai = 0; ai < 2; ++ai)
#pragma unroll
            for (int m = 0; m < 4; ++m) { bf16_t* op = ACT + (size_t)(row0 + ai * 128 + m * 16) * 512 + col0; float r[8];
#pragma unroll
                for (int n = 0; n < 2; ++n)
#pragma unroll
                    for (int j = 0; j < 4; ++j) { const float a = acc[ai][0][m][n][j], bb = acc[ai][1][m][n][j]; r[n * 4 + j] = a * sigmoidf_(a) * bb; }
                u32x4 w; w.x = cvt_pk_bf16(r[0], r[1]); w.y = cvt_pk_bf16(r[2], r[3]); w.z = cvt_pk_bf16(r[4], r[5]); w.w = cvt_pk_bf16(r[6], r[7]);
                *(u32x4*)op = w; }
    }
};
struct EpiPlain {
    static constexpr bool PERM = true, AFTER_DRAIN = false;
    bf16_t* O; int ldc;
    __device__ __forceinline__ void operator()(const AccT& acc, const pg8::Unit& u, int wr, int wc, int fr, int fq) const {
        const int row0 = u.pm * 256 + wr * 64 + fr; const int col0 = u.pn * 256 + wc * 32 + 8 * fq;
#pragma unroll
        for (int ai = 0; ai < 2; ++ai)
#pragma unroll
            for (int m = 0; m < 4; ++m) { bf16_t* rowp = O + (size_t)(row0 + ai * 128 + m * 16) * ldc + col0;
#pragma unroll
                for (int bj = 0; bj < 2; ++bj) { const f32x4 v0 = acc[ai][bj][m][0], v1 = acc[ai][bj][m][1]; u32x4 w;
                    w.x = cvt_pk_bf16(v0[0], v0[1]); w.y = cvt_pk_bf16(v0[2], v0[3]); w.z = cvt_pk_bf16(v1[0], v1[1]); w.w = cvt_pk_bf16(v1[2], v1[3]);
                    *(u32x4*)(rowp + bj * 128) = w; } }
    }
};
__device__ __forceinline__ int crow(int r, int hi) { return (r & 3) + 8 * (r >> 2) + 4 * hi; }
__device__ __forceinline__ float gelu_tanh(float x) { const float u2 = 2.0f * 0.7978845608028654f * (x + 0.044715f * x * x * x); return x * __builtin_amdgcn_rcpf(1.0f + __builtin_amdgcn_exp2f(-u2 * LOG2E)); }
struct EpiCmp {
    static constexpr bool PERM = true, AFTER_DRAIN = true;
    bf16_t* HID; const float* CB1; const bf16_t* CW2T; bf16_t* KC;
    __device__ __forceinline__ void fused(const AccT& acc, const pg8::Unit& u, int wr, int wc, int fr, int fq, int wid, int lane) const {
        const int kv = u.pm >> 4; const int row0 = u.pm * 256 + wr * 64 + fr; const int col0 = wc * 32 + 8 * fq;
        const float* bias = CB1 + kv * 256;
        f32x4 bv[2][2];
#pragma unroll
        for (int bj = 0; bj < 2; ++bj)
#pragma unroll
            for (int n = 0; n < 2; ++n) bv[bj][n] = *(const f32x4*)(bias + col0 + bj * 128 + 4 * n);
#pragma unroll
        for (int ai = 0; ai < 2; ++ai)
#pragma unroll
            for (int m = 0; m < 4; ++m) { bf16_t* rowp = HID + (size_t)(row0 + ai * 128 + m * 16) * 256 + col0;
#pragma unroll
                for (int bj = 0; bj < 2; ++bj) { const f32x4 v0 = acc[ai][bj][m][0] + bv[bj][0], v1 = acc[ai][bj][m][1] + bv[bj][1]; u32x4 w;
                    w.x = cvt_pk_bf16(gelu_tanh(v0[0]), gelu_tanh(v0[1])); w.y = cvt_pk_bf16(gelu_tanh(v0[2]), gelu_tanh(v0[3]));
                    w.z = cvt_pk_bf16(gelu_tanh(v1[0]), gelu_tanh(v1[1])); w.w = cvt_pk_bf16(gelu_tanh(v1[2]), gelu_tanh(v1[3]));
                    *(u32x4*)(rowp + bj * 128) = w; } }
        VM_WAIT(); __syncthreads();
        const int r32 = lane & 31, hi = lane >> 5;
        const bf16_t* ap = HID + (size_t)(u.pm * 256 + 32 * wid + r32) * 256 + hi * 8;
        const bf16_t* bp = CW2T + (size_t)kv * 64 * 256 + (size_t)r32 * 256 + hi * 8;
        f32x16 o0 = {}, o1 = {};
#pragma unroll 4
        for (int ks = 0; ks < 16; ++ks) {
            const bf16x8 a = *(const bf16x8*)(ap + ks * 16);
            const bf16x8 b0 = *(const bf16x8*)(bp + ks * 16), b1 = *(const bf16x8*)(bp + 32 * 256 + ks * 16);
            o0 = __builtin_amdgcn_mfma_f32_32x32x16_bf16(a, b0, o0, 0, 0, 0);
            o1 = __builtin_amdgcn_mfma_f32_32x32x16_bf16(a, b1, o1, 0, 0, 0);
        }
        bf16_t* kc = KC + (size_t)u.pm * 256 * 64;
#pragma unroll
        for (int r = 0; r < 16; ++r) { const int c = 32 * wid + crow(r, hi); const bool pad = (c == 255);
            kc[(size_t)c * 64 + r32] = pad ? (bf16_t)0 : (bf16_t)(cvt_pk_bf16(o0[r], 0.f) & 0xffffu);
            kc[(size_t)c * 64 + 32 + r32] = pad ? (bf16_t)0 : (bf16_t)(cvt_pk_bf16(o1[r], 0.f) & 0xffffu); }
    }
};

namespace att {
constexpr int L_RING = 0;
constexpr int L_WSF = 32768;
constexpr int L_OST = 34816;
constexpr int L_BKT = 67584;
constexpr int L_TBH = 71680;
constexpr int L_GSH = 72192;
constexpr int L_SEL = 75264;
constexpr int L_IMP = 75840;
constexpr int L_END = L_IMP + 65536;
static_assert(L_END <= LDS_MISC, "attention LDS map");

__device__ __forceinline__ void glds16(const void* gsrc, unsigned lds_dst) { unsigned keep;
    asm volatile("s_mov_b32 %0, m0\n\ts_mov_b32 m0, %2\n\ts_nop 0\n\tglobal_load_lds_dwordx4 %1, off\n\ts_mov_b32 m0, %0" : "=&s"(keep) : "v"(gsrc), "s"(lds_dst) : "memory"); }
__device__ __forceinline__ int bucket_of(int d) {
    if (d < 16) return d;
    int b = 16;
    b += (d >= 22); b += (d >= 30); b += (d >= 40); b += (d >= 54); b += (d >= 73); b += (d >= 99); b += (d >= 134); b += (d >= 182);
    b += (d >= 246); b += (d >= 332); b += (d >= 450); b += (d >= 609); b += (d >= 825); b += (d >= 1117); b += (d >= 1513);
    return b;
}
__device__ __forceinline__ void qkt(f32x16& p0, f32x16& p1, const LAS unsigned char* Kslot, const bf16x8 (&qr)[4], int r32, int hi) {
    const LAS unsigned char* kb = Kslot + hi * 1024 + r32 * 16;
    p0 = (f32x16){}; p1 = (f32x16){};
#pragma unroll
    for (int d0 = 0; d0 < 4; ++d0) {
        const bf16x8 b0 = *(const LAS bf16x8*)(kb + d0 * 2048);
        const bf16x8 b1 = *(const LAS bf16x8*)(kb + d0 * 2048 + 512);
        p0 = __builtin_amdgcn_mfma_f32_32x32x16_bf16(b0, qr[d0], p0, 0, 0, 0);
        p1 = __builtin_amdgcn_mfma_f32_32x32x16_bf16(b1, qr[d0], p1, 0, 0, 0);
    }
}
__device__ __forceinline__ void pv(f32x16 (&o)[2], int vb, bf16x8 pa0, bf16x8 pa1, bf16x8 pa2, bf16x8 pa3) {
#pragma unroll
    for (int d0 = 0; d0 < 2; ++d0) { s16x4 lo[4], hi[4];
#pragma unroll
        for (int ks = 0; ks < 4; ++ks) {
            asm volatile("ds_read_b64_tr_b16 %0,%1 offset:%c2" : "=&v"(lo[ks]) : "v"(vb), "i"(d0 * 4096 + ks * 1024) : "memory");
            asm volatile("ds_read_b64_tr_b16 %0,%1 offset:%c2" : "=&v"(hi[ks]) : "v"(vb), "i"(d0 * 4096 + ks * 1024 + 512) : "memory"); }
        asm volatile("s_waitcnt lgkmcnt(0)" ::: "memory"); __builtin_amdgcn_sched_barrier(0);
#define PK(k) (bf16x8){lo[k][0], lo[k][1], lo[k][2], lo[k][3], hi[k][0], hi[k][1], hi[k][2], hi[k][3]}
        o[d0] = __builtin_amdgcn_mfma_f32_32x32x16_bf16(pa0, PK(0), o[d0], 0, 0, 0);
        o[d0] = __builtin_amdgcn_mfma_f32_32x32x16_bf16(pa1, PK(1), o[d0], 0, 0, 0);
        o[d0] = __builtin_amdgcn_mfma_f32_32x32x16_bf16(pa2, PK(2), o[d0], 0, 0, 0);
        o[d0] = __builtin_amdgcn_mfma_f32_32x32x16_bf16(pa3, PK(3), o[d0], 0, 0, 0);
#undef PK
    }
}
__device__ __forceinline__ float xhalf_max(float v) { auto rr = __builtin_amdgcn_permlane32_swap(__float_as_uint(v), __float_as_uint(v), false, false); return __builtin_fmaxf(__uint_as_float(rr[0]), __uint_as_float(rr[1])); }
__device__ __forceinline__ float xhalf_sum(float v) { auto rr = __builtin_amdgcn_permlane32_swap(__float_as_uint(v), __float_as_uint(v), false, false); return __uint_as_float(rr[0]) + __uint_as_float(rr[1]); }

template <int KMUL>
__device__ __forceinline__ void tile_scores(f32x16& p0, f32x16& p1, int base_hi, int maxd, int dsh, bool laneok, const LAS unsigned char* bkt, const LAS float* tb) {
#pragma unroll
    for (int r = 0; r < 16; ++r) {
        const int off = KMUL * ((r & 3) + 8 * (r >> 2));
        { const int dist = base_hi - off; const bool ok = laneok && ((unsigned)dist <= (unsigned)maxd); int di = (dist < 0 ? 0 : dist) << dsh; di = di > 4095 ? 4095 : di;
          const float bb = tb[bkt[di]]; p0[r] = ok ? p0[r] + bb : -INFINITY; }
        { const int dist = base_hi - off - KMUL * 32; const bool ok = laneok && ((unsigned)dist <= (unsigned)maxd); int di = (dist < 0 ? 0 : dist) << dsh; di = di > 4095 ? 4095 : di;
          const float bb = tb[bkt[di]]; p1[r] = ok ? p1[r] + bb : -INFINITY; }
    }
}
#define ATT_PACK(p0, p1, pw0, pw1, pw2, pw3) do { \
    pw0 = (u32x4){cvt_pk_bf16(p0[0], p0[1]), cvt_pk_bf16(p0[2], p0[3]), cvt_pk_bf16(p0[4], p0[5]), cvt_pk_bf16(p0[6], p0[7])}; \
    pw1 = (u32x4){cvt_pk_bf16(p0[8], p0[9]), cvt_pk_bf16(p0[10], p0[11]), cvt_pk_bf16(p0[12], p0[13]), cvt_pk_bf16(p0[14], p0[15])}; \
    pw2 = (u32x4){cvt_pk_bf16(p1[0], p1[1]), cvt_pk_bf16(p1[2], p1[3]), cvt_pk_bf16(p1[4], p1[5]), cvt_pk_bf16(p1[6], p1[7])}; \
    pw3 = (u32x4){cvt_pk_bf16(p1[8], p1[9]), cvt_pk_bf16(p1[10], p1[11]), cvt_pk_bf16(p1[12], p1[13]), cvt_pk_bf16(p1[14], p1[15])}; } while (0)

struct LoopP {
    const bf16_t* Kb; const bf16_t* Vb; long pitch;
    unsigned long long tmask;
    int uqp; int maxd; int dsh; unsigned long long lanesel;
    int wlo, whi;
    const LAS float* tb;
    LAS float* imp;
};
template <int KMUL, int MODE>
__device__ __forceinline__ void attn_loop(LAS unsigned char* lds, int wid, int lane, const bf16x8 (&qr)[4], const LoopP P, float& m, float& l, f32x16 (&o)[2]) {
    const int r32 = lane & 31, hi = lane >> 5;
    const unsigned lds0 = (unsigned)(uintptr_t)lds;
    unsigned tlo = __builtin_amdgcn_readfirstlane((unsigned)P.tmask), thi = __builtin_amdgcn_readfirstlane((unsigned)(P.tmask >> 32));
    unsigned long long tm = ((unsigned long long)thi << 32) | tlo;
    if (tm == 0ull) return;
    const LAS unsigned char* bkt = lds + L_BKT;
    LAS float* wsf = (LAS float*)(lds + L_WSF) + wid * 64;
    const bf16_t* ksrc = P.Kb + (long)lane * P.pitch + wid * 8;
    const bf16_t* vsrc = P.Vb + (long)(16 * (wid & 3) + (lane >> 2)) * P.pitch + (wid >> 2) * 32 + (lane & 3) * 8;
    const int vb0 = (int)lds0 + ((lane >> 4) & 1) * 32 + (lane & 3) * 8 + (4 * hi + ((lane & 15) >> 2)) * 64;
#define ATT_DMA(t, st) do { glds16(ksrc + (long)(t) * 64 * P.pitch, (unsigned)__builtin_amdgcn_readfirstlane(lds0 + L_RING + (st) * 16384 + wid * 1024)); \
                            glds16(vsrc + (long)(t) * 64 * P.pitch, (unsigned)__builtin_amdgcn_readfirstlane(lds0 + L_RING + (st) * 16384 + 8192 + wid * 1024)); } while (0)
    int t = __builtin_ctzll(tm); tm &= tm - 1ull;
    int st = 0;
    ATT_DMA(t, 0);
    for (;;) {
        const bool hn = (tm != 0ull); int tn = 0;
        if (hn) { tn = __builtin_ctzll(tm); tm &= tm - 1ull; ATT_DMA(tn, st ^ 1); asm volatile("s_waitcnt vmcnt(2)\n\ts_barrier" ::: "memory"); }
        else { asm volatile("s_waitcnt vmcnt(0)\n\ts_barrier" ::: "memory"); }
        if (t >= P.wlo && t <= P.whi) {
            f32x16 p0, p1;
            qkt(p0, p1, lds + L_RING + st * 16384, qr, r32, hi);
            const bool laneok = ((P.lanesel >> t) & 1ull) != 0ull;
            tile_scores<KMUL>(p0, p1, P.uqp - KMUL * (64 * t + 4 * hi), P.maxd, P.dsh, laneok, bkt, P.tb);
            if (MODE == 2) {
#pragma unroll
                for (int r = 0; r < 16; ++r) { p0[r] = __builtin_amdgcn_exp2f(p0[r] - m) * l; p1[r] = __builtin_amdgcn_exp2f(p1[r] - m) * l; }
#pragma unroll
                for (int k = 0; k < 4; ++k) { const int n0 = 16 * t + 2 * k + hi;
                    P.imp[n0] += 2.0f * (p0[4 * k] + p0[4 * k + 1] + p0[4 * k + 2]) + p0[4 * k + 3];
                    P.imp[n0 + 8] += 2.0f * (p1[4 * k] + p1[4 * k + 1] + p1[4 * k + 2]) + p1[4 * k + 3]; }
#pragma unroll
                for (int k = 0; k < 4; ++k) { const int n0 = 16 * t + 2 * k + hi;
                    P.imp[n0 + 1] += p0[4 * k + 3];
                    if (n0 + 9 < 64) P.imp[n0 + 9] += p1[4 * k + 3]; }
            } else {
                float rm = p0[0];
#pragma unroll
                for (int r = 1; r < 16; ++r) rm = __builtin_fmaxf(rm, p0[r]);
#pragma unroll
                for (int r = 0; r < 16; ++r) rm = __builtin_fmaxf(rm, p1[r]);
                rm = xhalf_max(rm);
                const float mnew = __builtin_fmaxf(m, rm);
                const float msafe = (mnew == -INFINITY) ? 0.0f : mnew;
                const float alpha = __builtin_amdgcn_exp2f(m - msafe);
                float ps = 0.f;
#pragma unroll
                for (int r = 0; r < 16; ++r) { p0[r] = __builtin_amdgcn_exp2f(p0[r] - msafe); p1[r] = __builtin_amdgcn_exp2f(p1[r] - msafe); ps += p0[r] + p1[r]; }
                l = l * alpha + ps; m = mnew;
                if (MODE == 0) {
                    if (__any(alpha != 1.0f)) {
                        if (hi == 0) wsf[r32] = alpha;
                        LDS_WAIT();
#pragma unroll
                        for (int r = 0; r < 16; ++r) { const float f = wsf[crow(r, hi)]; o[0][r] *= f; o[1][r] *= f; }
                    }
                }
            }
            if (MODE != 1) {
                u32x4 pw0, pw1, pw2, pw3; ATT_PACK(p0, p1, pw0, pw1, pw2, pw3);
                pv(o, vb0 + L_RING + st * 16384 + 8192, __builtin_bit_cast(bf16x8, pw0), __builtin_bit_cast(bf16x8, pw1), __builtin_bit_cast(bf16x8, pw2), __builtin_bit_cast(bf16x8, pw3));
            }
        }
        asm volatile("s_waitcnt lgkmcnt(0)\n\ts_barrier" ::: "memory");
        if (!hn) break;
        t = tn; st ^= 1;
    }
#undef ATT_DMA
}
__device__ __forceinline__ void stage_rows(LAS unsigned char* lds, int wid, int lane, const f32x16 (&ot)[2]) {
    const int r32 = lane & 31, hi = lane >> 5;
    LAS bf16_t* stg = (LAS bf16_t*)(lds + L_OST) + wid * 2048;
#pragma unroll
    for (int r = 0; r < 16; ++r) { const int orow = crow(r, hi);
#pragma unroll
        for (int d0 = 0; d0 < 2; ++d0) stg[orow * 64 + d0 * 32 + r32] = (bf16_t)(cvt_pk_bf16(ot[d0][r], 0.f) & 0xffffu); }
    LDS_WAIT();
}
}

struct Ctx { int tid, lane, wave, vcu, G, bx; LAS unsigned char* lds; };

__device__ __forceinline__ void tr_item(const float* W, size_t ldw, int srccol, int nvalid, bf16_t* WT, size_t ldk, int dstrow, int k0, LAS float* scr, int lane) {
#pragma unroll 8
    for (int i = 0; i < 32; ++i) { const int kk = 2 * i + (lane >> 5), n = lane & 31; scr[kk * 33 + n] = (n < nvalid) ? W[(size_t)(k0 + kk) * ldw + srccol + n] : 0.f; }
    LDS_WAIT(); asm volatile("" ::: "memory");
    const int c = lane & 7;
#pragma unroll
    for (int j = 0; j < 4; ++j) { const int n = (lane >> 3) + 8 * j; const LAS float* s = scr + (8 * c) * 33 + n;
        u32x4 o; o.x = cvt_pk_bf16(s[0 * 33], s[1 * 33]); o.y = cvt_pk_bf16(s[2 * 33], s[3 * 33]); o.z = cvt_pk_bf16(s[4 * 33], s[5 * 33]); o.w = cvt_pk_bf16(s[6 * 33], s[7 * 33]);
        *(u32x4*)(WT + (size_t)(dstrow + n) * ldk + k0 + 8 * c) = o; }
    LDS_WAIT(); asm volatile("" ::: "memory");
}
__device__ __forceinline__ void conv_small(const Args& a, const Ctx& C) {
    LAS float* scr = (LAS float*)(C.lds + C.wave * 16384);
    const int gw = C.vcu * NWAVES + C.wave, NGW = C.G * NWAVES;
    constexpr int I_WIN = 184 * 16, I_CW1 = 2 * 8 * 32, I_WUN = 32 * 8, I_WUD = 32 * 4, I_WO = 32 * 16, I_CW2 = 2 * 2 * 4;
    constexpr int PER = I_WIN + I_CW1 + I_WUN + I_WUD + I_WO + I_CW2;
    unsigned char* ws = a.ws;
    for (int it = gw; it < 2 * PER; it += NGW) {
        const int l = it / PER; int r = it % PER;
        if (r < I_WIN) { const int nb = r / 16, kb = r % 16; const int nd = 32 * nb; int src, nv = 32;
            if (nd < 1280) src = nd; else if (nd < 5632) src = nd + 24; else if (nd == 5632) { src = 1280; nv = 24; } else { src = 0; nv = 0; }
            tr_item(a.w_in + (size_t)l * DM * INW, INW, src, nv, (bf16_t*)(ws + WS_WINT) + (size_t)l * NIN * DM, DM, nd, 64 * kb, scr, C.lane); continue; }
        r -= I_WIN;
        if (r < I_CW1) { const int kv = r / 256, q = r % 256, nb = q / 32, kb = q % 32;
            tr_item(a.cmp_w1 + (size_t)(l * 2 + kv) * 2048 * 256, 256, 32 * nb, 32, (bf16_t*)(ws + WS_CW1T) + (size_t)(l * 2 + kv) * 256 * 2048, 2048, 32 * nb, 64 * kb, scr, C.lane); continue; }
        r -= I_CW1;
        if (r < I_WUN) { const int nb = r / 8, kb = r % 8;
            tr_item(a.w_up_nsa + (size_t)l * 512 * 1024, 1024, 32 * nb, 32, (bf16_t*)(ws + WS_WUNT) + (size_t)l * 1024 * 512, 512, 32 * nb, 64 * kb, scr, C.lane); continue; }
        r -= I_WUN;
        if (r < I_WUD) { const int nb = r / 4, kb = r % 4;
            tr_item(a.w_up_dil + (size_t)l * 256 * 1024, 1024, 32 * nb, 32, (bf16_t*)(ws + WS_WUDT) + (size_t)l * 1024 * 256, 256, 32 * nb, 64 * kb, scr, C.lane); continue; }
        r -= I_WUD;
        if (r < I_WO) { const int nb = r / 16, kb = r % 16;
            tr_item(a.w_o + (size_t)l * 1024 * 1024, 1024, 32 * nb, 32, (bf16_t*)(ws + WS_WOT) + (size_t)l * 1024 * 1024, 1024, 32 * nb, 64 * kb, scr, C.lane); continue; }
        r -= I_WO;
        { const int kv = r / 8, q = r % 8, nb = q / 4, kb = q % 4;
            tr_item(a.cmp_w2 + (size_t)(l * 2 + kv) * 256 * 64, 64, 32 * nb, 32, (bf16_t*)(ws + WS_CW2T) + (size_t)(l * 2 + kv) * 64 * 256, 256, 32 * nb, 64 * kb, scr, C.lane); }
    }
}
__device__ __forceinline__ void conv_experts(const Args& a, const Ctx& C, int l) {
    LAS float* scr = (LAS float*)(C.lds + C.wave * 16384);
    const int gw = C.vcu * NWAVES + C.wave, NGW = C.G * NWAVES;
    constexpr int I_13 = 32 * 16, I_2 = 32 * 8, PER = I_13 + I_2;
    unsigned char* ws = a.ws;
    for (int it = gw; it < 32 * PER; it += NGW) {
        const int e = it / PER; int r = it % PER;
        if (r < I_13) { const int nb = r / 16, kb = r % 16; const int r0 = 32 * nb, pn = r0 >> 8, bj = (r0 >> 7) & 1, j0 = r0 & 127;
            const float* src = (bj ? a.exp_w3 : a.exp_w1) + (size_t)(l * 32 + e) * 1024 * 512;
            tr_item(src, 512, pn * 128 + j0, 32, (bf16_t*)(ws + WS_E13T) + (size_t)e * 1024 * 1024, 1024, r0, 64 * kb, scr, C.lane); continue; }
        r -= I_13;
        { const int nb = r / 8, kb = r % 8;
            tr_item(a.exp_w2 + (size_t)(l * 32 + e) * 512 * 1024, 1024, 32 * nb, 32, (bf16_t*)(ws + WS_E2T) + (size_t)e * 1024 * 512, 512, 32 * nb, 64 * kb, scr, C.lane); }
    }
}
__device__ __forceinline__ void prologue_vectors(const Args& a, const Ctx& C) {
    LAS float* sc = (LAS float*)(C.lds + 131072);
    LAS float* sl = (LAS float*)(C.lds);
    for (int i = C.tid; i < 8 * 1024; i += NTHR) { const float v = a.c[i]; sl[i] = v * sigmoidf_(v); }
    (void)sc;
    __syncthreads();
    const int gw = C.vcu * NWAVES + C.wave, NGW = C.G * NWAVES;
    float* MOD = (float*)(a.ws + WS_MOD); float* CB1 = (float*)(a.ws + WS_CB1);
    for (int it = gw; it < 192 + 16; it += NGW) {
        if (it < 192) { const int l = it / 96, col = (it % 96) * 64 + C.lane;
            const float* w = a.ada_w + (size_t)l * 1024 * 6144 + col;
            float acc[8];
#pragma unroll
            for (int b = 0; b < 8; ++b) acc[b] = 0.f;
            for (int k = 0; k < 1024; ++k) { const float wv = w[(size_t)k * 6144];
#pragma unroll
                for (int b = 0; b < 8; ++b) acc[b] += sl[b * 1024 + k] * wv; }
            const float bias = a.ada_b[l * 6144 + col];
#pragma unroll
            for (int b = 0; b < 8; ++b) MOD[(size_t)(l * 8 + b) * 6144 + col] = acc[b] + bias;
        } else { const int q = it - 192, lk = q / 4, col = (q % 4) * 64 + C.lane;
            const float* w = a.cmp_w1 + (size_t)lk * 2048 * 256 + col; const float* pos = a.cmp_pos + (size_t)lk * 2048;
            float acc = 0.f;
            for (int k = 0; k < 2048; ++k) acc += pos[k] * w[(size_t)k * 256];
            CB1[lk * 256 + col] = acc;
        }
    }
    __syncthreads();
}

__device__ __forceinline__ void moe_combine_row(const Args& a, int row, int lane, const float* g2  , f32x4 (&v)[4]) {
    const u32x4 rec = *(const u32x4*)(a.ws + WS_DEST + (size_t)row * 16);
    const bf16_t* Y = (const bf16_t*)(a.ws + WS_XS);
    const float w0 = __uint_as_float(rec.z), w1 = __uint_as_float(rec.w);
    const u32x2* y0 = (const u32x2*)(Y + (size_t)rec.x * 1024) + lane; const u32x2* y1 = (const u32x2*)(Y + (size_t)rec.y * 1024) + lane;
#pragma unroll
    for (int j = 0; j < 4; ++j) { const u32x2 p = y0[64 * j], q = y1[64 * j]; const f32x4 gg = *((const f32x4*)g2 + lane + 64 * j);
        v[j][0] += gg[0] * (w0 * bf_lo(p.x) + w1 * bf_lo(q.x)); v[j][1] += gg[1] * (w0 * bf_hi(p.x) + w1 * bf_hi(q.x));
        v[j][2] += gg[2] * (w0 * bf_lo(p.y) + w1 * bf_lo(q.y)); v[j][3] += gg[3] * (w0 * bf_hi(p.y) + w1 * bf_hi(q.y)); }
}
__device__ __forceinline__ void norm1_phase(const Args& a, const Ctx& C, int l) {
    const int gw = C.vcu * NWAVES + C.wave, NGW = C.G * NWAVES;
    const float* MOD = (const float*)(a.ws + WS_MOD); bf16_t* H = (bf16_t*)(a.ws + WS_H);
    const float* nw = a.norm1 + l * 1024;
    for (int row = gw; row < T; row += NGW) {
        const int b = row >> 12; const float* xr = (l == 0 ? a.x : (const float*)a.out) + (size_t)row * 1024;
        f32x4 v[4];
#pragma unroll
        for (int j = 0; j < 4; ++j) v[j] = *((const f32x4*)xr + C.lane + 64 * j);
        if (l == 1) { moe_combine_row(a, row, C.lane, MOD + (size_t)(0 * 8 + b) * 6144 + 5120, v);
#pragma unroll
            for (int j = 0; j < 4; ++j) *((f32x4*)(a.out + (size_t)row * 1024) + C.lane + 64 * j) = v[j]; }
        float ss = 0.f;
#pragma unroll
        for (int j = 0; j < 4; ++j) ss += (v[j][0] * v[j][0] + v[j][1] * v[j][1]) + (v[j][2] * v[j][2] + v[j][3] * v[j][3]);
        const float rstd = 1.0f / sqrtf(wave_sum(ss) * (1.0f / 1024.0f) + RMS_EPS);
        const float* mb = MOD + (size_t)(l * 8 + b) * 6144;
#pragma unroll
        for (int j = 0; j < 4; ++j) { const f32x4 g = *((const f32x4*)nw + C.lane + 64 * j), sh = *((const f32x4*)mb + C.lane + 64 * j), sc = *((const f32x4*)(mb + 1024) + C.lane + 64 * j);
            const f32x4 h = v[j] * rstd * g * (sc + 1.0f) + sh; u32x2 w; w.x = cvt_pk_bf16(h[0], h[1]); w.y = cvt_pk_bf16(h[2], h[3]);
            *((u32x2*)(H + (size_t)row * 1024) + C.lane + 64 * j) = w; }
    }
}
__device__ __forceinline__ void final_phase(const Args& a, const Ctx& C) {
    const int gw = C.vcu * NWAVES + C.wave, NGW = C.G * NWAVES;
    const float* MOD = (const float*)(a.ws + WS_MOD);
    for (int row = gw; row < T; row += NGW) {
        const int b = row >> 12; float* xr = a.out + (size_t)row * 1024;
        f32x4 v[4];
#pragma unroll
        for (int j = 0; j < 4; ++j) v[j] = *((const f32x4*)xr + C.lane + 64 * j);
        moe_combine_row(a, row, C.lane, MOD + (size_t)(1 * 8 + b) * 6144 + 5120, v);
        float ss = 0.f;
#pragma unroll
        for (int j = 0; j < 4; ++j) ss += (v[j][0] * v[j][0] + v[j][1] * v[j][1]) + (v[j][2] * v[j][2] + v[j][3] * v[j][3]);
        const float rstd = 1.0f / sqrtf(wave_sum(ss) * (1.0f / 1024.0f) + RMS_EPS);
#pragma unroll
        for (int j = 0; j < 4; ++j) { const f32x4 g = *((const f32x4*)a.norm_f + C.lane + 64 * j); *((f32x4*)xr + C.lane + 64 * j) = v[j] * rstd * g; }
    }
}
__device__ __forceinline__ void norm2_router_phase(const Args& a, const Ctx& C, int l) {
    LAS float* WL = (LAS float*)(C.lds);
    LAS int* wcnt = (LAS int*)(C.lds + LDS_MISC + 256);
    const float* wg = a.router_wg + (size_t)l * 1024 * 4; const float* we = a.router_we + (size_t)l * 1024 * 32;
    for (int i = C.tid; i < 1024 * 4; i += NTHR) { const int k = i >> 2, c = i & 3; WL[c * 1024 + k] = wg[i]; }
    for (int i = C.tid; i < 1024 * 32; i += NTHR) { const int k = i >> 5, c = i & 31; WL[(4 + c) * 1024 + k] = we[i]; }
    __syncthreads();
    const float* MOD = (const float*)(a.ws + WS_MOD); bf16_t* H2 = (bf16_t*)(a.ws + WS_H2);
    const float* nw = a.norm2 + l * 1024; const float* bg = a.router_bg + l * 4; const float* be = a.router_be + l * 32;
    int* CNTBLK = (int*)(a.ws + WS_CNTBLK);
    for (int ch = C.vcu; ch < T / 128; ch += C.G) {
        int my_e0 = 0, my_e1 = 0; float my_w0 = 0.f, my_w1 = 0.f;
        for (int j = 0; j < 16; ++j) {
            const int row = ch * 128 + C.wave * 16 + j; const int b = row >> 12;
            const float* xr = a.out + (size_t)row * 1024;
            f32x4 v[4];
#pragma unroll
            for (int q = 0; q < 4; ++q) v[q] = *((const f32x4*)xr + C.lane + 64 * q);
            float ss = 0.f;
#pragma unroll
            for (int q = 0; q < 4; ++q) ss += (v[q][0] * v[q][0] + v[q][1] * v[q][1]) + (v[q][2] * v[q][2] + v[q][3] * v[q][3]);
            const float rstd = 1.0f / sqrtf(wave_sum(ss) * (1.0f / 1024.0f) + RMS_EPS);
            const float* mb = MOD + (size_t)(l * 8 + b) * 6144 + 3072;
#pragma unroll
            for (int q = 0; q < 4; ++q) { const f32x4 g = *((const f32x4*)nw + C.lane + 64 * q), sh = *((const f32x4*)mb + C.lane + 64 * q), sc = *((const f32x4*)(mb + 1024) + C.lane + 64 * q);
                v[q] = v[q] * rstd * g * (sc + 1.0f) + sh; u32x2 w; w.x = cvt_pk_bf16(v[q][0], v[q][1]); w.y = cvt_pk_bf16(v[q][2], v[q][3]);
                *((u32x2*)(H2 + (size_t)row * 1024) + C.lane + 64 * q) = w; }
            float lg[4];
#pragma unroll
            for (int c = 0; c < 4; ++c) { float s = 0.f;
#pragma unroll
                for (int q = 0; q < 4; ++q) { const f32x4 w = *((const LAS f32x4*)(WL + c * 1024) + C.lane + 64 * q); s += (v[q][0] * w[0] + v[q][1] * w[1]) + (v[q][2] * w[2] + v[q][3] * w[3]); }
                lg[c] = wave_sum(s) + bg[c]; }
            int grp = 0; float gmax = lg[0];
#pragma unroll
            for (int c = 1; c < 4; ++c) if (lg[c] > gmax) { gmax = lg[c]; grp = c; }
            float gs = 0.f;
#pragma unroll
            for (int c = 0; c < 4; ++c) gs += __builtin_amdgcn_exp2f((lg[c] - gmax) * LOG2E);
            const float pgrp = 1.0f / gs;
            grp = __builtin_amdgcn_readfirstlane(grp);
            float le[8];
#pragma unroll
            for (int e = 0; e < 8; ++e) { float s = 0.f; const LAS float* wrow = WL + (4 + grp * 8 + e) * 1024;
#pragma unroll
                for (int q = 0; q < 4; ++q) { const f32x4 w = *((const LAS f32x4*)wrow + C.lane + 64 * q); s += (v[q][0] * w[0] + v[q][1] * w[1]) + (v[q][2] * w[2] + v[q][3] * w[3]); }
                le[e] = wave_sum(s) + be[grp * 8 + e]; }
            int i0 = 0; float v0 = le[0];
#pragma unroll
            for (int e = 1; e < 8; ++e) if (le[e] > v0) { v0 = le[e]; i0 = e; }
            int i1 = -1; float v1 = -INFINITY;
#pragma unroll
            for (int e = 0; e < 8; ++e) if (e != i0 && le[e] > v1) { v1 = le[e]; i1 = e; }
            const float ex = __builtin_amdgcn_exp2f((v1 - v0) * LOG2E);
            const float w0 = pgrp / (1.0f + ex), w1 = pgrp * ex / (1.0f + ex);
            if (C.lane == j) { my_e0 = grp * 8 + i0; my_e1 = grp * 8 + i1; my_w0 = w0; my_w1 = w1; }
        }
        const int ea = bperm_i(C.lane >> 1, my_e0), eb = bperm_i(C.lane >> 1, my_e1);
        const int es = (C.lane < 32) ? ((C.lane & 1) ? eb : ea) : -1;
        int rank = 0, cnt = 0;
#pragma unroll
        for (int s = 0; s < 32; ++s) { const int v = __builtin_amdgcn_readlane(es, s); rank += (v == es && s < C.lane) ? 1 : 0; cnt += (v == C.lane) ? 1 : 0; }
        __syncthreads();
        if (C.lane < 32) wcnt[C.wave * 32 + C.lane] = cnt;
        __syncthreads();
        int lrank = rank;
        if (C.lane < 32) { for (int w = 0; w < C.wave; ++w) lrank += wcnt[w * 32 + es]; }
        if (C.wave == 0 && C.lane < 32) { int tot = 0;
#pragma unroll
            for (int w = 0; w < 8; ++w) tot += wcnt[w * 32 + C.lane];
            CNTBLK[ch * 32 + C.lane] = tot; }
        const int lr0 = bperm_i((2 * C.lane) & 63, lrank), lr1 = bperm_i((2 * C.lane + 1) & 63, lrank);
        if (C.lane < 16) { const int row = ch * 128 + C.wave * 16 + C.lane;
            u32x4 rec; rec.x = (unsigned)my_e0 | ((unsigned)my_e1 << 8); rec.y = (unsigned)lr0 | ((unsigned)lr1 << 16); rec.z = __float_as_uint(my_w0); rec.w = __float_as_uint(my_w1);
            *(u32x4*)(a.ws + WS_REC + (size_t)row * 16) = rec; }
    }
}
__device__ __forceinline__ void moe_scatter_phase(const Args& a, const Ctx& C) {
    LAS int* part_lt = (LAS int*)(C.lds);
    LAS int* part_all = part_lt + 512;
    LAS int* base = part_all + 512;
    LAS int* tot = base + 32;
    LAS int* pst = tot + 32;
    const int* CNTBLK = (const int*)(a.ws + WS_CNTBLK);
    int* TILEE = (int*)(a.ws + WS_TILEE);
    const bf16_t* H2 = (const bf16_t*)(a.ws + WS_H2); bf16_t* XS = (bf16_t*)(a.ws + WS_XS);
    for (int ch = C.vcu; ch < T / 128; ch += C.G) {
        __syncthreads();
        { const int e = C.tid & 31, p = C.tid >> 5; int slt = 0, sall = 0;
            for (int c = p; c < T / 128; c += 16) { const int v = CNTBLK[c * 32 + e]; sall += v; slt += (c < ch) ? v : 0; }
            part_lt[p * 32 + e] = slt; part_all[p * 32 + e] = sall; }
        __syncthreads();
        if (C.tid < 32) { int b = 0, t2 = 0;
#pragma unroll
            for (int p = 0; p < 16; ++p) { b += part_lt[p * 32 + C.tid]; t2 += part_all[p * 32 + C.tid]; }
            base[C.tid] = b; tot[C.tid] = t2; }
        __syncthreads();
        if (C.tid < 32) { int ps = 0; for (int e = 0; e < C.tid; ++e) ps += (tot[e] + 255) & ~255; pst[C.tid] = ps;
            if (ch == 0) { const int nt = (tot[C.tid] + 255) >> 8; const int t0 = ps >> 8; for (int m = 0; m < nt; ++m) TILEE[16 + t0 + m] = C.tid; if (C.tid == 31) TILEE[0] = t0 + nt; } }
        __syncthreads();
        int d0 = 0, d1 = 0;
        if (C.lane < 16) { const int row = ch * 128 + C.wave * 16 + C.lane;
            const u32x4 rec = *(const u32x4*)(a.ws + WS_REC + (size_t)row * 16);
            const int e0 = rec.x & 255, e1 = (rec.x >> 8) & 255;
            d0 = pst[e0] + base[e0] + (int)(rec.y & 0xffffu); d1 = pst[e1] + base[e1] + (int)(rec.y >> 16);
            u32x4 o; o.x = (unsigned)d0; o.y = (unsigned)d1; o.z = rec.z; o.w = rec.w;
            *(u32x4*)(a.ws + WS_DEST + (size_t)row * 16) = o; }
        for (int j = 0; j < 16; ++j) { const int row = ch * 128 + C.wave * 16 + j;
            const int t0 = __builtin_amdgcn_readlane(d0, j), t1 = __builtin_amdgcn_readlane(d1, j);
            const u32x4* src = (const u32x4*)(H2 + (size_t)row * 1024) + C.lane;
            const u32x4 va = src[0], vb = src[64];
            u32x4* o0 = (u32x4*)(XS + (size_t)t0 * 1024) + C.lane; u32x4* o1 = (u32x4*)(XS + (size_t)t1 * 1024) + C.lane;
            o0[0] = va; o0[64] = vb; o1[0] = va; o1[64] = vb; }
    }
}
struct MoeOrder {
    int G, c, nu; int ex[8]; const char* A; const char* B; size_t tA, tB, eB;
    __device__ __forceinline__ bool next(int i, pg8::Unit& u) const {
        const int L = i * G + c; if (i >= 8 || L >= nu) return false;
        const int e = i == 0 ? ex[0] : i == 1 ? ex[1] : i == 2 ? ex[2] : i == 3 ? ex[3] : i == 4 ? ex[4] : i == 5 ? ex[5] : i == 6 ? ex[6] : ex[7];
        u.pm = L >> 2; u.pn = L & 3; u.A = A + (size_t)u.pm * tA; u.B = B + (size_t)e * eB + (size_t)u.pn * tB; return true;
    }
};

__device__ __forceinline__ void dil_unit(const Args& a, const Ctx& C, int du) {
    using namespace att;
    LAS unsigned char* lds = C.lds;
    const int x = du & 15; int r = du >> 4; const int h = r & 3; r >>= 2; const int grp = r % 3, b = r / 3;
    const int dsh = 2 * grp, d = 1 << dsh; const int nub = 16 >> dsh; const int res = x / nub, ub = x % nub;
    const int wid = C.wave, lane = C.lane, r32 = lane & 31, hi = lane >> 5;
    __syncthreads();
    if (C.tid < 32) ((LAS float*)(lds + L_TBH))[C.tid] = a.rel_bias[C.tid * 20 + 8 + grp * 4 + h] * LOG2E;
    const bf16_t* QKV = (const bf16_t*)(a.ws + WS_A);
    const int u = 256 * ub + 32 * wid + r32; const size_t tokq = (size_t)b * SEQ + (size_t)u * d + res;
    const bf16_t* qp = QKV + tokq * LDQ + 1280 + grp * 256 + h * 64;
    bf16x8 qr[4];
#pragma unroll
    for (int d0 = 0; d0 < 4; ++d0) qr[d0] = *(const bf16x8*)(qp + d0 * 16 + hi * 8);
    __syncthreads();
    LoopP P; P.Kb = QKV + ((size_t)b * SEQ + res) * LDQ + 1280 + 768 + grp * 256 + h * 64; P.Vb = P.Kb + 768; P.pitch = (long)d * LDQ;
    { const int klo = 4 * ub - 2 < 0 ? 0 : 4 * ub - 2; unsigned long long tmk = 0ull; for (int k = klo; k <= 4 * ub + 3; ++k) tmk |= 1ull << k; P.tmask = tmk; }
    P.uqp = u; P.maxd = 128; P.dsh = dsh; P.lanesel = ~0ull;
    { const int lo = 256 * ub + 32 * wid - 128; P.wlo = lo < 0 ? 0 : (lo >> 6); P.whi = (256 * ub + 32 * wid + 31) >> 6; }
    P.tb = (const LAS float*)(lds + L_TBH); P.imp = nullptr;
    float m = -INFINITY, l = 0.f; f32x16 o[2]; o[0] = (f32x16){}; o[1] = (f32x16){};
    attn_loop<1, 0>(lds, wid, lane, qr, P, m, l, o);
    l = xhalf_sum(l);
    LAS float* wsf = (LAS float*)(lds + L_WSF) + wid * 64;
    if (hi == 0) { wsf[r32] = l > 0.f ? 1.0f / l : 0.f; ((float*)(a.ws + WS_LSE))[((size_t)grp * T + tokq) * 4 + h] = m + __builtin_amdgcn_logf(l); }
    LDS_WAIT();
#pragma unroll
    for (int rr = 0; rr < 16; ++rr) { const float f = wsf[crow(rr, hi)]; o[0][rr] *= f; o[1][rr] *= f; }
    stage_rows(lds, wid, lane, o);
    bf16_t* ODP = (bf16_t*)(a.ws + WS_ODP) + (size_t)grp * T * 256;
    const LAS bf16_t* stg = (const LAS bf16_t*)(lds + L_OST) + wid * 2048;
#pragma unroll
    for (int i = 0; i < 4; ++i) { const int row = i * 8 + (lane >> 3), chn = lane & 7; const u32x4 v = *(const LAS u32x4*)(stg + row * 64 + chn * 8);
        const size_t tok = (size_t)b * SEQ + (size_t)(256 * ub + 32 * wid + row) * d + res;
        *(u32x4*)(ODP + tok * 256 + h * 64 + chn * 8) = v; }
}
__device__ __forceinline__ void dil_combine(const Args& a, const Ctx& C) {
    const float* LSE = (const float*)(a.ws + WS_LSE); const bf16_t* ODP = (const bf16_t*)(a.ws + WS_ODP); bf16_t* ODIL = (bf16_t*)(a.ws + WS_ODIL);
    const int gt = C.vcu * NTHR + C.tid, NT = C.G * NTHR;
    for (int idx = gt; idx < T * 32; idx += NT) {
        const int tok = idx >> 5, h = (idx >> 3) & 3, chn = idx & 7;
        const float l0 = LSE[((size_t)0 * T + tok) * 4 + h], l1 = LSE[((size_t)1 * T + tok) * 4 + h], l2 = LSE[((size_t)2 * T + tok) * 4 + h];
        const float mx = __builtin_fmaxf(l0, __builtin_fmaxf(l1, l2));
        float w0 = __builtin_amdgcn_exp2f(l0 - mx), w1 = __builtin_amdgcn_exp2f(l1 - mx), w2 = __builtin_amdgcn_exp2f(l2 - mx);
        const float inv = 1.0f / (w0 + w1 + w2); w0 *= inv; w1 *= inv; w2 *= inv;
        const size_t off = (size_t)tok * 256 + h * 64 + chn * 8;
        const u32x4 a0 = *(const u32x4*)(ODP + off), a1 = *(const u32x4*)(ODP + (size_t)T * 256 + off), a2 = *(const u32x4*)(ODP + (size_t)2 * T * 256 + off);
        u32x4 o;
        o.x = cvt_pk_bf16(w0 * bf_lo(a0.x) + w1 * bf_lo(a1.x) + w2 * bf_lo(a2.x), w0 * bf_hi(a0.x) + w1 * bf_hi(a1.x) + w2 * bf_hi(a2.x));
        o.y = cvt_pk_bf16(w0 * bf_lo(a0.y) + w1 * bf_lo(a1.y) + w2 * bf_lo(a2.y), w0 * bf_hi(a0.y) + w1 * bf_hi(a1.y) + w2 * bf_hi(a2.y));
        o.z = cvt_pk_bf16(w0 * bf_lo(a0.z) + w1 * bf_lo(a1.z) + w2 * bf_lo(a2.z), w0 * bf_hi(a0.z) + w1 * bf_hi(a1.z) + w2 * bf_hi(a2.z));
        o.w = cvt_pk_bf16(w0 * bf_lo(a0.w) + w1 * bf_lo(a1.w) + w2 * bf_lo(a2.w), w0 * bf_hi(a0.w) + w1 * bf_hi(a1.w) + w2 * bf_hi(a2.w));
        *(u32x4*)(ODIL + off) = o;
    }
}
__device__ __forceinline__ void nsa_unit(const Args& a, const Ctx& C, int b, int hk, int i) {
    using namespace att;
    LAS unsigned char* lds = C.lds;
    const int wid = C.wave, lane = C.lane, r32 = lane & 31, hi = lane >> 5, tid = C.tid;
    const int g = wid >> 1, tq = (wid & 1) * 32 + r32, t = 64 * i + tq; const size_t tok = (size_t)b * SEQ + t;
    LAS float* impP = (LAS float*)(lds + L_IMP);
    LAS float* tbh = (LAS float*)(lds + L_TBH);
    LAS float* gsh = (LAS float*)(lds + L_GSH) + wid * 96;
    LAS unsigned* selw = (LAS unsigned*)(lds + L_SEL);
    LAS float* wsf = (LAS float*)(lds + L_WSF) + wid * 64;
    const bf16_t* QKV = (const bf16_t*)(a.ws + WS_A);
    __syncthreads();
    for (int e = tid; e < 4 * 64 * 64; e += NTHR) impP[e] = 0.f;
    if (tid < 128) tbh[tid] = a.rel_bias[(tid & 31) * 20 + hk * 4 + (tid >> 5)] * LOG2E;
    if (tid < 2) selw[128 + tid] = 0u;
    if (hi == 0) { const float* gn = (const float*)(a.ws + WS_GN) + tok * 32 + hk * 4 + g;
        gsh[r32] = gn[0]; gsh[32 + r32] = gn[8]; gsh[64 + r32] = gn[16]; }
    bf16x8 qr[4];
    { const bf16_t* qp = QKV + tok * LDQ + hk * 256 + g * 64;
#pragma unroll
        for (int d0 = 0; d0 < 4; ++d0) qr[d0] = *(const bf16x8*)(qp + d0 * 16 + hi * 8); }
    __syncthreads();
    f32x16 o[2];
    LAS float* otacc = (LAS float*)(lds + L_IMP) + wid * 2048 + r32;
    LoopP P; P.tb = tbh + g * 32; P.imp = impP + (g * 64 + tq) * 64; P.wlo = 0; P.whi = 63; P.dsh = 0;
    {
        const bf16_t* KC = (const bf16_t*)(a.ws + WS_KC);
        P.Kb = KC + (size_t)((0 * 8 + b) * 2 + hk) * 256 * 64; P.Vb = KC + (size_t)((1 * 8 + b) * 2 + hk) * 256 * 64; P.pitch = 64;
        const int nt = (4 * i + 2) / 64 + 1; P.tmask = (1ull << nt) - 1ull;
        P.uqp = t - 31; P.maxd = 1 << 30; P.lanesel = ~0ull;
        float m = -INFINITY, l = 0.f;
        attn_loop<16, 1>(lds, wid, lane, qr, P, m, l, o);
        l = xhalf_sum(l);
        float msafe = (m == -INFINITY) ? 0.f : m, invl = l > 0.f ? 1.0f / l : 0.f;
        o[0] = (f32x16){}; o[1] = (f32x16){};
        attn_loop<16, 2>(lds, wid, lane, qr, P, msafe, invl, o);
    }
    __syncthreads();
    {
#pragma unroll
        for (int k = 0; k < 8; ++k) { const int idx = tid * 8 + k; impP[idx] = ((impP[idx] + impP[4096 + idx]) + impP[8192 + idx]) + impP[12288 + idx]; }
        __syncthreads();
        const int q = tid >> 3, part = tid & 7;
        const int ncand = i - 2 > 0 ? i - 2 : 0; const int nforced = i + 1 < 3 ? i + 1 : 3; const int krem = 16 - nforced;
        unsigned bits = 0u;
        if (ncand > krem) {
            float vn[8]; int cn[8];
#pragma unroll
            for (int e = 0; e < 8; ++e) { vn[e] = impP[q * 64 + part * 8 + e]; cn[e] = 0; }
            for (int mm = 1; mm <= i - 2; ++mm) { const float xv = impP[q * 64 + mm];
#pragma unroll
                for (int e = 0; e < 8; ++e) { const int n = part * 8 + e; cn[e] += (xv > vn[e] || (xv == vn[e] && mm < n)) ? 1 : 0; } }
#pragma unroll
            for (int e = 0; e < 8; ++e) { const int n = part * 8 + e; if (n >= 1 && n <= i - 2 && cn[e] < krem) bits |= 1u << e; }
        } else {
#pragma unroll
            for (int e = 0; e < 8; ++e) { const int n = part * 8 + e; if (n >= 1 && n <= i - 2) bits |= 1u << e; }
        }
#pragma unroll
        for (int e = 0; e < 8; ++e) { const int n = part * 8 + e; if (n == 0 || n == i || n == i - 1) bits |= 1u << e; }
        unsigned lo = part < 4 ? bits << (8 * part) : 0u, hi2 = part >= 4 ? bits << (8 * (part - 4)) : 0u;
        lo |= swz_xor_u<1>(lo); hi2 |= swz_xor_u<1>(hi2); lo |= swz_xor_u<2>(lo); hi2 |= swz_xor_u<2>(hi2); lo |= swz_xor_u<4>(lo); hi2 |= swz_xor_u<4>(hi2);
        if (part == 0) { selw[2 * q] = lo; selw[2 * q + 1] = hi2; atomicOr((unsigned*)&selw[128], lo); atomicOr((unsigned*)&selw[129], hi2); }
    }
    __syncthreads();
#pragma unroll
    for (int r = 0; r < 16; ++r) { const float f = gsh[crow(r, hi)]; otacc[crow(r, hi) * 64] = f * o[0][r]; otacc[crow(r, hi) * 64 + 32] = f * o[1][r]; }
    {
        P.Kb = QKV + (size_t)b * SEQ * LDQ + 512 + 256 + hk * 64; P.Vb = P.Kb + 128; P.pitch = LDQ;
        P.tmask = ((unsigned long long)selw[129] << 32) | selw[128];
        P.uqp = t; P.maxd = 1 << 30; P.lanesel = ((unsigned long long)selw[2 * tq + 1] << 32) | selw[2 * tq];
        float m = -INFINITY, l = 0.f; o[0] = (f32x16){}; o[1] = (f32x16){};
        attn_loop<1, 0>(lds, wid, lane, qr, P, m, l, o);
        l = xhalf_sum(l);
        if (hi == 0) wsf[r32] = (l > 0.f ? 1.0f / l : 0.f) * gsh[32 + r32];
        LDS_WAIT();
#pragma unroll
        for (int r = 0; r < 16; ++r) { const float f = wsf[crow(r, hi)]; otacc[crow(r, hi) * 64] += f * o[0][r]; otacc[crow(r, hi) * 64 + 32] += f * o[1][r]; }
    }
    {
        P.Kb = QKV + (size_t)b * SEQ * LDQ + 512 + 512 + hk * 64; P.Vb = P.Kb + 128; P.pitch = LDQ;
        { const int jlo = i - 8 < 0 ? 0 : i - 8; unsigned long long tmk = 0ull; for (int j = jlo; j <= i; ++j) tmk |= 1ull << j; P.tmask = tmk; }
        P.uqp = t; P.maxd = 512; P.lanesel = ~0ull;
        float m = -INFINITY, l = 0.f; o[0] = (f32x16){}; o[1] = (f32x16){};
        attn_loop<1, 0>(lds, wid, lane, qr, P, m, l, o);
        l = xhalf_sum(l);
        LDS_WAIT();
        if (hi == 0) wsf[r32] = (l > 0.f ? 1.0f / l : 0.f) * gsh[64 + r32];
        LDS_WAIT();
#pragma unroll
        for (int r = 0; r < 16; ++r) { const float f = wsf[crow(r, hi)]; otacc[crow(r, hi) * 64] += f * o[0][r]; otacc[crow(r, hi) * 64 + 32] += f * o[1][r]; }
    }
    LDS_WAIT();
    bf16_t* ONSA = (bf16_t*)(a.ws + WS_ONSA);
    const LAS float* accw = (const LAS float*)(lds + L_IMP) + wid * 2048;
#pragma unroll
    for (int k = 0; k < 4; ++k) { const int row = k * 8 + (lane >> 3), chn = lane & 7;
        const f32x4 f0 = *(const LAS f32x4*)(accw + row * 64 + chn * 8), f1 = *(const LAS f32x4*)(accw + row * 64 + chn * 8 + 4);
        u32x4 v; v.x = cvt_pk_bf16(f0[0], f0[1]); v.y = cvt_pk_bf16(f0[2], f0[3]); v.z = cvt_pk_bf16(f1[0], f1[1]); v.w = cvt_pk_bf16(f1[2], f1[3]);
        const size_t tk = (size_t)b * SEQ + 64 * i + (wid & 1) * 32 + row;
        *(u32x4*)(ONSA + tk * 512 + hk * 256 + g * 64 + chn * 8) = v; }
}
__device__ __forceinline__ void build_bkt(const Ctx& C) {
    LAS unsigned char* bkt = C.lds + att::L_BKT;
    for (int d = C.tid; d < 4096; d += NTHR) bkt[d] = (unsigned char)att::bucket_of(d);
    __syncthreads();
}

typedef const Args __attribute__((address_space(4)))* CArgsP;
__device__ __forceinline__ Args load_args() {
#if defined(__HIP_DEVICE_COMPILE__)
    CArgsP p = (CArgsP)__builtin_amdgcn_kernarg_segment_ptr(); asm volatile("" : "+s"(p)); Args a;
    a.x = p->x; a.c = p->c; a.rel_bias = p->rel_bias; a.ada_w = p->ada_w; a.ada_b = p->ada_b; a.norm1 = p->norm1; a.norm2 = p->norm2; a.w_in = p->w_in;
    a.cmp_pos = p->cmp_pos; a.cmp_w1 = p->cmp_w1; a.cmp_w2 = p->cmp_w2; a.w_up_nsa = p->w_up_nsa; a.w_up_dil = p->w_up_dil; a.w_o = p->w_o;
    a.router_wg = p->router_wg; a.router_bg = p->router_bg; a.router_we = p->router_we; a.router_be = p->router_be; a.exp_w1 = p->exp_w1; a.exp_w3 = p->exp_w3; a.exp_w2 = p->exp_w2; a.norm_f = p->norm_f;
    a.out = p->out; a.ws = p->ws; a.ph_lo = p->ph_lo; a.ph_hi = p->ph_hi; a.use_bar = p->use_bar; a.pad = 0;
    return a;
#else
    return Args{};
#endif
}
#define LOADA() const Args a = load_args()
__global__ void __launch_bounds__(NTHR, 2) fwd_kernel(Args a_) {
    extern __shared__ __attribute__((aligned(16))) unsigned char lds_raw[];
    LAS unsigned char* const lds_base = (LAS unsigned char*)lds_raw;
    const int wave0_ = __builtin_amdgcn_readfirstlane((int)threadIdx.x >> 6);
#define FRESH() Ctx C; { int w_ = wave0_; asm volatile("" : "+s"(w_)); int t_ = lane_id_fresh(); asm volatile("" : "+v"(t_)); t_ += w_ * 64; int g_ = gridDim.x, b_ = blockIdx.x; asm volatile("" : "+s"(g_), "+s"(b_)); \
        C.lds = lds_base; C.tid = t_; C.lane = t_ & 63; C.wave = w_; C.G = g_; C.bx = b_; C.vcu = (g_ % 8 == 0) ? (b_ % 8) * (g_ / 8) + b_ / 8 : b_; }
    volatile LAS unsigned* MISC = (volatile LAS unsigned*)(lds_base + LDS_MISC);
    if (threadIdx.x < 64) MISC[threadIdx.x] = 0u;
    __syncthreads();
    unsigned* ctl = (unsigned*)(a_.ws + WS_CTL);
    XcdBarrier bar; bar.bar = ctl + CW_BAR; bar.x = 0; bar.st = nullptr;
    if (a_.use_bar) bar = xcd_barrier_post(ctl + CW_BAR, MISC + 8);
    const int lo = a_.ph_lo, hi = a_.ph_hi;
#ifndef PH_MASK
#define PH_MASK 0xFFFFFFFFu
#endif
#define IN(k) (((PH_MASK >> ((k) == 0 ? 10 : (k) == 21 ? 11 : (((k) - 1) % 10))) & 1u) && lo <= (k) && (k) < hi)
#define SEAM(k) do { if (IN(k) && IN((k) + 1)) { XcdBarrier b2_ = bar; asm volatile("" : "+s"(b2_.bar)); int w2_ = wave0_; asm volatile("" : "+s"(w2_)); xcd_barrier(b2_, w2_ == 0 && lane_id_fresh() == 0); } } while (0)
    if (IN(0)) { FRESH(); LOADA(); prologue_vectors(a, C); conv_small(a, C); conv_experts(a, C, 0); }
    SEAM(0);
    _Pragma("unroll") for (int l = 0; l < 2; ++l) {
        const int pb = 1 + 10 * l;
        if (IN(pb + 0)) { FRESH(); LOADA(); norm1_phase(a, C, l); if (l == 1) conv_experts(a, C, 1); }
        SEAM(pb + 0);
        if (IN(pb + 1)) { FRESH(); LOADA(); unsigned char* ws = a.ws;
            pg8::Gemm g{2048u, 2048u, 128u, 1024}; pg8::DenseOrder S; S.init(T, NIN, C.G, C.bx, ws + WS_H, 2048u, ws + WS_WINT + (size_t)l * NIN * DM * 2, 2048u);
            EpiInProj E{(bf16_t*)(ws + WS_A), (bf16_t*)(ws + WS_MG), (float*)(ws + WS_GN)};
            pg8::gemm_phase<EpiInProj, pg8::DenseOrder, true>(C.lds, C.tid, g, S, E);
        }
        SEAM(pb + 1);
        if (IN(pb + 2)) { FRESH(); LOADA(); unsigned char* ws = a.ws;
            struct CmpOrder { int c; const char* A; const char* B;
                __device__ __forceinline__ bool next(int i, pg8::Unit& u) const { if (i > 0 || c >= 32) return false; const int kv = c >> 4, b = (c >> 1) & 7, hk = c & 1;
                    u.pm = c; u.pn = 0; u.A = A + ((size_t)b * SEQ * LDQ + 512 + kv * 128 + hk * 64) * 2; u.B = B + (size_t)kv * 256 * 2048 * 2; return true; } };
            pg8::Gemm g{(unsigned)(16 * LDQ * 2), 4096u, (unsigned)(LDQ * 2), 2048};
            CmpOrder S{C.vcu, (const char*)(ws + WS_A), (const char*)(ws + WS_CW1T + (size_t)l * 2 * 256 * 2048 * 2)};
            EpiCmp E{(bf16_t*)(ws + WS_HID), (const float*)(ws + WS_CB1) + l * 512, (const bf16_t*)(ws + WS_CW2T) + (size_t)l * 2 * 64 * 256, (bf16_t*)(ws + WS_KC)};
            pg8::gemm_phase<EpiCmp, CmpOrder, false>(C.lds, C.tid, g, S, E);
            __syncthreads();
            build_bkt(C);
            for (int du = C.vcu; du < 1536; du += C.G) dil_unit(a, C, du);
        }
        SEAM(pb + 2);
        if (IN(pb + 3)) { FRESH(); LOADA();
            dil_combine(a, C);
            build_bkt(C);
            for (int v = C.vcu; v < 256; v += C.G) { const int b = v >> 5, hk = (v >> 4) & 1, s = v & 15;
                for (int k = 0; k < 4; ++k) { const int qi = (k == 0) ? s : (k == 1) ? 31 - s : (k == 2) ? 32 + s : 63 - s; nsa_unit(a, C, b, hk, qi); } }
            __syncthreads();
        }
        SEAM(pb + 3);
        if (IN(pb + 4)) { FRESH(); LOADA(); unsigned char* ws = a.ws;
            { pg8::Gemm g{1024u, 1024u, 128u, 512}; pg8::DenseOrder S; S.init(T, 1024, C.G, C.bx, ws + WS_ONSA, 1024u, ws + WS_WUNT + (size_t)l * 1024 * 512 * 2, 1024u);
              EpiUp<0> E{(bf16_t*)(ws + WS_MERGED), (const bf16_t*)(ws + WS_MG)};
              pg8::gemm_phase<EpiUp<0>, pg8::DenseOrder, true>(C.lds, C.tid, g, S, E); }
            VM_WAIT(); __syncthreads();
            { pg8::Gemm g{512u, 512u, 128u, 256}; pg8::DenseOrder S; S.init(T, 1024, C.G, C.bx, ws + WS_ODIL, 512u, ws + WS_WUDT + (size_t)l * 1024 * 256 * 2, 512u);
              EpiUp<1> E{(bf16_t*)(ws + WS_MERGED), (const bf16_t*)(ws + WS_MG)};
              pg8::gemm_phase<EpiUp<1>, pg8::DenseOrder, true>(C.lds, C.tid, g, S, E); }
        }
        SEAM(pb + 4);
        if (IN(pb + 5)) { FRESH(); LOADA(); unsigned char* ws = a.ws;
            pg8::Gemm g{2048u, 2048u, 128u, 1024}; pg8::DenseOrder S; S.init(T, 1024, C.G, C.bx, ws + WS_MERGED, 2048u, ws + WS_WOT + (size_t)l * 1024 * 1024 * 2, 2048u);
            EpiOut E{l == 0 ? a.x : (const float*)a.out, a.out, (const float*)(ws + WS_MOD) + (size_t)l * 8 * 6144 + 2048};
            pg8::gemm_phase<EpiOut, pg8::DenseOrder, true>(C.lds, C.tid, g, S, E);
        }
        SEAM(pb + 5);
        if (IN(pb + 6)) { FRESH(); LOADA(); norm2_router_phase(a, C, l); }
        SEAM(pb + 6);
        if (IN(pb + 7)) { FRESH(); LOADA(); moe_scatter_phase(a, C); }
        SEAM(pb + 7);
        if (IN(pb + 8)) { FRESH(); LOADA(); unsigned char* ws = a.ws;
            const int* TILEE = (const int*)(ws + WS_TILEE); const int ntl = TILEE[0];
            MoeOrder S; S.G = C.G; S.c = C.vcu; S.nu = ntl * 4; S.A = (const char*)(ws + WS_XS); S.B = (const char*)(ws + WS_E13T); S.tA = (size_t)256 * 2048; S.tB = (size_t)256 * 2048; S.eB = (size_t)1024 * 2048;
#pragma unroll
            for (int i = 0; i < 8; ++i) { const int L = i * C.G + C.vcu; S.ex[i] = (L < S.nu) ? TILEE[16 + (L >> 2)] : 0; }
            pg8::Gemm g{2048u, 2048u, 128u, 1024};
            EpiMoe1 E{(bf16_t*)(ws + WS_ACT)};
            pg8::gemm_phase<EpiMoe1, MoeOrder, true>(C.lds, C.tid, g, S, E);
        }
        SEAM(pb + 8);
        if (IN(pb + 9)) { FRESH(); LOADA(); unsigned char* ws = a.ws;
            const int* TILEE = (const int*)(ws + WS_TILEE); const int ntl = TILEE[0];
            MoeOrder S; S.G = C.G; S.c = C.vcu; S.nu = ntl * 4; S.A = (const char*)(ws + WS_ACT); S.B = (const char*)(ws + WS_E2T); S.tA = (size_t)256 * 1024; S.tB = (size_t)256 * 1024; S.eB = (size_t)1024 * 1024;
#pragma unroll
            for (int i = 0; i < 8; ++i) { const int L = i * C.G + C.vcu; S.ex[i] = (L < S.nu) ? TILEE[16 + (L >> 2)] : 0; }
            pg8::Gemm g{1024u, 1024u, 128u, 512};
            EpiPlain E{(bf16_t*)(ws + WS_XS), 1024};
            pg8::gemm_phase<EpiPlain, MoeOrder, true>(C.lds, C.tid, g, S, E);
        }
        SEAM(pb + 9);
    }
    if (IN(21)) { FRESH(); LOADA(); final_phase(a, C); }
#undef IN
#undef SEAM
}

#ifndef ONE_LAUNCH
#define ONE_LAUNCH 0
#endif
extern "C" void kernel_launch(void* const* d_in, const int* in_sizes, int n_in, void* d_out, int out_size, void* d_ws, size_t ws_size, hipStream_t stream) {
    static int grid = 0;
    if (grid == 0) {
        if (n_in != 22 || out_size != T * DM || ws_size < WS_END) { fprintf(stderr, "kernel_launch: unexpected problem (n_in %d out %d ws %zu)\n", n_in, out_size, ws_size); grid = -1; return; }
        int dev = 0, cus = 0;
        if (hipGetDevice(&dev) != hipSuccess || hipDeviceGetAttribute(&cus, hipDeviceAttributeMultiprocessorCount, dev) != hipSuccess) { grid = -1; return; }
        if (hipFuncSetAttribute((const void*)fwd_kernel, hipFuncAttributeMaxDynamicSharedMemorySize, LDS_BYTES) != hipSuccess) { fprintf(stderr, "kernel_launch: hipFuncSetAttribute failed\n"); grid = -1; return; }
        int per_cu = 0;
        if (hipOccupancyMaxActiveBlocksPerMultiprocessor(&per_cu, (const void*)fwd_kernel, NTHR, LDS_BYTES) != hipSuccess || per_cu < 1) { fprintf(stderr, "kernel_launch: occupancy query reports %d\n", per_cu); }
        (void)hipGetLastError();
        grid = cus;
    }
    if (grid < 0) return;
    (void)hipMemsetAsync((char*)d_ws + WS_CTL, 0, CTL_ZERO_BYTES, stream);
    Args a{};
    a.x = (const float*)d_in[0]; a.c = (const float*)d_in[1]; a.rel_bias = (const float*)d_in[2]; a.ada_w = (const float*)d_in[3]; a.ada_b = (const float*)d_in[4];
    a.norm1 = (const float*)d_in[5]; a.norm2 = (const float*)d_in[6]; a.w_in = (const float*)d_in[7]; a.cmp_pos = (const float*)d_in[8]; a.cmp_w1 = (const float*)d_in[9];
    a.cmp_w2 = (const float*)d_in[10]; a.w_up_nsa = (const float*)d_in[11]; a.w_up_dil = (const float*)d_in[12]; a.w_o = (const float*)d_in[13];
    a.router_wg = (const float*)d_in[14]; a.router_bg = (const float*)d_in[15]; a.router_we = (const float*)d_in[16]; a.router_be = (const float*)d_in[17];
    a.exp_w1 = (const float*)d_in[18]; a.exp_w3 = (const float*)d_in[19]; a.exp_w2 = (const float*)d_in[20]; a.norm_f = (const float*)d_in[21];
    a.out = (float*)d_out; a.ws = (unsigned char*)d_ws; a.pad = 0;
#if ONE_LAUNCH
    a.ph_lo = 0; a.ph_hi = NPHASE; a.use_bar = 1;
    hipLaunchKernelGGL(fwd_kernel, dim3(grid), dim3(NTHR), LDS_BYTES, stream, a);
#else
    for (int p = 0; p < NPHASE; ++p) { a.ph_lo = p; a.ph_hi = p + 1; a.use_bar = 0;
        hipLaunchKernelGGL(fwd_kernel, dim3(grid), dim3(NTHR), LDS_BYTES, stream, a); }
#endif
}
```

```cpp
#include <hip/hip_runtime.h>
#include <cstdint>
#include <cstdio>

#define GAS __attribute__((address_space(1)))
#define LAS __attribute__((address_space(3)))
typedef unsigned short bf16_t;
typedef short bf16x8 __attribute__((ext_vector_type(8)));
typedef short s16x4 __attribute__((ext_vector_type(4)));
typedef float f32x4 __attribute__((ext_vector_type(4)));
typedef float f32x2 __attribute__((ext_vector_type(2)));
typedef float f32x16 __attribute__((ext_vector_type(16)));
typedef unsigned u32x4 __attribute__((ext_vector_type(4)));
typedef unsigned u32x2 __attribute__((ext_vector_type(2)));
typedef __bf16 bf16x2_t __attribute__((ext_vector_type(2)));

constexpr int NB = 8, SEQ = 4096, DM = 1024, T = NB * SEQ;
constexpr int LDQ = 3584;
constexpr int NIN = 5888;
constexpr int INW = 5656;
constexpr float LOG2E = 1.4426950408889634f;
constexpr float C2 = 0.125f * LOG2E;
constexpr int NWAVES = 8, NTHR = 512;
constexpr float RMS_EPS = 1e-6f;
constexpr int NPHASE = 22;

constexpr size_t MiB = 1u << 20;
constexpr size_t WS_CTL = 0, CTL_ZERO_BYTES = MiB;
constexpr size_t WS_MOD = 1 * MiB;
constexpr size_t WS_CB1 = WS_MOD + 400 * 1024;
constexpr size_t WS_CW2T = WS_MOD + 512 * 1024;
constexpr size_t WS_CNTBLK = WS_MOD + 768 * 1024;
constexpr size_t WS_TILEE = WS_MOD + 832 * 1024;
constexpr size_t WS_WINT = 4 * MiB;
constexpr size_t WS_CW1T = 27 * MiB;
constexpr size_t WS_WUNT = 31 * MiB;
constexpr size_t WS_WUDT = 33 * MiB;
constexpr size_t WS_WOT = 34 * MiB;
constexpr size_t WS_E13T = 38 * MiB;
constexpr size_t WS_E2T = 102 * MiB;
constexpr size_t WS_A = 134 * MiB;
constexpr size_t WS_XS = WS_A;
constexpr size_t WS_ACT = WS_A + 144 * MiB;
constexpr size_t WS_MERGED = WS_A;
constexpr size_t WS_MG = 359 * MiB;
constexpr size_t WS_H2 = WS_MG;
constexpr size_t WS_REC = WS_MG + 64 * MiB;
constexpr size_t WS_DEST = WS_MG + 65 * MiB;
constexpr size_t WS_B = 487 * MiB;
constexpr size_t WS_H = WS_B;
constexpr size_t WS_ONSA = WS_B;
constexpr size_t WS_ODP = WS_B + 32 * MiB;
constexpr size_t WS_LSE = WS_B + 80 * MiB;
constexpr size_t WS_ODIL = WS_B + 82 * MiB;
constexpr size_t WS_GN = WS_B + 98 * MiB;
constexpr size_t WS_KC = WS_B + 102 * MiB;
constexpr size_t WS_HID = WS_B + 103 * MiB;
constexpr size_t WS_END = WS_B + 107 * MiB;

constexpr int CW_TMO = 0, CW_BAR = 4096;

constexpr int LDS_MISC = 147456;
constexpr int LDS_BYTES = 147456 + 4096;

__device__ __forceinline__ unsigned cvt_pk_bf16(float lo, float hi) { f32x2 v = {lo, hi}; bf16x2_t b = __builtin_convertvector(v, bf16x2_t); return __builtin_bit_cast(unsigned, b); }
__device__ __forceinline__ float bf_lo(unsigned w) { return __uint_as_float(w << 16); }
__device__ __forceinline__ float bf_hi(unsigned w) { return __uint_as_float(w & 0xffff0000u); }
__device__ __forceinline__ float sigmoidf_(float x) { return __builtin_amdgcn_rcpf(1.0f + __builtin_amdgcn_exp2f(-x * LOG2E)); }
__device__ __forceinline__ int lane_id_fresh() { unsigned ones = ~0u; asm volatile("" : "+s"(ones)); return (int)__builtin_amdgcn_mbcnt_hi(ones, __builtin_amdgcn_mbcnt_lo(ones, 0u)); }
template <int X> __device__ __forceinline__ float swz_xor_f(float v) { return __int_as_float(__builtin_amdgcn_ds_swizzle(__float_as_int(v), (X << 10) | 0x1f)); }
template <int X> __device__ __forceinline__ unsigned swz_xor_u(unsigned v) { return (unsigned)__builtin_amdgcn_ds_swizzle((int)v, (X << 10) | 0x1f); }
__device__ __forceinline__ float wave_sum(float v) {
    v += swz_xor_f<1>(v); v += swz_xor_f<2>(v); v += swz_xor_f<4>(v); v += swz_xor_f<8>(v); v += swz_xor_f<16>(v);
    auto rr = __builtin_amdgcn_permlane32_swap(__float_as_uint(v), __float_as_uint(v), false, false);
    return __uint_as_float(rr[0]) + __uint_as_float(rr[1]);
}
__device__ __forceinline__ int bperm_i(int srclane, int v) { return __builtin_amdgcn_ds_bpermute(srclane << 2, v); }
#define LDS_WAIT() asm volatile("s_waitcnt lgkmcnt(0)" ::: "memory")
#define VM_WAIT() asm volatile("s_waitcnt vmcnt(0)" ::: "memory")

#define XB_TMO      128
#define XB_XCNT(j)  (256  + 64 * (j))
#define XB_XSUB(j)  (1280 + 64 * (j))
#define XB_XGEN(j)  (2304 + 64 * (j))
#define XB_TOP      3328
#define XB_TOPGEN   3392
#define XCD_BAR_WORDS 3456
#define XB_SPIN_CAP (1u << 20)
__device__ __forceinline__ unsigned xb_ld(unsigned* p)              { return __hip_atomic_load(p, __ATOMIC_RELAXED, __HIP_MEMORY_SCOPE_AGENT); }
__device__ __forceinline__ unsigned xb_add(unsigned* p, unsigned v) { return __hip_atomic_fetch_add(p, v, __ATOMIC_RELAXED, __HIP_MEMORY_SCOPE_AGENT); }
__device__ __forceinline__ unsigned xb_xcc_id() { return (unsigned)__builtin_amdgcn_s_getreg((3 << 11) | 20) & 0xFu; }
#define XB_SPIN(cond, bar) do { unsigned _sp = 0; while (cond) { __builtin_amdgcn_s_sleep(1); \
    if ((++_sp & 255u) == 0u) { if (xb_ld(&(bar)[XB_TMO])) break; if (_sp > XB_SPIN_CAP) { atomicAdd(&(bar)[XB_TMO], 1u); break; } } } } while (0)
struct XcdBarrier { unsigned* bar; unsigned x; volatile LAS unsigned* st; };
__device__ __forceinline__ XcdBarrier xcd_barrier_post(unsigned* bar, volatile LAS unsigned* st) {
    XcdBarrier b; b.bar = bar; b.x = xb_xcc_id(); b.st = st;
    if (threadIdx.x == 0) (void)xb_add(&bar[XB_XCNT(b.x)], 1u);
    return b;
}
__device__ __forceinline__ void xcd_barrier_complete(unsigned* bar, unsigned x, unsigned& nloc, unsigned& nx) {
    const unsigned G = gridDim.x * gridDim.y * gridDim.z;
    unsigned sum, cnt, mine, sp = 0u;
    for (;;) {
        sum = 0u; cnt = 0u; mine = 0u;
#pragma unroll
        for (unsigned j = 0; j < 16; ++j) { const unsigned c = xb_ld(&bar[XB_XCNT(j)]); sum += c; cnt += (c > 0u) ? 1u : 0u; mine = (j == x) ? c : mine; }
        if (sum == G) break;
        __builtin_amdgcn_s_sleep(1);
        if ((++sp & 255u) == 0u) { if (xb_ld(&bar[XB_TMO])) break; if (sp > XB_SPIN_CAP) { atomicAdd(&bar[XB_TMO], 1u); break; } }
    }
    nloc = mine > 0u ? mine : 1u; nx = cnt > 0u ? cnt : 1u;
}
__device__ __forceinline__ void xcd_barrier(const XcdBarrier& b, const bool leader_thread) {
    asm volatile("s_waitcnt vmcnt(0)" ::: "memory");
    __syncthreads();
    if (leader_thread) {
        unsigned* bar = b.bar;
        __builtin_amdgcn_s_waitcnt(0);
        unsigned nloc = b.st[0], nx = b.st[1];
        if (nloc == 0u) { xcd_barrier_complete(bar, b.x, nloc, nx); b.st[0] = nloc; b.st[1] = nx; }
        const unsigned old = xb_add(&bar[XB_XSUB(b.x)], 1u);
        const unsigned gen = old / nloc;
        if (old + 1u == (gen + 1u) * nloc) {
            __builtin_amdgcn_fence(__ATOMIC_RELEASE, "agent");
            asm volatile("s_waitcnt vmcnt(0)" ::: "memory");
            const unsigned og = xb_add(&bar[XB_TOP], 1u);
            const unsigned tg = og / nx;
            if (og + 1u == (tg + 1u) * nx) xb_add(&bar[XB_TOPGEN], 1u);
            else XB_SPIN(xb_ld(&bar[XB_TOPGEN]) == tg, bar);
            __builtin_amdgcn_fence(__ATOMIC_ACQUIRE, "agent");
            xb_add(&bar[XB_XGEN(b.x)], 1u);
            asm volatile("s_waitcnt vmcnt(0)" ::: "memory");
        } else {
            XB_SPIN(xb_ld(&bar[XB_XGEN(b.x)]) == gen, bar);
            __builtin_amdgcn_fence(__ATOMIC_ACQUIRE, "agent");
            asm volatile("s_waitcnt vmcnt(0)" ::: "memory");
        }
    }
    __syncthreads();
}

namespace pg8 {
constexpr int BM = 256, BK = 64, HALF = 128, HTB = HALF * BK * 2, STAGE_BYTES = 8 * HTB;
__device__ __forceinline__ int lds_byte(int r, int c) { const int st = (r >> 4) * 2 + (c >> 5), rr = r & 15, cc = c & 31, ob = rr * 64 + cc * 2; return st * 1024 + (ob ^ (((ob >> 9) & 1) << 5)); }
__device__ __forceinline__ void stage_rc(int b, int& R, int& C) { const int st = b / 1024, sb = b % 1024, swz = sb ^ (((sb >> 9) & 1) << 5); R = (st >> 1) * 16 + swz / 64; C = (st & 1) * 32 + (swz % 64) / 2; }
__device__ __forceinline__ int perm32(int rho) { const int n = rho >> 4, i = rho & 15; return 8 * (i >> 2) + 4 * n + (i & 3); }

struct Unit { const char* A; const char* B; int pm, pn; };
struct Gemm { unsigned lda, ldb, kstepA; int K; };

template <class Epi, class Sched, bool ALIGN_EPI>
__device__ __forceinline__ void gemm_phase(LAS unsigned char* lds, const int tid, const Gemm g, const Sched& S, const Epi& E) {
    const int wid = __builtin_amdgcn_readfirstlane(tid >> 6), lane = tid & 63, wr = wid >> 2, wc = wid & 3, fr = lane & 15, fq = lane >> 4;
    const int nt = g.K / BK;
    unsigned voffA[2], voffB[2];
#pragma unroll
    for (int i = 0; i < 2; ++i) { int R, C; stage_rc(tid * 16 + i * 8192, R, C); const int Rb = Epi::PERM ? ((R & ~31) + perm32(R & 31)) : R;
        voffA[i] = (unsigned)R * g.lda + (unsigned)C * 2u; voffB[i] = (unsigned)Rb * g.ldb + (unsigned)C * 2u; }
    const size_t kstepA = (size_t)g.kstepA, kstepB = (size_t)(BK * 2);
    const size_t hstepA = (size_t)HALF * g.lda, hstepB = (size_t)HALF * g.ldb;
    const unsigned ldsw = (unsigned)wid * 1024u;
    const int aoff = lds_byte(wr * 64 + fr, fq * 8), boff = lds_byte(wc * 32 + fr, fq * 8);
#define PG8_SA(b, h) (((b) * 2 + (h)) * HTB)
#define PG8_SB(b, h) ((4 + (b) * 2 + (h)) * HTB)
#define PG8_STAGE(bufoff, gbase, voff) do { _Pragma("unroll") for (int _i = 0; _i < 2; ++_i) \
        __builtin_amdgcn_global_load_lds((const unsigned*)((const char*)(gbase) + (voff)[_i]), (LAS unsigned*)(lds + (bufoff) + ldsw + _i * 8192), 16, 0, 0); } while (0)
#define PG8_LDA(dst, b, h) do { _Pragma("unroll") for (int m = 0; m < 4; ++m) _Pragma("unroll") for (int k = 0; k < 2; ++k) dst[m][k] = *(const LAS bf16x8*)(lds + PG8_SA(b, h) + aoff + m * 2048 + k * 1024); } while (0)
#define PG8_LDB(dst, b, h) do { _Pragma("unroll") for (int n = 0; n < 2; ++n) _Pragma("unroll") for (int k = 0; k < 2; ++k) dst[n][k] = *(const LAS bf16x8*)(lds + PG8_SB(b, h) + boff + n * 2048 + k * 1024); } while (0)
#define PG8_MMA(ai, bj, At, Bt) do { __builtin_amdgcn_s_setprio(1); _Pragma("unroll") for (int m = 0; m < 4; ++m) _Pragma("unroll") for (int n = 0; n < 2; ++n) _Pragma("unroll") for (int k = 0; k < 2; ++k) \
        acc[ai][bj][m][n] = __builtin_amdgcn_mfma_f32_16x16x32_bf16(Bt[n][k], At[m][k], acc[ai][bj][m][n], 0, 0, 0); __builtin_amdgcn_s_setprio(0); } while (0)
#define PG8_WAIT_V(n) asm volatile("s_waitcnt vmcnt(" #n ")" ::: "memory")
#define PG8_WAIT_L(n) asm volatile("s_waitcnt lgkmcnt(" #n ")" ::: "memory")
#define PG8_BAR __builtin_amdgcn_s_barrier()
#define PG8_SCHED __builtin_amdgcn_sched_barrier(0)
    Unit cur, nxt; int ui = 0;
    if (!S.next(0, cur)) return;
    f32x4 acc[2][2][4][2];
#pragma unroll
    for (int a = 0; a < 2; ++a)
#pragma unroll
        for (int b = 0; b < 2; ++b)
#pragma unroll
            for (int m = 0; m < 4; ++m)
#pragma unroll
                for (int n = 0; n < 2; ++n) acc[a][b][m][n] = (f32x4){0.f, 0.f, 0.f, 0.f};
    bf16x8 At[4][2], B0[2][2], B1[2][2];
    const char* cA = cur.A; const char* cB = cur.B;
    PG8_STAGE(PG8_SB(0, 0), cB, voffB); PG8_STAGE(PG8_SB(0, 1), cB + hstepB, voffB); PG8_STAGE(PG8_SA(0, 0), cA, voffA); PG8_STAGE(PG8_SA(0, 1), cA + hstepA, voffA);
    if (wr == 1) PG8_BAR;
    PG8_WAIT_V(2); PG8_BAR;
    PG8_STAGE(PG8_SB(1, 0), cB + kstepB, voffB); PG8_STAGE(PG8_SA(1, 0), cA + kstepA, voffA); PG8_STAGE(PG8_SB(1, 1), cB + hstepB + kstepB, voffB);
    PG8_WAIT_V(6); PG8_BAR;
    for (;;) {
        const bool has_next = S.next(ui + 1, nxt);
        const char* nA = has_next ? nxt.A : cA; const char* nB = has_next ? nxt.B : cB;
        for (int t = 0; t < nt; t += 2) {
            const bool last = (t == nt - 2);
            const char* a1 = cA + (size_t)(t + 1) * kstepA;
            const char* a2 = last ? nA : cA + (size_t)(t + 2) * kstepA; const char* b2 = last ? nB : cB + (size_t)(t + 2) * kstepB;
            const char* a3 = a2 + kstepA; const char* b3 = b2 + kstepB;
            PG8_LDB(B0, 0, 0); PG8_LDB(B1, 0, 1); PG8_SCHED; PG8_LDA(At, 0, 0); PG8_STAGE(PG8_SA(1, 1), a1 + hstepA, voffA);
            PG8_WAIT_V(8); PG8_WAIT_L(0); PG8_BAR; PG8_MMA(0, 0, At, B0); PG8_MMA(0, 1, At, B1); PG8_BAR; PG8_SCHED;
            PG8_LDA(At, 0, 1); PG8_STAGE(PG8_SB(0, 0), b2, voffB); PG8_STAGE(PG8_SB(0, 1), b2 + hstepB, voffB); PG8_STAGE(PG8_SA(0, 0), a2, voffA);
            PG8_WAIT_V(8); PG8_WAIT_L(0); PG8_BAR; PG8_MMA(1, 0, At, B0); PG8_MMA(1, 1, At, B1); PG8_BAR; PG8_SCHED;
            PG8_LDB(B0, 1, 0); PG8_LDB(B1, 1, 1); PG8_SCHED; PG8_LDA(At, 1, 0); PG8_STAGE(PG8_SA(0, 1), a2 + hstepA, voffA);
            PG8_WAIT_V(8); PG8_WAIT_L(0); PG8_BAR; PG8_MMA(0, 0, At, B0); PG8_MMA(0, 1, At, B1); PG8_BAR; PG8_SCHED;
            PG8_LDA(At, 1, 1); PG8_STAGE(PG8_SB(1, 0), b3, voffB); PG8_STAGE(PG8_SB(1, 1), b3 + hstepB, voffB); PG8_STAGE(PG8_SA(1, 0), a3, voffA);
            PG8_WAIT_V(8); PG8_WAIT_L(0); PG8_BAR; PG8_MMA(1, 0, At, B0); PG8_MMA(1, 1, At, B1); PG8_BAR; PG8_SCHED;
        }
        if constexpr (ALIGN_EPI) { if (wr == 0) PG8_BAR; }
        if constexpr (!Epi::AFTER_DRAIN) { E(acc, cur, wr, wc, fr, fq); }
        if (!has_next) break;
#pragma unroll
        for (int a = 0; a < 2; ++a)
#pragma unroll
            for (int b = 0; b < 2; ++b)
#pragma unroll
                for (int m = 0; m < 4; ++m)
#pragma unroll
                    for (int n = 0; n < 2; ++n) acc[a][b][m][n] = (f32x4){0.f, 0.f, 0.f, 0.f};
        cur = nxt; cA = nA; cB = nB; ++ui;
        if constexpr (ALIGN_EPI) { if (wr == 1) PG8_BAR; }
    }
    PG8_WAIT_V(0);
    if constexpr (!ALIGN_EPI) { if (wr == 0) PG8_BAR; }
    PG8_BAR;
    if constexpr (Epi::AFTER_DRAIN) { E.fused(acc, cur, wr, wc, fr, fq, wid, lane); }
#undef PG8_SA
#undef PG8_SB
#undef PG8_STAGE
#undef PG8_LDA
#undef PG8_LDB
#undef PG8_MMA
#undef PG8_WAIT_V
#undef PG8_WAIT_L
#undef PG8_BAR
#undef PG8_SCHED
}

struct DenseOrder {
    int nM, nN, nwg, G, c; const char* A; const char* B; size_t tA, tB;
    __device__ __forceinline__ void init(int M, int N, int G_, int c_, const void* A_, unsigned lda, const void* B_, unsigned ldb) {
        nM = M / BM; nN = N / BM; nwg = nM * nN; G = G_; c = c_; A = (const char*)A_; B = (const char*)B_; tA = (size_t)BM * lda; tB = (size_t)BM * ldb; }
    __device__ __forceinline__ bool next(int i, Unit& u) const {
        const long L = (long)i * G + c; if (L >= nwg) return false;
        int wgid = (int)L; { const int q = nwg / 8, r = nwg % 8, xcd = wgid % 8, off = wgid / 8; wgid = (xcd < r ? xcd * (q + 1) : r * (q + 1) + (xcd - r) * q) + off; }
        const int nig = 8 * nN, gid = wgid / nig, fm = gid * 8, gsz = (nM - fm) < 8 ? (nM - fm) : 8;
        u.pm = fm + ((wgid % nig) % gsz); u.pn = (wgid % nig) / gsz;
        u.A = A + (size_t)u.pm * tA; u.B = B + (size_t)u.pn * tB; return true;
    }
};
}

struct Args {
    const float* x; const float* c; const float* rel_bias; const float* ada_w; const float* ada_b; const float* norm1; const float* norm2; const float* w_in;
    const float* cmp_pos; const float* cmp_w1; const float* cmp_w2; const float* w_up_nsa; const float* w_up_dil; const float* w_o;
    const float* router_wg; const float* router_bg; const float* router_we; const float* router_be; const float* exp_w1; const float* exp_w3; const float* exp_w2; const float* norm_f;
    float* out; unsigned char* ws; int ph_lo, ph_hi, use_bar, pad;
};

typedef f32x4 AccT[2][2][4][2];
struct EpiInProj {
    static constexpr bool PERM = true, AFTER_DRAIN = false;
    bf16_t* QKV; bf16_t* MG; float* GN;
    __device__ __forceinline__ void operator()(const AccT& acc, const pg8::Unit& u, int wr, int wc, int fr, int fq) const {
        const int pn = u.pn; const int row0 = u.pm * 256 + wr * 64 + fr;
        if (pn < 14) {
            const float sc = (pn < 2 || (pn >= 5 && pn < 8)) ? C2 : 1.0f;
            const int col0 = pn * 256 + wc * 32 + 8 * fq;
#pragma unroll
            for (int ai = 0; ai < 2; ++ai)
#pragma unroll
                for (int m = 0; m < 4; ++m) { bf16_t* rowp = QKV + (size_t)(row0 + ai * 128 + m * 16) * LDQ + col0;
#pragma unroll
                    for (int bj = 0; bj < 2; ++bj) { const f32x4 v0 = acc[ai][bj][m][0] * sc, v1 = acc[ai][bj][m][1] * sc; u32x4 w;
                        w.x = cvt_pk_bf16(v0[0], v0[1]); w.y = cvt_pk_bf16(v0[2], v0[3]); w.z = cvt_pk_bf16(v1[0], v1[1]); w.w = cvt_pk_bf16(v1[2], v1[3]);
                        *(u32x4*)(rowp + bj * 128) = w; } }
        } else if (pn < 22) {
            const int col0 = (pn - 14) * 256 + wc * 32 + 8 * fq;
#pragma unroll
            for (int ai = 0; ai < 2; ++ai)
#pragma unroll
                for (int m = 0; m < 4; ++m) { bf16_t* rowp = MG + (size_t)(row0 + ai * 128 + m * 16) * 2048 + col0;
#pragma unroll
                    for (int bj = 0; bj < 2; ++bj) { const f32x4 v0 = acc[ai][bj][m][0], v1 = acc[ai][bj][m][1]; u32x4 w;
                        w.x = cvt_pk_bf16(sigmoidf_(v0[0]), sigmoidf_(v0[1])); w.y = cvt_pk_bf16(sigmoidf_(v0[2]), sigmoidf_(v0[3]));
                        w.z = cvt_pk_bf16(sigmoidf_(v1[0]), sigmoidf_(v1[1])); w.w = cvt_pk_bf16(sigmoidf_(v1[2]), sigmoidf_(v1[3]));
                        *(u32x4*)(rowp + bj * 128) = w; } }
        } else {
            if (wc == 0 && fq < 3) {
#pragma unroll
                for (int ai = 0; ai < 2; ++ai)
#pragma unroll
                    for (int m = 0; m < 4; ++m) { float* rowp = GN + (size_t)(row0 + ai * 128 + m * 16) * 32 + 8 * fq;
                        const f32x4 v0 = acc[ai][0][m][0], v1 = acc[ai][0][m][1];
                        *(f32x4*)(rowp) = (f32x4){sigmoidf_(v0[0]), sigmoidf_(v0[1]), sigmoidf_(v0[2]), sigmoidf_(v0[3])};
                        *(f32x4*)(rowp + 4) = (f32x4){sigmoidf_(v1[0]), sigmoidf_(v1[1]), sigmoidf_(v1[2]), sigmoidf_(v1[3])}; }
            }
        }
    }
};
template <int PASS> struct EpiUp {
    static constexpr bool PERM = true, AFTER_DRAIN = false;
    bf16_t* MERGED; const bf16_t* MG;
    __device__ __forceinline__ void operator()(const AccT& acc, const pg8::Unit& u, int wr, int wc, int fr, int fq) const {
        const int row0 = u.pm * 256 + wr * 64 + fr; const int col0 = u.pn * 256 + wc * 32 + 8 * fq;
#pragma unroll
        for (int ai = 0; ai < 2; ++ai)
#pragma unroll
            for (int m = 0; m < 4; ++m) { const size_t row = (size_t)(row0 + ai * 128 + m * 16);
#pragma unroll
                for (int bj = 0; bj < 2; ++bj) {
                    const u32x4 gw = *(const u32x4*)(MG + row * 2048 + PASS * 1024 + col0 + bj * 128);
                    bf16_t* op = MERGED + row * 1024 + col0 + bj * 128;
                    const f32x4 v0 = acc[ai][bj][m][0], v1 = acc[ai][bj][m][1];
                    float r[8] = {v0[0] * bf_lo(gw.x), v0[1] * bf_hi(gw.x), v0[2] * bf_lo(gw.y), v0[3] * bf_hi(gw.y), v1[0] * bf_lo(gw.z), v1[1] * bf_hi(gw.z), v1[2] * bf_lo(gw.w), v1[3] * bf_hi(gw.w)};
                    if (PASS == 1) { const u32x4 ow = *(const u32x4*)op;
                        r[0] += bf_lo(ow.x); r[1] += bf_hi(ow.x); r[2] += bf_lo(ow.y); r[3] += bf_hi(ow.y); r[4] += bf_lo(ow.z); r[5] += bf_hi(ow.z); r[6] += bf_lo(ow.w); r[7] += bf_hi(ow.w); }
                    u32x4 w; w.x = cvt_pk_bf16(r[0], r[1]); w.y = cvt_pk_bf16(r[2], r[3]); w.z = cvt_pk_bf16(r[4], r[5]); w.w = cvt_pk_bf16(r[6], r[7]);
                    *(u32x4*)op = w; }
                asm volatile("" ::: "memory"); }
    }
};
struct EpiOut {
    static constexpr bool PERM = true, AFTER_DRAIN = false;
    const float* xin; float* xout; const float* g1;
    __device__ __forceinline__ void operator()(const AccT& acc, const pg8::Unit& u, int wr, int wc, int fr, int fq) const {
        const int row0 = u.pm * 256 + wr * 64 + fr; const int col0 = u.pn * 256 + wc * 32 + 8 * fq; const int b = u.pm >> 4;
        f32x4 gv[2][2];
#pragma unroll
        for (int bj = 0; bj < 2; ++bj)
#pragma unroll
            for (int n = 0; n < 2; ++n) gv[bj][n] = *(const f32x4*)(g1 + (size_t)b * 6144 + col0 + bj * 128 + 4 * n);
#pragma unroll
        for (int ai = 0; ai < 2; ++ai)
#pragma unroll
            for (int m = 0; m < 4; ++m) { const size_t off = (size_t)(row0 + ai * 128 + m * 16) * 1024 + col0;
#pragma unroll
                for (int bj = 0; bj < 2; ++bj)
#pragma unroll
                    for (int n = 0; n < 2; ++n) { const f32x4 xv = *(const f32x4*)(xin + off + bj * 128 + 4 * n);
                        *(f32x4*)(xout + off + bj * 128 + 4 * n) = xv + gv[bj][n] * acc[ai][bj][m][n]; }
                asm volatile("" ::: "memory"); }
    }
};
struct EpiMoe1 {
    static constexpr bool PERM = true, AFTER_DRAIN = false;
    bf16_t* ACT;
    __device__ __forceinline__ void operator()(const AccT& acc, const pg8::Unit& u, int wr, int wc, int fr, int fq) const {
        const int row0 = u.pm * 256 + wr * 64 + fr; const int col0 = u.pn * 128 + wc * 32 + 8 * fq;
#pragma unroll
        for (int ai = 0; ai < 2; ++ai)
#pragma unroll
            for (int m = 0; m < 4; ++m) { bf16_t* op = ACT + (size_t)(row0 + ai * 128 + m * 16) * 512 + col0; float r[8];
#pragma unroll
                for (int n = 0; n < 2; ++n)
#pragma unroll
                    for (int j = 0; j < 4; ++j) { const float a = acc[ai][0][m][n][j], bb = acc[ai][1][m][n][j]; r[n * 4 + j] = a * sigmoidf_(a) * bb; }
                u32x4 w; w.x = cvt_pk_bf16(r[0], r[1]); w.y = cvt_pk_bf16(r[2], r[3]); w.z = cvt_pk_bf16(r[4], r[5]); w.w = cvt_pk_bf16(r[6], r[7]);
                *(u32x4*)op = w; }
    }
};
struct EpiPlain {
    static constexpr bool PERM = true, AFTER_DRAIN = false;
    bf16_t* O; int ldc;
    __device__ __forceinline__ void operator()(const AccT& acc, const pg8::Unit& u, int wr, int wc, int fr, int fq) const {
        const int row0 = u.pm * 256 + wr * 64 + fr; const int col0 = u.pn * 256 + wc * 32 + 8 * fq;
#pragma unroll
        for (int ai = 0; ai < 2; ++ai)
#pragma unroll
            for (int m = 0; m < 4; ++m) { bf16_t* rowp = O + (size_t)(row0 + ai * 128 + m * 16) * ldc + col0;
#pragma unroll
                for (int bj = 0; bj < 2; ++bj) { const f32x4 v0 = acc[ai][bj][m][0], v1 = acc[ai][bj][m][1]; u32x4 w;
                    w.x = cvt_pk_bf16(v0[0], v0[1]); w.y = cvt_pk_bf16(v0[2], v0[3]); w.z = cvt_pk_bf16(v1[0], v1[1]); w.w = cvt_pk_bf16(v1[2], v1[3]);
                    *(u32x4*)(rowp + bj * 128) = w; } }
    }
};
__device__ __forceinline__ int crow(int r, int hi) { return (r & 3) + 8 * (r >> 2) + 4 * hi; }
__device__ __forceinline__ float gelu_tanh(float x) { const float u2 = 2.0f * 0.7978845608028654f * (x + 0.044715f * x * x * x); return x * __builtin_amdgcn_rcpf(1.0f + __builtin_amdgcn_exp2f(-u2 * LOG2E)); }
struct EpiCmp {
    static constexpr bool PERM = true, AFTER_DRAIN = true;
    bf16_t* HID; const float* CB1; const bf16_t* CW2T; bf16_t* KC;
    __device__ __forceinline__ void fused(const AccT& acc, const pg8::Unit& u, int wr, int wc, int fr, int fq, int wid, int lane) const {
        const int kv = u.pm >> 4; const int row0 = u.pm * 256 + wr * 64 + fr; const int col0 = wc * 32 + 8 * fq;
        const float* bias = CB1 + kv * 256;
        f32x4 bv[2][2];
#pragma unroll
        for (int bj = 0; bj < 2; ++bj)
#pragma unroll
            for (int n = 0; n < 2; ++n) bv[bj][n] = *(const f32x4*)(bias + col0 + bj * 128 + 4 * n);
#pragma unroll
        for (int ai = 0; ai < 2; ++ai)
#pragma unroll
            for (int m = 0; m < 4; ++m) { bf16_t* rowp = HID + (size_t)(row0 + ai * 128 + m * 16) * 256 + col0;
#pragma unroll
                for (int bj = 0; bj < 2; ++bj) { const f32x4 v0 = acc[ai][bj][m][0] + bv[bj][0], v1 = acc[ai][bj][m][1] + bv[bj][1]; u32x4 w;
                    w.x = cvt_pk_bf16(gelu_tanh(v0[0]), gelu_tanh(v0[1])); w.y = cvt_pk_bf16(gelu_tanh(v0[2]), gelu_tanh(v0[3]));
                    w.z = cvt_pk_bf16(gelu_tanh(v1[0]), gelu_tanh(v1[1])); w.w = cvt_pk_bf16(gelu_tanh(v1[2]), gelu_tanh(v1[3]));
                    *(u32x4*)(rowp + bj * 128) = w; } }
        VM_WAIT(); __syncthreads();
        const int r32 = lane & 31, hi = lane >> 5;
        const bf16_t* ap = HID + (size_t)(u.pm * 256 + 32 * wid + r32) * 256 + hi * 8;
        const bf16_t* bp = CW2T + (size_t)kv * 64 * 256 + (size_t)r32 * 256 + hi * 8;
        f32x16 o0 = {}, o1 = {};
#pragma unroll 4
        for (int ks = 0; ks < 16; ++ks) {
            const bf16x8 a = *(const bf16x8*)(ap + ks * 16);
            const bf16x8 b0 = *(const bf16x8*)(bp + ks * 16), b1 = *(const bf16x8*)(bp + 32 * 256 + ks * 16);
            o0 = __builtin_amdgcn_mfma_f32_32x32x16_bf16(a, b0, o0, 0, 0, 0);
            o1 = __builtin_amdgcn_mfma_f32_32x32x16_bf16(a, b1, o1, 0, 0, 0);
        }
        bf16_t* kc = KC + (size_t)u.pm * 256 * 64;
#pragma unroll
        for (int r = 0; r < 16; ++r) { const int c = 32 * wid + crow(r, hi); const bool pad = (c == 255);
            kc[(size_t)c * 64 + r32] = pad ? (bf16_t)0 : (bf16_t)(cvt_pk_bf16(o0[r], 0.f) & 0xffffu);
            kc[(size_t)c * 64 + 32 + r32] = pad ? (bf16_t)0 : (bf16_t)(cvt_pk_bf16(o1[r], 0.f) & 0xffffu); }
    }
};

namespace att {
constexpr int L_RING = 0;
constexpr int L_WSF = 32768;
constexpr int L_OST = 34816;
constexpr int L_BKT = 67584;
constexpr int L_TBH = 71680;
constexpr int L_GSH = 72192;
constexpr int L_SEL = 75264;
constexpr int L_IMP = 75840;
constexpr int L_END = L_IMP + 65536;
static_assert(L_END <= LDS_MISC, "attention LDS map");

__device__ __forceinline__ void glds16(const void* gsrc, unsigned lds_dst) { unsigned keep;
    asm volatile("s_mov_b32 %0, m0\n\ts_mov_b32 m0, %2\n\ts_nop 0\n\tglobal_load_lds_dwordx4 %1, off\n\ts_mov_b32 m0, %0" : "=&s"(keep) : "v"(gsrc), "s"(lds_dst) : "memory"); }
__device__ __forceinline__ int bucket_of(int d) {
    if (d < 16) return d;
    int b = 16;
    b += (d >= 22); b += (d >= 30); b += (d >= 40); b += (d >= 54); b += (d >= 73); b += (d >= 99); b += (d >= 134); b += (d >= 182);
    b += (d >= 246); b += (d >= 332); b += (d >= 450); b += (d >= 609); b += (d >= 825); b += (d >= 1117); b += (d >= 1513);
    return b;
}
__device__ __forceinline__ void qkt(f32x16& p0, f32x16& p1, const LAS unsigned char* Kslot, const bf16x8 (&qr)[4], int r32, int hi) {
    const LAS unsigned char* kb = Kslot + hi * 1024 + r32 * 16;
    p0 = (f32x16){}; p1 = (f32x16){};
#pragma unroll
    for (int d0 = 0; d0 < 4; ++d0) {
        const bf16x8 b0 = *(const LAS bf16x8*)(kb + d0 * 2048);
        const bf16x8 b1 = *(const LAS bf16x8*)(kb + d0 * 2048 + 512);
        p0 = __builtin_amdgcn_mfma_f32_32x32x16_bf16(b0, qr[d0], p0, 0, 0, 0);
        p1 = __builtin_amdgcn_mfma_f32_32x32x16_bf16(b1, qr[d0], p1, 0, 0, 0);
    }
}
__device__ __forceinline__ void pv(f32x16 (&o)[2], int vb, bf16x8 pa0, bf16x8 pa1, bf16x8 pa2, bf16x8 pa3) {
#pragma unroll
    for (int d0 = 0; d0 < 2; ++d0) { s16x4 lo[4], hi[4];
#pragma unroll
        for (int ks = 0; ks < 4; ++ks) {
            asm volatile("ds_read_b64_tr_b16 %0,%1 offset:%c2" : "=&v"(lo[ks]) : "v"(vb), "i"(d0 * 4096 + ks * 1024) : "memory");
            asm volatile("ds_read_b64_tr_b16 %0,%1 offset:%c2" : "=&v"(hi[ks]) : "v"(vb), "i"(d0 * 4096 + ks * 1024 + 512) : "memory"); }
        asm volatile("s_waitcnt lgkmcnt(0)" ::: "memory"); __builtin_amdgcn_sched_barrier(0);
#define PK(k) (bf16x8){lo[k][0], lo[k][1], lo[k][2], lo[k][3], hi[k][0], hi[k][1], hi[k][2], hi[k][3]}
        o[d0] = __builtin_amdgcn_mfma_f32_32x32x16_bf16(pa0, PK(0), o[d0], 0, 0, 0);
        o[d0] = __builtin_amdgcn_mfma_f32_32x32x16_bf16(pa1, PK(1), o[d0], 0, 0, 0);
        o[d0] = __builtin_amdgcn_mfma_f32_32x32x16_bf16(pa2, PK(2), o[d0], 0, 0, 0);
        o[d0] = __builtin_amdgcn_mfma_f32_32x32x16_bf16(pa3, PK(3), o[d0], 0, 0, 0);
#undef PK
    }
}
__device__ __forceinline__ float xhalf_max(float v) { auto rr = __builtin_amdgcn_permlane32_swap(__float_as_uint(v), __float_as_uint(v), false, false); return __builtin_fmaxf(__uint_as_float(rr[0]), __uint_as_float(rr[1])); }
__device__ __forceinline__ float xhalf_sum(float v) { auto rr = __builtin_amdgcn_permlane32_swap(__float_as_uint(v), __float_as_uint(v), false, false); return __uint_as_float(rr[0]) + __uint_as_float(rr[1]); }

template <int KMUL>
__device__ __forceinline__ void tile_scores(f32x16& p0, f32x16& p1, int base_hi, int maxd, int dsh, bool laneok, const LAS unsigned char* bkt, const LAS float* tb) {
#pragma unroll
    for (int r = 0; r < 16; ++r) {
        const int off = KMUL * ((r & 3) + 8 * (r >> 2));
        { const int dist = base_hi - off; const bool ok = laneok && ((unsigned)dist <= (unsigned)maxd); int di = (dist < 0 ? 0 : dist) << dsh; di = di > 4095 ? 4095 : di;
          const float bb = tb[bkt[di]]; p0[r] = ok ? p0[r] + bb : -INFINITY; }
        { const int dist = base_hi - off - KMUL * 32; const bool ok = laneok && ((unsigned)dist <= (unsigned)maxd); int di = (dist < 0 ? 0 : dist) << dsh; di = di > 4095 ? 4095 : di;
          const float bb = tb[bkt[di]]; p1[r] = ok ? p1[r] + bb : -INFINITY; }
    }
}
#define ATT_PACK(p0, p1, pw0, pw1, pw2, pw3) do { \
    pw0 = (u32x4){cvt_pk_bf16(p0[0], p0[1]), cvt_pk_bf16(p0[2], p0[3]), cvt_pk_bf16(p0[4], p0[5]), cvt_pk_bf16(p0[6], p0[7])}; \
    pw1 = (u32x4){cvt_pk_bf16(p0[8], p0[9]), cvt_pk_bf16(p0[10], p0[11]), cvt_pk_bf16(p0[12], p0[13]), cvt_pk_bf16(p0[14], p0[15])}; \
    pw2 = (u32x4){cvt_pk_bf16(p1[0], p1[1]), cvt_pk_bf16(p1[2], p1[3]), cvt_pk_bf16(p1[4], p1[5]), cvt_pk_bf16(p1[6], p1[7])}; \
    pw3 = (u32x4){cvt_pk_bf16(p1[8], p1[9]), cvt_pk_bf16(p1[10], p1[11]), cvt_pk_bf16(p1[12], p1[13]), cvt_pk_bf16(p1[14], p1[15])}; } while (0)

struct LoopP {
    const bf16_t* Kb; const bf16_t* Vb; long pitch;
    unsigned long long tmask;
    int uqp; int maxd; int dsh; unsigned long long lanesel;
    int wlo, whi;
    const LAS float* tb;
    LAS float* imp;
};
template <int KMUL, int MODE>
__device__ __forceinline__ void attn_loop(LAS unsigned char* lds, int wid, int lane, const bf16x8 (&qr)[4], const LoopP P, float& m, float& l, f32x16 (&o)[2]) {
    const int r32 = lane & 31, hi = lane >> 5;
    const unsigned lds0 = (unsigned)(uintptr_t)lds;
    unsigned tlo = __builtin_amdgcn_readfirstlane((unsigned)P.tmask), thi = __builtin_amdgcn_readfirstlane((unsigned)(P.tmask >> 32));
    unsigned long long tm = ((unsigned long long)thi << 32) | tlo;
    if (tm == 0ull) return;
    const LAS unsigned char* bkt = lds + L_BKT;
    LAS float* wsf = (LAS float*)(lds + L_WSF) + wid * 64;
    const bf16_t* ksrc = P.Kb + (long)lane * P.pitch + wid * 8;
    const bf16_t* vsrc = P.Vb + (long)(16 * (wid & 3) + (lane >> 2)) * P.pitch + (wid >> 2) * 32 + (lane & 3) * 8;
    const int vb0 = (int)lds0 + ((lane >> 4) & 1) * 32 + (lane & 3) * 8 + (4 * hi + ((lane & 15) >> 2)) * 64;
#define ATT_DMA(t, st) do { glds16(ksrc + (long)(t) * 64 * P.pitch, (unsigned)__builtin_amdgcn_readfirstlane(lds0 + L_RING + (st) * 16384 + wid * 1024)); \
                            glds16(vsrc + (long)(t) * 64 * P.pitch, (unsigned)__builtin_amdgcn_readfirstlane(lds0 + L_RING + (st) * 16384 + 8192 + wid * 1024)); } while (0)
    int t = __builtin_ctzll(tm); tm &= tm - 1ull;
    int st = 0;
    ATT_DMA(t, 0);
    for (;;) {
        const bool hn = (tm != 0ull); int tn = 0;
        if (hn) { tn = __builtin_ctzll(tm); tm &= tm - 1ull; ATT_DMA(tn, st ^ 1); asm volatile("s_waitcnt vmcnt(2)\n\ts_barrier" ::: "memory"); }
        else { asm volatile("s_waitcnt vmcnt(0)\n\ts_barrier" ::: "memory"); }
        if (t >= P.wlo && t <= P.whi) {
            f32x16 p0, p1;
            qkt(p0, p1, lds + L_RING + st * 16384, qr, r32, hi);
            const bool laneok = ((P.lanesel >> t) & 1ull) != 0ull;
            tile_scores<KMUL>(p0, p1, P.uqp - KMUL * (64 * t + 4 * hi), P.maxd, P.dsh, laneok, bkt, P.tb);
            if (MODE == 2) {
#pragma unroll
                for (int r = 0; r < 16; ++r) { p0[r] = __builtin_amdgcn_exp2f(p0[r] - m) * l; p1[r] = __builtin_amdgcn_exp2f(p1[r] - m) * l; }
#pragma unroll
                for (int k = 0; k < 4; ++k) { const int n0 = 16 * t + 2 * k + hi;
                    P.imp[n0] += 2.0f * (p0[4 * k] + p0[4 * k + 1] + p0[4 * k + 2]) + p0[4 * k + 3];
                    P.imp[n0 + 8] += 2.0f * (p1[4 * k] + p1[4 * k + 1] + p1[4 * k + 2]) + p1[4 * k + 3]; }
#pragma unroll
                for (int k = 0; k < 4; ++k) { const int n0 = 16 * t + 2 * k + hi;
                    P.imp[n0 + 1] += p0[4 * k + 3];
                    if (n0 + 9 < 64) P.imp[n0 + 9] += p1[4 * k + 3]; }
            } else {
                float rm = p0[0];
#pragma unroll
                for (int r = 1; r < 16; ++r) rm = __builtin_fmaxf(rm, p0[r]);
#pragma unroll
                for (int r = 0; r < 16; ++r) rm = __builtin_fmaxf(rm, p1[r]);
                rm = xhalf_max(rm);
                const float mnew = __builtin_fmaxf(m, rm);
                const float msafe = (mnew == -INFINITY) ? 0.0f : mnew;
                const float alpha = __builtin_amdgcn_exp2f(m - msafe);
                float ps = 0.f;
#pragma unroll
                for (int r = 0; r < 16; ++r) { p0[r] = __builtin_amdgcn_exp2f(p0[r] - msafe); p1[r] = __builtin_amdgcn_exp2f(p1[r] - msafe); ps += p0[r] + p1[r]; }
                l = l * alpha + ps; m = mnew;
                if (MODE == 0) {
                    if (__any(alpha != 1.0f)) {
                        if (hi == 0) wsf[r32] = alpha;
                        LDS_WAIT();
#pragma unroll
                        for (int r = 0; r < 16; ++r) { const float f = wsf[crow(r, hi)]; o[0][r] *= f; o[1][r] *= f; }
                    }
                }
            }
            if (MODE != 1) {
                u32x4 pw0, pw1, pw2, pw3; ATT_PACK(p0, p1, pw0, pw1, pw2, pw3);
                pv(o, vb0 + L_RING + st * 16384 + 8192, __builtin_bit_cast(bf16x8, pw0), __builtin_bit_cast(bf16x8, pw1), __builtin_bit_cast(bf16x8, pw2), __builtin_bit_cast(bf16x8, pw3));
            }
        }
        asm volatile("s_waitcnt lgkmcnt(0)\n\ts_barrier" ::: "memory");
        if (!hn) break;
        t = tn; st ^= 1;
    }
#undef ATT_DMA
}
__device__ __forceinline__ void stage_rows(LAS unsigned char* lds, int wid, int lane, const f32x16 (&ot)[2]) {
    const int r32 = lane & 31, hi = lane >> 5;
    LAS bf16_t* stg = (LAS bf16_t*)(lds + L_OST) + wid * 2048;
#pragma unroll
    for (int r = 0; r < 16; ++r) { const int orow = crow(r, hi);
#pragma unroll
        for (int d0 = 0; d0 < 2; ++d0) stg[orow * 64 + d0 * 32 + r32] = (bf16_t)(cvt_pk_bf16(ot[d0][r], 0.f) & 0xffffu); }
    LDS_WAIT();
}
}

struct Ctx { int tid, lane, wave, vcu, G, bx; LAS unsigned char* lds; };

__device__ __forceinline__ void tr_item(const float* W, size_t ldw, int srccol, int nvalid, bf16_t* WT, size_t ldk, int dstrow, int k0, LAS float* scr, int lane) {
#pragma unroll 8
    for (int i = 0; i < 32; ++i) { const int kk = 2 * i + (lane >> 5), n = lane & 31; scr[kk * 33 + n] = (n < nvalid) ? W[(size_t)(k0 + kk) * ldw + srccol + n] : 0.f; }
    LDS_WAIT(); asm volatile("" ::: "memory");
    const int c = lane & 7;
#pragma unroll
    for (int j = 0; j < 4; ++j) { const int n = (lane >> 3) + 8 * j; const LAS float* s = scr + (8 * c) * 33 + n;
        u32x4 o; o.x = cvt_pk_bf16(s[0 * 33], s[1 * 33]); o.y = cvt_pk_bf16(s[2 * 33], s[3 * 33]); o.z = cvt_pk_bf16(s[4 * 33], s[5 * 33]); o.w = cvt_pk_bf16(s[6 * 33], s[7 * 33]);
        *(u32x4*)(WT + (size_t)(dstrow + n) * ldk + k0 + 8 * c) = o; }
    LDS_WAIT(); asm volatile("" ::: "memory");
}
__device__ __forceinline__ void conv_small(const Args& a, const Ctx& C) {
    LAS float* scr = (LAS float*)(C.lds + C.wave * 16384);
    const int gw = C.vcu * NWAVES + C.wave, NGW = C.G * NWAVES;
    constexpr int I_WIN = 184 * 16, I_CW1 = 2 * 8 * 32, I_WUN = 32 * 8, I_WUD = 32 * 4, I_WO = 32 * 16, I_CW2 = 2 * 2 * 4;
    constexpr int PER = I_WIN + I_CW1 + I_WUN + I_WUD + I_WO + I_CW2;
    unsigned char* ws = a.ws;
    for (int it = gw; it < 2 * PER; it += NGW) {
        const int l = it / PER; int r = it % PER;
        if (r < I_WIN) { const int nb = r / 16, kb = r % 16; const int nd = 32 * nb; int src, nv = 32;
            if (nd < 1280) src = nd; else if (nd < 5632) src = nd + 24; else if (nd == 5632) { src = 1280; nv = 24; } else { src = 0; nv = 0; }
            tr_item(a.w_in + (size_t)l * DM * INW, INW, src, nv, (bf16_t*)(ws + WS_WINT) + (size_t)l * NIN * DM, DM, nd, 64 * kb, scr, C.lane); continue; }
        r -= I_WIN;
        if (r < I_CW1) { const int kv = r / 256, q = r % 256, nb = q / 32, kb = q % 32;
            tr_item(a.cmp_w1 + (size_t)(l * 2 + kv) * 2048 * 256, 256, 32 * nb, 32, (bf16_t*)(ws + WS_CW1T) + (size_t)(l * 2 + kv) * 256 * 2048, 2048, 32 * nb, 64 * kb, scr, C.lane); continue; }
        r -= I_CW1;
        if (r < I_WUN) { const int nb = r / 8, kb = r % 8;
            tr_item(a.w_up_nsa + (size_t)l * 512 * 1024, 1024, 32 * nb, 32, (bf16_t*)(ws + WS_WUNT) + (size_t)l * 1024 * 512, 512, 32 * nb, 64 * kb, scr, C.lane); continue; }
        r -= I_WUN;
        if (r < I_WUD) { const int nb = r / 4, kb = r % 4;
            tr_item(a.w_up_dil + (size_t)l * 256 * 1024, 1024, 32 * nb, 32, (bf16_t*)(ws + WS_WUDT) + (size_t)l * 1024 * 256, 256, 32 * nb, 64 * kb, scr, C.lane); continue; }
        r -= I_WUD;
        if (r < I_WO) { const int nb = r / 16, kb = r % 16;
            tr_item(a.w_o + (size_t)l * 1024 * 1024, 1024, 32 * nb, 32, (bf16_t*)(ws + WS_WOT) + (size_t)l * 1024 * 1024, 1024, 32 * nb, 64 * kb, scr, C.lane); continue; }
        r -= I_WO;
        { const int kv = r / 8, q = r % 8, nb = q / 4, kb = q % 4;
            tr_item(a.cmp_w2 + (size_t)(l * 2 + kv) * 256 * 64, 64, 32 * nb, 32, (bf16_t*)(ws + WS_CW2T) + (size_t)(l * 2 + kv) * 64 * 256, 256, 32 * nb, 64 * kb, scr, C.lane); }
    }
}
__device__ __forceinline__ void conv_experts(const Args& a, const Ctx& C, int l) {
    LAS float* scr = (LAS float*)(C.lds + C.wave * 16384);
    const int gw = C.vcu * NWAVES + C.wave, NGW = C.G * NWAVES;
    constexpr int I_13 = 32 * 16, I_2 = 32 * 8, PER = I_13 + I_2;
    unsigned char* ws = a.ws;
    for (int it = gw; it < 32 * PER; it += NGW) {
        const int e = it / PER; int r = it % PER;
        if (r < I_13) { const int nb = r / 16, kb = r % 16; const int r0 = 32 * nb, pn = r0 >> 8, bj = (r0 >> 7) & 1, j0 = r0 & 127;
            const float* src = (bj ? a.exp_w3 : a.exp_w1) + (size_t)(l * 32 + e) * 1024 * 512;
            tr_item(src, 512, pn * 128 + j0, 32, (bf16_t*)(ws + WS_E13T) + (size_t)e * 1024 * 1024, 1024, r0, 64 * kb, scr, C.lane); continue; }
        r -= I_13;
        { const int nb = r / 8, kb = r % 8;
            tr_item(a.exp_w2 + (size_t)(l * 32 + e) * 512 * 1024, 1024, 32 * nb, 32, (bf16_t*)(ws + WS_E2T) + (size_t)e * 1024 * 512, 512, 32 * nb, 64 * kb, scr, C.lane); }
    }
}
__device__ __forceinline__ void prologue_vectors(const Args& a, const Ctx& C) {
    LAS float* sc = (LAS float*)(C.lds + 131072);
    LAS float* sl = (LAS float*)(C.lds);
    for (int i = C.tid; i < 8 * 1024; i += NTHR) { const float v = a.c[i]; sl[i] = v * sigmoidf_(v); }
    (void)sc;
    __syncthreads();
    const int gw = C.vcu * NWAVES + C.wave, NGW = C.G * NWAVES;
    float* MOD = (float*)(a.ws + WS_MOD); float* CB1 = (float*)(a.ws + WS_CB1);
    for (int it = gw; it < 192 + 16; it += NGW) {
        if (it < 192) { const int l = it / 96, col = (it % 96) * 64 + C.lane;
            const float* w = a.ada_w + (size_t)l * 1024 * 6144 + col;
            float acc[8];
#pragma unroll
            for (int b = 0; b < 8; ++b) acc[b] = 0.f;
            for (int k = 0; k < 1024; ++k) { const float wv = w[(size_t)k * 6144];
#pragma unroll
                for (int b = 0; b < 8; ++b) acc[b] += sl[b * 1024 + k] * wv; }
            const float bias = a.ada_b[l * 6144 + col];
#pragma unroll
            for (int b = 0; b < 8; ++b) MOD[(size_t)(l * 8 + b) * 6144 + col] = acc[b] + bias;
        } else { const int q = it - 192, lk = q / 4, col = (q % 4) * 64 + C.lane;
            const float* w = a.cmp_w1 + (size_t)lk * 2048 * 256 + col; const float* pos = a.cmp_pos + (size_t)lk * 2048;
            float acc = 0.f;
            for (int k = 0; k < 2048; ++k) acc += pos[k] * w[(size_t)k * 256];
            CB1[lk * 256 + col] = acc;
        }
    }
    __syncthreads();
}

__device__ __forceinline__ void moe_combine_row(const Args& a, int row, int lane, const float* g2  , f32x4 (&v)[4]) {
    const u32x4 rec = *(const u32x4*)(a.ws + WS_DEST + (size_t)row * 16);
    const bf16_t* Y = (const bf16_t*)(a.ws + WS_XS);
    const float w0 = __uint_as_float(rec.z), w1 = __uint_as_float(rec.w);
    const u32x2* y0 = (const u32x2*)(Y + (size_t)rec.x * 1024) + lane; const u32x2* y1 = (const u32x2*)(Y + (size_t)rec.y * 1024) + lane;
#pragma unroll
    for (int j = 0; j < 4; ++j) { const u32x2 p = y0[64 * j], q = y1[64 * j]; const f32x4 gg = *((const f32x4*)g2 + lane + 64 * j);
        v[j][0] += gg[0] * (w0 * bf_lo(p.x) + w1 * bf_lo(q.x)); v[j][1] += gg[1] * (w0 * bf_hi(p.x) + w1 * bf_hi(q.x));
        v[j][2] += gg[2] * (w0 * bf_lo(p.y) + w1 * bf_lo(q.y)); v[j][3] += gg[3] * (w0 * bf_hi(p.y) + w1 * bf_hi(q.y)); }
}
__device__ __forceinline__ void norm1_phase(const Args& a, const Ctx& C, int l) {
    const int gw = C.vcu * NWAVES + C.wave, NGW = C.G * NWAVES;
    const float* MOD = (const float*)(a.ws + WS_MOD); bf16_t* H = (bf16_t*)(a.ws + WS_H);
    const float* nw = a.norm1 + l * 1024;
    for (int row = gw; row < T; row += NGW) {
        const int b = row >> 12; const float* xr = (l == 0 ? a.x : (const float*)a.out) + (size_t)row * 1024;
        f32x4 v[4];
#pragma unroll
        for (int j = 0; j < 4; ++j) v[j] = *((const f32x4*)xr + C.lane + 64 * j);
        if (l == 1) { moe_combine_row(a, row, C.lane, MOD + (size_t)(0 * 8 + b) * 6144 + 5120, v);
#pragma unroll
            for (int j = 0; j < 4; ++j) *((f32x4*)(a.out + (size_t)row * 1024) + C.lane + 64 * j) = v[j]; }
        float ss = 0.f;
#pragma unroll
        for (int j = 0; j < 4; ++j) ss += (v[j][0] * v[j][0] + v[j][1] * v[j][1]) + (v[j][2] * v[j][2] + v[j][3] * v[j][3]);
        const float rstd = 1.0f / sqrtf(wave_sum(ss) * (1.0f / 1024.0f) + RMS_EPS);
        const float* mb = MOD + (size_t)(l * 8 + b) * 6144;
#pragma unroll
        for (int j = 0; j < 4; ++j) { const f32x4 g = *((const f32x4*)nw + C.lane + 64 * j), sh = *((const f32x4*)mb + C.lane + 64 * j), sc = *((const f32x4*)(mb + 1024) + C.lane + 64 * j);
            const f32x4 h = v[j] * rstd * g * (sc + 1.0f) + sh; u32x2 w; w.x = cvt_pk_bf16(h[0], h[1]); w.y = cvt_pk_bf16(h[2], h[3]);
            *((u32x2*)(H + (size_t)row * 1024) + C.lane + 64 * j) = w; }
    }
}
__device__ __forceinline__ void final_phase(const Args& a, const Ctx& C) {
    const int gw = C.vcu * NWAVES + C.wave, NGW = C.G * NWAVES;
    const float* MOD = (const float*)(a.ws + WS_MOD);
    for (int row = gw; row < T; row += NGW) {
        const int b = row >> 12; float* xr = a.out + (size_t)row * 1024;
        f32x4 v[4];
#pragma unroll
        for (int j = 0; j < 4; ++j) v[j] = *((const f32x4*)xr + C.lane + 64 * j);
        moe_combine_row(a, row, C.lane, MOD + (size_t)(1 * 8 + b) * 6144 + 5120, v);
        float ss = 0.f;
#pragma unroll
        for (int j = 0; j < 4; ++j) ss += (v[j][0] * v[j][0] + v[j][1] * v[j][1]) + (v[j][2] * v[j][2] + v[j][3] * v[j][3]);
        const float rstd = 1.0f / sqrtf(wave_sum(ss) * (1.0f / 1024.0f) + RMS_EPS);
#pragma unroll
        for (int j = 0; j < 4; ++j) { const f32x4 g = *((const f32x4*)a.norm_f + C.lane + 64 * j); *((f32x4*)xr + C.lane + 64 * j) = v[j] * rstd * g; }
    }
}
__device__ __forceinline__ void norm2_router_phase(const Args& a, const Ctx& C, int l) {
    LAS float* WL = (LAS float*)(C.lds);
    LAS int* wcnt = (LAS int*)(C.lds + LDS_MISC + 256);
    const float* wg = a.router_wg + (size_t)l * 1024 * 4; const float* we = a.router_we + (size_t)l * 1024 * 32;
    for (int i = C.tid; i < 1024 * 4; i += NTHR) { const int k = i >> 2, c = i & 3; WL[c * 1024 + k] = wg[i]; }
    for (int i = C.tid; i < 1024 * 32; i += NTHR) { const int k = i >> 5, c = i & 31; WL[(4 + c) * 1024 + k] = we[i]; }
    __syncthreads();
    const float* MOD = (const float*)(a.ws + WS_MOD); bf16_t* H2 = (bf16_t*)(a.ws + WS_H2);
    const float* nw = a.norm2 + l * 1024; const float* bg = a.router_bg + l * 4; const float* be = a.router_be + l * 32;
    int* CNTBLK = (int*)(a.ws + WS_CNTBLK);
    for (int ch = C.vcu; ch < T / 128; ch += C.G) {
        int my_e0 = 0, my_e1 = 0; float my_w0 = 0.f, my_w1 = 0.f;
        for (int j = 0; j < 16; ++j) {
            const int row = ch * 128 + C.wave * 16 + j; const int b = row >> 12;
            const float* xr = a.out + (size_t)row * 1024;
            f32x4 v[4];
#pragma unroll
            for (int q = 0; q < 4; ++q) v[q] = *((const f32x4*)xr + C.lane + 64 * q);
            float ss = 0.f;
#pragma unroll
            for (int q = 0; q < 4; ++q) ss += (v[q][0] * v[q][0] + v[q][1] * v[q][1]) + (v[q][2] * v[q][2] + v[q][3] * v[q][3]);
            const float rstd = 1.0f / sqrtf(wave_sum(ss) * (1.0f / 1024.0f) + RMS_EPS);
            const float* mb = MOD + (size_t)(l * 8 + b) * 6144 + 3072;
#pragma unroll
            for (int q = 0; q < 4; ++q) { const f32x4 g = *((const f32x4*)nw + C.lane + 64 * q), sh = *((const f32x4*)mb + C.lane + 64 * q), sc = *((const f32x4*)(mb + 1024) + C.lane + 64 * q);
                v[q] = v[q] * rstd * g * (sc + 1.0f) + sh; u32x2 w; w.x = cvt_pk_bf16(v[q][0], v[q][1]); w.y = cvt_pk_bf16(v[q][2], v[q][3]);
                *((u32x2*)(H2 + (size_t)row * 1024) + C.lane + 64 * q) = w; }
            float lg[4];
#pragma unroll
            for (int c = 0; c < 4; ++c) { float s = 0.f;
#pragma unroll
                for (int q = 0; q < 4; ++q) { const f32x4 w = *((const LAS f32x4*)(WL + c * 1024) + C.lane + 64 * q); s += (v[q][0] * w[0] + v[q][1] * w[1]) + (v[q][2] * w[2] + v[q][3] * w[3]); }
                lg[c] = wave_sum(s) + bg[c]; }
            int grp = 0; float gmax = lg[0];
#pragma unroll
            for (int c = 1; c < 4; ++c) if (lg[c] > gmax) { gmax = lg[c]; grp = c; }
            float gs = 0.f;
#pragma unroll
            for (int c = 0; c < 4; ++c) gs += __builtin_amdgcn_exp2f((lg[c] - gmax) * LOG2E);
            const float pgrp = 1.0f / gs;
            grp = __builtin_amdgcn_readfirstlane(grp);
            float le[8];
#pragma unroll
            for (int e = 0; e < 8; ++e) { float s = 0.f; const LAS float* wrow = WL + (4 + grp * 8 + e) * 1024;
#pragma unroll
                for (int q = 0; q < 4; ++q) { const f32x4 w = *((const LAS f32x4*)wrow + C.lane + 64 * q); s += (v[q][0] * w[0] + v[q][1] * w[1]) + (v[q][2] * w[2] + v[q][3] * w[3]); }
                le[e] = wave_sum(s) + be[grp * 8 + e]; }
            int i0 = 0; float v0 = le[0];
#pragma unroll
            for (int e = 1; e < 8; ++e) if (le[e] > v0) { v0 = le[e]; i0 = e; }
            int i1 = -1; float v1 = -INFINITY;
#pragma unroll
            for (int e = 0; e < 8; ++e) if (e != i0 && le[e] > v1) { v1 = le[e]; i1 = e; }
            const float ex = __builtin_amdgcn_exp2f((v1 - v0) * LOG2E);
            const float w0 = pgrp / (1.0f + ex), w1 = pgrp * ex / (1.0f + ex);
            if (C.lane == j) { my_e0 = grp * 8 + i0; my_e1 = grp * 8 + i1; my_w0 = w0; my_w1 = w1; }
        }
        const int ea = bperm_i(C.lane >> 1, my_e0), eb = bperm_i(C.lane >> 1, my_e1);
        const int es = (C.lane < 32) ? ((C.lane & 1) ? eb : ea) : -1;
        int rank = 0, cnt = 0;
#pragma unroll
        for (int s = 0; s < 32; ++s) { const int v = __builtin_amdgcn_readlane(es, s); rank += (v == es && s < C.lane) ? 1 : 0; cnt += (v == C.lane) ? 1 : 0; }
        __syncthreads();
        if (C.lane < 32) wcnt[C.wave * 32 + C.lane] = cnt;
        __syncthreads();
        int lrank = rank;
        if (C.lane < 32) { for (int w = 0; w < C.wave; ++w) lrank += wcnt[w * 32 + es]; }
        if (C.wave == 0 && C.lane < 32) { int tot = 0;
#pragma unroll
            for (int w = 0; w < 8; ++w) tot += wcnt[w * 32 + C.lane];
            CNTBLK[ch * 32 + C.lane] = tot; }
        const int lr0 = bperm_i((2 * C.lane) & 63, lrank), lr1 = bperm_i((2 * C.lane + 1) & 63, lrank);
        if (C.lane < 16) { const int row = ch * 128 + C.wave * 16 + C.lane;
            u32x4 rec; rec.x = (unsigned)my_e0 | ((unsigned)my_e1 << 8); rec.y = (unsigned)lr0 | ((unsigned)lr1 << 16); rec.z = __float_as_uint(my_w0); rec.w = __float_as_uint(my_w1);
            *(u32x4*)(a.ws + WS_REC + (size_t)row * 16) = rec; }
    }
}
__device__ __forceinline__ void moe_scatter_phase(const Args& a, const Ctx& C) {
    LAS int* part_lt = (LAS int*)(C.lds);
    LAS int* part_all = part_lt + 512;
    LAS int* base = part_all + 512;
    LAS int* tot = base + 32;
    LAS int* pst = tot + 32;
    const int* CNTBLK = (const int*)(a.ws + WS_CNTBLK);
    int* TILEE = (int*)(a.ws + WS_TILEE);
    const bf16_t* H2 = (const bf16_t*)(a.ws + WS_H2); bf16_t* XS = (bf16_t*)(a.ws + WS_XS);
    for (int ch = C.vcu; ch < T / 128; ch += C.G) {
        __syncthreads();
        { const int e = C.tid & 31, p = C.tid >> 5; int slt = 0, sall = 0;
            for (int c = p; c < T / 128; c += 16) { const int v = CNTBLK[c * 32 + e]; sall += v; slt += (c < ch) ? v : 0; }
            part_lt[p * 32 + e] = slt; part_all[p * 32 + e] = sall; }
        __syncthreads();
        if (C.tid < 32) { int b = 0, t2 = 0;
#pragma unroll
            for (int p = 0; p < 16; ++p) { b += part_lt[p * 32 + C.tid]; t2 += part_all[p * 32 + C.tid]; }
            base[C.tid] = b; tot[C.tid] = t2; }
        __syncthreads();
        if (C.tid < 32) { int ps = 0; for (int e = 0; e < C.tid; ++e) ps += (tot[e] + 255) & ~255; pst[C.tid] = ps;
            if (ch == 0) { const int nt = (tot[C.tid] + 255) >> 8; const int t0 = ps >> 8; for (int m = 0; m < nt; ++m) TILEE[16 + t0 + m] = C.tid; if (C.tid == 31) TILEE[0] = t0 + nt; } }
        __syncthreads();
        int d0 = 0, d1 = 0;
        if (C.lane < 16) { const int row = ch * 128 + C.wave * 16 + C.lane;
            const u32x4 rec = *(const u32x4*)(a.ws + WS_REC + (size_t)row * 16);
            const int e0 = rec.x & 255, e1 = (rec.x >> 8) & 255;
            d0 = pst[e0] + base[e0] + (int)(rec.y & 0xffffu); d1 = pst[e1] + base[e1] + (int)(rec.y >> 16);
            u32x4 o; o.x = (unsigned)d0; o.y = (unsigned)d1; o.z = rec.z; o.w = rec.w;
            *(u32x4*)(a.ws + WS_DEST + (size_t)row * 16) = o; }
        for (int j = 0; j < 16; ++j) { const int row = ch * 128 + C.wave * 16 + j;
            const int t0 = __builtin_amdgcn_readlane(d0, j), t1 = __builtin_amdgcn_readlane(d1, j);
            const u32x4* src = (const u32x4*)(H2 + (size_t)row * 1024) + C.lane;
            const u32x4 va = src[0], vb = src[64];
            u32x4* o0 = (u32x4*)(XS + (size_t)t0 * 1024) + C.lane; u32x4* o1 = (u32x4*)(XS + (size_t)t1 * 1024) + C.lane;
            o0[0] = va; o0[64] = vb; o1[0] = va; o1[64] = vb; }
    }
}
struct MoeOrder {
    int G, c, nu; int ex[8]; const char* A; const char* B; size_t tA, tB, eB;
    __device__ __forceinline__ bool next(int i, pg8::Unit& u) const {
        const int L = i * G + c; if (i >= 8 || L >= nu) return false;
        const int e = i == 0 ? ex[0] : i == 1 ? ex[1] : i == 2 ? ex[2] : i == 3 ? ex[3] : i == 4 ? ex[4] : i == 5 ? ex[5] : i == 6 ? ex[6] : ex[7];
        u.pm = L >> 2; u.pn = L & 3; u.A = A + (size_t)u.pm * tA; u.B = B + (size_t)e * eB + (size_t)u.pn * tB; return true;
    }
};

__device__ __forceinline__ void dil_unit(const Args& a, const Ctx& C, int du) {
    using namespace att;
    LAS unsigned char* lds = C.lds;
    const int x = du & 15; int r = du >> 4; const int h = r & 3; r >>= 2; const int grp = r % 3, b = r / 3;
    const int dsh = 2 * grp, d = 1 << dsh; const int nub = 16 >> dsh; const int res = x / nub, ub = x % nub;
    const int wid = C.wave, lane = C.lane, r32 = lane & 31, hi = lane >> 5;
    __syncthreads();
    if (C.tid < 32) ((LAS float*)(lds + L_TBH))[C.tid] = a.rel_bias[C.tid * 20 + 8 + grp * 4 + h] * LOG2E;
    const bf16_t* QKV = (const bf16_t*)(a.ws + WS_A);
    const int u = 256 * ub + 32 * wid + r32; const size_t tokq = (size_t)b * SEQ + (size_t)u * d + res;
    const bf16_t* qp = QKV + tokq * LDQ + 1280 + grp * 256 + h * 64;
    bf16x8 qr[4];
#pragma unroll
    for (int d0 = 0; d0 < 4; ++d0) qr[d0] = *(const bf16x8*)(qp + d0 * 16 + hi * 8);
    __syncthreads();
    LoopP P; P.Kb = QKV + ((size_t)b * SEQ + res) * LDQ + 1280 + 768 + grp * 256 + h * 64; P.Vb = P.Kb + 768; P.pitch = (long)d * LDQ;
    { const int klo = 4 * ub - 2 < 0 ? 0 : 4 * ub - 2; unsigned long long tmk = 0ull; for (int k = klo; k <= 4 * ub + 3; ++k) tmk |= 1ull << k; P.tmask = tmk; }
    P.uqp = u; P.maxd = 128; P.dsh = dsh; P.lanesel = ~0ull;
    { const int lo = 256 * ub + 32 * wid - 128; P.wlo = lo < 0 ? 0 : (lo >> 6); P.whi = (256 * ub + 32 * wid + 31) >> 6; }
    P.tb = (const LAS float*)(lds + L_TBH); P.imp = nullptr;
    float m = -INFINITY, l = 0.f; f32x16 o[2]; o[0] = (f32x16){}; o[1] = (f32x16){};
    attn_loop<1, 0>(lds, wid, lane, qr, P, m, l, o);
    l = xhalf_sum(l);
    LAS float* wsf = (LAS float*)(lds + L_WSF) + wid * 64;
    if (hi == 0) { wsf[r32] = l > 0.f ? 1.0f / l : 0.f; ((float*)(a.ws + WS_LSE))[((size_t)grp * T + tokq) * 4 + h] = m + __builtin_amdgcn_logf(l); }
    LDS_WAIT();
#pragma unroll
    for (int rr = 0; rr < 16; ++rr) { const float f = wsf[crow(rr, hi)]; o[0][rr] *= f; o[1][rr] *= f; }
    stage_rows(lds, wid, lane, o);
    bf16_t* ODP = (bf16_t*)(a.ws + WS_ODP) + (size_t)grp * T * 256;
    const LAS bf16_t* stg = (const LAS bf16_t*)(lds + L_OST) + wid * 2048;
#pragma unroll
    for (int i = 0; i < 4; ++i) { const int row = i * 8 + (lane >> 3), chn = lane & 7; const u32x4 v = *(const LAS u32x4*)(stg + row * 64 + chn * 8);
        const size_t tok = (size_t)b * SEQ + (size_t)(256 * ub + 32 * wid + row) * d + res;
        *(u32x4*)(ODP + tok * 256 + h * 64 + chn * 8) = v; }
}
__device__ __forceinline__ void dil_combine(const Args& a, const Ctx& C) {
    const float* LSE = (const float*)(a.ws + WS_LSE); const bf16_t* ODP = (const bf16_t*)(a.ws + WS_ODP); bf16_t* ODIL = (bf16_t*)(a.ws + WS_ODIL);
    const int gt = C.vcu * NTHR + C.tid, NT = C.G * NTHR;
    for (int idx = gt; idx < T * 32; idx += NT) {
        const int tok = idx >> 5, h = (idx >> 3) & 3, chn = idx & 7;
        const float l0 = LSE[((size_t)0 * T + tok) * 4 + h], l1 = LSE[((size_t)1 * T + tok) * 4 + h], l2 = LSE[((size_t)2 * T + tok) * 4 + h];
        const float mx = __builtin_fmaxf(l0, __builtin_fmaxf(l1, l2));
        float w0 = __builtin_amdgcn_exp2f(l0 - mx), w1 = __builtin_amdgcn_exp2f(l1 - mx), w2 = __builtin_amdgcn_exp2f(l2 - mx);
        const float inv = 1.0f / (w0 + w1 + w2); w0 *= inv; w1 *= inv; w2 *= inv;
        const size_t off = (size_t)tok * 256 + h * 64 + chn * 8;
        const u32x4 a0 = *(const u32x4*)(ODP + off), a1 = *(const u32x4*)(ODP + (size_t)T * 256 + off), a2 = *(const u32x4*)(ODP + (size_t)2 * T * 256 + off);
        u32x4 o;
        o.x = cvt_pk_bf16(w0 * bf_lo(a0.x) + w1 * bf_lo(a1.x) + w2 * bf_lo(a2.x), w0 * bf_hi(a0.x) + w1 * bf_hi(a1.x) + w2 * bf_hi(a2.x));
        o.y = cvt_pk_bf16(w0 * bf_lo(a0.y) + w1 * bf_lo(a1.y) + w2 * bf_lo(a2.y), w0 * bf_hi(a0.y) + w1 * bf_hi(a1.y) + w2 * bf_hi(a2.y));
        o.z = cvt_pk_bf16(w0 * bf_lo(a0.z) + w1 * bf_lo(a1.z) + w2 * bf_lo(a2.z), w0 * bf_hi(a0.z) + w1 * bf_hi(a1.z) + w2 * bf_hi(a2.z));
        o.w = cvt_pk_bf16(w0 * bf_lo(a0.w) + w1 * bf_lo(a1.w) + w2 * bf_lo(a2.w), w0 * bf_hi(a0.w) + w1 * bf_hi(a1.w) + w2 * bf_hi(a2.w));
        *(u32x4*)(ODIL + off) = o;
    }
}
__device__ __forceinline__ void nsa_unit(const Args& a, const Ctx& C, int b, int hk, int i) {
    using namespace att;
    LAS unsigned char* lds = C.lds;
    const int wid = C.wave, lane = C.lane, r32 = lane & 31, hi = lane >> 5, tid = C.tid;
    const int g = wid >> 1, tq = (wid & 1) * 32 + r32, t = 64 * i + tq; const size_t tok = (size_t)b * SEQ + t;
    LAS float* impP = (LAS float*)(lds + L_IMP);
    LAS float* tbh = (LAS float*)(lds + L_TBH);
    LAS float* gsh = (LAS float*)(lds + L_GSH) + wid * 96;
    LAS unsigned* selw = (LAS unsigned*)(lds + L_SEL);
    LAS float* wsf = (LAS float*)(lds + L_WSF) + wid * 64;
    const bf16_t* QKV = (const bf16_t*)(a.ws + WS_A);
    __syncthreads();
    for (int e = tid; e < 4 * 64 * 64; e += NTHR) impP[e] = 0.f;
    if (tid < 128) tbh[tid] = a.rel_bias[(tid & 31) * 20 + hk * 4 + (tid >> 5)] * LOG2E;
    if (tid < 2) selw[128 + tid] = 0u;
    if (hi == 0) { const float* gn = (const float*)(a.ws + WS_GN) + tok * 32 + hk * 4 + g;
        gsh[r32] = gn[0]; gsh[32 + r32] = gn[8]; gsh[64 + r32] = gn[16]; }
    bf16x8 qr[4];
    { const bf16_t* qp = QKV + tok * LDQ + hk * 256 + g * 64;
#pragma unroll
        for (int d0 = 0; d0 < 4; ++d0) qr[d0] = *(const bf16x8*)(qp + d0 * 16 + hi * 8); }
    __syncthreads();
    f32x16 o[2];
    LAS float* otacc = (LAS float*)(lds + L_IMP) + wid * 2048 + r32;
    LoopP P; P.tb = tbh + g * 32; P.imp = impP + (g * 64 + tq) * 64; P.wlo = 0; P.whi = 63; P.dsh = 0;
    {
        const bf16_t* KC = (const bf16_t*)(a.ws + WS_KC);
        P.Kb = KC + (size_t)((0 * 8 + b) * 2 + hk) * 256 * 64; P.Vb = KC + (size_t)((1 * 8 + b) * 2 + hk) * 256 * 64; P.pitch = 64;
        const int nt = (4 * i + 2) / 64 + 1; P.tmask = (1ull << nt) - 1ull;
        P.uqp = t - 31; P.maxd = 1 << 30; P.lanesel = ~0ull;
        float m = -INFINITY, l = 0.f;
        attn_loop<16, 1>(lds, wid, lane, qr, P, m, l, o);
        l = xhalf_sum(l);
        float msafe = (m == -INFINITY) ? 0.f : m, invl = l > 0.f ? 1.0f / l : 0.f;
        o[0] = (f32x16){}; o[1] = (f32x16){};
        attn_loop<16, 2>(lds, wid, lane, qr, P, msafe, invl, o);
    }
    __syncthreads();
    {
#pragma unroll
        for (int k = 0; k < 8; ++k) { const int idx = tid * 8 + k; impP[idx] = ((impP[idx] + impP[4096 + idx]) + impP[8192 + idx]) + impP[12288 + idx]; }
        __syncthreads();
        const int q = tid >> 3, part = tid & 7;
        const int ncand = i - 2 > 0 ? i - 2 : 0; const int nforced = i + 1 < 3 ? i + 1 : 3; const int krem = 16 - nforced;
        unsigned bits = 0u;
        if (ncand > krem) {
            float vn[8]; int cn[8];
#pragma unroll
            for (int e = 0; e < 8; ++e) { vn[e] = impP[q * 64 + part * 8 + e]; cn[e] = 0; }
            for (int mm = 1; mm <= i - 2; ++mm) { const float xv = impP[q * 64 + mm];
#pragma unroll
                for (int e = 0; e < 8; ++e) { const int n = part * 8 + e; cn[e] += (xv > vn[e] || (xv == vn[e] && mm < n)) ? 1 : 0; } }
#pragma unroll
            for (int e = 0; e < 8; ++e) { const int n = part * 8 + e; if (n >= 1 && n <= i - 2 && cn[e] < krem) bits |= 1u << e; }
        } else {
#pragma unroll
            for (int e = 0; e < 8; ++e) { const int n = part * 8 + e; if (n >= 1 && n <= i - 2) bits |= 1u << e; }
        }
#pragma unroll
        for (int e = 0; e < 8; ++e) { const int n = part * 8 + e; if (n == 0 || n == i || n == i - 1) bits |= 1u << e; }
        unsigned lo = part < 4 ? bits << (8 * part) : 0u, hi2 = part >= 4 ? bits << (8 * (part - 4)) : 0u;
        lo |= swz_xor_u<1>(lo); hi2 |= swz_xor_u<1>(hi2); lo |= swz_xor_u<2>(lo); hi2 |= swz_xor_u<2>(hi2); lo |= swz_xor_u<4>(lo); hi2 |= swz_xor_u<4>(hi2);
        if (part == 0) { selw[2 * q] = lo; selw[2 * q + 1] = hi2; atomicOr((unsigned*)&selw[128], lo); atomicOr((unsigned*)&selw[129], hi2); }
    }
    __syncthreads();
#pragma unroll
    for (int r = 0; r < 16; ++r) { const float f = gsh[crow(r, hi)]; otacc[crow(r, hi) * 64] = f * o[0][r]; otacc[crow(r, hi) * 64 + 32] = f * o[1][r]; }
    {
        P.Kb = QKV + (size_t)b * SEQ * LDQ + 512 + 256 + hk * 64; P.Vb = P.Kb + 128; P.pitch = LDQ;
        P.tmask = ((unsigned long long)selw[129] << 32) | selw[128];
        P.uqp = t; P.maxd = 1 << 30; P.lanesel = ((unsigned long long)selw[2 * tq + 1] << 32) | selw[2 * tq];
        float m = -INFINITY, l = 0.f; o[0] = (f32x16){}; o[1] = (f32x16){};
        attn_loop<1, 0>(lds, wid, lane, qr, P, m, l, o);
        l = xhalf_sum(l);
        if (hi == 0) wsf[r32] = (l > 0.f ? 1.0f / l : 0.f) * gsh[32 + r32];
        LDS_WAIT();
#pragma unroll
        for (int r = 0; r < 16; ++r) { const float f = wsf[crow(r, hi)]; otacc[crow(r, hi) * 64] += f * o[0][r]; otacc[crow(r, hi) * 64 + 32] += f * o[1][r]; }
    }
    {
        P.Kb = QKV + (size_t)b * SEQ * LDQ + 512 + 512 + hk * 64; P.Vb = P.Kb + 128; P.pitch = LDQ;
        { const int jlo = i - 8 < 0 ? 0 : i - 8; unsigned long long tmk = 0ull; for (int j = jlo; j <= i; ++j) tmk |= 1ull << j; P.tmask = tmk; }
        P.uqp = t; P.maxd = 512; P.lanesel = ~0ull;
        float m = -INFINITY, l = 0.f; o[0] = (f32x16){}; o[1] = (f32x16){};
        attn_loop<1, 0>(lds, wid, lane, qr, P, m, l, o);
        l = xhalf_sum(l);
        LDS_WAIT();
        if (hi == 0) wsf[r32] = (l > 0.f ? 1.0f / l : 0.f) * gsh[64 + r32];
        LDS_WAIT();
#pragma unroll
        for (int r = 0; r < 16; ++r) { const float f = wsf[crow(r, hi)]; otacc[crow(r, hi) * 64] += f * o[0][r]; otacc[crow(r, hi) * 64 + 32] += f * o[1][r]; }
    }
    LDS_WAIT();
    bf16_t* ONSA = (bf16_t*)(a.ws + WS_ONSA);
    const LAS float* accw = (const LAS float*)(lds + L_IMP) + wid * 2048;
#pragma unroll
    for (int k = 0; k < 4; ++k) { const int row = k * 8 + (lane >> 3), chn = lane & 7;
        const f32x4 f0 = *(const LAS f32x4*)(accw + row * 64 + chn * 8), f1 = *(const LAS f32x4*)(accw + row * 64 + chn * 8 + 4);
        u32x4 v; v.x = cvt_pk_bf16(f0[0], f0[1]); v.y = cvt_pk_bf16(f0[2], f0[3]); v.z = cvt_pk_bf16(f1[0], f1[1]); v.w = cvt_pk_bf16(f1[2], f1[3]);
        const size_t tk = (size_t)b * SEQ + 64 * i + (wid & 1) * 32 + row;
        *(u32x4*)(ONSA + tk * 512 + hk * 256 + g * 64 + chn * 8) = v; }
}
__device__ __forceinline__ void build_bkt(const Ctx& C) {
    LAS unsigned char* bkt = C.lds + att::L_BKT;
    for (int d = C.tid; d < 4096; d += NTHR) bkt[d] = (unsigned char)att::bucket_of(d);
    __syncthreads();
}

typedef const Args __attribute__((address_space(4)))* CArgsP;
__device__ __forceinline__ Args load_args() {
#if defined(__HIP_DEVICE_COMPILE__)
    CArgsP p = (CArgsP)__builtin_amdgcn_kernarg_segment_ptr(); asm volatile("" : "+s"(p)); Args a;
    a.x = p->x; a.c = p->c; a.rel_bias = p->rel_bias; a.ada_w = p->ada_w; a.ada_b = p->ada_b; a.norm1 = p->norm1; a.norm2 = p->norm2; a.w_in = p->w_in;
    a.cmp_pos = p->cmp_pos; a.cmp_w1 = p->cmp_w1; a.cmp_w2 = p->cmp_w2; a.w_up_nsa = p->w_up_nsa; a.w_up_dil = p->w_up_dil; a.w_o = p->w_o;
    a.router_wg = p->router_wg; a.router_bg = p->router_bg; a.router_we = p->router_we; a.router_be = p->router_be; a.exp_w1 = p->exp_w1; a.exp_w3 = p->exp_w3; a.exp_w2 = p->exp_w2; a.norm_f = p->norm_f;
    a.out = p->out; a.ws = p->ws; a.ph_lo = p->ph_lo; a.ph_hi = p->ph_hi; a.use_bar = p->use_bar; a.pad = 0;
    return a;
#else
    return Args{};
#endif
}
#define LOADA() const Args a = load_args()
__global__ void __launch_bounds__(NTHR, 2) fwd_kernel(Args a_) {
    extern __shared__ __attribute__((aligned(16))) unsigned char lds_raw[];
    LAS unsigned char* const lds_base = (LAS unsigned char*)lds_raw;
    const int wave0_ = __builtin_amdgcn_readfirstlane((int)threadIdx.x >> 6);
#define FRESH() Ctx C; { int w_ = wave0_; asm volatile("" : "+s"(w_)); int t_ = lane_id_fresh(); asm volatile("" : "+v"(t_)); t_ += w_ * 64; int g_ = gridDim.x, b_ = blockIdx.x; asm volatile("" : "+s"(g_), "+s"(b_)); \
        C.lds = lds_base; C.tid = t_; C.lane = t_ & 63; C.wave = w_; C.G = g_; C.bx = b_; C.vcu = (g_ % 8 == 0) ? (b_ % 8) * (g_ / 8) + b_ / 8 : b_; }
    volatile LAS unsigned* MISC = (volatile LAS unsigned*)(lds_base + LDS_MISC);
    if (threadIdx.x < 64) MISC[threadIdx.x] = 0u;
    __syncthreads();
    unsigned* ctl = (unsigned*)(a_.ws + WS_CTL);
    XcdBarrier bar; bar.bar = ctl + CW_BAR; bar.x = 0; bar.st = nullptr;
    if (a_.use_bar) bar = xcd_barrier_post(ctl + CW_BAR, MISC + 8);
    const int lo = a_.ph_lo, hi = a_.ph_hi;
#ifndef PH_MASK
#define PH_MASK 0xFFFFFFFFu
#endif
#define IN(k) (((PH_MASK >> ((k) == 0 ? 10 : (k) == 21 ? 11 : (((k) - 1) % 10))) & 1u) && lo <= (k) && (k) < hi)
#define SEAM(k) do { if (IN(k) && IN((k) + 1)) { XcdBarrier b2_ = bar; asm volatile("" : "+s"(b2_.bar)); int w2_ = wave0_; asm volatile("" : "+s"(w2_)); xcd_barrier(b2_, w2_ == 0 && lane_id_fresh() == 0); } } while (0)
    if (IN(0)) { FRESH(); LOADA(); prologue_vectors(a, C); conv_small(a, C); conv_experts(a, C, 0); }
    SEAM(0);
    _Pragma("unroll") for (int l = 0; l < 2; ++l) {
        const int pb = 1 + 10 * l;
        if (IN(pb + 0)) { FRESH(); LOADA(); norm1_phase(a, C, l); if (l == 1) conv_experts(a, C, 1); }
        SEAM(pb + 0);
        if (IN(pb + 1)) { FRESH(); LOADA(); unsigned char* ws = a.ws;
            pg8::Gemm g{2048u, 2048u, 128u, 1024}; pg8::DenseOrder S; S.init(T, NIN, C.G, C.bx, ws + WS_H, 2048u, ws + WS_WINT + (size_t)l * NIN * DM * 2, 2048u);
            EpiInProj E{(bf16_t*)(ws + WS_A), (bf16_t*)(ws + WS_MG), (float*)(ws + WS_GN)};
            pg8::gemm_phase<EpiInProj, pg8::DenseOrder, true>(C.lds, C.tid, g, S, E);
        }
        SEAM(pb + 1);
        if (IN(pb + 2)) { FRESH(); LOADA(); unsigned char* ws = a.ws;
            struct CmpOrder { int c; const char* A; const char* B;
                __device__ __forceinline__ bool next(int i, pg8::Unit& u) const { if (i > 0 || c >= 32) return false; const int kv = c >> 4, b = (c >> 1) & 7, hk = c & 1;
                    u.pm = c; u.pn = 0; u.A = A + ((size_t)b * SEQ * LDQ + 512 + kv * 128 + hk * 64) * 2; u.B = B + (size_t)kv * 256 * 2048 * 2; return true; } };
            pg8::Gemm g{(unsigned)(16 * LDQ * 2), 4096u, (unsigned)(LDQ * 2), 2048};
            CmpOrder S{C.vcu, (const char*)(ws + WS_A), (const char*)(ws + WS_CW1T + (size_t)l * 2 * 256 * 2048 * 2)};
            EpiCmp E{(bf16_t*)(ws + WS_HID), (const float*)(ws + WS_CB1) + l * 512, (const bf16_t*)(ws + WS_CW2T) + (size_t)l * 2 * 64 * 256, (bf16_t*)(ws + WS_KC)};
            pg8::gemm_phase<EpiCmp, CmpOrder, false>(C.lds, C.tid, g, S, E);
            __syncthreads();
            build_bkt(C);
            for (int du = C.vcu; du < 1536; du += C.G) dil_unit(a, C, du);
        }
        SEAM(pb + 2);
        if (IN(pb + 3)) { FRESH(); LOADA();
            dil_combine(a, C);
            build_bkt(C);
            for (int v = C.vcu; v < 256; v += C.G) { const int b = v >> 5, hk = (v >> 4) & 1, s = v & 15;
                for (int k = 0; k < 4; ++k) { const int qi = (k == 0) ? s : (k == 1) ? 31 - s : (k == 2) ? 32 + s : 63 - s; nsa_unit(a, C, b, hk, qi); } }
            __syncthreads();
        }
        SEAM(pb + 3);
        if (IN(pb + 4)) { FRESH(); LOADA(); unsigned char* ws = a.ws;
            { pg8::Gemm g{1024u, 1024u, 128u, 512}; pg8::DenseOrder S; S.init(T, 1024, C.G, C.bx, ws + WS_ONSA, 1024u, ws + WS_WUNT + (size_t)l * 1024 * 512 * 2, 1024u);
              EpiUp<0> E{(bf16_t*)(ws + WS_MERGED), (const bf16_t*)(ws + WS_MG)};
              pg8::gemm_phase<EpiUp<0>, pg8::DenseOrder, true>(C.lds, C.tid, g, S, E); }
            VM_WAIT(); __syncthreads();
            { pg8::Gemm g{512u, 512u, 128u, 256}; pg8::DenseOrder S; S.init(T, 1024, C.G, C.bx, ws + WS_ODIL, 512u, ws + WS_WUDT + (size_t)l * 1024 * 256 * 2, 512u);
              EpiUp<1> E{(bf16_t*)(ws + WS_MERGED), (const bf16_t*)(ws + WS_MG)};
              pg8::gemm_phase<EpiUp<1>, pg8::DenseOrder, true>(C.lds, C.tid, g, S, E); }
        }
        SEAM(pb + 4);
        if (IN(pb + 5)) { FRESH(); LOADA(); unsigned char* ws = a.ws;
            pg8::Gemm g{2048u, 2048u, 128u, 1024}; pg8::DenseOrder S; S.init(T, 1024, C.G, C.bx, ws + WS_MERGED, 2048u, ws + WS_WOT + (size_t)l * 1024 * 1024 * 2, 2048u);
            EpiOut E{l == 0 ? a.x : (const float*)a.out, a.out, (const float*)(ws + WS_MOD) + (size_t)l * 8 * 6144 + 2048};
            pg8::gemm_phase<EpiOut, pg8::DenseOrder, true>(C.lds, C.tid, g, S, E);
        }
        SEAM(pb + 5);
        if (IN(pb + 6)) { FRESH(); LOADA(); norm2_router_phase(a, C, l); }
        SEAM(pb + 6);
        if (IN(pb + 7)) { FRESH(); LOADA(); moe_scatter_phase(a, C); }
        SEAM(pb + 7);
        if (IN(pb + 8)) { FRESH(); LOADA(); unsigned char* ws = a.ws;
            const int* TILEE = (const int*)(ws + WS_TILEE); const int ntl = TILEE[0];
            MoeOrder S; S.G = C.G; S.c = C.vcu; S.nu = ntl * 4; S.A = (const char*)(ws + WS_XS); S.B = (const char*)(ws + WS_E13T); S.tA = (size_t)256 * 2048; S.tB = (size_t)256 * 2048; S.eB = (size_t)1024 * 2048;
#pragma unroll
            for (int i = 0; i < 8; ++i) { const int L = i * C.G + C.vcu; S.ex[i] = (L < S.nu) ? TILEE[16 + (L >> 2)] : 0; }
            pg8::Gemm g{2048u, 2048u, 128u, 1024};
            EpiMoe1 E{(bf16_t*)(ws + WS_ACT)};
            pg8::gemm_phase<EpiMoe1, MoeOrder, true>(C.lds, C.tid, g, S, E);
        }
        SEAM(pb + 8);
        if (IN(pb + 9)) { FRESH(); LOADA(); unsigned char* ws = a.ws;
            const int* TILEE = (const int*)(ws + WS_TILEE); const int ntl = TILEE[0];
            MoeOrder S; S.G = C.G; S.c = C.vcu; S.nu = ntl * 4; S.A = (const char*)(ws + WS_ACT); S.B = (const char*)(ws + WS_E2T); S.tA = (size_t)256 * 1024; S.tB = (size_t)256 * 1024; S.eB = (size_t)1024 * 1024;
#pragma unroll
            for (int i = 0; i < 8; ++i) { const int L = i * C.G + C.vcu; S.ex[i] = (L < S.nu) ? TILEE[16 + (L >> 2)] : 0; }
            pg8::Gemm g{1024u, 1024u, 128u, 512};
            EpiPlain E{(bf16_t*)(ws + WS_XS), 1024};
            pg8::gemm_phase<EpiPlain, MoeOrder, true>(C.lds, C.tid, g, S, E);
        }
        SEAM(pb + 9);
    }
    if (IN(21)) { FRESH(); LOADA(); final_phase(a, C); }
#undef IN
#undef SEAM
}

#ifndef ONE_LAUNCH
#define ONE_LAUNCH 1
#endif
extern "C" void kernel_launch(void* const* d_in, const int* in_sizes, int n_in, void* d_out, int out_size, void* d_ws, size_t ws_size, hipStream_t stream) {
    static int grid = 0;
    if (grid == 0) {
        if (n_in != 22 || out_size != T * DM || ws_size < WS_END) { fprintf(stderr, "kernel_launch: unexpected problem (n_in %d out %d ws %zu)\n", n_in, out_size, ws_size); grid = -1; return; }
        int dev = 0, cus = 0;
        if (hipGetDevice(&dev) != hipSuccess || hipDeviceGetAttribute(&cus, hipDeviceAttributeMultiprocessorCount, dev) != hipSuccess) { grid = -1; return; }
        if (hipFuncSetAttribute((const void*)fwd_kernel, hipFuncAttributeMaxDynamicSharedMemorySize, LDS_BYTES) != hipSuccess) { fprintf(stderr, "kernel_launch: hipFuncSetAttribute failed\n"); grid = -1; return; }
        int per_cu = 0;
        if (hipOccupancyMaxActiveBlocksPerMultiprocessor(&per_cu, (const void*)fwd_kernel, NTHR, LDS_BYTES) != hipSuccess || per_cu < 1) { fprintf(stderr, "kernel_launch: occupancy query reports %d\n", per_cu); }
        (void)hipGetLastError();
        grid = cus;
    }
    if (grid < 0) return;
    (void)hipMemsetAsync((char*)d_ws + WS_CTL, 0, CTL_ZERO_BYTES, stream);
    Args a{};
    a.x = (const float*)d_in[0]; a.c = (const float*)d_in[1]; a.rel_bias = (const float*)d_in[2]; a.ada_w = (const float*)d_in[3]; a.ada_b = (const float*)d_in[4];
    a.norm1 = (const float*)d_in[5]; a.norm2 = (const float*)d_in[6]; a.w_in = (const float*)d_in[7]; a.cmp_pos = (const float*)d_in[8]; a.cmp_w1 = (const float*)d_in[9];
    a.cmp_w2 = (const float*)d_in[10]; a.w_up_nsa = (const float*)d_in[11]; a.w_up_dil = (const float*)d_in[12]; a.w_o = (const float*)d_in[13];
    a.router_wg = (const float*)d_in[14]; a.router_bg = (const float*)d_in[15]; a.router_we = (const float*)d_in[16]; a.router_be = (const float*)d_in[17];
    a.exp_w1 = (const float*)d_in[18]; a.exp_w3 = (const float*)d_in[19]; a.exp_w2 = (const float*)d_in[20]; a.norm_f = (const float*)d_in[21];
    a.out = (float*)d_out; a.ws = (unsigned char*)d_ws; a.pad = 0;
#if ONE_LAUNCH
    a.ph_lo = 0; a.ph_hi = NPHASE; a.use_bar = 1;
    hipLaunchKernelGGL(fwd_kernel, dim3(grid), dim3(NTHR), LDS_BYTES, stream, a);
#else
    for (int p = 0; p < NPHASE; ++p) { a.ph_lo = p; a.ph_hi = p + 1; a.use_bar = 0;
        hipLaunchKernelGGL(fwd_kernel, dim3(grid), dim3(NTHR), LDS_BYTES, stream, a); }
#endif
}
```

```cpp
#include <hip/hip_runtime.h>
#include <cstdint>
#include <cstdio>

#define GAS __attribute__((address_space(1)))
#define LAS __attribute__((address_space(3)))
typedef unsigned short bf16_t;
typedef short bf16x8 __attribute__((ext_vector_type(8)));
typedef short s16x4 __attribute__((ext_vector_type(4)));
typedef float f32x4 __attribute__((ext_vector_type(4)));
typedef float f32x2 __attribute__((ext_vector_type(2)));
typedef float f32x16 __attribute__((ext_vector_type(16)));
typedef unsigned u32x4 __attribute__((ext_vector_type(4)));
typedef unsigned u32x2 __attribute__((ext_vector_type(2)));
typedef __bf16 bf16x2_t __attribute__((ext_vector_type(2)));

constexpr int NB = 8, SEQ = 4096, DM = 1024, T = NB * SEQ;
constexpr int LDQ = 3584;
constexpr int NIN = 5888;
constexpr int INW = 5656;
constexpr float LOG2E = 1.4426950408889634f;
constexpr float C2 = 0.125f * LOG2E;
constexpr int NWAVES = 8, NTHR = 512;
constexpr float RMS_EPS = 1e-6f;
constexpr int NPHASE = 22;
#ifndef ABL
#define ABL 0
#endif
#ifndef REP_MASK
#define REP_MASK 0u
#endif
#define REPEAT(k) _Pragma("clang loop unroll(disable)") for (int rep_ = 0; rep_ < (int)((REP_MASK >> (k)) & 1u) + 1; ++rep_)

constexpr size_t MiB = 1u << 20;
constexpr size_t WS_CTL = 0, CTL_ZERO_BYTES = MiB;
constexpr size_t WS_MOD = 1 * MiB;
constexpr size_t WS_CB1 = WS_MOD + 400 * 1024;
constexpr size_t WS_CW2T = WS_MOD + 512 * 1024;
constexpr size_t WS_CNTBLK = WS_MOD + 768 * 1024;
constexpr size_t WS_TILEE = WS_MOD + 832 * 1024;
constexpr size_t WS_WINT = 4 * MiB;
constexpr size_t WS_CW1T = 27 * MiB;
constexpr size_t WS_WUNT = 31 * MiB;
constexpr size_t WS_WUDT = 33 * MiB;
constexpr size_t WS_WOT = 34 * MiB;
constexpr size_t WS_E13T = 38 * MiB;
constexpr size_t WS_E2T = 102 * MiB;
constexpr size_t WS_A = 134 * MiB;
constexpr size_t WS_XS = WS_A;
constexpr size_t WS_ACT = WS_A + 144 * MiB;
constexpr size_t WS_MERGED = WS_A;
constexpr size_t WS_MG = 359 * MiB;
constexpr size_t WS_H2 = WS_MG;
constexpr size_t WS_REC = WS_MG + 64 * MiB;
constexpr size_t WS_DEST = WS_MG + 65 * MiB;
constexpr size_t WS_B = 487 * MiB;
constexpr size_t WS_H = WS_B;
constexpr size_t WS_ONSA = WS_B;
constexpr size_t WS_ODP = WS_B + 32 * MiB;
constexpr size_t WS_LSE = WS_B + 80 * MiB;
constexpr size_t WS_ODIL = WS_B + 82 * MiB;
constexpr size_t WS_GN = WS_B + 98 * MiB;
constexpr size_t WS_KC = WS_B + 102 * MiB;
constexpr size_t WS_HID = WS_B + 103 * MiB;
constexpr size_t WS_END = WS_B + 107 * MiB;

constexpr int CW_TMO = 0, CW_BAR = 4096;

constexpr int LDS_MISC = 158208;
constexpr int LDS_BYTES = 158208 + 2048;

__device__ __forceinline__ unsigned cvt_pk_bf16(float lo, float hi) { f32x2 v = {lo, hi}; bf16x2_t b = __builtin_convertvector(v, bf16x2_t); return __builtin_bit_cast(unsigned, b); }
__device__ __forceinline__ float bf_lo(unsigned w) { return __uint_as_float(w << 16); }
__device__ __forceinline__ float bf_hi(unsigned w) { return __uint_as_float(w & 0xffff0000u); }
__device__ __forceinline__ float sigmoidf_(float x) { return __builtin_amdgcn_rcpf(1.0f + __builtin_amdgcn_exp2f(-x * LOG2E)); }
__device__ __forceinline__ int lane_id_fresh() { unsigned ones = ~0u; asm volatile("" : "+s"(ones)); return (int)__builtin_amdgcn_mbcnt_hi(ones, __builtin_amdgcn_mbcnt_lo(ones, 0u)); }
template <int X> __device__ __forceinline__ float swz_xor_f(float v) { return __int_as_float(__builtin_amdgcn_ds_swizzle(__float_as_int(v), (X << 10) | 0x1f)); }
template <int X> __device__ __forceinline__ unsigned swz_xor_u(unsigned v) { return (unsigned)__builtin_amdgcn_ds_swizzle((int)v, (X << 10) | 0x1f); }
__device__ __forceinline__ float wave_sum(float v) {
    v += swz_xor_f<1>(v); v += swz_xor_f<2>(v); v += swz_xor_f<4>(v); v += swz_xor_f<8>(v); v += swz_xor_f<16>(v);
    auto rr = __builtin_amdgcn_permlane32_swap(__float_as_uint(v), __float_as_uint(v), false, false);
    return __uint_as_float(rr[0]) + __uint_as_float(rr[1]);
}
__device__ __forceinline__ int bperm_i(int srclane, int v) { return __builtin_amdgcn_ds_bpermute(srclane << 2, v); }
#define LDS_WAIT() asm volatile("s_waitcnt lgkmcnt(0)" ::: "memory")
#define VM_WAIT() asm volatile("s_waitcnt vmcnt(0)" ::: "memory")

#define XB_TMO      128
#define XB_XCNT(j)  (256  + 64 * (j))
#define XB_XSUB(j)  (1280 + 64 * (j))
#define XB_XGEN(j)  (2304 + 64 * (j))
#define XB_TOP      3328
#define XB_TOPGEN   3392
#define XCD_BAR_WORDS 3456
#define XB_SPIN_CAP (1u << 20)
__device__ __forceinline__ unsigned xb_ld(unsigned* p)              { return __hip_atomic_load(p, __ATOMIC_RELAXED, __HIP_MEMORY_SCOPE_AGENT); }
__device__ __forceinline__ unsigned xb_add(unsigned* p, unsigned v) { return __hip_atomic_fetch_add(p, v, __ATOMIC_RELAXED, __HIP_MEMORY_SCOPE_AGENT); }
__device__ __forceinline__ unsigned xb_xcc_id() { return (unsigned)__builtin_amdgcn_s_getreg((3 << 11) | 20) & 0xFu; }
#define XB_SPIN(cond, bar) do { unsigned _sp = 0; while (cond) { __builtin_amdgcn_s_sleep(1); \
    if ((++_sp & 255u) == 0u) { if (xb_ld(&(bar)[XB_TMO])) break; if (_sp > XB_SPIN_CAP) { atomicAdd(&(bar)[XB_TMO], 1u); break; } } } } while (0)
struct XcdBarrier { unsigned* bar; unsigned x; volatile LAS unsigned* st; };
__device__ __forceinline__ XcdBarrier xcd_barrier_post(unsigned* bar, volatile LAS unsigned* st) {
    XcdBarrier b; b.bar = bar; b.x = xb_xcc_id(); b.st = st;
    if (threadIdx.x == 0) (void)xb_add(&bar[XB_XCNT(b.x)], 1u);
    return b;
}
__device__ __forceinline__ void xcd_barrier_complete(unsigned* bar, unsigned x, unsigned& nloc, unsigned& nx) {
    const unsigned G = gridDim.x * gridDim.y * gridDim.z;
    unsigned sum, cnt, mine, sp = 0u;
    for (;;) {
        sum = 0u; cnt = 0u; mine = 0u;
#pragma unroll
        for (unsigned j = 0; j < 16; ++j) { const unsigned c = xb_ld(&bar[XB_XCNT(j)]); sum += c; cnt += (c > 0u) ? 1u : 0u; mine = (j == x) ? c : mine; }
        if (sum == G) break;
        __builtin_amdgcn_s_sleep(1);
        if ((++sp & 255u) == 0u) { if (xb_ld(&bar[XB_TMO])) break; if (sp > XB_SPIN_CAP) { atomicAdd(&bar[XB_TMO], 1u); break; } }
    }
    nloc = mine > 0u ? mine : 1u; nx = cnt > 0u ? cnt : 1u;
}
__device__ __forceinline__ void xcd_barrier(const XcdBarrier& b, const bool leader_thread) {
    asm volatile("s_waitcnt vmcnt(0)" ::: "memory");
    __syncthreads();
    if (leader_thread) {
        unsigned* bar = b.bar;
        __builtin_amdgcn_s_waitcnt(0);
        unsigned nloc = b.st[0], nx = b.st[1];
        if (nloc == 0u) { xcd_barrier_complete(bar, b.x, nloc, nx); b.st[0] = nloc; b.st[1] = nx; }
        const unsigned old = xb_add(&bar[XB_XSUB(b.x)], 1u);
        const unsigned gen = old / nloc;
        if (old + 1u == (gen + 1u) * nloc) {
            __builtin_amdgcn_fence(__ATOMIC_RELEASE, "agent");
            asm volatile("s_waitcnt vmcnt(0)" ::: "memory");
            const unsigned og = xb_add(&bar[XB_TOP], 1u);
            const unsigned tg = og / nx;
            if (og + 1u == (tg + 1u) * nx) xb_add(&bar[XB_TOPGEN], 1u);
            else XB_SPIN(xb_ld(&bar[XB_TOPGEN]) == tg, bar);
            __builtin_amdgcn_fence(__ATOMIC_ACQUIRE, "agent");
            xb_add(&bar[XB_XGEN(b.x)], 1u);
            asm volatile("s_waitcnt vmcnt(0)" ::: "memory");
        } else {
            XB_SPIN(xb_ld(&bar[XB_XGEN(b.x)]) == gen, bar);
            __builtin_amdgcn_fence(__ATOMIC_ACQUIRE, "agent");
            asm volatile("s_waitcnt vmcnt(0)" ::: "memory");
        }
    }
    __syncthreads();
}

namespace pg8 {
constexpr int BM = 256, BK = 64, HALF = 128, HTB = HALF * BK * 2, STAGE_BYTES = 8 * HTB;
__device__ __forceinline__ int lds_byte(int r, int c) { const int st = (r >> 4) * 2 + (c >> 5), rr = r & 15, cc = c & 31, ob = rr * 64 + cc * 2; return st * 1024 + (ob ^ (((ob >> 9) & 1) << 5)); }
__device__ __forceinline__ void stage_rc(int b, int& R, int& C) { const int st = b / 1024, sb = b % 1024, swz = sb ^ (((sb >> 9) & 1) << 5); R = (st >> 1) * 16 + swz / 64; C = (st & 1) * 32 + (swz % 64) / 2; }
__device__ __forceinline__ int perm32(int rho) { const int n = rho >> 4, i = rho & 15; return 8 * (i >> 2) + 4 * n + (i & 3); }

struct Unit { const char* A; const char* B; int pm, pn; };
struct Gemm { unsigned lda, ldb, kstepA; int K; };

template <class Epi, class Sched, bool ALIGN_EPI>
__device__ __forceinline__ void gemm_phase(LAS unsigned char* lds, const int tid, const Gemm g, const Sched& S, const Epi& E) {
    const int wid = __builtin_amdgcn_readfirstlane(tid >> 6), lane = tid & 63, wr = wid >> 2, wc = wid & 3, fr = lane & 15, fq = lane >> 4;
    const int nt = g.K / BK;
    unsigned voffA[2], voffB[2];
#pragma unroll
    for (int i = 0; i < 2; ++i) { int R, C; stage_rc(tid * 16 + i * 8192, R, C); const int Rb = Epi::PERM ? ((R & ~31) + perm32(R & 31)) : R;
        voffA[i] = (unsigned)R * g.lda + (unsigned)C * 2u; voffB[i] = (unsigned)Rb * g.ldb + (unsigned)C * 2u; }
    const size_t kstepA = (size_t)g.kstepA, kstepB = (size_t)(BK * 2);
    const size_t hstepA = (size_t)HALF * g.lda, hstepB = (size_t)HALF * g.ldb;
    const unsigned ldsw = (unsigned)wid * 1024u;
    const int aoff = lds_byte(wr * 64 + fr, fq * 8), boff = lds_byte(wc * 32 + fr, fq * 8);
#define PG8_SA(b, h) (((b) * 2 + (h)) * HTB)
#define PG8_SB(b, h) ((4 + (b) * 2 + (h)) * HTB)
#define PG8_STAGE(bufoff, gbase, voff) do { _Pragma("unroll") for (int _i = 0; _i < 2; ++_i) \
        __builtin_amdgcn_global_load_lds((const unsigned*)((const char*)(gbase) + (voff)[_i]), (LAS unsigned*)(lds + (bufoff) + ldsw + _i * 8192), 16, 0, 0); } while (0)
#define PG8_LDA(dst, b, h) do { _Pragma("unroll") for (int m = 0; m < 4; ++m) _Pragma("unroll") for (int k = 0; k < 2; ++k) dst[m][k] = *(const LAS bf16x8*)(lds + PG8_SA(b, h) + aoff + m * 2048 + k * 1024); } while (0)
#define PG8_LDB(dst, b, h) do { _Pragma("unroll") for (int n = 0; n < 2; ++n) _Pragma("unroll") for (int k = 0; k < 2; ++k) dst[n][k] = *(const LAS bf16x8*)(lds + PG8_SB(b, h) + boff + n * 2048 + k * 1024); } while (0)
#define PG8_MMA(ai, bj, At, Bt) do { __builtin_amdgcn_s_setprio(1); _Pragma("unroll") for (int m = 0; m < 4; ++m) _Pragma("unroll") for (int n = 0; n < 2; ++n) _Pragma("unroll") for (int k = 0; k < 2; ++k) \
        acc[ai][bj][m][n] = __builtin_amdgcn_mfma_f32_16x16x32_bf16(Bt[n][k], At[m][k], acc[ai][bj][m][n], 0, 0, 0); __builtin_amdgcn_s_setprio(0); } while (0)
#define PG8_WAIT_V(n) asm volatile("s_waitcnt vmcnt(" #n ")" ::: "memory")
#define PG8_WAIT_L(n) asm volatile("s_waitcnt lgkmcnt(" #n ")" ::: "memory")
#define PG8_BAR __builtin_amdgcn_s_barrier()
#define PG8_SCHED __builtin_amdgcn_sched_barrier(0)
    Unit cur, nxt; int ui = 0;
    if (!S.next(0, cur)) return;
    f32x4 acc[2][2][4][2];
#pragma unroll
    for (int a = 0; a < 2; ++a)
#pragma unroll
        for (int b = 0; b < 2; ++b)
#pragma unroll
            for (int m = 0; m < 4; ++m)
#pragma unroll
                for (int n = 0; n < 2; ++n) acc[a][b][m][n] = (f32x4){0.f, 0.f, 0.f, 0.f};
    bf16x8 At[4][2], B0[2][2], B1[2][2];
    const char* cA = cur.A; const char* cB = cur.B;
    PG8_STAGE(PG8_SB(0, 0), cB, voffB); PG8_STAGE(PG8_SB(0, 1), cB + hstepB, voffB); PG8_STAGE(PG8_SA(0, 0), cA, voffA); PG8_STAGE(PG8_SA(0, 1), cA + hstepA, voffA);
    if (wr == 1) PG8_BAR;
    PG8_WAIT_V(2); PG8_BAR;
    PG8_STAGE(PG8_SB(1, 0), cB + kstepB, voffB); PG8_STAGE(PG8_SA(1, 0), cA + kstepA, voffA); PG8_STAGE(PG8_SB(1, 1), cB + hstepB + kstepB, voffB);
    PG8_WAIT_V(6); PG8_BAR;
    for (;;) {
        const bool has_next = S.next(ui + 1, nxt);
        const char* nA = has_next ? nxt.A : cA; const char* nB = has_next ? nxt.B : cB;
        for (int t = 0; t < nt; t += 2) {
            const bool last = (t == nt - 2);
            const char* a1 = cA + (size_t)(t + 1) * kstepA;
            const char* a2 = last ? nA : cA + (size_t)(t + 2) * kstepA; const char* b2 = last ? nB : cB + (size_t)(t + 2) * kstepB;
            const char* a3 = a2 + kstepA; const char* b3 = b2 + kstepB;
            PG8_LDB(B0, 0, 0); PG8_LDB(B1, 0, 1); PG8_SCHED; PG8_LDA(At, 0, 0); PG8_STAGE(PG8_SA(1, 1), a1 + hstepA, voffA);
            PG8_WAIT_V(8); PG8_WAIT_L(0); PG8_BAR; PG8_MMA(0, 0, At, B0); PG8_MMA(0, 1, At, B1); PG8_BAR; PG8_SCHED;
            PG8_LDA(At, 0, 1); PG8_STAGE(PG8_SB(0, 0), b2, voffB); PG8_STAGE(PG8_SB(0, 1), b2 + hstepB, voffB); PG8_STAGE(PG8_SA(0, 0), a2, voffA);
            PG8_WAIT_V(8); PG8_WAIT_L(0); PG8_BAR; PG8_MMA(1, 0, At, B0); PG8_MMA(1, 1, At, B1); PG8_BAR; PG8_SCHED;
            PG8_LDB(B0, 1, 0); PG8_LDB(B1, 1, 1); PG8_SCHED; PG8_LDA(At, 1, 0); PG8_STAGE(PG8_SA(0, 1), a2 + hstepA, voffA);
            PG8_WAIT_V(8); PG8_WAIT_L(0); PG8_BAR; PG8_MMA(0, 0, At, B0); PG8_MMA(0, 1, At, B1); PG8_BAR; PG8_SCHED;
            PG8_LDA(At, 1, 1); PG8_STAGE(PG8_SB(1, 0), b3, voffB); PG8_STAGE(PG8_SB(1, 1), b3 + hstepB, voffB); PG8_STAGE(PG8_SA(1, 0), a3, voffA);
            PG8_WAIT_V(8); PG8_WAIT_L(0); PG8_BAR; PG8_MMA(1, 0, At, B0); PG8_MMA(1, 1, At, B1); PG8_BAR; PG8_SCHED;
        }
        if constexpr (ALIGN_EPI) { if (wr == 0) PG8_BAR; }
        if constexpr (!Epi::AFTER_DRAIN) { E(acc, cur, wr, wc, fr, fq); }
        if (!has_next) break;
#pragma unroll
        for (int a = 0; a < 2; ++a)
#pragma unroll
            for (int b = 0; b < 2; ++b)
#pragma unroll
                for (int m = 0; m < 4; ++m)
#pragma unroll
                    for (int n = 0; n < 2; ++n) acc[a][b][m][n] = (f32x4){0.f, 0.f, 0.f, 0.f};
        cur = nxt; cA = nA; cB = nB; ++ui;
        if constexpr (ALIGN_EPI) { if (wr == 1) PG8_BAR; }
    }
    PG8_WAIT_V(0);
    if constexpr (!ALIGN_EPI) { if (wr == 0) PG8_BAR; }
    PG8_BAR;
    if constexpr (Epi::AFTER_DRAIN) { E.fused(acc, cur, wr, wc, fr, fq, wid, lane); }
#undef PG8_SA
#undef PG8_SB
#undef PG8_STAGE
#undef PG8_LDA
#undef PG8_LDB
#undef PG8_MMA
#undef PG8_WAIT_V
#undef PG8_WAIT_L
#undef PG8_BAR
#undef PG8_SCHED
}

struct DenseOrder {
    int nM, nN, nwg, G, c; const char* A; const char* B; size_t tA, tB;
    __device__ __forceinline__ void init(int M, int N, int G_, int c_, const void* A_, unsigned lda, const void* B_, unsigned ldb) {
        nM = M / BM; nN = N / BM; nwg = nM * nN; G = G_; c = c_; A = (const char*)A_; B = (const char*)B_; tA = (size_t)BM * lda; tB = (size_t)BM * ldb; }
    __device__ __forceinline__ bool next(int i, Unit& u) const {
        const long L = (long)i * G + c; if (L >= nwg) return false;
        int wgid = (int)L; { const int q = nwg / 8, r = nwg % 8, xcd = wgid % 8, off = wgid / 8; wgid = (xcd < r ? xcd * (q + 1) : r * (q + 1) + (xcd - r) * q) + off; }
        const int nig = 8 * nN, gid = wgid / nig, fm = gid * 8, gsz = (nM - fm) < 8 ? (nM - fm) : 8;
        u.pm = fm + ((wgid % nig) % gsz); u.pn = (wgid % nig) / gsz;
        u.A = A + (size_t)u.pm * tA; u.B = B + (size_t)u.pn * tB; return true;
    }
};
}

struct Args {
    const float* x; const float* c; const float* rel_bias; const float* ada_w; const float* ada_b; const float* norm1; const float* norm2; const float* w_in;
    const float* cmp_pos; const float* cmp_w1; const float* cmp_w2; const float* w_up_nsa; const float* w_up_dil; const float* w_o;
    const float* router_wg; const float* router_bg; const float* router_we; const float* router_be; const float* exp_w1; const float* exp_w3; const float* exp_w2; const float* norm_f;
    float* out; unsigned char* ws; int ph_lo, ph_hi, use_bar, pad;
};

typedef f32x4 AccT[2][2][4][2];
struct EpiInProj {
    static constexpr bool PERM = true, AFTER_DRAIN = false;
    bf16_t* QKV; bf16_t* MG; float* GN;
    __device__ __forceinline__ void operator()(const AccT& acc, const pg8::Unit& u, int wr, int wc, int fr, int fq) const {
        const int pn = u.pn; const int row0 = u.pm * 256 + wr * 64 + fr;
        if (pn < 14) {
            const float sc = (pn < 2 || (pn >= 5 && pn < 8)) ? C2 : 1.0f;
            const int col0 = pn * 256 + wc * 32 + 8 * fq;
#pragma unroll
            for (int ai = 0; ai < 2; ++ai)
#pragma unroll
                for (int m = 0; m < 4; ++m) { bf16_t* rowp = QKV + (size_t)(row0 + ai * 128 + m * 16) * LDQ + col0;
#pragma unroll
                    for (int bj = 0; bj < 2; ++bj) { const f32x4 v0 = acc[ai][bj][m][0] * sc, v1 = acc[ai][bj][m][1] * sc; u32x4 w;
                        w.x = cvt_pk_bf16(v0[0], v0[1]); w.y = cvt_pk_bf16(v0[2], v0[3]); w.z = cvt_pk_bf16(v1[0], v1[1]); w.w = cvt_pk_bf16(v1[2], v1[3]);
                        *(u32x4*)(rowp + bj * 128) = w; } }
        } else if (pn < 22) {
            const int col0 = (pn - 14) * 256 + wc * 32 + 8 * fq;
#pragma unroll
            for (int ai = 0; ai < 2; ++ai)
#pragma unroll
                for (int m = 0; m < 4; ++m) { bf16_t* rowp = MG + (size_t)(row0 + ai * 128 + m * 16) * 2048 + col0;
#pragma unroll
                    for (int bj = 0; bj < 2; ++bj) { const f32x4 v0 = acc[ai][bj][m][0], v1 = acc[ai][bj][m][1]; u32x4 w;
                        w.x = cvt_pk_bf16(sigmoidf_(v0[0]), sigmoidf_(v0[1])); w.y = cvt_pk_bf16(sigmoidf_(v0[2]), sigmoidf_(v0[3]));
                        w.z = cvt_pk_bf16(sigmoidf_(v1[0]), sigmoidf_(v1[1])); w.w = cvt_pk_bf16(sigmoidf_(v1[2]), sigmoidf_(v1[3]));
                        *(u32x4*)(rowp + bj * 128) = w; } }
        } else {
            if (wc == 0 && fq < 3) {
#pragma unroll
                for (int ai = 0; ai < 2; ++ai)
#pragma unroll
                    for (int m = 0; m < 4; ++m) { float* rowp = GN + (size_t)(row0 + ai * 128 + m * 16) * 32 + 8 * fq;
                        const f32x4 v0 = acc[ai][0][m][0], v1 = acc[ai][0][m][1];
                        *(f32x4*)(rowp) = (f32x4){sigmoidf_(v0[0]), sigmoidf_(v0[1]), sigmoidf_(v0[2]), sigmoidf_(v0[3])};
                        *(f32x4*)(rowp + 4) = (f32x4){sigmoidf_(v1[0]), sigmoidf_(v1[1]), sigmoidf_(v1[2]), sigmoidf_(v1[3])}; }
            }
        }
    }
};
template <int PASS> struct EpiUp {
    static constexpr bool PERM = true, AFTER_DRAIN = false;
    bf16_t* MERGED; const bf16_t* MG;
    __device__ __forceinline__ void operator()(const AccT& acc, const pg8::Unit& u, int wr, int wc, int fr, int fq) const {
        const int row0 = u.pm * 256 + wr * 64 + fr; const int col0 = u.pn * 256 + wc * 32 + 8 * fq;
#pragma unroll
        for (int ai = 0; ai < 2; ++ai)
#pragma unroll
            for (int m = 0; m < 4; ++m) { const size_t row = (size_t)(row0 + ai * 128 + m * 16);
#pragma unroll
                for (int bj = 0; bj < 2; ++bj) {
                    const u32x4 gw = *(const u32x4*)(MG + row * 2048 + PASS * 1024 + col0 + bj * 128);
                    bf16_t* op = MERGED + row * 1024 + col0 + bj * 128;
                    const f32x4 v0 = acc[ai][bj][m][0], v1 = acc[ai][bj][m][1];
                    float r[8] = {v0[0] * bf_lo(gw.x), v0[1] * bf_hi(gw.x), v0[2] * bf_lo(gw.y), v0[3] * bf_hi(gw.y), v1[0] * bf_lo(gw.z), v1[1] * bf_hi(gw.z), v1[2] * bf_lo(gw.w), v1[3] * bf_hi(gw.w)};
                    if (PASS == 1) { const u32x4 ow = *(const u32x4*)op;
                        r[0] += bf_lo(ow.x); r[1] += bf_hi(ow.x); r[2] += bf_lo(ow.y); r[3] += bf_hi(ow.y); r[4] += bf_lo(ow.z); r[5] += bf_hi(ow.z); r[6] += bf_lo(ow.w); r[7] += bf_hi(ow.w); }
                    u32x4 w; w.x = cvt_pk_bf16(r[0], r[1]); w.y = cvt_pk_bf16(r[2], r[3]); w.z = cvt_pk_bf16(r[4], r[5]); w.w = cvt_pk_bf16(r[6], r[7]);
                    *(u32x4*)op = w; }
                asm volatile("" ::: "memory"); }
    }
};
struct EpiOut {
    static constexpr bool PERM = true, AFTER_DRAIN = false;
    const float* xin; float* xout; const float* g1;
    __device__ __forceinline__ void operator()(const AccT& acc, const pg8::Unit& u, int wr, int wc, int fr, int fq) const {
        const int row0 = u.pm * 256 + wr * 64 + fr; const int col0 = u.pn * 256 + wc * 32 + 8 * fq; const int b = u.pm >> 4;
        f32x4 gv[2][2];
#pragma unroll
        for (int bj = 0; bj < 2; ++bj)
#pragma unroll
            for (int n = 0; n < 2; ++n) gv[bj][n] = *(const f32x4*)(g1 + (size_t)b * 6144 + col0 + bj * 128 + 4 * n);
#pragma unroll
        for (int ai = 0; ai < 2; ++ai)
#pragma unroll
            for (int m = 0; m < 4; ++m) { const size_t off = (size_t)(row0 + ai * 128 + m * 16) * 1024 + col0;
#pragma unroll
                for (int bj = 0; bj < 2; ++bj)
#pragma unroll
                    for (int n = 0; n < 2; ++n) { const f32x4 xv = *(const f32x4*)(xin + off + bj * 128 + 4 * n);
                        *(f32x4*)(xout + off + bj * 128 + 4 * n) = (ABL == 7) ? xv : xv + gv[bj][n] * acc[ai][bj][m][n]; }
                asm volatile("" ::: "memory"); }
    }
};
struct EpiMoe1 {
    static constexpr bool PERM = true, AFTER_DRAIN = false;
    bf16_t* ACT;
    __device__ __forceinline__ void operator()(const AccT& acc, const pg8::Unit& u, int wr, int wc, int fr, int fq) const {
        const int row0 = u.pm * 256 + wr * 64 + fr; const int col0 = u.pn * 128 + wc * 32 + 8 * fq;
#pragma unroll
        for (int ai = 0; ai < 2; ++ai)
#pragma unroll
            for (int m = 0; m < 4; ++m) { bf16_t* op = ACT + (size_t)(row0 + ai * 128 + m * 16) * 512 + col0; float r[8];
#pragma unroll
                for (int n = 0; n < 2; ++n)
#pragma unroll
                    for (int j = 0; j < 4; ++j) { const float a = acc[ai][0][m][n][j], bb = acc[ai][1][m][n][j]; r[n * 4 + j] = a * sigmoidf_(a) * bb; }
                u32x4 w; w.x = cvt_pk_bf16(r[0], r[1]); w.y = cvt_pk_bf16(r[2], r[3]); w.z = cvt_pk_bf16(r[4], r[5]); w.w = cvt_pk_bf16(r[6], r[7]);
                *(u32x4*)op = w; }
    }
};
struct EpiPlain {
    static constexpr bool PERM = true, AFTER_DRAIN = false;
    bf16_t* O; int ldc;
    __device__ __forceinline__ void operator()(const AccT& acc, const pg8::Unit& u, int wr, int wc, int fr, int fq) const {
        const int row0 = u.pm * 256 + wr * 64 + fr; const int col0 = u.pn * 256 + wc * 32 + 8 * fq;
#pragma unroll
        for (int ai = 0; ai < 2; ++ai)
#pragma unroll
            for (int m = 0; m < 4; ++m) { bf16_t* rowp = O + (size_t)(row0 + ai * 128 + m * 16) * ldc + col0;
#pragma unroll
                for (int bj = 0; bj < 2; ++bj) { const f32x4 v0 = acc[ai][bj][m][0], v1 = acc[ai][bj][m][1]; u32x4 w;
                    w.x = cvt_pk_bf16(v0[0], v0[1]); w.y = cvt_pk_bf16(v0[2], v0[3]); w.z = cvt_pk_bf16(v1[0], v1[1]); w.w = cvt_pk_bf16(v1[2], v1[3]);
                    *(u32x4*)(rowp + bj * 128) = w; } }
    }
};
__device__ __forceinline__ int crow(int r, int hi) { return (r & 3) + 8 * (r >> 2) + 4 * hi; }
__device__ __forceinline__ float gelu_tanh(float x) { const float u2 = 2.0f * 0.7978845608028654f * (x + 0.044715f * x * x * x); return x * __builtin_amdgcn_rcpf(1.0f + __builtin_amdgcn_exp2f(-u2 * LOG2E)); }
struct EpiCmp {
    static constexpr bool PERM = true, AFTER_DRAIN = true;
    bf16_t* HID; const float* CB1; const bf16_t* CW2T; bf16_t* KC;
    __device__ __forceinline__ void fused(const AccT& acc, const pg8::Unit& u, int wr, int wc, int fr, int fq, int wid, int lane) const {
        const int kv = u.pm >> 4; const int row0 = u.pm * 256 + wr * 64 + fr; const int col0 = wc * 32 + 8 * fq;
        const float* bias = CB1 + kv * 256;
        f32x4 bv[2][2];
#pragma unroll
        for (int bj = 0; bj < 2; ++bj)
#pragma unroll
            for (int n = 0; n < 2; ++n) bv[bj][n] = *(const f32x4*)(bias + col0 + bj * 128 + 4 * n);
#pragma unroll
        for (int ai = 0; ai < 2; ++ai)
#pragma unroll
            for (int m = 0; m < 4; ++m) { bf16_t* rowp = HID + (size_t)(row0 + ai * 128 + m * 16) * 256 + col0;
#pragma unroll
                for (int bj = 0; bj < 2; ++bj) { const f32x4 v0 = acc[ai][bj][m][0] + bv[bj][0], v1 = acc[ai][bj][m][1] + bv[bj][1]; u32x4 w;
                    w.x = cvt_pk_bf16(gelu_tanh(v0[0]), gelu_tanh(v0[1])); w.y = cvt_pk_bf16(gelu_tanh(v0[2]), gelu_tanh(v0[3]));
                    w.z = cvt_pk_bf16(gelu_tanh(v1[0]), gelu_tanh(v1[1])); w.w = cvt_pk_bf16(gelu_tanh(v1[2]), gelu_tanh(v1[3]));
                    *(u32x4*)(rowp + bj * 128) = w; } }
        VM_WAIT(); __syncthreads();
        const int r32 = lane & 31, hi = lane >> 5;
        const bf16_t* ap = HID + (size_t)(u.pm * 256 + 32 * wid + r32) * 256 + hi * 8;
        const bf16_t* bp = CW2T + (size_t)kv * 64 * 256 + (size_t)r32 * 256 + hi * 8;
        f32x16 o0 = {}, o1 = {};
#pragma unroll 4
        for (int ks = 0; ks < 16; ++ks) {
            const bf16x8 a = *(const bf16x8*)(ap + ks * 16);
            const bf16x8 b0 = *(const bf16x8*)(bp + ks * 16), b1 = *(const bf16x8*)(bp + 32 * 256 + ks * 16);
            o0 = __builtin_amdgcn_mfma_f32_32x32x16_bf16(a, b0, o0, 0, 0, 0);
            o1 = __builtin_amdgcn_mfma_f32_32x32x16_bf16(a, b1, o1, 0, 0, 0);
        }
        bf16_t* kc = KC + (size_t)u.pm * 256 * 64;
#pragma unroll
        for (int r = 0; r < 16; ++r) { const int c = 32 * wid + crow(r, hi); const bool pad = (c == 255);
            kc[(size_t)c * 64 + r32] = pad ? (bf16_t)0 : (bf16_t)(cvt_pk_bf16(o0[r], 0.f) & 0xffffu);
            kc[(size_t)c * 64 + 32 + r32] = pad ? (bf16_t)0 : (bf16_t)(cvt_pk_bf16(o1[r], 0.f) & 0xffffu); }
    }
};

namespace att {
constexpr int L_KR = 0;
constexpr int L_VR = 24576;
constexpr int L_WSF = 49152;
constexpr int L_BKT = 51200;
constexpr int L_TBH = 55296;
constexpr int L_GSH = 55808;
constexpr int L_SEL = 58880;
constexpr int L_OTA = 59904;
constexpr int L_X = 92672;
constexpr int L_END = L_X + 65536;
static_assert(L_END <= LDS_MISC, "attention LDS map");

__device__ __forceinline__ void glds16(const void* gsrc, unsigned lds_dst) { unsigned keep;
    asm volatile("s_mov_b32 %0, m0\n\ts_mov_b32 m0, %2\n\ts_nop 0\n\tglobal_load_lds_dwordx4 %1, off\n\ts_mov_b32 m0, %0" : "=&s"(keep) : "v"(gsrc), "s"(lds_dst) : "memory"); }
__device__ __forceinline__ int bucket_of(int d) {
    if (d < 16) return d;
    int b = 16;
    b += (d >= 22); b += (d >= 30); b += (d >= 40); b += (d >= 54); b += (d >= 73); b += (d >= 99); b += (d >= 134); b += (d >= 182);
    b += (d >= 246); b += (d >= 332); b += (d >= 450); b += (d >= 609); b += (d >= 825); b += (d >= 1117); b += (d >= 1513);
    return b;
}
__device__ __forceinline__ void qkt(f32x16& p0, f32x16& p1, const LAS unsigned char* Kslot, const bf16x8 (&qr)[4], int r32, int hi) {
    const LAS unsigned char* kb = Kslot + hi * 1024 + r32 * 16;
    p0 = (f32x16){}; p1 = (f32x16){};
#pragma unroll
    for (int d0 = 0; d0 < 4; ++d0) {
        const bf16x8 b0 = *(const LAS bf16x8*)(kb + d0 * 2048);
        const bf16x8 b1 = *(const LAS bf16x8*)(kb + d0 * 2048 + 512);
        p0 = __builtin_amdgcn_mfma_f32_32x32x16_bf16(b0, qr[d0], p0, 0, 0, 0);
        p1 = __builtin_amdgcn_mfma_f32_32x32x16_bf16(b1, qr[d0], p1, 0, 0, 0);
    }
}
__device__ __forceinline__ void pv(f32x16 (&o)[2], int vb, bf16x8 pa0, bf16x8 pa1, bf16x8 pa2, bf16x8 pa3) {
#pragma unroll
    for (int d0 = 0; d0 < 2; ++d0) { s16x4 lo[4], hi[4];
#pragma unroll
        for (int ks = 0; ks < 4; ++ks) {
            asm volatile("ds_read_b64_tr_b16 %0,%1 offset:%c2" : "=&v"(lo[ks]) : "v"(vb), "i"(d0 * 4096 + ks * 1024) : "memory");
            asm volatile("ds_read_b64_tr_b16 %0,%1 offset:%c2" : "=&v"(hi[ks]) : "v"(vb), "i"(d0 * 4096 + ks * 1024 + 512) : "memory"); }
        asm volatile("s_waitcnt lgkmcnt(0)" ::: "memory"); __builtin_amdgcn_sched_barrier(0);
#define PK(k) (bf16x8){lo[k][0], lo[k][1], lo[k][2], lo[k][3], hi[k][0], hi[k][1], hi[k][2], hi[k][3]}
        o[d0] = __builtin_amdgcn_mfma_f32_32x32x16_bf16(pa0, PK(0), o[d0], 0, 0, 0);
        o[d0] = __builtin_amdgcn_mfma_f32_32x32x16_bf16(pa1, PK(1), o[d0], 0, 0, 0);
        o[d0] = __builtin_amdgcn_mfma_f32_32x32x16_bf16(pa2, PK(2), o[d0], 0, 0, 0);
        o[d0] = __builtin_amdgcn_mfma_f32_32x32x16_bf16(pa3, PK(3), o[d0], 0, 0, 0);
#undef PK
    }
}
__device__ __forceinline__ float xhalf_max(float v) { auto rr = __builtin_amdgcn_permlane32_swap(__float_as_uint(v), __float_as_uint(v), false, false); return __builtin_fmaxf(__uint_as_float(rr[0]), __uint_as_float(rr[1])); }
__device__ __forceinline__ float xhalf_sum(float v) { auto rr = __builtin_amdgcn_permlane32_swap(__float_as_uint(v), __float_as_uint(v), false, false); return __uint_as_float(rr[0]) + __uint_as_float(rr[1]); }

template <int KMUL>
__device__ __forceinline__ void tile_scores(f32x16& p0, f32x16& p1, int base_hi, int maxd, int dsh, bool laneok, const LAS unsigned char* bkt, const LAS float* tb) {
#pragma unroll
    for (int r = 0; r < 16; ++r) {
        const int off = KMUL * ((r & 3) + 8 * (r >> 2));
        { const int dist = base_hi - off; const bool ok = laneok && ((unsigned)dist <= (unsigned)maxd); int di = (dist < 0 ? 0 : dist) << dsh; di = di > 4095 ? 4095 : di;
          const float bb = tb[bkt[di]]; p0[r] = ok ? p0[r] + bb : -INFINITY; }
        { const int dist = base_hi - off - KMUL * 32; const bool ok = laneok && ((unsigned)dist <= (unsigned)maxd); int di = (dist < 0 ? 0 : dist) << dsh; di = di > 4095 ? 4095 : di;
          const float bb = tb[bkt[di]]; p1[r] = ok ? p1[r] + bb : -INFINITY; }
    }
}
#define ATT_PACK(p0, p1, pw0, pw1, pw2, pw3) do { \
    pw0 = (u32x4){cvt_pk_bf16(p0[0], p0[1]), cvt_pk_bf16(p0[2], p0[3]), cvt_pk_bf16(p0[4], p0[5]), cvt_pk_bf16(p0[6], p0[7])}; \
    pw1 = (u32x4){cvt_pk_bf16(p0[8], p0[9]), cvt_pk_bf16(p0[10], p0[11]), cvt_pk_bf16(p0[12], p0[13]), cvt_pk_bf16(p0[14], p0[15])}; \
    pw2 = (u32x4){cvt_pk_bf16(p1[0], p1[1]), cvt_pk_bf16(p1[2], p1[3]), cvt_pk_bf16(p1[4], p1[5]), cvt_pk_bf16(p1[6], p1[7])}; \
    pw3 = (u32x4){cvt_pk_bf16(p1[8], p1[9]), cvt_pk_bf16(p1[10], p1[11]), cvt_pk_bf16(p1[12], p1[13]), cvt_pk_bf16(p1[14], p1[15])}; } while (0)

struct LoopP {
    const bf16_t* Kb; const bf16_t* Vb; long pitch;
    unsigned long long tmask;
    int uqp; int maxd; int dsh; unsigned long long lanesel;
    int wlo, whi;
    const LAS float* tb;
    LAS float* imp;
};
template <int KMUL, int MODE>
__device__ __forceinline__ void attn_loop(LAS unsigned char* lds, int wid, int lane, const bf16x8 (&qr)[4], const LoopP P, float& m, float& l, f32x16 (&o)[2]) {
    const int r32 = lane & 31, hi = lane >> 5;
    const unsigned lds0 = (unsigned)(uintptr_t)lds;
    unsigned tlo = __builtin_amdgcn_readfirstlane((unsigned)P.tmask), thi = __builtin_amdgcn_readfirstlane((unsigned)(P.tmask >> 32));
    unsigned long long tm = ((unsigned long long)thi << 32) | tlo;
    if (tm == 0ull) return;
    const LAS unsigned char* bkt = lds + L_BKT;
    LAS float* wsf = (LAS float*)(lds + L_WSF) + wid * 64;
    const bf16_t* ksrc = P.Kb + (long)lane * P.pitch + wid * 8;
    const bf16_t* vsrc = P.Vb + (long)(16 * (wid & 3) + (lane >> 2)) * P.pitch + (wid >> 2) * 32 + (lane & 3) * 8;
    const int vb0 = (int)lds0 + ((lane >> 4) & 1) * 32 + (lane & 3) * 8 + (4 * hi + ((lane & 15) >> 2)) * 64;
#define ATT_DMA(t, st) do { glds16(ksrc + (long)(t) * 64 * P.pitch, (unsigned)__builtin_amdgcn_readfirstlane(lds0 + L_KR + (st) * 16384 + wid * 1024)); \
                            glds16(vsrc + (long)(t) * 64 * P.pitch, (unsigned)__builtin_amdgcn_readfirstlane(lds0 + L_KR + (st) * 16384 + 8192 + wid * 1024)); } while (0)
    int t = __builtin_ctzll(tm); tm &= tm - 1ull;
    int st = 0;
    ATT_DMA(t, 0);
    for (;;) {
        const bool hn = (tm != 0ull); int tn = 0;
        if (hn) { tn = __builtin_ctzll(tm); tm &= tm - 1ull; ATT_DMA(tn, st ^ 1); asm volatile("s_waitcnt vmcnt(2)\n\ts_barrier" ::: "memory"); }
        else { asm volatile("s_waitcnt vmcnt(0)\n\ts_barrier" ::: "memory"); }
        if (t >= P.wlo && t <= P.whi) {
            f32x16 p0, p1;
            qkt(p0, p1, lds + L_KR + st * 16384, qr, r32, hi);
            const bool laneok = ((P.lanesel >> t) & 1ull) != 0ull;
            tile_scores<KMUL>(p0, p1, P.uqp - KMUL * (64 * t + 4 * hi), P.maxd, P.dsh, laneok, bkt, P.tb);
            if (MODE == 2) {
#pragma unroll
                for (int r = 0; r < 16; ++r) { p0[r] = __builtin_amdgcn_exp2f(p0[r] - m) * l; p1[r] = __builtin_amdgcn_exp2f(p1[r] - m) * l; }
#pragma unroll
                for (int k = 0; k < 4; ++k) { const int n0 = 16 * t + 2 * k + hi;
                    P.imp[n0] += 2.0f * (p0[4 * k] + p0[4 * k + 1] + p0[4 * k + 2]) + p0[4 * k + 3];
                    P.imp[n0 + 8] += 2.0f * (p1[4 * k] + p1[4 * k + 1] + p1[4 * k + 2]) + p1[4 * k + 3]; }
#pragma unroll
                for (int k = 0; k < 4; ++k) { const int n0 = 16 * t + 2 * k + hi;
                    P.imp[n0 + 1] += p0[4 * k + 3];
                    if (n0 + 9 < 64) P.imp[n0 + 9] += p1[4 * k + 3]; }
            } else {
                float rm = p0[0];
#pragma unroll
                for (int r = 1; r < 16; ++r) rm = __builtin_fmaxf(rm, p0[r]);
#pragma unroll
                for (int r = 0; r < 16; ++r) rm = __builtin_fmaxf(rm, p1[r]);
                rm = xhalf_max(rm);
                const float mnew = __builtin_fmaxf(m, rm);
                const float msafe = (mnew == -INFINITY) ? 0.0f : mnew;
                const float alpha = __builtin_amdgcn_exp2f(m - msafe);
                float ps = 0.f;
#pragma unroll
                for (int r = 0; r < 16; ++r) { p0[r] = __builtin_amdgcn_exp2f(p0[r] - msafe); p1[r] = __builtin_amdgcn_exp2f(p1[r] - msafe); ps += p0[r] + p1[r]; }
                l = l * alpha + ps; m = mnew;
                if (MODE == 0) {
                    if (__any(alpha != 1.0f)) {
                        if (hi == 0) wsf[r32] = alpha;
                        LDS_WAIT();
#pragma unroll
                        for (int r = 0; r < 16; ++r) { const float f = wsf[crow(r, hi)]; o[0][r] *= f; o[1][r] *= f; }
                    }
                }
            }
            if (MODE != 1) {
                u32x4 pw0, pw1, pw2, pw3; ATT_PACK(p0, p1, pw0, pw1, pw2, pw3);
                pv(o, vb0 + L_KR + st * 16384 + 8192, __builtin_bit_cast(bf16x8, pw0), __builtin_bit_cast(bf16x8, pw1), __builtin_bit_cast(bf16x8, pw2), __builtin_bit_cast(bf16x8, pw3));
            }
        }
        asm volatile("s_waitcnt lgkmcnt(0)\n\ts_barrier" ::: "memory");
        if (!hn) break;
        t = tn; st ^= 1;
    }
#undef ATT_DMA
}
__device__ __forceinline__ void stage_rows(LAS unsigned char* lds, int wid, int lane, const f32x16 (&ot)[2]) {
    const int r32 = lane & 31, hi = lane >> 5;
    LAS bf16_t* stg = (LAS bf16_t*)(lds + L_OTA) + wid * 2048;
#pragma unroll
    for (int r = 0; r < 16; ++r) { const int orow = crow(r, hi);
#pragma unroll
        for (int d0 = 0; d0 < 2; ++d0) stg[orow * 64 + d0 * 32 + r32] = (bf16_t)(cvt_pk_bf16(ot[d0][r], 0.f) & 0xffffu); }
    LDS_WAIT();
}
struct StreamP { const bf16_t* Kb; const bf16_t* Vb; long pitch; int NT; const LAS unsigned char* tl; unsigned long long lanesel; int uq; const LAS float* lut; int xtop; int dclamp; };
typedef const LAS unsigned char* lds_cptr;
typedef short v4i16_t __attribute__((ext_vector_type(4)));
__device__ __forceinline__ void kload8(bf16x8* kf, lds_cptr kp) {
    kf[0] = *(const LAS bf16x8*)(kp);        kf[1] = *(const LAS bf16x8*)(kp + 512);
    kf[2] = *(const LAS bf16x8*)(kp + 2048); kf[3] = *(const LAS bf16x8*)(kp + 2560);
    kf[4] = *(const LAS bf16x8*)(kp + 4096); kf[5] = *(const LAS bf16x8*)(kp + 4608);
    kf[6] = *(const LAS bf16x8*)(kp + 6144); kf[7] = *(const LAS bf16x8*)(kp + 6656);
}
__device__ __forceinline__ void kload2(bf16x8* kf, lds_cptr kp, int j) { kf[2 * j] = *(const LAS bf16x8*)(kp + j * 2048); kf[2 * j + 1] = *(const LAS bf16x8*)(kp + j * 2048 + 512); }
__device__ __forceinline__ s16x4 vtr(lds_cptr p) { return __builtin_bit_cast(s16x4, __builtin_amdgcn_ds_read_tr16_b64_v4i16((LAS v4i16_t*)p)); }
constexpr int SLOTB = 8192;
#define ST_WAIT_BAR(N) asm volatile("s_waitcnt vmcnt(" #N ") lgkmcnt(0)\n\ts_barrier" ::: "memory")
template <int THRL>
__device__ __forceinline__ void attn_stream(LAS unsigned char* lds, const int wid, const int lane, const bf16x8 (&qr)[4], const StreamP S, float& mhat_o, float& l_o, f32x16 (&o)[2]) {
    const int r32 = lane & 31, hi = lane >> 5;
    const unsigned lds0 = (unsigned)(uintptr_t)lds;
    LAS float* wsf = (LAS float*)(lds + L_WSF) + wid * 64;
    const int NT = S.NT;
    const bf16_t* ksrc = S.Kb + (long)lane * S.pitch + wid * 8;
    const bf16_t* vsrc = S.Vb + (long)(16 * (wid & 3) + (lane >> 2)) * S.pitch + (wid >> 2) * 32 + (lane & 3) * 8;
    const unsigned kdst = lds0 + L_KR + wid * 1024, vdst = lds0 + L_VR + wid * 1024;
#define TLRAW(k) ((int)__builtin_amdgcn_readfirstlane((int)S.tl[k]))
#define DMA_K(k, slot) do { const int tr_ = TLRAW(k) & 63; glds16(ksrc + (long)tr_ * 64 * S.pitch, (unsigned)__builtin_amdgcn_readfirstlane(kdst + (slot))); } while (0)
#define DMA_V(k, slot) do { const int tr_ = TLRAW(k) & 63; glds16(vsrc + (long)tr_ * 64 * S.pitch, (unsigned)__builtin_amdgcn_readfirstlane(vdst + (slot))); } while (0)
    const lds_cptr kp0 = (lds_cptr)lds + L_KR + hi * 1024 + r32 * 16;
    const lds_cptr vp0 = (lds_cptr)lds + L_VR + ((lane >> 4) & 1) * 32 + (lane & 3) * 8 + (4 * hi + ((lane & 15) >> 2)) * 64;
    const int vb0 = (int)(lds0 + L_VR) + ((lane >> 4) & 1) * 32 + (lane & 3) * 8 + (4 * hi + ((lane & 15) >> 2)) * 64;
    bf16x8 kf[8];
#define LUTLOAD(C0, C1, k) do { const int raw_ = TLRAW(k); const int tj_ = raw_ & 63; int d0_ = S.uq - 64 * tj_ - 4 * hi; d0_ = d0_ < S.dclamp ? d0_ : S.dclamp; \
        const bool ok_ = (raw_ < 128) && (((S.lanesel >> tj_) & 1ull) != 0ull); const LAS float* lp_ = S.lut + (ok_ ? S.xtop - d0_ : S.xtop + 64); \
        _Pragma("unroll") for (int r = 0; r < 16; ++r) { C0[r] = lp_[(r & 3) + 8 * (r >> 2)]; C1[r] = lp_[(r & 3) + 8 * (r >> 2) + 32]; } } while (0)
#define SBAR() __builtin_amdgcn_sched_barrier(0)
#define PIN(x) asm volatile("" : "+v"(x))
#define PKW(P, B) cvt_pk_bf16(P[B], P[B + 1])
#define PAF(k) __builtin_bit_cast(bf16x8, pw##k)
#define VFR(i) (bf16x8){vlo[i][0], vlo[i][1], vlo[i][2], vlo[i][3], vhi[i][0], vhi[i][1], vhi[i][2], vhi[i][3]}
#define MX3(a, b, c) __builtin_fmaxf(__builtin_fmaxf((a), (b)), (c))
#define MFMA32(a, b, c) __builtin_amdgcn_mfma_f32_32x32x16_bf16(a, b, c, 0, 0, 0)
#define GAPA(MF, A0, A1, A2, A3, W0, W1, PW) do { MF; sacc += A0; sacc += A1; sacc += A2; sacc += A3; PIN(sacc); W0; W1; PIN(PW); SBAR(); } while (0)
#define EX(v) __builtin_amdgcn_exp2f(v)
#define GAPB(MF, X, B) do { MF; X[B] = EX(X[B]); X[B + 1] = EX(X[B + 1]); X[B + 2] = EX(X[B + 2]); X[B + 3] = EX(X[B + 3]); PIN(X); SBAR(); } while (0)
#define VRD(i) do { vlo[i] = vtr(vp_ + (((i) >> 2) * 4096 + ((i) & 3) * 1024)); vhi[i] = vtr(vp_ + (((i) >> 2) * 4096 + ((i) & 3) * 1024 + 512)); } while (0)
#define KRD(G, j) do { if (G) { kload2(kf, kp0 + sl_next, j); SBAR(); } } while (0)
#define ROT() do { sl_prev = sl_cur; sl_cur = sl_next; sl_next = (sl_next == 2 * SLOTB) ? 0 : sl_next + SLOTB; } while (0)
#define RESC() do { if (resc) { LDS_WAIT(); _Pragma("unroll") for (int d_ = 0; d_ < 2; ++d_) _Pragma("unroll") for (int r = 0; r < 16; ++r) o[d_][r] *= wsf[crow(r, hi)]; } } while (0)
#define ENDW(tt) do { if ((tt) + 3 < NT) { ST_WAIT_BAR(2); } else if ((tt) + 2 < NT) { ST_WAIT_BAR(1); } else { ST_WAIT_BAR(0); } } while (0)
#define STEP(C0, C1, P0, P1, t, GK, GV, GL) do { SBAR(); \
    const lds_cptr vp_ = vp0 + sl_prev; \
    VRD(0); SBAR(); float sacc = (P0[0] + P0[1]); \
    GAPA(C0 = MFMA32(kf[0], qr[0], C0), P0[2], P0[3], P0[4], P0[5],     pw0[0] = PKW(P0, 0), pw0[1] = PKW(P0, 2), pw0); \
    VRD(4); SBAR(); GAPA(C1 = MFMA32(kf[1], qr[0], C1), P0[6], P0[7], P0[8], P0[9],     pw0[2] = PKW(P0, 4), pw0[3] = PKW(P0, 6), pw0); \
    VRD(1); SBAR(); GAPA(C0 = MFMA32(kf[2], qr[1], C0), P0[10], P0[11], P0[12], P0[13], pw1[0] = PKW(P0, 8), pw1[1] = PKW(P0, 10), pw1); \
    VRD(5); SBAR(); GAPA(C1 = MFMA32(kf[3], qr[1], C1), P0[14], P0[15], P1[0], P1[1],   pw1[2] = PKW(P0, 12), pw1[3] = PKW(P0, 14), pw1); \
    VRD(2); SBAR(); GAPA(C0 = MFMA32(kf[4], qr[2], C0), P1[2], P1[3], P1[4], P1[5],     pw2[0] = PKW(P1, 0), pw2[1] = PKW(P1, 2), pw2); \
    VRD(6); SBAR(); GAPA(C1 = MFMA32(kf[5], qr[2], C1), P1[6], P1[7], P1[8], P1[9],     pw2[2] = PKW(P1, 4), pw2[3] = PKW(P1, 6), pw2); \
    VRD(3); SBAR(); GAPA(C0 = MFMA32(kf[6], qr[3], C0), P1[10], P1[11], P1[12], P1[13], pw3[0] = PKW(P1, 8), pw3[1] = PKW(P1, 10), pw3); \
    VRD(7); SBAR(); GAPA(C1 = MFMA32(kf[7], qr[3], C1), P1[14], P1[15], 0.f, 0.f,       pw3[2] = PKW(P1, 12), pw3[3] = PKW(P1, 14), pw3); \
    l_reg += sacc; \
    if (GK) { DMA_K((t) + 3, sl_cur); } if (GV) { DMA_V((t) + 1, sl_next); } \
    { _Pragma("unroll") for (int r = 0; r < 16; ++r) { C0[r] -= mhat; C1[r] -= mhat; } \
      float a_ = MX3(C0[0], C0[1], C1[0]), b_ = MX3(C0[2], C0[3], C1[1]); a_ = MX3(a_, C1[2], C1[3]); \
      _Pragma("unroll") for (int r = 4; r < 16; r += 4) { a_ = MX3(a_, C0[r], C0[r + 1]); b_ = MX3(b_, C0[r + 2], C0[r + 3]); a_ = MX3(a_, C1[r], C1[r + 1]); b_ = MX3(b_, C1[r + 2], C1[r + 3]); } \
      float rm = xhalf_max(__builtin_fmaxf(a_, b_)); \
      resc = false; \
      if (__builtin_expect(__any(rm > (float)THRL), 0)) { const float dl = __builtin_fmaxf(rm, 0.f); mhat += dl; \
        _Pragma("unroll") for (int r = 0; r < 16; ++r) { C0[r] -= dl; C1[r] -= dl; } \
        const float f = __builtin_amdgcn_exp2f(-dl); l_reg *= f; if (hi == 0) wsf[r32] = f; resc = true; } } \
    SBAR(); \
    GAPB(o[0] = MFMA32(PAF(0), VFR(0), o[0]), C0, 0); \
    GAPB(o[1] = MFMA32(PAF(0), VFR(4), o[1]), C0, 4); \
    KRD(GL, 0); GAPB(o[0] = MFMA32(PAF(1), VFR(1), o[0]), C0, 8); \
    KRD(GL, 1); GAPB(o[1] = MFMA32(PAF(1), VFR(5), o[1]), C0, 12); \
    KRD(GL, 2); GAPB(o[0] = MFMA32(PAF(2), VFR(2), o[0]), C1, 0); \
    KRD(GL, 3); GAPB(o[1] = MFMA32(PAF(2), VFR(6), o[1]), C1, 4); \
    GAPB(o[0] = MFMA32(PAF(3), VFR(3), o[0]), C1, 8); \
    GAPB(o[1] = MFMA32(PAF(3), VFR(7), o[1]), C1, 12); \
    } while (0)
    float mhat = 0.f, l_reg = 0.f; bool resc = false;
    o[0] = (f32x16){}; o[1] = (f32x16){};
    f32x16 pA0, pA1, pB0, pB1;
    int sl_prev = 0, sl_cur = 0, sl_next = SLOTB;
    DMA_K(0, 0); DMA_V(0, 0); DMA_K(1, SLOTB); DMA_K(2, 2 * SLOTB);
    LUTLOAD(pA0, pA1, 0);
    ST_WAIT_BAR(3);
    { const lds_cptr kb = kp0;
#pragma unroll
      for (int d0 = 0; d0 < 4; ++d0) { const bf16x8 b0 = *(const LAS bf16x8*)(kb + d0 * 2048); const bf16x8 b1 = *(const LAS bf16x8*)(kb + d0 * 2048 + 512);
          pA0 = MFMA32(b0, qr[d0], pA0); pA1 = MFMA32(b1, qr[d0], pA1); }
      float rm = pA0[0];
#pragma unroll
      for (int r = 1; r < 16; ++r) rm = __builtin_fmaxf(rm, pA0[r]);
#pragma unroll
      for (int r = 0; r < 16; ++r) rm = __builtin_fmaxf(rm, pA1[r]);
      rm = xhalf_max(rm);
      mhat = (rm == -INFINITY) ? 0.f : rm;
#pragma unroll
      for (int r = 0; r < 16; ++r) { pA0[r] = EX(pA0[r] - mhat); pA1[r] = EX(pA1[r] - mhat); } }
    ST_WAIT_BAR(0);
    DMA_K(3, 0); DMA_V(1, SLOTB);
    ROT();
    kload8(kf, kp0 + sl_cur);
    LUTLOAD(pB0, pB1, 1);
    ST_WAIT_BAR(2);
    s16x4 vlo[8], vhi[8]; u32x4 pw0, pw1, pw2, pw3;
    int t = 1;
    for (; t + 1 < NT; t += 2) {
        STEP(pB0, pB1, pA0, pA1, t, (t + 3 < NT), (t + 1 < NT), (t + 1 < NT));       LUTLOAD(pA0, pA1, t + 1); ENDW(t);     RESC(); ROT();
        STEP(pA0, pA1, pB0, pB1, t + 1, (t + 4 < NT), (t + 2 < NT), (t + 2 < NT));   LUTLOAD(pB0, pB1, t + 2); ENDW(t + 1); RESC(); ROT();
    }
    STEP(pB0, pB1, pA0, pA1, NT - 1, false, false, false); RESC();
    { float sacc = pB0[0] + pB0[1];
#pragma unroll
      for (int r = 2; r < 16; ++r) sacc += pB0[r];
#pragma unroll
      for (int r = 0; r < 16; ++r) sacc += pB1[r];
      l_reg += sacc;
      ATT_PACK(pB0, pB1, pw0, pw1, pw2, pw3);
      SBAR(); pv(o, vb0 + sl_cur, PAF(0), PAF(1), PAF(2), PAF(3)); }
    asm volatile("s_waitcnt lgkmcnt(0)\n\ts_barrier" ::: "memory");
    mhat_o = mhat; l_o = l_reg;
#undef TLRAW
#undef DMA_K
#undef DMA_V
#undef LUTLOAD
#undef SBAR
#undef PIN
#undef PKW
#undef PAF
#undef VFR
#undef MX3
#undef MFMA32
#undef GAPA
#undef EX
#undef GAPB
#undef VRD
#undef KRD
#undef ROT
#undef RESC
#undef ENDW
#undef STEP
}
}

struct Ctx { int tid, lane, wave, vcu, G, bx; LAS unsigned char* lds; };

__device__ __forceinline__ void tr_item(const float* W, size_t ldw, int srccol, int nvalid, bf16_t* WT, size_t ldk, int dstrow, int k0, LAS float* scr, int lane) {
#pragma unroll 8
    for (int i = 0; i < 32; ++i) { const int kk = 2 * i + (lane >> 5), n = lane & 31; scr[kk * 33 + n] = (n < nvalid) ? W[(size_t)(k0 + kk) * ldw + srccol + n] : 0.f; }
    LDS_WAIT(); asm volatile("" ::: "memory");
    const int c = lane & 7;
#pragma unroll
    for (int j = 0; j < 4; ++j) { const int n = (lane >> 3) + 8 * j; const LAS float* s = scr + (8 * c) * 33 + n;
        u32x4 o; o.x = cvt_pk_bf16(s[0 * 33], s[1 * 33]); o.y = cvt_pk_bf16(s[2 * 33], s[3 * 33]); o.z = cvt_pk_bf16(s[4 * 33], s[5 * 33]); o.w = cvt_pk_bf16(s[6 * 33], s[7 * 33]);
        *(u32x4*)(WT + (size_t)(dstrow + n) * ldk + k0 + 8 * c) = o; }
    LDS_WAIT(); asm volatile("" ::: "memory");
}
__device__ __forceinline__ void conv_small(const Args& a, const Ctx& C) {
    LAS float* scr = (LAS float*)(C.lds + C.wave * 16384);
    const int gw = C.vcu * NWAVES + C.wave, NGW = C.G * NWAVES;
    constexpr int I_WIN = 184 * 16, I_CW1 = 2 * 8 * 32, I_WUN = 32 * 8, I_WUD = 32 * 4, I_WO = 32 * 16, I_CW2 = 2 * 2 * 4;
    constexpr int PER = I_WIN + I_CW1 + I_WUN + I_WUD + I_WO + I_CW2;
    unsigned char* ws = a.ws;
    for (int it = gw; it < 2 * PER; it += NGW) {
        const int l = it / PER; int r = it % PER;
        if (r < I_WIN) { const int nb = r / 16, kb = r % 16; const int nd = 32 * nb; int src, nv = 32;
            if (nd < 1280) src = nd; else if (nd < 5632) src = nd + 24; else if (nd == 5632) { src = 1280; nv = 24; } else { src = 0; nv = 0; }
            tr_item(a.w_in + (size_t)l * DM * INW, INW, src, nv, (bf16_t*)(ws + WS_WINT) + (size_t)l * NIN * DM, DM, nd, 64 * kb, scr, C.lane); continue; }
        r -= I_WIN;
        if (r < I_CW1) { const int kv = r / 256, q = r % 256, nb = q / 32, kb = q % 32;
            tr_item(a.cmp_w1 + (size_t)(l * 2 + kv) * 2048 * 256, 256, 32 * nb, 32, (bf16_t*)(ws + WS_CW1T) + (size_t)(l * 2 + kv) * 256 * 2048, 2048, 32 * nb, 64 * kb, scr, C.lane); continue; }
        r -= I_CW1;
        if (r < I_WUN) { const int nb = r / 8, kb = r % 8;
            tr_item(a.w_up_nsa + (size_t)l * 512 * 1024, 1024, 32 * nb, 32, (bf16_t*)(ws + WS_WUNT) + (size_t)l * 1024 * 512, 512, 32 * nb, 64 * kb, scr, C.lane); continue; }
        r -= I_WUN;
        if (r < I_WUD) { const int nb = r / 4, kb = r % 4;
            tr_item(a.w_up_dil + (size_t)l * 256 * 1024, 1024, 32 * nb, 32, (bf16_t*)(ws + WS_WUDT) + (size_t)l * 1024 * 256, 256, 32 * nb, 64 * kb, scr, C.lane); continue; }
        r -= I_WUD;
        if (r < I_WO) { const int nb = r / 16, kb = r % 16;
            tr_item(a.w_o + (size_t)l * 1024 * 1024, 1024, 32 * nb, 32, (bf16_t*)(ws + WS_WOT) + (size_t)l * 1024 * 1024, 1024, 32 * nb, 64 * kb, scr, C.lane); continue; }
        r -= I_WO;
        { const int kv = r / 8, q = r % 8, nb = q / 4, kb = q % 4;
            tr_item(a.cmp_w2 + (size_t)(l * 2 + kv) * 256 * 64, 64, 32 * nb, 32, (bf16_t*)(ws + WS_CW2T) + (size_t)(l * 2 + kv) * 64 * 256, 256, 32 * nb, 64 * kb, scr, C.lane); }
    }
}
__device__ __forceinline__ void conv_experts(const Args& a, const Ctx& C, int l) {
    LAS float* scr = (LAS float*)(C.lds + C.wave * 16384);
    const int gw = C.vcu * NWAVES + C.wave, NGW = C.G * NWAVES;
    constexpr int I_13 = 32 * 16, I_2 = 32 * 8, PER = I_13 + I_2;
    unsigned char* ws = a.ws;
    for (int it = gw; it < 32 * PER; it += NGW) {
        const int e = it / PER; int r = it % PER;
        if (r < I_13) { const int nb = r / 16, kb = r % 16; const int r0 = 32 * nb, pn = r0 >> 8, bj = (r0 >> 7) & 1, j0 = r0 & 127;
            const float* src = (bj ? a.exp_w3 : a.exp_w1) + (size_t)(l * 32 + e) * 1024 * 512;
            tr_item(src, 512, pn * 128 + j0, 32, (bf16_t*)(ws + WS_E13T) + (size_t)e * 1024 * 1024, 1024, r0, 64 * kb, scr, C.lane); continue; }
        r -= I_13;
        { const int nb = r / 8, kb = r % 8;
            tr_item(a.exp_w2 + (size_t)(l * 32 + e) * 512 * 1024, 1024, 32 * nb, 32, (bf16_t*)(ws + WS_E2T) + (size_t)e * 1024 * 512, 512, 32 * nb, 64 * kb, scr, C.lane); }
    }
}
__device__ __forceinline__ void prologue_vectors(const Args& a, const Ctx& C) {
    LAS float* sc = (LAS float*)(C.lds + 131072);
    LAS float* sl = (LAS float*)(C.lds);
    for (int i = C.tid; i < 8 * 1024; i += NTHR) { const float v = a.c[i]; sl[i] = v * sigmoidf_(v); }
    (void)sc;
    __syncthreads();
    const int gw = C.vcu * NWAVES + C.wave, NGW = C.G * NWAVES;
    float* MOD = (float*)(a.ws + WS_MOD); float* CB1 = (float*)(a.ws + WS_CB1);
    for (int it = gw; it < 192 + 16; it += NGW) {
        if (it < 192) { const int l = it / 96, col = (it % 96) * 64 + C.lane;
            const float* w = a.ada_w + (size_t)l * 1024 * 6144 + col;
            float acc[8];
#pragma unroll
            for (int b = 0; b < 8; ++b) acc[b] = 0.f;
            for (int k = 0; k < 1024; ++k) { const float wv = w[(size_t)k * 6144];
#pragma unroll
                for (int b = 0; b < 8; ++b) acc[b] += sl[b * 1024 + k] * wv; }
            const float bias = a.ada_b[l * 6144 + col];
#pragma unroll
            for (int b = 0; b < 8; ++b) MOD[(size_t)(l * 8 + b) * 6144 + col] = acc[b] + bias;
        } else { const int q = it - 192, lk = q / 4, col = (q % 4) * 64 + C.lane;
            const float* w = a.cmp_w1 + (size_t)lk * 2048 * 256 + col; const float* pos = a.cmp_pos + (size_t)lk * 2048;
            float acc = 0.f;
            for (int k = 0; k < 2048; ++k) acc += pos[k] * w[(size_t)k * 256];
            CB1[lk * 256 + col] = acc;
        }
    }
    __syncthreads();
}

__device__ __forceinline__ void moe_combine_row(const Args& a, int row, int lane, const float* g2  , f32x4 (&v)[4]) {
    const u32x4 rec = *(const u32x4*)(a.ws + WS_DEST + (size_t)row * 16);
    const bf16_t* Y = (const bf16_t*)(a.ws + WS_XS);
    const float w0 = (ABL == 6) ? 0.f : __uint_as_float(rec.z), w1 = (ABL == 6) ? 0.f : __uint_as_float(rec.w);
    const u32x2* y0 = (const u32x2*)(Y + (size_t)rec.x * 1024) + lane; const u32x2* y1 = (const u32x2*)(Y + (size_t)rec.y * 1024) + lane;
#pragma unroll
    for (int j = 0; j < 4; ++j) { const u32x2 p = y0[64 * j], q = y1[64 * j]; const f32x4 gg = *((const f32x4*)g2 + lane + 64 * j);
        v[j][0] += gg[0] * (w0 * bf_lo(p.x) + w1 * bf_lo(q.x)); v[j][1] += gg[1] * (w0 * bf_hi(p.x) + w1 * bf_hi(q.x));
        v[j][2] += gg[2] * (w0 * bf_lo(p.y) + w1 * bf_lo(q.y)); v[j][3] += gg[3] * (w0 * bf_hi(p.y) + w1 * bf_hi(q.y)); }
}
__device__ __forceinline__ void norm1_phase(const Args& a, const Ctx& C, int l) {
    const int gw = C.vcu * NWAVES + C.wave, NGW = C.G * NWAVES;
    const float* MOD = (const float*)(a.ws + WS_MOD); bf16_t* H = (bf16_t*)(a.ws + WS_H);
    const float* nw = a.norm1 + l * 1024;
    for (int row = gw; row < T; row += NGW) {
        const int b = row >> 12; const float* xr = (l == 0 ? a.x : (const float*)a.out) + (size_t)row * 1024;
        f32x4 v[4];
#pragma unroll
        for (int j = 0; j < 4; ++j) v[j] = *((const f32x4*)xr + C.lane + 64 * j);
        if (l == 1) { moe_combine_row(a, row, C.lane, MOD + (size_t)(0 * 8 + b) * 6144 + 5120, v);
#pragma unroll
            for (int j = 0; j < 4; ++j) *((f32x4*)(a.out + (size_t)row * 1024) + C.lane + 64 * j) = v[j]; }
        float ss = 0.f;
#pragma unroll
        for (int j = 0; j < 4; ++j) ss += (v[j][0] * v[j][0] + v[j][1] * v[j][1]) + (v[j][2] * v[j][2] + v[j][3] * v[j][3]);
        const float rstd = 1.0f / sqrtf(wave_sum(ss) * (1.0f / 1024.0f) + RMS_EPS);
        const float* mb = MOD + (size_t)(l * 8 + b) * 6144;
#pragma unroll
        for (int j = 0; j < 4; ++j) { const f32x4 g = *((const f32x4*)nw + C.lane + 64 * j), sh = *((const f32x4*)mb + C.lane + 64 * j), sc = *((const f32x4*)(mb + 1024) + C.lane + 64 * j);
            const f32x4 h = v[j] * rstd * g * (sc + 1.0f) + sh; u32x2 w; w.x = cvt_pk_bf16(h[0], h[1]); w.y = cvt_pk_bf16(h[2], h[3]);
            *((u32x2*)(H + (size_t)row * 1024) + C.lane + 64 * j) = w; }
    }
}
__device__ __forceinline__ void final_phase(const Args& a, const Ctx& C) {
    const int gw = C.vcu * NWAVES + C.wave, NGW = C.G * NWAVES;
    const float* MOD = (const float*)(a.ws + WS_MOD);
    for (int row = gw; row < T; row += NGW) {
        const int b = row >> 12; float* xr = a.out + (size_t)row * 1024;
        f32x4 v[4];
#pragma unroll
        for (int j = 0; j < 4; ++j) v[j] = *((const f32x4*)xr + C.lane + 64 * j);
        moe_combine_row(a, row, C.lane, MOD + (size_t)(1 * 8 + b) * 6144 + 5120, v);
        float ss = 0.f;
#pragma unroll
        for (int j = 0; j < 4; ++j) ss += (v[j][0] * v[j][0] + v[j][1] * v[j][1]) + (v[j][2] * v[j][2] + v[j][3] * v[j][3]);
        const float rstd = 1.0f / sqrtf(wave_sum(ss) * (1.0f / 1024.0f) + RMS_EPS);
#pragma unroll
        for (int j = 0; j < 4; ++j) { const f32x4 g = *((const f32x4*)a.norm_f + C.lane + 64 * j); *((f32x4*)xr + C.lane + 64 * j) = v[j] * rstd * g; }
    }
}
__device__ __forceinline__ void norm2_router_phase(const Args& a, const Ctx& C, int l) {
    LAS float* WL = (LAS float*)(C.lds);
    LAS int* wcnt = (LAS int*)(C.lds + LDS_MISC + 256);
    const float* wg = a.router_wg + (size_t)l * 1024 * 4; const float* we = a.router_we + (size_t)l * 1024 * 32;
    for (int i = C.tid; i < 1024 * 4; i += NTHR) { const int k = i >> 2, c = i & 3; WL[c * 1024 + k] = wg[i]; }
    for (int i = C.tid; i < 1024 * 32; i += NTHR) { const int k = i >> 5, c = i & 31; WL[(4 + c) * 1024 + k] = we[i]; }
    __syncthreads();
    const float* MOD = (const float*)(a.ws + WS_MOD); bf16_t* H2 = (bf16_t*)(a.ws + WS_H2);
    const float* nw = a.norm2 + l * 1024; const float* bg = a.router_bg + l * 4; const float* be = a.router_be + l * 32;
    int* CNTBLK = (int*)(a.ws + WS_CNTBLK);
    for (int ch = C.vcu; ch < T / 128; ch += C.G) {
        int my_e0 = 0, my_e1 = 0; float my_w0 = 0.f, my_w1 = 0.f;
        for (int j = 0; j < 16; ++j) {
            const int row = ch * 128 + C.wave * 16 + j; const int b = row >> 12;
            const float* xr = a.out + (size_t)row * 1024;
            f32x4 v[4];
#pragma unroll
            for (int q = 0; q < 4; ++q) v[q] = *((const f32x4*)xr + C.lane + 64 * q);
            float ss = 0.f;
#pragma unroll
            for (int q = 0; q < 4; ++q) ss += (v[q][0] * v[q][0] + v[q][1] * v[q][1]) + (v[q][2] * v[q][2] + v[q][3] * v[q][3]);
            const float rstd = 1.0f / sqrtf(wave_sum(ss) * (1.0f / 1024.0f) + RMS_EPS);
            const float* mb = MOD + (size_t)(l * 8 + b) * 6144 + 3072;
#pragma unroll
            for (int q = 0; q < 4; ++q) { const f32x4 g = *((const f32x4*)nw + C.lane + 64 * q), sh = *((const f32x4*)mb + C.lane + 64 * q), sc = *((const f32x4*)(mb + 1024) + C.lane + 64 * q);
                v[q] = v[q] * rstd * g * (sc + 1.0f) + sh; u32x2 w; w.x = cvt_pk_bf16(v[q][0], v[q][1]); w.y = cvt_pk_bf16(v[q][2], v[q][3]);
                *((u32x2*)(H2 + (size_t)row * 1024) + C.lane + 64 * q) = w; }
            float lg[4];
#pragma unroll
            for (int c = 0; c < 4; ++c) { float s = 0.f;
#pragma unroll
                for (int q = 0; q < 4; ++q) { const f32x4 w = *((const LAS f32x4*)(WL + c * 1024) + C.lane + 64 * q); s += (v[q][0] * w[0] + v[q][1] * w[1]) + (v[q][2] * w[2] + v[q][3] * w[3]); }
                lg[c] = wave_sum(s) + bg[c]; }
            int grp = 0; float gmax = lg[0];
#pragma unroll
            for (int c = 1; c < 4; ++c) if (lg[c] > gmax) { gmax = lg[c]; grp = c; }
            float gs = 0.f;
#pragma unroll
            for (int c = 0; c < 4; ++c) gs += __builtin_amdgcn_exp2f((lg[c] - gmax) * LOG2E);
            const float pgrp = 1.0f / gs;
            grp = __builtin_amdgcn_readfirstlane(grp);
            float le[8];
#pragma unroll
            for (int e = 0; e < 8; ++e) { float s = 0.f; const LAS float* wrow = WL + (4 + grp * 8 + e) * 1024;
#pragma unroll
                for (int q = 0; q < 4; ++q) { const f32x4 w = *((const LAS f32x4*)wrow + C.lane + 64 * q); s += (v[q][0] * w[0] + v[q][1] * w[1]) + (v[q][2] * w[2] + v[q][3] * w[3]); }
                le[e] = wave_sum(s) + be[grp * 8 + e]; }
            int i0 = 0; float v0 = le[0];
#pragma unroll
            for (int e = 1; e < 8; ++e) if (le[e] > v0) { v0 = le[e]; i0 = e; }
            int i1 = -1; float v1 = -INFINITY;
#pragma unroll
            for (int e = 0; e < 8; ++e) if (e != i0 && le[e] > v1) { v1 = le[e]; i1 = e; }
            const float ex = __builtin_amdgcn_exp2f((v1 - v0) * LOG2E);
            const float w0 = pgrp / (1.0f + ex), w1 = pgrp * ex / (1.0f + ex);
            if (C.lane == j) { my_e0 = grp * 8 + i0; my_e1 = grp * 8 + i1; my_w0 = w0; my_w1 = w1; }
        }
        const int ea = bperm_i(C.lane >> 1, my_e0), eb = bperm_i(C.lane >> 1, my_e1);
        const int es = (C.lane < 32) ? ((C.lane & 1) ? eb : ea) : -1;
        int rank = 0, cnt = 0;
#pragma unroll
        for (int s = 0; s < 32; ++s) { const int v = __builtin_amdgcn_readlane(es, s); rank += (v == es && s < C.lane) ? 1 : 0; cnt += (v == C.lane) ? 1 : 0; }
        __syncthreads();
        if (C.lane < 32) wcnt[C.wave * 32 + C.lane] = cnt;
        __syncthreads();
        int lrank = rank;
        if (C.lane < 32) { for (int w = 0; w < C.wave; ++w) lrank += wcnt[w * 32 + es]; }
        if (C.wave == 0 && C.lane < 32) { int tot = 0;
#pragma unroll
            for (int w = 0; w < 8; ++w) tot += wcnt[w * 32 + C.lane];
            CNTBLK[ch * 32 + C.lane] = tot; }
        const int lr0 = bperm_i((2 * C.lane) & 63, lrank), lr1 = bperm_i((2 * C.lane + 1) & 63, lrank);
        if (C.lane < 16) { const int row = ch * 128 + C.wave * 16 + C.lane;
            u32x4 rec; rec.x = (unsigned)my_e0 | ((unsigned)my_e1 << 8); rec.y = (unsigned)lr0 | ((unsigned)lr1 << 16); rec.z = __float_as_uint(my_w0); rec.w = __float_as_uint(my_w1);
            *(u32x4*)(a.ws + WS_REC + (size_t)row * 16) = rec; }
    }
}
__device__ __forceinline__ void moe_scatter_phase(const Args& a, const Ctx& C) {
    LAS int* part_lt = (LAS int*)(C.lds);
    LAS int* part_all = part_lt + 512;
    LAS int* base = part_all + 512;
    LAS int* tot = base + 32;
    LAS int* pst = tot + 32;
    const int* CNTBLK = (const int*)(a.ws + WS_CNTBLK);
    int* TILEE = (int*)(a.ws + WS_TILEE);
    const bf16_t* H2 = (const bf16_t*)(a.ws + WS_H2); bf16_t* XS = (bf16_t*)(a.ws + WS_XS);
    for (int ch = C.vcu; ch < T / 128; ch += C.G) {
        __syncthreads();
        { const int e = C.tid & 31, p = C.tid >> 5; int slt = 0, sall = 0;
            for (int c = p; c < T / 128; c += 16) { const int v = CNTBLK[c * 32 + e]; sall += v; slt += (c < ch) ? v : 0; }
            part_lt[p * 32 + e] = slt; part_all[p * 32 + e] = sall; }
        __syncthreads();
        if (C.tid < 32) { int b = 0, t2 = 0;
#pragma unroll
            for (int p = 0; p < 16; ++p) { b += part_lt[p * 32 + C.tid]; t2 += part_all[p * 32 + C.tid]; }
            base[C.tid] = b; tot[C.tid] = t2; }
        __syncthreads();
        if (C.tid < 32) { int ps = 0; for (int e = 0; e < C.tid; ++e) ps += (tot[e] + 255) & ~255; pst[C.tid] = ps;
            if (ch == 0) { const int nt = (tot[C.tid] + 255) >> 8; const int t0 = ps >> 8; for (int m = 0; m < nt; ++m) TILEE[16 + t0 + m] = C.tid; if (C.tid == 31) TILEE[0] = t0 + nt; } }
        __syncthreads();
        int d0 = 0, d1 = 0;
        if (C.lane < 16) { const int row = ch * 128 + C.wave * 16 + C.lane;
            const u32x4 rec = *(const u32x4*)(a.ws + WS_REC + (size_t)row * 16);
            const int e0 = rec.x & 255, e1 = (rec.x >> 8) & 255;
            d0 = pst[e0] + base[e0] + (int)(rec.y & 0xffffu); d1 = pst[e1] + base[e1] + (int)(rec.y >> 16);
            u32x4 o; o.x = (unsigned)d0; o.y = (unsigned)d1; o.z = rec.z; o.w = rec.w;
            *(u32x4*)(a.ws + WS_DEST + (size_t)row * 16) = o; }
        for (int j = 0; j < 16; ++j) { const int row = ch * 128 + C.wave * 16 + j;
            const int t0 = __builtin_amdgcn_readlane(d0, j), t1 = __builtin_amdgcn_readlane(d1, j);
            const u32x4* src = (const u32x4*)(H2 + (size_t)row * 1024) + C.lane;
            const u32x4 va = src[0], vb = src[64];
            u32x4* o0 = (u32x4*)(XS + (size_t)t0 * 1024) + C.lane; u32x4* o1 = (u32x4*)(XS + (size_t)t1 * 1024) + C.lane;
            o0[0] = va; o0[64] = vb; o1[0] = va; o1[64] = vb; }
    }
}
struct MoeOrder {
    int G, c, nu; int ex[8]; const char* A; const char* B; size_t tA, tB, eB;
    __device__ __forceinline__ bool next(int i, pg8::Unit& u) const {
        const int L = i * G + c; if (i >= 8 || L >= nu) return false;
        const int e = i == 0 ? ex[0] : i == 1 ? ex[1] : i == 2 ? ex[2] : i == 3 ? ex[3] : i == 4 ? ex[4] : i == 5 ? ex[5] : i == 6 ? ex[6] : ex[7];
        u.pm = L >> 2; u.pn = L & 3; u.A = A + (size_t)u.pm * tA; u.B = B + (size_t)e * eB + (size_t)u.pn * tB; return true;
    }
};

__device__ __forceinline__ void dil_unit(const Args& a, const Ctx& C, int du) {
    using namespace att;
    LAS unsigned char* lds = C.lds;
    const int x = du & 15; int r = du >> 4; const int h = r & 3; r >>= 2; const int grp = r % 3, b = r / 3;
    const int dsh = 2 * grp, d = 1 << dsh; const int nub = 16 >> dsh; const int res = x / nub, ub = x % nub;
    const int wid = C.wave, lane = C.lane, r32 = lane & 31, hi = lane >> 5;
    LAS float* lut = (LAS float*)(lds + L_X);
    LAS unsigned char* tl = lds + L_SEL + 768;
    __syncthreads();
    for (int e = C.tid; e < 704; e += NTHR) { const int m = 384 - e; float v = -INFINITY;
        if (m >= 0 && m <= 128) { int di = m << dsh; di = di > 4095 ? 4095 : di; v = a.rel_bias[(int)lds[L_BKT + di] * 20 + 8 + grp * 4 + h] * LOG2E; }
        lut[e] = v; }
    if (C.tid < 6) { const int kt = 4 * ub - 2 + C.tid; tl[C.tid] = (unsigned char)(kt < 0 ? 0x80 : kt); }
    const bf16_t* QKV = (const bf16_t*)(a.ws + WS_A);
    const int u = 256 * ub + 32 * wid + r32; const size_t tokq = (size_t)b * SEQ + (size_t)u * d + res;
    const bf16_t* qp = QKV + tokq * LDQ + 1280 + grp * 256 + h * 64;
    bf16x8 qr[4];
#pragma unroll
    for (int d0 = 0; d0 < 4; ++d0) qr[d0] = *(const bf16x8*)(qp + d0 * 16 + hi * 8);
    __syncthreads();
    StreamP S; S.Kb = QKV + ((size_t)b * SEQ + res) * LDQ + 1280 + 768 + grp * 256 + h * 64; S.Vb = S.Kb + 768; S.pitch = (long)d * LDQ;
    S.NT = 6; S.tl = tl; S.lanesel = ~0ull; S.uq = u; S.lut = lut; S.xtop = 384; S.dclamp = 1 << 30;
    float m = 0.f, l = 0.f; f32x16 o[2];
    attn_stream<8>(lds, wid, lane, qr, S, m, l, o);
    l = xhalf_sum(l);
    LAS float* wsf = (LAS float*)(lds + L_WSF) + wid * 64;
    if (hi == 0) { wsf[r32] = l > 0.f ? 1.0f / l : 0.f; ((float*)(a.ws + WS_LSE))[((size_t)grp * T + tokq) * 4 + h] = m + __builtin_amdgcn_logf(l); }
    LDS_WAIT();
#pragma unroll
    for (int rr = 0; rr < 16; ++rr) { const float f = wsf[crow(rr, hi)]; o[0][rr] *= f; o[1][rr] *= f; }
    stage_rows(lds, wid, lane, o);
    bf16_t* ODP = (bf16_t*)(a.ws + WS_ODP) + (size_t)grp * T * 256;
    const LAS bf16_t* stg = (const LAS bf16_t*)(lds + L_OTA) + wid * 2048;
#pragma unroll
    for (int i = 0; i < 4; ++i) { const int row = i * 8 + (lane >> 3), chn = lane & 7; const u32x4 v = *(const LAS u32x4*)(stg + row * 64 + chn * 8);
        const size_t tok = (size_t)b * SEQ + (size_t)(256 * ub + 32 * wid + row) * d + res;
        *(u32x4*)(ODP + tok * 256 + h * 64 + chn * 8) = v; }
}
__device__ __forceinline__ void dil_combine(const Args& a, const Ctx& C) {
    const float* LSE = (const float*)(a.ws + WS_LSE); const bf16_t* ODP = (const bf16_t*)(a.ws + WS_ODP); bf16_t* ODIL = (bf16_t*)(a.ws + WS_ODIL);
    const int gt = C.vcu * NTHR + C.tid, NT = C.G * NTHR;
    for (int idx = gt; idx < T * 32; idx += NT) {
        const int tok = idx >> 5, h = (idx >> 3) & 3, chn = idx & 7;
        const float l0 = LSE[((size_t)0 * T + tok) * 4 + h], l1 = LSE[((size_t)1 * T + tok) * 4 + h], l2 = LSE[((size_t)2 * T + tok) * 4 + h];
        const float mx = __builtin_fmaxf(l0, __builtin_fmaxf(l1, l2));
        float w0 = __builtin_amdgcn_exp2f(l0 - mx), w1 = __builtin_amdgcn_exp2f(l1 - mx), w2 = __builtin_amdgcn_exp2f(l2 - mx);
        const float inv = 1.0f / (w0 + w1 + w2); w0 *= inv; w1 *= inv; w2 *= inv;
        const size_t off = (size_t)tok * 256 + h * 64 + chn * 8;
        const u32x4 a0 = *(const u32x4*)(ODP + off), a1 = *(const u32x4*)(ODP + (size_t)T * 256 + off), a2 = *(const u32x4*)(ODP + (size_t)2 * T * 256 + off);
        u32x4 o;
        o.x = cvt_pk_bf16(w0 * bf_lo(a0.x) + w1 * bf_lo(a1.x) + w2 * bf_lo(a2.x), w0 * bf_hi(a0.x) + w1 * bf_hi(a1.x) + w2 * bf_hi(a2.x));
        o.y = cvt_pk_bf16(w0 * bf_lo(a0.y) + w1 * bf_lo(a1.y) + w2 * bf_lo(a2.y), w0 * bf_hi(a0.y) + w1 * bf_hi(a1.y) + w2 * bf_hi(a2.y));
        o.z = cvt_pk_bf16(w0 * bf_lo(a0.z) + w1 * bf_lo(a1.z) + w2 * bf_lo(a2.z), w0 * bf_hi(a0.z) + w1 * bf_hi(a1.z) + w2 * bf_hi(a2.z));
        o.w = cvt_pk_bf16(w0 * bf_lo(a0.w) + w1 * bf_lo(a1.w) + w2 * bf_lo(a2.w), w0 * bf_hi(a0.w) + w1 * bf_hi(a1.w) + w2 * bf_hi(a2.w));
        if (ABL == 4) o = (u32x4){0u, 0u, 0u, 0u};
        *(u32x4*)(ODIL + off) = o;
    }
}
template <bool INIT>
__device__ __forceinline__ void ota_update(LAS bf16_t* ota  , const LAS float* frow, int hi, const f32x16 (&o)[2]) {
#pragma unroll
    for (int r = 0; r < 16; ++r) { const int row = crow(r, hi); const float f = frow[row];
        float v0 = f * o[0][r], v1 = f * o[1][r];
        if (!INIT) { v0 += __uint_as_float((unsigned)ota[row * 64] << 16); v1 += __uint_as_float((unsigned)ota[row * 64 + 32] << 16); }
        ota[row * 64] = (bf16_t)(cvt_pk_bf16(v0, 0.f) & 0xffffu); ota[row * 64 + 32] = (bf16_t)(cvt_pk_bf16(v1, 0.f) & 0xffffu); }
}
#define NSA_SECT() const int lane = lane_id_fresh(); const int tid = wid * 64 + lane; const int r32 = lane & 31, hi = lane >> 5; (void)tid; (void)r32; (void)hi
__device__ __forceinline__ void nsa_unit(const Args& a, const Ctx& C, int b, int hk, int i) {
    using namespace att;
    LAS unsigned char* lds = C.lds;
    const int wid = C.wave; const int g = wid >> 1;
    const bf16_t* QKV = (const bf16_t*)(a.ws + WS_A);
    bf16x8 qr[4];
    f32x16 o[2];
    __syncthreads();
    { NSA_SECT();
        const int tq = (wid & 1) * 32 + r32, t = 64 * i + tq; const size_t tok = (size_t)b * SEQ + t;
        LAS float* impP = (LAS float*)(lds + L_X); LAS float* tbh = (LAS float*)(lds + L_TBH); LAS float* gsh = (LAS float*)(lds + L_GSH) + wid * 96; LAS unsigned* selw = (LAS unsigned*)(lds + L_SEL);
        for (int e = tid; e < 4 * 64 * 64; e += NTHR) impP[e] = 0.f;
        if (tid < 128) tbh[tid] = a.rel_bias[(tid & 31) * 20 + hk * 4 + (tid >> 5)] * LOG2E;
        if (tid < 2) selw[128 + tid] = 0u;
        if (hi == 0) { const float* gn = (const float*)(a.ws + WS_GN) + tok * 32 + hk * 4 + g;
            gsh[r32] = (ABL == 1) ? 0.f : gn[0]; gsh[32 + r32] = (ABL == 2) ? 0.f : gn[8]; gsh[64 + r32] = (ABL == 3) ? 0.f : gn[16]; }
        const bf16_t* qp = QKV + tok * LDQ + hk * 256 + g * 64;
#pragma unroll
        for (int d0 = 0; d0 < 4; ++d0) qr[d0] = *(const bf16x8*)(qp + d0 * 16 + hi * 8);
        __syncthreads();
        LoopP P; P.tb = tbh + g * 32; P.imp = impP + (g * 64 + tq) * 64; P.wlo = 0; P.whi = 63; P.dsh = 0;
        const bf16_t* KC = (const bf16_t*)(a.ws + WS_KC);
        P.Kb = KC + (size_t)((0 * 8 + b) * 2 + hk) * 256 * 64; P.Vb = KC + (size_t)((1 * 8 + b) * 2 + hk) * 256 * 64; P.pitch = 64;
        const int nt = (4 * i + 2) / 64 + 1; P.tmask = (1ull << nt) - 1ull;
        P.uqp = t - 31; P.maxd = 1 << 30; P.lanesel = ~0ull;
        float m = -INFINITY, l = 0.f;
        attn_loop<16, 1>(lds, wid, lane, qr, P, m, l, o);
        l = xhalf_sum(l);
        float msafe = (m == -INFINITY) ? 0.f : m, invl = l > 0.f ? 1.0f / l : 0.f;
        o[0] = (f32x16){}; o[1] = (f32x16){};
        attn_loop<16, 2>(lds, wid, lane, qr, P, msafe, invl, o);
        ota_update<true>((LAS bf16_t*)(lds + L_OTA) + wid * 2048 + r32, gsh, hi, o);
    }
    __syncthreads();
    { NSA_SECT();
        LAS float* impP = (LAS float*)(lds + L_X); LAS unsigned* selw = (LAS unsigned*)(lds + L_SEL);
#pragma unroll
        for (int k = 0; k < 8; ++k) { const int idx = tid * 8 + k; impP[idx] = ((impP[idx] + impP[4096 + idx]) + impP[8192 + idx]) + impP[12288 + idx]; }
        __syncthreads();
        const int q = tid >> 3, part = tid & 7;
        const int ncand = i - 2 > 0 ? i - 2 : 0; const int nforced = i + 1 < 3 ? i + 1 : 3; const int krem = 16 - nforced;
        unsigned bits = 0u;
        if (ncand > krem && ABL != 5) {
            float vn[8]; int cn[8];
#pragma unroll
            for (int e = 0; e < 8; ++e) { vn[e] = impP[q * 64 + part * 8 + e]; cn[e] = 0; }
            for (int mm = 1; mm <= i - 2; ++mm) { const float xv = impP[q * 64 + mm];
#pragma unroll
                for (int e = 0; e < 8; ++e) { const int n = part * 8 + e; cn[e] += (xv > vn[e] || (xv == vn[e] && mm < n)) ? 1 : 0; } }
#pragma unroll
            for (int e = 0; e < 8; ++e) { const int n = part * 8 + e; if (n >= 1 && n <= i - 2 && cn[e] < krem) bits |= 1u << e; }
        } else {
#pragma unroll
            for (int e = 0; e < 8; ++e) { const int n = part * 8 + e; if (n >= 1 && n <= i - 2) bits |= 1u << e; }
        }
#pragma unroll
        for (int e = 0; e < 8; ++e) { const int n = part * 8 + e; if (n == 0 || n == i || n == i - 1) bits |= 1u << e; }
        unsigned lo = part < 4 ? bits << (8 * part) : 0u, hi2 = part >= 4 ? bits << (8 * (part - 4)) : 0u;
        lo |= swz_xor_u<1>(lo); hi2 |= swz_xor_u<1>(hi2); lo |= swz_xor_u<2>(lo); hi2 |= swz_xor_u<2>(hi2); lo |= swz_xor_u<4>(lo); hi2 |= swz_xor_u<4>(hi2);
        if (part == 0) { selw[2 * q] = lo; selw[2 * q + 1] = hi2; atomicOr((unsigned*)&selw[128], lo); atomicOr((unsigned*)&selw[129], hi2); }
    }
    __syncthreads();
    int NTS, NTW;
    { NSA_SECT();
        LAS unsigned* selw = (LAS unsigned*)(lds + L_SEL); LAS float* tbh = (LAS float*)(lds + L_TBH);
        LAS unsigned char* tls = lds + L_SEL + 768; LAS unsigned char* tlw = lds + L_SEL + 848;
        const unsigned long long uni = ((unsigned long long)(unsigned)__builtin_amdgcn_readfirstlane((int)selw[129]) << 32) | (unsigned)__builtin_amdgcn_readfirstlane((int)selw[128]);
        const int nsel = __builtin_popcountll(uni); const int nts = (nsel + 1) & ~1; NTS = nts < 4 ? 4 : nts;
        const int jlo = i - 8 < 0 ? 0 : i - 8; const int nwin = i - jlo + 1; const int ntw = (nwin + 1) & ~1; NTW = ntw < 4 ? 4 : ntw;
        if (tid < 64) { if ((uni >> tid) & 1ull) tls[__builtin_popcountll(uni & ((1ull << tid) - 1ull))] = (unsigned char)tid; }
        else if (tid < 72) { const int k = nsel + (tid - 64); if (k < NTS) tls[k] = 0x80; }
        else if (tid < 88) { const int k = tid - 72; if (k < NTW) tlw[k] = (unsigned char)(k < nwin ? jlo + k : 0x80); }
        LAS float* lut = (LAS float*)(lds + L_X);
        for (int e = tid; e < 4 * 1792; e += NTHR) { const int gg = e / 1792, xx = e % 1792; const int dist = 1636 - xx;
            lut[e] = dist < 0 ? -INFINITY : tbh[gg * 32 + (int)lds[L_BKT + dist]]; }
        for (int e = tid; e < 4 * 768; e += NTHR) { const int gg = e / 768, xx = e % 768; const int dist = 640 - xx;
            lut[7168 + e] = (dist < 0 || dist > 512) ? -INFINITY : tbh[gg * 32 + (int)lds[L_BKT + dist]]; }
    }
    __syncthreads();
#pragma clang loop unroll(disable)
    for (int br = 0; br < 2; ++br) {
        float m = 0.f, l = 0.f;
        { NSA_SECT();
            const int tq = (wid & 1) * 32 + r32, t = 64 * i + tq;
            LAS unsigned* selw = (LAS unsigned*)(lds + L_SEL); LAS float* lut = (LAS float*)(lds + L_X);
            StreamP S; S.Kb = QKV + (size_t)b * SEQ * LDQ + 512 + 256 + br * 256 + hk * 64; S.Vb = S.Kb + 128; S.pitch = LDQ;
            S.NT = br ? NTW : NTS; S.tl = lds + L_SEL + (br ? 848 : 768); S.uq = t;
            S.lanesel = br ? ~0ull : (((unsigned long long)selw[2 * tq + 1] << 32) | selw[2 * tq]);
            S.lut = br ? lut + 7168 + g * 768 : lut + g * 1792; S.xtop = br ? 640 : 1636; S.dclamp = br ? (1 << 30) : 1636;
            attn_stream<8>(lds, wid, lane, qr, S, m, l, o);
        }
        { NSA_SECT();
            LAS float* gsh = (LAS float*)(lds + L_GSH) + wid * 96; LAS float* wsf = (LAS float*)(lds + L_WSF) + wid * 64;
            l = xhalf_sum(l);
            LDS_WAIT();
            if (hi == 0) wsf[r32] = (l > 0.f ? 1.0f / l : 0.f) * gsh[32 + br * 32 + r32];
            LDS_WAIT();
            ota_update<false>((LAS bf16_t*)(lds + L_OTA) + wid * 2048 + r32, wsf, hi, o);
        }
    }
    { NSA_SECT();
        LDS_WAIT();
        bf16_t* ONSA = (bf16_t*)(a.ws + WS_ONSA);
        const LAS bf16_t* stg = (const LAS bf16_t*)(lds + L_OTA) + wid * 2048;
#pragma unroll
        for (int k = 0; k < 4; ++k) { const int row = k * 8 + (lane >> 3), chn = lane & 7; const u32x4 v = *(const LAS u32x4*)(stg + row * 64 + chn * 8);
            const size_t tk = (size_t)b * SEQ + 64 * i + (wid & 1) * 32 + row;
            *(u32x4*)(ONSA + tk * 512 + hk * 256 + g * 64 + chn * 8) = v; }
    }
}
__device__ __forceinline__ void build_bkt(const Ctx& C) {
    LAS unsigned char* bkt = C.lds + att::L_BKT;
    for (int d = C.tid; d < 4096; d += NTHR) bkt[d] = (unsigned char)att::bucket_of(d);
    __syncthreads();
}

typedef const Args __attribute__((address_space(4)))* CArgsP;
__device__ __forceinline__ Args load_args() {
#if defined(__HIP_DEVICE_COMPILE__)
    CArgsP p = (CArgsP)__builtin_amdgcn_kernarg_segment_ptr(); asm volatile("" : "+s"(p)); Args a;
    a.x = p->x; a.c = p->c; a.rel_bias = p->rel_bias; a.ada_w = p->ada_w; a.ada_b = p->ada_b; a.norm1 = p->norm1; a.norm2 = p->norm2; a.w_in = p->w_in;
    a.cmp_pos = p->cmp_pos; a.cmp_w1 = p->cmp_w1; a.cmp_w2 = p->cmp_w2; a.w_up_nsa = p->w_up_nsa; a.w_up_dil = p->w_up_dil; a.w_o = p->w_o;
    a.router_wg = p->router_wg; a.router_bg = p->router_bg; a.router_we = p->router_we; a.router_be = p->router_be; a.exp_w1 = p->exp_w1; a.exp_w3 = p->exp_w3; a.exp_w2 = p->exp_w2; a.norm_f = p->norm_f;
    a.out = p->out; a.ws = p->ws; a.ph_lo = p->ph_lo; a.ph_hi = p->ph_hi; a.use_bar = p->use_bar; a.pad = 0;
    return a;
#else
    return Args{};
#endif
}
#define LOADA() const Args a = load_args()
__global__ void __launch_bounds__(NTHR, 2) fwd_kernel(Args a_) {
    extern __shared__ __attribute__((aligned(16))) unsigned char lds_raw[];
    LAS unsigned char* const lds_base = (LAS unsigned char*)lds_raw;
    const int wave0_ = __builtin_amdgcn_readfirstlane((int)threadIdx.x >> 6);
#define FRESH() Ctx C; { int w_ = wave0_; asm volatile("" : "+s"(w_)); int t_ = lane_id_fresh(); asm volatile("" : "+v"(t_)); t_ += w_ * 64; int g_ = gridDim.x, b_ = blockIdx.x; asm volatile("" : "+s"(g_), "+s"(b_)); \
        C.lds = lds_base; C.tid = t_; C.lane = t_ & 63; C.wave = w_; C.G = g_; C.bx = b_; C.vcu = (g_ % 8 == 0) ? (b_ % 8) * (g_ / 8) + b_ / 8 : b_; }
    volatile LAS unsigned* MISC = (volatile LAS unsigned*)(lds_base + LDS_MISC);
    if (threadIdx.x < 64) MISC[threadIdx.x] = 0u;
    __syncthreads();
    unsigned* ctl = (unsigned*)(a_.ws + WS_CTL);
    XcdBarrier bar; bar.bar = ctl + CW_BAR; bar.x = 0; bar.st = nullptr;
    if (a_.use_bar) bar = xcd_barrier_post(ctl + CW_BAR, MISC + 8);
    const int lo = a_.ph_lo, hi = a_.ph_hi;
#ifndef PH_MASK
#define PH_MASK 0xFFFFFFFFu
#endif
#define IN(k) (((PH_MASK >> ((k) == 0 ? 10 : (k) == 21 ? 11 : (((k) - 1) % 10))) & 1u) && lo <= (k) && (k) < hi)
#define SEAM(k) do { if (IN(k) && IN((k) + 1)) { XcdBarrier b2_ = bar; asm volatile("" : "+s"(b2_.bar)); int w2_ = wave0_; asm volatile("" : "+s"(w2_)); xcd_barrier(b2_, w2_ == 0 && lane_id_fresh() == 0); } } while (0)
    if (IN(0)) { FRESH(); LOADA(); prologue_vectors(a, C); conv_small(a, C); conv_experts(a, C, 0); }
    SEAM(0);
    _Pragma("unroll") for (int l = 0; l < 2; ++l) {
        const int pb = 1 + 10 * l;
        if (IN(pb + 0)) REPEAT(0) { FRESH(); LOADA(); norm1_phase(a, C, l); if (l == 1) conv_experts(a, C, 1); }
        SEAM(pb + 0);
        if (IN(pb + 1)) REPEAT(1) { FRESH(); LOADA(); unsigned char* ws = a.ws;
            pg8::Gemm g{2048u, 2048u, 128u, 1024}; pg8::DenseOrder S; S.init(T, NIN, C.G, C.bx, ws + WS_H, 2048u, ws + WS_WINT + (size_t)l * NIN * DM * 2, 2048u);
            EpiInProj E{(bf16_t*)(ws + WS_A), (bf16_t*)(ws + WS_MG), (float*)(ws + WS_GN)};
            pg8::gemm_phase<EpiInProj, pg8::DenseOrder, true>(C.lds, C.tid, g, S, E);
        }
        SEAM(pb + 1);
        if (IN(pb + 2)) REPEAT(2) { FRESH(); LOADA(); unsigned char* ws = a.ws;
            struct CmpOrder { int c; const char* A; const char* B;
                __device__ __forceinline__ bool next(int i, pg8::Unit& u) const { if (i > 0 || c >= 32) return false; const int kv = c >> 4, b = (c >> 1) & 7, hk = c & 1;
                    u.pm = c; u.pn = 0; u.A = A + ((size_t)b * SEQ * LDQ + 512 + kv * 128 + hk * 64) * 2; u.B = B + (size_t)kv * 256 * 2048 * 2; return true; } };
            pg8::Gemm g{(unsigned)(16 * LDQ * 2), 4096u, (unsigned)(LDQ * 2), 2048};
            CmpOrder S{C.vcu, (const char*)(ws + WS_A), (const char*)(ws + WS_CW1T + (size_t)l * 2 * 256 * 2048 * 2)};
            EpiCmp E{(bf16_t*)(ws + WS_HID), (const float*)(ws + WS_CB1) + l * 512, (const bf16_t*)(ws + WS_CW2T) + (size_t)l * 2 * 64 * 256, (bf16_t*)(ws + WS_KC)};
            pg8::gemm_phase<EpiCmp, CmpOrder, false>(C.lds, C.tid, g, S, E);
            __syncthreads();
            build_bkt(C);
            for (int du = C.vcu; du < 1536; du += C.G) dil_unit(a, C, du);
        }
        SEAM(pb + 2);
        if (IN(pb + 3)) REPEAT(3) { FRESH(); LOADA();
            dil_combine(a, C);
            build_bkt(C);
            for (int v = C.vcu; v < 256; v += C.G) { const int b = v >> 5, hk = (v >> 4) & 1, s = v & 15;
                for (int k = 0; k < 4; ++k) { const int qi = (k == 0) ? s : (k == 1) ? 31 - s : (k == 2) ? 32 + s : 63 - s; nsa_unit(a, C, b, hk, qi); } }
            __syncthreads();
        }
        SEAM(pb + 3);
        if (IN(pb + 4)) REPEAT(4) { FRESH(); LOADA(); unsigned char* ws = a.ws;
            { pg8::Gemm g{1024u, 1024u, 128u, 512}; pg8::DenseOrder S; S.init(T, 1024, C.G, C.bx, ws + WS_ONSA, 1024u, ws + WS_WUNT + (size_t)l * 1024 * 512 * 2, 1024u);
              EpiUp<0> E{(bf16_t*)(ws + WS_MERGED), (const bf16_t*)(ws + WS_MG)};
              pg8::gemm_phase<EpiUp<0>, pg8::DenseOrder, true>(C.lds, C.tid, g, S, E); }
            VM_WAIT(); __syncthreads();
            { pg8::Gemm g{512u, 512u, 128u, 256}; pg8::DenseOrder S; S.init(T, 1024, C.G, C.bx, ws + WS_ODIL, 512u, ws + WS_WUDT + (size_t)l * 1024 * 256 * 2, 512u);
              EpiUp<1> E{(bf16_t*)(ws + WS_MERGED), (const bf16_t*)(ws + WS_MG)};
              pg8::gemm_phase<EpiUp<1>, pg8::DenseOrder, true>(C.lds, C.tid, g, S, E); }
        }
        SEAM(pb + 4);
        if (IN(pb + 5)) REPEAT(5) { FRESH(); LOADA(); unsigned char* ws = a.ws;
            pg8::Gemm g{2048u, 2048u, 128u, 1024}; pg8::DenseOrder S; S.init(T, 1024, C.G, C.bx, ws + WS_MERGED, 2048u, ws + WS_WOT + (size_t)l * 1024 * 1024 * 2, 2048u);
            EpiOut E{l == 0 ? a.x : (const float*)a.out, a.out, (const float*)(ws + WS_MOD) + (size_t)l * 8 * 6144 + 2048};
            pg8::gemm_phase<EpiOut, pg8::DenseOrder, true>(C.lds, C.tid, g, S, E);
        }
        SEAM(pb + 5);
        if (IN(pb + 6)) REPEAT(6) { FRESH(); LOADA(); norm2_router_phase(a, C, l); }
        SEAM(pb + 6);
        if (IN(pb + 7)) REPEAT(7) { FRESH(); LOADA(); moe_scatter_phase(a, C); }
        SEAM(pb + 7);
        if (IN(pb + 8)) REPEAT(8) { FRESH(); LOADA(); unsigned char* ws = a.ws;
            const int* TILEE = (const int*)(ws + WS_TILEE); const int ntl = TILEE[0];
            MoeOrder S; S.G = C.G; S.c = C.vcu; S.nu = ntl * 4; S.A = (const char*)(ws + WS_XS); S.B = (const char*)(ws + WS_E13T); S.tA = (size_t)256 * 2048; S.tB = (size_t)256 * 2048; S.eB = (size_t)1024 * 2048;
#pragma unroll
            for (int i = 0; i < 8; ++i) { const int L = i * C.G + C.vcu; S.ex[i] = (L < S.nu) ? TILEE[16 + (L >> 2)] : 0; }
            pg8::Gemm g{2048u, 2048u, 128u, 1024};
            EpiMoe1 E{(bf16_t*)(ws + WS_ACT)};
            pg8::gemm_phase<EpiMoe1, MoeOrder, true>(C.lds, C.tid, g, S, E);
        }
        SEAM(pb + 8);
        if (IN(pb + 9)) REPEAT(9) { FRESH(); LOADA(); unsigned char* ws = a.ws;
            const int* TILEE = (const int*)(ws + WS_TILEE); const int ntl = TILEE[0];
            MoeOrder S; S.G = C.G; S.c = C.vcu; S.nu = ntl * 4; S.A = (const char*)(ws + WS_ACT); S.B = (const char*)(ws + WS_E2T); S.tA = (size_t)256 * 1024; S.tB = (size_t)256 * 1024; S.eB = (size_t)1024 * 1024;
#pragma unroll
            for (int i = 0; i < 8; ++i) { const int L = i * C.G + C.vcu; S.ex[i] = (L < S.nu) ? TILEE[16 + (L >> 2)] : 0; }
            pg8::Gemm g{1024u, 1024u, 128u, 512};
            EpiPlain E{(bf16_t*)(ws + WS_XS), 1024};
            pg8::gemm_phase<EpiPlain, MoeOrder, true>(C.lds, C.tid, g, S, E);
        }
        SEAM(pb + 9);
    }
    if (IN(21)) { FRESH(); LOADA(); final_phase(a, C); }
#undef IN
#undef SEAM
}

#ifndef ONE_LAUNCH
#define ONE_LAUNCH 1
#endif
extern "C" void kernel_launch(void* const* d_in, const int* in_sizes, int n_in, void* d_out, int out_size, void* d_ws, size_t ws_size, hipStream_t stream) {
    static int grid = 0;
    if (grid == 0) {
        if (n_in != 22 || out_size != T * DM || ws_size < WS_END) { fprintf(stderr, "kernel_launch: unexpected problem (n_in %d out %d ws %zu)\n", n_in, out_size, ws_size); grid = -1; return; }
        int dev = 0, cus = 0;
        if (hipGetDevice(&dev) != hipSuccess || hipDeviceGetAttribute(&cus, hipDeviceAttributeMultiprocessorCount, dev) != hipSuccess) { grid = -1; return; }
        if (hipFuncSetAttribute((const void*)fwd_kernel, hipFuncAttributeMaxDynamicSharedMemorySize, LDS_BYTES) != hipSuccess) { fprintf(stderr, "kernel_launch: hipFuncSetAttribute failed\n"); grid = -1; return; }
        int per_cu = 0;
        if (hipOccupancyMaxActiveBlocksPerMultiprocessor(&per_cu, (const void*)fwd_kernel, NTHR, LDS_BYTES) != hipSuccess || per_cu < 1) { fprintf(stderr, "kernel_launch: occupancy query reports %d\n", per_cu); }
        (void)hipGetLastError();
        grid = cus;
    }
    if (grid < 0) return;
    (void)hipMemsetAsync((char*)d_ws + WS_CTL, 0, CTL_ZERO_BYTES, stream);
    Args a{};
    a.x = (const float*)d_in[0]; a.c = (const float*)d_in[1]; a.rel_bias = (const float*)d_in[2]; a.ada_w = (const float*)d_in[3]; a.ada_b = (const float*)d_in[4];
    a.norm1 = (const float*)d_in[5]; a.norm2 = (const float*)d_in[6]; a.w_in = (const float*)d_in[7]; a.cmp_pos = (const float*)d_in[8]; a.cmp_w1 = (const float*)d_in[9];
    a.cmp_w2 = (const float*)d_in[10]; a.w_up_nsa = (const float*)d_in[11]; a.w_up_dil = (const float*)d_in[12]; a.w_o = (const float*)d_in[13];
    a.router_wg = (const float*)d_in[14]; a.router_bg = (const float*)d_in[15]; a.router_we = (const float*)d_in[16]; a.router_be = (const float*)d_in[17];
    a.exp_w1 = (const float*)d_in[18]; a.exp_w3 = (const float*)d_in[19]; a.exp_w2 = (const float*)d_in[20]; a.norm_f = (const float*)d_in[21];
    a.out = (float*)d_out; a.ws = (unsigned char*)d_ws; a.pad = 0;
#if ONE_LAUNCH
    a.ph_lo = 0; a.ph_hi = NPHASE; a.use_bar = 1;
    hipLaunchKernelGGL(fwd_kernel, dim3(grid), dim3(NTHR), LDS_BYTES, stream, a);
#else
    for (int p = 0; p < NPHASE; ++p) { a.ph_lo = p; a.ph_hi = p + 1; a.use_bar = 0;
        hipLaunchKernelGGL(fwd_kernel, dim3(grid), dim3(NTHR), LDS_BYTES, stream, a); }
#endif
}
```

```cpp
#include <hip/hip_runtime.h>
#include <cstdint>
#include <cstdio>

#define GAS __attribute__((address_space(1)))
#define LAS __attribute__((address_space(3)))
typedef unsigned short bf16_t;
typedef short bf16x8 __attribute__((ext_vector_type(8)));
typedef short s16x4 __attribute__((ext_vector_type(4)));
typedef float f32x4 __attribute__((ext_vector_type(4)));
typedef float f32x2 __attribute__((ext_vector_type(2)));
typedef float f32x16 __attribute__((ext_vector_type(16)));
typedef unsigned u32x4 __attribute__((ext_vector_type(4)));
typedef unsigned u32x2 __attribute__((ext_vector_type(2)));
typedef __bf16 bf16x2_t __attribute__((ext_vector_type(2)));

constexpr int NB = 8, SEQ = 4096, DM = 1024, T = NB * SEQ;
constexpr int LDQ = 3584;
constexpr int NIN = 5888;
constexpr int INW = 5656;
constexpr float LOG2E = 1.4426950408889634f;
constexpr float C2 = 0.125f * LOG2E;
constexpr int NWAVES = 8, NTHR = 512;
constexpr float RMS_EPS = 1e-6f;
constexpr int NPHASE = 22;
#ifndef ABL
#define ABL 0
#endif
#ifndef REP_MASK
#define REP_MASK 0u
#endif
#define REPEAT(k) _Pragma("clang loop unroll(disable)") for (int rep_ = 0; rep_ < (int)((REP_MASK >> (k)) & 1u) + 1; ++rep_)

constexpr size_t MiB = 1u << 20;
constexpr size_t WS_CTL = 0, CTL_ZERO_BYTES = MiB;
constexpr size_t WS_MOD = 1 * MiB;
constexpr size_t WS_CB1 = WS_MOD + 400 * 1024;
constexpr size_t WS_CW2T = WS_MOD + 512 * 1024;
constexpr size_t WS_CNTBLK = WS_MOD + 768 * 1024;
constexpr size_t WS_TILEE = WS_MOD + 832 * 1024;
constexpr size_t WS_WINT = 4 * MiB;
constexpr size_t WS_CW1T = 27 * MiB;
constexpr size_t WS_WUNT = 31 * MiB;
constexpr size_t WS_WUDT = 33 * MiB;
constexpr size_t WS_WOT = 34 * MiB;
constexpr size_t WS_E13T = 38 * MiB;
constexpr size_t WS_E2T = 102 * MiB;
constexpr size_t WS_A = 134 * MiB;
constexpr size_t WS_XS = WS_A;
constexpr size_t WS_ACT = WS_A + 144 * MiB;
constexpr size_t WS_MERGED = WS_A;
constexpr size_t WS_MG = 359 * MiB;
constexpr size_t WS_H2 = WS_MG;
constexpr size_t WS_REC = WS_MG + 64 * MiB;
constexpr size_t WS_DEST = WS_MG + 65 * MiB;
constexpr size_t WS_B = 487 * MiB;
constexpr size_t WS_H = WS_B;
constexpr size_t WS_ONSA = WS_B;
constexpr size_t WS_ODP = WS_B + 32 * MiB;
constexpr size_t WS_LSE = WS_B + 80 * MiB;
constexpr size_t WS_ODIL = WS_B + 82 * MiB;
constexpr size_t WS_GN = WS_B + 98 * MiB;
constexpr size_t WS_KC = WS_B + 102 * MiB;
constexpr size_t WS_HID = WS_B + 103 * MiB;
constexpr size_t WS_END = WS_B + 107 * MiB;

constexpr int CW_TMO = 0, CW_BAR = 4096, CW_Q = 8192;

constexpr int LDS_MISC = 158784;
constexpr int LDS_BYTES = 158784 + 2048;

__device__ __forceinline__ unsigned cvt_pk_bf16(float lo, float hi) { f32x2 v = {lo, hi}; bf16x2_t b = __builtin_convertvector(v, bf16x2_t); return __builtin_bit_cast(unsigned, b); }
__device__ __forceinline__ float bf_lo(unsigned w) { return __uint_as_float(w << 16); }
__device__ __forceinline__ float bf_hi(unsigned w) { return __uint_as_float(w & 0xffff0000u); }
__device__ __forceinline__ float sigmoidf_(float x) { return __builtin_amdgcn_rcpf(1.0f + __builtin_amdgcn_exp2f(-x * LOG2E)); }
__device__ __forceinline__ int lane_id_fresh() { unsigned ones = ~0u; asm volatile("" : "+s"(ones)); return (int)__builtin_amdgcn_mbcnt_hi(ones, __builtin_amdgcn_mbcnt_lo(ones, 0u)); }
template <int X> __device__ __forceinline__ float swz_xor_f(float v) { return __int_as_float(__builtin_amdgcn_ds_swizzle(__float_as_int(v), (X << 10) | 0x1f)); }
template <int X> __device__ __forceinline__ unsigned swz_xor_u(unsigned v) { return (unsigned)__builtin_amdgcn_ds_swizzle((int)v, (X << 10) | 0x1f); }
__device__ __forceinline__ float wave_sum(float v) {
    v += swz_xor_f<1>(v); v += swz_xor_f<2>(v); v += swz_xor_f<4>(v); v += swz_xor_f<8>(v); v += swz_xor_f<16>(v);
    auto rr = __builtin_amdgcn_permlane32_swap(__float_as_uint(v), __float_as_uint(v), false, false);
    return __uint_as_float(rr[0]) + __uint_as_float(rr[1]);
}
__device__ __forceinline__ int bperm_i(int srclane, int v) { return __builtin_amdgcn_ds_bpermute(srclane << 2, v); }
#define LDS_WAIT() asm volatile("s_waitcnt lgkmcnt(0)" ::: "memory")
#define VM_WAIT() asm volatile("s_waitcnt vmcnt(0)" ::: "memory")

#define XB_TMO      128
#define XB_XCNT(j)  (256  + 64 * (j))
#define XB_XSUB(j)  (1280 + 64 * (j))
#define XB_XGEN(j)  (2304 + 64 * (j))
#define XB_TOP      3328
#define XB_TOPGEN   3392
#define XCD_BAR_WORDS 3456
#define XB_SPIN_CAP (1u << 20)
__device__ __forceinline__ unsigned xb_ld(unsigned* p)              { return __hip_atomic_load(p, __ATOMIC_RELAXED, __HIP_MEMORY_SCOPE_AGENT); }
__device__ __forceinline__ unsigned xb_add(unsigned* p, unsigned v) { return __hip_atomic_fetch_add(p, v, __ATOMIC_RELAXED, __HIP_MEMORY_SCOPE_AGENT); }
__device__ __forceinline__ unsigned xb_xcc_id() { return (unsigned)__builtin_amdgcn_s_getreg((3 << 11) | 20) & 0xFu; }
#define XB_SPIN(cond, bar) do { unsigned _sp = 0; while (cond) { __builtin_amdgcn_s_sleep(1); \
    if ((++_sp & 255u) == 0u) { if (xb_ld(&(bar)[XB_TMO])) break; if (_sp > XB_SPIN_CAP) { atomicAdd(&(bar)[XB_TMO], 1u); break; } } } } while (0)
struct XcdBarrier { unsigned* bar; unsigned x; volatile LAS unsigned* st; };
__device__ __forceinline__ XcdBarrier xcd_barrier_post(unsigned* bar, volatile LAS unsigned* st) {
    XcdBarrier b; b.bar = bar; b.x = xb_xcc_id(); b.st = st;
    if (threadIdx.x == 0) (void)xb_add(&bar[XB_XCNT(b.x)], 1u);
    return b;
}
__device__ __forceinline__ void xcd_barrier_complete(unsigned* bar, unsigned x, unsigned& nloc, unsigned& nx) {
    const unsigned G = gridDim.x * gridDim.y * gridDim.z;
    unsigned sum, cnt, mine, sp = 0u;
    for (;;) {
        sum = 0u; cnt = 0u; mine = 0u;
#pragma unroll
        for (unsigned j = 0; j < 16; ++j) { const unsigned c = xb_ld(&bar[XB_XCNT(j)]); sum += c; cnt += (c > 0u) ? 1u : 0u; mine = (j == x) ? c : mine; }
        if (sum == G) break;
        __builtin_amdgcn_s_sleep(1);
        if ((++sp & 255u) == 0u) { if (xb_ld(&bar[XB_TMO])) break; if (sp > XB_SPIN_CAP) { atomicAdd(&bar[XB_TMO], 1u); break; } }
    }
    nloc = mine > 0u ? mine : 1u; nx = cnt > 0u ? cnt : 1u;
}
__device__ __forceinline__ void xcd_barrier(const XcdBarrier& b, const bool leader_thread) {
    asm volatile("s_waitcnt vmcnt(0)" ::: "memory");
    __syncthreads();
    if (leader_thread) {
        unsigned* bar = b.bar;
        __builtin_amdgcn_s_waitcnt(0);
        unsigned nloc = b.st[0], nx = b.st[1];
        if (nloc == 0u) { xcd_barrier_complete(bar, b.x, nloc, nx); b.st[0] = nloc; b.st[1] = nx; }
        const unsigned old = xb_add(&bar[XB_XSUB(b.x)], 1u);
        const unsigned gen = old / nloc;
        if (old + 1u == (gen + 1u) * nloc) {
            __builtin_amdgcn_fence(__ATOMIC_RELEASE, "agent");
            asm volatile("s_waitcnt vmcnt(0)" ::: "memory");
            const unsigned og = xb_add(&bar[XB_TOP], 1u);
            const unsigned tg = og / nx;
            if (og + 1u == (tg + 1u) * nx) xb_add(&bar[XB_TOPGEN], 1u);
            else XB_SPIN(xb_ld(&bar[XB_TOPGEN]) == tg, bar);
            __builtin_amdgcn_fence(__ATOMIC_ACQUIRE, "agent");
            xb_add(&bar[XB_XGEN(b.x)], 1u);
            asm volatile("s_waitcnt vmcnt(0)" ::: "memory");
        } else {
            XB_SPIN(xb_ld(&bar[XB_XGEN(b.x)]) == gen, bar);
            __builtin_amdgcn_fence(__ATOMIC_ACQUIRE, "agent");
            asm volatile("s_waitcnt vmcnt(0)" ::: "memory");
        }
    }
    __syncthreads();
}

namespace pg8 {
constexpr int BM = 256, BK = 64, HALF = 128, HTB = HALF * BK * 2, STAGE_BYTES = 8 * HTB;
__device__ __forceinline__ int lds_byte(int r, int c) { const int st = (r >> 4) * 2 + (c >> 5), rr = r & 15, cc = c & 31, ob = rr * 64 + cc * 2; return st * 1024 + (ob ^ (((ob >> 9) & 1) << 5)); }
__device__ __forceinline__ void stage_rc(int b, int& R, int& C) { const int st = b / 1024, sb = b % 1024, swz = sb ^ (((sb >> 9) & 1) << 5); R = (st >> 1) * 16 + swz / 64; C = (st & 1) * 32 + (swz % 64) / 2; }
__device__ __forceinline__ int perm32(int rho) { const int n = rho >> 4, i = rho & 15; return 8 * (i >> 2) + 4 * n + (i & 3); }

struct Unit { const char* A; const char* B; int pm, pn; };
struct Gemm { unsigned lda, ldb, kstepA; int K; };

template <class Epi, class Sched, bool ALIGN_EPI>
__device__ __forceinline__ void gemm_phase(LAS unsigned char* lds, const int tid, const Gemm g, const Sched& S, const Epi& E) {
    const int wid = __builtin_amdgcn_readfirstlane(tid >> 6), lane = tid & 63, wr = wid >> 2, wc = wid & 3, fr = lane & 15, fq = lane >> 4;
    const int nt = g.K / BK;
    unsigned voffA[2], voffB[2];
#pragma unroll
    for (int i = 0; i < 2; ++i) { int R, C; stage_rc(tid * 16 + i * 8192, R, C); const int Rb = Epi::PERM ? ((R & ~31) + perm32(R & 31)) : R;
        voffA[i] = (unsigned)R * g.lda + (unsigned)C * 2u; voffB[i] = (unsigned)Rb * g.ldb + (unsigned)C * 2u; }
    const size_t kstepA = (size_t)g.kstepA, kstepB = (size_t)(BK * 2);
    const size_t hstepA = (size_t)HALF * g.lda, hstepB = (size_t)HALF * g.ldb;
    const unsigned ldsw = (unsigned)wid * 1024u;
    const int aoff = lds_byte(wr * 64 + fr, fq * 8), boff = lds_byte(wc * 32 + fr, fq * 8);
#define PG8_SA(b, h) (((b) * 2 + (h)) * HTB)
#define PG8_SB(b, h) ((4 + (b) * 2 + (h)) * HTB)
#define PG8_STAGE(bufoff, gbase, voff) do { _Pragma("unroll") for (int _i = 0; _i < 2; ++_i) \
        __builtin_amdgcn_global_load_lds((const unsigned*)((const char*)(gbase) + (voff)[_i]), (LAS unsigned*)(lds + (bufoff) + ldsw + _i * 8192), 16, 0, 0); } while (0)
#define PG8_LDA(dst, b, h) do { _Pragma("unroll") for (int m = 0; m < 4; ++m) _Pragma("unroll") for (int k = 0; k < 2; ++k) dst[m][k] = *(const LAS bf16x8*)(lds + PG8_SA(b, h) + aoff + m * 2048 + k * 1024); } while (0)
#define PG8_LDB(dst, b, h) do { _Pragma("unroll") for (int n = 0; n < 2; ++n) _Pragma("unroll") for (int k = 0; k < 2; ++k) dst[n][k] = *(const LAS bf16x8*)(lds + PG8_SB(b, h) + boff + n * 2048 + k * 1024); } while (0)
#define PG8_MMA(ai, bj, At, Bt) do { __builtin_amdgcn_s_setprio(1); _Pragma("unroll") for (int m = 0; m < 4; ++m) _Pragma("unroll") for (int n = 0; n < 2; ++n) _Pragma("unroll") for (int k = 0; k < 2; ++k) \
        acc[ai][bj][m][n] = __builtin_amdgcn_mfma_f32_16x16x32_bf16(Bt[n][k], At[m][k], acc[ai][bj][m][n], 0, 0, 0); __builtin_amdgcn_s_setprio(0); } while (0)
#define PG8_WAIT_V(n) asm volatile("s_waitcnt vmcnt(" #n ")" ::: "memory")
#define PG8_WAIT_L(n) asm volatile("s_waitcnt lgkmcnt(" #n ")" ::: "memory")
#define PG8_BAR __builtin_amdgcn_s_barrier()
#define PG8_SCHED __builtin_amdgcn_sched_barrier(0)
    Unit cur, nxt; int ui = 0;
    if (!S.next(0, cur)) return;
    f32x4 acc[2][2][4][2];
#pragma unroll
    for (int a = 0; a < 2; ++a)
#pragma unroll
        for (int b = 0; b < 2; ++b)
#pragma unroll
            for (int m = 0; m < 4; ++m)
#pragma unroll
                for (int n = 0; n < 2; ++n) acc[a][b][m][n] = (f32x4){0.f, 0.f, 0.f, 0.f};
    bf16x8 At[4][2], B0[2][2], B1[2][2];
    const char* cA = cur.A; const char* cB = cur.B;
    PG8_STAGE(PG8_SB(0, 0), cB, voffB); PG8_STAGE(PG8_SB(0, 1), cB + hstepB, voffB); PG8_STAGE(PG8_SA(0, 0), cA, voffA); PG8_STAGE(PG8_SA(0, 1), cA + hstepA, voffA);
    if (wr == 1) PG8_BAR;
    PG8_WAIT_V(2); PG8_BAR;
    PG8_STAGE(PG8_SB(1, 0), cB + kstepB, voffB); PG8_STAGE(PG8_SA(1, 0), cA + kstepA, voffA); PG8_STAGE(PG8_SB(1, 1), cB + hstepB + kstepB, voffB);
    PG8_WAIT_V(6); PG8_BAR;
    for (;;) {
        const bool has_next = S.next(ui + 1, nxt);
        const char* nA = has_next ? nxt.A : cA; const char* nB = has_next ? nxt.B : cB;
        for (int t = 0; t < nt; t += 2) {
            const bool last = (t == nt - 2);
            const char* a1 = cA + (size_t)(t + 1) * kstepA;
            const char* a2 = last ? nA : cA + (size_t)(t + 2) * kstepA; const char* b2 = last ? nB : cB + (size_t)(t + 2) * kstepB;
            const char* a3 = a2 + kstepA; const char* b3 = b2 + kstepB;
            PG8_LDB(B0, 0, 0); PG8_LDB(B1, 0, 1); PG8_SCHED; PG8_LDA(At, 0, 0); PG8_STAGE(PG8_SA(1, 1), a1 + hstepA, voffA);
            PG8_WAIT_V(8); PG8_WAIT_L(0); PG8_BAR; PG8_MMA(0, 0, At, B0); PG8_MMA(0, 1, At, B1); PG8_BAR; PG8_SCHED;
            PG8_LDA(At, 0, 1); PG8_STAGE(PG8_SB(0, 0), b2, voffB); PG8_STAGE(PG8_SB(0, 1), b2 + hstepB, voffB); PG8_STAGE(PG8_SA(0, 0), a2, voffA);
            PG8_WAIT_V(8); PG8_WAIT_L(0); PG8_BAR; PG8_MMA(1, 0, At, B0); PG8_MMA(1, 1, At, B1); PG8_BAR; PG8_SCHED;
            PG8_LDB(B0, 1, 0); PG8_LDB(B1, 1, 1); PG8_SCHED; PG8_LDA(At, 1, 0); PG8_STAGE(PG8_SA(0, 1), a2 + hstepA, voffA);
            PG8_WAIT_V(8); PG8_WAIT_L(0); PG8_BAR; PG8_MMA(0, 0, At, B0); PG8_MMA(0, 1, At, B1); PG8_BAR; PG8_SCHED;
            PG8_LDA(At, 1, 1); PG8_STAGE(PG8_SB(1, 0), b3, voffB); PG8_STAGE(PG8_SB(1, 1), b3 + hstepB, voffB); PG8_STAGE(PG8_SA(1, 0), a3, voffA);
            PG8_WAIT_V(8); PG8_WAIT_L(0); PG8_BAR; PG8_MMA(1, 0, At, B0); PG8_MMA(1, 1, At, B1); PG8_BAR; PG8_SCHED;
        }
        if constexpr (ALIGN_EPI) { if (wr == 0) PG8_BAR; }
        if constexpr (!Epi::AFTER_DRAIN) { E(acc, cur, wr, wc, fr, fq); }
        if (!has_next) break;
#pragma unroll
        for (int a = 0; a < 2; ++a)
#pragma unroll
            for (int b = 0; b < 2; ++b)
#pragma unroll
                for (int m = 0; m < 4; ++m)
#pragma unroll
                    for (int n = 0; n < 2; ++n) acc[a][b][m][n] = (f32x4){0.f, 0.f, 0.f, 0.f};
        cur = nxt; cA = nA; cB = nB; ++ui;
        if constexpr (ALIGN_EPI) { if (wr == 1) PG8_BAR; }
    }
    PG8_WAIT_V(0);
    if constexpr (!ALIGN_EPI) { if (wr == 0) PG8_BAR; }
    PG8_BAR;
    if constexpr (Epi::AFTER_DRAIN) { E.fused(acc, cur, wr, wc, fr, fq, wid, lane); }
#undef PG8_SA
#undef PG8_SB
#undef PG8_STAGE
#undef PG8_LDA
#undef PG8_LDB
#undef PG8_MMA
#undef PG8_WAIT_V
#undef PG8_WAIT_L
#undef PG8_BAR
#undef PG8_SCHED
}

struct DenseOrder {
    int nM, nN, nwg, G, c; const char* A; const char* B; size_t tA, tB;
    __device__ __forceinline__ void init(int M, int N, int G_, int c_, const void* A_, unsigned lda, const void* B_, unsigned ldb) {
        nM = M / BM; nN = N / BM; nwg = nM * nN; G = G_; c = c_; A = (const char*)A_; B = (const char*)B_; tA = (size_t)BM * lda; tB = (size_t)BM * ldb; }
    __device__ __forceinline__ bool next(int i, Unit& u) const {
        const long L = (long)i * G + c; if (L >= nwg) return false;
        int wgid = (int)L; { const int q = nwg / 8, r = nwg % 8, xcd = wgid % 8, off = wgid / 8; wgid = (xcd < r ? xcd * (q + 1) : r * (q + 1) + (xcd - r) * q) + off; }
        const int nig = 8 * nN, gid = wgid / nig, fm = gid * 8, gsz = (nM - fm) < 8 ? (nM - fm) : 8;
        u.pm = fm + ((wgid % nig) % gsz); u.pn = (wgid % nig) / gsz;
        u.A = A + (size_t)u.pm * tA; u.B = B + (size_t)u.pn * tB; return true;
    }
};
}

struct Args {
    const float* x; const float* c; const float* rel_bias; const float* ada_w; const float* ada_b; const float* norm1; const float* norm2; const float* w_in;
    const float* cmp_pos; const float* cmp_w1; const float* cmp_w2; const float* w_up_nsa; const float* w_up_dil; const float* w_o;
    const float* router_wg; const float* router_bg; const float* router_we; const float* router_be; const float* exp_w1; const float* exp_w3; const float* exp_w2; const float* norm_f;
    float* out; unsigned char* ws; int ph_lo, ph_hi, use_bar, pad;
};

typedef f32x4 AccT[2][2][4][2];
struct EpiInProj {
    static constexpr bool PERM = true, AFTER_DRAIN = false;
    bf16_t* QKV; bf16_t* MG; float* GN;
    __device__ __forceinline__ void operator()(const AccT& acc, const pg8::Unit& u, int wr, int wc, int fr, int fq) const {
        const int pn = u.pn; const int row0 = u.pm * 256 + wr * 64 + fr;
        if (pn < 14) {
            const float sc = (pn < 2 || (pn >= 5 && pn < 8)) ? C2 : 1.0f;
            const int col0 = pn * 256 + wc * 32 + 8 * fq;
#pragma unroll
            for (int ai = 0; ai < 2; ++ai)
#pragma unroll
                for (int m = 0; m < 4; ++m) { bf16_t* rowp = QKV + (size_t)(row0 + ai * 128 + m * 16) * LDQ + col0;
#pragma unroll
                    for (int bj = 0; bj < 2; ++bj) { const f32x4 v0 = acc[ai][bj][m][0] * sc, v1 = acc[ai][bj][m][1] * sc; u32x4 w;
                        w.x = cvt_pk_bf16(v0[0], v0[1]); w.y = cvt_pk_bf16(v0[2], v0[3]); w.z = cvt_pk_bf16(v1[0], v1[1]); w.w = cvt_pk_bf16(v1[2], v1[3]);
                        *(u32x4*)(rowp + bj * 128) = w; } }
        } else if (pn < 22) {
            const int col0 = (pn - 14) * 256 + wc * 32 + 8 * fq;
#pragma unroll
            for (int ai = 0; ai < 2; ++ai)
#pragma unroll
                for (int m = 0; m < 4; ++m) { bf16_t* rowp = MG + (size_t)(row0 + ai * 128 + m * 16) * 2048 + col0;
#pragma unroll
                    for (int bj = 0; bj < 2; ++bj) { const f32x4 v0 = acc[ai][bj][m][0], v1 = acc[ai][bj][m][1]; u32x4 w;
                        w.x = cvt_pk_bf16(sigmoidf_(v0[0]), sigmoidf_(v0[1])); w.y = cvt_pk_bf16(sigmoidf_(v0[2]), sigmoidf_(v0[3]));
                        w.z = cvt_pk_bf16(sigmoidf_(v1[0]), sigmoidf_(v1[1])); w.w = cvt_pk_bf16(sigmoidf_(v1[2]), sigmoidf_(v1[3]));
                        *(u32x4*)(rowp + bj * 128) = w; } }
        } else {
            if (wc == 0 && fq < 3) {
#pragma unroll
                for (int ai = 0; ai < 2; ++ai)
#pragma unroll
                    for (int m = 0; m < 4; ++m) { float* rowp = GN + (size_t)(row0 + ai * 128 + m * 16) * 32 + 8 * fq;
                        const f32x4 v0 = acc[ai][0][m][0], v1 = acc[ai][0][m][1];
                        *(f32x4*)(rowp) = (f32x4){sigmoidf_(v0[0]), sigmoidf_(v0[1]), sigmoidf_(v0[2]), sigmoidf_(v0[3])};
                        *(f32x4*)(rowp + 4) = (f32x4){sigmoidf_(v1[0]), sigmoidf_(v1[1]), sigmoidf_(v1[2]), sigmoidf_(v1[3])}; }
            }
        }
    }
};
template <int PASS> struct EpiUp {
    static constexpr bool PERM = true, AFTER_DRAIN = false;
    bf16_t* MERGED; const bf16_t* MG;
    __device__ __forceinline__ void operator()(const AccT& acc, const pg8::Unit& u, int wr, int wc, int fr, int fq) const {
        const int row0 = u.pm * 256 + wr * 64 + fr; const int col0 = u.pn * 256 + wc * 32 + 8 * fq;
#pragma unroll
        for (int ai = 0; ai < 2; ++ai)
#pragma unroll
            for (int m = 0; m < 4; ++m) { const size_t row = (size_t)(row0 + ai * 128 + m * 16);
#pragma unroll
                for (int bj = 0; bj < 2; ++bj) {
                    const u32x4 gw = *(const u32x4*)(MG + row * 2048 + PASS * 1024 + col0 + bj * 128);
                    bf16_t* op = MERGED + row * 1024 + col0 + bj * 128;
                    const f32x4 v0 = acc[ai][bj][m][0], v1 = acc[ai][bj][m][1];
                    float r[8] = {v0[0] * bf_lo(gw.x), v0[1] * bf_hi(gw.x), v0[2] * bf_lo(gw.y), v0[3] * bf_hi(gw.y), v1[0] * bf_lo(gw.z), v1[1] * bf_hi(gw.z), v1[2] * bf_lo(gw.w), v1[3] * bf_hi(gw.w)};
                    if (PASS == 1) { const u32x4 ow = *(const u32x4*)op;
                        r[0] += bf_lo(ow.x); r[1] += bf_hi(ow.x); r[2] += bf_lo(ow.y); r[3] += bf_hi(ow.y); r[4] += bf_lo(ow.z); r[5] += bf_hi(ow.z); r[6] += bf_lo(ow.w); r[7] += bf_hi(ow.w); }
                    u32x4 w; w.x = cvt_pk_bf16(r[0], r[1]); w.y = cvt_pk_bf16(r[2], r[3]); w.z = cvt_pk_bf16(r[4], r[5]); w.w = cvt_pk_bf16(r[6], r[7]);
                    *(u32x4*)op = w; }
                asm volatile("" ::: "memory"); }
    }
};
struct EpiOut {
    static constexpr bool PERM = true, AFTER_DRAIN = false;
    const float* xin; float* xout; const float* g1;
    __device__ __forceinline__ void operator()(const AccT& acc, const pg8::Unit& u, int wr, int wc, int fr, int fq) const {
        const int row0 = u.pm * 256 + wr * 64 + fr; const int col0 = u.pn * 256 + wc * 32 + 8 * fq; const int b = u.pm >> 4;
        f32x4 gv[2][2];
#pragma unroll
        for (int bj = 0; bj < 2; ++bj)
#pragma unroll
            for (int n = 0; n < 2; ++n) gv[bj][n] = *(const f32x4*)(g1 + (size_t)b * 6144 + col0 + bj * 128 + 4 * n);
#pragma unroll
        for (int ai = 0; ai < 2; ++ai)
#pragma unroll
            for (int m = 0; m < 4; ++m) { const size_t off = (size_t)(row0 + ai * 128 + m * 16) * 1024 + col0;
#pragma unroll
                for (int bj = 0; bj < 2; ++bj)
#pragma unroll
                    for (int n = 0; n < 2; ++n) { const f32x4 xv = *(const f32x4*)(xin + off + bj * 128 + 4 * n);
                        *(f32x4*)(xout + off + bj * 128 + 4 * n) = (ABL == 7) ? xv : xv + gv[bj][n] * acc[ai][bj][m][n]; }
                asm volatile("" ::: "memory"); }
    }
};
struct EpiMoe1 {
    static constexpr bool PERM = true, AFTER_DRAIN = false;
    bf16_t* ACT;
    __device__ __forceinline__ void operator()(const AccT& acc, const pg8::Unit& u, int wr, int wc, int fr, int fq) const {
        const int row0 = u.pm * 256 + wr * 64 + fr; const int col0 = u.pn * 128 + wc * 32 + 8 * fq;
#pragma unroll
        for (int ai = 0; ai < 2; ++ai)
#pragma unroll
            for (int m = 0; m < 4; ++m) { bf16_t* op = ACT + (size_t)(row0 + ai * 128 + m * 16) * 512 + col0; float r[8];
#pragma unroll
                for (int n = 0; n < 2; ++n)
#pragma unroll
                    for (int j = 0; j < 4; ++j) { const float a = acc[ai][0][m][n][j], bb = acc[ai][1][m][n][j]; r[n * 4 + j] = a * sigmoidf_(a) * bb; }
                u32x4 w; w.x = cvt_pk_bf16(r[0], r[1]); w.y = cvt_pk_bf16(r[2], r[3]); w.z = cvt_pk_bf16(r[4], r[5]); w.w = cvt_pk_bf16(r[6], r[7]);
                *(u32x4*)op = w; }
    }
};
struct EpiPlain {
    static constexpr bool PERM = true, AFTER_DRAIN = false;
    bf16_t* O; int ldc;
    __device__ __forceinline__ void operator()(const AccT& acc, const pg8::Unit& u, int wr, int wc, int fr, int fq) const {
        const int row0 = u.pm * 256 + wr * 64 + fr; const int col0 = u.pn * 256 + wc * 32 + 8 * fq;
#pragma unroll
        for (int ai = 0; ai < 2; ++ai)
#pragma unroll
            for (int m = 0; m < 4; ++m) { bf16_t* rowp = O + (size_t)(row0 + ai * 128 + m * 16) * ldc + col0;
#pragma unroll
                for (int bj = 0; bj < 2; ++bj) { const f32x4 v0 = acc[ai][bj][m][0], v1 = acc[ai][bj][m][1]; u32x4 w;
                    w.x = cvt_pk_bf16(v0[0], v0[1]); w.y = cvt_pk_bf16(v0[2], v0[3]); w.z = cvt_pk_bf16(v1[0], v1[1]); w.w = cvt_pk_bf16(v1[2], v1[3]);
                    *(u32x4*)(rowp + bj * 128) = w; } }
    }
};
__device__ __forceinline__ int crow(int r, int hi) { return (r & 3) + 8 * (r >> 2) + 4 * hi; }
__device__ __forceinline__ float gelu_tanh(float x) { const float u2 = 2.0f * 0.7978845608028654f * (x + 0.044715f * x * x * x); return x * __builtin_amdgcn_rcpf(1.0f + __builtin_amdgcn_exp2f(-u2 * LOG2E)); }
struct EpiCmp {
    static constexpr bool PERM = true, AFTER_DRAIN = true;
    bf16_t* HID; const float* CB1; const bf16_t* CW2T; bf16_t* KC;
    __device__ __forceinline__ void fused(const AccT& acc, const pg8::Unit& u, int wr, int wc, int fr, int fq, int wid, int lane) const {
        const int kv = u.pm >> 4; const int row0 = u.pm * 256 + wr * 64 + fr; const int col0 = wc * 32 + 8 * fq;
        const float* bias = CB1 + kv * 256;
        f32x4 bv[2][2];
#pragma unroll
        for (int bj = 0; bj < 2; ++bj)
#pragma unroll
            for (int n = 0; n < 2; ++n) bv[bj][n] = *(const f32x4*)(bias + col0 + bj * 128 + 4 * n);
#pragma unroll
        for (int ai = 0; ai < 2; ++ai)
#pragma unroll
            for (int m = 0; m < 4; ++m) { bf16_t* rowp = HID + (size_t)(row0 + ai * 128 + m * 16) * 256 + col0;
#pragma unroll
                for (int bj = 0; bj < 2; ++bj) { const f32x4 v0 = acc[ai][bj][m][0] + bv[bj][0], v1 = acc[ai][bj][m][1] + bv[bj][1]; u32x4 w;
                    w.x = cvt_pk_bf16(gelu_tanh(v0[0]), gelu_tanh(v0[1])); w.y = cvt_pk_bf16(gelu_tanh(v0[2]), gelu_tanh(v0[3]));
                    w.z = cvt_pk_bf16(gelu_tanh(v1[0]), gelu_tanh(v1[1])); w.w = cvt_pk_bf16(gelu_tanh(v1[2]), gelu_tanh(v1[3]));
                    *(u32x4*)(rowp + bj * 128) = w; } }
        VM_WAIT(); __syncthreads();
        const int r32 = lane & 31, hi = lane >> 5;
        const bf16_t* ap = HID + (size_t)(u.pm * 256 + 32 * wid + r32) * 256 + hi * 8;
        const bf16_t* bp = CW2T + (size_t)kv * 64 * 256 + (size_t)r32 * 256 + hi * 8;
        f32x16 o0 = {}, o1 = {};
#pragma unroll 4
        for (int ks = 0; ks < 16; ++ks) {
            const bf16x8 a = *(const bf16x8*)(ap + ks * 16);
            const bf16x8 b0 = *(const bf16x8*)(bp + ks * 16), b1 = *(const bf16x8*)(bp + 32 * 256 + ks * 16);
            o0 = __builtin_amdgcn_mfma_f32_32x32x16_bf16(a, b0, o0, 0, 0, 0);
            o1 = __builtin_amdgcn_mfma_f32_32x32x16_bf16(a, b1, o1, 0, 0, 0);
        }
        bf16_t* kc = KC + (size_t)u.pm * 256 * 64;
#pragma unroll
        for (int r = 0; r < 16; ++r) { const int c = 32 * wid + crow(r, hi); const bool pad = (c == 255);
            kc[(size_t)c * 64 + r32] = pad ? (bf16_t)0 : (bf16_t)(cvt_pk_bf16(o0[r], 0.f) & 0xffffu);
            kc[(size_t)c * 64 + 32 + r32] = pad ? (bf16_t)0 : (bf16_t)(cvt_pk_bf16(o1[r], 0.f) & 0xffffu); }
    }
};

namespace att {
constexpr int L_KR = 0;
constexpr int L_VR = 24576;
constexpr int L_WSF = 49152;
constexpr int L_BKT = 51200;
constexpr int L_BKC = 55296;
constexpr int L_TBH = 64000;
constexpr int L_GSH = 64576;
constexpr int L_SEL = 67648;
constexpr int L_OTA = 68672;
constexpr int L_IMP = 101440;
constexpr int L_LUT = 117824;
constexpr int L_END = L_LUT + 40960;
static_assert(L_END <= LDS_MISC, "attention LDS map");

__device__ __forceinline__ void glds16(const void* gsrc, unsigned lds_dst) { unsigned keep;
    asm volatile("s_mov_b32 %0, m0\n\ts_mov_b32 m0, %2\n\ts_nop 0\n\tglobal_load_lds_dwordx4 %1, off\n\ts_mov_b32 m0, %0" : "=&s"(keep) : "v"(gsrc), "s"(lds_dst) : "memory"); }
__device__ __forceinline__ int bucket_of(int d) {
    if (d < 16) return d;
    int b = 16;
    b += (d >= 22); b += (d >= 30); b += (d >= 40); b += (d >= 54); b += (d >= 73); b += (d >= 99); b += (d >= 134); b += (d >= 182);
    b += (d >= 246); b += (d >= 332); b += (d >= 450); b += (d >= 609); b += (d >= 825); b += (d >= 1117); b += (d >= 1513);
    return b;
}
__device__ __forceinline__ void qkt(f32x16& p0, f32x16& p1, const LAS unsigned char* Kslot, const bf16x8 (&qr)[4], int r32, int hi) {
    const LAS unsigned char* kb = Kslot + hi * 1024 + r32 * 16;
    p0 = (f32x16){}; p1 = (f32x16){};
#pragma unroll
    for (int d0 = 0; d0 < 4; ++d0) {
        const bf16x8 b0 = *(const LAS bf16x8*)(kb + d0 * 2048);
        const bf16x8 b1 = *(const LAS bf16x8*)(kb + d0 * 2048 + 512);
        p0 = __builtin_amdgcn_mfma_f32_32x32x16_bf16(b0, qr[d0], p0, 0, 0, 0);
        p1 = __builtin_amdgcn_mfma_f32_32x32x16_bf16(b1, qr[d0], p1, 0, 0, 0);
    }
}
__device__ __forceinline__ void pv(f32x16 (&o)[2], int vb, bf16x8 pa0, bf16x8 pa1, bf16x8 pa2, bf16x8 pa3) {
#pragma unroll
    for (int d0 = 0; d0 < 2; ++d0) { s16x4 lo[4], hi[4];
#pragma unroll
        for (int ks = 0; ks < 4; ++ks) {
            asm volatile("ds_read_b64_tr_b16 %0,%1 offset:%c2" : "=&v"(lo[ks]) : "v"(vb), "i"(d0 * 4096 + ks * 1024) : "memory");
            asm volatile("ds_read_b64_tr_b16 %0,%1 offset:%c2" : "=&v"(hi[ks]) : "v"(vb), "i"(d0 * 4096 + ks * 1024 + 512) : "memory"); }
        asm volatile("s_waitcnt lgkmcnt(0)" ::: "memory"); __builtin_amdgcn_sched_barrier(0);
#define PK(k) (bf16x8){lo[k][0], lo[k][1], lo[k][2], lo[k][3], hi[k][0], hi[k][1], hi[k][2], hi[k][3]}
        o[d0] = __builtin_amdgcn_mfma_f32_32x32x16_bf16(pa0, PK(0), o[d0], 0, 0, 0);
        o[d0] = __builtin_amdgcn_mfma_f32_32x32x16_bf16(pa1, PK(1), o[d0], 0, 0, 0);
        o[d0] = __builtin_amdgcn_mfma_f32_32x32x16_bf16(pa2, PK(2), o[d0], 0, 0, 0);
        o[d0] = __builtin_amdgcn_mfma_f32_32x32x16_bf16(pa3, PK(3), o[d0], 0, 0, 0);
#undef PK
    }
}
__device__ __forceinline__ float xhalf_max(float v) { auto rr = __builtin_amdgcn_permlane32_swap(__float_as_uint(v), __float_as_uint(v), false, false); return __builtin_fmaxf(__uint_as_float(rr[0]), __uint_as_float(rr[1])); }
__device__ __forceinline__ float xhalf_sum(float v) { auto rr = __builtin_amdgcn_permlane32_swap(__float_as_uint(v), __float_as_uint(v), false, false); return __uint_as_float(rr[0]) + __uint_as_float(rr[1]); }

#define ATT_PACK(p0, p1, pw0, pw1, pw2, pw3) do { \
    pw0 = (u32x4){cvt_pk_bf16(p0[0], p0[1]), cvt_pk_bf16(p0[2], p0[3]), cvt_pk_bf16(p0[4], p0[5]), cvt_pk_bf16(p0[6], p0[7])}; \
    pw1 = (u32x4){cvt_pk_bf16(p0[8], p0[9]), cvt_pk_bf16(p0[10], p0[11]), cvt_pk_bf16(p0[12], p0[13]), cvt_pk_bf16(p0[14], p0[15])}; \
    pw2 = (u32x4){cvt_pk_bf16(p1[0], p1[1]), cvt_pk_bf16(p1[2], p1[3]), cvt_pk_bf16(p1[4], p1[5]), cvt_pk_bf16(p1[6], p1[7])}; \
    pw3 = (u32x4){cvt_pk_bf16(p1[8], p1[9]), cvt_pk_bf16(p1[10], p1[11]), cvt_pk_bf16(p1[12], p1[13]), cvt_pk_bf16(p1[14], p1[15])}; } while (0)

__device__ __forceinline__ void stage_rows(LAS unsigned char* lds, int wid, int lane, const f32x16 (&ot)[2]) {
    const int r32 = lane & 31, hi = lane >> 5;
    LAS bf16_t* stg = (LAS bf16_t*)(lds + L_OTA) + wid * 2048;
#pragma unroll
    for (int r = 0; r < 16; ++r) { const int orow = crow(r, hi);
#pragma unroll
        for (int d0 = 0; d0 < 2; ++d0) stg[orow * 64 + d0 * 32 + r32] = (bf16_t)(cvt_pk_bf16(ot[d0][r], 0.f) & 0xffffu); }
    LDS_WAIT();
}
struct StreamP { const bf16_t* Kb; const bf16_t* Vb; long pitch; int NT; const LAS unsigned char* tl; unsigned long long lanesel; int uq; const LAS float* lut; int xtop; int dclamp; };
typedef const LAS unsigned char* lds_cptr;
typedef short v4i16_t __attribute__((ext_vector_type(4)));
__device__ __forceinline__ void kload8(bf16x8* kf, lds_cptr kp) {
    kf[0] = *(const LAS bf16x8*)(kp);        kf[1] = *(const LAS bf16x8*)(kp + 512);
    kf[2] = *(const LAS bf16x8*)(kp + 2048); kf[3] = *(const LAS bf16x8*)(kp + 2560);
    kf[4] = *(const LAS bf16x8*)(kp + 4096); kf[5] = *(const LAS bf16x8*)(kp + 4608);
    kf[6] = *(const LAS bf16x8*)(kp + 6144); kf[7] = *(const LAS bf16x8*)(kp + 6656);
}
__device__ __forceinline__ void kload2(bf16x8* kf, lds_cptr kp, int j) { kf[2 * j] = *(const LAS bf16x8*)(kp + j * 2048); kf[2 * j + 1] = *(const LAS bf16x8*)(kp + j * 2048 + 512); }
__device__ __forceinline__ s16x4 vtr(lds_cptr p) { return __builtin_bit_cast(s16x4, __builtin_amdgcn_ds_read_tr16_b64_v4i16((LAS v4i16_t*)p)); }
constexpr int SLOTB = 8192;
#define ST_WAIT_BAR(N) asm volatile("s_waitcnt vmcnt(" #N ") lgkmcnt(0)\n\ts_barrier" ::: "memory")
template <int THRL>
__device__ __forceinline__ void attn_stream(LAS unsigned char* lds, const int wid, const int lane, const bf16x8 (&qr)[4], const StreamP S, float& mhat_o, float& l_o, f32x16 (&o)[2]) {
    const int r32 = lane & 31, hi = lane >> 5;
    const unsigned lds0 = (unsigned)(uintptr_t)lds;
    LAS float* wsf = (LAS float*)(lds + L_WSF) + wid * 64;
    const int NT = S.NT;
    const bf16_t* ksrc = S.Kb + (long)lane * S.pitch + wid * 8;
    const bf16_t* vsrc = S.Vb + (long)(16 * (wid & 3) + (lane >> 2)) * S.pitch + (wid >> 2) * 32 + (lane & 3) * 8;
    const unsigned kdst = lds0 + L_KR + wid * 1024, vdst = lds0 + L_VR + wid * 1024;
#define TLRAW(k) ((int)__builtin_amdgcn_readfirstlane((int)S.tl[k]))
#define DMA_K(k, slot) do { const int tr_ = TLRAW(k) & 63; glds16(ksrc + (long)tr_ * 64 * S.pitch, (unsigned)__builtin_amdgcn_readfirstlane(kdst + (slot))); } while (0)
#define DMA_V(k, slot) do { const int tr_ = TLRAW(k) & 63; glds16(vsrc + (long)tr_ * 64 * S.pitch, (unsigned)__builtin_amdgcn_readfirstlane(vdst + (slot))); } while (0)
    const lds_cptr kp0 = (lds_cptr)lds + L_KR + hi * 1024 + r32 * 16;
    const lds_cptr vp0 = (lds_cptr)lds + L_VR + ((lane >> 4) & 1) * 32 + (lane & 3) * 8 + (4 * hi + ((lane & 15) >> 2)) * 64;
    const int vb0 = (int)(lds0 + L_VR) + ((lane >> 4) & 1) * 32 + (lane & 3) * 8 + (4 * hi + ((lane & 15) >> 2)) * 64;
    bf16x8 kf[8];
#define LUTLOAD(C0, C1, k) do { const int raw_ = TLRAW(k); const int tj_ = raw_ & 63; int d0_ = S.uq - 64 * tj_ - 4 * hi; d0_ = d0_ < S.dclamp ? d0_ : S.dclamp; \
        const bool ok_ = (raw_ < 128) && (((S.lanesel >> tj_) & 1ull) != 0ull); const LAS float* lp_ = S.lut + (ok_ ? S.xtop - d0_ : S.xtop + 64); \
        _Pragma("unroll") for (int r = 0; r < 16; ++r) { C0[r] = lp_[(r & 3) + 8 * (r >> 2)]; C1[r] = lp_[(r & 3) + 8 * (r >> 2) + 32]; } } while (0)
#define SBAR() __builtin_amdgcn_sched_barrier(0)
#define PIN(x) asm volatile("" : "+v"(x))
#define PKW(P, B) cvt_pk_bf16(P[B], P[B + 1])
#define PAF(k) __builtin_bit_cast(bf16x8, pw##k)
#define VFR(i) (bf16x8){vlo[i][0], vlo[i][1], vlo[i][2], vlo[i][3], vhi[i][0], vhi[i][1], vhi[i][2], vhi[i][3]}
#define MX3(a, b, c) __builtin_fmaxf(__builtin_fmaxf((a), (b)), (c))
#define MFMA32(a, b, c) __builtin_amdgcn_mfma_f32_32x32x16_bf16(a, b, c, 0, 0, 0)
#define GAPA(MF, A0, A1, A2, A3, W0, W1, PW) do { MF; sacc += A0; sacc += A1; sacc += A2; sacc += A3; PIN(sacc); W0; W1; PIN(PW); SBAR(); } while (0)
#define EX(v) __builtin_amdgcn_exp2f(v)
#define GAPB(MF, X, B) do { MF; X[B] = EX(X[B]); X[B + 1] = EX(X[B + 1]); X[B + 2] = EX(X[B + 2]); X[B + 3] = EX(X[B + 3]); PIN(X); SBAR(); } while (0)
#define VRD(i) do { vlo[i] = vtr(vp_ + (((i) >> 2) * 4096 + ((i) & 3) * 1024)); vhi[i] = vtr(vp_ + (((i) >> 2) * 4096 + ((i) & 3) * 1024 + 512)); } while (0)
#define KRD(G, j) do { if (G) { kload2(kf, kp0 + sl_next, j); SBAR(); } } while (0)
#define ROT() do { sl_prev = sl_cur; sl_cur = sl_next; sl_next = (sl_next == 2 * SLOTB) ? 0 : sl_next + SLOTB; } while (0)
#define RESC() do { if (resc) { LDS_WAIT(); _Pragma("unroll") for (int d_ = 0; d_ < 2; ++d_) _Pragma("unroll") for (int r = 0; r < 16; ++r) o[d_][r] *= wsf[crow(r, hi)]; } } while (0)
#define ENDW(tt) do { if ((tt) + 3 < NT) { ST_WAIT_BAR(2); } else if ((tt) + 2 < NT) { ST_WAIT_BAR(1); } else { ST_WAIT_BAR(0); } } while (0)
#define STEP(C0, C1, P0, P1, t, GK, GV, GL) do { SBAR(); \
    const lds_cptr vp_ = vp0 + sl_prev; \
    VRD(0); SBAR(); float sacc = (P0[0] + P0[1]); \
    GAPA(C0 = MFMA32(kf[0], qr[0], C0), P0[2], P0[3], P0[4], P0[5],     pw0[0] = PKW(P0, 0), pw0[1] = PKW(P0, 2), pw0); \
    VRD(4); SBAR(); GAPA(C1 = MFMA32(kf[1], qr[0], C1), P0[6], P0[7], P0[8], P0[9],     pw0[2] = PKW(P0, 4), pw0[3] = PKW(P0, 6), pw0); \
    VRD(1); SBAR(); GAPA(C0 = MFMA32(kf[2], qr[1], C0), P0[10], P0[11], P0[12], P0[13], pw1[0] = PKW(P0, 8), pw1[1] = PKW(P0, 10), pw1); \
    VRD(5); SBAR(); GAPA(C1 = MFMA32(kf[3], qr[1], C1), P0[14], P0[15], P1[0], P1[1],   pw1[2] = PKW(P0, 12), pw1[3] = PKW(P0, 14), pw1); \
    VRD(2); SBAR(); GAPA(C0 = MFMA32(kf[4], qr[2], C0), P1[2], P1[3], P1[4], P1[5],     pw2[0] = PKW(P1, 0), pw2[1] = PKW(P1, 2), pw2); \
    VRD(6); SBAR(); GAPA(C1 = MFMA32(kf[5], qr[2], C1), P1[6], P1[7], P1[8], P1[9],     pw2[2] = PKW(P1, 4), pw2[3] = PKW(P1, 6), pw2); \
    VRD(3); SBAR(); GAPA(C0 = MFMA32(kf[6], qr[3], C0), P1[10], P1[11], P1[12], P1[13], pw3[0] = PKW(P1, 8), pw3[1] = PKW(P1, 10), pw3); \
    VRD(7); SBAR(); GAPA(C1 = MFMA32(kf[7], qr[3], C1), P1[14], P1[15], 0.f, 0.f,       pw3[2] = PKW(P1, 12), pw3[3] = PKW(P1, 14), pw3); \
    l_reg += sacc; \
    if (GK) { DMA_K((t) + 3, sl_cur); } if (GV) { DMA_V((t) + 1, sl_next); } \
    { _Pragma("unroll") for (int r = 0; r < 16; ++r) { C0[r] -= mhat; C1[r] -= mhat; } \
      float a_ = MX3(C0[0], C0[1], C1[0]), b_ = MX3(C0[2], C0[3], C1[1]); a_ = MX3(a_, C1[2], C1[3]); \
      _Pragma("unroll") for (int r = 4; r < 16; r += 4) { a_ = MX3(a_, C0[r], C0[r + 1]); b_ = MX3(b_, C0[r + 2], C0[r + 3]); a_ = MX3(a_, C1[r], C1[r + 1]); b_ = MX3(b_, C1[r + 2], C1[r + 3]); } \
      float rm = xhalf_max(__builtin_fmaxf(a_, b_)); \
      resc = false; \
      if (__builtin_expect(__any(rm > (float)THRL), 0)) { const float dl = __builtin_fmaxf(rm, 0.f); mhat += dl; \
        _Pragma("unroll") for (int r = 0; r < 16; ++r) { C0[r] -= dl; C1[r] -= dl; } \
        const float f = __builtin_amdgcn_exp2f(-dl); l_reg *= f; if (hi == 0) wsf[r32] = f; resc = true; } } \
    SBAR(); \
    GAPB(o[0] = MFMA32(PAF(0), VFR(0), o[0]), C0, 0); \
    GAPB(o[1] = MFMA32(PAF(0), VFR(4), o[1]), C0, 4); \
    KRD(GL, 0); GAPB(o[0] = MFMA32(PAF(1), VFR(1), o[0]), C0, 8); \
    KRD(GL, 1); GAPB(o[1] = MFMA32(PAF(1), VFR(5), o[1]), C0, 12); \
    KRD(GL, 2); GAPB(o[0] = MFMA32(PAF(2), VFR(2), o[0]), C1, 0); \
    KRD(GL, 3); GAPB(o[1] = MFMA32(PAF(2), VFR(6), o[1]), C1, 4); \
    GAPB(o[0] = MFMA32(PAF(3), VFR(3), o[0]), C1, 8); \
    GAPB(o[1] = MFMA32(PAF(3), VFR(7), o[1]), C1, 12); \
    } while (0)
    float mhat = 0.f, l_reg = 0.f; bool resc = false;
    o[0] = (f32x16){}; o[1] = (f32x16){};
    f32x16 pA0, pA1, pB0, pB1;
    int sl_prev = 0, sl_cur = 0, sl_next = SLOTB;
    DMA_K(0, 0); DMA_V(0, 0); DMA_K(1, SLOTB); DMA_K(2, 2 * SLOTB);
    LUTLOAD(pA0, pA1, 0);
    ST_WAIT_BAR(3);
    { const lds_cptr kb = kp0;
#pragma unroll
      for (int d0 = 0; d0 < 4; ++d0) { const bf16x8 b0 = *(const LAS bf16x8*)(kb + d0 * 2048); const bf16x8 b1 = *(const LAS bf16x8*)(kb + d0 * 2048 + 512);
          pA0 = MFMA32(b0, qr[d0], pA0); pA1 = MFMA32(b1, qr[d0], pA1); }
      float rm = pA0[0];
#pragma unroll
      for (int r = 1; r < 16; ++r) rm = __builtin_fmaxf(rm, pA0[r]);
#pragma unroll
      for (int r = 0; r < 16; ++r) rm = __builtin_fmaxf(rm, pA1[r]);
      rm = xhalf_max(rm);
      mhat = (rm == -INFINITY) ? 0.f : rm;
#pragma unroll
      for (int r = 0; r < 16; ++r) { pA0[r] = EX(pA0[r] - mhat); pA1[r] = EX(pA1[r] - mhat); } }
    ST_WAIT_BAR(0);
    DMA_K(3, 0); DMA_V(1, SLOTB);
    ROT();
    kload8(kf, kp0 + sl_cur);
    LUTLOAD(pB0, pB1, 1);
    ST_WAIT_BAR(2);
    s16x4 vlo[8], vhi[8]; u32x4 pw0, pw1, pw2, pw3;
    int t = 1;
    for (; t + 1 < NT; t += 2) {
        STEP(pB0, pB1, pA0, pA1, t, (t + 3 < NT), (t + 1 < NT), (t + 1 < NT));       LUTLOAD(pA0, pA1, t + 1); ENDW(t);     RESC(); ROT();
        STEP(pA0, pA1, pB0, pB1, t + 1, (t + 4 < NT), (t + 2 < NT), (t + 2 < NT));   LUTLOAD(pB0, pB1, t + 2); ENDW(t + 1); RESC(); ROT();
    }
    STEP(pB0, pB1, pA0, pA1, NT - 1, false, false, false); RESC();
    { float sacc = pB0[0] + pB0[1];
#pragma unroll
      for (int r = 2; r < 16; ++r) sacc += pB0[r];
#pragma unroll
      for (int r = 0; r < 16; ++r) sacc += pB1[r];
      l_reg += sacc;
      ATT_PACK(pB0, pB1, pw0, pw1, pw2, pw3);
      SBAR(); pv(o, vb0 + sl_cur, PAF(0), PAF(1), PAF(2), PAF(3)); }
    asm volatile("s_waitcnt lgkmcnt(0)\n\ts_barrier" ::: "memory");
    mhat_o = mhat; l_o = l_reg;
#undef TLRAW
#undef DMA_K
#undef DMA_V
#undef LUTLOAD
#undef SBAR
#undef PIN
#undef PKW
#undef PAF
#undef VFR
#undef MX3
#undef MFMA32
#undef GAPA
#undef EX
#undef GAPB
#undef VRD
#undef KRD
#undef ROT
#undef RESC
#undef ENDW
#undef STEP
}
__device__ __forceinline__ void cmp_scores(f32x16& s0, f32x16& s1, LAS unsigned char* lds, const LAS unsigned char* bkc, const LAS unsigned char* tb, const bf16x8 (&qr)[4], const int k, const int r32, const int hi) {
#pragma unroll
    for (int r = 0; r < 16; ++r) { const int off = 16 * ((r & 3) + 8 * (r >> 2));
        s0[r] = *(const LAS float*)(tb + bkc[1024 * k + off]); s1[r] = *(const LAS float*)(tb + bkc[1024 * k + off + 512]); }
    const LAS unsigned char* kb = lds + k * 8192 + hi * 1024 + r32 * 16;
#pragma unroll
    for (int d0 = 0; d0 < 4; ++d0) { const bf16x8 b0 = *(const LAS bf16x8*)(kb + d0 * 2048); const bf16x8 b1 = *(const LAS bf16x8*)(kb + d0 * 2048 + 512);
        s0 = __builtin_amdgcn_mfma_f32_32x32x16_bf16(b0, qr[d0], s0, 0, 0, 0); s1 = __builtin_amdgcn_mfma_f32_32x32x16_bf16(b1, qr[d0], s1, 0, 0, 0); }
}
__device__ __forceinline__ float xhalf_other(float v, int hi) { auto rr = __builtin_amdgcn_permlane32_swap(__float_as_uint(v), __float_as_uint(v), false, false); return __uint_as_float(hi ? rr[0] : rr[1]); }
__device__ __forceinline__ void cmp_branch(LAS unsigned char* lds, const int wid, const int lane, const bf16x8 (&qr)[4], const bf16_t* Kb, const bf16_t* Vb, const int nt, const int t, f32x16 (&o)[2]) {
    const int r32 = lane & 31, hi = lane >> 5, g = wid >> 1, tq = (wid & 1) * 32 + r32;
    const unsigned lds0 = (unsigned)(uintptr_t)lds;
    { const bf16_t* ksrc = Kb + (long)lane * 64 + wid * 8; const bf16_t* vsrc = Vb + (long)(16 * (wid & 3) + (lane >> 2)) * 64 + (wid >> 2) * 32 + (lane & 3) * 8;
      for (int k = 0; k < nt; ++k) { glds16(ksrc + (long)k * 4096, (unsigned)__builtin_amdgcn_readfirstlane(lds0 + k * 8192 + wid * 1024));
                                     glds16(vsrc + (long)k * 4096, (unsigned)__builtin_amdgcn_readfirstlane(lds0 + L_OTA + k * 8192 + wid * 1024)); } }
    const LAS unsigned char* bkc = lds + L_BKC + (4126 - t + 64 * hi);
    const LAS unsigned char* tb = lds + L_TBH + g * 144;
    asm volatile("s_waitcnt vmcnt(0)\n\ts_barrier" ::: "memory");
    float m = -INFINITY, l = 0.f;
#pragma clang loop unroll(disable)
    for (int k = 0; k < nt; ++k) { f32x16 s0, s1; cmp_scores(s0, s1, lds, bkc, tb, qr, k, r32, hi);
        float rm = s0[0];
#pragma unroll
        for (int r = 1; r < 16; ++r) rm = __builtin_fmaxf(rm, s0[r]);
#pragma unroll
        for (int r = 0; r < 16; ++r) rm = __builtin_fmaxf(rm, s1[r]);
        rm = xhalf_max(rm);
        const float mn = __builtin_fmaxf(m, rm), ms = (mn == -INFINITY) ? 0.f : mn;
        float ps = 0.f;
#pragma unroll
        for (int r = 0; r < 16; ++r) ps += __builtin_amdgcn_exp2f(s0[r] - ms) + __builtin_amdgcn_exp2f(s1[r] - ms);
        l = l * __builtin_amdgcn_exp2f(m - ms) + ps; m = mn; }
    l = xhalf_sum(l);
    const float msafe = (m == -INFINITY) ? 0.f : m, inv = l > 0.f ? 1.0f / l : 0.f;
    float I[4][8]; float pc7 = 0.f;
    o[0] = (f32x16){}; o[1] = (f32x16){};
    const int vb0 = (int)(lds0 + L_OTA) + ((lane >> 4) & 1) * 32 + (lane & 3) * 8 + (4 * hi + ((lane & 15) >> 2)) * 64;
#pragma unroll
    for (int k = 0; k < 4; ++k) {
        if (k < nt) { f32x16 s0, s1; cmp_scores(s0, s1, lds, bkc, tb, qr, k, r32, hi);
#pragma unroll
            for (int r = 0; r < 16; ++r) { s0[r] = __builtin_amdgcn_exp2f(s0[r] - msafe) * inv; s1[r] = __builtin_amdgcn_exp2f(s1[r] - msafe) * inv; }
            float pc[8];
#pragma unroll
            for (int q = 0; q < 4; ++q) { I[k][q] = 2.0f * (s0[4 * q] + s0[4 * q + 1] + s0[4 * q + 2]) + s0[4 * q + 3]; I[k][4 + q] = 2.0f * (s1[4 * q] + s1[4 * q + 1] + s1[4 * q + 2]) + s1[4 * q + 3];
                pc[q] = xhalf_other(s0[4 * q + 3], hi); pc[4 + q] = xhalf_other(s1[4 * q + 3], hi); }
#pragma unroll
            for (int j = 0; j < 8; ++j) I[k][j] += hi ? pc[j] : (j > 0 ? pc[j - 1] : pc7);
            pc7 = pc[7];
            u32x4 pw0, pw1, pw2, pw3; ATT_PACK(s0, s1, pw0, pw1, pw2, pw3);
            pv(o, vb0 + k * 8192, __builtin_bit_cast(bf16x8, pw0), __builtin_bit_cast(bf16x8, pw1), __builtin_bit_cast(bf16x8, pw2), __builtin_bit_cast(bf16x8, pw3));
        } else {
#pragma unroll
            for (int j = 0; j < 8; ++j) I[k][j] = 0.f;
        }
    }
    LAS float* imp = (LAS float*)(lds + L_IMP) + tq * 64 + hi;
#pragma unroll 1
    for (int gi = 0; gi < 4; ++gi) {
        if (g == gi) {
#pragma unroll
            for (int k = 0; k < 4; ++k) if (k < nt) {
#pragma unroll
                for (int j = 0; j < 8; ++j) __builtin_amdgcn_ds_faddf(imp + 16 * k + 2 * j, I[k][j], 0, 0, false);
            }
        }
        asm volatile("s_waitcnt lgkmcnt(0)\n\ts_barrier" ::: "memory");
    }
}
}

struct Ctx { int tid, lane, wave, vcu, G, bx; LAS unsigned char* lds; };

__device__ __forceinline__ void tr_item(const float* W, size_t ldw, int srccol, int nvalid, bf16_t* WT, size_t ldk, int dstrow, int k0, LAS float* scr, int lane) {
#pragma unroll 8
    for (int i = 0; i < 32; ++i) { const int kk = 2 * i + (lane >> 5), n = lane & 31; scr[kk * 33 + n] = (n < nvalid) ? W[(size_t)(k0 + kk) * ldw + srccol + n] : 0.f; }
    LDS_WAIT(); asm volatile("" ::: "memory");
    const int c = lane & 7;
#pragma unroll
    for (int j = 0; j < 4; ++j) { const int n = (lane >> 3) + 8 * j; const LAS float* s = scr + (8 * c) * 33 + n;
        u32x4 o; o.x = cvt_pk_bf16(s[0 * 33], s[1 * 33]); o.y = cvt_pk_bf16(s[2 * 33], s[3 * 33]); o.z = cvt_pk_bf16(s[4 * 33], s[5 * 33]); o.w = cvt_pk_bf16(s[6 * 33], s[7 * 33]);
        *(u32x4*)(WT + (size_t)(dstrow + n) * ldk + k0 + 8 * c) = o; }
    LDS_WAIT(); asm volatile("" ::: "memory");
}
__device__ __forceinline__ void conv_small(const Args& a, const Ctx& C) {
    LAS float* scr = (LAS float*)(C.lds + C.wave * 16384);
    const int gw = C.vcu * NWAVES + C.wave, NGW = C.G * NWAVES;
    constexpr int I_WIN = 184 * 16, I_CW1 = 2 * 8 * 32, I_WUN = 32 * 8, I_WUD = 32 * 4, I_WO = 32 * 16, I_CW2 = 2 * 2 * 4;
    constexpr int PER = I_WIN + I_CW1 + I_WUN + I_WUD + I_WO + I_CW2;
    unsigned char* ws = a.ws;
    for (int it = gw; it < 2 * PER; it += NGW) {
        const int l = it / PER; int r = it % PER;
        if (r < I_WIN) { const int nb = r / 16, kb = r % 16; const int nd = 32 * nb; int src, nv = 32;
            if (nd < 1280) src = nd; else if (nd < 5632) src = nd + 24; else if (nd == 5632) { src = 1280; nv = 24; } else { src = 0; nv = 0; }
            tr_item(a.w_in + (size_t)l * DM * INW, INW, src, nv, (bf16_t*)(ws + WS_WINT) + (size_t)l * NIN * DM, DM, nd, 64 * kb, scr, C.lane); continue; }
        r -= I_WIN;
        if (r < I_CW1) { const int kv = r / 256, q = r % 256, nb = q / 32, kb = q % 32;
            tr_item(a.cmp_w1 + (size_t)(l * 2 + kv) * 2048 * 256, 256, 32 * nb, 32, (bf16_t*)(ws + WS_CW1T) + (size_t)(l * 2 + kv) * 256 * 2048, 2048, 32 * nb, 64 * kb, scr, C.lane); continue; }
        r -= I_CW1;
        if (r < I_WUN) { const int nb = r / 8, kb = r % 8;
            tr_item(a.w_up_nsa + (size_t)l * 512 * 1024, 1024, 32 * nb, 32, (bf16_t*)(ws + WS_WUNT) + (size_t)l * 1024 * 512, 512, 32 * nb, 64 * kb, scr, C.lane); continue; }
        r -= I_WUN;
        if (r < I_WUD) { const int nb = r / 4, kb = r % 4;
            tr_item(a.w_up_dil + (size_t)l * 256 * 1024, 1024, 32 * nb, 32, (bf16_t*)(ws + WS_WUDT) + (size_t)l * 1024 * 256, 256, 32 * nb, 64 * kb, scr, C.lane); continue; }
        r -= I_WUD;
        if (r < I_WO) { const int nb = r / 16, kb = r % 16;
            tr_item(a.w_o + (size_t)l * 1024 * 1024, 1024, 32 * nb, 32, (bf16_t*)(ws + WS_WOT) + (size_t)l * 1024 * 1024, 1024, 32 * nb, 64 * kb, scr, C.lane); continue; }
        r -= I_WO;
        { const int kv = r / 8, q = r % 8, nb = q / 4, kb = q % 4;
            tr_item(a.cmp_w2 + (size_t)(l * 2 + kv) * 256 * 64, 64, 32 * nb, 32, (bf16_t*)(ws + WS_CW2T) + (size_t)(l * 2 + kv) * 64 * 256, 256, 32 * nb, 64 * kb, scr, C.lane); }
    }
}
__device__ __forceinline__ void conv_experts(const Args& a, const Ctx& C, int l) {
    LAS float* scr = (LAS float*)(C.lds + C.wave * 16384);
    const int gw = C.vcu * NWAVES + C.wave, NGW = C.G * NWAVES;
    constexpr int I_13 = 32 * 16, I_2 = 32 * 8, PER = I_13 + I_2;
    unsigned char* ws = a.ws;
    for (int it = gw; it < 32 * PER; it += NGW) {
        const int e = it / PER; int r = it % PER;
        if (r < I_13) { const int nb = r / 16, kb = r % 16; const int r0 = 32 * nb, pn = r0 >> 8, bj = (r0 >> 7) & 1, j0 = r0 & 127;
            const float* src = (bj ? a.exp_w3 : a.exp_w1) + (size_t)(l * 32 + e) * 1024 * 512;
            tr_item(src, 512, pn * 128 + j0, 32, (bf16_t*)(ws + WS_E13T) + (size_t)e * 1024 * 1024, 1024, r0, 64 * kb, scr, C.lane); continue; }
        r -= I_13;
        { const int nb = r / 8, kb = r % 8;
            tr_item(a.exp_w2 + (size_t)(l * 32 + e) * 512 * 1024, 1024, 32 * nb, 32, (bf16_t*)(ws + WS_E2T) + (size_t)e * 1024 * 512, 512, 32 * nb, 64 * kb, scr, C.lane); }
    }
}
__device__ __forceinline__ void prologue_vectors(const Args& a, const Ctx& C) {
    LAS float* sc = (LAS float*)(C.lds + 131072);
    LAS float* sl = (LAS float*)(C.lds);
    for (int i = C.tid; i < 8 * 1024; i += NTHR) { const float v = a.c[i]; sl[i] = v * sigmoidf_(v); }
    (void)sc;
    __syncthreads();
    const int gw = C.vcu * NWAVES + C.wave, NGW = C.G * NWAVES;
    float* MOD = (float*)(a.ws + WS_MOD); float* CB1 = (float*)(a.ws + WS_CB1);
    for (int it = gw; it < 192 + 16; it += NGW) {
        if (it < 192) { const int l = it / 96, col = (it % 96) * 64 + C.lane;
            const float* w = a.ada_w + (size_t)l * 1024 * 6144 + col;
            float acc[8];
#pragma unroll
            for (int b = 0; b < 8; ++b) acc[b] = 0.f;
            for (int k = 0; k < 1024; ++k) { const float wv = w[(size_t)k * 6144];
#pragma unroll
                for (int b = 0; b < 8; ++b) acc[b] += sl[b * 1024 + k] * wv; }
            const float bias = a.ada_b[l * 6144 + col];
#pragma unroll
            for (int b = 0; b < 8; ++b) MOD[(size_t)(l * 8 + b) * 6144 + col] = acc[b] + bias;
        } else { const int q = it - 192, lk = q / 4, col = (q % 4) * 64 + C.lane;
            const float* w = a.cmp_w1 + (size_t)lk * 2048 * 256 + col; const float* pos = a.cmp_pos + (size_t)lk * 2048;
            float acc = 0.f;
            for (int k = 0; k < 2048; ++k) acc += pos[k] * w[(size_t)k * 256];
            CB1[lk * 256 + col] = acc;
        }
    }
    __syncthreads();
}

__device__ __forceinline__ void moe_combine_row(const Args& a, int row, int lane, const float* g2  , f32x4 (&v)[4]) {
    const u32x4 rec = *(const u32x4*)(a.ws + WS_DEST + (size_t)row * 16);
    const bf16_t* Y = (const bf16_t*)(a.ws + WS_XS);
    const float w0 = (ABL == 6) ? 0.f : __uint_as_float(rec.z), w1 = (ABL == 6) ? 0.f : __uint_as_float(rec.w);
    const u32x2* y0 = (const u32x2*)(Y + (size_t)rec.x * 1024) + lane; const u32x2* y1 = (const u32x2*)(Y + (size_t)rec.y * 1024) + lane;
#pragma unroll
    for (int j = 0; j < 4; ++j) { const u32x2 p = y0[64 * j], q = y1[64 * j]; const f32x4 gg = *((const f32x4*)g2 + lane + 64 * j);
        v[j][0] += gg[0] * (w0 * bf_lo(p.x) + w1 * bf_lo(q.x)); v[j][1] += gg[1] * (w0 * bf_hi(p.x) + w1 * bf_hi(q.x));
        v[j][2] += gg[2] * (w0 * bf_lo(p.y) + w1 * bf_lo(q.y)); v[j][3] += gg[3] * (w0 * bf_hi(p.y) + w1 * bf_hi(q.y)); }
}
__device__ __forceinline__ void norm1_phase(const Args& a, const Ctx& C, int l) {
    const int gw = C.vcu * NWAVES + C.wave, NGW = C.G * NWAVES;
    const float* MOD = (const float*)(a.ws + WS_MOD); bf16_t* H = (bf16_t*)(a.ws + WS_H);
    const float* nw = a.norm1 + l * 1024;
    for (int row = gw; row < T; row += NGW) {
        const int b = row >> 12; const float* xr = (l == 0 ? a.x : (const float*)a.out) + (size_t)row * 1024;
        f32x4 v[4];
#pragma unroll
        for (int j = 0; j < 4; ++j) v[j] = *((const f32x4*)xr + C.lane + 64 * j);
        if (l == 1) { moe_combine_row(a, row, C.lane, MOD + (size_t)(0 * 8 + b) * 6144 + 5120, v);
#pragma unroll
            for (int j = 0; j < 4; ++j) *((f32x4*)(a.out + (size_t)row * 1024) + C.lane + 64 * j) = v[j]; }
        float ss = 0.f;
#pragma unroll
        for (int j = 0; j < 4; ++j) ss += (v[j][0] * v[j][0] + v[j][1] * v[j][1]) + (v[j][2] * v[j][2] + v[j][3] * v[j][3]);
        const float rstd = 1.0f / sqrtf(wave_sum(ss) * (1.0f / 1024.0f) + RMS_EPS);
        const float* mb = MOD + (size_t)(l * 8 + b) * 6144;
#pragma unroll
        for (int j = 0; j < 4; ++j) { const f32x4 g = *((const f32x4*)nw + C.lane + 64 * j), sh = *((const f32x4*)mb + C.lane + 64 * j), sc = *((const f32x4*)(mb + 1024) + C.lane + 64 * j);
            const f32x4 h = v[j] * rstd * g * (sc + 1.0f) + sh; u32x2 w; w.x = cvt_pk_bf16(h[0], h[1]); w.y = cvt_pk_bf16(h[2], h[3]);
            *((u32x2*)(H + (size_t)row * 1024) + C.lane + 64 * j) = w; }
    }
}
__device__ __forceinline__ void final_phase(const Args& a, const Ctx& C) {
    const int gw = C.vcu * NWAVES + C.wave, NGW = C.G * NWAVES;
    const float* MOD = (const float*)(a.ws + WS_MOD);
    for (int row = gw; row < T; row += NGW) {
        const int b = row >> 12; float* xr = a.out + (size_t)row * 1024;
        f32x4 v[4];
#pragma unroll
        for (int j = 0; j < 4; ++j) v[j] = *((const f32x4*)xr + C.lane + 64 * j);
        moe_combine_row(a, row, C.lane, MOD + (size_t)(1 * 8 + b) * 6144 + 5120, v);
        float ss = 0.f;
#pragma unroll
        for (int j = 0; j < 4; ++j) ss += (v[j][0] * v[j][0] + v[j][1] * v[j][1]) + (v[j][2] * v[j][2] + v[j][3] * v[j][3]);
        const float rstd = 1.0f / sqrtf(wave_sum(ss) * (1.0f / 1024.0f) + RMS_EPS);
#pragma unroll
        for (int j = 0; j < 4; ++j) { const f32x4 g = *((const f32x4*)a.norm_f + C.lane + 64 * j); *((f32x4*)xr + C.lane + 64 * j) = v[j] * rstd * g; }
    }
}
__device__ __forceinline__ void norm2_router_phase(const Args& a, const Ctx& C, int l) {
    LAS float* WL = (LAS float*)(C.lds);
    LAS int* wcnt = (LAS int*)(C.lds + LDS_MISC + 256);
    const float* wg = a.router_wg + (size_t)l * 1024 * 4; const float* we = a.router_we + (size_t)l * 1024 * 32;
    for (int i = C.tid; i < 1024 * 4; i += NTHR) { const int k = i >> 2, c = i & 3; WL[c * 1024 + k] = wg[i]; }
    for (int i = C.tid; i < 1024 * 32; i += NTHR) { const int k = i >> 5, c = i & 31; WL[(4 + c) * 1024 + k] = we[i]; }
    __syncthreads();
    const float* MOD = (const float*)(a.ws + WS_MOD); bf16_t* H2 = (bf16_t*)(a.ws + WS_H2);
    const float* nw = a.norm2 + l * 1024; const float* bg = a.router_bg + l * 4; const float* be = a.router_be + l * 32;
    int* CNTBLK = (int*)(a.ws + WS_CNTBLK);
    for (int ch = C.vcu; ch < T / 128; ch += C.G) {
        int my_e0 = 0, my_e1 = 0; float my_w0 = 0.f, my_w1 = 0.f;
        for (int j = 0; j < 16; ++j) {
            const int row = ch * 128 + C.wave * 16 + j; const int b = row >> 12;
            const float* xr = a.out + (size_t)row * 1024;
            f32x4 v[4];
#pragma unroll
            for (int q = 0; q < 4; ++q) v[q] = *((const f32x4*)xr + C.lane + 64 * q);
            float ss = 0.f;
#pragma unroll
            for (int q = 0; q < 4; ++q) ss += (v[q][0] * v[q][0] + v[q][1] * v[q][1]) + (v[q][2] * v[q][2] + v[q][3] * v[q][3]);
            const float rstd = 1.0f / sqrtf(wave_sum(ss) * (1.0f / 1024.0f) + RMS_EPS);
            const float* mb = MOD + (size_t)(l * 8 + b) * 6144 + 3072;
#pragma unroll
            for (int q = 0; q < 4; ++q) { const f32x4 g = *((const f32x4*)nw + C.lane + 64 * q), sh = *((const f32x4*)mb + C.lane + 64 * q), sc = *((const f32x4*)(mb + 1024) + C.lane + 64 * q);
                v[q] = v[q] * rstd * g * (sc + 1.0f) + sh; u32x2 w; w.x = cvt_pk_bf16(v[q][0], v[q][1]); w.y = cvt_pk_bf16(v[q][2], v[q][3]);
                *((u32x2*)(H2 + (size_t)row * 1024) + C.lane + 64 * q) = w; }
            float lg[4];
#pragma unroll
            for (int c = 0; c < 4; ++c) { float s = 0.f;
#pragma unroll
                for (int q = 0; q < 4; ++q) { const f32x4 w = *((const LAS f32x4*)(WL + c * 1024) + C.lane + 64 * q); s += (v[q][0] * w[0] + v[q][1] * w[1]) + (v[q][2] * w[2] + v[q][3] * w[3]); }
                lg[c] = wave_sum(s) + bg[c]; }
            int grp = 0; float gmax = lg[0];
#pragma unroll
            for (int c = 1; c < 4; ++c) if (lg[c] > gmax) { gmax = lg[c]; grp = c; }
            float gs = 0.f;
#pragma unroll
            for (int c = 0; c < 4; ++c) gs += __builtin_amdgcn_exp2f((lg[c] - gmax) * LOG2E);
            const float pgrp = 1.0f / gs;
            grp = __builtin_amdgcn_readfirstlane(grp);
            float le[8];
#pragma unroll
            for (int e = 0; e < 8; ++e) { float s = 0.f; const LAS float* wrow = WL + (4 + grp * 8 + e) * 1024;
#pragma unroll
                for (int q = 0; q < 4; ++q) { const f32x4 w = *((const LAS f32x4*)wrow + C.lane + 64 * q); s += (v[q][0] * w[0] + v[q][1] * w[1]) + (v[q][2] * w[2] + v[q][3] * w[3]); }
                le[e] = wave_sum(s) + be[grp * 8 + e]; }
            int i0 = 0; float v0 = le[0];
#pragma unroll
            for (int e = 1; e < 8; ++e) if (le[e] > v0) { v0 = le[e]; i0 = e; }
            int i1 = -1; float v1 = -INFINITY;
#pragma unroll
            for (int e = 0; e < 8; ++e) if (e != i0 && le[e] > v1) { v1 = le[e]; i1 = e; }
            const float ex = __builtin_amdgcn_exp2f((v1 - v0) * LOG2E);
            const float w0 = pgrp / (1.0f + ex), w1 = pgrp * ex / (1.0f + ex);
            if (C.lane == j) { my_e0 = grp * 8 + i0; my_e1 = grp * 8 + i1; my_w0 = w0; my_w1 = w1; }
        }
        const int ea = bperm_i(C.lane >> 1, my_e0), eb = bperm_i(C.lane >> 1, my_e1);
        const int es = (C.lane < 32) ? ((C.lane & 1) ? eb : ea) : -1;
        int rank = 0, cnt = 0;
#pragma unroll
        for (int s = 0; s < 32; ++s) { const int v = __builtin_amdgcn_readlane(es, s); rank += (v == es && s < C.lane) ? 1 : 0; cnt += (v == C.lane) ? 1 : 0; }
        __syncthreads();
        if (C.lane < 32) wcnt[C.wave * 32 + C.lane] = cnt;
        __syncthreads();
        int lrank = rank;
        if (C.lane < 32) { for (int w = 0; w < C.wave; ++w) lrank += wcnt[w * 32 + es]; }
        if (C.wave == 0 && C.lane < 32) { int tot = 0;
#pragma unroll
            for (int w = 0; w < 8; ++w) tot += wcnt[w * 32 + C.lane];
            CNTBLK[ch * 32 + C.lane] = tot; }
        const int lr0 = bperm_i((2 * C.lane) & 63, lrank), lr1 = bperm_i((2 * C.lane + 1) & 63, lrank);
        if (C.lane < 16) { const int row = ch * 128 + C.wave * 16 + C.lane;
            u32x4 rec; rec.x = (unsigned)my_e0 | ((unsigned)my_e1 << 8); rec.y = (unsigned)lr0 | ((unsigned)lr1 << 16); rec.z = __float_as_uint(my_w0); rec.w = __float_as_uint(my_w1);
            *(u32x4*)(a.ws + WS_REC + (size_t)row * 16) = rec; }
    }
}
__device__ __forceinline__ void moe_scatter_phase(const Args& a, const Ctx& C) {
    LAS int* part_lt = (LAS int*)(C.lds);
    LAS int* part_all = part_lt + 512;
    LAS int* base = part_all + 512;
    LAS int* tot = base + 32;
    LAS int* pst = tot + 32;
    const int* CNTBLK = (const int*)(a.ws + WS_CNTBLK);
    int* TILEE = (int*)(a.ws + WS_TILEE);
    const bf16_t* H2 = (const bf16_t*)(a.ws + WS_H2); bf16_t* XS = (bf16_t*)(a.ws + WS_XS);
    for (int ch = C.vcu; ch < T / 128; ch += C.G) {
        __syncthreads();
        { const int e = C.tid & 31, p = C.tid >> 5; int slt = 0, sall = 0;
            for (int c = p; c < T / 128; c += 16) { const int v = CNTBLK[c * 32 + e]; sall += v; slt += (c < ch) ? v : 0; }
            part_lt[p * 32 + e] = slt; part_all[p * 32 + e] = sall; }
        __syncthreads();
        if (C.tid < 32) { int b = 0, t2 = 0;
#pragma unroll
            for (int p = 0; p < 16; ++p) { b += part_lt[p * 32 + C.tid]; t2 += part_all[p * 32 + C.tid]; }
            base[C.tid] = b; tot[C.tid] = t2; }
        __syncthreads();
        if (C.tid < 32) { int ps = 0; for (int e = 0; e < C.tid; ++e) ps += (tot[e] + 255) & ~255; pst[C.tid] = ps;
            if (ch == 0) { const int nt = (tot[C.tid] + 255) >> 8; const int t0 = ps >> 8; for (int m = 0; m < nt; ++m) TILEE[16 + t0 + m] = C.tid; if (C.tid == 31) TILEE[0] = t0 + nt; } }
        __syncthreads();
        int d0 = 0, d1 = 0;
        if (C.lane < 16) { const int row = ch * 128 + C.wave * 16 + C.lane;
            const u32x4 rec = *(const u32x4*)(a.ws + WS_REC + (size_t)row * 16);
            const int e0 = rec.x & 255, e1 = (rec.x >> 8) & 255;
            d0 = pst[e0] + base[e0] + (int)(rec.y & 0xffffu); d1 = pst[e1] + base[e1] + (int)(rec.y >> 16);
            u32x4 o; o.x = (unsigned)d0; o.y = (unsigned)d1; o.z = rec.z; o.w = rec.w;
            *(u32x4*)(a.ws + WS_DEST + (size_t)row * 16) = o; }
        for (int j = 0; j < 16; ++j) { const int row = ch * 128 + C.wave * 16 + j;
            const int t0 = __builtin_amdgcn_readlane(d0, j), t1 = __builtin_amdgcn_readlane(d1, j);
            const u32x4* src = (const u32x4*)(H2 + (size_t)row * 1024) + C.lane;
            const u32x4 va = src[0], vb = src[64];
            u32x4* o0 = (u32x4*)(XS + (size_t)t0 * 1024) + C.lane; u32x4* o1 = (u32x4*)(XS + (size_t)t1 * 1024) + C.lane;
            o0[0] = va; o0[64] = vb; o1[0] = va; o1[64] = vb; }
    }
}
struct MoeOrder {
    int G, c, nu; int ex[8]; const char* A; const char* B; size_t tA, tB, eB;
    __device__ __forceinline__ bool next(int i, pg8::Unit& u) const {
        const int L = i * G + c; if (i >= 8 || L >= nu) return false;
        const int e = i == 0 ? ex[0] : i == 1 ? ex[1] : i == 2 ? ex[2] : i == 3 ? ex[3] : i == 4 ? ex[4] : i == 5 ? ex[5] : i == 6 ? ex[6] : ex[7];
        u.pm = L >> 2; u.pn = L & 3; u.A = A + (size_t)u.pm * tA; u.B = B + (size_t)e * eB + (size_t)u.pn * tB; return true;
    }
};

__device__ __forceinline__ void dil_unit(const Args& a, const Ctx& C, int du) {
    using namespace att;
    LAS unsigned char* lds = C.lds;
    const int x = du & 15; int r = du >> 4; const int h = r & 3; r >>= 2; const int grp = r % 3, b = r / 3;
    const int dsh = 2 * grp, d = 1 << dsh; const int nub = 16 >> dsh; const int res = x / nub, ub = x % nub;
    const int wid = C.wave, lane = C.lane, r32 = lane & 31, hi = lane >> 5;
    LAS float* lut = (LAS float*)(lds + L_LUT);
    LAS unsigned char* tl = lds + L_SEL + 768;
    __syncthreads();
    for (int e = C.tid; e < 704; e += NTHR) { const int m = 384 - e; float v = -INFINITY;
        if (m >= 0 && m <= 128) { int di = m << dsh; di = di > 4095 ? 4095 : di; v = a.rel_bias[(int)lds[L_BKT + di] * 20 + 8 + grp * 4 + h] * LOG2E; }
        lut[e] = v; }
    if (C.tid < 6) { const int kt = 4 * ub - 2 + C.tid; tl[C.tid] = (unsigned char)(kt < 0 ? 0x80 : kt); }
    const bf16_t* QKV = (const bf16_t*)(a.ws + WS_A);
    const int u = 256 * ub + 32 * wid + r32; const size_t tokq = (size_t)b * SEQ + (size_t)u * d + res;
    const bf16_t* qp = QKV + tokq * LDQ + 1280 + grp * 256 + h * 64;
    bf16x8 qr[4];
#pragma unroll
    for (int d0 = 0; d0 < 4; ++d0) qr[d0] = *(const bf16x8*)(qp + d0 * 16 + hi * 8);
    __syncthreads();
    StreamP S; S.Kb = QKV + ((size_t)b * SEQ + res) * LDQ + 1280 + 768 + grp * 256 + h * 64; S.Vb = S.Kb + 768; S.pitch = (long)d * LDQ;
    S.NT = 6; S.tl = tl; S.lanesel = ~0ull; S.uq = u; S.lut = lut; S.xtop = 384; S.dclamp = 1 << 30;
    float m = 0.f, l = 0.f; f32x16 o[2];
    attn_stream<8>(lds, wid, lane, qr, S, m, l, o);
    l = xhalf_sum(l);
    LAS float* wsf = (LAS float*)(lds + L_WSF) + wid * 64;
    if (hi == 0) { wsf[r32] = l > 0.f ? 1.0f / l : 0.f; ((float*)(a.ws + WS_LSE))[((size_t)grp * T + tokq) * 4 + h] = m + __builtin_amdgcn_logf(l); }
    LDS_WAIT();
#pragma unroll
    for (int rr = 0; rr < 16; ++rr) { const float f = wsf[crow(rr, hi)]; o[0][rr] *= f; o[1][rr] *= f; }
    stage_rows(lds, wid, lane, o);
    bf16_t* ODP = (bf16_t*)(a.ws + WS_ODP) + (size_t)grp * T * 256;
    const LAS bf16_t* stg = (const LAS bf16_t*)(lds + L_OTA) + wid * 2048;
#pragma unroll
    for (int i = 0; i < 4; ++i) { const int row = i * 8 + (lane >> 3), chn = lane & 7; const u32x4 v = *(const LAS u32x4*)(stg + row * 64 + chn * 8);
        const size_t tok = (size_t)b * SEQ + (size_t)(256 * ub + 32 * wid + row) * d + res;
        *(u32x4*)(ODP + tok * 256 + h * 64 + chn * 8) = v; }
}
__device__ __forceinline__ void dil_combine(const Args& a, const Ctx& C) {
    const float* LSE = (const float*)(a.ws + WS_LSE); const bf16_t* ODP = (const bf16_t*)(a.ws + WS_ODP); bf16_t* ODIL = (bf16_t*)(a.ws + WS_ODIL);
    const int gt = C.vcu * NTHR + C.tid, NT = C.G * NTHR;
    for (int idx = gt; idx < T * 32; idx += NT) {
        const int tok = idx >> 5, h = (idx >> 3) & 3, chn = idx & 7;
        const float l0 = LSE[((size_t)0 * T + tok) * 4 + h], l1 = LSE[((size_t)1 * T + tok) * 4 + h], l2 = LSE[((size_t)2 * T + tok) * 4 + h];
        const float mx = __builtin_fmaxf(l0, __builtin_fmaxf(l1, l2));
        float w0 = __builtin_amdgcn_exp2f(l0 - mx), w1 = __builtin_amdgcn_exp2f(l1 - mx), w2 = __builtin_amdgcn_exp2f(l2 - mx);
        const float inv = 1.0f / (w0 + w1 + w2); w0 *= inv; w1 *= inv; w2 *= inv;
        const size_t off = (size_t)tok * 256 + h * 64 + chn * 8;
        const u32x4 a0 = *(const u32x4*)(ODP + off), a1 = *(const u32x4*)(ODP + (size_t)T * 256 + off), a2 = *(const u32x4*)(ODP + (size_t)2 * T * 256 + off);
        u32x4 o;
        o.x = cvt_pk_bf16(w0 * bf_lo(a0.x) + w1 * bf_lo(a1.x) + w2 * bf_lo(a2.x), w0 * bf_hi(a0.x) + w1 * bf_hi(a1.x) + w2 * bf_hi(a2.x));
        o.y = cvt_pk_bf16(w0 * bf_lo(a0.y) + w1 * bf_lo(a1.y) + w2 * bf_lo(a2.y), w0 * bf_hi(a0.y) + w1 * bf_hi(a1.y) + w2 * bf_hi(a2.y));
        o.z = cvt_pk_bf16(w0 * bf_lo(a0.z) + w1 * bf_lo(a1.z) + w2 * bf_lo(a2.z), w0 * bf_hi(a0.z) + w1 * bf_hi(a1.z) + w2 * bf_hi(a2.z));
        o.w = cvt_pk_bf16(w0 * bf_lo(a0.w) + w1 * bf_lo(a1.w) + w2 * bf_lo(a2.w), w0 * bf_hi(a0.w) + w1 * bf_hi(a1.w) + w2 * bf_hi(a2.w));
        if (ABL == 4) o = (u32x4){0u, 0u, 0u, 0u};
        *(u32x4*)(ODIL + off) = o;
    }
}
template <bool INIT>
__device__ __forceinline__ void ota_update(LAS bf16_t* ota  , const LAS float* frow, int hi, const f32x16 (&o)[2]) {
#pragma unroll
    for (int r = 0; r < 16; ++r) { const int row = crow(r, hi); const float f = frow[row];
        float v0 = f * o[0][r], v1 = f * o[1][r];
        if (!INIT) { v0 += __uint_as_float((unsigned)ota[row * 64] << 16); v1 += __uint_as_float((unsigned)ota[row * 64 + 32] << 16); }
        ota[row * 64] = (bf16_t)(cvt_pk_bf16(v0, 0.f) & 0xffffu); ota[row * 64 + 32] = (bf16_t)(cvt_pk_bf16(v1, 0.f) & 0xffffu); }
}
#define NSA_SECT() const int lane = lane_id_fresh(); const int tid = wid * 64 + lane; const int r32 = lane & 31, hi = lane >> 5; (void)tid; (void)r32; (void)hi
__device__ __forceinline__ void nsa_unit(const Args& a, const Ctx& C, int b, int hk, int i) {
    using namespace att;
    LAS unsigned char* lds = C.lds;
    const int wid = C.wave; const int g = wid >> 1;
    const bf16_t* QKV = (const bf16_t*)(a.ws + WS_A);
    bf16x8 qr[4];
    f32x16 o[2];
    __syncthreads();
    { NSA_SECT();
        const int tq = (wid & 1) * 32 + r32, t = 64 * i + tq; const size_t tok = (size_t)b * SEQ + t;
        LAS float* imp = (LAS float*)(lds + L_IMP); LAS float* gsh = (LAS float*)(lds + L_GSH) + wid * 96; LAS unsigned* selw = (LAS unsigned*)(lds + L_SEL);
        for (int e = tid; e < 64 * 64; e += NTHR) imp[e] = 0.f;
        if (tid < 2) selw[128 + tid] = 0u;
        if (hi == 0) { const float* gn = (const float*)(a.ws + WS_GN) + tok * 32 + hk * 4 + g;
            gsh[r32] = (ABL == 1) ? 0.f : gn[0]; gsh[32 + r32] = (ABL == 2) ? 0.f : gn[8]; gsh[64 + r32] = (ABL == 3) ? 0.f : gn[16]; }
        const bf16_t* qp = QKV + tok * LDQ + hk * 256 + g * 64;
#pragma unroll
        for (int d0 = 0; d0 < 4; ++d0) qr[d0] = *(const bf16x8*)(qp + d0 * 16 + hi * 8);
        __syncthreads();
        const bf16_t* KC = (const bf16_t*)(a.ws + WS_KC);
        cmp_branch(lds, wid, lane, qr, KC + (size_t)((0 * 8 + b) * 2 + hk) * 256 * 64, KC + (size_t)((1 * 8 + b) * 2 + hk) * 256 * 64, (4 * i + 2) / 64 + 1, t, o);
        ota_update<true>((LAS bf16_t*)(lds + L_OTA) + wid * 2048 + r32, gsh, hi, o);
    }
    __syncthreads();
    { NSA_SECT();
        LAS float* impP = (LAS float*)(lds + L_IMP); LAS unsigned* selw = (LAS unsigned*)(lds + L_SEL);
        const int q = tid >> 3, part = tid & 7;
        const int ncand = i - 2 > 0 ? i - 2 : 0; const int nforced = i + 1 < 3 ? i + 1 : 3; const int krem = 16 - nforced;
        unsigned bits = 0u;
        if (ncand > krem && ABL != 5) {
            float vn[8]; int cn[8];
#pragma unroll
            for (int e = 0; e < 8; ++e) { vn[e] = impP[q * 64 + part * 8 + e]; cn[e] = 0; }
            for (int mm = 1; mm <= i - 2; ++mm) { const float xv = impP[q * 64 + mm];
#pragma unroll
                for (int e = 0; e < 8; ++e) { const int n = part * 8 + e; cn[e] += (xv > vn[e] || (xv == vn[e] && mm < n)) ? 1 : 0; } }
#pragma unroll
            for (int e = 0; e < 8; ++e) { const int n = part * 8 + e; if (n >= 1 && n <= i - 2 && cn[e] < krem) bits |= 1u << e; }
        } else {
#pragma unroll
            for (int e = 0; e < 8; ++e) { const int n = part * 8 + e; if (n >= 1 && n <= i - 2) bits |= 1u << e; }
        }
#pragma unroll
        for (int e = 0; e < 8; ++e) { const int n = part * 8 + e; if (n == 0 || n == i || n == i - 1) bits |= 1u << e; }
        unsigned lo = part < 4 ? bits << (8 * part) : 0u, hi2 = part >= 4 ? bits << (8 * (part - 4)) : 0u;
        lo |= swz_xor_u<1>(lo); hi2 |= swz_xor_u<1>(hi2); lo |= swz_xor_u<2>(lo); hi2 |= swz_xor_u<2>(hi2); lo |= swz_xor_u<4>(lo); hi2 |= swz_xor_u<4>(hi2);
        if (part == 0) { selw[2 * q] = lo; selw[2 * q + 1] = hi2; atomicOr((unsigned*)&selw[128], lo); atomicOr((unsigned*)&selw[129], hi2); }
    }
    __syncthreads();
    int NTS, NTW;
    { NSA_SECT();
        LAS unsigned* selw = (LAS unsigned*)(lds + L_SEL);
        LAS unsigned char* tls = lds + L_SEL + 768; LAS unsigned char* tlw = lds + L_SEL + 848;
        const unsigned long long uni = ((unsigned long long)(unsigned)__builtin_amdgcn_readfirstlane((int)selw[129]) << 32) | (unsigned)__builtin_amdgcn_readfirstlane((int)selw[128]);
        const int nsel = __builtin_popcountll(uni); const int nts = (nsel + 1) & ~1; NTS = nts < 4 ? 4 : nts;
        const int jlo = i - 8 < 0 ? 0 : i - 8; const int nwin = i - jlo + 1; const int ntw = (nwin + 1) & ~1; NTW = ntw < 4 ? 4 : ntw;
        if (tid < 64) { if ((uni >> tid) & 1ull) tls[__builtin_popcountll(uni & ((1ull << tid) - 1ull))] = (unsigned char)tid; }
        else if (tid < 72) { const int k = nsel + (tid - 64); if (k < NTS) tls[k] = 0x80; }
        else if (tid < 88) { const int k = tid - 72; if (k < NTW) tlw[k] = (unsigned char)(k < nwin ? jlo + k : 0x80); }
    }
    __syncthreads();
#pragma clang loop unroll(disable)
    for (int br = 0; br < 2; ++br) {
        float m = 0.f, l = 0.f;
        { NSA_SECT();
            const int tq = (wid & 1) * 32 + r32, t = 64 * i + tq;
            LAS unsigned* selw = (LAS unsigned*)(lds + L_SEL); LAS float* lut = (LAS float*)(lds + L_LUT);
            StreamP S; S.Kb = QKV + (size_t)b * SEQ * LDQ + 512 + 256 + br * 256 + hk * 64; S.Vb = S.Kb + 128; S.pitch = LDQ;
            S.NT = br ? NTW : NTS; S.tl = lds + L_SEL + (br ? 848 : 768); S.uq = t;
            S.lanesel = br ? ~0ull : (((unsigned long long)selw[2 * tq + 1] << 32) | selw[2 * tq]);
            S.lut = br ? lut + 7168 + g * 768 : lut + g * 1792; S.xtop = br ? 640 : 1636; S.dclamp = br ? (1 << 30) : 1636;
            attn_stream<8>(lds, wid, lane, qr, S, m, l, o);
        }
        { NSA_SECT();
            LAS float* gsh = (LAS float*)(lds + L_GSH) + wid * 96; LAS float* wsf = (LAS float*)(lds + L_WSF) + wid * 64;
            l = xhalf_sum(l);
            LDS_WAIT();
            if (hi == 0) wsf[r32] = (l > 0.f ? 1.0f / l : 0.f) * gsh[32 + br * 32 + r32];
            LDS_WAIT();
            ota_update<false>((LAS bf16_t*)(lds + L_OTA) + wid * 2048 + r32, wsf, hi, o);
        }
    }
    { NSA_SECT();
        LDS_WAIT();
        bf16_t* ONSA = (bf16_t*)(a.ws + WS_ONSA);
        const LAS bf16_t* stg = (const LAS bf16_t*)(lds + L_OTA) + wid * 2048;
#pragma unroll
        for (int k = 0; k < 4; ++k) { const int row = k * 8 + (lane >> 3), chn = lane & 7; const u32x4 v = *(const LAS u32x4*)(stg + row * 64 + chn * 8);
            const size_t tk = (size_t)b * SEQ + 64 * i + (wid & 1) * 32 + row;
            *(u32x4*)(ONSA + tk * 512 + hk * 256 + g * 64 + chn * 8) = v; }
    }
}
__device__ __forceinline__ void build_bkt(const Ctx& C) {
    LAS unsigned char* bkt = C.lds + att::L_BKT; LAS unsigned char* bkc = C.lds + att::L_BKC;
    for (int d = C.tid; d < 4096; d += NTHR) bkt[d] = (unsigned char)att::bucket_of(d);
    for (int x = C.tid; x < 8704; x += NTHR) { const int dist = 4095 - x; bkc[x] = (unsigned char)(dist < 0 ? 128 : 4 * att::bucket_of(dist)); }
    __syncthreads();
}
__device__ __forceinline__ void build_nsa_tables(const Args& a, const Ctx& C, int hk) {
    using namespace att;
    LAS float* tbh = (LAS float*)(C.lds + L_TBH); LAS float* lut = (LAS float*)(C.lds + L_LUT);
    __syncthreads();
    if (C.tid < 144) { const int gg = C.tid / 36, bk = C.tid % 36; tbh[C.tid] = bk < 32 ? a.rel_bias[bk * 20 + hk * 4 + gg] * LOG2E : -INFINITY; }
    __syncthreads();
    for (int e = C.tid; e < 4 * 1792; e += NTHR) { const int gg = e / 1792, xx = e % 1792; const int dist = 1636 - xx;
        lut[e] = dist < 0 ? -INFINITY : tbh[gg * 36 + (int)C.lds[L_BKT + dist]]; }
    for (int e = C.tid; e < 4 * 768; e += NTHR) { const int gg = e / 768, xx = e % 768; const int dist = 640 - xx;
        lut[7168 + e] = (dist < 0 || dist > 512) ? -INFINITY : tbh[gg * 36 + (int)C.lds[L_BKT + dist]]; }
    __syncthreads();
}

typedef const Args __attribute__((address_space(4)))* CArgsP;
__device__ __forceinline__ Args load_args() {
#if defined(__HIP_DEVICE_COMPILE__)
    CArgsP p = (CArgsP)__builtin_amdgcn_kernarg_segment_ptr(); asm volatile("" : "+s"(p)); Args a;
    a.x = p->x; a.c = p->c; a.rel_bias = p->rel_bias; a.ada_w = p->ada_w; a.ada_b = p->ada_b; a.norm1 = p->norm1; a.norm2 = p->norm2; a.w_in = p->w_in;
    a.cmp_pos = p->cmp_pos; a.cmp_w1 = p->cmp_w1; a.cmp_w2 = p->cmp_w2; a.w_up_nsa = p->w_up_nsa; a.w_up_dil = p->w_up_dil; a.w_o = p->w_o;
    a.router_wg = p->router_wg; a.router_bg = p->router_bg; a.router_we = p->router_we; a.router_be = p->router_be; a.exp_w1 = p->exp_w1; a.exp_w3 = p->exp_w3; a.exp_w2 = p->exp_w2; a.norm_f = p->norm_f;
    a.out = p->out; a.ws = p->ws; a.ph_lo = p->ph_lo; a.ph_hi = p->ph_hi; a.use_bar = p->use_bar; a.pad = 0;
    return a;
#else
    return Args{};
#endif
}
#define LOADA() const Args a = load_args()
__global__ void __launch_bounds__(NTHR, 2) fwd_kernel(Args a_) {
    extern __shared__ __attribute__((aligned(16))) unsigned char lds_raw[];
    LAS unsigned char* const lds_base = (LAS unsigned char*)lds_raw;
    const int wave0_ = __builtin_amdgcn_readfirstlane((int)threadIdx.x >> 6);
#define FRESH() Ctx C; { int w_ = wave0_; asm volatile("" : "+s"(w_)); int t_ = lane_id_fresh(); asm volatile("" : "+v"(t_)); t_ += w_ * 64; int g_ = gridDim.x, b_ = blockIdx.x; asm volatile("" : "+s"(g_), "+s"(b_)); \
        C.lds = lds_base; C.tid = t_; C.lane = t_ & 63; C.wave = w_; C.G = g_; C.bx = b_; C.vcu = (g_ % 8 == 0) ? (b_ % 8) * (g_ / 8) + b_ / 8 : b_; }
    volatile LAS unsigned* MISC = (volatile LAS unsigned*)(lds_base + LDS_MISC);
    if (threadIdx.x < 64) MISC[threadIdx.x] = 0u;
    __syncthreads();
    unsigned* ctl = (unsigned*)(a_.ws + WS_CTL);
    XcdBarrier bar; bar.bar = ctl + CW_BAR; bar.x = 0; bar.st = nullptr;
    if (a_.use_bar) bar = xcd_barrier_post(ctl + CW_BAR, MISC + 8);
    const int lo = a_.ph_lo, hi = a_.ph_hi;
#ifndef PH_MASK
#define PH_MASK 0xFFFFFFFFu
#endif
#define IN(k) (((PH_MASK >> ((k) == 0 ? 10 : (k) == 21 ? 11 : (((k) - 1) % 10))) & 1u) && lo <= (k) && (k) < hi)
#define SEAM(k) do { if (IN(k) && IN((k) + 1)) { XcdBarrier b2_ = bar; asm volatile("" : "+s"(b2_.bar)); int w2_ = wave0_; asm volatile("" : "+s"(w2_)); xcd_barrier(b2_, w2_ == 0 && lane_id_fresh() == 0); } } while (0)
    if (IN(0)) REPEAT(10) { FRESH(); LOADA(); prologue_vectors(a, C); conv_small(a, C); conv_experts(a, C, 0); }
    SEAM(0);
    _Pragma("unroll") for (int l = 0; l < 2; ++l) {
        const int pb = 1 + 10 * l;
        if (IN(pb + 0)) REPEAT(0) { FRESH(); LOADA(); norm1_phase(a, C, l); if (l == 1) conv_experts(a, C, 1); }
        SEAM(pb + 0);
        if (IN(pb + 1)) REPEAT(1) { FRESH(); LOADA(); unsigned char* ws = a.ws;
            pg8::Gemm g{2048u, 2048u, 128u, 1024}; pg8::DenseOrder S; S.init(T, NIN, C.G, C.bx, ws + WS_H, 2048u, ws + WS_WINT + (size_t)l * NIN * DM * 2, 2048u);
            EpiInProj E{(bf16_t*)(ws + WS_A), (bf16_t*)(ws + WS_MG), (float*)(ws + WS_GN)};
            pg8::gemm_phase<EpiInProj, pg8::DenseOrder, true>(C.lds, C.tid, g, S, E);
        }
        SEAM(pb + 1);
        if (IN(pb + 2)) REPEAT(2) { FRESH(); LOADA(); unsigned char* ws = a.ws;
            struct CmpOrder { int c; const char* A; const char* B;
                __device__ __forceinline__ bool next(int i, pg8::Unit& u) const { if (i > 0 || c >= 32) return false; const int kv = c >> 4, b = (c >> 1) & 7, hk = c & 1;
                    u.pm = c; u.pn = 0; u.A = A + ((size_t)b * SEQ * LDQ + 512 + kv * 128 + hk * 64) * 2; u.B = B + (size_t)kv * 256 * 2048 * 2; return true; } };
            pg8::Gemm g{(unsigned)(16 * LDQ * 2), 4096u, (unsigned)(LDQ * 2), 2048};
            CmpOrder S{C.vcu, (const char*)(ws + WS_A), (const char*)(ws + WS_CW1T + (size_t)l * 2 * 256 * 2048 * 2)};
            EpiCmp E{(bf16_t*)(ws + WS_HID), (const float*)(ws + WS_CB1) + l * 512, (const bf16_t*)(ws + WS_CW2T) + (size_t)l * 2 * 64 * 256, (bf16_t*)(ws + WS_KC)};
            pg8::gemm_phase<EpiCmp, CmpOrder, false>(C.lds, C.tid, g, S, E);
            __syncthreads();
            build_bkt(C);
            for (;;) { __syncthreads();
                if (C.tid == 0) *(volatile LAS int*)(C.lds + LDS_MISC + 512) = (int)__hip_atomic_fetch_add((unsigned*)(ws + WS_CTL) + CW_Q + l, 1u, __ATOMIC_RELAXED, __HIP_MEMORY_SCOPE_AGENT);
                __syncthreads();
                const int du = __builtin_amdgcn_readfirstlane(*(volatile LAS int*)(C.lds + LDS_MISC + 512));
                if (du >= 1536) break;
                dil_unit(a, C, du); }
        }
        SEAM(pb + 2);
        if (IN(pb + 3)) REPEAT(3) { FRESH(); LOADA();
            dil_combine(a, C);
            build_bkt(C);
            int cur_hk = -1;
            for (int v = C.vcu; v < 256; v += C.G) { const int b = v >> 5, hk = (v >> 4) & 1, s = v & 15;
                if (hk != cur_hk) { build_nsa_tables(a, C, hk); cur_hk = hk; }
                for (int k = 0; k < 4; ++k) { const int qi = (k == 0) ? s : (k == 1) ? 31 - s : (k == 2) ? 32 + s : 63 - s; nsa_unit(a, C, b, hk, qi); } }
            __syncthreads();
        }
        SEAM(pb + 3);
        if (IN(pb + 4)) REPEAT(4) { FRESH(); LOADA(); unsigned char* ws = a.ws;
            { pg8::Gemm g{1024u, 1024u, 128u, 512}; pg8::DenseOrder S; S.init(T, 1024, C.G, C.bx, ws + WS_ONSA, 1024u, ws + WS_WUNT + (size_t)l * 1024 * 512 * 2, 1024u);
              EpiUp<0> E{(bf16_t*)(ws + WS_MERGED), (const bf16_t*)(ws + WS_MG)};
              pg8::gemm_phase<EpiUp<0>, pg8::DenseOrder, true>(C.lds, C.tid, g, S, E); }
            VM_WAIT(); __syncthreads();
            { pg8::Gemm g{512u, 512u, 128u, 256}; pg8::DenseOrder S; S.init(T, 1024, C.G, C.bx, ws + WS_ODIL, 512u, ws + WS_WUDT + (size_t)l * 1024 * 256 * 2, 512u);
              EpiUp<1> E{(bf16_t*)(ws + WS_MERGED), (const bf16_t*)(ws + WS_MG)};
              pg8::gemm_phase<EpiUp<1>, pg8::DenseOrder, true>(C.lds, C.tid, g, S, E); }
        }
        SEAM(pb + 4);
        if (IN(pb + 5)) REPEAT(5) { FRESH(); LOADA(); unsigned char* ws = a.ws;
            pg8::Gemm g{2048u, 2048u, 128u, 1024}; pg8::DenseOrder S; S.init(T, 1024, C.G, C.bx, ws + WS_MERGED, 2048u, ws + WS_WOT + (size_t)l * 1024 * 1024 * 2, 2048u);
            EpiOut E{l == 0 ? a.x : (const float*)a.out, a.out, (const float*)(ws + WS_MOD) + (size_t)l * 8 * 6144 + 2048};
            pg8::gemm_phase<EpiOut, pg8::DenseOrder, true>(C.lds, C.tid, g, S, E);
        }
        SEAM(pb + 5);
        if (IN(pb + 6)) REPEAT(6) { FRESH(); LOADA(); norm2_router_phase(a, C, l); }
        SEAM(pb + 6);
        if (IN(pb + 7)) REPEAT(7) { FRESH(); LOADA(); moe_scatter_phase(a, C); }
        SEAM(pb + 7);
        if (IN(pb + 8)) REPEAT(8) { FRESH(); LOADA(); unsigned char* ws = a.ws;
            const int* TILEE = (const int*)(ws + WS_TILEE); const int ntl = TILEE[0];
            MoeOrder S; S.G = C.G; S.c = C.vcu; S.nu = ntl * 4; S.A = (const char*)(ws + WS_XS); S.B = (const char*)(ws + WS_E13T); S.tA = (size_t)256 * 2048; S.tB = (size_t)256 * 2048; S.eB = (size_t)1024 * 2048;
#pragma unroll
            for (int i = 0; i < 8; ++i) { const int L = i * C.G + C.vcu; S.ex[i] = (L < S.nu) ? TILEE[16 + (L >> 2)] : 0; }
            pg8::Gemm g{2048u, 2048u, 128u, 1024};
            EpiMoe1 E{(bf16_t*)(ws + WS_ACT)};
            pg8::gemm_phase<EpiMoe1, MoeOrder, true>(C.lds, C.tid, g, S, E);
        }
        SEAM(pb + 8);
        if (IN(pb + 9)) REPEAT(9) { FRESH(); LOADA(); unsigned char* ws = a.ws;
            const int* TILEE = (const int*)(ws + WS_TILEE); const int ntl = TILEE[0];
            MoeOrder S; S.G = C.G; S.c = C.vcu; S.nu = ntl * 4; S.A = (const char*)(ws + WS_ACT); S.B = (const char*)(ws + WS_E2T); S.tA = (size_t)256 * 1024; S.tB = (size_t)256 * 1024; S.eB = (size_t)1024 * 1024;
#pragma unroll
            for (int i = 0; i < 8; ++i) { const int L = i * C.G + C.vcu; S.ex[i] = (L < S.nu) ? TILEE[16 + (L >> 2)] : 0; }
            pg8::Gemm g{1024u, 1024u, 128u, 512};
            EpiPlain E{(bf16_t*)(ws + WS_XS), 1024};
            pg8::gemm_phase<EpiPlain, MoeOrder, true>(C.lds, C.tid, g, S, E);
        }
        SEAM(pb + 9);
    }
    if (IN(21)) { FRESH(); LOADA(); final_phase(a, C); }
#undef IN
#undef SEAM
}

#ifndef ONE_LAUNCH
#define ONE_LAUNCH 1
#endif
extern "C" void kernel_launch(void* const* d_in, const int* in_sizes, int n_in, void* d_out, int out_size, void* d_ws, size_t ws_size, hipStream_t stream) {
    static int grid = 0;
    if (grid == 0) {
        if (n_in != 22 || out_size != T * DM || ws_size < WS_END) { fprintf(stderr, "kernel_launch: unexpected problem (n_in %d out %d ws %zu)\n", n_in, out_size, ws_size); grid = -1; return; }
        int dev = 0, cus = 0;
        if (hipGetDevice(&dev) != hipSuccess || hipDeviceGetAttribute(&cus, hipDeviceAttributeMultiprocessorCount, dev) != hipSuccess) { grid = -1; return; }
        if (hipFuncSetAttribute((const void*)fwd_kernel, hipFuncAttributeMaxDynamicSharedMemorySize, LDS_BYTES) != hipSuccess) { fprintf(stderr, "kernel_launch: hipFuncSetAttribute failed\n"); grid = -1; return; }
        int per_cu = 0;
        if (hipOccupancyMaxActiveBlocksPerMultiprocessor(&per_cu, (const void*)fwd_kernel, NTHR, LDS_BYTES) != hipSuccess || per_cu < 1) { fprintf(stderr, "kernel_launch: occupancy query reports %d\n", per_cu); }
        (void)hipGetLastError();
        grid = cus;
    }
    if (grid < 0) return;
    (void)hipMemsetAsync((char*)d_ws + WS_CTL, 0, CTL_ZERO_BYTES, stream);
    Args a{};
    a.x = (const float*)d_in[0]; a.c = (const float*)d_in[1]; a.rel_bias = (const float*)d_in[2]; a.ada_w = (const float*)d_in[3]; a.ada_b = (const float*)d_in[4];
    a.norm1 = (const float*)d_in[5]; a.norm2 = (const float*)d_in[6]; a.w_in = (const float*)d_in[7]; a.cmp_pos = (const float*)d_in[8]; a.cmp_w1 = (const float*)d_in[9];
    a.cmp_w2 = (const float*)d_in[10]; a.w_up_nsa = (const float*)d_in[11]; a.w_up_dil = (const float*)d_in[12]; a.w_o = (const float*)d_in[13];
    a.router_wg = (const float*)d_in[14]; a.router_bg = (const float*)d_in[15]; a.router_we = (const float*)d_in[16]; a.router_be = (const float*)d_in[17];
    a.exp_w1 = (const float*)d_in[18]; a.exp_w3 = (const float*)d_in[19]; a.exp_w2 = (const float*)d_in[20]; a.norm_f = (const float*)d_in[21];
    a.out = (float*)d_out; a.ws = (unsigned char*)d_ws; a.pad = 0;
#if ONE_LAUNCH
    a.ph_lo = 0; a.ph_hi = NPHASE; a.use_bar = 1;
    hipLaunchKernelGGL(fwd_kernel, dim3(grid), dim3(NTHR), LDS_BYTES, stream, a);
#else
    for (int p = 0; p < NPHASE; ++p) { a.ph_lo = p; a.ph_hi = p + 1; a.use_bar = 0;
        hipLaunchKernelGGL(fwd_kernel, dim3(grid), dim3(NTHR), LDS_BYTES, stream, a); }
#endif
}
```

```cpp
#include <hip/hip_runtime.h>
#include <cstdint>
#include <cstdio>

#define GAS __attribute__((address_space(1)))
#define LAS __attribute__((address_space(3)))
typedef unsigned short bf16_t;
typedef short bf16x8 __attribute__((ext_vector_type(8)));
typedef short s16x4 __attribute__((ext_vector_type(4)));
typedef float f32x4 __attribute__((ext_vector_type(4)));
typedef float f32x2 __attribute__((ext_vector_type(2)));
typedef float f32x16 __attribute__((ext_vector_type(16)));
typedef unsigned u32x4 __attribute__((ext_vector_type(4)));
typedef unsigned u32x2 __attribute__((ext_vector_type(2)));
typedef __bf16 bf16x2_t __attribute__((ext_vector_type(2)));

constexpr int NB = 8, SEQ = 4096, DM = 1024, T = NB * SEQ;
constexpr int LDQ = 3584;
constexpr int NIN = 5888;
constexpr int INW = 5656;
constexpr float LOG2E = 1.4426950408889634f;
constexpr float C2 = 0.125f * LOG2E;
constexpr int NWAVES = 8, NTHR = 512;
constexpr float RMS_EPS = 1e-6f;
constexpr int NPHASE = 22;
#ifndef ABL
#define ABL 0
#endif
#ifndef REP_MASK
#define REP_MASK 0u
#endif
#define REPEAT(k) _Pragma("clang loop unroll(disable)") for (int rep_ = 0; rep_ < (int)((REP_MASK >> (k)) & 1u) + 1; ++rep_)

constexpr size_t MiB = 1u << 20;
constexpr size_t WS_CTL = 0, CTL_ZERO_BYTES = MiB;
constexpr size_t WS_MOD = 1 * MiB;
constexpr size_t WS_CB1 = WS_MOD + 400 * 1024;
constexpr size_t WS_CW2T = WS_MOD + 512 * 1024;
constexpr size_t WS_CNTBLK = WS_MOD + 768 * 1024;
constexpr size_t WS_TILEE = WS_MOD + 832 * 1024;
constexpr size_t WS_WINT = 4 * MiB;
constexpr size_t WS_CW1T = 27 * MiB;
constexpr size_t WS_WUNT = 31 * MiB;
constexpr size_t WS_WUDT = 33 * MiB;
constexpr size_t WS_WOT = 34 * MiB;
constexpr size_t WS_E13T = 38 * MiB;
constexpr size_t WS_E2T = 102 * MiB;
constexpr size_t WS_A = 134 * MiB;
constexpr size_t WS_XS = WS_A;
constexpr size_t WS_ACT = WS_A + 144 * MiB;
constexpr size_t WS_MERGED = WS_A;
constexpr size_t WS_MG = 359 * MiB;
constexpr size_t WS_H2 = WS_MG;
constexpr size_t WS_REC = WS_MG + 64 * MiB;
constexpr size_t WS_DEST = WS_MG + 65 * MiB;
constexpr size_t WS_B = 487 * MiB;
constexpr size_t WS_H = WS_B;
constexpr size_t WS_ONSA = WS_B;
constexpr size_t WS_ODP = WS_B + 32 * MiB;
constexpr size_t WS_LSE = WS_B + 80 * MiB;
constexpr size_t WS_ODIL = WS_B + 82 * MiB;
constexpr size_t WS_GN = WS_B + 98 * MiB;
constexpr size_t WS_KC = WS_B + 102 * MiB;
constexpr size_t WS_HID = WS_B + 103 * MiB;
constexpr size_t WS_END = WS_B + 107 * MiB;

constexpr int CW_TMO = 0, CW_BAR = 4096, CW_Q = 8192;

constexpr int LDS_MISC = 158784;
constexpr int LDS_BYTES = 158784 + 2048;

__device__ __forceinline__ unsigned cvt_pk_bf16(float lo, float hi) { f32x2 v = {lo, hi}; bf16x2_t b = __builtin_convertvector(v, bf16x2_t); return __builtin_bit_cast(unsigned, b); }
__device__ __forceinline__ float bf_lo(unsigned w) { return __uint_as_float(w << 16); }
__device__ __forceinline__ float bf_hi(unsigned w) { return __uint_as_float(w & 0xffff0000u); }
__device__ __forceinline__ float sigmoidf_(float x) { return __builtin_amdgcn_rcpf(1.0f + __builtin_amdgcn_exp2f(-x * LOG2E)); }
__device__ __forceinline__ int lane_id_fresh() { unsigned ones = ~0u; asm volatile("" : "+s"(ones)); return (int)__builtin_amdgcn_mbcnt_hi(ones, __builtin_amdgcn_mbcnt_lo(ones, 0u)); }
template <int X> __device__ __forceinline__ float swz_xor_f(float v) { return __int_as_float(__builtin_amdgcn_ds_swizzle(__float_as_int(v), (X << 10) | 0x1f)); }
template <int X> __device__ __forceinline__ unsigned swz_xor_u(unsigned v) { return (unsigned)__builtin_amdgcn_ds_swizzle((int)v, (X << 10) | 0x1f); }
__device__ __forceinline__ float wave_sum(float v) {
    v += swz_xor_f<1>(v); v += swz_xor_f<2>(v); v += swz_xor_f<4>(v); v += swz_xor_f<8>(v); v += swz_xor_f<16>(v);
    auto rr = __builtin_amdgcn_permlane32_swap(__float_as_uint(v), __float_as_uint(v), false, false);
    return __uint_as_float(rr[0]) + __uint_as_float(rr[1]);
}
__device__ __forceinline__ int bperm_i(int srclane, int v) { return __builtin_amdgcn_ds_bpermute(srclane << 2, v); }
#define LDS_WAIT() asm volatile("s_waitcnt lgkmcnt(0)" ::: "memory")
#define VM_WAIT() asm volatile("s_waitcnt vmcnt(0)" ::: "memory")

#define XB_TMO      128
#define XB_XCNT(j)  (256  + 64 * (j))
#define XB_XSUB(j)  (1280 + 64 * (j))
#define XB_XGEN(j)  (2304 + 64 * (j))
#define XB_TOP      3328
#define XB_TOPGEN   3392
#define XCD_BAR_WORDS 3456
#define XB_SPIN_CAP (1u << 20)
__device__ __forceinline__ unsigned xb_ld(unsigned* p)              { return __hip_atomic_load(p, __ATOMIC_RELAXED, __HIP_MEMORY_SCOPE_AGENT); }
__device__ __forceinline__ unsigned xb_add(unsigned* p, unsigned v) { return __hip_atomic_fetch_add(p, v, __ATOMIC_RELAXED, __HIP_MEMORY_SCOPE_AGENT); }
__device__ __forceinline__ unsigned xb_xcc_id() { return (unsigned)__builtin_amdgcn_s_getreg((3 << 11) | 20) & 0xFu; }
#define XB_SPIN(cond, bar) do { unsigned _sp = 0; while (cond) { __builtin_amdgcn_s_sleep(1); \
    if ((++_sp & 255u) == 0u) { if (xb_ld(&(bar)[XB_TMO])) break; if (_sp > XB_SPIN_CAP) { atomicAdd(&(bar)[XB_TMO], 1u); break; } } } } while (0)
struct XcdBarrier { unsigned* bar; unsigned x; volatile LAS unsigned* st; };
__device__ __forceinline__ XcdBarrier xcd_barrier_post(unsigned* bar, volatile LAS unsigned* st) {
    XcdBarrier b; b.bar = bar; b.x = xb_xcc_id(); b.st = st;
    if (threadIdx.x == 0) (void)xb_add(&bar[XB_XCNT(b.x)], 1u);
    return b;
}
__device__ __forceinline__ void xcd_barrier_complete(unsigned* bar, unsigned x, unsigned& nloc, unsigned& nx) {
    const unsigned G = gridDim.x * gridDim.y * gridDim.z;
    unsigned sum, cnt, mine, sp = 0u;
    for (;;) {
        sum = 0u; cnt = 0u; mine = 0u;
#pragma unroll
        for (unsigned j = 0; j < 16; ++j) { const unsigned c = xb_ld(&bar[XB_XCNT(j)]); sum += c; cnt += (c > 0u) ? 1u : 0u; mine = (j == x) ? c : mine; }
        if (sum == G) break;
        __builtin_amdgcn_s_sleep(1);
        if ((++sp & 255u) == 0u) { if (xb_ld(&bar[XB_TMO])) break; if (sp > XB_SPIN_CAP) { atomicAdd(&bar[XB_TMO], 1u); break; } }
    }
    nloc = mine > 0u ? mine : 1u; nx = cnt > 0u ? cnt : 1u;
}
__device__ __forceinline__ void xcd_barrier(const XcdBarrier& b, const bool leader_thread) {
    asm volatile("s_waitcnt vmcnt(0)" ::: "memory");
    __syncthreads();
    if (leader_thread) {
        unsigned* bar = b.bar;
        __builtin_amdgcn_s_waitcnt(0);
        unsigned nloc = b.st[0], nx = b.st[1];
        if (nloc == 0u) { xcd_barrier_complete(bar, b.x, nloc, nx); b.st[0] = nloc; b.st[1] = nx; }
        const unsigned old = xb_add(&bar[XB_XSUB(b.x)], 1u);
        const unsigned gen = old / nloc;
        if (old + 1u == (gen + 1u) * nloc) {
            __builtin_amdgcn_fence(__ATOMIC_RELEASE, "agent");
            asm volatile("s_waitcnt vmcnt(0)" ::: "memory");
            const unsigned og = xb_add(&bar[XB_TOP], 1u);
            const unsigned tg = og / nx;
            if (og + 1u == (tg + 1u) * nx) xb_add(&bar[XB_TOPGEN], 1u);
            else XB_SPIN(xb_ld(&bar[XB_TOPGEN]) == tg, bar);
            __builtin_amdgcn_fence(__ATOMIC_ACQUIRE, "agent");
            xb_add(&bar[XB_XGEN(b.x)], 1u);
            asm volatile("s_waitcnt vmcnt(0)" ::: "memory");
        } else {
            XB_SPIN(xb_ld(&bar[XB_XGEN(b.x)]) == gen, bar);
            __builtin_amdgcn_fence(__ATOMIC_ACQUIRE, "agent");
            asm volatile("s_waitcnt vmcnt(0)" ::: "memory");
        }
    }
    __syncthreads();
}

namespace pg8 {
constexpr int BM = 256, BK = 64, HALF = 128, HTB = HALF * BK * 2, STAGE_BYTES = 8 * HTB;
__device__ __forceinline__ int lds_byte(int r, int c) { const int st = (r >> 4) * 2 + (c >> 5), rr = r & 15, cc = c & 31, ob = rr * 64 + cc * 2; return st * 1024 + (ob ^ (((ob >> 9) & 1) << 5)); }
__device__ __forceinline__ void stage_rc(int b, int& R, int& C) { const int st = b / 1024, sb = b % 1024, swz = sb ^ (((sb >> 9) & 1) << 5); R = (st >> 1) * 16 + swz / 64; C = (st & 1) * 32 + (swz % 64) / 2; }
__device__ __forceinline__ int perm32(int rho) { const int n = rho >> 4, i = rho & 15; return 8 * (i >> 2) + 4 * n + (i & 3); }

struct Unit { const char* A; const char* B; int pm, pn; };
struct Gemm { unsigned lda, ldb, kstepA; int K; };

template <class Epi, class Sched, bool ALIGN_EPI>
__device__ __forceinline__ void gemm_phase(LAS unsigned char* lds, const int tid, const Gemm g, const Sched& S, const Epi& E) {
    const int wid = __builtin_amdgcn_readfirstlane(tid >> 6), lane = tid & 63, wr = wid >> 2, wc = wid & 3, fr = lane & 15, fq = lane >> 4;
    const int nt = g.K / BK;
    unsigned voffA[2], voffB[2];
#pragma unroll
    for (int i = 0; i < 2; ++i) { int R, C; stage_rc(tid * 16 + i * 8192, R, C); const int Rb = Epi::PERM ? ((R & ~31) + perm32(R & 31)) : R;
        voffA[i] = (unsigned)R * g.lda + (unsigned)C * 2u; voffB[i] = (unsigned)Rb * g.ldb + (unsigned)C * 2u; }
    const size_t kstepA = (size_t)g.kstepA, kstepB = (size_t)(BK * 2);
    const size_t hstepA = (size_t)HALF * g.lda, hstepB = (size_t)HALF * g.ldb;
    const unsigned ldsw = (unsigned)wid * 1024u;
    const int aoff = lds_byte(wr * 64 + fr, fq * 8), boff = lds_byte(wc * 32 + fr, fq * 8);
#define PG8_SA(b, h) (((b) * 2 + (h)) * HTB)
#define PG8_SB(b, h) ((4 + (b) * 2 + (h)) * HTB)
#define PG8_STAGE(bufoff, gbase, voff) do { _Pragma("unroll") for (int _i = 0; _i < 2; ++_i) \
        __builtin_amdgcn_global_load_lds((const unsigned*)((const char*)(gbase) + (voff)[_i]), (LAS unsigned*)(lds + (bufoff) + ldsw + _i * 8192), 16, 0, 0); } while (0)
#define PG8_LDA(dst, b, h) do { _Pragma("unroll") for (int m = 0; m < 4; ++m) _Pragma("unroll") for (int k = 0; k < 2; ++k) dst[m][k] = *(const LAS bf16x8*)(lds + PG8_SA(b, h) + aoff + m * 2048 + k * 1024); } while (0)
#define PG8_LDB(dst, b, h) do { _Pragma("unroll") for (int n = 0; n < 2; ++n) _Pragma("unroll") for (int k = 0; k < 2; ++k) dst[n][k] = *(const LAS bf16x8*)(lds + PG8_SB(b, h) + boff + n * 2048 + k * 1024); } while (0)
#define PG8_MMA(ai, bj, At, Bt) do { __builtin_amdgcn_s_setprio(1); _Pragma("unroll") for (int m = 0; m < 4; ++m) _Pragma("unroll") for (int n = 0; n < 2; ++n) _Pragma("unroll") for (int k = 0; k < 2; ++k) \
        acc[ai][bj][m][n] = __builtin_amdgcn_mfma_f32_16x16x32_bf16(Bt[n][k], At[m][k], acc[ai][bj][m][n], 0, 0, 0); __builtin_amdgcn_s_setprio(0); } while (0)
#define PG8_WAIT_V(n) asm volatile("s_waitcnt vmcnt(" #n ")" ::: "memory")
#define PG8_WAIT_L(n) asm volatile("s_waitcnt lgkmcnt(" #n ")" ::: "memory")
#define PG8_BAR __builtin_amdgcn_s_barrier()
#define PG8_SCHED __builtin_amdgcn_sched_barrier(0)
    Unit cur, nxt; int ui = 0;
    if (!S.next(0, cur)) return;
    f32x4 acc[2][2][4][2];
#pragma unroll
    for (int a = 0; a < 2; ++a)
#pragma unroll
        for (int b = 0; b < 2; ++b)
#pragma unroll
            for (int m = 0; m < 4; ++m)
#pragma unroll
                for (int n = 0; n < 2; ++n) acc[a][b][m][n] = (f32x4){0.f, 0.f, 0.f, 0.f};
    bf16x8 At[4][2], B0[2][2], B1[2][2];
    const char* cA = cur.A; const char* cB = cur.B;
    PG8_STAGE(PG8_SB(0, 0), cB, voffB); PG8_STAGE(PG8_SB(0, 1), cB + hstepB, voffB); PG8_STAGE(PG8_SA(0, 0), cA, voffA); PG8_STAGE(PG8_SA(0, 1), cA + hstepA, voffA);
    if (wr == 1) PG8_BAR;
    PG8_WAIT_V(2); PG8_BAR;
    PG8_STAGE(PG8_SB(1, 0), cB + kstepB, voffB); PG8_STAGE(PG8_SA(1, 0), cA + kstepA, voffA); PG8_STAGE(PG8_SB(1, 1), cB + hstepB + kstepB, voffB);
    PG8_WAIT_V(6); PG8_BAR;
    for (;;) {
        const bool has_next = S.next(ui + 1, nxt);
        const char* nA = has_next ? nxt.A : cA; const char* nB = has_next ? nxt.B : cB;
        for (int t = 0; t < nt; t += 2) {
            const bool last = (t == nt - 2);
            const char* a1 = cA + (size_t)(t + 1) * kstepA;
            const char* a2 = last ? nA : cA + (size_t)(t + 2) * kstepA; const char* b2 = last ? nB : cB + (size_t)(t + 2) * kstepB;
            const char* a3 = a2 + kstepA; const char* b3 = b2 + kstepB;
            PG8_LDB(B0, 0, 0); PG8_LDB(B1, 0, 1); PG8_SCHED; PG8_LDA(At, 0, 0); PG8_STAGE(PG8_SA(1, 1), a1 + hstepA, voffA);
            PG8_WAIT_V(8); PG8_WAIT_L(0); PG8_BAR; PG8_MMA(0, 0, At, B0); PG8_MMA(0, 1, At, B1); PG8_BAR; PG8_SCHED;
            PG8_LDA(At, 0, 1); PG8_STAGE(PG8_SB(0, 0), b2, voffB); PG8_STAGE(PG8_SB(0, 1), b2 + hstepB, voffB); PG8_STAGE(PG8_SA(0, 0), a2, voffA);
            PG8_WAIT_V(8); PG8_WAIT_L(0); PG8_BAR; PG8_MMA(1, 0, At, B0); PG8_MMA(1, 1, At, B1); PG8_BAR; PG8_SCHED;
            PG8_LDB(B0, 1, 0); PG8_LDB(B1, 1, 1); PG8_SCHED; PG8_LDA(At, 1, 0); PG8_STAGE(PG8_SA(0, 1), a2 + hstepA, voffA);
            PG8_WAIT_V(8); PG8_WAIT_L(0); PG8_BAR; PG8_MMA(0, 0, At, B0); PG8_MMA(0, 1, At, B1); PG8_BAR; PG8_SCHED;
            PG8_LDA(At, 1, 1); PG8_STAGE(PG8_SB(1, 0), b3, voffB); PG8_STAGE(PG8_SB(1, 1), b3 + hstepB, voffB); PG8_STAGE(PG8_SA(1, 0), a3, voffA);
            PG8_WAIT_V(8); PG8_WAIT_L(0); PG8_BAR; PG8_MMA(1, 0, At, B0); PG8_MMA(1, 1, At, B1); PG8_BAR; PG8_SCHED;
        }
        if constexpr (ALIGN_EPI) { if (wr == 0) PG8_BAR; }
        if constexpr (!Epi::AFTER_DRAIN) { E(acc, cur, wr, wc, fr, fq); }
        if (!has_next) break;
#pragma unroll
        for (int a = 0; a < 2; ++a)
#pragma unroll
            for (int b = 0; b < 2; ++b)
#pragma unroll
                for (int m = 0; m < 4; ++m)
#pragma unroll
                    for (int n = 0; n < 2; ++n) acc[a][b][m][n] = (f32x4){0.f, 0.f, 0.f, 0.f};
        cur = nxt; cA = nA; cB = nB; ++ui;
        if constexpr (ALIGN_EPI) { if (wr == 1) PG8_BAR; }
    }
    PG8_WAIT_V(0);
    if constexpr (!ALIGN_EPI) { if (wr == 0) PG8_BAR; }
    PG8_BAR;
    if constexpr (Epi::AFTER_DRAIN) { E.fused(acc, cur, wr, wc, fr, fq, wid, lane); }
#undef PG8_SA
#undef PG8_SB
#undef PG8_STAGE
#undef PG8_LDA
#undef PG8_LDB
#undef PG8_MMA
#undef PG8_WAIT_V
#undef PG8_WAIT_L
#undef PG8_BAR
#undef PG8_SCHED
}

struct DenseOrder {
    int nM, nN, nwg, G, c; const char* A; const char* B; size_t tA, tB;
    __device__ __forceinline__ void init(int M, int N, int G_, int c_, const void* A_, unsigned lda, const void* B_, unsigned ldb) {
        nM = M / BM; nN = N / BM; nwg = nM * nN; G = G_; c = c_; A = (const char*)A_; B = (const char*)B_; tA = (size_t)BM * lda; tB = (size_t)BM * ldb; }
    __device__ __forceinline__ bool next(int i, Unit& u) const {
        const long L = (long)i * G + c; if (L >= nwg) return false;
        int wgid = (int)L; { const int q = nwg / 8, r = nwg % 8, xcd = wgid % 8, off = wgid / 8; wgid = (xcd < r ? xcd * (q + 1) : r * (q + 1) + (xcd - r) * q) + off; }
        const int nig = 8 * nN, gid = wgid / nig, fm = gid * 8, gsz = (nM - fm) < 8 ? (nM - fm) : 8;
        u.pm = fm + ((wgid % nig) % gsz); u.pn = (wgid % nig) / gsz;
        u.A = A + (size_t)u.pm * tA; u.B = B + (size_t)u.pn * tB; return true;
    }
};
}

struct Args {
    const float* x; const float* c; const float* rel_bias; const float* ada_w; const float* ada_b; const float* norm1; const float* norm2; const float* w_in;
    const float* cmp_pos; const float* cmp_w1; const float* cmp_w2; const float* w_up_nsa; const float* w_up_dil; const float* w_o;
    const float* router_wg; const float* router_bg; const float* router_we; const float* router_be; const float* exp_w1; const float* exp_w3; const float* exp_w2; const float* norm_f;
    float* out; unsigned char* ws; int ph_lo, ph_hi, use_bar, pad;
};

typedef f32x4 AccT[2][2][4][2];
struct EpiInProj {
    static constexpr bool PERM = true, AFTER_DRAIN = false;
    bf16_t* QKV; bf16_t* MG; float* GN;
    __device__ __forceinline__ void operator()(const AccT& acc, const pg8::Unit& u, int wr, int wc, int fr, int fq) const {
        const int pn = u.pn; const int row0 = u.pm * 256 + wr * 64 + fr;
        if (pn < 14) {
            const float sc = (pn < 2 || (pn >= 5 && pn < 8)) ? C2 : 1.0f;
            const int col0 = pn * 256 + wc * 32 + 8 * fq;
#pragma unroll
            for (int ai = 0; ai < 2; ++ai)
#pragma unroll
                for (int m = 0; m < 4; ++m) { bf16_t* rowp = QKV + (size_t)(row0 + ai * 128 + m * 16) * LDQ + col0;
#pragma unroll
                    for (int bj = 0; bj < 2; ++bj) { const f32x4 v0 = acc[ai][bj][m][0] * sc, v1 = acc[ai][bj][m][1] * sc; u32x4 w;
                        w.x = cvt_pk_bf16(v0[0], v0[1]); w.y = cvt_pk_bf16(v0[2], v0[3]); w.z = cvt_pk_bf16(v1[0], v1[1]); w.w = cvt_pk_bf16(v1[2], v1[3]);
                        *(u32x4*)(rowp + bj * 128) = w; } }
        } else if (pn < 22) {
            const int col0 = (pn - 14) * 256 + wc * 32 + 8 * fq;
#pragma unroll
            for (int ai = 0; ai < 2; ++ai)
#pragma unroll
                for (int m = 0; m < 4; ++m) { bf16_t* rowp = MG + (size_t)(row0 + ai * 128 + m * 16) * 2048 + col0;
#pragma unroll
                    for (int bj = 0; bj < 2; ++bj) { const f32x4 v0 = acc[ai][bj][m][0], v1 = acc[ai][bj][m][1]; u32x4 w;
                        w.x = cvt_pk_bf16(sigmoidf_(v0[0]), sigmoidf_(v0[1])); w.y = cvt_pk_bf16(sigmoidf_(v0[2]), sigmoidf_(v0[3]));
                        w.z = cvt_pk_bf16(sigmoidf_(v1[0]), sigmoidf_(v1[1])); w.w = cvt_pk_bf16(sigmoidf_(v1[2]), sigmoidf_(v1[3]));
                        *(u32x4*)(rowp + bj * 128) = w; } }
        } else {
            if (wc == 0 && fq < 3) {
#pragma unroll
                for (int ai = 0; ai < 2; ++ai)
#pragma unroll
                    for (int m = 0; m < 4; ++m) { float* rowp = GN + (size_t)(row0 + ai * 128 + m * 16) * 32 + 8 * fq;
                        const f32x4 v0 = acc[ai][0][m][0], v1 = acc[ai][0][m][1];
                        *(f32x4*)(rowp) = (f32x4){sigmoidf_(v0[0]), sigmoidf_(v0[1]), sigmoidf_(v0[2]), sigmoidf_(v0[3])};
                        *(f32x4*)(rowp + 4) = (f32x4){sigmoidf_(v1[0]), sigmoidf_(v1[1]), sigmoidf_(v1[2]), sigmoidf_(v1[3])}; }
            }
        }
    }
};
template <int PASS> struct EpiUp {
    static constexpr bool PERM = true, AFTER_DRAIN = false;
    bf16_t* MERGED; const bf16_t* MG;
    __device__ __forceinline__ void operator()(const AccT& acc, const pg8::Unit& u, int wr, int wc, int fr, int fq) const {
        const int row0 = u.pm * 256 + wr * 64 + fr; const int col0 = u.pn * 256 + wc * 32 + 8 * fq;
#pragma unroll
        for (int ai = 0; ai < 2; ++ai)
#pragma unroll
            for (int m = 0; m < 4; ++m) { const size_t row = (size_t)(row0 + ai * 128 + m * 16);
#pragma unroll
                for (int bj = 0; bj < 2; ++bj) {
                    const u32x4 gw = *(const u32x4*)(MG + row * 2048 + PASS * 1024 + col0 + bj * 128);
                    bf16_t* op = MERGED + row * 1024 + col0 + bj * 128;
                    const f32x4 v0 = acc[ai][bj][m][0], v1 = acc[ai][bj][m][1];
                    float r[8] = {v0[0] * bf_lo(gw.x), v0[1] * bf_hi(gw.x), v0[2] * bf_lo(gw.y), v0[3] * bf_hi(gw.y), v1[0] * bf_lo(gw.z), v1[1] * bf_hi(gw.z), v1[2] * bf_lo(gw.w), v1[3] * bf_hi(gw.w)};
                    if (PASS == 1) { const u32x4 ow = *(const u32x4*)op;
                        r[0] += bf_lo(ow.x); r[1] += bf_hi(ow.x); r[2] += bf_lo(ow.y); r[3] += bf_hi(ow.y); r[4] += bf_lo(ow.z); r[5] += bf_hi(ow.z); r[6] += bf_lo(ow.w); r[7] += bf_hi(ow.w); }
                    u32x4 w; w.x = cvt_pk_bf16(r[0], r[1]); w.y = cvt_pk_bf16(r[2], r[3]); w.z = cvt_pk_bf16(r[4], r[5]); w.w = cvt_pk_bf16(r[6], r[7]);
                    *(u32x4*)op = w; }
                asm volatile("" ::: "memory"); }
    }
};
struct EpiOut {
    static constexpr bool PERM = true, AFTER_DRAIN = false;
    const float* xin; float* xout; const float* g1;
    __device__ __forceinline__ void operator()(const AccT& acc, const pg8::Unit& u, int wr, int wc, int fr, int fq) const {
        const int row0 = u.pm * 256 + wr * 64 + fr; const int col0 = u.pn * 256 + wc * 32 + 8 * fq; const int b = u.pm >> 4;
        f32x4 gv[2][2];
#pragma unroll
        for (int bj = 0; bj < 2; ++bj)
#pragma unroll
            for (int n = 0; n < 2; ++n) gv[bj][n] = *(const f32x4*)(g1 + (size_t)b * 6144 + col0 + bj * 128 + 4 * n);
#pragma unroll
        for (int ai = 0; ai < 2; ++ai)
#pragma unroll
            for (int m = 0; m < 4; ++m) { const size_t off = (size_t)(row0 + ai * 128 + m * 16) * 1024 + col0;
#pragma unroll
                for (int bj = 0; bj < 2; ++bj)
#pragma unroll
                    for (int n = 0; n < 2; ++n) { const f32x4 xv = *(const f32x4*)(xin + off + bj * 128 + 4 * n);
                        *(f32x4*)(xout + off + bj * 128 + 4 * n) = (ABL == 7) ? xv : xv + gv[bj][n] * acc[ai][bj][m][n]; }
                asm volatile("" ::: "memory"); }
    }
};
struct EpiMoe1 {
    static constexpr bool PERM = true, AFTER_DRAIN = false;
    bf16_t* ACT;
    __device__ __forceinline__ void operator()(const AccT& acc, const pg8::Unit& u, int wr, int wc, int fr, int fq) const {
        const int row0 = u.pm * 256 + wr * 64 + fr; const int col0 = u.pn * 128 + wc * 32 + 8 * fq;
#pragma unroll
        for (int ai = 0; ai < 2; ++ai)
#pragma unroll
            for (int m = 0; m < 4; ++m) { bf16_t* op = ACT + (size_t)(row0 + ai * 128 + m * 16) * 512 + col0; float r[8];
#pragma unroll
                for (int n = 0; n < 2; ++n)
#pragma unroll
                    for (int j = 0; j < 4; ++j) { const float a = acc[ai][0][m][n][j], bb = acc[ai][1][m][n][j]; r[n * 4 + j] = a * sigmoidf_(a) * bb; }
                u32x4 w; w.x = cvt_pk_bf16(r[0], r[1]); w.y = cvt_pk_bf16(r[2], r[3]); w.z = cvt_pk_bf16(r[4], r[5]); w.w = cvt_pk_bf16(r[6], r[7]);
                *(u32x4*)op = w; }
    }
};
struct EpiPlain {
    static constexpr bool PERM = true, AFTER_DRAIN = false;
    bf16_t* O; int ldc;
    __device__ __forceinline__ void operator()(const AccT& acc, const pg8::Unit& u, int wr, int wc, int fr, int fq) const {
        const int row0 = u.pm * 256 + wr * 64 + fr; const int col0 = u.pn * 256 + wc * 32 + 8 * fq;
#pragma unroll
        for (int ai = 0; ai < 2; ++ai)
#pragma unroll
            for (int m = 0; m < 4; ++m) { bf16_t* rowp = O + (size_t)(row0 + ai * 128 + m * 16) * ldc + col0;
#pragma unroll
                for (int bj = 0; bj < 2; ++bj) { const f32x4 v0 = acc[ai][bj][m][0], v1 = acc[ai][bj][m][1]; u32x4 w;
                    w.x = cvt_pk_bf16(v0[0], v0[1]); w.y = cvt_pk_bf16(v0[2], v0[3]); w.z = cvt_pk_bf16(v1[0], v1[1]); w.w = cvt_pk_bf16(v1[2], v1[3]);
                    *(u32x4*)(rowp + bj * 128) = w; } }
    }
};
__device__ __forceinline__ int crow(int r, int hi) { return (r & 3) + 8 * (r >> 2) + 4 * hi; }
__device__ __forceinline__ float gelu_tanh(float x) { const float u2 = 2.0f * 0.7978845608028654f * (x + 0.044715f * x * x * x); return x * __builtin_amdgcn_rcpf(1.0f + __builtin_amdgcn_exp2f(-u2 * LOG2E)); }
struct EpiCmp {
    static constexpr bool PERM = true, AFTER_DRAIN = true;
    bf16_t* HID; const float* CB1; const bf16_t* CW2T; bf16_t* KC;
    __device__ __forceinline__ void fused(const AccT& acc, const pg8::Unit& u, int wr, int wc, int fr, int fq, int wid, int lane) const {
        const int kv = u.pm >> 4; const int row0 = u.pm * 256 + wr * 64 + fr; const int col0 = wc * 32 + 8 * fq;
        const float* bias = CB1 + kv * 256;
        f32x4 bv[2][2];
#pragma unroll
        for (int bj = 0; bj < 2; ++bj)
#pragma unroll
            for (int n = 0; n < 2; ++n) bv[bj][n] = *(const f32x4*)(bias + col0 + bj * 128 + 4 * n);
#pragma unroll
        for (int ai = 0; ai < 2; ++ai)
#pragma unroll
            for (int m = 0; m < 4; ++m) { bf16_t* rowp = HID + (size_t)(row0 + ai * 128 + m * 16) * 256 + col0;
#pragma unroll
                for (int bj = 0; bj < 2; ++bj) { const f32x4 v0 = acc[ai][bj][m][0] + bv[bj][0], v1 = acc[ai][bj][m][1] + bv[bj][1]; u32x4 w;
                    w.x = cvt_pk_bf16(gelu_tanh(v0[0]), gelu_tanh(v0[1])); w.y = cvt_pk_bf16(gelu_tanh(v0[2]), gelu_tanh(v0[3]));
                    w.z = cvt_pk_bf16(gelu_tanh(v1[0]), gelu_tanh(v1[1])); w.w = cvt_pk_bf16(gelu_tanh(v1[2]), gelu_tanh(v1[3]));
                    *(u32x4*)(rowp + bj * 128) = w; } }
        VM_WAIT(); __syncthreads();
        const int r32 = lane & 31, hi = lane >> 5;
        const bf16_t* ap = HID + (size_t)(u.pm * 256 + 32 * wid + r32) * 256 + hi * 8;
        const bf16_t* bp = CW2T + (size_t)kv * 64 * 256 + (size_t)r32 * 256 + hi * 8;
        f32x16 o0 = {}, o1 = {};
#pragma unroll 4
        for (int ks = 0; ks < 16; ++ks) {
            const bf16x8 a = *(const bf16x8*)(ap + ks * 16);
            const bf16x8 b0 = *(const bf16x8*)(bp + ks * 16), b1 = *(const bf16x8*)(bp + 32 * 256 + ks * 16);
            o0 = __builtin_amdgcn_mfma_f32_32x32x16_bf16(a, b0, o0, 0, 0, 0);
            o1 = __builtin_amdgcn_mfma_f32_32x32x16_bf16(a, b1, o1, 0, 0, 0);
        }
        bf16_t* kc = KC + (size_t)u.pm * 256 * 64;
#pragma unroll
        for (int r = 0; r < 16; ++r) { const int c = 32 * wid + crow(r, hi); const bool pad = (c == 255);
            kc[(size_t)c * 64 + r32] = pad ? (bf16_t)0 : (bf16_t)(cvt_pk_bf16(o0[r], 0.f) & 0xffffu);
            kc[(size_t)c * 64 + 32 + r32] = pad ? (bf16_t)0 : (bf16_t)(cvt_pk_bf16(o1[r], 0.f) & 0xffffu); }
    }
};

namespace att {
constexpr int L_KR = 0;
constexpr int L_VR = 24576;
constexpr int L_WSF = 49152;
constexpr int L_BKT = 51200;
constexpr int L_BKC = 55296;
constexpr int L_TBH = 64000;
constexpr int L_GSH = 64576;
constexpr int L_SEL = 67648;
constexpr int L_OTA = 68672;
constexpr int L_IMP = 101440;
constexpr int L_LUT = 117824;
constexpr int L_END = L_LUT + 40960;
static_assert(L_END <= LDS_MISC, "attention LDS map");

__device__ __forceinline__ void glds16(const void* gsrc, unsigned lds_dst) { unsigned keep;
    asm volatile("s_mov_b32 %0, m0\n\ts_mov_b32 m0, %2\n\ts_nop 0\n\tglobal_load_lds_dwordx4 %1, off\n\ts_mov_b32 m0, %0" : "=&s"(keep) : "v"(gsrc), "s"(lds_dst) : "memory"); }
__device__ __forceinline__ int bucket_of(int d) {
    if (d < 16) return d;
    int b = 16;
    b += (d >= 22); b += (d >= 30); b += (d >= 40); b += (d >= 54); b += (d >= 73); b += (d >= 99); b += (d >= 134); b += (d >= 182);
    b += (d >= 246); b += (d >= 332); b += (d >= 450); b += (d >= 609); b += (d >= 825); b += (d >= 1117); b += (d >= 1513);
    return b;
}
__device__ __forceinline__ void qkt(f32x16& p0, f32x16& p1, const LAS unsigned char* Kslot, const bf16x8 (&qr)[4], int r32, int hi) {
    const LAS unsigned char* kb = Kslot + hi * 1024 + r32 * 16;
    p0 = (f32x16){}; p1 = (f32x16){};
#pragma unroll
    for (int d0 = 0; d0 < 4; ++d0) {
        const bf16x8 b0 = *(const LAS bf16x8*)(kb + d0 * 2048);
        const bf16x8 b1 = *(const LAS bf16x8*)(kb + d0 * 2048 + 512);
        p0 = __builtin_amdgcn_mfma_f32_32x32x16_bf16(b0, qr[d0], p0, 0, 0, 0);
        p1 = __builtin_amdgcn_mfma_f32_32x32x16_bf16(b1, qr[d0], p1, 0, 0, 0);
    }
}
__device__ __forceinline__ void pv(f32x16 (&o)[2], int vb, bf16x8 pa0, bf16x8 pa1, bf16x8 pa2, bf16x8 pa3) {
#pragma unroll
    for (int d0 = 0; d0 < 2; ++d0) { s16x4 lo[4], hi[4];
#pragma unroll
        for (int ks = 0; ks < 4; ++ks) {
            asm volatile("ds_read_b64_tr_b16 %0,%1 offset:%c2" : "=&v"(lo[ks]) : "v"(vb), "i"(d0 * 4096 + ks * 1024) : "memory");
            asm volatile("ds_read_b64_tr_b16 %0,%1 offset:%c2" : "=&v"(hi[ks]) : "v"(vb), "i"(d0 * 4096 + ks * 1024 + 512) : "memory"); }
        asm volatile("s_waitcnt lgkmcnt(0)" ::: "memory"); __builtin_amdgcn_sched_barrier(0);
#define PK(k) (bf16x8){lo[k][0], lo[k][1], lo[k][2], lo[k][3], hi[k][0], hi[k][1], hi[k][2], hi[k][3]}
        o[d0] = __builtin_amdgcn_mfma_f32_32x32x16_bf16(pa0, PK(0), o[d0], 0, 0, 0);
        o[d0] = __builtin_amdgcn_mfma_f32_32x32x16_bf16(pa1, PK(1), o[d0], 0, 0, 0);
        o[d0] = __builtin_amdgcn_mfma_f32_32x32x16_bf16(pa2, PK(2), o[d0], 0, 0, 0);
        o[d0] = __builtin_amdgcn_mfma_f32_32x32x16_bf16(pa3, PK(3), o[d0], 0, 0, 0);
#undef PK
    }
}
__device__ __forceinline__ float xhalf_max(float v) { auto rr = __builtin_amdgcn_permlane32_swap(__float_as_uint(v), __float_as_uint(v), false, false); return __builtin_fmaxf(__uint_as_float(rr[0]), __uint_as_float(rr[1])); }
__device__ __forceinline__ float xhalf_sum(float v) { auto rr = __builtin_amdgcn_permlane32_swap(__float_as_uint(v), __float_as_uint(v), false, false); return __uint_as_float(rr[0]) + __uint_as_float(rr[1]); }

#define ATT_PACK(p0, p1, pw0, pw1, pw2, pw3) do { \
    pw0 = (u32x4){cvt_pk_bf16(p0[0], p0[1]), cvt_pk_bf16(p0[2], p0[3]), cvt_pk_bf16(p0[4], p0[5]), cvt_pk_bf16(p0[6], p0[7])}; \
    pw1 = (u32x4){cvt_pk_bf16(p0[8], p0[9]), cvt_pk_bf16(p0[10], p0[11]), cvt_pk_bf16(p0[12], p0[13]), cvt_pk_bf16(p0[14], p0[15])}; \
    pw2 = (u32x4){cvt_pk_bf16(p1[0], p1[1]), cvt_pk_bf16(p1[2], p1[3]), cvt_pk_bf16(p1[4], p1[5]), cvt_pk_bf16(p1[6], p1[7])}; \
    pw3 = (u32x4){cvt_pk_bf16(p1[8], p1[9]), cvt_pk_bf16(p1[10], p1[11]), cvt_pk_bf16(p1[12], p1[13]), cvt_pk_bf16(p1[14], p1[15])}; } while (0)

__device__ __forceinline__ void stage_rows(LAS unsigned char* lds, int wid, int lane, const f32x16 (&ot)[2]) {
    const int r32 = lane & 31, hi = lane >> 5;
    LAS bf16_t* stg = (LAS bf16_t*)(lds + L_OTA) + wid * 2048;
#pragma unroll
    for (int r = 0; r < 16; ++r) { const int orow = crow(r, hi);
#pragma unroll
        for (int d0 = 0; d0 < 2; ++d0) stg[orow * 64 + d0 * 32 + r32] = (bf16_t)(cvt_pk_bf16(ot[d0][r], 0.f) & 0xffffu); }
    LDS_WAIT();
}
struct StreamP { const bf16_t* Kb; const bf16_t* Vb; long pitch; int NT; const LAS unsigned char* tl; unsigned long long lanesel; int uq; const LAS float* lut; int xtop; int dclamp; };
typedef const LAS unsigned char* lds_cptr;
typedef short v4i16_t __attribute__((ext_vector_type(4)));
__device__ __forceinline__ void kload8(bf16x8* kf, lds_cptr kp) {
    kf[0] = *(const LAS bf16x8*)(kp);        kf[1] = *(const LAS bf16x8*)(kp + 512);
    kf[2] = *(const LAS bf16x8*)(kp + 2048); kf[3] = *(const LAS bf16x8*)(kp + 2560);
    kf[4] = *(const LAS bf16x8*)(kp + 4096); kf[5] = *(const LAS bf16x8*)(kp + 4608);
    kf[6] = *(const LAS bf16x8*)(kp + 6144); kf[7] = *(const LAS bf16x8*)(kp + 6656);
}
__device__ __forceinline__ void kload2(bf16x8* kf, lds_cptr kp, int j) { kf[2 * j] = *(const LAS bf16x8*)(kp + j * 2048); kf[2 * j + 1] = *(const LAS bf16x8*)(kp + j * 2048 + 512); }
__device__ __forceinline__ s16x4 vtr(lds_cptr p) { return __builtin_bit_cast(s16x4, __builtin_amdgcn_ds_read_tr16_b64_v4i16((LAS v4i16_t*)p)); }
constexpr int SLOTB = 8192;
#define ST_WAIT_BAR(N) asm volatile("s_waitcnt vmcnt(" #N ") lgkmcnt(0)\n\ts_barrier" ::: "memory")
template <int THRL>
__device__ __forceinline__ void attn_stream(LAS unsigned char* lds, const int wid, const int lane, const bf16x8 (&qr)[4], const StreamP S, float& mhat_o, float& l_o, f32x16 (&o)[2]) {
    const int r32 = lane & 31, hi = lane >> 5;
    const unsigned lds0 = (unsigned)(uintptr_t)lds;
    LAS float* wsf = (LAS float*)(lds + L_WSF) + wid * 64;
    const int NT = S.NT;
    const bf16_t* ksrc = S.Kb + (long)lane * S.pitch + wid * 8;
    const bf16_t* vsrc = S.Vb + (long)(16 * (wid & 3) + (lane >> 2)) * S.pitch + (wid >> 2) * 32 + (lane & 3) * 8;
    const unsigned kdst = lds0 + L_KR + wid * 1024, vdst = lds0 + L_VR + wid * 1024;
    const int tlv = (lane < NT) ? (int)S.tl[lane] : 0x80;
#define TLRAW(k) ((int)__builtin_amdgcn_readlane(tlv, __builtin_amdgcn_readfirstlane(k)))
#define DMA_K(k, slot) do { const int tr_ = TLRAW(k) & 63; glds16(ksrc + (long)tr_ * 64 * S.pitch, (unsigned)__builtin_amdgcn_readfirstlane(kdst + (slot))); } while (0)
#define DMA_V(k, slot) do { const int tr_ = TLRAW(k) & 63; glds16(vsrc + (long)tr_ * 64 * S.pitch, (unsigned)__builtin_amdgcn_readfirstlane(vdst + (slot))); } while (0)
    const lds_cptr kp0 = (lds_cptr)lds + L_KR + hi * 1024 + r32 * 16;
    const lds_cptr vp0 = (lds_cptr)lds + L_VR + ((lane >> 4) & 1) * 32 + (lane & 3) * 8 + (4 * hi + ((lane & 15) >> 2)) * 64;
    const int vb0 = (int)(lds0 + L_VR) + ((lane >> 4) & 1) * 32 + (lane & 3) * 8 + (4 * hi + ((lane & 15) >> 2)) * 64;
    bf16x8 kf[8];
#define LOFF(r) (((r) & 3) + 8 * ((r) >> 2))
#define LUTPTR(k, lp) do { const int raw_ = TLRAW(k); const int tj_ = raw_ & 63; int d0_ = S.uq - 64 * tj_ - 4 * hi; d0_ = d0_ < S.dclamp ? d0_ : S.dclamp; \
        const bool ok_ = (raw_ < 128) && (((S.lanesel >> tj_) & 1ull) != 0ull); lp = S.lut + (ok_ ? S.xtop - d0_ : S.xtop + 64); } while (0)
#define LUTLOAD(C0, C1, k) do { const int raw_ = TLRAW(k); const int tj_ = raw_ & 63; int d0_ = S.uq - 64 * tj_ - 4 * hi; d0_ = d0_ < S.dclamp ? d0_ : S.dclamp; \
        const bool ok_ = (raw_ < 128) && (((S.lanesel >> tj_) & 1ull) != 0ull); const LAS float* lp_ = S.lut + (ok_ ? S.xtop - d0_ : S.xtop + 64); \
        _Pragma("unroll") for (int r = 0; r < 16; ++r) { C0[r] = lp_[(r & 3) + 8 * (r >> 2)]; C1[r] = lp_[(r & 3) + 8 * (r >> 2) + 32]; } } while (0)
#define SBAR() __builtin_amdgcn_sched_barrier(0)
#define PIN(x) asm volatile("" : "+v"(x))
#define PKW(P, B) cvt_pk_bf16(P[B], P[B + 1])
#define PAF(k) __builtin_bit_cast(bf16x8, pw##k)
#define VFR(i) (bf16x8){vlo[i][0], vlo[i][1], vlo[i][2], vlo[i][3], vhi[i][0], vhi[i][1], vhi[i][2], vhi[i][3]}
#define MX3(a, b, c) __builtin_fmaxf(__builtin_fmaxf((a), (b)), (c))
#define MFMA32(a, b, c) __builtin_amdgcn_mfma_f32_32x32x16_bf16(a, b, c, 0, 0, 0)
#define GAPA(MF, A0, A1, A2, A3, W0, W1, PW) do { MF; sacc += A0; sacc += A1; sacc += A2; sacc += A3; PIN(sacc); W0; W1; PIN(PW); SBAR(); } while (0)
#define EX(v) __builtin_amdgcn_exp2f(v)
#define GAPB(MF, X, B, GN, PL, PO) do { MF; X[B] = EX(X[B]); X[B + 1] = EX(X[B + 1]); X[B + 2] = EX(X[B + 2]); X[B + 3] = EX(X[B + 3]); PIN(X); \
        if (GN) { PL[B] = lpn_[LOFF(B) + PO]; PL[B + 1] = lpn_[LOFF(B + 1) + PO]; PL[B + 2] = lpn_[LOFF(B + 2) + PO]; PL[B + 3] = lpn_[LOFF(B + 3) + PO]; } SBAR(); } while (0)
#define VRD(i) do { vlo[i] = vtr(vp_ + (((i) >> 2) * 4096 + ((i) & 3) * 1024)); vhi[i] = vtr(vp_ + (((i) >> 2) * 4096 + ((i) & 3) * 1024 + 512)); } while (0)
#define KRD(G, j) do { if (G) { kload2(kf, kp0 + sl_next, j); SBAR(); } } while (0)
#define ROT() do { sl_prev = sl_cur; sl_cur = sl_next; sl_next = (sl_next == 2 * SLOTB) ? 0 : sl_next + SLOTB; } while (0)
#define RESC() do { if (resc) { LDS_WAIT(); _Pragma("unroll") for (int d_ = 0; d_ < 2; ++d_) _Pragma("unroll") for (int r = 0; r < 16; ++r) o[d_][r] *= wsf[crow(r, hi)]; } } while (0)
#define ENDW(tt) do { if ((tt) + 3 < NT) { ST_WAIT_BAR(2); } else if ((tt) + 2 < NT) { ST_WAIT_BAR(1); } else { ST_WAIT_BAR(0); } } while (0)
#define STEP(C0, C1, P0, P1, t, GK, GV, GL, GN) do { SBAR(); \
    const lds_cptr vp_ = vp0 + sl_prev; const LAS float* lpn_ = S.lut; if (GN) { LUTPTR((t) + 1, lpn_); } \
    VRD(0); SBAR(); float sacc = (P0[0] + P0[1]); \
    GAPA(C0 = MFMA32(kf[0], qr[0], C0), P0[2], P0[3], P0[4], P0[5],     pw0[0] = PKW(P0, 0), pw0[1] = PKW(P0, 2), pw0); \
    VRD(4); SBAR(); GAPA(C1 = MFMA32(kf[1], qr[0], C1), P0[6], P0[7], P0[8], P0[9],     pw0[2] = PKW(P0, 4), pw0[3] = PKW(P0, 6), pw0); \
    VRD(1); SBAR(); GAPA(C0 = MFMA32(kf[2], qr[1], C0), P0[10], P0[11], P0[12], P0[13], pw1[0] = PKW(P0, 8), pw1[1] = PKW(P0, 10), pw1); \
    VRD(5); SBAR(); GAPA(C1 = MFMA32(kf[3], qr[1], C1), P0[14], P0[15], P1[0], P1[1],   pw1[2] = PKW(P0, 12), pw1[3] = PKW(P0, 14), pw1); \
    VRD(2); SBAR(); GAPA(C0 = MFMA32(kf[4], qr[2], C0), P1[2], P1[3], P1[4], P1[5],     pw2[0] = PKW(P1, 0), pw2[1] = PKW(P1, 2), pw2); \
    VRD(6); SBAR(); GAPA(C1 = MFMA32(kf[5], qr[2], C1), P1[6], P1[7], P1[8], P1[9],     pw2[2] = PKW(P1, 4), pw2[3] = PKW(P1, 6), pw2); \
    VRD(3); SBAR(); GAPA(C0 = MFMA32(kf[6], qr[3], C0), P1[10], P1[11], P1[12], P1[13], pw3[0] = PKW(P1, 8), pw3[1] = PKW(P1, 10), pw3); \
    VRD(7); SBAR(); GAPA(C1 = MFMA32(kf[7], qr[3], C1), P1[14], P1[15], 0.f, 0.f,       pw3[2] = PKW(P1, 12), pw3[3] = PKW(P1, 14), pw3); \
    l_reg += sacc; \
    if (GK) { DMA_K((t) + 3, sl_cur); } if (GV) { DMA_V((t) + 1, sl_next); } \
    { _Pragma("unroll") for (int r = 0; r < 16; ++r) { C0[r] -= mhat; C1[r] -= mhat; } \
      float a_ = MX3(C0[0], C0[1], C1[0]), b_ = MX3(C0[2], C0[3], C1[1]); a_ = MX3(a_, C1[2], C1[3]); \
      _Pragma("unroll") for (int r = 4; r < 16; r += 4) { a_ = MX3(a_, C0[r], C0[r + 1]); b_ = MX3(b_, C0[r + 2], C0[r + 3]); a_ = MX3(a_, C1[r], C1[r + 1]); b_ = MX3(b_, C1[r + 2], C1[r + 3]); } \
      float rm = xhalf_max(__builtin_fmaxf(a_, b_)); \
      resc = false; \
      if (__builtin_expect(__any(rm > (float)THRL), 0)) { const float dl = __builtin_fmaxf(rm, 0.f); mhat += dl; \
        _Pragma("unroll") for (int r = 0; r < 16; ++r) { C0[r] -= dl; C1[r] -= dl; } \
        const float f = __builtin_amdgcn_exp2f(-dl); l_reg *= f; if (hi == 0) wsf[r32] = f; resc = true; } } \
    SBAR(); \
    GAPB(o[0] = MFMA32(PAF(0), VFR(0), o[0]), C0, 0, GN, P0, 0); \
    GAPB(o[1] = MFMA32(PAF(0), VFR(4), o[1]), C0, 4, GN, P0, 0); \
    KRD(GL, 0); GAPB(o[0] = MFMA32(PAF(1), VFR(1), o[0]), C0, 8, GN, P0, 0); \
    KRD(GL, 1); GAPB(o[1] = MFMA32(PAF(1), VFR(5), o[1]), C0, 12, GN, P0, 0); \
    KRD(GL, 2); GAPB(o[0] = MFMA32(PAF(2), VFR(2), o[0]), C1, 0, GN, P1, 32); \
    KRD(GL, 3); GAPB(o[1] = MFMA32(PAF(2), VFR(6), o[1]), C1, 4, GN, P1, 32); \
    GAPB(o[0] = MFMA32(PAF(3), VFR(3), o[0]), C1, 8, GN, P1, 32); \
    GAPB(o[1] = MFMA32(PAF(3), VFR(7), o[1]), C1, 12, GN, P1, 32); \
    } while (0)
    float mhat = 0.f, l_reg = 0.f; bool resc = false;
    o[0] = (f32x16){}; o[1] = (f32x16){};
    f32x16 pA0, pA1, pB0, pB1;
    int sl_prev = 0, sl_cur = 0, sl_next = SLOTB;
    DMA_K(0, 0); DMA_V(0, 0); DMA_K(1, SLOTB); DMA_K(2, 2 * SLOTB);
    LUTLOAD(pA0, pA1, 0);
    ST_WAIT_BAR(3);
    { const lds_cptr kb = kp0;
#pragma unroll
      for (int d0 = 0; d0 < 4; ++d0) { const bf16x8 b0 = *(const LAS bf16x8*)(kb + d0 * 2048); const bf16x8 b1 = *(const LAS bf16x8*)(kb + d0 * 2048 + 512);
          pA0 = MFMA32(b0, qr[d0], pA0); pA1 = MFMA32(b1, qr[d0], pA1); }
      float rm = pA0[0];
#pragma unroll
      for (int r = 1; r < 16; ++r) rm = __builtin_fmaxf(rm, pA0[r]);
#pragma unroll
      for (int r = 0; r < 16; ++r) rm = __builtin_fmaxf(rm, pA1[r]);
      rm = xhalf_max(rm);
      mhat = (rm == -INFINITY) ? 0.f : rm;
#pragma unroll
      for (int r = 0; r < 16; ++r) { pA0[r] = EX(pA0[r] - mhat); pA1[r] = EX(pA1[r] - mhat); } }
    ST_WAIT_BAR(0);
    DMA_K(3, 0); DMA_V(1, SLOTB);
    ROT();
    kload8(kf, kp0 + sl_cur);
    LUTLOAD(pB0, pB1, 1);
    ST_WAIT_BAR(2);
    s16x4 vlo[8], vhi[8]; u32x4 pw0, pw1, pw2, pw3;
    int t = 1;
    for (; t + 5 < NT; t += 2) {
        STEP(pB0, pB1, pA0, pA1, t, true, true, true, true);     ST_WAIT_BAR(2); RESC(); ROT();
        STEP(pA0, pA1, pB0, pB1, t + 1, true, true, true, true); ST_WAIT_BAR(2); RESC(); ROT();
    }
    for (; t + 1 < NT; t += 2) {
        STEP(pB0, pB1, pA0, pA1, t, (t + 3 < NT), (t + 1 < NT), (t + 1 < NT), true);       ENDW(t);     RESC(); ROT();
        STEP(pA0, pA1, pB0, pB1, t + 1, (t + 4 < NT), (t + 2 < NT), (t + 2 < NT), true);   ENDW(t + 1); RESC(); ROT();
    }
    STEP(pB0, pB1, pA0, pA1, NT - 1, false, false, false, false); RESC();
    { float sacc = pB0[0] + pB0[1];
#pragma unroll
      for (int r = 2; r < 16; ++r) sacc += pB0[r];
#pragma unroll
      for (int r = 0; r < 16; ++r) sacc += pB1[r];
      l_reg += sacc;
      ATT_PACK(pB0, pB1, pw0, pw1, pw2, pw3);
      SBAR(); pv(o, vb0 + sl_cur, PAF(0), PAF(1), PAF(2), PAF(3)); }
    asm volatile("s_waitcnt lgkmcnt(0)\n\ts_barrier" ::: "memory");
    mhat_o = mhat; l_o = l_reg;
#undef TLRAW
#undef DMA_K
#undef DMA_V
#undef LUTLOAD
#undef LUTPTR
#undef LOFF
#undef SBAR
#undef PIN
#undef PKW
#undef PAF
#undef VFR
#undef MX3
#undef MFMA32
#undef GAPA
#undef EX
#undef GAPB
#undef VRD
#undef KRD
#undef ROT
#undef RESC
#undef ENDW
#undef STEP
}
__device__ __forceinline__ void cmp_scores(f32x16& s0, f32x16& s1, LAS unsigned char* lds, const LAS unsigned char* bkc, const LAS unsigned char* tb, const bf16x8 (&qr)[4], const int k, const int r32, const int hi) {
#pragma unroll
    for (int r = 0; r < 16; ++r) { const int off = 16 * ((r & 3) + 8 * (r >> 2));
        s0[r] = *(const LAS float*)(tb + bkc[1024 * k + off]); s1[r] = *(const LAS float*)(tb + bkc[1024 * k + off + 512]); }
    const LAS unsigned char* kb = lds + k * 8192 + hi * 1024 + r32 * 16;
#pragma unroll
    for (int d0 = 0; d0 < 4; ++d0) { const bf16x8 b0 = *(const LAS bf16x8*)(kb + d0 * 2048); const bf16x8 b1 = *(const LAS bf16x8*)(kb + d0 * 2048 + 512);
        s0 = __builtin_amdgcn_mfma_f32_32x32x16_bf16(b0, qr[d0], s0, 0, 0, 0); s1 = __builtin_amdgcn_mfma_f32_32x32x16_bf16(b1, qr[d0], s1, 0, 0, 0); }
}
__device__ __forceinline__ float xhalf_other(float v, int hi) { auto rr = __builtin_amdgcn_permlane32_swap(__float_as_uint(v), __float_as_uint(v), false, false); return __uint_as_float(hi ? rr[0] : rr[1]); }
__device__ __forceinline__ void cmp_branch(LAS unsigned char* lds, const int wid, const int lane, const bf16x8 (&qr)[4], const bf16_t* Kb, const bf16_t* Vb, const int nt, const int t, f32x16 (&o)[2]) {
    const int r32 = lane & 31, hi = lane >> 5, g = wid >> 1, tq = (wid & 1) * 32 + r32;
    const unsigned lds0 = (unsigned)(uintptr_t)lds;
    { const bf16_t* ksrc = Kb + (long)lane * 64 + wid * 8; const bf16_t* vsrc = Vb + (long)(16 * (wid & 3) + (lane >> 2)) * 64 + (wid >> 2) * 32 + (lane & 3) * 8;
      for (int k = 0; k < nt; ++k) { glds16(ksrc + (long)k * 4096, (unsigned)__builtin_amdgcn_readfirstlane(lds0 + k * 8192 + wid * 1024));
                                     glds16(vsrc + (long)k * 4096, (unsigned)__builtin_amdgcn_readfirstlane(lds0 + L_OTA + k * 8192 + wid * 1024)); } }
    const LAS unsigned char* bkc = lds + L_BKC + (4126 - t + 64 * hi);
    const LAS unsigned char* tb = lds + L_TBH + g * 144;
    asm volatile("s_waitcnt vmcnt(0)\n\ts_barrier" ::: "memory");
    float m = -INFINITY, l = 0.f;
#pragma clang loop unroll(disable)
    for (int k = 0; k < nt; ++k) { f32x16 s0, s1; cmp_scores(s0, s1, lds, bkc, tb, qr, k, r32, hi);
        float rm = s0[0];
#pragma unroll
        for (int r = 1; r < 16; ++r) rm = __builtin_fmaxf(rm, s0[r]);
#pragma unroll
        for (int r = 0; r < 16; ++r) rm = __builtin_fmaxf(rm, s1[r]);
        rm = xhalf_max(rm);
        const float mn = __builtin_fmaxf(m, rm), ms = (mn == -INFINITY) ? 0.f : mn;
        float ps = 0.f;
#pragma unroll
        for (int r = 0; r < 16; ++r) ps += __builtin_amdgcn_exp2f(s0[r] - ms) + __builtin_amdgcn_exp2f(s1[r] - ms);
        l = l * __builtin_amdgcn_exp2f(m - ms) + ps; m = mn; }
    l = xhalf_sum(l);
    const float msafe = (m == -INFINITY) ? 0.f : m, inv = l > 0.f ? 1.0f / l : 0.f;
    float I[4][8]; float pc7 = 0.f;
    o[0] = (f32x16){}; o[1] = (f32x16){};
    const int vb0 = (int)(lds0 + L_OTA) + ((lane >> 4) & 1) * 32 + (lane & 3) * 8 + (4 * hi + ((lane & 15) >> 2)) * 64;
#pragma unroll
    for (int k = 0; k < 4; ++k) {
        if (k < nt) { f32x16 s0, s1; cmp_scores(s0, s1, lds, bkc, tb, qr, k, r32, hi);
#pragma unroll
            for (int r = 0; r < 16; ++r) { s0[r] = __builtin_amdgcn_exp2f(s0[r] - msafe) * inv; s1[r] = __builtin_amdgcn_exp2f(s1[r] - msafe) * inv; }
            float pc[8];
#pragma unroll
            for (int q = 0; q < 4; ++q) { I[k][q] = 2.0f * (s0[4 * q] + s0[4 * q + 1] + s0[4 * q + 2]) + s0[4 * q + 3]; I[k][4 + q] = 2.0f * (s1[4 * q] + s1[4 * q + 1] + s1[4 * q + 2]) + s1[4 * q + 3];
                pc[q] = xhalf_other(s0[4 * q + 3], hi); pc[4 + q] = xhalf_other(s1[4 * q + 3], hi); }
#pragma unroll
            for (int j = 0; j < 8; ++j) I[k][j] += hi ? pc[j] : (j > 0 ? pc[j - 1] : pc7);
            pc7 = pc[7];
            u32x4 pw0, pw1, pw2, pw3; ATT_PACK(s0, s1, pw0, pw1, pw2, pw3);
            pv(o, vb0 + k * 8192, __builtin_bit_cast(bf16x8, pw0), __builtin_bit_cast(bf16x8, pw1), __builtin_bit_cast(bf16x8, pw2), __builtin_bit_cast(bf16x8, pw3));
        } else {
#pragma unroll
            for (int j = 0; j < 8; ++j) I[k][j] = 0.f;
        }
    }
    LAS float* imp = (LAS float*)(lds + L_IMP) + tq * 64 + hi;
#pragma unroll 1
    for (int gi = 0; gi < 4; ++gi) {
        if (g == gi) {
#pragma unroll
            for (int k = 0; k < 4; ++k) if (k < nt) {
#pragma unroll
                for (int j = 0; j < 8; ++j) __builtin_amdgcn_ds_faddf(imp + 16 * k + 2 * j, I[k][j], 0, 0, false);
            }
        }
        asm volatile("s_waitcnt lgkmcnt(0)\n\ts_barrier" ::: "memory");
    }
}
}

struct Ctx { int tid, lane, wave, vcu, G, bx; LAS unsigned char* lds; };

__device__ __forceinline__ void tr_item(const float* W, size_t ldw, int srccol, int nvalid, bf16_t* WT, size_t ldk, int dstrow, int k0, LAS float* scr, int lane) {
#pragma unroll 8
    for (int i = 0; i < 32; ++i) { const int kk = 2 * i + (lane >> 5), n = lane & 31; scr[kk * 33 + n] = (n < nvalid) ? W[(size_t)(k0 + kk) * ldw + srccol + n] : 0.f; }
    LDS_WAIT(); asm volatile("" ::: "memory");
    const int c = lane & 7;
#pragma unroll
    for (int j = 0; j < 4; ++j) { const int n = (lane >> 3) + 8 * j; const LAS float* s = scr + (8 * c) * 33 + n;
        u32x4 o; o.x = cvt_pk_bf16(s[0 * 33], s[1 * 33]); o.y = cvt_pk_bf16(s[2 * 33], s[3 * 33]); o.z = cvt_pk_bf16(s[4 * 33], s[5 * 33]); o.w = cvt_pk_bf16(s[6 * 33], s[7 * 33]);
        *(u32x4*)(WT + (size_t)(dstrow + n) * ldk + k0 + 8 * c) = o; }
    LDS_WAIT(); asm volatile("" ::: "memory");
}
__device__ __forceinline__ void conv_small(const Args& a, const Ctx& C) {
    LAS float* scr = (LAS float*)(C.lds + C.wave * 16384);
    const int gw = C.vcu * NWAVES + C.wave, NGW = C.G * NWAVES;
    constexpr int I_WIN = 184 * 16, I_CW1 = 2 * 8 * 32, I_WUN = 32 * 8, I_WUD = 32 * 4, I_WO = 32 * 16, I_CW2 = 2 * 2 * 4;
    constexpr int PER = I_WIN + I_CW1 + I_WUN + I_WUD + I_WO + I_CW2;
    unsigned char* ws = a.ws;
    for (int it = gw; it < 2 * PER; it += NGW) {
        const int l = it / PER; int r = it % PER;
        if (r < I_WIN) { const int nb = r / 16, kb = r % 16; const int nd = 32 * nb; int src, nv = 32;
            if (nd < 1280) src = nd; else if (nd < 5632) src = nd + 24; else if (nd == 5632) { src = 1280; nv = 24; } else { src = 0; nv = 0; }
            tr_item(a.w_in + (size_t)l * DM * INW, INW, src, nv, (bf16_t*)(ws + WS_WINT) + (size_t)l * NIN * DM, DM, nd, 64 * kb, scr, C.lane); continue; }
        r -= I_WIN;
        if (r < I_CW1) { const int kv = r / 256, q = r % 256, nb = q / 32, kb = q % 32;
            tr_item(a.cmp_w1 + (size_t)(l * 2 + kv) * 2048 * 256, 256, 32 * nb, 32, (bf16_t*)(ws + WS_CW1T) + (size_t)(l * 2 + kv) * 256 * 2048, 2048, 32 * nb, 64 * kb, scr, C.lane); continue; }
        r -= I_CW1;
        if (r < I_WUN) { const int nb = r / 8, kb = r % 8;
            tr_item(a.w_up_nsa + (size_t)l * 512 * 1024, 1024, 32 * nb, 32, (bf16_t*)(ws + WS_WUNT) + (size_t)l * 1024 * 512, 512, 32 * nb, 64 * kb, scr, C.lane); continue; }
        r -= I_WUN;
        if (r < I_WUD) { const int nb = r / 4, kb = r % 4;
            tr_item(a.w_up_dil + (size_t)l * 256 * 1024, 1024, 32 * nb, 32, (bf16_t*)(ws + WS_WUDT) + (size_t)l * 1024 * 256, 256, 32 * nb, 64 * kb, scr, C.lane); continue; }
        r -= I_WUD;
        if (r < I_WO) { const int nb = r / 16, kb = r % 16;
            tr_item(a.w_o + (size_t)l * 1024 * 1024, 1024, 32 * nb, 32, (bf16_t*)(ws + WS_WOT) + (size_t)l * 1024 * 1024, 1024, 32 * nb, 64 * kb, scr, C.lane); continue; }
        r -= I_WO;
        { const int kv = r / 8, q = r % 8, nb = q / 4, kb = q % 4;
            tr_item(a.cmp_w2 + (size_t)(l * 2 + kv) * 256 * 64, 64, 32 * nb, 32, (bf16_t*)(ws + WS_CW2T) + (size_t)(l * 2 + kv) * 64 * 256, 256, 32 * nb, 64 * kb, scr, C.lane); }
    }
}
__device__ __forceinline__ void conv_experts(const Args& a, const Ctx& C, int l) {
    LAS float* scr = (LAS float*)(C.lds + C.wave * 16384);
    const int gw = C.vcu * NWAVES + C.wave, NGW = C.G * NWAVES;
    constexpr int I_13 = 32 * 16, I_2 = 32 * 8, PER = I_13 + I_2;
    unsigned char* ws = a.ws;
    for (int it = gw; it < 32 * PER; it += NGW) {
        const int e = it / PER; int r = it % PER;
        if (r < I_13) { const int nb = r / 16, kb = r % 16; const int r0 = 32 * nb, pn = r0 >> 8, bj = (r0 >> 7) & 1, j0 = r0 & 127;
            const float* src = (bj ? a.exp_w3 : a.exp_w1) + (size_t)(l * 32 + e) * 1024 * 512;
            tr_item(src, 512, pn * 128 + j0, 32, (bf16_t*)(ws + WS_E13T) + (size_t)e * 1024 * 1024, 1024, r0, 64 * kb, scr, C.lane); continue; }
        r -= I_13;
        { const int nb = r / 8, kb = r % 8;
            tr_item(a.exp_w2 + (size_t)(l * 32 + e) * 512 * 1024, 1024, 32 * nb, 32, (bf16_t*)(ws + WS_E2T) + (size_t)e * 1024 * 512, 512, 32 * nb, 64 * kb, scr, C.lane); }
    }
}
__device__ __forceinline__ void prologue_vectors(const Args& a, const Ctx& C) {
    LAS float* sc = (LAS float*)(C.lds + 131072);
    LAS float* sl = (LAS float*)(C.lds);
    for (int i = C.tid; i < 8 * 1024; i += NTHR) { const float v = a.c[i]; sl[i] = v * sigmoidf_(v); }
    (void)sc;
    __syncthreads();
    const int gw = C.vcu * NWAVES + C.wave, NGW = C.G * NWAVES;
    float* MOD = (float*)(a.ws + WS_MOD); float* CB1 = (float*)(a.ws + WS_CB1);
    for (int it = gw; it < 192 + 16; it += NGW) {
        if (it < 192) { const int l = it / 96, col = (it % 96) * 64 + C.lane;
            const float* w = a.ada_w + (size_t)l * 1024 * 6144 + col;
            float acc[8];
#pragma unroll
            for (int b = 0; b < 8; ++b) acc[b] = 0.f;
            for (int k = 0; k < 1024; ++k) { const float wv = w[(size_t)k * 6144];
#pragma unroll
                for (int b = 0; b < 8; ++b) acc[b] += sl[b * 1024 + k] * wv; }
            const float bias = a.ada_b[l * 6144 + col];
#pragma unroll
            for (int b = 0; b < 8; ++b) MOD[(size_t)(l * 8 + b) * 6144 + col] = acc[b] + bias;
        } else { const int q = it - 192, lk = q / 4, col = (q % 4) * 64 + C.lane;
            const float* w = a.cmp_w1 + (size_t)lk * 2048 * 256 + col; const float* pos = a.cmp_pos + (size_t)lk * 2048;
            float acc = 0.f;
            for (int k = 0; k < 2048; ++k) acc += pos[k] * w[(size_t)k * 256];
            CB1[lk * 256 + col] = acc;
        }
    }
    __syncthreads();
}

__device__ __forceinline__ void moe_combine_row(const Args& a, int row, int lane, const float* g2  , f32x4 (&v)[4]) {
    const u32x4 rec = *(const u32x4*)(a.ws + WS_DEST + (size_t)row * 16);
    const bf16_t* Y = (const bf16_t*)(a.ws + WS_XS);
    const float w0 = (ABL == 6) ? 0.f : __uint_as_float(rec.z), w1 = (ABL == 6) ? 0.f : __uint_as_float(rec.w);
    const u32x2* y0 = (const u32x2*)(Y + (size_t)rec.x * 1024) + lane; const u32x2* y1 = (const u32x2*)(Y + (size_t)rec.y * 1024) + lane;
#pragma unroll
    for (int j = 0; j < 4; ++j) { const u32x2 p = y0[64 * j], q = y1[64 * j]; const f32x4 gg = *((const f32x4*)g2 + lane + 64 * j);
        v[j][0] += gg[0] * (w0 * bf_lo(p.x) + w1 * bf_lo(q.x)); v[j][1] += gg[1] * (w0 * bf_hi(p.x) + w1 * bf_hi(q.x));
        v[j][2] += gg[2] * (w0 * bf_lo(p.y) + w1 * bf_lo(q.y)); v[j][3] += gg[3] * (w0 * bf_hi(p.y) + w1 * bf_hi(q.y)); }
}
__device__ __forceinline__ void norm1_phase(const Args& a, const Ctx& C, int l) {
    const int gw = C.vcu * NWAVES + C.wave, NGW = C.G * NWAVES;
    const float* MOD = (const float*)(a.ws + WS_MOD); bf16_t* H = (bf16_t*)(a.ws + WS_H);
    const float* nw = a.norm1 + l * 1024;
    for (int row = gw; row < T; row += NGW) {
        const int b = row >> 12; const float* xr = (l == 0 ? a.x : (const float*)a.out) + (size_t)row * 1024;
        f32x4 v[4];
#pragma unroll
        for (int j = 0; j < 4; ++j) v[j] = *((const f32x4*)xr + C.lane + 64 * j);
        if (l == 1) { moe_combine_row(a, row, C.lane, MOD + (size_t)(0 * 8 + b) * 6144 + 5120, v);
#pragma unroll
            for (int j = 0; j < 4; ++j) *((f32x4*)(a.out + (size_t)row * 1024) + C.lane + 64 * j) = v[j]; }
        float ss = 0.f;
#pragma unroll
        for (int j = 0; j < 4; ++j) ss += (v[j][0] * v[j][0] + v[j][1] * v[j][1]) + (v[j][2] * v[j][2] + v[j][3] * v[j][3]);
        const float rstd = 1.0f / sqrtf(wave_sum(ss) * (1.0f / 1024.0f) + RMS_EPS);
        const float* mb = MOD + (size_t)(l * 8 + b) * 6144;
#pragma unroll
        for (int j = 0; j < 4; ++j) { const f32x4 g = *((const f32x4*)nw + C.lane + 64 * j), sh = *((const f32x4*)mb + C.lane + 64 * j), sc = *((const f32x4*)(mb + 1024) + C.lane + 64 * j);
            const f32x4 h = v[j] * rstd * g * (sc + 1.0f) + sh; u32x2 w; w.x = cvt_pk_bf16(h[0], h[1]); w.y = cvt_pk_bf16(h[2], h[3]);
            *((u32x2*)(H + (size_t)row * 1024) + C.lane + 64 * j) = w; }
    }
}
__device__ __forceinline__ void final_phase(const Args& a, const Ctx& C) {
    const int gw = C.vcu * NWAVES + C.wave, NGW = C.G * NWAVES;
    const float* MOD = (const float*)(a.ws + WS_MOD);
    for (int row = gw; row < T; row += NGW) {
        const int b = row >> 12; float* xr = a.out + (size_t)row * 1024;
        f32x4 v[4];
#pragma unroll
        for (int j = 0; j < 4; ++j) v[j] = *((const f32x4*)xr + C.lane + 64 * j);
        moe_combine_row(a, row, C.lane, MOD + (size_t)(1 * 8 + b) * 6144 + 5120, v);
        float ss = 0.f;
#pragma unroll
        for (int j = 0; j < 4; ++j) ss += (v[j][0] * v[j][0] + v[j][1] * v[j][1]) + (v[j][2] * v[j][2] + v[j][3] * v[j][3]);
        const float rstd = 1.0f / sqrtf(wave_sum(ss) * (1.0f / 1024.0f) + RMS_EPS);
#pragma unroll
        for (int j = 0; j < 4; ++j) { const f32x4 g = *((const f32x4*)a.norm_f + C.lane + 64 * j); *((f32x4*)xr + C.lane + 64 * j) = v[j] * rstd * g; }
    }
}
__device__ __forceinline__ void norm2_router_phase(const Args& a, const Ctx& C, int l) {
    LAS float* WL = (LAS float*)(C.lds);
    LAS int* wcnt = (LAS int*)(C.lds + LDS_MISC + 256);
    const float* wg = a.router_wg + (size_t)l * 1024 * 4; const float* we = a.router_we + (size_t)l * 1024 * 32;
    for (int i = C.tid; i < 1024 * 4; i += NTHR) { const int k = i >> 2, c = i & 3; WL[c * 1024 + k] = wg[i]; }
    for (int i = C.tid; i < 1024 * 32; i += NTHR) { const int k = i >> 5, c = i & 31; WL[(4 + c) * 1024 + k] = we[i]; }
    __syncthreads();
    const float* MOD = (const float*)(a.ws + WS_MOD); bf16_t* H2 = (bf16_t*)(a.ws + WS_H2);
    const float* nw = a.norm2 + l * 1024; const float* bg = a.router_bg + l * 4; const float* be = a.router_be + l * 32;
    int* CNTBLK = (int*)(a.ws + WS_CNTBLK);
    for (int ch = C.vcu; ch < T / 128; ch += C.G) {
        int my_e0 = 0, my_e1 = 0; float my_w0 = 0.f, my_w1 = 0.f;
        for (int j = 0; j < 16; ++j) {
            const int row = ch * 128 + C.wave * 16 + j; const int b = row >> 12;
            const float* xr = a.out + (size_t)row * 1024;
            f32x4 v[4];
#pragma unroll
            for (int q = 0; q < 4; ++q) v[q] = *((const f32x4*)xr + C.lane + 64 * q);
            float ss = 0.f;
#pragma unroll
            for (int q = 0; q < 4; ++q) ss += (v[q][0] * v[q][0] + v[q][1] * v[q][1]) + (v[q][2] * v[q][2] + v[q][3] * v[q][3]);
            const float rstd = 1.0f / sqrtf(wave_sum(ss) * (1.0f / 1024.0f) + RMS_EPS);
            const float* mb = MOD + (size_t)(l * 8 + b) * 6144 + 3072;
#pragma unroll
            for (int q = 0; q < 4; ++q) { const f32x4 g = *((const f32x4*)nw + C.lane + 64 * q), sh = *((const f32x4*)mb + C.lane + 64 * q), sc = *((const f32x4*)(mb + 1024) + C.lane + 64 * q);
                v[q] = v[q] * rstd * g * (sc + 1.0f) + sh; u32x2 w; w.x = cvt_pk_bf16(v[q][0], v[q][1]); w.y = cvt_pk_bf16(v[q][2], v[q][3]);
                *((u32x2*)(H2 + (size_t)row * 1024) + C.lane + 64 * q) = w; }
            float lg[4];
#pragma unroll
            for (int c = 0; c < 4; ++c) { float s = 0.f;
#pragma unroll
                for (int q = 0; q < 4; ++q) { const f32x4 w = *((const LAS f32x4*)(WL + c * 1024) + C.lane + 64 * q); s += (v[q][0] * w[0] + v[q][1] * w[1]) + (v[q][2] * w[2] + v[q][3] * w[3]); }
                lg[c] = wave_sum(s) + bg[c]; }
            int grp = 0; float gmax = lg[0];
#pragma unroll
            for (int c = 1; c < 4; ++c) if (lg[c] > gmax) { gmax = lg[c]; grp = c; }
            float gs = 0.f;
#pragma unroll
            for (int c = 0; c < 4; ++c) gs += __builtin_amdgcn_exp2f((lg[c] - gmax) * LOG2E);
            const float pgrp = 1.0f / gs;
            grp = __builtin_amdgcn_readfirstlane(grp);
            float le[8];
#pragma unroll
            for (int e = 0; e < 8; ++e) { float s = 0.f; const LAS float* wrow = WL + (4 + grp * 8 + e) * 1024;
#pragma unroll
                for (int q = 0; q < 4; ++q) { const f32x4 w = *((const LAS f32x4*)wrow + C.lane + 64 * q); s += (v[q][0] * w[0] + v[q][1] * w[1]) + (v[q][2] * w[2] + v[q][3] * w[3]); }
                le[e] = wave_sum(s) + be[grp * 8 + e]; }
            int i0 = 0; float v0 = le[0];
#pragma unroll
            for (int e = 1; e < 8; ++e) if (le[e] > v0) { v0 = le[e]; i0 = e; }
            int i1 = -1; float v1 = -INFINITY;
#pragma unroll
            for (int e = 0; e < 8; ++e) if (e != i0 && le[e] > v1) { v1 = le[e]; i1 = e; }
            const float ex = __builtin_amdgcn_exp2f((v1 - v0) * LOG2E);
            const float w0 = pgrp / (1.0f + ex), w1 = pgrp * ex / (1.0f + ex);
            if (C.lane == j) { my_e0 = grp * 8 + i0; my_e1 = grp * 8 + i1; my_w0 = w0; my_w1 = w1; }
        }
        const int ea = bperm_i(C.lane >> 1, my_e0), eb = bperm_i(C.lane >> 1, my_e1);
        const int es = (C.lane < 32) ? ((C.lane & 1) ? eb : ea) : -1;
        int rank = 0, cnt = 0;
#pragma unroll
        for (int s = 0; s < 32; ++s) { const int v = __builtin_amdgcn_readlane(es, s); rank += (v == es && s < C.lane) ? 1 : 0; cnt += (v == C.lane) ? 1 : 0; }
        __syncthreads();
        if (C.lane < 32) wcnt[C.wave * 32 + C.lane] = cnt;
        __syncthreads();
        int lrank = rank;
        if (C.lane < 32) { for (int w = 0; w < C.wave; ++w) lrank += wcnt[w * 32 + es]; }
        if (C.wave == 0 && C.lane < 32) { int tot = 0;
#pragma unroll
            for (int w = 0; w < 8; ++w) tot += wcnt[w * 32 + C.lane];
            CNTBLK[ch * 32 + C.lane] = tot; }
        const int lr0 = bperm_i((2 * C.lane) & 63, lrank), lr1 = bperm_i((2 * C.lane + 1) & 63, lrank);
        if (C.lane < 16) { const int row = ch * 128 + C.wave * 16 + C.lane;
            u32x4 rec; rec.x = (unsigned)my_e0 | ((unsigned)my_e1 << 8); rec.y = (unsigned)lr0 | ((unsigned)lr1 << 16); rec.z = __float_as_uint(my_w0); rec.w = __float_as_uint(my_w1);
            *(u32x4*)(a.ws + WS_REC + (size_t)row * 16) = rec; }
    }
}
__device__ __forceinline__ void moe_scatter_phase(const Args& a, const Ctx& C) {
    LAS int* part_lt = (LAS int*)(C.lds);
    LAS int* part_all = part_lt + 512;
    LAS int* base = part_all + 512;
    LAS int* tot = base + 32;
    LAS int* pst = tot + 32;
    const int* CNTBLK = (const int*)(a.ws + WS_CNTBLK);
    int* TILEE = (int*)(a.ws + WS_TILEE);
    const bf16_t* H2 = (const bf16_t*)(a.ws + WS_H2); bf16_t* XS = (bf16_t*)(a.ws + WS_XS);
    for (int ch = C.vcu; ch < T / 128; ch += C.G) {
        __syncthreads();
        { const int e = C.tid & 31, p = C.tid >> 5; int slt = 0, sall = 0;
            for (int c = p; c < T / 128; c += 16) { const int v = CNTBLK[c * 32 + e]; sall += v; slt += (c < ch) ? v : 0; }
            part_lt[p * 32 + e] = slt; part_all[p * 32 + e] = sall; }
        __syncthreads();
        if (C.tid < 32) { int b = 0, t2 = 0;
#pragma unroll
            for (int p = 0; p < 16; ++p) { b += part_lt[p * 32 + C.tid]; t2 += part_all[p * 32 + C.tid]; }
            base[C.tid] = b; tot[C.tid] = t2; }
        __syncthreads();
        if (C.tid < 32) { int ps = 0; for (int e = 0; e < C.tid; ++e) ps += (tot[e] + 255) & ~255; pst[C.tid] = ps;
            if (ch == 0) { const int nt = (tot[C.tid] + 255) >> 8; const int t0 = ps >> 8; for (int m = 0; m < nt; ++m) TILEE[16 + t0 + m] = C.tid; if (C.tid == 31) TILEE[0] = t0 + nt; } }
        __syncthreads();
        int d0 = 0, d1 = 0;
        if (C.lane < 16) { const int row = ch * 128 + C.wave * 16 + C.lane;
            const u32x4 rec = *(const u32x4*)(a.ws + WS_REC + (size_t)row * 16);
            const int e0 = rec.x & 255, e1 = (rec.x >> 8) & 255;
            d0 = pst[e0] + base[e0] + (int)(rec.y & 0xffffu); d1 = pst[e1] + base[e1] + (int)(rec.y >> 16);
            u32x4 o; o.x = (unsigned)d0; o.y = (unsigned)d1; o.z = rec.z; o.w = rec.w;
            *(u32x4*)(a.ws + WS_DEST + (size_t)row * 16) = o; }
        for (int j = 0; j < 16; ++j) { const int row = ch * 128 + C.wave * 16 + j;
            const int t0 = __builtin_amdgcn_readlane(d0, j), t1 = __builtin_amdgcn_readlane(d1, j);
            const u32x4* src = (const u32x4*)(H2 + (size_t)row * 1024) + C.lane;
            const u32x4 va = src[0], vb = src[64];
            u32x4* o0 = (u32x4*)(XS + (size_t)t0 * 1024) + C.lane; u32x4* o1 = (u32x4*)(XS + (size_t)t1 * 1024) + C.lane;
            o0[0] = va; o0[64] = vb; o1[0] = va; o1[64] = vb; }
    }
}
struct MoeOrder {
    int G, c, nu; int ex[8]; const char* A; const char* B; size_t tA, tB, eB;
    __device__ __forceinline__ bool next(int i, pg8::Unit& u) const {
        const int L = i * G + c; if (i >= 8 || L >= nu) return false;
        const int e = i == 0 ? ex[0] : i == 1 ? ex[1] : i == 2 ? ex[2] : i == 3 ? ex[3] : i == 4 ? ex[4] : i == 5 ? ex[5] : i == 6 ? ex[6] : ex[7];
        u.pm = L >> 2; u.pn = L & 3; u.A = A + (size_t)u.pm * tA; u.B = B + (size_t)e * eB + (size_t)u.pn * tB; return true;
    }
};

__device__ __forceinline__ void dil_unit(const Args& a, const Ctx& C, int du) {
    using namespace att;
    LAS unsigned char* lds = C.lds;
    const int x = du & 15; int r = du >> 4; const int h = r & 3; r >>= 2; const int grp = r % 3, b = r / 3;
    const int dsh = 2 * grp, d = 1 << dsh; const int nub = 16 >> dsh; const int res = x / nub, ub = x % nub;
    const int wid = C.wave, lane = C.lane, r32 = lane & 31, hi = lane >> 5;
    LAS float* lut = (LAS float*)(lds + L_LUT);
    LAS unsigned char* tl = lds + L_SEL + 768;
    __syncthreads();
    for (int e = C.tid; e < 704; e += NTHR) { const int m = 384 - e; float v = -INFINITY;
        if (m >= 0 && m <= 128) { int di = m << dsh; di = di > 4095 ? 4095 : di; v = a.rel_bias[(int)lds[L_BKT + di] * 20 + 8 + grp * 4 + h] * LOG2E; }
        lut[e] = v; }
    if (C.tid < 6) { const int kt = 4 * ub - 2 + C.tid; tl[C.tid] = (unsigned char)(kt < 0 ? 0x80 : kt); }
    const bf16_t* QKV = (const bf16_t*)(a.ws + WS_A);
    const int u = 256 * ub + 32 * wid + r32; const size_t tokq = (size_t)b * SEQ + (size_t)u * d + res;
    const bf16_t* qp = QKV + tokq * LDQ + 1280 + grp * 256 + h * 64;
    bf16x8 qr[4];
#pragma unroll
    for (int d0 = 0; d0 < 4; ++d0) qr[d0] = *(const bf16x8*)(qp + d0 * 16 + hi * 8);
    __syncthreads();
    StreamP S; S.Kb = QKV + ((size_t)b * SEQ + res) * LDQ + 1280 + 768 + grp * 256 + h * 64; S.Vb = S.Kb + 768; S.pitch = (long)d * LDQ;
    S.NT = 6; S.tl = tl; S.lanesel = ~0ull; S.uq = u; S.lut = lut; S.xtop = 384; S.dclamp = 1 << 30;
    float m = 0.f, l = 0.f; f32x16 o[2];
    attn_stream<8>(lds, wid, lane, qr, S, m, l, o);
    l = xhalf_sum(l);
    LAS float* wsf = (LAS float*)(lds + L_WSF) + wid * 64;
    if (hi == 0) { wsf[r32] = l > 0.f ? 1.0f / l : 0.f; ((float*)(a.ws + WS_LSE))[((size_t)grp * T + tokq) * 4 + h] = m + __builtin_amdgcn_logf(l); }
    LDS_WAIT();
#pragma unroll
    for (int rr = 0; rr < 16; ++rr) { const float f = wsf[crow(rr, hi)]; o[0][rr] *= f; o[1][rr] *= f; }
    stage_rows(lds, wid, lane, o);
    bf16_t* ODP = (bf16_t*)(a.ws + WS_ODP) + (size_t)grp * T * 256;
    const LAS bf16_t* stg = (const LAS bf16_t*)(lds + L_OTA) + wid * 2048;
#pragma unroll
    for (int i = 0; i < 4; ++i) { const int row = i * 8 + (lane >> 3), chn = lane & 7; const u32x4 v = *(const LAS u32x4*)(stg + row * 64 + chn * 8);
        const size_t tok = (size_t)b * SEQ + (size_t)(256 * ub + 32 * wid + row) * d + res;
        *(u32x4*)(ODP + tok * 256 + h * 64 + chn * 8) = v; }
}
__device__ __forceinline__ void dil_combine(const Args& a, const Ctx& C) {
    const float* LSE = (const float*)(a.ws + WS_LSE); const bf16_t* ODP = (const bf16_t*)(a.ws + WS_ODP); bf16_t* ODIL = (bf16_t*)(a.ws + WS_ODIL);
    const int gt = C.vcu * NTHR + C.tid, NT = C.G * NTHR;
    for (int idx = gt; idx < T * 32; idx += NT) {
        const int tok = idx >> 5, h = (idx >> 3) & 3, chn = idx & 7;
        const float l0 = LSE[((size_t)0 * T + tok) * 4 + h], l1 = LSE[((size_t)1 * T + tok) * 4 + h], l2 = LSE[((size_t)2 * T + tok) * 4 + h];
        const float mx = __builtin_fmaxf(l0, __builtin_fmaxf(l1, l2));
        float w0 = __builtin_amdgcn_exp2f(l0 - mx), w1 = __builtin_amdgcn_exp2f(l1 - mx), w2 = __builtin_amdgcn_exp2f(l2 - mx);
        const float inv = 1.0f / (w0 + w1 + w2); w0 *= inv; w1 *= inv; w2 *= inv;
        const size_t off = (size_t)tok * 256 + h * 64 + chn * 8;
        const u32x4 a0 = *(const u32x4*)(ODP + off), a1 = *(const u32x4*)(ODP + (size_t)T * 256 + off), a2 = *(const u32x4*)(ODP + (size_t)2 * T * 256 + off);
        u32x4 o;
        o.x = cvt_pk_bf16(w0 * bf_lo(a0.x) + w1 * bf_lo(a1.x) + w2 * bf_lo(a2.x), w0 * bf_hi(a0.x) + w1 * bf_hi(a1.x) + w2 * bf_hi(a2.x));
        o.y = cvt_pk_bf16(w0 * bf_lo(a0.y) + w1 * bf_lo(a1.y) + w2 * bf_lo(a2.y), w0 * bf_hi(a0.y) + w1 * bf_hi(a1.y) + w2 * bf_hi(a2.y));
        o.z = cvt_pk_bf16(w0 * bf_lo(a0.z) + w1 * bf_lo(a1.z) + w2 * bf_lo(a2.z), w0 * bf_hi(a0.z) + w1 * bf_hi(a1.z) + w2 * bf_hi(a2.z));
        o.w = cvt_pk_bf16(w0 * bf_lo(a0.w) + w1 * bf_lo(a1.w) + w2 * bf_lo(a2.w), w0 * bf_hi(a0.w) + w1 * bf_hi(a1.w) + w2 * bf_hi(a2.w));
        if (ABL == 4) o = (u32x4){0u, 0u, 0u, 0u};
        *(u32x4*)(ODIL + off) = o;
    }
}
template <bool INIT>
__device__ __forceinline__ void ota_update(LAS bf16_t* ota  , const LAS float* frow, int hi, const f32x16 (&o)[2]) {
#pragma unroll
    for (int r = 0; r < 16; ++r) { const int row = crow(r, hi); const float f = frow[row];
        float v0 = f * o[0][r], v1 = f * o[1][r];
        if (!INIT) { v0 += __uint_as_float((unsigned)ota[row * 64] << 16); v1 += __uint_as_float((unsigned)ota[row * 64 + 32] << 16); }
        ota[row * 64] = (bf16_t)(cvt_pk_bf16(v0, 0.f) & 0xffffu); ota[row * 64 + 32] = (bf16_t)(cvt_pk_bf16(v1, 0.f) & 0xffffu); }
}
#define NSA_SECT() const int lane = lane_id_fresh(); const int tid = wid * 64 + lane; const int r32 = lane & 31, hi = lane >> 5; (void)tid; (void)r32; (void)hi
__device__ __forceinline__ void nsa_unit(const Args& a, const Ctx& C, int b, int hk, int i) {
    using namespace att;
    LAS unsigned char* lds = C.lds;
    const int wid = C.wave; const int g = wid >> 1;
    const bf16_t* QKV = (const bf16_t*)(a.ws + WS_A);
    bf16x8 qr[4];
    f32x16 o[2];
    __syncthreads();
    { NSA_SECT();
        const int tq = (wid & 1) * 32 + r32, t = 64 * i + tq; const size_t tok = (size_t)b * SEQ + t;
        LAS float* imp = (LAS float*)(lds + L_IMP); LAS float* gsh = (LAS float*)(lds + L_GSH) + wid * 96; LAS unsigned* selw = (LAS unsigned*)(lds + L_SEL);
        for (int e = tid; e < 64 * 64; e += NTHR) imp[e] = 0.f;
        if (tid < 2) selw[128 + tid] = 0u;
        if (hi == 0) { const float* gn = (const float*)(a.ws + WS_GN) + tok * 32 + hk * 4 + g;
            gsh[r32] = (ABL == 1) ? 0.f : gn[0]; gsh[32 + r32] = (ABL == 2) ? 0.f : gn[8]; gsh[64 + r32] = (ABL == 3) ? 0.f : gn[16]; }
        const bf16_t* qp = QKV + tok * LDQ + hk * 256 + g * 64;
#pragma unroll
        for (int d0 = 0; d0 < 4; ++d0) qr[d0] = *(const bf16x8*)(qp + d0 * 16 + hi * 8);
        __syncthreads();
        const bf16_t* KC = (const bf16_t*)(a.ws + WS_KC);
        cmp_branch(lds, wid, lane, qr, KC + (size_t)((0 * 8 + b) * 2 + hk) * 256 * 64, KC + (size_t)((1 * 8 + b) * 2 + hk) * 256 * 64, (4 * i + 2) / 64 + 1, t, o);
        ota_update<true>((LAS bf16_t*)(lds + L_OTA) + wid * 2048 + r32, gsh, hi, o);
    }
    __syncthreads();
    { NSA_SECT();
        LAS float* impP = (LAS float*)(lds + L_IMP); LAS unsigned* selw = (LAS unsigned*)(lds + L_SEL);
        const int q = tid >> 3, part = tid & 7;
        const int ncand = i - 2 > 0 ? i - 2 : 0; const int nforced = i + 1 < 3 ? i + 1 : 3; const int krem = 16 - nforced;
        unsigned bits = 0u;
        if (ncand > krem && ABL != 5) {
            float vn[8]; int cn[8];
#pragma unroll
            for (int e = 0; e < 8; ++e) { vn[e] = impP[q * 64 + part * 8 + e]; cn[e] = 0; }
            for (int mm = 1; mm <= i - 2; ++mm) { const float xv = impP[q * 64 + mm];
#pragma unroll
                for (int e = 0; e < 8; ++e) { const int n = part * 8 + e; cn[e] += (xv > vn[e] || (xv == vn[e] && mm < n)) ? 1 : 0; } }
#pragma unroll
            for (int e = 0; e < 8; ++e) { const int n = part * 8 + e; if (n >= 1 && n <= i - 2 && cn[e] < krem) bits |= 1u << e; }
        } else {
#pragma unroll
            for (int e = 0; e < 8; ++e) { const int n = part * 8 + e; if (n >= 1 && n <= i - 2) bits |= 1u << e; }
        }
#pragma unroll
        for (int e = 0; e < 8; ++e) { const int n = part * 8 + e; if (n == 0 || n == i || n == i - 1) bits |= 1u << e; }
        unsigned lo = part < 4 ? bits << (8 * part) : 0u, hi2 = part >= 4 ? bits << (8 * (part - 4)) : 0u;
        lo |= swz_xor_u<1>(lo); hi2 |= swz_xor_u<1>(hi2); lo |= swz_xor_u<2>(lo); hi2 |= swz_xor_u<2>(hi2); lo |= swz_xor_u<4>(lo); hi2 |= swz_xor_u<4>(hi2);
        if (part == 0) { selw[2 * q] = lo; selw[2 * q + 1] = hi2; atomicOr((unsigned*)&selw[128], lo); atomicOr((unsigned*)&selw[129], hi2); }
    }
    __syncthreads();
    int NTS, NTW;
    { NSA_SECT();
        LAS unsigned* selw = (LAS unsigned*)(lds + L_SEL);
        LAS unsigned char* tls = lds + L_SEL + 768; LAS unsigned char* tlw = lds + L_SEL + 848;
        const unsigned long long uni = ((unsigned long long)(unsigned)__builtin_amdgcn_readfirstlane((int)selw[129]) << 32) | (unsigned)__builtin_amdgcn_readfirstlane((int)selw[128]);
        const int nsel = __builtin_popcountll(uni); const int nts = (nsel + 1) & ~1; NTS = nts < 4 ? 4 : nts;
        const int jlo = i - 8 < 0 ? 0 : i - 8; const int nwin = i - jlo + 1; const int ntw = (nwin + 1) & ~1; NTW = ntw < 4 ? 4 : ntw;
        if (tid < 64) { if ((uni >> tid) & 1ull) tls[__builtin_popcountll(uni & ((1ull << tid) - 1ull))] = (unsigned char)tid; }
        else if (tid < 72) { const int k = nsel + (tid - 64); if (k < NTS) tls[k] = 0x80; }
        else if (tid < 88) { const int k = tid - 72; if (k < NTW) tlw[k] = (unsigned char)(k < nwin ? jlo + k : 0x80); }
    }
    __syncthreads();
#pragma clang loop unroll(disable)
    for (int br = 0; br < 2; ++br) {
        float m = 0.f, l = 0.f;
        { NSA_SECT();
            const int tq = (wid & 1) * 32 + r32, t = 64 * i + tq;
            LAS unsigned* selw = (LAS unsigned*)(lds + L_SEL); LAS float* lut = (LAS float*)(lds + L_LUT);
            StreamP S; S.Kb = QKV + (size_t)b * SEQ * LDQ + 512 + 256 + br * 256 + hk * 64; S.Vb = S.Kb + 128; S.pitch = LDQ;
            S.NT = br ? NTW : NTS; S.tl = lds + L_SEL + (br ? 848 : 768); S.uq = t;
            S.lanesel = br ? ~0ull : (((unsigned long long)selw[2 * tq + 1] << 32) | selw[2 * tq]);
            S.lut = br ? lut + 7168 + g * 768 : lut + g * 1792; S.xtop = br ? 640 : 1636; S.dclamp = br ? (1 << 30) : 1636;
            attn_stream<8>(lds, wid, lane, qr, S, m, l, o);
        }
        { NSA_SECT();
            LAS float* gsh = (LAS float*)(lds + L_GSH) + wid * 96; LAS float* wsf = (LAS float*)(lds + L_WSF) + wid * 64;
            l = xhalf_sum(l);
            LDS_WAIT();
            if (hi == 0) wsf[r32] = (l > 0.f ? 1.0f / l : 0.f) * gsh[32 + br * 32 + r32];
            LDS_WAIT();
            ota_update<false>((LAS bf16_t*)(lds + L_OTA) + wid * 2048 + r32, wsf, hi, o);
        }
    }
    { NSA_SECT();
        LDS_WAIT();
        bf16_t* ONSA = (bf16_t*)(a.ws + WS_ONSA);
        const LAS bf16_t* stg = (const LAS bf16_t*)(lds + L_OTA) + wid * 2048;
#pragma unroll
        for (int k = 0; k < 4; ++k) { const int row = k * 8 + (lane >> 3), chn = lane & 7; const u32x4 v = *(const LAS u32x4*)(stg + row * 64 + chn * 8);
            const size_t tk = (size_t)b * SEQ + 64 * i + (wid & 1) * 32 + row;
            *(u32x4*)(ONSA + tk * 512 + hk * 256 + g * 64 + chn * 8) = v; }
    }
}
__device__ __forceinline__ void build_bkt(const Ctx& C) {
    LAS unsigned char* bkt = C.lds + att::L_BKT; LAS unsigned char* bkc = C.lds + att::L_BKC;
    for (int d = C.tid; d < 4096; d += NTHR) bkt[d] = (unsigned char)att::bucket_of(d);
    for (int x = C.tid; x < 8704; x += NTHR) { const int dist = 4095 - x; bkc[x] = (unsigned char)(dist < 0 ? 128 : 4 * att::bucket_of(dist)); }
    __syncthreads();
}
__device__ __forceinline__ void build_nsa_tables(const Args& a, const Ctx& C, int hk) {
    using namespace att;
    LAS float* tbh = (LAS float*)(C.lds + L_TBH); LAS float* lut = (LAS float*)(C.lds + L_LUT);
    __syncthreads();
    if (C.tid < 144) { const int gg = C.tid / 36, bk = C.tid % 36; tbh[C.tid] = bk < 32 ? a.rel_bias[bk * 20 + hk * 4 + gg] * LOG2E : -INFINITY; }
    __syncthreads();
    for (int e = C.tid; e < 4 * 1792; e += NTHR) { const int gg = e / 1792, xx = e % 1792; const int dist = 1636 - xx;
        lut[e] = dist < 0 ? -INFINITY : tbh[gg * 36 + (int)C.lds[L_BKT + dist]]; }
    for (int e = C.tid; e < 4 * 768; e += NTHR) { const int gg = e / 768, xx = e % 768; const int dist = 640 - xx;
        lut[7168 + e] = (dist < 0 || dist > 512) ? -INFINITY : tbh[gg * 36 + (int)C.lds[L_BKT + dist]]; }
    __syncthreads();
}

typedef const Args __attribute__((address_space(4)))* CArgsP;
__device__ __forceinline__ Args load_args() {
#if defined(__HIP_DEVICE_COMPILE__)
    CArgsP p = (CArgsP)__builtin_amdgcn_kernarg_segment_ptr(); asm volatile("" : "+s"(p)); Args a;
    a.x = p->x; a.c = p->c; a.rel_bias = p->rel_bias; a.ada_w = p->ada_w; a.ada_b = p->ada_b; a.norm1 = p->norm1; a.norm2 = p->norm2; a.w_in = p->w_in;
    a.cmp_pos = p->cmp_pos; a.cmp_w1 = p->cmp_w1; a.cmp_w2 = p->cmp_w2; a.w_up_nsa = p->w_up_nsa; a.w_up_dil = p->w_up_dil; a.w_o = p->w_o;
    a.router_wg = p->router_wg; a.router_bg = p->router_bg; a.router_we = p->router_we; a.router_be = p->router_be; a.exp_w1 = p->exp_w1; a.exp_w3 = p->exp_w3; a.exp_w2 = p->exp_w2; a.norm_f = p->norm_f;
    a.out = p->out; a.ws = p->ws; a.ph_lo = p->ph_lo; a.ph_hi = p->ph_hi; a.use_bar = p->use_bar; a.pad = 0;
    return a;
#else
    return Args{};
#endif
}
#define LOADA() const Args a = load_args()
__global__ void __launch_bounds__(NTHR, 2) fwd_kernel(Args a_) {
    extern __shared__ __attribute__((aligned(16))) unsigned char lds_raw[];
    LAS unsigned char* const lds_base = (LAS unsigned char*)lds_raw;
    const int wave0_ = __builtin_amdgcn_readfirstlane((int)threadIdx.x >> 6);
#define FRESH() Ctx C; { int w_ = wave0_; asm volatile("" : "+s"(w_)); int t_ = lane_id_fresh(); asm volatile("" : "+v"(t_)); t_ += w_ * 64; int g_ = gridDim.x, b_ = blockIdx.x; asm volatile("" : "+s"(g_), "+s"(b_)); \
        C.lds = lds_base; C.tid = t_; C.lane = t_ & 63; C.wave = w_; C.G = g_; C.bx = b_; C.vcu = (g_ % 8 == 0) ? (b_ % 8) * (g_ / 8) + b_ / 8 : b_; }
    volatile LAS unsigned* MISC = (volatile LAS unsigned*)(lds_base + LDS_MISC);
    if (threadIdx.x < 64) MISC[threadIdx.x] = 0u;
    __syncthreads();
    unsigned* ctl = (unsigned*)(a_.ws + WS_CTL);
    XcdBarrier bar; bar.bar = ctl + CW_BAR; bar.x = 0; bar.st = nullptr;
    if (a_.use_bar) bar = xcd_barrier_post(ctl + CW_BAR, MISC + 8);
    const int lo = a_.ph_lo, hi = a_.ph_hi;
#ifndef PH_MASK
#define PH_MASK 0xFFFFFFFFu
#endif
#define IN(k) (((PH_MASK >> ((k) == 0 ? 10 : (k) == 21 ? 11 : (((k) - 1) % 10))) & 1u) && lo <= (k) && (k) < hi)
#define SEAM(k) do { if (IN(k) && IN((k) + 1)) { XcdBarrier b2_ = bar; asm volatile("" : "+s"(b2_.bar)); int w2_ = wave0_; asm volatile("" : "+s"(w2_)); xcd_barrier(b2_, w2_ == 0 && lane_id_fresh() == 0); } } while (0)
    if (IN(0)) REPEAT(10) { FRESH(); LOADA(); prologue_vectors(a, C); conv_small(a, C); conv_experts(a, C, 0); }
    SEAM(0);
    _Pragma("unroll") for (int l = 0; l < 2; ++l) {
        const int pb = 1 + 10 * l;
        if (IN(pb + 0)) REPEAT(0) { FRESH(); LOADA(); norm1_phase(a, C, l); if (l == 1) conv_experts(a, C, 1); }
        SEAM(pb + 0);
        if (IN(pb + 1)) REPEAT(1) { FRESH(); LOADA(); unsigned char* ws = a.ws;
            pg8::Gemm g{2048u, 2048u, 128u, 1024}; pg8::DenseOrder S; S.init(T, NIN, C.G, C.bx, ws + WS_H, 2048u, ws + WS_WINT + (size_t)l * NIN * DM * 2, 2048u);
            EpiInProj E{(bf16_t*)(ws + WS_A), (bf16_t*)(ws + WS_MG), (float*)(ws + WS_GN)};
            pg8::gemm_phase<EpiInProj, pg8::DenseOrder, true>(C.lds, C.tid, g, S, E);
        }
        SEAM(pb + 1);
        if (IN(pb + 2)) REPEAT(2) { FRESH(); LOADA(); unsigned char* ws = a.ws;
            struct CmpOrder { int c; const char* A; const char* B;
                __device__ __forceinline__ bool next(int i, pg8::Unit& u) const { if (i > 0 || c >= 32) return false; const int kv = c >> 4, b = (c >> 1) & 7, hk = c & 1;
                    u.pm = c; u.pn = 0; u.A = A + ((size_t)b * SEQ * LDQ + 512 + kv * 128 + hk * 64) * 2; u.B = B + (size_t)kv * 256 * 2048 * 2; return true; } };
            pg8::Gemm g{(unsigned)(16 * LDQ * 2), 4096u, (unsigned)(LDQ * 2), 2048};
            CmpOrder S{C.vcu, (const char*)(ws + WS_A), (const char*)(ws + WS_CW1T + (size_t)l * 2 * 256 * 2048 * 2)};
            EpiCmp E{(bf16_t*)(ws + WS_HID), (const float*)(ws + WS_CB1) + l * 512, (const bf16_t*)(ws + WS_CW2T) + (size_t)l * 2 * 64 * 256, (bf16_t*)(ws + WS_KC)};
            pg8::gemm_phase<EpiCmp, CmpOrder, false>(C.lds, C.tid, g, S, E);
            __syncthreads();
            build_bkt(C);
            for (;;) { __syncthreads();
                if (C.tid == 0) *(volatile LAS int*)(C.lds + LDS_MISC + 512) = (int)__hip_atomic_fetch_add((unsigned*)(ws + WS_CTL) + CW_Q + l, 1u, __ATOMIC_RELAXED, __HIP_MEMORY_SCOPE_AGENT);
                __syncthreads();
                const int du = __builtin_amdgcn_readfirstlane(*(volatile LAS int*)(C.lds + LDS_MISC + 512));
                if (du >= 1536) break;
                dil_unit(a, C, du); }
        }
        SEAM(pb + 2);
        if (IN(pb + 3)) REPEAT(3) { FRESH(); LOADA();
            dil_combine(a, C);
            build_bkt(C);
            int cur_hk = -1;
            for (int v = C.vcu; v < 256; v += C.G) { const int b = v >> 5, hk = (v >> 4) & 1, s = v & 15;
                if (hk != cur_hk) { build_nsa_tables(a, C, hk); cur_hk = hk; }
                for (int k = 0; k < 4; ++k) { const int qi = (k == 0) ? s : (k == 1) ? 31 - s : (k == 2) ? 32 + s : 63 - s; nsa_unit(a, C, b, hk, qi); } }
            __syncthreads();
        }
        SEAM(pb + 3);
        if (IN(pb + 4)) REPEAT(4) { FRESH(); LOADA(); unsigned char* ws = a.ws;
            { pg8::Gemm g{1024u, 1024u, 128u, 512}; pg8::DenseOrder S; S.init(T, 1024, C.G, C.bx, ws + WS_ONSA, 1024u, ws + WS_WUNT + (size_t)l * 1024 * 512 * 2, 1024u);
              EpiUp<0> E{(bf16_t*)(ws + WS_MERGED), (const bf16_t*)(ws + WS_MG)};
              pg8::gemm_phase<EpiUp<0>, pg8::DenseOrder, true>(C.lds, C.tid, g, S, E); }
            VM_WAIT(); __syncthreads();
            { pg8::Gemm g{512u, 512u, 128u, 256}; pg8::DenseOrder S; S.init(T, 1024, C.G, C.bx, ws + WS_ODIL, 512u, ws + WS_WUDT + (size_t)l * 1024 * 256 * 2, 512u);
              EpiUp<1> E{(bf16_t*)(ws + WS_MERGED), (const bf16_t*)(ws + WS_MG)};
              pg8::gemm_phase<EpiUp<1>, pg8::DenseOrder, true>(C.lds, C.tid, g, S, E); }
        }
        SEAM(pb + 4);
        if (IN(pb + 5)) REPEAT(5) { FRESH(); LOADA(); unsigned char* ws = a.ws;
            pg8::Gemm g{2048u, 2048u, 128u, 1024}; pg8::DenseOrder S; S.init(T, 1024, C.G, C.bx, ws + WS_MERGED, 2048u, ws + WS_WOT + (size_t)l * 1024 * 1024 * 2, 2048u);
            EpiOut E{l == 0 ? a.x : (const float*)a.out, a.out, (const float*)(ws + WS_MOD) + (size_t)l * 8 * 6144 + 2048};
            pg8::gemm_phase<EpiOut, pg8::DenseOrder, true>(C.lds, C.tid, g, S, E);
        }
        SEAM(pb + 5);
        if (IN(pb + 6)) REPEAT(6) { FRESH(); LOADA(); norm2_router_phase(a, C, l); }
        SEAM(pb + 6);
        if (IN(pb + 7)) REPEAT(7) { FRESH(); LOADA(); moe_scatter_phase(a, C); }
        SEAM(pb + 7);
        if (IN(pb + 8)) REPEAT(8) { FRESH(); LOADA(); unsigned char* ws = a.ws;
            const int* TILEE = (const int*)(ws + WS_TILEE); const int ntl = TILEE[0];
            MoeOrder S; S.G = C.G; S.c = C.vcu; S.nu = ntl * 4; S.A = (const char*)(ws + WS_XS); S.B = (const char*)(ws + WS_E13T); S.tA = (size_t)256 * 2048; S.tB = (size_t)256 * 2048; S.eB = (size_t)1024 * 2048;
#pragma unroll
            for (int i = 0; i < 8; ++i) { const int L = i * C.G + C.vcu; S.ex[i] = (L < S.nu) ? TILEE[16 + (L >> 2)] : 0; }
            pg8::Gemm g{2048u, 2048u, 128u, 1024};
            EpiMoe1 E{(bf16_t*)(ws + WS_ACT)};
            pg8::gemm_phase<EpiMoe1, MoeOrder, true>(C.lds, C.tid, g, S, E);
        }
        SEAM(pb + 8);
        if (IN(pb + 9)) REPEAT(9) { FRESH(); LOADA(); unsigned char* ws = a.ws;
            const int* TILEE = (const int*)(ws + WS_TILEE); const int ntl = TILEE[0];
            MoeOrder S; S.G = C.G; S.c = C.vcu; S.nu = ntl * 4; S.A = (const char*)(ws + WS_ACT); S.B = (const char*)(ws + WS_E2T); S.tA = (size_t)256 * 1024; S.tB = (size_t)256 * 1024; S.eB = (size_t)1024 * 1024;
#pragma unroll
            for (int i = 0; i < 8; ++i) { const int L = i * C.G + C.vcu; S.ex[i] = (L < S.nu) ? TILEE[16 + (L >> 2)] : 0; }
            pg8::Gemm g{1024u, 1024u, 128u, 512};
            EpiPlain E{(bf16_t*)(ws + WS_XS), 1024};
            pg8::gemm_phase<EpiPlain, MoeOrder, true>(C.lds, C.tid, g, S, E);
        }
        SEAM(pb + 9);
    }
    if (IN(21)) { FRESH(); LOADA(); final_phase(a, C); }
#undef IN
#undef SEAM
}

#ifndef ONE_LAUNCH
#define ONE_LAUNCH 1
#endif
extern "C" void kernel_launch(void* const* d_in, const int* in_sizes, int n_in, void* d_out, int out_size, void* d_ws, size_t ws_size, hipStream_t stream) {
    static int grid = 0;
    if (grid == 0) {
        if (n_in != 22 || out_size != T * DM || ws_size < WS_END) { fprintf(stderr, "kernel_launch: unexpected problem (n_in %d out %d ws %zu)\n", n_in, out_size, ws_size); grid = -1; return; }
        int dev = 0, cus = 0;
        if (hipGetDevice(&dev) != hipSuccess || hipDeviceGetAttribute(&cus, hipDeviceAttributeMultiprocessorCount, dev) != hipSuccess) { grid = -1; return; }
        if (hipFuncSetAttribute((const void*)fwd_kernel, hipFuncAttributeMaxDynamicSharedMemorySize, LDS_BYTES) != hipSuccess) { fprintf(stderr, "kernel_launch: hipFuncSetAttribute failed\n"); grid = -1; return; }
        int per_cu = 0;
        if (hipOccupancyMaxActiveBlocksPerMultiprocessor(&per_cu, (const void*)fwd_kernel, NTHR, LDS_BYTES) != hipSuccess || per_cu < 1) { fprintf(stderr, "kernel_launch: occupancy query reports %d\n", per_cu); }
        (void)hipGetLastError();
        grid = cus;
    }
    if (grid < 0) return;
    (void)hipMemsetAsync((char*)d_ws + WS_CTL, 0, CTL_ZERO_BYTES, stream);
    Args a{};
    a.x = (const float*)d_in[0]; a.c = (const float*)d_in[1]; a.rel_bias = (const float*)d_in[2]; a.ada_w = (const float*)d_in[3]; a.ada_b = (const float*)d_in[4];
    a.norm1 = (const float*)d_in[5]; a.norm2 = (const float*)d_in[6]; a.w_in = (const float*)d_in[7]; a.cmp_pos = (const float*)d_in[8]; a.cmp_w1 = (const float*)d_in[9];
    a.cmp_w2 = (const float*)d_in[10]; a.w_up_nsa = (const float*)d_in[11]; a.w_up_dil = (const float*)d_in[12]; a.w_o = (const float*)d_in[13];
    a.router_wg = (const float*)d_in[14]; a.router_bg = (const float*)d_in[15]; a.router_we = (const float*)d_in[16]; a.router_be = (const float*)d_in[17];
    a.exp_w1 = (const float*)d_in[18]; a.exp_w3 = (const float*)d_in[19]; a.exp_w2 = (const float*)d_in[20]; a.norm_f = (const float*)d_in[21];
    a.out = (float*)d_out; a.ws = (unsigned char*)d_ws; a.pad = 0;
#if ONE_LAUNCH
    a.ph_lo = 0; a.ph_hi = NPHASE; a.use_bar = 1;
    hipLaunchKernelGGL(fwd_kernel, dim3(grid), dim3(NTHR), LDS_BYTES, stream, a);
#else
    for (int p = 0; p < NPHASE; ++p) { a.ph_lo = p; a.ph_hi = p + 1; a.use_bar = 0;
        hipLaunchKernelGGL(fwd_kernel, dim3(grid), dim3(NTHR), LDS_BYTES, stream, a); }
#endif
}
```

```cpp
#include <hip/hip_runtime.h>
#include <cstdint>
#include <cstdio>

#define GAS __attribute__((address_space(1)))
#define LAS __attribute__((address_space(3)))
typedef unsigned short bf16_t;
typedef short bf16x8 __attribute__((ext_vector_type(8)));
typedef short s16x4 __attribute__((ext_vector_type(4)));
typedef float f32x4 __attribute__((ext_vector_type(4)));
typedef float f32x2 __attribute__((ext_vector_type(2)));
typedef float f32x16 __attribute__((ext_vector_type(16)));
typedef unsigned u32x4 __attribute__((ext_vector_type(4)));
typedef unsigned u32x2 __attribute__((ext_vector_type(2)));
typedef __bf16 bf16x2_t __attribute__((ext_vector_type(2)));

constexpr int NB = 8, SEQ = 4096, DM = 1024, T = NB * SEQ;
constexpr int LDQ = 3584;
constexpr int NIN = 5888;
constexpr int INW = 5656;
constexpr float LOG2E = 1.4426950408889634f;
constexpr float C2 = 0.125f * LOG2E;
constexpr int NWAVES = 8, NTHR = 512;
constexpr float RMS_EPS = 1e-6f;
constexpr int NPHASE = 22;
#ifndef ABL
#define ABL 0
#endif
#ifndef REP_MASK
#define REP_MASK 0u
#endif
#define REPEAT(k) _Pragma("clang loop unroll(disable)") for (int rep_ = 0; rep_ < (int)((REP_MASK >> (k)) & 1u) + 1; ++rep_)

constexpr size_t MiB = 1u << 20;
constexpr size_t WS_CTL = 0, CTL_ZERO_BYTES = MiB;
constexpr size_t WS_MOD = 1 * MiB;
constexpr size_t WS_CB1 = WS_MOD + 400 * 1024;
constexpr size_t WS_CW2T = WS_MOD + 512 * 1024;
constexpr size_t WS_CNTBLK = WS_MOD + 768 * 1024;
constexpr size_t WS_TILEE = WS_MOD + 832 * 1024;
constexpr size_t WS_WINT = 4 * MiB;
constexpr size_t WS_CW1T = 27 * MiB;
constexpr size_t WS_WUNT = 31 * MiB;
constexpr size_t WS_WUDT = 33 * MiB;
constexpr size_t WS_WOT = 34 * MiB;
constexpr size_t WS_E13T = 38 * MiB;
constexpr size_t WS_E2T = 102 * MiB;
constexpr size_t WS_A = 134 * MiB;
constexpr size_t WS_XS = WS_A;
constexpr size_t WS_ACT = WS_A + 144 * MiB;
constexpr size_t WS_MERGED = WS_A;
constexpr size_t WS_MG = 359 * MiB;
constexpr size_t WS_H2 = WS_MG;
constexpr size_t WS_REC = WS_MG + 64 * MiB;
constexpr size_t WS_DEST = WS_MG + 65 * MiB;
constexpr size_t WS_B = 487 * MiB;
constexpr size_t WS_H = WS_B;
constexpr size_t WS_ONSA = WS_B;
constexpr size_t WS_ODP = WS_B + 32 * MiB;
constexpr size_t WS_LSE = WS_B + 80 * MiB;
constexpr size_t WS_ODIL = WS_B + 82 * MiB;
constexpr size_t WS_GN = WS_B + 98 * MiB;
constexpr size_t WS_KC = WS_B + 102 * MiB;
constexpr size_t WS_HID = WS_B + 103 * MiB;
constexpr size_t WS_END = WS_B + 107 * MiB;

constexpr int CW_TMO = 0, CW_BAR = 4096, CW_Q = 8192;

constexpr int LDS_MISC = 158784;
constexpr int LDS_BYTES = 158784 + 2048;

__device__ __forceinline__ unsigned cvt_pk_bf16(float lo, float hi) { f32x2 v = {lo, hi}; bf16x2_t b = __builtin_convertvector(v, bf16x2_t); return __builtin_bit_cast(unsigned, b); }
__device__ __forceinline__ float bf_lo(unsigned w) { return __uint_as_float(w << 16); }
__device__ __forceinline__ float bf_hi(unsigned w) { return __uint_as_float(w & 0xffff0000u); }
__device__ __forceinline__ float sigmoidf_(float x) { return __builtin_amdgcn_rcpf(1.0f + __builtin_amdgcn_exp2f(-x * LOG2E)); }
__device__ __forceinline__ int lane_id_fresh() { unsigned ones = ~0u; asm volatile("" : "+s"(ones)); return (int)__builtin_amdgcn_mbcnt_hi(ones, __builtin_amdgcn_mbcnt_lo(ones, 0u)); }
template <int X> __device__ __forceinline__ float swz_xor_f(float v) { return __int_as_float(__builtin_amdgcn_ds_swizzle(__float_as_int(v), (X << 10) | 0x1f)); }
template <int X> __device__ __forceinline__ unsigned swz_xor_u(unsigned v) { return (unsigned)__builtin_amdgcn_ds_swizzle((int)v, (X << 10) | 0x1f); }
__device__ __forceinline__ float wave_sum(float v) {
    v += swz_xor_f<1>(v); v += swz_xor_f<2>(v); v += swz_xor_f<4>(v); v += swz_xor_f<8>(v); v += swz_xor_f<16>(v);
    auto rr = __builtin_amdgcn_permlane32_swap(__float_as_uint(v), __float_as_uint(v), false, false);
    return __uint_as_float(rr[0]) + __uint_as_float(rr[1]);
}
__device__ __forceinline__ int bperm_i(int srclane, int v) { return __builtin_amdgcn_ds_bpermute(srclane << 2, v); }
#define LDS_WAIT() asm volatile("s_waitcnt lgkmcnt(0)" ::: "memory")
#define VM_WAIT() asm volatile("s_waitcnt vmcnt(0)" ::: "memory")

#define XB_TMO      128
#define XB_XCNT(j)  (256  + 64 * (j))
#define XB_XSUB(j)  (1280 + 64 * (j))
#define XB_XGEN(j)  (2304 + 64 * (j))
#define XB_TOP      3328
#define XB_TOPGEN   3392
#define XCD_BAR_WORDS 3456
#define XB_SPIN_CAP (1u << 20)
__device__ __forceinline__ unsigned xb_ld(unsigned* p)              { return __hip_atomic_load(p, __ATOMIC_RELAXED, __HIP_MEMORY_SCOPE_AGENT); }
__device__ __forceinline__ unsigned xb_add(unsigned* p, unsigned v) { return __hip_atomic_fetch_add(p, v, __ATOMIC_RELAXED, __HIP_MEMORY_SCOPE_AGENT); }
__device__ __forceinline__ unsigned xb_xcc_id() { return (unsigned)__builtin_amdgcn_s_getreg((3 << 11) | 20) & 0xFu; }
#define XB_SPIN(cond, bar) do { unsigned _sp = 0; while (cond) { __builtin_amdgcn_s_sleep(1); \
    if ((++_sp & 255u) == 0u) { if (xb_ld(&(bar)[XB_TMO])) break; if (_sp > XB_SPIN_CAP) { atomicAdd(&(bar)[XB_TMO], 1u); break; } } } } while (0)
struct XcdBarrier { unsigned* bar; unsigned x; volatile LAS unsigned* st; };
__device__ __forceinline__ XcdBarrier xcd_barrier_post(unsigned* bar, volatile LAS unsigned* st) {
    XcdBarrier b; b.bar = bar; b.x = xb_xcc_id(); b.st = st;
    if (threadIdx.x == 0) (void)xb_add(&bar[XB_XCNT(b.x)], 1u);
    return b;
}
__device__ __forceinline__ void xcd_barrier_complete(unsigned* bar, unsigned x, unsigned& nloc, unsigned& nx) {
    const unsigned G = gridDim.x * gridDim.y * gridDim.z;
    unsigned sum, cnt, mine, sp = 0u;
    for (;;) {
        sum = 0u; cnt = 0u; mine = 0u;
#pragma unroll
        for (unsigned j = 0; j < 16; ++j) { const unsigned c = xb_ld(&bar[XB_XCNT(j)]); sum += c; cnt += (c > 0u) ? 1u : 0u; mine = (j == x) ? c : mine; }
        if (sum == G) break;
        __builtin_amdgcn_s_sleep(1);
        if ((++sp & 255u) == 0u) { if (xb_ld(&bar[XB_TMO])) break; if (sp > XB_SPIN_CAP) { atomicAdd(&bar[XB_TMO], 1u); break; } }
    }
    nloc = mine > 0u ? mine : 1u; nx = cnt > 0u ? cnt : 1u;
}
__device__ __forceinline__ void xcd_barrier(const XcdBarrier& b, const bool leader_thread) {
    asm volatile("s_waitcnt vmcnt(0)" ::: "memory");
    __syncthreads();
    if (leader_thread) {
        unsigned* bar = b.bar;
        __builtin_amdgcn_s_waitcnt(0);
        unsigned nloc = b.st[0], nx = b.st[1];
        if (nloc == 0u) { xcd_barrier_complete(bar, b.x, nloc, nx); b.st[0] = nloc; b.st[1] = nx; }
        const unsigned old = xb_add(&bar[XB_XSUB(b.x)], 1u);
        const unsigned gen = old / nloc;
        if (old + 1u == (gen + 1u) * nloc) {
            __builtin_amdgcn_fence(__ATOMIC_RELEASE, "agent");
            asm volatile("s_waitcnt vmcnt(0)" ::: "memory");
            const unsigned og = xb_add(&bar[XB_TOP], 1u);
            const unsigned tg = og / nx;
            if (og + 1u == (tg + 1u) * nx) xb_add(&bar[XB_TOPGEN], 1u);
            else XB_SPIN(xb_ld(&bar[XB_TOPGEN]) == tg, bar);
            __builtin_amdgcn_fence(__ATOMIC_ACQUIRE, "agent");
            xb_add(&bar[XB_XGEN(b.x)], 1u);
            asm volatile("s_waitcnt vmcnt(0)" ::: "memory");
        } else {
            XB_SPIN(xb_ld(&bar[XB_XGEN(b.x)]) == gen, bar);
            __builtin_amdgcn_fence(__ATOMIC_ACQUIRE, "agent");
            asm volatile("s_waitcnt vmcnt(0)" ::: "memory");
        }
    }
    __syncthreads();
}

namespace pg8 {
constexpr int BM = 256, BK = 64, HALF = 128, HTB = HALF * BK * 2, STAGE_BYTES = 8 * HTB;
__device__ __forceinline__ int lds_byte(int r, int c) { const int st = (r >> 4) * 2 + (c >> 5), rr = r & 15, cc = c & 31, ob = rr * 64 + cc * 2; return st * 1024 + (ob ^ (((ob >> 9) & 1) << 5)); }
__device__ __forceinline__ void stage_rc(int b, int& R, int& C) { const int st = b / 1024, sb = b % 1024, swz = sb ^ (((sb >> 9) & 1) << 5); R = (st >> 1) * 16 + swz / 64; C = (st & 1) * 32 + (swz % 64) / 2; }
__device__ __forceinline__ int perm32(int rho) { const int n = rho >> 4, i = rho & 15; return 8 * (i >> 2) + 4 * n + (i & 3); }

struct Unit { const char* A; const char* B; int pm, pn; };
struct Gemm { unsigned lda, ldb, kstepA; int K; };

template <class Epi, class Sched, bool ALIGN_EPI>
__device__ __forceinline__ void gemm_phase(LAS unsigned char* lds, const int tid, const Gemm g, const Sched& S, const Epi& E) {
    const int wid = __builtin_amdgcn_readfirstlane(tid >> 6), lane = tid & 63, wr = wid >> 2, wc = wid & 3, fr = lane & 15, fq = lane >> 4;
    const int nt = g.K / BK;
    unsigned voffA[2], voffB[2];
#pragma unroll
    for (int i = 0; i < 2; ++i) { int R, C; stage_rc(tid * 16 + i * 8192, R, C); const int Rb = Epi::PERM ? ((R & ~31) + perm32(R & 31)) : R;
        voffA[i] = (unsigned)R * g.lda + (unsigned)C * 2u; voffB[i] = (unsigned)Rb * g.ldb + (unsigned)C * 2u; }
    const size_t kstepA = (size_t)g.kstepA, kstepB = (size_t)(BK * 2);
    const size_t hstepA = (size_t)HALF * g.lda, hstepB = (size_t)HALF * g.ldb;
    const unsigned ldsw = (unsigned)wid * 1024u;
    const int aoff = lds_byte(wr * 64 + fr, fq * 8), boff = lds_byte(wc * 32 + fr, fq * 8);
#define PG8_SA(b, h) (((b) * 2 + (h)) * HTB)
#define PG8_SB(b, h) ((4 + (b) * 2 + (h)) * HTB)
#define PG8_STAGE(bufoff, gbase, voff) do { _Pragma("unroll") for (int _i = 0; _i < 2; ++_i) \
        __builtin_amdgcn_global_load_lds((const unsigned*)((const char*)(gbase) + (voff)[_i]), (LAS unsigned*)(lds + (bufoff) + ldsw + _i * 8192), 16, 0, 0); } while (0)
#define PG8_LDA(dst, b, h) do { _Pragma("unroll") for (int m = 0; m < 4; ++m) _Pragma("unroll") for (int k = 0; k < 2; ++k) dst[m][k] = *(const LAS bf16x8*)(lds + PG8_SA(b, h) + aoff + m * 2048 + k * 1024); } while (0)
#define PG8_LDB(dst, b, h) do { _Pragma("unroll") for (int n = 0; n < 2; ++n) _Pragma("unroll") for (int k = 0; k < 2; ++k) dst[n][k] = *(const LAS bf16x8*)(lds + PG8_SB(b, h) + boff + n * 2048 + k * 1024); } while (0)
#define PG8_MMA(ai, bj, At, Bt) do { __builtin_amdgcn_s_setprio(1); _Pragma("unroll") for (int m = 0; m < 4; ++m) _Pragma("unroll") for (int n = 0; n < 2; ++n) _Pragma("unroll") for (int k = 0; k < 2; ++k) \
        acc[ai][bj][m][n] = __builtin_amdgcn_mfma_f32_16x16x32_bf16(Bt[n][k], At[m][k], acc[ai][bj][m][n], 0, 0, 0); __builtin_amdgcn_s_setprio(0); } while (0)
#define PG8_WAIT_V(n) asm volatile("s_waitcnt vmcnt(" #n ")" ::: "memory")
#define PG8_WAIT_L(n) asm volatile("s_waitcnt lgkmcnt(" #n ")" ::: "memory")
#define PG8_BAR __builtin_amdgcn_s_barrier()
#define PG8_SCHED __builtin_amdgcn_sched_barrier(0)
    Unit cur, nxt; int ui = 0;
    if (!S.next(0, cur)) return;
    f32x4 acc[2][2][4][2];
#pragma unroll
    for (int a = 0; a < 2; ++a)
#pragma unroll
        for (int b = 0; b < 2; ++b)
#pragma unroll
            for (int m = 0; m < 4; ++m)
#pragma unroll
                for (int n = 0; n < 2; ++n) acc[a][b][m][n] = (f32x4){0.f, 0.f, 0.f, 0.f};
    bf16x8 At[4][2], B0[2][2], B1[2][2];
    const char* cA = cur.A; const char* cB = cur.B;
    PG8_STAGE(PG8_SB(0, 0), cB, voffB); PG8_STAGE(PG8_SB(0, 1), cB + hstepB, voffB); PG8_STAGE(PG8_SA(0, 0), cA, voffA); PG8_STAGE(PG8_SA(0, 1), cA + hstepA, voffA);
    if (wr == 1) PG8_BAR;
    PG8_WAIT_V(2); PG8_BAR;
    PG8_STAGE(PG8_SB(1, 0), cB + kstepB, voffB); PG8_STAGE(PG8_SA(1, 0), cA + kstepA, voffA); PG8_STAGE(PG8_SB(1, 1), cB + hstepB + kstepB, voffB);
    PG8_WAIT_V(6); PG8_BAR;
    for (;;) {
        const bool has_next = S.next(ui + 1, nxt);
        const char* nA = has_next ? nxt.A : cA; const char* nB = has_next ? nxt.B : cB;
        for (int t = 0; t < nt; t += 2) {
            const bool last = (t == nt - 2);
            const char* a1 = cA + (size_t)(t + 1) * kstepA;
            const char* a2 = last ? nA : cA + (size_t)(t + 2) * kstepA; const char* b2 = last ? nB : cB + (size_t)(t + 2) * kstepB;
            const char* a3 = a2 + kstepA; const char* b3 = b2 + kstepB;
            PG8_LDB(B0, 0, 0); PG8_LDB(B1, 0, 1); PG8_SCHED; PG8_LDA(At, 0, 0); PG8_STAGE(PG8_SA(1, 1), a1 + hstepA, voffA);
            PG8_WAIT_V(8); PG8_WAIT_L(0); PG8_BAR; PG8_MMA(0, 0, At, B0); PG8_MMA(0, 1, At, B1); PG8_BAR; PG8_SCHED;
            PG8_LDA(At, 0, 1); PG8_STAGE(PG8_SB(0, 0), b2, voffB); PG8_STAGE(PG8_SB(0, 1), b2 + hstepB, voffB); PG8_STAGE(PG8_SA(0, 0), a2, voffA);
            PG8_WAIT_V(8); PG8_WAIT_L(0); PG8_BAR; PG8_MMA(1, 0, At, B0); PG8_MMA(1, 1, At, B1); PG8_BAR; PG8_SCHED;
            PG8_LDB(B0, 1, 0); PG8_LDB(B1, 1, 1); PG8_SCHED; PG8_LDA(At, 1, 0); PG8_STAGE(PG8_SA(0, 1), a2 + hstepA, voffA);
            PG8_WAIT_V(8); PG8_WAIT_L(0); PG8_BAR; PG8_MMA(0, 0, At, B0); PG8_MMA(0, 1, At, B1); PG8_BAR; PG8_SCHED;
            PG8_LDA(At, 1, 1); PG8_STAGE(PG8_SB(1, 0), b3, voffB); PG8_STAGE(PG8_SB(1, 1), b3 + hstepB, voffB); PG8_STAGE(PG8_SA(1, 0), a3, voffA);
            PG8_WAIT_V(8); PG8_WAIT_L(0); PG8_BAR; PG8_MMA(1, 0, At, B0); PG8_MMA(1, 1, At, B1); PG8_BAR; PG8_SCHED;
        }
        if constexpr (ALIGN_EPI) { if (wr == 0) PG8_BAR; }
        if constexpr (!Epi::AFTER_DRAIN) { E(acc, cur, wr, wc, fr, fq); }
        if (!has_next) break;
#pragma unroll
        for (int a = 0; a < 2; ++a)
#pragma unroll
            for (int b = 0; b < 2; ++b)
#pragma unroll
                for (int m = 0; m < 4; ++m)
#pragma unroll
                    for (int n = 0; n < 2; ++n) acc[a][b][m][n] = (f32x4){0.f, 0.f, 0.f, 0.f};
        cur = nxt; cA = nA; cB = nB; ++ui;
        if constexpr (ALIGN_EPI) { if (wr == 1) PG8_BAR; }
    }
    PG8_WAIT_V(0);
    if constexpr (!ALIGN_EPI) { if (wr == 0) PG8_BAR; }
    PG8_BAR;
    if constexpr (Epi::AFTER_DRAIN) { E.fused(acc, cur, wr, wc, fr, fq, wid, lane); }
#undef PG8_SA
#undef PG8_SB
#undef PG8_STAGE
#undef PG8_LDA
#undef PG8_LDB
#undef PG8_MMA
#undef PG8_WAIT_V
#undef PG8_WAIT_L
#undef PG8_BAR
#undef PG8_SCHED
}

struct DenseOrder {
    int nM, nN, nwg, G, c; const char* A; const char* B; size_t tA, tB;
    __device__ __forceinline__ void init(int M, int N, int G_, int c_, const void* A_, unsigned lda, const void* B_, unsigned ldb) {
        nM = M / BM; nN = N / BM; nwg = nM * nN; G = G_; c = c_; A = (const char*)A_; B = (const char*)B_; tA = (size_t)BM * lda; tB = (size_t)BM * ldb; }
    __device__ __forceinline__ bool next(int i, Unit& u) const {
        const long L = (long)i * G + c; if (L >= nwg) return false;
        int wgid = (int)L; { const int q = nwg / 8, r = nwg % 8, xcd = wgid % 8, off = wgid / 8; wgid = (xcd < r ? xcd * (q + 1) : r * (q + 1) + (xcd - r) * q) + off; }
        const int nig = 8 * nN, gid = wgid / nig, fm = gid * 8, gsz = (nM - fm) < 8 ? (nM - fm) : 8;
        u.pm = fm + ((wgid % nig) % gsz); u.pn = (wgid % nig) / gsz;
        u.A = A + (size_t)u.pm * tA; u.B = B + (size_t)u.pn * tB; return true;
    }
};
}

struct Args {
    const float* x; const float* c; const float* rel_bias; const float* ada_w; const float* ada_b; const float* norm1; const float* norm2; const float* w_in;
    const float* cmp_pos; const float* cmp_w1; const float* cmp_w2; const float* w_up_nsa; const float* w_up_dil; const float* w_o;
    const float* router_wg; const float* router_bg; const float* router_we; const float* router_be; const float* exp_w1; const float* exp_w3; const float* exp_w2; const float* norm_f;
    float* out; unsigned char* ws; int ph_lo, ph_hi, use_bar, pad;
};

typedef f32x4 AccT[2][2][4][2];
struct EpiInProj {
    static constexpr bool PERM = true, AFTER_DRAIN = false;
    bf16_t* QKV; bf16_t* MG; float* GN;
    __device__ __forceinline__ void operator()(const AccT& acc, const pg8::Unit& u, int wr, int wc, int fr, int fq) const {
        const int pn = u.pn; const int row0 = u.pm * 256 + wr * 64 + fr;
        if (pn < 14) {
            const float sc = (pn < 2 || (pn >= 5 && pn < 8)) ? C2 : 1.0f;
            const int col0 = pn * 256 + wc * 32 + 8 * fq;
#pragma unroll
            for (int ai = 0; ai < 2; ++ai)
#pragma unroll
                for (int m = 0; m < 4; ++m) { bf16_t* rowp = QKV + (size_t)(row0 + ai * 128 + m * 16) * LDQ + col0;
#pragma unroll
                    for (int bj = 0; bj < 2; ++bj) { const f32x4 v0 = acc[ai][bj][m][0] * sc, v1 = acc[ai][bj][m][1] * sc; u32x4 w;
                        w.x = cvt_pk_bf16(v0[0], v0[1]); w.y = cvt_pk_bf16(v0[2], v0[3]); w.z = cvt_pk_bf16(v1[0], v1[1]); w.w = cvt_pk_bf16(v1[2], v1[3]);
                        *(u32x4*)(rowp + bj * 128) = w; } }
        } else if (pn < 22) {
            const int col0 = (pn - 14) * 256 + wc * 32 + 8 * fq;
#pragma unroll
            for (int ai = 0; ai < 2; ++ai)
#pragma unroll
                for (int m = 0; m < 4; ++m) { bf16_t* rowp = MG + (size_t)(row0 + ai * 128 + m * 16) * 2048 + col0;
#pragma unroll
                    for (int bj = 0; bj < 2; ++bj) { const f32x4 v0 = acc[ai][bj][m][0], v1 = acc[ai][bj][m][1]; u32x4 w;
                        w.x = cvt_pk_bf16(sigmoidf_(v0[0]), sigmoidf_(v0[1])); w.y = cvt_pk_bf16(sigmoidf_(v0[2]), sigmoidf_(v0[3]));
                        w.z = cvt_pk_bf16(sigmoidf_(v1[0]), sigmoidf_(v1[1])); w.w = cvt_pk_bf16(sigmoidf_(v1[2]), sigmoidf_(v1[3]));
                        *(u32x4*)(rowp + bj * 128) = w; } }
        } else {
            if (wc == 0 && fq < 3) {
#pragma unroll
                for (int ai = 0; ai < 2; ++ai)
#pragma unroll
                    for (int m = 0; m < 4; ++m) { float* rowp = GN + (size_t)(row0 + ai * 128 + m * 16) * 32 + 8 * fq;
                        const f32x4 v0 = acc[ai][0][m][0], v1 = acc[ai][0][m][1];
                        *(f32x4*)(rowp) = (f32x4){sigmoidf_(v0[0]), sigmoidf_(v0[1]), sigmoidf_(v0[2]), sigmoidf_(v0[3])};
                        *(f32x4*)(rowp + 4) = (f32x4){sigmoidf_(v1[0]), sigmoidf_(v1[1]), sigmoidf_(v1[2]), sigmoidf_(v1[3])}; }
            }
        }
    }
};
template <int PASS> struct EpiUp {
    static constexpr bool PERM = true, AFTER_DRAIN = false;
    bf16_t* MERGED; const bf16_t* MG;
    __device__ __forceinline__ void operator()(const AccT& acc, const pg8::Unit& u, int wr, int wc, int fr, int fq) const {
        const int row0 = u.pm * 256 + wr * 64 + fr; const int col0 = u.pn * 256 + wc * 32 + 8 * fq;
#pragma unroll
        for (int ai = 0; ai < 2; ++ai)
#pragma unroll
            for (int m = 0; m < 4; ++m) { const size_t row = (size_t)(row0 + ai * 128 + m * 16);
#pragma unroll
                for (int bj = 0; bj < 2; ++bj) {
                    const u32x4 gw = *(const u32x4*)(MG + row * 2048 + PASS * 1024 + col0 + bj * 128);
                    bf16_t* op = MERGED + row * 1024 + col0 + bj * 128;
                    const f32x4 v0 = acc[ai][bj][m][0], v1 = acc[ai][bj][m][1];
                    float r[8] = {v0[0] * bf_lo(gw.x), v0[1] * bf_hi(gw.x), v0[2] * bf_lo(gw.y), v0[3] * bf_hi(gw.y), v1[0] * bf_lo(gw.z), v1[1] * bf_hi(gw.z), v1[2] * bf_lo(gw.w), v1[3] * bf_hi(gw.w)};
                    if (PASS == 1) { const u32x4 ow = *(const u32x4*)op;
                        r[0] += bf_lo(ow.x); r[1] += bf_hi(ow.x); r[2] += bf_lo(ow.y); r[3] += bf_hi(ow.y); r[4] += bf_lo(ow.z); r[5] += bf_hi(ow.z); r[6] += bf_lo(ow.w); r[7] += bf_hi(ow.w); }
                    u32x4 w; w.x = cvt_pk_bf16(r[0], r[1]); w.y = cvt_pk_bf16(r[2], r[3]); w.z = cvt_pk_bf16(r[4], r[5]); w.w = cvt_pk_bf16(r[6], r[7]);
                    *(u32x4*)op = w; }
                asm volatile("" ::: "memory"); }
    }
};
struct EpiOut {
    static constexpr bool PERM = true, AFTER_DRAIN = false;
    const float* xin; float* xout; const float* g1;
    __device__ __forceinline__ void operator()(const AccT& acc, const pg8::Unit& u, int wr, int wc, int fr, int fq) const {
        const int row0 = u.pm * 256 + wr * 64 + fr; const int col0 = u.pn * 256 + wc * 32 + 8 * fq; const int b = u.pm >> 4;
        f32x4 gv[2][2];
#pragma unroll
        for (int bj = 0; bj < 2; ++bj)
#pragma unroll
            for (int n = 0; n < 2; ++n) gv[bj][n] = *(const f32x4*)(g1 + (size_t)b * 6144 + col0 + bj * 128 + 4 * n);
#pragma unroll
        for (int ai = 0; ai < 2; ++ai)
#pragma unroll
            for (int m = 0; m < 4; ++m) { const size_t off = (size_t)(row0 + ai * 128 + m * 16) * 1024 + col0;
#pragma unroll
                for (int bj = 0; bj < 2; ++bj)
#pragma unroll
                    for (int n = 0; n < 2; ++n) { const f32x4 xv = *(const f32x4*)(xin + off + bj * 128 + 4 * n);
                        *(f32x4*)(xout + off + bj * 128 + 4 * n) = (ABL == 7) ? xv : xv + gv[bj][n] * acc[ai][bj][m][n]; }
                asm volatile("" ::: "memory"); }
    }
};
struct EpiMoe1 {
    static constexpr bool PERM = true, AFTER_DRAIN = false;
    bf16_t* ACT;
    __device__ __forceinline__ void operator()(const AccT& acc, const pg8::Unit& u, int wr, int wc, int fr, int fq) const {
        const int row0 = u.pm * 256 + wr * 64 + fr; const int col0 = u.pn * 128 + wc * 32 + 8 * fq;
#pragma unroll
        for (int ai = 0; ai < 2; ++ai)
#pragma unroll
            for (int m = 0; m < 4; ++m) { bf16_t* op = ACT + (size_t)(row0 + ai * 128 + m * 16) * 512 + col0; float r[8];
#pragma unroll
                for (int n = 0; n < 2; ++n)
#pragma unroll
                    for (int j = 0; j < 4; ++j) { const float a = acc[ai][0][m][n][j], bb = acc[ai][1][m][n][j]; r[n * 4 + j] = a * sigmoidf_(a) * bb; }
                u32x4 w; w.x = cvt_pk_bf16(r[0], r[1]); w.y = cvt_pk_bf16(r[2], r[3]); w.z = cvt_pk_bf16(r[4], r[5]); w.w = cvt_pk_bf16(r[6], r[7]);
                *(u32x4*)op = w; }
    }
};
struct EpiPlain {
    static constexpr bool PERM = true, AFTER_DRAIN = false;
    bf16_t* O; int ldc;
    __device__ __forceinline__ void operator()(const AccT& acc, const pg8::Unit& u, int wr, int wc, int fr, int fq) const {
        const int row0 = u.pm * 256 + wr * 64 + fr; const int col0 = u.pn * 256 + wc * 32 + 8 * fq;
#pragma unroll
        for (int ai = 0; ai < 2; ++ai)
#pragma unroll
            for (int m = 0; m < 4; ++m) { bf16_t* rowp = O + (size_t)(row0 + ai * 128 + m * 16) * ldc + col0;
#pragma unroll
                for (int bj = 0; bj < 2; ++bj) { const f32x4 v0 = acc[ai][bj][m][0], v1 = acc[ai][bj][m][1]; u32x4 w;
                    w.x = cvt_pk_bf16(v0[0], v0[1]); w.y = cvt_pk_bf16(v0[2], v0[3]); w.z = cvt_pk_bf16(v1[0], v1[1]); w.w = cvt_pk_bf16(v1[2], v1[3]);
                    *(u32x4*)(rowp + bj * 128) = w; } }
    }
};
__device__ __forceinline__ int crow(int r, int hi) { return (r & 3) + 8 * (r >> 2) + 4 * hi; }
__device__ __forceinline__ float gelu_tanh(float x) { const float u2 = 2.0f * 0.7978845608028654f * (x + 0.044715f * x * x * x); return x * __builtin_amdgcn_rcpf(1.0f + __builtin_amdgcn_exp2f(-u2 * LOG2E)); }
struct EpiCmp {
    static constexpr bool PERM = true, AFTER_DRAIN = true;
    bf16_t* HID; const float* CB1; const bf16_t* CW2T; bf16_t* KC;
    __device__ __forceinline__ void fused(const AccT& acc, const pg8::Unit& u, int wr, int wc, int fr, int fq, int wid, int lane) const {
        const int kv = u.pm >> 4; const int row0 = u.pm * 256 + wr * 64 + fr; const int col0 = wc * 32 + 8 * fq;
        const float* bias = CB1 + kv * 256;
        f32x4 bv[2][2];
#pragma unroll
        for (int bj = 0; bj < 2; ++bj)
#pragma unroll
            for (int n = 0; n < 2; ++n) bv[bj][n] = *(const f32x4*)(bias + col0 + bj * 128 + 4 * n);
#pragma unroll
        for (int ai = 0; ai < 2; ++ai)
#pragma unroll
            for (int m = 0; m < 4; ++m) { bf16_t* rowp = HID + (size_t)(row0 + ai * 128 + m * 16) * 256 + col0;
#pragma unroll
                for (int bj = 0; bj < 2; ++bj) { const f32x4 v0 = acc[ai][bj][m][0] + bv[bj][0], v1 = acc[ai][bj][m][1] + bv[bj][1]; u32x4 w;
                    w.x = cvt_pk_bf16(gelu_tanh(v0[0]), gelu_tanh(v0[1])); w.y = cvt_pk_bf16(gelu_tanh(v0[2]), gelu_tanh(v0[3]));
                    w.z = cvt_pk_bf16(gelu_tanh(v1[0]), gelu_tanh(v1[1])); w.w = cvt_pk_bf16(gelu_tanh(v1[2]), gelu_tanh(v1[3]));
                    *(u32x4*)(rowp + bj * 128) = w; } }
        VM_WAIT(); __syncthreads();
        const int r32 = lane & 31, hi = lane >> 5;
        const bf16_t* ap = HID + (size_t)(u.pm * 256 + 32 * wid + r32) * 256 + hi * 8;
        const bf16_t* bp = CW2T + (size_t)kv * 64 * 256 + (size_t)r32 * 256 + hi * 8;
        f32x16 o0 = {}, o1 = {};
#pragma unroll 4
        for (int ks = 0; ks < 16; ++ks) {
            const bf16x8 a = *(const bf16x8*)(ap + ks * 16);
            const bf16x8 b0 = *(const bf16x8*)(bp + ks * 16), b1 = *(const bf16x8*)(bp + 32 * 256 + ks * 16);
            o0 = __builtin_amdgcn_mfma_f32_32x32x16_bf16(a, b0, o0, 0, 0, 0);
            o1 = __builtin_amdgcn_mfma_f32_32x32x16_bf16(a, b1, o1, 0, 0, 0);
        }
        bf16_t* kc = KC + (size_t)u.pm * 256 * 64;
#pragma unroll
        for (int r = 0; r < 16; ++r) { const int c = 32 * wid + crow(r, hi); const bool pad = (c == 255);
            kc[(size_t)c * 64 + r32] = pad ? (bf16_t)0 : (bf16_t)(cvt_pk_bf16(o0[r], 0.f) & 0xffffu);
            kc[(size_t)c * 64 + 32 + r32] = pad ? (bf16_t)0 : (bf16_t)(cvt_pk_bf16(o1[r], 0.f) & 0xffffu); }
    }
};

namespace att {
constexpr int L_KR = 0;
constexpr int L_VR = 24576;
constexpr int L_WSF = 49152;
constexpr int L_BKT = 51200;
constexpr int L_BKC = 55296;
constexpr int L_TBH = 64000;
constexpr int L_GSH = 64576;
constexpr int L_SEL = 67648;
constexpr int L_OTA = 68672;
constexpr int L_IMP = 101440;
constexpr int L_LUT = 117824;
constexpr int L_END = L_LUT + 40960;
static_assert(L_END <= LDS_MISC, "attention LDS map");

__device__ __forceinline__ void glds16(const void* gsrc, unsigned lds_dst) { unsigned keep;
    asm volatile("s_mov_b32 %0, m0\n\ts_mov_b32 m0, %2\n\ts_nop 0\n\tglobal_load_lds_dwordx4 %1, off\n\ts_mov_b32 m0, %0" : "=&s"(keep) : "v"(gsrc), "s"(lds_dst) : "memory"); }
__device__ __forceinline__ int bucket_of(int d) {
    if (d < 16) return d;
    int b = 16;
    b += (d >= 22); b += (d >= 30); b += (d >= 40); b += (d >= 54); b += (d >= 73); b += (d >= 99); b += (d >= 134); b += (d >= 182);
    b += (d >= 246); b += (d >= 332); b += (d >= 450); b += (d >= 609); b += (d >= 825); b += (d >= 1117); b += (d >= 1513);
    return b;
}
__device__ __forceinline__ void qkt(f32x16& p0, f32x16& p1, const LAS unsigned char* Kslot, const bf16x8 (&qr)[4], int r32, int hi) {
    const LAS unsigned char* kb = Kslot + hi * 1024 + r32 * 16;
    p0 = (f32x16){}; p1 = (f32x16){};
#pragma unroll
    for (int d0 = 0; d0 < 4; ++d0) {
        const bf16x8 b0 = *(const LAS bf16x8*)(kb + d0 * 2048);
        const bf16x8 b1 = *(const LAS bf16x8*)(kb + d0 * 2048 + 512);
        p0 = __builtin_amdgcn_mfma_f32_32x32x16_bf16(b0, qr[d0], p0, 0, 0, 0);
        p1 = __builtin_amdgcn_mfma_f32_32x32x16_bf16(b1, qr[d0], p1, 0, 0, 0);
    }
}
__device__ __forceinline__ void pv(f32x16 (&o)[2], int vb, bf16x8 pa0, bf16x8 pa1, bf16x8 pa2, bf16x8 pa3) {
#pragma unroll
    for (int d0 = 0; d0 < 2; ++d0) { s16x4 lo[4], hi[4];
#pragma unroll
        for (int ks = 0; ks < 4; ++ks) {
            asm volatile("ds_read_b64_tr_b16 %0,%1 offset:%c2" : "=&v"(lo[ks]) : "v"(vb), "i"(d0 * 4096 + ks * 1024) : "memory");
            asm volatile("ds_read_b64_tr_b16 %0,%1 offset:%c2" : "=&v"(hi[ks]) : "v"(vb), "i"(d0 * 4096 + ks * 1024 + 512) : "memory"); }
        asm volatile("s_waitcnt lgkmcnt(0)" ::: "memory"); __builtin_amdgcn_sched_barrier(0);
#define PK(k) (bf16x8){lo[k][0], lo[k][1], lo[k][2], lo[k][3], hi[k][0], hi[k][1], hi[k][2], hi[k][3]}
        o[d0] = __builtin_amdgcn_mfma_f32_32x32x16_bf16(pa0, PK(0), o[d0], 0, 0, 0);
        o[d0] = __builtin_amdgcn_mfma_f32_32x32x16_bf16(pa1, PK(1), o[d0], 0, 0, 0);
        o[d0] = __builtin_amdgcn_mfma_f32_32x32x16_bf16(pa2, PK(2), o[d0], 0, 0, 0);
        o[d0] = __builtin_amdgcn_mfma_f32_32x32x16_bf16(pa3, PK(3), o[d0], 0, 0, 0);
#undef PK
    }
}
__device__ __forceinline__ float xhalf_max(float v) { auto rr = __builtin_amdgcn_permlane32_swap(__float_as_uint(v), __float_as_uint(v), false, false); return __builtin_fmaxf(__uint_as_float(rr[0]), __uint_as_float(rr[1])); }
__device__ __forceinline__ float xhalf_sum(float v) { auto rr = __builtin_amdgcn_permlane32_swap(__float_as_uint(v), __float_as_uint(v), false, false); return __uint_as_float(rr[0]) + __uint_as_float(rr[1]); }

#define ATT_PACK(p0, p1, pw0, pw1, pw2, pw3) do { \
    pw0 = (u32x4){cvt_pk_bf16(p0[0], p0[1]), cvt_pk_bf16(p0[2], p0[3]), cvt_pk_bf16(p0[4], p0[5]), cvt_pk_bf16(p0[6], p0[7])}; \
    pw1 = (u32x4){cvt_pk_bf16(p0[8], p0[9]), cvt_pk_bf16(p0[10], p0[11]), cvt_pk_bf16(p0[12], p0[13]), cvt_pk_bf16(p0[14], p0[15])}; \
    pw2 = (u32x4){cvt_pk_bf16(p1[0], p1[1]), cvt_pk_bf16(p1[2], p1[3]), cvt_pk_bf16(p1[4], p1[5]), cvt_pk_bf16(p1[6], p1[7])}; \
    pw3 = (u32x4){cvt_pk_bf16(p1[8], p1[9]), cvt_pk_bf16(p1[10], p1[11]), cvt_pk_bf16(p1[12], p1[13]), cvt_pk_bf16(p1[14], p1[15])}; } while (0)

__device__ __forceinline__ void stage_rows(LAS unsigned char* lds, int wid, int lane, const f32x16 (&ot)[2]) {
    const int r32 = lane & 31, hi = lane >> 5;
    LAS bf16_t* stg = (LAS bf16_t*)(lds + L_OTA) + wid * 2048;
#pragma unroll
    for (int r = 0; r < 16; ++r) { const int orow = crow(r, hi);
#pragma unroll
        for (int d0 = 0; d0 < 2; ++d0) stg[orow * 64 + d0 * 32 + r32] = (bf16_t)(cvt_pk_bf16(ot[d0][r], 0.f) & 0xffffu); }
    LDS_WAIT();
}
struct StreamP { const bf16_t* Kb; const bf16_t* Vb; long pitch; int NT; const LAS unsigned char* tl; unsigned long long lanesel; int uq; const LAS float* lut; int xtop; int dclamp; };
typedef const LAS unsigned char* lds_cptr;
typedef short v4i16_t __attribute__((ext_vector_type(4)));
__device__ __forceinline__ void kload8(bf16x8* kf, lds_cptr kp) {
    kf[0] = *(const LAS bf16x8*)(kp);        kf[1] = *(const LAS bf16x8*)(kp + 512);
    kf[2] = *(const LAS bf16x8*)(kp + 2048); kf[3] = *(const LAS bf16x8*)(kp + 2560);
    kf[4] = *(const LAS bf16x8*)(kp + 4096); kf[5] = *(const LAS bf16x8*)(kp + 4608);
    kf[6] = *(const LAS bf16x8*)(kp + 6144); kf[7] = *(const LAS bf16x8*)(kp + 6656);
}
__device__ __forceinline__ void kload2(bf16x8* kf, lds_cptr kp, int j) { kf[2 * j] = *(const LAS bf16x8*)(kp + j * 2048); kf[2 * j + 1] = *(const LAS bf16x8*)(kp + j * 2048 + 512); }
__device__ __forceinline__ s16x4 vtr(lds_cptr p) { return __builtin_bit_cast(s16x4, __builtin_amdgcn_ds_read_tr16_b64_v4i16((LAS v4i16_t*)p)); }
constexpr int SLOTB = 8192;
#define ST_WAIT_BAR(N) asm volatile("s_waitcnt vmcnt(" #N ") lgkmcnt(0)\n\ts_barrier" ::: "memory")
template <int THRL>
__device__ __forceinline__ void attn_stream(LAS unsigned char* lds, const int wid, const int lane, const bf16x8 (&qr)[4], const StreamP S, float& mhat_o, float& l_o, f32x16 (&o)[2]) {
    const int r32 = lane & 31, hi = lane >> 5;
    const unsigned lds0 = (unsigned)(uintptr_t)lds;
    LAS float* wsf = (LAS float*)(lds + L_WSF) + wid * 64;
    const int NT = S.NT;
    const bf16_t* ksrc = S.Kb + (long)lane * S.pitch + wid * 8;
    const bf16_t* vsrc = S.Vb + (long)(16 * (wid & 3) + (lane >> 2)) * S.pitch + (wid >> 2) * 32 + (lane & 3) * 8;
    const unsigned kdst = lds0 + L_KR + wid * 1024, vdst = lds0 + L_VR + wid * 1024;
    const int tlv = (lane < NT) ? (int)S.tl[lane] : 0x80;
#define TLRAW(k) ((int)__builtin_amdgcn_readlane(tlv, __builtin_amdgcn_readfirstlane(k)))
#define DMA_K(k, slot) do { const int tr_ = TLRAW(k) & 63; glds16(ksrc + (long)tr_ * 64 * S.pitch, (unsigned)__builtin_amdgcn_readfirstlane(kdst + (slot))); } while (0)
#define DMA_V(k, slot) do { const int tr_ = TLRAW(k) & 63; glds16(vsrc + (long)tr_ * 64 * S.pitch, (unsigned)__builtin_amdgcn_readfirstlane(vdst + (slot))); } while (0)
    const lds_cptr kp0 = (lds_cptr)lds + L_KR + hi * 1024 + r32 * 16;
    const lds_cptr vp0 = (lds_cptr)lds + L_VR + ((lane >> 4) & 1) * 32 + (lane & 3) * 8 + (4 * hi + ((lane & 15) >> 2)) * 64;
    const int vb0 = (int)(lds0 + L_VR) + ((lane >> 4) & 1) * 32 + (lane & 3) * 8 + (4 * hi + ((lane & 15) >> 2)) * 64;
    bf16x8 kf[8];
#define LOFF(r) (((r) & 3) + 8 * ((r) >> 2))
#define LUTPTR(k, lp) do { const int raw_ = TLRAW(k); const int tj_ = raw_ & 63; int d0_ = S.uq - 64 * tj_ - 4 * hi; d0_ = d0_ < S.dclamp ? d0_ : S.dclamp; \
        const bool ok_ = (raw_ < 128) && (((S.lanesel >> tj_) & 1ull) != 0ull); lp = S.lut + (ok_ ? S.xtop - d0_ : S.xtop + 64); } while (0)
#define LUTLOAD(C0, C1, k) do { const int raw_ = TLRAW(k); const int tj_ = raw_ & 63; int d0_ = S.uq - 64 * tj_ - 4 * hi; d0_ = d0_ < S.dclamp ? d0_ : S.dclamp; \
        const bool ok_ = (raw_ < 128) && (((S.lanesel >> tj_) & 1ull) != 0ull); const LAS float* lp_ = S.lut + (ok_ ? S.xtop - d0_ : S.xtop + 64); \
        _Pragma("unroll") for (int r = 0; r < 16; ++r) { C0[r] = lp_[(r & 3) + 8 * (r >> 2)]; C1[r] = lp_[(r & 3) + 8 * (r >> 2) + 32]; } } while (0)
#define SBAR() __builtin_amdgcn_sched_barrier(0)
#define PIN(x) asm volatile("" : "+v"(x))
#define PKW(P, B) cvt_pk_bf16(P[B], P[B + 1])
#define PAF(k) __builtin_bit_cast(bf16x8, pw##k)
#define VFR(i) (bf16x8){vlo[i][0], vlo[i][1], vlo[i][2], vlo[i][3], vhi[i][0], vhi[i][1], vhi[i][2], vhi[i][3]}
#define MX3(a, b, c) __builtin_fmaxf(__builtin_fmaxf((a), (b)), (c))
#define MFMA32(a, b, c) __builtin_amdgcn_mfma_f32_32x32x16_bf16(a, b, c, 0, 0, 0)
#define GAPA(MF, A0, A1, A2, A3, W0, W1, PW) do { MF; sacc += A0; sacc += A1; sacc += A2; sacc += A3; PIN(sacc); W0; W1; PIN(PW); SBAR(); } while (0)
#define EX(v) __builtin_amdgcn_exp2f(v)
#define GAPB(MF, X, B, GN, PL, PO) do { MF; X[B] = EX(X[B]); X[B + 1] = EX(X[B + 1]); X[B + 2] = EX(X[B + 2]); X[B + 3] = EX(X[B + 3]); PIN(X); \
        if (GN) { PL[B] = lpn_[LOFF(B) + PO]; PL[B + 1] = lpn_[LOFF(B + 1) + PO]; PL[B + 2] = lpn_[LOFF(B + 2) + PO]; PL[B + 3] = lpn_[LOFF(B + 3) + PO]; } SBAR(); } while (0)
#define VRD(i) do { vlo[i] = vtr(vp_ + (((i) >> 2) * 4096 + ((i) & 3) * 1024)); vhi[i] = vtr(vp_ + (((i) >> 2) * 4096 + ((i) & 3) * 1024 + 512)); } while (0)
#define KRD(G, j) do { if (G) { kload2(kf, kp0 + sl_next, j); SBAR(); } } while (0)
#define ROT() do { sl_prev = sl_cur; sl_cur = sl_next; sl_next = (sl_next == 2 * SLOTB) ? 0 : sl_next + SLOTB; } while (0)
#define RESC() do { if (resc) { LDS_WAIT(); _Pragma("unroll") for (int d_ = 0; d_ < 2; ++d_) _Pragma("unroll") for (int r = 0; r < 16; ++r) o[d_][r] *= wsf[crow(r, hi)]; } } while (0)
#define ENDW(tt) do { if ((tt) + 3 < NT) { ST_WAIT_BAR(2); } else if ((tt) + 2 < NT) { ST_WAIT_BAR(1); } else { ST_WAIT_BAR(0); } } while (0)
#define STEP(C0, C1, P0, P1, t, GK, GV, GL, GN) do { SBAR(); \
    const lds_cptr vp_ = vp0 + sl_prev; const LAS float* lpn_ = S.lut; if (GN) { LUTPTR((t) + 1, lpn_); } \
    VRD(0); SBAR(); float sacc = (P0[0] + P0[1]); \
    GAPA(C0 = MFMA32(kf[0], qr[0], C0), P0[2], P0[3], P0[4], P0[5],     pw0[0] = PKW(P0, 0), pw0[1] = PKW(P0, 2), pw0); \
    VRD(4); SBAR(); GAPA(C1 = MFMA32(kf[1], qr[0], C1), P0[6], P0[7], P0[8], P0[9],     pw0[2] = PKW(P0, 4), pw0[3] = PKW(P0, 6), pw0); \
    VRD(1); SBAR(); GAPA(C0 = MFMA32(kf[2], qr[1], C0), P0[10], P0[11], P0[12], P0[13], pw1[0] = PKW(P0, 8), pw1[1] = PKW(P0, 10), pw1); \
    VRD(5); SBAR(); GAPA(C1 = MFMA32(kf[3], qr[1], C1), P0[14], P0[15], P1[0], P1[1],   pw1[2] = PKW(P0, 12), pw1[3] = PKW(P0, 14), pw1); \
    VRD(2); SBAR(); GAPA(C0 = MFMA32(kf[4], qr[2], C0), P1[2], P1[3], P1[4], P1[5],     pw2[0] = PKW(P1, 0), pw2[1] = PKW(P1, 2), pw2); \
    VRD(6); SBAR(); GAPA(C1 = MFMA32(kf[5], qr[2], C1), P1[6], P1[7], P1[8], P1[9],     pw2[2] = PKW(P1, 4), pw2[3] = PKW(P1, 6), pw2); \
    VRD(3); SBAR(); GAPA(C0 = MFMA32(kf[6], qr[3], C0), P1[10], P1[11], P1[12], P1[13], pw3[0] = PKW(P1, 8), pw3[1] = PKW(P1, 10), pw3); \
    VRD(7); SBAR(); GAPA(C1 = MFMA32(kf[7], qr[3], C1), P1[14], P1[15], 0.f, 0.f,       pw3[2] = PKW(P1, 12), pw3[3] = PKW(P1, 14), pw3); \
    l_reg += sacc; \
    if (GK) { DMA_K((t) + 3, sl_cur); } if (GV) { DMA_V((t) + 1, sl_next); } \
    { _Pragma("unroll") for (int r = 0; r < 16; ++r) { C0[r] -= mhat; C1[r] -= mhat; } \
      float a_ = MX3(C0[0], C0[1], C1[0]), b_ = MX3(C0[2], C0[3], C1[1]); a_ = MX3(a_, C1[2], C1[3]); \
      _Pragma("unroll") for (int r = 4; r < 16; r += 4) { a_ = MX3(a_, C0[r], C0[r + 1]); b_ = MX3(b_, C0[r + 2], C0[r + 3]); a_ = MX3(a_, C1[r], C1[r + 1]); b_ = MX3(b_, C1[r + 2], C1[r + 3]); } \
      float rm = xhalf_max(__builtin_fmaxf(a_, b_)); \
      resc = false; \
      if (__builtin_expect(__any(rm > (float)THRL), 0)) { const float dl = __builtin_fmaxf(rm, 0.f); mhat += dl; \
        _Pragma("unroll") for (int r = 0; r < 16; ++r) { C0[r] -= dl; C1[r] -= dl; } \
        const float f = __builtin_amdgcn_exp2f(-dl); l_reg *= f; if (hi == 0) wsf[r32] = f; resc = true; } } \
    SBAR(); \
    GAPB(o[0] = MFMA32(PAF(0), VFR(0), o[0]), C0, 0, GN, P0, 0); \
    GAPB(o[1] = MFMA32(PAF(0), VFR(4), o[1]), C0, 4, GN, P0, 0); \
    KRD(GL, 0); GAPB(o[0] = MFMA32(PAF(1), VFR(1), o[0]), C0, 8, GN, P0, 0); \
    KRD(GL, 1); GAPB(o[1] = MFMA32(PAF(1), VFR(5), o[1]), C0, 12, GN, P0, 0); \
    KRD(GL, 2); GAPB(o[0] = MFMA32(PAF(2), VFR(2), o[0]), C1, 0, GN, P1, 32); \
    KRD(GL, 3); GAPB(o[1] = MFMA32(PAF(2), VFR(6), o[1]), C1, 4, GN, P1, 32); \
    GAPB(o[0] = MFMA32(PAF(3), VFR(3), o[0]), C1, 8, GN, P1, 32); \
    GAPB(o[1] = MFMA32(PAF(3), VFR(7), o[1]), C1, 12, GN, P1, 32); \
    } while (0)
    float mhat = 0.f, l_reg = 0.f; bool resc = false;
    o[0] = (f32x16){}; o[1] = (f32x16){};
    f32x16 pA0, pA1, pB0, pB1;
    int sl_prev = 0, sl_cur = 0, sl_next = SLOTB;
    DMA_K(0, 0); DMA_V(0, 0); DMA_K(1, SLOTB); DMA_K(2, 2 * SLOTB);
    LUTLOAD(pA0, pA1, 0);
    ST_WAIT_BAR(3);
    { const lds_cptr kb = kp0;
#pragma unroll
      for (int d0 = 0; d0 < 4; ++d0) { const bf16x8 b0 = *(const LAS bf16x8*)(kb + d0 * 2048); const bf16x8 b1 = *(const LAS bf16x8*)(kb + d0 * 2048 + 512);
          pA0 = MFMA32(b0, qr[d0], pA0); pA1 = MFMA32(b1, qr[d0], pA1); }
      float rm = pA0[0];
#pragma unroll
      for (int r = 1; r < 16; ++r) rm = __builtin_fmaxf(rm, pA0[r]);
#pragma unroll
      for (int r = 0; r < 16; ++r) rm = __builtin_fmaxf(rm, pA1[r]);
      rm = xhalf_max(rm);
      mhat = (rm == -INFINITY) ? 0.f : rm;
#pragma unroll
      for (int r = 0; r < 16; ++r) { pA0[r] = EX(pA0[r] - mhat); pA1[r] = EX(pA1[r] - mhat); } }
    ST_WAIT_BAR(0);
    DMA_K(3, 0); DMA_V(1, SLOTB);
    ROT();
    kload8(kf, kp0 + sl_cur);
    LUTLOAD(pB0, pB1, 1);
    ST_WAIT_BAR(2);
    s16x4 vlo[8], vhi[8]; u32x4 pw0, pw1, pw2, pw3;
    int t = 1;
    for (; t + 5 < NT; t += 2) {
        STEP(pB0, pB1, pA0, pA1, t, true, true, true, true);     ST_WAIT_BAR(2); RESC(); ROT();
        STEP(pA0, pA1, pB0, pB1, t + 1, true, true, true, true); ST_WAIT_BAR(2); RESC(); ROT();
    }
    for (; t + 1 < NT; t += 2) {
        STEP(pB0, pB1, pA0, pA1, t, (t + 3 < NT), (t + 1 < NT), (t + 1 < NT), true);       ENDW(t);     RESC(); ROT();
        STEP(pA0, pA1, pB0, pB1, t + 1, (t + 4 < NT), (t + 2 < NT), (t + 2 < NT), true);   ENDW(t + 1); RESC(); ROT();
    }
    STEP(pB0, pB1, pA0, pA1, NT - 1, false, false, false, false); RESC();
    { float sacc = pB0[0] + pB0[1];
#pragma unroll
      for (int r = 2; r < 16; ++r) sacc += pB0[r];
#pragma unroll
      for (int r = 0; r < 16; ++r) sacc += pB1[r];
      l_reg += sacc;
      ATT_PACK(pB0, pB1, pw0, pw1, pw2, pw3);
      SBAR(); pv(o, vb0 + sl_cur, PAF(0), PAF(1), PAF(2), PAF(3)); }
    asm volatile("s_waitcnt lgkmcnt(0)\n\ts_barrier" ::: "memory");
    mhat_o = mhat; l_o = l_reg;
#undef TLRAW
#undef DMA_K
#undef DMA_V
#undef LUTLOAD
#undef LUTPTR
#undef LOFF
#undef SBAR
#undef PIN
#undef PKW
#undef PAF
#undef VFR
#undef MX3
#undef MFMA32
#undef GAPA
#undef EX
#undef GAPB
#undef VRD
#undef KRD
#undef ROT
#undef RESC
#undef ENDW
#undef STEP
}
__device__ __forceinline__ void cmp_scores(f32x16& s0, f32x16& s1, LAS unsigned char* lds, const LAS unsigned char* bkc, const LAS unsigned char* tb, const bf16x8 (&qr)[4], const int k, const int r32, const int hi) {
#pragma unroll
    for (int r = 0; r < 16; ++r) { const int off = 16 * ((r & 3) + 8 * (r >> 2));
        s0[r] = *(const LAS float*)(tb + bkc[1024 * k + off]); s1[r] = *(const LAS float*)(tb + bkc[1024 * k + off + 512]); }
    const LAS unsigned char* kb = lds + k * 8192 + hi * 1024 + r32 * 16;
#pragma unroll
    for (int d0 = 0; d0 < 4; ++d0) { const bf16x8 b0 = *(const LAS bf16x8*)(kb + d0 * 2048); const bf16x8 b1 = *(const LAS bf16x8*)(kb + d0 * 2048 + 512);
        s0 = __builtin_amdgcn_mfma_f32_32x32x16_bf16(b0, qr[d0], s0, 0, 0, 0); s1 = __builtin_amdgcn_mfma_f32_32x32x16_bf16(b1, qr[d0], s1, 0, 0, 0); }
}
__device__ __forceinline__ float xhalf_other(float v, int hi) { auto rr = __builtin_amdgcn_permlane32_swap(__float_as_uint(v), __float_as_uint(v), false, false); return __uint_as_float(hi ? rr[0] : rr[1]); }
__device__ __forceinline__ void cmp_branch(LAS unsigned char* lds, const int wid, const int lane, const bf16x8 (&qr)[4], const bf16_t* Kb, const bf16_t* Vb, const int nt, const int t, f32x16 (&o)[2]) {
    const int r32 = lane & 31, hi = lane >> 5, g = wid >> 1, tq = (wid & 1) * 32 + r32;
    const unsigned lds0 = (unsigned)(uintptr_t)lds;
    { const bf16_t* ksrc = Kb + (long)lane * 64 + wid * 8; const bf16_t* vsrc = Vb + (long)(16 * (wid & 3) + (lane >> 2)) * 64 + (wid >> 2) * 32 + (lane & 3) * 8;
      for (int k = 0; k < nt; ++k) { glds16(ksrc + (long)k * 4096, (unsigned)__builtin_amdgcn_readfirstlane(lds0 + k * 8192 + wid * 1024));
                                     glds16(vsrc + (long)k * 4096, (unsigned)__builtin_amdgcn_readfirstlane(lds0 + L_OTA + k * 8192 + wid * 1024)); } }
    const LAS unsigned char* bkc = lds + L_BKC + (4126 - t + 64 * hi);
    const LAS unsigned char* tb = lds + L_TBH + g * 144;
    asm volatile("s_waitcnt vmcnt(0)\n\ts_barrier" ::: "memory");
    float m = -INFINITY, l = 0.f;
#pragma clang loop unroll(disable)
    for (int k = 0; k < nt; ++k) { f32x16 s0, s1; cmp_scores(s0, s1, lds, bkc, tb, qr, k, r32, hi);
        float rm = s0[0];
#pragma unroll
        for (int r = 1; r < 16; ++r) rm = __builtin_fmaxf(rm, s0[r]);
#pragma unroll
        for (int r = 0; r < 16; ++r) rm = __builtin_fmaxf(rm, s1[r]);
        rm = xhalf_max(rm);
        const float mn = __builtin_fmaxf(m, rm), ms = (mn == -INFINITY) ? 0.f : mn;
        float ps = 0.f;
#pragma unroll
        for (int r = 0; r < 16; ++r) ps += __builtin_amdgcn_exp2f(s0[r] - ms) + __builtin_amdgcn_exp2f(s1[r] - ms);
        l = l * __builtin_amdgcn_exp2f(m - ms) + ps; m = mn; }
    l = xhalf_sum(l);
    const float msafe = (m == -INFINITY) ? 0.f : m, inv = l > 0.f ? 1.0f / l : 0.f;
    float I[4][8]; float pc7 = 0.f;
    o[0] = (f32x16){}; o[1] = (f32x16){};
    const int vb0 = (int)(lds0 + L_OTA) + ((lane >> 4) & 1) * 32 + (lane & 3) * 8 + (4 * hi + ((lane & 15) >> 2)) * 64;
#pragma unroll
    for (int k = 0; k < 4; ++k) {
        if (k < nt) { f32x16 s0, s1; cmp_scores(s0, s1, lds, bkc, tb, qr, k, r32, hi);
#pragma unroll
            for (int r = 0; r < 16; ++r) { s0[r] = __builtin_amdgcn_exp2f(s0[r] - msafe) * inv; s1[r] = __builtin_amdgcn_exp2f(s1[r] - msafe) * inv; }
            float pc[8];
#pragma unroll
            for (int q = 0; q < 4; ++q) { I[k][q] = 2.0f * (s0[4 * q] + s0[4 * q + 1] + s0[4 * q + 2]) + s0[4 * q + 3]; I[k][4 + q] = 2.0f * (s1[4 * q] + s1[4 * q + 1] + s1[4 * q + 2]) + s1[4 * q + 3];
                pc[q] = xhalf_other(s0[4 * q + 3], hi); pc[4 + q] = xhalf_other(s1[4 * q + 3], hi); }
#pragma unroll
            for (int j = 0; j < 8; ++j) I[k][j] += hi ? pc[j] : (j > 0 ? pc[j - 1] : pc7);
            pc7 = pc[7];
            u32x4 pw0, pw1, pw2, pw3; ATT_PACK(s0, s1, pw0, pw1, pw2, pw3);
            pv(o, vb0 + k * 8192, __builtin_bit_cast(bf16x8, pw0), __builtin_bit_cast(bf16x8, pw1), __builtin_bit_cast(bf16x8, pw2), __builtin_bit_cast(bf16x8, pw3));
        } else {
#pragma unroll
            for (int j = 0; j < 8; ++j) I[k][j] = 0.f;
        }
    }
    LAS float* imp = (LAS float*)(lds + L_IMP) + tq * 64 + hi;
#pragma unroll 1
    for (int gi = 0; gi < 4; ++gi) {
        if (g == gi) {
#pragma unroll
            for (int k = 0; k < 4; ++k) if (k < nt) {
#pragma unroll
                for (int j = 0; j < 8; ++j) __builtin_amdgcn_ds_faddf(imp + 16 * k + 2 * j, I[k][j], 0, 0, false);
            }
        }
        asm volatile("s_waitcnt lgkmcnt(0)\n\ts_barrier" ::: "memory");
    }
}
}

struct Ctx { int tid, lane, wave, vcu, G, bx; LAS unsigned char* lds; };

struct TrD { const float* src; size_t ldw; int nvalid; bf16_t* dst; size_t ldk; };
__device__ __forceinline__ void tr_load(const TrD& d, float (&v)[32], int lane) {
    const int n = lane & 31; const float* src = d.src + (size_t)(lane >> 5) * d.ldw + n;
#pragma unroll
    for (int i = 0; i < 32; ++i) v[i] = (n < d.nvalid) ? src[(size_t)(2 * i) * d.ldw] : 0.f;
}
__device__ __forceinline__ void tr_store(const TrD& d, const float (&v)[32], LAS float* scr, int lane) {
    const int n = lane & 31;
#pragma unroll
    for (int i = 0; i < 32; ++i) scr[(2 * i + (lane >> 5)) * 33 + n] = v[i];
    LDS_WAIT(); asm volatile("" ::: "memory");
    const int c = lane & 7;
#pragma unroll
    for (int j = 0; j < 4; ++j) { const int nn = (lane >> 3) + 8 * j; const LAS float* s = scr + (8 * c) * 33 + nn;
        u32x4 o; o.x = cvt_pk_bf16(s[0 * 33], s[1 * 33]); o.y = cvt_pk_bf16(s[2 * 33], s[3 * 33]); o.z = cvt_pk_bf16(s[4 * 33], s[5 * 33]); o.w = cvt_pk_bf16(s[6 * 33], s[7 * 33]);
        *(u32x4*)(d.dst + (size_t)nn * d.ldk + 8 * c) = o; }
    LDS_WAIT(); asm volatile("" ::: "memory");
}
__device__ __forceinline__ TrD mk_trd(const float* W, size_t ldw, int srccol, int nvalid, bf16_t* WT, size_t ldk, int dstrow, int k0) {
    TrD d; d.src = W + (size_t)k0 * ldw + srccol; d.ldw = ldw; d.nvalid = nvalid; d.dst = WT + (size_t)dstrow * ldk + k0; d.ldk = ldk; return d; }
__device__ __forceinline__ TrD dec_small(const Args& a, int it) {
    constexpr int I_WIN = 184 * 16, I_CW1 = 2 * 8 * 32, I_WUN = 32 * 8, I_WUD = 32 * 4, I_WO = 32 * 16, I_CW2 = 2 * 2 * 4;
    constexpr int PER = I_WIN + I_CW1 + I_WUN + I_WUD + I_WO + I_CW2;
    unsigned char* ws = a.ws;
    const int l = it / PER; int r = it % PER;
    if (r < I_WIN) { const int nb = r / 16, kb = r % 16; const int nd = 32 * nb; int src, nv = 32;
        if (nd < 1280) src = nd; else if (nd < 5632) src = nd + 24; else if (nd == 5632) { src = 1280; nv = 24; } else { src = 0; nv = 0; }
        return mk_trd(a.w_in + (size_t)l * DM * INW, INW, src, nv, (bf16_t*)(ws + WS_WINT) + (size_t)l * NIN * DM, DM, nd, 64 * kb); }
    r -= I_WIN;
    if (r < I_CW1) { const int kv = r / 256, q = r % 256, nb = q / 32, kb = q % 32;
        return mk_trd(a.cmp_w1 + (size_t)(l * 2 + kv) * 2048 * 256, 256, 32 * nb, 32, (bf16_t*)(ws + WS_CW1T) + (size_t)(l * 2 + kv) * 256 * 2048, 2048, 32 * nb, 64 * kb); }
    r -= I_CW1;
    if (r < I_WUN) { const int nb = r / 8, kb = r % 8;
        return mk_trd(a.w_up_nsa + (size_t)l * 512 * 1024, 1024, 32 * nb, 32, (bf16_t*)(ws + WS_WUNT) + (size_t)l * 1024 * 512, 512, 32 * nb, 64 * kb); }
    r -= I_WUN;
    if (r < I_WUD) { const int nb = r / 4, kb = r % 4;
        return mk_trd(a.w_up_dil + (size_t)l * 256 * 1024, 1024, 32 * nb, 32, (bf16_t*)(ws + WS_WUDT) + (size_t)l * 1024 * 256, 256, 32 * nb, 64 * kb); }
    r -= I_WUD;
    if (r < I_WO) { const int nb = r / 16, kb = r % 16;
        return mk_trd(a.w_o + (size_t)l * 1024 * 1024, 1024, 32 * nb, 32, (bf16_t*)(ws + WS_WOT) + (size_t)l * 1024 * 1024, 1024, 32 * nb, 64 * kb); }
    r -= I_WO;
    { const int kv = r / 8, q = r % 8, nb = q / 4, kb = q % 4;
        return mk_trd(a.cmp_w2 + (size_t)(l * 2 + kv) * 256 * 64, 64, 32 * nb, 32, (bf16_t*)(ws + WS_CW2T) + (size_t)(l * 2 + kv) * 64 * 256, 256, 32 * nb, 64 * kb); }
}
__device__ __forceinline__ TrD dec_expert(const Args& a, int l, int it) {
    constexpr int I_13 = 32 * 16, I_2 = 32 * 8, PER = I_13 + I_2;
    unsigned char* ws = a.ws;
    const int e = it / PER; int r = it % PER;
    if (r < I_13) { const int nb = r / 16, kb = r % 16; const int r0 = 32 * nb, pn = r0 >> 8, bj = (r0 >> 7) & 1, j0 = r0 & 127;
        const float* src = (bj ? a.exp_w3 : a.exp_w1) + (size_t)(l * 32 + e) * 1024 * 512;
        return mk_trd(src, 512, pn * 128 + j0, 32, (bf16_t*)(ws + WS_E13T) + (size_t)e * 1024 * 1024, 1024, r0, 64 * kb); }
    r -= I_13;
    { const int nb = r / 8, kb = r % 8;
        return mk_trd(a.exp_w2 + (size_t)(l * 32 + e) * 512 * 1024, 1024, 32 * nb, 32, (bf16_t*)(ws + WS_E2T) + (size_t)e * 1024 * 512, 512, 32 * nb, 64 * kb); }
}
template <int KIND> __device__ __forceinline__ void conv_items(const Args& a, const Ctx& C, int l, int nitems) {
    LAS float* scr = (LAS float*)(C.lds + C.wave * 16384);
    const int gw = C.vcu * NWAVES + C.wave, NGW = C.G * NWAVES;
    float va[32], vb[32]; TrD d0, d1;
    int it = gw;
    if (it >= nitems) return;
    d0 = KIND ? dec_expert(a, l, it) : dec_small(a, it); tr_load(d0, va, C.lane);
    for (;;) {
        const int itn = it + NGW; const bool hn = itn < nitems;
        if (hn) { d1 = KIND ? dec_expert(a, l, itn) : dec_small(a, itn); tr_load(d1, vb, C.lane); }
        tr_store(d0, va, scr, C.lane);
        if (!hn) break;
        const int itnn = itn + NGW; const bool hnn = itnn < nitems;
        if (hnn) { d0 = KIND ? dec_expert(a, l, itnn) : dec_small(a, itnn); tr_load(d0, va, C.lane); }
        tr_store(d1, vb, scr, C.lane);
        if (!hnn) break;
        it = itnn;
    }
}
__device__ __forceinline__ void conv_small(const Args& a, const Ctx& C) { conv_items<0>(a, C, 0, 2 * 4368); }
__device__ __forceinline__ void conv_experts(const Args& a, const Ctx& C, int l) { conv_items<1>(a, C, l, 32 * 768); }
__device__ __forceinline__ void prologue_vectors(const Args& a, const Ctx& C) {
    LAS float* sc = (LAS float*)(C.lds + 131072);
    LAS float* sl = (LAS float*)(C.lds);
    for (int i = C.tid; i < 8 * 1024; i += NTHR) { const float v = a.c[i]; sl[i] = v * sigmoidf_(v); }
    (void)sc;
    __syncthreads();
    const int gw = C.vcu * NWAVES + C.wave, NGW = C.G * NWAVES;
    float* MOD = (float*)(a.ws + WS_MOD); float* CB1 = (float*)(a.ws + WS_CB1);
    for (int it = gw; it < 192 + 16; it += NGW) {
        if (it < 192) { const int l = it / 96, col = (it % 96) * 64 + C.lane;
            const float* w = a.ada_w + (size_t)l * 1024 * 6144 + col;
            float acc[8];
#pragma unroll
            for (int b = 0; b < 8; ++b) acc[b] = 0.f;
            for (int k = 0; k < 1024; ++k) { const float wv = w[(size_t)k * 6144];
#pragma unroll
                for (int b = 0; b < 8; ++b) acc[b] += sl[b * 1024 + k] * wv; }
            const float bias = a.ada_b[l * 6144 + col];
#pragma unroll
            for (int b = 0; b < 8; ++b) MOD[(size_t)(l * 8 + b) * 6144 + col] = acc[b] + bias;
        } else { const int q = it - 192, lk = q / 4, col = (q % 4) * 64 + C.lane;
            const float* w = a.cmp_w1 + (size_t)lk * 2048 * 256 + col; const float* pos = a.cmp_pos + (size_t)lk * 2048;
            float acc = 0.f;
            for (int k = 0; k < 2048; ++k) acc += pos[k] * w[(size_t)k * 256];
            CB1[lk * 256 + col] = acc;
        }
    }
    __syncthreads();
}

__device__ __forceinline__ void moe_combine_row(const Args& a, int row, int lane, const float* g2  , f32x4 (&v)[4]) {
    const u32x4 rec = *(const u32x4*)(a.ws + WS_DEST + (size_t)row * 16);
    const bf16_t* Y = (const bf16_t*)(a.ws + WS_XS);
    const float w0 = (ABL == 6) ? 0.f : __uint_as_float(rec.z), w1 = (ABL == 6) ? 0.f : __uint_as_float(rec.w);
    const u32x2* y0 = (const u32x2*)(Y + (size_t)rec.x * 1024) + lane; const u32x2* y1 = (const u32x2*)(Y + (size_t)rec.y * 1024) + lane;
#pragma unroll
    for (int j = 0; j < 4; ++j) { const u32x2 p = y0[64 * j], q = y1[64 * j]; const f32x4 gg = *((const f32x4*)g2 + lane + 64 * j);
        v[j][0] += gg[0] * (w0 * bf_lo(p.x) + w1 * bf_lo(q.x)); v[j][1] += gg[1] * (w0 * bf_hi(p.x) + w1 * bf_hi(q.x));
        v[j][2] += gg[2] * (w0 * bf_lo(p.y) + w1 * bf_lo(q.y)); v[j][3] += gg[3] * (w0 * bf_hi(p.y) + w1 * bf_hi(q.y)); }
}
__device__ __forceinline__ void norm1_phase(const Args& a, const Ctx& C, int l) {
    const int gw = C.vcu * NWAVES + C.wave, NGW = C.G * NWAVES;
    const float* MOD = (const float*)(a.ws + WS_MOD); bf16_t* H = (bf16_t*)(a.ws + WS_H);
    const float* nw = a.norm1 + l * 1024;
    for (int row = gw; row < T; row += NGW) {
        const int b = row >> 12; const float* xr = (l == 0 ? a.x : (const float*)a.out) + (size_t)row * 1024;
        f32x4 v[4];
#pragma unroll
        for (int j = 0; j < 4; ++j) v[j] = *((const f32x4*)xr + C.lane + 64 * j);
        if (l == 1) { moe_combine_row(a, row, C.lane, MOD + (size_t)(0 * 8 + b) * 6144 + 5120, v);
#pragma unroll
            for (int j = 0; j < 4; ++j) *((f32x4*)(a.out + (size_t)row * 1024) + C.lane + 64 * j) = v[j]; }
        float ss = 0.f;
#pragma unroll
        for (int j = 0; j < 4; ++j) ss += (v[j][0] * v[j][0] + v[j][1] * v[j][1]) + (v[j][2] * v[j][2] + v[j][3] * v[j][3]);
        const float rstd = 1.0f / sqrtf(wave_sum(ss) * (1.0f / 1024.0f) + RMS_EPS);
        const float* mb = MOD + (size_t)(l * 8 + b) * 6144;
#pragma unroll
        for (int j = 0; j < 4; ++j) { const f32x4 g = *((const f32x4*)nw + C.lane + 64 * j), sh = *((const f32x4*)mb + C.lane + 64 * j), sc = *((const f32x4*)(mb + 1024) + C.lane + 64 * j);
            const f32x4 h = v[j] * rstd * g * (sc + 1.0f) + sh; u32x2 w; w.x = cvt_pk_bf16(h[0], h[1]); w.y = cvt_pk_bf16(h[2], h[3]);
            *((u32x2*)(H + (size_t)row * 1024) + C.lane + 64 * j) = w; }
    }
}
__device__ __forceinline__ void final_phase(const Args& a, const Ctx& C) {
    const int gw = C.vcu * NWAVES + C.wave, NGW = C.G * NWAVES;
    const float* MOD = (const float*)(a.ws + WS_MOD);
    for (int row = gw; row < T; row += NGW) {
        const int b = row >> 12; float* xr = a.out + (size_t)row * 1024;
        f32x4 v[4];
#pragma unroll
        for (int j = 0; j < 4; ++j) v[j] = *((const f32x4*)xr + C.lane + 64 * j);
        moe_combine_row(a, row, C.lane, MOD + (size_t)(1 * 8 + b) * 6144 + 5120, v);
        float ss = 0.f;
#pragma unroll
        for (int j = 0; j < 4; ++j) ss += (v[j][0] * v[j][0] + v[j][1] * v[j][1]) + (v[j][2] * v[j][2] + v[j][3] * v[j][3]);
        const float rstd = 1.0f / sqrtf(wave_sum(ss) * (1.0f / 1024.0f) + RMS_EPS);
#pragma unroll
        for (int j = 0; j < 4; ++j) { const f32x4 g = *((const f32x4*)a.norm_f + C.lane + 64 * j); *((f32x4*)xr + C.lane + 64 * j) = v[j] * rstd * g; }
    }
}
typedef float f32x4v __attribute__((ext_vector_type(4)));
__device__ __forceinline__ void norm2_router_phase(const Args& a, const Ctx& C, int l) {
    constexpr int RP = 2064;
    LAS unsigned char* HH = C.lds; LAS unsigned char* HL = C.lds + 16 * RP;
    LAS float* PART = (LAS float*)(C.lds + 2 * 16 * RP);
    LAS float* LOGI = PART + 8 * 16 * 48;
    LAS int* wcnt = (LAS int*)(C.lds + LDS_MISC + 256);
    const float* wg = a.router_wg + (size_t)l * 1024 * 4; const float* we = a.router_we + (size_t)l * 1024 * 32;
    const int lane = C.lane, wave = C.wave, fr = lane & 15, fq = lane >> 4;
    bf16x8 Wh[4][3], Wl[4][3];
#pragma unroll
    for (int ks = 0; ks < 4; ++ks)
#pragma unroll
        for (int ct = 0; ct < 3; ++ct) { const int cc = 16 * ct + fr; const int k0 = 128 * wave + 32 * ks + 8 * fq; unsigned hw[4], lw[4];
#pragma unroll
            for (int i = 0; i < 8; i += 2) { float v0 = 0.f, v1 = 0.f;
                if (cc < 4) { v0 = wg[(size_t)(k0 + i) * 4 + cc]; v1 = wg[(size_t)(k0 + i + 1) * 4 + cc]; }
                else if (cc < 36) { v0 = we[(size_t)(k0 + i) * 32 + cc - 4]; v1 = we[(size_t)(k0 + i + 1) * 32 + cc - 4]; }
                const unsigned hp = cvt_pk_bf16(v0, v1); hw[i >> 1] = hp; lw[i >> 1] = cvt_pk_bf16(v0 - bf_lo(hp), v1 - bf_hi(hp)); }
            Wh[ks][ct] = __builtin_bit_cast(bf16x8, (u32x4){hw[0], hw[1], hw[2], hw[3]}); Wl[ks][ct] = __builtin_bit_cast(bf16x8, (u32x4){lw[0], lw[1], lw[2], lw[3]}); }
    const float* MOD = (const float*)(a.ws + WS_MOD); bf16_t* H2 = (bf16_t*)(a.ws + WS_H2);
    const float* nw = a.norm2 + l * 1024; const float* bg = a.router_bg + l * 4; const float* be = a.router_be + l * 32;
    int* CNTBLK = (int*)(a.ws + WS_CNTBLK);
    for (int ch = C.vcu; ch < T / 128; ch += C.G) {
        int my_e0 = 0, my_e1 = 0; float my_w0 = 0.f, my_w1 = 0.f;
#pragma clang loop unroll(disable)
        for (int gi = 0; gi < 8; ++gi) {
            { const int row0 = ch * 128 + gi * 16 + 2 * wave; const int b = row0 >> 12;
              f32x4 v[2][4];
#pragma unroll
              for (int rr = 0; rr < 2; ++rr)
#pragma unroll
                  for (int q = 0; q < 4; ++q) v[rr][q] = *((const f32x4*)(a.out + (size_t)(row0 + rr) * 1024) + lane + 64 * q);
              const float* mb = MOD + (size_t)(l * 8 + b) * 6144 + 3072;
#pragma unroll
              for (int rr = 0; rr < 2; ++rr) { float ss = 0.f;
#pragma unroll
                  for (int q = 0; q < 4; ++q) ss += (v[rr][q][0] * v[rr][q][0] + v[rr][q][1] * v[rr][q][1]) + (v[rr][q][2] * v[rr][q][2] + v[rr][q][3] * v[rr][q][3]);
                  const float rstd = 1.0f / sqrtf(wave_sum(ss) * (1.0f / 1024.0f) + RMS_EPS);
#pragma unroll
                  for (int q = 0; q < 4; ++q) { const f32x4 g = *((const f32x4*)nw + lane + 64 * q), sh = *((const f32x4*)mb + lane + 64 * q), sc = *((const f32x4*)(mb + 1024) + lane + 64 * q);
                      const f32x4 h = v[rr][q] * rstd * g * (sc + 1.0f) + sh;
                      u32x2 hw; hw.x = cvt_pk_bf16(h[0], h[1]); hw.y = cvt_pk_bf16(h[2], h[3]);
                      u32x2 lw; lw.x = cvt_pk_bf16(h[0] - bf_lo(hw.x), h[1] - bf_hi(hw.x)); lw.y = cvt_pk_bf16(h[2] - bf_lo(hw.y), h[3] - bf_hi(hw.y));
                      *((u32x2*)(H2 + (size_t)(row0 + rr) * 1024) + lane + 64 * q) = hw;
                      *(LAS u32x2*)(HH + (2 * wave + rr) * RP + (4 * lane + 256 * q) * 2) = hw; *(LAS u32x2*)(HL + (2 * wave + rr) * RP + (4 * lane + 256 * q) * 2) = lw; } }
            }
            __syncthreads();
            { f32x4v acc[3]; acc[0] = (f32x4v){0.f, 0.f, 0.f, 0.f}; acc[1] = acc[0]; acc[2] = acc[0];
#pragma unroll
              for (int ks = 0; ks < 4; ++ks) { const int ko = (128 * wave + 32 * ks + 8 * fq) * 2;
                  const bf16x8 ah = *(const LAS bf16x8*)(HH + fr * RP + ko), al = *(const LAS bf16x8*)(HL + fr * RP + ko);
#pragma unroll
                  for (int ct = 0; ct < 3; ++ct) { acc[ct] = __builtin_amdgcn_mfma_f32_16x16x32_bf16(Wh[ks][ct], ah, acc[ct], 0, 0, 0);
                      acc[ct] = __builtin_amdgcn_mfma_f32_16x16x32_bf16(Wh[ks][ct], al, acc[ct], 0, 0, 0); acc[ct] = __builtin_amdgcn_mfma_f32_16x16x32_bf16(Wl[ks][ct], ah, acc[ct], 0, 0, 0); } }
#pragma unroll
              for (int ct = 0; ct < 3; ++ct) *(LAS f32x4v*)(PART + (wave * 16 + fr) * 48 + 16 * ct + 4 * fq) = acc[ct]; }
            __syncthreads();
            { const int row = C.tid >> 5, c = C.tid & 31;
              { float sacc = 0.f;
#pragma unroll
                for (int w = 0; w < 8; ++w) sacc += PART[(w * 16 + row) * 48 + c];
                LOGI[row * 48 + c] = sacc + (c < 4 ? bg[c] : be[c - 4]); }
              if (c < 4) { float sacc = 0.f;
#pragma unroll
                for (int w = 0; w < 8; ++w) sacc += PART[(w * 16 + row) * 48 + 32 + c];
                LOGI[row * 48 + 32 + c] = sacc + be[28 + c]; } }
            __syncthreads();
            if (wave == gi && lane < 16) { const LAS float* lg = LOGI + lane * 48;
                int grp = 0; float gmax = lg[0];
#pragma unroll
                for (int c = 1; c < 4; ++c) if (lg[c] > gmax) { gmax = lg[c]; grp = c; }
                float gs = 0.f;
#pragma unroll
                for (int c = 0; c < 4; ++c) gs += __builtin_amdgcn_exp2f((lg[c] - gmax) * LOG2E);
                const float pgrp = 1.0f / gs;
                float le[8];
#pragma unroll
                for (int e = 0; e < 8; ++e) le[e] = lg[4 + grp * 8 + e];
                int i0 = 0; float v0 = le[0];
#pragma unroll
                for (int e = 1; e < 8; ++e) if (le[e] > v0) { v0 = le[e]; i0 = e; }
                int i1 = -1; float v1 = -INFINITY;
#pragma unroll
                for (int e = 0; e < 8; ++e) if (e != i0 && le[e] > v1) { v1 = le[e]; i1 = e; }
                const float ex = __builtin_amdgcn_exp2f((v1 - v0) * LOG2E);
                my_e0 = grp * 8 + i0; my_e1 = grp * 8 + i1; my_w0 = pgrp / (1.0f + ex); my_w1 = pgrp * ex / (1.0f + ex); }
        }
        const int ea = bperm_i(C.lane >> 1, my_e0), eb = bperm_i(C.lane >> 1, my_e1);
        const int es = (C.lane < 32) ? ((C.lane & 1) ? eb : ea) : -1;
        int rank = 0, cnt = 0;
#pragma unroll
        for (int s2 = 0; s2 < 32; ++s2) { const int v = __builtin_amdgcn_readlane(es, s2); rank += (v == es && s2 < C.lane) ? 1 : 0; cnt += (v == C.lane) ? 1 : 0; }
        __syncthreads();
        if (C.lane < 32) wcnt[C.wave * 32 + C.lane] = cnt;
        __syncthreads();
        int lrank = rank;
        if (C.lane < 32) { for (int w = 0; w < C.wave; ++w) lrank += wcnt[w * 32 + es]; }
        if (C.wave == 0 && C.lane < 32) { int tot = 0;
#pragma unroll
            for (int w = 0; w < 8; ++w) tot += wcnt[w * 32 + C.lane];
            CNTBLK[ch * 32 + C.lane] = tot; }
        const int lr0 = bperm_i((2 * C.lane) & 63, lrank), lr1 = bperm_i((2 * C.lane + 1) & 63, lrank);
        if (C.lane < 16) { const int row = ch * 128 + C.wave * 16 + C.lane;
            u32x4 rec; rec.x = (unsigned)my_e0 | ((unsigned)my_e1 << 8); rec.y = (unsigned)lr0 | ((unsigned)lr1 << 16); rec.z = __float_as_uint(my_w0); rec.w = __float_as_uint(my_w1);
            *(u32x4*)(a.ws + WS_REC + (size_t)row * 16) = rec; }
    }
}
__device__ __forceinline__ void moe_scatter_phase(const Args& a, const Ctx& C) {
    LAS int* part_lt = (LAS int*)(C.lds);
    LAS int* part_all = part_lt + 512;
    LAS int* base = part_all + 512;
    LAS int* tot = base + 32;
    LAS int* pst = tot + 32;
    const int* CNTBLK = (const int*)(a.ws + WS_CNTBLK);
    int* TILEE = (int*)(a.ws + WS_TILEE);
    const bf16_t* H2 = (const bf16_t*)(a.ws + WS_H2); bf16_t* XS = (bf16_t*)(a.ws + WS_XS);
    for (int ch = C.vcu; ch < T / 128; ch += C.G) {
        __syncthreads();
        { const int e = C.tid & 31, p = C.tid >> 5; int slt = 0, sall = 0;
            for (int c = p; c < T / 128; c += 16) { const int v = CNTBLK[c * 32 + e]; sall += v; slt += (c < ch) ? v : 0; }
            part_lt[p * 32 + e] = slt; part_all[p * 32 + e] = sall; }
        __syncthreads();
        if (C.tid < 32) { int b = 0, t2 = 0;
#pragma unroll
            for (int p = 0; p < 16; ++p) { b += part_lt[p * 32 + C.tid]; t2 += part_all[p * 32 + C.tid]; }
            base[C.tid] = b; tot[C.tid] = t2; }
        __syncthreads();
        if (C.tid < 32) { int ps = 0; for (int e = 0; e < C.tid; ++e) ps += (tot[e] + 255) & ~255; pst[C.tid] = ps;
            if (ch == 0) { const int nt = (tot[C.tid] + 255) >> 8; const int t0 = ps >> 8; for (int m = 0; m < nt; ++m) TILEE[16 + t0 + m] = C.tid; if (C.tid == 31) TILEE[0] = t0 + nt; } }
        __syncthreads();
        int d0 = 0, d1 = 0;
        if (C.lane < 16) { const int row = ch * 128 + C.wave * 16 + C.lane;
            const u32x4 rec = *(const u32x4*)(a.ws + WS_REC + (size_t)row * 16);
            const int e0 = rec.x & 255, e1 = (rec.x >> 8) & 255;
            d0 = pst[e0] + base[e0] + (int)(rec.y & 0xffffu); d1 = pst[e1] + base[e1] + (int)(rec.y >> 16);
            u32x4 o; o.x = (unsigned)d0; o.y = (unsigned)d1; o.z = rec.z; o.w = rec.w;
            *(u32x4*)(a.ws + WS_DEST + (size_t)row * 16) = o; }
        for (int j = 0; j < 16; ++j) { const int row = ch * 128 + C.wave * 16 + j;
            const int t0 = __builtin_amdgcn_readlane(d0, j), t1 = __builtin_amdgcn_readlane(d1, j);
            const u32x4* src = (const u32x4*)(H2 + (size_t)row * 1024) + C.lane;
            const u32x4 va = src[0], vb = src[64];
            u32x4* o0 = (u32x4*)(XS + (size_t)t0 * 1024) + C.lane; u32x4* o1 = (u32x4*)(XS + (size_t)t1 * 1024) + C.lane;
            o0[0] = va; o0[64] = vb; o1[0] = va; o1[64] = vb; }
    }
}
struct MoeOrder {
    int G, c, nu; int ex[8]; const char* A; const char* B; size_t tA, tB, eB;
    __device__ __forceinline__ bool next(int i, pg8::Unit& u) const {
        const int L = i * G + c; if (i >= 8 || L >= nu) return false;
        const int e = i == 0 ? ex[0] : i == 1 ? ex[1] : i == 2 ? ex[2] : i == 3 ? ex[3] : i == 4 ? ex[4] : i == 5 ? ex[5] : i == 6 ? ex[6] : ex[7];
        u.pm = L >> 2; u.pn = L & 3; u.A = A + (size_t)u.pm * tA; u.B = B + (size_t)e * eB + (size_t)u.pn * tB; return true;
    }
};

__device__ __forceinline__ void dil_unit(const Args& a, const Ctx& C, int du) {
    using namespace att;
    LAS unsigned char* lds = C.lds;
    const int x = du & 15; int r = du >> 4; const int h = r & 3; r >>= 2; const int grp = r % 3, b = r / 3;
    const int dsh = 2 * grp, d = 1 << dsh; const int nub = 16 >> dsh; const int res = x / nub, ub = x % nub;
    const int wid = C.wave, lane = C.lane, r32 = lane & 31, hi = lane >> 5;
    LAS float* lut = (LAS float*)(lds + L_LUT);
    LAS unsigned char* tl = lds + L_SEL + 768;
    __syncthreads();
    for (int e = C.tid; e < 704; e += NTHR) { const int m = 384 - e; float v = -INFINITY;
        if (m >= 0 && m <= 128) { int di = m << dsh; di = di > 4095 ? 4095 : di; v = a.rel_bias[(int)lds[L_BKT + di] * 20 + 8 + grp * 4 + h] * LOG2E; }
        lut[e] = v; }
    if (C.tid < 6) { const int kt = 4 * ub - 2 + C.tid; tl[C.tid] = (unsigned char)(kt < 0 ? 0x80 : kt); }
    const bf16_t* QKV = (const bf16_t*)(a.ws + WS_A);
    const int u = 256 * ub + 32 * wid + r32; const size_t tokq = (size_t)b * SEQ + (size_t)u * d + res;
    const bf16_t* qp = QKV + tokq * LDQ + 1280 + grp * 256 + h * 64;
    bf16x8 qr[4];
#pragma unroll
    for (int d0 = 0; d0 < 4; ++d0) qr[d0] = *(const bf16x8*)(qp + d0 * 16 + hi * 8);
    __syncthreads();
    StreamP S; S.Kb = QKV + ((size_t)b * SEQ + res) * LDQ + 1280 + 768 + grp * 256 + h * 64; S.Vb = S.Kb + 768; S.pitch = (long)d * LDQ;
    S.NT = 6; S.tl = tl; S.lanesel = ~0ull; S.uq = u; S.lut = lut; S.xtop = 384; S.dclamp = 1 << 30;
    float m = 0.f, l = 0.f; f32x16 o[2];
    attn_stream<8>(lds, wid, lane, qr, S, m, l, o);
    l = xhalf_sum(l);
    LAS float* wsf = (LAS float*)(lds + L_WSF) + wid * 64;
    if (hi == 0) { wsf[r32] = l > 0.f ? 1.0f / l : 0.f; ((float*)(a.ws + WS_LSE))[((size_t)grp * T + tokq) * 4 + h] = m + __builtin_amdgcn_logf(l); }
    LDS_WAIT();
#pragma unroll
    for (int rr = 0; rr < 16; ++rr) { const float f = wsf[crow(rr, hi)]; o[0][rr] *= f; o[1][rr] *= f; }
    stage_rows(lds, wid, lane, o);
    bf16_t* ODP = (bf16_t*)(a.ws + WS_ODP) + (size_t)grp * T * 256;
    const LAS bf16_t* stg = (const LAS bf16_t*)(lds + L_OTA) + wid * 2048;
#pragma unroll
    for (int i = 0; i < 4; ++i) { const int row = i * 8 + (lane >> 3), chn = lane & 7; const u32x4 v = *(const LAS u32x4*)(stg + row * 64 + chn * 8);
        const size_t tok = (size_t)b * SEQ + (size_t)(256 * ub + 32 * wid + row) * d + res;
        *(u32x4*)(ODP + tok * 256 + h * 64 + chn * 8) = v; }
}
__device__ __forceinline__ void dil_combine(const Args& a, const Ctx& C) {
    const float* LSE = (const float*)(a.ws + WS_LSE); const bf16_t* ODP = (const bf16_t*)(a.ws + WS_ODP); bf16_t* ODIL = (bf16_t*)(a.ws + WS_ODIL);
    const int gt = C.vcu * NTHR + C.tid, NT = C.G * NTHR;
    for (int idx = gt; idx < T * 32; idx += NT) {
        const int tok = idx >> 5, h = (idx >> 3) & 3, chn = idx & 7;
        const float l0 = LSE[((size_t)0 * T + tok) * 4 + h], l1 = LSE[((size_t)1 * T + tok) * 4 + h], l2 = LSE[((size_t)2 * T + tok) * 4 + h];
        const float mx = __builtin_fmaxf(l0, __builtin_fmaxf(l1, l2));
        float w0 = __builtin_amdgcn_exp2f(l0 - mx), w1 = __builtin_amdgcn_exp2f(l1 - mx), w2 = __builtin_amdgcn_exp2f(l2 - mx);
        const float inv = 1.0f / (w0 + w1 + w2); w0 *= inv; w1 *= inv; w2 *= inv;
        const size_t off = (size_t)tok * 256 + h * 64 + chn * 8;
        const u32x4 a0 = *(const u32x4*)(ODP + off), a1 = *(const u32x4*)(ODP + (size_t)T * 256 + off), a2 = *(const u32x4*)(ODP + (size_t)2 * T * 256 + off);
        u32x4 o;
        o.x = cvt_pk_bf16(w0 * bf_lo(a0.x) + w1 * bf_lo(a1.x) + w2 * bf_lo(a2.x), w0 * bf_hi(a0.x) + w1 * bf_hi(a1.x) + w2 * bf_hi(a2.x));
        o.y = cvt_pk_bf16(w0 * bf_lo(a0.y) + w1 * bf_lo(a1.y) + w2 * bf_lo(a2.y), w0 * bf_hi(a0.y) + w1 * bf_hi(a1.y) + w2 * bf_hi(a2.y));
        o.z = cvt_pk_bf16(w0 * bf_lo(a0.z) + w1 * bf_lo(a1.z) + w2 * bf_lo(a2.z), w0 * bf_hi(a0.z) + w1 * bf_hi(a1.z) + w2 * bf_hi(a2.z));
        o.w = cvt_pk_bf16(w0 * bf_lo(a0.w) + w1 * bf_lo(a1.w) + w2 * bf_lo(a2.w), w0 * bf_hi(a0.w) + w1 * bf_hi(a1.w) + w2 * bf_hi(a2.w));
        if (ABL == 4) o = (u32x4){0u, 0u, 0u, 0u};
        *(u32x4*)(ODIL + off) = o;
    }
}
template <bool INIT>
__device__ __forceinline__ void ota_update(LAS bf16_t* ota  , const LAS float* frow, int hi, const f32x16 (&o)[2]) {
#pragma unroll
    for (int r = 0; r < 16; ++r) { const int row = crow(r, hi); const float f = frow[row];
        float v0 = f * o[0][r], v1 = f * o[1][r];
        if (!INIT) { v0 += __uint_as_float((unsigned)ota[row * 64] << 16); v1 += __uint_as_float((unsigned)ota[row * 64 + 32] << 16); }
        ota[row * 64] = (bf16_t)(cvt_pk_bf16(v0, 0.f) & 0xffffu); ota[row * 64 + 32] = (bf16_t)(cvt_pk_bf16(v1, 0.f) & 0xffffu); }
}
#define NSA_SECT() const int lane = lane_id_fresh(); const int tid = wid * 64 + lane; const int r32 = lane & 31, hi = lane >> 5; (void)tid; (void)r32; (void)hi
__device__ __forceinline__ void nsa_unit(const Args& a, const Ctx& C, int b, int hk, int i) {
    using namespace att;
    LAS unsigned char* lds = C.lds;
    const int wid = C.wave; const int g = wid >> 1;
    const bf16_t* QKV = (const bf16_t*)(a.ws + WS_A);
    bf16x8 qr[4];
    f32x16 o[2];
    __syncthreads();
    { NSA_SECT();
        const int tq = (wid & 1) * 32 + r32, t = 64 * i + tq; const size_t tok = (size_t)b * SEQ + t;
        LAS float* imp = (LAS float*)(lds + L_IMP); LAS float* gsh = (LAS float*)(lds + L_GSH) + wid * 96; LAS unsigned* selw = (LAS unsigned*)(lds + L_SEL);
        for (int e = tid; e < 64 * 64; e += NTHR) imp[e] = 0.f;
        if (tid < 2) selw[128 + tid] = 0u;
        if (hi == 0) { const float* gn = (const float*)(a.ws + WS_GN) + tok * 32 + hk * 4 + g;
            gsh[r32] = (ABL == 1) ? 0.f : gn[0]; gsh[32 + r32] = (ABL == 2) ? 0.f : gn[8]; gsh[64 + r32] = (ABL == 3) ? 0.f : gn[16]; }
        const bf16_t* qp = QKV + tok * LDQ + hk * 256 + g * 64;
#pragma unroll
        for (int d0 = 0; d0 < 4; ++d0) qr[d0] = *(const bf16x8*)(qp + d0 * 16 + hi * 8);
        __syncthreads();
        const bf16_t* KC = (const bf16_t*)(a.ws + WS_KC);
        cmp_branch(lds, wid, lane, qr, KC + (size_t)((0 * 8 + b) * 2 + hk) * 256 * 64, KC + (size_t)((1 * 8 + b) * 2 + hk) * 256 * 64, (4 * i + 2) / 64 + 1, t, o);
        ota_update<true>((LAS bf16_t*)(lds + L_OTA) + wid * 2048 + r32, gsh, hi, o);
    }
    __syncthreads();
    { NSA_SECT();
        LAS float* impP = (LAS float*)(lds + L_IMP); LAS unsigned* selw = (LAS unsigned*)(lds + L_SEL);
        const int q = tid >> 3, part = tid & 7;
        const int ncand = i - 2 > 0 ? i - 2 : 0; const int nforced = i + 1 < 3 ? i + 1 : 3; const int krem = 16 - nforced;
        unsigned bits = 0u;
        if (ncand > krem && ABL != 5) {
            float vn[8]; int cn[8];
#pragma unroll
            for (int e = 0; e < 8; ++e) { vn[e] = impP[q * 64 + part * 8 + e]; cn[e] = 0; }
            for (int mm = 1; mm <= i - 2; ++mm) { const float xv = impP[q * 64 + mm];
#pragma unroll
                for (int e = 0; e < 8; ++e) { const int n = part * 8 + e; cn[e] += (xv > vn[e] || (xv == vn[e] && mm < n)) ? 1 : 0; } }
#pragma unroll
            for (int e = 0; e < 8; ++e) { const int n = part * 8 + e; if (n >= 1 && n <= i - 2 && cn[e] < krem) bits |= 1u << e; }
        } else {
#pragma unroll
            for (int e = 0; e < 8; ++e) { const int n = part * 8 + e; if (n >= 1 && n <= i - 2) bits |= 1u << e; }
        }
#pragma unroll
        for (int e = 0; e < 8; ++e) { const int n = part * 8 + e; if (n == 0 || n == i || n == i - 1) bits |= 1u << e; }
        unsigned lo = part < 4 ? bits << (8 * part) : 0u, hi2 = part >= 4 ? bits << (8 * (part - 4)) : 0u;
        lo |= swz_xor_u<1>(lo); hi2 |= swz_xor_u<1>(hi2); lo |= swz_xor_u<2>(lo); hi2 |= swz_xor_u<2>(hi2); lo |= swz_xor_u<4>(lo); hi2 |= swz_xor_u<4>(hi2);
        if (part == 0) { selw[2 * q] = lo; selw[2 * q + 1] = hi2; atomicOr((unsigned*)&selw[128], lo); atomicOr((unsigned*)&selw[129], hi2); }
    }
    __syncthreads();
    int NTS, NTW;
    { NSA_SECT();
        LAS unsigned* selw = (LAS unsigned*)(lds + L_SEL);
        LAS unsigned char* tls = lds + L_SEL + 768; LAS unsigned char* tlw = lds + L_SEL + 848;
        const unsigned long long uni = ((unsigned long long)(unsigned)__builtin_amdgcn_readfirstlane((int)selw[129]) << 32) | (unsigned)__builtin_amdgcn_readfirstlane((int)selw[128]);
        const int nsel = __builtin_popcountll(uni); const int nts = (nsel + 1) & ~1; NTS = nts < 4 ? 4 : nts;
        const int jlo = i - 8 < 0 ? 0 : i - 8; const int nwin = i - jlo + 1; const int ntw = (nwin + 1) & ~1; NTW = ntw < 4 ? 4 : ntw;
        if (tid < 64) { if ((uni >> tid) & 1ull) tls[__builtin_popcountll(uni & ((1ull << tid) - 1ull))] = (unsigned char)tid; }
        else if (tid < 72) { const int k = nsel + (tid - 64); if (k < NTS) tls[k] = 0x80; }
        else if (tid < 88) { const int k = tid - 72; if (k < NTW) tlw[k] = (unsigned char)(k < nwin ? jlo + k : 0x80); }
    }
    __syncthreads();
#pragma clang loop unroll(disable)
    for (int br = 0; br < 2; ++br) {
        float m = 0.f, l = 0.f;
        { NSA_SECT();
            const int tq = (wid & 1) * 32 + r32, t = 64 * i + tq;
            LAS unsigned* selw = (LAS unsigned*)(lds + L_SEL); LAS float* lut = (LAS float*)(lds + L_LUT);
            StreamP S; S.Kb = QKV + (size_t)b * SEQ * LDQ + 512 + 256 + br * 256 + hk * 64; S.Vb = S.Kb + 128; S.pitch = LDQ;
            S.NT = br ? NTW : NTS; S.tl = lds + L_SEL + (br ? 848 : 768); S.uq = t;
            S.lanesel = br ? ~0ull : (((unsigned long long)selw[2 * tq + 1] << 32) | selw[2 * tq]);
            S.lut = br ? lut + 7168 + g * 768 : lut + g * 1792; S.xtop = br ? 640 : 1636; S.dclamp = br ? (1 << 30) : 1636;
            attn_stream<8>(lds, wid, lane, qr, S, m, l, o);
        }
        { NSA_SECT();
            LAS float* gsh = (LAS float*)(lds + L_GSH) + wid * 96; LAS float* wsf = (LAS float*)(lds + L_WSF) + wid * 64;
            l = xhalf_sum(l);
            LDS_WAIT();
            if (hi == 0) wsf[r32] = (l > 0.f ? 1.0f / l : 0.f) * gsh[32 + br * 32 + r32];
            LDS_WAIT();
            ota_update<false>((LAS bf16_t*)(lds + L_OTA) + wid * 2048 + r32, wsf, hi, o);
        }
    }
    { NSA_SECT();
        LDS_WAIT();
        bf16_t* ONSA = (bf16_t*)(a.ws + WS_ONSA);
        const LAS bf16_t* stg = (const LAS bf16_t*)(lds + L_OTA) + wid * 2048;
#pragma unroll
        for (int k = 0; k < 4; ++k) { const int row = k * 8 + (lane >> 3), chn = lane & 7; const u32x4 v = *(const LAS u32x4*)(stg + row * 64 + chn * 8);
            const size_t tk = (size_t)b * SEQ + 64 * i + (wid & 1) * 32 + row;
            *(u32x4*)(ONSA + tk * 512 + hk * 256 + g * 64 + chn * 8) = v; }
    }
}
__device__ __forceinline__ void build_bkt(const Ctx& C) {
    LAS unsigned char* bkt = C.lds + att::L_BKT; LAS unsigned char* bkc = C.lds + att::L_BKC;
    for (int d = C.tid; d < 4096; d += NTHR) bkt[d] = (unsigned char)att::bucket_of(d);
    for (int x = C.tid; x < 8704; x += NTHR) { const int dist = 4095 - x; bkc[x] = (unsigned char)(dist < 0 ? 128 : 4 * att::bucket_of(dist)); }
    __syncthreads();
}
__device__ __forceinline__ void build_nsa_tables(const Args& a, const Ctx& C, int hk) {
    using namespace att;
    LAS float* tbh = (LAS float*)(C.lds + L_TBH); LAS float* lut = (LAS float*)(C.lds + L_LUT);
    __syncthreads();
    if (C.tid < 144) { const int gg = C.tid / 36, bk = C.tid % 36; tbh[C.tid] = bk < 32 ? a.rel_bias[bk * 20 + hk * 4 + gg] * LOG2E : -INFINITY; }
    __syncthreads();
    for (int e = C.tid; e < 4 * 1792; e += NTHR) { const int gg = e / 1792, xx = e % 1792; const int dist = 1636 - xx;
        lut[e] = dist < 0 ? -INFINITY : tbh[gg * 36 + (int)C.lds[L_BKT + dist]]; }
    for (int e = C.tid; e < 4 * 768; e += NTHR) { const int gg = e / 768, xx = e % 768; const int dist = 640 - xx;
        lut[7168 + e] = (dist < 0 || dist > 512) ? -INFINITY : tbh[gg * 36 + (int)C.lds[L_BKT + dist]]; }
    __syncthreads();
}

typedef const Args __attribute__((address_space(4)))* CArgsP;
__device__ __forceinline__ Args load_args() {
#if defined(__HIP_DEVICE_COMPILE__)
    CArgsP p = (CArgsP)__builtin_amdgcn_kernarg_segment_ptr(); asm volatile("" : "+s"(p)); Args a;
    a.x = p->x; a.c = p->c; a.rel_bias = p->rel_bias; a.ada_w = p->ada_w; a.ada_b = p->ada_b; a.norm1 = p->norm1; a.norm2 = p->norm2; a.w_in = p->w_in;
    a.cmp_pos = p->cmp_pos; a.cmp_w1 = p->cmp_w1; a.cmp_w2 = p->cmp_w2; a.w_up_nsa = p->w_up_nsa; a.w_up_dil = p->w_up_dil; a.w_o = p->w_o;
    a.router_wg = p->router_wg; a.router_bg = p->router_bg; a.router_we = p->router_we; a.router_be = p->router_be; a.exp_w1 = p->exp_w1; a.exp_w3 = p->exp_w3; a.exp_w2 = p->exp_w2; a.norm_f = p->norm_f;
    a.out = p->out; a.ws = p->ws; a.ph_lo = p->ph_lo; a.ph_hi = p->ph_hi; a.use_bar = p->use_bar; a.pad = 0;
    return a;
#else
    return Args{};
#endif
}
#define LOADA() const Args a = load_args()
__global__ void __launch_bounds__(NTHR, 2) fwd_kernel(Args a_) {
    extern __shared__ __attribute__((aligned(16))) unsigned char lds_raw[];
    LAS unsigned char* const lds_base = (LAS unsigned char*)lds_raw;
    const int wave0_ = __builtin_amdgcn_readfirstlane((int)threadIdx.x >> 6);
#define FRESH() Ctx C; { int w_ = wave0_; asm volatile("" : "+s"(w_)); int t_ = lane_id_fresh(); asm volatile("" : "+v"(t_)); t_ += w_ * 64; int g_ = gridDim.x, b_ = blockIdx.x; asm volatile("" : "+s"(g_), "+s"(b_)); \
        C.lds = lds_base; C.tid = t_; C.lane = t_ & 63; C.wave = w_; C.G = g_; C.bx = b_; C.vcu = (g_ % 8 == 0) ? (b_ % 8) * (g_ / 8) + b_ / 8 : b_; }
    volatile LAS unsigned* MISC = (volatile LAS unsigned*)(lds_base + LDS_MISC);
    if (threadIdx.x < 64) MISC[threadIdx.x] = 0u;
    __syncthreads();
    unsigned* ctl = (unsigned*)(a_.ws + WS_CTL);
    XcdBarrier bar; bar.bar = ctl + CW_BAR; bar.x = 0; bar.st = nullptr;
    if (a_.use_bar) bar = xcd_barrier_post(ctl + CW_BAR, MISC + 8);
    const int lo = a_.ph_lo, hi = a_.ph_hi;
#ifndef PH_MASK
#define PH_MASK 0xFFFFFFFFu
#endif
#define IN(k) (((PH_MASK >> ((k) == 0 ? 10 : (k) == 21 ? 11 : (((k) - 1) % 10))) & 1u) && lo <= (k) && (k) < hi)
#define SEAM(k) do { if (IN(k) && IN((k) + 1)) { XcdBarrier b2_ = bar; asm volatile("" : "+s"(b2_.bar)); int w2_ = wave0_; asm volatile("" : "+s"(w2_)); xcd_barrier(b2_, w2_ == 0 && lane_id_fresh() == 0); } } while (0)
    if (IN(0)) REPEAT(10) { __syncthreads(); FRESH(); LOADA(); prologue_vectors(a, C); conv_small(a, C); conv_experts(a, C, 0); }
    SEAM(0);
    _Pragma("unroll") for (int l = 0; l < 2; ++l) {
        const int pb = 1 + 10 * l;
        if (IN(pb + 0)) REPEAT(0) { FRESH(); LOADA(); norm1_phase(a, C, l); if (l == 1) conv_experts(a, C, 1); }
        SEAM(pb + 0);
        if (IN(pb + 1)) REPEAT(1) { FRESH(); LOADA(); unsigned char* ws = a.ws;
            pg8::Gemm g{2048u, 2048u, 128u, 1024}; pg8::DenseOrder S; S.init(T, NIN, C.G, C.bx, ws + WS_H, 2048u, ws + WS_WINT + (size_t)l * NIN * DM * 2, 2048u);
            EpiInProj E{(bf16_t*)(ws + WS_A), (bf16_t*)(ws + WS_MG), (float*)(ws + WS_GN)};
            pg8::gemm_phase<EpiInProj, pg8::DenseOrder, true>(C.lds, C.tid, g, S, E);
        }
        SEAM(pb + 1);
        if (IN(pb + 2)) REPEAT(2) { FRESH(); LOADA(); unsigned char* ws = a.ws;
            struct CmpOrder { int c; const char* A; const char* B;
                __device__ __forceinline__ bool next(int i, pg8::Unit& u) const { if (i > 0 || c >= 32) return false; const int kv = c >> 4, b = (c >> 1) & 7, hk = c & 1;
                    u.pm = c; u.pn = 0; u.A = A + ((size_t)b * SEQ * LDQ + 512 + kv * 128 + hk * 64) * 2; u.B = B + (size_t)kv * 256 * 2048 * 2; return true; } };
            pg8::Gemm g{(unsigned)(16 * LDQ * 2), 4096u, (unsigned)(LDQ * 2), 2048};
            CmpOrder S{C.vcu, (const char*)(ws + WS_A), (const char*)(ws + WS_CW1T + (size_t)l * 2 * 256 * 2048 * 2)};
            EpiCmp E{(bf16_t*)(ws + WS_HID), (const float*)(ws + WS_CB1) + l * 512, (const bf16_t*)(ws + WS_CW2T) + (size_t)l * 2 * 64 * 256, (bf16_t*)(ws + WS_KC)};
            pg8::gemm_phase<EpiCmp, CmpOrder, false>(C.lds, C.tid, g, S, E);
            __syncthreads();
            build_bkt(C);
            for (;;) { __syncthreads();
                if (C.tid == 0) *(volatile LAS int*)(C.lds + LDS_MISC + 512) = (int)__hip_atomic_fetch_add((unsigned*)(ws + WS_CTL) + CW_Q + l, 1u, __ATOMIC_RELAXED, __HIP_MEMORY_SCOPE_AGENT);
                __syncthreads();
                const int du = __builtin_amdgcn_readfirstlane(*(volatile LAS int*)(C.lds + LDS_MISC + 512));
                if (du >= 1536) break;
                dil_unit(a, C, du); }
        }
        SEAM(pb + 2);
        if (IN(pb + 3)) REPEAT(3) { FRESH(); LOADA();
            dil_combine(a, C);
            build_bkt(C);
            int cur_hk = -1;
            for (int v = C.vcu; v < 256; v += C.G) { const int b = v >> 5, hk = (v >> 4) & 1, s = v & 15;
                if (hk != cur_hk) { build_nsa_tables(a, C, hk); cur_hk = hk; }
                for (int k = 0; k < 4; ++k) { const int qi = (k == 0) ? s : (k == 1) ? 31 - s : (k == 2) ? 32 + s : 63 - s; nsa_unit(a, C, b, hk, qi); } }
            __syncthreads();
        }
        SEAM(pb + 3);
        if (IN(pb + 4)) REPEAT(4) { FRESH(); LOADA(); unsigned char* ws = a.ws;
            { pg8::Gemm g{1024u, 1024u, 128u, 512}; pg8::DenseOrder S; S.init(T, 1024, C.G, C.bx, ws + WS_ONSA, 1024u, ws + WS_WUNT + (size_t)l * 1024 * 512 * 2, 1024u);
              EpiUp<0> E{(bf16_t*)(ws + WS_MERGED), (const bf16_t*)(ws + WS_MG)};
              pg8::gemm_phase<EpiUp<0>, pg8::DenseOrder, true>(C.lds, C.tid, g, S, E); }
            VM_WAIT(); __syncthreads();
            { pg8::Gemm g{512u, 512u, 128u, 256}; pg8::DenseOrder S; S.init(T, 1024, C.G, C.bx, ws + WS_ODIL, 512u, ws + WS_WUDT + (size_t)l * 1024 * 256 * 2, 512u);
              EpiUp<1> E{(bf16_t*)(ws + WS_MERGED), (const bf16_t*)(ws + WS_MG)};
              pg8::gemm_phase<EpiUp<1>, pg8::DenseOrder, true>(C.lds, C.tid, g, S, E); }
        }
        SEAM(pb + 4);
        if (IN(pb + 5)) REPEAT(5) { FRESH(); LOADA(); unsigned char* ws = a.ws;
            pg8::Gemm g{2048u, 2048u, 128u, 1024}; pg8::DenseOrder S; S.init(T, 1024, C.G, C.bx, ws + WS_MERGED, 2048u, ws + WS_WOT + (size_t)l * 1024 * 1024 * 2, 2048u);
            EpiOut E{l == 0 ? a.x : (const float*)a.out, a.out, (const float*)(ws + WS_MOD) + (size_t)l * 8 * 6144 + 2048};
            pg8::gemm_phase<EpiOut, pg8::DenseOrder, true>(C.lds, C.tid, g, S, E);
        }
        SEAM(pb + 5);
        if (IN(pb + 6)) REPEAT(6) { FRESH(); LOADA(); norm2_router_phase(a, C, l); }
        SEAM(pb + 6);
        if (IN(pb + 7)) REPEAT(7) { FRESH(); LOADA(); moe_scatter_phase(a, C); }
        SEAM(pb + 7);
        if (IN(pb + 8)) REPEAT(8) { FRESH(); LOADA(); unsigned char* ws = a.ws;
            const int* TILEE = (const int*)(ws + WS_TILEE); const int ntl = TILEE[0];
            MoeOrder S; S.G = C.G; S.c = C.vcu; S.nu = ntl * 4; S.A = (const char*)(ws + WS_XS); S.B = (const char*)(ws + WS_E13T); S.tA = (size_t)256 * 2048; S.tB = (size_t)256 * 2048; S.eB = (size_t)1024 * 2048;
#pragma unroll
            for (int i = 0; i < 8; ++i) { const int L = i * C.G + C.vcu; S.ex[i] = (L < S.nu) ? TILEE[16 + (L >> 2)] : 0; }
            pg8::Gemm g{2048u, 2048u, 128u, 1024};
            EpiMoe1 E{(bf16_t*)(ws + WS_ACT)};
            pg8::gemm_phase<EpiMoe1, MoeOrder, true>(C.lds, C.tid, g, S, E);
        }
        SEAM(pb + 8);
        if (IN(pb + 9)) REPEAT(9) { FRESH(); LOADA(); unsigned char* ws = a.ws;
            const int* TILEE = (const int*)(ws + WS_TILEE); const int ntl = TILEE[0];
            MoeOrder S; S.G = C.G; S.c = C.vcu; S.nu = ntl * 4; S.A = (const char*)(ws + WS_ACT); S.B = (const char*)(ws + WS_E2T); S.tA = (size_t)256 * 1024; S.tB = (size_t)256 * 1024; S.eB = (size_t)1024 * 1024;
#pragma unroll
            for (int i = 0; i < 8; ++i) { const int L = i * C.G + C.vcu; S.ex[i] = (L < S.nu) ? TILEE[16 + (L >> 2)] : 0; }
            pg8::Gemm g{1024u, 1024u, 128u, 512};
            EpiPlain E{(bf16_t*)(ws + WS_XS), 1024};
            pg8::gemm_phase<EpiPlain, MoeOrder, true>(C.lds, C.tid, g, S, E);
        }
        SEAM(pb + 9);
    }
    if (IN(21)) { FRESH(); LOADA(); final_phase(a, C); }
#undef IN
#undef SEAM
}

#ifndef ONE_LAUNCH
#define ONE_LAUNCH 1
#endif
extern "C" void kernel_launch(void* const* d_in, const int* in_sizes, int n_in, void* d_out, int out_size, void* d_ws, size_t ws_size, hipStream_t stream) {
    static int grid = 0;
    if (grid == 0) {
        if (n_in != 22 || out_size != T * DM || ws_size < WS_END) { fprintf(stderr, "kernel_launch: unexpected problem (n_in %d out %d ws %zu)\n", n_in, out_size, ws_size); grid = -1; return; }
        int dev = 0, cus = 0;
        if (hipGetDevice(&dev) != hipSuccess || hipDeviceGetAttribute(&cus, hipDeviceAttributeMultiprocessorCount, dev) != hipSuccess) { grid = -1; return; }
        if (hipFuncSetAttribute((const void*)fwd_kernel, hipFuncAttributeMaxDynamicSharedMemorySize, LDS_BYTES) != hipSuccess) { fprintf(stderr, "kernel_launch: hipFuncSetAttribute failed\n"); grid = -1; return; }
        int per_cu = 0;
        if (hipOccupancyMaxActiveBlocksPerMultiprocessor(&per_cu, (const void*)fwd_kernel, NTHR, LDS_BYTES) != hipSuccess || per_cu < 1) { fprintf(stderr, "kernel_launch: occupancy query reports %d\n", per_cu); }
        (void)hipGetLastError();
        grid = cus;
    }
    if (grid < 0) return;
    (void)hipMemsetAsync((char*)d_ws + WS_CTL, 0, CTL_ZERO_BYTES, stream);
    Args a{};
    a.x = (const float*)d_in[0]; a.c = (const float*)d_in[1]; a.rel_bias = (const float*)d_in[2]; a.ada_w = (const float*)d_in[3]; a.ada_b = (const float*)d_in[4];
    a.norm1 = (const float*)d_in[5]; a.norm2 = (const float*)d_in[6]; a.w_in = (const float*)d_in[7]; a.cmp_pos = (const float*)d_in[8]; a.cmp_w1 = (const float*)d_in[9];
    a.cmp_w2 = (const float*)d_in[10]; a.w_up_nsa = (const float*)d_in[11]; a.w_up_dil = (const float*)d_in[12]; a.w_o = (const float*)d_in[13];
    a.router_wg = (const float*)d_in[14]; a.router_bg = (const float*)d_in[15]; a.router_we = (const float*)d_in[16]; a.router_be = (const float*)d_in[17];
    a.exp_w1 = (const float*)d_in[18]; a.exp_w3 = (const float*)d_in[19]; a.exp_w2 = (const float*)d_in[20]; a.norm_f = (const float*)d_in[21];
    a.out = (float*)d_out; a.ws = (unsigned char*)d_ws; a.pad = 0;
#if ONE_LAUNCH
    a.ph_lo = 0; a.ph_hi = NPHASE; a.use_bar = 1;
    hipLaunchKernelGGL(fwd_kernel, dim3(grid), dim3(NTHR), LDS_BYTES, stream, a);
#else
    for (int p = 0; p < NPHASE; ++p) { a.ph_lo = p; a.ph_hi = p + 1; a.use_bar = 0;
        hipLaunchKernelGGL(fwd_kernel, dim3(grid), dim3(NTHR), LDS_BYTES, stream, a); }
#endif
}
```

```cpp
#include <hip/hip_runtime.h>
#include <cstdint>
#include <cstdio>

#define GAS __attribute__((address_space(1)))
#define LAS __attribute__((address_space(3)))
typedef unsigned short bf16_t;
typedef short bf16x8 __attribute__((ext_vector_type(8)));
typedef short s16x4 __attribute__((ext_vector_type(4)));
typedef float f32x4 __attribute__((ext_vector_type(4)));
typedef float f32x2 __attribute__((ext_vector_type(2)));
typedef float f32x16 __attribute__((ext_vector_type(16)));
typedef unsigned u32x4 __attribute__((ext_vector_type(4)));
typedef unsigned u32x2 __attribute__((ext_vector_type(2)));
typedef __bf16 bf16x2_t __attribute__((ext_vector_type(2)));

constexpr int NB = 8, SEQ = 4096, DM = 1024, T = NB * SEQ;
constexpr int LDQ = 3584;
constexpr int NIN = 5888;
constexpr int INW = 5656;
constexpr float LOG2E = 1.4426950408889634f;
constexpr float C2 = 0.125f * LOG2E;
constexpr int NWAVES = 8, NTHR = 512;
constexpr float RMS_EPS = 1e-6f;
constexpr int NPHASE = 22;
#ifndef ABL
#define ABL 0
#endif
#ifndef REP_MASK
#define REP_MASK 0u
#endif
#define REPEAT(k) _Pragma("clang loop unroll(disable)") for (int rep_ = 0; rep_ < (int)((REP_MASK >> (k)) & 1u) + 1; ++rep_)

constexpr size_t MiB = 1u << 20;
constexpr size_t WS_CTL = 0, CTL_ZERO_BYTES = MiB;
constexpr size_t WS_MOD = 1 * MiB;
constexpr size_t WS_CB1 = WS_MOD + 400 * 1024;
constexpr size_t WS_CW2T = WS_MOD + 512 * 1024;
constexpr size_t WS_CNTBLK = WS_MOD + 768 * 1024;
constexpr size_t WS_TILEE = WS_MOD + 832 * 1024;
constexpr size_t WS_WINT = 4 * MiB;
constexpr size_t WS_CW1T = 27 * MiB;
constexpr size_t WS_WUNT = 31 * MiB;
constexpr size_t WS_WUDT = 33 * MiB;
constexpr size_t WS_WOT = 34 * MiB;
constexpr size_t WS_E13T = 38 * MiB;
constexpr size_t WS_E2T = 102 * MiB;
constexpr size_t WS_A = 134 * MiB;
constexpr size_t WS_XS = WS_A;
constexpr size_t WS_ACT = WS_A + 144 * MiB;
constexpr size_t WS_MERGED = WS_A;
constexpr size_t WS_MG = 359 * MiB;
constexpr size_t WS_H2 = WS_MG;
constexpr size_t WS_REC = WS_MG + 64 * MiB;
constexpr size_t WS_DEST = WS_MG + 65 * MiB;
constexpr size_t WS_B = 487 * MiB;
constexpr size_t WS_H = WS_B;
constexpr size_t WS_ONSA = WS_B;
constexpr size_t WS_ODP = WS_B + 32 * MiB;
constexpr size_t WS_LSE = WS_B + 80 * MiB;
constexpr size_t WS_ODIL = WS_B + 82 * MiB;
constexpr size_t WS_GN = WS_B + 98 * MiB;
constexpr size_t WS_KC = WS_B + 102 * MiB;
constexpr size_t WS_HID = WS_B + 103 * MiB;
constexpr size_t WS_END = WS_B + 107 * MiB;

constexpr int CW_TMO = 0, CW_BAR = 4096, CW_Q = 8192;

constexpr int LDS_MISC = 158784;
constexpr int LDS_BYTES = 158784 + 2048;

__device__ __forceinline__ unsigned cvt_pk_bf16(float lo, float hi) { f32x2 v = {lo, hi}; bf16x2_t b = __builtin_convertvector(v, bf16x2_t); return __builtin_bit_cast(unsigned, b); }
__device__ __forceinline__ float bf_lo(unsigned w) { return __uint_as_float(w << 16); }
__device__ __forceinline__ float bf_hi(unsigned w) { return __uint_as_float(w & 0xffff0000u); }
__device__ __forceinline__ float sigmoidf_(float x) { return __builtin_amdgcn_rcpf(1.0f + __builtin_amdgcn_exp2f(-x * LOG2E)); }
__device__ __forceinline__ int lane_id_fresh() { unsigned ones = ~0u; asm volatile("" : "+s"(ones)); return (int)__builtin_amdgcn_mbcnt_hi(ones, __builtin_amdgcn_mbcnt_lo(ones, 0u)); }
template <int X> __device__ __forceinline__ float swz_xor_f(float v) { return __int_as_float(__builtin_amdgcn_ds_swizzle(__float_as_int(v), (X << 10) | 0x1f)); }
template <int X> __device__ __forceinline__ unsigned swz_xor_u(unsigned v) { return (unsigned)__builtin_amdgcn_ds_swizzle((int)v, (X << 10) | 0x1f); }
__device__ __forceinline__ float wave_sum(float v) {
    v += swz_xor_f<1>(v); v += swz_xor_f<2>(v); v += swz_xor_f<4>(v); v += swz_xor_f<8>(v); v += swz_xor_f<16>(v);
    auto rr = __builtin_amdgcn_permlane32_swap(__float_as_uint(v), __float_as_uint(v), false, false);
    return __uint_as_float(rr[0]) + __uint_as_float(rr[1]);
}
__device__ __forceinline__ int bperm_i(int srclane, int v) { return __builtin_amdgcn_ds_bpermute(srclane << 2, v); }
#define LDS_WAIT() asm volatile("s_waitcnt lgkmcnt(0)" ::: "memory")
#define VM_WAIT() asm volatile("s_waitcnt vmcnt(0)" ::: "memory")

#define XB_TMO      128
#define XB_XCNT(j)  (256  + 64 * (j))
#define XB_XSUB(j)  (1280 + 64 * (j))
#define XB_XGEN(j)  (2304 + 64 * (j))
#define XB_TOP      3328
#define XB_TOPGEN   3392
#define XCD_BAR_WORDS 3456
#define XB_SPIN_CAP (1u << 20)
__device__ __forceinline__ unsigned xb_ld(unsigned* p)              { return __hip_atomic_load(p, __ATOMIC_RELAXED, __HIP_MEMORY_SCOPE_AGENT); }
__device__ __forceinline__ unsigned xb_add(unsigned* p, unsigned v) { return __hip_atomic_fetch_add(p, v, __ATOMIC_RELAXED, __HIP_MEMORY_SCOPE_AGENT); }
__device__ __forceinline__ unsigned xb_xcc_id() { return (unsigned)__builtin_amdgcn_s_getreg((3 << 11) | 20) & 0xFu; }
#define XB_SPIN(cond, bar) do { unsigned _sp = 0; while (cond) { __builtin_amdgcn_s_sleep(1); \
    if ((++_sp & 255u) == 0u) { if (xb_ld(&(bar)[XB_TMO])) break; if (_sp > XB_SPIN_CAP) { atomicAdd(&(bar)[XB_TMO], 1u); break; } } } } while (0)
struct XcdBarrier { unsigned* bar; unsigned x; volatile LAS unsigned* st; };
__device__ __forceinline__ XcdBarrier xcd_barrier_post(unsigned* bar, volatile LAS unsigned* st) {
    XcdBarrier b; b.bar = bar; b.x = xb_xcc_id(); b.st = st;
    if (threadIdx.x == 0) (void)xb_add(&bar[XB_XCNT(b.x)], 1u);
    return b;
}
__device__ __forceinline__ void xcd_barrier_complete(unsigned* bar, unsigned x, unsigned& nloc, unsigned& nx) {
    const unsigned G = gridDim.x * gridDim.y * gridDim.z;
    unsigned sum, cnt, mine, sp = 0u;
    for (;;) {
        sum = 0u; cnt = 0u; mine = 0u;
#pragma unroll
        for (unsigned j = 0; j < 16; ++j) { const unsigned c = xb_ld(&bar[XB_XCNT(j)]); sum += c; cnt += (c > 0u) ? 1u : 0u; mine = (j == x) ? c : mine; }
        if (sum == G) break;
        __builtin_amdgcn_s_sleep(1);
        if ((++sp & 255u) == 0u) { if (xb_ld(&bar[XB_TMO])) break; if (sp > XB_SPIN_CAP) { atomicAdd(&bar[XB_TMO], 1u); break; } }
    }
    nloc = mine > 0u ? mine : 1u; nx = cnt > 0u ? cnt : 1u;
}
__device__ __forceinline__ void xcd_barrier(const XcdBarrier& b, const bool leader_thread) {
    asm volatile("s_waitcnt vmcnt(0)" ::: "memory");
    __syncthreads();
    if (leader_thread) {
        unsigned* bar = b.bar;
        __builtin_amdgcn_s_waitcnt(0);
        unsigned nloc = b.st[0], nx = b.st[1];
        if (nloc == 0u) { xcd_barrier_complete(bar, b.x, nloc, nx); b.st[0] = nloc; b.st[1] = nx; }
        const unsigned old = xb_add(&bar[XB_XSUB(b.x)], 1u);
        const unsigned gen = old / nloc;
        if (old + 1u == (gen + 1u) * nloc) {
            __builtin_amdgcn_fence(__ATOMIC_RELEASE, "agent");
            asm volatile("s_waitcnt vmcnt(0)" ::: "memory");
            const unsigned og = xb_add(&bar[XB_TOP], 1u);
            const unsigned tg = og / nx;
            if (og + 1u == (tg + 1u) * nx) xb_add(&bar[XB_TOPGEN], 1u);
            else XB_SPIN(xb_ld(&bar[XB_TOPGEN]) == tg, bar);
            __builtin_amdgcn_fence(__ATOMIC_ACQUIRE, "agent");
            xb_add(&bar[XB_XGEN(b.x)], 1u);
            asm volatile("s_waitcnt vmcnt(0)" ::: "memory");
        } else {
            XB_SPIN(xb_ld(&bar[XB_XGEN(b.x)]) == gen, bar);
            __builtin_amdgcn_fence(__ATOMIC_ACQUIRE, "agent");
            asm volatile("s_waitcnt vmcnt(0)" ::: "memory");
        }
    }
    __syncthreads();
}

namespace pg8 {
constexpr int BM = 256, BK = 64, HALF = 128, HTB = HALF * BK * 2, STAGE_BYTES = 8 * HTB;
__device__ __forceinline__ int lds_byte(int r, int c) { const int st = (r >> 4) * 2 + (c >> 5), rr = r & 15, cc = c & 31, ob = rr * 64 + cc * 2; return st * 1024 + (ob ^ (((ob >> 9) & 1) << 5)); }
__device__ __forceinline__ void stage_rc(int b, int& R, int& C) { const int st = b / 1024, sb = b % 1024, swz = sb ^ (((sb >> 9) & 1) << 5); R = (st >> 1) * 16 + swz / 64; C = (st & 1) * 32 + (swz % 64) / 2; }
__device__ __forceinline__ int perm32(int rho) { const int n = rho >> 4, i = rho & 15; return 8 * (i >> 2) + 4 * n + (i & 3); }

struct Unit { const char* A; const char* B; int pm, pn; const char* A2; const char* B2; };
struct Gemm { unsigned lda, ldb, kstepA; int K; unsigned lda2, ldb2; int K2; };

template <class Epi, class Sched, bool ALIGN_EPI, bool SEG2 = false>
__device__ __forceinline__ void gemm_phase(LAS unsigned char* lds, const int tid, const Gemm g, const Sched& S, const Epi& E) {
    const int wid = __builtin_amdgcn_readfirstlane(tid >> 6), lane = tid & 63, wr = wid >> 2, wc = wid & 3, fr = lane & 15, fq = lane >> 4;
    const int nt0 = g.K / BK; const int nt = nt0 + (SEG2 ? g.K2 / BK : 0);
    unsigned voffA[2], voffB[2], voffA2[2], voffB2[2];
#pragma unroll
    for (int i = 0; i < 2; ++i) { int R, C; stage_rc(tid * 16 + i * 8192, R, C); const int Rb = Epi::PERM ? ((R & ~31) + perm32(R & 31)) : R;
        voffA[i] = (unsigned)R * g.lda + (unsigned)C * 2u; voffB[i] = (unsigned)Rb * g.ldb + (unsigned)C * 2u;
        voffA2[i] = SEG2 ? (unsigned)R * g.lda2 + (unsigned)C * 2u : 0u; voffB2[i] = SEG2 ? (unsigned)Rb * g.ldb2 + (unsigned)C * 2u : 0u; }
    const size_t kstepA = (size_t)g.kstepA, kstepB = (size_t)(BK * 2);
    const size_t hstepA = (size_t)HALF * g.lda, hstepB = (size_t)HALF * g.ldb;
    const size_t hstepA2 = SEG2 ? (size_t)HALF * g.lda2 : 0, hstepB2 = SEG2 ? (size_t)HALF * g.ldb2 : 0;
    const unsigned ldsw = (unsigned)wid * 1024u;
    const int aoff = lds_byte(wr * 64 + fr, fq * 8), boff = lds_byte(wc * 32 + fr, fq * 8);
#define PG8_SA(b, h) (((b) * 2 + (h)) * HTB)
#define PG8_SB(b, h) ((4 + (b) * 2 + (h)) * HTB)
#define PG8_STAGE(bufoff, gbase, voff) do { _Pragma("unroll") for (int _i = 0; _i < 2; ++_i) \
        __builtin_amdgcn_global_load_lds((const unsigned*)((const char*)(gbase) + (voff)[_i]), (LAS unsigned*)(lds + (bufoff) + ldsw + _i * 8192), 16, 0, 0); } while (0)
#define PG8_STAGE2(bufoff, gbase, sel, v0, v1) do { _Pragma("unroll") for (int _i = 0; _i < 2; ++_i) \
        __builtin_amdgcn_global_load_lds((const unsigned*)((const char*)(gbase) + ((sel) ? (v1)[_i] : (v0)[_i])), (LAS unsigned*)(lds + (bufoff) + ldsw + _i * 8192), 16, 0, 0); } while (0)
#define PG8_LDA(dst, b, h) do { _Pragma("unroll") for (int m = 0; m < 4; ++m) _Pragma("unroll") for (int k = 0; k < 2; ++k) dst[m][k] = *(const LAS bf16x8*)(lds + PG8_SA(b, h) + aoff + m * 2048 + k * 1024); } while (0)
#define PG8_LDB(dst, b, h) do { _Pragma("unroll") for (int n = 0; n < 2; ++n) _Pragma("unroll") for (int k = 0; k < 2; ++k) dst[n][k] = *(const LAS bf16x8*)(lds + PG8_SB(b, h) + boff + n * 2048 + k * 1024); } while (0)
#define PG8_MMA(ai, bj, At, Bt) do { __builtin_amdgcn_s_setprio(1); _Pragma("unroll") for (int m = 0; m < 4; ++m) _Pragma("unroll") for (int n = 0; n < 2; ++n) _Pragma("unroll") for (int k = 0; k < 2; ++k) \
        acc[ai][bj][m][n] = __builtin_amdgcn_mfma_f32_16x16x32_bf16(Bt[n][k], At[m][k], acc[ai][bj][m][n], 0, 0, 0); __builtin_amdgcn_s_setprio(0); } while (0)
#define PG8_WAIT_V(n) asm volatile("s_waitcnt vmcnt(" #n ")" ::: "memory")
#define PG8_WAIT_L(n) asm volatile("s_waitcnt lgkmcnt(" #n ")" ::: "memory")
#define PG8_BAR __builtin_amdgcn_s_barrier()
#define PG8_SCHED __builtin_amdgcn_sched_barrier(0)
    Unit cur, nxt; int ui = 0;
    if (!S.next(0, cur)) return;
    f32x4 acc[2][2][4][2];
#pragma unroll
    for (int a = 0; a < 2; ++a)
#pragma unroll
        for (int b = 0; b < 2; ++b)
#pragma unroll
            for (int m = 0; m < 4; ++m)
#pragma unroll
                for (int n = 0; n < 2; ++n) acc[a][b][m][n] = (f32x4){0.f, 0.f, 0.f, 0.f};
    bf16x8 At[4][2], B0[2][2], B1[2][2];
    const char* cA = cur.A; const char* cB = cur.B;
    PG8_STAGE(PG8_SB(0, 0), cB, voffB); PG8_STAGE(PG8_SB(0, 1), cB + hstepB, voffB); PG8_STAGE(PG8_SA(0, 0), cA, voffA); PG8_STAGE(PG8_SA(0, 1), cA + hstepA, voffA);
    if (wr == 1) PG8_BAR;
    PG8_WAIT_V(2); PG8_BAR;
    PG8_STAGE(PG8_SB(1, 0), cB + kstepB, voffB); PG8_STAGE(PG8_SA(1, 0), cA + kstepA, voffA); PG8_STAGE(PG8_SB(1, 1), cB + hstepB + kstepB, voffB);
    PG8_WAIT_V(6); PG8_BAR;
    for (;;) {
        const bool has_next = S.next(ui + 1, nxt);
        const char* nA = has_next ? nxt.A : cA; const char* nB = has_next ? nxt.B : cB;
        for (int t = 0; t < nt; t += 2) {
            const bool last = (t == nt - 2);
            if constexpr (SEG2) {
                const bool s1 = (t >= nt0);
                const bool s2 = !last && (t + 2 >= nt0);
                if (t == nt0) E.mid(acc, cur, wr, wc, fr, fq);
                const char* a1 = s1 ? cur.A2 + (size_t)(t + 1 - nt0) * kstepB : cA + (size_t)(t + 1) * kstepA; const size_t h1 = s1 ? hstepA2 : hstepA;
                const char* a2 = last ? nA : (s2 ? cur.A2 + (size_t)(t + 2 - nt0) * kstepB : cA + (size_t)(t + 2) * kstepA);
                const char* b2 = last ? nB : (s2 ? cur.B2 + (size_t)(t + 2 - nt0) * kstepB : cB + (size_t)(t + 2) * kstepB);
                const char* a3 = a2 + (s2 ? kstepB : kstepA); const char* b3 = b2 + kstepB;
                const size_t hA2 = s2 ? hstepA2 : hstepA, hB2 = s2 ? hstepB2 : hstepB;
                PG8_LDB(B0, 0, 0); PG8_LDB(B1, 0, 1); PG8_SCHED; PG8_LDA(At, 0, 0); PG8_STAGE2(PG8_SA(1, 1), a1 + h1, s1, voffA, voffA2);
                PG8_WAIT_V(8); PG8_WAIT_L(0); PG8_BAR; PG8_MMA(0, 0, At, B0); PG8_MMA(0, 1, At, B1); PG8_BAR; PG8_SCHED;
                PG8_LDA(At, 0, 1); PG8_STAGE2(PG8_SB(0, 0), b2, s2, voffB, voffB2); PG8_STAGE2(PG8_SB(0, 1), b2 + hB2, s2, voffB, voffB2); PG8_STAGE2(PG8_SA(0, 0), a2, s2, voffA, voffA2);
                PG8_WAIT_V(8); PG8_WAIT_L(0); PG8_BAR; PG8_MMA(1, 0, At, B0); PG8_MMA(1, 1, At, B1); PG8_BAR; PG8_SCHED;
                PG8_LDB(B0, 1, 0); PG8_LDB(B1, 1, 1); PG8_SCHED; PG8_LDA(At, 1, 0); PG8_STAGE2(PG8_SA(0, 1), a2 + hA2, s2, voffA, voffA2);
                PG8_WAIT_V(8); PG8_WAIT_L(0); PG8_BAR; PG8_MMA(0, 0, At, B0); PG8_MMA(0, 1, At, B1); PG8_BAR; PG8_SCHED;
                PG8_LDA(At, 1, 1); PG8_STAGE2(PG8_SB(1, 0), b3, s2, voffB, voffB2); PG8_STAGE2(PG8_SB(1, 1), b3 + hB2, s2, voffB, voffB2); PG8_STAGE2(PG8_SA(1, 0), a3, s2, voffA, voffA2);
                PG8_WAIT_V(8); PG8_WAIT_L(0); PG8_BAR; PG8_MMA(1, 0, At, B0); PG8_MMA(1, 1, At, B1); PG8_BAR; PG8_SCHED;
            } else {
            const char* a1 = cA + (size_t)(t + 1) * kstepA;
            const char* a2 = last ? nA : cA + (size_t)(t + 2) * kstepA; const char* b2 = last ? nB : cB + (size_t)(t + 2) * kstepB;
            const char* a3 = a2 + kstepA; const char* b3 = b2 + kstepB;
            PG8_LDB(B0, 0, 0); PG8_LDB(B1, 0, 1); PG8_SCHED; PG8_LDA(At, 0, 0); PG8_STAGE(PG8_SA(1, 1), a1 + hstepA, voffA);
            PG8_WAIT_V(8); PG8_WAIT_L(0); PG8_BAR; PG8_MMA(0, 0, At, B0); PG8_MMA(0, 1, At, B1); PG8_BAR; PG8_SCHED;
            PG8_LDA(At, 0, 1); PG8_STAGE(PG8_SB(0, 0), b2, voffB); PG8_STAGE(PG8_SB(0, 1), b2 + hstepB, voffB); PG8_STAGE(PG8_SA(0, 0), a2, voffA);
            PG8_WAIT_V(8); PG8_WAIT_L(0); PG8_BAR; PG8_MMA(1, 0, At, B0); PG8_MMA(1, 1, At, B1); PG8_BAR; PG8_SCHED;
            PG8_LDB(B0, 1, 0); PG8_LDB(B1, 1, 1); PG8_SCHED; PG8_LDA(At, 1, 0); PG8_STAGE(PG8_SA(0, 1), a2 + hstepA, voffA);
            PG8_WAIT_V(8); PG8_WAIT_L(0); PG8_BAR; PG8_MMA(0, 0, At, B0); PG8_MMA(0, 1, At, B1); PG8_BAR; PG8_SCHED;
            PG8_LDA(At, 1, 1); PG8_STAGE(PG8_SB(1, 0), b3, voffB); PG8_STAGE(PG8_SB(1, 1), b3 + hstepB, voffB); PG8_STAGE(PG8_SA(1, 0), a3, voffA);
            PG8_WAIT_V(8); PG8_WAIT_L(0); PG8_BAR; PG8_MMA(1, 0, At, B0); PG8_MMA(1, 1, At, B1); PG8_BAR; PG8_SCHED;
            }
        }
        if constexpr (ALIGN_EPI) { if (wr == 0) PG8_BAR; }
        if constexpr (!Epi::AFTER_DRAIN) { E(acc, cur, wr, wc, fr, fq); }
        if (!has_next) break;
#pragma unroll
        for (int a = 0; a < 2; ++a)
#pragma unroll
            for (int b = 0; b < 2; ++b)
#pragma unroll
                for (int m = 0; m < 4; ++m)
#pragma unroll
                    for (int n = 0; n < 2; ++n) acc[a][b][m][n] = (f32x4){0.f, 0.f, 0.f, 0.f};
        cur = nxt; cA = nA; cB = nB; ++ui;
        if constexpr (ALIGN_EPI) { if (wr == 1) PG8_BAR; }
    }
    PG8_WAIT_V(0);
    if constexpr (!ALIGN_EPI) { if (wr == 0) PG8_BAR; }
    PG8_BAR;
    if constexpr (Epi::AFTER_DRAIN) { E.fused(acc, cur, wr, wc, fr, fq, wid, lane); }
#undef PG8_SA
#undef PG8_SB
#undef PG8_STAGE
#undef PG8_STAGE2
#undef PG8_LDA
#undef PG8_LDB
#undef PG8_MMA
#undef PG8_WAIT_V
#undef PG8_WAIT_L
#undef PG8_BAR
#undef PG8_SCHED
}

struct DenseOrder {
    int nM, nN, nwg, G, c; const char* A; const char* B; size_t tA, tB; const char* A2 = nullptr; const char* B2 = nullptr; size_t tA2 = 0, tB2 = 0;
    __device__ __forceinline__ void init(int M, int N, int G_, int c_, const void* A_, unsigned lda, const void* B_, unsigned ldb) {
        nM = M / BM; nN = N / BM; nwg = nM * nN; G = G_; c = c_; A = (const char*)A_; B = (const char*)B_; tA = (size_t)BM * lda; tB = (size_t)BM * ldb; }
    __device__ __forceinline__ bool next(int i, Unit& u) const {
        const long L = (long)i * G + c; if (L >= nwg) return false;
        int wgid = (int)L; { const int q = nwg / 8, r = nwg % 8, xcd = wgid % 8, off = wgid / 8; wgid = (xcd < r ? xcd * (q + 1) : r * (q + 1) + (xcd - r) * q) + off; }
        const int nig = 8 * nN, gid = wgid / nig, fm = gid * 8, gsz = (nM - fm) < 8 ? (nM - fm) : 8;
        u.pm = fm + ((wgid % nig) % gsz); u.pn = (wgid % nig) / gsz;
        u.A = A + (size_t)u.pm * tA; u.B = B + (size_t)u.pn * tB; u.A2 = A2 + (size_t)u.pm * tA2; u.B2 = B2 + (size_t)u.pn * tB2; return true;
    }
};
}

struct Args {
    const float* x; const float* c; const float* rel_bias; const float* ada_w; const float* ada_b; const float* norm1; const float* norm2; const float* w_in;
    const float* cmp_pos; const float* cmp_w1; const float* cmp_w2; const float* w_up_nsa; const float* w_up_dil; const float* w_o;
    const float* router_wg; const float* router_bg; const float* router_we; const float* router_be; const float* exp_w1; const float* exp_w3; const float* exp_w2; const float* norm_f;
    float* out; unsigned char* ws; int ph_lo, ph_hi, use_bar, pad;
};

typedef f32x4 AccT[2][2][4][2];
struct EpiInProj {
    static constexpr bool PERM = true, AFTER_DRAIN = false;
    bf16_t* QKV; bf16_t* MG; float* GN;
    __device__ __forceinline__ void operator()(const AccT& acc, const pg8::Unit& u, int wr, int wc, int fr, int fq) const {
        const int pn = u.pn; const int row0 = u.pm * 256 + wr * 64 + fr;
        if (pn < 14) {
            const float sc = (pn < 2 || (pn >= 5 && pn < 8)) ? C2 : 1.0f;
            const int col0 = pn * 256 + wc * 32 + 8 * fq;
#pragma unroll
            for (int ai = 0; ai < 2; ++ai)
#pragma unroll
                for (int m = 0; m < 4; ++m) { bf16_t* rowp = QKV + (size_t)(row0 + ai * 128 + m * 16) * LDQ + col0;
#pragma unroll
                    for (int bj = 0; bj < 2; ++bj) { const f32x4 v0 = acc[ai][bj][m][0] * sc, v1 = acc[ai][bj][m][1] * sc; u32x4 w;
                        w.x = cvt_pk_bf16(v0[0], v0[1]); w.y = cvt_pk_bf16(v0[2], v0[3]); w.z = cvt_pk_bf16(v1[0], v1[1]); w.w = cvt_pk_bf16(v1[2], v1[3]);
                        *(u32x4*)(rowp + bj * 128) = w; } }
        } else if (pn < 22) {
            const int col0 = (pn - 14) * 256 + wc * 32 + 8 * fq;
#pragma unroll
            for (int ai = 0; ai < 2; ++ai)
#pragma unroll
                for (int m = 0; m < 4; ++m) { bf16_t* rowp = MG + (size_t)(row0 + ai * 128 + m * 16) * 2048 + col0;
#pragma unroll
                    for (int bj = 0; bj < 2; ++bj) { const f32x4 v0 = acc[ai][bj][m][0], v1 = acc[ai][bj][m][1]; u32x4 w;
                        w.x = cvt_pk_bf16(sigmoidf_(v0[0]), sigmoidf_(v0[1])); w.y = cvt_pk_bf16(sigmoidf_(v0[2]), sigmoidf_(v0[3]));
                        w.z = cvt_pk_bf16(sigmoidf_(v1[0]), sigmoidf_(v1[1])); w.w = cvt_pk_bf16(sigmoidf_(v1[2]), sigmoidf_(v1[3]));
                        *(u32x4*)(rowp + bj * 128) = w; } }
        } else {
            if (wc == 0 && fq < 3) {
#pragma unroll
                for (int ai = 0; ai < 2; ++ai)
#pragma unroll
                    for (int m = 0; m < 4; ++m) { float* rowp = GN + (size_t)(row0 + ai * 128 + m * 16) * 32 + 8 * fq;
                        const f32x4 v0 = acc[ai][0][m][0], v1 = acc[ai][0][m][1];
                        *(f32x4*)(rowp) = (f32x4){sigmoidf_(v0[0]), sigmoidf_(v0[1]), sigmoidf_(v0[2]), sigmoidf_(v0[3])};
                        *(f32x4*)(rowp + 4) = (f32x4){sigmoidf_(v1[0]), sigmoidf_(v1[1]), sigmoidf_(v1[2]), sigmoidf_(v1[3])}; }
            }
        }
    }
};
template <int PASS> struct EpiUp {
    static constexpr bool PERM = true, AFTER_DRAIN = false;
    bf16_t* MERGED; const bf16_t* MG;
    __device__ __forceinline__ void operator()(const AccT& acc, const pg8::Unit& u, int wr, int wc, int fr, int fq) const {
        const int row0 = u.pm * 256 + wr * 64 + fr; const int col0 = u.pn * 256 + wc * 32 + 8 * fq;
#pragma unroll
        for (int ai = 0; ai < 2; ++ai)
#pragma unroll
            for (int m = 0; m < 4; ++m) { const size_t row = (size_t)(row0 + ai * 128 + m * 16);
#pragma unroll
                for (int bj = 0; bj < 2; ++bj) {
                    const u32x4 gw = *(const u32x4*)(MG + row * 2048 + PASS * 1024 + col0 + bj * 128);
                    bf16_t* op = MERGED + row * 1024 + col0 + bj * 128;
                    const f32x4 v0 = acc[ai][bj][m][0], v1 = acc[ai][bj][m][1];
                    float r[8] = {v0[0] * bf_lo(gw.x), v0[1] * bf_hi(gw.x), v0[2] * bf_lo(gw.y), v0[3] * bf_hi(gw.y), v1[0] * bf_lo(gw.z), v1[1] * bf_hi(gw.z), v1[2] * bf_lo(gw.w), v1[3] * bf_hi(gw.w)};
                    if (PASS == 1) { const u32x4 ow = *(const u32x4*)op;
                        r[0] += bf_lo(ow.x); r[1] += bf_hi(ow.x); r[2] += bf_lo(ow.y); r[3] += bf_hi(ow.y); r[4] += bf_lo(ow.z); r[5] += bf_hi(ow.z); r[6] += bf_lo(ow.w); r[7] += bf_hi(ow.w); }
                    u32x4 w; w.x = cvt_pk_bf16(r[0], r[1]); w.y = cvt_pk_bf16(r[2], r[3]); w.z = cvt_pk_bf16(r[4], r[5]); w.w = cvt_pk_bf16(r[6], r[7]);
                    *(u32x4*)op = w; }
                asm volatile("" ::: "memory"); }
    }
};
struct EpiUpFused {
    static constexpr bool PERM = true, AFTER_DRAIN = false;
    bf16_t* MERGED; const bf16_t* MG;
    __device__ __forceinline__ void mid(AccT& acc, const pg8::Unit& u, int wr, int wc, int fr, int fq) const {
        const int row0 = u.pm * 256 + wr * 64 + fr; const int col0 = u.pn * 256 + wc * 32 + 8 * fq;
#pragma unroll
        for (int ai = 0; ai < 2; ++ai)
#pragma unroll
            for (int m = 0; m < 4; ++m) { const size_t row = (size_t)(row0 + ai * 128 + m * 16);
#pragma unroll
                for (int bj = 0; bj < 2; ++bj) {
                    const u32x4 g0 = *(const u32x4*)(MG + row * 2048 + col0 + bj * 128), g1 = *(const u32x4*)(MG + row * 2048 + 1024 + col0 + bj * 128);
                    f32x4& v0 = acc[ai][bj][m][0]; f32x4& v1 = acc[ai][bj][m][1];
                    v0[0] *= bf_lo(g0.x) * __builtin_amdgcn_rcpf(bf_lo(g1.x)); v0[1] *= bf_hi(g0.x) * __builtin_amdgcn_rcpf(bf_hi(g1.x));
                    v0[2] *= bf_lo(g0.y) * __builtin_amdgcn_rcpf(bf_lo(g1.y)); v0[3] *= bf_hi(g0.y) * __builtin_amdgcn_rcpf(bf_hi(g1.y));
                    v1[0] *= bf_lo(g0.z) * __builtin_amdgcn_rcpf(bf_lo(g1.z)); v1[1] *= bf_hi(g0.z) * __builtin_amdgcn_rcpf(bf_hi(g1.z));
                    v1[2] *= bf_lo(g0.w) * __builtin_amdgcn_rcpf(bf_lo(g1.w)); v1[3] *= bf_hi(g0.w) * __builtin_amdgcn_rcpf(bf_hi(g1.w)); }
                asm volatile("" ::: "memory"); }
    }
    __device__ __forceinline__ void operator()(const AccT& acc, const pg8::Unit& u, int wr, int wc, int fr, int fq) const {
        const int row0 = u.pm * 256 + wr * 64 + fr; const int col0 = u.pn * 256 + wc * 32 + 8 * fq;
#pragma unroll
        for (int ai = 0; ai < 2; ++ai)
#pragma unroll
            for (int m = 0; m < 4; ++m) { const size_t row = (size_t)(row0 + ai * 128 + m * 16);
#pragma unroll
                for (int bj = 0; bj < 2; ++bj) {
                    const u32x4 g1 = *(const u32x4*)(MG + row * 2048 + 1024 + col0 + bj * 128);
                    const f32x4 v0 = acc[ai][bj][m][0], v1 = acc[ai][bj][m][1]; u32x4 w;
                    w.x = cvt_pk_bf16(v0[0] * bf_lo(g1.x), v0[1] * bf_hi(g1.x)); w.y = cvt_pk_bf16(v0[2] * bf_lo(g1.y), v0[3] * bf_hi(g1.y));
                    w.z = cvt_pk_bf16(v1[0] * bf_lo(g1.z), v1[1] * bf_hi(g1.z)); w.w = cvt_pk_bf16(v1[2] * bf_lo(g1.w), v1[3] * bf_hi(g1.w));
                    *(u32x4*)(MERGED + row * 1024 + col0 + bj * 128) = w; }
                asm volatile("" ::: "memory"); }
    }
};
struct EpiOut {
    static constexpr bool PERM = true, AFTER_DRAIN = false;
    const float* xin; float* xout; const float* g1;
    __device__ __forceinline__ void operator()(const AccT& acc, const pg8::Unit& u, int wr, int wc, int fr, int fq) const {
        const int row0 = u.pm * 256 + wr * 64 + fr; const int col0 = u.pn * 256 + wc * 32 + 8 * fq; const int b = u.pm >> 4;
        f32x4 gv[2][2];
#pragma unroll
        for (int bj = 0; bj < 2; ++bj)
#pragma unroll
            for (int n = 0; n < 2; ++n) gv[bj][n] = *(const f32x4*)(g1 + (size_t)b * 6144 + col0 + bj * 128 + 4 * n);
#pragma unroll
        for (int ai = 0; ai < 2; ++ai)
#pragma unroll
            for (int m = 0; m < 4; ++m) { const size_t off = (size_t)(row0 + ai * 128 + m * 16) * 1024 + col0;
#pragma unroll
                for (int bj = 0; bj < 2; ++bj)
#pragma unroll
                    for (int n = 0; n < 2; ++n) { const f32x4 xv = *(const f32x4*)(xin + off + bj * 128 + 4 * n);
                        *(f32x4*)(xout + off + bj * 128 + 4 * n) = (ABL == 7) ? xv : xv + gv[bj][n] * acc[ai][bj][m][n]; }
                asm volatile("" ::: "memory"); }
    }
};
struct EpiMoe1 {
    static constexpr bool PERM = true, AFTER_DRAIN = false;
    bf16_t* ACT;
    __device__ __forceinline__ void operator()(const AccT& acc, const pg8::Unit& u, int wr, int wc, int fr, int fq) const {
        const int row0 = u.pm * 256 + wr * 64 + fr; const int col0 = u.pn * 128 + wc * 32 + 8 * fq;
#pragma unroll
        for (int ai = 0; ai < 2; ++ai)
#pragma unroll
            for (int m = 0; m < 4; ++m) { bf16_t* op = ACT + (size_t)(row0 + ai * 128 + m * 16) * 512 + col0; float r[8];
#pragma unroll
                for (int n = 0; n < 2; ++n)
#pragma unroll
                    for (int j = 0; j < 4; ++j) { const float a = acc[ai][0][m][n][j], bb = acc[ai][1][m][n][j]; r[n * 4 + j] = a * sigmoidf_(a) * bb; }
                u32x4 w; w.x = cvt_pk_bf16(r[0], r[1]); w.y = cvt_pk_bf16(r[2], r[3]); w.z = cvt_pk_bf16(r[4], r[5]); w.w = cvt_pk_bf16(r[6], r[7]);
                *(u32x4*)op = w; }
    }
};
struct EpiPlain {
    static constexpr bool PERM = true, AFTER_DRAIN = false;
    bf16_t* O; int ldc;
    __device__ __forceinline__ void operator()(const AccT& acc, const pg8::Unit& u, int wr, int wc, int fr, int fq) const {
        const int row0 = u.pm * 256 + wr * 64 + fr; const int col0 = u.pn * 256 + wc * 32 + 8 * fq;
#pragma unroll
        for (int ai = 0; ai < 2; ++ai)
#pragma unroll
            for (int m = 0; m < 4; ++m) { bf16_t* rowp = O + (size_t)(row0 + ai * 128 + m * 16) * ldc + col0;
#pragma unroll
                for (int bj = 0; bj < 2; ++bj) { const f32x4 v0 = acc[ai][bj][m][0], v1 = acc[ai][bj][m][1]; u32x4 w;
                    w.x = cvt_pk_bf16(v0[0], v0[1]); w.y = cvt_pk_bf16(v0[2], v0[3]); w.z = cvt_pk_bf16(v1[0], v1[1]); w.w = cvt_pk_bf16(v1[2], v1[3]);
                    *(u32x4*)(rowp + bj * 128) = w; } }
    }
};
__device__ __forceinline__ int crow(int r, int hi) { return (r & 3) + 8 * (r >> 2) + 4 * hi; }
__device__ __forceinline__ float gelu_tanh(float x) { const float u2 = 2.0f * 0.7978845608028654f * (x + 0.044715f * x * x * x); return x * __builtin_amdgcn_rcpf(1.0f + __builtin_amdgcn_exp2f(-u2 * LOG2E)); }
struct EpiCmp {
    static constexpr bool PERM = true, AFTER_DRAIN = true;
    bf16_t* HID; const float* CB1; const bf16_t* CW2T; bf16_t* KC;
    __device__ __forceinline__ void fused(const AccT& acc, const pg8::Unit& u, int wr, int wc, int fr, int fq, int wid, int lane) const {
        const int kv = u.pm >> 4; const int row0 = u.pm * 256 + wr * 64 + fr; const int col0 = wc * 32 + 8 * fq;
        const float* bias = CB1 + kv * 256;
        f32x4 bv[2][2];
#pragma unroll
        for (int bj = 0; bj < 2; ++bj)
#pragma unroll
            for (int n = 0; n < 2; ++n) bv[bj][n] = *(const f32x4*)(bias + col0 + bj * 128 + 4 * n);
#pragma unroll
        for (int ai = 0; ai < 2; ++ai)
#pragma unroll
            for (int m = 0; m < 4; ++m) { bf16_t* rowp = HID + (size_t)(row0 + ai * 128 + m * 16) * 256 + col0;
#pragma unroll
                for (int bj = 0; bj < 2; ++bj) { const f32x4 v0 = acc[ai][bj][m][0] + bv[bj][0], v1 = acc[ai][bj][m][1] + bv[bj][1]; u32x4 w;
                    w.x = cvt_pk_bf16(gelu_tanh(v0[0]), gelu_tanh(v0[1])); w.y = cvt_pk_bf16(gelu_tanh(v0[2]), gelu_tanh(v0[3]));
                    w.z = cvt_pk_bf16(gelu_tanh(v1[0]), gelu_tanh(v1[1])); w.w = cvt_pk_bf16(gelu_tanh(v1[2]), gelu_tanh(v1[3]));
                    *(u32x4*)(rowp + bj * 128) = w; } }
        VM_WAIT(); __syncthreads();
        const int r32 = lane & 31, hi = lane >> 5;
        const bf16_t* ap = HID + (size_t)(u.pm * 256 + 32 * wid + r32) * 256 + hi * 8;
        const bf16_t* bp = CW2T + (size_t)kv * 64 * 256 + (size_t)r32 * 256 + hi * 8;
        f32x16 o0 = {}, o1 = {};
#pragma unroll 4
        for (int ks = 0; ks < 16; ++ks) {
            const bf16x8 a = *(const bf16x8*)(ap + ks * 16);
            const bf16x8 b0 = *(const bf16x8*)(bp + ks * 16), b1 = *(const bf16x8*)(bp + 32 * 256 + ks * 16);
            o0 = __builtin_amdgcn_mfma_f32_32x32x16_bf16(a, b0, o0, 0, 0, 0);
            o1 = __builtin_amdgcn_mfma_f32_32x32x16_bf16(a, b1, o1, 0, 0, 0);
        }
        bf16_t* kc = KC + (size_t)u.pm * 256 * 64;
#pragma unroll
        for (int r = 0; r < 16; ++r) { const int c = 32 * wid + crow(r, hi); const bool pad = (c == 255);
            kc[(size_t)c * 64 + r32] = pad ? (bf16_t)0 : (bf16_t)(cvt_pk_bf16(o0[r], 0.f) & 0xffffu);
            kc[(size_t)c * 64 + 32 + r32] = pad ? (bf16_t)0 : (bf16_t)(cvt_pk_bf16(o1[r], 0.f) & 0xffffu); }
    }
};

namespace att {
constexpr int L_KR = 0;
constexpr int L_VR = 24576;
constexpr int L_WSF = 49152;
constexpr int L_BKT = 51200;
constexpr int L_BKC = 55296;
constexpr int L_TBH = 64000;
constexpr int L_GSH = 64576;
constexpr int L_SEL = 67648;
constexpr int L_OTA = 68672;
constexpr int L_IMP = 101440;
constexpr int L_LUT = 117824;
constexpr int L_END = L_LUT + 40960;
static_assert(L_END <= LDS_MISC, "attention LDS map");

__device__ __forceinline__ void glds16(const void* gsrc, unsigned lds_dst) { unsigned keep;
    asm volatile("s_mov_b32 %0, m0\n\ts_mov_b32 m0, %2\n\ts_nop 0\n\tglobal_load_lds_dwordx4 %1, off\n\ts_mov_b32 m0, %0" : "=&s"(keep) : "v"(gsrc), "s"(lds_dst) : "memory"); }
__device__ __forceinline__ int bucket_of(int d) {
    if (d < 16) return d;
    int b = 16;
    b += (d >= 22); b += (d >= 30); b += (d >= 40); b += (d >= 54); b += (d >= 73); b += (d >= 99); b += (d >= 134); b += (d >= 182);
    b += (d >= 246); b += (d >= 332); b += (d >= 450); b += (d >= 609); b += (d >= 825); b += (d >= 1117); b += (d >= 1513);
    return b;
}
__device__ __forceinline__ void qkt(f32x16& p0, f32x16& p1, const LAS unsigned char* Kslot, const bf16x8 (&qr)[4], int r32, int hi) {
    const LAS unsigned char* kb = Kslot + hi * 1024 + r32 * 16;
    p0 = (f32x16){}; p1 = (f32x16){};
#pragma unroll
    for (int d0 = 0; d0 < 4; ++d0) {
        const bf16x8 b0 = *(const LAS bf16x8*)(kb + d0 * 2048);
        const bf16x8 b1 = *(const LAS bf16x8*)(kb + d0 * 2048 + 512);
        p0 = __builtin_amdgcn_mfma_f32_32x32x16_bf16(b0, qr[d0], p0, 0, 0, 0);
        p1 = __builtin_amdgcn_mfma_f32_32x32x16_bf16(b1, qr[d0], p1, 0, 0, 0);
    }
}
__device__ __forceinline__ void pv(f32x16 (&o)[2], int vb, bf16x8 pa0, bf16x8 pa1, bf16x8 pa2, bf16x8 pa3) {
#pragma unroll
    for (int d0 = 0; d0 < 2; ++d0) { s16x4 lo[4], hi[4];
#pragma unroll
        for (int ks = 0; ks < 4; ++ks) {
            asm volatile("ds_read_b64_tr_b16 %0,%1 offset:%c2" : "=&v"(lo[ks]) : "v"(vb), "i"(d0 * 4096 + ks * 1024) : "memory");
            asm volatile("ds_read_b64_tr_b16 %0,%1 offset:%c2" : "=&v"(hi[ks]) : "v"(vb), "i"(d0 * 4096 + ks * 1024 + 512) : "memory"); }
        asm volatile("s_waitcnt lgkmcnt(0)" ::: "memory"); __builtin_amdgcn_sched_barrier(0);
#define PK(k) (bf16x8){lo[k][0], lo[k][1], lo[k][2], lo[k][3], hi[k][0], hi[k][1], hi[k][2], hi[k][3]}
        o[d0] = __builtin_amdgcn_mfma_f32_32x32x16_bf16(pa0, PK(0), o[d0], 0, 0, 0);
        o[d0] = __builtin_amdgcn_mfma_f32_32x32x16_bf16(pa1, PK(1), o[d0], 0, 0, 0);
        o[d0] = __builtin_amdgcn_mfma_f32_32x32x16_bf16(pa2, PK(2), o[d0], 0, 0, 0);
        o[d0] = __builtin_amdgcn_mfma_f32_32x32x16_bf16(pa3, PK(3), o[d0], 0, 0, 0);
#undef PK
    }
}
__device__ __forceinline__ float xhalf_max(float v) { auto rr = __builtin_amdgcn_permlane32_swap(__float_as_uint(v), __float_as_uint(v), false, false); return __builtin_fmaxf(__uint_as_float(rr[0]), __uint_as_float(rr[1])); }
__device__ __forceinline__ float xhalf_sum(float v) { auto rr = __builtin_amdgcn_permlane32_swap(__float_as_uint(v), __float_as_uint(v), false, false); return __uint_as_float(rr[0]) + __uint_as_float(rr[1]); }

#define ATT_PACK(p0, p1, pw0, pw1, pw2, pw3) do { \
    pw0 = (u32x4){cvt_pk_bf16(p0[0], p0[1]), cvt_pk_bf16(p0[2], p0[3]), cvt_pk_bf16(p0[4], p0[5]), cvt_pk_bf16(p0[6], p0[7])}; \
    pw1 = (u32x4){cvt_pk_bf16(p0[8], p0[9]), cvt_pk_bf16(p0[10], p0[11]), cvt_pk_bf16(p0[12], p0[13]), cvt_pk_bf16(p0[14], p0[15])}; \
    pw2 = (u32x4){cvt_pk_bf16(p1[0], p1[1]), cvt_pk_bf16(p1[2], p1[3]), cvt_pk_bf16(p1[4], p1[5]), cvt_pk_bf16(p1[6], p1[7])}; \
    pw3 = (u32x4){cvt_pk_bf16(p1[8], p1[9]), cvt_pk_bf16(p1[10], p1[11]), cvt_pk_bf16(p1[12], p1[13]), cvt_pk_bf16(p1[14], p1[15])}; } while (0)

__device__ __forceinline__ void stage_rows(LAS unsigned char* lds, int wid, int lane, const f32x16 (&ot)[2]) {
    const int r32 = lane & 31, hi = lane >> 5;
    LAS bf16_t* stg = (LAS bf16_t*)(lds + L_OTA) + wid * 2048;
#pragma unroll
    for (int r = 0; r < 16; ++r) { const int orow = crow(r, hi);
#pragma unroll
        for (int d0 = 0; d0 < 2; ++d0) stg[orow * 64 + d0 * 32 + r32] = (bf16_t)(cvt_pk_bf16(ot[d0][r], 0.f) & 0xffffu); }
    LDS_WAIT();
}
struct StreamP { const bf16_t* Kb; const bf16_t* Vb; long pitch; int NT; const LAS unsigned char* tl; unsigned long long lanesel; int uq; const LAS float* lut; int xtop; int dclamp; };
typedef const LAS unsigned char* lds_cptr;
typedef short v4i16_t __attribute__((ext_vector_type(4)));
__device__ __forceinline__ void kload8(bf16x8* kf, lds_cptr kp) {
    kf[0] = *(const LAS bf16x8*)(kp);        kf[1] = *(const LAS bf16x8*)(kp + 512);
    kf[2] = *(const LAS bf16x8*)(kp + 2048); kf[3] = *(const LAS bf16x8*)(kp + 2560);
    kf[4] = *(const LAS bf16x8*)(kp + 4096); kf[5] = *(const LAS bf16x8*)(kp + 4608);
    kf[6] = *(const LAS bf16x8*)(kp + 6144); kf[7] = *(const LAS bf16x8*)(kp + 6656);
}
__device__ __forceinline__ void kload2(bf16x8* kf, lds_cptr kp, int j) { kf[2 * j] = *(const LAS bf16x8*)(kp + j * 2048); kf[2 * j + 1] = *(const LAS bf16x8*)(kp + j * 2048 + 512); }
__device__ __forceinline__ s16x4 vtr(lds_cptr p) { return __builtin_bit_cast(s16x4, __builtin_amdgcn_ds_read_tr16_b64_v4i16((LAS v4i16_t*)p)); }
constexpr int SLOTB = 8192;
#define ST_WAIT_BAR(N) asm volatile("s_waitcnt vmcnt(" #N ") lgkmcnt(0)\n\ts_barrier" ::: "memory")
template <int THRL>
__device__ __forceinline__ void attn_stream(LAS unsigned char* lds, const int wid, const int lane, const bf16x8 (&qr)[4], const StreamP S, float& mhat_o, float& l_o, f32x16 (&o)[2]) {
    const int r32 = lane & 31, hi = lane >> 5;
    const unsigned lds0 = (unsigned)(uintptr_t)lds;
    LAS float* wsf = (LAS float*)(lds + L_WSF) + wid * 64;
    const int NT = S.NT;
    const bf16_t* ksrc = S.Kb + (long)lane * S.pitch + wid * 8;
    const bf16_t* vsrc = S.Vb + (long)(16 * (wid & 3) + (lane >> 2)) * S.pitch + (wid >> 2) * 32 + (lane & 3) * 8;
    const unsigned kdst = lds0 + L_KR + wid * 1024, vdst = lds0 + L_VR + wid * 1024;
    const int tlv = (lane < NT) ? (int)S.tl[lane] : 0x80;
#define TLRAW(k) ((int)__builtin_amdgcn_readlane(tlv, __builtin_amdgcn_readfirstlane(k)))
#define DMA_K(k, slot) do { const int tr_ = TLRAW(k) & 63; glds16(ksrc + (long)tr_ * 64 * S.pitch, (unsigned)__builtin_amdgcn_readfirstlane(kdst + (slot))); } while (0)
#define DMA_V(k, slot) do { const int tr_ = TLRAW(k) & 63; glds16(vsrc + (long)tr_ * 64 * S.pitch, (unsigned)__builtin_amdgcn_readfirstlane(vdst + (slot))); } while (0)
    const lds_cptr kp0 = (lds_cptr)lds + L_KR + hi * 1024 + r32 * 16;
    const lds_cptr vp0 = (lds_cptr)lds + L_VR + ((lane >> 4) & 1) * 32 + (lane & 3) * 8 + (4 * hi + ((lane & 15) >> 2)) * 64;
    const int vb0 = (int)(lds0 + L_VR) + ((lane >> 4) & 1) * 32 + (lane & 3) * 8 + (4 * hi + ((lane & 15) >> 2)) * 64;
    bf16x8 kf[8];
#define LOFF(r) (((r) & 3) + 8 * ((r) >> 2))
#define LUTPTR(k, lp) do { const int raw_ = TLRAW(k); const int tj_ = raw_ & 63; int d0_ = S.uq - 64 * tj_ - 4 * hi; d0_ = d0_ < S.dclamp ? d0_ : S.dclamp; \
        const bool ok_ = (raw_ < 128) && (((S.lanesel >> tj_) & 1ull) != 0ull); lp = S.lut + (ok_ ? S.xtop - d0_ : S.xtop + 64); } while (0)
#define LUTLOAD(C0, C1, k) do { const int raw_ = TLRAW(k); const int tj_ = raw_ & 63; int d0_ = S.uq - 64 * tj_ - 4 * hi; d0_ = d0_ < S.dclamp ? d0_ : S.dclamp; \
        const bool ok_ = (raw_ < 128) && (((S.lanesel >> tj_) & 1ull) != 0ull); const LAS float* lp_ = S.lut + (ok_ ? S.xtop - d0_ : S.xtop + 64); \
        _Pragma("unroll") for (int r = 0; r < 16; ++r) { C0[r] = lp_[(r & 3) + 8 * (r >> 2)]; C1[r] = lp_[(r & 3) + 8 * (r >> 2) + 32]; } } while (0)
#define SBAR() __builtin_amdgcn_sched_barrier(0)
#define PIN(x) asm volatile("" : "+v"(x))
#define PKW(P, B) cvt_pk_bf16(P[B], P[B + 1])
#define PAF(k) __builtin_bit_cast(bf16x8, pw##k)
#define VFR(i) (bf16x8){vlo[i][0], vlo[i][1], vlo[i][2], vlo[i][3], vhi[i][0], vhi[i][1], vhi[i][2], vhi[i][3]}
#define MX3(a, b, c) __builtin_fmaxf(__builtin_fmaxf((a), (b)), (c))
#define MFMA32(a, b, c) __builtin_amdgcn_mfma_f32_32x32x16_bf16(a, b, c, 0, 0, 0)
#define GAPA(MF, A0, A1, A2, A3, W0, W1, PW) do { MF; sacc += A0; sacc += A1; sacc += A2; sacc += A3; PIN(sacc); W0; W1; PIN(PW); SBAR(); } while (0)
#define EX(v) __builtin_amdgcn_exp2f(v)
#define GAPB(MF, X, B, GN, PL, PO) do { MF; X[B] = EX(X[B]); X[B + 1] = EX(X[B + 1]); X[B + 2] = EX(X[B + 2]); X[B + 3] = EX(X[B + 3]); PIN(X); \
        if (GN) { PL[B] = lpn_[LOFF(B) + PO]; PL[B + 1] = lpn_[LOFF(B + 1) + PO]; PL[B + 2] = lpn_[LOFF(B + 2) + PO]; PL[B + 3] = lpn_[LOFF(B + 3) + PO]; } SBAR(); } while (0)
#define VRD(i) do { vlo[i] = vtr(vp_ + (((i) >> 2) * 4096 + ((i) & 3) * 1024)); vhi[i] = vtr(vp_ + (((i) >> 2) * 4096 + ((i) & 3) * 1024 + 512)); } while (0)
#define KRD(G, j) do { if (G) { kload2(kf, kp0 + sl_next, j); SBAR(); } } while (0)
#define ROT() do { sl_prev = sl_cur; sl_cur = sl_next; sl_next = (sl_next == 2 * SLOTB) ? 0 : sl_next + SLOTB; } while (0)
#define RESC() do { if (resc) { LDS_WAIT(); _Pragma("unroll") for (int d_ = 0; d_ < 2; ++d_) _Pragma("unroll") for (int r = 0; r < 16; ++r) o[d_][r] *= wsf[crow(r, hi)]; } } while (0)
#define ENDW(tt) do { if ((tt) + 3 < NT) { ST_WAIT_BAR(2); } else if ((tt) + 2 < NT) { ST_WAIT_BAR(1); } else { ST_WAIT_BAR(0); } } while (0)
#define STEP(C0, C1, P0, P1, t, GK, GV, GL, GN) do { SBAR(); \
    const lds_cptr vp_ = vp0 + sl_prev; const LAS float* lpn_ = S.lut; if (GN) { LUTPTR((t) + 1, lpn_); } \
    VRD(0); SBAR(); float sacc = (P0[0] + P0[1]); \
    GAPA(C0 = MFMA32(kf[0], qr[0], C0), P0[2], P0[3], P0[4], P0[5],     pw0[0] = PKW(P0, 0), pw0[1] = PKW(P0, 2), pw0); \
    VRD(4); SBAR(); GAPA(C1 = MFMA32(kf[1], qr[0], C1), P0[6], P0[7], P0[8], P0[9],     pw0[2] = PKW(P0, 4), pw0[3] = PKW(P0, 6), pw0); \
    VRD(1); SBAR(); GAPA(C0 = MFMA32(kf[2], qr[1], C0), P0[10], P0[11], P0[12], P0[13], pw1[0] = PKW(P0, 8), pw1[1] = PKW(P0, 10), pw1); \
    VRD(5); SBAR(); GAPA(C1 = MFMA32(kf[3], qr[1], C1), P0[14], P0[15], P1[0], P1[1],   pw1[2] = PKW(P0, 12), pw1[3] = PKW(P0, 14), pw1); \
    VRD(2); SBAR(); GAPA(C0 = MFMA32(kf[4], qr[2], C0), P1[2], P1[3], P1[4], P1[5],     pw2[0] = PKW(P1, 0), pw2[1] = PKW(P1, 2), pw2); \
    VRD(6); SBAR(); GAPA(C1 = MFMA32(kf[5], qr[2], C1), P1[6], P1[7], P1[8], P1[9],     pw2[2] = PKW(P1, 4), pw2[3] = PKW(P1, 6), pw2); \
    VRD(3); SBAR(); GAPA(C0 = MFMA32(kf[6], qr[3], C0), P1[10], P1[11], P1[12], P1[13], pw3[0] = PKW(P1, 8), pw3[1] = PKW(P1, 10), pw3); \
    VRD(7); SBAR(); GAPA(C1 = MFMA32(kf[7], qr[3], C1), P1[14], P1[15], 0.f, 0.f,       pw3[2] = PKW(P1, 12), pw3[3] = PKW(P1, 14), pw3); \
    l_reg += sacc; \
    if (GK) { DMA_K((t) + 3, sl_cur); } if (GV) { DMA_V((t) + 1, sl_next); } \
    { _Pragma("unroll") for (int r = 0; r < 16; ++r) { C0[r] -= mhat; C1[r] -= mhat; } \
      float a_ = MX3(C0[0], C0[1], C1[0]), b_ = MX3(C0[2], C0[3], C1[1]); a_ = MX3(a_, C1[2], C1[3]); \
      _Pragma("unroll") for (int r = 4; r < 16; r += 4) { a_ = MX3(a_, C0[r], C0[r + 1]); b_ = MX3(b_, C0[r + 2], C0[r + 3]); a_ = MX3(a_, C1[r], C1[r + 1]); b_ = MX3(b_, C1[r + 2], C1[r + 3]); } \
      float rm = xhalf_max(__builtin_fmaxf(a_, b_)); \
      resc = false; \
      if (__builtin_expect(__any(rm > (float)THRL), 0)) { const float dl = __builtin_fmaxf(rm, 0.f); mhat += dl; \
        _Pragma("unroll") for (int r = 0; r < 16; ++r) { C0[r] -= dl; C1[r] -= dl; } \
        const float f = __builtin_amdgcn_exp2f(-dl); l_reg *= f; if (hi == 0) wsf[r32] = f; resc = true; } } \
    SBAR(); \
    GAPB(o[0] = MFMA32(PAF(0), VFR(0), o[0]), C0, 0, GN, P0, 0); \
    GAPB(o[1] = MFMA32(PAF(0), VFR(4), o[1]), C0, 4, GN, P0, 0); \
    KRD(GL, 0); GAPB(o[0] = MFMA32(PAF(1), VFR(1), o[0]), C0, 8, GN, P0, 0); \
    KRD(GL, 1); GAPB(o[1] = MFMA32(PAF(1), VFR(5), o[1]), C0, 12, GN, P0, 0); \
    KRD(GL, 2); GAPB(o[0] = MFMA32(PAF(2), VFR(2), o[0]), C1, 0, GN, P1, 32); \
    KRD(GL, 3); GAPB(o[1] = MFMA32(PAF(2), VFR(6), o[1]), C1, 4, GN, P1, 32); \
    GAPB(o[0] = MFMA32(PAF(3), VFR(3), o[0]), C1, 8, GN, P1, 32); \
    GAPB(o[1] = MFMA32(PAF(3), VFR(7), o[1]), C1, 12, GN, P1, 32); \
    } while (0)
    float mhat = 0.f, l_reg = 0.f; bool resc = false;
    o[0] = (f32x16){}; o[1] = (f32x16){};
    f32x16 pA0, pA1, pB0, pB1;
    int sl_prev = 0, sl_cur = 0, sl_next = SLOTB;
    DMA_K(0, 0); DMA_V(0, 0); DMA_K(1, SLOTB); DMA_K(2, 2 * SLOTB);
    LUTLOAD(pA0, pA1, 0);
    ST_WAIT_BAR(3);
    { const lds_cptr kb = kp0;
#pragma unroll
      for (int d0 = 0; d0 < 4; ++d0) { const bf16x8 b0 = *(const LAS bf16x8*)(kb + d0 * 2048); const bf16x8 b1 = *(const LAS bf16x8*)(kb + d0 * 2048 + 512);
          pA0 = MFMA32(b0, qr[d0], pA0); pA1 = MFMA32(b1, qr[d0], pA1); }
      float rm = pA0[0];
#pragma unroll
      for (int r = 1; r < 16; ++r) rm = __builtin_fmaxf(rm, pA0[r]);
#pragma unroll
      for (int r = 0; r < 16; ++r) rm = __builtin_fmaxf(rm, pA1[r]);
      rm = xhalf_max(rm);
      mhat = (rm == -INFINITY) ? 0.f : rm;
#pragma unroll
      for (int r = 0; r < 16; ++r) { pA0[r] = EX(pA0[r] - mhat); pA1[r] = EX(pA1[r] - mhat); } }
    ST_WAIT_BAR(0);
    DMA_K(3, 0); DMA_V(1, SLOTB);
    ROT();
    kload8(kf, kp0 + sl_cur);
    LUTLOAD(pB0, pB1, 1);
    ST_WAIT_BAR(2);
    s16x4 vlo[8], vhi[8]; u32x4 pw0, pw1, pw2, pw3;
    int t = 1;
    for (; t + 5 < NT; t += 2) {
        STEP(pB0, pB1, pA0, pA1, t, true, true, true, true);     ST_WAIT_BAR(2); RESC(); ROT();
        STEP(pA0, pA1, pB0, pB1, t + 1, true, true, true, true); ST_WAIT_BAR(2); RESC(); ROT();
    }
    for (; t + 1 < NT; t += 2) {
        STEP(pB0, pB1, pA0, pA1, t, (t + 3 < NT), (t + 1 < NT), (t + 1 < NT), true);       ENDW(t);     RESC(); ROT();
        STEP(pA0, pA1, pB0, pB1, t + 1, (t + 4 < NT), (t + 2 < NT), (t + 2 < NT), true);   ENDW(t + 1); RESC(); ROT();
    }
    STEP(pB0, pB1, pA0, pA1, NT - 1, false, false, false, false); RESC();
    { float sacc = pB0[0] + pB0[1];
#pragma unroll
      for (int r = 2; r < 16; ++r) sacc += pB0[r];
#pragma unroll
      for (int r = 0; r < 16; ++r) sacc += pB1[r];
      l_reg += sacc;
      ATT_PACK(pB0, pB1, pw0, pw1, pw2, pw3);
      SBAR(); pv(o, vb0 + sl_cur, PAF(0), PAF(1), PAF(2), PAF(3)); }
    asm volatile("s_waitcnt lgkmcnt(0)\n\ts_barrier" ::: "memory");
    mhat_o = mhat; l_o = l_reg;
#undef TLRAW
#undef DMA_K
#undef DMA_V
#undef LUTLOAD
#undef LUTPTR
#undef LOFF
#undef SBAR
#undef PIN
#undef PKW
#undef PAF
#undef VFR
#undef MX3
#undef MFMA32
#undef GAPA
#undef EX
#undef GAPB
#undef VRD
#undef KRD
#undef ROT
#undef RESC
#undef ENDW
#undef STEP
}
__device__ __forceinline__ void cmp_scores(f32x16& s0, f32x16& s1, LAS unsigned char* lds, const LAS unsigned char* bkc, const LAS unsigned char* tb, const bf16x8 (&qr)[4], const int k, const int r32, const int hi) {
#pragma unroll
    for (int r = 0; r < 16; ++r) { const int off = 16 * ((r & 3) + 8 * (r >> 2));
        s0[r] = *(const LAS float*)(tb + bkc[1024 * k + off]); s1[r] = *(const LAS float*)(tb + bkc[1024 * k + off + 512]); }
    const LAS unsigned char* kb = lds + k * 8192 + hi * 1024 + r32 * 16;
#pragma unroll
    for (int d0 = 0; d0 < 4; ++d0) { const bf16x8 b0 = *(const LAS bf16x8*)(kb + d0 * 2048); const bf16x8 b1 = *(const LAS bf16x8*)(kb + d0 * 2048 + 512);
        s0 = __builtin_amdgcn_mfma_f32_32x32x16_bf16(b0, qr[d0], s0, 0, 0, 0); s1 = __builtin_amdgcn_mfma_f32_32x32x16_bf16(b1, qr[d0], s1, 0, 0, 0); }
}
__device__ __forceinline__ float xhalf_other(float v, int hi) { auto rr = __builtin_amdgcn_permlane32_swap(__float_as_uint(v), __float_as_uint(v), false, false); return __uint_as_float(hi ? rr[0] : rr[1]); }
__device__ __forceinline__ void cmp_branch(LAS unsigned char* lds, const int wid, const int lane, const bf16x8 (&qr)[4], const bf16_t* Kb, const bf16_t* Vb, const int nt, const int t, f32x16 (&o)[2]) {
    const int r32 = lane & 31, hi = lane >> 5, g = wid >> 1, tq = (wid & 1) * 32 + r32;
    const unsigned lds0 = (unsigned)(uintptr_t)lds;
    { const bf16_t* ksrc = Kb + (long)lane * 64 + wid * 8; const bf16_t* vsrc = Vb + (long)(16 * (wid & 3) + (lane >> 2)) * 64 + (wid >> 2) * 32 + (lane & 3) * 8;
      for (int k = 0; k < nt; ++k) { glds16(ksrc + (long)k * 4096, (unsigned)__builtin_amdgcn_readfirstlane(lds0 + k * 8192 + wid * 1024));
                                     glds16(vsrc + (long)k * 4096, (unsigned)__builtin_amdgcn_readfirstlane(lds0 + L_OTA + k * 8192 + wid * 1024)); } }
    const LAS unsigned char* bkc = lds + L_BKC + (4126 - t + 64 * hi);
    const LAS unsigned char* tb = lds + L_TBH + g * 144;
    asm volatile("s_waitcnt vmcnt(0)\n\ts_barrier" ::: "memory");
    float m = -INFINITY, l = 0.f;
#pragma clang loop unroll(disable)
    for (int k = 0; k < nt; ++k) { f32x16 s0, s1; cmp_scores(s0, s1, lds, bkc, tb, qr, k, r32, hi);
        float rm = s0[0];
#pragma unroll
        for (int r = 1; r < 16; ++r) rm = __builtin_fmaxf(rm, s0[r]);
#pragma unroll
        for (int r = 0; r < 16; ++r) rm = __builtin_fmaxf(rm, s1[r]);
        rm = xhalf_max(rm);
        const float mn = __builtin_fmaxf(m, rm), ms = (mn == -INFINITY) ? 0.f : mn;
        float ps = 0.f;
#pragma unroll
        for (int r = 0; r < 16; ++r) ps += __builtin_amdgcn_exp2f(s0[r] - ms) + __builtin_amdgcn_exp2f(s1[r] - ms);
        l = l * __builtin_amdgcn_exp2f(m - ms) + ps; m = mn; }
    l = xhalf_sum(l);
    const float msafe = (m == -INFINITY) ? 0.f : m, inv = l > 0.f ? 1.0f / l : 0.f;
    float I[4][8]; float pc7 = 0.f;
    o[0] = (f32x16){}; o[1] = (f32x16){};
    const int vb0 = (int)(lds0 + L_OTA) + ((lane >> 4) & 1) * 32 + (lane & 3) * 8 + (4 * hi + ((lane & 15) >> 2)) * 64;
#pragma unroll
    for (int k = 0; k < 4; ++k) {
        if (k < nt) { f32x16 s0, s1; cmp_scores(s0, s1, lds, bkc, tb, qr, k, r32, hi);
#pragma unroll
            for (int r = 0; r < 16; ++r) { s0[r] = __builtin_amdgcn_exp2f(s0[r] - msafe) * inv; s1[r] = __builtin_amdgcn_exp2f(s1[r] - msafe) * inv; }
            float pc[8];
#pragma unroll
            for (int q = 0; q < 4; ++q) { I[k][q] = 2.0f * (s0[4 * q] + s0[4 * q + 1] + s0[4 * q + 2]) + s0[4 * q + 3]; I[k][4 + q] = 2.0f * (s1[4 * q] + s1[4 * q + 1] + s1[4 * q + 2]) + s1[4 * q + 3];
                pc[q] = xhalf_other(s0[4 * q + 3], hi); pc[4 + q] = xhalf_other(s1[4 * q + 3], hi); }
#pragma unroll
            for (int j = 0; j < 8; ++j) I[k][j] += hi ? pc[j] : (j > 0 ? pc[j - 1] : pc7);
            pc7 = pc[7];
            u32x4 pw0, pw1, pw2, pw3; ATT_PACK(s0, s1, pw0, pw1, pw2, pw3);
            pv(o, vb0 + k * 8192, __builtin_bit_cast(bf16x8, pw0), __builtin_bit_cast(bf16x8, pw1), __builtin_bit_cast(bf16x8, pw2), __builtin_bit_cast(bf16x8, pw3));
        } else {
#pragma unroll
            for (int j = 0; j < 8; ++j) I[k][j] = 0.f;
        }
    }
    LAS float* imp = (LAS float*)(lds + L_IMP) + tq * 64 + hi;
#pragma unroll 1
    for (int gi = 0; gi < 4; ++gi) {
        if (g == gi) {
#pragma unroll
            for (int k = 0; k < 4; ++k) if (k < nt) {
#pragma unroll
                for (int j = 0; j < 8; ++j) __builtin_amdgcn_ds_faddf(imp + 16 * k + 2 * j, I[k][j], 0, 0, false);
            }
        }
        asm volatile("s_waitcnt lgkmcnt(0)\n\ts_barrier" ::: "memory");
    }
}
}

struct Ctx { int tid, lane, wave, vcu, G, bx; LAS unsigned char* lds; };

struct TrD { const float* src; size_t ldw; int nvalid; bf16_t* dst; size_t ldk; };
__device__ __forceinline__ void tr_load(const TrD& d, float (&v)[32], int lane) {
    const int n = lane & 31; const float* src = d.src + (size_t)(lane >> 5) * d.ldw + n;
#pragma unroll
    for (int i = 0; i < 32; ++i) v[i] = (n < d.nvalid) ? src[(size_t)(2 * i) * d.ldw] : 0.f;
}
__device__ __forceinline__ void tr_store(const TrD& d, const float (&v)[32], LAS float* scr, int lane) {
    const int n = lane & 31;
#pragma unroll
    for (int i = 0; i < 32; ++i) scr[(2 * i + (lane >> 5)) * 33 + n] = v[i];
    LDS_WAIT(); asm volatile("" ::: "memory");
    const int c = lane & 7;
#pragma unroll
    for (int j = 0; j < 4; ++j) { const int nn = (lane >> 3) + 8 * j; const LAS float* s = scr + (8 * c) * 33 + nn;
        u32x4 o; o.x = cvt_pk_bf16(s[0 * 33], s[1 * 33]); o.y = cvt_pk_bf16(s[2 * 33], s[3 * 33]); o.z = cvt_pk_bf16(s[4 * 33], s[5 * 33]); o.w = cvt_pk_bf16(s[6 * 33], s[7 * 33]);
        *(u32x4*)(d.dst + (size_t)nn * d.ldk + 8 * c) = o; }
    LDS_WAIT(); asm volatile("" ::: "memory");
}
__device__ __forceinline__ TrD mk_trd(const float* W, size_t ldw, int srccol, int nvalid, bf16_t* WT, size_t ldk, int dstrow, int k0) {
    TrD d; d.src = W + (size_t)k0 * ldw + srccol; d.ldw = ldw; d.nvalid = nvalid; d.dst = WT + (size_t)dstrow * ldk + k0; d.ldk = ldk; return d; }
__device__ __forceinline__ TrD dec_small(const Args& a, int it) {
    constexpr int I_WIN = 184 * 16, I_CW1 = 2 * 8 * 32, I_WUN = 32 * 8, I_WUD = 32 * 4, I_WO = 32 * 16, I_CW2 = 2 * 2 * 4;
    constexpr int PER = I_WIN + I_CW1 + I_WUN + I_WUD + I_WO + I_CW2;
    unsigned char* ws = a.ws;
    const int l = it / PER; int r = it % PER;
    if (r < I_WIN) { const int nb = r / 16, kb = r % 16; const int nd = 32 * nb; int src, nv = 32;
        if (nd < 1280) src = nd; else if (nd < 5632) src = nd + 24; else if (nd == 5632) { src = 1280; nv = 24; } else { src = 0; nv = 0; }
        return mk_trd(a.w_in + (size_t)l * DM * INW, INW, src, nv, (bf16_t*)(ws + WS_WINT) + (size_t)l * NIN * DM, DM, nd, 64 * kb); }
    r -= I_WIN;
    if (r < I_CW1) { const int kv = r / 256, q = r % 256, nb = q / 32, kb = q % 32;
        return mk_trd(a.cmp_w1 + (size_t)(l * 2 + kv) * 2048 * 256, 256, 32 * nb, 32, (bf16_t*)(ws + WS_CW1T) + (size_t)(l * 2 + kv) * 256 * 2048, 2048, 32 * nb, 64 * kb); }
    r -= I_CW1;
    if (r < I_WUN) { const int nb = r / 8, kb = r % 8;
        return mk_trd(a.w_up_nsa + (size_t)l * 512 * 1024, 1024, 32 * nb, 32, (bf16_t*)(ws + WS_WUNT) + (size_t)l * 1024 * 512, 512, 32 * nb, 64 * kb); }
    r -= I_WUN;
    if (r < I_WUD) { const int nb = r / 4, kb = r % 4;
        return mk_trd(a.w_up_dil + (size_t)l * 256 * 1024, 1024, 32 * nb, 32, (bf16_t*)(ws + WS_WUDT) + (size_t)l * 1024 * 256, 256, 32 * nb, 64 * kb); }
    r -= I_WUD;
    if (r < I_WO) { const int nb = r / 16, kb = r % 16;
        return mk_trd(a.w_o + (size_t)l * 1024 * 1024, 1024, 32 * nb, 32, (bf16_t*)(ws + WS_WOT) + (size_t)l * 1024 * 1024, 1024, 32 * nb, 64 * kb); }
    r -= I_WO;
    { const int kv = r / 8, q = r % 8, nb = q / 4, kb = q % 4;
        return mk_trd(a.cmp_w2 + (size_t)(l * 2 + kv) * 256 * 64, 64, 32 * nb, 32, (bf16_t*)(ws + WS_CW2T) + (size_t)(l * 2 + kv) * 64 * 256, 256, 32 * nb, 64 * kb); }
}
__device__ __forceinline__ TrD dec_expert(const Args& a, int l, int it) {
    constexpr int I_13 = 32 * 16, I_2 = 32 * 8, PER = I_13 + I_2;
    unsigned char* ws = a.ws;
    const int e = it / PER; int r = it % PER;
    if (r < I_13) { const int nb = r / 16, kb = r % 16; const int r0 = 32 * nb, pn = r0 >> 8, bj = (r0 >> 7) & 1, j0 = r0 & 127;
        const float* src = (bj ? a.exp_w3 : a.exp_w1) + (size_t)(l * 32 + e) * 1024 * 512;
        return mk_trd(src, 512, pn * 128 + j0, 32, (bf16_t*)(ws + WS_E13T) + (size_t)e * 1024 * 1024, 1024, r0, 64 * kb); }
    r -= I_13;
    { const int nb = r / 8, kb = r % 8;
        return mk_trd(a.exp_w2 + (size_t)(l * 32 + e) * 512 * 1024, 1024, 32 * nb, 32, (bf16_t*)(ws + WS_E2T) + (size_t)e * 1024 * 512, 512, 32 * nb, 64 * kb); }
}
template <int KIND> __device__ __forceinline__ void conv_items(const Args& a, const Ctx& C, int l, int nitems) {
    LAS float* scr = (LAS float*)(C.lds + C.wave * 16384);
    const int gw = C.vcu * NWAVES + C.wave, NGW = C.G * NWAVES;
    float va[32], vb[32]; TrD d0, d1;
    int it = gw;
    if (it >= nitems) return;
    d0 = KIND ? dec_expert(a, l, it) : dec_small(a, it); tr_load(d0, va, C.lane);
    for (;;) {
        const int itn = it + NGW; const bool hn = itn < nitems;
        if (hn) { d1 = KIND ? dec_expert(a, l, itn) : dec_small(a, itn); tr_load(d1, vb, C.lane); }
        tr_store(d0, va, scr, C.lane);
        if (!hn) break;
        const int itnn = itn + NGW; const bool hnn = itnn < nitems;
        if (hnn) { d0 = KIND ? dec_expert(a, l, itnn) : dec_small(a, itnn); tr_load(d0, va, C.lane); }
        tr_store(d1, vb, scr, C.lane);
        if (!hnn) break;
        it = itnn;
    }
}
__device__ __forceinline__ void conv_small(const Args& a, const Ctx& C) { conv_items<0>(a, C, 0, 2 * 4368); }
__device__ __forceinline__ void conv_experts(const Args& a, const Ctx& C, int l) { conv_items<1>(a, C, l, 32 * 768); }
__device__ __forceinline__ void prologue_vectors(const Args& a, const Ctx& C) {
    LAS float* sc = (LAS float*)(C.lds + 131072);
    LAS float* sl = (LAS float*)(C.lds);
    for (int i = C.tid; i < 8 * 1024; i += NTHR) { const float v = a.c[i]; sl[i] = v * sigmoidf_(v); }
    (void)sc;
    __syncthreads();
    const int gw = C.vcu * NWAVES + C.wave, NGW = C.G * NWAVES;
    float* MOD = (float*)(a.ws + WS_MOD); float* CB1 = (float*)(a.ws + WS_CB1);
    for (int it = gw; it < 192 + 16; it += NGW) {
        if (it < 192) { const int l = it / 96, col = (it % 96) * 64 + C.lane;
            const float* w = a.ada_w + (size_t)l * 1024 * 6144 + col;
            float acc[8];
#pragma unroll
            for (int b = 0; b < 8; ++b) acc[b] = 0.f;
            for (int k = 0; k < 1024; ++k) { const float wv = w[(size_t)k * 6144];
#pragma unroll
                for (int b = 0; b < 8; ++b) acc[b] += sl[b * 1024 + k] * wv; }
            const float bias = a.ada_b[l * 6144 + col];
#pragma unroll
            for (int b = 0; b < 8; ++b) MOD[(size_t)(l * 8 + b) * 6144 + col] = acc[b] + bias;
        } else { const int q = it - 192, lk = q / 4, col = (q % 4) * 64 + C.lane;
            const float* w = a.cmp_w1 + (size_t)lk * 2048 * 256 + col; const float* pos = a.cmp_pos + (size_t)lk * 2048;
            float acc = 0.f;
            for (int k = 0; k < 2048; ++k) acc += pos[k] * w[(size_t)k * 256];
            CB1[lk * 256 + col] = acc;
        }
    }
    __syncthreads();
}

__device__ __forceinline__ void moe_combine_row(const Args& a, int row, int lane, const float* g2  , f32x4 (&v)[4]) {
    const u32x4 rec = *(const u32x4*)(a.ws + WS_DEST + (size_t)row * 16);
    const bf16_t* Y = (const bf16_t*)(a.ws + WS_XS);
    const float w0 = (ABL == 6) ? 0.f : __uint_as_float(rec.z), w1 = (ABL == 6) ? 0.f : __uint_as_float(rec.w);
    const u32x2* y0 = (const u32x2*)(Y + (size_t)rec.x * 1024) + lane; const u32x2* y1 = (const u32x2*)(Y + (size_t)rec.y * 1024) + lane;
#pragma unroll
    for (int j = 0; j < 4; ++j) { const u32x2 p = y0[64 * j], q = y1[64 * j]; const f32x4 gg = *((const f32x4*)g2 + lane + 64 * j);
        v[j][0] += gg[0] * (w0 * bf_lo(p.x) + w1 * bf_lo(q.x)); v[j][1] += gg[1] * (w0 * bf_hi(p.x) + w1 * bf_hi(q.x));
        v[j][2] += gg[2] * (w0 * bf_lo(p.y) + w1 * bf_lo(q.y)); v[j][3] += gg[3] * (w0 * bf_hi(p.y) + w1 * bf_hi(q.y)); }
}
__device__ __forceinline__ void norm1_phase(const Args& a, const Ctx& C, int l) {
    const int gw = C.vcu * NWAVES + C.wave, NGW = C.G * NWAVES;
    const float* MOD = (const float*)(a.ws + WS_MOD); bf16_t* H = (bf16_t*)(a.ws + WS_H);
    const float* nw = a.norm1 + l * 1024;
    for (int row = gw; row < T; row += NGW) {
        const int b = row >> 12; const float* xr = (l == 0 ? a.x : (const float*)a.out) + (size_t)row * 1024;
        f32x4 v[4];
#pragma unroll
        for (int j = 0; j < 4; ++j) v[j] = *((const f32x4*)xr + C.lane + 64 * j);
        if (l == 1) { moe_combine_row(a, row, C.lane, MOD + (size_t)(0 * 8 + b) * 6144 + 5120, v);
#pragma unroll
            for (int j = 0; j < 4; ++j) *((f32x4*)(a.out + (size_t)row * 1024) + C.lane + 64 * j) = v[j]; }
        float ss = 0.f;
#pragma unroll
        for (int j = 0; j < 4; ++j) ss += (v[j][0] * v[j][0] + v[j][1] * v[j][1]) + (v[j][2] * v[j][2] + v[j][3] * v[j][3]);
        const float rstd = 1.0f / sqrtf(wave_sum(ss) * (1.0f / 1024.0f) + RMS_EPS);
        const float* mb = MOD + (size_t)(l * 8 + b) * 6144;
#pragma unroll
        for (int j = 0; j < 4; ++j) { const f32x4 g = *((const f32x4*)nw + C.lane + 64 * j), sh = *((const f32x4*)mb + C.lane + 64 * j), sc = *((const f32x4*)(mb + 1024) + C.lane + 64 * j);
            const f32x4 h = v[j] * rstd * g * (sc + 1.0f) + sh; u32x2 w; w.x = cvt_pk_bf16(h[0], h[1]); w.y = cvt_pk_bf16(h[2], h[3]);
            *((u32x2*)(H + (size_t)row * 1024) + C.lane + 64 * j) = w; }
    }
}
__device__ __forceinline__ void final_phase(const Args& a, const Ctx& C) {
    const int gw = C.vcu * NWAVES + C.wave, NGW = C.G * NWAVES;
    const float* MOD = (const float*)(a.ws + WS_MOD);
    for (int row = gw; row < T; row += NGW) {
        const int b = row >> 12; float* xr = a.out + (size_t)row * 1024;
        f32x4 v[4];
#pragma unroll
        for (int j = 0; j < 4; ++j) v[j] = *((const f32x4*)xr + C.lane + 64 * j);
        moe_combine_row(a, row, C.lane, MOD + (size_t)(1 * 8 + b) * 6144 + 5120, v);
        float ss = 0.f;
#pragma unroll
        for (int j = 0; j < 4; ++j) ss += (v[j][0] * v[j][0] + v[j][1] * v[j][1]) + (v[j][2] * v[j][2] + v[j][3] * v[j][3]);
        const float rstd = 1.0f / sqrtf(wave_sum(ss) * (1.0f / 1024.0f) + RMS_EPS);
#pragma unroll
        for (int j = 0; j < 4; ++j) { const f32x4 g = *((const f32x4*)a.norm_f + C.lane + 64 * j); *((f32x4*)xr + C.lane + 64 * j) = v[j] * rstd * g; }
    }
}
typedef float f32x4v __attribute__((ext_vector_type(4)));
__device__ __forceinline__ void norm2_router_phase(const Args& a, const Ctx& C, int l) {
    constexpr int RP = 2064;
    LAS unsigned char* HH = C.lds; LAS unsigned char* HL = C.lds + 16 * RP;
    LAS float* PART = (LAS float*)(C.lds + 2 * 16 * RP);
    LAS float* LOGI = PART + 8 * 16 * 48;
    LAS int* wcnt = (LAS int*)(C.lds + LDS_MISC + 256);
    const float* wg = a.router_wg + (size_t)l * 1024 * 4; const float* we = a.router_we + (size_t)l * 1024 * 32;
    const int lane = C.lane, wave = C.wave, fr = lane & 15, fq = lane >> 4;
    bf16x8 Wh[4][3], Wl[4][3];
#pragma unroll
    for (int ks = 0; ks < 4; ++ks)
#pragma unroll
        for (int ct = 0; ct < 3; ++ct) { const int cc = 16 * ct + fr; const int k0 = 128 * wave + 32 * ks + 8 * fq; unsigned hw[4], lw[4];
#pragma unroll
            for (int i = 0; i < 8; i += 2) { float v0 = 0.f, v1 = 0.f;
                if (cc < 4) { v0 = wg[(size_t)(k0 + i) * 4 + cc]; v1 = wg[(size_t)(k0 + i + 1) * 4 + cc]; }
                else if (cc < 36) { v0 = we[(size_t)(k0 + i) * 32 + cc - 4]; v1 = we[(size_t)(k0 + i + 1) * 32 + cc - 4]; }
                const unsigned hp = cvt_pk_bf16(v0, v1); hw[i >> 1] = hp; lw[i >> 1] = cvt_pk_bf16(v0 - bf_lo(hp), v1 - bf_hi(hp)); }
            Wh[ks][ct] = __builtin_bit_cast(bf16x8, (u32x4){hw[0], hw[1], hw[2], hw[3]}); Wl[ks][ct] = __builtin_bit_cast(bf16x8, (u32x4){lw[0], lw[1], lw[2], lw[3]}); }
    const float* MOD = (const float*)(a.ws + WS_MOD); bf16_t* H2 = (bf16_t*)(a.ws + WS_H2);
    const float* nw = a.norm2 + l * 1024; const float* bg = a.router_bg + l * 4; const float* be = a.router_be + l * 32;
    int* CNTBLK = (int*)(a.ws + WS_CNTBLK);
    for (int ch = C.vcu; ch < T / 128; ch += C.G) {
        int my_e0 = 0, my_e1 = 0; float my_w0 = 0.f, my_w1 = 0.f;
#pragma clang loop unroll(disable)
        for (int gi = 0; gi < 8; ++gi) {
            { const int row0 = ch * 128 + gi * 16 + 2 * wave; const int b = row0 >> 12;
              f32x4 v[2][4];
#pragma unroll
              for (int rr = 0; rr < 2; ++rr)
#pragma unroll
                  for (int q = 0; q < 4; ++q) v[rr][q] = *((const f32x4*)(a.out + (size_t)(row0 + rr) * 1024) + lane + 64 * q);
              const float* mb = MOD + (size_t)(l * 8 + b) * 6144 + 3072;
#pragma unroll
              for (int rr = 0; rr < 2; ++rr) { float ss = 0.f;
#pragma unroll
                  for (int q = 0; q < 4; ++q) ss += (v[rr][q][0] * v[rr][q][0] + v[rr][q][1] * v[rr][q][1]) + (v[rr][q][2] * v[rr][q][2] + v[rr][q][3] * v[rr][q][3]);
                  const float rstd = 1.0f / sqrtf(wave_sum(ss) * (1.0f / 1024.0f) + RMS_EPS);
#pragma unroll
                  for (int q = 0; q < 4; ++q) { const f32x4 g = *((const f32x4*)nw + lane + 64 * q), sh = *((const f32x4*)mb + lane + 64 * q), sc = *((const f32x4*)(mb + 1024) + lane + 64 * q);
                      const f32x4 h = v[rr][q] * rstd * g * (sc + 1.0f) + sh;
                      u32x2 hw; hw.x = cvt_pk_bf16(h[0], h[1]); hw.y = cvt_pk_bf16(h[2], h[3]);
                      u32x2 lw; lw.x = cvt_pk_bf16(h[0] - bf_lo(hw.x), h[1] - bf_hi(hw.x)); lw.y = cvt_pk_bf16(h[2] - bf_lo(hw.y), h[3] - bf_hi(hw.y));
                      *((u32x2*)(H2 + (size_t)(row0 + rr) * 1024) + lane + 64 * q) = hw;
                      *(LAS u32x2*)(HH + (2 * wave + rr) * RP + (4 * lane + 256 * q) * 2) = hw; *(LAS u32x2*)(HL + (2 * wave + rr) * RP + (4 * lane + 256 * q) * 2) = lw; } }
            }
            __syncthreads();
            { f32x4v acc[3]; acc[0] = (f32x4v){0.f, 0.f, 0.f, 0.f}; acc[1] = acc[0]; acc[2] = acc[0];
#pragma unroll
              for (int ks = 0; ks < 4; ++ks) { const int ko = (128 * wave + 32 * ks + 8 * fq) * 2;
                  const bf16x8 ah = *(const LAS bf16x8*)(HH + fr * RP + ko), al = *(const LAS bf16x8*)(HL + fr * RP + ko);
#pragma unroll
                  for (int ct = 0; ct < 3; ++ct) { acc[ct] = __builtin_amdgcn_mfma_f32_16x16x32_bf16(Wh[ks][ct], ah, acc[ct], 0, 0, 0);
                      acc[ct] = __builtin_amdgcn_mfma_f32_16x16x32_bf16(Wh[ks][ct], al, acc[ct], 0, 0, 0); acc[ct] = __builtin_amdgcn_mfma_f32_16x16x32_bf16(Wl[ks][ct], ah, acc[ct], 0, 0, 0); } }
#pragma unroll
              for (int ct = 0; ct < 3; ++ct) *(LAS f32x4v*)(PART + (wave * 16 + fr) * 48 + 16 * ct + 4 * fq) = acc[ct]; }
            __syncthreads();
            { const int row = C.tid >> 5, c = C.tid & 31;
              { float sacc = 0.f;
#pragma unroll
                for (int w = 0; w < 8; ++w) sacc += PART[(w * 16 + row) * 48 + c];
                LOGI[row * 48 + c] = sacc + (c < 4 ? bg[c] : be[c - 4]); }
              if (c < 4) { float sacc = 0.f;
#pragma unroll
                for (int w = 0; w < 8; ++w) sacc += PART[(w * 16 + row) * 48 + 32 + c];
                LOGI[row * 48 + 32 + c] = sacc + be[28 + c]; } }
            __syncthreads();
            if (wave == gi && lane < 16) { const LAS float* lg = LOGI + lane * 48;
                int grp = 0; float gmax = lg[0];
#pragma unroll
                for (int c = 1; c < 4; ++c) if (lg[c] > gmax) { gmax = lg[c]; grp = c; }
                float gs = 0.f;
#pragma unroll
                for (int c = 0; c < 4; ++c) gs += __builtin_amdgcn_exp2f((lg[c] - gmax) * LOG2E);
                const float pgrp = 1.0f / gs;
                float le[8];
#pragma unroll
                for (int e = 0; e < 8; ++e) le[e] = lg[4 + grp * 8 + e];
                int i0 = 0; float v0 = le[0];
#pragma unroll
                for (int e = 1; e < 8; ++e) if (le[e] > v0) { v0 = le[e]; i0 = e; }
                int i1 = -1; float v1 = -INFINITY;
#pragma unroll
                for (int e = 0; e < 8; ++e) if (e != i0 && le[e] > v1) { v1 = le[e]; i1 = e; }
                const float ex = __builtin_amdgcn_exp2f((v1 - v0) * LOG2E);
                my_e0 = grp * 8 + i0; my_e1 = grp * 8 + i1; my_w0 = pgrp / (1.0f + ex); my_w1 = pgrp * ex / (1.0f + ex); }
        }
        const int ea = bperm_i(C.lane >> 1, my_e0), eb = bperm_i(C.lane >> 1, my_e1);
        const int es = (C.lane < 32) ? ((C.lane & 1) ? eb : ea) : -1;
        int rank = 0, cnt = 0;
#pragma unroll
        for (int s2 = 0; s2 < 32; ++s2) { const int v = __builtin_amdgcn_readlane(es, s2); rank += (v == es && s2 < C.lane) ? 1 : 0; cnt += (v == C.lane) ? 1 : 0; }
        __syncthreads();
        if (C.lane < 32) wcnt[C.wave * 32 + C.lane] = cnt;
        __syncthreads();
        int lrank = rank;
        if (C.lane < 32) { for (int w = 0; w < C.wave; ++w) lrank += wcnt[w * 32 + es]; }
        if (C.wave == 0 && C.lane < 32) { int tot = 0;
#pragma unroll
            for (int w = 0; w < 8; ++w) tot += wcnt[w * 32 + C.lane];
            CNTBLK[ch * 32 + C.lane] = tot; }
        const int lr0 = bperm_i((2 * C.lane) & 63, lrank), lr1 = bperm_i((2 * C.lane + 1) & 63, lrank);
        if (C.lane < 16) { const int row = ch * 128 + C.wave * 16 + C.lane;
            u32x4 rec; rec.x = (unsigned)my_e0 | ((unsigned)my_e1 << 8); rec.y = (unsigned)lr0 | ((unsigned)lr1 << 16); rec.z = __float_as_uint(my_w0); rec.w = __float_as_uint(my_w1);
            *(u32x4*)(a.ws + WS_REC + (size_t)row * 16) = rec; }
    }
}
__device__ __forceinline__ void moe_scatter_phase(const Args& a, const Ctx& C) {
    LAS int* part_lt = (LAS int*)(C.lds);
    LAS int* part_all = part_lt + 512;
    LAS int* base = part_all + 512;
    LAS int* tot = base + 32;
    LAS int* pst = tot + 32;
    const int* CNTBLK = (const int*)(a.ws + WS_CNTBLK);
    int* TILEE = (int*)(a.ws + WS_TILEE);
    const bf16_t* H2 = (const bf16_t*)(a.ws + WS_H2); bf16_t* XS = (bf16_t*)(a.ws + WS_XS);
    for (int ch = C.vcu; ch < T / 128; ch += C.G) {
        __syncthreads();
        { const int e = C.tid & 31, p = C.tid >> 5; int slt = 0, sall = 0;
            for (int c = p; c < T / 128; c += 16) { const int v = CNTBLK[c * 32 + e]; sall += v; slt += (c < ch) ? v : 0; }
            part_lt[p * 32 + e] = slt; part_all[p * 32 + e] = sall; }
        __syncthreads();
        if (C.tid < 32) { int b = 0, t2 = 0;
#pragma unroll
            for (int p = 0; p < 16; ++p) { b += part_lt[p * 32 + C.tid]; t2 += part_all[p * 32 + C.tid]; }
            base[C.tid] = b; tot[C.tid] = t2; }
        __syncthreads();
        if (C.tid < 32) { int ps = 0; for (int e = 0; e < C.tid; ++e) ps += (tot[e] + 255) & ~255; pst[C.tid] = ps;
            if (ch == 0) { const int nt = (tot[C.tid] + 255) >> 8; const int t0 = ps >> 8; for (int m = 0; m < nt; ++m) TILEE[16 + t0 + m] = C.tid; if (C.tid == 31) TILEE[0] = t0 + nt; } }
        __syncthreads();
        int d0 = 0, d1 = 0;
        if (C.lane < 16) { const int row = ch * 128 + C.wave * 16 + C.lane;
            const u32x4 rec = *(const u32x4*)(a.ws + WS_REC + (size_t)row * 16);
            const int e0 = rec.x & 255, e1 = (rec.x >> 8) & 255;
            d0 = pst[e0] + base[e0] + (int)(rec.y & 0xffffu); d1 = pst[e1] + base[e1] + (int)(rec.y >> 16);
            u32x4 o; o.x = (unsigned)d0; o.y = (unsigned)d1; o.z = rec.z; o.w = rec.w;
            *(u32x4*)(a.ws + WS_DEST + (size_t)row * 16) = o; }
        for (int j = 0; j < 16; ++j) { const int row = ch * 128 + C.wave * 16 + j;
            const int t0 = __builtin_amdgcn_readlane(d0, j), t1 = __builtin_amdgcn_readlane(d1, j);
            const u32x4* src = (const u32x4*)(H2 + (size_t)row * 1024) + C.lane;
            const u32x4 va = src[0], vb = src[64];
            u32x4* o0 = (u32x4*)(XS + (size_t)t0 * 1024) + C.lane; u32x4* o1 = (u32x4*)(XS + (size_t)t1 * 1024) + C.lane;
            o0[0] = va; o0[64] = vb; o1[0] = va; o1[64] = vb; }
    }
}
struct MoeOrder {
    int G, c, nu; int ex[8]; const char* A; const char* B; size_t tA, tB, eB;
    __device__ __forceinline__ bool next(int i, pg8::Unit& u) const {
        const int L = i * G + c; if (i >= 8 || L >= nu) return false;
        const int e = i == 0 ? ex[0] : i == 1 ? ex[1] : i == 2 ? ex[2] : i == 3 ? ex[3] : i == 4 ? ex[4] : i == 5 ? ex[5] : i == 6 ? ex[6] : ex[7];
        u.pm = L >> 2; u.pn = L & 3; u.A = A + (size_t)u.pm * tA; u.B = B + (size_t)e * eB + (size_t)u.pn * tB; return true;
    }
};

__device__ __forceinline__ void dil_unit(const Args& a, const Ctx& C, int du) {
    using namespace att;
    LAS unsigned char* lds = C.lds;
    const int x = du & 15; int r = du >> 4; const int h = r & 3; r >>= 2; const int grp = r % 3, b = r / 3;
    const int dsh = 2 * grp, d = 1 << dsh; const int nub = 16 >> dsh; const int res = x / nub, ub = x % nub;
    const int wid = C.wave, lane = C.lane, r32 = lane & 31, hi = lane >> 5;
    LAS float* lut = (LAS float*)(lds + L_LUT);
    LAS unsigned char* tl = lds + L_SEL + 768;
    __syncthreads();
    for (int e = C.tid; e < 704; e += NTHR) { const int m = 384 - e; float v = -INFINITY;
        if (m >= 0 && m <= 128) { int di = m << dsh; di = di > 4095 ? 4095 : di; v = a.rel_bias[(int)lds[L_BKT + di] * 20 + 8 + grp * 4 + h] * LOG2E; }
        lut[e] = v; }
    if (C.tid < 6) { const int kt = 4 * ub - 2 + C.tid; tl[C.tid] = (unsigned char)(kt < 0 ? 0x80 : kt); }
    const bf16_t* QKV = (const bf16_t*)(a.ws + WS_A);
    const int u = 256 * ub + 32 * wid + r32; const size_t tokq = (size_t)b * SEQ + (size_t)u * d + res;
    const bf16_t* qp = QKV + tokq * LDQ + 1280 + grp * 256 + h * 64;
    bf16x8 qr[4];
#pragma unroll
    for (int d0 = 0; d0 < 4; ++d0) qr[d0] = *(const bf16x8*)(qp + d0 * 16 + hi * 8);
    __syncthreads();
    StreamP S; S.Kb = QKV + ((size_t)b * SEQ + res) * LDQ + 1280 + 768 + grp * 256 + h * 64; S.Vb = S.Kb + 768; S.pitch = (long)d * LDQ;
    S.NT = 6; S.tl = tl; S.lanesel = ~0ull; S.uq = u; S.lut = lut; S.xtop = 384; S.dclamp = 1 << 30;
    float m = 0.f, l = 0.f; f32x16 o[2];
    attn_stream<8>(lds, wid, lane, qr, S, m, l, o);
    l = xhalf_sum(l);
    LAS float* wsf = (LAS float*)(lds + L_WSF) + wid * 64;
    if (hi == 0) { wsf[r32] = l > 0.f ? 1.0f / l : 0.f; ((float*)(a.ws + WS_LSE))[((size_t)grp * T + tokq) * 4 + h] = m + __builtin_amdgcn_logf(l); }
    LDS_WAIT();
#pragma unroll
    for (int rr = 0; rr < 16; ++rr) { const float f = wsf[crow(rr, hi)]; o[0][rr] *= f; o[1][rr] *= f; }
    stage_rows(lds, wid, lane, o);
    bf16_t* ODP = (bf16_t*)(a.ws + WS_ODP) + (size_t)grp * T * 256;
    const LAS bf16_t* stg = (const LAS bf16_t*)(lds + L_OTA) + wid * 2048;
#pragma unroll
    for (int i = 0; i < 4; ++i) { const int row = i * 8 + (lane >> 3), chn = lane & 7; const u32x4 v = *(const LAS u32x4*)(stg + row * 64 + chn * 8);
        const size_t tok = (size_t)b * SEQ + (size_t)(256 * ub + 32 * wid + row) * d + res;
        *(u32x4*)(ODP + tok * 256 + h * 64 + chn * 8) = v; }
}
__device__ __forceinline__ void dil_combine(const Args& a, const Ctx& C) {
    const float* LSE = (const float*)(a.ws + WS_LSE); const bf16_t* ODP = (const bf16_t*)(a.ws + WS_ODP); bf16_t* ODIL = (bf16_t*)(a.ws + WS_ODIL);
    const int gt = C.vcu * NTHR + C.tid, NT = C.G * NTHR;
    for (int idx = gt; idx < T * 32; idx += NT) {
        const int tok = idx >> 5, h = (idx >> 3) & 3, chn = idx & 7;
        const float l0 = LSE[((size_t)0 * T + tok) * 4 + h], l1 = LSE[((size_t)1 * T + tok) * 4 + h], l2 = LSE[((size_t)2 * T + tok) * 4 + h];
        const float mx = __builtin_fmaxf(l0, __builtin_fmaxf(l1, l2));
        float w0 = __builtin_amdgcn_exp2f(l0 - mx), w1 = __builtin_amdgcn_exp2f(l1 - mx), w2 = __builtin_amdgcn_exp2f(l2 - mx);
        const float inv = 1.0f / (w0 + w1 + w2); w0 *= inv; w1 *= inv; w2 *= inv;
        const size_t off = (size_t)tok * 256 + h * 64 + chn * 8;
        const u32x4 a0 = *(const u32x4*)(ODP + off), a1 = *(const u32x4*)(ODP + (size_t)T * 256 + off), a2 = *(const u32x4*)(ODP + (size_t)2 * T * 256 + off);
        u32x4 o;
        o.x = cvt_pk_bf16(w0 * bf_lo(a0.x) + w1 * bf_lo(a1.x) + w2 * bf_lo(a2.x), w0 * bf_hi(a0.x) + w1 * bf_hi(a1.x) + w2 * bf_hi(a2.x));
        o.y = cvt_pk_bf16(w0 * bf_lo(a0.y) + w1 * bf_lo(a1.y) + w2 * bf_lo(a2.y), w0 * bf_hi(a0.y) + w1 * bf_hi(a1.y) + w2 * bf_hi(a2.y));
        o.z = cvt_pk_bf16(w0 * bf_lo(a0.z) + w1 * bf_lo(a1.z) + w2 * bf_lo(a2.z), w0 * bf_hi(a0.z) + w1 * bf_hi(a1.z) + w2 * bf_hi(a2.z));
        o.w = cvt_pk_bf16(w0 * bf_lo(a0.w) + w1 * bf_lo(a1.w) + w2 * bf_lo(a2.w), w0 * bf_hi(a0.w) + w1 * bf_hi(a1.w) + w2 * bf_hi(a2.w));
        if (ABL == 4) o = (u32x4){0u, 0u, 0u, 0u};
        *(u32x4*)(ODIL + off) = o;
    }
}
template <bool INIT>
__device__ __forceinline__ void ota_update(LAS bf16_t* ota  , const LAS float* frow, int hi, const f32x16 (&o)[2]) {
#pragma unroll
    for (int r = 0; r < 16; ++r) { const int row = crow(r, hi); const float f = frow[row];
        float v0 = f * o[0][r], v1 = f * o[1][r];
        if (!INIT) { v0 += __uint_as_float((unsigned)ota[row * 64] << 16); v1 += __uint_as_float((unsigned)ota[row * 64 + 32] << 16); }
        ota[row * 64] = (bf16_t)(cvt_pk_bf16(v0, 0.f) & 0xffffu); ota[row * 64 + 32] = (bf16_t)(cvt_pk_bf16(v1, 0.f) & 0xffffu); }
}
#define NSA_SECT() const int lane = lane_id_fresh(); const int tid = wid * 64 + lane; const int r32 = lane & 31, hi = lane >> 5; (void)tid; (void)r32; (void)hi
__device__ __forceinline__ void nsa_unit(const Args& a, const Ctx& C, int b, int hk, int i) {
    using namespace att;
    LAS unsigned char* lds = C.lds;
    const int wid = C.wave; const int g = wid >> 1;
    const bf16_t* QKV = (const bf16_t*)(a.ws + WS_A);
    bf16x8 qr[4];
    f32x16 o[2];
    __syncthreads();
    { NSA_SECT();
        const int tq = (wid & 1) * 32 + r32, t = 64 * i + tq; const size_t tok = (size_t)b * SEQ + t;
        LAS float* imp = (LAS float*)(lds + L_IMP); LAS float* gsh = (LAS float*)(lds + L_GSH) + wid * 96; LAS unsigned* selw = (LAS unsigned*)(lds + L_SEL);
        for (int e = tid; e < 64 * 64; e += NTHR) imp[e] = 0.f;
        if (tid < 2) selw[128 + tid] = 0u;
        if (hi == 0) { const float* gn = (const float*)(a.ws + WS_GN) + tok * 32 + hk * 4 + g;
            gsh[r32] = (ABL == 1) ? 0.f : gn[0]; gsh[32 + r32] = (ABL == 2) ? 0.f : gn[8]; gsh[64 + r32] = (ABL == 3) ? 0.f : gn[16]; }
        const bf16_t* qp = QKV + tok * LDQ + hk * 256 + g * 64;
#pragma unroll
        for (int d0 = 0; d0 < 4; ++d0) qr[d0] = *(const bf16x8*)(qp + d0 * 16 + hi * 8);
        __syncthreads();
        const bf16_t* KC = (const bf16_t*)(a.ws + WS_KC);
        cmp_branch(lds, wid, lane, qr, KC + (size_t)((0 * 8 + b) * 2 + hk) * 256 * 64, KC + (size_t)((1 * 8 + b) * 2 + hk) * 256 * 64, (4 * i + 2) / 64 + 1, t, o);
        ota_update<true>((LAS bf16_t*)(lds + L_OTA) + wid * 2048 + r32, gsh, hi, o);
    }
    __syncthreads();
    { NSA_SECT();
        LAS float* impP = (LAS float*)(lds + L_IMP); LAS unsigned* selw = (LAS unsigned*)(lds + L_SEL);
        const int q = tid >> 3, part = tid & 7;
        const int ncand = i - 2 > 0 ? i - 2 : 0; const int nforced = i + 1 < 3 ? i + 1 : 3; const int krem = 16 - nforced;
        unsigned bits = 0u;
        if (ncand > krem && ABL != 5) {
            float vn[8]; int cn[8];
#pragma unroll
            for (int e = 0; e < 8; ++e) { vn[e] = impP[q * 64 + part * 8 + e]; cn[e] = 0; }
            for (int mm = 1; mm <= i - 2; ++mm) { const float xv = impP[q * 64 + mm];
#pragma unroll
                for (int e = 0; e < 8; ++e) { const int n = part * 8 + e; cn[e] += (xv > vn[e] || (xv == vn[e] && mm < n)) ? 1 : 0; } }
#pragma unroll
            for (int e = 0; e < 8; ++e) { const int n = part * 8 + e; if (n >= 1 && n <= i - 2 && cn[e] < krem) bits |= 1u << e; }
        } else {
#pragma unroll
            for (int e = 0; e < 8; ++e) { const int n = part * 8 + e; if (n >= 1 && n <= i - 2) bits |= 1u << e; }
        }
#pragma unroll
        for (int e = 0; e < 8; ++e) { const int n = part * 8 + e; if (n == 0 || n == i || n == i - 1) bits |= 1u << e; }
        unsigned lo = part < 4 ? bits << (8 * part) : 0u, hi2 = part >= 4 ? bits << (8 * (part - 4)) : 0u;
        lo |= swz_xor_u<1>(lo); hi2 |= swz_xor_u<1>(hi2); lo |= swz_xor_u<2>(lo); hi2 |= swz_xor_u<2>(hi2); lo |= swz_xor_u<4>(lo); hi2 |= swz_xor_u<4>(hi2);
        if (part == 0) { selw[2 * q] = lo; selw[2 * q + 1] = hi2; atomicOr((unsigned*)&selw[128], lo); atomicOr((unsigned*)&selw[129], hi2); }
    }
    __syncthreads();
    int NTS, NTW;
    { NSA_SECT();
        LAS unsigned* selw = (LAS unsigned*)(lds + L_SEL);
        LAS unsigned char* tls = lds + L_SEL + 768; LAS unsigned char* tlw = lds + L_SEL + 848;
        const unsigned long long uni = ((unsigned long long)(unsigned)__builtin_amdgcn_readfirstlane((int)selw[129]) << 32) | (unsigned)__builtin_amdgcn_readfirstlane((int)selw[128]);
        const int nsel = __builtin_popcountll(uni); const int nts = (nsel + 1) & ~1; NTS = nts < 4 ? 4 : nts;
        const int jlo = i - 8 < 0 ? 0 : i - 8; const int nwin = i - jlo + 1; const int ntw = (nwin + 1) & ~1; NTW = ntw < 4 ? 4 : ntw;
        if (tid < 64) { if ((uni >> tid) & 1ull) tls[__builtin_popcountll(uni & ((1ull << tid) - 1ull))] = (unsigned char)tid; }
        else if (tid < 72) { const int k = nsel + (tid - 64); if (k < NTS) tls[k] = 0x80; }
        else if (tid < 88) { const int k = tid - 72; if (k < NTW) tlw[k] = (unsigned char)(k < nwin ? jlo + k : 0x80); }
    }
    __syncthreads();
#pragma clang loop unroll(disable)
    for (int br = 0; br < 2; ++br) {
        float m = 0.f, l = 0.f;
        { NSA_SECT();
            const int tq = (wid & 1) * 32 + r32, t = 64 * i + tq;
            LAS unsigned* selw = (LAS unsigned*)(lds + L_SEL); LAS float* lut = (LAS float*)(lds + L_LUT);
            StreamP S; S.Kb = QKV + (size_t)b * SEQ * LDQ + 512 + 256 + br * 256 + hk * 64; S.Vb = S.Kb + 128; S.pitch = LDQ;
            S.NT = br ? NTW : NTS; S.tl = lds + L_SEL + (br ? 848 : 768); S.uq = t;
            S.lanesel = br ? ~0ull : (((unsigned long long)selw[2 * tq + 1] << 32) | selw[2 * tq]);
            S.lut = br ? lut + 7168 + g * 768 : lut + g * 1792; S.xtop = br ? 640 : 1636; S.dclamp = br ? (1 << 30) : 1636;
            attn_stream<8>(lds, wid, lane, qr, S, m, l, o);
        }
        { NSA_SECT();
            LAS float* gsh = (LAS float*)(lds + L_GSH) + wid * 96; LAS float* wsf = (LAS float*)(lds + L_WSF) + wid * 64;
            l = xhalf_sum(l);
            LDS_WAIT();
            if (hi == 0) wsf[r32] = (l > 0.f ? 1.0f / l : 0.f) * gsh[32 + br * 32 + r32];
            LDS_WAIT();
            ota_update<false>((LAS bf16_t*)(lds + L_OTA) + wid * 2048 + r32, wsf, hi, o);
        }
    }
    { NSA_SECT();
        LDS_WAIT();
        bf16_t* ONSA = (bf16_t*)(a.ws + WS_ONSA);
        const LAS bf16_t* stg = (const LAS bf16_t*)(lds + L_OTA) + wid * 2048;
#pragma unroll
        for (int k = 0; k < 4; ++k) { const int row = k * 8 + (lane >> 3), chn = lane & 7; const u32x4 v = *(const LAS u32x4*)(stg + row * 64 + chn * 8);
            const size_t tk = (size_t)b * SEQ + 64 * i + (wid & 1) * 32 + row;
            *(u32x4*)(ONSA + tk * 512 + hk * 256 + g * 64 + chn * 8) = v; }
    }
}
__device__ __forceinline__ void build_bkt(const Ctx& C) {
    LAS unsigned char* bkt = C.lds + att::L_BKT; LAS unsigned char* bkc = C.lds + att::L_BKC;
    for (int d = C.tid; d < 4096; d += NTHR) bkt[d] = (unsigned char)att::bucket_of(d);
    for (int x = C.tid; x < 8704; x += NTHR) { const int dist = 4095 - x; bkc[x] = (unsigned char)(dist < 0 ? 128 : 4 * att::bucket_of(dist)); }
    __syncthreads();
}
__device__ __forceinline__ void build_nsa_tables(const Args& a, const Ctx& C, int hk) {
    using namespace att;
    LAS float* tbh = (LAS float*)(C.lds + L_TBH); LAS float* lut = (LAS float*)(C.lds + L_LUT);
    __syncthreads();
    if (C.tid < 144) { const int gg = C.tid / 36, bk = C.tid % 36; tbh[C.tid] = bk < 32 ? a.rel_bias[bk * 20 + hk * 4 + gg] * LOG2E : -INFINITY; }
    __syncthreads();
    for (int e = C.tid; e < 4 * 1792; e += NTHR) { const int gg = e / 1792, xx = e % 1792; const int dist = 1636 - xx;
        lut[e] = dist < 0 ? -INFINITY : tbh[gg * 36 + (int)C.lds[L_BKT + dist]]; }
    for (int e = C.tid; e < 4 * 768; e += NTHR) { const int gg = e / 768, xx = e % 768; const int dist = 640 - xx;
        lut[7168 + e] = (dist < 0 || dist > 512) ? -INFINITY : tbh[gg * 36 + (int)C.lds[L_BKT + dist]]; }
    __syncthreads();
}

typedef const Args __attribute__((address_space(4)))* CArgsP;
__device__ __forceinline__ Args load_args() {
#if defined(__HIP_DEVICE_COMPILE__)
    CArgsP p = (CArgsP)__builtin_amdgcn_kernarg_segment_ptr(); asm volatile("" : "+s"(p)); Args a;
    a.x = p->x; a.c = p->c; a.rel_bias = p->rel_bias; a.ada_w = p->ada_w; a.ada_b = p->ada_b; a.norm1 = p->norm1; a.norm2 = p->norm2; a.w_in = p->w_in;
    a.cmp_pos = p->cmp_pos; a.cmp_w1 = p->cmp_w1; a.cmp_w2 = p->cmp_w2; a.w_up_nsa = p->w_up_nsa; a.w_up_dil = p->w_up_dil; a.w_o = p->w_o;
    a.router_wg = p->router_wg; a.router_bg = p->router_bg; a.router_we = p->router_we; a.router_be = p->router_be; a.exp_w1 = p->exp_w1; a.exp_w3 = p->exp_w3; a.exp_w2 = p->exp_w2; a.norm_f = p->norm_f;
    a.out = p->out; a.ws = p->ws; a.ph_lo = p->ph_lo; a.ph_hi = p->ph_hi; a.use_bar = p->use_bar; a.pad = 0;
    return a;
#else
    return Args{};
#endif
}
#define LOADA() const Args a = load_args()
__global__ void __launch_bounds__(NTHR, 2) fwd_kernel(Args a_) {
    extern __shared__ __attribute__((aligned(16))) unsigned char lds_raw[];
    LAS unsigned char* const lds_base = (LAS unsigned char*)lds_raw;
    const int wave0_ = __builtin_amdgcn_readfirstlane((int)threadIdx.x >> 6);
#define FRESH() Ctx C; { int w_ = wave0_; asm volatile("" : "+s"(w_)); int t_ = lane_id_fresh(); asm volatile("" : "+v"(t_)); t_ += w_ * 64; int g_ = gridDim.x, b_ = blockIdx.x; asm volatile("" : "+s"(g_), "+s"(b_)); \
        C.lds = lds_base; C.tid = t_; C.lane = t_ & 63; C.wave = w_; C.G = g_; C.bx = b_; C.vcu = (g_ % 8 == 0) ? (b_ % 8) * (g_ / 8) + b_ / 8 : b_; }
    volatile LAS unsigned* MISC = (volatile LAS unsigned*)(lds_base + LDS_MISC);
    if (threadIdx.x < 64) MISC[threadIdx.x] = 0u;
    __syncthreads();
    unsigned* ctl = (unsigned*)(a_.ws + WS_CTL);
    XcdBarrier bar; bar.bar = ctl + CW_BAR; bar.x = 0; bar.st = nullptr;
    if (a_.use_bar) bar = xcd_barrier_post(ctl + CW_BAR, MISC + 8);
    const int lo = a_.ph_lo, hi = a_.ph_hi;
#ifndef PH_MASK
#define PH_MASK 0xFFFFFFFFu
#endif
#define IN(k) (((PH_MASK >> ((k) == 0 ? 10 : (k) == 21 ? 11 : (((k) - 1) % 10))) & 1u) && lo <= (k) && (k) < hi)
#define SEAM(k) do { if (IN(k) && IN((k) + 1)) { XcdBarrier b2_ = bar; asm volatile("" : "+s"(b2_.bar)); int w2_ = wave0_; asm volatile("" : "+s"(w2_)); xcd_barrier(b2_, w2_ == 0 && lane_id_fresh() == 0); } } while (0)
    if (IN(0)) REPEAT(10) { __syncthreads(); FRESH(); LOADA(); prologue_vectors(a, C); conv_small(a, C); conv_experts(a, C, 0); }
    SEAM(0);
    _Pragma("unroll") for (int l = 0; l < 2; ++l) {
        const int pb = 1 + 10 * l;
        if (IN(pb + 0)) REPEAT(0) { FRESH(); LOADA(); norm1_phase(a, C, l); if (l == 1) conv_experts(a, C, 1); }
        SEAM(pb + 0);
        if (IN(pb + 1)) REPEAT(1) { FRESH(); LOADA(); unsigned char* ws = a.ws;
            pg8::Gemm g{2048u, 2048u, 128u, 1024}; pg8::DenseOrder S; S.init(T, NIN, C.G, C.bx, ws + WS_H, 2048u, ws + WS_WINT + (size_t)l * NIN * DM * 2, 2048u);
            EpiInProj E{(bf16_t*)(ws + WS_A), (bf16_t*)(ws + WS_MG), (float*)(ws + WS_GN)};
            pg8::gemm_phase<EpiInProj, pg8::DenseOrder, true>(C.lds, C.tid, g, S, E);
        }
        SEAM(pb + 1);
        if (IN(pb + 2)) REPEAT(2) { FRESH(); LOADA(); unsigned char* ws = a.ws;
            struct CmpOrder { int c; const char* A; const char* B;
                __device__ __forceinline__ bool next(int i, pg8::Unit& u) const { if (i > 0 || c >= 32) return false; const int kv = c >> 4, b = (c >> 1) & 7, hk = c & 1;
                    u.pm = c; u.pn = 0; u.A = A + ((size_t)b * SEQ * LDQ + 512 + kv * 128 + hk * 64) * 2; u.B = B + (size_t)kv * 256 * 2048 * 2; return true; } };
            pg8::Gemm g{(unsigned)(16 * LDQ * 2), 4096u, (unsigned)(LDQ * 2), 2048};
            CmpOrder S{C.vcu, (const char*)(ws + WS_A), (const char*)(ws + WS_CW1T + (size_t)l * 2 * 256 * 2048 * 2)};
            EpiCmp E{(bf16_t*)(ws + WS_HID), (const float*)(ws + WS_CB1) + l * 512, (const bf16_t*)(ws + WS_CW2T) + (size_t)l * 2 * 64 * 256, (bf16_t*)(ws + WS_KC)};
            pg8::gemm_phase<EpiCmp, CmpOrder, false>(C.lds, C.tid, g, S, E);
            __syncthreads();
            build_bkt(C);
            for (;;) { __syncthreads();
                if (C.tid == 0) *(volatile LAS int*)(C.lds + LDS_MISC + 512) = (int)__hip_atomic_fetch_add((unsigned*)(ws + WS_CTL) + CW_Q + l, 1u, __ATOMIC_RELAXED, __HIP_MEMORY_SCOPE_AGENT);
                __syncthreads();
                const int du = __builtin_amdgcn_readfirstlane(*(volatile LAS int*)(C.lds + LDS_MISC + 512));
                if (du >= 1536) break;
                dil_unit(a, C, du); }
        }
        SEAM(pb + 2);
        if (IN(pb + 3)) REPEAT(3) { FRESH(); LOADA();
            dil_combine(a, C);
            build_bkt(C);
            int cur_hk = -1;
            for (int v = C.vcu; v < 256; v += C.G) { const int b = v >> 5, hk = (v >> 4) & 1, s = v & 15;
                if (hk != cur_hk) { build_nsa_tables(a, C, hk); cur_hk = hk; }
                for (int k = 0; k < 4; ++k) { const int qi = (k == 0) ? s : (k == 1) ? 31 - s : (k == 2) ? 32 + s : 63 - s; nsa_unit(a, C, b, hk, qi); } }
            __syncthreads();
        }
        SEAM(pb + 3);
        if (IN(pb + 4)) REPEAT(4) { FRESH(); LOADA(); unsigned char* ws = a.ws;
            pg8::Gemm g{1024u, 1024u, 128u, 512, 512u, 512u, 256}; pg8::DenseOrder S; S.init(T, 1024, C.G, C.bx, ws + WS_ONSA, 1024u, ws + WS_WUNT + (size_t)l * 1024 * 512 * 2, 1024u);
            S.A2 = (const char*)(ws + WS_ODIL); S.B2 = (const char*)(ws + WS_WUDT + (size_t)l * 1024 * 256 * 2); S.tA2 = (size_t)256 * 512; S.tB2 = (size_t)256 * 512;
            EpiUpFused E{(bf16_t*)(ws + WS_MERGED), (const bf16_t*)(ws + WS_MG)};
            pg8::gemm_phase<EpiUpFused, pg8::DenseOrder, true, true>(C.lds, C.tid, g, S, E);
        }
        SEAM(pb + 4);
        if (IN(pb + 5)) REPEAT(5) { FRESH(); LOADA(); unsigned char* ws = a.ws;
            pg8::Gemm g{2048u, 2048u, 128u, 1024}; pg8::DenseOrder S; S.init(T, 1024, C.G, C.bx, ws + WS_MERGED, 2048u, ws + WS_WOT + (size_t)l * 1024 * 1024 * 2, 2048u);
            EpiOut E{l == 0 ? a.x : (const float*)a.out, a.out, (const float*)(ws + WS_MOD) + (size_t)l * 8 * 6144 + 2048};
            pg8::gemm_phase<EpiOut, pg8::DenseOrder, true>(C.lds, C.tid, g, S, E);
        }
        SEAM(pb + 5);
        if (IN(pb + 6)) REPEAT(6) { FRESH(); LOADA(); norm2_router_phase(a, C, l); }
        SEAM(pb + 6);
        if (IN(pb + 7)) REPEAT(7) { FRESH(); LOADA(); moe_scatter_phase(a, C); }
        SEAM(pb + 7);
        if (IN(pb + 8)) REPEAT(8) { FRESH(); LOADA(); unsigned char* ws = a.ws;
            const int* TILEE = (const int*)(ws + WS_TILEE); const int ntl = TILEE[0];
            MoeOrder S; S.G = C.G; S.c = C.vcu; S.nu = ntl * 4; S.A = (const char*)(ws + WS_XS); S.B = (const char*)(ws + WS_E13T); S.tA = (size_t)256 * 2048; S.tB = (size_t)256 * 2048; S.eB = (size_t)1024 * 2048;
#pragma unroll
            for (int i = 0; i < 8; ++i) { const int L = i * C.G + C.vcu; S.ex[i] = (L < S.nu) ? TILEE[16 + (L >> 2)] : 0; }
            pg8::Gemm g{2048u, 2048u, 128u, 1024};
            EpiMoe1 E{(bf16_t*)(ws + WS_ACT)};
            pg8::gemm_phase<EpiMoe1, MoeOrder, true>(C.lds, C.tid, g, S, E);
        }
        SEAM(pb + 8);
        if (IN(pb + 9)) REPEAT(9) { FRESH(); LOADA(); unsigned char* ws = a.ws;
            const int* TILEE = (const int*)(ws + WS_TILEE); const int ntl = TILEE[0];
            MoeOrder S; S.G = C.G; S.c = C.vcu; S.nu = ntl * 4; S.A = (const char*)(ws + WS_ACT); S.B = (const char*)(ws + WS_E2T); S.tA = (size_t)256 * 1024; S.tB = (size_t)256 * 1024; S.eB = (size_t)1024 * 1024;
#pragma unroll
            for (int i = 0; i < 8; ++i) { const int L = i * C.G + C.vcu; S.ex[i] = (L < S.nu) ? TILEE[16 + (L >> 2)] : 0; }
            pg8::Gemm g{1024u, 1024u, 128u, 512};
            EpiPlain E{(bf16_t*)(ws + WS_XS), 1024};
            pg8::gemm_phase<EpiPlain, MoeOrder, true>(C.lds, C.tid, g, S, E);
        }
        SEAM(pb + 9);
    }
    if (IN(21)) { FRESH(); LOADA(); final_phase(a, C); }
#undef IN
#undef SEAM
}

#ifndef ONE_LAUNCH
#define ONE_LAUNCH 1
#endif
extern "C" void kernel_launch(void* const* d_in, const int* in_sizes, int n_in, void* d_out, int out_size, void* d_ws, size_t ws_size, hipStream_t stream) {
    static int grid = 0;
    if (grid == 0) {
        if (n_in != 22 || out_size != T * DM || ws_size < WS_END) { fprintf(stderr, "kernel_launch: unexpected problem (n_in %d out %d ws %zu)\n", n_in, out_size, ws_size); grid = -1; return; }
        int dev = 0, cus = 0;
        if (hipGetDevice(&dev) != hipSuccess || hipDeviceGetAttribute(&cus, hipDeviceAttributeMultiprocessorCount, dev) != hipSuccess) { grid = -1; return; }
        if (hipFuncSetAttribute((const void*)fwd_kernel, hipFuncAttributeMaxDynamicSharedMemorySize, LDS_BYTES) != hipSuccess) { fprintf(stderr, "kernel_launch: hipFuncSetAttribute failed\n"); grid = -1; return; }
        int per_cu = 0;
        if (hipOccupancyMaxActiveBlocksPerMultiprocessor(&per_cu, (const void*)fwd_kernel, NTHR, LDS_BYTES) != hipSuccess || per_cu < 1) { fprintf(stderr, "kernel_launch: occupancy query reports %d\n", per_cu); }
        (void)hipGetLastError();
        grid = cus;
    }
    if (grid < 0) return;
    (void)hipMemsetAsync((char*)d_ws + WS_CTL, 0, CTL_ZERO_BYTES, stream);
    Args a{};
    a.x = (const float*)d_in[0]; a.c = (const float*)d_in[1]; a.rel_bias = (const float*)d_in[2]; a.ada_w = (const float*)d_in[3]; a.ada_b = (const float*)d_in[4];
    a.norm1 = (const float*)d_in[5]; a.norm2 = (const float*)d_in[6]; a.w_in = (const float*)d_in[7]; a.cmp_pos = (const float*)d_in[8]; a.cmp_w1 = (const float*)d_in[9];
    a.cmp_w2 = (const float*)d_in[10]; a.w_up_nsa = (const float*)d_in[11]; a.w_up_dil = (const float*)d_in[12]; a.w_o = (const float*)d_in[13];
    a.router_wg = (const float*)d_in[14]; a.router_bg = (const float*)d_in[15]; a.router_we = (const float*)d_in[16]; a.router_be = (const float*)d_in[17];
    a.exp_w1 = (const float*)d_in[18]; a.exp_w3 = (const float*)d_in[19]; a.exp_w2 = (const float*)d_in[20]; a.norm_f = (const float*)d_in[21];
    a.out = (float*)d_out; a.ws = (unsigned char*)d_ws; a.pad = 0;
#if ONE_LAUNCH
    a.ph_lo = 0; a.ph_hi = NPHASE; a.use_bar = 1;
    hipLaunchKernelGGL(fwd_kernel, dim3(grid), dim3(NTHR), LDS_BYTES, stream, a);
#else
    for (int p = 0; p < NPHASE; ++p) { a.ph_lo = p; a.ph_hi = p + 1; a.use_bar = 0;
        hipLaunchKernelGGL(fwd_kernel, dim3(grid), dim3(NTHR), LDS_BYTES, stream, a); }
#endif
}
```

```cpp
#include <hip/hip_runtime.h>
#include <cstdint>
#include <cstdio>

#define GAS __attribute__((address_space(1)))
#define LAS __attribute__((address_space(3)))
typedef unsigned short bf16_t;
typedef short bf16x8 __attribute__((ext_vector_type(8)));
typedef short s16x4 __attribute__((ext_vector_type(4)));
typedef float f32x4 __attribute__((ext_vector_type(4)));
typedef float f32x2 __attribute__((ext_vector_type(2)));
typedef float f32x16 __attribute__((ext_vector_type(16)));
typedef unsigned u32x4 __attribute__((ext_vector_type(4)));
typedef unsigned u32x2 __attribute__((ext_vector_type(2)));
typedef __bf16 bf16x2_t __attribute__((ext_vector_type(2)));

constexpr int NB = 8, SEQ = 4096, DM = 1024, T = NB * SEQ;
constexpr int LDQ = 3584;
constexpr int NIN = 5888;
constexpr int INW = 5656;
constexpr float LOG2E = 1.4426950408889634f;
constexpr float C2 = 0.125f * LOG2E;
constexpr int NWAVES = 8, NTHR = 512;
constexpr float RMS_EPS = 1e-6f;
constexpr int NPHASE = 22;
#ifndef ABL
#define ABL 0
#endif
#ifndef REP_MASK
#define REP_MASK 0u
#endif
#ifndef TMASK
#define TMASK 0u
#endif
#define TAMP 8ull
#ifndef TNSA
#define TNSA 0
#endif
#define REPEAT(k) _Pragma("clang loop unroll(disable)") for (int rep_ = 0; rep_ < (int)((REP_MASK >> (k)) & 1u) + 1; ++rep_)

constexpr size_t MiB = 1u << 20;
constexpr size_t WS_CTL = 0, CTL_ZERO_BYTES = MiB;
constexpr size_t WS_MOD = 1 * MiB;
constexpr size_t WS_CB1 = WS_MOD + 400 * 1024;
constexpr size_t WS_CW2T = WS_MOD + 512 * 1024;
constexpr size_t WS_CNTBLK = WS_MOD + 768 * 1024;
constexpr size_t WS_TILEE = WS_MOD + 832 * 1024;
constexpr size_t WS_WINT = 4 * MiB;
constexpr size_t WS_CW1T = 27 * MiB;
constexpr size_t WS_WUNT = 31 * MiB;
constexpr size_t WS_WUDT = 33 * MiB;
constexpr size_t WS_WOT = 34 * MiB;
constexpr size_t WS_E13T = 38 * MiB;
constexpr size_t WS_E2T = 102 * MiB;
constexpr size_t WS_A = 134 * MiB;
constexpr size_t WS_XS = WS_A;
constexpr size_t WS_ACT = WS_A + 144 * MiB;
constexpr size_t WS_MERGED = WS_A;
constexpr size_t WS_MG = 359 * MiB;
constexpr size_t WS_H2 = WS_MG;
constexpr size_t WS_REC = WS_MG + 64 * MiB;
constexpr size_t WS_DEST = WS_MG + 65 * MiB;
constexpr size_t WS_TOKL = WS_MG + 66 * MiB;
constexpr size_t WS_B = 487 * MiB;
constexpr size_t WS_H = WS_B;
constexpr size_t WS_ONSA = WS_B;
constexpr size_t WS_ODP = WS_B + 32 * MiB;
constexpr size_t WS_LSE = WS_B + 80 * MiB;
constexpr size_t WS_ODIL = WS_B + 82 * MiB;
constexpr size_t WS_GN = WS_B + 98 * MiB;
constexpr size_t WS_KC = WS_B + 102 * MiB;
constexpr size_t WS_HID = WS_B + 103 * MiB;
constexpr size_t WS_END = WS_B + 107 * MiB;

constexpr int CW_TMO = 0, CW_BAR = 4096, CW_Q = 8192;

constexpr int LDS_MISC = 158784;
constexpr int LDS_BYTES = 158784 + 2048;

__device__ __forceinline__ unsigned cvt_pk_bf16(float lo, float hi) { f32x2 v = {lo, hi}; bf16x2_t b = __builtin_convertvector(v, bf16x2_t); return __builtin_bit_cast(unsigned, b); }
__device__ __forceinline__ float bf_lo(unsigned w) { return __uint_as_float(w << 16); }
__device__ __forceinline__ float bf_hi(unsigned w) { return __uint_as_float(w & 0xffff0000u); }
__device__ __forceinline__ float sigmoidf_(float x) { return __builtin_amdgcn_rcpf(1.0f + __builtin_amdgcn_exp2f(-x * LOG2E)); }
__device__ __forceinline__ int lane_id_fresh() { unsigned ones = ~0u; asm volatile("" : "+s"(ones)); return (int)__builtin_amdgcn_mbcnt_hi(ones, __builtin_amdgcn_mbcnt_lo(ones, 0u)); }
template <int X> __device__ __forceinline__ float swz_xor_f(float v) { return __int_as_float(__builtin_amdgcn_ds_swizzle(__float_as_int(v), (X << 10) | 0x1f)); }
template <int X> __device__ __forceinline__ unsigned swz_xor_u(unsigned v) { return (unsigned)__builtin_amdgcn_ds_swizzle((int)v, (X << 10) | 0x1f); }
__device__ __forceinline__ float wave_sum(float v) {
    v += swz_xor_f<1>(v); v += swz_xor_f<2>(v); v += swz_xor_f<4>(v); v += swz_xor_f<8>(v); v += swz_xor_f<16>(v);
    auto rr = __builtin_amdgcn_permlane32_swap(__float_as_uint(v), __float_as_uint(v), false, false);
    return __uint_as_float(rr[0]) + __uint_as_float(rr[1]);
}
__device__ __forceinline__ int bperm_i(int srclane, int v) { return __builtin_amdgcn_ds_bpermute(srclane << 2, v); }
#define LDS_WAIT() asm volatile("s_waitcnt lgkmcnt(0)" ::: "memory")
#define VM_WAIT() asm volatile("s_waitcnt vmcnt(0)" ::: "memory")

#define XB_TMO      128
#define XB_XCNT(j)  (256  + 64 * (j))
#define XB_XSUB(j)  (1280 + 64 * (j))
#define XB_XGEN(j)  (2304 + 64 * (j))
#define XB_TOP      3328
#define XB_TOPGEN   3392
#define XCD_BAR_WORDS 3456
#define XB_SPIN_CAP (1u << 20)
__device__ __forceinline__ unsigned xb_ld(unsigned* p)              { return __hip_atomic_load(p, __ATOMIC_RELAXED, __HIP_MEMORY_SCOPE_AGENT); }
__device__ __forceinline__ unsigned xb_add(unsigned* p, unsigned v) { return __hip_atomic_fetch_add(p, v, __ATOMIC_RELAXED, __HIP_MEMORY_SCOPE_AGENT); }
__device__ __forceinline__ unsigned xb_xcc_id() { return (unsigned)__builtin_amdgcn_s_getreg((3 << 11) | 20) & 0xFu; }
#define XB_SPIN(cond, bar) do { unsigned _sp = 0; while (cond) { __builtin_amdgcn_s_sleep(1); \
    if ((++_sp & 255u) == 0u) { if (xb_ld(&(bar)[XB_TMO])) break; if (_sp > XB_SPIN_CAP) { atomicAdd(&(bar)[XB_TMO], 1u); break; } } } } while (0)
struct XcdBarrier { unsigned* bar; unsigned x; volatile LAS unsigned* st; };
__device__ __forceinline__ XcdBarrier xcd_barrier_post(unsigned* bar, volatile LAS unsigned* st) {
    XcdBarrier b; b.bar = bar; b.x = xb_xcc_id(); b.st = st;
    if (threadIdx.x == 0) (void)xb_add(&bar[XB_XCNT(b.x)], 1u);
    return b;
}
__device__ __forceinline__ void xcd_barrier_complete(unsigned* bar, unsigned x, unsigned& nloc, unsigned& nx) {
    const unsigned G = gridDim.x * gridDim.y * gridDim.z;
    unsigned sum, cnt, mine, sp = 0u;
    for (;;) {
        sum = 0u; cnt = 0u; mine = 0u;
#pragma unroll
        for (unsigned j = 0; j < 16; ++j) { const unsigned c = xb_ld(&bar[XB_XCNT(j)]); sum += c; cnt += (c > 0u) ? 1u : 0u; mine = (j == x) ? c : mine; }
        if (sum == G) break;
        __builtin_amdgcn_s_sleep(1);
        if ((++sp & 255u) == 0u) { if (xb_ld(&bar[XB_TMO])) break; if (sp > XB_SPIN_CAP) { atomicAdd(&bar[XB_TMO], 1u); break; } }
    }
    nloc = mine > 0u ? mine : 1u; nx = cnt > 0u ? cnt : 1u;
}
__device__ __forceinline__ void xcd_barrier(const XcdBarrier& b, const bool leader_thread) {
    asm volatile("s_waitcnt vmcnt(0)" ::: "memory");
    __syncthreads();
    if (leader_thread) {
        unsigned* bar = b.bar;
        __builtin_amdgcn_s_waitcnt(0);
        unsigned nloc = b.st[0], nx = b.st[1];
        if (nloc == 0u) { xcd_barrier_complete(bar, b.x, nloc, nx); b.st[0] = nloc; b.st[1] = nx; }
        const unsigned old = xb_add(&bar[XB_XSUB(b.x)], 1u);
        const unsigned gen = old / nloc;
        if (old + 1u == (gen + 1u) * nloc) {
            __builtin_amdgcn_fence(__ATOMIC_RELEASE, "agent");
            asm volatile("s_waitcnt vmcnt(0)" ::: "memory");
            const unsigned og = xb_add(&bar[XB_TOP], 1u);
            const unsigned tg = og / nx;
            if (og + 1u == (tg + 1u) * nx) xb_add(&bar[XB_TOPGEN], 1u);
            else XB_SPIN(xb_ld(&bar[XB_TOPGEN]) == tg, bar);
            __builtin_amdgcn_fence(__ATOMIC_ACQUIRE, "agent");
            xb_add(&bar[XB_XGEN(b.x)], 1u);
            asm volatile("s_waitcnt vmcnt(0)" ::: "memory");
        } else {
            XB_SPIN(xb_ld(&bar[XB_XGEN(b.x)]) == gen, bar);
            __builtin_amdgcn_fence(__ATOMIC_ACQUIRE, "agent");
            asm volatile("s_waitcnt vmcnt(0)" ::: "memory");
        }
    }
    __syncthreads();
}

namespace pg8 {
constexpr int BM = 256, BK = 64, HALF = 128, HTB = HALF * BK * 2, STAGE_BYTES = 8 * HTB;
__device__ __forceinline__ int lds_byte(int r, int c) { const int st = (r >> 4) * 2 + (c >> 5), rr = r & 15, cc = c & 31, ob = rr * 64 + cc * 2; return st * 1024 + (ob ^ (((ob >> 9) & 1) << 5)); }
__device__ __forceinline__ void stage_rc(int b, int& R, int& C) { const int st = b / 1024, sb = b % 1024, swz = sb ^ (((sb >> 9) & 1) << 5); R = (st >> 1) * 16 + swz / 64; C = (st & 1) * 32 + (swz % 64) / 2; }
__device__ __forceinline__ int perm32(int rho) { const int n = rho >> 4, i = rho & 15; return 8 * (i >> 2) + 4 * n + (i & 3); }

struct Unit { const char* A; const char* B; int pm, pn; const char* A2; const char* B2; };
struct Gemm { unsigned lda, ldb, kstepA; int K; unsigned lda2, ldb2; int K2; const int* tokl; const char* Abase; };

template <class Epi, class Sched, bool ALIGN_EPI, bool SEG2 = false, bool GATHER = false>
__device__ __forceinline__ void gemm_phase(LAS unsigned char* lds, const int tid, const Gemm g, const Sched& S, const Epi& E) {
    const int wid = __builtin_amdgcn_readfirstlane(tid >> 6), lane = tid & 63, wr = wid >> 2, wc = wid & 3, fr = lane & 15, fq = lane >> 4;
    const int nt0 = g.K / BK; const int nt = nt0 + (SEG2 ? g.K2 / BK : 0);
    unsigned voffA[2], voffB[2], voffA2[2], voffB2[2]; int Rrow[2]; unsigned Cb[2];
#pragma unroll
    for (int i = 0; i < 2; ++i) { int R, C; stage_rc(tid * 16 + i * 8192, R, C); Rrow[i] = R; Cb[i] = (unsigned)C * 2u; const int Rb = Epi::PERM ? ((R & ~31) + perm32(R & 31)) : R;
        voffA[i] = (unsigned)R * g.lda + (unsigned)C * 2u; voffB[i] = (unsigned)Rb * g.ldb + (unsigned)C * 2u;
        voffA2[i] = SEG2 ? (unsigned)R * g.lda2 + (unsigned)C * 2u : 0u; voffB2[i] = SEG2 ? (unsigned)Rb * g.ldb2 + (unsigned)C * 2u : 0u; }
    const size_t kstepA = (size_t)g.kstepA, kstepB = (size_t)(BK * 2);
    const size_t hstepA = (size_t)HALF * g.lda, hstepB = (size_t)HALF * g.ldb;
    const size_t hstepA2 = SEG2 ? (size_t)HALF * g.lda2 : 0, hstepB2 = SEG2 ? (size_t)HALF * g.ldb2 : 0;
    const unsigned ldsw = (unsigned)wid * 1024u;
    const int aoff = lds_byte(wr * 64 + fr, fq * 8), boff = lds_byte(wc * 32 + fr, fq * 8);
#define PG8_SA(b, h) (((b) * 2 + (h)) * HTB)
#define PG8_SB(b, h) ((4 + (b) * 2 + (h)) * HTB)
#define PG8_STAGE(bufoff, gbase, voff) do { _Pragma("unroll") for (int _i = 0; _i < 2; ++_i) \
        __builtin_amdgcn_global_load_lds((const unsigned*)((const char*)(gbase) + (voff)[_i]), (LAS unsigned*)(lds + (bufoff) + ldsw + _i * 8192), 16, 0, 0); } while (0)
#define PG8_STAGE2(bufoff, gbase, sel, v0, v1) do { _Pragma("unroll") for (int _i = 0; _i < 2; ++_i) \
        __builtin_amdgcn_global_load_lds((const unsigned*)((const char*)(gbase) + ((sel) ? (v1)[_i] : (v0)[_i])), (LAS unsigned*)(lds + (bufoff) + ldsw + _i * 8192), 16, 0, 0); } while (0)
#define PG8_LDA(dst, b, h) do { _Pragma("unroll") for (int m = 0; m < 4; ++m) _Pragma("unroll") for (int k = 0; k < 2; ++k) dst[m][k] = *(const LAS bf16x8*)(lds + PG8_SA(b, h) + aoff + m * 2048 + k * 1024); } while (0)
#define PG8_LDB(dst, b, h) do { _Pragma("unroll") for (int n = 0; n < 2; ++n) _Pragma("unroll") for (int k = 0; k < 2; ++k) dst[n][k] = *(const LAS bf16x8*)(lds + PG8_SB(b, h) + boff + n * 2048 + k * 1024); } while (0)
#define PG8_MMA(ai, bj, At, Bt) do { __builtin_amdgcn_s_setprio(1); _Pragma("unroll") for (int m = 0; m < 4; ++m) _Pragma("unroll") for (int n = 0; n < 2; ++n) _Pragma("unroll") for (int k = 0; k < 2; ++k) \
        acc[ai][bj][m][n] = __builtin_amdgcn_mfma_f32_16x16x32_bf16(Bt[n][k], At[m][k], acc[ai][bj][m][n], 0, 0, 0); __builtin_amdgcn_s_setprio(0); } while (0)
#define PG8_WAIT_V(n) asm volatile("s_waitcnt vmcnt(" #n ")" ::: "memory")
#define PG8_WAIT_L(n) asm volatile("s_waitcnt lgkmcnt(" #n ")" ::: "memory")
#define PG8_BAR __builtin_amdgcn_s_barrier()
#define PG8_SCHED __builtin_amdgcn_sched_barrier(0)
    Unit cur, nxt; int ui = 0;
    if (!S.next(0, cur)) return;
    f32x4 acc[2][2][4][2];
#pragma unroll
    for (int a = 0; a < 2; ++a)
#pragma unroll
        for (int b = 0; b < 2; ++b)
#pragma unroll
            for (int m = 0; m < 4; ++m)
#pragma unroll
                for (int n = 0; n < 2; ++n) acc[a][b][m][n] = (f32x4){0.f, 0.f, 0.f, 0.f};
    bf16x8 At[4][2], B0[2][2], B1[2][2];
    const char* cA = GATHER ? g.Abase : cur.A; const char* cB = cur.B;
    unsigned vC0[2], vC1[2], vN0[2], vN1[2];
#define PG8_GLOAD(U, d0, d1) do { _Pragma("unroll") for (int _i = 0; _i < 2; ++_i) { \
        d0[_i] = (unsigned)g.tokl[(U).pm * 256 + Rrow[_i]] * g.lda + Cb[_i]; d1[_i] = (unsigned)g.tokl[(U).pm * 256 + 128 + Rrow[_i]] * g.lda + Cb[_i]; } } while (0)
    if constexpr (GATHER) { PG8_GLOAD(cur, vC0, vC1); }
    if constexpr (GATHER) {
        PG8_STAGE(PG8_SB(0, 0), cB, voffB); PG8_STAGE(PG8_SB(0, 1), cB + hstepB, voffB); PG8_STAGE(PG8_SA(0, 0), cA, vC0); PG8_STAGE(PG8_SA(0, 1), cA, vC1);
        if (wr == 1) PG8_BAR;
        PG8_WAIT_V(2); PG8_BAR;
        PG8_STAGE(PG8_SB(1, 0), cB + kstepB, voffB); PG8_STAGE(PG8_SA(1, 0), cA + kstepA, vC0); PG8_STAGE(PG8_SB(1, 1), cB + hstepB + kstepB, voffB);
        PG8_WAIT_V(6); PG8_BAR;
    } else {
    PG8_STAGE(PG8_SB(0, 0), cB, voffB); PG8_STAGE(PG8_SB(0, 1), cB + hstepB, voffB); PG8_STAGE(PG8_SA(0, 0), cA, voffA); PG8_STAGE(PG8_SA(0, 1), cA + hstepA, voffA);
    if (wr == 1) PG8_BAR;
    PG8_WAIT_V(2); PG8_BAR;
    PG8_STAGE(PG8_SB(1, 0), cB + kstepB, voffB); PG8_STAGE(PG8_SA(1, 0), cA + kstepA, voffA); PG8_STAGE(PG8_SB(1, 1), cB + hstepB + kstepB, voffB);
    PG8_WAIT_V(6); PG8_BAR;
    }
    for (;;) {
        const bool has_next = S.next(ui + 1, nxt);
        const char* nA = GATHER ? cA : (has_next ? nxt.A : cA); const char* nB = has_next ? nxt.B : cB;
        if constexpr (GATHER) { if (has_next) { PG8_GLOAD(nxt, vN0, vN1); } else { vN0[0] = vC0[0]; vN0[1] = vC0[1]; vN1[0] = vC1[0]; vN1[1] = vC1[1]; } }
        for (int t = 0; t < nt; t += 2) {
            const bool last = (t == nt - 2);
            if constexpr (SEG2) {
                const bool s1 = (t >= nt0);
                const bool s2 = !last && (t + 2 >= nt0);
                if (t == nt0) E.mid(acc, cur, wr, wc, fr, fq);
                const char* a1 = s1 ? cur.A2 + (size_t)(t + 1 - nt0) * kstepB : cA + (size_t)(t + 1) * kstepA; const size_t h1 = s1 ? hstepA2 : hstepA;
                const char* a2 = last ? nA : (s2 ? cur.A2 + (size_t)(t + 2 - nt0) * kstepB : cA + (size_t)(t + 2) * kstepA);
                const char* b2 = last ? nB : (s2 ? cur.B2 + (size_t)(t + 2 - nt0) * kstepB : cB + (size_t)(t + 2) * kstepB);
                const char* a3 = a2 + (s2 ? kstepB : kstepA); const char* b3 = b2 + kstepB;
                const size_t hA2 = s2 ? hstepA2 : hstepA, hB2 = s2 ? hstepB2 : hstepB;
                PG8_LDB(B0, 0, 0); PG8_LDB(B1, 0, 1); PG8_SCHED; PG8_LDA(At, 0, 0); PG8_STAGE2(PG8_SA(1, 1), a1 + h1, s1, voffA, voffA2);
                PG8_WAIT_V(8); PG8_WAIT_L(0); PG8_BAR; PG8_MMA(0, 0, At, B0); PG8_MMA(0, 1, At, B1); PG8_BAR; PG8_SCHED;
                PG8_LDA(At, 0, 1); PG8_STAGE2(PG8_SB(0, 0), b2, s2, voffB, voffB2); PG8_STAGE2(PG8_SB(0, 1), b2 + hB2, s2, voffB, voffB2); PG8_STAGE2(PG8_SA(0, 0), a2, s2, voffA, voffA2);
                PG8_WAIT_V(8); PG8_WAIT_L(0); PG8_BAR; PG8_MMA(1, 0, At, B0); PG8_MMA(1, 1, At, B1); PG8_BAR; PG8_SCHED;
                PG8_LDB(B0, 1, 0); PG8_LDB(B1, 1, 1); PG8_SCHED; PG8_LDA(At, 1, 0); PG8_STAGE2(PG8_SA(0, 1), a2 + hA2, s2, voffA, voffA2);
                PG8_WAIT_V(8); PG8_WAIT_L(0); PG8_BAR; PG8_MMA(0, 0, At, B0); PG8_MMA(0, 1, At, B1); PG8_BAR; PG8_SCHED;
                PG8_LDA(At, 1, 1); PG8_STAGE2(PG8_SB(1, 0), b3, s2, voffB, voffB2); PG8_STAGE2(PG8_SB(1, 1), b3 + hB2, s2, voffB, voffB2); PG8_STAGE2(PG8_SA(1, 0), a3, s2, voffA, voffA2);
                PG8_WAIT_V(8); PG8_WAIT_L(0); PG8_BAR; PG8_MMA(1, 0, At, B0); PG8_MMA(1, 1, At, B1); PG8_BAR; PG8_SCHED;
            } else if constexpr (GATHER) {
            const char* a1 = cA + (size_t)(t + 1) * kstepA;
            const char* a2 = last ? cA : cA + (size_t)(t + 2) * kstepA; const char* b2 = last ? nB : cB + (size_t)(t + 2) * kstepB;
            const char* a3 = a2 + kstepA; const char* b3 = b2 + kstepB;
            unsigned w0[2], w1[2]; w0[0] = last ? vN0[0] : vC0[0]; w0[1] = last ? vN0[1] : vC0[1]; w1[0] = last ? vN1[0] : vC1[0]; w1[1] = last ? vN1[1] : vC1[1];
            PG8_LDB(B0, 0, 0); PG8_LDB(B1, 0, 1); PG8_SCHED; PG8_LDA(At, 0, 0); PG8_STAGE(PG8_SA(1, 1), a1, vC1);
            PG8_WAIT_V(8); PG8_WAIT_L(0); PG8_BAR; PG8_MMA(0, 0, At, B0); PG8_MMA(0, 1, At, B1); PG8_BAR; PG8_SCHED;
            PG8_LDA(At, 0, 1); PG8_STAGE(PG8_SB(0, 0), b2, voffB); PG8_STAGE(PG8_SB(0, 1), b2 + hstepB, voffB); PG8_STAGE(PG8_SA(0, 0), a2, w0);
            PG8_WAIT_V(8); PG8_WAIT_L(0); PG8_BAR; PG8_MMA(1, 0, At, B0); PG8_MMA(1, 1, At, B1); PG8_BAR; PG8_SCHED;
            PG8_LDB(B0, 1, 0); PG8_LDB(B1, 1, 1); PG8_SCHED; PG8_LDA(At, 1, 0); PG8_STAGE(PG8_SA(0, 1), a2, w1);
            PG8_WAIT_V(8); PG8_WAIT_L(0); PG8_BAR; PG8_MMA(0, 0, At, B0); PG8_MMA(0, 1, At, B1); PG8_BAR; PG8_SCHED;
            PG8_LDA(At, 1, 1); PG8_STAGE(PG8_SB(1, 0), b3, voffB); PG8_STAGE(PG8_SB(1, 1), b3 + hstepB, voffB); PG8_STAGE(PG8_SA(1, 0), a3, w0);
            PG8_WAIT_V(8); PG8_WAIT_L(0); PG8_BAR; PG8_MMA(1, 0, At, B0); PG8_MMA(1, 1, At, B1); PG8_BAR; PG8_SCHED;
            } else {
            const char* a1 = cA + (size_t)(t + 1) * kstepA;
            const char* a2 = last ? nA : cA + (size_t)(t + 2) * kstepA; const char* b2 = last ? nB : cB + (size_t)(t + 2) * kstepB;
            const char* a3 = a2 + kstepA; const char* b3 = b2 + kstepB;
            PG8_LDB(B0, 0, 0); PG8_LDB(B1, 0, 1); PG8_SCHED; PG8_LDA(At, 0, 0); PG8_STAGE(PG8_SA(1, 1), a1 + hstepA, voffA);
            PG8_WAIT_V(8); PG8_WAIT_L(0); PG8_BAR; PG8_MMA(0, 0, At, B0); PG8_MMA(0, 1, At, B1); PG8_BAR; PG8_SCHED;
            PG8_LDA(At, 0, 1); PG8_STAGE(PG8_SB(0, 0), b2, voffB); PG8_STAGE(PG8_SB(0, 1), b2 + hstepB, voffB); PG8_STAGE(PG8_SA(0, 0), a2, voffA);
            PG8_WAIT_V(8); PG8_WAIT_L(0); PG8_BAR; PG8_MMA(1, 0, At, B0); PG8_MMA(1, 1, At, B1); PG8_BAR; PG8_SCHED;
            PG8_LDB(B0, 1, 0); PG8_LDB(B1, 1, 1); PG8_SCHED; PG8_LDA(At, 1, 0); PG8_STAGE(PG8_SA(0, 1), a2 + hstepA, voffA);
            PG8_WAIT_V(8); PG8_WAIT_L(0); PG8_BAR; PG8_MMA(0, 0, At, B0); PG8_MMA(0, 1, At, B1); PG8_BAR; PG8_SCHED;
            PG8_LDA(At, 1, 1); PG8_STAGE(PG8_SB(1, 0), b3, voffB); PG8_STAGE(PG8_SB(1, 1), b3 + hstepB, voffB); PG8_STAGE(PG8_SA(1, 0), a3, voffA);
            PG8_WAIT_V(8); PG8_WAIT_L(0); PG8_BAR; PG8_MMA(1, 0, At, B0); PG8_MMA(1, 1, At, B1); PG8_BAR; PG8_SCHED;
            }
        }
        if constexpr (ALIGN_EPI) { if (wr == 0) PG8_BAR; }
        if constexpr (!Epi::AFTER_DRAIN) { E(acc, cur, wr, wc, fr, fq); }
        if (!has_next) break;
#pragma unroll
        for (int a = 0; a < 2; ++a)
#pragma unroll
            for (int b = 0; b < 2; ++b)
#pragma unroll
                for (int m = 0; m < 4; ++m)
#pragma unroll
                    for (int n = 0; n < 2; ++n) acc[a][b][m][n] = (f32x4){0.f, 0.f, 0.f, 0.f};
        cur = nxt; cA = nA; cB = nB; ++ui;
        if constexpr (GATHER) { vC0[0] = vN0[0]; vC0[1] = vN0[1]; vC1[0] = vN1[0]; vC1[1] = vN1[1]; }
        if constexpr (ALIGN_EPI) { if (wr == 1) PG8_BAR; }
    }
    PG8_WAIT_V(0);
    if constexpr (!ALIGN_EPI) { if (wr == 0) PG8_BAR; }
    PG8_BAR;
    if constexpr (Epi::AFTER_DRAIN) { E.fused(acc, cur, wr, wc, fr, fq, wid, lane); }
#undef PG8_SA
#undef PG8_SB
#undef PG8_STAGE
#undef PG8_STAGE2
#undef PG8_GLOAD
#undef PG8_LDA
#undef PG8_LDB
#undef PG8_MMA
#undef PG8_WAIT_V
#undef PG8_WAIT_L
#undef PG8_BAR
#undef PG8_SCHED
}

struct DenseOrder {
    int nM, nN, nwg, G, c; const char* A; const char* B; size_t tA, tB; const char* A2 = nullptr; const char* B2 = nullptr; size_t tA2 = 0, tB2 = 0;
    __device__ __forceinline__ void init(int M, int N, int G_, int c_, const void* A_, unsigned lda, const void* B_, unsigned ldb) {
        nM = M / BM; nN = N / BM; nwg = nM * nN; G = G_; c = c_; A = (const char*)A_; B = (const char*)B_; tA = (size_t)BM * lda; tB = (size_t)BM * ldb; }
    __device__ __forceinline__ bool next(int i, Unit& u) const {
        const long L = (long)i * G + c; if (L >= nwg) return false;
        int wgid = (int)L; { const int q = nwg / 8, r = nwg % 8, xcd = wgid % 8, off = wgid / 8; wgid = (xcd < r ? xcd * (q + 1) : r * (q + 1) + (xcd - r) * q) + off; }
        const int nig = 8 * nN, gid = wgid / nig, fm = gid * 8, gsz = (nM - fm) < 8 ? (nM - fm) : 8;
        u.pm = fm + ((wgid % nig) % gsz); u.pn = (wgid % nig) / gsz;
        u.A = A + (size_t)u.pm * tA; u.B = B + (size_t)u.pn * tB; u.A2 = A2 + (size_t)u.pm * tA2; u.B2 = B2 + (size_t)u.pn * tB2; return true;
    }
};
}

struct Args {
    const float* x; const float* c; const float* rel_bias; const float* ada_w; const float* ada_b; const float* norm1; const float* norm2; const float* w_in;
    const float* cmp_pos; const float* cmp_w1; const float* cmp_w2; const float* w_up_nsa; const float* w_up_dil; const float* w_o;
    const float* router_wg; const float* router_bg; const float* router_we; const float* router_be; const float* exp_w1; const float* exp_w3; const float* exp_w2; const float* norm_f;
    float* out; unsigned char* ws; int ph_lo, ph_hi, use_bar, pad;
};

typedef f32x4 AccT[2][2][4][2];
__device__ __forceinline__ unsigned q8(float x) { return (unsigned)(sigmoidf_(x) * 255.0f + 0.5f); }
struct EpiInProj {
    static constexpr bool PERM = true, AFTER_DRAIN = false;
    bf16_t* QKV; unsigned char* MG; float* GN;
    __device__ __forceinline__ void operator()(const AccT& acc, const pg8::Unit& u, int wr, int wc, int fr, int fq) const {
        const int pn = u.pn; const int row0 = u.pm * 256 + wr * 64 + fr;
        if (pn < 14) {
            const float sc = (pn < 2 || (pn >= 5 && pn < 8)) ? C2 : 1.0f;
            const int col0 = pn * 256 + wc * 32 + 8 * fq;
#pragma unroll
            for (int ai = 0; ai < 2; ++ai)
#pragma unroll
                for (int m = 0; m < 4; ++m) { bf16_t* rowp = QKV + (size_t)(row0 + ai * 128 + m * 16) * LDQ + col0;
#pragma unroll
                    for (int bj = 0; bj < 2; ++bj) { const f32x4 v0 = acc[ai][bj][m][0] * sc, v1 = acc[ai][bj][m][1] * sc; u32x4 w;
                        w.x = cvt_pk_bf16(v0[0], v0[1]); w.y = cvt_pk_bf16(v0[2], v0[3]); w.z = cvt_pk_bf16(v1[0], v1[1]); w.w = cvt_pk_bf16(v1[2], v1[3]);
                        *(u32x4*)(rowp + bj * 128) = w; } }
        } else if (pn < 22) {
            const int col0 = (pn - 14) * 256 + wc * 32 + 8 * fq;
#pragma unroll
            for (int ai = 0; ai < 2; ++ai)
#pragma unroll
                for (int m = 0; m < 4; ++m) { unsigned char* rowp = MG + (size_t)(row0 + ai * 128 + m * 16) * 2048 + col0;
#pragma unroll
                    for (int bj = 0; bj < 2; ++bj) { const f32x4 v0 = acc[ai][bj][m][0], v1 = acc[ai][bj][m][1]; u32x2 w;
                        w.x = q8(v0[0]) | (q8(v0[1]) << 8) | (q8(v0[2]) << 16) | (q8(v0[3]) << 24); w.y = q8(v1[0]) | (q8(v1[1]) << 8) | (q8(v1[2]) << 16) | (q8(v1[3]) << 24);
                        *(u32x2*)(rowp + bj * 128) = w; } }
        } else {
            if (wc == 0 && fq < 3) {
#pragma unroll
                for (int ai = 0; ai < 2; ++ai)
#pragma unroll
                    for (int m = 0; m < 4; ++m) { float* rowp = GN + (size_t)(row0 + ai * 128 + m * 16) * 32 + 8 * fq;
                        const f32x4 v0 = acc[ai][0][m][0], v1 = acc[ai][0][m][1];
                        *(f32x4*)(rowp) = (f32x4){sigmoidf_(v0[0]), sigmoidf_(v0[1]), sigmoidf_(v0[2]), sigmoidf_(v0[3])};
                        *(f32x4*)(rowp + 4) = (f32x4){sigmoidf_(v1[0]), sigmoidf_(v1[1]), sigmoidf_(v1[2]), sigmoidf_(v1[3])}; }
            }
        }
    }
};
template <int PASS> struct EpiUp {
    static constexpr bool PERM = true, AFTER_DRAIN = false;
    bf16_t* MERGED; const bf16_t* MG;
    __device__ __forceinline__ void operator()(const AccT& acc, const pg8::Unit& u, int wr, int wc, int fr, int fq) const {
        const int row0 = u.pm * 256 + wr * 64 + fr; const int col0 = u.pn * 256 + wc * 32 + 8 * fq;
#pragma unroll
        for (int ai = 0; ai < 2; ++ai)
#pragma unroll
            for (int m = 0; m < 4; ++m) { const size_t row = (size_t)(row0 + ai * 128 + m * 16);
#pragma unroll
                for (int bj = 0; bj < 2; ++bj) {
                    const u32x4 gw = *(const u32x4*)(MG + row * 2048 + PASS * 1024 + col0 + bj * 128);
                    bf16_t* op = MERGED + row * 1024 + col0 + bj * 128;
                    const f32x4 v0 = acc[ai][bj][m][0], v1 = acc[ai][bj][m][1];
                    float r[8] = {v0[0] * bf_lo(gw.x), v0[1] * bf_hi(gw.x), v0[2] * bf_lo(gw.y), v0[3] * bf_hi(gw.y), v1[0] * bf_lo(gw.z), v1[1] * bf_hi(gw.z), v1[2] * bf_lo(gw.w), v1[3] * bf_hi(gw.w)};
                    if (PASS == 1) { const u32x4 ow = *(const u32x4*)op;
                        r[0] += bf_lo(ow.x); r[1] += bf_hi(ow.x); r[2] += bf_lo(ow.y); r[3] += bf_hi(ow.y); r[4] += bf_lo(ow.z); r[5] += bf_hi(ow.z); r[6] += bf_lo(ow.w); r[7] += bf_hi(ow.w); }
                    u32x4 w; w.x = cvt_pk_bf16(r[0], r[1]); w.y = cvt_pk_bf16(r[2], r[3]); w.z = cvt_pk_bf16(r[4], r[5]); w.w = cvt_pk_bf16(r[6], r[7]);
                    *(u32x4*)op = w; }
                asm volatile("" ::: "memory"); }
    }
};
struct EpiUpFused {
    static constexpr bool PERM = true, AFTER_DRAIN = false;
    bf16_t* MERGED; const unsigned char* MG;
    __device__ __forceinline__ void mid(AccT& acc, const pg8::Unit& u, int wr, int wc, int fr, int fq) const {
        const int row0 = u.pm * 256 + wr * 64 + fr; const int col0 = u.pn * 256 + wc * 32 + 8 * fq;
#pragma unroll
        for (int ai = 0; ai < 2; ++ai)
#pragma unroll
            for (int m = 0; m < 4; ++m) { const size_t row = (size_t)(row0 + ai * 128 + m * 16);
#pragma unroll
                for (int bj = 0; bj < 2; ++bj) {
                    const u32x2 g0 = *(const u32x2*)(MG + row * 2048 + col0 + bj * 128), g1 = *(const u32x2*)(MG + row * 2048 + 1024 + col0 + bj * 128);
                    f32x4& v0 = acc[ai][bj][m][0]; f32x4& v1 = acc[ai][bj][m][1];
#pragma unroll
                    for (int j = 0; j < 4; ++j) { const float a0 = (float)((g0.x >> (8 * j)) & 255u), b0 = (float)((g1.x >> (8 * j)) & 255u), a1 = (float)((g0.y >> (8 * j)) & 255u), b1 = (float)((g1.y >> (8 * j)) & 255u);
                        v0[j] *= a0 * __builtin_amdgcn_rcpf(__builtin_fmaxf(b0, 0.5f)); v1[j] *= a1 * __builtin_amdgcn_rcpf(__builtin_fmaxf(b1, 0.5f)); } }
                asm volatile("" ::: "memory"); }
    }
    __device__ __forceinline__ void operator()(const AccT& acc, const pg8::Unit& u, int wr, int wc, int fr, int fq) const {
        const int row0 = u.pm * 256 + wr * 64 + fr; const int col0 = u.pn * 256 + wc * 32 + 8 * fq;
#pragma unroll
        for (int ai = 0; ai < 2; ++ai)
#pragma unroll
            for (int m = 0; m < 4; ++m) { const size_t row = (size_t)(row0 + ai * 128 + m * 16);
#pragma unroll
                for (int bj = 0; bj < 2; ++bj) {
                    const u32x2 g1 = *(const u32x2*)(MG + row * 2048 + 1024 + col0 + bj * 128);
                    const f32x4 v0 = acc[ai][bj][m][0], v1 = acc[ai][bj][m][1]; float r[8];
#pragma unroll
                    for (int j = 0; j < 4; ++j) { r[j] = v0[j] * (__builtin_fmaxf((float)((g1.x >> (8 * j)) & 255u), 0.5f) * (1.0f / 255.0f)); r[4 + j] = v1[j] * (__builtin_fmaxf((float)((g1.y >> (8 * j)) & 255u), 0.5f) * (1.0f / 255.0f)); }
                    u32x4 w; w.x = cvt_pk_bf16(r[0], r[1]); w.y = cvt_pk_bf16(r[2], r[3]); w.z = cvt_pk_bf16(r[4], r[5]); w.w = cvt_pk_bf16(r[6], r[7]);
                    *(u32x4*)(MERGED + row * 1024 + col0 + bj * 128) = w; }
                asm volatile("" ::: "memory"); }
    }
};
struct EpiOut {
    static constexpr bool PERM = true, AFTER_DRAIN = false;
    const float* xin; float* xout; const float* g1;
    __device__ __forceinline__ void operator()(const AccT& acc, const pg8::Unit& u, int wr, int wc, int fr, int fq) const {
        const int row0 = u.pm * 256 + wr * 64 + fr; const int col0 = u.pn * 256 + wc * 32 + 8 * fq; const int b = u.pm >> 4;
        f32x4 gv[2][2];
#pragma unroll
        for (int bj = 0; bj < 2; ++bj)
#pragma unroll
            for (int n = 0; n < 2; ++n) gv[bj][n] = *(const f32x4*)(g1 + (size_t)b * 6144 + col0 + bj * 128 + 4 * n);
#pragma unroll
        for (int ai = 0; ai < 2; ++ai)
#pragma unroll
            for (int m = 0; m < 4; ++m) { const size_t off = (size_t)(row0 + ai * 128 + m * 16) * 1024 + col0;
#pragma unroll
                for (int bj = 0; bj < 2; ++bj)
#pragma unroll
                    for (int n = 0; n < 2; ++n) { const f32x4 xv = *(const f32x4*)(xin + off + bj * 128 + 4 * n);
                        *(f32x4*)(xout + off + bj * 128 + 4 * n) = (ABL == 7) ? xv : xv + gv[bj][n] * acc[ai][bj][m][n]; }
                asm volatile("" ::: "memory"); }
    }
};
struct EpiMoe1 {
    static constexpr bool PERM = true, AFTER_DRAIN = false;
    bf16_t* ACT;
    __device__ __forceinline__ void operator()(const AccT& acc, const pg8::Unit& u, int wr, int wc, int fr, int fq) const {
        const int row0 = u.pm * 256 + wr * 64 + fr; const int col0 = u.pn * 128 + wc * 32 + 8 * fq;
#pragma unroll
        for (int ai = 0; ai < 2; ++ai)
#pragma unroll
            for (int m = 0; m < 4; ++m) { bf16_t* op = ACT + (size_t)(row0 + ai * 128 + m * 16) * 512 + col0; float r[8];
#pragma unroll
                for (int n = 0; n < 2; ++n)
#pragma unroll
                    for (int j = 0; j < 4; ++j) { const float a = acc[ai][0][m][n][j], bb = acc[ai][1][m][n][j]; r[n * 4 + j] = a * sigmoidf_(a) * bb; }
                u32x4 w; w.x = cvt_pk_bf16(r[0], r[1]); w.y = cvt_pk_bf16(r[2], r[3]); w.z = cvt_pk_bf16(r[4], r[5]); w.w = cvt_pk_bf16(r[6], r[7]);
                *(u32x4*)op = w; }
    }
};
struct EpiPlain {
    static constexpr bool PERM = true, AFTER_DRAIN = false;
    bf16_t* O; int ldc;
    __device__ __forceinline__ void operator()(const AccT& acc, const pg8::Unit& u, int wr, int wc, int fr, int fq) const {
        const int row0 = u.pm * 256 + wr * 64 + fr; const int col0 = u.pn * 256 + wc * 32 + 8 * fq;
#pragma unroll
        for (int ai = 0; ai < 2; ++ai)
#pragma unroll
            for (int m = 0; m < 4; ++m) { bf16_t* rowp = O + (size_t)(row0 + ai * 128 + m * 16) * ldc + col0;
#pragma unroll
                for (int bj = 0; bj < 2; ++bj) { const f32x4 v0 = acc[ai][bj][m][0], v1 = acc[ai][bj][m][1]; u32x4 w;
                    w.x = cvt_pk_bf16(v0[0], v0[1]); w.y = cvt_pk_bf16(v0[2], v0[3]); w.z = cvt_pk_bf16(v1[0], v1[1]); w.w = cvt_pk_bf16(v1[2], v1[3]);
                    *(u32x4*)(rowp + bj * 128) = w; } }
    }
};
__device__ __forceinline__ int crow(int r, int hi) { return (r & 3) + 8 * (r >> 2) + 4 * hi; }
__device__ __forceinline__ float gelu_tanh(float x) { const float u2 = 2.0f * 0.7978845608028654f * (x + 0.044715f * x * x * x); return x * __builtin_amdgcn_rcpf(1.0f + __builtin_amdgcn_exp2f(-u2 * LOG2E)); }
struct EpiCmp {
    static constexpr bool PERM = true, AFTER_DRAIN = true;
    bf16_t* HID; const float* CB1; const bf16_t* CW2T; bf16_t* KC;
    __device__ __forceinline__ void fused(const AccT& acc, const pg8::Unit& u, int wr, int wc, int fr, int fq, int wid, int lane) const {
        const int kv = u.pm >> 4; const int row0 = u.pm * 256 + wr * 64 + fr; const int col0 = wc * 32 + 8 * fq;
        const float* bias = CB1 + kv * 256;
        f32x4 bv[2][2];
#pragma unroll
        for (int bj = 0; bj < 2; ++bj)
#pragma unroll
            for (int n = 0; n < 2; ++n) bv[bj][n] = *(const f32x4*)(bias + col0 + bj * 128 + 4 * n);
#pragma unroll
        for (int ai = 0; ai < 2; ++ai)
#pragma unroll
            for (int m = 0; m < 4; ++m) { bf16_t* rowp = HID + (size_t)(row0 + ai * 128 + m * 16) * 256 + col0;
#pragma unroll
                for (int bj = 0; bj < 2; ++bj) { const f32x4 v0 = acc[ai][bj][m][0] + bv[bj][0], v1 = acc[ai][bj][m][1] + bv[bj][1]; u32x4 w;
                    w.x = cvt_pk_bf16(gelu_tanh(v0[0]), gelu_tanh(v0[1])); w.y = cvt_pk_bf16(gelu_tanh(v0[2]), gelu_tanh(v0[3]));
                    w.z = cvt_pk_bf16(gelu_tanh(v1[0]), gelu_tanh(v1[1])); w.w = cvt_pk_bf16(gelu_tanh(v1[2]), gelu_tanh(v1[3]));
                    *(u32x4*)(rowp + bj * 128) = w; } }
        VM_WAIT(); __syncthreads();
        const int r32 = lane & 31, hi = lane >> 5;
        const bf16_t* ap = HID + (size_t)(u.pm * 256 + 32 * wid + r32) * 256 + hi * 8;
        const bf16_t* bp = CW2T + (size_t)kv * 64 * 256 + (size_t)r32 * 256 + hi * 8;
        f32x16 o0 = {}, o1 = {};
#pragma unroll 4
        for (int ks = 0; ks < 16; ++ks) {
            const bf16x8 a = *(const bf16x8*)(ap + ks * 16);
            const bf16x8 b0 = *(const bf16x8*)(bp + ks * 16), b1 = *(const bf16x8*)(bp + 32 * 256 + ks * 16);
            o0 = __builtin_amdgcn_mfma_f32_32x32x16_bf16(a, b0, o0, 0, 0, 0);
            o1 = __builtin_amdgcn_mfma_f32_32x32x16_bf16(a, b1, o1, 0, 0, 0);
        }
        bf16_t* kc = KC + (size_t)u.pm * 256 * 64;
#pragma unroll
        for (int r = 0; r < 16; ++r) { const int c = 32 * wid + crow(r, hi); const bool pad = (c == 255);
            kc[(size_t)c * 64 + r32] = pad ? (bf16_t)0 : (bf16_t)(cvt_pk_bf16(o0[r], 0.f) & 0xffffu);
            kc[(size_t)c * 64 + 32 + r32] = pad ? (bf16_t)0 : (bf16_t)(cvt_pk_bf16(o1[r], 0.f) & 0xffffu); }
    }
};

namespace att {
constexpr int L_KR = 0;
constexpr int L_VR = 24576;
constexpr int L_WSF = 49152;
constexpr int L_BKT = 51200;
constexpr int L_BKC = 55296;
constexpr int L_TBH = 64000;
constexpr int L_GSH = 64576;
constexpr int L_SEL = 67648;
constexpr int L_OTA = 68672;
constexpr int L_IMP = 101440;
constexpr int L_LUT = 117824;
constexpr int L_END = L_LUT + 40960;
static_assert(L_END <= LDS_MISC, "attention LDS map");

__device__ __forceinline__ void glds16(const void* gsrc, unsigned lds_dst) { unsigned keep;
    asm volatile("s_mov_b32 %0, m0\n\ts_mov_b32 m0, %2\n\ts_nop 0\n\tglobal_load_lds_dwordx4 %1, off\n\ts_mov_b32 m0, %0" : "=&s"(keep) : "v"(gsrc), "s"(lds_dst) : "memory"); }
__device__ __forceinline__ int bucket_of(int d) {
    if (d < 16) return d;
    int b = 16;
    b += (d >= 22); b += (d >= 30); b += (d >= 40); b += (d >= 54); b += (d >= 73); b += (d >= 99); b += (d >= 134); b += (d >= 182);
    b += (d >= 246); b += (d >= 332); b += (d >= 450); b += (d >= 609); b += (d >= 825); b += (d >= 1117); b += (d >= 1513);
    return b;
}
__device__ __forceinline__ void qkt(f32x16& p0, f32x16& p1, const LAS unsigned char* Kslot, const bf16x8 (&qr)[4], int r32, int hi) {
    const LAS unsigned char* kb = Kslot + hi * 1024 + r32 * 16;
    p0 = (f32x16){}; p1 = (f32x16){};
#pragma unroll
    for (int d0 = 0; d0 < 4; ++d0) {
        const bf16x8 b0 = *(const LAS bf16x8*)(kb + d0 * 2048);
        const bf16x8 b1 = *(const LAS bf16x8*)(kb + d0 * 2048 + 512);
        p0 = __builtin_amdgcn_mfma_f32_32x32x16_bf16(b0, qr[d0], p0, 0, 0, 0);
        p1 = __builtin_amdgcn_mfma_f32_32x32x16_bf16(b1, qr[d0], p1, 0, 0, 0);
    }
}
__device__ __forceinline__ void pv(f32x16 (&o)[2], int vb, bf16x8 pa0, bf16x8 pa1, bf16x8 pa2, bf16x8 pa3) {
#pragma unroll
    for (int d0 = 0; d0 < 2; ++d0) { s16x4 lo[4], hi[4];
#pragma unroll
        for (int ks = 0; ks < 4; ++ks) {
            asm volatile("ds_read_b64_tr_b16 %0,%1 offset:%c2" : "=&v"(lo[ks]) : "v"(vb), "i"(d0 * 4096 + ks * 1024) : "memory");
            asm volatile("ds_read_b64_tr_b16 %0,%1 offset:%c2" : "=&v"(hi[ks]) : "v"(vb), "i"(d0 * 4096 + ks * 1024 + 512) : "memory"); }
        asm volatile("s_waitcnt lgkmcnt(0)" ::: "memory"); __builtin_amdgcn_sched_barrier(0);
#define PK(k) (bf16x8){lo[k][0], lo[k][1], lo[k][2], lo[k][3], hi[k][0], hi[k][1], hi[k][2], hi[k][3]}
        o[d0] = __builtin_amdgcn_mfma_f32_32x32x16_bf16(pa0, PK(0), o[d0], 0, 0, 0);
        o[d0] = __builtin_amdgcn_mfma_f32_32x32x16_bf16(pa1, PK(1), o[d0], 0, 0, 0);
        o[d0] = __builtin_amdgcn_mfma_f32_32x32x16_bf16(pa2, PK(2), o[d0], 0, 0, 0);
        o[d0] = __builtin_amdgcn_mfma_f32_32x32x16_bf16(pa3, PK(3), o[d0], 0, 0, 0);
#undef PK
    }
}
__device__ __forceinline__ float xhalf_max(float v) { auto rr = __builtin_amdgcn_permlane32_swap(__float_as_uint(v), __float_as_uint(v), false, false); return __builtin_fmaxf(__uint_as_float(rr[0]), __uint_as_float(rr[1])); }
__device__ __forceinline__ float xhalf_sum(float v) { auto rr = __builtin_amdgcn_permlane32_swap(__float_as_uint(v), __float_as_uint(v), false, false); return __uint_as_float(rr[0]) + __uint_as_float(rr[1]); }

#define ATT_PACK(p0, p1, pw0, pw1, pw2, pw3) do { \
    pw0 = (u32x4){cvt_pk_bf16(p0[0], p0[1]), cvt_pk_bf16(p0[2], p0[3]), cvt_pk_bf16(p0[4], p0[5]), cvt_pk_bf16(p0[6], p0[7])}; \
    pw1 = (u32x4){cvt_pk_bf16(p0[8], p0[9]), cvt_pk_bf16(p0[10], p0[11]), cvt_pk_bf16(p0[12], p0[13]), cvt_pk_bf16(p0[14], p0[15])}; \
    pw2 = (u32x4){cvt_pk_bf16(p1[0], p1[1]), cvt_pk_bf16(p1[2], p1[3]), cvt_pk_bf16(p1[4], p1[5]), cvt_pk_bf16(p1[6], p1[7])}; \
    pw3 = (u32x4){cvt_pk_bf16(p1[8], p1[9]), cvt_pk_bf16(p1[10], p1[11]), cvt_pk_bf16(p1[12], p1[13]), cvt_pk_bf16(p1[14], p1[15])}; } while (0)

__device__ __forceinline__ void stage_rows(LAS unsigned char* lds, int wid, int lane, const f32x16 (&ot)[2]) {
    const int r32 = lane & 31, hi = lane >> 5;
    LAS bf16_t* stg = (LAS bf16_t*)(lds + L_OTA) + wid * 2048;
#pragma unroll
    for (int r = 0; r < 16; ++r) { const int orow = crow(r, hi);
#pragma unroll
        for (int d0 = 0; d0 < 2; ++d0) stg[orow * 64 + d0 * 32 + r32] = (bf16_t)(cvt_pk_bf16(ot[d0][r], 0.f) & 0xffffu); }
    LDS_WAIT();
}
struct StreamP { const bf16_t* Kb; const bf16_t* Vb; long pitch; int NT; const LAS unsigned char* tl; unsigned long long lanesel; int uq; const LAS float* lut; int xtop; int dclamp; };
typedef const LAS unsigned char* lds_cptr;
typedef short v4i16_t __attribute__((ext_vector_type(4)));
__device__ __forceinline__ void kload8(bf16x8* kf, lds_cptr kp) {
    kf[0] = *(const LAS bf16x8*)(kp);        kf[1] = *(const LAS bf16x8*)(kp + 512);
    kf[2] = *(const LAS bf16x8*)(kp + 2048); kf[3] = *(const LAS bf16x8*)(kp + 2560);
    kf[4] = *(const LAS bf16x8*)(kp + 4096); kf[5] = *(const LAS bf16x8*)(kp + 4608);
    kf[6] = *(const LAS bf16x8*)(kp + 6144); kf[7] = *(const LAS bf16x8*)(kp + 6656);
}
__device__ __forceinline__ void kload2(bf16x8* kf, lds_cptr kp, int j) { kf[2 * j] = *(const LAS bf16x8*)(kp + j * 2048); kf[2 * j + 1] = *(const LAS bf16x8*)(kp + j * 2048 + 512); }
__device__ __forceinline__ s16x4 vtr(lds_cptr p) { return __builtin_bit_cast(s16x4, __builtin_amdgcn_ds_read_tr16_b64_v4i16((LAS v4i16_t*)p)); }
constexpr int SLOTB = 8192;
#define ST_WAIT_BAR(N) asm volatile("s_waitcnt vmcnt(" #N ") lgkmcnt(0)\n\ts_barrier" ::: "memory")
template <int THRL>
__device__ __forceinline__ void attn_stream(LAS unsigned char* lds, const int wid, const int lane, const bf16x8 (&qr)[4], const StreamP S, float& mhat_o, float& l_o, f32x16 (&o)[2]) {
    const int r32 = lane & 31, hi = lane >> 5;
    const unsigned lds0 = (unsigned)(uintptr_t)lds;
    LAS float* wsf = (LAS float*)(lds + L_WSF) + wid * 64;
    const int NT = S.NT;
    const bf16_t* ksrc = S.Kb + (long)lane * S.pitch + wid * 8;
    const bf16_t* vsrc = S.Vb + (long)(16 * (wid & 3) + (lane >> 2)) * S.pitch + (wid >> 2) * 32 + (lane & 3) * 8;
    const unsigned kdst = lds0 + L_KR + wid * 1024, vdst = lds0 + L_VR + wid * 1024;
    const int tlv = (lane < NT) ? (int)S.tl[lane] : 0x80;
#define TLRAW(k) ((int)__builtin_amdgcn_readlane(tlv, __builtin_amdgcn_readfirstlane(k)))
#define DMA_K(k, slot) do { const int tr_ = TLRAW(k) & 63; glds16(ksrc + (long)tr_ * 64 * S.pitch, (unsigned)__builtin_amdgcn_readfirstlane(kdst + (slot))); } while (0)
#define DMA_V(k, slot) do { const int tr_ = TLRAW(k) & 63; glds16(vsrc + (long)tr_ * 64 * S.pitch, (unsigned)__builtin_amdgcn_readfirstlane(vdst + (slot))); } while (0)
    const lds_cptr kp0 = (lds_cptr)lds + L_KR + hi * 1024 + r32 * 16;
    const lds_cptr vp0 = (lds_cptr)lds + L_VR + ((lane >> 4) & 1) * 32 + (lane & 3) * 8 + (4 * hi + ((lane & 15) >> 2)) * 64;
    const int vb0 = (int)(lds0 + L_VR) + ((lane >> 4) & 1) * 32 + (lane & 3) * 8 + (4 * hi + ((lane & 15) >> 2)) * 64;
    bf16x8 kf[8];
#define LOFF(r) (((r) & 3) + 8 * ((r) >> 2))
#define LUTPTR(k, lp) do { const int raw_ = TLRAW(k); const int tj_ = raw_ & 63; int d0_ = S.uq - 64 * tj_ - 4 * hi; d0_ = d0_ < S.dclamp ? d0_ : S.dclamp; \
        const bool ok_ = (raw_ < 128) && (((S.lanesel >> tj_) & 1ull) != 0ull); lp = S.lut + (ok_ ? S.xtop - d0_ : S.xtop + 64); } while (0)
#define LUTLOAD(C0, C1, k) do { const int raw_ = TLRAW(k); const int tj_ = raw_ & 63; int d0_ = S.uq - 64 * tj_ - 4 * hi; d0_ = d0_ < S.dclamp ? d0_ : S.dclamp; \
        const bool ok_ = (raw_ < 128) && (((S.lanesel >> tj_) & 1ull) != 0ull); const LAS float* lp_ = S.lut + (ok_ ? S.xtop - d0_ : S.xtop + 64); \
        _Pragma("unroll") for (int r = 0; r < 16; ++r) { C0[r] = lp_[(r & 3) + 8 * (r >> 2)]; C1[r] = lp_[(r & 3) + 8 * (r >> 2) + 32]; } } while (0)
#define SBAR() __builtin_amdgcn_sched_barrier(0)
#define PIN(x) asm volatile("" : "+v"(x))
#define PKW(P, B) cvt_pk_bf16(P[B], P[B + 1])
#define PAF(k) __builtin_bit_cast(bf16x8, pw##k)
#define VFR(i) (bf16x8){vlo[i][0], vlo[i][1], vlo[i][2], vlo[i][3], vhi[i][0], vhi[i][1], vhi[i][2], vhi[i][3]}
#define MX3(a, b, c) __builtin_fmaxf(__builtin_fmaxf((a), (b)), (c))
#define MFMA32(a, b, c) __builtin_amdgcn_mfma_f32_32x32x16_bf16(a, b, c, 0, 0, 0)
#define GAPA(MF, A0, A1, A2, A3, W0, W1, PW) do { MF; sacc += A0; sacc += A1; sacc += A2; sacc += A3; PIN(sacc); W0; W1; PIN(PW); SBAR(); } while (0)
#define EX(v) __builtin_amdgcn_exp2f(v)
#define GAPB(MF, X, B, GN, PL, PO) do { MF; X[B] = EX(X[B]); X[B + 1] = EX(X[B + 1]); X[B + 2] = EX(X[B + 2]); X[B + 3] = EX(X[B + 3]); PIN(X); \
        if (GN) { PL[B] = lpn_[LOFF(B) + PO]; PL[B + 1] = lpn_[LOFF(B + 1) + PO]; PL[B + 2] = lpn_[LOFF(B + 2) + PO]; PL[B + 3] = lpn_[LOFF(B + 3) + PO]; } SBAR(); } while (0)
#define VRD(i) do { vlo[i] = vtr(vp_ + (((i) >> 2) * 4096 + ((i) & 3) * 1024)); vhi[i] = vtr(vp_ + (((i) >> 2) * 4096 + ((i) & 3) * 1024 + 512)); } while (0)
#define KRD(G, j) do { if (G) { kload2(kf, kp0 + sl_next, j); SBAR(); } } while (0)
#define ROT() do { sl_prev = sl_cur; sl_cur = sl_next; sl_next = (sl_next == 2 * SLOTB) ? 0 : sl_next + SLOTB; } while (0)
#define RESC() do { if (resc) { LDS_WAIT(); _Pragma("unroll") for (int d_ = 0; d_ < 2; ++d_) _Pragma("unroll") for (int r = 0; r < 16; ++r) o[d_][r] *= wsf[crow(r, hi)]; } } while (0)
#define ENDW(tt) do { if ((tt) + 3 < NT) { ST_WAIT_BAR(2); } else if ((tt) + 2 < NT) { ST_WAIT_BAR(1); } else { ST_WAIT_BAR(0); } } while (0)
#define STEP(C0, C1, P0, P1, t, GK, GV, GL, GN) do { SBAR(); \
    const lds_cptr vp_ = vp0 + sl_prev; const LAS float* lpn_ = S.lut; if (GN) { LUTPTR((t) + 1, lpn_); } \
    VRD(0); SBAR(); float sacc = (P0[0] + P0[1]); \
    GAPA(C0 = MFMA32(kf[0], qr[0], C0), P0[2], P0[3], P0[4], P0[5],     pw0[0] = PKW(P0, 0), pw0[1] = PKW(P0, 2), pw0); \
    VRD(4); SBAR(); GAPA(C1 = MFMA32(kf[1], qr[0], C1), P0[6], P0[7], P0[8], P0[9],     pw0[2] = PKW(P0, 4), pw0[3] = PKW(P0, 6), pw0); \
    VRD(1); SBAR(); GAPA(C0 = MFMA32(kf[2], qr[1], C0), P0[10], P0[11], P0[12], P0[13], pw1[0] = PKW(P0, 8), pw1[1] = PKW(P0, 10), pw1); \
    VRD(5); SBAR(); GAPA(C1 = MFMA32(kf[3], qr[1], C1), P0[14], P0[15], P1[0], P1[1],   pw1[2] = PKW(P0, 12), pw1[3] = PKW(P0, 14), pw1); \
    VRD(2); SBAR(); GAPA(C0 = MFMA32(kf[4], qr[2], C0), P1[2], P1[3], P1[4], P1[5],     pw2[0] = PKW(P1, 0), pw2[1] = PKW(P1, 2), pw2); \
    VRD(6); SBAR(); GAPA(C1 = MFMA32(kf[5], qr[2], C1), P1[6], P1[7], P1[8], P1[9],     pw2[2] = PKW(P1, 4), pw2[3] = PKW(P1, 6), pw2); \
    VRD(3); SBAR(); GAPA(C0 = MFMA32(kf[6], qr[3], C0), P1[10], P1[11], P1[12], P1[13], pw3[0] = PKW(P1, 8), pw3[1] = PKW(P1, 10), pw3); \
    VRD(7); SBAR(); GAPA(C1 = MFMA32(kf[7], qr[3], C1), P1[14], P1[15], 0.f, 0.f,       pw3[2] = PKW(P1, 12), pw3[3] = PKW(P1, 14), pw3); \
    l_reg += sacc; \
    if (GK) { DMA_K((t) + 3, sl_cur); } if (GV) { DMA_V((t) + 1, sl_next); } \
    { _Pragma("unroll") for (int r = 0; r < 16; ++r) { C0[r] -= mhat; C1[r] -= mhat; } \
      float a_ = MX3(C0[0], C0[1], C1[0]), b_ = MX3(C0[2], C0[3], C1[1]); a_ = MX3(a_, C1[2], C1[3]); \
      _Pragma("unroll") for (int r = 4; r < 16; r += 4) { a_ = MX3(a_, C0[r], C0[r + 1]); b_ = MX3(b_, C0[r + 2], C0[r + 3]); a_ = MX3(a_, C1[r], C1[r + 1]); b_ = MX3(b_, C1[r + 2], C1[r + 3]); } \
      float rm = xhalf_max(__builtin_fmaxf(a_, b_)); \
      resc = false; \
      if (__builtin_expect(__any(rm > (float)THRL), 0)) { const float dl = __builtin_fmaxf(rm, 0.f); mhat += dl; \
        _Pragma("unroll") for (int r = 0; r < 16; ++r) { C0[r] -= dl; C1[r] -= dl; } \
        const float f = __builtin_amdgcn_exp2f(-dl); l_reg *= f; if (hi == 0) wsf[r32] = f; resc = true; } } \
    SBAR(); \
    GAPB(o[0] = MFMA32(PAF(0), VFR(0), o[0]), C0, 0, GN, P0, 0); \
    GAPB(o[1] = MFMA32(PAF(0), VFR(4), o[1]), C0, 4, GN, P0, 0); \
    KRD(GL, 0); GAPB(o[0] = MFMA32(PAF(1), VFR(1), o[0]), C0, 8, GN, P0, 0); \
    KRD(GL, 1); GAPB(o[1] = MFMA32(PAF(1), VFR(5), o[1]), C0, 12, GN, P0, 0); \
    KRD(GL, 2); GAPB(o[0] = MFMA32(PAF(2), VFR(2), o[0]), C1, 0, GN, P1, 32); \
    KRD(GL, 3); GAPB(o[1] = MFMA32(PAF(2), VFR(6), o[1]), C1, 4, GN, P1, 32); \
    GAPB(o[0] = MFMA32(PAF(3), VFR(3), o[0]), C1, 8, GN, P1, 32); \
    GAPB(o[1] = MFMA32(PAF(3), VFR(7), o[1]), C1, 12, GN, P1, 32); \
    } while (0)
    float mhat = 0.f, l_reg = 0.f; bool resc = false;
    o[0] = (f32x16){}; o[1] = (f32x16){};
    f32x16 pA0, pA1, pB0, pB1;
    int sl_prev = 0, sl_cur = 0, sl_next = SLOTB;
    DMA_K(0, 0); DMA_V(0, 0); DMA_K(1, SLOTB); DMA_K(2, 2 * SLOTB);
    LUTLOAD(pA0, pA1, 0);
    ST_WAIT_BAR(3);
    { const lds_cptr kb = kp0;
#pragma unroll
      for (int d0 = 0; d0 < 4; ++d0) { const bf16x8 b0 = *(const LAS bf16x8*)(kb + d0 * 2048); const bf16x8 b1 = *(const LAS bf16x8*)(kb + d0 * 2048 + 512);
          pA0 = MFMA32(b0, qr[d0], pA0); pA1 = MFMA32(b1, qr[d0], pA1); }
      float rm = pA0[0];
#pragma unroll
      for (int r = 1; r < 16; ++r) rm = __builtin_fmaxf(rm, pA0[r]);
#pragma unroll
      for (int r = 0; r < 16; ++r) rm = __builtin_fmaxf(rm, pA1[r]);
      rm = xhalf_max(rm);
      mhat = (rm == -INFINITY) ? 0.f : rm;
#pragma unroll
      for (int r = 0; r < 16; ++r) { pA0[r] = EX(pA0[r] - mhat); pA1[r] = EX(pA1[r] - mhat); } }
    ST_WAIT_BAR(0);
    DMA_K(3, 0); DMA_V(1, SLOTB);
    ROT();
    kload8(kf, kp0 + sl_cur);
    LUTLOAD(pB0, pB1, 1);
    ST_WAIT_BAR(2);
    s16x4 vlo[8], vhi[8]; u32x4 pw0, pw1, pw2, pw3;
    int t = 1;
    for (; t + 5 < NT; t += 2) {
        STEP(pB0, pB1, pA0, pA1, t, true, true, true, true);     ST_WAIT_BAR(2); RESC(); ROT();
        STEP(pA0, pA1, pB0, pB1, t + 1, true, true, true, true); ST_WAIT_BAR(2); RESC(); ROT();
    }
    for (; t + 1 < NT; t += 2) {
        STEP(pB0, pB1, pA0, pA1, t, (t + 3 < NT), (t + 1 < NT), (t + 1 < NT), true);       ENDW(t);     RESC(); ROT();
        STEP(pA0, pA1, pB0, pB1, t + 1, (t + 4 < NT), (t + 2 < NT), (t + 2 < NT), true);   ENDW(t + 1); RESC(); ROT();
    }
    STEP(pB0, pB1, pA0, pA1, NT - 1, false, false, false, false); RESC();
    { float sacc = pB0[0] + pB0[1];
#pragma unroll
      for (int r = 2; r < 16; ++r) sacc += pB0[r];
#pragma unroll
      for (int r = 0; r < 16; ++r) sacc += pB1[r];
      l_reg += sacc;
      ATT_PACK(pB0, pB1, pw0, pw1, pw2, pw3);
      SBAR(); pv(o, vb0 + sl_cur, PAF(0), PAF(1), PAF(2), PAF(3)); }
    asm volatile("s_waitcnt lgkmcnt(0)\n\ts_barrier" ::: "memory");
    mhat_o = mhat; l_o = l_reg;
#undef TLRAW
#undef DMA_K
#undef DMA_V
#undef LUTLOAD
#undef LUTPTR
#undef LOFF
#undef SBAR
#undef PIN
#undef PKW
#undef PAF
#undef VFR
#undef MX3
#undef MFMA32
#undef GAPA
#undef EX
#undef GAPB
#undef VRD
#undef KRD
#undef ROT
#undef RESC
#undef ENDW
#undef STEP
}
__device__ __forceinline__ void cmp_scores(f32x16& s0, f32x16& s1, LAS unsigned char* lds, const LAS unsigned char* bkc, const LAS unsigned char* tb, const bf16x8 (&qr)[4], const int k, const int r32, const int hi) {
#pragma unroll
    for (int r = 0; r < 16; ++r) { const int off = 16 * ((r & 3) + 8 * (r >> 2));
        s0[r] = *(const LAS float*)(tb + bkc[1024 * k + off]); s1[r] = *(const LAS float*)(tb + bkc[1024 * k + off + 512]); }
    const LAS unsigned char* kb = lds + k * 8192 + hi * 1024 + r32 * 16;
#pragma unroll
    for (int d0 = 0; d0 < 4; ++d0) { const bf16x8 b0 = *(const LAS bf16x8*)(kb + d0 * 2048); const bf16x8 b1 = *(const LAS bf16x8*)(kb + d0 * 2048 + 512);
        s0 = __builtin_amdgcn_mfma_f32_32x32x16_bf16(b0, qr[d0], s0, 0, 0, 0); s1 = __builtin_amdgcn_mfma_f32_32x32x16_bf16(b1, qr[d0], s1, 0, 0, 0); }
}
__device__ __forceinline__ float xhalf_other(float v, int hi) { auto rr = __builtin_amdgcn_permlane32_swap(__float_as_uint(v), __float_as_uint(v), false, false); return __uint_as_float(hi ? rr[0] : rr[1]); }
__device__ __forceinline__ void cmp_issue(LAS unsigned char* lds, const int wid, const int lane, const bf16_t* Kb, const bf16_t* Vb, const int nt) {
    const unsigned lds0 = (unsigned)(uintptr_t)lds;
    { const bf16_t* ksrc = Kb + (long)lane * 64 + wid * 8; const bf16_t* vsrc = Vb + (long)(16 * (wid & 3) + (lane >> 2)) * 64 + (wid >> 2) * 32 + (lane & 3) * 8;
      for (int k = 0; k < nt; ++k) { glds16(ksrc + (long)k * 4096, (unsigned)__builtin_amdgcn_readfirstlane(lds0 + k * 8192 + wid * 1024));
                                     glds16(vsrc + (long)k * 4096, (unsigned)__builtin_amdgcn_readfirstlane(lds0 + L_OTA + k * 8192 + wid * 1024)); } }
}
__device__ __forceinline__ void cmp_branch(LAS unsigned char* lds, const int wid, const int lane, const bf16x8 (&qr)[4], const int nt, const int t, f32x16 (&o)[2]) {
    const int r32 = lane & 31, hi = lane >> 5, g = wid >> 1, tq = (wid & 1) * 32 + r32;
    const unsigned lds0 = (unsigned)(uintptr_t)lds;
    const LAS unsigned char* bkc = lds + L_BKC + (4126 - t + 64 * hi);
    const LAS unsigned char* tb = lds + L_TBH + g * 144;
    asm volatile("s_waitcnt vmcnt(0) lgkmcnt(0)\n\ts_barrier" ::: "memory");
    float m = -INFINITY, l = 0.f;
#pragma clang loop unroll(disable)
    for (int k = 0; k < nt; ++k) { f32x16 s0, s1; cmp_scores(s0, s1, lds, bkc, tb, qr, k, r32, hi);
        float rm = s0[0];
#pragma unroll
        for (int r = 1; r < 16; ++r) rm = __builtin_fmaxf(rm, s0[r]);
#pragma unroll
        for (int r = 0; r < 16; ++r) rm = __builtin_fmaxf(rm, s1[r]);
        rm = xhalf_max(rm);
        const float mn = __builtin_fmaxf(m, rm), ms = (mn == -INFINITY) ? 0.f : mn;
        float ps = 0.f;
#pragma unroll
        for (int r = 0; r < 16; ++r) ps += __builtin_amdgcn_exp2f(s0[r] - ms) + __builtin_amdgcn_exp2f(s1[r] - ms);
        l = l * __builtin_amdgcn_exp2f(m - ms) + ps; m = mn; }
    l = xhalf_sum(l);
    const float msafe = (m == -INFINITY) ? 0.f : m, inv = l > 0.f ? 1.0f / l : 0.f;
    float I[4][8]; float pc7 = 0.f;
    o[0] = (f32x16){}; o[1] = (f32x16){};
    const int vb0 = (int)(lds0 + L_OTA) + ((lane >> 4) & 1) * 32 + (lane & 3) * 8 + (4 * hi + ((lane & 15) >> 2)) * 64;
#pragma unroll
    for (int k = 0; k < 4; ++k) {
        if (k < nt) { f32x16 s0, s1; cmp_scores(s0, s1, lds, bkc, tb, qr, k, r32, hi);
#pragma unroll
            for (int r = 0; r < 16; ++r) { s0[r] = __builtin_amdgcn_exp2f(s0[r] - msafe) * inv; s1[r] = __builtin_amdgcn_exp2f(s1[r] - msafe) * inv; }
            float pc[8];
#pragma unroll
            for (int q = 0; q < 4; ++q) { I[k][q] = 2.0f * (s0[4 * q] + s0[4 * q + 1] + s0[4 * q + 2]) + s0[4 * q + 3]; I[k][4 + q] = 2.0f * (s1[4 * q] + s1[4 * q + 1] + s1[4 * q + 2]) + s1[4 * q + 3];
                pc[q] = xhalf_other(s0[4 * q + 3], hi); pc[4 + q] = xhalf_other(s1[4 * q + 3], hi); }
#pragma unroll
            for (int j = 0; j < 8; ++j) I[k][j] += hi ? pc[j] : (j > 0 ? pc[j - 1] : pc7);
            pc7 = pc[7];
            u32x4 pw0, pw1, pw2, pw3; ATT_PACK(s0, s1, pw0, pw1, pw2, pw3);
            pv(o, vb0 + k * 8192, __builtin_bit_cast(bf16x8, pw0), __builtin_bit_cast(bf16x8, pw1), __builtin_bit_cast(bf16x8, pw2), __builtin_bit_cast(bf16x8, pw3));
        } else {
#pragma unroll
            for (int j = 0; j < 8; ++j) I[k][j] = 0.f;
        }
    }
    LAS float* imp = (LAS float*)(lds + L_IMP) + tq * 64 + hi;
#pragma unroll 1
    for (int gi = 0; gi < 4; ++gi) {
        if (g == gi) {
#pragma unroll
            for (int k = 0; k < 4; ++k) if (k < nt) {
#pragma unroll
                for (int j = 0; j < 8; ++j) __builtin_amdgcn_ds_faddf(imp + 16 * k + 2 * j, I[k][j], 0, 0, false);
            }
        }
        asm volatile("s_waitcnt lgkmcnt(0)\n\ts_barrier" ::: "memory");
    }
}
}

struct Ctx { int tid, lane, wave, vcu, G, bx; LAS unsigned char* lds; };

struct TrD { const float* src; size_t ldw; int nvalid; bf16_t* dst; size_t ldk; };
__device__ __forceinline__ void tr_load(const TrD& d, float (&v)[32], int lane) {
    const int n = lane & 31; const float* src = d.src + (size_t)(lane >> 5) * d.ldw + n;
#pragma unroll
    for (int i = 0; i < 32; ++i) v[i] = (n < d.nvalid) ? src[(size_t)(2 * i) * d.ldw] : 0.f;
}
__device__ __forceinline__ void tr_store(const TrD& d, const float (&v)[32], LAS float* scr, int lane) {
    const int n = lane & 31;
#pragma unroll
    for (int i = 0; i < 32; ++i) scr[(2 * i + (lane >> 5)) * 33 + n] = v[i];
    LDS_WAIT(); asm volatile("" ::: "memory");
    const int c = lane & 7;
#pragma unroll
    for (int j = 0; j < 4; ++j) { const int nn = (lane >> 3) + 8 * j; const LAS float* s = scr + (8 * c) * 33 + nn;
        u32x4 o; o.x = cvt_pk_bf16(s[0 * 33], s[1 * 33]); o.y = cvt_pk_bf16(s[2 * 33], s[3 * 33]); o.z = cvt_pk_bf16(s[4 * 33], s[5 * 33]); o.w = cvt_pk_bf16(s[6 * 33], s[7 * 33]);
        *(u32x4*)(d.dst + (size_t)nn * d.ldk + 8 * c) = o; }
    LDS_WAIT(); asm volatile("" ::: "memory");
}
__device__ __forceinline__ TrD mk_trd(const float* W, size_t ldw, int srccol, int nvalid, bf16_t* WT, size_t ldk, int dstrow, int k0) {
    TrD d; d.src = W + (size_t)k0 * ldw + srccol; d.ldw = ldw; d.nvalid = nvalid; d.dst = WT + (size_t)dstrow * ldk + k0; d.ldk = ldk; return d; }
__device__ __forceinline__ TrD dec_small(const Args& a, int it) {
    constexpr int I_WIN = 184 * 16, I_CW1 = 2 * 8 * 32, I_WUN = 32 * 8, I_WUD = 32 * 4, I_WO = 32 * 16, I_CW2 = 2 * 2 * 4;
    constexpr int PER = I_WIN + I_CW1 + I_WUN + I_WUD + I_WO + I_CW2;
    unsigned char* ws = a.ws;
    const int l = it / PER; int r = it % PER;
    if (r < I_WIN) { const int nb = r / 16, kb = r % 16; const int nd = 32 * nb; int src, nv = 32;
        if (nd < 1280) src = nd; else if (nd < 5632) src = nd + 24; else if (nd == 5632) { src = 1280; nv = 24; } else { src = 0; nv = 0; }
        return mk_trd(a.w_in + (size_t)l * DM * INW, INW, src, nv, (bf16_t*)(ws + WS_WINT) + (size_t)l * NIN * DM, DM, nd, 64 * kb); }
    r -= I_WIN;
    if (r < I_CW1) { const int kv = r / 256, q = r % 256, nb = q / 32, kb = q % 32;
        return mk_trd(a.cmp_w1 + (size_t)(l * 2 + kv) * 2048 * 256, 256, 32 * nb, 32, (bf16_t*)(ws + WS_CW1T) + (size_t)(l * 2 + kv) * 256 * 2048, 2048, 32 * nb, 64 * kb); }
    r -= I_CW1;
    if (r < I_WUN) { const int nb = r / 8, kb = r % 8;
        return mk_trd(a.w_up_nsa + (size_t)l * 512 * 1024, 1024, 32 * nb, 32, (bf16_t*)(ws + WS_WUNT) + (size_t)l * 1024 * 512, 512, 32 * nb, 64 * kb); }
    r -= I_WUN;
    if (r < I_WUD) { const int nb = r / 4, kb = r % 4;
        return mk_trd(a.w_up_dil + (size_t)l * 256 * 1024, 1024, 32 * nb, 32, (bf16_t*)(ws + WS_WUDT) + (size_t)l * 1024 * 256, 256, 32 * nb, 64 * kb); }
    r -= I_WUD;
    if (r < I_WO) { const int nb = r / 16, kb = r % 16;
        return mk_trd(a.w_o + (size_t)l * 1024 * 1024, 1024, 32 * nb, 32, (bf16_t*)(ws + WS_WOT) + (size_t)l * 1024 * 1024, 1024, 32 * nb, 64 * kb); }
    r -= I_WO;
    { const int kv = r / 8, q = r % 8, nb = q / 4, kb = q % 4;
        return mk_trd(a.cmp_w2 + (size_t)(l * 2 + kv) * 256 * 64, 64, 32 * nb, 32, (bf16_t*)(ws + WS_CW2T) + (size_t)(l * 2 + kv) * 64 * 256, 256, 32 * nb, 64 * kb); }
}
__device__ __forceinline__ TrD dec_expert(const Args& a, int l, int it) {
    constexpr int I_13 = 32 * 16, I_2 = 32 * 8, PER = I_13 + I_2;
    unsigned char* ws = a.ws;
    const int e = it / PER; int r = it % PER;
    if (r < I_13) { const int nb = r / 16, kb = r % 16; const int r0 = 32 * nb, pn = r0 >> 8, bj = (r0 >> 7) & 1, j0 = r0 & 127;
        const float* src = (bj ? a.exp_w3 : a.exp_w1) + (size_t)(l * 32 + e) * 1024 * 512;
        return mk_trd(src, 512, pn * 128 + j0, 32, (bf16_t*)(ws + WS_E13T) + (size_t)e * 1024 * 1024, 1024, r0, 64 * kb); }
    r -= I_13;
    { const int nb = r / 8, kb = r % 8;
        return mk_trd(a.exp_w2 + (size_t)(l * 32 + e) * 512 * 1024, 1024, 32 * nb, 32, (bf16_t*)(ws + WS_E2T) + (size_t)e * 1024 * 512, 512, 32 * nb, 64 * kb); }
}
template <int KIND> __device__ __forceinline__ void conv_items(const Args& a, const Ctx& C, int l, int first, int nitems, LAS float* scr) {
    const int NGW = C.G * NWAVES;
    float va[32], vb[32]; TrD d0, d1;
    int it = first;
    if (it >= nitems) return;
    d0 = KIND ? dec_expert(a, l, it) : dec_small(a, it); tr_load(d0, va, C.lane);
    for (;;) {
        const int itn = it + NGW; const bool hn = itn < nitems;
        if (hn) { d1 = KIND ? dec_expert(a, l, itn) : dec_small(a, itn); tr_load(d1, vb, C.lane); }
        tr_store(d0, va, scr, C.lane);
        if (!hn) break;
        const int itnn = itn + NGW; const bool hnn = itnn < nitems;
        if (hnn) { d0 = KIND ? dec_expert(a, l, itnn) : dec_small(a, itnn); tr_load(d0, va, C.lane); }
        tr_store(d1, vb, scr, C.lane);
        if (!hnn) break;
        it = itnn;
    }
}
__device__ __forceinline__ void conv_small(const Args& a, const Ctx& C) { conv_items<0>(a, C, 0, C.vcu * NWAVES + C.wave, 2 * 4368, (LAS float*)(C.lds + C.wave * 16384)); }
__device__ __forceinline__ void conv_experts_slice(const Args& a, const Ctx& C, int l, int q) {
    const int NGW = C.G * NWAVES; const int per = 3 * NGW;
    LAS float* scr = (LAS float*)(C.lds + (C.wave < 5 ? C.wave * 8448 : att::L_OTA + (C.wave - 5) * 8448));
    const int lo = q * per, hi = (q == 3) ? 32 * 768 : ((q + 1) * per < 32 * 768 ? (q + 1) * per : 32 * 768);
    if (lo < hi) conv_items<1>(a, C, l, lo + C.vcu * NWAVES + C.wave, hi, scr);
}
__device__ __forceinline__ void prologue_vectors(const Args& a, const Ctx& C) {
    LAS float* sl = (LAS float*)(C.lds);
    LAS float* part = (LAS float*)(C.lds + 32768);
    for (int i = C.tid; i < 8 * 1024; i += NTHR) { const float v = a.c[i]; sl[i] = v * sigmoidf_(v); }
    __syncthreads();
    float* MOD = (float*)(a.ws + WS_MOD); float* CB1 = (float*)(a.ws + WS_CB1);
    for (int it = C.vcu; it < 192 + 16; it += C.G) {
        float acc[8];
#pragma unroll
        for (int b = 0; b < 8; ++b) acc[b] = 0.f;
        if (it < 192) { const int l = it / 96, col = (it % 96) * 64 + C.lane;
            const float* w = a.ada_w + (size_t)l * 1024 * 6144 + col;
            for (int k0 = 128 * C.wave; k0 < 128 * C.wave + 128; k0 += 32) { float wv[32];
#pragma unroll
                for (int j = 0; j < 32; ++j) wv[j] = w[(size_t)(k0 + j) * 6144];
#pragma unroll
                for (int j = 0; j < 32; ++j)
#pragma unroll
                    for (int b = 0; b < 8; ++b) acc[b] += sl[b * 1024 + k0 + j] * wv[j]; }
        } else { const int q = it - 192, lk = q / 4, col = (q % 4) * 64 + C.lane;
            const float* w = a.cmp_w1 + (size_t)lk * 2048 * 256 + col; const float* pos = a.cmp_pos + (size_t)lk * 2048;
            for (int k0 = 256 * C.wave; k0 < 256 * C.wave + 256; k0 += 32) { float wv[32];
#pragma unroll
                for (int j = 0; j < 32; ++j) wv[j] = w[(size_t)(k0 + j) * 256];
#pragma unroll
                for (int j = 0; j < 32; ++j) acc[0] += pos[k0 + j] * wv[j]; }
        }
        __syncthreads();
#pragma unroll
        for (int b = 0; b < 8; ++b) part[(C.wave * 8 + b) * 64 + C.lane] = acc[b];
        __syncthreads();
        if (C.wave == 0) {
            float tot[8];
#pragma unroll
            for (int b = 0; b < 8; ++b) { float t2 = 0.f;
#pragma unroll
                for (int w = 0; w < 8; ++w) t2 += part[(w * 8 + b) * 64 + C.lane];
                tot[b] = t2; }
            if (it < 192) { const int l = it / 96, col = (it % 96) * 64 + C.lane; const float bias = a.ada_b[l * 6144 + col];
#pragma unroll
                for (int b = 0; b < 8; ++b) MOD[(size_t)(l * 8 + b) * 6144 + col] = tot[b] + bias;
            } else { const int q = it - 192, lk = q / 4, col = (q % 4) * 64 + C.lane; CB1[lk * 256 + col] = tot[0]; }
        }
    }
    __syncthreads();
}

__device__ __forceinline__ void moe_combine_row(const Args& a, int row, int lane, const float* g2  , f32x4 (&v)[4]) {
    const u32x4 rec = *(const u32x4*)(a.ws + WS_DEST + (size_t)row * 16);
    const bf16_t* Y = (const bf16_t*)(a.ws + WS_XS);
    const float w0 = (ABL == 6) ? 0.f : __uint_as_float(rec.z), w1 = (ABL == 6) ? 0.f : __uint_as_float(rec.w);
    const u32x2* y0 = (const u32x2*)(Y + (size_t)rec.x * 1024) + lane; const u32x2* y1 = (const u32x2*)(Y + (size_t)rec.y * 1024) + lane;
#pragma unroll
    for (int j = 0; j < 4; ++j) { const u32x2 p = y0[64 * j], q = y1[64 * j]; const f32x4 gg = *((const f32x4*)g2 + lane + 64 * j);
        v[j][0] += gg[0] * (w0 * bf_lo(p.x) + w1 * bf_lo(q.x)); v[j][1] += gg[1] * (w0 * bf_hi(p.x) + w1 * bf_hi(q.x));
        v[j][2] += gg[2] * (w0 * bf_lo(p.y) + w1 * bf_lo(q.y)); v[j][3] += gg[3] * (w0 * bf_hi(p.y) + w1 * bf_hi(q.y)); }
}
__device__ __forceinline__ void norm1_phase(const Args& a, const Ctx& C, int l) {
    const int gw = C.vcu * NWAVES + C.wave, NGW = C.G * NWAVES;
    const float* MOD = (const float*)(a.ws + WS_MOD); bf16_t* H = (bf16_t*)(a.ws + WS_H);
    const float* nw = a.norm1 + l * 1024;
    for (int row = gw; row < T; row += NGW) {
        const int b = row >> 12; const float* xr = (l == 0 ? a.x : (const float*)a.out) + (size_t)row * 1024;
        f32x4 v[4];
#pragma unroll
        for (int j = 0; j < 4; ++j) v[j] = *((const f32x4*)xr + C.lane + 64 * j);
        if (l == 1) { moe_combine_row(a, row, C.lane, MOD + (size_t)(0 * 8 + b) * 6144 + 5120, v);
#pragma unroll
            for (int j = 0; j < 4; ++j) *((f32x4*)(a.out + (size_t)row * 1024) + C.lane + 64 * j) = v[j]; }
        float ss = 0.f;
#pragma unroll
        for (int j = 0; j < 4; ++j) ss += (v[j][0] * v[j][0] + v[j][1] * v[j][1]) + (v[j][2] * v[j][2] + v[j][3] * v[j][3]);
        const float rstd = 1.0f / sqrtf(wave_sum(ss) * (1.0f / 1024.0f) + RMS_EPS);
        const float* mb = MOD + (size_t)(l * 8 + b) * 6144;
#pragma unroll
        for (int j = 0; j < 4; ++j) { const f32x4 g = *((const f32x4*)nw + C.lane + 64 * j), sh = *((const f32x4*)mb + C.lane + 64 * j), sc = *((const f32x4*)(mb + 1024) + C.lane + 64 * j);
            const f32x4 h = v[j] * rstd * g * (sc + 1.0f) + sh; u32x2 w; w.x = cvt_pk_bf16(h[0], h[1]); w.y = cvt_pk_bf16(h[2], h[3]);
            *((u32x2*)(H + (size_t)row * 1024) + C.lane + 64 * j) = w; }
    }
}
__device__ __forceinline__ void final_phase(const Args& a, const Ctx& C) {
    const int gw = C.vcu * NWAVES + C.wave, NGW = C.G * NWAVES;
    const float* MOD = (const float*)(a.ws + WS_MOD);
    for (int row = gw; row < T; row += NGW) {
        const int b = row >> 12; float* xr = a.out + (size_t)row * 1024;
        f32x4 v[4];
#pragma unroll
        for (int j = 0; j < 4; ++j) v[j] = *((const f32x4*)xr + C.lane + 64 * j);
        moe_combine_row(a, row, C.lane, MOD + (size_t)(1 * 8 + b) * 6144 + 5120, v);
        float ss = 0.f;
#pragma unroll
        for (int j = 0; j < 4; ++j) ss += (v[j][0] * v[j][0] + v[j][1] * v[j][1]) + (v[j][2] * v[j][2] + v[j][3] * v[j][3]);
        const float rstd = 1.0f / sqrtf(wave_sum(ss) * (1.0f / 1024.0f) + RMS_EPS);
#pragma unroll
        for (int j = 0; j < 4; ++j) { const f32x4 g = *((const f32x4*)a.norm_f + C.lane + 64 * j); *((f32x4*)xr + C.lane + 64 * j) = v[j] * rstd * g; }
    }
}
typedef float f32x4v __attribute__((ext_vector_type(4)));
__device__ __forceinline__ void norm2_router_phase(const Args& a, const Ctx& C, int l) {
    constexpr int RP = 2064;
    LAS unsigned char* HH = C.lds; LAS unsigned char* HL = C.lds + 16 * RP;
    LAS float* PART = (LAS float*)(C.lds + 2 * 16 * RP);
    LAS float* LOGI = PART + 8 * 16 * 48;
    LAS int* wcnt = (LAS int*)(C.lds + LDS_MISC + 256);
    const float* wg = a.router_wg + (size_t)l * 1024 * 4; const float* we = a.router_we + (size_t)l * 1024 * 32;
    const int lane = C.lane, wave = C.wave, fr = lane & 15, fq = lane >> 4;
    bf16x8 Wh[4][3], Wl[4][3];
#pragma unroll
    for (int ks = 0; ks < 4; ++ks)
#pragma unroll
        for (int ct = 0; ct < 3; ++ct) { const int cc = 16 * ct + fr; const int k0 = 128 * wave + 32 * ks + 8 * fq; unsigned hw[4], lw[4];
#pragma unroll
            for (int i = 0; i < 8; i += 2) { float v0 = 0.f, v1 = 0.f;
                if (cc < 4) { v0 = wg[(size_t)(k0 + i) * 4 + cc]; v1 = wg[(size_t)(k0 + i + 1) * 4 + cc]; }
                else if (cc < 36) { v0 = we[(size_t)(k0 + i) * 32 + cc - 4]; v1 = we[(size_t)(k0 + i + 1) * 32 + cc - 4]; }
                const unsigned hp = cvt_pk_bf16(v0, v1); hw[i >> 1] = hp; lw[i >> 1] = cvt_pk_bf16(v0 - bf_lo(hp), v1 - bf_hi(hp)); }
            Wh[ks][ct] = __builtin_bit_cast(bf16x8, (u32x4){hw[0], hw[1], hw[2], hw[3]}); Wl[ks][ct] = __builtin_bit_cast(bf16x8, (u32x4){lw[0], lw[1], lw[2], lw[3]}); }
    const float* MOD = (const float*)(a.ws + WS_MOD); bf16_t* H2 = (bf16_t*)(a.ws + WS_H2);
    const float* nw = a.norm2 + l * 1024; const float* bg = a.router_bg + l * 4; const float* be = a.router_be + l * 32;
    int* CNTBLK = (int*)(a.ws + WS_CNTBLK);
    for (int ch = C.vcu; ch < T / 128; ch += C.G) {
        int my_e0 = 0, my_e1 = 0; float my_w0 = 0.f, my_w1 = 0.f;
#pragma clang loop unroll(disable)
        for (int gi = 0; gi < 8; ++gi) {
            { const int row0 = ch * 128 + gi * 16 + 2 * wave; const int b = row0 >> 12;
              f32x4 v[2][4];
#pragma unroll
              for (int rr = 0; rr < 2; ++rr)
#pragma unroll
                  for (int q = 0; q < 4; ++q) v[rr][q] = *((const f32x4*)(a.out + (size_t)(row0 + rr) * 1024) + lane + 64 * q);
              const float* mb = MOD + (size_t)(l * 8 + b) * 6144 + 3072;
#pragma unroll
              for (int rr = 0; rr < 2; ++rr) { float ss = 0.f;
#pragma unroll
                  for (int q = 0; q < 4; ++q) ss += (v[rr][q][0] * v[rr][q][0] + v[rr][q][1] * v[rr][q][1]) + (v[rr][q][2] * v[rr][q][2] + v[rr][q][3] * v[rr][q][3]);
                  const float rstd = 1.0f / sqrtf(wave_sum(ss) * (1.0f / 1024.0f) + RMS_EPS);
#pragma unroll
                  for (int q = 0; q < 4; ++q) { const f32x4 g = *((const f32x4*)nw + lane + 64 * q), sh = *((const f32x4*)mb + lane + 64 * q), sc = *((const f32x4*)(mb + 1024) + lane + 64 * q);
                      const f32x4 h = v[rr][q] * rstd * g * (sc + 1.0f) + sh;
                      u32x2 hw; hw.x = cvt_pk_bf16(h[0], h[1]); hw.y = cvt_pk_bf16(h[2], h[3]);
                      u32x2 lw; lw.x = cvt_pk_bf16(h[0] - bf_lo(hw.x), h[1] - bf_hi(hw.x)); lw.y = cvt_pk_bf16(h[2] - bf_lo(hw.y), h[3] - bf_hi(hw.y));
                      *((u32x2*)(H2 + (size_t)(row0 + rr) * 1024) + lane + 64 * q) = hw;
                      *(LAS u32x2*)(HH + (2 * wave + rr) * RP + (4 * lane + 256 * q) * 2) = hw; *(LAS u32x2*)(HL + (2 * wave + rr) * RP + (4 * lane + 256 * q) * 2) = lw; } }
            }
            __syncthreads();
            { f32x4v acc[3]; acc[0] = (f32x4v){0.f, 0.f, 0.f, 0.f}; acc[1] = acc[0]; acc[2] = acc[0];
#pragma unroll
              for (int ks = 0; ks < 4; ++ks) { const int ko = (128 * wave + 32 * ks + 8 * fq) * 2;
                  const bf16x8 ah = *(const LAS bf16x8*)(HH + fr * RP + ko), al = *(const LAS bf16x8*)(HL + fr * RP + ko);
#pragma unroll
                  for (int ct = 0; ct < 3; ++ct) { acc[ct] = __builtin_amdgcn_mfma_f32_16x16x32_bf16(Wh[ks][ct], ah, acc[ct], 0, 0, 0);
                      acc[ct] = __builtin_amdgcn_mfma_f32_16x16x32_bf16(Wh[ks][ct], al, acc[ct], 0, 0, 0); acc[ct] = __builtin_amdgcn_mfma_f32_16x16x32_bf16(Wl[ks][ct], ah, acc[ct], 0, 0, 0); } }
#pragma unroll
              for (int ct = 0; ct < 3; ++ct) *(LAS f32x4v*)(PART + (wave * 16 + fr) * 48 + 16 * ct + 4 * fq) = acc[ct]; }
            __syncthreads();
            { const int row = C.tid >> 5, c = C.tid & 31;
              { float sacc = 0.f;
#pragma unroll
                for (int w = 0; w < 8; ++w) sacc += PART[(w * 16 + row) * 48 + c];
                LOGI[row * 48 + c] = sacc + (c < 4 ? bg[c] : be[c - 4]); }
              if (c < 4) { float sacc = 0.f;
#pragma unroll
                for (int w = 0; w < 8; ++w) sacc += PART[(w * 16 + row) * 48 + 32 + c];
                LOGI[row * 48 + 32 + c] = sacc + be[28 + c]; } }
            __syncthreads();
            if (wave == gi && lane < 16) { const LAS float* lg = LOGI + lane * 48;
                int grp = 0; float gmax = lg[0];
#pragma unroll
                for (int c = 1; c < 4; ++c) if (lg[c] > gmax) { gmax = lg[c]; grp = c; }
                float gs = 0.f;
#pragma unroll
                for (int c = 0; c < 4; ++c) gs += __builtin_amdgcn_exp2f((lg[c] - gmax) * LOG2E);
                const float pgrp = 1.0f / gs;
                float le[8];
#pragma unroll
                for (int e = 0; e < 8; ++e) le[e] = lg[4 + grp * 8 + e];
                int i0 = 0; float v0 = le[0];
#pragma unroll
                for (int e = 1; e < 8; ++e) if (le[e] > v0) { v0 = le[e]; i0 = e; }
                int i1 = -1; float v1 = -INFINITY;
#pragma unroll
                for (int e = 0; e < 8; ++e) if (e != i0 && le[e] > v1) { v1 = le[e]; i1 = e; }
                const float ex = __builtin_amdgcn_exp2f((v1 - v0) * LOG2E);
                my_e0 = grp * 8 + i0; my_e1 = grp * 8 + i1; my_w0 = pgrp / (1.0f + ex); my_w1 = pgrp * ex / (1.0f + ex); }
        }
        const int ea = bperm_i(C.lane >> 1, my_e0), eb = bperm_i(C.lane >> 1, my_e1);
        const int es = (C.lane < 32) ? ((C.lane & 1) ? eb : ea) : -1;
        int rank = 0, cnt = 0;
#pragma unroll
        for (int s2 = 0; s2 < 32; ++s2) { const int v = __builtin_amdgcn_readlane(es, s2); rank += (v == es && s2 < C.lane) ? 1 : 0; cnt += (v == C.lane) ? 1 : 0; }
        __syncthreads();
        if (C.lane < 32) wcnt[C.wave * 32 + C.lane] = cnt;
        __syncthreads();
        int lrank = rank;
        if (C.lane < 32) { for (int w = 0; w < C.wave; ++w) lrank += wcnt[w * 32 + es]; }
        if (C.wave == 0 && C.lane < 32) { int tot = 0;
#pragma unroll
            for (int w = 0; w < 8; ++w) tot += wcnt[w * 32 + C.lane];
            CNTBLK[ch * 32 + C.lane] = tot; }
        const int lr0 = bperm_i((2 * C.lane) & 63, lrank), lr1 = bperm_i((2 * C.lane + 1) & 63, lrank);
        if (C.lane < 16) { const int row = ch * 128 + C.wave * 16 + C.lane;
            u32x4 rec; rec.x = (unsigned)my_e0 | ((unsigned)my_e1 << 8); rec.y = (unsigned)lr0 | ((unsigned)lr1 << 16); rec.z = __float_as_uint(my_w0); rec.w = __float_as_uint(my_w1);
            *(u32x4*)(a.ws + WS_REC + (size_t)row * 16) = rec; }
    }
}
__device__ __forceinline__ void moe_scatter_phase(const Args& a, const Ctx& C) {
    LAS int* part_lt = (LAS int*)(C.lds);
    LAS int* part_all = part_lt + 512;
    LAS int* base = part_all + 512;
    LAS int* tot = base + 32;
    LAS int* pst = tot + 32;
    const int* CNTBLK = (const int*)(a.ws + WS_CNTBLK);
    int* TILEE = (int*)(a.ws + WS_TILEE);
    int* TOKL = (int*)(a.ws + WS_TOKL);
    for (int ch = C.vcu; ch < T / 128; ch += C.G) {
        __syncthreads();
        { const int e = C.tid & 31, p = C.tid >> 5; int slt = 0, sall = 0;
            for (int c = p; c < T / 128; c += 16) { const int v = CNTBLK[c * 32 + e]; sall += v; slt += (c < ch) ? v : 0; }
            part_lt[p * 32 + e] = slt; part_all[p * 32 + e] = sall; }
        __syncthreads();
        if (C.tid < 32) { int b = 0, t2 = 0;
#pragma unroll
            for (int p = 0; p < 16; ++p) { b += part_lt[p * 32 + C.tid]; t2 += part_all[p * 32 + C.tid]; }
            base[C.tid] = b; tot[C.tid] = t2; }
        __syncthreads();
        if (C.tid < 32) { int ps = 0; for (int e = 0; e < C.tid; ++e) ps += (tot[e] + 255) & ~255; pst[C.tid] = ps;
            if (ch == 0) { const int nt = (tot[C.tid] + 255) >> 8; const int t0 = ps >> 8; for (int m = 0; m < nt; ++m) TILEE[16 + t0 + m] = C.tid; if (C.tid == 31) TILEE[0] = t0 + nt; } }
        __syncthreads();
        int d0 = 0, d1 = 0;
        if (C.lane < 16) { const int row = ch * 128 + C.wave * 16 + C.lane;
            const u32x4 rec = *(const u32x4*)(a.ws + WS_REC + (size_t)row * 16);
            const int e0 = rec.x & 255, e1 = (rec.x >> 8) & 255;
            d0 = pst[e0] + base[e0] + (int)(rec.y & 0xffffu); d1 = pst[e1] + base[e1] + (int)(rec.y >> 16);
            u32x4 o; o.x = (unsigned)d0; o.y = (unsigned)d1; o.z = rec.z; o.w = rec.w;
            *(u32x4*)(a.ws + WS_DEST + (size_t)row * 16) = o; }
        if (C.lane < 16) { const int row = ch * 128 + C.wave * 16 + C.lane; TOKL[d0] = row; TOKL[d1] = row; }
        if (ch == 0) {
            for (int e = 0; e < 32; ++e) { const int lo = pst[e] + tot[e], hi = pst[e] + ((tot[e] + 255) & ~255);
                for (int k = lo + C.tid; k < hi; k += NTHR) TOKL[k] = 0; } }
    }
}
struct MoeOrder {
    int G, c, nu; int ex[8]; const char* A; const char* B; size_t tA, tB, eB;
    __device__ __forceinline__ bool next(int i, pg8::Unit& u) const {
        const int L = i * G + c; if (i >= 8 || L >= nu) return false;
        const int e = i == 0 ? ex[0] : i == 1 ? ex[1] : i == 2 ? ex[2] : i == 3 ? ex[3] : i == 4 ? ex[4] : i == 5 ? ex[5] : i == 6 ? ex[6] : ex[7];
        u.pm = L >> 2; u.pn = L & 3; u.A = A + (size_t)u.pm * tA; u.B = B + (size_t)e * eB + (size_t)u.pn * tB; return true;
    }
};

__device__ __forceinline__ void dil_unit(const Args& a, const Ctx& C, int du) {
    using namespace att;
    LAS unsigned char* lds = C.lds;
    const int x = du & 15; int r = du >> 4; const int h = r & 3; r >>= 2; const int grp = r % 3, b = r / 3;
    const int dsh = 2 * grp, d = 1 << dsh; const int nub = 16 >> dsh; const int res = x / nub, ub = x % nub;
    const int wid = C.wave, lane = C.lane, r32 = lane & 31, hi = lane >> 5;
    LAS float* lut = (LAS float*)(lds + L_LUT);
    LAS unsigned char* tl = lds + L_SEL + 768;
    __syncthreads();
    for (int e = C.tid; e < 704; e += NTHR) { const int m = 384 - e; float v = -INFINITY;
        if (m >= 0 && m <= 128) { int di = m << dsh; di = di > 4095 ? 4095 : di; v = a.rel_bias[(int)lds[L_BKT + di] * 20 + 8 + grp * 4 + h] * LOG2E; }
        lut[e] = v; }
    if (C.tid < 6) { const int kt = 4 * ub - 2 + C.tid; tl[C.tid] = (unsigned char)(kt < 0 ? 0x80 : kt); }
    const bf16_t* QKV = (const bf16_t*)(a.ws + WS_A);
    const int u = 256 * ub + 32 * wid + r32; const size_t tokq = (size_t)b * SEQ + (size_t)u * d + res;
    const bf16_t* qp = QKV + tokq * LDQ + 1280 + grp * 256 + h * 64;
    bf16x8 qr[4];
#pragma unroll
    for (int d0 = 0; d0 < 4; ++d0) qr[d0] = *(const bf16x8*)(qp + d0 * 16 + hi * 8);
    __syncthreads();
    StreamP S; S.Kb = QKV + ((size_t)b * SEQ + res) * LDQ + 1280 + 768 + grp * 256 + h * 64; S.Vb = S.Kb + 768; S.pitch = (long)d * LDQ;
    S.NT = 6; S.tl = tl; S.lanesel = ~0ull; S.uq = u; S.lut = lut; S.xtop = 384; S.dclamp = 1 << 30;
    float m = 0.f, l = 0.f; f32x16 o[2];
    attn_stream<8>(lds, wid, lane, qr, S, m, l, o);
    l = xhalf_sum(l);
    LAS float* wsf = (LAS float*)(lds + L_WSF) + wid * 64;
    if (hi == 0) { wsf[r32] = l > 0.f ? 1.0f / l : 0.f; ((float*)(a.ws + WS_LSE))[((size_t)grp * T + tokq) * 4 + h] = m + __builtin_amdgcn_logf(l); }
    LDS_WAIT();
#pragma unroll
    for (int rr = 0; rr < 16; ++rr) { const float f = wsf[crow(rr, hi)]; o[0][rr] *= f; o[1][rr] *= f; }
    stage_rows(lds, wid, lane, o);
    bf16_t* ODP = (bf16_t*)(a.ws + WS_ODP) + (size_t)grp * T * 256;
    const LAS bf16_t* stg = (const LAS bf16_t*)(lds + L_OTA) + wid * 2048;
#pragma unroll
    for (int i = 0; i < 4; ++i) { const int row = i * 8 + (lane >> 3), chn = lane & 7; const u32x4 v = *(const LAS u32x4*)(stg + row * 64 + chn * 8);
        const size_t tok = (size_t)b * SEQ + (size_t)(256 * ub + 32 * wid + row) * d + res;
        *(u32x4*)(ODP + tok * 256 + h * 64 + chn * 8) = v; }
}
__device__ __forceinline__ void dil_combine(const Args& a, const Ctx& C) {
    const float* LSE = (const float*)(a.ws + WS_LSE); const bf16_t* ODP = (const bf16_t*)(a.ws + WS_ODP); bf16_t* ODIL = (bf16_t*)(a.ws + WS_ODIL);
    const int gt = C.vcu * NTHR + C.tid, NT = C.G * NTHR;
    for (int idx = gt; idx < T * 32; idx += NT) {
        const int tok = idx >> 5, h = (idx >> 3) & 3, chn = idx & 7;
        const float l0 = LSE[((size_t)0 * T + tok) * 4 + h], l1 = LSE[((size_t)1 * T + tok) * 4 + h], l2 = LSE[((size_t)2 * T + tok) * 4 + h];
        const float mx = __builtin_fmaxf(l0, __builtin_fmaxf(l1, l2));
        float w0 = __builtin_amdgcn_exp2f(l0 - mx), w1 = __builtin_amdgcn_exp2f(l1 - mx), w2 = __builtin_amdgcn_exp2f(l2 - mx);
        const float inv = 1.0f / (w0 + w1 + w2); w0 *= inv; w1 *= inv; w2 *= inv;
        const size_t off = (size_t)tok * 256 + h * 64 + chn * 8;
        const u32x4 a0 = *(const u32x4*)(ODP + off), a1 = *(const u32x4*)(ODP + (size_t)T * 256 + off), a2 = *(const u32x4*)(ODP + (size_t)2 * T * 256 + off);
        u32x4 o;
        o.x = cvt_pk_bf16(w0 * bf_lo(a0.x) + w1 * bf_lo(a1.x) + w2 * bf_lo(a2.x), w0 * bf_hi(a0.x) + w1 * bf_hi(a1.x) + w2 * bf_hi(a2.x));
        o.y = cvt_pk_bf16(w0 * bf_lo(a0.y) + w1 * bf_lo(a1.y) + w2 * bf_lo(a2.y), w0 * bf_hi(a0.y) + w1 * bf_hi(a1.y) + w2 * bf_hi(a2.y));
        o.z = cvt_pk_bf16(w0 * bf_lo(a0.z) + w1 * bf_lo(a1.z) + w2 * bf_lo(a2.z), w0 * bf_hi(a0.z) + w1 * bf_hi(a1.z) + w2 * bf_hi(a2.z));
        o.w = cvt_pk_bf16(w0 * bf_lo(a0.w) + w1 * bf_lo(a1.w) + w2 * bf_lo(a2.w), w0 * bf_hi(a0.w) + w1 * bf_hi(a1.w) + w2 * bf_hi(a2.w));
        if (ABL == 4) o = (u32x4){0u, 0u, 0u, 0u};
        *(u32x4*)(ODIL + off) = o;
    }
}
template <bool INIT>
__device__ __forceinline__ void ota_update(LAS bf16_t* ota  , const LAS float* frow, int hi, const f32x16 (&o)[2]) {
#pragma unroll
    for (int r = 0; r < 16; ++r) { const int row = crow(r, hi); const float f = frow[row];
        float v0 = f * o[0][r], v1 = f * o[1][r];
        if (!INIT) { v0 += __uint_as_float((unsigned)ota[row * 64] << 16); v1 += __uint_as_float((unsigned)ota[row * 64 + 32] << 16); }
        ota[row * 64] = (bf16_t)(cvt_pk_bf16(v0, 0.f) & 0xffffu); ota[row * 64 + 32] = (bf16_t)(cvt_pk_bf16(v1, 0.f) & 0xffffu); }
}
#define NSA_T0(which) do { if (TNSA == (which) && blockIdx.x == 0 && wid == 0 && lane_id_fresh() == 0) { volatile LAS unsigned* M_ = (volatile LAS unsigned*)(lds + LDS_MISC); const unsigned long long t_ = __builtin_amdgcn_s_memrealtime(); M_[20] = (unsigned)t_; M_[21] = (unsigned)(t_ >> 32); } } while (0)
#define NSA_T1(which) do { if (TNSA == (which) && blockIdx.x == 0 && wid == 0 && lane_id_fresh() == 0) { volatile LAS unsigned* M_ = (volatile LAS unsigned*)(lds + LDS_MISC); const unsigned long long t_ = __builtin_amdgcn_s_memrealtime(); const unsigned long long t0_ = ((unsigned long long)M_[21] << 32) | M_[20]; \
        const unsigned long long d_ = (((unsigned long long)M_[23] << 32) | M_[22]) + (t_ - t0_); M_[22] = (unsigned)d_; M_[23] = (unsigned)(d_ >> 32); } } while (0)
#define NSA_SECT() const int lane = lane_id_fresh(); const int tid = wid * 64 + lane; const int r32 = lane & 31, hi = lane >> 5; (void)tid; (void)r32; (void)hi
__device__ __forceinline__ void nsa_unit(const Args& a, const Ctx& C, int b, int hk, int i) {
    using namespace att;
    LAS unsigned char* lds = C.lds;
    const int wid = C.wave; const int g = wid >> 1;
    const bf16_t* QKV = (const bf16_t*)(a.ws + WS_A);
    bf16x8 qr[4];
    f32x16 o[2];
    __syncthreads();
    NSA_T0(2);
    { NSA_SECT();
        const int tq = (wid & 1) * 32 + r32, t = 64 * i + tq; const size_t tok = (size_t)b * SEQ + t;
        LAS float* imp = (LAS float*)(lds + L_IMP); LAS float* gsh = (LAS float*)(lds + L_GSH) + wid * 96; LAS unsigned* selw = (LAS unsigned*)(lds + L_SEL);
        const bf16_t* KC = (const bf16_t*)(a.ws + WS_KC); const int nt = (4 * i + 2) / 64 + 1;
        cmp_issue(lds, wid, lane, KC + (size_t)((0 * 8 + b) * 2 + hk) * 256 * 64, KC + (size_t)((1 * 8 + b) * 2 + hk) * 256 * 64, nt);
        const bf16_t* qp = QKV + tok * LDQ + hk * 256 + g * 64;
#pragma unroll
        for (int d0 = 0; d0 < 4; ++d0) qr[d0] = *(const bf16x8*)(qp + d0 * 16 + hi * 8);
        float g0 = 0.f, g1 = 0.f, g2 = 0.f;
        if (hi == 0) { const float* gn = (const float*)(a.ws + WS_GN) + tok * 32 + hk * 4 + g; g0 = gn[0]; g1 = gn[8]; g2 = gn[16]; }
        for (int e = tid; e < 64 * 64; e += NTHR) imp[e] = 0.f;
        if (tid < 2) selw[128 + tid] = 0u;
        if (hi == 0) { gsh[r32] = (ABL == 1) ? 0.f : g0; gsh[32 + r32] = (ABL == 2) ? 0.f : g1; gsh[64 + r32] = (ABL == 3) ? 0.f : g2; }
        cmp_branch(lds, wid, lane, qr, nt, t, o);
        ota_update<true>((LAS bf16_t*)(lds + L_OTA) + wid * 2048 + r32, gsh, hi, o);
    }
    __syncthreads();
    NSA_T1(2);
    { NSA_SECT();
        LAS float* impP = (LAS float*)(lds + L_IMP); LAS unsigned* selw = (LAS unsigned*)(lds + L_SEL);
        const int q = tid >> 3, part = tid & 7;
        const int ncand = i - 2 > 0 ? i - 2 : 0; const int nforced = i + 1 < 3 ? i + 1 : 3; const int krem = 16 - nforced;
        unsigned bits = 0u;
        if (ncand > krem && ABL != 5) {
            float vn[8]; int cn[8];
#pragma unroll
            for (int e = 0; e < 8; ++e) { vn[e] = impP[q * 64 + part * 8 + e]; cn[e] = 0; }
#pragma unroll 4
            for (int mm = 1; mm <= i - 2; ++mm) { const float xv = impP[q * 64 + mm];
#pragma unroll
                for (int e = 0; e < 8; ++e) { const int n = part * 8 + e; cn[e] += (xv > vn[e] || (xv == vn[e] && mm < n)) ? 1 : 0; } }
#pragma unroll
            for (int e = 0; e < 8; ++e) { const int n = part * 8 + e; if (n >= 1 && n <= i - 2 && cn[e] < krem) bits |= 1u << e; }
        } else {
#pragma unroll
            for (int e = 0; e < 8; ++e) { const int n = part * 8 + e; if (n >= 1 && n <= i - 2) bits |= 1u << e; }
        }
#pragma unroll
        for (int e = 0; e < 8; ++e) { const int n = part * 8 + e; if (n == 0 || n == i || n == i - 1) bits |= 1u << e; }
        unsigned lo = part < 4 ? bits << (8 * part) : 0u, hi2 = part >= 4 ? bits << (8 * (part - 4)) : 0u;
        lo |= swz_xor_u<1>(lo); hi2 |= swz_xor_u<1>(hi2); lo |= swz_xor_u<2>(lo); hi2 |= swz_xor_u<2>(hi2); lo |= swz_xor_u<4>(lo); hi2 |= swz_xor_u<4>(hi2);
        if (part == 0) { selw[2 * q] = lo; selw[2 * q + 1] = hi2; atomicOr((unsigned*)&selw[128], lo); atomicOr((unsigned*)&selw[129], hi2); }
    }
    __syncthreads();
    int NTS, NTW;
    { NSA_SECT();
        LAS unsigned* selw = (LAS unsigned*)(lds + L_SEL);
        LAS unsigned char* tls = lds + L_SEL + 768; LAS unsigned char* tlw = lds + L_SEL + 848;
        const unsigned long long uni = ((unsigned long long)(unsigned)__builtin_amdgcn_readfirstlane((int)selw[129]) << 32) | (unsigned)__builtin_amdgcn_readfirstlane((int)selw[128]);
        const int nsel = __builtin_popcountll(uni); const int nts = (nsel + 1) & ~1; NTS = nts < 4 ? 4 : nts;
        const int jlo = i - 8 < 0 ? 0 : i - 8; const int nwin = i - jlo + 1; const int ntw = (nwin + 1) & ~1; NTW = ntw < 4 ? 4 : ntw;
        if (tid < 64) { if ((uni >> tid) & 1ull) tls[__builtin_popcountll(uni & ((1ull << tid) - 1ull))] = (unsigned char)tid; }
        else if (tid < 72) { const int k = nsel + (tid - 64); if (k < NTS) tls[k] = 0x80; }
        else if (tid < 88) { const int k = tid - 72; if (k < NTW) tlw[k] = (unsigned char)(k < nwin ? jlo + k : 0x80); }
    }
    __syncthreads();
    NSA_T0(1);
#pragma clang loop unroll(disable)
    for (int br = 0; br < 2; ++br) {
        float m = 0.f, l = 0.f;
        { NSA_SECT();
            const int tq = (wid & 1) * 32 + r32, t = 64 * i + tq;
            LAS unsigned* selw = (LAS unsigned*)(lds + L_SEL); LAS float* lut = (LAS float*)(lds + L_LUT);
            StreamP S; S.Kb = QKV + (size_t)b * SEQ * LDQ + 512 + 256 + br * 256 + hk * 64; S.Vb = S.Kb + 128; S.pitch = LDQ;
            S.NT = br ? NTW : NTS; S.tl = lds + L_SEL + (br ? 848 : 768); S.uq = t;
            S.lanesel = br ? ~0ull : (((unsigned long long)selw[2 * tq + 1] << 32) | selw[2 * tq]);
            S.lut = br ? lut + 7168 + g * 768 : lut + g * 1792; S.xtop = br ? 640 : 1636; S.dclamp = br ? (1 << 30) : 1636;
            attn_stream<8>(lds, wid, lane, qr, S, m, l, o);
        }
        { NSA_SECT();
            LAS float* gsh = (LAS float*)(lds + L_GSH) + wid * 96; LAS float* wsf = (LAS float*)(lds + L_WSF) + wid * 64;
            l = xhalf_sum(l);
            LDS_WAIT();
            if (hi == 0) wsf[r32] = (l > 0.f ? 1.0f / l : 0.f) * gsh[32 + br * 32 + r32];
            LDS_WAIT();
            ota_update<false>((LAS bf16_t*)(lds + L_OTA) + wid * 2048 + r32, wsf, hi, o);
        }
    }
    NSA_T1(1);
    { NSA_SECT();
        LDS_WAIT();
        bf16_t* ONSA = (bf16_t*)(a.ws + WS_ONSA);
        const LAS bf16_t* stg = (const LAS bf16_t*)(lds + L_OTA) + wid * 2048;
#pragma unroll
        for (int k = 0; k < 4; ++k) { const int row = k * 8 + (lane >> 3), chn = lane & 7; const u32x4 v = *(const LAS u32x4*)(stg + row * 64 + chn * 8);
            const size_t tk = (size_t)b * SEQ + 64 * i + (wid & 1) * 32 + row;
            *(u32x4*)(ONSA + tk * 512 + hk * 256 + g * 64 + chn * 8) = v; }
    }
}
__device__ __forceinline__ void build_bkt(const Ctx& C) {
    LAS unsigned char* bkt = C.lds + att::L_BKT; LAS unsigned char* bkc = C.lds + att::L_BKC;
    for (int d = C.tid; d < 4096; d += NTHR) bkt[d] = (unsigned char)att::bucket_of(d);
    for (int x = C.tid; x < 8704; x += NTHR) { const int dist = 4095 - x; bkc[x] = (unsigned char)(dist < 0 ? 128 : 4 * att::bucket_of(dist)); }
    __syncthreads();
}
__device__ __forceinline__ void build_nsa_tables(const Args& a, const Ctx& C, int hk) {
    using namespace att;
    LAS float* tbh = (LAS float*)(C.lds + L_TBH); LAS float* lut = (LAS float*)(C.lds + L_LUT);
    __syncthreads();
    if (C.tid < 144) { const int gg = C.tid / 36, bk = C.tid % 36; tbh[C.tid] = bk < 32 ? a.rel_bias[bk * 20 + hk * 4 + gg] * LOG2E : -INFINITY; }
    __syncthreads();
    for (int e = C.tid; e < 4 * 1792; e += NTHR) { const int gg = e / 1792, xx = e % 1792; const int dist = 1636 - xx;
        lut[e] = dist < 0 ? -INFINITY : tbh[gg * 36 + (int)C.lds[L_BKT + dist]]; }
    for (int e = C.tid; e < 4 * 768; e += NTHR) { const int gg = e / 768, xx = e % 768; const int dist = 640 - xx;
        lut[7168 + e] = (dist < 0 || dist > 512) ? -INFINITY : tbh[gg * 36 + (int)C.lds[L_BKT + dist]]; }
    __syncthreads();
}

typedef const Args __attribute__((address_space(4)))* CArgsP;
__device__ __forceinline__ Args load_args() {
#if defined(__HIP_DEVICE_COMPILE__)
    CArgsP p = (CArgsP)__builtin_amdgcn_kernarg_segment_ptr(); asm volatile("" : "+s"(p)); Args a;
    a.x = p->x; a.c = p->c; a.rel_bias = p->rel_bias; a.ada_w = p->ada_w; a.ada_b = p->ada_b; a.norm1 = p->norm1; a.norm2 = p->norm2; a.w_in = p->w_in;
    a.cmp_pos = p->cmp_pos; a.cmp_w1 = p->cmp_w1; a.cmp_w2 = p->cmp_w2; a.w_up_nsa = p->w_up_nsa; a.w_up_dil = p->w_up_dil; a.w_o = p->w_o;
    a.router_wg = p->router_wg; a.router_bg = p->router_bg; a.router_we = p->router_we; a.router_be = p->router_be; a.exp_w1 = p->exp_w1; a.exp_w3 = p->exp_w3; a.exp_w2 = p->exp_w2; a.norm_f = p->norm_f;
    a.out = p->out; a.ws = p->ws; a.ph_lo = p->ph_lo; a.ph_hi = p->ph_hi; a.use_bar = p->use_bar; a.pad = 0;
    return a;
#else
    return Args{};
#endif
}
#define LOADA() const Args a = load_args()
__global__ void __launch_bounds__(NTHR, 2) fwd_kernel(Args a_) {
    extern __shared__ __attribute__((aligned(16))) unsigned char lds_raw[];
    LAS unsigned char* const lds_base = (LAS unsigned char*)lds_raw;
    const int wave0_ = __builtin_amdgcn_readfirstlane((int)threadIdx.x >> 6);
#define FRESH() Ctx C; { int w_ = wave0_; asm volatile("" : "+s"(w_)); int t_ = lane_id_fresh(); asm volatile("" : "+v"(t_)); t_ += w_ * 64; int g_ = gridDim.x, b_ = blockIdx.x; asm volatile("" : "+s"(g_), "+s"(b_)); \
        C.lds = lds_base; C.tid = t_; C.lane = t_ & 63; C.wave = w_; C.G = g_; C.bx = b_; C.vcu = (g_ % 8 == 0) ? (b_ % 8) * (g_ / 8) + b_ / 8 : b_; }
    volatile LAS unsigned* MISC = (volatile LAS unsigned*)(lds_base + LDS_MISC);
    if (threadIdx.x < 64) MISC[threadIdx.x] = 0u;
    __syncthreads();
    unsigned* ctl = (unsigned*)(a_.ws + WS_CTL);
    XcdBarrier bar; bar.bar = ctl + CW_BAR; bar.x = 0; bar.st = nullptr;
    if (a_.use_bar) bar = xcd_barrier_post(ctl + CW_BAR, MISC + 8);
    const int lo = a_.ph_lo, hi = a_.ph_hi;
#ifndef PH_MASK
#define PH_MASK 0xFFFFFFFFu
#endif
#define IN(k) (((PH_MASK >> ((k) == 0 ? 10 : (k) == 21 ? 11 : (((k) - 1) % 10))) & 1u) && lo <= (k) && (k) < hi)
#define TIMED(k) ((TMASK >> (k)) & 1u)
#define TBEG(k) do { if (TMASK != 0u && TIMED(k) && blockIdx.x == 0 && wave0_ == 0 && lane_id_fresh() == 0) { const unsigned long long t_ = __builtin_amdgcn_s_memrealtime(); MISC[20] = (unsigned)t_; MISC[21] = (unsigned)(t_ >> 32); } } while (0)
#define TEND(k) do { if (TMASK != 0u && TIMED(k) && blockIdx.x == 0 && wave0_ == 0 && lane_id_fresh() == 0) { const unsigned long long t_ = __builtin_amdgcn_s_memrealtime(); const unsigned long long t0_ = ((unsigned long long)MISC[21] << 32) | MISC[20]; \
        const unsigned long long d_ = (((unsigned long long)MISC[23] << 32) | MISC[22]) + (t_ - t0_); MISC[22] = (unsigned)d_; MISC[23] = (unsigned)(d_ >> 32); } } while (0)
#define SEAM(k) do { if (IN(k) && IN((k) + 1)) { XcdBarrier b2_ = bar; asm volatile("" : "+s"(b2_.bar)); int w2_ = wave0_; asm volatile("" : "+s"(w2_)); xcd_barrier(b2_, w2_ == 0 && lane_id_fresh() == 0); } } while (0)
    TBEG(0);
    if (IN(0)) REPEAT(10) { __syncthreads(); FRESH(); LOADA(); prologue_vectors(a, C); conv_small(a, C); }
    SEAM(0); TEND(0);
    _Pragma("unroll") for (int l = 0; l < 2; ++l) {
        const int pb = 1 + 10 * l;
        TBEG(pb + 0);
        if (IN(pb + 0)) REPEAT(0) { FRESH(); LOADA(); norm1_phase(a, C, l); }
        SEAM(pb + 0); TEND(pb + 0);
        TBEG(pb + 1);
        if (IN(pb + 1)) REPEAT(1) { FRESH(); LOADA(); unsigned char* ws = a.ws;
            pg8::Gemm g{2048u, 2048u, 128u, 1024}; pg8::DenseOrder S; S.init(T, 5632, C.G, C.bx, ws + WS_H, 2048u, ws + WS_WINT + (size_t)l * NIN * DM * 2, 2048u);
            EpiInProj E{(bf16_t*)(ws + WS_A), (unsigned char*)(ws + WS_MG), (float*)(ws + WS_GN)};
            pg8::gemm_phase<EpiInProj, pg8::DenseOrder, true>(C.lds, C.tid, g, S, E);
            { const bf16_t* H = (const bf16_t*)(ws + WS_H); const bf16_t* WG = (const bf16_t*)(ws + WS_WINT) + ((size_t)l * NIN + 5632) * DM; float* GN = (float*)(ws + WS_GN);
              const int r32 = C.lane & 31, hi = C.lane >> 5;
              for (int it = C.vcu * NWAVES + C.wave; it < T / 32; it += C.G * NWAVES) {
                  const bf16_t* ap = H + (size_t)(32 * it + r32) * DM + hi * 8; const bf16_t* bp = WG + (size_t)r32 * DM + hi * 8;
                  f32x16 acc = {};
#pragma unroll 8
                  for (int ks = 0; ks < 64; ++ks) acc = __builtin_amdgcn_mfma_f32_32x32x16_bf16(*(const bf16x8*)(ap + ks * 16), *(const bf16x8*)(bp + ks * 16), acc, 0, 0, 0);
                  if (r32 < 24) {
#pragma unroll
                      for (int r = 0; r < 16; ++r) GN[(size_t)(32 * it + crow(r, hi)) * 32 + r32] = sigmoidf_(acc[r]); } } }
        }
        SEAM(pb + 1); TEND(pb + 1);
        TBEG(pb + 2);
        if (IN(pb + 2)) REPEAT(2) { FRESH(); LOADA(); unsigned char* ws = a.ws;
            struct CmpOrder { int c; const char* A; const char* B;
                __device__ __forceinline__ bool next(int i, pg8::Unit& u) const { if (i > 0 || c >= 32) return false; const int kv = c >> 4, b = (c >> 1) & 7, hk = c & 1;
                    u.pm = c; u.pn = 0; u.A = A + ((size_t)b * SEQ * LDQ + 512 + kv * 128 + hk * 64) * 2; u.B = B + (size_t)kv * 256 * 2048 * 2; return true; } };
            pg8::Gemm g{(unsigned)(16 * LDQ * 2), 4096u, (unsigned)(LDQ * 2), 2048};
            CmpOrder S{C.vcu, (const char*)(ws + WS_A), (const char*)(ws + WS_CW1T + (size_t)l * 2 * 256 * 2048 * 2)};
            EpiCmp E{(bf16_t*)(ws + WS_HID), (const float*)(ws + WS_CB1) + l * 512, (const bf16_t*)(ws + WS_CW2T) + (size_t)l * 2 * 64 * 256, (bf16_t*)(ws + WS_KC)};
            pg8::gemm_phase<EpiCmp, CmpOrder, false>(C.lds, C.tid, g, S, E);
            __syncthreads();
            build_bkt(C);
            for (;;) { __syncthreads();
                if (C.tid == 0) *(volatile LAS int*)(C.lds + LDS_MISC + 512) = (int)__hip_atomic_fetch_add((unsigned*)(ws + WS_CTL) + CW_Q + l, 1u, __ATOMIC_RELAXED, __HIP_MEMORY_SCOPE_AGENT);
                __syncthreads();
                const int du = __builtin_amdgcn_readfirstlane(*(volatile LAS int*)(C.lds + LDS_MISC + 512));
                if (du >= 1536) break;
                dil_unit(a, C, du); }
        }
        SEAM(pb + 2); TEND(pb + 2);
        TBEG(pb + 3);
        if (IN(pb + 3)) REPEAT(3) { FRESH(); LOADA();
            dil_combine(a, C);
            build_bkt(C);
            int cur_hk = -1;
            for (int v = C.vcu; v < 256; v += C.G) { const int b = v >> 5, hk = (v >> 4) & 1, s = v & 15;
                if (hk != cur_hk) { build_nsa_tables(a, C, hk); cur_hk = hk; }
                for (int k = 0; k < 4; ++k) { const int qi = (k == 0) ? s : (k == 1) ? 31 - s : (k == 2) ? 32 + s : 63 - s; nsa_unit(a, C, b, hk, qi);
                    __syncthreads(); if (v < C.G) conv_experts_slice(a, C, l, k); } }
            if (C.vcu >= 256) { for (int q = 0; q < 4; ++q) conv_experts_slice(a, C, l, q); }
            __syncthreads();
        }
        SEAM(pb + 3); TEND(pb + 3);
        TBEG(pb + 4);
        if (IN(pb + 4)) REPEAT(4) { FRESH(); LOADA(); unsigned char* ws = a.ws;
            pg8::Gemm g{1024u, 1024u, 128u, 512, 512u, 512u, 256}; pg8::DenseOrder S; S.init(T, 1024, C.G, C.bx, ws + WS_ONSA, 1024u, ws + WS_WUNT + (size_t)l * 1024 * 512 * 2, 1024u);
            S.A2 = (const char*)(ws + WS_ODIL); S.B2 = (const char*)(ws + WS_WUDT + (size_t)l * 1024 * 256 * 2); S.tA2 = (size_t)256 * 512; S.tB2 = (size_t)256 * 512;
            EpiUpFused E{(bf16_t*)(ws + WS_MERGED), (const unsigned char*)(ws + WS_MG)};
            pg8::gemm_phase<EpiUpFused, pg8::DenseOrder, true, true>(C.lds, C.tid, g, S, E);
        }
        SEAM(pb + 4); TEND(pb + 4);
        TBEG(pb + 5);
        if (IN(pb + 5)) REPEAT(5) { FRESH(); LOADA(); unsigned char* ws = a.ws;
            pg8::Gemm g{2048u, 2048u, 128u, 1024}; pg8::DenseOrder S; S.init(T, 1024, C.G, C.bx, ws + WS_MERGED, 2048u, ws + WS_WOT + (size_t)l * 1024 * 1024 * 2, 2048u);
            EpiOut E{l == 0 ? a.x : (const float*)a.out, a.out, (const float*)(ws + WS_MOD) + (size_t)l * 8 * 6144 + 2048};
            pg8::gemm_phase<EpiOut, pg8::DenseOrder, true>(C.lds, C.tid, g, S, E);
        }
        SEAM(pb + 5); TEND(pb + 5);
        TBEG(pb + 6);
        if (IN(pb + 6)) REPEAT(6) { FRESH(); LOADA(); norm2_router_phase(a, C, l); }
        SEAM(pb + 6); TEND(pb + 6);
        TBEG(pb + 7);
        if (IN(pb + 7)) REPEAT(7) { FRESH(); LOADA(); moe_scatter_phase(a, C); }
        SEAM(pb + 7); TEND(pb + 7);
        TBEG(pb + 8);
        if (IN(pb + 8)) REPEAT(8) { FRESH(); LOADA(); unsigned char* ws = a.ws;
            const int* TILEE = (const int*)(ws + WS_TILEE); const int ntl = TILEE[0];
            MoeOrder S; S.G = C.G; S.c = C.vcu; S.nu = ntl * 4; S.A = (const char*)(ws + WS_XS); S.B = (const char*)(ws + WS_E13T); S.tA = (size_t)256 * 2048; S.tB = (size_t)256 * 2048; S.eB = (size_t)1024 * 2048;
#pragma unroll
            for (int i = 0; i < 8; ++i) { const int L = i * C.G + C.vcu; S.ex[i] = (L < S.nu) ? TILEE[16 + (L >> 2)] : 0; }
            pg8::Gemm g{2048u, 2048u, 128u, 1024, 0u, 0u, 0, (const int*)(ws + WS_TOKL), (const char*)(ws + WS_H2)};
            EpiMoe1 E{(bf16_t*)(ws + WS_ACT)};
            pg8::gemm_phase<EpiMoe1, MoeOrder, true, false, true>(C.lds, C.tid, g, S, E);
        }
        SEAM(pb + 8); TEND(pb + 8);
        TBEG(pb + 9);
        if (IN(pb + 9)) REPEAT(9) { FRESH(); LOADA(); unsigned char* ws = a.ws;
            const int* TILEE = (const int*)(ws + WS_TILEE); const int ntl = TILEE[0];
            MoeOrder S; S.G = C.G; S.c = C.vcu; S.nu = ntl * 4; S.A = (const char*)(ws + WS_ACT); S.B = (const char*)(ws + WS_E2T); S.tA = (size_t)256 * 1024; S.tB = (size_t)256 * 1024; S.eB = (size_t)1024 * 1024;
#pragma unroll
            for (int i = 0; i < 8; ++i) { const int L = i * C.G + C.vcu; S.ex[i] = (L < S.nu) ? TILEE[16 + (L >> 2)] : 0; }
            pg8::Gemm g{1024u, 1024u, 128u, 512};
            EpiPlain E{(bf16_t*)(ws + WS_XS), 1024};
            pg8::gemm_phase<EpiPlain, MoeOrder, true>(C.lds, C.tid, g, S, E);
        }
        SEAM(pb + 9); TEND(pb + 9);
    }
    TBEG(21);
    if (IN(21)) { FRESH(); LOADA(); final_phase(a, C); }
    TEND(21);
    if ((TMASK != 0u || TNSA != 0) && blockIdx.x == 0 && wave0_ == 0 && lane_id_fresh() == 0) { const unsigned long long d_ = ((unsigned long long)MISC[23] << 32) | MISC[22]; const unsigned long long t0_ = __builtin_amdgcn_s_memrealtime();
        while (__builtin_amdgcn_s_memrealtime() - t0_ < TAMP * d_) __builtin_amdgcn_s_sleep(8); }
#undef IN
#undef SEAM
}

#ifndef ONE_LAUNCH
#define ONE_LAUNCH 1
#endif
extern "C" void kernel_launch(void* const* d_in, const int* in_sizes, int n_in, void* d_out, int out_size, void* d_ws, size_t ws_size, hipStream_t stream) {
    static int grid = 0;
    if (grid == 0) {
        if (n_in != 22 || out_size != T * DM || ws_size < WS_END) { fprintf(stderr, "kernel_launch: unexpected problem (n_in %d out %d ws %zu)\n", n_in, out_size, ws_size); grid = -1; return; }
        int dev = 0, cus = 0;
        if (hipGetDevice(&dev) != hipSuccess || hipDeviceGetAttribute(&cus, hipDeviceAttributeMultiprocessorCount, dev) != hipSuccess) { grid = -1; return; }
        if (hipFuncSetAttribute((const void*)fwd_kernel, hipFuncAttributeMaxDynamicSharedMemorySize, LDS_BYTES) != hipSuccess) { fprintf(stderr, "kernel_launch: hipFuncSetAttribute failed\n"); grid = -1; return; }
        int per_cu = 0;
        if (hipOccupancyMaxActiveBlocksPerMultiprocessor(&per_cu, (const void*)fwd_kernel, NTHR, LDS_BYTES) != hipSuccess || per_cu < 1) { fprintf(stderr, "kernel_launch: occupancy query reports %d\n", per_cu); }
        (void)hipGetLastError();
        grid = cus;
    }
    if (grid < 0) return;
    (void)hipMemsetAsync((char*)d_ws + WS_CTL, 0, CTL_ZERO_BYTES, stream);
    Args a{};
    a.x = (const float*)d_in[0]; a.c = (const float*)d_in[1]; a.rel_bias = (const float*)d_in[2]; a.ada_w = (const float*)d_in[3]; a.ada_b = (const float*)d_in[4];
    a.norm1 = (const float*)d_in[5]; a.norm2 = (const float*)d_in[6]; a.w_in = (const float*)d_in[7]; a.cmp_pos = (const float*)d_in[8]; a.cmp_w1 = (const float*)d_in[9];
    a.cmp_w2 = (const float*)d_in[10]; a.w_up_nsa = (const float*)d_in[11]; a.w_up_dil = (const float*)d_in[12]; a.w_o = (const float*)d_in[13];
    a.router_wg = (const float*)d_in[14]; a.router_bg = (const float*)d_in[15]; a.router_we = (const float*)d_in[16]; a.router_be = (const float*)d_in[17];
    a.exp_w1 = (const float*)d_in[18]; a.exp_w3 = (const float*)d_in[19]; a.exp_w2 = (const float*)d_in[20]; a.norm_f = (const float*)d_in[21];
    a.out = (float*)d_out; a.ws = (unsigned char*)d_ws; a.pad = 0;
#if ONE_LAUNCH
    a.ph_lo = 0; a.ph_hi = NPHASE; a.use_bar = 1;
    hipLaunchKernelGGL(fwd_kernel, dim3(grid), dim3(NTHR), LDS_BYTES, stream, a);
#else
    for (int p = 0; p < NPHASE; ++p) { a.ph_lo = p; a.ph_hi = p + 1; a.use_bar = 0;
        hipLaunchKernelGGL(fwd_kernel, dim3(grid), dim3(NTHR), LDS_BYTES, stream, a); }
#endif
}
```

```cpp
#include <hip/hip_runtime.h>
#include <cstdint>
#include <cstdio>

#define GAS __attribute__((address_space(1)))
#define LAS __attribute__((address_space(3)))
typedef unsigned short bf16_t;
typedef short bf16x8 __attribute__((ext_vector_type(8)));
typedef short s16x4 __attribute__((ext_vector_type(4)));
typedef float f32x4 __attribute__((ext_vector_type(4)));
typedef float f32x2 __attribute__((ext_vector_type(2)));
typedef float f32x16 __attribute__((ext_vector_type(16)));
typedef unsigned u32x4 __attribute__((ext_vector_type(4)));
typedef unsigned u32x2 __attribute__((ext_vector_type(2)));
typedef __bf16 bf16x2_t __attribute__((ext_vector_type(2)));

constexpr int NB = 8, SEQ = 4096, DM = 1024, T = NB * SEQ;
constexpr int LDQ = 3584;
constexpr int NIN = 5888;
constexpr int INW = 5656;
constexpr float LOG2E = 1.4426950408889634f;
constexpr float C2 = 0.125f * LOG2E;
constexpr int NWAVES = 8, NTHR = 512;
constexpr float RMS_EPS = 1e-6f;
constexpr int NPHASE = 22;
#ifndef ABL
#define ABL 0
#endif
#ifndef REP_MASK
#define REP_MASK 0u
#endif
#ifndef TMASK
#define TMASK 0u
#endif
#define TAMP 8ull
#ifndef TNSA
#define TNSA 0
#endif
#define REPEAT(k) _Pragma("clang loop unroll(disable)") for (int rep_ = 0; rep_ < (int)((REP_MASK >> (k)) & 1u) + 1; ++rep_)

constexpr size_t MiB = 1u << 20;
constexpr size_t WS_CTL = 0, CTL_ZERO_BYTES = MiB;
constexpr size_t WS_MOD = 1 * MiB;
constexpr size_t WS_CB1 = WS_MOD + 400 * 1024;
constexpr size_t WS_CW2T = WS_MOD + 512 * 1024;
constexpr size_t WS_CNTBLK = WS_MOD + 768 * 1024;
constexpr size_t WS_TILEE = WS_MOD + 832 * 1024;
constexpr size_t WS_WINT = 4 * MiB;
constexpr size_t WS_CW1T = 27 * MiB;
constexpr size_t WS_WUNT = 31 * MiB;
constexpr size_t WS_WUDT = 33 * MiB;
constexpr size_t WS_WOT = 34 * MiB;
constexpr size_t WS_E13T = 38 * MiB;
constexpr size_t WS_E2T = 102 * MiB;
constexpr size_t WS_A = 134 * MiB;
constexpr size_t WS_XS = WS_A;
constexpr size_t WS_ACT = WS_A + 144 * MiB;
constexpr size_t WS_MERGED = WS_A;
constexpr size_t WS_MG = 359 * MiB;
constexpr size_t WS_H2 = WS_MG;
constexpr size_t WS_REC = WS_MG + 64 * MiB;
constexpr size_t WS_DEST = WS_MG + 65 * MiB;
constexpr size_t WS_TOKL = WS_MG + 66 * MiB;
constexpr size_t WS_B = 487 * MiB;
constexpr size_t WS_H = WS_B;
constexpr size_t WS_ONSA = WS_B;
constexpr size_t WS_ODP = WS_B + 32 * MiB;
constexpr size_t WS_LSE = WS_B + 80 * MiB;
constexpr size_t WS_ODIL = WS_B + 82 * MiB;
constexpr size_t WS_GN = WS_B + 98 * MiB;
constexpr size_t WS_KC = WS_B + 102 * MiB;
constexpr size_t WS_HID = WS_B + 103 * MiB;
constexpr size_t WS_END = WS_B + 107 * MiB;

constexpr int CW_TMO = 0, CW_BAR = 4096, CW_Q = 8192;

constexpr int LDS_MISC = 158784;
constexpr int LDS_BYTES = 158784 + 2048;

__device__ __forceinline__ unsigned cvt_pk_bf16(float lo, float hi) { f32x2 v = {lo, hi}; bf16x2_t b = __builtin_convertvector(v, bf16x2_t); return __builtin_bit_cast(unsigned, b); }
__device__ __forceinline__ float bf_lo(unsigned w) { return __uint_as_float(w << 16); }
__device__ __forceinline__ float bf_hi(unsigned w) { return __uint_as_float(w & 0xffff0000u); }
__device__ __forceinline__ float sigmoidf_(float x) { return __builtin_amdgcn_rcpf(1.0f + __builtin_amdgcn_exp2f(-x * LOG2E)); }
__device__ __forceinline__ int lane_id_fresh() { unsigned ones = ~0u; asm volatile("" : "+s"(ones)); return (int)__builtin_amdgcn_mbcnt_hi(ones, __builtin_amdgcn_mbcnt_lo(ones, 0u)); }
template <int X> __device__ __forceinline__ float swz_xor_f(float v) { return __int_as_float(__builtin_amdgcn_ds_swizzle(__float_as_int(v), (X << 10) | 0x1f)); }
template <int X> __device__ __forceinline__ unsigned swz_xor_u(unsigned v) { return (unsigned)__builtin_amdgcn_ds_swizzle((int)v, (X << 10) | 0x1f); }
__device__ __forceinline__ float wave_sum(float v) {
    v += swz_xor_f<1>(v); v += swz_xor_f<2>(v); v += swz_xor_f<4>(v); v += swz_xor_f<8>(v); v += swz_xor_f<16>(v);
    auto rr = __builtin_amdgcn_permlane32_swap(__float_as_uint(v), __float_as_uint(v), false, false);
    return __uint_as_float(rr[0]) + __uint_as_float(rr[1]);
}
__device__ __forceinline__ int bperm_i(int srclane, int v) { return __builtin_amdgcn_ds_bpermute(srclane << 2, v); }
#define LDS_WAIT() asm volatile("s_waitcnt lgkmcnt(0)" ::: "memory")
#define VM_WAIT() asm volatile("s_waitcnt vmcnt(0)" ::: "memory")

#define XB_TMO      128
#define XB_XCNT(j)  (256  + 64 * (j))
#define XB_XSUB(j)  (1280 + 64 * (j))
#define XB_XGEN(j)  (2304 + 64 * (j))
#define XB_TOP      3328
#define XB_TOPGEN   3392
#define XCD_BAR_WORDS 3456
#define XB_SPIN_CAP (1u << 20)
__device__ __forceinline__ unsigned xb_ld(unsigned* p)              { return __hip_atomic_load(p, __ATOMIC_RELAXED, __HIP_MEMORY_SCOPE_AGENT); }
__device__ __forceinline__ unsigned xb_add(unsigned* p, unsigned v) { return __hip_atomic_fetch_add(p, v, __ATOMIC_RELAXED, __HIP_MEMORY_SCOPE_AGENT); }
__device__ __forceinline__ unsigned xb_xcc_id() { return (unsigned)__builtin_amdgcn_s_getreg((3 << 11) | 20) & 0xFu; }
#define XB_SPIN(cond, bar) do { unsigned _sp = 0; while (cond) { __builtin_amdgcn_s_sleep(1); \
    if ((++_sp & 255u) == 0u) { if (xb_ld(&(bar)[XB_TMO])) break; if (_sp > XB_SPIN_CAP) { atomicAdd(&(bar)[XB_TMO], 1u); break; } } } } while (0)
struct XcdBarrier { unsigned* bar; unsigned x; volatile LAS unsigned* st; };
__device__ __forceinline__ XcdBarrier xcd_barrier_post(unsigned* bar, volatile LAS unsigned* st) {
    XcdBarrier b; b.bar = bar; b.x = xb_xcc_id(); b.st = st;
    if (threadIdx.x == 0) (void)xb_add(&bar[XB_XCNT(b.x)], 1u);
    return b;
}
__device__ __forceinline__ void xcd_barrier_complete(unsigned* bar, unsigned x, unsigned& nloc, unsigned& nx) {
    const unsigned G = gridDim.x * gridDim.y * gridDim.z;
    unsigned sum, cnt, mine, sp = 0u;
    for (;;) {
        sum = 0u; cnt = 0u; mine = 0u;
#pragma unroll
        for (unsigned j = 0; j < 16; ++j) { const unsigned c = xb_ld(&bar[XB_XCNT(j)]); sum += c; cnt += (c > 0u) ? 1u : 0u; mine = (j == x) ? c : mine; }
        if (sum == G) break;
        __builtin_amdgcn_s_sleep(1);
        if ((++sp & 255u) == 0u) { if (xb_ld(&bar[XB_TMO])) break; if (sp > XB_SPIN_CAP) { atomicAdd(&bar[XB_TMO], 1u); break; } }
    }
    nloc = mine > 0u ? mine : 1u; nx = cnt > 0u ? cnt : 1u;
}
__device__ __forceinline__ void xcd_barrier(const XcdBarrier& b, const bool leader_thread) {
    asm volatile("s_waitcnt vmcnt(0)" ::: "memory");
    __syncthreads();
    if (leader_thread) {
        unsigned* bar = b.bar;
        __builtin_amdgcn_s_waitcnt(0);
        unsigned nloc = b.st[0], nx = b.st[1];
        if (nloc == 0u) { xcd_barrier_complete(bar, b.x, nloc, nx); b.st[0] = nloc; b.st[1] = nx; }
        const unsigned old = xb_add(&bar[XB_XSUB(b.x)], 1u);
        const unsigned gen = old / nloc;
        if (old + 1u == (gen + 1u) * nloc) {
            __builtin_amdgcn_fence(__ATOMIC_RELEASE, "agent");
            asm volatile("s_waitcnt vmcnt(0)" ::: "memory");
            const unsigned og = xb_add(&bar[XB_TOP], 1u);
            const unsigned tg = og / nx;
            if (og + 1u == (tg + 1u) * nx) xb_add(&bar[XB_TOPGEN], 1u);
            else XB_SPIN(xb_ld(&bar[XB_TOPGEN]) == tg, bar);
            __builtin_amdgcn_fence(__ATOMIC_ACQUIRE, "agent");
            xb_add(&bar[XB_XGEN(b.x)], 1u);
            asm volatile("s_waitcnt vmcnt(0)" ::: "memory");
        } else {
            XB_SPIN(xb_ld(&bar[XB_XGEN(b.x)]) == gen, bar);
            __builtin_amdgcn_fence(__ATOMIC_ACQUIRE, "agent");
            asm volatile("s_waitcnt vmcnt(0)" ::: "memory");
        }
    }
    __syncthreads();
}

namespace pg8 {
constexpr int BM = 256, BK = 64, HALF = 128, HTB = HALF * BK * 2, STAGE_BYTES = 8 * HTB;
__device__ __forceinline__ int lds_byte(int r, int c) { const int st = (r >> 4) * 2 + (c >> 5), rr = r & 15, cc = c & 31, ob = rr * 64 + cc * 2; return st * 1024 + (ob ^ (((ob >> 9) & 1) << 5)); }
__device__ __forceinline__ void stage_rc(int b, int& R, int& C) { const int st = b / 1024, sb = b % 1024, swz = sb ^ (((sb >> 9) & 1) << 5); R = (st >> 1) * 16 + swz / 64; C = (st & 1) * 32 + (swz % 64) / 2; }
__device__ __forceinline__ int perm32(int rho) { const int n = rho >> 4, i = rho & 15; return 8 * (i >> 2) + 4 * n + (i & 3); }

struct Unit { const char* A; const char* B; int pm, pn; const char* A2; const char* B2; };
struct Gemm { unsigned lda, ldb, kstepA; int K; unsigned lda2, ldb2; int K2; const int* tokl; const char* Abase; int sc_w, sc_a; };

template <class Epi, class Sched, bool ALIGN_EPI, bool SEG2 = false, bool GATHER = false, bool FP8 = false>
__device__ __forceinline__ void gemm_phase(LAS unsigned char* lds, const int tid, const Gemm g, const Sched& S, const Epi& E) {
    const int wid = __builtin_amdgcn_readfirstlane(tid >> 6), lane = tid & 63, wr = wid >> 2, wc = wid & 3, fr = lane & 15, fq = lane >> 4;
    const int nt0 = g.K / (FP8 ? 2 * BK : BK); const int nt = nt0 + (SEG2 ? g.K2 / BK : 0);
    unsigned voffA[2], voffB[2], voffA2[2], voffB2[2]; int Rrow[2]; unsigned Cb[2];
#pragma unroll
    for (int i = 0; i < 2; ++i) { int R, C; stage_rc(tid * 16 + i * 8192, R, C); Rrow[i] = R; Cb[i] = (unsigned)C * 2u; const int Rb = Epi::PERM ? ((R & ~31) + perm32(R & 31)) : R;
        voffA[i] = (unsigned)R * g.lda + (unsigned)C * 2u; voffB[i] = (unsigned)Rb * g.ldb + (unsigned)C * 2u;
        voffA2[i] = SEG2 ? (unsigned)R * g.lda2 + (unsigned)C * 2u : 0u; voffB2[i] = SEG2 ? (unsigned)Rb * g.ldb2 + (unsigned)C * 2u : 0u; }
    const size_t kstepA = (size_t)g.kstepA, kstepB = (size_t)(BK * 2);
    const size_t hstepA = (size_t)HALF * g.lda, hstepB = (size_t)HALF * g.ldb;
    const size_t hstepA2 = SEG2 ? (size_t)HALF * g.lda2 : 0, hstepB2 = SEG2 ? (size_t)HALF * g.ldb2 : 0;
    const unsigned ldsw = (unsigned)wid * 1024u;
    const int aoff = lds_byte(wr * 64 + fr, FP8 ? fq * 16 : fq * 8), boff = lds_byte(wc * 32 + fr, FP8 ? fq * 16 : fq * 8);
#define PG8_SA(b, h) (((b) * 2 + (h)) * HTB)
#define PG8_SB(b, h) ((4 + (b) * 2 + (h)) * HTB)
#define PG8_STAGE(bufoff, gbase, voff) do { _Pragma("unroll") for (int _i = 0; _i < 2; ++_i) \
        __builtin_amdgcn_global_load_lds((const unsigned*)((const char*)(gbase) + (voff)[_i]), (LAS unsigned*)(lds + (bufoff) + ldsw + _i * 8192), 16, 0, 0); } while (0)
#define PG8_STAGE2(bufoff, gbase, sel, v0, v1) do { _Pragma("unroll") for (int _i = 0; _i < 2; ++_i) \
        __builtin_amdgcn_global_load_lds((const unsigned*)((const char*)(gbase) + ((sel) ? (v1)[_i] : (v0)[_i])), (LAS unsigned*)(lds + (bufoff) + ldsw + _i * 8192), 16, 0, 0); } while (0)
#define PG8_LDA(dst, b, h) do { if constexpr (FP8) { _Pragma("unroll") for (int m = 0; m < 4; ++m) dst##8[m] = *(const LAS v8i_*)(lds + PG8_SA(b, h) + aoff + m * 2048); } \
        else { _Pragma("unroll") for (int m = 0; m < 4; ++m) _Pragma("unroll") for (int k = 0; k < 2; ++k) dst[m][k] = *(const LAS bf16x8*)(lds + PG8_SA(b, h) + aoff + m * 2048 + k * 1024); } } while (0)
#define PG8_LDB(dst, b, h) do { if constexpr (FP8) { _Pragma("unroll") for (int n = 0; n < 2; ++n) dst##8[n] = *(const LAS v8i_*)(lds + PG8_SB(b, h) + boff + n * 2048); } \
        else { _Pragma("unroll") for (int n = 0; n < 2; ++n) _Pragma("unroll") for (int k = 0; k < 2; ++k) dst[n][k] = *(const LAS bf16x8*)(lds + PG8_SB(b, h) + boff + n * 2048 + k * 1024); } } while (0)
#define PG8_MMA(ai, bj, At, Bt) do { __builtin_amdgcn_s_setprio(1); _Pragma("unroll") for (int m = 0; m < 4; ++m) _Pragma("unroll") for (int n = 0; n < 2; ++n) { \
        if constexpr (FP8) { asm volatile("v_mfma_f32_16x16x128_f8f6f4 %0, %1, %2, %0" : "+v"(acc[ai][bj][m][n]) : "v"(Bt##8[n]), "v"(At##8[m])); }     \
        else { _Pragma("unroll") for (int k = 0; k < 2; ++k) acc[ai][bj][m][n] = __builtin_amdgcn_mfma_f32_16x16x32_bf16(Bt[n][k], At[m][k], acc[ai][bj][m][n], 0, 0, 0); } } \
        __builtin_amdgcn_s_setprio(0); } while (0)
#define PG8_WAIT_V(n) asm volatile("s_waitcnt vmcnt(" #n ")" ::: "memory")
#define PG8_WAIT_L(n) asm volatile("s_waitcnt lgkmcnt(" #n ")" ::: "memory")
#define PG8_BAR __builtin_amdgcn_s_barrier()
#define PG8_SCHED __builtin_amdgcn_sched_barrier(0)
    Unit cur, nxt; int ui = 0;
    if (!S.next(0, cur)) return;
    f32x4 acc[2][2][4][2];
#pragma unroll
    for (int a = 0; a < 2; ++a)
#pragma unroll
        for (int b = 0; b < 2; ++b)
#pragma unroll
            for (int m = 0; m < 4; ++m)
#pragma unroll
                for (int n = 0; n < 2; ++n) acc[a][b][m][n] = (f32x4){0.f, 0.f, 0.f, 0.f};
    typedef int v8i_ __attribute__((ext_vector_type(8)));
    bf16x8 At[4][2], B0[2][2], B1[2][2]; v8i_ At8[4], B08[2], B18[2];
    const char* cA = GATHER ? g.Abase : cur.A; const char* cB = cur.B;
    unsigned vC0[2], vC1[2], vN0[2], vN1[2];
#define PG8_GLOAD(U, d0, d1) do { _Pragma("unroll") for (int _i = 0; _i < 2; ++_i) { \
        d0[_i] = (unsigned)g.tokl[(U).pm * 256 + Rrow[_i]] * g.lda + Cb[_i]; d1[_i] = (unsigned)g.tokl[(U).pm * 256 + 128 + Rrow[_i]] * g.lda + Cb[_i]; } } while (0)
    if constexpr (GATHER) { PG8_GLOAD(cur, vC0, vC1); }
    if constexpr (GATHER) {
        PG8_STAGE(PG8_SB(0, 0), cB, voffB); PG8_STAGE(PG8_SB(0, 1), cB + hstepB, voffB); PG8_STAGE(PG8_SA(0, 0), cA, vC0); PG8_STAGE(PG8_SA(0, 1), cA, vC1);
        if (wr == 1) PG8_BAR;
        PG8_WAIT_V(2); PG8_BAR;
        PG8_STAGE(PG8_SB(1, 0), cB + kstepB, voffB); PG8_STAGE(PG8_SA(1, 0), cA + kstepA, vC0); PG8_STAGE(PG8_SB(1, 1), cB + hstepB + kstepB, voffB);
        PG8_WAIT_V(6); PG8_BAR;
    } else {
    PG8_STAGE(PG8_SB(0, 0), cB, voffB); PG8_STAGE(PG8_SB(0, 1), cB + hstepB, voffB); PG8_STAGE(PG8_SA(0, 0), cA, voffA); PG8_STAGE(PG8_SA(0, 1), cA + hstepA, voffA);
    if (wr == 1) PG8_BAR;
    PG8_WAIT_V(2); PG8_BAR;
    PG8_STAGE(PG8_SB(1, 0), cB + kstepB, voffB); PG8_STAGE(PG8_SA(1, 0), cA + kstepA, voffA); PG8_STAGE(PG8_SB(1, 1), cB + hstepB + kstepB, voffB);
    PG8_WAIT_V(6); PG8_BAR;
    }
    for (;;) {
        const bool has_next = S.next(ui + 1, nxt);
        const char* nA = GATHER ? cA : (has_next ? nxt.A : cA); const char* nB = has_next ? nxt.B : cB;
        if constexpr (GATHER) { if (has_next) { PG8_GLOAD(nxt, vN0, vN1); } else { vN0[0] = vC0[0]; vN0[1] = vC0[1]; vN1[0] = vC1[0]; vN1[1] = vC1[1]; } }
#pragma clang loop unroll(disable)
        for (int t = 0; t < nt; t += 2) {
            const bool last = (t == nt - 2);
            if constexpr (SEG2) {
                const bool s1 = (t >= nt0);
                const bool s2 = !last && (t + 2 >= nt0);
                if (t == nt0) E.mid(acc, cur, wr, wc, fr, fq);
                const char* a1 = s1 ? cur.A2 + (size_t)(t + 1 - nt0) * kstepB : cA + (size_t)(t + 1) * kstepA; const size_t h1 = s1 ? hstepA2 : hstepA;
                const char* a2 = last ? nA : (s2 ? cur.A2 + (size_t)(t + 2 - nt0) * kstepB : cA + (size_t)(t + 2) * kstepA);
                const char* b2 = last ? nB : (s2 ? cur.B2 + (size_t)(t + 2 - nt0) * kstepB : cB + (size_t)(t + 2) * kstepB);
                const char* a3 = a2 + (s2 ? kstepB : kstepA); const char* b3 = b2 + kstepB;
                const size_t hA2 = s2 ? hstepA2 : hstepA, hB2 = s2 ? hstepB2 : hstepB;
                PG8_LDB(B0, 0, 0); PG8_LDB(B1, 0, 1); PG8_SCHED; PG8_LDA(At, 0, 0); PG8_STAGE2(PG8_SA(1, 1), a1 + h1, s1, voffA, voffA2);
                PG8_WAIT_V(8); PG8_WAIT_L(0); PG8_BAR; PG8_MMA(0, 0, At, B0); PG8_MMA(0, 1, At, B1); PG8_BAR; PG8_SCHED;
                PG8_LDA(At, 0, 1); PG8_STAGE2(PG8_SB(0, 0), b2, s2, voffB, voffB2); PG8_STAGE2(PG8_SB(0, 1), b2 + hB2, s2, voffB, voffB2); PG8_STAGE2(PG8_SA(0, 0), a2, s2, voffA, voffA2);
                PG8_WAIT_V(8); PG8_WAIT_L(0); PG8_BAR; PG8_MMA(1, 0, At, B0); PG8_MMA(1, 1, At, B1); PG8_BAR; PG8_SCHED;
                PG8_LDB(B0, 1, 0); PG8_LDB(B1, 1, 1); PG8_SCHED; PG8_LDA(At, 1, 0); PG8_STAGE2(PG8_SA(0, 1), a2 + hA2, s2, voffA, voffA2);
                PG8_WAIT_V(8); PG8_WAIT_L(0); PG8_BAR; PG8_MMA(0, 0, At, B0); PG8_MMA(0, 1, At, B1); PG8_BAR; PG8_SCHED;
                PG8_LDA(At, 1, 1); PG8_STAGE2(PG8_SB(1, 0), b3, s2, voffB, voffB2); PG8_STAGE2(PG8_SB(1, 1), b3 + hB2, s2, voffB, voffB2); PG8_STAGE2(PG8_SA(1, 0), a3, s2, voffA, voffA2);
                PG8_WAIT_V(8); PG8_WAIT_L(0); PG8_BAR; PG8_MMA(1, 0, At, B0); PG8_MMA(1, 1, At, B1); PG8_BAR; PG8_SCHED;
            } else if constexpr (GATHER) {
            const char* a1 = cA + (size_t)(t + 1) * kstepA;
            const char* a2 = last ? cA : cA + (size_t)(t + 2) * kstepA; const char* b2 = last ? nB : cB + (size_t)(t + 2) * kstepB;
            const char* a3 = a2 + kstepA; const char* b3 = b2 + kstepB;
            unsigned w0[2], w1[2]; w0[0] = last ? vN0[0] : vC0[0]; w0[1] = last ? vN0[1] : vC0[1]; w1[0] = last ? vN1[0] : vC1[0]; w1[1] = last ? vN1[1] : vC1[1];
            PG8_LDB(B0, 0, 0); PG8_LDB(B1, 0, 1); PG8_SCHED; PG8_LDA(At, 0, 0); PG8_STAGE(PG8_SA(1, 1), a1, vC1);
            PG8_WAIT_V(8); PG8_WAIT_L(0); PG8_BAR; PG8_MMA(0, 0, At, B0); PG8_MMA(0, 1, At, B1); PG8_BAR; PG8_SCHED;
            PG8_LDA(At, 0, 1); PG8_STAGE(PG8_SB(0, 0), b2, voffB); PG8_STAGE(PG8_SB(0, 1), b2 + hstepB, voffB); PG8_STAGE(PG8_SA(0, 0), a2, w0);
            PG8_WAIT_V(8); PG8_WAIT_L(0); PG8_BAR; PG8_MMA(1, 0, At, B0); PG8_MMA(1, 1, At, B1); PG8_BAR; PG8_SCHED;
            PG8_LDB(B0, 1, 0); PG8_LDB(B1, 1, 1); PG8_SCHED; PG8_LDA(At, 1, 0); PG8_STAGE(PG8_SA(0, 1), a2, w1);
            PG8_WAIT_V(8); PG8_WAIT_L(0); PG8_BAR; PG8_MMA(0, 0, At, B0); PG8_MMA(0, 1, At, B1); PG8_BAR; PG8_SCHED;
            PG8_LDA(At, 1, 1); PG8_STAGE(PG8_SB(1, 0), b3, voffB); PG8_STAGE(PG8_SB(1, 1), b3 + hstepB, voffB); PG8_STAGE(PG8_SA(1, 0), a3, w0);
            PG8_WAIT_V(8); PG8_WAIT_L(0); PG8_BAR; PG8_MMA(1, 0, At, B0); PG8_MMA(1, 1, At, B1); PG8_BAR; PG8_SCHED;
            } else {
            const char* a1 = cA + (size_t)(t + 1) * kstepA;
            const char* a2 = last ? nA : cA + (size_t)(t + 2) * kstepA; const char* b2 = last ? nB : cB + (size_t)(t + 2) * kstepB;
            const char* a3 = a2 + kstepA; const char* b3 = b2 + kstepB;
            PG8_LDB(B0, 0, 0); PG8_LDB(B1, 0, 1); PG8_SCHED; PG8_LDA(At, 0, 0); PG8_STAGE(PG8_SA(1, 1), a1 + hstepA, voffA);
            PG8_WAIT_V(8); PG8_WAIT_L(0); PG8_BAR; PG8_MMA(0, 0, At, B0); PG8_MMA(0, 1, At, B1); PG8_BAR; PG8_SCHED;
            PG8_LDA(At, 0, 1); PG8_STAGE(PG8_SB(0, 0), b2, voffB); PG8_STAGE(PG8_SB(0, 1), b2 + hstepB, voffB); PG8_STAGE(PG8_SA(0, 0), a2, voffA);
            PG8_WAIT_V(8); PG8_WAIT_L(0); PG8_BAR; PG8_MMA(1, 0, At, B0); PG8_MMA(1, 1, At, B1); PG8_BAR; PG8_SCHED;
            PG8_LDB(B0, 1, 0); PG8_LDB(B1, 1, 1); PG8_SCHED; PG8_LDA(At, 1, 0); PG8_STAGE(PG8_SA(0, 1), a2 + hstepA, voffA);
            PG8_WAIT_V(8); PG8_WAIT_L(0); PG8_BAR; PG8_MMA(0, 0, At, B0); PG8_MMA(0, 1, At, B1); PG8_BAR; PG8_SCHED;
            PG8_LDA(At, 1, 1); PG8_STAGE(PG8_SB(1, 0), b3, voffB); PG8_STAGE(PG8_SB(1, 1), b3 + hstepB, voffB); PG8_STAGE(PG8_SA(1, 0), a3, voffA);
            PG8_WAIT_V(8); PG8_WAIT_L(0); PG8_BAR; PG8_MMA(1, 0, At, B0); PG8_MMA(1, 1, At, B1); PG8_BAR; PG8_SCHED;
            }
        }
        if constexpr (ALIGN_EPI) { if (wr == 0) PG8_BAR; }
        if constexpr (FP8) { asm volatile("s_nop 15\n\ts_nop 15" ::: "memory"); }
        if constexpr (!Epi::AFTER_DRAIN) { int fr_ = fr, fq_ = fq; asm volatile("" : "+v"(fr_), "+v"(fq_));
            E(acc, cur, wr, wc, fr_, fq_); }
        if (!has_next) break;
#pragma unroll
        for (int a = 0; a < 2; ++a)
#pragma unroll
            for (int b = 0; b < 2; ++b)
#pragma unroll
                for (int m = 0; m < 4; ++m)
#pragma unroll
                    for (int n = 0; n < 2; ++n) acc[a][b][m][n] = (f32x4){0.f, 0.f, 0.f, 0.f};
        cur = nxt; cA = nA; cB = nB; ++ui;
        if constexpr (GATHER) { vC0[0] = vN0[0]; vC0[1] = vN0[1]; vC1[0] = vN1[0]; vC1[1] = vN1[1]; }
        if constexpr (ALIGN_EPI) { if (wr == 1) PG8_BAR; }
    }
    PG8_WAIT_V(0);
    if constexpr (!ALIGN_EPI) { if (wr == 0) PG8_BAR; }
    PG8_BAR;
    if constexpr (Epi::AFTER_DRAIN) { E.fused(acc, cur, wr, wc, fr, fq, wid, lane); }
#undef PG8_SA
#undef PG8_SB
#undef PG8_STAGE
#undef PG8_STAGE2
#undef PG8_GLOAD
#undef PG8_LDA
#undef PG8_LDB
#undef PG8_MMA
#undef PG8_WAIT_V
#undef PG8_WAIT_L
#undef PG8_BAR
#undef PG8_SCHED
}

struct DenseOrder {
    int nM, nN, nwg, G, c; const char* A; const char* B; size_t tA, tB; const char* A2 = nullptr; const char* B2 = nullptr; size_t tA2 = 0, tB2 = 0;
    __device__ __forceinline__ void init(int M, int N, int G_, int c_, const void* A_, unsigned lda, const void* B_, unsigned ldb) {
        nM = M / BM; nN = N / BM; nwg = nM * nN; G = G_; c = c_; A = (const char*)A_; B = (const char*)B_; tA = (size_t)BM * lda; tB = (size_t)BM * ldb; }
    __device__ __forceinline__ bool next(int i, Unit& u) const {
        const long L = (long)i * G + c; if (L >= nwg) return false;
        int wgid = (int)L; { const int q = nwg / 8, r = nwg % 8, xcd = wgid % 8, off = wgid / 8; wgid = (xcd < r ? xcd * (q + 1) : r * (q + 1) + (xcd - r) * q) + off; }
        const int nig = 8 * nN, gid = wgid / nig, fm = gid * 8, gsz = (nM - fm) < 8 ? (nM - fm) : 8;
        u.pm = fm + ((wgid % nig) % gsz); u.pn = (wgid % nig) / gsz;
        u.A = A + (size_t)u.pm * tA; u.B = B + (size_t)u.pn * tB; u.A2 = A2 + (size_t)u.pm * tA2; u.B2 = B2 + (size_t)u.pn * tB2; return true;
    }
};
}

struct Args {
    const float* x; const float* c; const float* rel_bias; const float* ada_w; const float* ada_b; const float* norm1; const float* norm2; const float* w_in;
    const float* cmp_pos; const float* cmp_w1; const float* cmp_w2; const float* w_up_nsa; const float* w_up_dil; const float* w_o;
    const float* router_wg; const float* router_bg; const float* router_we; const float* router_be; const float* exp_w1; const float* exp_w3; const float* exp_w2; const float* norm_f;
    float* out; unsigned char* ws; int ph_lo, ph_hi, use_bar, pad;
};

typedef f32x4 AccT[2][2][4][2];
__device__ __forceinline__ unsigned q8(float x) { return (unsigned)(sigmoidf_(x) * 255.0f + 0.5f); }
struct EpiInProj {
    static constexpr bool PERM = true, AFTER_DRAIN = false;
    bf16_t* QKV; unsigned char* MG; float* GN; float os;
    __device__ __forceinline__ void operator()(const AccT& acc, const pg8::Unit& u, int wr, int wc, int fr, int fq) const {
        const int pn = u.pn; const int row0 = u.pm * 256 + wr * 64 + fr;
        if (pn < 14) {
            const float sc = ((pn < 2 || (pn >= 5 && pn < 8)) ? C2 : 1.0f) * os;
            const int col0 = pn * 256 + wc * 32 + 8 * fq;
#pragma unroll
            for (int ai = 0; ai < 2; ++ai)
#pragma unroll
                for (int m = 0; m < 4; ++m) { bf16_t* rowp = QKV + (size_t)(row0 + ai * 128 + m * 16) * LDQ + col0;
#pragma unroll
                    for (int bj = 0; bj < 2; ++bj) { const f32x4 v0 = acc[ai][bj][m][0] * sc, v1 = acc[ai][bj][m][1] * sc; u32x4 w;
                        w.x = cvt_pk_bf16(v0[0], v0[1]); w.y = cvt_pk_bf16(v0[2], v0[3]); w.z = cvt_pk_bf16(v1[0], v1[1]); w.w = cvt_pk_bf16(v1[2], v1[3]);
                        *(u32x4*)(rowp + bj * 128) = w; } }
        } else if (pn < 22) {
            const int col0 = (pn - 14) * 256 + wc * 32 + 8 * fq;
#pragma unroll
            for (int ai = 0; ai < 2; ++ai)
#pragma unroll
                for (int m = 0; m < 4; ++m) { unsigned char* rowp = MG + (size_t)(row0 + ai * 128 + m * 16) * 2048 + col0;
#pragma unroll
                    for (int bj = 0; bj < 2; ++bj) { const f32x4 v0 = acc[ai][bj][m][0] * os, v1 = acc[ai][bj][m][1] * os; u32x2 w;
                        w.x = q8(v0[0]) | (q8(v0[1]) << 8) | (q8(v0[2]) << 16) | (q8(v0[3]) << 24); w.y = q8(v1[0]) | (q8(v1[1]) << 8) | (q8(v1[2]) << 16) | (q8(v1[3]) << 24);
                        *(u32x2*)(rowp + bj * 128) = w; } }
        } else {
            if (wc == 0 && fq < 3) {
#pragma unroll
                for (int ai = 0; ai < 2; ++ai)
#pragma unroll
                    for (int m = 0; m < 4; ++m) { float* rowp = GN + (size_t)(row0 + ai * 128 + m * 16) * 32 + 8 * fq;
                        const f32x4 v0 = acc[ai][0][m][0] * os, v1 = acc[ai][0][m][1] * os;
                        *(f32x4*)(rowp) = (f32x4){sigmoidf_(v0[0]), sigmoidf_(v0[1]), sigmoidf_(v0[2]), sigmoidf_(v0[3])};
                        *(f32x4*)(rowp + 4) = (f32x4){sigmoidf_(v1[0]), sigmoidf_(v1[1]), sigmoidf_(v1[2]), sigmoidf_(v1[3])}; }
            }
        }
    }
};
template <int PASS> struct EpiUp {
    static constexpr bool PERM = true, AFTER_DRAIN = false;
    bf16_t* MERGED; const bf16_t* MG;
    __device__ __forceinline__ void operator()(const AccT& acc, const pg8::Unit& u, int wr, int wc, int fr, int fq) const {
        const int row0 = u.pm * 256 + wr * 64 + fr; const int col0 = u.pn * 256 + wc * 32 + 8 * fq;
#pragma unroll
        for (int ai = 0; ai < 2; ++ai)
#pragma unroll
            for (int m = 0; m < 4; ++m) { const size_t row = (size_t)(row0 + ai * 128 + m * 16);
#pragma unroll
                for (int bj = 0; bj < 2; ++bj) {
                    const u32x4 gw = *(const u32x4*)(MG + row * 2048 + PASS * 1024 + col0 + bj * 128);
                    bf16_t* op = MERGED + row * 1024 + col0 + bj * 128;
                    const f32x4 v0 = acc[ai][bj][m][0], v1 = acc[ai][bj][m][1];
                    float r[8] = {v0[0] * bf_lo(gw.x), v0[1] * bf_hi(gw.x), v0[2] * bf_lo(gw.y), v0[3] * bf_hi(gw.y), v1[0] * bf_lo(gw.z), v1[1] * bf_hi(gw.z), v1[2] * bf_lo(gw.w), v1[3] * bf_hi(gw.w)};
                    if (PASS == 1) { const u32x4 ow = *(const u32x4*)op;
                        r[0] += bf_lo(ow.x); r[1] += bf_hi(ow.x); r[2] += bf_lo(ow.y); r[3] += bf_hi(ow.y); r[4] += bf_lo(ow.z); r[5] += bf_hi(ow.z); r[6] += bf_lo(ow.w); r[7] += bf_hi(ow.w); }
                    u32x4 w; w.x = cvt_pk_bf16(r[0], r[1]); w.y = cvt_pk_bf16(r[2], r[3]); w.z = cvt_pk_bf16(r[4], r[5]); w.w = cvt_pk_bf16(r[6], r[7]);
                    *(u32x4*)op = w; }
                asm volatile("" ::: "memory"); }
    }
};
struct EpiUpFused {
    static constexpr bool PERM = true, AFTER_DRAIN = false;
    bf16_t* MERGED; const unsigned char* MG;
    __device__ __forceinline__ void mid(AccT& acc, const pg8::Unit& u, int wr, int wc, int fr, int fq) const {
        const int row0 = u.pm * 256 + wr * 64 + fr; const int col0 = u.pn * 256 + wc * 32 + 8 * fq;
#pragma unroll
        for (int ai = 0; ai < 2; ++ai)
#pragma unroll
            for (int m = 0; m < 4; ++m) { const size_t row = (size_t)(row0 + ai * 128 + m * 16);
#pragma unroll
                for (int bj = 0; bj < 2; ++bj) {
                    const u32x2 g0 = *(const u32x2*)(MG + row * 2048 + col0 + bj * 128), g1 = *(const u32x2*)(MG + row * 2048 + 1024 + col0 + bj * 128);
                    f32x4& v0 = acc[ai][bj][m][0]; f32x4& v1 = acc[ai][bj][m][1];
#pragma unroll
                    for (int j = 0; j < 4; ++j) { const float a0 = (float)((g0.x >> (8 * j)) & 255u), b0 = (float)((g1.x >> (8 * j)) & 255u), a1 = (float)((g0.y >> (8 * j)) & 255u), b1 = (float)((g1.y >> (8 * j)) & 255u);
                        v0[j] *= a0 * __builtin_amdgcn_rcpf(__builtin_fmaxf(b0, 0.5f)); v1[j] *= a1 * __builtin_amdgcn_rcpf(__builtin_fmaxf(b1, 0.5f)); } }
                asm volatile("" ::: "memory"); }
    }
    __device__ __forceinline__ void operator()(const AccT& acc, const pg8::Unit& u, int wr, int wc, int fr, int fq) const {
        const int row0 = u.pm * 256 + wr * 64 + fr; const int col0 = u.pn * 256 + wc * 32 + 8 * fq;
#pragma unroll
        for (int ai = 0; ai < 2; ++ai)
#pragma unroll
            for (int m = 0; m < 4; ++m) { const size_t row = (size_t)(row0 + ai * 128 + m * 16);
#pragma unroll
                for (int bj = 0; bj < 2; ++bj) {
                    const u32x2 g1 = *(const u32x2*)(MG + row * 2048 + 1024 + col0 + bj * 128);
                    const f32x4 v0 = acc[ai][bj][m][0], v1 = acc[ai][bj][m][1]; float r[8];
#pragma unroll
                    for (int j = 0; j < 4; ++j) { r[j] = v0[j] * (__builtin_fmaxf((float)((g1.x >> (8 * j)) & 255u), 0.5f) * (1.0f / 255.0f)); r[4 + j] = v1[j] * (__builtin_fmaxf((float)((g1.y >> (8 * j)) & 255u), 0.5f) * (1.0f / 255.0f)); }
                    u32x4 w; w.x = cvt_pk_bf16(r[0], r[1]); w.y = cvt_pk_bf16(r[2], r[3]); w.z = cvt_pk_bf16(r[4], r[5]); w.w = cvt_pk_bf16(r[6], r[7]);
                    *(u32x4*)(MERGED + row * 1024 + col0 + bj * 128) = w; }
                asm volatile("" ::: "memory"); }
    }
};
struct EpiOut {
    static constexpr bool PERM = true, AFTER_DRAIN = false;
    const float* xin; float* xout; const float* g1;
    __device__ __forceinline__ void operator()(const AccT& acc, const pg8::Unit& u, int wr, int wc, int fr, int fq) const {
        const int row0 = u.pm * 256 + wr * 64 + fr; const int col0 = u.pn * 256 + wc * 32 + 8 * fq; const int b = u.pm >> 4;
        f32x4 gv[2][2];
#pragma unroll
        for (int bj = 0; bj < 2; ++bj)
#pragma unroll
            for (int n = 0; n < 2; ++n) gv[bj][n] = *(const f32x4*)(g1 + (size_t)b * 6144 + col0 + bj * 128 + 4 * n);
#pragma unroll
        for (int ai = 0; ai < 2; ++ai)
#pragma unroll
            for (int m = 0; m < 4; ++m) { const size_t off = (size_t)(row0 + ai * 128 + m * 16) * 1024 + col0;
#pragma unroll
                for (int bj = 0; bj < 2; ++bj)
#pragma unroll
                    for (int n = 0; n < 2; ++n) { const f32x4 xv = *(const f32x4*)(xin + off + bj * 128 + 4 * n);
                        *(f32x4*)(xout + off + bj * 128 + 4 * n) = (ABL == 7) ? xv : xv + gv[bj][n] * acc[ai][bj][m][n]; }
                asm volatile("" ::: "memory"); }
    }
};
struct EpiMoe1 {
    static constexpr bool PERM = true, AFTER_DRAIN = false;
    bf16_t* ACT;
    __device__ __forceinline__ void operator()(const AccT& acc, const pg8::Unit& u, int wr, int wc, int fr, int fq) const {
        const int row0 = u.pm * 256 + wr * 64 + fr; const int col0 = u.pn * 128 + wc * 32 + 8 * fq;
#pragma unroll
        for (int ai = 0; ai < 2; ++ai)
#pragma unroll
            for (int m = 0; m < 4; ++m) { bf16_t* op = ACT + (size_t)(row0 + ai * 128 + m * 16) * 512 + col0; float r[8];
#pragma unroll
                for (int n = 0; n < 2; ++n)
#pragma unroll
                    for (int j = 0; j < 4; ++j) { const float a = acc[ai][0][m][n][j], bb = acc[ai][1][m][n][j]; r[n * 4 + j] = a * sigmoidf_(a) * bb; }
                u32x4 w; w.x = cvt_pk_bf16(r[0], r[1]); w.y = cvt_pk_bf16(r[2], r[3]); w.z = cvt_pk_bf16(r[4], r[5]); w.w = cvt_pk_bf16(r[6], r[7]);
                *(u32x4*)op = w; }
    }
};
struct EpiPlain {
    static constexpr bool PERM = true, AFTER_DRAIN = false;
    bf16_t* O; int ldc;
    __device__ __forceinline__ void operator()(const AccT& acc, const pg8::Unit& u, int wr, int wc, int fr, int fq) const {
        const int row0 = u.pm * 256 + wr * 64 + fr; const int col0 = u.pn * 256 + wc * 32 + 8 * fq;
#pragma unroll
        for (int ai = 0; ai < 2; ++ai)
#pragma unroll
            for (int m = 0; m < 4; ++m) { bf16_t* rowp = O + (size_t)(row0 + ai * 128 + m * 16) * ldc + col0;
#pragma unroll
                for (int bj = 0; bj < 2; ++bj) { const f32x4 v0 = acc[ai][bj][m][0], v1 = acc[ai][bj][m][1]; u32x4 w;
                    w.x = cvt_pk_bf16(v0[0], v0[1]); w.y = cvt_pk_bf16(v0[2], v0[3]); w.z = cvt_pk_bf16(v1[0], v1[1]); w.w = cvt_pk_bf16(v1[2], v1[3]);
                    *(u32x4*)(rowp + bj * 128) = w; } }
    }
};
__device__ __forceinline__ int crow(int r, int hi) { return (r & 3) + 8 * (r >> 2) + 4 * hi; }
__device__ __forceinline__ float gelu_tanh(float x) { const float u2 = 2.0f * 0.7978845608028654f * (x + 0.044715f * x * x * x); return x * __builtin_amdgcn_rcpf(1.0f + __builtin_amdgcn_exp2f(-u2 * LOG2E)); }
struct EpiCmp {
    static constexpr bool PERM = true, AFTER_DRAIN = true;
    bf16_t* HID; const float* CB1; const bf16_t* CW2T; bf16_t* KC;
    __device__ __forceinline__ void fused(const AccT& acc, const pg8::Unit& u, int wr, int wc, int fr, int fq, int wid, int lane) const {
        const int kv = u.pm >> 4; const int row0 = u.pm * 256 + wr * 64 + fr; const int col0 = wc * 32 + 8 * fq;
        const float* bias = CB1 + kv * 256;
        f32x4 bv[2][2];
#pragma unroll
        for (int bj = 0; bj < 2; ++bj)
#pragma unroll
            for (int n = 0; n < 2; ++n) bv[bj][n] = *(const f32x4*)(bias + col0 + bj * 128 + 4 * n);
#pragma unroll
        for (int ai = 0; ai < 2; ++ai)
#pragma unroll
            for (int m = 0; m < 4; ++m) { bf16_t* rowp = HID + (size_t)(row0 + ai * 128 + m * 16) * 256 + col0;
#pragma unroll
                for (int bj = 0; bj < 2; ++bj) { const f32x4 v0 = acc[ai][bj][m][0] + bv[bj][0], v1 = acc[ai][bj][m][1] + bv[bj][1]; u32x4 w;
                    w.x = cvt_pk_bf16(gelu_tanh(v0[0]), gelu_tanh(v0[1])); w.y = cvt_pk_bf16(gelu_tanh(v0[2]), gelu_tanh(v0[3]));
                    w.z = cvt_pk_bf16(gelu_tanh(v1[0]), gelu_tanh(v1[1])); w.w = cvt_pk_bf16(gelu_tanh(v1[2]), gelu_tanh(v1[3]));
                    *(u32x4*)(rowp + bj * 128) = w; } }
        VM_WAIT(); __syncthreads();
        const int r32 = lane & 31, hi = lane >> 5;
        const bf16_t* ap = HID + (size_t)(u.pm * 256 + 32 * wid + r32) * 256 + hi * 8;
        const bf16_t* bp = CW2T + (size_t)kv * 64 * 256 + (size_t)r32 * 256 + hi * 8;
        f32x16 o0 = {}, o1 = {};
#pragma unroll 4
        for (int ks = 0; ks < 16; ++ks) {
            const bf16x8 a = *(const bf16x8*)(ap + ks * 16);
            const bf16x8 b0 = *(const bf16x8*)(bp + ks * 16), b1 = *(const bf16x8*)(bp + 32 * 256 + ks * 16);
            o0 = __builtin_amdgcn_mfma_f32_32x32x16_bf16(a, b0, o0, 0, 0, 0);
            o1 = __builtin_amdgcn_mfma_f32_32x32x16_bf16(a, b1, o1, 0, 0, 0);
        }
        bf16_t* kc = KC + (size_t)u.pm * 256 * 64;
#pragma unroll
        for (int r = 0; r < 16; ++r) { const int c = 32 * wid + crow(r, hi); const bool pad = (c == 255);
            kc[(size_t)c * 64 + r32] = pad ? (bf16_t)0 : (bf16_t)(cvt_pk_bf16(o0[r], 0.f) & 0xffffu);
            kc[(size_t)c * 64 + 32 + r32] = pad ? (bf16_t)0 : (bf16_t)(cvt_pk_bf16(o1[r], 0.f) & 0xffffu); }
    }
};

namespace att {
constexpr int L_KR = 0;
constexpr int L_VR = 24576;
constexpr int L_WSF = 49152;
constexpr int L_BKT = 51200;
constexpr int L_BKC = 55296;
constexpr int L_TBH = 64000;
constexpr int L_GSH = 64576;
constexpr int L_SEL = 67648;
constexpr int L_OTA = 68672;
constexpr int L_IMP = 101440;
constexpr int L_LUT = 117824;
constexpr int L_END = L_LUT + 40960;
static_assert(L_END <= LDS_MISC, "attention LDS map");

__device__ __forceinline__ void glds16(const void* gsrc, unsigned lds_dst) { unsigned keep;
    asm volatile("s_mov_b32 %0, m0\n\ts_mov_b32 m0, %2\n\ts_nop 0\n\tglobal_load_lds_dwordx4 %1, off\n\ts_mov_b32 m0, %0" : "=&s"(keep) : "v"(gsrc), "s"(lds_dst) : "memory"); }
__device__ __forceinline__ int bucket_of(int d) {
    if (d < 16) return d;
    int b = 16;
    b += (d >= 22); b += (d >= 30); b += (d >= 40); b += (d >= 54); b += (d >= 73); b += (d >= 99); b += (d >= 134); b += (d >= 182);
    b += (d >= 246); b += (d >= 332); b += (d >= 450); b += (d >= 609); b += (d >= 825); b += (d >= 1117); b += (d >= 1513);
    return b;
}
__device__ __forceinline__ void qkt(f32x16& p0, f32x16& p1, const LAS unsigned char* Kslot, const bf16x8 (&qr)[4], int r32, int hi) {
    const LAS unsigned char* kb = Kslot + hi * 1024 + r32 * 16;
    p0 = (f32x16){}; p1 = (f32x16){};
#pragma unroll
    for (int d0 = 0; d0 < 4; ++d0) {
        const bf16x8 b0 = *(const LAS bf16x8*)(kb + d0 * 2048);
        const bf16x8 b1 = *(const LAS bf16x8*)(kb + d0 * 2048 + 512);
        p0 = __builtin_amdgcn_mfma_f32_32x32x16_bf16(b0, qr[d0], p0, 0, 0, 0);
        p1 = __builtin_amdgcn_mfma_f32_32x32x16_bf16(b1, qr[d0], p1, 0, 0, 0);
    }
}
__device__ __forceinline__ void pv(f32x16 (&o)[2], int vb, bf16x8 pa0, bf16x8 pa1, bf16x8 pa2, bf16x8 pa3) {
#pragma unroll
    for (int d0 = 0; d0 < 2; ++d0) { s16x4 lo[4], hi[4];
#pragma unroll
        for (int ks = 0; ks < 4; ++ks) {
            asm volatile("ds_read_b64_tr_b16 %0,%1 offset:%c2" : "=&v"(lo[ks]) : "v"(vb), "i"(d0 * 4096 + ks * 1024) : "memory");
            asm volatile("ds_read_b64_tr_b16 %0,%1 offset:%c2" : "=&v"(hi[ks]) : "v"(vb), "i"(d0 * 4096 + ks * 1024 + 512) : "memory"); }
        asm volatile("s_waitcnt lgkmcnt(0)" ::: "memory"); __builtin_amdgcn_sched_barrier(0);
#define PK(k) (bf16x8){lo[k][0], lo[k][1], lo[k][2], lo[k][3], hi[k][0], hi[k][1], hi[k][2], hi[k][3]}
        o[d0] = __builtin_amdgcn_mfma_f32_32x32x16_bf16(pa0, PK(0), o[d0], 0, 0, 0);
        o[d0] = __builtin_amdgcn_mfma_f32_32x32x16_bf16(pa1, PK(1), o[d0], 0, 0, 0);
        o[d0] = __builtin_amdgcn_mfma_f32_32x32x16_bf16(pa2, PK(2), o[d0], 0, 0, 0);
        o[d0] = __builtin_amdgcn_mfma_f32_32x32x16_bf16(pa3, PK(3), o[d0], 0, 0, 0);
#undef PK
    }
}
__device__ __forceinline__ float xhalf_max(float v) { auto rr = __builtin_amdgcn_permlane32_swap(__float_as_uint(v), __float_as_uint(v), false, false); return __builtin_fmaxf(__uint_as_float(rr[0]), __uint_as_float(rr[1])); }
__device__ __forceinline__ float xhalf_sum(float v) { auto rr = __builtin_amdgcn_permlane32_swap(__float_as_uint(v), __float_as_uint(v), false, false); return __uint_as_float(rr[0]) + __uint_as_float(rr[1]); }

#define ATT_PACK(p0, p1, pw0, pw1, pw2, pw3) do { \
    pw0 = (u32x4){cvt_pk_bf16(p0[0], p0[1]), cvt_pk_bf16(p0[2], p0[3]), cvt_pk_bf16(p0[4], p0[5]), cvt_pk_bf16(p0[6], p0[7])}; \
    pw1 = (u32x4){cvt_pk_bf16(p0[8], p0[9]), cvt_pk_bf16(p0[10], p0[11]), cvt_pk_bf16(p0[12], p0[13]), cvt_pk_bf16(p0[14], p0[15])}; \
    pw2 = (u32x4){cvt_pk_bf16(p1[0], p1[1]), cvt_pk_bf16(p1[2], p1[3]), cvt_pk_bf16(p1[4], p1[5]), cvt_pk_bf16(p1[6], p1[7])}; \
    pw3 = (u32x4){cvt_pk_bf16(p1[8], p1[9]), cvt_pk_bf16(p1[10], p1[11]), cvt_pk_bf16(p1[12], p1[13]), cvt_pk_bf16(p1[14], p1[15])}; } while (0)

__device__ __forceinline__ void stage_rows(LAS unsigned char* lds, int wid, int lane, const f32x16 (&ot)[2]) {
    const int r32 = lane & 31, hi = lane >> 5;
    LAS bf16_t* stg = (LAS bf16_t*)(lds + L_OTA) + wid * 2048;
#pragma unroll
    for (int r = 0; r < 16; ++r) { const int orow = crow(r, hi);
#pragma unroll
        for (int d0 = 0; d0 < 2; ++d0) stg[orow * 64 + d0 * 32 + r32] = (bf16_t)(cvt_pk_bf16(ot[d0][r], 0.f) & 0xffffu); }
    LDS_WAIT();
}
struct StreamP { const bf16_t* Kb; const bf16_t* Vb; long pitch; int NT; const LAS unsigned char* tl; unsigned long long lanesel; int uq; const LAS float* lut; int xtop; int dclamp; };
typedef const LAS unsigned char* lds_cptr;
typedef short v4i16_t __attribute__((ext_vector_type(4)));
__device__ __forceinline__ void kload8(bf16x8* kf, lds_cptr kp) {
    kf[0] = *(const LAS bf16x8*)(kp);        kf[1] = *(const LAS bf16x8*)(kp + 512);
    kf[2] = *(const LAS bf16x8*)(kp + 2048); kf[3] = *(const LAS bf16x8*)(kp + 2560);
    kf[4] = *(const LAS bf16x8*)(kp + 4096); kf[5] = *(const LAS bf16x8*)(kp + 4608);
    kf[6] = *(const LAS bf16x8*)(kp + 6144); kf[7] = *(const LAS bf16x8*)(kp + 6656);
}
__device__ __forceinline__ void kload2(bf16x8* kf, lds_cptr kp, int j) { kf[2 * j] = *(const LAS bf16x8*)(kp + j * 2048); kf[2 * j + 1] = *(const LAS bf16x8*)(kp + j * 2048 + 512); }
__device__ __forceinline__ s16x4 vtr(lds_cptr p) { return __builtin_bit_cast(s16x4, __builtin_amdgcn_ds_read_tr16_b64_v4i16((LAS v4i16_t*)p)); }
constexpr int SLOTB = 8192;
#define ST_WAIT_BAR(N) asm volatile("s_waitcnt vmcnt(" #N ") lgkmcnt(0)\n\ts_barrier" ::: "memory")
template <int THRL>
__device__ __forceinline__ void attn_stream(LAS unsigned char* lds, const int wid, const int lane, const bf16x8 (&qr)[4], const StreamP S, float& mhat_o, float& l_o, f32x16 (&o)[2]) {
    const int r32 = lane & 31, hi = lane >> 5;
    const unsigned lds0 = (unsigned)(uintptr_t)lds;
    LAS float* wsf = (LAS float*)(lds + L_WSF) + wid * 64;
    const int NT = S.NT;
    const bf16_t* ksrc = S.Kb + (long)lane * S.pitch + wid * 8;
    const bf16_t* vsrc = S.Vb + (long)(16 * (wid & 3) + (lane >> 2)) * S.pitch + (wid >> 2) * 32 + (lane & 3) * 8;
    const unsigned kdst = lds0 + L_KR + wid * 1024, vdst = lds0 + L_VR + wid * 1024;
    const int tlv = (lane < NT) ? (int)S.tl[lane] : 0x80;
#define TLRAW(k) ((int)__builtin_amdgcn_readlane(tlv, __builtin_amdgcn_readfirstlane(k)))
#define DMA_K(k, slot) do { const int tr_ = TLRAW(k) & 63; glds16(ksrc + (long)tr_ * 64 * S.pitch, (unsigned)__builtin_amdgcn_readfirstlane(kdst + (slot))); } while (0)
#define DMA_V(k, slot) do { const int tr_ = TLRAW(k) & 63; glds16(vsrc + (long)tr_ * 64 * S.pitch, (unsigned)__builtin_amdgcn_readfirstlane(vdst + (slot))); } while (0)
    const lds_cptr kp0 = (lds_cptr)lds + L_KR + hi * 1024 + r32 * 16;
    const lds_cptr vp0 = (lds_cptr)lds + L_VR + ((lane >> 4) & 1) * 32 + (lane & 3) * 8 + (4 * hi + ((lane & 15) >> 2)) * 64;
    const int vb0 = (int)(lds0 + L_VR) + ((lane >> 4) & 1) * 32 + (lane & 3) * 8 + (4 * hi + ((lane & 15) >> 2)) * 64;
    bf16x8 kf[8];
#define LOFF(r) (((r) & 3) + 8 * ((r) >> 2))
#define LUTPTR(k, lp) do { const int raw_ = TLRAW(k); const int tj_ = raw_ & 63; int d0_ = S.uq - 64 * tj_ - 4 * hi; d0_ = d0_ < S.dclamp ? d0_ : S.dclamp; \
        const bool ok_ = (raw_ < 128) && (((S.lanesel >> tj_) & 1ull) != 0ull); lp = S.lut + (ok_ ? S.xtop - d0_ : S.xtop + 64); } while (0)
#define LUTLOAD(C0, C1, k) do { const int raw_ = TLRAW(k); const int tj_ = raw_ & 63; int d0_ = S.uq - 64 * tj_ - 4 * hi; d0_ = d0_ < S.dclamp ? d0_ : S.dclamp; \
        const bool ok_ = (raw_ < 128) && (((S.lanesel >> tj_) & 1ull) != 0ull); const LAS float* lp_ = S.lut + (ok_ ? S.xtop - d0_ : S.xtop + 64); \
        _Pragma("unroll") for (int r = 0; r < 16; ++r) { C0[r] = lp_[(r & 3) + 8 * (r >> 2)]; C1[r] = lp_[(r & 3) + 8 * (r >> 2) + 32]; } } while (0)
#define SBAR() __builtin_amdgcn_sched_barrier(0)
#define PIN(x) asm volatile("" : "+v"(x))
#define PKW(P, B) cvt_pk_bf16(P[B], P[B + 1])
#define PAF(k) __builtin_bit_cast(bf16x8, pw##k)
#define VFR(i) (bf16x8){vlo[i][0], vlo[i][1], vlo[i][2], vlo[i][3], vhi[i][0], vhi[i][1], vhi[i][2], vhi[i][3]}
#define MX3(a, b, c) __builtin_fmaxf(__builtin_fmaxf((a), (b)), (c))
#define MFMA32(a, b, c) __builtin_amdgcn_mfma_f32_32x32x16_bf16(a, b, c, 0, 0, 0)
#define GAPA(MF, A0, A1, A2, A3, W0, W1, PW) do { MF; sacc += A0; sacc += A1; sacc += A2; sacc += A3; PIN(sacc); W0; W1; PIN(PW); SBAR(); } while (0)
#define EX(v) __builtin_amdgcn_exp2f(v)
#define GAPB(MF, X, B, GN, PL, PO) do { MF; X[B] = EX(X[B]); X[B + 1] = EX(X[B + 1]); X[B + 2] = EX(X[B + 2]); X[B + 3] = EX(X[B + 3]); PIN(X); \
        if (GN) { PL[B] = lpn_[LOFF(B) + PO]; PL[B + 1] = lpn_[LOFF(B + 1) + PO]; PL[B + 2] = lpn_[LOFF(B + 2) + PO]; PL[B + 3] = lpn_[LOFF(B + 3) + PO]; } SBAR(); } while (0)
#define VRD(i) do { vlo[i] = vtr(vp_ + (((i) >> 2) * 4096 + ((i) & 3) * 1024)); vhi[i] = vtr(vp_ + (((i) >> 2) * 4096 + ((i) & 3) * 1024 + 512)); } while (0)
#define KRD(G, j) do { if (G) { kload2(kf, kp0 + sl_next, j); SBAR(); } } while (0)
#define ROT() do { sl_prev = sl_cur; sl_cur = sl_next; sl_next = (sl_next == 2 * SLOTB) ? 0 : sl_next + SLOTB; } while (0)
#define RESC() do { if (resc) { LDS_WAIT(); _Pragma("unroll") for (int d_ = 0; d_ < 2; ++d_) _Pragma("unroll") for (int r = 0; r < 16; ++r) o[d_][r] *= wsf[crow(r, hi)]; } } while (0)
#define ENDW(tt) do { if ((tt) + 3 < NT) { ST_WAIT_BAR(2); } else if ((tt) + 2 < NT) { ST_WAIT_BAR(1); } else { ST_WAIT_BAR(0); } } while (0)
#define STEP(C0, C1, P0, P1, t, GK, GV, GL, GN) do { SBAR(); \
    const lds_cptr vp_ = vp0 + sl_prev; const LAS float* lpn_ = S.lut; if (GN) { LUTPTR((t) + 1, lpn_); } \
    VRD(0); SBAR(); float sacc = (P0[0] + P0[1]); \
    GAPA(C0 = MFMA32(kf[0], qr[0], C0), P0[2], P0[3], P0[4], P0[5],     pw0[0] = PKW(P0, 0), pw0[1] = PKW(P0, 2), pw0); \
    VRD(4); SBAR(); GAPA(C1 = MFMA32(kf[1], qr[0], C1), P0[6], P0[7], P0[8], P0[9],     pw0[2] = PKW(P0, 4), pw0[3] = PKW(P0, 6), pw0); \
    VRD(1); SBAR(); GAPA(C0 = MFMA32(kf[2], qr[1], C0), P0[10], P0[11], P0[12], P0[13], pw1[0] = PKW(P0, 8), pw1[1] = PKW(P0, 10), pw1); \
    VRD(5); SBAR(); GAPA(C1 = MFMA32(kf[3], qr[1], C1), P0[14], P0[15], P1[0], P1[1],   pw1[2] = PKW(P0, 12), pw1[3] = PKW(P0, 14), pw1); \
    VRD(2); SBAR(); GAPA(C0 = MFMA32(kf[4], qr[2], C0), P1[2], P1[3], P1[4], P1[5],     pw2[0] = PKW(P1, 0), pw2[1] = PKW(P1, 2), pw2); \
    VRD(6); SBAR(); GAPA(C1 = MFMA32(kf[5], qr[2], C1), P1[6], P1[7], P1[8], P1[9],     pw2[2] = PKW(P1, 4), pw2[3] = PKW(P1, 6), pw2); \
    VRD(3); SBAR(); GAPA(C0 = MFMA32(kf[6], qr[3], C0), P1[10], P1[11], P1[12], P1[13], pw3[0] = PKW(P1, 8), pw3[1] = PKW(P1, 10), pw3); \
    VRD(7); SBAR(); GAPA(C1 = MFMA32(kf[7], qr[3], C1), P1[14], P1[15], 0.f, 0.f,       pw3[2] = PKW(P1, 12), pw3[3] = PKW(P1, 14), pw3); \
    l_reg += sacc; \
    if (GK) { DMA_K((t) + 3, sl_cur); } if (GV) { DMA_V((t) + 1, sl_next); } \
    { _Pragma("unroll") for (int r = 0; r < 16; ++r) { C0[r] -= mhat; C1[r] -= mhat; } \
      float a_ = MX3(C0[0], C0[1], C1[0]), b_ = MX3(C0[2], C0[3], C1[1]); a_ = MX3(a_, C1[2], C1[3]); \
      _Pragma("unroll") for (int r = 4; r < 16; r += 4) { a_ = MX3(a_, C0[r], C0[r + 1]); b_ = MX3(b_, C0[r + 2], C0[r + 3]); a_ = MX3(a_, C1[r], C1[r + 1]); b_ = MX3(b_, C1[r + 2], C1[r + 3]); } \
      float rm = xhalf_max(__builtin_fmaxf(a_, b_)); \
      resc = false; \
      if (__builtin_expect(__any(rm > (float)THRL), 0)) { const float dl = __builtin_fmaxf(rm, 0.f); mhat += dl; \
        _Pragma("unroll") for (int r = 0; r < 16; ++r) { C0[r] -= dl; C1[r] -= dl; } \
        const float f = __builtin_amdgcn_exp2f(-dl); l_reg *= f; if (hi == 0) wsf[r32] = f; resc = true; } } \
    SBAR(); \
    GAPB(o[0] = MFMA32(PAF(0), VFR(0), o[0]), C0, 0, GN, P0, 0); \
    GAPB(o[1] = MFMA32(PAF(0), VFR(4), o[1]), C0, 4, GN, P0, 0); \
    KRD(GL, 0); GAPB(o[0] = MFMA32(PAF(1), VFR(1), o[0]), C0, 8, GN, P0, 0); \
    KRD(GL, 1); GAPB(o[1] = MFMA32(PAF(1), VFR(5), o[1]), C0, 12, GN, P0, 0); \
    KRD(GL, 2); GAPB(o[0] = MFMA32(PAF(2), VFR(2), o[0]), C1, 0, GN, P1, 32); \
    KRD(GL, 3); GAPB(o[1] = MFMA32(PAF(2), VFR(6), o[1]), C1, 4, GN, P1, 32); \
    GAPB(o[0] = MFMA32(PAF(3), VFR(3), o[0]), C1, 8, GN, P1, 32); \
    GAPB(o[1] = MFMA32(PAF(3), VFR(7), o[1]), C1, 12, GN, P1, 32); \
    } while (0)
    float mhat = 0.f, l_reg = 0.f; bool resc = false;
    o[0] = (f32x16){}; o[1] = (f32x16){};
    f32x16 pA0, pA1, pB0, pB1;
    int sl_prev = 0, sl_cur = 0, sl_next = SLOTB;
    DMA_K(0, 0); DMA_V(0, 0); DMA_K(1, SLOTB); DMA_K(2, 2 * SLOTB);
    LUTLOAD(pA0, pA1, 0);
    ST_WAIT_BAR(3);
    { const lds_cptr kb = kp0;
#pragma unroll
      for (int d0 = 0; d0 < 4; ++d0) { const bf16x8 b0 = *(const LAS bf16x8*)(kb + d0 * 2048); const bf16x8 b1 = *(const LAS bf16x8*)(kb + d0 * 2048 + 512);
          pA0 = MFMA32(b0, qr[d0], pA0); pA1 = MFMA32(b1, qr[d0], pA1); }
      float rm = pA0[0];
#pragma unroll
      for (int r = 1; r < 16; ++r) rm = __builtin_fmaxf(rm, pA0[r]);
#pragma unroll
      for (int r = 0; r < 16; ++r) rm = __builtin_fmaxf(rm, pA1[r]);
      rm = xhalf_max(rm);
      mhat = (rm == -INFINITY) ? 0.f : rm;
#pragma unroll
      for (int r = 0; r < 16; ++r) { pA0[r] = EX(pA0[r] - mhat); pA1[r] = EX(pA1[r] - mhat); } }
    ST_WAIT_BAR(0);
    DMA_K(3, 0); DMA_V(1, SLOTB);
    ROT();
    kload8(kf, kp0 + sl_cur);
    LUTLOAD(pB0, pB1, 1);
    ST_WAIT_BAR(2);
    s16x4 vlo[8], vhi[8]; u32x4 pw0, pw1, pw2, pw3;
    int t = 1;
    for (; t + 5 < NT; t += 2) {
        STEP(pB0, pB1, pA0, pA1, t, true, true, true, true);     ST_WAIT_BAR(2); RESC(); ROT();
        STEP(pA0, pA1, pB0, pB1, t + 1, true, true, true, true); ST_WAIT_BAR(2); RESC(); ROT();
    }
    for (; t + 1 < NT; t += 2) {
        STEP(pB0, pB1, pA0, pA1, t, (t + 3 < NT), (t + 1 < NT), (t + 1 < NT), true);       ENDW(t);     RESC(); ROT();
        STEP(pA0, pA1, pB0, pB1, t + 1, (t + 4 < NT), (t + 2 < NT), (t + 2 < NT), true);   ENDW(t + 1); RESC(); ROT();
    }
    STEP(pB0, pB1, pA0, pA1, NT - 1, false, false, false, false); RESC();
    { float sacc = pB0[0] + pB0[1];
#pragma unroll
      for (int r = 2; r < 16; ++r) sacc += pB0[r];
#pragma unroll
      for (int r = 0; r < 16; ++r) sacc += pB1[r];
      l_reg += sacc;
      ATT_PACK(pB0, pB1, pw0, pw1, pw2, pw3);
      SBAR(); pv(o, vb0 + sl_cur, PAF(0), PAF(1), PAF(2), PAF(3)); }
    asm volatile("s_waitcnt lgkmcnt(0)\n\ts_barrier" ::: "memory");
    mhat_o = mhat; l_o = l_reg;
#undef TLRAW
#undef DMA_K
#undef DMA_V
#undef LUTLOAD
#undef LUTPTR
#undef LOFF
#undef SBAR
#undef PIN
#undef PKW
#undef PAF
#undef VFR
#undef MX3
#undef MFMA32
#undef GAPA
#undef EX
#undef GAPB
#undef VRD
#undef KRD
#undef ROT
#undef RESC
#undef ENDW
#undef STEP
}
__device__ __forceinline__ void cmp_scores(f32x16& s0, f32x16& s1, LAS unsigned char* lds, const LAS unsigned char* bkc, const LAS unsigned char* tb, const bf16x8 (&qr)[4], const int k, const int r32, const int hi) {
#pragma unroll
    for (int r = 0; r < 16; ++r) { const int off = 16 * ((r & 3) + 8 * (r >> 2));
        s0[r] = *(const LAS float*)(tb + bkc[1024 * k + off]); s1[r] = *(const LAS float*)(tb + bkc[1024 * k + off + 512]); }
    const LAS unsigned char* kb = lds + k * 8192 + hi * 1024 + r32 * 16;
#pragma unroll
    for (int d0 = 0; d0 < 4; ++d0) { const bf16x8 b0 = *(const LAS bf16x8*)(kb + d0 * 2048); const bf16x8 b1 = *(const LAS bf16x8*)(kb + d0 * 2048 + 512);
        s0 = __builtin_amdgcn_mfma_f32_32x32x16_bf16(b0, qr[d0], s0, 0, 0, 0); s1 = __builtin_amdgcn_mfma_f32_32x32x16_bf16(b1, qr[d0], s1, 0, 0, 0); }
}
__device__ __forceinline__ float xhalf_other(float v, int hi) { auto rr = __builtin_amdgcn_permlane32_swap(__float_as_uint(v), __float_as_uint(v), false, false); return __uint_as_float(hi ? rr[0] : rr[1]); }
__device__ __forceinline__ void cmp_issue(LAS unsigned char* lds, const int wid, const int lane, const bf16_t* Kb, const bf16_t* Vb, const int nt) {
    const unsigned lds0 = (unsigned)(uintptr_t)lds;
    { const bf16_t* ksrc = Kb + (long)lane * 64 + wid * 8; const bf16_t* vsrc = Vb + (long)(16 * (wid & 3) + (lane >> 2)) * 64 + (wid >> 2) * 32 + (lane & 3) * 8;
      for (int k = 0; k < nt; ++k) { glds16(ksrc + (long)k * 4096, (unsigned)__builtin_amdgcn_readfirstlane(lds0 + k * 8192 + wid * 1024));
                                     glds16(vsrc + (long)k * 4096, (unsigned)__builtin_amdgcn_readfirstlane(lds0 + L_OTA + k * 8192 + wid * 1024)); } }
}
__device__ __forceinline__ void cmp_branch(LAS unsigned char* lds, const int wid, const int lane, const bf16x8 (&qr)[4], const int nt, const int t, f32x16 (&o)[2]) {
    const int r32 = lane & 31, hi = lane >> 5, g = wid >> 1, tq = (wid & 1) * 32 + r32;
    const unsigned lds0 = (unsigned)(uintptr_t)lds;
    const LAS unsigned char* bkc = lds + L_BKC + (4126 - t + 64 * hi);
    const LAS unsigned char* tb = lds + L_TBH + g * 144;
    asm volatile("s_waitcnt vmcnt(0) lgkmcnt(0)\n\ts_barrier" ::: "memory");
    float m = -INFINITY, l = 0.f;
#pragma clang loop unroll(disable)
    for (int k = 0; k < nt; ++k) { f32x16 s0, s1; cmp_scores(s0, s1, lds, bkc, tb, qr, k, r32, hi);
        float rm = s0[0];
#pragma unroll
        for (int r = 1; r < 16; ++r) rm = __builtin_fmaxf(rm, s0[r]);
#pragma unroll
        for (int r = 0; r < 16; ++r) rm = __builtin_fmaxf(rm, s1[r]);
        rm = xhalf_max(rm);
        const float mn = __builtin_fmaxf(m, rm), ms = (mn == -INFINITY) ? 0.f : mn;
        float ps = 0.f;
#pragma unroll
        for (int r = 0; r < 16; ++r) ps += __builtin_amdgcn_exp2f(s0[r] - ms) + __builtin_amdgcn_exp2f(s1[r] - ms);
        l = l * __builtin_amdgcn_exp2f(m - ms) + ps; m = mn; }
    l = xhalf_sum(l);
    const float msafe = (m == -INFINITY) ? 0.f : m, inv = l > 0.f ? 1.0f / l : 0.f;
    float I[4][8]; float pc7 = 0.f;
    o[0] = (f32x16){}; o[1] = (f32x16){};
    const int vb0 = (int)(lds0 + L_OTA) + ((lane >> 4) & 1) * 32 + (lane & 3) * 8 + (4 * hi + ((lane & 15) >> 2)) * 64;
#pragma unroll
    for (int k = 0; k < 4; ++k) {
        if (k < nt) { f32x16 s0, s1; cmp_scores(s0, s1, lds, bkc, tb, qr, k, r32, hi);
#pragma unroll
            for (int r = 0; r < 16; ++r) { s0[r] = __builtin_amdgcn_exp2f(s0[r] - msafe) * inv; s1[r] = __builtin_amdgcn_exp2f(s1[r] - msafe) * inv; }
            float pc[8];
#pragma unroll
            for (int q = 0; q < 4; ++q) { I[k][q] = 2.0f * (s0[4 * q] + s0[4 * q + 1] + s0[4 * q + 2]) + s0[4 * q + 3]; I[k][4 + q] = 2.0f * (s1[4 * q] + s1[4 * q + 1] + s1[4 * q + 2]) + s1[4 * q + 3];
                pc[q] = xhalf_other(s0[4 * q + 3], hi); pc[4 + q] = xhalf_other(s1[4 * q + 3], hi); }
#pragma unroll
            for (int j = 0; j < 8; ++j) I[k][j] += hi ? pc[j] : (j > 0 ? pc[j - 1] : pc7);
            pc7 = pc[7];
            u32x4 pw0, pw1, pw2, pw3; ATT_PACK(s0, s1, pw0, pw1, pw2, pw3);
            pv(o, vb0 + k * 8192, __builtin_bit_cast(bf16x8, pw0), __builtin_bit_cast(bf16x8, pw1), __builtin_bit_cast(bf16x8, pw2), __builtin_bit_cast(bf16x8, pw3));
        } else {
#pragma unroll
            for (int j = 0; j < 8; ++j) I[k][j] = 0.f;
        }
    }
    LAS float* imp = (LAS float*)(lds + L_IMP) + tq * 64 + hi;
#pragma unroll 1
    for (int gi = 0; gi < 4; ++gi) {
        if (g == gi) {
#pragma unroll
            for (int k = 0; k < 4; ++k) if (k < nt) {
#pragma unroll
                for (int j = 0; j < 8; ++j) __builtin_amdgcn_ds_faddf(imp + 16 * k + 2 * j, I[k][j], 0, 0, false);
            }
        }
        asm volatile("s_waitcnt lgkmcnt(0)\n\ts_barrier" ::: "memory");
    }
}
}

struct Ctx { int tid, lane, wave, vcu, G, bx; LAS unsigned char* lds; };

struct TrD { const float* src; size_t ldw; int nvalid; bf16_t* dst; size_t ldk; float fp8s; };
__device__ __forceinline__ void tr_load(const TrD& d, float (&v)[32], int lane) {
    const int n = lane & 31; const float* src = d.src + (size_t)(lane >> 5) * d.ldw + n;
#pragma unroll
    for (int i = 0; i < 32; ++i) v[i] = (n < d.nvalid) ? src[(size_t)(2 * i) * d.ldw] : 0.f;
}
__device__ __forceinline__ void tr_store(const TrD& d, const float (&v)[32], LAS float* scr, int lane) {
    const int n = lane & 31;
#pragma unroll
    for (int i = 0; i < 32; ++i) scr[(2 * i + (lane >> 5)) * 33 + n] = v[i];
    LDS_WAIT(); asm volatile("" ::: "memory");
    const int c = lane & 7;
#pragma unroll
    for (int j = 0; j < 4; ++j) { const int nn = (lane >> 3) + 8 * j; const LAS float* s = scr + (8 * c) * 33 + nn;
        if (d.fp8s != 0.f) { const float f = d.fp8s; u32x2 o;
            o.x = (unsigned)__builtin_amdgcn_cvt_pk_fp8_f32(s[0 * 33] * f, s[1 * 33] * f, 0, false); o.x = (unsigned)__builtin_amdgcn_cvt_pk_fp8_f32(s[2 * 33] * f, s[3 * 33] * f, (int)o.x, true);
            o.y = (unsigned)__builtin_amdgcn_cvt_pk_fp8_f32(s[4 * 33] * f, s[5 * 33] * f, 0, false); o.y = (unsigned)__builtin_amdgcn_cvt_pk_fp8_f32(s[6 * 33] * f, s[7 * 33] * f, (int)o.y, true);
            *(u32x2*)((unsigned char*)d.dst + (size_t)nn * d.ldk + 8 * c) = o;
        } else {
        u32x4 o; o.x = cvt_pk_bf16(s[0 * 33], s[1 * 33]); o.y = cvt_pk_bf16(s[2 * 33], s[3 * 33]); o.z = cvt_pk_bf16(s[4 * 33], s[5 * 33]); o.w = cvt_pk_bf16(s[6 * 33], s[7 * 33]);
        *(u32x4*)(d.dst + (size_t)nn * d.ldk + 8 * c) = o; } }
    LDS_WAIT(); asm volatile("" ::: "memory");
}
__device__ __forceinline__ TrD mk_trd(const float* W, size_t ldw, int srccol, int nvalid, bf16_t* WT, size_t ldk, int dstrow, int k0) {
    TrD d; d.src = W + (size_t)k0 * ldw + srccol; d.ldw = ldw; d.nvalid = nvalid; d.dst = WT + (size_t)dstrow * ldk + k0; d.ldk = ldk; d.fp8s = 0.f; return d; }
__device__ __forceinline__ TrD mk_trd8(const float* W, size_t ldw, int srccol, int nvalid, unsigned char* WT8, size_t ldk, int dstrow, int k0, float scale) {
    TrD d; d.src = W + (size_t)k0 * ldw + srccol; d.ldw = ldw; d.nvalid = nvalid; d.dst = (bf16_t*)(WT8 + (size_t)dstrow * ldk + k0); d.ldk = ldk; d.fp8s = scale; return d; }
__device__ __forceinline__ TrD dec_small(const Args& a, int it) {
    constexpr int I_WIN = 184 * 16, I_CW1 = 2 * 8 * 32, I_WUN = 32 * 8, I_WUD = 32 * 4, I_WO = 32 * 16, I_CW2 = 2 * 2 * 4;
    constexpr int PER = I_WIN + I_CW1 + I_WUN + I_WUD + I_WO + I_CW2;
    unsigned char* ws = a.ws;
    const int l = it / PER; int r = it % PER;
    if (r < I_WIN) { const int nb = r / 16, kb = r % 16; const int nd = 32 * nb; int src, nv = 32;
        if (nd < 1280) src = nd; else if (nd < 5632) src = nd + 24; else if (nd == 5632) { src = 1280; nv = 24; } else { src = 0; nv = 0; }
        return mk_trd8(a.w_in + (size_t)l * DM * INW, INW, src, nv, (unsigned char*)(ws + WS_WINT) + (size_t)l * NIN * DM, DM, nd, 64 * kb, 256.0f); }
    r -= I_WIN;
    if (r < I_CW1) { const int kv = r / 256, q = r % 256, nb = q / 32, kb = q % 32;
        return mk_trd(a.cmp_w1 + (size_t)(l * 2 + kv) * 2048 * 256, 256, 32 * nb, 32, (bf16_t*)(ws + WS_CW1T) + (size_t)(l * 2 + kv) * 256 * 2048, 2048, 32 * nb, 64 * kb); }
    r -= I_CW1;
    if (r < I_WUN) { const int nb = r / 8, kb = r % 8;
        return mk_trd(a.w_up_nsa + (size_t)l * 512 * 1024, 1024, 32 * nb, 32, (bf16_t*)(ws + WS_WUNT) + (size_t)l * 1024 * 512, 512, 32 * nb, 64 * kb); }
    r -= I_WUN;
    if (r < I_WUD) { const int nb = r / 4, kb = r % 4;
        return mk_trd(a.w_up_dil + (size_t)l * 256 * 1024, 1024, 32 * nb, 32, (bf16_t*)(ws + WS_WUDT) + (size_t)l * 1024 * 256, 256, 32 * nb, 64 * kb); }
    r -= I_WUD;
    if (r < I_WO) { const int nb = r / 16, kb = r % 16;
        return mk_trd(a.w_o + (size_t)l * 1024 * 1024, 1024, 32 * nb, 32, (bf16_t*)(ws + WS_WOT) + (size_t)l * 1024 * 1024, 1024, 32 * nb, 64 * kb); }
    r -= I_WO;
    { const int kv = r / 8, q = r % 8, nb = q / 4, kb = q % 4;
        return mk_trd(a.cmp_w2 + (size_t)(l * 2 + kv) * 256 * 64, 64, 32 * nb, 32, (bf16_t*)(ws + WS_CW2T) + (size_t)(l * 2 + kv) * 64 * 256, 256, 32 * nb, 64 * kb); }
}
__device__ __forceinline__ TrD dec_expert(const Args& a, int l, int it) {
    constexpr int I_13 = 32 * 16, I_2 = 32 * 8, PER = I_13 + I_2;
    unsigned char* ws = a.ws;
    const int e = it / PER; int r = it % PER;
    if (r < I_13) { const int nb = r / 16, kb = r % 16; const int r0 = 32 * nb, pn = r0 >> 8, bj = (r0 >> 7) & 1, j0 = r0 & 127;
        const float* src = (bj ? a.exp_w3 : a.exp_w1) + (size_t)(l * 32 + e) * 1024 * 512;
        return mk_trd(src, 512, pn * 128 + j0, 32, (bf16_t*)(ws + WS_E13T) + (size_t)e * 1024 * 1024, 1024, r0, 64 * kb); }
    r -= I_13;
    { const int nb = r / 8, kb = r % 8;
        return mk_trd(a.exp_w2 + (size_t)(l * 32 + e) * 512 * 1024, 1024, 32 * nb, 32, (bf16_t*)(ws + WS_E2T) + (size_t)e * 1024 * 512, 512, 32 * nb, 64 * kb); }
}
template <int KIND> __device__ __forceinline__ void conv_items(const Args& a, const Ctx& C, int l, int first, int nitems, LAS float* scr) {
    const int NGW = C.G * NWAVES;
    float va[32], vb[32]; TrD d0, d1;
    int it = first;
    if (it >= nitems) return;
    d0 = KIND ? dec_expert(a, l, it) : dec_small(a, it); tr_load(d0, va, C.lane);
    for (;;) {
        const int itn = it + NGW; const bool hn = itn < nitems;
        if (hn) { d1 = KIND ? dec_expert(a, l, itn) : dec_small(a, itn); tr_load(d1, vb, C.lane); }
        tr_store(d0, va, scr, C.lane);
        if (!hn) break;
        const int itnn = itn + NGW; const bool hnn = itnn < nitems;
        if (hnn) { d0 = KIND ? dec_expert(a, l, itnn) : dec_small(a, itnn); tr_load(d0, va, C.lane); }
        tr_store(d1, vb, scr, C.lane);
        if (!hnn) break;
        it = itnn;
    }
}
__device__ __forceinline__ void conv_small(const Args& a, const Ctx& C) { conv_items<0>(a, C, 0, C.vcu * NWAVES + C.wave, 2 * 4368, (LAS float*)(C.lds + C.wave * 16384)); }
__device__ __forceinline__ void conv_experts_slice(const Args& a, const Ctx& C, int l, int q) {
    const int NGW = C.G * NWAVES; const int per = 3 * NGW;
    LAS float* scr = (LAS float*)(C.lds + (C.wave < 5 ? C.wave * 8448 : att::L_OTA + (C.wave - 5) * 8448));
    const int lo = q * per, hi = (q == 3) ? 32 * 768 : ((q + 1) * per < 32 * 768 ? (q + 1) * per : 32 * 768);
    if (lo < hi) conv_items<1>(a, C, l, lo + C.vcu * NWAVES + C.wave, hi, scr);
}
__device__ __forceinline__ void prologue_vectors(const Args& a, const Ctx& C) {
    LAS float* sl = (LAS float*)(C.lds);
    LAS float* part = (LAS float*)(C.lds + 32768);
    for (int i = C.tid; i < 8 * 1024; i += NTHR) { const float v = a.c[i]; sl[i] = v * sigmoidf_(v); }
    __syncthreads();
    float* MOD = (float*)(a.ws + WS_MOD); float* CB1 = (float*)(a.ws + WS_CB1);
    for (int it = C.vcu; it < 192 + 16; it += C.G) {
        float acc[8];
#pragma unroll
        for (int b = 0; b < 8; ++b) acc[b] = 0.f;
        if (it < 192) { const int l = it / 96, col = (it % 96) * 64 + C.lane;
            const float* w = a.ada_w + (size_t)l * 1024 * 6144 + col;
            for (int k0 = 128 * C.wave; k0 < 128 * C.wave + 128; k0 += 32) { float wv[32];
#pragma unroll
                for (int j = 0; j < 32; ++j) wv[j] = w[(size_t)(k0 + j) * 6144];
#pragma unroll
                for (int j = 0; j < 32; ++j)
#pragma unroll
                    for (int b = 0; b < 8; ++b) acc[b] += sl[b * 1024 + k0 + j] * wv[j]; }
        } else { const int q = it - 192, lk = q / 4, col = (q % 4) * 64 + C.lane;
            const float* w = a.cmp_w1 + (size_t)lk * 2048 * 256 + col; const float* pos = a.cmp_pos + (size_t)lk * 2048;
            for (int k0 = 256 * C.wave; k0 < 256 * C.wave + 256; k0 += 32) { float wv[32];
#pragma unroll
                for (int j = 0; j < 32; ++j) wv[j] = w[(size_t)(k0 + j) * 256];
#pragma unroll
                for (int j = 0; j < 32; ++j) acc[0] += pos[k0 + j] * wv[j]; }
        }
        __syncthreads();
#pragma unroll
        for (int b = 0; b < 8; ++b) part[(C.wave * 8 + b) * 64 + C.lane] = acc[b];
        __syncthreads();
        if (C.wave == 0) {
            float tot[8];
#pragma unroll
            for (int b = 0; b < 8; ++b) { float t2 = 0.f;
#pragma unroll
                for (int w = 0; w < 8; ++w) t2 += part[(w * 8 + b) * 64 + C.lane];
                tot[b] = t2; }
            if (it < 192) { const int l = it / 96, col = (it % 96) * 64 + C.lane; const float bias = a.ada_b[l * 6144 + col];
#pragma unroll
                for (int b = 0; b < 8; ++b) MOD[(size_t)(l * 8 + b) * 6144 + col] = tot[b] + bias;
            } else { const int q = it - 192, lk = q / 4, col = (q % 4) * 64 + C.lane; CB1[lk * 256 + col] = tot[0]; }
        }
    }
    __syncthreads();
}

__device__ __forceinline__ void moe_combine_row(const Args& a, int row, int lane, const float* g2  , f32x4 (&v)[4]) {
    const u32x4 rec = *(const u32x4*)(a.ws + WS_DEST + (size_t)row * 16);
    const bf16_t* Y = (const bf16_t*)(a.ws + WS_XS);
    const float w0 = (ABL == 6) ? 0.f : __uint_as_float(rec.z), w1 = (ABL == 6) ? 0.f : __uint_as_float(rec.w);
    const u32x2* y0 = (const u32x2*)(Y + (size_t)rec.x * 1024) + lane; const u32x2* y1 = (const u32x2*)(Y + (size_t)rec.y * 1024) + lane;
#pragma unroll
    for (int j = 0; j < 4; ++j) { const u32x2 p = y0[64 * j], q = y1[64 * j]; const f32x4 gg = *((const f32x4*)g2 + lane + 64 * j);
        v[j][0] += gg[0] * (w0 * bf_lo(p.x) + w1 * bf_lo(q.x)); v[j][1] += gg[1] * (w0 * bf_hi(p.x) + w1 * bf_hi(q.x));
        v[j][2] += gg[2] * (w0 * bf_lo(p.y) + w1 * bf_lo(q.y)); v[j][3] += gg[3] * (w0 * bf_hi(p.y) + w1 * bf_hi(q.y)); }
}
__device__ __forceinline__ void norm1_phase(const Args& a, const Ctx& C, int l) {
    const int gw = C.vcu * NWAVES + C.wave, NGW = C.G * NWAVES;
    const float* MOD = (const float*)(a.ws + WS_MOD); bf16_t* H = (bf16_t*)(a.ws + WS_H);
    const float* nw = a.norm1 + l * 1024;
    for (int row = gw; row < T; row += NGW) {
        const int b = row >> 12; const float* xr = (l == 0 ? a.x : (const float*)a.out) + (size_t)row * 1024;
        f32x4 v[4];
#pragma unroll
        for (int j = 0; j < 4; ++j) v[j] = *((const f32x4*)xr + C.lane + 64 * j);
        if (l == 1) { moe_combine_row(a, row, C.lane, MOD + (size_t)(0 * 8 + b) * 6144 + 5120, v);
#pragma unroll
            for (int j = 0; j < 4; ++j) *((f32x4*)(a.out + (size_t)row * 1024) + C.lane + 64 * j) = v[j]; }
        float ss = 0.f;
#pragma unroll
        for (int j = 0; j < 4; ++j) ss += (v[j][0] * v[j][0] + v[j][1] * v[j][1]) + (v[j][2] * v[j][2] + v[j][3] * v[j][3]);
        const float rstd = 1.0f / sqrtf(wave_sum(ss) * (1.0f / 1024.0f) + RMS_EPS);
        const float* mb = MOD + (size_t)(l * 8 + b) * 6144;
#pragma unroll
        for (int j = 0; j < 4; ++j) { const f32x4 g = *((const f32x4*)nw + C.lane + 64 * j), sh = *((const f32x4*)mb + C.lane + 64 * j), sc = *((const f32x4*)(mb + 1024) + C.lane + 64 * j);
            const f32x4 h = (v[j] * rstd * g * (sc + 1.0f) + sh) * 8.0f; unsigned w = (unsigned)__builtin_amdgcn_cvt_pk_fp8_f32(h[0], h[1], 0, false); w = (unsigned)__builtin_amdgcn_cvt_pk_fp8_f32(h[2], h[3], (int)w, true);
            *((unsigned*)((unsigned char*)H + (size_t)row * 1024) + C.lane + 64 * j) = w; }
    }
}
__device__ __forceinline__ void final_phase(const Args& a, const Ctx& C) {
    const int gw = C.vcu * NWAVES + C.wave, NGW = C.G * NWAVES;
    const float* MOD = (const float*)(a.ws + WS_MOD);
    for (int row = gw; row < T; row += NGW) {
        const int b = row >> 12; float* xr = a.out + (size_t)row * 1024;
        f32x4 v[4];
#pragma unroll
        for (int j = 0; j < 4; ++j) v[j] = *((const f32x4*)xr + C.lane + 64 * j);
        moe_combine_row(a, row, C.lane, MOD + (size_t)(1 * 8 + b) * 6144 + 5120, v);
        float ss = 0.f;
#pragma unroll
        for (int j = 0; j < 4; ++j) ss += (v[j][0] * v[j][0] + v[j][1] * v[j][1]) + (v[j][2] * v[j][2] + v[j][3] * v[j][3]);
        const float rstd = 1.0f / sqrtf(wave_sum(ss) * (1.0f / 1024.0f) + RMS_EPS);
#pragma unroll
        for (int j = 0; j < 4; ++j) { const f32x4 g = *((const f32x4*)a.norm_f + C.lane + 64 * j); *((f32x4*)xr + C.lane + 64 * j) = v[j] * rstd * g; }
    }
}
typedef float f32x4v __attribute__((ext_vector_type(4)));
__device__ __forceinline__ void norm2_router_phase(const Args& a, const Ctx& C, int l) {
    constexpr int RP = 2064;
    LAS unsigned char* HH = C.lds; LAS unsigned char* HL = C.lds + 16 * RP;
    LAS float* PART = (LAS float*)(C.lds + 2 * 16 * RP);
    LAS float* LOGI = PART + 8 * 16 * 48;
    LAS int* wcnt = (LAS int*)(C.lds + LDS_MISC + 256);
    const float* wg = a.router_wg + (size_t)l * 1024 * 4; const float* we = a.router_we + (size_t)l * 1024 * 32;
    const int lane = C.lane, wave = C.wave, fr = lane & 15, fq = lane >> 4;
    bf16x8 Wh[4][3], Wl[4][3];
#pragma unroll
    for (int ks = 0; ks < 4; ++ks)
#pragma unroll
        for (int ct = 0; ct < 3; ++ct) { const int cc = 16 * ct + fr; const int k0 = 128 * wave + 32 * ks + 8 * fq; unsigned hw[4], lw[4];
#pragma unroll
            for (int i = 0; i < 8; i += 2) { float v0 = 0.f, v1 = 0.f;
                if (cc < 4) { v0 = wg[(size_t)(k0 + i) * 4 + cc]; v1 = wg[(size_t)(k0 + i + 1) * 4 + cc]; }
                else if (cc < 36) { v0 = we[(size_t)(k0 + i) * 32 + cc - 4]; v1 = we[(size_t)(k0 + i + 1) * 32 + cc - 4]; }
                const unsigned hp = cvt_pk_bf16(v0, v1); hw[i >> 1] = hp; lw[i >> 1] = cvt_pk_bf16(v0 - bf_lo(hp), v1 - bf_hi(hp)); }
            Wh[ks][ct] = __builtin_bit_cast(bf16x8, (u32x4){hw[0], hw[1], hw[2], hw[3]}); Wl[ks][ct] = __builtin_bit_cast(bf16x8, (u32x4){lw[0], lw[1], lw[2], lw[3]}); }
    const float* MOD = (const float*)(a.ws + WS_MOD); bf16_t* H2 = (bf16_t*)(a.ws + WS_H2);
    const float* nw = a.norm2 + l * 1024; const float* bg = a.router_bg + l * 4; const float* be = a.router_be + l * 32;
    int* CNTBLK = (int*)(a.ws + WS_CNTBLK);
    for (int ch = C.vcu; ch < T / 128; ch += C.G) {
        int my_e0 = 0, my_e1 = 0; float my_w0 = 0.f, my_w1 = 0.f;
#pragma clang loop unroll(disable)
        for (int gi = 0; gi < 8; ++gi) {
            { const int row0 = ch * 128 + gi * 16 + 2 * wave; const int b = row0 >> 12;
              f32x4 v[2][4];
#pragma unroll
              for (int rr = 0; rr < 2; ++rr)
#pragma unroll
                  for (int q = 0; q < 4; ++q) v[rr][q] = *((const f32x4*)(a.out + (size_t)(row0 + rr) * 1024) + lane + 64 * q);
              const float* mb = MOD + (size_t)(l * 8 + b) * 6144 + 3072;
#pragma unroll
              for (int rr = 0; rr < 2; ++rr) { float ss = 0.f;
#pragma unroll
                  for (int q = 0; q < 4; ++q) ss += (v[rr][q][0] * v[rr][q][0] + v[rr][q][1] * v[rr][q][1]) + (v[rr][q][2] * v[rr][q][2] + v[rr][q][3] * v[rr][q][3]);
                  const float rstd = 1.0f / sqrtf(wave_sum(ss) * (1.0f / 1024.0f) + RMS_EPS);
#pragma unroll
                  for (int q = 0; q < 4; ++q) { const f32x4 g = *((const f32x4*)nw + lane + 64 * q), sh = *((const f32x4*)mb + lane + 64 * q), sc = *((const f32x4*)(mb + 1024) + lane + 64 * q);
                      const f32x4 h = v[rr][q] * rstd * g * (sc + 1.0f) + sh;
                      u32x2 hw; hw.x = cvt_pk_bf16(h[0], h[1]); hw.y = cvt_pk_bf16(h[2], h[3]);
                      u32x2 lw; lw.x = cvt_pk_bf16(h[0] - bf_lo(hw.x), h[1] - bf_hi(hw.x)); lw.y = cvt_pk_bf16(h[2] - bf_lo(hw.y), h[3] - bf_hi(hw.y));
                      *((u32x2*)(H2 + (size_t)(row0 + rr) * 1024) + lane + 64 * q) = hw;
                      *(LAS u32x2*)(HH + (2 * wave + rr) * RP + (4 * lane + 256 * q) * 2) = hw; *(LAS u32x2*)(HL + (2 * wave + rr) * RP + (4 * lane + 256 * q) * 2) = lw; } }
            }
            __syncthreads();
            { f32x4v acc[3]; acc[0] = (f32x4v){0.f, 0.f, 0.f, 0.f}; acc[1] = acc[0]; acc[2] = acc[0];
#pragma unroll
              for (int ks = 0; ks < 4; ++ks) { const int ko = (128 * wave + 32 * ks + 8 * fq) * 2;
                  const bf16x8 ah = *(const LAS bf16x8*)(HH + fr * RP + ko), al = *(const LAS bf16x8*)(HL + fr * RP + ko);
#pragma unroll
                  for (int ct = 0; ct < 3; ++ct) { acc[ct] = __builtin_amdgcn_mfma_f32_16x16x32_bf16(Wh[ks][ct], ah, acc[ct], 0, 0, 0);
                      acc[ct] = __builtin_amdgcn_mfma_f32_16x16x32_bf16(Wh[ks][ct], al, acc[ct], 0, 0, 0); acc[ct] = __builtin_amdgcn_mfma_f32_16x16x32_bf16(Wl[ks][ct], ah, acc[ct], 0, 0, 0); } }
#pragma unroll
              for (int ct = 0; ct < 3; ++ct) *(LAS f32x4v*)(PART + (wave * 16 + fr) * 48 + 16 * ct + 4 * fq) = acc[ct]; }
            __syncthreads();
            { const int row = C.tid >> 5, c = C.tid & 31;
              { float sacc = 0.f;
#pragma unroll
                for (int w = 0; w < 8; ++w) sacc += PART[(w * 16 + row) * 48 + c];
                LOGI[row * 48 + c] = sacc + (c < 4 ? bg[c] : be[c - 4]); }
              if (c < 4) { float sacc = 0.f;
#pragma unroll
                for (int w = 0; w < 8; ++w) sacc += PART[(w * 16 + row) * 48 + 32 + c];
                LOGI[row * 48 + 32 + c] = sacc + be[28 + c]; } }
            __syncthreads();
            if (wave == gi && lane < 16) { const LAS float* lg = LOGI + lane * 48;
                int grp = 0; float gmax = lg[0];
#pragma unroll
                for (int c = 1; c < 4; ++c) if (lg[c] > gmax) { gmax = lg[c]; grp = c; }
                float gs = 0.f;
#pragma unroll
                for (int c = 0; c < 4; ++c) gs += __builtin_amdgcn_exp2f((lg[c] - gmax) * LOG2E);
                const float pgrp = 1.0f / gs;
                float le[8];
#pragma unroll
                for (int e = 0; e < 8; ++e) le[e] = lg[4 + grp * 8 + e];
                int i0 = 0; float v0 = le[0];
#pragma unroll
                for (int e = 1; e < 8; ++e) if (le[e] > v0) { v0 = le[e]; i0 = e; }
                int i1 = -1; float v1 = -INFINITY;
#pragma unroll
                for (int e = 0; e < 8; ++e) if (e != i0 && le[e] > v1) { v1 = le[e]; i1 = e; }
                const float ex = __builtin_amdgcn_exp2f((v1 - v0) * LOG2E);
                my_e0 = grp * 8 + i0; my_e1 = grp * 8 + i1; my_w0 = pgrp / (1.0f + ex); my_w1 = pgrp * ex / (1.0f + ex); }
        }
        const int ea = bperm_i(C.lane >> 1, my_e0), eb = bperm_i(C.lane >> 1, my_e1);
        const int es = (C.lane < 32) ? ((C.lane & 1) ? eb : ea) : -1;
        int rank = 0, cnt = 0;
#pragma unroll
        for (int s2 = 0; s2 < 32; ++s2) { const int v = __builtin_amdgcn_readlane(es, s2); rank += (v == es && s2 < C.lane) ? 1 : 0; cnt += (v == C.lane) ? 1 : 0; }
        __syncthreads();
        if (C.lane < 32) wcnt[C.wave * 32 + C.lane] = cnt;
        __syncthreads();
        int lrank = rank;
        if (C.lane < 32) { for (int w = 0; w < C.wave; ++w) lrank += wcnt[w * 32 + es]; }
        if (C.wave == 0 && C.lane < 32) { int tot = 0;
#pragma unroll
            for (int w = 0; w < 8; ++w) tot += wcnt[w * 32 + C.lane];
            CNTBLK[ch * 32 + C.lane] = tot; }
        const int lr0 = bperm_i((2 * C.lane) & 63, lrank), lr1 = bperm_i((2 * C.lane + 1) & 63, lrank);
        if (C.lane < 16) { const int row = ch * 128 + C.wave * 16 + C.lane;
            u32x4 rec; rec.x = (unsigned)my_e0 | ((unsigned)my_e1 << 8); rec.y = (unsigned)lr0 | ((unsigned)lr1 << 16); rec.z = __float_as_uint(my_w0); rec.w = __float_as_uint(my_w1);
            *(u32x4*)(a.ws + WS_REC + (size_t)row * 16) = rec; }
    }
}
__device__ __forceinline__ void moe_scatter_phase(const Args& a, const Ctx& C) {
    LAS int* part_lt = (LAS int*)(C.lds);
    LAS int* part_all = part_lt + 512;
    LAS int* base = part_all + 512;
    LAS int* tot = base + 32;
    LAS int* pst = tot + 32;
    const int* CNTBLK = (const int*)(a.ws + WS_CNTBLK);
    int* TILEE = (int*)(a.ws + WS_TILEE);
    int* TOKL = (int*)(a.ws + WS_TOKL);
    for (int ch = C.vcu; ch < T / 128; ch += C.G) {
        __syncthreads();
        { const int e = C.tid & 31, p = C.tid >> 5; int slt = 0, sall = 0;
            for (int c = p; c < T / 128; c += 16) { const int v = CNTBLK[c * 32 + e]; sall += v; slt += (c < ch) ? v : 0; }
            part_lt[p * 32 + e] = slt; part_all[p * 32 + e] = sall; }
        __syncthreads();
        if (C.tid < 32) { int b = 0, t2 = 0;
#pragma unroll
            for (int p = 0; p < 16; ++p) { b += part_lt[p * 32 + C.tid]; t2 += part_all[p * 32 + C.tid]; }
            base[C.tid] = b; tot[C.tid] = t2; }
        __syncthreads();
        if (C.tid < 32) { int ps = 0; for (int e = 0; e < C.tid; ++e) ps += (tot[e] + 255) & ~255; pst[C.tid] = ps;
            if (ch == 0) { const int nt = (tot[C.tid] + 255) >> 8; const int t0 = ps >> 8; for (int m = 0; m < nt; ++m) TILEE[16 + t0 + m] = C.tid; if (C.tid == 31) TILEE[0] = t0 + nt; } }
        __syncthreads();
        int d0 = 0, d1 = 0;
        if (C.lane < 16) { const int row = ch * 128 + C.wave * 16 + C.lane;
            const u32x4 rec = *(const u32x4*)(a.ws + WS_REC + (size_t)row * 16);
            const int e0 = rec.x & 255, e1 = (rec.x >> 8) & 255;
            d0 = pst[e0] + base[e0] + (int)(rec.y & 0xffffu); d1 = pst[e1] + base[e1] + (int)(rec.y >> 16);
            u32x4 o; o.x = (unsigned)d0; o.y = (unsigned)d1; o.z = rec.z; o.w = rec.w;
            *(u32x4*)(a.ws + WS_DEST + (size_t)row * 16) = o; }
        if (C.lane < 16) { const int row = ch * 128 + C.wave * 16 + C.lane; TOKL[d0] = row; TOKL[d1] = row; }
        if (ch == 0) {
            for (int e = 0; e < 32; ++e) { const int lo = pst[e] + tot[e], hi = pst[e] + ((tot[e] + 255) & ~255);
                for (int k = lo + C.tid; k < hi; k += NTHR) TOKL[k] = 0; } }
    }
}
struct MoeOrder {
    int G, c, nu; int ex[8]; const char* A; const char* B; size_t tA, tB, eB;
    __device__ __forceinline__ bool next(int i, pg8::Unit& u) const {
        const int L = i * G + c; if (i >= 8 || L >= nu) return false;
        const int e = i == 0 ? ex[0] : i == 1 ? ex[1] : i == 2 ? ex[2] : i == 3 ? ex[3] : i == 4 ? ex[4] : i == 5 ? ex[5] : i == 6 ? ex[6] : ex[7];
        u.pm = L >> 2; u.pn = L & 3; u.A = A + (size_t)u.pm * tA; u.B = B + (size_t)e * eB + (size_t)u.pn * tB; return true;
    }
};

__device__ __forceinline__ void dil_unit(const Args& a, const Ctx& C, int du) {
    using namespace att;
    LAS unsigned char* lds = C.lds;
    const int x = du & 15; int r = du >> 4; const int h = r & 3; r >>= 2; const int grp = r % 3, b = r / 3;
    const int dsh = 2 * grp, d = 1 << dsh; const int nub = 16 >> dsh; const int res = x / nub, ub = x % nub;
    const int wid = C.wave, lane = C.lane, r32 = lane & 31, hi = lane >> 5;
    LAS float* lut = (LAS float*)(lds + L_LUT);
    LAS unsigned char* tl = lds + L_SEL + 768;
    __syncthreads();
    for (int e = C.tid; e < 704; e += NTHR) { const int m = 384 - e; float v = -INFINITY;
        if (m >= 0 && m <= 128) { int di = m << dsh; di = di > 4095 ? 4095 : di; v = a.rel_bias[(int)lds[L_BKT + di] * 20 + 8 + grp * 4 + h] * LOG2E; }
        lut[e] = v; }
    if (C.tid < 6) { const int kt = 4 * ub - 2 + C.tid; tl[C.tid] = (unsigned char)(kt < 0 ? 0x80 : kt); }
    const bf16_t* QKV = (const bf16_t*)(a.ws + WS_A);
    const int u = 256 * ub + 32 * wid + r32; const size_t tokq = (size_t)b * SEQ + (size_t)u * d + res;
    const bf16_t* qp = QKV + tokq * LDQ + 1280 + grp * 256 + h * 64;
    bf16x8 qr[4];
#pragma unroll
    for (int d0 = 0; d0 < 4; ++d0) qr[d0] = *(const bf16x8*)(qp + d0 * 16 + hi * 8);
    __syncthreads();
    StreamP S; S.Kb = QKV + ((size_t)b * SEQ + res) * LDQ + 1280 + 768 + grp * 256 + h * 64; S.Vb = S.Kb + 768; S.pitch = (long)d * LDQ;
    S.NT = 6; S.tl = tl; S.lanesel = ~0ull; S.uq = u; S.lut = lut; S.xtop = 384; S.dclamp = 1 << 30;
    float m = 0.f, l = 0.f; f32x16 o[2];
    attn_stream<8>(lds, wid, lane, qr, S, m, l, o);
    l = xhalf_sum(l);
    LAS float* wsf = (LAS float*)(lds + L_WSF) + wid * 64;
    if (hi == 0) { wsf[r32] = l > 0.f ? 1.0f / l : 0.f; ((float*)(a.ws + WS_LSE))[((size_t)grp * T + tokq) * 4 + h] = m + __builtin_amdgcn_logf(l); }
    LDS_WAIT();
#pragma unroll
    for (int rr = 0; rr < 16; ++rr) { const float f = wsf[crow(rr, hi)]; o[0][rr] *= f; o[1][rr] *= f; }
    stage_rows(lds, wid, lane, o);
    bf16_t* ODP = (bf16_t*)(a.ws + WS_ODP) + (size_t)grp * T * 256;
    const LAS bf16_t* stg = (const LAS bf16_t*)(lds + L_OTA) + wid * 2048;
#pragma unroll
    for (int i = 0; i < 4; ++i) { const int row = i * 8 + (lane >> 3), chn = lane & 7; const u32x4 v = *(const LAS u32x4*)(stg + row * 64 + chn * 8);
        const size_t tok = (size_t)b * SEQ + (size_t)(256 * ub + 32 * wid + row) * d + res;
        *(u32x4*)(ODP + tok * 256 + h * 64 + chn * 8) = v; }
}
__device__ __forceinline__ void dil_combine(const Args& a, const Ctx& C) {
    const float* LSE = (const float*)(a.ws + WS_LSE); const bf16_t* ODP = (const bf16_t*)(a.ws + WS_ODP); bf16_t* ODIL = (bf16_t*)(a.ws + WS_ODIL);
    const int gt = C.vcu * NTHR + C.tid, NT = C.G * NTHR;
    for (int idx = gt; idx < T * 32; idx += NT) {
        const int tok = idx >> 5, h = (idx >> 3) & 3, chn = idx & 7;
        const float l0 = LSE[((size_t)0 * T + tok) * 4 + h], l1 = LSE[((size_t)1 * T + tok) * 4 + h], l2 = LSE[((size_t)2 * T + tok) * 4 + h];
        const float mx = __builtin_fmaxf(l0, __builtin_fmaxf(l1, l2));
        float w0 = __builtin_amdgcn_exp2f(l0 - mx), w1 = __builtin_amdgcn_exp2f(l1 - mx), w2 = __builtin_amdgcn_exp2f(l2 - mx);
        const float inv = 1.0f / (w0 + w1 + w2); w0 *= inv; w1 *= inv; w2 *= inv;
        const size_t off = (size_t)tok * 256 + h * 64 + chn * 8;
        const u32x4 a0 = *(const u32x4*)(ODP + off), a1 = *(const u32x4*)(ODP + (size_t)T * 256 + off), a2 = *(const u32x4*)(ODP + (size_t)2 * T * 256 + off);
        u32x4 o;
        o.x = cvt_pk_bf16(w0 * bf_lo(a0.x) + w1 * bf_lo(a1.x) + w2 * bf_lo(a2.x), w0 * bf_hi(a0.x) + w1 * bf_hi(a1.x) + w2 * bf_hi(a2.x));
        o.y = cvt_pk_bf16(w0 * bf_lo(a0.y) + w1 * bf_lo(a1.y) + w2 * bf_lo(a2.y), w0 * bf_hi(a0.y) + w1 * bf_hi(a1.y) + w2 * bf_hi(a2.y));
        o.z = cvt_pk_bf16(w0 * bf_lo(a0.z) + w1 * bf_lo(a1.z) + w2 * bf_lo(a2.z), w0 * bf_hi(a0.z) + w1 * bf_hi(a1.z) + w2 * bf_hi(a2.z));
        o.w = cvt_pk_bf16(w0 * bf_lo(a0.w) + w1 * bf_lo(a1.w) + w2 * bf_lo(a2.w), w0 * bf_hi(a0.w) + w1 * bf_hi(a1.w) + w2 * bf_hi(a2.w));
        if (ABL == 4) o = (u32x4){0u, 0u, 0u, 0u};
        *(u32x4*)(ODIL + off) = o;
    }
}
template <bool INIT>
__device__ __forceinline__ void ota_update(LAS bf16_t* ota  , const LAS float* frow, int hi, const f32x16 (&o)[2]) {
#pragma unroll
    for (int r = 0; r < 16; ++r) { const int row = crow(r, hi); const float f = frow[row];
        float v0 = f * o[0][r], v1 = f * o[1][r];
        if (!INIT) { v0 += __uint_as_float((unsigned)ota[row * 64] << 16); v1 += __uint_as_float((unsigned)ota[row * 64 + 32] << 16); }
        ota[row * 64] = (bf16_t)(cvt_pk_bf16(v0, 0.f) & 0xffffu); ota[row * 64 + 32] = (bf16_t)(cvt_pk_bf16(v1, 0.f) & 0xffffu); }
}
#define NSA_T0(which) do { if (TNSA == (which) && blockIdx.x == 0 && wid == 0 && lane_id_fresh() == 0) { volatile LAS unsigned* M_ = (volatile LAS unsigned*)(lds + LDS_MISC); const unsigned long long t_ = __builtin_amdgcn_s_memrealtime(); M_[20] = (unsigned)t_; M_[21] = (unsigned)(t_ >> 32); } } while (0)
#define NSA_T1(which) do { if (TNSA == (which) && blockIdx.x == 0 && wid == 0 && lane_id_fresh() == 0) { volatile LAS unsigned* M_ = (volatile LAS unsigned*)(lds + LDS_MISC); const unsigned long long t_ = __builtin_amdgcn_s_memrealtime(); const unsigned long long t0_ = ((unsigned long long)M_[21] << 32) | M_[20]; \
        const unsigned long long d_ = (((unsigned long long)M_[23] << 32) | M_[22]) + (t_ - t0_); M_[22] = (unsigned)d_; M_[23] = (unsigned)(d_ >> 32); } } while (0)
#define NSA_SECT() const int lane = lane_id_fresh(); const int tid = wid * 64 + lane; const int r32 = lane & 31, hi = lane >> 5; (void)tid; (void)r32; (void)hi
__device__ __forceinline__ void nsa_unit(const Args& a, const Ctx& C, int b, int hk, int i) {
    using namespace att;
    LAS unsigned char* lds = C.lds;
    const int wid = C.wave; const int g = wid >> 1;
    const bf16_t* QKV = (const bf16_t*)(a.ws + WS_A);
    bf16x8 qr[4];
    f32x16 o[2];
    __syncthreads();
    NSA_T0(2);
    { NSA_SECT();
        const int tq = (wid & 1) * 32 + r32, t = 64 * i + tq; const size_t tok = (size_t)b * SEQ + t;
        LAS float* imp = (LAS float*)(lds + L_IMP); LAS float* gsh = (LAS float*)(lds + L_GSH) + wid * 96; LAS unsigned* selw = (LAS unsigned*)(lds + L_SEL);
        const bf16_t* KC = (const bf16_t*)(a.ws + WS_KC); const int nt = (4 * i + 2) / 64 + 1;
        cmp_issue(lds, wid, lane, KC + (size_t)((0 * 8 + b) * 2 + hk) * 256 * 64, KC + (size_t)((1 * 8 + b) * 2 + hk) * 256 * 64, nt);
        const bf16_t* qp = QKV + tok * LDQ + hk * 256 + g * 64;
#pragma unroll
        for (int d0 = 0; d0 < 4; ++d0) qr[d0] = *(const bf16x8*)(qp + d0 * 16 + hi * 8);
        float g0 = 0.f, g1 = 0.f, g2 = 0.f;
        if (hi == 0) { const float* gn = (const float*)(a.ws + WS_GN) + tok * 32 + hk * 4 + g; g0 = gn[0]; g1 = gn[8]; g2 = gn[16]; }
        for (int e = tid; e < 64 * 64; e += NTHR) imp[e] = 0.f;
        if (tid < 2) selw[128 + tid] = 0u;
        if (hi == 0) { gsh[r32] = (ABL == 1) ? 0.f : g0; gsh[32 + r32] = (ABL == 2) ? 0.f : g1; gsh[64 + r32] = (ABL == 3) ? 0.f : g2; }
        cmp_branch(lds, wid, lane, qr, nt, t, o);
        ota_update<true>((LAS bf16_t*)(lds + L_OTA) + wid * 2048 + r32, gsh, hi, o);
    }
    __syncthreads();
    NSA_T1(2);
    { NSA_SECT();
        LAS float* impP = (LAS float*)(lds + L_IMP); LAS unsigned* selw = (LAS unsigned*)(lds + L_SEL);
        const int q = tid >> 3, part = tid & 7;
        const int ncand = i - 2 > 0 ? i - 2 : 0; const int nforced = i + 1 < 3 ? i + 1 : 3; const int krem = 16 - nforced;
        unsigned bits = 0u;
        if (ncand > krem && ABL != 5) {
            float vn[8]; int cn[8];
#pragma unroll
            for (int e = 0; e < 8; ++e) { vn[e] = impP[q * 64 + part * 8 + e]; cn[e] = 0; }
#pragma unroll 4
            for (int mm = 1; mm <= i - 2; ++mm) { const float xv = impP[q * 64 + mm];
#pragma unroll
                for (int e = 0; e < 8; ++e) { const int n = part * 8 + e; cn[e] += (xv > vn[e] || (xv == vn[e] && mm < n)) ? 1 : 0; } }
#pragma unroll
            for (int e = 0; e < 8; ++e) { const int n = part * 8 + e; if (n >= 1 && n <= i - 2 && cn[e] < krem) bits |= 1u << e; }
        } else {
#pragma unroll
            for (int e = 0; e < 8; ++e) { const int n = part * 8 + e; if (n >= 1 && n <= i - 2) bits |= 1u << e; }
        }
#pragma unroll
        for (int e = 0; e < 8; ++e) { const int n = part * 8 + e; if (n == 0 || n == i || n == i - 1) bits |= 1u << e; }
        unsigned lo = part < 4 ? bits << (8 * part) : 0u, hi2 = part >= 4 ? bits << (8 * (part - 4)) : 0u;
        lo |= swz_xor_u<1>(lo); hi2 |= swz_xor_u<1>(hi2); lo |= swz_xor_u<2>(lo); hi2 |= swz_xor_u<2>(hi2); lo |= swz_xor_u<4>(lo); hi2 |= swz_xor_u<4>(hi2);
        if (part == 0) { selw[2 * q] = lo; selw[2 * q + 1] = hi2; atomicOr((unsigned*)&selw[128], lo); atomicOr((unsigned*)&selw[129], hi2); }
    }
    __syncthreads();
    int NTS, NTW;
    { NSA_SECT();
        LAS unsigned* selw = (LAS unsigned*)(lds + L_SEL);
        LAS unsigned char* tls = lds + L_SEL + 768; LAS unsigned char* tlw = lds + L_SEL + 848;
        const unsigned long long uni = ((unsigned long long)(unsigned)__builtin_amdgcn_readfirstlane((int)selw[129]) << 32) | (unsigned)__builtin_amdgcn_readfirstlane((int)selw[128]);
        const int nsel = __builtin_popcountll(uni); const int nts = (nsel + 1) & ~1; NTS = nts < 4 ? 4 : nts;
        const int jlo = i - 8 < 0 ? 0 : i - 8; const int nwin = i - jlo + 1; const int ntw = (nwin + 1) & ~1; NTW = ntw < 4 ? 4 : ntw;
        if (tid < 64) { if ((uni >> tid) & 1ull) tls[__builtin_popcountll(uni & ((1ull << tid) - 1ull))] = (unsigned char)tid; }
        else if (tid < 72) { const int k = nsel + (tid - 64); if (k < NTS) tls[k] = 0x80; }
        else if (tid < 88) { const int k = tid - 72; if (k < NTW) tlw[k] = (unsigned char)(k < nwin ? jlo + k : 0x80); }
    }
    __syncthreads();
    NSA_T0(1);
#pragma clang loop unroll(disable)
    for (int br = 0; br < 2; ++br) {
        float m = 0.f, l = 0.f;
        { NSA_SECT();
            const int tq = (wid & 1) * 32 + r32, t = 64 * i + tq;
            LAS unsigned* selw = (LAS unsigned*)(lds + L_SEL); LAS float* lut = (LAS float*)(lds + L_LUT);
            StreamP S; S.Kb = QKV + (size_t)b * SEQ * LDQ + 512 + 256 + br * 256 + hk * 64; S.Vb = S.Kb + 128; S.pitch = LDQ;
            S.NT = br ? NTW : NTS; S.tl = lds + L_SEL + (br ? 848 : 768); S.uq = t;
            S.lanesel = br ? ~0ull : (((unsigned long long)selw[2 * tq + 1] << 32) | selw[2 * tq]);
            S.lut = br ? lut + 7168 + g * 768 : lut + g * 1792; S.xtop = br ? 640 : 1636; S.dclamp = br ? (1 << 30) : 1636;
            attn_stream<8>(lds, wid, lane, qr, S, m, l, o);
        }
        { NSA_SECT();
            LAS float* gsh = (LAS float*)(lds + L_GSH) + wid * 96; LAS float* wsf = (LAS float*)(lds + L_WSF) + wid * 64;
            l = xhalf_sum(l);
            LDS_WAIT();
            if (hi == 0) wsf[r32] = (l > 0.f ? 1.0f / l : 0.f) * gsh[32 + br * 32 + r32];
            LDS_WAIT();
            ota_update<false>((LAS bf16_t*)(lds + L_OTA) + wid * 2048 + r32, wsf, hi, o);
        }
    }
    NSA_T1(1);
    { NSA_SECT();
        LDS_WAIT();
        bf16_t* ONSA = (bf16_t*)(a.ws + WS_ONSA);
        const LAS bf16_t* stg = (const LAS bf16_t*)(lds + L_OTA) + wid * 2048;
#pragma unroll
        for (int k = 0; k < 4; ++k) { const int row = k * 8 + (lane >> 3), chn = lane & 7; const u32x4 v = *(const LAS u32x4*)(stg + row * 64 + chn * 8);
            const size_t tk = (size_t)b * SEQ + 64 * i + (wid & 1) * 32 + row;
            *(u32x4*)(ONSA + tk * 512 + hk * 256 + g * 64 + chn * 8) = v; }
    }
}
__device__ __forceinline__ void build_bkt(const Ctx& C) {
    LAS unsigned char* bkt = C.lds + att::L_BKT; LAS unsigned char* bkc = C.lds + att::L_BKC;
    for (int d = C.tid; d < 4096; d += NTHR) bkt[d] = (unsigned char)att::bucket_of(d);
    for (int x = C.tid; x < 8704; x += NTHR) { const int dist = 4095 - x; bkc[x] = (unsigned char)(dist < 0 ? 128 : 4 * att::bucket_of(dist)); }
    __syncthreads();
}
__device__ __forceinline__ void build_nsa_tables(const Args& a, const Ctx& C, int hk) {
    using namespace att;
    LAS float* tbh = (LAS float*)(C.lds + L_TBH); LAS float* lut = (LAS float*)(C.lds + L_LUT);
    __syncthreads();
    if (C.tid < 144) { const int gg = C.tid / 36, bk = C.tid % 36; tbh[C.tid] = bk < 32 ? a.rel_bias[bk * 20 + hk * 4 + gg] * LOG2E : -INFINITY; }
    __syncthreads();
    for (int e = C.tid; e < 4 * 1792; e += NTHR) { const int gg = e / 1792, xx = e % 1792; const int dist = 1636 - xx;
        lut[e] = dist < 0 ? -INFINITY : tbh[gg * 36 + (int)C.lds[L_BKT + dist]]; }
    for (int e = C.tid; e < 4 * 768; e += NTHR) { const int gg = e / 768, xx = e % 768; const int dist = 640 - xx;
        lut[7168 + e] = (dist < 0 || dist > 512) ? -INFINITY : tbh[gg * 36 + (int)C.lds[L_BKT + dist]]; }
    __syncthreads();
}

typedef const Args __attribute__((address_space(4)))* CArgsP;
__device__ __forceinline__ Args load_args() {
#if defined(__HIP_DEVICE_COMPILE__)
    CArgsP p = (CArgsP)__builtin_amdgcn_kernarg_segment_ptr(); asm volatile("" : "+s"(p)); Args a;
    a.x = p->x; a.c = p->c; a.rel_bias = p->rel_bias; a.ada_w = p->ada_w; a.ada_b = p->ada_b; a.norm1 = p->norm1; a.norm2 = p->norm2; a.w_in = p->w_in;
    a.cmp_pos = p->cmp_pos; a.cmp_w1 = p->cmp_w1; a.cmp_w2 = p->cmp_w2; a.w_up_nsa = p->w_up_nsa; a.w_up_dil = p->w_up_dil; a.w_o = p->w_o;
    a.router_wg = p->router_wg; a.router_bg = p->router_bg; a.router_we = p->router_we; a.router_be = p->router_be; a.exp_w1 = p->exp_w1; a.exp_w3 = p->exp_w3; a.exp_w2 = p->exp_w2; a.norm_f = p->norm_f;
    a.out = p->out; a.ws = p->ws; a.ph_lo = p->ph_lo; a.ph_hi = p->ph_hi; a.use_bar = p->use_bar; a.pad = 0;
    return a;
#else
    return Args{};
#endif
}
#define LOADA() const Args a = load_args()
__global__ void __launch_bounds__(NTHR, 2) fwd_kernel(Args a_) {
    extern __shared__ __attribute__((aligned(16))) unsigned char lds_raw[];
    LAS unsigned char* const lds_base = (LAS unsigned char*)lds_raw;
    const int wave0_ = __builtin_amdgcn_readfirstlane((int)threadIdx.x >> 6);
#define FRESH() Ctx C; { int w_ = wave0_; asm volatile("" : "+s"(w_)); int t_ = lane_id_fresh(); asm volatile("" : "+v"(t_)); t_ += w_ * 64; int g_ = gridDim.x, b_ = blockIdx.x; asm volatile("" : "+s"(g_), "+s"(b_)); \
        C.lds = lds_base; C.tid = t_; C.lane = t_ & 63; C.wave = w_; C.G = g_; C.bx = b_; C.vcu = (g_ % 8 == 0) ? (b_ % 8) * (g_ / 8) + b_ / 8 : b_; }
    volatile LAS unsigned* MISC = (volatile LAS unsigned*)(lds_base + LDS_MISC);
    if (threadIdx.x < 64) MISC[threadIdx.x] = 0u;
    __syncthreads();
    unsigned* ctl = (unsigned*)(a_.ws + WS_CTL);
    XcdBarrier bar; bar.bar = ctl + CW_BAR; bar.x = 0; bar.st = nullptr;
    if (a_.use_bar) bar = xcd_barrier_post(ctl + CW_BAR, MISC + 8);
    const int lo = a_.ph_lo, hi = a_.ph_hi;
#ifndef PH_MASK
#define PH_MASK 0xFFFFFFFFu
#endif
#define IN(k) (((PH_MASK >> ((k) == 0 ? 10 : (k) == 21 ? 11 : (((k) - 1) % 10))) & 1u) && lo <= (k) && (k) < hi)
#define TIMED(k) ((TMASK >> (k)) & 1u)
#define TBEG(k) do { if (TMASK != 0u && TIMED(k) && blockIdx.x == 0 && wave0_ == 0 && lane_id_fresh() == 0) { const unsigned long long t_ = __builtin_amdgcn_s_memrealtime(); MISC[20] = (unsigned)t_; MISC[21] = (unsigned)(t_ >> 32); } } while (0)
#define TEND(k) do { if (TMASK != 0u && TIMED(k) && blockIdx.x == 0 && wave0_ == 0 && lane_id_fresh() == 0) { const unsigned long long t_ = __builtin_amdgcn_s_memrealtime(); const unsigned long long t0_ = ((unsigned long long)MISC[21] << 32) | MISC[20]; \
        const unsigned long long d_ = (((unsigned long long)MISC[23] << 32) | MISC[22]) + (t_ - t0_); MISC[22] = (unsigned)d_; MISC[23] = (unsigned)(d_ >> 32); } } while (0)
#define SEAM(k) do { if (IN(k) && IN((k) + 1)) { XcdBarrier b2_ = bar; asm volatile("" : "+s"(b2_.bar)); int w2_ = wave0_; asm volatile("" : "+s"(w2_)); xcd_barrier(b2_, w2_ == 0 && lane_id_fresh() == 0); } } while (0)
    TBEG(0);
    if (IN(0)) REPEAT(10) { __syncthreads(); FRESH(); LOADA(); prologue_vectors(a, C); conv_small(a, C); }
    SEAM(0); TEND(0);
    _Pragma("unroll") for (int l = 0; l < 2; ++l) {
        const int pb = 1 + 10 * l;
        TBEG(pb + 0);
        if (IN(pb + 0)) REPEAT(0) { FRESH(); LOADA(); norm1_phase(a, C, l); }
        SEAM(pb + 0); TEND(pb + 0);
        TBEG(pb + 1);
        if (IN(pb + 1)) REPEAT(1) { FRESH(); LOADA(); unsigned char* ws = a.ws;
            pg8::Gemm g{1024u, 1024u, 128u, 1024, 0u, 0u, 0, nullptr, nullptr, 0x77777777, 0x7c7c7c7c};
            pg8::DenseOrder S; S.init(T, NIN, C.G, C.bx, ws + WS_H, 1024u, ws + WS_WINT + (size_t)l * NIN * DM, 1024u);
            EpiInProj E{(bf16_t*)(ws + WS_A), (unsigned char*)(ws + WS_MG), (float*)(ws + WS_GN), 1.0f / 2048.0f};
            pg8::gemm_phase<EpiInProj, pg8::DenseOrder, true, false, false, true>(C.lds, C.tid, g, S, E);
        }
        SEAM(pb + 1); TEND(pb + 1);
        TBEG(pb + 2);
        if (IN(pb + 2)) REPEAT(2) { FRESH(); LOADA(); unsigned char* ws = a.ws;
            struct CmpOrder { int c; const char* A; const char* B;
                __device__ __forceinline__ bool next(int i, pg8::Unit& u) const { if (i > 0 || c >= 32) return false; const int kv = c >> 4, b = (c >> 1) & 7, hk = c & 1;
                    u.pm = c; u.pn = 0; u.A = A + ((size_t)b * SEQ * LDQ + 512 + kv * 128 + hk * 64) * 2; u.B = B + (size_t)kv * 256 * 2048 * 2; return true; } };
            pg8::Gemm g{(unsigned)(16 * LDQ * 2), 4096u, (unsigned)(LDQ * 2), 2048};
            CmpOrder S{C.vcu, (const char*)(ws + WS_A), (const char*)(ws + WS_CW1T + (size_t)l * 2 * 256 * 2048 * 2)};
            EpiCmp E{(bf16_t*)(ws + WS_HID), (const float*)(ws + WS_CB1) + l * 512, (const bf16_t*)(ws + WS_CW2T) + (size_t)l * 2 * 64 * 256, (bf16_t*)(ws + WS_KC)};
            pg8::gemm_phase<EpiCmp, CmpOrder, false>(C.lds, C.tid, g, S, E);
            __syncthreads();
            build_bkt(C);
            for (;;) { __syncthreads();
                if (C.tid == 0) *(volatile LAS int*)(C.lds + LDS_MISC + 512) = (int)__hip_atomic_fetch_add((unsigned*)(ws + WS_CTL) + CW_Q + l, 1u, __ATOMIC_RELAXED, __HIP_MEMORY_SCOPE_AGENT);
                __syncthreads();
                const int du = __builtin_amdgcn_readfirstlane(*(volatile LAS int*)(C.lds + LDS_MISC + 512));
                if (du >= 1536) break;
                dil_unit(a, C, du); }
        }
        SEAM(pb + 2); TEND(pb + 2);
        TBEG(pb + 3);
        if (IN(pb + 3)) REPEAT(3) { FRESH(); LOADA();
            dil_combine(a, C);
            build_bkt(C);
            int cur_hk = -1;
            for (int v = C.vcu; v < 256; v += C.G) { const int b = v >> 5, hk = (v >> 4) & 1, s = v & 15;
                if (hk != cur_hk) { build_nsa_tables(a, C, hk); cur_hk = hk; }
                for (int k = 0; k < 4; ++k) { const int qi = (k == 0) ? s : (k == 1) ? 31 - s : (k == 2) ? 32 + s : 63 - s; nsa_unit(a, C, b, hk, qi);
                    __syncthreads(); if (v < C.G) conv_experts_slice(a, C, l, k); } }
            if (C.vcu >= 256) { for (int q = 0; q < 4; ++q) conv_experts_slice(a, C, l, q); }
            __syncthreads();
        }
        SEAM(pb + 3); TEND(pb + 3);
        TBEG(pb + 4);
        if (IN(pb + 4)) REPEAT(4) { FRESH(); LOADA(); unsigned char* ws = a.ws;
            pg8::Gemm g{1024u, 1024u, 128u, 512, 512u, 512u, 256}; pg8::DenseOrder S; S.init(T, 1024, C.G, C.bx, ws + WS_ONSA, 1024u, ws + WS_WUNT + (size_t)l * 1024 * 512 * 2, 1024u);
            S.A2 = (const char*)(ws + WS_ODIL); S.B2 = (const char*)(ws + WS_WUDT + (size_t)l * 1024 * 256 * 2); S.tA2 = (size_t)256 * 512; S.tB2 = (size_t)256 * 512;
            EpiUpFused E{(bf16_t*)(ws + WS_MERGED), (const unsigned char*)(ws + WS_MG)};
            pg8::gemm_phase<EpiUpFused, pg8::DenseOrder, true, true>(C.lds, C.tid, g, S, E);
        }
        SEAM(pb + 4); TEND(pb + 4);
        TBEG(pb + 5);
        if (IN(pb + 5)) REPEAT(5) { FRESH(); LOADA(); unsigned char* ws = a.ws;
            pg8::Gemm g{2048u, 2048u, 128u, 1024}; pg8::DenseOrder S; S.init(T, 1024, C.G, C.bx, ws + WS_MERGED, 2048u, ws + WS_WOT + (size_t)l * 1024 * 1024 * 2, 2048u);
            EpiOut E{l == 0 ? a.x : (const float*)a.out, a.out, (const float*)(ws + WS_MOD) + (size_t)l * 8 * 6144 + 2048};
            pg8::gemm_phase<EpiOut, pg8::DenseOrder, true>(C.lds, C.tid, g, S, E);
        }
        SEAM(pb + 5); TEND(pb + 5);
        TBEG(pb + 6);
        if (IN(pb + 6)) REPEAT(6) { FRESH(); LOADA(); norm2_router_phase(a, C, l); }
        SEAM(pb + 6); TEND(pb + 6);
        TBEG(pb + 7);
        if (IN(pb + 7)) REPEAT(7) { FRESH(); LOADA(); moe_scatter_phase(a, C); }
        SEAM(pb + 7); TEND(pb + 7);
        TBEG(pb + 8);
        if (IN(pb + 8)) REPEAT(8) { FRESH(); LOADA(); unsigned char* ws = a.ws;
            const int* TILEE = (const int*)(ws + WS_TILEE); const int ntl = TILEE[0];
            MoeOrder S; S.G = C.G; S.c = C.vcu; S.nu = ntl * 4; S.A = (const char*)(ws + WS_XS); S.B = (const char*)(ws + WS_E13T); S.tA = (size_t)256 * 2048; S.tB = (size_t)256 * 2048; S.eB = (size_t)1024 * 2048;
#pragma unroll
            for (int i = 0; i < 8; ++i) { const int L = i * C.G + C.vcu; S.ex[i] = (L < S.nu) ? TILEE[16 + (L >> 2)] : 0; }
            pg8::Gemm g{2048u, 2048u, 128u, 1024, 0u, 0u, 0, (const int*)(ws + WS_TOKL), (const char*)(ws + WS_H2)};
            EpiMoe1 E{(bf16_t*)(ws + WS_ACT)};
            pg8::gemm_phase<EpiMoe1, MoeOrder, true, false, true>(C.lds, C.tid, g, S, E);
        }
        SEAM(pb + 8); TEND(pb + 8);
        TBEG(pb + 9);
        if (IN(pb + 9)) REPEAT(9) { FRESH(); LOADA(); unsigned char* ws = a.ws;
            const int* TILEE = (const int*)(ws + WS_TILEE); const int ntl = TILEE[0];
            MoeOrder S; S.G = C.G; S.c = C.vcu; S.nu = ntl * 4; S.A = (const char*)(ws + WS_ACT); S.B = (const char*)(ws + WS_E2T); S.tA = (size_t)256 * 1024; S.tB = (size_t)256 * 1024; S.eB = (size_t)1024 * 1024;
#pragma unroll
            for (int i = 0; i < 8; ++i) { const int L = i * C.G + C.vcu; S.ex[i] = (L < S.nu) ? TILEE[16 + (L >> 2)] : 0; }
            pg8::Gemm g{1024u, 1024u, 128u, 512};
            EpiPlain E{(bf16_t*)(ws + WS_XS), 1024};
            pg8::gemm_phase<EpiPlain, MoeOrder, true>(C.lds, C.tid, g, S, E);
        }
        SEAM(pb + 9); TEND(pb + 9);
    }
    TBEG(21);
    if (IN(21)) { FRESH(); LOADA(); final_phase(a, C); }
    TEND(21);
    if ((TMASK != 0u || TNSA != 0) && blockIdx.x == 0 && wave0_ == 0 && lane_id_fresh() == 0) { const unsigned long long d_ = ((unsigned long long)MISC[23] << 32) | MISC[22]; const unsigned long long t0_ = __builtin_amdgcn_s_memrealtime();
        while (__builtin_amdgcn_s_memrealtime() - t0_ < TAMP * d_) __builtin_amdgcn_s_sleep(8); }
#undef IN
#undef SEAM
}

#ifndef ONE_LAUNCH
#define ONE_LAUNCH 1
#endif
extern "C" void kernel_launch(void* const* d_in, const int* in_sizes, int n_in, void* d_out, int out_size, void* d_ws, size_t ws_size, hipStream_t stream) {
    static int grid = 0;
    if (grid == 0) {
        if (n_in != 22 || out_size != T * DM || ws_size < WS_END) { fprintf(stderr, "kernel_launch: unexpected problem (n_in %d out %d ws %zu)\n", n_in, out_size, ws_size); grid = -1; return; }
        int dev = 0, cus = 0;
        if (hipGetDevice(&dev) != hipSuccess || hipDeviceGetAttribute(&cus, hipDeviceAttributeMultiprocessorCount, dev) != hipSuccess) { grid = -1; return; }
        if (hipFuncSetAttribute((const void*)fwd_kernel, hipFuncAttributeMaxDynamicSharedMemorySize, LDS_BYTES) != hipSuccess) { fprintf(stderr, "kernel_launch: hipFuncSetAttribute failed\n"); grid = -1; return; }
        int per_cu = 0;
        if (hipOccupancyMaxActiveBlocksPerMultiprocessor(&per_cu, (const void*)fwd_kernel, NTHR, LDS_BYTES) != hipSuccess || per_cu < 1) { fprintf(stderr, "kernel_launch: occupancy query reports %d\n", per_cu); }
        (void)hipGetLastError();
        grid = cus;
    }
    if (grid < 0) return;
    (void)hipMemsetAsync((char*)d_ws + WS_CTL, 0, CTL_ZERO_BYTES, stream);
    Args a{};
    a.x = (const float*)d_in[0]; a.c = (const float*)d_in[1]; a.rel_bias = (const float*)d_in[2]; a.ada_w = (const float*)d_in[3]; a.ada_b = (const float*)d_in[4];
    a.norm1 = (const float*)d_in[5]; a.norm2 = (const float*)d_in[6]; a.w_in = (const float*)d_in[7]; a.cmp_pos = (const float*)d_in[8]; a.cmp_w1 = (const float*)d_in[9];
    a.cmp_w2 = (const float*)d_in[10]; a.w_up_nsa = (const float*)d_in[11]; a.w_up_dil = (const float*)d_in[12]; a.w_o = (const float*)d_in[13];
    a.router_wg = (const float*)d_in[14]; a.router_bg = (const float*)d_in[15]; a.router_we = (const float*)d_in[16]; a.router_be = (const float*)d_in[17];
    a.exp_w1 = (const float*)d_in[18]; a.exp_w3 = (const float*)d_in[19]; a.exp_w2 = (const float*)d_in[20]; a.norm_f = (const float*)d_in[21];
    a.out = (float*)d_out; a.ws = (unsigned char*)d_ws; a.pad = 0;
#if ONE_LAUNCH
    a.ph_lo = 0; a.ph_hi = NPHASE; a.use_bar = 1;
    hipLaunchKernelGGL(fwd_kernel, dim3(grid), dim3(NTHR), LDS_BYTES, stream, a);
#else
    for (int p = 0; p < NPHASE; ++p) { a.ph_lo = p; a.ph_hi = p + 1; a.use_bar = 0;
        hipLaunchKernelGGL(fwd_kernel, dim3(grid), dim3(NTHR), LDS_BYTES, stream, a); }
#endif
}
```

```cpp
#include <hip/hip_runtime.h>
#include <cstdint>
#include <cstdio>

#define GAS __attribute__((address_space(1)))
#define LAS __attribute__((address_space(3)))
typedef unsigned short bf16_t;
typedef short bf16x8 __attribute__((ext_vector_type(8)));
typedef short s16x4 __attribute__((ext_vector_type(4)));
typedef float f32x4 __attribute__((ext_vector_type(4)));
typedef float f32x2 __attribute__((ext_vector_type(2)));
typedef float f32x16 __attribute__((ext_vector_type(16)));
typedef unsigned u32x4 __attribute__((ext_vector_type(4)));
typedef unsigned u32x2 __attribute__((ext_vector_type(2)));
typedef __bf16 bf16x2_t __attribute__((ext_vector_type(2)));

constexpr int NB = 8, SEQ = 4096, DM = 1024, T = NB * SEQ;
constexpr int LDQ = 3584;
constexpr int NIN = 5888;
constexpr int INW = 5656;
constexpr float LOG2E = 1.4426950408889634f;
constexpr float C2 = 0.125f * LOG2E;
constexpr int NWAVES = 8, NTHR = 512;
constexpr float RMS_EPS = 1e-6f;
constexpr int NPHASE = 22;
#ifndef ABL
#define ABL 0
#endif
#ifndef REP_MASK
#define REP_MASK 0u
#endif
#ifndef TMASK
#define TMASK 0u
#endif
#define TAMP 8ull
#ifndef TNSA
#define TNSA 0
#endif
#define REPEAT(k) _Pragma("clang loop unroll(disable)") for (int rep_ = 0; rep_ < (int)((REP_MASK >> (k)) & 1u) + 1; ++rep_)

constexpr size_t MiB = 1u << 20;
constexpr size_t WS_CTL = 0, CTL_ZERO_BYTES = MiB;
constexpr size_t WS_MOD = 1 * MiB;
constexpr size_t WS_CB1 = WS_MOD + 400 * 1024;
constexpr size_t WS_CW2T = WS_MOD + 512 * 1024;
constexpr size_t WS_CNTBLK = WS_MOD + 768 * 1024;
constexpr size_t WS_TILEE = WS_MOD + 832 * 1024;
constexpr size_t WS_WINT = 4 * MiB;
constexpr size_t WS_CW1T = 27 * MiB;
constexpr size_t WS_WUNT = 31 * MiB;
constexpr size_t WS_WUDT = 33 * MiB;
constexpr size_t WS_WOT = 34 * MiB;
constexpr size_t WS_E13T = 38 * MiB;
constexpr size_t WS_E2T = 102 * MiB;
constexpr size_t WS_A = 134 * MiB;
constexpr size_t WS_XS = WS_A;
constexpr size_t WS_ACT = WS_A + 144 * MiB;
constexpr size_t WS_MERGED = WS_A;
constexpr size_t WS_MG = 359 * MiB;
constexpr size_t WS_H2 = WS_MG;
constexpr size_t WS_REC = WS_MG + 64 * MiB;
constexpr size_t WS_DEST = WS_MG + 65 * MiB;
constexpr size_t WS_TOKL = WS_MG + 66 * MiB;
constexpr size_t WS_B = 487 * MiB;
constexpr size_t WS_H = WS_B;
constexpr size_t WS_ONSA = WS_B;
constexpr size_t WS_ODP = WS_B + 32 * MiB;
constexpr size_t WS_LSE = WS_B + 80 * MiB;
constexpr size_t WS_ODIL = WS_B + 82 * MiB;
constexpr size_t WS_GN = WS_B + 98 * MiB;
constexpr size_t WS_KC = WS_B + 102 * MiB;
constexpr size_t WS_HID = WS_B + 103 * MiB;
constexpr size_t WS_END = WS_B + 107 * MiB;

constexpr int CW_TMO = 0, CW_BAR = 4096, CW_Q = 8192;

constexpr int LDS_MISC = 158784;
constexpr int LDS_BYTES = 158784 + 2048;

__device__ __forceinline__ unsigned cvt_pk_bf16(float lo, float hi) { f32x2 v = {lo, hi}; bf16x2_t b = __builtin_convertvector(v, bf16x2_t); return __builtin_bit_cast(unsigned, b); }
__device__ __forceinline__ float bf_lo(unsigned w) { return __uint_as_float(w << 16); }
__device__ __forceinline__ float bf_hi(unsigned w) { return __uint_as_float(w & 0xffff0000u); }
__device__ __forceinline__ float sigmoidf_(float x) { return __builtin_amdgcn_rcpf(1.0f + __builtin_amdgcn_exp2f(-x * LOG2E)); }
__device__ __forceinline__ int lane_id_fresh() { unsigned ones = ~0u; asm volatile("" : "+s"(ones)); return (int)__builtin_amdgcn_mbcnt_hi(ones, __builtin_amdgcn_mbcnt_lo(ones, 0u)); }
template <int X> __device__ __forceinline__ float swz_xor_f(float v) { return __int_as_float(__builtin_amdgcn_ds_swizzle(__float_as_int(v), (X << 10) | 0x1f)); }
template <int X> __device__ __forceinline__ unsigned swz_xor_u(unsigned v) { return (unsigned)__builtin_amdgcn_ds_swizzle((int)v, (X << 10) | 0x1f); }
__device__ __forceinline__ float wave_sum(float v) {
    v += swz_xor_f<1>(v); v += swz_xor_f<2>(v); v += swz_xor_f<4>(v); v += swz_xor_f<8>(v); v += swz_xor_f<16>(v);
    auto rr = __builtin_amdgcn_permlane32_swap(__float_as_uint(v), __float_as_uint(v), false, false);
    return __uint_as_float(rr[0]) + __uint_as_float(rr[1]);
}
__device__ __forceinline__ int bperm_i(int srclane, int v) { return __builtin_amdgcn_ds_bpermute(srclane << 2, v); }
#define LDS_WAIT() asm volatile("s_waitcnt lgkmcnt(0)" ::: "memory")
#define VM_WAIT() asm volatile("s_waitcnt vmcnt(0)" ::: "memory")

#define XB_TMO      128
#define XB_XCNT(j)  (256  + 64 * (j))
#define XB_XSUB(j)  (1280 + 64 * (j))
#define XB_XGEN(j)  (2304 + 64 * (j))
#define XB_TOP      3328
#define XB_TOPGEN   3392
#define XCD_BAR_WORDS 3456
#define XB_SPIN_CAP (1u << 20)
__device__ __forceinline__ unsigned xb_ld(unsigned* p)              { return __hip_atomic_load(p, __ATOMIC_RELAXED, __HIP_MEMORY_SCOPE_AGENT); }
__device__ __forceinline__ unsigned xb_add(unsigned* p, unsigned v) { return __hip_atomic_fetch_add(p, v, __ATOMIC_RELAXED, __HIP_MEMORY_SCOPE_AGENT); }
__device__ __forceinline__ unsigned xb_xcc_id() { return (unsigned)__builtin_amdgcn_s_getreg((3 << 11) | 20) & 0xFu; }
#define XB_SPIN(cond, bar) do { unsigned _sp = 0; while (cond) { __builtin_amdgcn_s_sleep(1); \
    if ((++_sp & 255u) == 0u) { if (xb_ld(&(bar)[XB_TMO])) break; if (_sp > XB_SPIN_CAP) { atomicAdd(&(bar)[XB_TMO], 1u); break; } } } } while (0)
struct XcdBarrier { unsigned* bar; unsigned x; volatile LAS unsigned* st; };
__device__ __forceinline__ XcdBarrier xcd_barrier_post(unsigned* bar, volatile LAS unsigned* st) {
    XcdBarrier b; b.bar = bar; b.x = xb_xcc_id(); b.st = st;
    if (threadIdx.x == 0) (void)xb_add(&bar[XB_XCNT(b.x)], 1u);
    return b;
}
__device__ __forceinline__ void xcd_barrier_complete(unsigned* bar, unsigned x, unsigned& nloc, unsigned& nx) {
    const unsigned G = gridDim.x * gridDim.y * gridDim.z;
    unsigned sum, cnt, mine, sp = 0u;
    for (;;) {
        sum = 0u; cnt = 0u; mine = 0u;
#pragma unroll
        for (unsigned j = 0; j < 16; ++j) { const unsigned c = xb_ld(&bar[XB_XCNT(j)]); sum += c; cnt += (c > 0u) ? 1u : 0u; mine = (j == x) ? c : mine; }
        if (sum == G) break;
        __builtin_amdgcn_s_sleep(1);
        if ((++sp & 255u) == 0u) { if (xb_ld(&bar[XB_TMO])) break; if (sp > XB_SPIN_CAP) { atomicAdd(&bar[XB_TMO], 1u); break; } }
    }
    nloc = mine > 0u ? mine : 1u; nx = cnt > 0u ? cnt : 1u;
}
__device__ __forceinline__ void xcd_barrier(const XcdBarrier& b, const bool leader_thread) {
    asm volatile("s_waitcnt vmcnt(0)" ::: "memory");
    __syncthreads();
    if (leader_thread) {
        unsigned* bar = b.bar;
        __builtin_amdgcn_s_waitcnt(0);
        unsigned nloc = b.st[0], nx = b.st[1];
        if (nloc == 0u) { xcd_barrier_complete(bar, b.x, nloc, nx); b.st[0] = nloc; b.st[1] = nx; }
        const unsigned old = xb_add(&bar[XB_XSUB(b.x)], 1u);
        const unsigned gen = old / nloc;
        if (old + 1u == (gen + 1u) * nloc) {
            __builtin_amdgcn_fence(__ATOMIC_RELEASE, "agent");
            asm volatile("s_waitcnt vmcnt(0)" ::: "memory");
            const unsigned og = xb_add(&bar[XB_TOP], 1u);
            const unsigned tg = og / nx;
            if (og + 1u == (tg + 1u) * nx) xb_add(&bar[XB_TOPGEN], 1u);
            else XB_SPIN(xb_ld(&bar[XB_TOPGEN]) == tg, bar);
            __builtin_amdgcn_fence(__ATOMIC_ACQUIRE, "agent");
            xb_add(&bar[XB_XGEN(b.x)], 1u);
            asm volatile("s_waitcnt vmcnt(0)" ::: "memory");
        } else {
            XB_SPIN(xb_ld(&bar[XB_XGEN(b.x)]) == gen, bar);
            __builtin_amdgcn_fence(__ATOMIC_ACQUIRE, "agent");
            asm volatile("s_waitcnt vmcnt(0)" ::: "memory");
        }
    }
    __syncthreads();
}

namespace pg8 {
constexpr int BM = 256, BK = 64, HALF = 128, HTB = HALF * BK * 2, STAGE_BYTES = 8 * HTB;
__device__ __forceinline__ int lds_byte(int r, int c) { const int st = (r >> 4) * 2 + (c >> 5), rr = r & 15, cc = c & 31, ob = rr * 64 + cc * 2; return st * 1024 + (ob ^ (((ob >> 9) & 1) << 5)); }
__device__ __forceinline__ void stage_rc(int b, int& R, int& C) { const int st = b / 1024, sb = b % 1024, swz = sb ^ (((sb >> 9) & 1) << 5); R = (st >> 1) * 16 + swz / 64; C = (st & 1) * 32 + (swz % 64) / 2; }
__device__ __forceinline__ int perm32(int rho) { const int n = rho >> 4, i = rho & 15; return 8 * (i >> 2) + 4 * n + (i & 3); }

struct Unit { const char* A; const char* B; int pm, pn; const char* A2; const char* B2; };
struct Gemm { unsigned lda, ldb, kstepA; int K; unsigned lda2, ldb2; int K2; const int* tokl; const char* Abase; int sc_w, sc_a; };

template <class Epi, class Sched, bool ALIGN_EPI, bool SEG2 = false, bool GATHER = false, bool FP8 = false>
__device__ __forceinline__ void gemm_phase(LAS unsigned char* lds, const int tid, const Gemm g, const Sched& S, const Epi& E) {
    const int wid = __builtin_amdgcn_readfirstlane(tid >> 6), lane = tid & 63, wr = wid >> 2, wc = wid & 3, fr = lane & 15, fq = lane >> 4;
    const int nt0 = g.K / (FP8 ? 2 * BK : BK); const int nt = nt0 + (SEG2 ? g.K2 / BK : 0);
    unsigned voffA[2], voffB[2], voffA2[2], voffB2[2]; int Rrow[2]; unsigned Cb[2];
#pragma unroll
    for (int i = 0; i < 2; ++i) { int R, C; stage_rc(tid * 16 + i * 8192, R, C); Rrow[i] = R; Cb[i] = (unsigned)C * 2u; const int Rb = Epi::PERM ? ((R & ~31) + perm32(R & 31)) : R;
        voffA[i] = (unsigned)R * g.lda + (unsigned)C * 2u; voffB[i] = (unsigned)Rb * g.ldb + (unsigned)C * 2u;
        voffA2[i] = SEG2 ? (unsigned)R * g.lda2 + (unsigned)C * 2u : 0u; voffB2[i] = SEG2 ? (unsigned)Rb * g.ldb2 + (unsigned)C * 2u : 0u; }
    const size_t kstepA = (size_t)g.kstepA, kstepB = (size_t)(BK * 2);
    const size_t hstepA = (size_t)HALF * g.lda, hstepB = (size_t)HALF * g.ldb;
    const size_t hstepA2 = SEG2 ? (size_t)HALF * g.lda2 : 0, hstepB2 = SEG2 ? (size_t)HALF * g.ldb2 : 0;
    const unsigned ldsw = (unsigned)wid * 1024u;
    const int aoff = lds_byte(wr * 64 + fr, FP8 ? fq * 16 : fq * 8), boff = lds_byte(wc * 32 + fr, FP8 ? fq * 16 : fq * 8);
#define PG8_SA(b, h) (((b) * 2 + (h)) * HTB)
#define PG8_SB(b, h) ((4 + (b) * 2 + (h)) * HTB)
#define PG8_STAGE(bufoff, gbase, voff) do { _Pragma("unroll") for (int _i = 0; _i < 2; ++_i) \
        __builtin_amdgcn_global_load_lds((const unsigned*)((const char*)(gbase) + (voff)[_i]), (LAS unsigned*)(lds + (bufoff) + ldsw + _i * 8192), 16, 0, 0); } while (0)
#define PG8_STAGE2(bufoff, gbase, sel, v0, v1) do { _Pragma("unroll") for (int _i = 0; _i < 2; ++_i) \
        __builtin_amdgcn_global_load_lds((const unsigned*)((const char*)(gbase) + ((sel) ? (v1)[_i] : (v0)[_i])), (LAS unsigned*)(lds + (bufoff) + ldsw + _i * 8192), 16, 0, 0); } while (0)
#define PG8_LDA(dst, b, h) do { if constexpr (FP8) { _Pragma("unroll") for (int m = 0; m < 4; ++m) dst##8[m] = *(const LAS v8i_*)(lds + PG8_SA(b, h) + aoff + m * 2048); } \
        else { _Pragma("unroll") for (int m = 0; m < 4; ++m) _Pragma("unroll") for (int k = 0; k < 2; ++k) dst[m][k] = *(const LAS bf16x8*)(lds + PG8_SA(b, h) + aoff + m * 2048 + k * 1024); } } while (0)
#define PG8_LDB(dst, b, h) do { if constexpr (FP8) { _Pragma("unroll") for (int n = 0; n < 2; ++n) dst##8[n] = *(const LAS v8i_*)(lds + PG8_SB(b, h) + boff + n * 2048); } \
        else { _Pragma("unroll") for (int n = 0; n < 2; ++n) _Pragma("unroll") for (int k = 0; k < 2; ++k) dst[n][k] = *(const LAS bf16x8*)(lds + PG8_SB(b, h) + boff + n * 2048 + k * 1024); } } while (0)
#define PG8_MMA(ai, bj, At, Bt) do { __builtin_amdgcn_s_setprio(1); _Pragma("unroll") for (int m = 0; m < 4; ++m) _Pragma("unroll") for (int n = 0; n < 2; ++n) { \
        if constexpr (FP8) { asm volatile("v_mfma_f32_16x16x128_f8f6f4 %0, %1, %2, %0" : "+v"(acc[ai][bj][m][n]) : "v"(Bt##8[n]), "v"(At##8[m])); }     \
        else { _Pragma("unroll") for (int k = 0; k < 2; ++k) acc[ai][bj][m][n] = __builtin_amdgcn_mfma_f32_16x16x32_bf16(Bt[n][k], At[m][k], acc[ai][bj][m][n], 0, 0, 0); } } \
        __builtin_amdgcn_s_setprio(0); } while (0)
#define PG8_WAIT_V(n) asm volatile("s_waitcnt vmcnt(" #n ")" ::: "memory")
#define PG8_WAIT_L(n) asm volatile("s_waitcnt lgkmcnt(" #n ")" ::: "memory")
#define PG8_BAR __builtin_amdgcn_s_barrier()
#define PG8_SCHED __builtin_amdgcn_sched_barrier(0)
    Unit cur, nxt; int ui = 0;
    if (!S.next(0, cur)) return;
    f32x4 acc[2][2][4][2];
#pragma unroll
    for (int a = 0; a < 2; ++a)
#pragma unroll
        for (int b = 0; b < 2; ++b)
#pragma unroll
            for (int m = 0; m < 4; ++m)
#pragma unroll
                for (int n = 0; n < 2; ++n) acc[a][b][m][n] = (f32x4){0.f, 0.f, 0.f, 0.f};
    typedef int v8i_ __attribute__((ext_vector_type(8)));
    bf16x8 At[4][2], B0[2][2], B1[2][2]; v8i_ At8[4], B08[2], B18[2];
    const char* cA = GATHER ? g.Abase : cur.A; const char* cB = cur.B;
    unsigned vC0[2], vC1[2], vN0[2], vN1[2];
#define PG8_GLOAD(U, d0, d1) do { _Pragma("unroll") for (int _i = 0; _i < 2; ++_i) { \
        d0[_i] = (unsigned)g.tokl[(U).pm * 256 + Rrow[_i]] * g.lda + Cb[_i]; d1[_i] = (unsigned)g.tokl[(U).pm * 256 + 128 + Rrow[_i]] * g.lda + Cb[_i]; } } while (0)
    if constexpr (GATHER) { PG8_GLOAD(cur, vC0, vC1); }
    if constexpr (GATHER) {
        PG8_STAGE(PG8_SB(0, 0), cB, voffB); PG8_STAGE(PG8_SB(0, 1), cB + hstepB, voffB); PG8_STAGE(PG8_SA(0, 0), cA, vC0); PG8_STAGE(PG8_SA(0, 1), cA, vC1);
        if (wr == 1) PG8_BAR;
        PG8_WAIT_V(2); PG8_BAR;
        PG8_STAGE(PG8_SB(1, 0), cB + kstepB, voffB); PG8_STAGE(PG8_SA(1, 0), cA + kstepA, vC0); PG8_STAGE(PG8_SB(1, 1), cB + hstepB + kstepB, voffB);
        PG8_WAIT_V(6); PG8_BAR;
    } else {
    PG8_STAGE(PG8_SB(0, 0), cB, voffB); PG8_STAGE(PG8_SB(0, 1), cB + hstepB, voffB); PG8_STAGE(PG8_SA(0, 0), cA, voffA); PG8_STAGE(PG8_SA(0, 1), cA + hstepA, voffA);
    if (wr == 1) PG8_BAR;
    PG8_WAIT_V(2); PG8_BAR;
    PG8_STAGE(PG8_SB(1, 0), cB + kstepB, voffB); PG8_STAGE(PG8_SA(1, 0), cA + kstepA, voffA); PG8_STAGE(PG8_SB(1, 1), cB + hstepB + kstepB, voffB);
    PG8_WAIT_V(6); PG8_BAR;
    }
    for (;;) {
        const bool has_next = S.next(ui + 1, nxt);
        const char* nA = GATHER ? cA : (has_next ? nxt.A : cA); const char* nB = has_next ? nxt.B : cB;
        if constexpr (GATHER) { if (has_next) { PG8_GLOAD(nxt, vN0, vN1); } else { vN0[0] = vC0[0]; vN0[1] = vC0[1]; vN1[0] = vC1[0]; vN1[1] = vC1[1]; } }
#pragma clang loop unroll(disable)
        for (int t = 0; t < nt; t += 2) {
            const bool last = (t == nt - 2);
            if constexpr (SEG2) {
                const bool s1 = (t >= nt0);
                const bool s2 = !last && (t + 2 >= nt0);
                if (t == nt0) E.mid(acc, cur, wr, wc, fr, fq);
                const char* a1 = s1 ? cur.A2 + (size_t)(t + 1 - nt0) * kstepB : cA + (size_t)(t + 1) * kstepA; const size_t h1 = s1 ? hstepA2 : hstepA;
                const char* a2 = last ? nA : (s2 ? cur.A2 + (size_t)(t + 2 - nt0) * kstepB : cA + (size_t)(t + 2) * kstepA);
                const char* b2 = last ? nB : (s2 ? cur.B2 + (size_t)(t + 2 - nt0) * kstepB : cB + (size_t)(t + 2) * kstepB);
                const char* a3 = a2 + (s2 ? kstepB : kstepA); const char* b3 = b2 + kstepB;
                const size_t hA2 = s2 ? hstepA2 : hstepA, hB2 = s2 ? hstepB2 : hstepB;
                PG8_LDB(B0, 0, 0); PG8_LDB(B1, 0, 1); PG8_SCHED; PG8_LDA(At, 0, 0); PG8_STAGE2(PG8_SA(1, 1), a1 + h1, s1, voffA, voffA2);
                PG8_WAIT_V(8); PG8_WAIT_L(0); PG8_BAR; PG8_MMA(0, 0, At, B0); PG8_MMA(0, 1, At, B1); PG8_BAR; PG8_SCHED;
                PG8_LDA(At, 0, 1); PG8_STAGE2(PG8_SB(0, 0), b2, s2, voffB, voffB2); PG8_STAGE2(PG8_SB(0, 1), b2 + hB2, s2, voffB, voffB2); PG8_STAGE2(PG8_SA(0, 0), a2, s2, voffA, voffA2);
                PG8_WAIT_V(8); PG8_WAIT_L(0); PG8_BAR; PG8_MMA(1, 0, At, B0); PG8_MMA(1, 1, At, B1); PG8_BAR; PG8_SCHED;
                PG8_LDB(B0, 1, 0); PG8_LDB(B1, 1, 1); PG8_SCHED; PG8_LDA(At, 1, 0); PG8_STAGE2(PG8_SA(0, 1), a2 + hA2, s2, voffA, voffA2);
                PG8_WAIT_V(8); PG8_WAIT_L(0); PG8_BAR; PG8_MMA(0, 0, At, B0); PG8_MMA(0, 1, At, B1); PG8_BAR; PG8_SCHED;
                PG8_LDA(At, 1, 1); PG8_STAGE2(PG8_SB(1, 0), b3, s2, voffB, voffB2); PG8_STAGE2(PG8_SB(1, 1), b3 + hB2, s2, voffB, voffB2); PG8_STAGE2(PG8_SA(1, 0), a3, s2, voffA, voffA2);
                PG8_WAIT_V(8); PG8_WAIT_L(0); PG8_BAR; PG8_MMA(1, 0, At, B0); PG8_MMA(1, 1, At, B1); PG8_BAR; PG8_SCHED;
            } else if constexpr (GATHER) {
            const char* a1 = cA + (size_t)(t + 1) * kstepA;
            const char* a2 = last ? cA : cA + (size_t)(t + 2) * kstepA; const char* b2 = last ? nB : cB + (size_t)(t + 2) * kstepB;
            const char* a3 = a2 + kstepA; const char* b3 = b2 + kstepB;
            unsigned w0[2], w1[2]; w0[0] = last ? vN0[0] : vC0[0]; w0[1] = last ? vN0[1] : vC0[1]; w1[0] = last ? vN1[0] : vC1[0]; w1[1] = last ? vN1[1] : vC1[1];
            PG8_LDB(B0, 0, 0); PG8_LDB(B1, 0, 1); PG8_SCHED; PG8_LDA(At, 0, 0); PG8_STAGE(PG8_SA(1, 1), a1, vC1);
            PG8_WAIT_V(8); PG8_WAIT_L(0); PG8_BAR; PG8_MMA(0, 0, At, B0); PG8_MMA(0, 1, At, B1); PG8_BAR; PG8_SCHED;
            PG8_LDA(At, 0, 1); PG8_STAGE(PG8_SB(0, 0), b2, voffB); PG8_STAGE(PG8_SB(0, 1), b2 + hstepB, voffB); PG8_STAGE(PG8_SA(0, 0), a2, w0);
            PG8_WAIT_V(8); PG8_WAIT_L(0); PG8_BAR; PG8_MMA(1, 0, At, B0); PG8_MMA(1, 1, At, B1); PG8_BAR; PG8_SCHED;
            PG8_LDB(B0, 1, 0); PG8_LDB(B1, 1, 1); PG8_SCHED; PG8_LDA(At, 1, 0); PG8_STAGE(PG8_SA(0, 1), a2, w1);
            PG8_WAIT_V(8); PG8_WAIT_L(0); PG8_BAR; PG8_MMA(0, 0, At, B0); PG8_MMA(0, 1, At, B1); PG8_BAR; PG8_SCHED;
            PG8_LDA(At, 1, 1); PG8_STAGE(PG8_SB(1, 0), b3, voffB); PG8_STAGE(PG8_SB(1, 1), b3 + hstepB, voffB); PG8_STAGE(PG8_SA(1, 0), a3, w0);
            PG8_WAIT_V(8); PG8_WAIT_L(0); PG8_BAR; PG8_MMA(1, 0, At, B0); PG8_MMA(1, 1, At, B1); PG8_BAR; PG8_SCHED;
            } else {
            const char* a1 = cA + (size_t)(t + 1) * kstepA;
            const char* a2 = last ? nA : cA + (size_t)(t + 2) * kstepA; const char* b2 = last ? nB : cB + (size_t)(t + 2) * kstepB;
            const char* a3 = a2 + kstepA; const char* b3 = b2 + kstepB;
            PG8_LDB(B0, 0, 0); PG8_LDB(B1, 0, 1); PG8_SCHED; PG8_LDA(At, 0, 0); PG8_STAGE(PG8_SA(1, 1), a1 + hstepA, voffA);
            PG8_WAIT_V(8); PG8_WAIT_L(0); PG8_BAR; PG8_MMA(0, 0, At, B0); PG8_MMA(0, 1, At, B1); PG8_BAR; PG8_SCHED;
            PG8_LDA(At, 0, 1); PG8_STAGE(PG8_SB(0, 0), b2, voffB); PG8_STAGE(PG8_SB(0, 1), b2 + hstepB, voffB); PG8_STAGE(PG8_SA(0, 0), a2, voffA);
            PG8_WAIT_V(8); PG8_WAIT_L(0); PG8_BAR; PG8_MMA(1, 0, At, B0); PG8_MMA(1, 1, At, B1); PG8_BAR; PG8_SCHED;
            PG8_LDB(B0, 1, 0); PG8_LDB(B1, 1, 1); PG8_SCHED; PG8_LDA(At, 1, 0); PG8_STAGE(PG8_SA(0, 1), a2 + hstepA, voffA);
            PG8_WAIT_V(8); PG8_WAIT_L(0); PG8_BAR; PG8_MMA(0, 0, At, B0); PG8_MMA(0, 1, At, B1); PG8_BAR; PG8_SCHED;
            PG8_LDA(At, 1, 1); PG8_STAGE(PG8_SB(1, 0), b3, voffB); PG8_STAGE(PG8_SB(1, 1), b3 + hstepB, voffB); PG8_STAGE(PG8_SA(1, 0), a3, voffA);
            PG8_WAIT_V(8); PG8_WAIT_L(0); PG8_BAR; PG8_MMA(1, 0, At, B0); PG8_MMA(1, 1, At, B1); PG8_BAR; PG8_SCHED;
            }
        }
        if constexpr (ALIGN_EPI) { if (wr == 0) PG8_BAR; }
        if constexpr (FP8) { asm volatile("s_nop 15\n\ts_nop 15" ::: "memory"); }
        if constexpr (!Epi::AFTER_DRAIN) { int fr_ = fr, fq_ = fq; asm volatile("" : "+v"(fr_), "+v"(fq_));
            E(acc, cur, wr, wc, fr_, fq_); }
        if (!has_next) break;
#pragma unroll
        for (int a = 0; a < 2; ++a)
#pragma unroll
            for (int b = 0; b < 2; ++b)
#pragma unroll
                for (int m = 0; m < 4; ++m)
#pragma unroll
                    for (int n = 0; n < 2; ++n) acc[a][b][m][n] = (f32x4){0.f, 0.f, 0.f, 0.f};
        cur = nxt; cA = nA; cB = nB; ++ui;
        if constexpr (GATHER) { vC0[0] = vN0[0]; vC0[1] = vN0[1]; vC1[0] = vN1[0]; vC1[1] = vN1[1]; }
        if constexpr (ALIGN_EPI) { if (wr == 1) PG8_BAR; }
    }
    PG8_WAIT_V(0);
    if constexpr (!ALIGN_EPI) { if (wr == 0) PG8_BAR; }
    PG8_BAR;
    if constexpr (Epi::AFTER_DRAIN) { E.fused(acc, cur, wr, wc, fr, fq, wid, lane); }
#undef PG8_SA
#undef PG8_SB
#undef PG8_STAGE
#undef PG8_STAGE2
#undef PG8_GLOAD
#undef PG8_LDA
#undef PG8_LDB
#undef PG8_MMA
#undef PG8_WAIT_V
#undef PG8_WAIT_L
#undef PG8_BAR
#undef PG8_SCHED
}

struct DenseOrder {
    int nM, nN, nwg, G, c; const char* A; const char* B; size_t tA, tB; const char* A2 = nullptr; const char* B2 = nullptr; size_t tA2 = 0, tB2 = 0;
    __device__ __forceinline__ void init(int M, int N, int G_, int c_, const void* A_, unsigned lda, const void* B_, unsigned ldb) {
        nM = M / BM; nN = N / BM; nwg = nM * nN; G = G_; c = c_; A = (const char*)A_; B = (const char*)B_; tA = (size_t)BM * lda; tB = (size_t)BM * ldb; }
    __device__ __forceinline__ bool next(int i, Unit& u) const {
        const long L = (long)i * G + c; if (L >= nwg) return false;
        int wgid = (int)L; { const int q = nwg / 8, r = nwg % 8, xcd = wgid % 8, off = wgid / 8; wgid = (xcd < r ? xcd * (q + 1) : r * (q + 1) + (xcd - r) * q) + off; }
        const int nig = 8 * nN, gid = wgid / nig, fm = gid * 8, gsz = (nM - fm) < 8 ? (nM - fm) : 8;
        u.pm = fm + ((wgid % nig) % gsz); u.pn = (wgid % nig) / gsz;
        u.A = A + (size_t)u.pm * tA; u.B = B + (size_t)u.pn * tB; u.A2 = A2 + (size_t)u.pm * tA2; u.B2 = B2 + (size_t)u.pn * tB2; return true;
    }
};
}

struct Args {
    const float* x; const float* c; const float* rel_bias; const float* ada_w; const float* ada_b; const float* norm1; const float* norm2; const float* w_in;
    const float* cmp_pos; const float* cmp_w1; const float* cmp_w2; const float* w_up_nsa; const float* w_up_dil; const float* w_o;
    const float* router_wg; const float* router_bg; const float* router_we; const float* router_be; const float* exp_w1; const float* exp_w3; const float* exp_w2; const float* norm_f;
    float* out; unsigned char* ws; int ph_lo, ph_hi, use_bar, pad;
};

typedef f32x4 AccT[2][2][4][2];
__device__ __forceinline__ unsigned q8(float x) { return (unsigned)(sigmoidf_(x) * 255.0f + 0.5f); }
struct EpiInProj {
    static constexpr bool PERM = true, AFTER_DRAIN = false;
    bf16_t* QKV; unsigned char* MG; float* GN; float os;
    __device__ __forceinline__ void operator()(const AccT& acc, const pg8::Unit& u, int wr, int wc, int fr, int fq) const {
        const int pn = u.pn; const int row0 = u.pm * 256 + wr * 64 + fr;
        if (pn < 14) {
            const float sc = ((pn < 2 || (pn >= 5 && pn < 8)) ? C2 : 1.0f) * os;
            const int col0 = pn * 256 + wc * 32 + 8 * fq;
#pragma unroll
            for (int ai = 0; ai < 2; ++ai)
#pragma unroll
                for (int m = 0; m < 4; ++m) { bf16_t* rowp = QKV + (size_t)(row0 + ai * 128 + m * 16) * LDQ + col0;
#pragma unroll
                    for (int bj = 0; bj < 2; ++bj) { const f32x4 v0 = acc[ai][bj][m][0] * sc, v1 = acc[ai][bj][m][1] * sc; u32x4 w;
                        w.x = cvt_pk_bf16(v0[0], v0[1]); w.y = cvt_pk_bf16(v0[2], v0[3]); w.z = cvt_pk_bf16(v1[0], v1[1]); w.w = cvt_pk_bf16(v1[2], v1[3]);
                        *(u32x4*)(rowp + bj * 128) = w; } }
        } else if (pn < 22) {
            const int col0 = (pn - 14) * 256 + wc * 32 + 8 * fq;
#pragma unroll
            for (int ai = 0; ai < 2; ++ai)
#pragma unroll
                for (int m = 0; m < 4; ++m) { unsigned char* rowp = MG + (size_t)(row0 + ai * 128 + m * 16) * 2048 + col0;
#pragma unroll
                    for (int bj = 0; bj < 2; ++bj) { const f32x4 v0 = acc[ai][bj][m][0] * os, v1 = acc[ai][bj][m][1] * os; u32x2 w;
                        w.x = q8(v0[0]) | (q8(v0[1]) << 8) | (q8(v0[2]) << 16) | (q8(v0[3]) << 24); w.y = q8(v1[0]) | (q8(v1[1]) << 8) | (q8(v1[2]) << 16) | (q8(v1[3]) << 24);
                        *(u32x2*)(rowp + bj * 128) = w; } }
        } else {
            if (wc == 0 && fq < 3) {
#pragma unroll
                for (int ai = 0; ai < 2; ++ai)
#pragma unroll
                    for (int m = 0; m < 4; ++m) { float* rowp = GN + (size_t)(row0 + ai * 128 + m * 16) * 32 + 8 * fq;
                        const f32x4 v0 = acc[ai][0][m][0] * os, v1 = acc[ai][0][m][1] * os;
                        *(f32x4*)(rowp) = (f32x4){sigmoidf_(v0[0]), sigmoidf_(v0[1]), sigmoidf_(v0[2]), sigmoidf_(v0[3])};
                        *(f32x4*)(rowp + 4) = (f32x4){sigmoidf_(v1[0]), sigmoidf_(v1[1]), sigmoidf_(v1[2]), sigmoidf_(v1[3])}; }
            }
        }
    }
};
template <int PASS> struct EpiUp {
    static constexpr bool PERM = true, AFTER_DRAIN = false;
    bf16_t* MERGED; const bf16_t* MG;
    __device__ __forceinline__ void operator()(const AccT& acc, const pg8::Unit& u, int wr, int wc, int fr, int fq) const {
        const int row0 = u.pm * 256 + wr * 64 + fr; const int col0 = u.pn * 256 + wc * 32 + 8 * fq;
#pragma unroll
        for (int ai = 0; ai < 2; ++ai)
#pragma unroll
            for (int m = 0; m < 4; ++m) { const size_t row = (size_t)(row0 + ai * 128 + m * 16);
#pragma unroll
                for (int bj = 0; bj < 2; ++bj) {
                    const u32x4 gw = *(const u32x4*)(MG + row * 2048 + PASS * 1024 + col0 + bj * 128);
                    bf16_t* op = MERGED + row * 1024 + col0 + bj * 128;
                    const f32x4 v0 = acc[ai][bj][m][0], v1 = acc[ai][bj][m][1];
                    float r[8] = {v0[0] * bf_lo(gw.x), v0[1] * bf_hi(gw.x), v0[2] * bf_lo(gw.y), v0[3] * bf_hi(gw.y), v1[0] * bf_lo(gw.z), v1[1] * bf_hi(gw.z), v1[2] * bf_lo(gw.w), v1[3] * bf_hi(gw.w)};
                    if (PASS == 1) { const u32x4 ow = *(const u32x4*)op;
                        r[0] += bf_lo(ow.x); r[1] += bf_hi(ow.x); r[2] += bf_lo(ow.y); r[3] += bf_hi(ow.y); r[4] += bf_lo(ow.z); r[5] += bf_hi(ow.z); r[6] += bf_lo(ow.w); r[7] += bf_hi(ow.w); }
                    u32x4 w; w.x = cvt_pk_bf16(r[0], r[1]); w.y = cvt_pk_bf16(r[2], r[3]); w.z = cvt_pk_bf16(r[4], r[5]); w.w = cvt_pk_bf16(r[6], r[7]);
                    *(u32x4*)op = w; }
                asm volatile("" ::: "memory"); }
    }
};
struct EpiUpFused {
    static constexpr bool PERM = true, AFTER_DRAIN = false;
    bf16_t* MERGED; const unsigned char* MG;
    __device__ __forceinline__ void mid(AccT& acc, const pg8::Unit& u, int wr, int wc, int fr, int fq) const {
        const int row0 = u.pm * 256 + wr * 64 + fr; const int col0 = u.pn * 256 + wc * 32 + 8 * fq;
#pragma unroll
        for (int ai = 0; ai < 2; ++ai)
#pragma unroll
            for (int m = 0; m < 4; ++m) { const size_t row = (size_t)(row0 + ai * 128 + m * 16);
#pragma unroll
                for (int bj = 0; bj < 2; ++bj) {
                    const u32x2 g0 = *(const u32x2*)(MG + row * 2048 + col0 + bj * 128), g1 = *(const u32x2*)(MG + row * 2048 + 1024 + col0 + bj * 128);
                    f32x4& v0 = acc[ai][bj][m][0]; f32x4& v1 = acc[ai][bj][m][1];
#pragma unroll
                    for (int j = 0; j < 4; ++j) { const float a0 = (float)((g0.x >> (8 * j)) & 255u), b0 = (float)((g1.x >> (8 * j)) & 255u), a1 = (float)((g0.y >> (8 * j)) & 255u), b1 = (float)((g1.y >> (8 * j)) & 255u);
                        v0[j] *= a0 * __builtin_amdgcn_rcpf(__builtin_fmaxf(b0, 0.5f)); v1[j] *= a1 * __builtin_amdgcn_rcpf(__builtin_fmaxf(b1, 0.5f)); } }
                asm volatile("" ::: "memory"); }
    }
    __device__ __forceinline__ void operator()(const AccT& acc, const pg8::Unit& u, int wr, int wc, int fr, int fq) const {
        const int row0 = u.pm * 256 + wr * 64 + fr; const int col0 = u.pn * 256 + wc * 32 + 8 * fq;
#pragma unroll
        for (int ai = 0; ai < 2; ++ai)
#pragma unroll
            for (int m = 0; m < 4; ++m) { const size_t row = (size_t)(row0 + ai * 128 + m * 16);
#pragma unroll
                for (int bj = 0; bj < 2; ++bj) {
                    const u32x2 g1 = *(const u32x2*)(MG + row * 2048 + 1024 + col0 + bj * 128);
                    const f32x4 v0 = acc[ai][bj][m][0], v1 = acc[ai][bj][m][1]; float r[8];
#pragma unroll
                    for (int j = 0; j < 4; ++j) { r[j] = v0[j] * (__builtin_fmaxf((float)((g1.x >> (8 * j)) & 255u), 0.5f) * (1.0f / 255.0f)); r[4 + j] = v1[j] * (__builtin_fmaxf((float)((g1.y >> (8 * j)) & 255u), 0.5f) * (1.0f / 255.0f)); }
                    u32x4 w; w.x = cvt_pk_bf16(r[0], r[1]); w.y = cvt_pk_bf16(r[2], r[3]); w.z = cvt_pk_bf16(r[4], r[5]); w.w = cvt_pk_bf16(r[6], r[7]);
                    *(u32x4*)(MERGED + row * 1024 + col0 + bj * 128) = w; }
                asm volatile("" ::: "memory"); }
    }
};
struct EpiOut {
    static constexpr bool PERM = true, AFTER_DRAIN = false;
    const float* xin; float* xout; const float* g1;
    __device__ __forceinline__ void operator()(const AccT& acc, const pg8::Unit& u, int wr, int wc, int fr, int fq) const {
        const int row0 = u.pm * 256 + wr * 64 + fr; const int col0 = u.pn * 256 + wc * 32 + 8 * fq; const int b = u.pm >> 4;
        f32x4 gv[2][2];
#pragma unroll
        for (int bj = 0; bj < 2; ++bj)
#pragma unroll
            for (int n = 0; n < 2; ++n) gv[bj][n] = *(const f32x4*)(g1 + (size_t)b * 6144 + col0 + bj * 128 + 4 * n);
#pragma unroll
        for (int ai = 0; ai < 2; ++ai)
#pragma unroll
            for (int m = 0; m < 4; ++m) { const size_t off = (size_t)(row0 + ai * 128 + m * 16) * 1024 + col0;
#pragma unroll
                for (int bj = 0; bj < 2; ++bj)
#pragma unroll
                    for (int n = 0; n < 2; ++n) { const f32x4 xv = *(const f32x4*)(xin + off + bj * 128 + 4 * n);
                        *(f32x4*)(xout + off + bj * 128 + 4 * n) = (ABL == 7) ? xv : xv + gv[bj][n] * acc[ai][bj][m][n]; }
                asm volatile("" ::: "memory"); }
    }
};
struct EpiMoe1 {
    static constexpr bool PERM = true, AFTER_DRAIN = false;
    bf16_t* ACT; float os;
    __device__ __forceinline__ void operator()(const AccT& acc, const pg8::Unit& u, int wr, int wc, int fr, int fq) const {
        const int row0 = u.pm * 256 + wr * 64 + fr; const int col0 = u.pn * 128 + wc * 32 + 8 * fq;
#pragma unroll
        for (int ai = 0; ai < 2; ++ai)
#pragma unroll
            for (int m = 0; m < 4; ++m) { bf16_t* op = ACT + (size_t)(row0 + ai * 128 + m * 16) * 512 + col0; float r[8];
#pragma unroll
                for (int n = 0; n < 2; ++n)
#pragma unroll
                    for (int j = 0; j < 4; ++j) { const float a = acc[ai][0][m][n][j] * os, bb = acc[ai][1][m][n][j] * os; r[n * 4 + j] = a * sigmoidf_(a) * bb; }
                u32x4 w; w.x = cvt_pk_bf16(r[0], r[1]); w.y = cvt_pk_bf16(r[2], r[3]); w.z = cvt_pk_bf16(r[4], r[5]); w.w = cvt_pk_bf16(r[6], r[7]);
                *(u32x4*)op = w; }
    }
};
struct EpiPlain {
    static constexpr bool PERM = true, AFTER_DRAIN = false;
    bf16_t* O; int ldc;
    __device__ __forceinline__ void operator()(const AccT& acc, const pg8::Unit& u, int wr, int wc, int fr, int fq) const {
        const int row0 = u.pm * 256 + wr * 64 + fr; const int col0 = u.pn * 256 + wc * 32 + 8 * fq;
#pragma unroll
        for (int ai = 0; ai < 2; ++ai)
#pragma unroll
            for (int m = 0; m < 4; ++m) { bf16_t* rowp = O + (size_t)(row0 + ai * 128 + m * 16) * ldc + col0;
#pragma unroll
                for (int bj = 0; bj < 2; ++bj) { const f32x4 v0 = acc[ai][bj][m][0], v1 = acc[ai][bj][m][1]; u32x4 w;
                    w.x = cvt_pk_bf16(v0[0], v0[1]); w.y = cvt_pk_bf16(v0[2], v0[3]); w.z = cvt_pk_bf16(v1[0], v1[1]); w.w = cvt_pk_bf16(v1[2], v1[3]);
                    *(u32x4*)(rowp + bj * 128) = w; } }
    }
};
__device__ __forceinline__ int crow(int r, int hi) { return (r & 3) + 8 * (r >> 2) + 4 * hi; }
__device__ __forceinline__ float gelu_tanh(float x) { const float u2 = 2.0f * 0.7978845608028654f * (x + 0.044715f * x * x * x); return x * __builtin_amdgcn_rcpf(1.0f + __builtin_amdgcn_exp2f(-u2 * LOG2E)); }
struct EpiCmp {
    static constexpr bool PERM = true, AFTER_DRAIN = true;
    bf16_t* HID; const float* CB1; const bf16_t* CW2T; bf16_t* KC;
    __device__ __forceinline__ void fused(const AccT& acc, const pg8::Unit& u, int wr, int wc, int fr, int fq, int wid, int lane) const {
        const int kv = u.pm >> 4; const int row0 = u.pm * 256 + wr * 64 + fr; const int col0 = wc * 32 + 8 * fq;
        const float* bias = CB1 + kv * 256;
        f32x4 bv[2][2];
#pragma unroll
        for (int bj = 0; bj < 2; ++bj)
#pragma unroll
            for (int n = 0; n < 2; ++n) bv[bj][n] = *(const f32x4*)(bias + col0 + bj * 128 + 4 * n);
#pragma unroll
        for (int ai = 0; ai < 2; ++ai)
#pragma unroll
            for (int m = 0; m < 4; ++m) { bf16_t* rowp = HID + (size_t)(row0 + ai * 128 + m * 16) * 256 + col0;
#pragma unroll
                for (int bj = 0; bj < 2; ++bj) { const f32x4 v0 = acc[ai][bj][m][0] + bv[bj][0], v1 = acc[ai][bj][m][1] + bv[bj][1]; u32x4 w;
                    w.x = cvt_pk_bf16(gelu_tanh(v0[0]), gelu_tanh(v0[1])); w.y = cvt_pk_bf16(gelu_tanh(v0[2]), gelu_tanh(v0[3]));
                    w.z = cvt_pk_bf16(gelu_tanh(v1[0]), gelu_tanh(v1[1])); w.w = cvt_pk_bf16(gelu_tanh(v1[2]), gelu_tanh(v1[3]));
                    *(u32x4*)(rowp + bj * 128) = w; } }
        VM_WAIT(); __syncthreads();
        const int r32 = lane & 31, hi = lane >> 5;
        const bf16_t* ap = HID + (size_t)(u.pm * 256 + 32 * wid + r32) * 256 + hi * 8;
        const bf16_t* bp = CW2T + (size_t)kv * 64 * 256 + (size_t)r32 * 256 + hi * 8;
        f32x16 o0 = {}, o1 = {};
#pragma unroll 4
        for (int ks = 0; ks < 16; ++ks) {
            const bf16x8 a = *(const bf16x8*)(ap + ks * 16);
            const bf16x8 b0 = *(const bf16x8*)(bp + ks * 16), b1 = *(const bf16x8*)(bp + 32 * 256 + ks * 16);
            o0 = __builtin_amdgcn_mfma_f32_32x32x16_bf16(a, b0, o0, 0, 0, 0);
            o1 = __builtin_amdgcn_mfma_f32_32x32x16_bf16(a, b1, o1, 0, 0, 0);
        }
        bf16_t* kc = KC + (size_t)u.pm * 256 * 64;
#pragma unroll
        for (int r = 0; r < 16; ++r) { const int c = 32 * wid + crow(r, hi); const bool pad = (c == 255);
            kc[(size_t)c * 64 + r32] = pad ? (bf16_t)0 : (bf16_t)(cvt_pk_bf16(o0[r], 0.f) & 0xffffu);
            kc[(size_t)c * 64 + 32 + r32] = pad ? (bf16_t)0 : (bf16_t)(cvt_pk_bf16(o1[r], 0.f) & 0xffffu); }
    }
};

namespace att {
constexpr int L_KR = 0;
constexpr int L_VR = 24576;
constexpr int L_WSF = 49152;
constexpr int L_BKT = 51200;
constexpr int L_BKC = 55296;
constexpr int L_TBH = 64000;
constexpr int L_GSH = 64576;
constexpr int L_SEL = 67648;
constexpr int L_OTA = 68672;
constexpr int L_IMP = 101440;
constexpr int L_LUT = 117824;
constexpr int L_END = L_LUT + 40960;
static_assert(L_END <= LDS_MISC, "attention LDS map");

__device__ __forceinline__ void glds16(const void* gsrc, unsigned lds_dst) { unsigned keep;
    asm volatile("s_mov_b32 %0, m0\n\ts_mov_b32 m0, %2\n\ts_nop 0\n\tglobal_load_lds_dwordx4 %1, off\n\ts_mov_b32 m0, %0" : "=&s"(keep) : "v"(gsrc), "s"(lds_dst) : "memory"); }
__device__ __forceinline__ int bucket_of(int d) {
    if (d < 16) return d;
    int b = 16;
    b += (d >= 22); b += (d >= 30); b += (d >= 40); b += (d >= 54); b += (d >= 73); b += (d >= 99); b += (d >= 134); b += (d >= 182);
    b += (d >= 246); b += (d >= 332); b += (d >= 450); b += (d >= 609); b += (d >= 825); b += (d >= 1117); b += (d >= 1513);
    return b;
}
__device__ __forceinline__ void qkt(f32x16& p0, f32x16& p1, const LAS unsigned char* Kslot, const bf16x8 (&qr)[4], int r32, int hi) {
    const LAS unsigned char* kb = Kslot + hi * 1024 + r32 * 16;
    p0 = (f32x16){}; p1 = (f32x16){};
#pragma unroll
    for (int d0 = 0; d0 < 4; ++d0) {
        const bf16x8 b0 = *(const LAS bf16x8*)(kb + d0 * 2048);
        const bf16x8 b1 = *(const LAS bf16x8*)(kb + d0 * 2048 + 512);
        p0 = __builtin_amdgcn_mfma_f32_32x32x16_bf16(b0, qr[d0], p0, 0, 0, 0);
        p1 = __builtin_amdgcn_mfma_f32_32x32x16_bf16(b1, qr[d0], p1, 0, 0, 0);
    }
}
__device__ __forceinline__ void pv(f32x16 (&o)[2], int vb, bf16x8 pa0, bf16x8 pa1, bf16x8 pa2, bf16x8 pa3) {
#pragma unroll
    for (int d0 = 0; d0 < 2; ++d0) { s16x4 lo[4], hi[4];
#pragma unroll
        for (int ks = 0; ks < 4; ++ks) {
            asm volatile("ds_read_b64_tr_b16 %0,%1 offset:%c2" : "=&v"(lo[ks]) : "v"(vb), "i"(d0 * 4096 + ks * 1024) : "memory");
            asm volatile("ds_read_b64_tr_b16 %0,%1 offset:%c2" : "=&v"(hi[ks]) : "v"(vb), "i"(d0 * 4096 + ks * 1024 + 512) : "memory"); }
        asm volatile("s_waitcnt lgkmcnt(0)" ::: "memory"); __builtin_amdgcn_sched_barrier(0);
#define PK(k) (bf16x8){lo[k][0], lo[k][1], lo[k][2], lo[k][3], hi[k][0], hi[k][1], hi[k][2], hi[k][3]}
        o[d0] = __builtin_amdgcn_mfma_f32_32x32x16_bf16(pa0, PK(0), o[d0], 0, 0, 0);
        o[d0] = __builtin_amdgcn_mfma_f32_32x32x16_bf16(pa1, PK(1), o[d0], 0, 0, 0);
        o[d0] = __builtin_amdgcn_mfma_f32_32x32x16_bf16(pa2, PK(2), o[d0], 0, 0, 0);
        o[d0] = __builtin_amdgcn_mfma_f32_32x32x16_bf16(pa3, PK(3), o[d0], 0, 0, 0);
#undef PK
    }
}
__device__ __forceinline__ float xhalf_max(float v) { auto rr = __builtin_amdgcn_permlane32_swap(__float_as_uint(v), __float_as_uint(v), false, false); return __builtin_fmaxf(__uint_as_float(rr[0]), __uint_as_float(rr[1])); }
__device__ __forceinline__ float xhalf_sum(float v) { auto rr = __builtin_amdgcn_permlane32_swap(__float_as_uint(v), __float_as_uint(v), false, false); return __uint_as_float(rr[0]) + __uint_as_float(rr[1]); }

#define ATT_PACK(p0, p1, pw0, pw1, pw2, pw3) do { \
    pw0 = (u32x4){cvt_pk_bf16(p0[0], p0[1]), cvt_pk_bf16(p0[2], p0[3]), cvt_pk_bf16(p0[4], p0[5]), cvt_pk_bf16(p0[6], p0[7])}; \
    pw1 = (u32x4){cvt_pk_bf16(p0[8], p0[9]), cvt_pk_bf16(p0[10], p0[11]), cvt_pk_bf16(p0[12], p0[13]), cvt_pk_bf16(p0[14], p0[15])}; \
    pw2 = (u32x4){cvt_pk_bf16(p1[0], p1[1]), cvt_pk_bf16(p1[2], p1[3]), cvt_pk_bf16(p1[4], p1[5]), cvt_pk_bf16(p1[6], p1[7])}; \
    pw3 = (u32x4){cvt_pk_bf16(p1[8], p1[9]), cvt_pk_bf16(p1[10], p1[11]), cvt_pk_bf16(p1[12], p1[13]), cvt_pk_bf16(p1[14], p1[15])}; } while (0)

__device__ __forceinline__ void stage_rows(LAS unsigned char* lds, int wid, int lane, const f32x16 (&ot)[2]) {
    const int r32 = lane & 31, hi = lane >> 5;
    LAS bf16_t* stg = (LAS bf16_t*)(lds + L_OTA) + wid * 2048;
#pragma unroll
    for (int r = 0; r < 16; ++r) { const int orow = crow(r, hi);
#pragma unroll
        for (int d0 = 0; d0 < 2; ++d0) stg[orow * 64 + d0 * 32 + r32] = (bf16_t)(cvt_pk_bf16(ot[d0][r], 0.f) & 0xffffu); }
    LDS_WAIT();
}
struct StreamP { const bf16_t* Kb; const bf16_t* Vb; long pitch; int NT; const LAS unsigned char* tl; unsigned long long lanesel; int uq; const LAS float* lut; int xtop; int dclamp; };
typedef const LAS unsigned char* lds_cptr;
typedef short v4i16_t __attribute__((ext_vector_type(4)));
__device__ __forceinline__ void kload8(bf16x8* kf, lds_cptr kp) {
    kf[0] = *(const LAS bf16x8*)(kp);        kf[1] = *(const LAS bf16x8*)(kp + 512);
    kf[2] = *(const LAS bf16x8*)(kp + 2048); kf[3] = *(const LAS bf16x8*)(kp + 2560);
    kf[4] = *(const LAS bf16x8*)(kp + 4096); kf[5] = *(const LAS bf16x8*)(kp + 4608);
    kf[6] = *(const LAS bf16x8*)(kp + 6144); kf[7] = *(const LAS bf16x8*)(kp + 6656);
}
__device__ __forceinline__ void kload2(bf16x8* kf, lds_cptr kp, int j) { kf[2 * j] = *(const LAS bf16x8*)(kp + j * 2048); kf[2 * j + 1] = *(const LAS bf16x8*)(kp + j * 2048 + 512); }
__device__ __forceinline__ s16x4 vtr(lds_cptr p) { return __builtin_bit_cast(s16x4, __builtin_amdgcn_ds_read_tr16_b64_v4i16((LAS v4i16_t*)p)); }
constexpr int SLOTB = 8192;
#define ST_WAIT_BAR(N) asm volatile("s_waitcnt vmcnt(" #N ") lgkmcnt(0)\n\ts_barrier" ::: "memory")
template <int THRL>
__device__ __forceinline__ void attn_stream(LAS unsigned char* lds, const int wid, const int lane, const bf16x8 (&qr)[4], const StreamP S, float& mhat_o, float& l_o, f32x16 (&o)[2]) {
    const int r32 = lane & 31, hi = lane >> 5;
    const unsigned lds0 = (unsigned)(uintptr_t)lds;
    LAS float* wsf = (LAS float*)(lds + L_WSF) + wid * 64;
    const int NT = S.NT;
    const bf16_t* ksrc = S.Kb + (long)lane * S.pitch + wid * 8;
    const bf16_t* vsrc = S.Vb + (long)(16 * (wid & 3) + (lane >> 2)) * S.pitch + (wid >> 2) * 32 + (lane & 3) * 8;
    const unsigned kdst = lds0 + L_KR + wid * 1024, vdst = lds0 + L_VR + wid * 1024;
    const int tlv = (lane < NT) ? (int)S.tl[lane] : 0x80;
#define TLRAW(k) ((int)__builtin_amdgcn_readlane(tlv, __builtin_amdgcn_readfirstlane(k)))
#define DMA_K(k, slot) do { const int tr_ = TLRAW(k) & 63; glds16(ksrc + (long)tr_ * 64 * S.pitch, (unsigned)__builtin_amdgcn_readfirstlane(kdst + (slot))); } while (0)
#define DMA_V(k, slot) do { const int tr_ = TLRAW(k) & 63; glds16(vsrc + (long)tr_ * 64 * S.pitch, (unsigned)__builtin_amdgcn_readfirstlane(vdst + (slot))); } while (0)
    const lds_cptr kp0 = (lds_cptr)lds + L_KR + hi * 1024 + r32 * 16;
    const lds_cptr vp0 = (lds_cptr)lds + L_VR + ((lane >> 4) & 1) * 32 + (lane & 3) * 8 + (4 * hi + ((lane & 15) >> 2)) * 64;
    const int vb0 = (int)(lds0 + L_VR) + ((lane >> 4) & 1) * 32 + (lane & 3) * 8 + (4 * hi + ((lane & 15) >> 2)) * 64;
    bf16x8 kf[8];
#define LOFF(r) (((r) & 3) + 8 * ((r) >> 2))
#define LUTPTR(k, lp) do { const int raw_ = TLRAW(k); const int tj_ = raw_ & 63; int d0_ = S.uq - 64 * tj_ - 4 * hi; d0_ = d0_ < S.dclamp ? d0_ : S.dclamp; \
        const bool ok_ = (raw_ < 128) && (((S.lanesel >> tj_) & 1ull) != 0ull); lp = S.lut + (ok_ ? S.xtop - d0_ : S.xtop + 64); } while (0)
#define LUTLOAD(C0, C1, k) do { const int raw_ = TLRAW(k); const int tj_ = raw_ & 63; int d0_ = S.uq - 64 * tj_ - 4 * hi; d0_ = d0_ < S.dclamp ? d0_ : S.dclamp; \
        const bool ok_ = (raw_ < 128) && (((S.lanesel >> tj_) & 1ull) != 0ull); const LAS float* lp_ = S.lut + (ok_ ? S.xtop - d0_ : S.xtop + 64); \
        _Pragma("unroll") for (int r = 0; r < 16; ++r) { C0[r] = lp_[(r & 3) + 8 * (r >> 2)]; C1[r] = lp_[(r & 3) + 8 * (r >> 2) + 32]; } } while (0)
#define SBAR() __builtin_amdgcn_sched_barrier(0)
#define PIN(x) asm volatile("" : "+v"(x))
#define PKW(P, B) cvt_pk_bf16(P[B], P[B + 1])
#define PAF(k) __builtin_bit_cast(bf16x8, pw##k)
#define VFR(i) (bf16x8){vlo[i][0], vlo[i][1], vlo[i][2], vlo[i][3], vhi[i][0], vhi[i][1], vhi[i][2], vhi[i][3]}
#define MX3(a, b, c) __builtin_fmaxf(__builtin_fmaxf((a), (b)), (c))
#define MFMA32(a, b, c) __builtin_amdgcn_mfma_f32_32x32x16_bf16(a, b, c, 0, 0, 0)
#define GAPA(MF, A0, A1, A2, A3, W0, W1, PW) do { MF; sacc += A0; sacc += A1; sacc += A2; sacc += A3; PIN(sacc); W0; W1; PIN(PW); SBAR(); } while (0)
#define EX(v) __builtin_amdgcn_exp2f(v)
#define GAPB(MF, X, B, GN, PL, PO) do { MF; X[B] = EX(X[B]); X[B + 1] = EX(X[B + 1]); X[B + 2] = EX(X[B + 2]); X[B + 3] = EX(X[B + 3]); PIN(X); \
        if (GN) { PL[B] = lpn_[LOFF(B) + PO]; PL[B + 1] = lpn_[LOFF(B + 1) + PO]; PL[B + 2] = lpn_[LOFF(B + 2) + PO]; PL[B + 3] = lpn_[LOFF(B + 3) + PO]; } SBAR(); } while (0)
#define VRD(i) do { vlo[i] = vtr(vp_ + (((i) >> 2) * 4096 + ((i) & 3) * 1024)); vhi[i] = vtr(vp_ + (((i) >> 2) * 4096 + ((i) & 3) * 1024 + 512)); } while (0)
#define KRD(G, j) do { if (G) { kload2(kf, kp0 + sl_next, j); SBAR(); } } while (0)
#define ROT() do { sl_prev = sl_cur; sl_cur = sl_next; sl_next = (sl_next == 2 * SLOTB) ? 0 : sl_next + SLOTB; } while (0)
#define RESC() do { if (resc) { LDS_WAIT(); _Pragma("unroll") for (int d_ = 0; d_ < 2; ++d_) _Pragma("unroll") for (int r = 0; r < 16; ++r) o[d_][r] *= wsf[crow(r, hi)]; } } while (0)
#define ENDW(tt) do { if ((tt) + 3 < NT) { ST_WAIT_BAR(2); } else if ((tt) + 2 < NT) { ST_WAIT_BAR(1); } else { ST_WAIT_BAR(0); } } while (0)
#define STEP(C0, C1, P0, P1, t, GK, GV, GL, GN) do { SBAR(); \
    const lds_cptr vp_ = vp0 + sl_prev; const LAS float* lpn_ = S.lut; if (GN) { LUTPTR((t) + 1, lpn_); } \
    VRD(0); SBAR(); float sacc = (P0[0] + P0[1]); \
    GAPA(C0 = MFMA32(kf[0], qr[0], C0), P0[2], P0[3], P0[4], P0[5],     pw0[0] = PKW(P0, 0), pw0[1] = PKW(P0, 2), pw0); \
    VRD(4); SBAR(); GAPA(C1 = MFMA32(kf[1], qr[0], C1), P0[6], P0[7], P0[8], P0[9],     pw0[2] = PKW(P0, 4), pw0[3] = PKW(P0, 6), pw0); \
    VRD(1); SBAR(); GAPA(C0 = MFMA32(kf[2], qr[1], C0), P0[10], P0[11], P0[12], P0[13], pw1[0] = PKW(P0, 8), pw1[1] = PKW(P0, 10), pw1); \
    VRD(5); SBAR(); GAPA(C1 = MFMA32(kf[3], qr[1], C1), P0[14], P0[15], P1[0], P1[1],   pw1[2] = PKW(P0, 12), pw1[3] = PKW(P0, 14), pw1); \
    VRD(2); SBAR(); GAPA(C0 = MFMA32(kf[4], qr[2], C0), P1[2], P1[3], P1[4], P1[5],     pw2[0] = PKW(P1, 0), pw2[1] = PKW(P1, 2), pw2); \
    VRD(6); SBAR(); GAPA(C1 = MFMA32(kf[5], qr[2], C1), P1[6], P1[7], P1[8], P1[9],     pw2[2] = PKW(P1, 4), pw2[3] = PKW(P1, 6), pw2); \
    VRD(3); SBAR(); GAPA(C0 = MFMA32(kf[6], qr[3], C0), P1[10], P1[11], P1[12], P1[13], pw3[0] = PKW(P1, 8), pw3[1] = PKW(P1, 10), pw3); \
    VRD(7); SBAR(); GAPA(C1 = MFMA32(kf[7], qr[3], C1), P1[14], P1[15], 0.f, 0.f,       pw3[2] = PKW(P1, 12), pw3[3] = PKW(P1, 14), pw3); \
    l_reg += sacc; \
    if (GK) { DMA_K((t) + 3, sl_cur); } if (GV) { DMA_V((t) + 1, sl_next); } \
    { _Pragma("unroll") for (int r = 0; r < 16; ++r) { C0[r] -= mhat; C1[r] -= mhat; } \
      float a_ = MX3(C0[0], C0[1], C1[0]), b_ = MX3(C0[2], C0[3], C1[1]); a_ = MX3(a_, C1[2], C1[3]); \
      _Pragma("unroll") for (int r = 4; r < 16; r += 4) { a_ = MX3(a_, C0[r], C0[r + 1]); b_ = MX3(b_, C0[r + 2], C0[r + 3]); a_ = MX3(a_, C1[r], C1[r + 1]); b_ = MX3(b_, C1[r + 2], C1[r + 3]); } \
      float rm = xhalf_max(__builtin_fmaxf(a_, b_)); \
      resc = false; \
      if (__builtin_expect(__any(rm > (float)THRL), 0)) { const float dl = __builtin_fmaxf(rm, 0.f); mhat += dl; \
        _Pragma("unroll") for (int r = 0; r < 16; ++r) { C0[r] -= dl; C1[r] -= dl; } \
        const float f = __builtin_amdgcn_exp2f(-dl); l_reg *= f; if (hi == 0) wsf[r32] = f; resc = true; } } \
    SBAR(); \
    GAPB(o[0] = MFMA32(PAF(0), VFR(0), o[0]), C0, 0, GN, P0, 0); \
    GAPB(o[1] = MFMA32(PAF(0), VFR(4), o[1]), C0, 4, GN, P0, 0); \
    KRD(GL, 0); GAPB(o[0] = MFMA32(PAF(1), VFR(1), o[0]), C0, 8, GN, P0, 0); \
    KRD(GL, 1); GAPB(o[1] = MFMA32(PAF(1), VFR(5), o[1]), C0, 12, GN, P0, 0); \
    KRD(GL, 2); GAPB(o[0] = MFMA32(PAF(2), VFR(2), o[0]), C1, 0, GN, P1, 32); \
    KRD(GL, 3); GAPB(o[1] = MFMA32(PAF(2), VFR(6), o[1]), C1, 4, GN, P1, 32); \
    GAPB(o[0] = MFMA32(PAF(3), VFR(3), o[0]), C1, 8, GN, P1, 32); \
    GAPB(o[1] = MFMA32(PAF(3), VFR(7), o[1]), C1, 12, GN, P1, 32); \
    } while (0)
    float mhat = 0.f, l_reg = 0.f; bool resc = false;
    o[0] = (f32x16){}; o[1] = (f32x16){};
    f32x16 pA0, pA1, pB0, pB1;
    int sl_prev = 0, sl_cur = 0, sl_next = SLOTB;
    DMA_K(0, 0); DMA_V(0, 0); DMA_K(1, SLOTB); DMA_K(2, 2 * SLOTB);
    LUTLOAD(pA0, pA1, 0);
    ST_WAIT_BAR(3);
    { const lds_cptr kb = kp0;
#pragma unroll
      for (int d0 = 0; d0 < 4; ++d0) { const bf16x8 b0 = *(const LAS bf16x8*)(kb + d0 * 2048); const bf16x8 b1 = *(const LAS bf16x8*)(kb + d0 * 2048 + 512);
          pA0 = MFMA32(b0, qr[d0], pA0); pA1 = MFMA32(b1, qr[d0], pA1); }
      float rm = pA0[0];
#pragma unroll
      for (int r = 1; r < 16; ++r) rm = __builtin_fmaxf(rm, pA0[r]);
#pragma unroll
      for (int r = 0; r < 16; ++r) rm = __builtin_fmaxf(rm, pA1[r]);
      rm = xhalf_max(rm);
      mhat = (rm == -INFINITY) ? 0.f : rm;
#pragma unroll
      for (int r = 0; r < 16; ++r) { pA0[r] = EX(pA0[r] - mhat); pA1[r] = EX(pA1[r] - mhat); } }
    ST_WAIT_BAR(0);
    DMA_K(3, 0); DMA_V(1, SLOTB);
    ROT();
    kload8(kf, kp0 + sl_cur);
    LUTLOAD(pB0, pB1, 1);
    ST_WAIT_BAR(2);
    s16x4 vlo[8], vhi[8]; u32x4 pw0, pw1, pw2, pw3;
    int t = 1;
    for (; t + 5 < NT; t += 2) {
        STEP(pB0, pB1, pA0, pA1, t, true, true, true, true);     ST_WAIT_BAR(2); RESC(); ROT();
        STEP(pA0, pA1, pB0, pB1, t + 1, true, true, true, true); ST_WAIT_BAR(2); RESC(); ROT();
    }
    for (; t + 1 < NT; t += 2) {
        STEP(pB0, pB1, pA0, pA1, t, (t + 3 < NT), (t + 1 < NT), (t + 1 < NT), true);       ENDW(t);     RESC(); ROT();
        STEP(pA0, pA1, pB0, pB1, t + 1, (t + 4 < NT), (t + 2 < NT), (t + 2 < NT), true);   ENDW(t + 1); RESC(); ROT();
    }
    STEP(pB0, pB1, pA0, pA1, NT - 1, false, false, false, false); RESC();
    { float sacc = pB0[0] + pB0[1];
#pragma unroll
      for (int r = 2; r < 16; ++r) sacc += pB0[r];
#pragma unroll
      for (int r = 0; r < 16; ++r) sacc += pB1[r];
      l_reg += sacc;
      ATT_PACK(pB0, pB1, pw0, pw1, pw2, pw3);
      SBAR(); pv(o, vb0 + sl_cur, PAF(0), PAF(1), PAF(2), PAF(3)); }
    asm volatile("s_waitcnt lgkmcnt(0)\n\ts_barrier" ::: "memory");
    mhat_o = mhat; l_o = l_reg;
#undef TLRAW
#undef DMA_K
#undef DMA_V
#undef LUTLOAD
#undef LUTPTR
#undef LOFF
#undef SBAR
#undef PIN
#undef PKW
#undef PAF
#undef VFR
#undef MX3
#undef MFMA32
#undef GAPA
#undef EX
#undef GAPB
#undef VRD
#undef KRD
#undef ROT
#undef RESC
#undef ENDW
#undef STEP
}
__device__ __forceinline__ void cmp_scores(f32x16& s0, f32x16& s1, LAS unsigned char* lds, const LAS unsigned char* bkc, const LAS unsigned char* tb, const bf16x8 (&qr)[4], const int k, const int r32, const int hi) {
#pragma unroll
    for (int r = 0; r < 16; ++r) { const int off = 16 * ((r & 3) + 8 * (r >> 2));
        s0[r] = *(const LAS float*)(tb + bkc[1024 * k + off]); s1[r] = *(const LAS float*)(tb + bkc[1024 * k + off + 512]); }
    const LAS unsigned char* kb = lds + k * 8192 + hi * 1024 + r32 * 16;
#pragma unroll
    for (int d0 = 0; d0 < 4; ++d0) { const bf16x8 b0 = *(const LAS bf16x8*)(kb + d0 * 2048); const bf16x8 b1 = *(const LAS bf16x8*)(kb + d0 * 2048 + 512);
        s0 = __builtin_amdgcn_mfma_f32_32x32x16_bf16(b0, qr[d0], s0, 0, 0, 0); s1 = __builtin_amdgcn_mfma_f32_32x32x16_bf16(b1, qr[d0], s1, 0, 0, 0); }
}
__device__ __forceinline__ float xhalf_other(float v, int hi) { auto rr = __builtin_amdgcn_permlane32_swap(__float_as_uint(v), __float_as_uint(v), false, false); return __uint_as_float(hi ? rr[0] : rr[1]); }
__device__ __forceinline__ void cmp_issue(LAS unsigned char* lds, const int wid, const int lane, const bf16_t* Kb, const bf16_t* Vb, const int nt) {
    const unsigned lds0 = (unsigned)(uintptr_t)lds;
    { const bf16_t* ksrc = Kb + (long)lane * 64 + wid * 8; const bf16_t* vsrc = Vb + (long)(16 * (wid & 3) + (lane >> 2)) * 64 + (wid >> 2) * 32 + (lane & 3) * 8;
      for (int k = 0; k < nt; ++k) { glds16(ksrc + (long)k * 4096, (unsigned)__builtin_amdgcn_readfirstlane(lds0 + k * 8192 + wid * 1024));
                                     glds16(vsrc + (long)k * 4096, (unsigned)__builtin_amdgcn_readfirstlane(lds0 + L_OTA + k * 8192 + wid * 1024)); } }
}
__device__ __forceinline__ void cmp_branch(LAS unsigned char* lds, const int wid, const int lane, const bf16x8 (&qr)[4], const int nt, const int t, f32x16 (&o)[2]) {
    const int r32 = lane & 31, hi = lane >> 5, g = wid >> 1, tq = (wid & 1) * 32 + r32;
    const unsigned lds0 = (unsigned)(uintptr_t)lds;
    const LAS unsigned char* bkc = lds + L_BKC + (4126 - t + 64 * hi);
    const LAS unsigned char* tb = lds + L_TBH + g * 144;
    asm volatile("s_waitcnt vmcnt(0) lgkmcnt(0)\n\ts_barrier" ::: "memory");
    float m = -INFINITY, l = 0.f;
#pragma clang loop unroll(disable)
    for (int k = 0; k < nt; ++k) { f32x16 s0, s1; cmp_scores(s0, s1, lds, bkc, tb, qr, k, r32, hi);
        float rm = s0[0];
#pragma unroll
        for (int r = 1; r < 16; ++r) rm = __builtin_fmaxf(rm, s0[r]);
#pragma unroll
        for (int r = 0; r < 16; ++r) rm = __builtin_fmaxf(rm, s1[r]);
        rm = xhalf_max(rm);
        const float mn = __builtin_fmaxf(m, rm), ms = (mn == -INFINITY) ? 0.f : mn;
        float ps = 0.f;
#pragma unroll
        for (int r = 0; r < 16; ++r) ps += __builtin_amdgcn_exp2f(s0[r] - ms) + __builtin_amdgcn_exp2f(s1[r] - ms);
        l = l * __builtin_amdgcn_exp2f(m - ms) + ps; m = mn; }
    l = xhalf_sum(l);
    const float msafe = (m == -INFINITY) ? 0.f : m, inv = l > 0.f ? 1.0f / l : 0.f;
    float I[4][8]; float pc7 = 0.f;
    o[0] = (f32x16){}; o[1] = (f32x16){};
    const int vb0 = (int)(lds0 + L_OTA) + ((lane >> 4) & 1) * 32 + (lane & 3) * 8 + (4 * hi + ((lane & 15) >> 2)) * 64;
#pragma unroll
    for (int k = 0; k < 4; ++k) {
        if (k < nt) { f32x16 s0, s1; cmp_scores(s0, s1, lds, bkc, tb, qr, k, r32, hi);
#pragma unroll
            for (int r = 0; r < 16; ++r) { s0[r] = __builtin_amdgcn_exp2f(s0[r] - msafe) * inv; s1[r] = __builtin_amdgcn_exp2f(s1[r] - msafe) * inv; }
            float pc[8];
#pragma unroll
            for (int q = 0; q < 4; ++q) { I[k][q] = 2.0f * (s0[4 * q] + s0[4 * q + 1] + s0[4 * q + 2]) + s0[4 * q + 3]; I[k][4 + q] = 2.0f * (s1[4 * q] + s1[4 * q + 1] + s1[4 * q + 2]) + s1[4 * q + 3];
                pc[q] = xhalf_other(s0[4 * q + 3], hi); pc[4 + q] = xhalf_other(s1[4 * q + 3], hi); }
#pragma unroll
            for (int j = 0; j < 8; ++j) I[k][j] += hi ? pc[j] : (j > 0 ? pc[j - 1] : pc7);
            pc7 = pc[7];
            u32x4 pw0, pw1, pw2, pw3; ATT_PACK(s0, s1, pw0, pw1, pw2, pw3);
            pv(o, vb0 + k * 8192, __builtin_bit_cast(bf16x8, pw0), __builtin_bit_cast(bf16x8, pw1), __builtin_bit_cast(bf16x8, pw2), __builtin_bit_cast(bf16x8, pw3));
        } else {
#pragma unroll
            for (int j = 0; j < 8; ++j) I[k][j] = 0.f;
        }
    }
    LAS float* imp = (LAS float*)(lds + L_IMP) + tq * 64 + hi;
#pragma unroll 1
    for (int gi = 0; gi < 4; ++gi) {
        if (g == gi) {
#pragma unroll
            for (int k = 0; k < 4; ++k) if (k < nt) {
#pragma unroll
                for (int j = 0; j < 8; ++j) __builtin_amdgcn_ds_faddf(imp + 16 * k + 2 * j, I[k][j], 0, 0, false);
            }
        }
        asm volatile("s_waitcnt lgkmcnt(0)\n\ts_barrier" ::: "memory");
    }
}
}

struct Ctx { int tid, lane, wave, vcu, G, bx; LAS unsigned char* lds; };

struct TrD { const float* src; size_t ldw; int nvalid; bf16_t* dst; size_t ldk; float fp8s; };
__device__ __forceinline__ void tr_load(const TrD& d, float (&v)[32], int lane) {
    const int n = lane & 31; const float* src = d.src + (size_t)(lane >> 5) * d.ldw + n;
#pragma unroll
    for (int i = 0; i < 32; ++i) v[i] = (n < d.nvalid) ? src[(size_t)(2 * i) * d.ldw] : 0.f;
}
__device__ __forceinline__ void tr_store(const TrD& d, const float (&v)[32], LAS float* scr, int lane) {
    const int n = lane & 31;
#pragma unroll
    for (int i = 0; i < 32; ++i) scr[(2 * i + (lane >> 5)) * 33 + n] = v[i];
    LDS_WAIT(); asm volatile("" ::: "memory");
    const int c = lane & 7;
#pragma unroll
    for (int j = 0; j < 4; ++j) { const int nn = (lane >> 3) + 8 * j; const LAS float* s = scr + (8 * c) * 33 + nn;
        if (d.fp8s != 0.f) { const float f = d.fp8s; u32x2 o;
            o.x = (unsigned)__builtin_amdgcn_cvt_pk_fp8_f32(s[0 * 33] * f, s[1 * 33] * f, 0, false); o.x = (unsigned)__builtin_amdgcn_cvt_pk_fp8_f32(s[2 * 33] * f, s[3 * 33] * f, (int)o.x, true);
            o.y = (unsigned)__builtin_amdgcn_cvt_pk_fp8_f32(s[4 * 33] * f, s[5 * 33] * f, 0, false); o.y = (unsigned)__builtin_amdgcn_cvt_pk_fp8_f32(s[6 * 33] * f, s[7 * 33] * f, (int)o.y, true);
            *(u32x2*)((unsigned char*)d.dst + (size_t)nn * d.ldk + 8 * c) = o;
        } else {
        u32x4 o; o.x = cvt_pk_bf16(s[0 * 33], s[1 * 33]); o.y = cvt_pk_bf16(s[2 * 33], s[3 * 33]); o.z = cvt_pk_bf16(s[4 * 33], s[5 * 33]); o.w = cvt_pk_bf16(s[6 * 33], s[7 * 33]);
        *(u32x4*)(d.dst + (size_t)nn * d.ldk + 8 * c) = o; } }
    LDS_WAIT(); asm volatile("" ::: "memory");
}
__device__ __forceinline__ TrD mk_trd(const float* W, size_t ldw, int srccol, int nvalid, bf16_t* WT, size_t ldk, int dstrow, int k0) {
    TrD d; d.src = W + (size_t)k0 * ldw + srccol; d.ldw = ldw; d.nvalid = nvalid; d.dst = WT + (size_t)dstrow * ldk + k0; d.ldk = ldk; d.fp8s = 0.f; return d; }
__device__ __forceinline__ TrD mk_trd8(const float* W, size_t ldw, int srccol, int nvalid, unsigned char* WT8, size_t ldk, int dstrow, int k0, float scale) {
    TrD d; d.src = W + (size_t)k0 * ldw + srccol; d.ldw = ldw; d.nvalid = nvalid; d.dst = (bf16_t*)(WT8 + (size_t)dstrow * ldk + k0); d.ldk = ldk; d.fp8s = scale; return d; }
__device__ __forceinline__ TrD dec_small(const Args& a, int it) {
    constexpr int I_WIN = 184 * 16, I_CW1 = 2 * 8 * 32, I_WUN = 32 * 8, I_WUD = 32 * 4, I_WO = 32 * 16, I_CW2 = 2 * 2 * 4;
    constexpr int PER = I_WIN + I_CW1 + I_WUN + I_WUD + I_WO + I_CW2;
    unsigned char* ws = a.ws;
    const int l = it / PER; int r = it % PER;
    if (r < I_WIN) { const int nb = r / 16, kb = r % 16; const int nd = 32 * nb; int src, nv = 32;
        if (nd < 1280) src = nd; else if (nd < 5632) src = nd + 24; else if (nd == 5632) { src = 1280; nv = 24; } else { src = 0; nv = 0; }
        return mk_trd8(a.w_in + (size_t)l * DM * INW, INW, src, nv, (unsigned char*)(ws + WS_WINT) + (size_t)l * NIN * DM, DM, nd, 64 * kb, 256.0f); }
    r -= I_WIN;
    if (r < I_CW1) { const int kv = r / 256, q = r % 256, nb = q / 32, kb = q % 32;
        return mk_trd(a.cmp_w1 + (size_t)(l * 2 + kv) * 2048 * 256, 256, 32 * nb, 32, (bf16_t*)(ws + WS_CW1T) + (size_t)(l * 2 + kv) * 256 * 2048, 2048, 32 * nb, 64 * kb); }
    r -= I_CW1;
    if (r < I_WUN) { const int nb = r / 8, kb = r % 8;
        return mk_trd(a.w_up_nsa + (size_t)l * 512 * 1024, 1024, 32 * nb, 32, (bf16_t*)(ws + WS_WUNT) + (size_t)l * 1024 * 512, 512, 32 * nb, 64 * kb); }
    r -= I_WUN;
    if (r < I_WUD) { const int nb = r / 4, kb = r % 4;
        return mk_trd(a.w_up_dil + (size_t)l * 256 * 1024, 1024, 32 * nb, 32, (bf16_t*)(ws + WS_WUDT) + (size_t)l * 1024 * 256, 256, 32 * nb, 64 * kb); }
    r -= I_WUD;
    if (r < I_WO) { const int nb = r / 16, kb = r % 16;
        return mk_trd(a.w_o + (size_t)l * 1024 * 1024, 1024, 32 * nb, 32, (bf16_t*)(ws + WS_WOT) + (size_t)l * 1024 * 1024, 1024, 32 * nb, 64 * kb); }
    r -= I_WO;
    { const int kv = r / 8, q = r % 8, nb = q / 4, kb = q % 4;
        return mk_trd(a.cmp_w2 + (size_t)(l * 2 + kv) * 256 * 64, 64, 32 * nb, 32, (bf16_t*)(ws + WS_CW2T) + (size_t)(l * 2 + kv) * 64 * 256, 256, 32 * nb, 64 * kb); }
}
__device__ __forceinline__ TrD dec_expert(const Args& a, int l, int it) {
    constexpr int I_13 = 32 * 16, I_2 = 32 * 8, PER = I_13 + I_2;
    unsigned char* ws = a.ws;
    const int e = it / PER; int r = it % PER;
    if (r < I_13) { const int nb = r / 16, kb = r % 16; const int r0 = 32 * nb, pn = r0 >> 8, bj = (r0 >> 7) & 1, j0 = r0 & 127;
        const float* src = (bj ? a.exp_w3 : a.exp_w1) + (size_t)(l * 32 + e) * 1024 * 512;
        return mk_trd8(src, 512, pn * 128 + j0, 32, (unsigned char*)(ws + WS_E13T) + (size_t)e * 1024 * 1024, 1024, r0, 64 * kb, 256.0f); }
    r -= I_13;
    { const int nb = r / 8, kb = r % 8;
        return mk_trd(a.exp_w2 + (size_t)(l * 32 + e) * 512 * 1024, 1024, 32 * nb, 32, (bf16_t*)(ws + WS_E2T) + (size_t)e * 1024 * 512, 512, 32 * nb, 64 * kb); }
}
template <int KIND> __device__ __forceinline__ void conv_items(const Args& a, const Ctx& C, int l, int first, int nitems, LAS float* scr) {
    const int NGW = C.G * NWAVES;
    float va[32], vb[32]; TrD d0, d1;
    int it = first;
    if (it >= nitems) return;
    d0 = KIND ? dec_expert(a, l, it) : dec_small(a, it); tr_load(d0, va, C.lane);
    for (;;) {
        const int itn = it + NGW; const bool hn = itn < nitems;
        if (hn) { d1 = KIND ? dec_expert(a, l, itn) : dec_small(a, itn); tr_load(d1, vb, C.lane); }
        tr_store(d0, va, scr, C.lane);
        if (!hn) break;
        const int itnn = itn + NGW; const bool hnn = itnn < nitems;
        if (hnn) { d0 = KIND ? dec_expert(a, l, itnn) : dec_small(a, itnn); tr_load(d0, va, C.lane); }
        tr_store(d1, vb, scr, C.lane);
        if (!hnn) break;
        it = itnn;
    }
}
__device__ __forceinline__ void conv_small(const Args& a, const Ctx& C) { conv_items<0>(a, C, 0, C.vcu * NWAVES + C.wave, 2 * 4368, (LAS float*)(C.lds + C.wave * 16384)); }
__device__ __forceinline__ void conv_experts_slice(const Args& a, const Ctx& C, int l, int q) {
    const int NGW = C.G * NWAVES; const int per = 3 * NGW;
    LAS float* scr = (LAS float*)(C.lds + (C.wave < 5 ? C.wave * 8448 : att::L_OTA + (C.wave - 5) * 8448));
    const int lo = q * per, hi = (q == 3) ? 32 * 768 : ((q + 1) * per < 32 * 768 ? (q + 1) * per : 32 * 768);
    if (lo < hi) conv_items<1>(a, C, l, lo + C.vcu * NWAVES + C.wave, hi, scr);
}
__device__ __forceinline__ void prologue_vectors(const Args& a, const Ctx& C) {
    LAS float* sl = (LAS float*)(C.lds);
    LAS float* part = (LAS float*)(C.lds + 32768);
    for (int i = C.tid; i < 8 * 1024; i += NTHR) { const float v = a.c[i]; sl[i] = v * sigmoidf_(v); }
    __syncthreads();
    float* MOD = (float*)(a.ws + WS_MOD); float* CB1 = (float*)(a.ws + WS_CB1);
    for (int it = C.vcu; it < 192 + 16; it += C.G) {
        float acc[8];
#pragma unroll
        for (int b = 0; b < 8; ++b) acc[b] = 0.f;
        if (it < 192) { const int l = it / 96, col = (it % 96) * 64 + C.lane;
            const float* w = a.ada_w + (size_t)l * 1024 * 6144 + col;
            for (int k0 = 128 * C.wave; k0 < 128 * C.wave + 128; k0 += 32) { float wv[32];
#pragma unroll
                for (int j = 0; j < 32; ++j) wv[j] = w[(size_t)(k0 + j) * 6144];
#pragma unroll
                for (int j = 0; j < 32; ++j)
#pragma unroll
                    for (int b = 0; b < 8; ++b) acc[b] += sl[b * 1024 + k0 + j] * wv[j]; }
        } else { const int q = it - 192, lk = q / 4, col = (q % 4) * 64 + C.lane;
            const float* w = a.cmp_w1 + (size_t)lk * 2048 * 256 + col; const float* pos = a.cmp_pos + (size_t)lk * 2048;
            for (int k0 = 256 * C.wave; k0 < 256 * C.wave + 256; k0 += 32) { float wv[32];
#pragma unroll
                for (int j = 0; j < 32; ++j) wv[j] = w[(size_t)(k0 + j) * 256];
#pragma unroll
                for (int j = 0; j < 32; ++j) acc[0] += pos[k0 + j] * wv[j]; }
        }
        __syncthreads();
#pragma unroll
        for (int b = 0; b < 8; ++b) part[(C.wave * 8 + b) * 64 + C.lane] = acc[b];
        __syncthreads();
        if (C.wave == 0) {
            float tot[8];
#pragma unroll
            for (int b = 0; b < 8; ++b) { float t2 = 0.f;
#pragma unroll
                for (int w = 0; w < 8; ++w) t2 += part[(w * 8 + b) * 64 + C.lane];
                tot[b] = t2; }
            if (it < 192) { const int l = it / 96, col = (it % 96) * 64 + C.lane; const float bias = a.ada_b[l * 6144 + col];
#pragma unroll
                for (int b = 0; b < 8; ++b) MOD[(size_t)(l * 8 + b) * 6144 + col] = tot[b] + bias;
            } else { const int q = it - 192, lk = q / 4, col = (q % 4) * 64 + C.lane; CB1[lk * 256 + col] = tot[0]; }
        }
    }
    __syncthreads();
}

__device__ __forceinline__ void moe_combine_row(const Args& a, int row, int lane, const float* g2  , f32x4 (&v)[4]) {
    const u32x4 rec = *(const u32x4*)(a.ws + WS_DEST + (size_t)row * 16);
    const bf16_t* Y = (const bf16_t*)(a.ws + WS_XS);
    const float w0 = (ABL == 6) ? 0.f : __uint_as_float(rec.z), w1 = (ABL == 6) ? 0.f : __uint_as_float(rec.w);
    const u32x2* y0 = (const u32x2*)(Y + (size_t)rec.x * 1024) + lane; const u32x2* y1 = (const u32x2*)(Y + (size_t)rec.y * 1024) + lane;
#pragma unroll
    for (int j = 0; j < 4; ++j) { const u32x2 p = y0[64 * j], q = y1[64 * j]; const f32x4 gg = *((const f32x4*)g2 + lane + 64 * j);
        v[j][0] += gg[0] * (w0 * bf_lo(p.x) + w1 * bf_lo(q.x)); v[j][1] += gg[1] * (w0 * bf_hi(p.x) + w1 * bf_hi(q.x));
        v[j][2] += gg[2] * (w0 * bf_lo(p.y) + w1 * bf_lo(q.y)); v[j][3] += gg[3] * (w0 * bf_hi(p.y) + w1 * bf_hi(q.y)); }
}
__device__ __forceinline__ void norm1_phase(const Args& a, const Ctx& C, int l) {
    const int gw = C.vcu * NWAVES + C.wave, NGW = C.G * NWAVES;
    const float* MOD = (const float*)(a.ws + WS_MOD); bf16_t* H = (bf16_t*)(a.ws + WS_H);
    const float* nw = a.norm1 + l * 1024;
    for (int row = gw; row < T; row += NGW) {
        const int b = row >> 12; const float* xr = (l == 0 ? a.x : (const float*)a.out) + (size_t)row * 1024;
        f32x4 v[4];
#pragma unroll
        for (int j = 0; j < 4; ++j) v[j] = *((const f32x4*)xr + C.lane + 64 * j);
        if (l == 1) { moe_combine_row(a, row, C.lane, MOD + (size_t)(0 * 8 + b) * 6144 + 5120, v);
#pragma unroll
            for (int j = 0; j < 4; ++j) *((f32x4*)(a.out + (size_t)row * 1024) + C.lane + 64 * j) = v[j]; }
        float ss = 0.f;
#pragma unroll
        for (int j = 0; j < 4; ++j) ss += (v[j][0] * v[j][0] + v[j][1] * v[j][1]) + (v[j][2] * v[j][2] + v[j][3] * v[j][3]);
        const float rstd = 1.0f / sqrtf(wave_sum(ss) * (1.0f / 1024.0f) + RMS_EPS);
        const float* mb = MOD + (size_t)(l * 8 + b) * 6144;
#pragma unroll
        for (int j = 0; j < 4; ++j) { const f32x4 g = *((const f32x4*)nw + C.lane + 64 * j), sh = *((const f32x4*)mb + C.lane + 64 * j), sc = *((const f32x4*)(mb + 1024) + C.lane + 64 * j);
            const f32x4 h = (v[j] * rstd * g * (sc + 1.0f) + sh) * 8.0f; unsigned w = (unsigned)__builtin_amdgcn_cvt_pk_fp8_f32(h[0], h[1], 0, false); w = (unsigned)__builtin_amdgcn_cvt_pk_fp8_f32(h[2], h[3], (int)w, true);
            *((unsigned*)((unsigned char*)H + (size_t)row * 1024) + C.lane + 64 * j) = w; }
    }
}
__device__ __forceinline__ void final_phase(const Args& a, const Ctx& C) {
    const int gw = C.vcu * NWAVES + C.wave, NGW = C.G * NWAVES;
    const float* MOD = (const float*)(a.ws + WS_MOD);
    for (int row = gw; row < T; row += NGW) {
        const int b = row >> 12; float* xr = a.out + (size_t)row * 1024;
        f32x4 v[4];
#pragma unroll
        for (int j = 0; j < 4; ++j) v[j] = *((const f32x4*)xr + C.lane + 64 * j);
        moe_combine_row(a, row, C.lane, MOD + (size_t)(1 * 8 + b) * 6144 + 5120, v);
        float ss = 0.f;
#pragma unroll
        for (int j = 0; j < 4; ++j) ss += (v[j][0] * v[j][0] + v[j][1] * v[j][1]) + (v[j][2] * v[j][2] + v[j][3] * v[j][3]);
        const float rstd = 1.0f / sqrtf(wave_sum(ss) * (1.0f / 1024.0f) + RMS_EPS);
#pragma unroll
        for (int j = 0; j < 4; ++j) { const f32x4 g = *((const f32x4*)a.norm_f + C.lane + 64 * j); *((f32x4*)xr + C.lane + 64 * j) = v[j] * rstd * g; }
    }
}
typedef float f32x4v __attribute__((ext_vector_type(4)));
__device__ __forceinline__ void norm2_router_phase(const Args& a, const Ctx& C, int l) {
    constexpr int RP = 2064;
    LAS unsigned char* HH = C.lds; LAS unsigned char* HL = C.lds + 16 * RP;
    LAS float* PART = (LAS float*)(C.lds + 2 * 16 * RP);
    LAS float* LOGI = PART + 8 * 16 * 48;
    LAS int* wcnt = (LAS int*)(C.lds + LDS_MISC + 256);
    const float* wg = a.router_wg + (size_t)l * 1024 * 4; const float* we = a.router_we + (size_t)l * 1024 * 32;
    const int lane = C.lane, wave = C.wave, fr = lane & 15, fq = lane >> 4;
    bf16x8 Wh[4][3], Wl[4][3];
#pragma unroll
    for (int ks = 0; ks < 4; ++ks)
#pragma unroll
        for (int ct = 0; ct < 3; ++ct) { const int cc = 16 * ct + fr; const int k0 = 128 * wave + 32 * ks + 8 * fq; unsigned hw[4], lw[4];
#pragma unroll
            for (int i = 0; i < 8; i += 2) { float v0 = 0.f, v1 = 0.f;
                if (cc < 4) { v0 = wg[(size_t)(k0 + i) * 4 + cc]; v1 = wg[(size_t)(k0 + i + 1) * 4 + cc]; }
                else if (cc < 36) { v0 = we[(size_t)(k0 + i) * 32 + cc - 4]; v1 = we[(size_t)(k0 + i + 1) * 32 + cc - 4]; }
                const unsigned hp = cvt_pk_bf16(v0, v1); hw[i >> 1] = hp; lw[i >> 1] = cvt_pk_bf16(v0 - bf_lo(hp), v1 - bf_hi(hp)); }
            Wh[ks][ct] = __builtin_bit_cast(bf16x8, (u32x4){hw[0], hw[1], hw[2], hw[3]}); Wl[ks][ct] = __builtin_bit_cast(bf16x8, (u32x4){lw[0], lw[1], lw[2], lw[3]}); }
    const float* MOD = (const float*)(a.ws + WS_MOD); bf16_t* H2 = (bf16_t*)(a.ws + WS_H2);
    const float* nw = a.norm2 + l * 1024; const float* bg = a.router_bg + l * 4; const float* be = a.router_be + l * 32;
    int* CNTBLK = (int*)(a.ws + WS_CNTBLK);
    for (int ch = C.vcu; ch < T / 128; ch += C.G) {
        int my_e0 = 0, my_e1 = 0; float my_w0 = 0.f, my_w1 = 0.f;
#pragma clang loop unroll(disable)
        for (int gi = 0; gi < 8; ++gi) {
            { const int row0 = ch * 128 + gi * 16 + 2 * wave; const int b = row0 >> 12;
              f32x4 v[2][4];
#pragma unroll
              for (int rr = 0; rr < 2; ++rr)
#pragma unroll
                  for (int q = 0; q < 4; ++q) v[rr][q] = *((const f32x4*)(a.out + (size_t)(row0 + rr) * 1024) + lane + 64 * q);
              const float* mb = MOD + (size_t)(l * 8 + b) * 6144 + 3072;
#pragma unroll
              for (int rr = 0; rr < 2; ++rr) { float ss = 0.f;
#pragma unroll
                  for (int q = 0; q < 4; ++q) ss += (v[rr][q][0] * v[rr][q][0] + v[rr][q][1] * v[rr][q][1]) + (v[rr][q][2] * v[rr][q][2] + v[rr][q][3] * v[rr][q][3]);
                  const float rstd = 1.0f / sqrtf(wave_sum(ss) * (1.0f / 1024.0f) + RMS_EPS);
#pragma unroll
                  for (int q = 0; q < 4; ++q) { const f32x4 g = *((const f32x4*)nw + lane + 64 * q), sh = *((const f32x4*)mb + lane + 64 * q), sc = *((const f32x4*)(mb + 1024) + lane + 64 * q);
                      const f32x4 h = v[rr][q] * rstd * g * (sc + 1.0f) + sh;
                      u32x2 hw; hw.x = cvt_pk_bf16(h[0], h[1]); hw.y = cvt_pk_bf16(h[2], h[3]);
                      u32x2 lw; lw.x = cvt_pk_bf16(h[0] - bf_lo(hw.x), h[1] - bf_hi(hw.x)); lw.y = cvt_pk_bf16(h[2] - bf_lo(hw.y), h[3] - bf_hi(hw.y));
                      { unsigned w8 = (unsigned)__builtin_amdgcn_cvt_pk_fp8_f32(h[0] * 8.0f, h[1] * 8.0f, 0, false); w8 = (unsigned)__builtin_amdgcn_cvt_pk_fp8_f32(h[2] * 8.0f, h[3] * 8.0f, (int)w8, true);
                        *((unsigned*)((unsigned char*)H2 + (size_t)(row0 + rr) * 1024) + lane + 64 * q) = w8; }
                      *(LAS u32x2*)(HH + (2 * wave + rr) * RP + (4 * lane + 256 * q) * 2) = hw; *(LAS u32x2*)(HL + (2 * wave + rr) * RP + (4 * lane + 256 * q) * 2) = lw; } }
            }
            __syncthreads();
            { f32x4v acc[3]; acc[0] = (f32x4v){0.f, 0.f, 0.f, 0.f}; acc[1] = acc[0]; acc[2] = acc[0];
#pragma unroll
              for (int ks = 0; ks < 4; ++ks) { const int ko = (128 * wave + 32 * ks + 8 * fq) * 2;
                  const bf16x8 ah = *(const LAS bf16x8*)(HH + fr * RP + ko), al = *(const LAS bf16x8*)(HL + fr * RP + ko);
#pragma unroll
                  for (int ct = 0; ct < 3; ++ct) { acc[ct] = __builtin_amdgcn_mfma_f32_16x16x32_bf16(Wh[ks][ct], ah, acc[ct], 0, 0, 0);
                      acc[ct] = __builtin_amdgcn_mfma_f32_16x16x32_bf16(Wh[ks][ct], al, acc[ct], 0, 0, 0); acc[ct] = __builtin_amdgcn_mfma_f32_16x16x32_bf16(Wl[ks][ct], ah, acc[ct], 0, 0, 0); } }
#pragma unroll
              for (int ct = 0; ct < 3; ++ct) *(LAS f32x4v*)(PART + (wave * 16 + fr) * 48 + 16 * ct + 4 * fq) = acc[ct]; }
            __syncthreads();
            { const int row = C.tid >> 5, c = C.tid & 31;
              { float sacc = 0.f;
#pragma unroll
                for (int w = 0; w < 8; ++w) sacc += PART[(w * 16 + row) * 48 + c];
                LOGI[row * 48 + c] = sacc + (c < 4 ? bg[c] : be[c - 4]); }
              if (c < 4) { float sacc = 0.f;
#pragma unroll
                for (int w = 0; w < 8; ++w) sacc += PART[(w * 16 + row) * 48 + 32 + c];
                LOGI[row * 48 + 32 + c] = sacc + be[28 + c]; } }
            __syncthreads();
            if (wave == gi && lane < 16) { const LAS float* lg = LOGI + lane * 48;
                int grp = 0; float gmax = lg[0];
#pragma unroll
                for (int c = 1; c < 4; ++c) if (lg[c] > gmax) { gmax = lg[c]; grp = c; }
                float gs = 0.f;
#pragma unroll
                for (int c = 0; c < 4; ++c) gs += __builtin_amdgcn_exp2f((lg[c] - gmax) * LOG2E);
                const float pgrp = 1.0f / gs;
                float le[8];
#pragma unroll
                for (int e = 0; e < 8; ++e) le[e] = lg[4 + grp * 8 + e];
                int i0 = 0; float v0 = le[0];
#pragma unroll
                for (int e = 1; e < 8; ++e) if (le[e] > v0) { v0 = le[e]; i0 = e; }
                int i1 = -1; float v1 = -INFINITY;
#pragma unroll
                for (int e = 0; e < 8; ++e) if (e != i0 && le[e] > v1) { v1 = le[e]; i1 = e; }
                const float ex = __builtin_amdgcn_exp2f((v1 - v0) * LOG2E);
                my_e0 = grp * 8 + i0; my_e1 = grp * 8 + i1; my_w0 = pgrp / (1.0f + ex); my_w1 = pgrp * ex / (1.0f + ex); }
        }
        const int ea = bperm_i(C.lane >> 1, my_e0), eb = bperm_i(C.lane >> 1, my_e1);
        const int es = (C.lane < 32) ? ((C.lane & 1) ? eb : ea) : -1;
        int rank = 0, cnt = 0;
#pragma unroll
        for (int s2 = 0; s2 < 32; ++s2) { const int v = __builtin_amdgcn_readlane(es, s2); rank += (v == es && s2 < C.lane) ? 1 : 0; cnt += (v == C.lane) ? 1 : 0; }
        __syncthreads();
        if (C.lane < 32) wcnt[C.wave * 32 + C.lane] = cnt;
        __syncthreads();
        int lrank = rank;
        if (C.lane < 32) { for (int w = 0; w < C.wave; ++w) lrank += wcnt[w * 32 + es]; }
        if (C.wave == 0 && C.lane < 32) { int tot = 0;
#pragma unroll
            for (int w = 0; w < 8; ++w) tot += wcnt[w * 32 + C.lane];
            CNTBLK[ch * 32 + C.lane] = tot; }
        const int lr0 = bperm_i((2 * C.lane) & 63, lrank), lr1 = bperm_i((2 * C.lane + 1) & 63, lrank);
        if (C.lane < 16) { const int row = ch * 128 + C.wave * 16 + C.lane;
            u32x4 rec; rec.x = (unsigned)my_e0 | ((unsigned)my_e1 << 8); rec.y = (unsigned)lr0 | ((unsigned)lr1 << 16); rec.z = __float_as_uint(my_w0); rec.w = __float_as_uint(my_w1);
            *(u32x4*)(a.ws + WS_REC + (size_t)row * 16) = rec; }
    }
}
__device__ __forceinline__ void moe_scatter_phase(const Args& a, const Ctx& C) {
    LAS int* part_lt = (LAS int*)(C.lds);
    LAS int* part_all = part_lt + 512;
    LAS int* base = part_all + 512;
    LAS int* tot = base + 32;
    LAS int* pst = tot + 32;
    const int* CNTBLK = (const int*)(a.ws + WS_CNTBLK);
    int* TILEE = (int*)(a.ws + WS_TILEE);
    int* TOKL = (int*)(a.ws + WS_TOKL);
    for (int ch = C.vcu; ch < T / 128; ch += C.G) {
        __syncthreads();
        { const int e = C.tid & 31, p = C.tid >> 5; int slt = 0, sall = 0;
            for (int c = p; c < T / 128; c += 16) { const int v = CNTBLK[c * 32 + e]; sall += v; slt += (c < ch) ? v : 0; }
            part_lt[p * 32 + e] = slt; part_all[p * 32 + e] = sall; }
        __syncthreads();
        if (C.tid < 32) { int b = 0, t2 = 0;
#pragma unroll
            for (int p = 0; p < 16; ++p) { b += part_lt[p * 32 + C.tid]; t2 += part_all[p * 32 + C.tid]; }
            base[C.tid] = b; tot[C.tid] = t2; }
        __syncthreads();
        if (C.tid < 32) { int ps = 0; for (int e = 0; e < C.tid; ++e) ps += (tot[e] + 255) & ~255; pst[C.tid] = ps;
            if (ch == 0) { const int nt = (tot[C.tid] + 255) >> 8; const int t0 = ps >> 8; for (int m = 0; m < nt; ++m) TILEE[16 + t0 + m] = C.tid; if (C.tid == 31) TILEE[0] = t0 + nt; } }
        __syncthreads();
        int d0 = 0, d1 = 0;
        if (C.lane < 16) { const int row = ch * 128 + C.wave * 16 + C.lane;
            const u32x4 rec = *(const u32x4*)(a.ws + WS_REC + (size_t)row * 16);
            const int e0 = rec.x & 255, e1 = (rec.x >> 8) & 255;
            d0 = pst[e0] + base[e0] + (int)(rec.y & 0xffffu); d1 = pst[e1] + base[e1] + (int)(rec.y >> 16);
            u32x4 o; o.x = (unsigned)d0; o.y = (unsigned)d1; o.z = rec.z; o.w = rec.w;
            *(u32x4*)(a.ws + WS_DEST + (size_t)row * 16) = o; }
        if (C.lane < 16) { const int row = ch * 128 + C.wave * 16 + C.lane; TOKL[d0] = row; TOKL[d1] = row; }
        if (ch == 0) {
            for (int e = 0; e < 32; ++e) { const int lo = pst[e] + tot[e], hi = pst[e] + ((tot[e] + 255) & ~255);
                for (int k = lo + C.tid; k < hi; k += NTHR) TOKL[k] = 0; } }
    }
}
struct MoeOrder {
    int G, c, nu; int ex[8]; const char* A; const char* B; size_t tA, tB, eB;
    __device__ __forceinline__ bool next(int i, pg8::Unit& u) const {
        const int L = i * G + c; if (i >= 8 || L >= nu) return false;
        const int e = i == 0 ? ex[0] : i == 1 ? ex[1] : i == 2 ? ex[2] : i == 3 ? ex[3] : i == 4 ? ex[4] : i == 5 ? ex[5] : i == 6 ? ex[6] : ex[7];
        u.pm = L >> 2; u.pn = L & 3; u.A = A + (size_t)u.pm * tA; u.B = B + (size_t)e * eB + (size_t)u.pn * tB; return true;
    }
};

__device__ __forceinline__ void dil_unit(const Args& a, const Ctx& C, int du) {
    using namespace att;
    LAS unsigned char* lds = C.lds;
    const int x = du & 15; int r = du >> 4; const int h = r & 3; r >>= 2; const int grp = r % 3, b = r / 3;
    const int dsh = 2 * grp, d = 1 << dsh; const int nub = 16 >> dsh; const int res = x / nub, ub = x % nub;
    const int wid = C.wave, lane = C.lane, r32 = lane & 31, hi = lane >> 5;
    LAS float* lut = (LAS float*)(lds + L_LUT);
    LAS unsigned char* tl = lds + L_SEL + 768;
    __syncthreads();
    for (int e = C.tid; e < 704; e += NTHR) { const int m = 384 - e; float v = -INFINITY;
        if (m >= 0 && m <= 128) { int di = m << dsh; di = di > 4095 ? 4095 : di; v = a.rel_bias[(int)lds[L_BKT + di] * 20 + 8 + grp * 4 + h] * LOG2E; }
        lut[e] = v; }
    if (C.tid < 6) { const int kt = 4 * ub - 2 + C.tid; tl[C.tid] = (unsigned char)(kt < 0 ? 0x80 : kt); }
    const bf16_t* QKV = (const bf16_t*)(a.ws + WS_A);
    const int u = 256 * ub + 32 * wid + r32; const size_t tokq = (size_t)b * SEQ + (size_t)u * d + res;
    const bf16_t* qp = QKV + tokq * LDQ + 1280 + grp * 256 + h * 64;
    bf16x8 qr[4];
#pragma unroll
    for (int d0 = 0; d0 < 4; ++d0) qr[d0] = *(const bf16x8*)(qp + d0 * 16 + hi * 8);
    __syncthreads();
    StreamP S; S.Kb = QKV + ((size_t)b * SEQ + res) * LDQ + 1280 + 768 + grp * 256 + h * 64; S.Vb = S.Kb + 768; S.pitch = (long)d * LDQ;
    S.NT = 6; S.tl = tl; S.lanesel = ~0ull; S.uq = u; S.lut = lut; S.xtop = 384; S.dclamp = 1 << 30;
    float m = 0.f, l = 0.f; f32x16 o[2];
    attn_stream<8>(lds, wid, lane, qr, S, m, l, o);
    l = xhalf_sum(l);
    LAS float* wsf = (LAS float*)(lds + L_WSF) + wid * 64;
    if (hi == 0) { wsf[r32] = l > 0.f ? 1.0f / l : 0.f; ((float*)(a.ws + WS_LSE))[((size_t)grp * T + tokq) * 4 + h] = m + __builtin_amdgcn_logf(l); }
    LDS_WAIT();
#pragma unroll
    for (int rr = 0; rr < 16; ++rr) { const float f = wsf[crow(rr, hi)]; o[0][rr] *= f; o[1][rr] *= f; }
    stage_rows(lds, wid, lane, o);
    bf16_t* ODP = (bf16_t*)(a.ws + WS_ODP) + (size_t)grp * T * 256;
    const LAS bf16_t* stg = (const LAS bf16_t*)(lds + L_OTA) + wid * 2048;
#pragma unroll
    for (int i = 0; i < 4; ++i) { const int row = i * 8 + (lane >> 3), chn = lane & 7; const u32x4 v = *(const LAS u32x4*)(stg + row * 64 + chn * 8);
        const size_t tok = (size_t)b * SEQ + (size_t)(256 * ub + 32 * wid + row) * d + res;
        *(u32x4*)(ODP + tok * 256 + h * 64 + chn * 8) = v; }
}
__device__ __forceinline__ void dil_combine(const Args& a, const Ctx& C) {
    const float* LSE = (const float*)(a.ws + WS_LSE); const bf16_t* ODP = (const bf16_t*)(a.ws + WS_ODP); bf16_t* ODIL = (bf16_t*)(a.ws + WS_ODIL);
    const int gt = C.vcu * NTHR + C.tid, NT = C.G * NTHR;
    for (int idx = gt; idx < T * 32; idx += NT) {
        const int tok = idx >> 5, h = (idx >> 3) & 3, chn = idx & 7;
        const float l0 = LSE[((size_t)0 * T + tok) * 4 + h], l1 = LSE[((size_t)1 * T + tok) * 4 + h], l2 = LSE[((size_t)2 * T + tok) * 4 + h];
        const float mx = __builtin_fmaxf(l0, __builtin_fmaxf(l1, l2));
        float w0 = __builtin_amdgcn_exp2f(l0 - mx), w1 = __builtin_amdgcn_exp2f(l1 - mx), w2 = __builtin_amdgcn_exp2f(l2 - mx);
        const float inv = 1.0f / (w0 + w1 + w2); w0 *= inv; w1 *= inv; w2 *= inv;
        const size_t off = (size_t)tok * 256 + h * 64 + chn * 8;
        const u32x4 a0 = *(const u32x4*)(ODP + off), a1 = *(const u32x4*)(ODP + (size_t)T * 256 + off), a2 = *(const u32x4*)(ODP + (size_t)2 * T * 256 + off);
        u32x4 o;
        o.x = cvt_pk_bf16(w0 * bf_lo(a0.x) + w1 * bf_lo(a1.x) + w2 * bf_lo(a2.x), w0 * bf_hi(a0.x) + w1 * bf_hi(a1.x) + w2 * bf_hi(a2.x));
        o.y = cvt_pk_bf16(w0 * bf_lo(a0.y) + w1 * bf_lo(a1.y) + w2 * bf_lo(a2.y), w0 * bf_hi(a0.y) + w1 * bf_hi(a1.y) + w2 * bf_hi(a2.y));
        o.z = cvt_pk_bf16(w0 * bf_lo(a0.z) + w1 * bf_lo(a1.z) + w2 * bf_lo(a2.z), w0 * bf_hi(a0.z) + w1 * bf_hi(a1.z) + w2 * bf_hi(a2.z));
        o.w = cvt_pk_bf16(w0 * bf_lo(a0.w) + w1 * bf_lo(a1.w) + w2 * bf_lo(a2.w), w0 * bf_hi(a0.w) + w1 * bf_hi(a1.w) + w2 * bf_hi(a2.w));
        if (ABL == 4) o = (u32x4){0u, 0u, 0u, 0u};
        *(u32x4*)(ODIL + off) = o;
    }
}
template <bool INIT>
__device__ __forceinline__ void ota_update(LAS bf16_t* ota  , const LAS float* frow, int hi, const f32x16 (&o)[2]) {
#pragma unroll
    for (int r = 0; r < 16; ++r) { const int row = crow(r, hi); const float f = frow[row];
        float v0 = f * o[0][r], v1 = f * o[1][r];
        if (!INIT) { v0 += __uint_as_float((unsigned)ota[row * 64] << 16); v1 += __uint_as_float((unsigned)ota[row * 64 + 32] << 16); }
        ota[row * 64] = (bf16_t)(cvt_pk_bf16(v0, 0.f) & 0xffffu); ota[row * 64 + 32] = (bf16_t)(cvt_pk_bf16(v1, 0.f) & 0xffffu); }
}
#define NSA_T0(which) do { if (TNSA == (which) && blockIdx.x == 0 && wid == 0 && lane_id_fresh() == 0) { volatile LAS unsigned* M_ = (volatile LAS unsigned*)(lds + LDS_MISC); const unsigned long long t_ = __builtin_amdgcn_s_memrealtime(); M_[20] = (unsigned)t_; M_[21] = (unsigned)(t_ >> 32); } } while (0)
#define NSA_T1(which) do { if (TNSA == (which) && blockIdx.x == 0 && wid == 0 && lane_id_fresh() == 0) { volatile LAS unsigned* M_ = (volatile LAS unsigned*)(lds + LDS_MISC); const unsigned long long t_ = __builtin_amdgcn_s_memrealtime(); const unsigned long long t0_ = ((unsigned long long)M_[21] << 32) | M_[20]; \
        const unsigned long long d_ = (((unsigned long long)M_[23] << 32) | M_[22]) + (t_ - t0_); M_[22] = (unsigned)d_; M_[23] = (unsigned)(d_ >> 32); } } while (0)
#define NSA_SECT() const int lane = lane_id_fresh(); const int tid = wid * 64 + lane; const int r32 = lane & 31, hi = lane >> 5; (void)tid; (void)r32; (void)hi
__device__ __forceinline__ void nsa_unit(const Args& a, const Ctx& C, int b, int hk, int i) {
    using namespace att;
    LAS unsigned char* lds = C.lds;
    const int wid = C.wave; const int g = wid >> 1;
    const bf16_t* QKV = (const bf16_t*)(a.ws + WS_A);
    bf16x8 qr[4];
    f32x16 o[2];
    __syncthreads();
    NSA_T0(2);
    { NSA_SECT();
        const int tq = (wid & 1) * 32 + r32, t = 64 * i + tq; const size_t tok = (size_t)b * SEQ + t;
        LAS float* imp = (LAS float*)(lds + L_IMP); LAS float* gsh = (LAS float*)(lds + L_GSH) + wid * 96; LAS unsigned* selw = (LAS unsigned*)(lds + L_SEL);
        const bf16_t* KC = (const bf16_t*)(a.ws + WS_KC); const int nt = (4 * i + 2) / 64 + 1;
        cmp_issue(lds, wid, lane, KC + (size_t)((0 * 8 + b) * 2 + hk) * 256 * 64, KC + (size_t)((1 * 8 + b) * 2 + hk) * 256 * 64, nt);
        const bf16_t* qp = QKV + tok * LDQ + hk * 256 + g * 64;
#pragma unroll
        for (int d0 = 0; d0 < 4; ++d0) qr[d0] = *(const bf16x8*)(qp + d0 * 16 + hi * 8);
        float g0 = 0.f, g1 = 0.f, g2 = 0.f;
        if (hi == 0) { const float* gn = (const float*)(a.ws + WS_GN) + tok * 32 + hk * 4 + g; g0 = gn[0]; g1 = gn[8]; g2 = gn[16]; }
        for (int e = tid; e < 64 * 64; e += NTHR) imp[e] = 0.f;
        if (tid < 2) selw[128 + tid] = 0u;
        if (hi == 0) { gsh[r32] = (ABL == 1) ? 0.f : g0; gsh[32 + r32] = (ABL == 2) ? 0.f : g1; gsh[64 + r32] = (ABL == 3) ? 0.f : g2; }
        cmp_branch(lds, wid, lane, qr, nt, t, o);
        ota_update<true>((LAS bf16_t*)(lds + L_OTA) + wid * 2048 + r32, gsh, hi, o);
    }
    __syncthreads();
    NSA_T1(2);
    { NSA_SECT();
        LAS float* impP = (LAS float*)(lds + L_IMP); LAS unsigned* selw = (LAS unsigned*)(lds + L_SEL);
        const int q = tid >> 3, part = tid & 7;
        const int ncand = i - 2 > 0 ? i - 2 : 0; const int nforced = i + 1 < 3 ? i + 1 : 3; const int krem = 16 - nforced;
        unsigned bits = 0u;
        if (ncand > krem && ABL != 5) {
            float vn[8]; int cn[8];
#pragma unroll
            for (int e = 0; e < 8; ++e) { vn[e] = impP[q * 64 + part * 8 + e]; cn[e] = 0; }
#pragma unroll 4
            for (int mm = 1; mm <= i - 2; ++mm) { const float xv = impP[q * 64 + mm];
#pragma unroll
                for (int e = 0; e < 8; ++e) { const int n = part * 8 + e; cn[e] += (xv > vn[e] || (xv == vn[e] && mm < n)) ? 1 : 0; } }
#pragma unroll
            for (int e = 0; e < 8; ++e) { const int n = part * 8 + e; if (n >= 1 && n <= i - 2 && cn[e] < krem) bits |= 1u << e; }
        } else {
#pragma unroll
            for (int e = 0; e < 8; ++e) { const int n = part * 8 + e; if (n >= 1 && n <= i - 2) bits |= 1u << e; }
        }
#pragma unroll
        for (int e = 0; e < 8; ++e) { const int n = part * 8 + e; if (n == 0 || n == i || n == i - 1) bits |= 1u << e; }
        unsigned lo = part < 4 ? bits << (8 * part) : 0u, hi2 = part >= 4 ? bits << (8 * (part - 4)) : 0u;
        lo |= swz_xor_u<1>(lo); hi2 |= swz_xor_u<1>(hi2); lo |= swz_xor_u<2>(lo); hi2 |= swz_xor_u<2>(hi2); lo |= swz_xor_u<4>(lo); hi2 |= swz_xor_u<4>(hi2);
        if (part == 0) { selw[2 * q] = lo; selw[2 * q + 1] = hi2; atomicOr((unsigned*)&selw[128], lo); atomicOr((unsigned*)&selw[129], hi2); }
    }
    __syncthreads();
    int NTS, NTW;
    { NSA_SECT();
        LAS unsigned* selw = (LAS unsigned*)(lds + L_SEL);
        LAS unsigned char* tls = lds + L_SEL + 768; LAS unsigned char* tlw = lds + L_SEL + 848;
        const unsigned long long uni = ((unsigned long long)(unsigned)__builtin_amdgcn_readfirstlane((int)selw[129]) << 32) | (unsigned)__builtin_amdgcn_readfirstlane((int)selw[128]);
        const int nsel = __builtin_popcountll(uni); const int nts = (nsel + 1) & ~1; NTS = nts < 4 ? 4 : nts;
        const int jlo = i - 8 < 0 ? 0 : i - 8; const int nwin = i - jlo + 1; const int ntw = (nwin + 1) & ~1; NTW = ntw < 4 ? 4 : ntw;
        if (tid < 64) { if ((uni >> tid) & 1ull) tls[__builtin_popcountll(uni & ((1ull << tid) - 1ull))] = (unsigned char)tid; }
        else if (tid < 72) { const int k = nsel + (tid - 64); if (k < NTS) tls[k] = 0x80; }
        else if (tid < 88) { const int k = tid - 72; if (k < NTW) tlw[k] = (unsigned char)(k < nwin ? jlo + k : 0x80); }
    }
    __syncthreads();
    NSA_T0(1);
#pragma clang loop unroll(disable)
    for (int br = 0; br < 2; ++br) {
        float m = 0.f, l = 0.f;
        { NSA_SECT();
            const int tq = (wid & 1) * 32 + r32, t = 64 * i + tq;
            LAS unsigned* selw = (LAS unsigned*)(lds + L_SEL); LAS float* lut = (LAS float*)(lds + L_LUT);
            StreamP S; S.Kb = QKV + (size_t)b * SEQ * LDQ + 512 + 256 + br * 256 + hk * 64; S.Vb = S.Kb + 128; S.pitch = LDQ;
            S.NT = br ? NTW : NTS; S.tl = lds + L_SEL + (br ? 848 : 768); S.uq = t;
            S.lanesel = br ? ~0ull : (((unsigned long long)selw[2 * tq + 1] << 32) | selw[2 * tq]);
            S.lut = br ? lut + 7168 + g * 768 : lut + g * 1792; S.xtop = br ? 640 : 1636; S.dclamp = br ? (1 << 30) : 1636;
            attn_stream<8>(lds, wid, lane, qr, S, m, l, o);
        }
        { NSA_SECT();
            LAS float* gsh = (LAS float*)(lds + L_GSH) + wid * 96; LAS float* wsf = (LAS float*)(lds + L_WSF) + wid * 64;
            l = xhalf_sum(l);
            LDS_WAIT();
            if (hi == 0) wsf[r32] = (l > 0.f ? 1.0f / l : 0.f) * gsh[32 + br * 32 + r32];
            LDS_WAIT();
            ota_update<false>((LAS bf16_t*)(lds + L_OTA) + wid * 2048 + r32, wsf, hi, o);
        }
    }
    NSA_T1(1);
    { NSA_SECT();
        LDS_WAIT();
        bf16_t* ONSA = (bf16_t*)(a.ws + WS_ONSA);
        const LAS bf16_t* stg = (const LAS bf16_t*)(lds + L_OTA) + wid * 2048;
#pragma unroll
        for (int k = 0; k < 4; ++k) { const int row = k * 8 + (lane >> 3), chn = lane & 7; const u32x4 v = *(const LAS u32x4*)(stg + row * 64 + chn * 8);
            const size_t tk = (size_t)b * SEQ + 64 * i + (wid & 1) * 32 + row;
            *(u32x4*)(ONSA + tk * 512 + hk * 256 + g * 64 + chn * 8) = v; }
    }
}
__device__ __forceinline__ void build_bkt(const Ctx& C) {
    LAS unsigned char* bkt = C.lds + att::L_BKT; LAS unsigned char* bkc = C.lds + att::L_BKC;
    for (int d = C.tid; d < 4096; d += NTHR) bkt[d] = (unsigned char)att::bucket_of(d);
    for (int x = C.tid; x < 8704; x += NTHR) { const int dist = 4095 - x; bkc[x] = (unsigned char)(dist < 0 ? 128 : 4 * att::bucket_of(dist)); }
    __syncthreads();
}
__device__ __forceinline__ void build_nsa_tables(const Args& a, const Ctx& C, int hk) {
    using namespace att;
    LAS float* tbh = (LAS float*)(C.lds + L_TBH); LAS float* lut = (LAS float*)(C.lds + L_LUT);
    __syncthreads();
    if (C.tid < 144) { const int gg = C.tid / 36, bk = C.tid % 36; tbh[C.tid] = bk < 32 ? a.rel_bias[bk * 20 + hk * 4 + gg] * LOG2E : -INFINITY; }
    __syncthreads();
    for (int e = C.tid; e < 4 * 1792; e += NTHR) { const int gg = e / 1792, xx = e % 1792; const int dist = 1636 - xx;
        lut[e] = dist < 0 ? -INFINITY : tbh[gg * 36 + (int)C.lds[L_BKT + dist]]; }
    for (int e = C.tid; e < 4 * 768; e += NTHR) { const int gg = e / 768, xx = e % 768; const int dist = 640 - xx;
        lut[7168 + e] = (dist < 0 || dist > 512) ? -INFINITY : tbh[gg * 36 + (int)C.lds[L_BKT + dist]]; }
    __syncthreads();
}

typedef const Args __attribute__((address_space(4)))* CArgsP;
__device__ __forceinline__ Args load_args() {
#if defined(__HIP_DEVICE_COMPILE__)
    CArgsP p = (CArgsP)__builtin_amdgcn_kernarg_segment_ptr(); asm volatile("" : "+s"(p)); Args a;
    a.x = p->x; a.c = p->c; a.rel_bias = p->rel_bias; a.ada_w = p->ada_w; a.ada_b = p->ada_b; a.norm1 = p->norm1; a.norm2 = p->norm2; a.w_in = p->w_in;
    a.cmp_pos = p->cmp_pos; a.cmp_w1 = p->cmp_w1; a.cmp_w2 = p->cmp_w2; a.w_up_nsa = p->w_up_nsa; a.w_up_dil = p->w_up_dil; a.w_o = p->w_o;
    a.router_wg = p->router_wg; a.router_bg = p->router_bg; a.router_we = p->router_we; a.router_be = p->router_be; a.exp_w1 = p->exp_w1; a.exp_w3 = p->exp_w3; a.exp_w2 = p->exp_w2; a.norm_f = p->norm_f;
    a.out = p->out; a.ws = p->ws; a.ph_lo = p->ph_lo; a.ph_hi = p->ph_hi; a.use_bar = p->use_bar; a.pad = 0;
    return a;
#else
    return Args{};
#endif
}
#define LOADA() const Args a = load_args()
__global__ void __launch_bounds__(NTHR, 2) fwd_kernel(Args a_) {
    extern __shared__ __attribute__((aligned(16))) unsigned char lds_raw[];
    LAS unsigned char* const lds_base = (LAS unsigned char*)lds_raw;
    const int wave0_ = __builtin_amdgcn_readfirstlane((int)threadIdx.x >> 6);
#define FRESH() Ctx C; { int w_ = wave0_; asm volatile("" : "+s"(w_)); int t_ = lane_id_fresh(); asm volatile("" : "+v"(t_)); t_ += w_ * 64; int g_ = gridDim.x, b_ = blockIdx.x; asm volatile("" : "+s"(g_), "+s"(b_)); \
        C.lds = lds_base; C.tid = t_; C.lane = t_ & 63; C.wave = w_; C.G = g_; C.bx = b_; C.vcu = (g_ % 8 == 0) ? (b_ % 8) * (g_ / 8) + b_ / 8 : b_; }
    volatile LAS unsigned* MISC = (volatile LAS unsigned*)(lds_base + LDS_MISC);
    if (threadIdx.x < 64) MISC[threadIdx.x] = 0u;
    __syncthreads();
    unsigned* ctl = (unsigned*)(a_.ws + WS_CTL);
    XcdBarrier bar; bar.bar = ctl + CW_BAR; bar.x = 0; bar.st = nullptr;
    if (a_.use_bar) bar = xcd_barrier_post(ctl + CW_BAR, MISC + 8);
    const int lo = a_.ph_lo, hi = a_.ph_hi;
#ifndef PH_MASK
#define PH_MASK 0xFFFFFFFFu
#endif
#define IN(k) (((PH_MASK >> ((k) == 0 ? 10 : (k) == 21 ? 11 : (((k) - 1) % 10))) & 1u) && lo <= (k) && (k) < hi)
#define TIMED(k) ((TMASK >> (k)) & 1u)
#define TBEG(k) do { if (TMASK != 0u && TIMED(k) && blockIdx.x == 0 && wave0_ == 0 && lane_id_fresh() == 0) { const unsigned long long t_ = __builtin_amdgcn_s_memrealtime(); MISC[20] = (unsigned)t_; MISC[21] = (unsigned)(t_ >> 32); } } while (0)
#define TEND(k) do { if (TMASK != 0u && TIMED(k) && blockIdx.x == 0 && wave0_ == 0 && lane_id_fresh() == 0) { const unsigned long long t_ = __builtin_amdgcn_s_memrealtime(); const unsigned long long t0_ = ((unsigned long long)MISC[21] << 32) | MISC[20]; \
        const unsigned long long d_ = (((unsigned long long)MISC[23] << 32) | MISC[22]) + (t_ - t0_); MISC[22] = (unsigned)d_; MISC[23] = (unsigned)(d_ >> 32); } } while (0)
#define SEAM(k) do { if (IN(k) && IN((k) + 1)) { XcdBarrier b2_ = bar; asm volatile("" : "+s"(b2_.bar)); int w2_ = wave0_; asm volatile("" : "+s"(w2_)); xcd_barrier(b2_, w2_ == 0 && lane_id_fresh() == 0); } } while (0)
    TBEG(0);
    if (IN(0)) REPEAT(10) { __syncthreads(); FRESH(); LOADA(); prologue_vectors(a, C); conv_small(a, C); }
    SEAM(0); TEND(0);
    _Pragma("unroll") for (int l = 0; l < 2; ++l) {
        const int pb = 1 + 10 * l;
        TBEG(pb + 0);
        if (IN(pb + 0)) REPEAT(0) { FRESH(); LOADA(); norm1_phase(a, C, l); }
        SEAM(pb + 0); TEND(pb + 0);
        TBEG(pb + 1);
        if (IN(pb + 1)) REPEAT(1) { FRESH(); LOADA(); unsigned char* ws = a.ws;
            pg8::Gemm g{1024u, 1024u, 128u, 1024, 0u, 0u, 0, nullptr, nullptr, 0x77777777, 0x7c7c7c7c};
            pg8::DenseOrder S; S.init(T, NIN, C.G, C.bx, ws + WS_H, 1024u, ws + WS_WINT + (size_t)l * NIN * DM, 1024u);
            EpiInProj E{(bf16_t*)(ws + WS_A), (unsigned char*)(ws + WS_MG), (float*)(ws + WS_GN), 1.0f / 2048.0f};
            pg8::gemm_phase<EpiInProj, pg8::DenseOrder, true, false, false, true>(C.lds, C.tid, g, S, E);
        }
        SEAM(pb + 1); TEND(pb + 1);
        TBEG(pb + 2);
        if (IN(pb + 2)) REPEAT(2) { FRESH(); LOADA(); unsigned char* ws = a.ws;
            struct CmpOrder { int c; const char* A; const char* B;
                __device__ __forceinline__ bool next(int i, pg8::Unit& u) const { if (i > 0 || c >= 32) return false; const int kv = c >> 4, b = (c >> 1) & 7, hk = c & 1;
                    u.pm = c; u.pn = 0; u.A = A + ((size_t)b * SEQ * LDQ + 512 + kv * 128 + hk * 64) * 2; u.B = B + (size_t)kv * 256 * 2048 * 2; return true; } };
            pg8::Gemm g{(unsigned)(16 * LDQ * 2), 4096u, (unsigned)(LDQ * 2), 2048};
            CmpOrder S{C.vcu, (const char*)(ws + WS_A), (const char*)(ws + WS_CW1T + (size_t)l * 2 * 256 * 2048 * 2)};
            EpiCmp E{(bf16_t*)(ws + WS_HID), (const float*)(ws + WS_CB1) + l * 512, (const bf16_t*)(ws + WS_CW2T) + (size_t)l * 2 * 64 * 256, (bf16_t*)(ws + WS_KC)};
            pg8::gemm_phase<EpiCmp, CmpOrder, false>(C.lds, C.tid, g, S, E);
            __syncthreads();
            build_bkt(C);
            for (;;) { __syncthreads();
                if (C.tid == 0) *(volatile LAS int*)(C.lds + LDS_MISC + 512) = (int)__hip_atomic_fetch_add((unsigned*)(ws + WS_CTL) + CW_Q + l, 1u, __ATOMIC_RELAXED, __HIP_MEMORY_SCOPE_AGENT);
                __syncthreads();
                const int du = __builtin_amdgcn_readfirstlane(*(volatile LAS int*)(C.lds + LDS_MISC + 512));
                if (du >= 1536) break;
                dil_unit(a, C, du); }
        }
        SEAM(pb + 2); TEND(pb + 2);
        TBEG(pb + 3);
        if (IN(pb + 3)) REPEAT(3) { FRESH(); LOADA();
            dil_combine(a, C);
            build_bkt(C);
            int cur_hk = -1;
            for (int v = C.vcu; v < 256; v += C.G) { const int b = v >> 5, hk = (v >> 4) & 1, s = v & 15;
                if (hk != cur_hk) { build_nsa_tables(a, C, hk); cur_hk = hk; }
                for (int k = 0; k < 4; ++k) { const int qi = (k == 0) ? s : (k == 1) ? 31 - s : (k == 2) ? 32 + s : 63 - s; nsa_unit(a, C, b, hk, qi);
                    __syncthreads(); if (v < C.G) conv_experts_slice(a, C, l, k); } }
            if (C.vcu >= 256) { for (int q = 0; q < 4; ++q) conv_experts_slice(a, C, l, q); }
            __syncthreads();
        }
        SEAM(pb + 3); TEND(pb + 3);
        TBEG(pb + 4);
        if (IN(pb + 4)) REPEAT(4) { FRESH(); LOADA(); unsigned char* ws = a.ws;
            pg8::Gemm g{1024u, 1024u, 128u, 512, 512u, 512u, 256}; pg8::DenseOrder S; S.init(T, 1024, C.G, C.bx, ws + WS_ONSA, 1024u, ws + WS_WUNT + (size_t)l * 1024 * 512 * 2, 1024u);
            S.A2 = (const char*)(ws + WS_ODIL); S.B2 = (const char*)(ws + WS_WUDT + (size_t)l * 1024 * 256 * 2); S.tA2 = (size_t)256 * 512; S.tB2 = (size_t)256 * 512;
            EpiUpFused E{(bf16_t*)(ws + WS_MERGED), (const unsigned char*)(ws + WS_MG)};
            pg8::gemm_phase<EpiUpFused, pg8::DenseOrder, true, true>(C.lds, C.tid, g, S, E);
        }
        SEAM(pb + 4); TEND(pb + 4);
        TBEG(pb + 5);
        if (IN(pb + 5)) REPEAT(5) { FRESH(); LOADA(); unsigned char* ws = a.ws;
            pg8::Gemm g{2048u, 2048u, 128u, 1024}; pg8::DenseOrder S; S.init(T, 1024, C.G, C.bx, ws + WS_MERGED, 2048u, ws + WS_WOT + (size_t)l * 1024 * 1024 * 2, 2048u);
            EpiOut E{l == 0 ? a.x : (const float*)a.out, a.out, (const float*)(ws + WS_MOD) + (size_t)l * 8 * 6144 + 2048};
            pg8::gemm_phase<EpiOut, pg8::DenseOrder, true>(C.lds, C.tid, g, S, E);
        }
        SEAM(pb + 5); TEND(pb + 5);
        TBEG(pb + 6);
        if (IN(pb + 6)) REPEAT(6) { FRESH(); LOADA(); norm2_router_phase(a, C, l); }
        SEAM(pb + 6); TEND(pb + 6);
        TBEG(pb + 7);
        if (IN(pb + 7)) REPEAT(7) { FRESH(); LOADA(); moe_scatter_phase(a, C); }
        SEAM(pb + 7); TEND(pb + 7);
        TBEG(pb + 8);
        if (IN(pb + 8)) REPEAT(8) { FRESH(); LOADA(); unsigned char* ws = a.ws;
            const int* TILEE = (const int*)(ws + WS_TILEE); const int ntl = TILEE[0];
            MoeOrder S; S.G = C.G; S.c = C.vcu; S.nu = ntl * 4; S.A = (const char*)(ws + WS_XS); S.B = (const char*)(ws + WS_E13T); S.tA = (size_t)256 * 1024; S.tB = (size_t)256 * 1024; S.eB = (size_t)1024 * 1024;
#pragma unroll
            for (int i = 0; i < 8; ++i) { const int L = i * C.G + C.vcu; S.ex[i] = (L < S.nu) ? TILEE[16 + (L >> 2)] : 0; }
            pg8::Gemm g{1024u, 1024u, 128u, 1024, 0u, 0u, 0, (const int*)(ws + WS_TOKL), (const char*)(ws + WS_H2), 0, 0};
            EpiMoe1 E{(bf16_t*)(ws + WS_ACT), 1.0f / 2048.0f};
            pg8::gemm_phase<EpiMoe1, MoeOrder, true, false, true, true>(C.lds, C.tid, g, S, E);
        }
        SEAM(pb + 8); TEND(pb + 8);
        TBEG(pb + 9);
        if (IN(pb + 9)) REPEAT(9) { FRESH(); LOADA(); unsigned char* ws = a.ws;
            const int* TILEE = (const int*)(ws + WS_TILEE); const int ntl = TILEE[0];
            MoeOrder S; S.G = C.G; S.c = C.vcu; S.nu = ntl * 4; S.A = (const char*)(ws + WS_ACT); S.B = (const char*)(ws + WS_E2T); S.tA = (size_t)256 * 1024; S.tB = (size_t)256 * 1024; S.eB = (size_t)1024 * 1024;
#pragma unroll
            for (int i = 0; i < 8; ++i) { const int L = i * C.G + C.vcu; S.ex[i] = (L < S.nu) ? TILEE[16 + (L >> 2)] : 0; }
            pg8::Gemm g{1024u, 1024u, 128u, 512};
            EpiPlain E{(bf16_t*)(ws + WS_XS), 1024};
            pg8::gemm_phase<EpiPlain, MoeOrder, true>(C.lds, C.tid, g, S, E);
        }
        SEAM(pb + 9); TEND(pb + 9);
    }
    TBEG(21);
    if (IN(21)) { FRESH(); LOADA(); final_phase(a, C); }
    TEND(21);
    if ((TMASK != 0u || TNSA != 0) && blockIdx.x == 0 && wave0_ == 0 && lane_id_fresh() == 0) { const unsigned long long d_ = ((unsigned long long)MISC[23] << 32) | MISC[22]; const unsigned long long t0_ = __builtin_amdgcn_s_memrealtime();
        while (__builtin_amdgcn_s_memrealtime() - t0_ < TAMP * d_) __builtin_amdgcn_s_sleep(8); }
#undef IN
#undef SEAM
}

#ifndef ONE_LAUNCH
#define ONE_LAUNCH 1
#endif
extern "C" void kernel_launch(void* const* d_in, const int* in_sizes, int n_in, void* d_out, int out_size, void* d_ws, size_t ws_size, hipStream_t stream) {
    static int grid = 0;
    if (grid == 0) {
        if (n_in != 22 || out_size != T * DM || ws_size < WS_END) { fprintf(stderr, "kernel_launch: unexpected problem (n_in %d out %d ws %zu)\n", n_in, out_size, ws_size); grid = -1; return; }
        int dev = 0, cus = 0;
        if (hipGetDevice(&dev) != hipSuccess || hipDeviceGetAttribute(&cus, hipDeviceAttributeMultiprocessorCount, dev) != hipSuccess) { grid = -1; return; }
        if (hipFuncSetAttribute((const void*)fwd_kernel, hipFuncAttributeMaxDynamicSharedMemorySize, LDS_BYTES) != hipSuccess) { fprintf(stderr, "kernel_launch: hipFuncSetAttribute failed\n"); grid = -1; return; }
        int per_cu = 0;
        if (hipOccupancyMaxActiveBlocksPerMultiprocessor(&per_cu, (const void*)fwd_kernel, NTHR, LDS_BYTES) != hipSuccess || per_cu < 1) { fprintf(stderr, "kernel_launch: occupancy query reports %d\n", per_cu); }
        (void)hipGetLastError();
        grid = cus;
    }
    if (grid < 0) return;
    (void)hipMemsetAsync((char*)d_ws + WS_CTL, 0, CTL_ZERO_BYTES, stream);
    Args a{};
    a.x = (const float*)d_in[0]; a.c = (const float*)d_in[1]; a.rel_bias = (const float*)d_in[2]; a.ada_w = (const float*)d_in[3]; a.ada_b = (const float*)d_in[4];
    a.norm1 = (const float*)d_in[5]; a.norm2 = (const float*)d_in[6]; a.w_in = (const float*)d_in[7]; a.cmp_pos = (const float*)d_in[8]; a.cmp_w1 = (const float*)d_in[9];
    a.cmp_w2 = (const float*)d_in[10]; a.w_up_nsa = (const float*)d_in[11]; a.w_up_dil = (const float*)d_in[12]; a.w_o = (const float*)d_in[13];
    a.router_wg = (const float*)d_in[14]; a.router_bg = (const float*)d_in[15]; a.router_we = (const float*)d_in[16]; a.router_be = (const float*)d_in[17];
    a.exp_w1 = (const float*)d_in[18]; a.exp_w3 = (const float*)d_in[19]; a.exp_w2 = (const float*)d_in[20]; a.norm_f = (const float*)d_in[21];
    a.out = (float*)d_out; a.ws = (unsigned char*)d_ws; a.pad = 0;
#if ONE_LAUNCH
    a.ph_lo = 0; a.ph_hi = NPHASE; a.use_bar = 1;
    hipLaunchKernelGGL(fwd_kernel, dim3(grid), dim3(NTHR), LDS_BYTES, stream, a);
#else
    for (int p = 0; p < NPHASE; ++p) { a.ph_lo = p; a.ph_hi = p + 1; a.use_bar = 0;
        hipLaunchKernelGGL(fwd_kernel, dim3(grid), dim3(NTHR), LDS_BYTES, stream, a); }
#endif
}
```

```cpp
#include <hip/hip_runtime.h>
#include <cstdint>
#include <cstdio>

#define GAS __attribute__((address_space(1)))
#define LAS __attribute__((address_space(3)))
typedef unsigned short bf16_t;
typedef short bf16x8 __attribute__((ext_vector_type(8)));
typedef short s16x4 __attribute__((ext_vector_type(4)));
typedef float f32x4 __attribute__((ext_vector_type(4)));
typedef float f32x2 __attribute__((ext_vector_type(2)));
typedef float f32x16 __attribute__((ext_vector_type(16)));
typedef unsigned u32x4 __attribute__((ext_vector_type(4)));
typedef unsigned u32x2 __attribute__((ext_vector_type(2)));
typedef __bf16 bf16x2_t __attribute__((ext_vector_type(2)));

constexpr int NB = 8, SEQ = 4096, DM = 1024, T = NB * SEQ;
constexpr int LDQ = 3584;
constexpr int NIN = 5888;
constexpr int INW = 5656;
constexpr float LOG2E = 1.4426950408889634f;
constexpr float C2 = 0.125f * LOG2E;
constexpr int NWAVES = 8, NTHR = 512;
constexpr float RMS_EPS = 1e-6f;
constexpr int NPHASE = 22;
#ifndef ABL
#define ABL 0
#endif
#ifndef REP_MASK
#define REP_MASK 0u
#endif
#ifndef TMASK
#define TMASK 0u
#endif
#define TAMP 8ull
#ifndef TNSA
#define TNSA 0
#endif
#define REPEAT(k) _Pragma("clang loop unroll(disable)") for (int rep_ = 0; rep_ < (int)((REP_MASK >> (k)) & 1u) + 1; ++rep_)

constexpr size_t MiB = 1u << 20;
constexpr size_t WS_CTL = 0, CTL_ZERO_BYTES = MiB;
constexpr size_t WS_MOD = 1 * MiB;
constexpr size_t WS_CB1 = WS_MOD + 400 * 1024;
constexpr size_t WS_CW2T = WS_MOD + 512 * 1024;
constexpr size_t WS_CNTBLK = WS_MOD + 768 * 1024;
constexpr size_t WS_TILEE = WS_MOD + 832 * 1024;
constexpr size_t WS_WINT = 4 * MiB;
constexpr size_t WS_CW1T = 27 * MiB;
constexpr size_t WS_WUNT = 31 * MiB;
constexpr size_t WS_WUDT = 33 * MiB;
constexpr size_t WS_WOT = 34 * MiB;
constexpr size_t WS_E13T = 38 * MiB;
constexpr size_t WS_E2T = 102 * MiB;
constexpr size_t WS_A = 134 * MiB;
constexpr size_t WS_XS = WS_A;
constexpr size_t WS_ACT = WS_A + 144 * MiB;
constexpr size_t WS_MERGED = WS_A;
constexpr size_t WS_MG = 359 * MiB;
constexpr size_t WS_H2 = WS_MG;
constexpr size_t WS_REC = WS_MG + 64 * MiB;
constexpr size_t WS_DEST = WS_MG + 65 * MiB;
constexpr size_t WS_TOKL = WS_MG + 66 * MiB;
constexpr size_t WS_B = 487 * MiB;
constexpr size_t WS_H = WS_B;
constexpr size_t WS_ONSA = WS_B;
constexpr size_t WS_ODP = WS_B + 32 * MiB;
constexpr size_t WS_LSE = WS_B + 80 * MiB;
constexpr size_t WS_ODIL = WS_B + 82 * MiB;
constexpr size_t WS_GN = WS_B + 98 * MiB;
constexpr size_t WS_KC = WS_B + 102 * MiB;
constexpr size_t WS_HID = WS_B + 103 * MiB;
constexpr size_t WS_END = WS_B + 107 * MiB;

constexpr int CW_TMO = 0, CW_BAR = 4096, CW_Q = 8192;

constexpr int LDS_MISC = 158784;
constexpr int LDS_BYTES = 158784 + 2048;

__device__ __forceinline__ unsigned cvt_pk_bf16(float lo, float hi) { f32x2 v = {lo, hi}; bf16x2_t b = __builtin_convertvector(v, bf16x2_t); return __builtin_bit_cast(unsigned, b); }
__device__ __forceinline__ float bf_lo(unsigned w) { return __uint_as_float(w << 16); }
__device__ __forceinline__ float bf_hi(unsigned w) { return __uint_as_float(w & 0xffff0000u); }
__device__ __forceinline__ float sigmoidf_(float x) { return __builtin_amdgcn_rcpf(1.0f + __builtin_amdgcn_exp2f(-x * LOG2E)); }
__device__ __forceinline__ int lane_id_fresh() { unsigned ones = ~0u; asm volatile("" : "+s"(ones)); return (int)__builtin_amdgcn_mbcnt_hi(ones, __builtin_amdgcn_mbcnt_lo(ones, 0u)); }
template <int X> __device__ __forceinline__ float swz_xor_f(float v) { return __int_as_float(__builtin_amdgcn_ds_swizzle(__float_as_int(v), (X << 10) | 0x1f)); }
template <int X> __device__ __forceinline__ unsigned swz_xor_u(unsigned v) { return (unsigned)__builtin_amdgcn_ds_swizzle((int)v, (X << 10) | 0x1f); }
__device__ __forceinline__ float wave_sum(float v) {
    v += swz_xor_f<1>(v); v += swz_xor_f<2>(v); v += swz_xor_f<4>(v); v += swz_xor_f<8>(v); v += swz_xor_f<16>(v);
    auto rr = __builtin_amdgcn_permlane32_swap(__float_as_uint(v), __float_as_uint(v), false, false);
    return __uint_as_float(rr[0]) + __uint_as_float(rr[1]);
}
__device__ __forceinline__ int bperm_i(int srclane, int v) { return __builtin_amdgcn_ds_bpermute(srclane << 2, v); }
#define LDS_WAIT() asm volatile("s_waitcnt lgkmcnt(0)" ::: "memory")
#define VM_WAIT() asm volatile("s_waitcnt vmcnt(0)" ::: "memory")

#define XB_TMO      128
#define XB_XCNT(j)  (256  + 64 * (j))
#define XB_XSUB(j)  (1280 + 64 * (j))
#define XB_XGEN(j)  (2304 + 64 * (j))
#define XB_TOP      3328
#define XB_TOPGEN   3392
#define XCD_BAR_WORDS 3456
#define XB_SPIN_CAP (1u << 20)
__device__ __forceinline__ unsigned xb_ld(unsigned* p)              { return __hip_atomic_load(p, __ATOMIC_RELAXED, __HIP_MEMORY_SCOPE_AGENT); }
__device__ __forceinline__ unsigned xb_add(unsigned* p, unsigned v) { return __hip_atomic_fetch_add(p, v, __ATOMIC_RELAXED, __HIP_MEMORY_SCOPE_AGENT); }
__device__ __forceinline__ unsigned xb_xcc_id() { return (unsigned)__builtin_amdgcn_s_getreg((3 << 11) | 20) & 0xFu; }
#define XB_SPIN(cond, bar) do { unsigned _sp = 0; while (cond) { __builtin_amdgcn_s_sleep(1); \
    if ((++_sp & 255u) == 0u) { if (xb_ld(&(bar)[XB_TMO])) break; if (_sp > XB_SPIN_CAP) { atomicAdd(&(bar)[XB_TMO], 1u); break; } } } } while (0)
struct XcdBarrier { unsigned* bar; unsigned x; volatile LAS unsigned* st; };
__device__ __forceinline__ XcdBarrier xcd_barrier_post(unsigned* bar, volatile LAS unsigned* st) {
    XcdBarrier b; b.bar = bar; b.x = xb_xcc_id(); b.st = st;
    if (threadIdx.x == 0) (void)xb_add(&bar[XB_XCNT(b.x)], 1u);
    return b;
}
__device__ __forceinline__ void xcd_barrier_complete(unsigned* bar, unsigned x, unsigned& nloc, unsigned& nx) {
    const unsigned G = gridDim.x * gridDim.y * gridDim.z;
    unsigned sum, cnt, mine, sp = 0u;
    for (;;) {
        sum = 0u; cnt = 0u; mine = 0u;
#pragma unroll
        for (unsigned j = 0; j < 16; ++j) { const unsigned c = xb_ld(&bar[XB_XCNT(j)]); sum += c; cnt += (c > 0u) ? 1u : 0u; mine = (j == x) ? c : mine; }
        if (sum == G) break;
        __builtin_amdgcn_s_sleep(1);
        if ((++sp & 255u) == 0u) { if (xb_ld(&bar[XB_TMO])) break; if (sp > XB_SPIN_CAP) { atomicAdd(&bar[XB_TMO], 1u); break; } }
    }
    nloc = mine > 0u ? mine : 1u; nx = cnt > 0u ? cnt : 1u;
}
__device__ __forceinline__ void xcd_barrier(const XcdBarrier& b, const bool leader_thread) {
    asm volatile("s_waitcnt vmcnt(0)" ::: "memory");
    __syncthreads();
    if (leader_thread) {
        unsigned* bar = b.bar;
        __builtin_amdgcn_s_waitcnt(0);
        unsigned nloc = b.st[0], nx = b.st[1];
        if (nloc == 0u) { xcd_barrier_complete(bar, b.x, nloc, nx); b.st[0] = nloc; b.st[1] = nx; }
        const unsigned old = xb_add(&bar[XB_XSUB(b.x)], 1u);
        const unsigned gen = old / nloc;
        if (old + 1u == (gen + 1u) * nloc) {
            __builtin_amdgcn_fence(__ATOMIC_RELEASE, "agent");
            asm volatile("s_waitcnt vmcnt(0)" ::: "memory");
            const unsigned og = xb_add(&bar[XB_TOP], 1u);
            const unsigned tg = og / nx;
            if (og + 1u == (tg + 1u) * nx) xb_add(&bar[XB_TOPGEN], 1u);
            else XB_SPIN(xb_ld(&bar[XB_TOPGEN]) == tg, bar);
            __builtin_amdgcn_fence(__ATOMIC_ACQUIRE, "agent");
            xb_add(&bar[XB_XGEN(b.x)], 1u);
            asm volatile("s_waitcnt vmcnt(0)" ::: "memory");
        } else {
            XB_SPIN(xb_ld(&bar[XB_XGEN(b.x)]) == gen, bar);
            __builtin_amdgcn_fence(__ATOMIC_ACQUIRE, "agent");
            asm volatile("s_waitcnt vmcnt(0)" ::: "memory");
        }
    }
    __syncthreads();
}

namespace pg8 {
constexpr int BM = 256, BK = 64, HALF = 128, HTB = HALF * BK * 2, STAGE_BYTES = 8 * HTB;
__device__ __forceinline__ int lds_byte(int r, int c) { const int st = (r >> 4) * 2 + (c >> 5), rr = r & 15, cc = c & 31, ob = rr * 64 + cc * 2; return st * 1024 + (ob ^ (((ob >> 9) & 1) << 5)); }
__device__ __forceinline__ void stage_rc(int b, int& R, int& C) { const int st = b / 1024, sb = b % 1024, swz = sb ^ (((sb >> 9) & 1) << 5); R = (st >> 1) * 16 + swz / 64; C = (st & 1) * 32 + (swz % 64) / 2; }
__device__ __forceinline__ int perm32(int rho) { const int n = rho >> 4, i = rho & 15; return 8 * (i >> 2) + 4 * n + (i & 3); }

struct Unit { const char* A; const char* B; int pm, pn; const char* A2; const char* B2; };
struct Gemm { unsigned lda, ldb, kstepA; int K; unsigned lda2, ldb2; int K2; const int* tokl; const char* Abase; int sc_w, sc_a; };

template <class Epi, class Sched, bool ALIGN_EPI, bool SEG2 = false, bool GATHER = false, bool FP8 = false>
__device__ __forceinline__ void gemm_phase(LAS unsigned char* lds, const int tid, const Gemm g, const Sched& S, const Epi& E) {
    const int wid = __builtin_amdgcn_readfirstlane(tid >> 6), lane = tid & 63, wr = wid >> 2, wc = wid & 3, fr = lane & 15, fq = lane >> 4;
    const int nt0 = g.K / (FP8 ? 2 * BK : BK); const int nt = nt0 + (SEG2 ? g.K2 / BK : 0);
    unsigned voffA[2], voffB[2], voffA2[2], voffB2[2]; int Rrow[2]; unsigned Cb[2];
#pragma unroll
    for (int i = 0; i < 2; ++i) { int R, C; stage_rc(tid * 16 + i * 8192, R, C); Rrow[i] = R; Cb[i] = (unsigned)C * 2u; const int Rb = Epi::PERM ? ((R & ~31) + perm32(R & 31)) : R;
        voffA[i] = (unsigned)R * g.lda + (unsigned)C * 2u; voffB[i] = (unsigned)Rb * g.ldb + (unsigned)C * 2u;
        voffA2[i] = SEG2 ? (unsigned)R * g.lda2 + (unsigned)C * 2u : 0u; voffB2[i] = SEG2 ? (unsigned)Rb * g.ldb2 + (unsigned)C * 2u : 0u; }
    const size_t kstepA = (size_t)g.kstepA, kstepB = (size_t)(BK * 2);
    const size_t hstepA = (size_t)HALF * g.lda, hstepB = (size_t)HALF * g.ldb;
    const size_t hstepA2 = SEG2 ? (size_t)HALF * g.lda2 : 0, hstepB2 = SEG2 ? (size_t)HALF * g.ldb2 : 0;
    const unsigned ldsw = (unsigned)wid * 1024u;
    const int aoff = lds_byte(wr * 64 + fr, FP8 ? fq * 16 : fq * 8), boff = lds_byte(wc * 32 + fr, FP8 ? fq * 16 : fq * 8);
#define PG8_SA(b, h) (((b) * 2 + (h)) * HTB)
#define PG8_SB(b, h) ((4 + (b) * 2 + (h)) * HTB)
#define PG8_STAGE(bufoff, gbase, voff) do { _Pragma("unroll") for (int _i = 0; _i < 2; ++_i) \
        __builtin_amdgcn_global_load_lds((const unsigned*)((const char*)(gbase) + (voff)[_i]), (LAS unsigned*)(lds + (bufoff) + ldsw + _i * 8192), 16, 0, 0); } while (0)
#define PG8_STAGE2(bufoff, gbase, sel, v0, v1) do { _Pragma("unroll") for (int _i = 0; _i < 2; ++_i) \
        __builtin_amdgcn_global_load_lds((const unsigned*)((const char*)(gbase) + ((sel) ? (v1)[_i] : (v0)[_i])), (LAS unsigned*)(lds + (bufoff) + ldsw + _i * 8192), 16, 0, 0); } while (0)
#define PG8_LDA(dst, b, h) do { if constexpr (FP8) { _Pragma("unroll") for (int m = 0; m < 4; ++m) dst##8[m] = *(const LAS v8i_*)(lds + PG8_SA(b, h) + aoff + m * 2048); } \
        else { _Pragma("unroll") for (int m = 0; m < 4; ++m) _Pragma("unroll") for (int k = 0; k < 2; ++k) dst[m][k] = *(const LAS bf16x8*)(lds + PG8_SA(b, h) + aoff + m * 2048 + k * 1024); } } while (0)
#define PG8_LDB(dst, b, h) do { if constexpr (FP8) { _Pragma("unroll") for (int n = 0; n < 2; ++n) dst##8[n] = *(const LAS v8i_*)(lds + PG8_SB(b, h) + boff + n * 2048); } \
        else { _Pragma("unroll") for (int n = 0; n < 2; ++n) _Pragma("unroll") for (int k = 0; k < 2; ++k) dst[n][k] = *(const LAS bf16x8*)(lds + PG8_SB(b, h) + boff + n * 2048 + k * 1024); } } while (0)
#define PG8_MMA(ai, bj, At, Bt) do { __builtin_amdgcn_s_setprio(1); _Pragma("unroll") for (int m = 0; m < 4; ++m) _Pragma("unroll") for (int n = 0; n < 2; ++n) { \
        if constexpr (FP8) { asm volatile("v_mfma_f32_16x16x128_f8f6f4 %0, %1, %2, %0" : "+v"(acc[ai][bj][m][n]) : "v"(Bt##8[n]), "v"(At##8[m])); }     \
        else { _Pragma("unroll") for (int k = 0; k < 2; ++k) acc[ai][bj][m][n] = __builtin_amdgcn_mfma_f32_16x16x32_bf16(Bt[n][k], At[m][k], acc[ai][bj][m][n], 0, 0, 0); } } \
        __builtin_amdgcn_s_setprio(0); } while (0)
#define PG8_WAIT_V(n) asm volatile("s_waitcnt vmcnt(" #n ")" ::: "memory")
#define PG8_WAIT_L(n) asm volatile("s_waitcnt lgkmcnt(" #n ")" ::: "memory")
#define PG8_BAR __builtin_amdgcn_s_barrier()
#define PG8_SCHED __builtin_amdgcn_sched_barrier(0)
    Unit cur, nxt; int ui = 0;
    if (!S.next(0, cur)) return;
    f32x4 acc[2][2][4][2];
#pragma unroll
    for (int a = 0; a < 2; ++a)
#pragma unroll
        for (int b = 0; b < 2; ++b)
#pragma unroll
            for (int m = 0; m < 4; ++m)
#pragma unroll
                for (int n = 0; n < 2; ++n) acc[a][b][m][n] = (f32x4){0.f, 0.f, 0.f, 0.f};
    typedef int v8i_ __attribute__((ext_vector_type(8)));
    bf16x8 At[4][2], B0[2][2], B1[2][2]; v8i_ At8[4], B08[2], B18[2];
    const char* cA = GATHER ? g.Abase : cur.A; const char* cB = cur.B;
    unsigned vC0[2], vC1[2], vN0[2], vN1[2];
#define PG8_GLOAD(U, d0, d1) do { _Pragma("unroll") for (int _i = 0; _i < 2; ++_i) { \
        d0[_i] = (unsigned)g.tokl[(U).pm * 256 + Rrow[_i]] * g.lda + Cb[_i]; d1[_i] = (unsigned)g.tokl[(U).pm * 256 + 128 + Rrow[_i]] * g.lda + Cb[_i]; } } while (0)
    if constexpr (GATHER) { PG8_GLOAD(cur, vC0, vC1); }
    if constexpr (GATHER) {
        PG8_STAGE(PG8_SB(0, 0), cB, voffB); PG8_STAGE(PG8_SB(0, 1), cB + hstepB, voffB); PG8_STAGE(PG8_SA(0, 0), cA, vC0); PG8_STAGE(PG8_SA(0, 1), cA, vC1);
        if (wr == 1) PG8_BAR;
        PG8_WAIT_V(2); PG8_BAR;
        PG8_STAGE(PG8_SB(1, 0), cB + kstepB, voffB); PG8_STAGE(PG8_SA(1, 0), cA + kstepA, vC0); PG8_STAGE(PG8_SB(1, 1), cB + hstepB + kstepB, voffB);
        PG8_WAIT_V(6); PG8_BAR;
    } else {
    PG8_STAGE(PG8_SB(0, 0), cB, voffB); PG8_STAGE(PG8_SB(0, 1), cB + hstepB, voffB); PG8_STAGE(PG8_SA(0, 0), cA, voffA); PG8_STAGE(PG8_SA(0, 1), cA + hstepA, voffA);
    if (wr == 1) PG8_BAR;
    PG8_WAIT_V(2); PG8_BAR;
    PG8_STAGE(PG8_SB(1, 0), cB + kstepB, voffB); PG8_STAGE(PG8_SA(1, 0), cA + kstepA, voffA); PG8_STAGE(PG8_SB(1, 1), cB + hstepB + kstepB, voffB);
    PG8_WAIT_V(6); PG8_BAR;
    }
    for (;;) {
        const bool has_next = S.next(ui + 1, nxt);
        const char* nA = GATHER ? cA : (has_next ? nxt.A : cA); const char* nB = has_next ? nxt.B : cB;
        if constexpr (GATHER) { if (has_next) { PG8_GLOAD(nxt, vN0, vN1); } else { vN0[0] = vC0[0]; vN0[1] = vC0[1]; vN1[0] = vC1[0]; vN1[1] = vC1[1]; } }
#pragma clang loop unroll(disable)
        for (int t = 0; t < nt; t += 2) {
            const bool last = (t == nt - 2);
            if constexpr (SEG2) {
                const bool s1 = (t >= nt0);
                const bool s2 = !last && (t + 2 >= nt0);
                if (t == nt0) E.mid(acc, cur, wr, wc, fr, fq);
                const char* a1 = s1 ? cur.A2 + (size_t)(t + 1 - nt0) * kstepB : cA + (size_t)(t + 1) * kstepA; const size_t h1 = s1 ? hstepA2 : hstepA;
                const char* a2 = last ? nA : (s2 ? cur.A2 + (size_t)(t + 2 - nt0) * kstepB : cA + (size_t)(t + 2) * kstepA);
                const char* b2 = last ? nB : (s2 ? cur.B2 + (size_t)(t + 2 - nt0) * kstepB : cB + (size_t)(t + 2) * kstepB);
                const char* a3 = a2 + (s2 ? kstepB : kstepA); const char* b3 = b2 + kstepB;
                const size_t hA2 = s2 ? hstepA2 : hstepA, hB2 = s2 ? hstepB2 : hstepB;
                PG8_LDB(B0, 0, 0); PG8_LDB(B1, 0, 1); PG8_SCHED; PG8_LDA(At, 0, 0); PG8_STAGE2(PG8_SA(1, 1), a1 + h1, s1, voffA, voffA2);
                PG8_WAIT_V(8); PG8_WAIT_L(0); PG8_BAR; PG8_MMA(0, 0, At, B0); PG8_MMA(0, 1, At, B1); PG8_BAR; PG8_SCHED;
                PG8_LDA(At, 0, 1); PG8_STAGE2(PG8_SB(0, 0), b2, s2, voffB, voffB2); PG8_STAGE2(PG8_SB(0, 1), b2 + hB2, s2, voffB, voffB2); PG8_STAGE2(PG8_SA(0, 0), a2, s2, voffA, voffA2);
                PG8_WAIT_V(8); PG8_WAIT_L(0); PG8_BAR; PG8_MMA(1, 0, At, B0); PG8_MMA(1, 1, At, B1); PG8_BAR; PG8_SCHED;
                PG8_LDB(B0, 1, 0); PG8_LDB(B1, 1, 1); PG8_SCHED; PG8_LDA(At, 1, 0); PG8_STAGE2(PG8_SA(0, 1), a2 + hA2, s2, voffA, voffA2);
                PG8_WAIT_V(8); PG8_WAIT_L(0); PG8_BAR; PG8_MMA(0, 0, At, B0); PG8_MMA(0, 1, At, B1); PG8_BAR; PG8_SCHED;
                PG8_LDA(At, 1, 1); PG8_STAGE2(PG8_SB(1, 0), b3, s2, voffB, voffB2); PG8_STAGE2(PG8_SB(1, 1), b3 + hB2, s2, voffB, voffB2); PG8_STAGE2(PG8_SA(1, 0), a3, s2, voffA, voffA2);
                PG8_WAIT_V(8); PG8_WAIT_L(0); PG8_BAR; PG8_MMA(1, 0, At, B0); PG8_MMA(1, 1, At, B1); PG8_BAR; PG8_SCHED;
            } else if constexpr (GATHER) {
            const char* a1 = cA + (size_t)(t + 1) * kstepA;
            const char* a2 = last ? cA : cA + (size_t)(t + 2) * kstepA; const char* b2 = last ? nB : cB + (size_t)(t + 2) * kstepB;
            const char* a3 = a2 + kstepA; const char* b3 = b2 + kstepB;
            unsigned w0[2], w1[2]; w0[0] = last ? vN0[0] : vC0[0]; w0[1] = last ? vN0[1] : vC0[1]; w1[0] = last ? vN1[0] : vC1[0]; w1[1] = last ? vN1[1] : vC1[1];
            PG8_LDB(B0, 0, 0); PG8_LDB(B1, 0, 1); PG8_SCHED; PG8_LDA(At, 0, 0); PG8_STAGE(PG8_SA(1, 1), a1, vC1);
            PG8_WAIT_V(8); PG8_WAIT_L(0); PG8_BAR; PG8_MMA(0, 0, At, B0); PG8_MMA(0, 1, At, B1); PG8_BAR; PG8_SCHED;
            PG8_LDA(At, 0, 1); PG8_STAGE(PG8_SB(0, 0), b2, voffB); PG8_STAGE(PG8_SB(0, 1), b2 + hstepB, voffB); PG8_STAGE(PG8_SA(0, 0), a2, w0);
            PG8_WAIT_V(8); PG8_WAIT_L(0); PG8_BAR; PG8_MMA(1, 0, At, B0); PG8_MMA(1, 1, At, B1); PG8_BAR; PG8_SCHED;
            PG8_LDB(B0, 1, 0); PG8_LDB(B1, 1, 1); PG8_SCHED; PG8_LDA(At, 1, 0); PG8_STAGE(PG8_SA(0, 1), a2, w1);
            PG8_WAIT_V(8); PG8_WAIT_L(0); PG8_BAR; PG8_MMA(0, 0, At, B0); PG8_MMA(0, 1, At, B1); PG8_BAR; PG8_SCHED;
            PG8_LDA(At, 1, 1); PG8_STAGE(PG8_SB(1, 0), b3, voffB); PG8_STAGE(PG8_SB(1, 1), b3 + hstepB, voffB); PG8_STAGE(PG8_SA(1, 0), a3, w0);
            PG8_WAIT_V(8); PG8_WAIT_L(0); PG8_BAR; PG8_MMA(1, 0, At, B0); PG8_MMA(1, 1, At, B1); PG8_BAR; PG8_SCHED;
            } else {
            const char* a1 = cA + (size_t)(t + 1) * kstepA;
            const char* a2 = last ? nA : cA + (size_t)(t + 2) * kstepA; const char* b2 = last ? nB : cB + (size_t)(t + 2) * kstepB;
            const char* a3 = a2 + kstepA; const char* b3 = b2 + kstepB;
            PG8_LDB(B0, 0, 0); PG8_LDB(B1, 0, 1); PG8_SCHED; PG8_LDA(At, 0, 0); PG8_STAGE(PG8_SA(1, 1), a1 + hstepA, voffA);
            PG8_WAIT_V(8); PG8_WAIT_L(0); PG8_BAR; PG8_MMA(0, 0, At, B0); PG8_MMA(0, 1, At, B1); PG8_BAR; PG8_SCHED;
            PG8_LDA(At, 0, 1); PG8_STAGE(PG8_SB(0, 0), b2, voffB); PG8_STAGE(PG8_SB(0, 1), b2 + hstepB, voffB); PG8_STAGE(PG8_SA(0, 0), a2, voffA);
            PG8_WAIT_V(8); PG8_WAIT_L(0); PG8_BAR; PG8_MMA(1, 0, At, B0); PG8_MMA(1, 1, At, B1); PG8_BAR; PG8_SCHED;
            PG8_LDB(B0, 1, 0); PG8_LDB(B1, 1, 1); PG8_SCHED; PG8_LDA(At, 1, 0); PG8_STAGE(PG8_SA(0, 1), a2 + hstepA, voffA);
            PG8_WAIT_V(8); PG8_WAIT_L(0); PG8_BAR; PG8_MMA(0, 0, At, B0); PG8_MMA(0, 1, At, B1); PG8_BAR; PG8_SCHED;
            PG8_LDA(At, 1, 1); PG8_STAGE(PG8_SB(1, 0), b3, voffB); PG8_STAGE(PG8_SB(1, 1), b3 + hstepB, voffB); PG8_STAGE(PG8_SA(1, 0), a3, voffA);
            PG8_WAIT_V(8); PG8_WAIT_L(0); PG8_BAR; PG8_MMA(1, 0, At, B0); PG8_MMA(1, 1, At, B1); PG8_BAR; PG8_SCHED;
            }
        }
        if constexpr (ALIGN_EPI) { if (wr == 0) PG8_BAR; }
        if constexpr (FP8) { asm volatile("s_nop 15\n\ts_nop 15" ::: "memory"); }
        if constexpr (!Epi::AFTER_DRAIN) { int fr_ = fr, fq_ = fq; asm volatile("" : "+v"(fr_), "+v"(fq_));
            E(acc, cur, wr, wc, fr_, fq_); }
        if (!has_next) break;
#pragma unroll
        for (int a = 0; a < 2; ++a)
#pragma unroll
            for (int b = 0; b < 2; ++b)
#pragma unroll
                for (int m = 0; m < 4; ++m)
#pragma unroll
                    for (int n = 0; n < 2; ++n) acc[a][b][m][n] = (f32x4){0.f, 0.f, 0.f, 0.f};
        cur = nxt; cA = nA; cB = nB; ++ui;
        if constexpr (GATHER) { vC0[0] = vN0[0]; vC0[1] = vN0[1]; vC1[0] = vN1[0]; vC1[1] = vN1[1]; }
        if constexpr (ALIGN_EPI) { if (wr == 1) PG8_BAR; }
    }
    PG8_WAIT_V(0);
    if constexpr (!ALIGN_EPI) { if (wr == 0) PG8_BAR; }
    PG8_BAR;
    if constexpr (Epi::AFTER_DRAIN) { E.fused(acc, cur, wr, wc, fr, fq, wid, lane); }
#undef PG8_SA
#undef PG8_SB
#undef PG8_STAGE
#undef PG8_STAGE2
#undef PG8_GLOAD
#undef PG8_LDA
#undef PG8_LDB
#undef PG8_MMA
#undef PG8_WAIT_V
#undef PG8_WAIT_L
#undef PG8_BAR
#undef PG8_SCHED
}

struct DenseOrder {
    int nM, nN, nwg, G, c; const char* A; const char* B; size_t tA, tB; const char* A2 = nullptr; const char* B2 = nullptr; size_t tA2 = 0, tB2 = 0;
    __device__ __forceinline__ void init(int M, int N, int G_, int c_, const void* A_, unsigned lda, const void* B_, unsigned ldb) {
        nM = M / BM; nN = N / BM; nwg = nM * nN; G = G_; c = c_; A = (const char*)A_; B = (const char*)B_; tA = (size_t)BM * lda; tB = (size_t)BM * ldb; }
    __device__ __forceinline__ bool next(int i, Unit& u) const {
        const long L = (long)i * G + c; if (L >= nwg) return false;
        int wgid = (int)L; { const int q = nwg / 8, r = nwg % 8, xcd = wgid % 8, off = wgid / 8; wgid = (xcd < r ? xcd * (q + 1) : r * (q + 1) + (xcd - r) * q) + off; }
        const int nig = 8 * nN, gid = wgid / nig, fm = gid * 8, gsz = (nM - fm) < 8 ? (nM - fm) : 8;
        u.pm = fm + ((wgid % nig) % gsz); u.pn = (wgid % nig) / gsz;
        u.A = A + (size_t)u.pm * tA; u.B = B + (size_t)u.pn * tB; u.A2 = A2 + (size_t)u.pm * tA2; u.B2 = B2 + (size_t)u.pn * tB2; return true;
    }
};
}

struct Args {
    const float* x; const float* c; const float* rel_bias; const float* ada_w; const float* ada_b; const float* norm1; const float* norm2; const float* w_in;
    const float* cmp_pos; const float* cmp_w1; const float* cmp_w2; const float* w_up_nsa; const float* w_up_dil; const float* w_o;
    const float* router_wg; const float* router_bg; const float* router_we; const float* router_be; const float* exp_w1; const float* exp_w3; const float* exp_w2; const float* norm_f;
    float* out; unsigned char* ws; int ph_lo, ph_hi, use_bar, pad;
};

typedef f32x4 AccT[2][2][4][2];
__device__ __forceinline__ unsigned q8(float x) { return (unsigned)(sigmoidf_(x) * 255.0f + 0.5f); }
struct EpiInProj {
    static constexpr bool PERM = true, AFTER_DRAIN = false;
    bf16_t* QKV; unsigned char* MG; float* GN; float os;
    __device__ __forceinline__ void operator()(const AccT& acc, const pg8::Unit& u, int wr, int wc, int fr, int fq) const {
        const int pn = u.pn; const int row0 = u.pm * 256 + wr * 64 + fr;
        if (pn < 14) {
            const float sc = ((pn < 2 || (pn >= 5 && pn < 8)) ? C2 : 1.0f) * os;
            const int col0 = pn * 256 + wc * 32 + 8 * fq;
#pragma unroll
            for (int ai = 0; ai < 2; ++ai)
#pragma unroll
                for (int m = 0; m < 4; ++m) { bf16_t* rowp = QKV + (size_t)(row0 + ai * 128 + m * 16) * LDQ + col0;
#pragma unroll
                    for (int bj = 0; bj < 2; ++bj) { const f32x4 v0 = acc[ai][bj][m][0] * sc, v1 = acc[ai][bj][m][1] * sc; u32x4 w;
                        w.x = cvt_pk_bf16(v0[0], v0[1]); w.y = cvt_pk_bf16(v0[2], v0[3]); w.z = cvt_pk_bf16(v1[0], v1[1]); w.w = cvt_pk_bf16(v1[2], v1[3]);
                        *(u32x4*)(rowp + bj * 128) = w; } }
        } else if (pn < 22) {
            const int col0 = (pn - 14) * 256 + wc * 32 + 8 * fq;
#pragma unroll
            for (int ai = 0; ai < 2; ++ai)
#pragma unroll
                for (int m = 0; m < 4; ++m) { unsigned char* rowp = MG + (size_t)(row0 + ai * 128 + m * 16) * 2048 + col0;
#pragma unroll
                    for (int bj = 0; bj < 2; ++bj) { const f32x4 v0 = acc[ai][bj][m][0] * os, v1 = acc[ai][bj][m][1] * os; u32x2 w;
                        w.x = q8(v0[0]) | (q8(v0[1]) << 8) | (q8(v0[2]) << 16) | (q8(v0[3]) << 24); w.y = q8(v1[0]) | (q8(v1[1]) << 8) | (q8(v1[2]) << 16) | (q8(v1[3]) << 24);
                        *(u32x2*)(rowp + bj * 128) = w; } }
        } else {
            if (wc == 0 && fq < 3) {
#pragma unroll
                for (int ai = 0; ai < 2; ++ai)
#pragma unroll
                    for (int m = 0; m < 4; ++m) { float* rowp = GN + (size_t)(row0 + ai * 128 + m * 16) * 32 + 8 * fq;
                        const f32x4 v0 = acc[ai][0][m][0] * os, v1 = acc[ai][0][m][1] * os;
                        *(f32x4*)(rowp) = (f32x4){sigmoidf_(v0[0]), sigmoidf_(v0[1]), sigmoidf_(v0[2]), sigmoidf_(v0[3])};
                        *(f32x4*)(rowp + 4) = (f32x4){sigmoidf_(v1[0]), sigmoidf_(v1[1]), sigmoidf_(v1[2]), sigmoidf_(v1[3])}; }
            }
        }
    }
};
template <int PASS> struct EpiUp {
    static constexpr bool PERM = true, AFTER_DRAIN = false;
    bf16_t* MERGED; const bf16_t* MG;
    __device__ __forceinline__ void operator()(const AccT& acc, const pg8::Unit& u, int wr, int wc, int fr, int fq) const {
        const int row0 = u.pm * 256 + wr * 64 + fr; const int col0 = u.pn * 256 + wc * 32 + 8 * fq;
#pragma unroll
        for (int ai = 0; ai < 2; ++ai)
#pragma unroll
            for (int m = 0; m < 4; ++m) { const size_t row = (size_t)(row0 + ai * 128 + m * 16);
#pragma unroll
                for (int bj = 0; bj < 2; ++bj) {
                    const u32x4 gw = *(const u32x4*)(MG + row * 2048 + PASS * 1024 + col0 + bj * 128);
                    bf16_t* op = MERGED + row * 1024 + col0 + bj * 128;
                    const f32x4 v0 = acc[ai][bj][m][0], v1 = acc[ai][bj][m][1];
                    float r[8] = {v0[0] * bf_lo(gw.x), v0[1] * bf_hi(gw.x), v0[2] * bf_lo(gw.y), v0[3] * bf_hi(gw.y), v1[0] * bf_lo(gw.z), v1[1] * bf_hi(gw.z), v1[2] * bf_lo(gw.w), v1[3] * bf_hi(gw.w)};
                    if (PASS == 1) { const u32x4 ow = *(const u32x4*)op;
                        r[0] += bf_lo(ow.x); r[1] += bf_hi(ow.x); r[2] += bf_lo(ow.y); r[3] += bf_hi(ow.y); r[4] += bf_lo(ow.z); r[5] += bf_hi(ow.z); r[6] += bf_lo(ow.w); r[7] += bf_hi(ow.w); }
                    u32x4 w; w.x = cvt_pk_bf16(r[0], r[1]); w.y = cvt_pk_bf16(r[2], r[3]); w.z = cvt_pk_bf16(r[4], r[5]); w.w = cvt_pk_bf16(r[6], r[7]);
                    *(u32x4*)op = w; }
                asm volatile("" ::: "memory"); }
    }
};
struct EpiUpFused {
    static constexpr bool PERM = true, AFTER_DRAIN = false;
    bf16_t* MERGED; const unsigned char* MG;
    __device__ __forceinline__ void mid(AccT& acc, const pg8::Unit& u, int wr, int wc, int fr, int fq) const {
        const int row0 = u.pm * 256 + wr * 64 + fr; const int col0 = u.pn * 256 + wc * 32 + 8 * fq;
#pragma unroll
        for (int ai = 0; ai < 2; ++ai)
#pragma unroll
            for (int m = 0; m < 4; ++m) { const size_t row = (size_t)(row0 + ai * 128 + m * 16);
#pragma unroll
                for (int bj = 0; bj < 2; ++bj) {
                    const u32x2 g0 = *(const u32x2*)(MG + row * 2048 + col0 + bj * 128), g1 = *(const u32x2*)(MG + row * 2048 + 1024 + col0 + bj * 128);
                    f32x4& v0 = acc[ai][bj][m][0]; f32x4& v1 = acc[ai][bj][m][1];
#pragma unroll
                    for (int j = 0; j < 4; ++j) { const float a0 = (float)((g0.x >> (8 * j)) & 255u), b0 = (float)((g1.x >> (8 * j)) & 255u), a1 = (float)((g0.y >> (8 * j)) & 255u), b1 = (float)((g1.y >> (8 * j)) & 255u);
                        v0[j] *= a0 * __builtin_amdgcn_rcpf(__builtin_fmaxf(b0, 0.5f)); v1[j] *= a1 * __builtin_amdgcn_rcpf(__builtin_fmaxf(b1, 0.5f)); } }
                asm volatile("" ::: "memory"); }
    }
    __device__ __forceinline__ void operator()(const AccT& acc, const pg8::Unit& u, int wr, int wc, int fr, int fq) const {
        const int row0 = u.pm * 256 + wr * 64 + fr; const int col0 = u.pn * 256 + wc * 32 + 8 * fq;
#pragma unroll
        for (int ai = 0; ai < 2; ++ai)
#pragma unroll
            for (int m = 0; m < 4; ++m) { const size_t row = (size_t)(row0 + ai * 128 + m * 16);
#pragma unroll
                for (int bj = 0; bj < 2; ++bj) {
                    const u32x2 g1 = *(const u32x2*)(MG + row * 2048 + 1024 + col0 + bj * 128);
                    const f32x4 v0 = acc[ai][bj][m][0], v1 = acc[ai][bj][m][1]; float r[8];
#pragma unroll
                    for (int j = 0; j < 4; ++j) { r[j] = v0[j] * (__builtin_fmaxf((float)((g1.x >> (8 * j)) & 255u), 0.5f) * (1.0f / 255.0f)); r[4 + j] = v1[j] * (__builtin_fmaxf((float)((g1.y >> (8 * j)) & 255u), 0.5f) * (1.0f / 255.0f)); }
                    u32x4 w; w.x = cvt_pk_bf16(r[0], r[1]); w.y = cvt_pk_bf16(r[2], r[3]); w.z = cvt_pk_bf16(r[4], r[5]); w.w = cvt_pk_bf16(r[6], r[7]);
                    *(u32x4*)(MERGED + row * 1024 + col0 + bj * 128) = w; }
                asm volatile("" ::: "memory"); }
    }
};
struct EpiOut {
    static constexpr bool PERM = true, AFTER_DRAIN = false;
    const float* xin; float* xout; const float* g1;
    __device__ __forceinline__ void operator()(const AccT& acc, const pg8::Unit& u, int wr, int wc, int fr, int fq) const {
        const int row0 = u.pm * 256 + wr * 64 + fr; const int col0 = u.pn * 256 + wc * 32 + 8 * fq; const int b = u.pm >> 4;
        f32x4 gv[2][2];
#pragma unroll
        for (int bj = 0; bj < 2; ++bj)
#pragma unroll
            for (int n = 0; n < 2; ++n) gv[bj][n] = *(const f32x4*)(g1 + (size_t)b * 6144 + col0 + bj * 128 + 4 * n);
#pragma unroll
        for (int ai = 0; ai < 2; ++ai)
#pragma unroll
            for (int m = 0; m < 4; ++m) { const size_t off = (size_t)(row0 + ai * 128 + m * 16) * 1024 + col0;
#pragma unroll
                for (int bj = 0; bj < 2; ++bj)
#pragma unroll
                    for (int n = 0; n < 2; ++n) { const f32x4 xv = *(const f32x4*)(xin + off + bj * 128 + 4 * n);
                        *(f32x4*)(xout + off + bj * 128 + 4 * n) = (ABL == 7) ? xv : xv + gv[bj][n] * acc[ai][bj][m][n]; }
                asm volatile("" ::: "memory"); }
    }
};
struct EpiMoe1 {
    static constexpr bool PERM = true, AFTER_DRAIN = false;
    unsigned char* ACT; float os;
    __device__ __forceinline__ void operator()(const AccT& acc, const pg8::Unit& u, int wr, int wc, int fr, int fq) const {
        const int row0 = u.pm * 256 + wr * 64 + fr; const int col0 = u.pn * 128 + wc * 32 + 8 * fq;
#pragma unroll
        for (int ai = 0; ai < 2; ++ai)
#pragma unroll
            for (int m = 0; m < 4; ++m) { unsigned char* op = ACT + (size_t)(row0 + ai * 128 + m * 16) * 512 + col0; float r[8];
#pragma unroll
                for (int n = 0; n < 2; ++n)
#pragma unroll
                    for (int j = 0; j < 4; ++j) { const float a = acc[ai][0][m][n][j] * os, bb = acc[ai][1][m][n][j] * os; r[n * 4 + j] = a * sigmoidf_(a) * bb * 4.0f; }
                u32x2 w; w.x = (unsigned)__builtin_amdgcn_cvt_pk_fp8_f32(r[0], r[1], 0, false); w.x = (unsigned)__builtin_amdgcn_cvt_pk_fp8_f32(r[2], r[3], (int)w.x, true);
                w.y = (unsigned)__builtin_amdgcn_cvt_pk_fp8_f32(r[4], r[5], 0, false); w.y = (unsigned)__builtin_amdgcn_cvt_pk_fp8_f32(r[6], r[7], (int)w.y, true);
                *(u32x2*)op = w; }
    }
};
struct EpiPlain {
    static constexpr bool PERM = true, AFTER_DRAIN = false;
    bf16_t* O; int ldc; float os;
    __device__ __forceinline__ void operator()(const AccT& acc, const pg8::Unit& u, int wr, int wc, int fr, int fq) const {
        const int row0 = u.pm * 256 + wr * 64 + fr; const int col0 = u.pn * 256 + wc * 32 + 8 * fq;
#pragma unroll
        for (int ai = 0; ai < 2; ++ai)
#pragma unroll
            for (int m = 0; m < 4; ++m) { bf16_t* rowp = O + (size_t)(row0 + ai * 128 + m * 16) * ldc + col0;
#pragma unroll
                for (int bj = 0; bj < 2; ++bj) { const f32x4 v0 = acc[ai][bj][m][0] * os, v1 = acc[ai][bj][m][1] * os; u32x4 w;
                    w.x = cvt_pk_bf16(v0[0], v0[1]); w.y = cvt_pk_bf16(v0[2], v0[3]); w.z = cvt_pk_bf16(v1[0], v1[1]); w.w = cvt_pk_bf16(v1[2], v1[3]);
                    *(u32x4*)(rowp + bj * 128) = w; } }
    }
};
__device__ __forceinline__ int crow(int r, int hi) { return (r & 3) + 8 * (r >> 2) + 4 * hi; }
__device__ __forceinline__ float gelu_tanh(float x) { const float u2 = 2.0f * 0.7978845608028654f * (x + 0.044715f * x * x * x); return x * __builtin_amdgcn_rcpf(1.0f + __builtin_amdgcn_exp2f(-u2 * LOG2E)); }
struct EpiCmp {
    static constexpr bool PERM = true, AFTER_DRAIN = true;
    bf16_t* HID; const float* CB1; const bf16_t* CW2T; bf16_t* KC;
    __device__ __forceinline__ void fused(const AccT& acc, const pg8::Unit& u, int wr, int wc, int fr, int fq, int wid, int lane) const {
        const int kv = u.pm >> 4; const int row0 = u.pm * 256 + wr * 64 + fr; const int col0 = wc * 32 + 8 * fq;
        const float* bias = CB1 + kv * 256;
        f32x4 bv[2][2];
#pragma unroll
        for (int bj = 0; bj < 2; ++bj)
#pragma unroll
            for (int n = 0; n < 2; ++n) bv[bj][n] = *(const f32x4*)(bias + col0 + bj * 128 + 4 * n);
#pragma unroll
        for (int ai = 0; ai < 2; ++ai)
#pragma unroll
            for (int m = 0; m < 4; ++m) { bf16_t* rowp = HID + (size_t)(row0 + ai * 128 + m * 16) * 256 + col0;
#pragma unroll
                for (int bj = 0; bj < 2; ++bj) { const f32x4 v0 = acc[ai][bj][m][0] + bv[bj][0], v1 = acc[ai][bj][m][1] + bv[bj][1]; u32x4 w;
                    w.x = cvt_pk_bf16(gelu_tanh(v0[0]), gelu_tanh(v0[1])); w.y = cvt_pk_bf16(gelu_tanh(v0[2]), gelu_tanh(v0[3]));
                    w.z = cvt_pk_bf16(gelu_tanh(v1[0]), gelu_tanh(v1[1])); w.w = cvt_pk_bf16(gelu_tanh(v1[2]), gelu_tanh(v1[3]));
                    *(u32x4*)(rowp + bj * 128) = w; } }
        VM_WAIT(); __syncthreads();
        const int r32 = lane & 31, hi = lane >> 5;
        const bf16_t* ap = HID + (size_t)(u.pm * 256 + 32 * wid + r32) * 256 + hi * 8;
        const bf16_t* bp = CW2T + (size_t)kv * 64 * 256 + (size_t)r32 * 256 + hi * 8;
        f32x16 o0 = {}, o1 = {};
#pragma unroll 4
        for (int ks = 0; ks < 16; ++ks) {
            const bf16x8 a = *(const bf16x8*)(ap + ks * 16);
            const bf16x8 b0 = *(const bf16x8*)(bp + ks * 16), b1 = *(const bf16x8*)(bp + 32 * 256 + ks * 16);
            o0 = __builtin_amdgcn_mfma_f32_32x32x16_bf16(a, b0, o0, 0, 0, 0);
            o1 = __builtin_amdgcn_mfma_f32_32x32x16_bf16(a, b1, o1, 0, 0, 0);
        }
        bf16_t* kc = KC + (size_t)u.pm * 256 * 64;
#pragma unroll
        for (int r = 0; r < 16; ++r) { const int c = 32 * wid + crow(r, hi); const bool pad = (c == 255);
            kc[(size_t)c * 64 + r32] = pad ? (bf16_t)0 : (bf16_t)(cvt_pk_bf16(o0[r], 0.f) & 0xffffu);
            kc[(size_t)c * 64 + 32 + r32] = pad ? (bf16_t)0 : (bf16_t)(cvt_pk_bf16(o1[r], 0.f) & 0xffffu); }
    }
};

namespace att {
constexpr int L_KR = 0;
constexpr int L_VR = 24576;
constexpr int L_WSF = 49152;
constexpr int L_BKT = 51200;
constexpr int L_BKC = 55296;
constexpr int L_TBH = 64000;
constexpr int L_GSH = 64576;
constexpr int L_SEL = 67648;
constexpr int L_OTA = 68672;
constexpr int L_IMP = 101440;
constexpr int L_LUT = 117824;
constexpr int L_END = L_LUT + 40960;
static_assert(L_END <= LDS_MISC, "attention LDS map");

__device__ __forceinline__ void glds16(const void* gsrc, unsigned lds_dst) { unsigned keep;
    asm volatile("s_mov_b32 %0, m0\n\ts_mov_b32 m0, %2\n\ts_nop 0\n\tglobal_load_lds_dwordx4 %1, off\n\ts_mov_b32 m0, %0" : "=&s"(keep) : "v"(gsrc), "s"(lds_dst) : "memory"); }
__device__ __forceinline__ int bucket_of(int d) {
    if (d < 16) return d;
    int b = 16;
    b += (d >= 22); b += (d >= 30); b += (d >= 40); b += (d >= 54); b += (d >= 73); b += (d >= 99); b += (d >= 134); b += (d >= 182);
    b += (d >= 246); b += (d >= 332); b += (d >= 450); b += (d >= 609); b += (d >= 825); b += (d >= 1117); b += (d >= 1513);
    return b;
}
__device__ __forceinline__ void qkt(f32x16& p0, f32x16& p1, const LAS unsigned char* Kslot, const bf16x8 (&qr)[4], int r32, int hi) {
    const LAS unsigned char* kb = Kslot + hi * 1024 + r32 * 16;
    p0 = (f32x16){}; p1 = (f32x16){};
#pragma unroll
    for (int d0 = 0; d0 < 4; ++d0) {
        const bf16x8 b0 = *(const LAS bf16x8*)(kb + d0 * 2048);
        const bf16x8 b1 = *(const LAS bf16x8*)(kb + d0 * 2048 + 512);
        p0 = __builtin_amdgcn_mfma_f32_32x32x16_bf16(b0, qr[d0], p0, 0, 0, 0);
        p1 = __builtin_amdgcn_mfma_f32_32x32x16_bf16(b1, qr[d0], p1, 0, 0, 0);
    }
}
__device__ __forceinline__ void pv(f32x16 (&o)[2], int vb, bf16x8 pa0, bf16x8 pa1, bf16x8 pa2, bf16x8 pa3) {
#pragma unroll
    for (int d0 = 0; d0 < 2; ++d0) { s16x4 lo[4], hi[4];
#pragma unroll
        for (int ks = 0; ks < 4; ++ks) {
            asm volatile("ds_read_b64_tr_b16 %0,%1 offset:%c2" : "=&v"(lo[ks]) : "v"(vb), "i"(d0 * 4096 + ks * 1024) : "memory");
            asm volatile("ds_read_b64_tr_b16 %0,%1 offset:%c2" : "=&v"(hi[ks]) : "v"(vb), "i"(d0 * 4096 + ks * 1024 + 512) : "memory"); }
        asm volatile("s_waitcnt lgkmcnt(0)" ::: "memory"); __builtin_amdgcn_sched_barrier(0);
#define PK(k) (bf16x8){lo[k][0], lo[k][1], lo[k][2], lo[k][3], hi[k][0], hi[k][1], hi[k][2], hi[k][3]}
        o[d0] = __builtin_amdgcn_mfma_f32_32x32x16_bf16(pa0, PK(0), o[d0], 0, 0, 0);
        o[d0] = __builtin_amdgcn_mfma_f32_32x32x16_bf16(pa1, PK(1), o[d0], 0, 0, 0);
        o[d0] = __builtin_amdgcn_mfma_f32_32x32x16_bf16(pa2, PK(2), o[d0], 0, 0, 0);
        o[d0] = __builtin_amdgcn_mfma_f32_32x32x16_bf16(pa3, PK(3), o[d0], 0, 0, 0);
#undef PK
    }
}
__device__ __forceinline__ float xhalf_max(float v) { auto rr = __builtin_amdgcn_permlane32_swap(__float_as_uint(v), __float_as_uint(v), false, false); return __builtin_fmaxf(__uint_as_float(rr[0]), __uint_as_float(rr[1])); }
__device__ __forceinline__ float xhalf_sum(float v) { auto rr = __builtin_amdgcn_permlane32_swap(__float_as_uint(v), __float_as_uint(v), false, false); return __uint_as_float(rr[0]) + __uint_as_float(rr[1]); }

#define ATT_PACK(p0, p1, pw0, pw1, pw2, pw3) do { \
    pw0 = (u32x4){cvt_pk_bf16(p0[0], p0[1]), cvt_pk_bf16(p0[2], p0[3]), cvt_pk_bf16(p0[4], p0[5]), cvt_pk_bf16(p0[6], p0[7])}; \
    pw1 = (u32x4){cvt_pk_bf16(p0[8], p0[9]), cvt_pk_bf16(p0[10], p0[11]), cvt_pk_bf16(p0[12], p0[13]), cvt_pk_bf16(p0[14], p0[15])}; \
    pw2 = (u32x4){cvt_pk_bf16(p1[0], p1[1]), cvt_pk_bf16(p1[2], p1[3]), cvt_pk_bf16(p1[4], p1[5]), cvt_pk_bf16(p1[6], p1[7])}; \
    pw3 = (u32x4){cvt_pk_bf16(p1[8], p1[9]), cvt_pk_bf16(p1[10], p1[11]), cvt_pk_bf16(p1[12], p1[13]), cvt_pk_bf16(p1[14], p1[15])}; } while (0)

__device__ __forceinline__ void stage_rows(LAS unsigned char* lds, int wid, int lane, const f32x16 (&ot)[2]) {
    const int r32 = lane & 31, hi = lane >> 5;
    LAS bf16_t* stg = (LAS bf16_t*)(lds + L_OTA) + wid * 2048;
#pragma unroll
    for (int r = 0; r < 16; ++r) { const int orow = crow(r, hi);
#pragma unroll
        for (int d0 = 0; d0 < 2; ++d0) stg[orow * 64 + d0 * 32 + r32] = (bf16_t)(cvt_pk_bf16(ot[d0][r], 0.f) & 0xffffu); }
    LDS_WAIT();
}
struct StreamP { const bf16_t* Kb; const bf16_t* Vb; long pitch; int NT; const LAS unsigned char* tl; unsigned long long lanesel; int uq; const LAS float* lut; int xtop; int dclamp; };
typedef const LAS unsigned char* lds_cptr;
typedef short v4i16_t __attribute__((ext_vector_type(4)));
__device__ __forceinline__ void kload8(bf16x8* kf, lds_cptr kp) {
    kf[0] = *(const LAS bf16x8*)(kp);        kf[1] = *(const LAS bf16x8*)(kp + 512);
    kf[2] = *(const LAS bf16x8*)(kp + 2048); kf[3] = *(const LAS bf16x8*)(kp + 2560);
    kf[4] = *(const LAS bf16x8*)(kp + 4096); kf[5] = *(const LAS bf16x8*)(kp + 4608);
    kf[6] = *(const LAS bf16x8*)(kp + 6144); kf[7] = *(const LAS bf16x8*)(kp + 6656);
}
__device__ __forceinline__ void kload2(bf16x8* kf, lds_cptr kp, int j) { kf[2 * j] = *(const LAS bf16x8*)(kp + j * 2048); kf[2 * j + 1] = *(const LAS bf16x8*)(kp + j * 2048 + 512); }
__device__ __forceinline__ s16x4 vtr(lds_cptr p) { return __builtin_bit_cast(s16x4, __builtin_amdgcn_ds_read_tr16_b64_v4i16((LAS v4i16_t*)p)); }
constexpr int SLOTB = 8192;
#define ST_WAIT_BAR(N) asm volatile("s_waitcnt vmcnt(" #N ") lgkmcnt(0)\n\ts_barrier" ::: "memory")
template <int THRL>
__device__ __forceinline__ void attn_stream(LAS unsigned char* lds, const int wid, const int lane, const bf16x8 (&qr)[4], const StreamP S, float& mhat_o, float& l_o, f32x16 (&o)[2]) {
    const int r32 = lane & 31, hi = lane >> 5;
    const unsigned lds0 = (unsigned)(uintptr_t)lds;
    LAS float* wsf = (LAS float*)(lds + L_WSF) + wid * 64;
    const int NT = S.NT;
    const bf16_t* ksrc = S.Kb + (long)lane * S.pitch + wid * 8;
    const bf16_t* vsrc = S.Vb + (long)(16 * (wid & 3) + (lane >> 2)) * S.pitch + (wid >> 2) * 32 + (lane & 3) * 8;
    const unsigned kdst = lds0 + L_KR + wid * 1024, vdst = lds0 + L_VR + wid * 1024;
    const int tlv = (lane < NT) ? (int)S.tl[lane] : 0x80;
#define TLRAW(k) ((int)__builtin_amdgcn_readlane(tlv, __builtin_amdgcn_readfirstlane(k)))
#define DMA_K(k, slot) do { const int tr_ = TLRAW(k) & 63; glds16(ksrc + (long)tr_ * 64 * S.pitch, (unsigned)__builtin_amdgcn_readfirstlane(kdst + (slot))); } while (0)
#define DMA_V(k, slot) do { const int tr_ = TLRAW(k) & 63; glds16(vsrc + (long)tr_ * 64 * S.pitch, (unsigned)__builtin_amdgcn_readfirstlane(vdst + (slot))); } while (0)
    const lds_cptr kp0 = (lds_cptr)lds + L_KR + hi * 1024 + r32 * 16;
    const lds_cptr vp0 = (lds_cptr)lds + L_VR + ((lane >> 4) & 1) * 32 + (lane & 3) * 8 + (4 * hi + ((lane & 15) >> 2)) * 64;
    const int vb0 = (int)(lds0 + L_VR) + ((lane >> 4) & 1) * 32 + (lane & 3) * 8 + (4 * hi + ((lane & 15) >> 2)) * 64;
    bf16x8 kf[8];
#define LOFF(r) (((r) & 3) + 8 * ((r) >> 2))
#define LUTPTR(k, lp) do { const int raw_ = TLRAW(k); const int tj_ = raw_ & 63; int d0_ = S.uq - 64 * tj_ - 4 * hi; d0_ = d0_ < S.dclamp ? d0_ : S.dclamp; \
        const bool ok_ = (raw_ < 128) && (((S.lanesel >> tj_) & 1ull) != 0ull); lp = S.lut + (ok_ ? S.xtop - d0_ : S.xtop + 64); } while (0)
#define LUTLOAD(C0, C1, k) do { const int raw_ = TLRAW(k); const int tj_ = raw_ & 63; int d0_ = S.uq - 64 * tj_ - 4 * hi; d0_ = d0_ < S.dclamp ? d0_ : S.dclamp; \
        const bool ok_ = (raw_ < 128) && (((S.lanesel >> tj_) & 1ull) != 0ull); const LAS float* lp_ = S.lut + (ok_ ? S.xtop - d0_ : S.xtop + 64); \
        _Pragma("unroll") for (int r = 0; r < 16; ++r) { C0[r] = lp_[(r & 3) + 8 * (r >> 2)]; C1[r] = lp_[(r & 3) + 8 * (r >> 2) + 32]; } } while (0)
#define SBAR() __builtin_amdgcn_sched_barrier(0)
#define PIN(x) asm volatile("" : "+v"(x))
#define PKW(P, B) cvt_pk_bf16(P[B], P[B + 1])
#define PAF(k) __builtin_bit_cast(bf16x8, pw##k)
#define VFR(i) (bf16x8){vlo[i][0], vlo[i][1], vlo[i][2], vlo[i][3], vhi[i][0], vhi[i][1], vhi[i][2], vhi[i][3]}
#define MX3(a, b, c) __builtin_fmaxf(__builtin_fmaxf((a), (b)), (c))
#define MFMA32(a, b, c) __builtin_amdgcn_mfma_f32_32x32x16_bf16(a, b, c, 0, 0, 0)
#define GAPA(MF, A0, A1, A2, A3, W0, W1, PW) do { MF; sacc += A0; sacc += A1; sacc += A2; sacc += A3; PIN(sacc); W0; W1; PIN(PW); SBAR(); } while (0)
#define EX(v) __builtin_amdgcn_exp2f(v)
#define GAPB(MF, X, B, GN, PL, PO) do { MF; X[B] = EX(X[B]); X[B + 1] = EX(X[B + 1]); X[B + 2] = EX(X[B + 2]); X[B + 3] = EX(X[B + 3]); PIN(X); \
        if (GN) { PL[B] = lpn_[LOFF(B) + PO]; PL[B + 1] = lpn_[LOFF(B + 1) + PO]; PL[B + 2] = lpn_[LOFF(B + 2) + PO]; PL[B + 3] = lpn_[LOFF(B + 3) + PO]; } SBAR(); } while (0)
#define VRD(i) do { vlo[i] = vtr(vp_ + (((i) >> 2) * 4096 + ((i) & 3) * 1024)); vhi[i] = vtr(vp_ + (((i) >> 2) * 4096 + ((i) & 3) * 1024 + 512)); } while (0)
#define KRD(G, j) do { if (G) { kload2(kf, kp0 + sl_next, j); SBAR(); } } while (0)
#define ROT() do { sl_prev = sl_cur; sl_cur = sl_next; sl_next = (sl_next == 2 * SLOTB) ? 0 : sl_next + SLOTB; } while (0)
#define RESC() do { if (resc) { LDS_WAIT(); _Pragma("unroll") for (int d_ = 0; d_ < 2; ++d_) _Pragma("unroll") for (int r = 0; r < 16; ++r) o[d_][r] *= wsf[crow(r, hi)]; } } while (0)
#define ENDW(tt) do { if ((tt) + 3 < NT) { ST_WAIT_BAR(2); } else if ((tt) + 2 < NT) { ST_WAIT_BAR(1); } else { ST_WAIT_BAR(0); } } while (0)
#define STEP(C0, C1, P0, P1, t, GK, GV, GL, GN) do { SBAR(); \
    const lds_cptr vp_ = vp0 + sl_prev; const LAS float* lpn_ = S.lut; if (GN) { LUTPTR((t) + 1, lpn_); } \
    VRD(0); SBAR(); float sacc = (P0[0] + P0[1]); \
    GAPA(C0 = MFMA32(kf[0], qr[0], C0), P0[2], P0[3], P0[4], P0[5],     pw0[0] = PKW(P0, 0), pw0[1] = PKW(P0, 2), pw0); \
    VRD(4); SBAR(); GAPA(C1 = MFMA32(kf[1], qr[0], C1), P0[6], P0[7], P0[8], P0[9],     pw0[2] = PKW(P0, 4), pw0[3] = PKW(P0, 6), pw0); \
    VRD(1); SBAR(); GAPA(C0 = MFMA32(kf[2], qr[1], C0), P0[10], P0[11], P0[12], P0[13], pw1[0] = PKW(P0, 8), pw1[1] = PKW(P0, 10), pw1); \
    VRD(5); SBAR(); GAPA(C1 = MFMA32(kf[3], qr[1], C1), P0[14], P0[15], P1[0], P1[1],   pw1[2] = PKW(P0, 12), pw1[3] = PKW(P0, 14), pw1); \
    VRD(2); SBAR(); GAPA(C0 = MFMA32(kf[4], qr[2], C0), P1[2], P1[3], P1[4], P1[5],     pw2[0] = PKW(P1, 0), pw2[1] = PKW(P1, 2), pw2); \
    VRD(6); SBAR(); GAPA(C1 = MFMA32(kf[5], qr[2], C1), P1[6], P1[7], P1[8], P1[9],     pw2[2] = PKW(P1, 4), pw2[3] = PKW(P1, 6), pw2); \
    VRD(3); SBAR(); GAPA(C0 = MFMA32(kf[6], qr[3], C0), P1[10], P1[11], P1[12], P1[13], pw3[0] = PKW(P1, 8), pw3[1] = PKW(P1, 10), pw3); \
    VRD(7); SBAR(); GAPA(C1 = MFMA32(kf[7], qr[3], C1), P1[14], P1[15], 0.f, 0.f,       pw3[2] = PKW(P1, 12), pw3[3] = PKW(P1, 14), pw3); \
    l_reg += sacc; \
    if (GK) { DMA_K((t) + 3, sl_cur); } if (GV) { DMA_V((t) + 1, sl_next); } \
    { _Pragma("unroll") for (int r = 0; r < 16; ++r) { C0[r] -= mhat; C1[r] -= mhat; } \
      float a_ = MX3(C0[0], C0[1], C1[0]), b_ = MX3(C0[2], C0[3], C1[1]); a_ = MX3(a_, C1[2], C1[3]); \
      _Pragma("unroll") for (int r = 4; r < 16; r += 4) { a_ = MX3(a_, C0[r], C0[r + 1]); b_ = MX3(b_, C0[r + 2], C0[r + 3]); a_ = MX3(a_, C1[r], C1[r + 1]); b_ = MX3(b_, C1[r + 2], C1[r + 3]); } \
      float rm = xhalf_max(__builtin_fmaxf(a_, b_)); \
      resc = false; \
      if (__builtin_expect(__any(rm > (float)THRL), 0)) { const float dl = __builtin_fmaxf(rm, 0.f); mhat += dl; \
        _Pragma("unroll") for (int r = 0; r < 16; ++r) { C0[r] -= dl; C1[r] -= dl; } \
        const float f = __builtin_amdgcn_exp2f(-dl); l_reg *= f; if (hi == 0) wsf[r32] = f; resc = true; } } \
    SBAR(); \
    GAPB(o[0] = MFMA32(PAF(0), VFR(0), o[0]), C0, 0, GN, P0, 0); \
    GAPB(o[1] = MFMA32(PAF(0), VFR(4), o[1]), C0, 4, GN, P0, 0); \
    KRD(GL, 0); GAPB(o[0] = MFMA32(PAF(1), VFR(1), o[0]), C0, 8, GN, P0, 0); \
    KRD(GL, 1); GAPB(o[1] = MFMA32(PAF(1), VFR(5), o[1]), C0, 12, GN, P0, 0); \
    KRD(GL, 2); GAPB(o[0] = MFMA32(PAF(2), VFR(2), o[0]), C1, 0, GN, P1, 32); \
    KRD(GL, 3); GAPB(o[1] = MFMA32(PAF(2), VFR(6), o[1]), C1, 4, GN, P1, 32); \
    GAPB(o[0] = MFMA32(PAF(3), VFR(3), o[0]), C1, 8, GN, P1, 32); \
    GAPB(o[1] = MFMA32(PAF(3), VFR(7), o[1]), C1, 12, GN, P1, 32); \
    } while (0)
    float mhat = 0.f, l_reg = 0.f; bool resc = false;
    o[0] = (f32x16){}; o[1] = (f32x16){};
    f32x16 pA0, pA1, pB0, pB1;
    int sl_prev = 0, sl_cur = 0, sl_next = SLOTB;
    DMA_K(0, 0); DMA_V(0, 0); DMA_K(1, SLOTB); DMA_K(2, 2 * SLOTB);
    LUTLOAD(pA0, pA1, 0);
    ST_WAIT_BAR(3);
    { const lds_cptr kb = kp0;
#pragma unroll
      for (int d0 = 0; d0 < 4; ++d0) { const bf16x8 b0 = *(const LAS bf16x8*)(kb + d0 * 2048); const bf16x8 b1 = *(const LAS bf16x8*)(kb + d0 * 2048 + 512);
          pA0 = MFMA32(b0, qr[d0], pA0); pA1 = MFMA32(b1, qr[d0], pA1); }
      float rm = pA0[0];
#pragma unroll
      for (int r = 1; r < 16; ++r) rm = __builtin_fmaxf(rm, pA0[r]);
#pragma unroll
      for (int r = 0; r < 16; ++r) rm = __builtin_fmaxf(rm, pA1[r]);
      rm = xhalf_max(rm);
      mhat = (rm == -INFINITY) ? 0.f : rm;
#pragma unroll
      for (int r = 0; r < 16; ++r) { pA0[r] = EX(pA0[r] - mhat); pA1[r] = EX(pA1[r] - mhat); } }
    ST_WAIT_BAR(0);
    DMA_K(3, 0); DMA_V(1, SLOTB);
    ROT();
    kload8(kf, kp0 + sl_cur);
    LUTLOAD(pB0, pB1, 1);
    ST_WAIT_BAR(2);
    s16x4 vlo[8], vhi[8]; u32x4 pw0, pw1, pw2, pw3;
    int t = 1;
    for (; t + 5 < NT; t += 2) {
        STEP(pB0, pB1, pA0, pA1, t, true, true, true, true);     ST_WAIT_BAR(2); RESC(); ROT();
        STEP(pA0, pA1, pB0, pB1, t + 1, true, true, true, true); ST_WAIT_BAR(2); RESC(); ROT();
    }
    for (; t + 1 < NT; t += 2) {
        STEP(pB0, pB1, pA0, pA1, t, (t + 3 < NT), (t + 1 < NT), (t + 1 < NT), true);       ENDW(t);     RESC(); ROT();
        STEP(pA0, pA1, pB0, pB1, t + 1, (t + 4 < NT), (t + 2 < NT), (t + 2 < NT), true);   ENDW(t + 1); RESC(); ROT();
    }
    STEP(pB0, pB1, pA0, pA1, NT - 1, false, false, false, false); RESC();
    { float sacc = pB0[0] + pB0[1];
#pragma unroll
      for (int r = 2; r < 16; ++r) sacc += pB0[r];
#pragma unroll
      for (int r = 0; r < 16; ++r) sacc += pB1[r];
      l_reg += sacc;
      ATT_PACK(pB0, pB1, pw0, pw1, pw2, pw3);
      SBAR(); pv(o, vb0 + sl_cur, PAF(0), PAF(1), PAF(2), PAF(3)); }
    asm volatile("s_waitcnt lgkmcnt(0)\n\ts_barrier" ::: "memory");
    mhat_o = mhat; l_o = l_reg;
#undef TLRAW
#undef DMA_K
#undef DMA_V
#undef LUTLOAD
#undef LUTPTR
#undef LOFF
#undef SBAR
#undef PIN
#undef PKW
#undef PAF
#undef VFR
#undef MX3
#undef MFMA32
#undef GAPA
#undef EX
#undef GAPB
#undef VRD
#undef KRD
#undef ROT
#undef RESC
#undef ENDW
#undef STEP
}
__device__ __forceinline__ void cmp_scores(f32x16& s0, f32x16& s1, LAS unsigned char* lds, const LAS unsigned char* bkc, const LAS unsigned char* tb, const bf16x8 (&qr)[4], const int k, const int r32, const int hi) {
#pragma unroll
    for (int r = 0; r < 16; ++r) { const int off = 16 * ((r & 3) + 8 * (r >> 2));
        s0[r] = *(const LAS float*)(tb + bkc[1024 * k + off]); s1[r] = *(const LAS float*)(tb + bkc[1024 * k + off + 512]); }
    const LAS unsigned char* kb = lds + k * 8192 + hi * 1024 + r32 * 16;
#pragma unroll
    for (int d0 = 0; d0 < 4; ++d0) { const bf16x8 b0 = *(const LAS bf16x8*)(kb + d0 * 2048); const bf16x8 b1 = *(const LAS bf16x8*)(kb + d0 * 2048 + 512);
        s0 = __builtin_amdgcn_mfma_f32_32x32x16_bf16(b0, qr[d0], s0, 0, 0, 0); s1 = __builtin_amdgcn_mfma_f32_32x32x16_bf16(b1, qr[d0], s1, 0, 0, 0); }
}
__device__ __forceinline__ float xhalf_other(float v, int hi) { auto rr = __builtin_amdgcn_permlane32_swap(__float_as_uint(v), __float_as_uint(v), false, false); return __uint_as_float(hi ? rr[0] : rr[1]); }
__device__ __forceinline__ void cmp_issue(LAS unsigned char* lds, const int wid, const int lane, const bf16_t* Kb, const bf16_t* Vb, const int nt) {
    const unsigned lds0 = (unsigned)(uintptr_t)lds;
    { const bf16_t* ksrc = Kb + (long)lane * 64 + wid * 8; const bf16_t* vsrc = Vb + (long)(16 * (wid & 3) + (lane >> 2)) * 64 + (wid >> 2) * 32 + (lane & 3) * 8;
      for (int k = 0; k < nt; ++k) { glds16(ksrc + (long)k * 4096, (unsigned)__builtin_amdgcn_readfirstlane(lds0 + k * 8192 + wid * 1024));
                                     glds16(vsrc + (long)k * 4096, (unsigned)__builtin_amdgcn_readfirstlane(lds0 + L_OTA + k * 8192 + wid * 1024)); } }
}
__device__ __forceinline__ void cmp_branch(LAS unsigned char* lds, const int wid, const int lane, const bf16x8 (&qr)[4], const int nt, const int t, f32x16 (&o)[2]) {
    const int r32 = lane & 31, hi = lane >> 5, g = wid >> 1, tq = (wid & 1) * 32 + r32;
    const unsigned lds0 = (unsigned)(uintptr_t)lds;
    const LAS unsigned char* bkc = lds + L_BKC + (4126 - t + 64 * hi);
    const LAS unsigned char* tb = lds + L_TBH + g * 144;
    asm volatile("s_waitcnt vmcnt(0) lgkmcnt(0)\n\ts_barrier" ::: "memory");
    float m = -INFINITY, l = 0.f;
#pragma clang loop unroll(disable)
    for (int k = 0; k < nt; ++k) { f32x16 s0, s1; cmp_scores(s0, s1, lds, bkc, tb, qr, k, r32, hi);
        float rm = s0[0];
#pragma unroll
        for (int r = 1; r < 16; ++r) rm = __builtin_fmaxf(rm, s0[r]);
#pragma unroll
        for (int r = 0; r < 16; ++r) rm = __builtin_fmaxf(rm, s1[r]);
        rm = xhalf_max(rm);
        const float mn = __builtin_fmaxf(m, rm), ms = (mn == -INFINITY) ? 0.f : mn;
        float ps = 0.f;
#pragma unroll
        for (int r = 0; r < 16; ++r) ps += __builtin_amdgcn_exp2f(s0[r] - ms) + __builtin_amdgcn_exp2f(s1[r] - ms);
        l = l * __builtin_amdgcn_exp2f(m - ms) + ps; m = mn; }
    l = xhalf_sum(l);
    const float msafe = (m == -INFINITY) ? 0.f : m, inv = l > 0.f ? 1.0f / l : 0.f;
    float I[4][8]; float pc7 = 0.f;
    o[0] = (f32x16){}; o[1] = (f32x16){};
    const int vb0 = (int)(lds0 + L_OTA) + ((lane >> 4) & 1) * 32 + (lane & 3) * 8 + (4 * hi + ((lane & 15) >> 2)) * 64;
#pragma unroll
    for (int k = 0; k < 4; ++k) {
        if (k < nt) { f32x16 s0, s1; cmp_scores(s0, s1, lds, bkc, tb, qr, k, r32, hi);
#pragma unroll
            for (int r = 0; r < 16; ++r) { s0[r] = __builtin_amdgcn_exp2f(s0[r] - msafe) * inv; s1[r] = __builtin_amdgcn_exp2f(s1[r] - msafe) * inv; }
            float pc[8];
#pragma unroll
            for (int q = 0; q < 4; ++q) { I[k][q] = 2.0f * (s0[4 * q] + s0[4 * q + 1] + s0[4 * q + 2]) + s0[4 * q + 3]; I[k][4 + q] = 2.0f * (s1[4 * q] + s1[4 * q + 1] + s1[4 * q + 2]) + s1[4 * q + 3];
                pc[q] = xhalf_other(s0[4 * q + 3], hi); pc[4 + q] = xhalf_other(s1[4 * q + 3], hi); }
#pragma unroll
            for (int j = 0; j < 8; ++j) I[k][j] += hi ? pc[j] : (j > 0 ? pc[j - 1] : pc7);
            pc7 = pc[7];
            u32x4 pw0, pw1, pw2, pw3; ATT_PACK(s0, s1, pw0, pw1, pw2, pw3);
            pv(o, vb0 + k * 8192, __builtin_bit_cast(bf16x8, pw0), __builtin_bit_cast(bf16x8, pw1), __builtin_bit_cast(bf16x8, pw2), __builtin_bit_cast(bf16x8, pw3));
        } else {
#pragma unroll
            for (int j = 0; j < 8; ++j) I[k][j] = 0.f;
        }
    }
    LAS float* imp = (LAS float*)(lds + L_IMP) + tq * 64 + hi;
#pragma unroll 1
    for (int gi = 0; gi < 4; ++gi) {
        if (g == gi) {
#pragma unroll
            for (int k = 0; k < 4; ++k) if (k < nt) {
#pragma unroll
                for (int j = 0; j < 8; ++j) __builtin_amdgcn_ds_faddf(imp + 16 * k + 2 * j, I[k][j], 0, 0, false);
            }
        }
        asm volatile("s_waitcnt lgkmcnt(0)\n\ts_barrier" ::: "memory");
    }
}
}

struct Ctx { int tid, lane, wave, vcu, G, bx; LAS unsigned char* lds; };

struct TrD { const float* src; size_t ldw; int nvalid; bf16_t* dst; size_t ldk; float fp8s; };
__device__ __forceinline__ void tr_load(const TrD& d, float (&v)[32], int lane) {
    const int n = lane & 31; const float* src = d.src + (size_t)(lane >> 5) * d.ldw + n;
#pragma unroll
    for (int i = 0; i < 32; ++i) v[i] = (n < d.nvalid) ? src[(size_t)(2 * i) * d.ldw] : 0.f;
}
__device__ __forceinline__ void tr_store(const TrD& d, const float (&v)[32], LAS float* scr, int lane) {
    const int n = lane & 31;
#pragma unroll
    for (int i = 0; i < 32; ++i) scr[(2 * i + (lane >> 5)) * 33 + n] = v[i];
    LDS_WAIT(); asm volatile("" ::: "memory");
    const int c = lane & 7;
#pragma unroll
    for (int j = 0; j < 4; ++j) { const int nn = (lane >> 3) + 8 * j; const LAS float* s = scr + (8 * c) * 33 + nn;
        if (d.fp8s != 0.f) { const float f = d.fp8s; u32x2 o;
            o.x = (unsigned)__builtin_amdgcn_cvt_pk_fp8_f32(s[0 * 33] * f, s[1 * 33] * f, 0, false); o.x = (unsigned)__builtin_amdgcn_cvt_pk_fp8_f32(s[2 * 33] * f, s[3 * 33] * f, (int)o.x, true);
            o.y = (unsigned)__builtin_amdgcn_cvt_pk_fp8_f32(s[4 * 33] * f, s[5 * 33] * f, 0, false); o.y = (unsigned)__builtin_amdgcn_cvt_pk_fp8_f32(s[6 * 33] * f, s[7 * 33] * f, (int)o.y, true);
            *(u32x2*)((unsigned char*)d.dst + (size_t)nn * d.ldk + 8 * c) = o;
        } else {
        u32x4 o; o.x = cvt_pk_bf16(s[0 * 33], s[1 * 33]); o.y = cvt_pk_bf16(s[2 * 33], s[3 * 33]); o.z = cvt_pk_bf16(s[4 * 33], s[5 * 33]); o.w = cvt_pk_bf16(s[6 * 33], s[7 * 33]);
        *(u32x4*)(d.dst + (size_t)nn * d.ldk + 8 * c) = o; } }
    LDS_WAIT(); asm volatile("" ::: "memory");
}
__device__ __forceinline__ TrD mk_trd(const float* W, size_t ldw, int srccol, int nvalid, bf16_t* WT, size_t ldk, int dstrow, int k0) {
    TrD d; d.src = W + (size_t)k0 * ldw + srccol; d.ldw = ldw; d.nvalid = nvalid; d.dst = WT + (size_t)dstrow * ldk + k0; d.ldk = ldk; d.fp8s = 0.f; return d; }
__device__ __forceinline__ TrD mk_trd8(const float* W, size_t ldw, int srccol, int nvalid, unsigned char* WT8, size_t ldk, int dstrow, int k0, float scale) {
    TrD d; d.src = W + (size_t)k0 * ldw + srccol; d.ldw = ldw; d.nvalid = nvalid; d.dst = (bf16_t*)(WT8 + (size_t)dstrow * ldk + k0); d.ldk = ldk; d.fp8s = scale; return d; }
__device__ __forceinline__ TrD dec_small(const Args& a, int it) {
    constexpr int I_WIN = 184 * 16, I_CW1 = 2 * 8 * 32, I_WUN = 32 * 8, I_WUD = 32 * 4, I_WO = 32 * 16, I_CW2 = 2 * 2 * 4;
    constexpr int PER = I_WIN + I_CW1 + I_WUN + I_WUD + I_WO + I_CW2;
    unsigned char* ws = a.ws;
    const int l = it / PER; int r = it % PER;
    if (r < I_WIN) { const int nb = r / 16, kb = r % 16; const int nd = 32 * nb; int src, nv = 32;
        if (nd < 1280) src = nd; else if (nd < 5632) src = nd + 24; else if (nd == 5632) { src = 1280; nv = 24; } else { src = 0; nv = 0; }
        return mk_trd8(a.w_in + (size_t)l * DM * INW, INW, src, nv, (unsigned char*)(ws + WS_WINT) + (size_t)l * NIN * DM, DM, nd, 64 * kb, 256.0f); }
    r -= I_WIN;
    if (r < I_CW1) { const int kv = r / 256, q = r % 256, nb = q / 32, kb = q % 32;
        return mk_trd(a.cmp_w1 + (size_t)(l * 2 + kv) * 2048 * 256, 256, 32 * nb, 32, (bf16_t*)(ws + WS_CW1T) + (size_t)(l * 2 + kv) * 256 * 2048, 2048, 32 * nb, 64 * kb); }
    r -= I_CW1;
    if (r < I_WUN) { const int nb = r / 8, kb = r % 8;
        return mk_trd(a.w_up_nsa + (size_t)l * 512 * 1024, 1024, 32 * nb, 32, (bf16_t*)(ws + WS_WUNT) + (size_t)l * 1024 * 512, 512, 32 * nb, 64 * kb); }
    r -= I_WUN;
    if (r < I_WUD) { const int nb = r / 4, kb = r % 4;
        return mk_trd(a.w_up_dil + (size_t)l * 256 * 1024, 1024, 32 * nb, 32, (bf16_t*)(ws + WS_WUDT) + (size_t)l * 1024 * 256, 256, 32 * nb, 64 * kb); }
    r -= I_WUD;
    if (r < I_WO) { const int nb = r / 16, kb = r % 16;
        return mk_trd(a.w_o + (size_t)l * 1024 * 1024, 1024, 32 * nb, 32, (bf16_t*)(ws + WS_WOT) + (size_t)l * 1024 * 1024, 1024, 32 * nb, 64 * kb); }
    r -= I_WO;
    { const int kv = r / 8, q = r % 8, nb = q / 4, kb = q % 4;
        return mk_trd(a.cmp_w2 + (size_t)(l * 2 + kv) * 256 * 64, 64, 32 * nb, 32, (bf16_t*)(ws + WS_CW2T) + (size_t)(l * 2 + kv) * 64 * 256, 256, 32 * nb, 64 * kb); }
}
__device__ __forceinline__ TrD dec_expert(const Args& a, int l, int it) {
    constexpr int I_13 = 32 * 16, I_2 = 32 * 8, PER = I_13 + I_2;
    unsigned char* ws = a.ws;
    const int e = it / PER; int r = it % PER;
    if (r < I_13) { const int nb = r / 16, kb = r % 16; const int r0 = 32 * nb, pn = r0 >> 8, bj = (r0 >> 7) & 1, j0 = r0 & 127;
        const float* src = (bj ? a.exp_w3 : a.exp_w1) + (size_t)(l * 32 + e) * 1024 * 512;
        return mk_trd8(src, 512, pn * 128 + j0, 32, (unsigned char*)(ws + WS_E13T) + (size_t)e * 1024 * 1024, 1024, r0, 64 * kb, 256.0f); }
    r -= I_13;
    { const int nb = r / 8, kb = r % 8;
        return mk_trd8(a.exp_w2 + (size_t)(l * 32 + e) * 512 * 1024, 1024, 32 * nb, 32, (unsigned char*)(ws + WS_E2T) + (size_t)e * 1024 * 512, 512, 32 * nb, 64 * kb, 256.0f); }
}
template <int KIND> __device__ __forceinline__ void conv_items(const Args& a, const Ctx& C, int l, int first, int nitems, LAS float* scr) {
    const int NGW = C.G * NWAVES;
    float va[32], vb[32]; TrD d0, d1;
    int it = first;
    if (it >= nitems) return;
    d0 = KIND ? dec_expert(a, l, it) : dec_small(a, it); tr_load(d0, va, C.lane);
    for (;;) {
        const int itn = it + NGW; const bool hn = itn < nitems;
        if (hn) { d1 = KIND ? dec_expert(a, l, itn) : dec_small(a, itn); tr_load(d1, vb, C.lane); }
        tr_store(d0, va, scr, C.lane);
        if (!hn) break;
        const int itnn = itn + NGW; const bool hnn = itnn < nitems;
        if (hnn) { d0 = KIND ? dec_expert(a, l, itnn) : dec_small(a, itnn); tr_load(d0, va, C.lane); }
        tr_store(d1, vb, scr, C.lane);
        if (!hnn) break;
        it = itnn;
    }
}
__device__ __forceinline__ void conv_small(const Args& a, const Ctx& C) { conv_items<0>(a, C, 0, C.vcu * NWAVES + C.wave, 2 * 4368, (LAS float*)(C.lds + C.wave * 16384)); }
__device__ __forceinline__ void conv_experts_slice(const Args& a, const Ctx& C, int l, int q) {
    const int NGW = C.G * NWAVES; const int per = 3 * NGW;
    LAS float* scr = (LAS float*)(C.lds + (C.wave < 5 ? C.wave * 8448 : att::L_OTA + (C.wave - 5) * 8448));
    const int lo = q * per, hi = (q == 3) ? 32 * 768 : ((q + 1) * per < 32 * 768 ? (q + 1) * per : 32 * 768);
    if (lo < hi) conv_items<1>(a, C, l, lo + C.vcu * NWAVES + C.wave, hi, scr);
}
__device__ __forceinline__ void prologue_vectors(const Args& a, const Ctx& C) {
    LAS float* sl = (LAS float*)(C.lds);
    LAS float* part = (LAS float*)(C.lds + 32768);
    for (int i = C.tid; i < 8 * 1024; i += NTHR) { const float v = a.c[i]; sl[i] = v * sigmoidf_(v); }
    __syncthreads();
    float* MOD = (float*)(a.ws + WS_MOD); float* CB1 = (float*)(a.ws + WS_CB1);
    for (int it = C.vcu; it < 192 + 16; it += C.G) {
        float acc[8];
#pragma unroll
        for (int b = 0; b < 8; ++b) acc[b] = 0.f;
        if (it < 192) { const int l = it / 96, col = (it % 96) * 64 + C.lane;
            const float* w = a.ada_w + (size_t)l * 1024 * 6144 + col;
            for (int k0 = 128 * C.wave; k0 < 128 * C.wave + 128; k0 += 32) { float wv[32];
#pragma unroll
                for (int j = 0; j < 32; ++j) wv[j] = w[(size_t)(k0 + j) * 6144];
#pragma unroll
                for (int j = 0; j < 32; ++j)
#pragma unroll
                    for (int b = 0; b < 8; ++b) acc[b] += sl[b * 1024 + k0 + j] * wv[j]; }
        } else { const int q = it - 192, lk = q / 4, col = (q % 4) * 64 + C.lane;
            const float* w = a.cmp_w1 + (size_t)lk * 2048 * 256 + col; const float* pos = a.cmp_pos + (size_t)lk * 2048;
            for (int k0 = 256 * C.wave; k0 < 256 * C.wave + 256; k0 += 32) { float wv[32];
#pragma unroll
                for (int j = 0; j < 32; ++j) wv[j] = w[(size_t)(k0 + j) * 256];
#pragma unroll
                for (int j = 0; j < 32; ++j) acc[0] += pos[k0 + j] * wv[j]; }
        }
        __syncthreads();
#pragma unroll
        for (int b = 0; b < 8; ++b) part[(C.wave * 8 + b) * 64 + C.lane] = acc[b];
        __syncthreads();
        if (C.wave == 0) {
            float tot[8];
#pragma unroll
            for (int b = 0; b < 8; ++b) { float t2 = 0.f;
#pragma unroll
                for (int w = 0; w < 8; ++w) t2 += part[(w * 8 + b) * 64 + C.lane];
                tot[b] = t2; }
            if (it < 192) { const int l = it / 96, col = (it % 96) * 64 + C.lane; const float bias = a.ada_b[l * 6144 + col];
#pragma unroll
                for (int b = 0; b < 8; ++b) MOD[(size_t)(l * 8 + b) * 6144 + col] = tot[b] + bias;
            } else { const int q = it - 192, lk = q / 4, col = (q % 4) * 64 + C.lane; CB1[lk * 256 + col] = tot[0]; }
        }
    }
    __syncthreads();
}

__device__ __forceinline__ void moe_combine_row(const Args& a, int row, int lane, const float* g2  , f32x4 (&v)[4]) {
    const u32x4 rec = *(const u32x4*)(a.ws + WS_DEST + (size_t)row * 16);
    const bf16_t* Y = (const bf16_t*)(a.ws + WS_XS);
    const float w0 = (ABL == 6) ? 0.f : __uint_as_float(rec.z), w1 = (ABL == 6) ? 0.f : __uint_as_float(rec.w);
    const u32x2* y0 = (const u32x2*)(Y + (size_t)rec.x * 1024) + lane; const u32x2* y1 = (const u32x2*)(Y + (size_t)rec.y * 1024) + lane;
#pragma unroll
    for (int j = 0; j < 4; ++j) { const u32x2 p = y0[64 * j], q = y1[64 * j]; const f32x4 gg = *((const f32x4*)g2 + lane + 64 * j);
        v[j][0] += gg[0] * (w0 * bf_lo(p.x) + w1 * bf_lo(q.x)); v[j][1] += gg[1] * (w0 * bf_hi(p.x) + w1 * bf_hi(q.x));
        v[j][2] += gg[2] * (w0 * bf_lo(p.y) + w1 * bf_lo(q.y)); v[j][3] += gg[3] * (w0 * bf_hi(p.y) + w1 * bf_hi(q.y)); }
}
__device__ __forceinline__ void norm1_phase(const Args& a, const Ctx& C, int l) {
    const int gw = C.vcu * NWAVES + C.wave, NGW = C.G * NWAVES;
    const float* MOD = (const float*)(a.ws + WS_MOD); bf16_t* H = (bf16_t*)(a.ws + WS_H);
    const float* nw = a.norm1 + l * 1024;
    for (int row = gw; row < T; row += NGW) {
        const int b = row >> 12; const float* xr = (l == 0 ? a.x : (const float*)a.out) + (size_t)row * 1024;
        f32x4 v[4];
#pragma unroll
        for (int j = 0; j < 4; ++j) v[j] = *((const f32x4*)xr + C.lane + 64 * j);
        if (l == 1) { moe_combine_row(a, row, C.lane, MOD + (size_t)(0 * 8 + b) * 6144 + 5120, v);
#pragma unroll
            for (int j = 0; j < 4; ++j) *((f32x4*)(a.out + (size_t)row * 1024) + C.lane + 64 * j) = v[j]; }
        float ss = 0.f;
#pragma unroll
        for (int j = 0; j < 4; ++j) ss += (v[j][0] * v[j][0] + v[j][1] * v[j][1]) + (v[j][2] * v[j][2] + v[j][3] * v[j][3]);
        const float rstd = 1.0f / sqrtf(wave_sum(ss) * (1.0f / 1024.0f) + RMS_EPS);
        const float* mb = MOD + (size_t)(l * 8 + b) * 6144;
#pragma unroll
        for (int j = 0; j < 4; ++j) { const f32x4 g = *((const f32x4*)nw + C.lane + 64 * j), sh = *((const f32x4*)mb + C.lane + 64 * j), sc = *((const f32x4*)(mb + 1024) + C.lane + 64 * j);
            const f32x4 h = (v[j] * rstd * g * (sc + 1.0f) + sh) * 8.0f; unsigned w = (unsigned)__builtin_amdgcn_cvt_pk_fp8_f32(h[0], h[1], 0, false); w = (unsigned)__builtin_amdgcn_cvt_pk_fp8_f32(h[2], h[3], (int)w, true);
            *((unsigned*)((unsigned char*)H + (size_t)row * 1024) + C.lane + 64 * j) = w; }
    }
}
__device__ __forceinline__ void final_phase(const Args& a, const Ctx& C) {
    const int gw = C.vcu * NWAVES + C.wave, NGW = C.G * NWAVES;
    const float* MOD = (const float*)(a.ws + WS_MOD);
    for (int row = gw; row < T; row += NGW) {
        const int b = row >> 12; float* xr = a.out + (size_t)row * 1024;
        f32x4 v[4];
#pragma unroll
        for (int j = 0; j < 4; ++j) v[j] = *((const f32x4*)xr + C.lane + 64 * j);
        moe_combine_row(a, row, C.lane, MOD + (size_t)(1 * 8 + b) * 6144 + 5120, v);
        float ss = 0.f;
#pragma unroll
        for (int j = 0; j < 4; ++j) ss += (v[j][0] * v[j][0] + v[j][1] * v[j][1]) + (v[j][2] * v[j][2] + v[j][3] * v[j][3]);
        const float rstd = 1.0f / sqrtf(wave_sum(ss) * (1.0f / 1024.0f) + RMS_EPS);
#pragma unroll
        for (int j = 0; j < 4; ++j) { const f32x4 g = *((const f32x4*)a.norm_f + C.lane + 64 * j); *((f32x4*)xr + C.lane + 64 * j) = v[j] * rstd * g; }
    }
}
typedef float f32x4v __attribute__((ext_vector_type(4)));
__device__ __forceinline__ void norm2_router_phase(const Args& a, const Ctx& C, int l) {
    constexpr int RP = 2064;
    LAS unsigned char* HH = C.lds; LAS unsigned char* HL = C.lds + 16 * RP;
    LAS float* PART = (LAS float*)(C.lds + 2 * 16 * RP);
    LAS float* LOGI = PART + 8 * 16 * 48;
    LAS int* wcnt = (LAS int*)(C.lds + LDS_MISC + 256);
    const float* wg = a.router_wg + (size_t)l * 1024 * 4; const float* we = a.router_we + (size_t)l * 1024 * 32;
    const int lane = C.lane, wave = C.wave, fr = lane & 15, fq = lane >> 4;
    bf16x8 Wh[4][3], Wl[4][3];
#pragma unroll
    for (int ks = 0; ks < 4; ++ks)
#pragma unroll
        for (int ct = 0; ct < 3; ++ct) { const int cc = 16 * ct + fr; const int k0 = 128 * wave + 32 * ks + 8 * fq; unsigned hw[4], lw[4];
#pragma unroll
            for (int i = 0; i < 8; i += 2) { float v0 = 0.f, v1 = 0.f;
                if (cc < 4) { v0 = wg[(size_t)(k0 + i) * 4 + cc]; v1 = wg[(size_t)(k0 + i + 1) * 4 + cc]; }
                else if (cc < 36) { v0 = we[(size_t)(k0 + i) * 32 + cc - 4]; v1 = we[(size_t)(k0 + i + 1) * 32 + cc - 4]; }
                const unsigned hp = cvt_pk_bf16(v0, v1); hw[i >> 1] = hp; lw[i >> 1] = cvt_pk_bf16(v0 - bf_lo(hp), v1 - bf_hi(hp)); }
            Wh[ks][ct] = __builtin_bit_cast(bf16x8, (u32x4){hw[0], hw[1], hw[2], hw[3]}); Wl[ks][ct] = __builtin_bit_cast(bf16x8, (u32x4){lw[0], lw[1], lw[2], lw[3]}); }
    const float* MOD = (const float*)(a.ws + WS_MOD); bf16_t* H2 = (bf16_t*)(a.ws + WS_H2);
    const float* nw = a.norm2 + l * 1024; const float* bg = a.router_bg + l * 4; const float* be = a.router_be + l * 32;
    int* CNTBLK = (int*)(a.ws + WS_CNTBLK);
    for (int ch = C.vcu; ch < T / 128; ch += C.G) {
        int my_e0 = 0, my_e1 = 0; float my_w0 = 0.f, my_w1 = 0.f;
#pragma clang loop unroll(disable)
        for (int gi = 0; gi < 8; ++gi) {
            { const int row0 = ch * 128 + gi * 16 + 2 * wave; const int b = row0 >> 12;
              f32x4 v[2][4];
#pragma unroll
              for (int rr = 0; rr < 2; ++rr)
#pragma unroll
                  for (int q = 0; q < 4; ++q) v[rr][q] = *((const f32x4*)(a.out + (size_t)(row0 + rr) * 1024) + lane + 64 * q);
              const float* mb = MOD + (size_t)(l * 8 + b) * 6144 + 3072;
#pragma unroll
              for (int rr = 0; rr < 2; ++rr) { float ss = 0.f;
#pragma unroll
                  for (int q = 0; q < 4; ++q) ss += (v[rr][q][0] * v[rr][q][0] + v[rr][q][1] * v[rr][q][1]) + (v[rr][q][2] * v[rr][q][2] + v[rr][q][3] * v[rr][q][3]);
                  const float rstd = 1.0f / sqrtf(wave_sum(ss) * (1.0f / 1024.0f) + RMS_EPS);
#pragma unroll
                  for (int q = 0; q < 4; ++q) { const f32x4 g = *((const f32x4*)nw + lane + 64 * q), sh = *((const f32x4*)mb + lane + 64 * q), sc = *((const f32x4*)(mb + 1024) + lane + 64 * q);
                      const f32x4 h = v[rr][q] * rstd * g * (sc + 1.0f) + sh;
                      u32x2 hw; hw.x = cvt_pk_bf16(h[0], h[1]); hw.y = cvt_pk_bf16(h[2], h[3]);
                      u32x2 lw; lw.x = cvt_pk_bf16(h[0] - bf_lo(hw.x), h[1] - bf_hi(hw.x)); lw.y = cvt_pk_bf16(h[2] - bf_lo(hw.y), h[3] - bf_hi(hw.y));
                      { unsigned w8 = (unsigned)__builtin_amdgcn_cvt_pk_fp8_f32(h[0] * 8.0f, h[1] * 8.0f, 0, false); w8 = (unsigned)__builtin_amdgcn_cvt_pk_fp8_f32(h[2] * 8.0f, h[3] * 8.0f, (int)w8, true);
                        *((unsigned*)((unsigned char*)H2 + (size_t)(row0 + rr) * 1024) + lane + 64 * q) = w8; }
                      *(LAS u32x2*)(HH + (2 * wave + rr) * RP + (4 * lane + 256 * q) * 2) = hw; *(LAS u32x2*)(HL + (2 * wave + rr) * RP + (4 * lane + 256 * q) * 2) = lw; } }
            }
            __syncthreads();
            { f32x4v acc[3]; acc[0] = (f32x4v){0.f, 0.f, 0.f, 0.f}; acc[1] = acc[0]; acc[2] = acc[0];
#pragma unroll
              for (int ks = 0; ks < 4; ++ks) { const int ko = (128 * wave + 32 * ks + 8 * fq) * 2;
                  const bf16x8 ah = *(const LAS bf16x8*)(HH + fr * RP + ko), al = *(const LAS bf16x8*)(HL + fr * RP + ko);
#pragma unroll
                  for (int ct = 0; ct < 3; ++ct) { acc[ct] = __builtin_amdgcn_mfma_f32_16x16x32_bf16(Wh[ks][ct], ah, acc[ct], 0, 0, 0);
                      acc[ct] = __builtin_amdgcn_mfma_f32_16x16x32_bf16(Wh[ks][ct], al, acc[ct], 0, 0, 0); acc[ct] = __builtin_amdgcn_mfma_f32_16x16x32_bf16(Wl[ks][ct], ah, acc[ct], 0, 0, 0); } }
#pragma unroll
              for (int ct = 0; ct < 3; ++ct) *(LAS f32x4v*)(PART + (wave * 16 + fr) * 48 + 16 * ct + 4 * fq) = acc[ct]; }
            __syncthreads();
            { const int row = C.tid >> 5, c = C.tid & 31;
              { float sacc = 0.f;
#pragma unroll
                for (int w = 0; w < 8; ++w) sacc += PART[(w * 16 + row) * 48 + c];
                LOGI[row * 48 + c] = sacc + (c < 4 ? bg[c] : be[c - 4]); }
              if (c < 4) { float sacc = 0.f;
#pragma unroll
                for (int w = 0; w < 8; ++w) sacc += PART[(w * 16 + row) * 48 + 32 + c];
                LOGI[row * 48 + 32 + c] = sacc + be[28 + c]; } }
            __syncthreads();
            if (wave == gi && lane < 16) { const LAS float* lg = LOGI + lane * 48;
                int grp = 0; float gmax = lg[0];
#pragma unroll
                for (int c = 1; c < 4; ++c) if (lg[c] > gmax) { gmax = lg[c]; grp = c; }
                float gs = 0.f;
#pragma unroll
                for (int c = 0; c < 4; ++c) gs += __builtin_amdgcn_exp2f((lg[c] - gmax) * LOG2E);
                const float pgrp = 1.0f / gs;
                float le[8];
#pragma unroll
                for (int e = 0; e < 8; ++e) le[e] = lg[4 + grp * 8 + e];
                int i0 = 0; float v0 = le[0];
#pragma unroll
                for (int e = 1; e < 8; ++e) if (le[e] > v0) { v0 = le[e]; i0 = e; }
                int i1 = -1; float v1 = -INFINITY;
#pragma unroll
                for (int e = 0; e < 8; ++e) if (e != i0 && le[e] > v1) { v1 = le[e]; i1 = e; }
                const float ex = __builtin_amdgcn_exp2f((v1 - v0) * LOG2E);
                my_e0 = grp * 8 + i0; my_e1 = grp * 8 + i1; my_w0 = pgrp / (1.0f + ex); my_w1 = pgrp * ex / (1.0f + ex); }
        }
        const int ea = bperm_i(C.lane >> 1, my_e0), eb = bperm_i(C.lane >> 1, my_e1);
        const int es = (C.lane < 32) ? ((C.lane & 1) ? eb : ea) : -1;
        int rank = 0, cnt = 0;
#pragma unroll
        for (int s2 = 0; s2 < 32; ++s2) { const int v = __builtin_amdgcn_readlane(es, s2); rank += (v == es && s2 < C.lane) ? 1 : 0; cnt += (v == C.lane) ? 1 : 0; }
        __syncthreads();
        if (C.lane < 32) wcnt[C.wave * 32 + C.lane] = cnt;
        __syncthreads();
        int lrank = rank;
        if (C.lane < 32) { for (int w = 0; w < C.wave; ++w) lrank += wcnt[w * 32 + es]; }
        if (C.wave == 0 && C.lane < 32) { int tot = 0;
#pragma unroll
            for (int w = 0; w < 8; ++w) tot += wcnt[w * 32 + C.lane];
            CNTBLK[ch * 32 + C.lane] = tot; }
        const int lr0 = bperm_i((2 * C.lane) & 63, lrank), lr1 = bperm_i((2 * C.lane + 1) & 63, lrank);
        if (C.lane < 16) { const int row = ch * 128 + C.wave * 16 + C.lane;
            u32x4 rec; rec.x = (unsigned)my_e0 | ((unsigned)my_e1 << 8); rec.y = (unsigned)lr0 | ((unsigned)lr1 << 16); rec.z = __float_as_uint(my_w0); rec.w = __float_as_uint(my_w1);
            *(u32x4*)(a.ws + WS_REC + (size_t)row * 16) = rec; }
    }
}
__device__ __forceinline__ void moe_scatter_phase(const Args& a, const Ctx& C) {
    LAS int* part_lt = (LAS int*)(C.lds);
    LAS int* part_all = part_lt + 512;
    LAS int* base = part_all + 512;
    LAS int* tot = base + 32;
    LAS int* pst = tot + 32;
    const int* CNTBLK = (const int*)(a.ws + WS_CNTBLK);
    int* TILEE = (int*)(a.ws + WS_TILEE);
    int* TOKL = (int*)(a.ws + WS_TOKL);
    for (int ch = C.vcu; ch < T / 128; ch += C.G) {
        __syncthreads();
        { const int e = C.tid & 31, p = C.tid >> 5; int slt = 0, sall = 0;
            for (int c = p; c < T / 128; c += 16) { const int v = CNTBLK[c * 32 + e]; sall += v; slt += (c < ch) ? v : 0; }
            part_lt[p * 32 + e] = slt; part_all[p * 32 + e] = sall; }
        __syncthreads();
        if (C.tid < 32) { int b = 0, t2 = 0;
#pragma unroll
            for (int p = 0; p < 16; ++p) { b += part_lt[p * 32 + C.tid]; t2 += part_all[p * 32 + C.tid]; }
            base[C.tid] = b; tot[C.tid] = t2; }
        __syncthreads();
        if (C.tid < 32) { int ps = 0; for (int e = 0; e < C.tid; ++e) ps += (tot[e] + 255) & ~255; pst[C.tid] = ps;
            if (ch == 0) { const int nt = (tot[C.tid] + 255) >> 8; const int t0 = ps >> 8; for (int m = 0; m < nt; ++m) TILEE[16 + t0 + m] = C.tid; if (C.tid == 31) TILEE[0] = t0 + nt; } }
        __syncthreads();
        int d0 = 0, d1 = 0;
        if (C.lane < 16) { const int row = ch * 128 + C.wave * 16 + C.lane;
            const u32x4 rec = *(const u32x4*)(a.ws + WS_REC + (size_t)row * 16);
            const int e0 = rec.x & 255, e1 = (rec.x >> 8) & 255;
            d0 = pst[e0] + base[e0] + (int)(rec.y & 0xffffu); d1 = pst[e1] + base[e1] + (int)(rec.y >> 16);
            u32x4 o; o.x = (unsigned)d0; o.y = (unsigned)d1; o.z = rec.z; o.w = rec.w;
            *(u32x4*)(a.ws + WS_DEST + (size_t)row * 16) = o; }
        if (C.lane < 16) { const int row = ch * 128 + C.wave * 16 + C.lane; TOKL[d0] = row; TOKL[d1] = row; }
        if (ch == 0) {
            for (int e = 0; e < 32; ++e) { const int lo = pst[e] + tot[e], hi = pst[e] + ((tot[e] + 255) & ~255);
                for (int k = lo + C.tid; k < hi; k += NTHR) TOKL[k] = 0; } }
    }
}
struct MoeOrder {
    int G, c, nu; int ex[8]; const char* A; const char* B; size_t tA, tB, eB;
    __device__ __forceinline__ bool next(int i, pg8::Unit& u) const {
        const int L = i * G + c; if (i >= 8 || L >= nu) return false;
        const int e = i == 0 ? ex[0] : i == 1 ? ex[1] : i == 2 ? ex[2] : i == 3 ? ex[3] : i == 4 ? ex[4] : i == 5 ? ex[5] : i == 6 ? ex[6] : ex[7];
        u.pm = L >> 2; u.pn = L & 3; u.A = A + (size_t)u.pm * tA; u.B = B + (size_t)e * eB + (size_t)u.pn * tB; return true;
    }
};

__device__ __forceinline__ void dil_unit(const Args& a, const Ctx& C, int du) {
    using namespace att;
    LAS unsigned char* lds = C.lds;
    const int x = du & 15; int r = du >> 4; const int h = r & 3; r >>= 2; const int grp = r % 3, b = r / 3;
    const int dsh = 2 * grp, d = 1 << dsh; const int nub = 16 >> dsh; const int res = x / nub, ub = x % nub;
    const int wid = C.wave, lane = C.lane, r32 = lane & 31, hi = lane >> 5;
    LAS float* lut = (LAS float*)(lds + L_LUT);
    LAS unsigned char* tl = lds + L_SEL + 768;
    __syncthreads();
    for (int e = C.tid; e < 704; e += NTHR) { const int m = 384 - e; float v = -INFINITY;
        if (m >= 0 && m <= 128) { int di = m << dsh; di = di > 4095 ? 4095 : di; v = a.rel_bias[(int)lds[L_BKT + di] * 20 + 8 + grp * 4 + h] * LOG2E; }
        lut[e] = v; }
    if (C.tid < 6) { const int kt = 4 * ub - 2 + C.tid; tl[C.tid] = (unsigned char)(kt < 0 ? 0x80 : kt); }
    const bf16_t* QKV = (const bf16_t*)(a.ws + WS_A);
    const int u = 256 * ub + 32 * wid + r32; const size_t tokq = (size_t)b * SEQ + (size_t)u * d + res;
    const bf16_t* qp = QKV + tokq * LDQ + 1280 + grp * 256 + h * 64;
    bf16x8 qr[4];
#pragma unroll
    for (int d0 = 0; d0 < 4; ++d0) qr[d0] = *(const bf16x8*)(qp + d0 * 16 + hi * 8);
    __syncthreads();
    StreamP S; S.Kb = QKV + ((size_t)b * SEQ + res) * LDQ + 1280 + 768 + grp * 256 + h * 64; S.Vb = S.Kb + 768; S.pitch = (long)d * LDQ;
    S.NT = 6; S.tl = tl; S.lanesel = ~0ull; S.uq = u; S.lut = lut; S.xtop = 384; S.dclamp = 1 << 30;
    float m = 0.f, l = 0.f; f32x16 o[2];
    attn_stream<8>(lds, wid, lane, qr, S, m, l, o);
    l = xhalf_sum(l);
    LAS float* wsf = (LAS float*)(lds + L_WSF) + wid * 64;
    if (hi == 0) { wsf[r32] = l > 0.f ? 1.0f / l : 0.f; ((float*)(a.ws + WS_LSE))[((size_t)grp * T + tokq) * 4 + h] = m + __builtin_amdgcn_logf(l); }
    LDS_WAIT();
#pragma unroll
    for (int rr = 0; rr < 16; ++rr) { const float f = wsf[crow(rr, hi)]; o[0][rr] *= f; o[1][rr] *= f; }
    stage_rows(lds, wid, lane, o);
    bf16_t* ODP = (bf16_t*)(a.ws + WS_ODP) + (size_t)grp * T * 256;
    const LAS bf16_t* stg = (const LAS bf16_t*)(lds + L_OTA) + wid * 2048;
#pragma unroll
    for (int i = 0; i < 4; ++i) { const int row = i * 8 + (lane >> 3), chn = lane & 7; const u32x4 v = *(const LAS u32x4*)(stg + row * 64 + chn * 8);
        const size_t tok = (size_t)b * SEQ + (size_t)(256 * ub + 32 * wid + row) * d + res;
        *(u32x4*)(ODP + tok * 256 + h * 64 + chn * 8) = v; }
}
__device__ __forceinline__ void dil_combine(const Args& a, const Ctx& C) {
    const float* LSE = (const float*)(a.ws + WS_LSE); const bf16_t* ODP = (const bf16_t*)(a.ws + WS_ODP); bf16_t* ODIL = (bf16_t*)(a.ws + WS_ODIL);
    const int gt = C.vcu * NTHR + C.tid, NT = C.G * NTHR;
    for (int idx = gt; idx < T * 32; idx += NT) {
        const int tok = idx >> 5, h = (idx >> 3) & 3, chn = idx & 7;
        const float l0 = LSE[((size_t)0 * T + tok) * 4 + h], l1 = LSE[((size_t)1 * T + tok) * 4 + h], l2 = LSE[((size_t)2 * T + tok) * 4 + h];
        const float mx = __builtin_fmaxf(l0, __builtin_fmaxf(l1, l2));
        float w0 = __builtin_amdgcn_exp2f(l0 - mx), w1 = __builtin_amdgcn_exp2f(l1 - mx), w2 = __builtin_amdgcn_exp2f(l2 - mx);
        const float inv = 1.0f / (w0 + w1 + w2); w0 *= inv; w1 *= inv; w2 *= inv;
        const size_t off = (size_t)tok * 256 + h * 64 + chn * 8;
        const u32x4 a0 = *(const u32x4*)(ODP + off), a1 = *(const u32x4*)(ODP + (size_t)T * 256 + off), a2 = *(const u32x4*)(ODP + (size_t)2 * T * 256 + off);
        u32x4 o;
        o.x = cvt_pk_bf16(w0 * bf_lo(a0.x) + w1 * bf_lo(a1.x) + w2 * bf_lo(a2.x), w0 * bf_hi(a0.x) + w1 * bf_hi(a1.x) + w2 * bf_hi(a2.x));
        o.y = cvt_pk_bf16(w0 * bf_lo(a0.y) + w1 * bf_lo(a1.y) + w2 * bf_lo(a2.y), w0 * bf_hi(a0.y) + w1 * bf_hi(a1.y) + w2 * bf_hi(a2.y));
        o.z = cvt_pk_bf16(w0 * bf_lo(a0.z) + w1 * bf_lo(a1.z) + w2 * bf_lo(a2.z), w0 * bf_hi(a0.z) + w1 * bf_hi(a1.z) + w2 * bf_hi(a2.z));
        o.w = cvt_pk_bf16(w0 * bf_lo(a0.w) + w1 * bf_lo(a1.w) + w2 * bf_lo(a2.w), w0 * bf_hi(a0.w) + w1 * bf_hi(a1.w) + w2 * bf_hi(a2.w));
        if (ABL == 4) o = (u32x4){0u, 0u, 0u, 0u};
        *(u32x4*)(ODIL + off) = o;
    }
}
template <bool INIT>
__device__ __forceinline__ void ota_update(LAS bf16_t* ota  , const LAS float* frow, int hi, const f32x16 (&o)[2]) {
#pragma unroll
    for (int r = 0; r < 16; ++r) { const int row = crow(r, hi); const float f = frow[row];
        float v0 = f * o[0][r], v1 = f * o[1][r];
        if (!INIT) { v0 += __uint_as_float((unsigned)ota[row * 64] << 16); v1 += __uint_as_float((unsigned)ota[row * 64 + 32] << 16); }
        ota[row * 64] = (bf16_t)(cvt_pk_bf16(v0, 0.f) & 0xffffu); ota[row * 64 + 32] = (bf16_t)(cvt_pk_bf16(v1, 0.f) & 0xffffu); }
}
#define NSA_T0(which) do { if (TNSA == (which) && blockIdx.x == 0 && wid == 0 && lane_id_fresh() == 0) { volatile LAS unsigned* M_ = (volatile LAS unsigned*)(lds + LDS_MISC); const unsigned long long t_ = __builtin_amdgcn_s_memrealtime(); M_[20] = (unsigned)t_; M_[21] = (unsigned)(t_ >> 32); } } while (0)
#define NSA_T1(which) do { if (TNSA == (which) && blockIdx.x == 0 && wid == 0 && lane_id_fresh() == 0) { volatile LAS unsigned* M_ = (volatile LAS unsigned*)(lds + LDS_MISC); const unsigned long long t_ = __builtin_amdgcn_s_memrealtime(); const unsigned long long t0_ = ((unsigned long long)M_[21] << 32) | M_[20]; \
        const unsigned long long d_ = (((unsigned long long)M_[23] << 32) | M_[22]) + (t_ - t0_); M_[22] = (unsigned)d_; M_[23] = (unsigned)(d_ >> 32); } } while (0)
#define NSA_SECT() const int lane = lane_id_fresh(); const int tid = wid * 64 + lane; const int r32 = lane & 31, hi = lane >> 5; (void)tid; (void)r32; (void)hi
__device__ __forceinline__ void nsa_unit(const Args& a, const Ctx& C, int b, int hk, int i) {
    using namespace att;
    LAS unsigned char* lds = C.lds;
    const int wid = C.wave; const int g = wid >> 1;
    const bf16_t* QKV = (const bf16_t*)(a.ws + WS_A);
    bf16x8 qr[4];
    f32x16 o[2];
    __syncthreads();
    NSA_T0(2);
    { NSA_SECT();
        const int tq = (wid & 1) * 32 + r32, t = 64 * i + tq; const size_t tok = (size_t)b * SEQ + t;
        LAS float* imp = (LAS float*)(lds + L_IMP); LAS float* gsh = (LAS float*)(lds + L_GSH) + wid * 96; LAS unsigned* selw = (LAS unsigned*)(lds + L_SEL);
        const bf16_t* KC = (const bf16_t*)(a.ws + WS_KC); const int nt = (4 * i + 2) / 64 + 1;
        cmp_issue(lds, wid, lane, KC + (size_t)((0 * 8 + b) * 2 + hk) * 256 * 64, KC + (size_t)((1 * 8 + b) * 2 + hk) * 256 * 64, nt);
        const bf16_t* qp = QKV + tok * LDQ + hk * 256 + g * 64;
#pragma unroll
        for (int d0 = 0; d0 < 4; ++d0) qr[d0] = *(const bf16x8*)(qp + d0 * 16 + hi * 8);
        float g0 = 0.f, g1 = 0.f, g2 = 0.f;
        if (hi == 0) { const float* gn = (const float*)(a.ws + WS_GN) + tok * 32 + hk * 4 + g; g0 = gn[0]; g1 = gn[8]; g2 = gn[16]; }
        for (int e = tid; e < 64 * 64; e += NTHR) imp[e] = 0.f;
        if (tid < 2) selw[128 + tid] = 0u;
        if (hi == 0) { gsh[r32] = (ABL == 1) ? 0.f : g0; gsh[32 + r32] = (ABL == 2) ? 0.f : g1; gsh[64 + r32] = (ABL == 3) ? 0.f : g2; }
        cmp_branch(lds, wid, lane, qr, nt, t, o);
        ota_update<true>((LAS bf16_t*)(lds + L_OTA) + wid * 2048 + r32, gsh, hi, o);
    }
    __syncthreads();
    NSA_T1(2);
    { NSA_SECT();
        LAS float* impP = (LAS float*)(lds + L_IMP); LAS unsigned* selw = (LAS unsigned*)(lds + L_SEL);
        const int q = tid >> 3, part = tid & 7;
        const int ncand = i - 2 > 0 ? i - 2 : 0; const int nforced = i + 1 < 3 ? i + 1 : 3; const int krem = 16 - nforced;
        unsigned bits = 0u;
        if (ncand > krem && ABL != 5) {
            float vn[8]; int cn[8];
#pragma unroll
            for (int e = 0; e < 8; ++e) { vn[e] = impP[q * 64 + part * 8 + e]; cn[e] = 0; }
#pragma unroll 4
            for (int mm = 1; mm <= i - 2; ++mm) { const float xv = impP[q * 64 + mm];
#pragma unroll
                for (int e = 0; e < 8; ++e) { const int n = part * 8 + e; cn[e] += (xv > vn[e] || (xv == vn[e] && mm < n)) ? 1 : 0; } }
#pragma unroll
            for (int e = 0; e < 8; ++e) { const int n = part * 8 + e; if (n >= 1 && n <= i - 2 && cn[e] < krem) bits |= 1u << e; }
        } else {
#pragma unroll
            for (int e = 0; e < 8; ++e) { const int n = part * 8 + e; if (n >= 1 && n <= i - 2) bits |= 1u << e; }
        }
#pragma unroll
        for (int e = 0; e < 8; ++e) { const int n = part * 8 + e; if (n == 0 || n == i || n == i - 1) bits |= 1u << e; }
        unsigned lo = part < 4 ? bits << (8 * part) : 0u, hi2 = part >= 4 ? bits << (8 * (part - 4)) : 0u;
        lo |= swz_xor_u<1>(lo); hi2 |= swz_xor_u<1>(hi2); lo |= swz_xor_u<2>(lo); hi2 |= swz_xor_u<2>(hi2); lo |= swz_xor_u<4>(lo); hi2 |= swz_xor_u<4>(hi2);
        if (part == 0) { selw[2 * q] = lo; selw[2 * q + 1] = hi2; atomicOr((unsigned*)&selw[128], lo); atomicOr((unsigned*)&selw[129], hi2); }
    }
    __syncthreads();
    int NTS, NTW;
    { NSA_SECT();
        LAS unsigned* selw = (LAS unsigned*)(lds + L_SEL);
        LAS unsigned char* tls = lds + L_SEL + 768; LAS unsigned char* tlw = lds + L_SEL + 848;
        const unsigned long long uni = ((unsigned long long)(unsigned)__builtin_amdgcn_readfirstlane((int)selw[129]) << 32) | (unsigned)__builtin_amdgcn_readfirstlane((int)selw[128]);
        const int nsel = __builtin_popcountll(uni); const int nts = (nsel + 1) & ~1; NTS = nts < 4 ? 4 : nts;
        const int jlo = i - 8 < 0 ? 0 : i - 8; const int nwin = i - jlo + 1; const int ntw = (nwin + 1) & ~1; NTW = ntw < 4 ? 4 : ntw;
        if (tid < 64) { if ((uni >> tid) & 1ull) tls[__builtin_popcountll(uni & ((1ull << tid) - 1ull))] = (unsigned char)tid; }
        else if (tid < 72) { const int k = nsel + (tid - 64); if (k < NTS) tls[k] = 0x80; }
        else if (tid < 88) { const int k = tid - 72; if (k < NTW) tlw[k] = (unsigned char)(k < nwin ? jlo + k : 0x80); }
    }
    __syncthreads();
    NSA_T0(1);
#pragma clang loop unroll(disable)
    for (int br = 0; br < 2; ++br) {
        float m = 0.f, l = 0.f;
        { NSA_SECT();
            const int tq = (wid & 1) * 32 + r32, t = 64 * i + tq;
            LAS unsigned* selw = (LAS unsigned*)(lds + L_SEL); LAS float* lut = (LAS float*)(lds + L_LUT);
            StreamP S; S.Kb = QKV + (size_t)b * SEQ * LDQ + 512 + 256 + br * 256 + hk * 64; S.Vb = S.Kb + 128; S.pitch = LDQ;
            S.NT = br ? NTW : NTS; S.tl = lds + L_SEL + (br ? 848 : 768); S.uq = t;
            S.lanesel = br ? ~0ull : (((unsigned long long)selw[2 * tq + 1] << 32) | selw[2 * tq]);
            S.lut = br ? lut + 7168 + g * 768 : lut + g * 1792; S.xtop = br ? 640 : 1636; S.dclamp = br ? (1 << 30) : 1636;
            attn_stream<8>(lds, wid, lane, qr, S, m, l, o);
        }
        { NSA_SECT();
            LAS float* gsh = (LAS float*)(lds + L_GSH) + wid * 96; LAS float* wsf = (LAS float*)(lds + L_WSF) + wid * 64;
            l = xhalf_sum(l);
            LDS_WAIT();
            if (hi == 0) wsf[r32] = (l > 0.f ? 1.0f / l : 0.f) * gsh[32 + br * 32 + r32];
            LDS_WAIT();
            ota_update<false>((LAS bf16_t*)(lds + L_OTA) + wid * 2048 + r32, wsf, hi, o);
        }
    }
    NSA_T1(1);
    { NSA_SECT();
        LDS_WAIT();
        bf16_t* ONSA = (bf16_t*)(a.ws + WS_ONSA);
        const LAS bf16_t* stg = (const LAS bf16_t*)(lds + L_OTA) + wid * 2048;
#pragma unroll
        for (int k = 0; k < 4; ++k) { const int row = k * 8 + (lane >> 3), chn = lane & 7; const u32x4 v = *(const LAS u32x4*)(stg + row * 64 + chn * 8);
            const size_t tk = (size_t)b * SEQ + 64 * i + (wid & 1) * 32 + row;
            *(u32x4*)(ONSA + tk * 512 + hk * 256 + g * 64 + chn * 8) = v; }
    }
}
__device__ __forceinline__ void build_bkt(const Ctx& C) {
    LAS unsigned char* bkt = C.lds + att::L_BKT; LAS unsigned char* bkc = C.lds + att::L_BKC;
    for (int d = C.tid; d < 4096; d += NTHR) bkt[d] = (unsigned char)att::bucket_of(d);
    for (int x = C.tid; x < 8704; x += NTHR) { const int dist = 4095 - x; bkc[x] = (unsigned char)(dist < 0 ? 128 : 4 * att::bucket_of(dist)); }
    __syncthreads();
}
__device__ __forceinline__ void build_nsa_tables(const Args& a, const Ctx& C, int hk) {
    using namespace att;
    LAS float* tbh = (LAS float*)(C.lds + L_TBH); LAS float* lut = (LAS float*)(C.lds + L_LUT);
    __syncthreads();
    if (C.tid < 144) { const int gg = C.tid / 36, bk = C.tid % 36; tbh[C.tid] = bk < 32 ? a.rel_bias[bk * 20 + hk * 4 + gg] * LOG2E : -INFINITY; }
    __syncthreads();
    for (int e = C.tid; e < 4 * 1792; e += NTHR) { const int gg = e / 1792, xx = e % 1792; const int dist = 1636 - xx;
        lut[e] = dist < 0 ? -INFINITY : tbh[gg * 36 + (int)C.lds[L_BKT + dist]]; }
    for (int e = C.tid; e < 4 * 768; e += NTHR) { const int gg = e / 768, xx = e % 768; const int dist = 640 - xx;
        lut[7168 + e] = (dist < 0 || dist > 512) ? -INFINITY : tbh[gg * 36 + (int)C.lds[L_BKT + dist]]; }
    __syncthreads();
}

typedef const Args __attribute__((address_space(4)))* CArgsP;
__device__ __forceinline__ Args load_args() {
#if defined(__HIP_DEVICE_COMPILE__)
    CArgsP p = (CArgsP)__builtin_amdgcn_kernarg_segment_ptr(); asm volatile("" : "+s"(p)); Args a;
    a.x = p->x; a.c = p->c; a.rel_bias = p->rel_bias; a.ada_w = p->ada_w; a.ada_b = p->ada_b; a.norm1 = p->norm1; a.norm2 = p->norm2; a.w_in = p->w_in;
    a.cmp_pos = p->cmp_pos; a.cmp_w1 = p->cmp_w1; a.cmp_w2 = p->cmp_w2; a.w_up_nsa = p->w_up_nsa; a.w_up_dil = p->w_up_dil; a.w_o = p->w_o;
    a.router_wg = p->router_wg; a.router_bg = p->router_bg; a.router_we = p->router_we; a.router_be = p->router_be; a.exp_w1 = p->exp_w1; a.exp_w3 = p->exp_w3; a.exp_w2 = p->exp_w2; a.norm_f = p->norm_f;
    a.out = p->out; a.ws = p->ws; a.ph_lo = p->ph_lo; a.ph_hi = p->ph_hi; a.use_bar = p->use_bar; a.pad = 0;
    return a;
#else
    return Args{};
#endif
}
#define LOADA() const Args a = load_args()
__global__ void __launch_bounds__(NTHR, 2) fwd_kernel(Args a_) {
    extern __shared__ __attribute__((aligned(16))) unsigned char lds_raw[];
    LAS unsigned char* const lds_base = (LAS unsigned char*)lds_raw;
    const int wave0_ = __builtin_amdgcn_readfirstlane((int)threadIdx.x >> 6);
#define FRESH() Ctx C; { int w_ = wave0_; asm volatile("" : "+s"(w_)); int t_ = lane_id_fresh(); asm volatile("" : "+v"(t_)); t_ += w_ * 64; int g_ = gridDim.x, b_ = blockIdx.x; asm volatile("" : "+s"(g_), "+s"(b_)); \
        C.lds = lds_base; C.tid = t_; C.lane = t_ & 63; C.wave = w_; C.G = g_; C.bx = b_; C.vcu = (g_ % 8 == 0) ? (b_ % 8) * (g_ / 8) + b_ / 8 : b_; }
    volatile LAS unsigned* MISC = (volatile LAS unsigned*)(lds_base + LDS_MISC);
    if (threadIdx.x < 64) MISC[threadIdx.x] = 0u;
    __syncthreads();
    unsigned* ctl = (unsigned*)(a_.ws + WS_CTL);
    XcdBarrier bar; bar.bar = ctl + CW_BAR; bar.x = 0; bar.st = nullptr;
    if (a_.use_bar) bar = xcd_barrier_post(ctl + CW_BAR, MISC + 8);
    const int lo = a_.ph_lo, hi = a_.ph_hi;
#ifndef PH_MASK
#define PH_MASK 0xFFFFFFFFu
#endif
#define IN(k) (((PH_MASK >> ((k) == 0 ? 10 : (k) == 21 ? 11 : (((k) - 1) % 10))) & 1u) && lo <= (k) && (k) < hi)
#define TIMED(k) ((TMASK >> (k)) & 1u)
#define TBEG(k) do { if (TMASK != 0u && TIMED(k) && blockIdx.x == 0 && wave0_ == 0 && lane_id_fresh() == 0) { const unsigned long long t_ = __builtin_amdgcn_s_memrealtime(); MISC[20] = (unsigned)t_; MISC[21] = (unsigned)(t_ >> 32); } } while (0)
#define TEND(k) do { if (TMASK != 0u && TIMED(k) && blockIdx.x == 0 && wave0_ == 0 && lane_id_fresh() == 0) { const unsigned long long t_ = __builtin_amdgcn_s_memrealtime(); const unsigned long long t0_ = ((unsigned long long)MISC[21] << 32) | MISC[20]; \
        const unsigned long long d_ = (((unsigned long long)MISC[23] << 32) | MISC[22]) + (t_ - t0_); MISC[22] = (unsigned)d_; MISC[23] = (unsigned)(d_ >> 32); } } while (0)
#define SEAM(k) do { if (IN(k) && IN((k) + 1)) { XcdBarrier b2_ = bar; asm volatile("" : "+s"(b2_.bar)); int w2_ = wave0_; asm volatile("" : "+s"(w2_)); xcd_barrier(b2_, w2_ == 0 && lane_id_fresh() == 0); } } while (0)
    TBEG(0);
    if (IN(0)) REPEAT(10) { __syncthreads(); FRESH(); LOADA(); prologue_vectors(a, C); conv_small(a, C); }
    SEAM(0); TEND(0);
    _Pragma("unroll") for (int l = 0; l < 2; ++l) {
        const int pb = 1 + 10 * l;
        TBEG(pb + 0);
        if (IN(pb + 0)) REPEAT(0) { FRESH(); LOADA(); norm1_phase(a, C, l); }
        SEAM(pb + 0); TEND(pb + 0);
        TBEG(pb + 1);
        if (IN(pb + 1)) REPEAT(1) { FRESH(); LOADA(); unsigned char* ws = a.ws;
            pg8::Gemm g{1024u, 1024u, 128u, 1024, 0u, 0u, 0, nullptr, nullptr, 0x77777777, 0x7c7c7c7c};
            pg8::DenseOrder S; S.init(T, NIN, C.G, C.bx, ws + WS_H, 1024u, ws + WS_WINT + (size_t)l * NIN * DM, 1024u);
            EpiInProj E{(bf16_t*)(ws + WS_A), (unsigned char*)(ws + WS_MG), (float*)(ws + WS_GN), 1.0f / 2048.0f};
            pg8::gemm_phase<EpiInProj, pg8::DenseOrder, true, false, false, true>(C.lds, C.tid, g, S, E);
        }
        SEAM(pb + 1); TEND(pb + 1);
        TBEG(pb + 2);
        if (IN(pb + 2)) REPEAT(2) { FRESH(); LOADA(); unsigned char* ws = a.ws;
            struct CmpOrder { int c; const char* A; const char* B;
                __device__ __forceinline__ bool next(int i, pg8::Unit& u) const { if (i > 0 || c >= 32) return false; const int kv = c >> 4, b = (c >> 1) & 7, hk = c & 1;
                    u.pm = c; u.pn = 0; u.A = A + ((size_t)b * SEQ * LDQ + 512 + kv * 128 + hk * 64) * 2; u.B = B + (size_t)kv * 256 * 2048 * 2; return true; } };
            pg8::Gemm g{(unsigned)(16 * LDQ * 2), 4096u, (unsigned)(LDQ * 2), 2048};
            CmpOrder S{C.vcu, (const char*)(ws + WS_A), (const char*)(ws + WS_CW1T + (size_t)l * 2 * 256 * 2048 * 2)};
            EpiCmp E{(bf16_t*)(ws + WS_HID), (const float*)(ws + WS_CB1) + l * 512, (const bf16_t*)(ws + WS_CW2T) + (size_t)l * 2 * 64 * 256, (bf16_t*)(ws + WS_KC)};
            pg8::gemm_phase<EpiCmp, CmpOrder, false>(C.lds, C.tid, g, S, E);
            __syncthreads();
            build_bkt(C);
            for (;;) { __syncthreads();
                if (C.tid == 0) *(volatile LAS int*)(C.lds + LDS_MISC + 512) = (int)__hip_atomic_fetch_add((unsigned*)(ws + WS_CTL) + CW_Q + l, 1u, __ATOMIC_RELAXED, __HIP_MEMORY_SCOPE_AGENT);
                __syncthreads();
                const int du = __builtin_amdgcn_readfirstlane(*(volatile LAS int*)(C.lds + LDS_MISC + 512));
                if (du >= 1536) break;
                dil_unit(a, C, du); }
        }
        SEAM(pb + 2); TEND(pb + 2);
        TBEG(pb + 3);
        if (IN(pb + 3)) REPEAT(3) { FRESH(); LOADA();
            dil_combine(a, C);
            build_bkt(C);
            int cur_hk = -1;
            for (int v = C.vcu; v < 256; v += C.G) { const int b = v >> 5, hk = (v >> 4) & 1, s = v & 15;
                if (hk != cur_hk) { build_nsa_tables(a, C, hk); cur_hk = hk; }
                for (int k = 0; k < 4; ++k) { const int qi = (k == 0) ? s : (k == 1) ? 31 - s : (k == 2) ? 32 + s : 63 - s; nsa_unit(a, C, b, hk, qi);
                    __syncthreads(); if (v < C.G) conv_experts_slice(a, C, l, k); } }
            if (C.vcu >= 256) { for (int q = 0; q < 4; ++q) conv_experts_slice(a, C, l, q); }
            __syncthreads();
        }
        SEAM(pb + 3); TEND(pb + 3);
        TBEG(pb + 4);
        if (IN(pb + 4)) REPEAT(4) { FRESH(); LOADA(); unsigned char* ws = a.ws;
            pg8::Gemm g{1024u, 1024u, 128u, 512, 512u, 512u, 256}; pg8::DenseOrder S; S.init(T, 1024, C.G, C.bx, ws + WS_ONSA, 1024u, ws + WS_WUNT + (size_t)l * 1024 * 512 * 2, 1024u);
            S.A2 = (const char*)(ws + WS_ODIL); S.B2 = (const char*)(ws + WS_WUDT + (size_t)l * 1024 * 256 * 2); S.tA2 = (size_t)256 * 512; S.tB2 = (size_t)256 * 512;
            EpiUpFused E{(bf16_t*)(ws + WS_MERGED), (const unsigned char*)(ws + WS_MG)};
            pg8::gemm_phase<EpiUpFused, pg8::DenseOrder, true, true>(C.lds, C.tid, g, S, E);
        }
        SEAM(pb + 4); TEND(pb + 4);
        TBEG(pb + 5);
        if (IN(pb + 5)) REPEAT(5) { FRESH(); LOADA(); unsigned char* ws = a.ws;
            pg8::Gemm g{2048u, 2048u, 128u, 1024}; pg8::DenseOrder S; S.init(T, 1024, C.G, C.bx, ws + WS_MERGED, 2048u, ws + WS_WOT + (size_t)l * 1024 * 1024 * 2, 2048u);
            EpiOut E{l == 0 ? a.x : (const float*)a.out, a.out, (const float*)(ws + WS_MOD) + (size_t)l * 8 * 6144 + 2048};
            pg8::gemm_phase<EpiOut, pg8::DenseOrder, true>(C.lds, C.tid, g, S, E);
        }
        SEAM(pb + 5); TEND(pb + 5);
        TBEG(pb + 6);
        if (IN(pb + 6)) REPEAT(6) { FRESH(); LOADA(); norm2_router_phase(a, C, l); }
        SEAM(pb + 6); TEND(pb + 6);
        TBEG(pb + 7);
        if (IN(pb + 7)) REPEAT(7) { FRESH(); LOADA(); moe_scatter_phase(a, C); }
        SEAM(pb + 7); TEND(pb + 7);
        TBEG(pb + 8);
        if (IN(pb + 8)) REPEAT(8) { FRESH(); LOADA(); unsigned char* ws = a.ws;
            const int* TILEE = (const int*)(ws + WS_TILEE); const int ntl = TILEE[0];
            MoeOrder S; S.G = C.G; S.c = C.vcu; S.nu = ntl * 4; S.A = (const char*)(ws + WS_XS); S.B = (const char*)(ws + WS_E13T); S.tA = (size_t)256 * 1024; S.tB = (size_t)256 * 1024; S.eB = (size_t)1024 * 1024;
#pragma unroll
            for (int i = 0; i < 8; ++i) { const int L = i * C.G + C.vcu; S.ex[i] = (L < S.nu) ? TILEE[16 + (L >> 2)] : 0; }
            pg8::Gemm g{1024u, 1024u, 128u, 1024, 0u, 0u, 0, (const int*)(ws + WS_TOKL), (const char*)(ws + WS_H2), 0, 0};
            EpiMoe1 E{(unsigned char*)(ws + WS_ACT), 1.0f / 2048.0f};
            pg8::gemm_phase<EpiMoe1, MoeOrder, true, false, true, true>(C.lds, C.tid, g, S, E);
        }
        SEAM(pb + 8); TEND(pb + 8);
        TBEG(pb + 9);
        if (IN(pb + 9)) REPEAT(9) { FRESH(); LOADA(); unsigned char* ws = a.ws;
            const int* TILEE = (const int*)(ws + WS_TILEE); const int ntl = TILEE[0];
            MoeOrder S; S.G = C.G; S.c = C.vcu; S.nu = ntl * 4; S.A = (const char*)(ws + WS_ACT); S.B = (const char*)(ws + WS_E2T); S.tA = (size_t)256 * 512; S.tB = (size_t)256 * 512; S.eB = (size_t)1024 * 512;
#pragma unroll
            for (int i = 0; i < 8; ++i) { const int L = i * C.G + C.vcu; S.ex[i] = (L < S.nu) ? TILEE[16 + (L >> 2)] : 0; }
            pg8::Gemm g{512u, 512u, 128u, 512};
            EpiPlain E{(bf16_t*)(ws + WS_XS), 1024, 1.0f / 1024.0f};
            pg8::gemm_phase<EpiPlain, MoeOrder, true, false, false, true>(C.lds, C.tid, g, S, E);
        }
        SEAM(pb + 9); TEND(pb + 9);
    }
    TBEG(21);
    if (IN(21)) { FRESH(); LOADA(); final_phase(a, C); }
    TEND(21);
    if ((TMASK != 0u || TNSA != 0) && blockIdx.x == 0 && wave0_ == 0 && lane_id_fresh() == 0) { const unsigned long long d_ = ((unsigned long long)MISC[23] << 32) | MISC[22]; const unsigned long long t0_ = __builtin_amdgcn_s_memrealtime();
        while (__builtin_amdgcn_s_memrealtime() - t0_ < TAMP * d_) __builtin_amdgcn_s_sleep(8); }
#undef IN
#undef SEAM
}

#ifndef ONE_LAUNCH
#define ONE_LAUNCH 1
#endif
extern "C" void kernel_launch(void* const* d_in, const int* in_sizes, int n_in, void* d_out, int out_size, void* d_ws, size_t ws_size, hipStream_t stream) {
    static int grid = 0;
    if (grid == 0) {
        if (n_in != 22 || out_size != T * DM || ws_size < WS_END) { fprintf(stderr, "kernel_launch: unexpected problem (n_in %d out %d ws %zu)\n", n_in, out_size, ws_size); grid = -1; return; }
        int dev = 0, cus = 0;
        if (hipGetDevice(&dev) != hipSuccess || hipDeviceGetAttribute(&cus, hipDeviceAttributeMultiprocessorCount, dev) != hipSuccess) { grid = -1; return; }
        if (hipFuncSetAttribute((const void*)fwd_kernel, hipFuncAttributeMaxDynamicSharedMemorySize, LDS_BYTES) != hipSuccess) { fprintf(stderr, "kernel_launch: hipFuncSetAttribute failed\n"); grid = -1; return; }
        int per_cu = 0;
        if (hipOccupancyMaxActiveBlocksPerMultiprocessor(&per_cu, (const void*)fwd_kernel, NTHR, LDS_BYTES) != hipSuccess || per_cu < 1) { fprintf(stderr, "kernel_launch: occupancy query reports %d\n", per_cu); }
        (void)hipGetLastError();
        grid = cus;
    }
    if (grid < 0) return;
    (void)hipMemsetAsync((char*)d_ws + WS_CTL, 0, CTL_ZERO_BYTES, stream);
    Args a{};
    a.x = (const float*)d_in[0]; a.c = (const float*)d_in[1]; a.rel_bias = (const float*)d_in[2]; a.ada_w = (const float*)d_in[3]; a.ada_b = (const float*)d_in[4];
    a.norm1 = (const float*)d_in[5]; a.norm2 = (const float*)d_in[6]; a.w_in = (const float*)d_in[7]; a.cmp_pos = (const float*)d_in[8]; a.cmp_w1 = (const float*)d_in[9];
    a.cmp_w2 = (const float*)d_in[10]; a.w_up_nsa = (const float*)d_in[11]; a.w_up_dil = (const float*)d_in[12]; a.w_o = (const float*)d_in[13];
    a.router_wg = (const float*)d_in[14]; a.router_bg = (const float*)d_in[15]; a.router_we = (const float*)d_in[16]; a.router_be = (const float*)d_in[17];
    a.exp_w1 = (const float*)d_in[18]; a.exp_w3 = (const float*)d_in[19]; a.exp_w2 = (const float*)d_in[20]; a.norm_f = (const float*)d_in[21];
    a.out = (float*)d_out; a.ws = (unsigned char*)d_ws; a.pad = 0;
#if ONE_LAUNCH
    a.ph_lo = 0; a.ph_hi = NPHASE; a.use_bar = 1;
    hipLaunchKernelGGL(fwd_kernel, dim3(grid), dim3(NTHR), LDS_BYTES, stream, a);
#else
    for (int p = 0; p < NPHASE; ++p) { a.ph_lo = p; a.ph_hi = p + 1; a.use_bar = 0;
        hipLaunchKernelGGL(fwd_kernel, dim3(grid), dim3(NTHR), LDS_BYTES, stream, a); }
#endif
}
```

```cpp
#include <hip/hip_runtime.h>
#include <cstdint>
#include <cstdio>

#define GAS __attribute__((address_space(1)))
#define LAS __attribute__((address_space(3)))
typedef unsigned short bf16_t;
typedef short bf16x8 __attribute__((ext_vector_type(8)));
typedef short s16x4 __attribute__((ext_vector_type(4)));
typedef float f32x4 __attribute__((ext_vector_type(4)));
typedef float f32x2 __attribute__((ext_vector_type(2)));
typedef float f32x16 __attribute__((ext_vector_type(16)));
typedef unsigned u32x4 __attribute__((ext_vector_type(4)));
typedef unsigned u32x2 __attribute__((ext_vector_type(2)));
typedef __bf16 bf16x2_t __attribute__((ext_vector_type(2)));

constexpr int NB = 8, SEQ = 4096, DM = 1024, T = NB * SEQ;
constexpr int LDQ = 3584;
constexpr int NIN = 5888;
constexpr int INW = 5656;
constexpr float LOG2E = 1.4426950408889634f;
constexpr float C2 = 0.125f * LOG2E;
constexpr int NWAVES = 8, NTHR = 512;
constexpr float RMS_EPS = 1e-6f;
constexpr int NPHASE = 22;
#ifndef ABL
#define ABL 0
#endif
#ifndef REP_MASK
#define REP_MASK 0u
#endif
#ifndef TMASK
#define TMASK 0u
#endif
#define TAMP 8ull
#ifndef TNSA
#define TNSA 0
#endif
#define REPEAT(k) _Pragma("clang loop unroll(disable)") for (int rep_ = 0; rep_ < (int)((REP_MASK >> (k)) & 1u) + 1; ++rep_)

constexpr size_t MiB = 1u << 20;
constexpr size_t WS_CTL = 0, CTL_ZERO_BYTES = MiB;
constexpr size_t WS_MOD = 1 * MiB;
constexpr size_t WS_CB1 = WS_MOD + 400 * 1024;
constexpr size_t WS_CW2T = WS_MOD + 512 * 1024;
constexpr size_t WS_CNTBLK = WS_MOD + 768 * 1024;
constexpr size_t WS_TILEE = WS_MOD + 832 * 1024;
constexpr size_t WS_WINT = 4 * MiB;
constexpr size_t WS_CW1T = 27 * MiB;
constexpr size_t WS_WUNT = 31 * MiB;
constexpr size_t WS_WUDT = 33 * MiB;
constexpr size_t WS_WOT = 34 * MiB;
constexpr size_t WS_E13T = 38 * MiB;
constexpr size_t WS_E2T = 102 * MiB;
constexpr size_t WS_A = 134 * MiB;
constexpr size_t WS_XS = WS_A;
constexpr size_t WS_ACT = WS_A + 144 * MiB;
constexpr size_t WS_MERGED = WS_A;
constexpr size_t WS_MG = 359 * MiB;
constexpr size_t WS_H2 = WS_MG;
constexpr size_t WS_REC = WS_MG + 64 * MiB;
constexpr size_t WS_DEST = WS_MG + 65 * MiB;
constexpr size_t WS_TOKL = WS_MG + 66 * MiB;
constexpr size_t WS_B = 487 * MiB;
constexpr size_t WS_H = WS_B;
constexpr size_t WS_ONSA = WS_B;
constexpr size_t WS_ODP = WS_B + 32 * MiB;
constexpr size_t WS_LSE = WS_B + 80 * MiB;
constexpr size_t WS_ODIL = WS_B + 82 * MiB;
constexpr size_t WS_GN = WS_B + 98 * MiB;
constexpr size_t WS_KC = WS_B + 102 * MiB;
constexpr size_t WS_HID = WS_B + 103 * MiB;
constexpr size_t WS_END = WS_B + 107 * MiB;

constexpr int CW_TMO = 0, CW_BAR = 4096, CW_Q = 8192;

constexpr int LDS_MISC = 158784;
constexpr int LDS_BYTES = 158784 + 2048;

__device__ __forceinline__ unsigned cvt_pk_bf16(float lo, float hi) { f32x2 v = {lo, hi}; bf16x2_t b = __builtin_convertvector(v, bf16x2_t); return __builtin_bit_cast(unsigned, b); }
__device__ __forceinline__ float bf_lo(unsigned w) { return __uint_as_float(w << 16); }
__device__ __forceinline__ float bf_hi(unsigned w) { return __uint_as_float(w & 0xffff0000u); }
__device__ __forceinline__ float sigmoidf_(float x) { return __builtin_amdgcn_rcpf(1.0f + __builtin_amdgcn_exp2f(-x * LOG2E)); }
__device__ __forceinline__ int lane_id_fresh() { unsigned ones = ~0u; asm volatile("" : "+s"(ones)); return (int)__builtin_amdgcn_mbcnt_hi(ones, __builtin_amdgcn_mbcnt_lo(ones, 0u)); }
template <int X> __device__ __forceinline__ float swz_xor_f(float v) { return __int_as_float(__builtin_amdgcn_ds_swizzle(__float_as_int(v), (X << 10) | 0x1f)); }
template <int X> __device__ __forceinline__ unsigned swz_xor_u(unsigned v) { return (unsigned)__builtin_amdgcn_ds_swizzle((int)v, (X << 10) | 0x1f); }
__device__ __forceinline__ float wave_sum(float v) {
    v += swz_xor_f<1>(v); v += swz_xor_f<2>(v); v += swz_xor_f<4>(v); v += swz_xor_f<8>(v); v += swz_xor_f<16>(v);
    auto rr = __builtin_amdgcn_permlane32_swap(__float_as_uint(v), __float_as_uint(v), false, false);
    return __uint_as_float(rr[0]) + __uint_as_float(rr[1]);
}
__device__ __forceinline__ int bperm_i(int srclane, int v) { return __builtin_amdgcn_ds_bpermute(srclane << 2, v); }
#define LDS_WAIT() asm volatile("s_waitcnt lgkmcnt(0)" ::: "memory")
#define VM_WAIT() asm volatile("s_waitcnt vmcnt(0)" ::: "memory")

#define XB_TMO      128
#define XB_XCNT(j)  (256  + 64 * (j))
#define XB_XSUB(j)  (1280 + 64 * (j))
#define XB_XGEN(j)  (2304 + 64 * (j))
#define XB_TOP      3328
#define XB_TOPGEN   3392
#define XCD_BAR_WORDS 3456
#define XB_SPIN_CAP (1u << 20)
__device__ __forceinline__ unsigned xb_ld(unsigned* p)              { return __hip_atomic_load(p, __ATOMIC_RELAXED, __HIP_MEMORY_SCOPE_AGENT); }
__device__ __forceinline__ unsigned xb_add(unsigned* p, unsigned v) { return __hip_atomic_fetch_add(p, v, __ATOMIC_RELAXED, __HIP_MEMORY_SCOPE_AGENT); }
__device__ __forceinline__ unsigned xb_xcc_id() { return (unsigned)__builtin_amdgcn_s_getreg((3 << 11) | 20) & 0xFu; }
#define XB_SPIN(cond, bar) do { unsigned _sp = 0; while (cond) { __builtin_amdgcn_s_sleep(1); \
    if ((++_sp & 255u) == 0u) { if (xb_ld(&(bar)[XB_TMO])) break; if (_sp > XB_SPIN_CAP) { atomicAdd(&(bar)[XB_TMO], 1u); break; } } } } while (0)
struct XcdBarrier { unsigned* bar; unsigned x; volatile LAS unsigned* st; };
__device__ __forceinline__ XcdBarrier xcd_barrier_post(unsigned* bar, volatile LAS unsigned* st) {
    XcdBarrier b; b.bar = bar; b.x = xb_xcc_id(); b.st = st;
    if (threadIdx.x == 0) (void)xb_add(&bar[XB_XCNT(b.x)], 1u);
    return b;
}
__device__ __forceinline__ void xcd_barrier_complete(unsigned* bar, unsigned x, unsigned& nloc, unsigned& nx) {
    const unsigned G = gridDim.x * gridDim.y * gridDim.z;
    unsigned sum, cnt, mine, sp = 0u;
    for (;;) {
        sum = 0u; cnt = 0u; mine = 0u;
#pragma unroll
        for (unsigned j = 0; j < 16; ++j) { const unsigned c = xb_ld(&bar[XB_XCNT(j)]); sum += c; cnt += (c > 0u) ? 1u : 0u; mine = (j == x) ? c : mine; }
        if (sum == G) break;
        __builtin_amdgcn_s_sleep(1);
        if ((++sp & 255u) == 0u) { if (xb_ld(&bar[XB_TMO])) break; if (sp > XB_SPIN_CAP) { atomicAdd(&bar[XB_TMO], 1u); break; } }
    }
    nloc = mine > 0u ? mine : 1u; nx = cnt > 0u ? cnt : 1u;
}
__device__ __forceinline__ void xcd_barrier(const XcdBarrier& b, const bool leader_thread) {
    asm volatile("s_waitcnt vmcnt(0)" ::: "memory");
    __syncthreads();
    if (leader_thread) {
        unsigned* bar = b.bar;
        __builtin_amdgcn_s_waitcnt(0);
        unsigned nloc = b.st[0], nx = b.st[1];
        if (nloc == 0u) { xcd_barrier_complete(bar, b.x, nloc, nx); b.st[0] = nloc; b.st[1] = nx; }
        const unsigned old = xb_add(&bar[XB_XSUB(b.x)], 1u);
        const unsigned gen = old / nloc;
        if (old + 1u == (gen + 1u) * nloc) {
            __builtin_amdgcn_fence(__ATOMIC_RELEASE, "agent");
            asm volatile("s_waitcnt vmcnt(0)" ::: "memory");
            const unsigned og = xb_add(&bar[XB_TOP], 1u);
            const unsigned tg = og / nx;
            if (og + 1u == (tg + 1u) * nx) xb_add(&bar[XB_TOPGEN], 1u);
            else XB_SPIN(xb_ld(&bar[XB_TOPGEN]) == tg, bar);
            __builtin_amdgcn_fence(__ATOMIC_ACQUIRE, "agent");
            xb_add(&bar[XB_XGEN(b.x)], 1u);
            asm volatile("s_waitcnt vmcnt(0)" ::: "memory");
        } else {
            XB_SPIN(xb_ld(&bar[XB_XGEN(b.x)]) == gen, bar);
            __builtin_amdgcn_fence(__ATOMIC_ACQUIRE, "agent");
            asm volatile("s_waitcnt vmcnt(0)" ::: "memory");
        }
    }
    __syncthreads();
}

namespace pg8 {
constexpr int BM = 256, BK = 64, HALF = 128, HTB = HALF * BK * 2, STAGE_BYTES = 8 * HTB;
__device__ __forceinline__ int lds_byte(int r, int c) { const int st = (r >> 4) * 2 + (c >> 5), rr = r & 15, cc = c & 31, ob = rr * 64 + cc * 2; return st * 1024 + (ob ^ (((ob >> 9) & 1) << 5)); }
__device__ __forceinline__ void stage_rc(int b, int& R, int& C) { const int st = b / 1024, sb = b % 1024, swz = sb ^ (((sb >> 9) & 1) << 5); R = (st >> 1) * 16 + swz / 64; C = (st & 1) * 32 + (swz % 64) / 2; }
__device__ __forceinline__ int perm32(int rho) { const int n = rho >> 4, i = rho & 15; return 8 * (i >> 2) + 4 * n + (i & 3); }

struct Unit { const char* A; const char* B; int pm, pn; const char* A2; const char* B2; };
struct Gemm { unsigned lda, ldb, kstepA; int K; unsigned lda2, ldb2; int K2; const int* tokl; const char* Abase; int sc_w, sc_a; };

template <class Epi, class Sched, bool ALIGN_EPI, bool SEG2 = false, bool GATHER = false, bool FP8 = false>
__device__ __forceinline__ void gemm_phase(LAS unsigned char* lds, const int tid, const Gemm g, const Sched& S, const Epi& E) {
    const int wid = __builtin_amdgcn_readfirstlane(tid >> 6), lane = tid & 63, wr = wid >> 2, wc = wid & 3, fr = lane & 15, fq = lane >> 4;
    const int nt0 = g.K / (FP8 ? 2 * BK : BK); const int nt = nt0 + (SEG2 ? g.K2 / BK : 0);
    unsigned voffA[2], voffB[2], voffA2[2], voffB2[2]; int Rrow[2]; unsigned Cb[2];
#pragma unroll
    for (int i = 0; i < 2; ++i) { int R, C; stage_rc(tid * 16 + i * 8192, R, C); Rrow[i] = R; Cb[i] = (unsigned)C * 2u; const int Rb = Epi::PERM ? ((R & ~31) + perm32(R & 31)) : R;
        voffA[i] = (unsigned)R * g.lda + (unsigned)C * 2u; voffB[i] = (unsigned)Rb * g.ldb + (unsigned)C * 2u;
        voffA2[i] = SEG2 ? (unsigned)R * g.lda2 + (unsigned)C * 2u : 0u; voffB2[i] = SEG2 ? (unsigned)Rb * g.ldb2 + (unsigned)C * 2u : 0u; }
    const size_t kstepA = (size_t)g.kstepA, kstepB = (size_t)(BK * 2);
    const size_t hstepA = (size_t)HALF * g.lda, hstepB = (size_t)HALF * g.ldb;
    const size_t hstepA2 = SEG2 ? (size_t)HALF * g.lda2 : 0, hstepB2 = SEG2 ? (size_t)HALF * g.ldb2 : 0;
    const unsigned ldsw = (unsigned)wid * 1024u;
    const int aoff = lds_byte(wr * 64 + fr, FP8 ? fq * 16 : fq * 8), boff = lds_byte(wc * 32 + fr, FP8 ? fq * 16 : fq * 8);
#define PG8_SA(b, h) (((b) * 2 + (h)) * HTB)
#define PG8_SB(b, h) ((4 + (b) * 2 + (h)) * HTB)
#define PG8_STAGE(bufoff, gbase, voff) do { _Pragma("unroll") for (int _i = 0; _i < 2; ++_i) \
        __builtin_amdgcn_global_load_lds((const unsigned*)((const char*)(gbase) + (voff)[_i]), (LAS unsigned*)(lds + (bufoff) + ldsw + _i * 8192), 16, 0, 0); } while (0)
#define PG8_STAGE2(bufoff, gbase, sel, v0, v1) do { _Pragma("unroll") for (int _i = 0; _i < 2; ++_i) \
        __builtin_amdgcn_global_load_lds((const unsigned*)((const char*)(gbase) + ((sel) ? (v1)[_i] : (v0)[_i])), (LAS unsigned*)(lds + (bufoff) + ldsw + _i * 8192), 16, 0, 0); } while (0)
#define PG8_LDA(dst, b, h) do { if constexpr (FP8) { _Pragma("unroll") for (int m = 0; m < 4; ++m) dst##8[m] = *(const LAS v8i_*)(lds + PG8_SA(b, h) + aoff + m * 2048); } \
        else { _Pragma("unroll") for (int m = 0; m < 4; ++m) _Pragma("unroll") for (int k = 0; k < 2; ++k) dst[m][k] = *(const LAS bf16x8*)(lds + PG8_SA(b, h) + aoff + m * 2048 + k * 1024); } } while (0)
#define PG8_LDB(dst, b, h) do { if constexpr (FP8) { _Pragma("unroll") for (int n = 0; n < 2; ++n) dst##8[n] = *(const LAS v8i_*)(lds + PG8_SB(b, h) + boff + n * 2048); } \
        else { _Pragma("unroll") for (int n = 0; n < 2; ++n) _Pragma("unroll") for (int k = 0; k < 2; ++k) dst[n][k] = *(const LAS bf16x8*)(lds + PG8_SB(b, h) + boff + n * 2048 + k * 1024); } } while (0)
#define PG8_MMA(ai, bj, At, Bt) do { __builtin_amdgcn_s_setprio(1); _Pragma("unroll") for (int m = 0; m < 4; ++m) _Pragma("unroll") for (int n = 0; n < 2; ++n) { \
        if constexpr (FP8) { asm volatile("v_mfma_f32_16x16x128_f8f6f4 %0, %1, %2, %0" : "+v"(acc[ai][bj][m][n]) : "v"(Bt##8[n]), "v"(At##8[m])); }     \
        else { _Pragma("unroll") for (int k = 0; k < 2; ++k) acc[ai][bj][m][n] = __builtin_amdgcn_mfma_f32_16x16x32_bf16(Bt[n][k], At[m][k], acc[ai][bj][m][n], 0, 0, 0); } } \
        __builtin_amdgcn_s_setprio(0); } while (0)
#define PG8_WAIT_V(n) asm volatile("s_waitcnt vmcnt(" #n ")" ::: "memory")
#define PG8_WAIT_L(n) asm volatile("s_waitcnt lgkmcnt(" #n ")" ::: "memory")
#define PG8_BAR __builtin_amdgcn_s_barrier()
#define PG8_SCHED __builtin_amdgcn_sched_barrier(0)
    Unit cur, nxt; int ui = 0;
    if (!S.next(0, cur)) return;
    f32x4 acc[2][2][4][2];
#pragma unroll
    for (int a = 0; a < 2; ++a)
#pragma unroll
        for (int b = 0; b < 2; ++b)
#pragma unroll
            for (int m = 0; m < 4; ++m)
#pragma unroll
                for (int n = 0; n < 2; ++n) acc[a][b][m][n] = (f32x4){0.f, 0.f, 0.f, 0.f};
    typedef int v8i_ __attribute__((ext_vector_type(8)));
    bf16x8 At[4][2], B0[2][2], B1[2][2]; v8i_ At8[4], B08[2], B18[2];
    const char* cA = GATHER ? g.Abase : cur.A; const char* cB = cur.B;
    unsigned vC0[2], vC1[2], vN0[2], vN1[2];
#define PG8_GLOAD(U, d0, d1) do { _Pragma("unroll") for (int _i = 0; _i < 2; ++_i) { \
        d0[_i] = (unsigned)g.tokl[(U).pm * 256 + Rrow[_i]] * g.lda + Cb[_i]; d1[_i] = (unsigned)g.tokl[(U).pm * 256 + 128 + Rrow[_i]] * g.lda + Cb[_i]; } } while (0)
    if constexpr (GATHER) { PG8_GLOAD(cur, vC0, vC1); }
    if constexpr (GATHER) {
        PG8_STAGE(PG8_SB(0, 0), cB, voffB); PG8_STAGE(PG8_SB(0, 1), cB + hstepB, voffB); PG8_STAGE(PG8_SA(0, 0), cA, vC0); PG8_STAGE(PG8_SA(0, 1), cA, vC1);
        if (wr == 1) PG8_BAR;
        PG8_WAIT_V(2); PG8_BAR;
        PG8_STAGE(PG8_SB(1, 0), cB + kstepB, voffB); PG8_STAGE(PG8_SA(1, 0), cA + kstepA, vC0); PG8_STAGE(PG8_SB(1, 1), cB + hstepB + kstepB, voffB);
        PG8_WAIT_V(6); PG8_BAR;
    } else {
    PG8_STAGE(PG8_SB(0, 0), cB, voffB); PG8_STAGE(PG8_SB(0, 1), cB + hstepB, voffB); PG8_STAGE(PG8_SA(0, 0), cA, voffA); PG8_STAGE(PG8_SA(0, 1), cA + hstepA, voffA);
    if (wr == 1) PG8_BAR;
    PG8_WAIT_V(2); PG8_BAR;
    PG8_STAGE(PG8_SB(1, 0), cB + kstepB, voffB); PG8_STAGE(PG8_SA(1, 0), cA + kstepA, voffA); PG8_STAGE(PG8_SB(1, 1), cB + hstepB + kstepB, voffB);
    PG8_WAIT_V(6); PG8_BAR;
    }
    for (;;) {
        const bool has_next = S.next(ui + 1, nxt);
        const char* nA = GATHER ? cA : (has_next ? nxt.A : cA); const char* nB = has_next ? nxt.B : cB;
        if constexpr (GATHER) { if (has_next) { PG8_GLOAD(nxt, vN0, vN1); } else { vN0[0] = vC0[0]; vN0[1] = vC0[1]; vN1[0] = vC1[0]; vN1[1] = vC1[1]; } }
#pragma clang loop unroll(disable)
        for (int t = 0; t < nt; t += 2) {
            const bool last = (t == nt - 2);
            if constexpr (SEG2) {
                const bool s1 = (t >= nt0);
                const bool s2 = !last && (t + 2 >= nt0);
                if (t == nt0) E.mid(acc, cur, wr, wc, fr, fq);
                const char* a1 = s1 ? cur.A2 + (size_t)(t + 1 - nt0) * kstepB : cA + (size_t)(t + 1) * kstepA; const size_t h1 = s1 ? hstepA2 : hstepA;
                const char* a2 = last ? nA : (s2 ? cur.A2 + (size_t)(t + 2 - nt0) * kstepB : cA + (size_t)(t + 2) * kstepA);
                const char* b2 = last ? nB : (s2 ? cur.B2 + (size_t)(t + 2 - nt0) * kstepB : cB + (size_t)(t + 2) * kstepB);
                const char* a3 = a2 + (s2 ? kstepB : kstepA); const char* b3 = b2 + kstepB;
                const size_t hA2 = s2 ? hstepA2 : hstepA, hB2 = s2 ? hstepB2 : hstepB;
                PG8_LDB(B0, 0, 0); PG8_LDB(B1, 0, 1); PG8_SCHED; PG8_LDA(At, 0, 0); PG8_STAGE2(PG8_SA(1, 1), a1 + h1, s1, voffA, voffA2);
                PG8_WAIT_V(8); PG8_WAIT_L(0); PG8_BAR; PG8_MMA(0, 0, At, B0); PG8_MMA(0, 1, At, B1); PG8_BAR; PG8_SCHED;
                PG8_LDA(At, 0, 1); PG8_STAGE2(PG8_SB(0, 0), b2, s2, voffB, voffB2); PG8_STAGE2(PG8_SB(0, 1), b2 + hB2, s2, voffB, voffB2); PG8_STAGE2(PG8_SA(0, 0), a2, s2, voffA, voffA2);
                PG8_WAIT_V(8); PG8_WAIT_L(0); PG8_BAR; PG8_MMA(1, 0, At, B0); PG8_MMA(1, 1, At, B1); PG8_BAR; PG8_SCHED;
                PG8_LDB(B0, 1, 0); PG8_LDB(B1, 1, 1); PG8_SCHED; PG8_LDA(At, 1, 0); PG8_STAGE2(PG8_SA(0, 1), a2 + hA2, s2, voffA, voffA2);
                PG8_WAIT_V(8); PG8_WAIT_L(0); PG8_BAR; PG8_MMA(0, 0, At, B0); PG8_MMA(0, 1, At, B1); PG8_BAR; PG8_SCHED;
                PG8_LDA(At, 1, 1); PG8_STAGE2(PG8_SB(1, 0), b3, s2, voffB, voffB2); PG8_STAGE2(PG8_SB(1, 1), b3 + hB2, s2, voffB, voffB2); PG8_STAGE2(PG8_SA(1, 0), a3, s2, voffA, voffA2);
                PG8_WAIT_V(8); PG8_WAIT_L(0); PG8_BAR; PG8_MMA(1, 0, At, B0); PG8_MMA(1, 1, At, B1); PG8_BAR; PG8_SCHED;
            } else if constexpr (GATHER) {
            const char* a1 = cA + (size_t)(t + 1) * kstepA;
            const char* a2 = last ? cA : cA + (size_t)(t + 2) * kstepA; const char* b2 = last ? nB : cB + (size_t)(t + 2) * kstepB;
            const char* a3 = a2 + kstepA; const char* b3 = b2 + kstepB;
            unsigned w0[2], w1[2]; w0[0] = last ? vN0[0] : vC0[0]; w0[1] = last ? vN0[1] : vC0[1]; w1[0] = last ? vN1[0] : vC1[0]; w1[1] = last ? vN1[1] : vC1[1];
            PG8_LDB(B0, 0, 0); PG8_LDB(B1, 0, 1); PG8_SCHED; PG8_LDA(At, 0, 0); PG8_STAGE(PG8_SA(1, 1), a1, vC1);
            PG8_WAIT_V(8); PG8_WAIT_L(0); PG8_BAR; PG8_MMA(0, 0, At, B0); PG8_MMA(0, 1, At, B1); PG8_BAR; PG8_SCHED;
            PG8_LDA(At, 0, 1); PG8_STAGE(PG8_SB(0, 0), b2, voffB); PG8_STAGE(PG8_SB(0, 1), b2 + hstepB, voffB); PG8_STAGE(PG8_SA(0, 0), a2, w0);
            PG8_WAIT_V(8); PG8_WAIT_L(0); PG8_BAR; PG8_MMA(1, 0, At, B0); PG8_MMA(1, 1, At, B1); PG8_BAR; PG8_SCHED;
            PG8_LDB(B0, 1, 0); PG8_LDB(B1, 1, 1); PG8_SCHED; PG8_LDA(At, 1, 0); PG8_STAGE(PG8_SA(0, 1), a2, w1);
            PG8_WAIT_V(8); PG8_WAIT_L(0); PG8_BAR; PG8_MMA(0, 0, At, B0); PG8_MMA(0, 1, At, B1); PG8_BAR; PG8_SCHED;
            PG8_LDA(At, 1, 1); PG8_STAGE(PG8_SB(1, 0), b3, voffB); PG8_STAGE(PG8_SB(1, 1), b3 + hstepB, voffB); PG8_STAGE(PG8_SA(1, 0), a3, w0);
            PG8_WAIT_V(8); PG8_WAIT_L(0); PG8_BAR; PG8_MMA(1, 0, At, B0); PG8_MMA(1, 1, At, B1); PG8_BAR; PG8_SCHED;
            } else {
            const char* a1 = cA + (size_t)(t + 1) * kstepA;
            const char* a2 = last ? nA : cA + (size_t)(t + 2) * kstepA; const char* b2 = last ? nB : cB + (size_t)(t + 2) * kstepB;
            const char* a3 = a2 + kstepA; const char* b3 = b2 + kstepB;
            PG8_LDB(B0, 0, 0); PG8_LDB(B1, 0, 1); PG8_SCHED; PG8_LDA(At, 0, 0); PG8_STAGE(PG8_SA(1, 1), a1 + hstepA, voffA);
            PG8_WAIT_V(8); PG8_WAIT_L(0); PG8_BAR; PG8_MMA(0, 0, At, B0); PG8_MMA(0, 1, At, B1); PG8_BAR; PG8_SCHED;
            PG8_LDA(At, 0, 1); PG8_STAGE(PG8_SB(0, 0), b2, voffB); PG8_STAGE(PG8_SB(0, 1), b2 + hstepB, voffB); PG8_STAGE(PG8_SA(0, 0), a2, voffA);
            PG8_WAIT_V(8); PG8_WAIT_L(0); PG8_BAR; PG8_MMA(1, 0, At, B0); PG8_MMA(1, 1, At, B1); PG8_BAR; PG8_SCHED;
            PG8_LDB(B0, 1, 0); PG8_LDB(B1, 1, 1); PG8_SCHED; PG8_LDA(At, 1, 0); PG8_STAGE(PG8_SA(0, 1), a2 + hstepA, voffA);
            PG8_WAIT_V(8); PG8_WAIT_L(0); PG8_BAR; PG8_MMA(0, 0, At, B0); PG8_MMA(0, 1, At, B1); PG8_BAR; PG8_SCHED;
            PG8_LDA(At, 1, 1); PG8_STAGE(PG8_SB(1, 0), b3, voffB); PG8_STAGE(PG8_SB(1, 1), b3 + hstepB, voffB); PG8_STAGE(PG8_SA(1, 0), a3, voffA);
            PG8_WAIT_V(8); PG8_WAIT_L(0); PG8_BAR; PG8_MMA(1, 0, At, B0); PG8_MMA(1, 1, At, B1); PG8_BAR; PG8_SCHED;
            }
        }
        if constexpr (ALIGN_EPI) { if (wr == 0) PG8_BAR; }
        if constexpr (FP8) { asm volatile("s_nop 15\n\ts_nop 15" ::: "memory"); }
        if constexpr (!Epi::AFTER_DRAIN) { int fr_ = fr, fq_ = fq; asm volatile("" : "+v"(fr_), "+v"(fq_));
            E(acc, cur, wr, wc, fr_, fq_); }
        if (!has_next) break;
#pragma unroll
        for (int a = 0; a < 2; ++a)
#pragma unroll
            for (int b = 0; b < 2; ++b)
#pragma unroll
                for (int m = 0; m < 4; ++m)
#pragma unroll
                    for (int n = 0; n < 2; ++n) acc[a][b][m][n] = (f32x4){0.f, 0.f, 0.f, 0.f};
        cur = nxt; cA = nA; cB = nB; ++ui;
        if constexpr (GATHER) { vC0[0] = vN0[0]; vC0[1] = vN0[1]; vC1[0] = vN1[0]; vC1[1] = vN1[1]; }
        if constexpr (ALIGN_EPI) { if (wr == 1) PG8_BAR; }
    }
    PG8_WAIT_V(0);
    if constexpr (!ALIGN_EPI) { if (wr == 0) PG8_BAR; }
    PG8_BAR;
    if constexpr (Epi::AFTER_DRAIN) { E.fused(acc, cur, wr, wc, fr, fq, wid, lane); }
#undef PG8_SA
#undef PG8_SB
#undef PG8_STAGE
#undef PG8_STAGE2
#undef PG8_GLOAD
#undef PG8_LDA
#undef PG8_LDB
#undef PG8_MMA
#undef PG8_WAIT_V
#undef PG8_WAIT_L
#undef PG8_BAR
#undef PG8_SCHED
}

struct DenseOrder {
    int nM, nN, nwg, G, c; const char* A; const char* B; size_t tA, tB; const char* A2 = nullptr; const char* B2 = nullptr; size_t tA2 = 0, tB2 = 0;
    __device__ __forceinline__ void init(int M, int N, int G_, int c_, const void* A_, unsigned lda, const void* B_, unsigned ldb) {
        nM = M / BM; nN = N / BM; nwg = nM * nN; G = G_; c = c_; A = (const char*)A_; B = (const char*)B_; tA = (size_t)BM * lda; tB = (size_t)BM * ldb; }
    __device__ __forceinline__ bool next(int i, Unit& u) const {
        const long L = (long)i * G + c; if (L >= nwg) return false;
        int wgid = (int)L; { const int q = nwg / 8, r = nwg % 8, xcd = wgid % 8, off = wgid / 8; wgid = (xcd < r ? xcd * (q + 1) : r * (q + 1) + (xcd - r) * q) + off; }
        const int nig = 8 * nN, gid = wgid / nig, fm = gid * 8, gsz = (nM - fm) < 8 ? (nM - fm) : 8;
        u.pm = fm + ((wgid % nig) % gsz); u.pn = (wgid % nig) / gsz;
        u.A = A + (size_t)u.pm * tA; u.B = B + (size_t)u.pn * tB; u.A2 = A2 + (size_t)u.pm * tA2; u.B2 = B2 + (size_t)u.pn * tB2; return true;
    }
};
}

struct Args {
    const float* x; const float* c; const float* rel_bias; const float* ada_w; const float* ada_b; const float* norm1; const float* norm2; const float* w_in;
    const float* cmp_pos; const float* cmp_w1; const float* cmp_w2; const float* w_up_nsa; const float* w_up_dil; const float* w_o;
    const float* router_wg; const float* router_bg; const float* router_we; const float* router_be; const float* exp_w1; const float* exp_w3; const float* exp_w2; const float* norm_f;
    float* out; unsigned char* ws; int ph_lo, ph_hi, use_bar, pad;
};

typedef f32x4 AccT[2][2][4][2];
__device__ __forceinline__ unsigned q8(float x) { return (unsigned)(sigmoidf_(x) * 255.0f + 0.5f); }
struct EpiInProj {
    static constexpr bool PERM = true, AFTER_DRAIN = false;
    bf16_t* QKV; unsigned char* MG; float* GN; float os;
    __device__ __forceinline__ void operator()(const AccT& acc, const pg8::Unit& u, int wr, int wc, int fr, int fq) const {
        const int pn = u.pn; const int row0 = u.pm * 256 + wr * 64 + fr;
        if (pn < 14) {
            const float sc = ((pn < 2 || (pn >= 5 && pn < 8)) ? C2 : 1.0f) * os;
            const int col0 = pn * 256 + wc * 32 + 8 * fq;
#pragma unroll
            for (int ai = 0; ai < 2; ++ai)
#pragma unroll
                for (int m = 0; m < 4; ++m) { bf16_t* rowp = QKV + (size_t)(row0 + ai * 128 + m * 16) * LDQ + col0;
#pragma unroll
                    for (int bj = 0; bj < 2; ++bj) { const f32x4 v0 = acc[ai][bj][m][0] * sc, v1 = acc[ai][bj][m][1] * sc; u32x4 w;
                        w.x = cvt_pk_bf16(v0[0], v0[1]); w.y = cvt_pk_bf16(v0[2], v0[3]); w.z = cvt_pk_bf16(v1[0], v1[1]); w.w = cvt_pk_bf16(v1[2], v1[3]);
                        *(u32x4*)(rowp + bj * 128) = w; } }
        } else if (pn < 22) {
            const int col0 = (pn - 14) * 256 + wc * 32 + 8 * fq;
#pragma unroll
            for (int ai = 0; ai < 2; ++ai)
#pragma unroll
                for (int m = 0; m < 4; ++m) { unsigned char* rowp = MG + (size_t)(row0 + ai * 128 + m * 16) * 2048 + col0;
#pragma unroll
                    for (int bj = 0; bj < 2; ++bj) { const f32x4 v0 = acc[ai][bj][m][0] * os, v1 = acc[ai][bj][m][1] * os; u32x2 w;
                        w.x = q8(v0[0]) | (q8(v0[1]) << 8) | (q8(v0[2]) << 16) | (q8(v0[3]) << 24); w.y = q8(v1[0]) | (q8(v1[1]) << 8) | (q8(v1[2]) << 16) | (q8(v1[3]) << 24);
                        *(u32x2*)(rowp + bj * 128) = w; } }
        } else {
            if (wc == 0 && fq < 3) {
#pragma unroll
                for (int ai = 0; ai < 2; ++ai)
#pragma unroll
                    for (int m = 0; m < 4; ++m) { float* rowp = GN + (size_t)(row0 + ai * 128 + m * 16) * 32 + 8 * fq;
                        const f32x4 v0 = acc[ai][0][m][0] * os, v1 = acc[ai][0][m][1] * os;
                        *(f32x4*)(rowp) = (f32x4){sigmoidf_(v0[0]), sigmoidf_(v0[1]), sigmoidf_(v0[2]), sigmoidf_(v0[3])};
                        *(f32x4*)(rowp + 4) = (f32x4){sigmoidf_(v1[0]), sigmoidf_(v1[1]), sigmoidf_(v1[2]), sigmoidf_(v1[3])}; }
            }
        }
    }
};
template <int PASS> struct EpiUp {
    static constexpr bool PERM = true, AFTER_DRAIN = false;
    bf16_t* MERGED; const bf16_t* MG;
    __device__ __forceinline__ void operator()(const AccT& acc, const pg8::Unit& u, int wr, int wc, int fr, int fq) const {
        const int row0 = u.pm * 256 + wr * 64 + fr; const int col0 = u.pn * 256 + wc * 32 + 8 * fq;
#pragma unroll
        for (int ai = 0; ai < 2; ++ai)
#pragma unroll
            for (int m = 0; m < 4; ++m) { const size_t row = (size_t)(row0 + ai * 128 + m * 16);
#pragma unroll
                for (int bj = 0; bj < 2; ++bj) {
                    const u32x4 gw = *(const u32x4*)(MG + row * 2048 + PASS * 1024 + col0 + bj * 128);
                    bf16_t* op = MERGED + row * 1024 + col0 + bj * 128;
                    const f32x4 v0 = acc[ai][bj][m][0], v1 = acc[ai][bj][m][1];
                    float r[8] = {v0[0] * bf_lo(gw.x), v0[1] * bf_hi(gw.x), v0[2] * bf_lo(gw.y), v0[3] * bf_hi(gw.y), v1[0] * bf_lo(gw.z), v1[1] * bf_hi(gw.z), v1[2] * bf_lo(gw.w), v1[3] * bf_hi(gw.w)};
                    if (PASS == 1) { const u32x4 ow = *(const u32x4*)op;
                        r[0] += bf_lo(ow.x); r[1] += bf_hi(ow.x); r[2] += bf_lo(ow.y); r[3] += bf_hi(ow.y); r[4] += bf_lo(ow.z); r[5] += bf_hi(ow.z); r[6] += bf_lo(ow.w); r[7] += bf_hi(ow.w); }
                    u32x4 w; w.x = cvt_pk_bf16(r[0], r[1]); w.y = cvt_pk_bf16(r[2], r[3]); w.z = cvt_pk_bf16(r[4], r[5]); w.w = cvt_pk_bf16(r[6], r[7]);
                    *(u32x4*)op = w; }
                asm volatile("" ::: "memory"); }
    }
};
struct EpiUpFused {
    static constexpr bool PERM = true, AFTER_DRAIN = false;
    bf16_t* MERGED; const unsigned char* MG;
    __device__ __forceinline__ void mid(AccT& acc, const pg8::Unit& u, int wr, int wc, int fr, int fq) const {
        const int row0 = u.pm * 256 + wr * 64 + fr; const int col0 = u.pn * 256 + wc * 32 + 8 * fq;
#pragma unroll
        for (int ai = 0; ai < 2; ++ai)
#pragma unroll
            for (int m = 0; m < 4; ++m) { const size_t row = (size_t)(row0 + ai * 128 + m * 16);
#pragma unroll
                for (int bj = 0; bj < 2; ++bj) {
                    const u32x2 g0 = *(const u32x2*)(MG + row * 2048 + col0 + bj * 128), g1 = *(const u32x2*)(MG + row * 2048 + 1024 + col0 + bj * 128);
                    f32x4& v0 = acc[ai][bj][m][0]; f32x4& v1 = acc[ai][bj][m][1];
#pragma unroll
                    for (int j = 0; j < 4; ++j) { const float a0 = (float)((g0.x >> (8 * j)) & 255u), b0 = (float)((g1.x >> (8 * j)) & 255u), a1 = (float)((g0.y >> (8 * j)) & 255u), b1 = (float)((g1.y >> (8 * j)) & 255u);
                        v0[j] *= a0 * __builtin_amdgcn_rcpf(__builtin_fmaxf(b0, 0.5f)); v1[j] *= a1 * __builtin_amdgcn_rcpf(__builtin_fmaxf(b1, 0.5f)); } }
                asm volatile("" ::: "memory"); }
    }
    __device__ __forceinline__ void operator()(const AccT& acc, const pg8::Unit& u, int wr, int wc, int fr, int fq) const {
        const int row0 = u.pm * 256 + wr * 64 + fr; const int col0 = u.pn * 256 + wc * 32 + 8 * fq;
#pragma unroll
        for (int ai = 0; ai < 2; ++ai)
#pragma unroll
            for (int m = 0; m < 4; ++m) { const size_t row = (size_t)(row0 + ai * 128 + m * 16);
#pragma unroll
                for (int bj = 0; bj < 2; ++bj) {
                    const u32x2 g1 = *(const u32x2*)(MG + row * 2048 + 1024 + col0 + bj * 128);
                    const f32x4 v0 = acc[ai][bj][m][0], v1 = acc[ai][bj][m][1]; float r[8];
#pragma unroll
                    for (int j = 0; j < 4; ++j) { r[j] = v0[j] * (__builtin_fmaxf((float)((g1.x >> (8 * j)) & 255u), 0.5f) * (1.0f / 255.0f)); r[4 + j] = v1[j] * (__builtin_fmaxf((float)((g1.y >> (8 * j)) & 255u), 0.5f) * (1.0f / 255.0f)); }
                    u32x4 w; w.x = cvt_pk_bf16(r[0], r[1]); w.y = cvt_pk_bf16(r[2], r[3]); w.z = cvt_pk_bf16(r[4], r[5]); w.w = cvt_pk_bf16(r[6], r[7]);
                    *(u32x4*)(MERGED + row * 1024 + col0 + bj * 128) = w; }
                asm volatile("" ::: "memory"); }
    }
};
struct EpiOut {
    static constexpr bool PERM = true, AFTER_DRAIN = false;
    const float* xin; float* xout; const float* g1;
    __device__ __forceinline__ void operator()(const AccT& acc, const pg8::Unit& u, int wr, int wc, int fr, int fq) const {
        const int row0 = u.pm * 256 + wr * 64 + fr; const int col0 = u.pn * 256 + wc * 32 + 8 * fq; const int b = u.pm >> 4;
        f32x4 gv[2][2];
#pragma unroll
        for (int bj = 0; bj < 2; ++bj)
#pragma unroll
            for (int n = 0; n < 2; ++n) gv[bj][n] = *(const f32x4*)(g1 + (size_t)b * 6144 + col0 + bj * 128 + 4 * n);
#pragma unroll
        for (int ai = 0; ai < 2; ++ai)
#pragma unroll
            for (int m = 0; m < 4; ++m) { const size_t off = (size_t)(row0 + ai * 128 + m * 16) * 1024 + col0;
#pragma unroll
                for (int bj = 0; bj < 2; ++bj)
#pragma unroll
                    for (int n = 0; n < 2; ++n) { const f32x4 xv = *(const f32x4*)(xin + off + bj * 128 + 4 * n);
                        *(f32x4*)(xout + off + bj * 128 + 4 * n) = (ABL == 7) ? xv : xv + gv[bj][n] * acc[ai][bj][m][n]; }
                asm volatile("" ::: "memory"); }
    }
};
struct EpiMoe1 {
    static constexpr bool PERM = true, AFTER_DRAIN = false;
    unsigned char* ACT; float os;
    __device__ __forceinline__ void operator()(const AccT& acc, const pg8::Unit& u, int wr, int wc, int fr, int fq) const {
        const int row0 = u.pm * 256 + wr * 64 + fr; const int col0 = u.pn * 128 + wc * 32 + 8 * fq;
#pragma unroll
        for (int ai = 0; ai < 2; ++ai)
#pragma unroll
            for (int m = 0; m < 4; ++m) { unsigned char* op = ACT + (size_t)(row0 + ai * 128 + m * 16) * 512 + col0; float r[8];
#pragma unroll
                for (int n = 0; n < 2; ++n)
#pragma unroll
                    for (int j = 0; j < 4; ++j) { const float a = acc[ai][0][m][n][j] * os, bb = acc[ai][1][m][n][j] * os; r[n * 4 + j] = a * sigmoidf_(a) * bb * 4.0f; }
                u32x2 w; w.x = (unsigned)__builtin_amdgcn_cvt_pk_fp8_f32(r[0], r[1], 0, false); w.x = (unsigned)__builtin_amdgcn_cvt_pk_fp8_f32(r[2], r[3], (int)w.x, true);
                w.y = (unsigned)__builtin_amdgcn_cvt_pk_fp8_f32(r[4], r[5], 0, false); w.y = (unsigned)__builtin_amdgcn_cvt_pk_fp8_f32(r[6], r[7], (int)w.y, true);
                *(u32x2*)op = w; }
    }
};
struct EpiPlain {
    static constexpr bool PERM = true, AFTER_DRAIN = false;
    bf16_t* O; int ldc; float os;
    __device__ __forceinline__ void operator()(const AccT& acc, const pg8::Unit& u, int wr, int wc, int fr, int fq) const {
        const int row0 = u.pm * 256 + wr * 64 + fr; const int col0 = u.pn * 256 + wc * 32 + 8 * fq;
#pragma unroll
        for (int ai = 0; ai < 2; ++ai)
#pragma unroll
            for (int m = 0; m < 4; ++m) { bf16_t* rowp = O + (size_t)(row0 + ai * 128 + m * 16) * ldc + col0;
#pragma unroll
                for (int bj = 0; bj < 2; ++bj) { const f32x4 v0 = acc[ai][bj][m][0] * os, v1 = acc[ai][bj][m][1] * os; u32x4 w;
                    w.x = cvt_pk_bf16(v0[0], v0[1]); w.y = cvt_pk_bf16(v0[2], v0[3]); w.z = cvt_pk_bf16(v1[0], v1[1]); w.w = cvt_pk_bf16(v1[2], v1[3]);
                    *(u32x4*)(rowp + bj * 128) = w; } }
    }
};
__device__ __forceinline__ int crow(int r, int hi) { return (r & 3) + 8 * (r >> 2) + 4 * hi; }
__device__ __forceinline__ float gelu_tanh(float x) { const float u2 = 2.0f * 0.7978845608028654f * (x + 0.044715f * x * x * x); return x * __builtin_amdgcn_rcpf(1.0f + __builtin_amdgcn_exp2f(-u2 * LOG2E)); }
struct EpiCmp {
    static constexpr bool PERM = true, AFTER_DRAIN = true;
    bf16_t* HID; const float* CB1; const bf16_t* CW2T; bf16_t* KC;
    __device__ __forceinline__ void fused(const AccT& acc, const pg8::Unit& u, int wr, int wc, int fr, int fq, int wid, int lane) const {
        const int kv = u.pm >> 4; const int row0 = u.pm * 256 + wr * 64 + fr; const int col0 = wc * 32 + 8 * fq;
        const float* bias = CB1 + kv * 256;
        f32x4 bv[2][2];
#pragma unroll
        for (int bj = 0; bj < 2; ++bj)
#pragma unroll
            for (int n = 0; n < 2; ++n) bv[bj][n] = *(const f32x4*)(bias + col0 + bj * 128 + 4 * n);
#pragma unroll
        for (int ai = 0; ai < 2; ++ai)
#pragma unroll
            for (int m = 0; m < 4; ++m) { bf16_t* rowp = HID + (size_t)(row0 + ai * 128 + m * 16) * 256 + col0;
#pragma unroll
                for (int bj = 0; bj < 2; ++bj) { const f32x4 v0 = acc[ai][bj][m][0] + bv[bj][0], v1 = acc[ai][bj][m][1] + bv[bj][1]; u32x4 w;
                    w.x = cvt_pk_bf16(gelu_tanh(v0[0]), gelu_tanh(v0[1])); w.y = cvt_pk_bf16(gelu_tanh(v0[2]), gelu_tanh(v0[3]));
                    w.z = cvt_pk_bf16(gelu_tanh(v1[0]), gelu_tanh(v1[1])); w.w = cvt_pk_bf16(gelu_tanh(v1[2]), gelu_tanh(v1[3]));
                    *(u32x4*)(rowp + bj * 128) = w; } }
        VM_WAIT(); __syncthreads();
        const int r32 = lane & 31, hi = lane >> 5;
        const bf16_t* ap = HID + (size_t)(u.pm * 256 + 32 * wid + r32) * 256 + hi * 8;
        const bf16_t* bp = CW2T + (size_t)kv * 64 * 256 + (size_t)r32 * 256 + hi * 8;
        f32x16 o0 = {}, o1 = {};
#pragma unroll 4
        for (int ks = 0; ks < 16; ++ks) {
            const bf16x8 a = *(const bf16x8*)(ap + ks * 16);
            const bf16x8 b0 = *(const bf16x8*)(bp + ks * 16), b1 = *(const bf16x8*)(bp + 32 * 256 + ks * 16);
            o0 = __builtin_amdgcn_mfma_f32_32x32x16_bf16(a, b0, o0, 0, 0, 0);
            o1 = __builtin_amdgcn_mfma_f32_32x32x16_bf16(a, b1, o1, 0, 0, 0);
        }
        bf16_t* kc = KC + (size_t)u.pm * 256 * 64;
#pragma unroll
        for (int r = 0; r < 16; ++r) { const int c = 32 * wid + crow(r, hi); const bool pad = (c == 255);
            kc[(size_t)c * 64 + r32] = pad ? (bf16_t)0 : (bf16_t)(cvt_pk_bf16(o0[r], 0.f) & 0xffffu);
            kc[(size_t)c * 64 + 32 + r32] = pad ? (bf16_t)0 : (bf16_t)(cvt_pk_bf16(o1[r], 0.f) & 0xffffu); }
    }
};

namespace att {
constexpr int L_KR = 0;
constexpr int L_VR = 24576;
constexpr int L_WSF = 49152;
constexpr int L_BKT = 51200;
constexpr int L_BKC = 55296;
constexpr int L_TBH = 64000;
constexpr int L_GSH = 64576;
constexpr int L_SEL = 67648;
constexpr int L_OTA = 68672;
constexpr int L_IMP = 101440;
constexpr int L_LUT = 117824;
constexpr int L_END = L_LUT + 40960;
static_assert(L_END <= LDS_MISC, "attention LDS map");

__device__ __forceinline__ void glds16(const void* gsrc, unsigned lds_dst) { unsigned keep;
    asm volatile("s_mov_b32 %0, m0\n\ts_mov_b32 m0, %2\n\ts_nop 0\n\tglobal_load_lds_dwordx4 %1, off\n\ts_mov_b32 m0, %0" : "=&s"(keep) : "v"(gsrc), "s"(lds_dst) : "memory"); }
__device__ __forceinline__ int bucket_of(int d) {
    if (d < 16) return d;
    int b = 16;
    b += (d >= 22); b += (d >= 30); b += (d >= 40); b += (d >= 54); b += (d >= 73); b += (d >= 99); b += (d >= 134); b += (d >= 182);
    b += (d >= 246); b += (d >= 332); b += (d >= 450); b += (d >= 609); b += (d >= 825); b += (d >= 1117); b += (d >= 1513);
    return b;
}
__device__ __forceinline__ void qkt(f32x16& p0, f32x16& p1, const LAS unsigned char* Kslot, const bf16x8 (&qr)[4], int r32, int hi) {
    const LAS unsigned char* kb = Kslot + hi * 1024 + r32 * 16;
    p0 = (f32x16){}; p1 = (f32x16){};
#pragma unroll
    for (int d0 = 0; d0 < 4; ++d0) {
        const bf16x8 b0 = *(const LAS bf16x8*)(kb + d0 * 2048);
        const bf16x8 b1 = *(const LAS bf16x8*)(kb + d0 * 2048 + 512);
        p0 = __builtin_amdgcn_mfma_f32_32x32x16_bf16(b0, qr[d0], p0, 0, 0, 0);
        p1 = __builtin_amdgcn_mfma_f32_32x32x16_bf16(b1, qr[d0], p1, 0, 0, 0);
    }
}
__device__ __forceinline__ void pv(f32x16 (&o)[2], int vb, bf16x8 pa0, bf16x8 pa1, bf16x8 pa2, bf16x8 pa3) {
#pragma unroll
    for (int d0 = 0; d0 < 2; ++d0) { s16x4 lo[4], hi[4];
#pragma unroll
        for (int ks = 0; ks < 4; ++ks) {
            asm volatile("ds_read_b64_tr_b16 %0,%1 offset:%c2" : "=&v"(lo[ks]) : "v"(vb), "i"(d0 * 4096 + ks * 1024) : "memory");
            asm volatile("ds_read_b64_tr_b16 %0,%1 offset:%c2" : "=&v"(hi[ks]) : "v"(vb), "i"(d0 * 4096 + ks * 1024 + 512) : "memory"); }
        asm volatile("s_waitcnt lgkmcnt(0)" ::: "memory"); __builtin_amdgcn_sched_barrier(0);
#define PK(k) (bf16x8){lo[k][0], lo[k][1], lo[k][2], lo[k][3], hi[k][0], hi[k][1], hi[k][2], hi[k][3]}
        o[d0] = __builtin_amdgcn_mfma_f32_32x32x16_bf16(pa0, PK(0), o[d0], 0, 0, 0);
        o[d0] = __builtin_amdgcn_mfma_f32_32x32x16_bf16(pa1, PK(1), o[d0], 0, 0, 0);
        o[d0] = __builtin_amdgcn_mfma_f32_32x32x16_bf16(pa2, PK(2), o[d0], 0, 0, 0);
        o[d0] = __builtin_amdgcn_mfma_f32_32x32x16_bf16(pa3, PK(3), o[d0], 0, 0, 0);
#undef PK
    }
}
__device__ __forceinline__ float xhalf_max(float v) { auto rr = __builtin_amdgcn_permlane32_swap(__float_as_uint(v), __float_as_uint(v), false, false); return __builtin_fmaxf(__uint_as_float(rr[0]), __uint_as_float(rr[1])); }
__device__ __forceinline__ float xhalf_sum(float v) { auto rr = __builtin_amdgcn_permlane32_swap(__float_as_uint(v), __float_as_uint(v), false, false); return __uint_as_float(rr[0]) + __uint_as_float(rr[1]); }

#define ATT_PACK(p0, p1, pw0, pw1, pw2, pw3) do { \
    pw0 = (u32x4){cvt_pk_bf16(p0[0], p0[1]), cvt_pk_bf16(p0[2], p0[3]), cvt_pk_bf16(p0[4], p0[5]), cvt_pk_bf16(p0[6], p0[7])}; \
    pw1 = (u32x4){cvt_pk_bf16(p0[8], p0[9]), cvt_pk_bf16(p0[10], p0[11]), cvt_pk_bf16(p0[12], p0[13]), cvt_pk_bf16(p0[14], p0[15])}; \
    pw2 = (u32x4){cvt_pk_bf16(p1[0], p1[1]), cvt_pk_bf16(p1[2], p1[3]), cvt_pk_bf16(p1[4], p1[5]), cvt_pk_bf16(p1[6], p1[7])}; \
    pw3 = (u32x4){cvt_pk_bf16(p1[8], p1[9]), cvt_pk_bf16(p1[10], p1[11]), cvt_pk_bf16(p1[12], p1[13]), cvt_pk_bf16(p1[14], p1[15])}; } while (0)

__device__ __forceinline__ void stage_rows(LAS unsigned char* lds, int wid, int lane, const f32x16 (&ot)[2]) {
    const int r32 = lane & 31, hi = lane >> 5;
    LAS bf16_t* stg = (LAS bf16_t*)(lds + L_OTA) + wid * 2048;
#pragma unroll
    for (int r = 0; r < 16; ++r) { const int orow = crow(r, hi);
#pragma unroll
        for (int d0 = 0; d0 < 2; ++d0) stg[orow * 64 + d0 * 32 + r32] = (bf16_t)(cvt_pk_bf16(ot[d0][r], 0.f) & 0xffffu); }
    LDS_WAIT();
}
struct StreamP { const bf16_t* Kb; const bf16_t* Vb; long pitch; int NT; const LAS unsigned char* tl; unsigned long long lanesel; int uq; const LAS float* lut; int xtop; int dclamp; };
typedef const LAS unsigned char* lds_cptr;
typedef short v4i16_t __attribute__((ext_vector_type(4)));
__device__ __forceinline__ void kload8(bf16x8* kf, lds_cptr kp) {
    kf[0] = *(const LAS bf16x8*)(kp);        kf[1] = *(const LAS bf16x8*)(kp + 512);
    kf[2] = *(const LAS bf16x8*)(kp + 2048); kf[3] = *(const LAS bf16x8*)(kp + 2560);
    kf[4] = *(const LAS bf16x8*)(kp + 4096); kf[5] = *(const LAS bf16x8*)(kp + 4608);
    kf[6] = *(const LAS bf16x8*)(kp + 6144); kf[7] = *(const LAS bf16x8*)(kp + 6656);
}
__device__ __forceinline__ void kload2(bf16x8* kf, lds_cptr kp, int j) { kf[2 * j] = *(const LAS bf16x8*)(kp + j * 2048); kf[2 * j + 1] = *(const LAS bf16x8*)(kp + j * 2048 + 512); }
__device__ __forceinline__ s16x4 vtr(lds_cptr p) { return __builtin_bit_cast(s16x4, __builtin_amdgcn_ds_read_tr16_b64_v4i16((LAS v4i16_t*)p)); }
constexpr int SLOTB = 8192;
#define ST_WAIT_BAR(N) asm volatile("s_waitcnt vmcnt(" #N ") lgkmcnt(0)\n\ts_barrier" ::: "memory")
template <int THRL>
__device__ __forceinline__ void attn_stream(LAS unsigned char* lds, const int wid, const int lane, const bf16x8 (&qr)[4], const StreamP S, float& mhat_o, float& l_o, f32x16 (&o)[2]) {
    const int r32 = lane & 31, hi = lane >> 5;
    const unsigned lds0 = (unsigned)(uintptr_t)lds;
    LAS float* wsf = (LAS float*)(lds + L_WSF) + wid * 64;
    const int NT = S.NT;
    const bf16_t* ksrc = S.Kb + (long)lane * S.pitch + wid * 8;
    const bf16_t* vsrc = S.Vb + (long)(16 * (wid & 3) + (lane >> 2)) * S.pitch + (wid >> 2) * 32 + (lane & 3) * 8;
    const unsigned kdst = lds0 + L_KR + wid * 1024, vdst = lds0 + L_VR + wid * 1024;
    const int tlv = (lane < NT) ? (int)S.tl[lane] : 0x80;
#define TLRAW(k) ((int)__builtin_amdgcn_readlane(tlv, __builtin_amdgcn_readfirstlane(k)))
#define DMA_K(k, slot) do { const int tr_ = TLRAW(k) & 63; glds16(ksrc + (long)tr_ * 64 * S.pitch, (unsigned)__builtin_amdgcn_readfirstlane(kdst + (slot))); } while (0)
#define DMA_V(k, slot) do { const int tr_ = TLRAW(k) & 63; glds16(vsrc + (long)tr_ * 64 * S.pitch, (unsigned)__builtin_amdgcn_readfirstlane(vdst + (slot))); } while (0)
    const lds_cptr kp0 = (lds_cptr)lds + L_KR + hi * 1024 + r32 * 16;
    const lds_cptr vp0 = (lds_cptr)lds + L_VR + ((lane >> 4) & 1) * 32 + (lane & 3) * 8 + (4 * hi + ((lane & 15) >> 2)) * 64;
    const int vb0 = (int)(lds0 + L_VR) + ((lane >> 4) & 1) * 32 + (lane & 3) * 8 + (4 * hi + ((lane & 15) >> 2)) * 64;
    bf16x8 kf[8];
#define LOFF(r) (((r) & 3) + 8 * ((r) >> 2))
#define LUTPTR(k, lp) do { const int raw_ = TLRAW(k); const int tj_ = raw_ & 63; int d0_ = S.uq - 64 * tj_ - 4 * hi; d0_ = d0_ < S.dclamp ? d0_ : S.dclamp; \
        const bool ok_ = (raw_ < 128) && (((S.lanesel >> tj_) & 1ull) != 0ull); lp = S.lut + (ok_ ? S.xtop - d0_ : S.xtop + 64); } while (0)
#define LUTLOAD(C0, C1, k) do { const int raw_ = TLRAW(k); const int tj_ = raw_ & 63; int d0_ = S.uq - 64 * tj_ - 4 * hi; d0_ = d0_ < S.dclamp ? d0_ : S.dclamp; \
        const bool ok_ = (raw_ < 128) && (((S.lanesel >> tj_) & 1ull) != 0ull); const LAS float* lp_ = S.lut + (ok_ ? S.xtop - d0_ : S.xtop + 64); \
        _Pragma("unroll") for (int r = 0; r < 16; ++r) { C0[r] = lp_[(r & 3) + 8 * (r >> 2)]; C1[r] = lp_[(r & 3) + 8 * (r >> 2) + 32]; } } while (0)
#define SBAR() __builtin_amdgcn_sched_barrier(0)
#define PIN(x) asm volatile("" : "+v"(x))
#define PKW(P, B) cvt_pk_bf16(P[B], P[B + 1])
#define PAF(k) __builtin_bit_cast(bf16x8, pw##k)
#define VFR(i) (bf16x8){vlo[i][0], vlo[i][1], vlo[i][2], vlo[i][3], vhi[i][0], vhi[i][1], vhi[i][2], vhi[i][3]}
#define MX3(a, b, c) __builtin_fmaxf(__builtin_fmaxf((a), (b)), (c))
#define MFMA32(a, b, c) __builtin_amdgcn_mfma_f32_32x32x16_bf16(a, b, c, 0, 0, 0)
#define GAPA(MF, A0, A1, A2, A3, W0, W1, PW) do { MF; sacc += A0; sacc += A1; sacc += A2; sacc += A3; PIN(sacc); W0; W1; PIN(PW); SBAR(); } while (0)
#define EX(v) __builtin_amdgcn_exp2f(v)
#define GAPB(MF, X, B, GN, PL, PO) do { MF; X[B] = EX(X[B]); X[B + 1] = EX(X[B + 1]); X[B + 2] = EX(X[B + 2]); X[B + 3] = EX(X[B + 3]); PIN(X); \
        if (GN) { PL[B] = lpn_[LOFF(B) + PO]; PL[B + 1] = lpn_[LOFF(B + 1) + PO]; PL[B + 2] = lpn_[LOFF(B + 2) + PO]; PL[B + 3] = lpn_[LOFF(B + 3) + PO]; } SBAR(); } while (0)
#define VRD(i) do { vlo[i] = vtr(vp_ + (((i) >> 2) * 4096 + ((i) & 3) * 1024)); vhi[i] = vtr(vp_ + (((i) >> 2) * 4096 + ((i) & 3) * 1024 + 512)); } while (0)
#define KRD(G, j) do { if (G) { kload2(kf, kp0 + sl_next, j); SBAR(); } } while (0)
#define ROT() do { sl_prev = sl_cur; sl_cur = sl_next; sl_next = (sl_next == 2 * SLOTB) ? 0 : sl_next + SLOTB; } while (0)
#define RESC() do { if (resc) { LDS_WAIT(); _Pragma("unroll") for (int d_ = 0; d_ < 2; ++d_) _Pragma("unroll") for (int r = 0; r < 16; ++r) o[d_][r] *= wsf[crow(r, hi)]; } } while (0)
#define ENDW(tt) do { if ((tt) + 3 < NT) { ST_WAIT_BAR(2); } else if ((tt) + 2 < NT) { ST_WAIT_BAR(1); } else { ST_WAIT_BAR(0); } } while (0)
#define STEP(C0, C1, P0, P1, t, GK, GV, GL, GN) do { SBAR(); \
    const lds_cptr vp_ = vp0 + sl_prev; const LAS float* lpn_ = S.lut; if (GN) { LUTPTR((t) + 1, lpn_); } \
    VRD(0); SBAR(); float sacc = (P0[0] + P0[1]); \
    GAPA(C0 = MFMA32(kf[0], qr[0], C0), P0[2], P0[3], P0[4], P0[5],     pw0[0] = PKW(P0, 0), pw0[1] = PKW(P0, 2), pw0); \
    VRD(4); SBAR(); GAPA(C1 = MFMA32(kf[1], qr[0], C1), P0[6], P0[7], P0[8], P0[9],     pw0[2] = PKW(P0, 4), pw0[3] = PKW(P0, 6), pw0); \
    VRD(1); SBAR(); GAPA(C0 = MFMA32(kf[2], qr[1], C0), P0[10], P0[11], P0[12], P0[13], pw1[0] = PKW(P0, 8), pw1[1] = PKW(P0, 10), pw1); \
    VRD(5); SBAR(); GAPA(C1 = MFMA32(kf[3], qr[1], C1), P0[14], P0[15], P1[0], P1[1],   pw1[2] = PKW(P0, 12), pw1[3] = PKW(P0, 14), pw1); \
    VRD(2); SBAR(); GAPA(C0 = MFMA32(kf[4], qr[2], C0), P1[2], P1[3], P1[4], P1[5],     pw2[0] = PKW(P1, 0), pw2[1] = PKW(P1, 2), pw2); \
    VRD(6); SBAR(); GAPA(C1 = MFMA32(kf[5], qr[2], C1), P1[6], P1[7], P1[8], P1[9],     pw2[2] = PKW(P1, 4), pw2[3] = PKW(P1, 6), pw2); \
    VRD(3); SBAR(); GAPA(C0 = MFMA32(kf[6], qr[3], C0), P1[10], P1[11], P1[12], P1[13], pw3[0] = PKW(P1, 8), pw3[1] = PKW(P1, 10), pw3); \
    VRD(7); SBAR(); GAPA(C1 = MFMA32(kf[7], qr[3], C1), P1[14], P1[15], 0.f, 0.f,       pw3[2] = PKW(P1, 12), pw3[3] = PKW(P1, 14), pw3); \
    l_reg += sacc; \
    if (GK) { DMA_K((t) + 3, sl_cur); } if (GV) { DMA_V((t) + 1, sl_next); } \
    { _Pragma("unroll") for (int r = 0; r < 16; ++r) { C0[r] -= mhat; C1[r] -= mhat; } \
      float a_ = MX3(C0[0], C0[1], C1[0]), b_ = MX3(C0[2], C0[3], C1[1]); a_ = MX3(a_, C1[2], C1[3]); \
      _Pragma("unroll") for (int r = 4; r < 16; r += 4) { a_ = MX3(a_, C0[r], C0[r + 1]); b_ = MX3(b_, C0[r + 2], C0[r + 3]); a_ = MX3(a_, C1[r], C1[r + 1]); b_ = MX3(b_, C1[r + 2], C1[r + 3]); } \
      float rm = xhalf_max(__builtin_fmaxf(a_, b_)); \
      resc = false; \
      if (__builtin_expect(__any(rm > (float)THRL), 0)) { const float dl = __builtin_fmaxf(rm, 0.f); mhat += dl; \
        _Pragma("unroll") for (int r = 0; r < 16; ++r) { C0[r] -= dl; C1[r] -= dl; } \
        const float f = __builtin_amdgcn_exp2f(-dl); l_reg *= f; if (hi == 0) wsf[r32] = f; resc = true; } } \
    SBAR(); \
    GAPB(o[0] = MFMA32(PAF(0), VFR(0), o[0]), C0, 0, GN, P0, 0); \
    GAPB(o[1] = MFMA32(PAF(0), VFR(4), o[1]), C0, 4, GN, P0, 0); \
    KRD(GL, 0); GAPB(o[0] = MFMA32(PAF(1), VFR(1), o[0]), C0, 8, GN, P0, 0); \
    KRD(GL, 1); GAPB(o[1] = MFMA32(PAF(1), VFR(5), o[1]), C0, 12, GN, P0, 0); \
    KRD(GL, 2); GAPB(o[0] = MFMA32(PAF(2), VFR(2), o[0]), C1, 0, GN, P1, 32); \
    KRD(GL, 3); GAPB(o[1] = MFMA32(PAF(2), VFR(6), o[1]), C1, 4, GN, P1, 32); \
    GAPB(o[0] = MFMA32(PAF(3), VFR(3), o[0]), C1, 8, GN, P1, 32); \
    GAPB(o[1] = MFMA32(PAF(3), VFR(7), o[1]), C1, 12, GN, P1, 32); \
    } while (0)
    float mhat = 0.f, l_reg = 0.f; bool resc = false;
    o[0] = (f32x16){}; o[1] = (f32x16){};
    f32x16 pA0, pA1, pB0, pB1;
    int sl_prev = 0, sl_cur = 0, sl_next = SLOTB;
    DMA_K(0, 0); DMA_V(0, 0); DMA_K(1, SLOTB); DMA_K(2, 2 * SLOTB);
    LUTLOAD(pA0, pA1, 0);
    ST_WAIT_BAR(3);
    { const lds_cptr kb = kp0;
#pragma unroll
      for (int d0 = 0; d0 < 4; ++d0) { const bf16x8 b0 = *(const LAS bf16x8*)(kb + d0 * 2048); const bf16x8 b1 = *(const LAS bf16x8*)(kb + d0 * 2048 + 512);
          pA0 = MFMA32(b0, qr[d0], pA0); pA1 = MFMA32(b1, qr[d0], pA1); }
      float rm = pA0[0];
#pragma unroll
      for (int r = 1; r < 16; ++r) rm = __builtin_fmaxf(rm, pA0[r]);
#pragma unroll
      for (int r = 0; r < 16; ++r) rm = __builtin_fmaxf(rm, pA1[r]);
      rm = xhalf_max(rm);
      mhat = (rm == -INFINITY) ? 0.f : rm;
#pragma unroll
      for (int r = 0; r < 16; ++r) { pA0[r] = EX(pA0[r] - mhat); pA1[r] = EX(pA1[r] - mhat); } }
    ST_WAIT_BAR(0);
    DMA_K(3, 0); DMA_V(1, SLOTB);
    ROT();
    kload8(kf, kp0 + sl_cur);
    LUTLOAD(pB0, pB1, 1);
    ST_WAIT_BAR(2);
    s16x4 vlo[8], vhi[8]; u32x4 pw0, pw1, pw2, pw3;
    int t = 1;
    for (; t + 5 < NT; t += 2) {
        STEP(pB0, pB1, pA0, pA1, t, true, true, true, true);     ST_WAIT_BAR(2); RESC(); ROT();
        STEP(pA0, pA1, pB0, pB1, t + 1, true, true, true, true); ST_WAIT_BAR(2); RESC(); ROT();
    }
    for (; t + 1 < NT; t += 2) {
        STEP(pB0, pB1, pA0, pA1, t, (t + 3 < NT), (t + 1 < NT), (t + 1 < NT), true);       ENDW(t);     RESC(); ROT();
        STEP(pA0, pA1, pB0, pB1, t + 1, (t + 4 < NT), (t + 2 < NT), (t + 2 < NT), true);   ENDW(t + 1); RESC(); ROT();
    }
    STEP(pB0, pB1, pA0, pA1, NT - 1, false, false, false, false); RESC();
    { float sacc = pB0[0] + pB0[1];
#pragma unroll
      for (int r = 2; r < 16; ++r) sacc += pB0[r];
#pragma unroll
      for (int r = 0; r < 16; ++r) sacc += pB1[r];
      l_reg += sacc;
      ATT_PACK(pB0, pB1, pw0, pw1, pw2, pw3);
      SBAR(); pv(o, vb0 + sl_cur, PAF(0), PAF(1), PAF(2), PAF(3)); }
    asm volatile("s_waitcnt lgkmcnt(0)\n\ts_barrier" ::: "memory");
    mhat_o = mhat; l_o = l_reg;
#undef TLRAW
#undef DMA_K
#undef DMA_V
#undef LUTLOAD
#undef LUTPTR
#undef LOFF
#undef SBAR
#undef PIN
#undef PKW
#undef PAF
#undef VFR
#undef MX3
#undef MFMA32
#undef GAPA
#undef EX
#undef GAPB
#undef VRD
#undef KRD
#undef ROT
#undef RESC
#undef ENDW
#undef STEP
}
__device__ __forceinline__ void cmp_scores(f32x16& s0, f32x16& s1, LAS unsigned char* lds, const LAS unsigned char* bkc, const LAS unsigned char* tb, const bf16x8 (&qr)[4], const int k, const int r32, const int hi) {
#pragma unroll
    for (int r = 0; r < 16; ++r) { const int off = 16 * ((r & 3) + 8 * (r >> 2));
        s0[r] = *(const LAS float*)(tb + bkc[1024 * k + off]); s1[r] = *(const LAS float*)(tb + bkc[1024 * k + off + 512]); }
    const LAS unsigned char* kb = lds + k * 8192 + hi * 1024 + r32 * 16;
#pragma unroll
    for (int d0 = 0; d0 < 4; ++d0) { const bf16x8 b0 = *(const LAS bf16x8*)(kb + d0 * 2048); const bf16x8 b1 = *(const LAS bf16x8*)(kb + d0 * 2048 + 512);
        s0 = __builtin_amdgcn_mfma_f32_32x32x16_bf16(b0, qr[d0], s0, 0, 0, 0); s1 = __builtin_amdgcn_mfma_f32_32x32x16_bf16(b1, qr[d0], s1, 0, 0, 0); }
}
__device__ __forceinline__ float xhalf_other(float v, int hi) { auto rr = __builtin_amdgcn_permlane32_swap(__float_as_uint(v), __float_as_uint(v), false, false); return __uint_as_float(hi ? rr[0] : rr[1]); }
__device__ __forceinline__ void cmp_issue(LAS unsigned char* lds, const int wid, const int lane, const bf16_t* Kb, const bf16_t* Vb, const int nt) {
    const unsigned lds0 = (unsigned)(uintptr_t)lds;
    { const bf16_t* ksrc = Kb + (long)lane * 64 + wid * 8; const bf16_t* vsrc = Vb + (long)(16 * (wid & 3) + (lane >> 2)) * 64 + (wid >> 2) * 32 + (lane & 3) * 8;
      for (int k = 0; k < nt; ++k) { glds16(ksrc + (long)k * 4096, (unsigned)__builtin_amdgcn_readfirstlane(lds0 + k * 8192 + wid * 1024));
                                     glds16(vsrc + (long)k * 4096, (unsigned)__builtin_amdgcn_readfirstlane(lds0 + L_OTA + k * 8192 + wid * 1024)); } }
}
__device__ __forceinline__ void cmp_branch(LAS unsigned char* lds, const int wid, const int lane, const bf16x8 (&qr)[4], const int nt, const int t, f32x16 (&o)[2]) {
    const int r32 = lane & 31, hi = lane >> 5, g = wid >> 1, tq = (wid & 1) * 32 + r32;
    const unsigned lds0 = (unsigned)(uintptr_t)lds;
    const LAS unsigned char* bkc = lds + L_BKC + (4126 - t + 64 * hi);
    const LAS unsigned char* tb = lds + L_TBH + g * 144;
    asm volatile("s_waitcnt vmcnt(0) lgkmcnt(0)\n\ts_barrier" ::: "memory");
    float m = -INFINITY, l = 0.f;
#pragma clang loop unroll(disable)
    for (int k = 0; k < nt; ++k) { f32x16 s0, s1; cmp_scores(s0, s1, lds, bkc, tb, qr, k, r32, hi);
        float rm = s0[0];
#pragma unroll
        for (int r = 1; r < 16; ++r) rm = __builtin_fmaxf(rm, s0[r]);
#pragma unroll
        for (int r = 0; r < 16; ++r) rm = __builtin_fmaxf(rm, s1[r]);
        rm = xhalf_max(rm);
        const float mn = __builtin_fmaxf(m, rm), ms = (mn == -INFINITY) ? 0.f : mn;
        float ps = 0.f;
#pragma unroll
        for (int r = 0; r < 16; ++r) ps += __builtin_amdgcn_exp2f(s0[r] - ms) + __builtin_amdgcn_exp2f(s1[r] - ms);
        l = l * __builtin_amdgcn_exp2f(m - ms) + ps; m = mn; }
    l = xhalf_sum(l);
    const float msafe = (m == -INFINITY) ? 0.f : m, inv = l > 0.f ? 1.0f / l : 0.f;
    float I[4][8]; float pc7 = 0.f;
    o[0] = (f32x16){}; o[1] = (f32x16){};
    const int vb0 = (int)(lds0 + L_OTA) + ((lane >> 4) & 1) * 32 + (lane & 3) * 8 + (4 * hi + ((lane & 15) >> 2)) * 64;
#pragma unroll
    for (int k = 0; k < 4; ++k) {
        if (k < nt) { f32x16 s0, s1; cmp_scores(s0, s1, lds, bkc, tb, qr, k, r32, hi);
#pragma unroll
            for (int r = 0; r < 16; ++r) { s0[r] = __builtin_amdgcn_exp2f(s0[r] - msafe) * inv; s1[r] = __builtin_amdgcn_exp2f(s1[r] - msafe) * inv; }
            float pc[8];
#pragma unroll
            for (int q = 0; q < 4; ++q) { I[k][q] = 2.0f * (s0[4 * q] + s0[4 * q + 1] + s0[4 * q + 2]) + s0[4 * q + 3]; I[k][4 + q] = 2.0f * (s1[4 * q] + s1[4 * q + 1] + s1[4 * q + 2]) + s1[4 * q + 3];
                pc[q] = xhalf_other(s0[4 * q + 3], hi); pc[4 + q] = xhalf_other(s1[4 * q + 3], hi); }
#pragma unroll
            for (int j = 0; j < 8; ++j) I[k][j] += hi ? pc[j] : (j > 0 ? pc[j - 1] : pc7);
            pc7 = pc[7];
            u32x4 pw0, pw1, pw2, pw3; ATT_PACK(s0, s1, pw0, pw1, pw2, pw3);
            pv(o, vb0 + k * 8192, __builtin_bit_cast(bf16x8, pw0), __builtin_bit_cast(bf16x8, pw1), __builtin_bit_cast(bf16x8, pw2), __builtin_bit_cast(bf16x8, pw3));
        } else {
#pragma unroll
            for (int j = 0; j < 8; ++j) I[k][j] = 0.f;
        }
    }
    LAS float* imp = (LAS float*)(lds + L_IMP) + tq * 64 + hi;
#pragma unroll 1
    for (int gi = 0; gi < 4; ++gi) {
        if (g == gi) {
#pragma unroll
            for (int k = 0; k < 4; ++k) if (k < nt) {
#pragma unroll
                for (int j = 0; j < 8; ++j) __builtin_amdgcn_ds_faddf(imp + 16 * k + 2 * j, I[k][j], 0, 0, false);
            }
        }
        asm volatile("s_waitcnt lgkmcnt(0)\n\ts_barrier" ::: "memory");
    }
}
}

struct Ctx { int tid, lane, wave, vcu, G, bx; LAS unsigned char* lds; };

struct TrD { const float* src; size_t ldw; int nvalid; bf16_t* dst; size_t ldk; float fp8s; };
__device__ __forceinline__ void tr_load(const TrD& d, float (&v)[32], int lane) {
    const int n = lane & 31; const float* src = d.src + (size_t)(lane >> 5) * d.ldw + n;
#pragma unroll
    for (int i = 0; i < 32; ++i) v[i] = (n < d.nvalid) ? src[(size_t)(2 * i) * d.ldw] : 0.f;
}
__device__ __forceinline__ void tr_store(const TrD& d, const float (&v)[32], LAS float* scr, int lane) {
    const int n = lane & 31;
#pragma unroll
    for (int i = 0; i < 32; ++i) scr[(2 * i + (lane >> 5)) * 33 + n] = v[i];
    LDS_WAIT(); asm volatile("" ::: "memory");
    const int c = lane & 7;
#pragma unroll
    for (int j = 0; j < 4; ++j) { const int nn = (lane >> 3) + 8 * j; const LAS float* s = scr + (8 * c) * 33 + nn;
        if (d.fp8s != 0.f) { const float f = d.fp8s; u32x2 o;
            o.x = (unsigned)__builtin_amdgcn_cvt_pk_fp8_f32(s[0 * 33] * f, s[1 * 33] * f, 0, false); o.x = (unsigned)__builtin_amdgcn_cvt_pk_fp8_f32(s[2 * 33] * f, s[3 * 33] * f, (int)o.x, true);
            o.y = (unsigned)__builtin_amdgcn_cvt_pk_fp8_f32(s[4 * 33] * f, s[5 * 33] * f, 0, false); o.y = (unsigned)__builtin_amdgcn_cvt_pk_fp8_f32(s[6 * 33] * f, s[7 * 33] * f, (int)o.y, true);
            *(u32x2*)((unsigned char*)d.dst + (size_t)nn * d.ldk + 8 * c) = o;
        } else {
        u32x4 o; o.x = cvt_pk_bf16(s[0 * 33], s[1 * 33]); o.y = cvt_pk_bf16(s[2 * 33], s[3 * 33]); o.z = cvt_pk_bf16(s[4 * 33], s[5 * 33]); o.w = cvt_pk_bf16(s[6 * 33], s[7 * 33]);
        *(u32x4*)(d.dst + (size_t)nn * d.ldk + 8 * c) = o; } }
    LDS_WAIT(); asm volatile("" ::: "memory");
}
__device__ __forceinline__ TrD mk_trd(const float* W, size_t ldw, int srccol, int nvalid, bf16_t* WT, size_t ldk, int dstrow, int k0) {
    TrD d; d.src = W + (size_t)k0 * ldw + srccol; d.ldw = ldw; d.nvalid = nvalid; d.dst = WT + (size_t)dstrow * ldk + k0; d.ldk = ldk; d.fp8s = 0.f; return d; }
__device__ __forceinline__ TrD mk_trd8(const float* W, size_t ldw, int srccol, int nvalid, unsigned char* WT8, size_t ldk, int dstrow, int k0, float scale) {
    TrD d; d.src = W + (size_t)k0 * ldw + srccol; d.ldw = ldw; d.nvalid = nvalid; d.dst = (bf16_t*)(WT8 + (size_t)dstrow * ldk + k0); d.ldk = ldk; d.fp8s = scale; return d; }
__device__ __forceinline__ TrD dec_small(const Args& a, int it) {
    constexpr int I_WIN = 184 * 16, I_CW1 = 2 * 8 * 32, I_WUN = 32 * 8, I_WUD = 32 * 4, I_WO = 32 * 16, I_CW2 = 2 * 2 * 4;
    constexpr int PER = I_WIN + I_CW1 + I_WUN + I_WUD + I_WO + I_CW2;
    unsigned char* ws = a.ws;
    const int l = it / PER; int r = it % PER;
    if (r < I_WIN) { const int nb = r / 16, kb = r % 16; const int nd = 32 * nb; int src, nv = 32;
        if (nd < 1280) src = nd; else if (nd < 5632) src = nd + 24; else if (nd == 5632) { src = 1280; nv = 24; } else { src = 0; nv = 0; }
        return mk_trd8(a.w_in + (size_t)l * DM * INW, INW, src, nv, (unsigned char*)(ws + WS_WINT) + (size_t)l * NIN * DM, DM, nd, 64 * kb, 256.0f); }
    r -= I_WIN;
    if (r < I_CW1) { const int kv = r / 256, q = r % 256, nb = q / 32, kb = q % 32;
        return mk_trd(a.cmp_w1 + (size_t)(l * 2 + kv) * 2048 * 256, 256, 32 * nb, 32, (bf16_t*)(ws + WS_CW1T) + (size_t)(l * 2 + kv) * 256 * 2048, 2048, 32 * nb, 64 * kb); }
    r -= I_CW1;
    if (r < I_WUN) { const int nb = r / 8, kb = r % 8;
        return mk_trd(a.w_up_nsa + (size_t)l * 512 * 1024, 1024, 32 * nb, 32, (bf16_t*)(ws + WS_WUNT) + (size_t)l * 1024 * 512, 512, 32 * nb, 64 * kb); }
    r -= I_WUN;
    if (r < I_WUD) { const int nb = r / 4, kb = r % 4;
        return mk_trd(a.w_up_dil + (size_t)l * 256 * 1024, 1024, 32 * nb, 32, (bf16_t*)(ws + WS_WUDT) + (size_t)l * 1024 * 256, 256, 32 * nb, 64 * kb); }
    r -= I_WUD;
    if (r < I_WO) { const int nb = r / 16, kb = r % 16;
        return mk_trd(a.w_o + (size_t)l * 1024 * 1024, 1024, 32 * nb, 32, (bf16_t*)(ws + WS_WOT) + (size_t)l * 1024 * 1024, 1024, 32 * nb, 64 * kb); }
    r -= I_WO;
    { const int kv = r / 8, q = r % 8, nb = q / 4, kb = q % 4;
        return mk_trd(a.cmp_w2 + (size_t)(l * 2 + kv) * 256 * 64, 64, 32 * nb, 32, (bf16_t*)(ws + WS_CW2T) + (size_t)(l * 2 + kv) * 64 * 256, 256, 32 * nb, 64 * kb); }
}
__device__ __forceinline__ TrD dec_expert(const Args& a, int l, int it) {
    constexpr int I_13 = 32 * 16, I_2 = 32 * 8, PER = I_13 + I_2;
    unsigned char* ws = a.ws;
    const int e = it / PER; int r = it % PER;
    if (r < I_13) { const int nb = r / 16, kb = r % 16; const int r0 = 32 * nb, pn = r0 >> 8, bj = (r0 >> 7) & 1, j0 = r0 & 127;
        const float* src = (bj ? a.exp_w3 : a.exp_w1) + (size_t)(l * 32 + e) * 1024 * 512;
        return mk_trd8(src, 512, pn * 128 + j0, 32, (unsigned char*)(ws + WS_E13T) + (size_t)e * 1024 * 1024, 1024, r0, 64 * kb, 256.0f); }
    r -= I_13;
    { const int nb = r / 8, kb = r % 8;
        return mk_trd8(a.exp_w2 + (size_t)(l * 32 + e) * 512 * 1024, 1024, 32 * nb, 32, (unsigned char*)(ws + WS_E2T) + (size_t)e * 1024 * 512, 512, 32 * nb, 64 * kb, 256.0f); }
}
template <int KIND> __device__ __forceinline__ void conv_items(const Args& a, const Ctx& C, int l, int first, int nitems, LAS float* scr) {
    const int NGW = C.G * NWAVES;
    float va[32], vb[32]; TrD d0, d1;
    int it = first;
    if (it >= nitems) return;
    d0 = KIND ? dec_expert(a, l, it) : dec_small(a, it); tr_load(d0, va, C.lane);
    for (;;) {
        const int itn = it + NGW; const bool hn = itn < nitems;
        if (hn) { d1 = KIND ? dec_expert(a, l, itn) : dec_small(a, itn); tr_load(d1, vb, C.lane); }
        tr_store(d0, va, scr, C.lane);
        if (!hn) break;
        const int itnn = itn + NGW; const bool hnn = itnn < nitems;
        if (hnn) { d0 = KIND ? dec_expert(a, l, itnn) : dec_small(a, itnn); tr_load(d0, va, C.lane); }
        tr_store(d1, vb, scr, C.lane);
        if (!hnn) break;
        it = itnn;
    }
}
__device__ __forceinline__ void conv_small(const Args& a, const Ctx& C) { conv_items<0>(a, C, 0, C.vcu * NWAVES + C.wave, 2 * 4368, (LAS float*)(C.lds + C.wave * 16384)); }
__device__ __forceinline__ void conv_experts_slice(const Args& a, const Ctx& C, int l, int q) {
    const int NGW = C.G * NWAVES; const int per = 3 * NGW;
    LAS float* scr = (LAS float*)(C.lds + (C.wave < 5 ? C.wave * 8448 : att::L_OTA + (C.wave - 5) * 8448));
    const int lo = q * per, hi = (q == 3) ? 32 * 768 : ((q + 1) * per < 32 * 768 ? (q + 1) * per : 32 * 768);
    if (lo < hi) conv_items<1>(a, C, l, lo + C.vcu * NWAVES + C.wave, hi, scr);
}
__device__ __forceinline__ void prologue_vectors(const Args& a, const Ctx& C) {
    LAS float* sl = (LAS float*)(C.lds);
    LAS float* part = (LAS float*)(C.lds + 32768);
    for (int i = C.tid; i < 8 * 1024; i += NTHR) { const float v = a.c[i]; sl[i] = v * sigmoidf_(v); }
    __syncthreads();
    float* MOD = (float*)(a.ws + WS_MOD); float* CB1 = (float*)(a.ws + WS_CB1);
    for (int it = C.vcu; it < 192 + 16; it += C.G) {
        float acc[8];
#pragma unroll
        for (int b = 0; b < 8; ++b) acc[b] = 0.f;
        if (it < 192) { const int l = it / 96, col = (it % 96) * 64 + C.lane;
            const float* w = a.ada_w + (size_t)l * 1024 * 6144 + col;
            for (int k0 = 128 * C.wave; k0 < 128 * C.wave + 128; k0 += 32) { float wv[32];
#pragma unroll
                for (int j = 0; j < 32; ++j) wv[j] = w[(size_t)(k0 + j) * 6144];
#pragma unroll
                for (int j = 0; j < 32; ++j)
#pragma unroll
                    for (int b = 0; b < 8; ++b) acc[b] += sl[b * 1024 + k0 + j] * wv[j]; }
        } else { const int q = it - 192, lk = q / 4, col = (q % 4) * 64 + C.lane;
            const float* w = a.cmp_w1 + (size_t)lk * 2048 * 256 + col; const float* pos = a.cmp_pos + (size_t)lk * 2048;
            for (int k0 = 256 * C.wave; k0 < 256 * C.wave + 256; k0 += 32) { float wv[32];
#pragma unroll
                for (int j = 0; j < 32; ++j) wv[j] = w[(size_t)(k0 + j) * 256];
#pragma unroll
                for (int j = 0; j < 32; ++j) acc[0] += pos[k0 + j] * wv[j]; }
        }
        __syncthreads();
#pragma unroll
        for (int b = 0; b < 8; ++b) part[(C.wave * 8 + b) * 64 + C.lane] = acc[b];
        __syncthreads();
        if (C.wave == 0) {
            float tot[8];
#pragma unroll
            for (int b = 0; b < 8; ++b) { float t2 = 0.f;
#pragma unroll
                for (int w = 0; w < 8; ++w) t2 += part[(w * 8 + b) * 64 + C.lane];
                tot[b] = t2; }
            if (it < 192) { const int l = it / 96, col = (it % 96) * 64 + C.lane; const float bias = a.ada_b[l * 6144 + col];
#pragma unroll
                for (int b = 0; b < 8; ++b) MOD[(size_t)(l * 8 + b) * 6144 + col] = tot[b] + bias;
            } else { const int q = it - 192, lk = q / 4, col = (q % 4) * 64 + C.lane; CB1[lk * 256 + col] = tot[0]; }
        }
    }
    __syncthreads();
}

struct RowX { f32x4 v[4]; };
struct RowY { u32x2 y0[4], y1[4]; };
template <int KIND> __device__ __forceinline__ void ld_x(const Args& a, int row, int lane, RowX& X) {
    const float* xr = (KIND == 0 ? a.x : (const float*)a.out) + (size_t)row * 1024;
#pragma unroll
    for (int j = 0; j < 4; ++j) X.v[j] = *((const f32x4*)xr + lane + 64 * j);
}
__device__ __forceinline__ void ld_y(const Args& a, const u32x4& rec, int lane, RowY& Y) {
    const bf16_t* Yb = (const bf16_t*)(a.ws + WS_XS);
    const u32x2* y0 = (const u32x2*)(Yb + (size_t)rec.x * 1024) + lane; const u32x2* y1 = (const u32x2*)(Yb + (size_t)rec.y * 1024) + lane;
#pragma unroll
    for (int j = 0; j < 4; ++j) { Y.y0[j] = y0[64 * j]; Y.y1[j] = y1[64 * j]; }
}
template <int KIND> __device__ __forceinline__ void row_finish(const Args& a, int l, int row, int lane, RowX& X, const RowY& Y, const u32x4& rec) {
    const int b = row >> 12; const float* MOD = (const float*)(a.ws + WS_MOD);
    if (KIND != 0) { const float* g2 = MOD + (size_t)((KIND == 1 ? 0 : 1) * 8 + b) * 6144 + 5120;
        const float w0 = (ABL == 6) ? 0.f : __uint_as_float(rec.z), w1 = (ABL == 6) ? 0.f : __uint_as_float(rec.w);
#pragma unroll
        for (int j = 0; j < 4; ++j) { const u32x2 p = Y.y0[j], q = Y.y1[j]; const f32x4 gg = *((const f32x4*)g2 + lane + 64 * j);
            X.v[j][0] += gg[0] * (w0 * bf_lo(p.x) + w1 * bf_lo(q.x)); X.v[j][1] += gg[1] * (w0 * bf_hi(p.x) + w1 * bf_hi(q.x));
            X.v[j][2] += gg[2] * (w0 * bf_lo(p.y) + w1 * bf_lo(q.y)); X.v[j][3] += gg[3] * (w0 * bf_hi(p.y) + w1 * bf_hi(q.y)); } }
    if (KIND == 1) {
#pragma unroll
        for (int j = 0; j < 4; ++j) *((f32x4*)(a.out + (size_t)row * 1024) + lane + 64 * j) = X.v[j]; }
    float ss = 0.f;
#pragma unroll
    for (int j = 0; j < 4; ++j) ss += (X.v[j][0] * X.v[j][0] + X.v[j][1] * X.v[j][1]) + (X.v[j][2] * X.v[j][2] + X.v[j][3] * X.v[j][3]);
    const float rstd = 1.0f / sqrtf(wave_sum(ss) * (1.0f / 1024.0f) + RMS_EPS);
    if (KIND == 2) {
#pragma unroll
        for (int j = 0; j < 4; ++j) { const f32x4 g = *((const f32x4*)a.norm_f + lane + 64 * j); *((f32x4*)(a.out + (size_t)row * 1024) + lane + 64 * j) = X.v[j] * rstd * g; }
    } else { const float* nw = a.norm1 + l * 1024; const float* mb = MOD + (size_t)(l * 8 + b) * 6144; unsigned char* H = a.ws + WS_H;
#pragma unroll
        for (int j = 0; j < 4; ++j) { const f32x4 g = *((const f32x4*)nw + lane + 64 * j), sh = *((const f32x4*)mb + lane + 64 * j), sc = *((const f32x4*)(mb + 1024) + lane + 64 * j);
            const f32x4 h = (X.v[j] * rstd * g * (sc + 1.0f) + sh) * 8.0f; unsigned w = (unsigned)__builtin_amdgcn_cvt_pk_fp8_f32(h[0], h[1], 0, false); w = (unsigned)__builtin_amdgcn_cvt_pk_fp8_f32(h[2], h[3], (int)w, true);
            *((unsigned*)(H + (size_t)row * 1024) + lane + 64 * j) = w; } }
}
template <int KIND> __device__ __forceinline__ void norm_rows(const Args& a, const Ctx& C, int l) {
    const int gw = C.vcu * NWAVES + C.wave, NGW = C.G * NWAVES, lane = C.lane;
    if (gw >= T) return;
    const unsigned char* DEST = a.ws + WS_DEST;
    RowX xa, xb; RowY ya, yb; u32x4 r0 = {}, r1 = {}, r2 = {};
    if (KIND != 0) { r0 = *(const u32x4*)(DEST + (size_t)gw * 16); if (gw + NGW < T) r1 = *(const u32x4*)(DEST + (size_t)(gw + NGW) * 16); }
    ld_x<KIND>(a, gw, lane, xa); if (KIND != 0) ld_y(a, r0, lane, ya);
    for (int row = gw; ; ) {
        const int rn = row + NGW, rnn = rn + NGW; const bool hn = rn < T;
        if (hn) { ld_x<KIND>(a, rn, lane, xb); if (KIND != 0) { ld_y(a, r1, lane, yb); if (rnn < T) r2 = *(const u32x4*)(DEST + (size_t)rnn * 16); } }
        row_finish<KIND>(a, l, row, lane, xa, ya, r0);
        if (!hn) break;
        const int rm = rnn + NGW; const bool hnn = rnn < T;
        r0 = r1; r1 = r2;
        if (hnn) { ld_x<KIND>(a, rnn, lane, xa); if (KIND != 0) { ld_y(a, r1, lane, ya); if (rm < T) r2 = *(const u32x4*)(DEST + (size_t)rm * 16); } }
        row_finish<KIND>(a, l, rn, lane, xb, yb, r0);
        if (!hnn) break;
        r0 = r1; r1 = r2;
        row = rnn;
    }
}
__device__ __forceinline__ void norm1_phase(const Args& a, const Ctx& C, int l) { if (l == 0) norm_rows<0>(a, C, 0); else norm_rows<1>(a, C, 1); }
__device__ __forceinline__ void final_phase(const Args& a, const Ctx& C) { norm_rows<2>(a, C, 0); }
typedef float f32x4v __attribute__((ext_vector_type(4)));
__device__ __forceinline__ void norm2_router_phase(const Args& a, const Ctx& C, int l) {
    constexpr int RP = 2064;
    LAS unsigned char* HH = C.lds; LAS unsigned char* HL = C.lds + 16 * RP;
    LAS float* PART = (LAS float*)(C.lds + 2 * 16 * RP);
    LAS float* LOGI = PART + 8 * 16 * 48;
    LAS int* wcnt = (LAS int*)(C.lds + LDS_MISC + 256);
    const float* wg = a.router_wg + (size_t)l * 1024 * 4; const float* we = a.router_we + (size_t)l * 1024 * 32;
    const int lane = C.lane, wave = C.wave, fr = lane & 15, fq = lane >> 4;
    bf16x8 Wh[4][3], Wl[4][3];
#pragma unroll
    for (int ks = 0; ks < 4; ++ks)
#pragma unroll
        for (int ct = 0; ct < 3; ++ct) { const int cc = 16 * ct + fr; const int k0 = 128 * wave + 32 * ks + 8 * fq; unsigned hw[4], lw[4];
#pragma unroll
            for (int i = 0; i < 8; i += 2) { float v0 = 0.f, v1 = 0.f;
                if (cc < 4) { v0 = wg[(size_t)(k0 + i) * 4 + cc]; v1 = wg[(size_t)(k0 + i + 1) * 4 + cc]; }
                else if (cc < 36) { v0 = we[(size_t)(k0 + i) * 32 + cc - 4]; v1 = we[(size_t)(k0 + i + 1) * 32 + cc - 4]; }
                const unsigned hp = cvt_pk_bf16(v0, v1); hw[i >> 1] = hp; lw[i >> 1] = cvt_pk_bf16(v0 - bf_lo(hp), v1 - bf_hi(hp)); }
            Wh[ks][ct] = __builtin_bit_cast(bf16x8, (u32x4){hw[0], hw[1], hw[2], hw[3]}); Wl[ks][ct] = __builtin_bit_cast(bf16x8, (u32x4){lw[0], lw[1], lw[2], lw[3]}); }
    const float* MOD = (const float*)(a.ws + WS_MOD); bf16_t* H2 = (bf16_t*)(a.ws + WS_H2);
    const float* nw = a.norm2 + l * 1024; const float* bg = a.router_bg + l * 4; const float* be = a.router_be + l * 32;
    int* CNTBLK = (int*)(a.ws + WS_CNTBLK);
    for (int ch = C.vcu; ch < T / 128; ch += C.G) {
        int my_e0 = 0, my_e1 = 0; float my_w0 = 0.f, my_w1 = 0.f;
#pragma clang loop unroll(disable)
        for (int gi = 0; gi < 8; ++gi) {
            { const int row0 = ch * 128 + gi * 16 + 2 * wave; const int b = row0 >> 12;
              f32x4 v[2][4];
#pragma unroll
              for (int rr = 0; rr < 2; ++rr)
#pragma unroll
                  for (int q = 0; q < 4; ++q) v[rr][q] = *((const f32x4*)(a.out + (size_t)(row0 + rr) * 1024) + lane + 64 * q);
              const float* mb = MOD + (size_t)(l * 8 + b) * 6144 + 3072;
#pragma unroll
              for (int rr = 0; rr < 2; ++rr) { float ss = 0.f;
#pragma unroll
                  for (int q = 0; q < 4; ++q) ss += (v[rr][q][0] * v[rr][q][0] + v[rr][q][1] * v[rr][q][1]) + (v[rr][q][2] * v[rr][q][2] + v[rr][q][3] * v[rr][q][3]);
                  const float rstd = 1.0f / sqrtf(wave_sum(ss) * (1.0f / 1024.0f) + RMS_EPS);
#pragma unroll
                  for (int q = 0; q < 4; ++q) { const f32x4 g = *((const f32x4*)nw + lane + 64 * q), sh = *((const f32x4*)mb + lane + 64 * q), sc = *((const f32x4*)(mb + 1024) + lane + 64 * q);
                      const f32x4 h = v[rr][q] * rstd * g * (sc + 1.0f) + sh;
                      u32x2 hw; hw.x = cvt_pk_bf16(h[0], h[1]); hw.y = cvt_pk_bf16(h[2], h[3]);
                      u32x2 lw; lw.x = cvt_pk_bf16(h[0] - bf_lo(hw.x), h[1] - bf_hi(hw.x)); lw.y = cvt_pk_bf16(h[2] - bf_lo(hw.y), h[3] - bf_hi(hw.y));
                      { unsigned w8 = (unsigned)__builtin_amdgcn_cvt_pk_fp8_f32(h[0] * 8.0f, h[1] * 8.0f, 0, false); w8 = (unsigned)__builtin_amdgcn_cvt_pk_fp8_f32(h[2] * 8.0f, h[3] * 8.0f, (int)w8, true);
                        *((unsigned*)((unsigned char*)H2 + (size_t)(row0 + rr) * 1024) + lane + 64 * q) = w8; }
                      *(LAS u32x2*)(HH + (2 * wave + rr) * RP + (4 * lane + 256 * q) * 2) = hw; *(LAS u32x2*)(HL + (2 * wave + rr) * RP + (4 * lane + 256 * q) * 2) = lw; } }
            }
            __syncthreads();
            { f32x4v acc[3]; acc[0] = (f32x4v){0.f, 0.f, 0.f, 0.f}; acc[1] = acc[0]; acc[2] = acc[0];
#pragma unroll
              for (int ks = 0; ks < 4; ++ks) { const int ko = (128 * wave + 32 * ks + 8 * fq) * 2;
                  const bf16x8 ah = *(const LAS bf16x8*)(HH + fr * RP + ko), al = *(const LAS bf16x8*)(HL + fr * RP + ko);
#pragma unroll
                  for (int ct = 0; ct < 3; ++ct) { acc[ct] = __builtin_amdgcn_mfma_f32_16x16x32_bf16(Wh[ks][ct], ah, acc[ct], 0, 0, 0);
                      acc[ct] = __builtin_amdgcn_mfma_f32_16x16x32_bf16(Wh[ks][ct], al, acc[ct], 0, 0, 0); acc[ct] = __builtin_amdgcn_mfma_f32_16x16x32_bf16(Wl[ks][ct], ah, acc[ct], 0, 0, 0); } }
#pragma unroll
              for (int ct = 0; ct < 3; ++ct) *(LAS f32x4v*)(PART + (wave * 16 + fr) * 48 + 16 * ct + 4 * fq) = acc[ct]; }
            __syncthreads();
            { const int row = C.tid >> 5, c = C.tid & 31;
              { float sacc = 0.f;
#pragma unroll
                for (int w = 0; w < 8; ++w) sacc += PART[(w * 16 + row) * 48 + c];
                LOGI[row * 48 + c] = sacc + (c < 4 ? bg[c] : be[c - 4]); }
              if (c < 4) { float sacc = 0.f;
#pragma unroll
                for (int w = 0; w < 8; ++w) sacc += PART[(w * 16 + row) * 48 + 32 + c];
                LOGI[row * 48 + 32 + c] = sacc + be[28 + c]; } }
            __syncthreads();
            if (wave == gi && lane < 16) { const LAS float* lg = LOGI + lane * 48;
                int grp = 0; float gmax = lg[0];
#pragma unroll
                for (int c = 1; c < 4; ++c) if (lg[c] > gmax) { gmax = lg[c]; grp = c; }
                float gs = 0.f;
#pragma unroll
                for (int c = 0; c < 4; ++c) gs += __builtin_amdgcn_exp2f((lg[c] - gmax) * LOG2E);
                const float pgrp = 1.0f / gs;
                float le[8];
#pragma unroll
                for (int e = 0; e < 8; ++e) le[e] = lg[4 + grp * 8 + e];
                int i0 = 0; float v0 = le[0];
#pragma unroll
                for (int e = 1; e < 8; ++e) if (le[e] > v0) { v0 = le[e]; i0 = e; }
                int i1 = -1; float v1 = -INFINITY;
#pragma unroll
                for (int e = 0; e < 8; ++e) if (e != i0 && le[e] > v1) { v1 = le[e]; i1 = e; }
                const float ex = __builtin_amdgcn_exp2f((v1 - v0) * LOG2E);
                my_e0 = grp * 8 + i0; my_e1 = grp * 8 + i1; my_w0 = pgrp / (1.0f + ex); my_w1 = pgrp * ex / (1.0f + ex); }
        }
        const int ea = bperm_i(C.lane >> 1, my_e0), eb = bperm_i(C.lane >> 1, my_e1);
        const int es = (C.lane < 32) ? ((C.lane & 1) ? eb : ea) : -1;
        int rank = 0, cnt = 0;
#pragma unroll
        for (int s2 = 0; s2 < 32; ++s2) { const int v = __builtin_amdgcn_readlane(es, s2); rank += (v == es && s2 < C.lane) ? 1 : 0; cnt += (v == C.lane) ? 1 : 0; }
        __syncthreads();
        if (C.lane < 32) wcnt[C.wave * 32 + C.lane] = cnt;
        __syncthreads();
        int lrank = rank;
        if (C.lane < 32) { for (int w = 0; w < C.wave; ++w) lrank += wcnt[w * 32 + es]; }
        if (C.wave == 0 && C.lane < 32) { int tot = 0;
#pragma unroll
            for (int w = 0; w < 8; ++w) tot += wcnt[w * 32 + C.lane];
            CNTBLK[ch * 32 + C.lane] = tot; }
        const int lr0 = bperm_i((2 * C.lane) & 63, lrank), lr1 = bperm_i((2 * C.lane + 1) & 63, lrank);
        if (C.lane < 16) { const int row = ch * 128 + C.wave * 16 + C.lane;
            u32x4 rec; rec.x = (unsigned)my_e0 | ((unsigned)my_e1 << 8); rec.y = (unsigned)lr0 | ((unsigned)lr1 << 16); rec.z = __float_as_uint(my_w0); rec.w = __float_as_uint(my_w1);
            *(u32x4*)(a.ws + WS_REC + (size_t)row * 16) = rec; }
    }
}
__device__ __forceinline__ void moe_scatter_phase(const Args& a, const Ctx& C) {
    LAS int* part_lt = (LAS int*)(C.lds);
    LAS int* part_all = part_lt + 512;
    LAS int* base = part_all + 512;
    LAS int* tot = base + 32;
    LAS int* pst = tot + 32;
    const int* CNTBLK = (const int*)(a.ws + WS_CNTBLK);
    int* TILEE = (int*)(a.ws + WS_TILEE);
    int* TOKL = (int*)(a.ws + WS_TOKL);
    for (int ch = C.vcu; ch < T / 128; ch += C.G) {
        __syncthreads();
        { const int e = C.tid & 31, p = C.tid >> 5; int slt = 0, sall = 0;
            for (int c = p; c < T / 128; c += 16) { const int v = CNTBLK[c * 32 + e]; sall += v; slt += (c < ch) ? v : 0; }
            part_lt[p * 32 + e] = slt; part_all[p * 32 + e] = sall; }
        __syncthreads();
        if (C.tid < 32) { int b = 0, t2 = 0;
#pragma unroll
            for (int p = 0; p < 16; ++p) { b += part_lt[p * 32 + C.tid]; t2 += part_all[p * 32 + C.tid]; }
            base[C.tid] = b; tot[C.tid] = t2; }
        __syncthreads();
        if (C.tid < 32) { int ps = 0; for (int e = 0; e < C.tid; ++e) ps += (tot[e] + 255) & ~255; pst[C.tid] = ps;
            if (ch == 0) { const int nt = (tot[C.tid] + 255) >> 8; const int t0 = ps >> 8; for (int m = 0; m < nt; ++m) TILEE[16 + t0 + m] = C.tid; if (C.tid == 31) TILEE[0] = t0 + nt; } }
        __syncthreads();
        int d0 = 0, d1 = 0;
        if (C.lane < 16) { const int row = ch * 128 + C.wave * 16 + C.lane;
            const u32x4 rec = *(const u32x4*)(a.ws + WS_REC + (size_t)row * 16);
            const int e0 = rec.x & 255, e1 = (rec.x >> 8) & 255;
            d0 = pst[e0] + base[e0] + (int)(rec.y & 0xffffu); d1 = pst[e1] + base[e1] + (int)(rec.y >> 16);
            u32x4 o; o.x = (unsigned)d0; o.y = (unsigned)d1; o.z = rec.z; o.w = rec.w;
            *(u32x4*)(a.ws + WS_DEST + (size_t)row * 16) = o; }
        if (C.lane < 16) { const int row = ch * 128 + C.wave * 16 + C.lane; TOKL[d0] = row; TOKL[d1] = row; }
        if (ch == 0) {
            for (int e = 0; e < 32; ++e) { const int lo = pst[e] + tot[e], hi = pst[e] + ((tot[e] + 255) & ~255);
                for (int k = lo + C.tid; k < hi; k += NTHR) TOKL[k] = 0; } }
    }
}
struct MoeOrder {
    int G, c, nu; int ex[8]; const char* A; const char* B; size_t tA, tB, eB;
    __device__ __forceinline__ bool next(int i, pg8::Unit& u) const {
        const int L = i * G + c; if (i >= 8 || L >= nu) return false;
        const int e = i == 0 ? ex[0] : i == 1 ? ex[1] : i == 2 ? ex[2] : i == 3 ? ex[3] : i == 4 ? ex[4] : i == 5 ? ex[5] : i == 6 ? ex[6] : ex[7];
        u.pm = L >> 2; u.pn = L & 3; u.A = A + (size_t)u.pm * tA; u.B = B + (size_t)e * eB + (size_t)u.pn * tB; return true;
    }
};

__device__ __forceinline__ void dil_unit(const Args& a, const Ctx& C, int du) {
    using namespace att;
    LAS unsigned char* lds = C.lds;
    const int x = du & 15; int r = du >> 4; const int h = r & 3; r >>= 2; const int grp = r % 3, b = r / 3;
    const int dsh = 2 * grp, d = 1 << dsh; const int nub = 16 >> dsh; const int res = x / nub, ub = x % nub;
    const int wid = C.wave, lane = C.lane, r32 = lane & 31, hi = lane >> 5;
    LAS float* lut = (LAS float*)(lds + L_LUT);
    LAS unsigned char* tl = lds + L_SEL + 768;
    __syncthreads();
    for (int e = C.tid; e < 704; e += NTHR) { const int m = 384 - e; float v = -INFINITY;
        if (m >= 0 && m <= 128) { int di = m << dsh; di = di > 4095 ? 4095 : di; v = a.rel_bias[(int)lds[L_BKT + di] * 20 + 8 + grp * 4 + h] * LOG2E; }
        lut[e] = v; }
    if (C.tid < 6) { const int kt = 4 * ub - 2 + C.tid; tl[C.tid] = (unsigned char)(kt < 0 ? 0x80 : kt); }
    const bf16_t* QKV = (const bf16_t*)(a.ws + WS_A);
    const int u = 256 * ub + 32 * wid + r32; const size_t tokq = (size_t)b * SEQ + (size_t)u * d + res;
    const bf16_t* qp = QKV + tokq * LDQ + 1280 + grp * 256 + h * 64;
    bf16x8 qr[4];
#pragma unroll
    for (int d0 = 0; d0 < 4; ++d0) qr[d0] = *(const bf16x8*)(qp + d0 * 16 + hi * 8);
    __syncthreads();
    StreamP S; S.Kb = QKV + ((size_t)b * SEQ + res) * LDQ + 1280 + 768 + grp * 256 + h * 64; S.Vb = S.Kb + 768; S.pitch = (long)d * LDQ;
    S.NT = 6; S.tl = tl; S.lanesel = ~0ull; S.uq = u; S.lut = lut; S.xtop = 384; S.dclamp = 1 << 30;
    float m = 0.f, l = 0.f; f32x16 o[2];
    attn_stream<8>(lds, wid, lane, qr, S, m, l, o);
    l = xhalf_sum(l);
    LAS float* wsf = (LAS float*)(lds + L_WSF) + wid * 64;
    if (hi == 0) { wsf[r32] = l > 0.f ? 1.0f / l : 0.f; ((float*)(a.ws + WS_LSE))[((size_t)grp * T + tokq) * 4 + h] = m + __builtin_amdgcn_logf(l); }
    LDS_WAIT();
#pragma unroll
    for (int rr = 0; rr < 16; ++rr) { const float f = wsf[crow(rr, hi)]; o[0][rr] *= f; o[1][rr] *= f; }
    stage_rows(lds, wid, lane, o);
    bf16_t* ODP = (bf16_t*)(a.ws + WS_ODP) + (size_t)grp * T * 256;
    const LAS bf16_t* stg = (const LAS bf16_t*)(lds + L_OTA) + wid * 2048;
#pragma unroll
    for (int i = 0; i < 4; ++i) { const int row = i * 8 + (lane >> 3), chn = lane & 7; const u32x4 v = *(const LAS u32x4*)(stg + row * 64 + chn * 8);
        const size_t tok = (size_t)b * SEQ + (size_t)(256 * ub + 32 * wid + row) * d + res;
        *(u32x4*)(ODP + tok * 256 + h * 64 + chn * 8) = v; }
}
__device__ __forceinline__ void dil_combine(const Args& a, const Ctx& C) {
    const float* LSE = (const float*)(a.ws + WS_LSE); const bf16_t* ODP = (const bf16_t*)(a.ws + WS_ODP); bf16_t* ODIL = (bf16_t*)(a.ws + WS_ODIL);
    const int gt = C.vcu * NTHR + C.tid, NT = C.G * NTHR;
    for (int idx = gt; idx < T * 32; idx += NT) {
        const int tok = idx >> 5, h = (idx >> 3) & 3, chn = idx & 7;
        const float l0 = LSE[((size_t)0 * T + tok) * 4 + h], l1 = LSE[((size_t)1 * T + tok) * 4 + h], l2 = LSE[((size_t)2 * T + tok) * 4 + h];
        const float mx = __builtin_fmaxf(l0, __builtin_fmaxf(l1, l2));
        float w0 = __builtin_amdgcn_exp2f(l0 - mx), w1 = __builtin_amdgcn_exp2f(l1 - mx), w2 = __builtin_amdgcn_exp2f(l2 - mx);
        const float inv = 1.0f / (w0 + w1 + w2); w0 *= inv; w1 *= inv; w2 *= inv;
        const size_t off = (size_t)tok * 256 + h * 64 + chn * 8;
        const u32x4 a0 = *(const u32x4*)(ODP + off), a1 = *(const u32x4*)(ODP + (size_t)T * 256 + off), a2 = *(const u32x4*)(ODP + (size_t)2 * T * 256 + off);
        u32x4 o;
        o.x = cvt_pk_bf16(w0 * bf_lo(a0.x) + w1 * bf_lo(a1.x) + w2 * bf_lo(a2.x), w0 * bf_hi(a0.x) + w1 * bf_hi(a1.x) + w2 * bf_hi(a2.x));
        o.y = cvt_pk_bf16(w0 * bf_lo(a0.y) + w1 * bf_lo(a1.y) + w2 * bf_lo(a2.y), w0 * bf_hi(a0.y) + w1 * bf_hi(a1.y) + w2 * bf_hi(a2.y));
        o.z = cvt_pk_bf16(w0 * bf_lo(a0.z) + w1 * bf_lo(a1.z) + w2 * bf_lo(a2.z), w0 * bf_hi(a0.z) + w1 * bf_hi(a1.z) + w2 * bf_hi(a2.z));
        o.w = cvt_pk_bf16(w0 * bf_lo(a0.w) + w1 * bf_lo(a1.w) + w2 * bf_lo(a2.w), w0 * bf_hi(a0.w) + w1 * bf_hi(a1.w) + w2 * bf_hi(a2.w));
        if (ABL == 4) o = (u32x4){0u, 0u, 0u, 0u};
        *(u32x4*)(ODIL + off) = o;
    }
}
template <bool INIT>
__device__ __forceinline__ void ota_update(LAS bf16_t* ota  , const LAS float* frow, int hi, const f32x16 (&o)[2]) {
#pragma unroll
    for (int r = 0; r < 16; ++r) { const int row = crow(r, hi); const float f = frow[row];
        float v0 = f * o[0][r], v1 = f * o[1][r];
        if (!INIT) { v0 += __uint_as_float((unsigned)ota[row * 64] << 16); v1 += __uint_as_float((unsigned)ota[row * 64 + 32] << 16); }
        ota[row * 64] = (bf16_t)(cvt_pk_bf16(v0, 0.f) & 0xffffu); ota[row * 64 + 32] = (bf16_t)(cvt_pk_bf16(v1, 0.f) & 0xffffu); }
}
#define NSA_T0(which) do { if (TNSA == (which) && blockIdx.x == 0 && wid == 0 && lane_id_fresh() == 0) { volatile LAS unsigned* M_ = (volatile LAS unsigned*)(lds + LDS_MISC); const unsigned long long t_ = __builtin_amdgcn_s_memrealtime(); M_[20] = (unsigned)t_; M_[21] = (unsigned)(t_ >> 32); } } while (0)
#define NSA_T1(which) do { if (TNSA == (which) && blockIdx.x == 0 && wid == 0 && lane_id_fresh() == 0) { volatile LAS unsigned* M_ = (volatile LAS unsigned*)(lds + LDS_MISC); const unsigned long long t_ = __builtin_amdgcn_s_memrealtime(); const unsigned long long t0_ = ((unsigned long long)M_[21] << 32) | M_[20]; \
        const unsigned long long d_ = (((unsigned long long)M_[23] << 32) | M_[22]) + (t_ - t0_); M_[22] = (unsigned)d_; M_[23] = (unsigned)(d_ >> 32); } } while (0)
#define NSA_SECT() const int lane = lane_id_fresh(); const int tid = wid * 64 + lane; const int r32 = lane & 31, hi = lane >> 5; (void)tid; (void)r32; (void)hi
__device__ __forceinline__ void nsa_unit(const Args& a, const Ctx& C, int b, int hk, int i) {
    using namespace att;
    LAS unsigned char* lds = C.lds;
    const int wid = C.wave; const int g = wid >> 1;
    const bf16_t* QKV = (const bf16_t*)(a.ws + WS_A);
    bf16x8 qr[4];
    f32x16 o[2];
    __syncthreads();
    NSA_T0(2);
    { NSA_SECT();
        const int tq = (wid & 1) * 32 + r32, t = 64 * i + tq; const size_t tok = (size_t)b * SEQ + t;
        LAS float* imp = (LAS float*)(lds + L_IMP); LAS float* gsh = (LAS float*)(lds + L_GSH) + wid * 96; LAS unsigned* selw = (LAS unsigned*)(lds + L_SEL);
        const bf16_t* KC = (const bf16_t*)(a.ws + WS_KC); const int nt = (4 * i + 2) / 64 + 1;
        cmp_issue(lds, wid, lane, KC + (size_t)((0 * 8 + b) * 2 + hk) * 256 * 64, KC + (size_t)((1 * 8 + b) * 2 + hk) * 256 * 64, nt);
        const bf16_t* qp = QKV + tok * LDQ + hk * 256 + g * 64;
#pragma unroll
        for (int d0 = 0; d0 < 4; ++d0) qr[d0] = *(const bf16x8*)(qp + d0 * 16 + hi * 8);
        float g0 = 0.f, g1 = 0.f, g2 = 0.f;
        if (hi == 0) { const float* gn = (const float*)(a.ws + WS_GN) + tok * 32 + hk * 4 + g; g0 = gn[0]; g1 = gn[8]; g2 = gn[16]; }
        for (int e = tid; e < 64 * 64; e += NTHR) imp[e] = 0.f;
        if (tid < 2) selw[128 + tid] = 0u;
        if (hi == 0) { gsh[r32] = (ABL == 1) ? 0.f : g0; gsh[32 + r32] = (ABL == 2) ? 0.f : g1; gsh[64 + r32] = (ABL == 3) ? 0.f : g2; }
        cmp_branch(lds, wid, lane, qr, nt, t, o);
        ota_update<true>((LAS bf16_t*)(lds + L_OTA) + wid * 2048 + r32, gsh, hi, o);
    }
    __syncthreads();
    NSA_T1(2);
    { NSA_SECT();
        LAS float* impP = (LAS float*)(lds + L_IMP); LAS unsigned* selw = (LAS unsigned*)(lds + L_SEL);
        const int q = tid >> 3, part = tid & 7;
        const int ncand = i - 2 > 0 ? i - 2 : 0; const int nforced = i + 1 < 3 ? i + 1 : 3; const int krem = 16 - nforced;
        unsigned bits = 0u;
        if (ncand > krem && ABL != 5) {
            float vn[8]; int cn[8];
#pragma unroll
            for (int e = 0; e < 8; ++e) { vn[e] = impP[q * 64 + part * 8 + e]; cn[e] = 0; }
#pragma unroll 4
            for (int mm = 1; mm <= i - 2; ++mm) { const float xv = impP[q * 64 + mm];
#pragma unroll
                for (int e = 0; e < 8; ++e) { const int n = part * 8 + e; cn[e] += (xv > vn[e] || (xv == vn[e] && mm < n)) ? 1 : 0; } }
#pragma unroll
            for (int e = 0; e < 8; ++e) { const int n = part * 8 + e; if (n >= 1 && n <= i - 2 && cn[e] < krem) bits |= 1u << e; }
        } else {
#pragma unroll
            for (int e = 0; e < 8; ++e) { const int n = part * 8 + e; if (n >= 1 && n <= i - 2) bits |= 1u << e; }
        }
#pragma unroll
        for (int e = 0; e < 8; ++e) { const int n = part * 8 + e; if (n == 0 || n == i || n == i - 1) bits |= 1u << e; }
        unsigned lo = part < 4 ? bits << (8 * part) : 0u, hi2 = part >= 4 ? bits << (8 * (part - 4)) : 0u;
        lo |= swz_xor_u<1>(lo); hi2 |= swz_xor_u<1>(hi2); lo |= swz_xor_u<2>(lo); hi2 |= swz_xor_u<2>(hi2); lo |= swz_xor_u<4>(lo); hi2 |= swz_xor_u<4>(hi2);
        if (part == 0) { selw[2 * q] = lo; selw[2 * q + 1] = hi2; atomicOr((unsigned*)&selw[128], lo); atomicOr((unsigned*)&selw[129], hi2); }
    }
    __syncthreads();
    int NTS, NTW;
    { NSA_SECT();
        LAS unsigned* selw = (LAS unsigned*)(lds + L_SEL);
        LAS unsigned char* tls = lds + L_SEL + 768; LAS unsigned char* tlw = lds + L_SEL + 848;
        const unsigned long long uni = ((unsigned long long)(unsigned)__builtin_amdgcn_readfirstlane((int)selw[129]) << 32) | (unsigned)__builtin_amdgcn_readfirstlane((int)selw[128]);
        const int nsel = __builtin_popcountll(uni); const int nts = (nsel + 1) & ~1; NTS = nts < 4 ? 4 : nts;
        const int jlo = i - 8 < 0 ? 0 : i - 8; const int nwin = i - jlo + 1; const int ntw = (nwin + 1) & ~1; NTW = ntw < 4 ? 4 : ntw;
        if (tid < 64) { if ((uni >> tid) & 1ull) tls[__builtin_popcountll(uni & ((1ull << tid) - 1ull))] = (unsigned char)tid; }
        else if (tid < 72) { const int k = nsel + (tid - 64); if (k < NTS) tls[k] = 0x80; }
        else if (tid < 88) { const int k = tid - 72; if (k < NTW) tlw[k] = (unsigned char)(k < nwin ? jlo + k : 0x80); }
    }
    __syncthreads();
    NSA_T0(1);
#pragma clang loop unroll(disable)
    for (int br = 0; br < 2; ++br) {
        float m = 0.f, l = 0.f;
        { NSA_SECT();
            const int tq = (wid & 1) * 32 + r32, t = 64 * i + tq;
            LAS unsigned* selw = (LAS unsigned*)(lds + L_SEL); LAS float* lut = (LAS float*)(lds + L_LUT);
            StreamP S; S.Kb = QKV + (size_t)b * SEQ * LDQ + 512 + 256 + br * 256 + hk * 64; S.Vb = S.Kb + 128; S.pitch = LDQ;
            S.NT = br ? NTW : NTS; S.tl = lds + L_SEL + (br ? 848 : 768); S.uq = t;
            S.lanesel = br ? ~0ull : (((unsigned long long)selw[2 * tq + 1] << 32) | selw[2 * tq]);
            S.lut = br ? lut + 7168 + g * 768 : lut + g * 1792; S.xtop = br ? 640 : 1636; S.dclamp = br ? (1 << 30) : 1636;
            attn_stream<8>(lds, wid, lane, qr, S, m, l, o);
        }
        { NSA_SECT();
            LAS float* gsh = (LAS float*)(lds + L_GSH) + wid * 96; LAS float* wsf = (LAS float*)(lds + L_WSF) + wid * 64;
            l = xhalf_sum(l);
            LDS_WAIT();
            if (hi == 0) wsf[r32] = (l > 0.f ? 1.0f / l : 0.f) * gsh[32 + br * 32 + r32];
            LDS_WAIT();
            ota_update<false>((LAS bf16_t*)(lds + L_OTA) + wid * 2048 + r32, wsf, hi, o);
        }
    }
    NSA_T1(1);
    { NSA_SECT();
        LDS_WAIT();
        bf16_t* ONSA = (bf16_t*)(a.ws + WS_ONSA);
        const LAS bf16_t* stg = (const LAS bf16_t*)(lds + L_OTA) + wid * 2048;
#pragma unroll
        for (int k = 0; k < 4; ++k) { const int row = k * 8 + (lane >> 3), chn = lane & 7; const u32x4 v = *(const LAS u32x4*)(stg + row * 64 + chn * 8);
            const size_t tk = (size_t)b * SEQ + 64 * i + (wid & 1) * 32 + row;
            *(u32x4*)(ONSA + tk * 512 + hk * 256 + g * 64 + chn * 8) = v; }
    }
}
__device__ __forceinline__ void build_bkt(const Ctx& C) {
    LAS unsigned char* bkt = C.lds + att::L_BKT; LAS unsigned char* bkc = C.lds + att::L_BKC;
    for (int d = C.tid; d < 4096; d += NTHR) bkt[d] = (unsigned char)att::bucket_of(d);
    for (int x = C.tid; x < 8704; x += NTHR) { const int dist = 4095 - x; bkc[x] = (unsigned char)(dist < 0 ? 128 : 4 * att::bucket_of(dist)); }
    __syncthreads();
}
__device__ __forceinline__ void build_nsa_tables(const Args& a, const Ctx& C, int hk) {
    using namespace att;
    LAS float* tbh = (LAS float*)(C.lds + L_TBH); LAS float* lut = (LAS float*)(C.lds + L_LUT);
    __syncthreads();
    if (C.tid < 144) { const int gg = C.tid / 36, bk = C.tid % 36; tbh[C.tid] = bk < 32 ? a.rel_bias[bk * 20 + hk * 4 + gg] * LOG2E : -INFINITY; }
    __syncthreads();
    for (int e = C.tid; e < 4 * 1792; e += NTHR) { const int gg = e / 1792, xx = e % 1792; const int dist = 1636 - xx;
        lut[e] = dist < 0 ? -INFINITY : tbh[gg * 36 + (int)C.lds[L_BKT + dist]]; }
    for (int e = C.tid; e < 4 * 768; e += NTHR) { const int gg = e / 768, xx = e % 768; const int dist = 640 - xx;
        lut[7168 + e] = (dist < 0 || dist > 512) ? -INFINITY : tbh[gg * 36 + (int)C.lds[L_BKT + dist]]; }
    __syncthreads();
}

typedef const Args __attribute__((address_space(4)))* CArgsP;
__device__ __forceinline__ Args load_args() {
#if defined(__HIP_DEVICE_COMPILE__)
    CArgsP p = (CArgsP)__builtin_amdgcn_kernarg_segment_ptr(); asm volatile("" : "+s"(p)); Args a;
    a.x = p->x; a.c = p->c; a.rel_bias = p->rel_bias; a.ada_w = p->ada_w; a.ada_b = p->ada_b; a.norm1 = p->norm1; a.norm2 = p->norm2; a.w_in = p->w_in;
    a.cmp_pos = p->cmp_pos; a.cmp_w1 = p->cmp_w1; a.cmp_w2 = p->cmp_w2; a.w_up_nsa = p->w_up_nsa; a.w_up_dil = p->w_up_dil; a.w_o = p->w_o;
    a.router_wg = p->router_wg; a.router_bg = p->router_bg; a.router_we = p->router_we; a.router_be = p->router_be; a.exp_w1 = p->exp_w1; a.exp_w3 = p->exp_w3; a.exp_w2 = p->exp_w2; a.norm_f = p->norm_f;
    a.out = p->out; a.ws = p->ws; a.ph_lo = p->ph_lo; a.ph_hi = p->ph_hi; a.use_bar = p->use_bar; a.pad = 0;
    return a;
#else
    return Args{};
#endif
}
#define LOADA() const Args a = load_args()
__global__ void __launch_bounds__(NTHR, 2) fwd_kernel(Args a_) {
    extern __shared__ __attribute__((aligned(16))) unsigned char lds_raw[];
    LAS unsigned char* const lds_base = (LAS unsigned char*)lds_raw;
    const int wave0_ = __builtin_amdgcn_readfirstlane((int)threadIdx.x >> 6);
#define FRESH() Ctx C; { int w_ = wave0_; asm volatile("" : "+s"(w_)); int t_ = lane_id_fresh(); asm volatile("" : "+v"(t_)); t_ += w_ * 64; int g_ = gridDim.x, b_ = blockIdx.x; asm volatile("" : "+s"(g_), "+s"(b_)); \
        C.lds = lds_base; C.tid = t_; C.lane = t_ & 63; C.wave = w_; C.G = g_; C.bx = b_; C.vcu = (g_ % 8 == 0) ? (b_ % 8) * (g_ / 8) + b_ / 8 : b_; }
    volatile LAS unsigned* MISC = (volatile LAS unsigned*)(lds_base + LDS_MISC);
    if (threadIdx.x < 64) MISC[threadIdx.x] = 0u;
    __syncthreads();
    unsigned* ctl = (unsigned*)(a_.ws + WS_CTL);
    XcdBarrier bar; bar.bar = ctl + CW_BAR; bar.x = 0; bar.st = nullptr;
    if (a_.use_bar) bar = xcd_barrier_post(ctl + CW_BAR, MISC + 8);
    const int lo = a_.ph_lo, hi = a_.ph_hi;
#ifndef PH_MASK
#define PH_MASK 0xFFFFFFFFu
#endif
#define IN(k) (((PH_MASK >> ((k) == 0 ? 10 : (k) == 21 ? 11 : (((k) - 1) % 10))) & 1u) && lo <= (k) && (k) < hi)
#define TIMED(k) ((TMASK >> (k)) & 1u)
#define TBEG(k) do { if (TMASK != 0u && TIMED(k) && blockIdx.x == 0 && wave0_ == 0 && lane_id_fresh() == 0) { const unsigned long long t_ = __builtin_amdgcn_s_memrealtime(); MISC[20] = (unsigned)t_; MISC[21] = (unsigned)(t_ >> 32); } } while (0)
#define TEND(k) do { if (TMASK != 0u && TIMED(k) && blockIdx.x == 0 && wave0_ == 0 && lane_id_fresh() == 0) { const unsigned long long t_ = __builtin_amdgcn_s_memrealtime(); const unsigned long long t0_ = ((unsigned long long)MISC[21] << 32) | MISC[20]; \
        const unsigned long long d_ = (((unsigned long long)MISC[23] << 32) | MISC[22]) + (t_ - t0_); MISC[22] = (unsigned)d_; MISC[23] = (unsigned)(d_ >> 32); } } while (0)
#define SEAM(k) do { if (IN(k) && IN((k) + 1)) { XcdBarrier b2_ = bar; asm volatile("" : "+s"(b2_.bar)); int w2_ = wave0_; asm volatile("" : "+s"(w2_)); xcd_barrier(b2_, w2_ == 0 && lane_id_fresh() == 0); } } while (0)
    TBEG(0);
    if (IN(0)) REPEAT(10) { __syncthreads(); FRESH(); LOADA(); prologue_vectors(a, C); conv_small(a, C); }
    SEAM(0); TEND(0);
    _Pragma("unroll") for (int l = 0; l < 2; ++l) {
        const int pb = 1 + 10 * l;
        TBEG(pb + 0);
        if (IN(pb + 0)) REPEAT(0) { FRESH(); LOADA(); norm1_phase(a, C, l); }
        SEAM(pb + 0); TEND(pb + 0);
        TBEG(pb + 1);
        if (IN(pb + 1)) REPEAT(1) { FRESH(); LOADA(); unsigned char* ws = a.ws;
            pg8::Gemm g{1024u, 1024u, 128u, 1024, 0u, 0u, 0, nullptr, nullptr, 0x77777777, 0x7c7c7c7c};
            pg8::DenseOrder S; S.init(T, NIN, C.G, C.bx, ws + WS_H, 1024u, ws + WS_WINT + (size_t)l * NIN * DM, 1024u);
            EpiInProj E{(bf16_t*)(ws + WS_A), (unsigned char*)(ws + WS_MG), (float*)(ws + WS_GN), 1.0f / 2048.0f};
            pg8::gemm_phase<EpiInProj, pg8::DenseOrder, true, false, false, true>(C.lds, C.tid, g, S, E);
        }
        SEAM(pb + 1); TEND(pb + 1);
        TBEG(pb + 2);
        if (IN(pb + 2)) REPEAT(2) { FRESH(); LOADA(); unsigned char* ws = a.ws;
            struct CmpOrder { int c; const char* A; const char* B;
                __device__ __forceinline__ bool next(int i, pg8::Unit& u) const { if (i > 0 || c >= 32) return false; const int kv = c >> 4, b = (c >> 1) & 7, hk = c & 1;
                    u.pm = c; u.pn = 0; u.A = A + ((size_t)b * SEQ * LDQ + 512 + kv * 128 + hk * 64) * 2; u.B = B + (size_t)kv * 256 * 2048 * 2; return true; } };
            pg8::Gemm g{(unsigned)(16 * LDQ * 2), 4096u, (unsigned)(LDQ * 2), 2048};
            CmpOrder S{C.vcu, (const char*)(ws + WS_A), (const char*)(ws + WS_CW1T + (size_t)l * 2 * 256 * 2048 * 2)};
            EpiCmp E{(bf16_t*)(ws + WS_HID), (const float*)(ws + WS_CB1) + l * 512, (const bf16_t*)(ws + WS_CW2T) + (size_t)l * 2 * 64 * 256, (bf16_t*)(ws + WS_KC)};
            pg8::gemm_phase<EpiCmp, CmpOrder, false>(C.lds, C.tid, g, S, E);
            __syncthreads();
            build_bkt(C);
            for (;;) { __syncthreads();
                if (C.tid == 0) *(volatile LAS int*)(C.lds + LDS_MISC + 512) = (int)__hip_atomic_fetch_add((unsigned*)(ws + WS_CTL) + CW_Q + l, 1u, __ATOMIC_RELAXED, __HIP_MEMORY_SCOPE_AGENT);
                __syncthreads();
                const int du = __builtin_amdgcn_readfirstlane(*(volatile LAS int*)(C.lds + LDS_MISC + 512));
                if (du >= 1536) break;
                dil_unit(a, C, du); }
        }
        SEAM(pb + 2); TEND(pb + 2);
        TBEG(pb + 3);
        if (IN(pb + 3)) REPEAT(3) { FRESH(); LOADA();
            dil_combine(a, C);
            build_bkt(C);
            int cur_hk = -1;
            for (int v = C.vcu; v < 256; v += C.G) { const int b = v >> 5, hk = (v >> 4) & 1, s = v & 15;
                if (hk != cur_hk) { build_nsa_tables(a, C, hk); cur_hk = hk; }
                for (int k = 0; k < 4; ++k) { const int qi = (k == 0) ? s : (k == 1) ? 31 - s : (k == 2) ? 32 + s : 63 - s; nsa_unit(a, C, b, hk, qi);
                    __syncthreads(); if (v < C.G) conv_experts_slice(a, C, l, k); } }
            if (C.vcu >= 256) { for (int q = 0; q < 4; ++q) conv_experts_slice(a, C, l, q); }
            __syncthreads();
        }
        SEAM(pb + 3); TEND(pb + 3);
        TBEG(pb + 4);
        if (IN(pb + 4)) REPEAT(4) { FRESH(); LOADA(); unsigned char* ws = a.ws;
            pg8::Gemm g{1024u, 1024u, 128u, 512, 512u, 512u, 256}; pg8::DenseOrder S; S.init(T, 1024, C.G, C.bx, ws + WS_ONSA, 1024u, ws + WS_WUNT + (size_t)l * 1024 * 512 * 2, 1024u);
            S.A2 = (const char*)(ws + WS_ODIL); S.B2 = (const char*)(ws + WS_WUDT + (size_t)l * 1024 * 256 * 2); S.tA2 = (size_t)256 * 512; S.tB2 = (size_t)256 * 512;
            EpiUpFused E{(bf16_t*)(ws + WS_MERGED), (const unsigned char*)(ws + WS_MG)};
            pg8::gemm_phase<EpiUpFused, pg8::DenseOrder, true, true>(C.lds, C.tid, g, S, E);
        }
        SEAM(pb + 4); TEND(pb + 4);
        TBEG(pb + 5);
        if (IN(pb + 5)) REPEAT(5) { FRESH(); LOADA(); unsigned char* ws = a.ws;
            pg8::Gemm g{2048u, 2048u, 128u, 1024}; pg8::DenseOrder S; S.init(T, 1024, C.G, C.bx, ws + WS_MERGED, 2048u, ws + WS_WOT + (size_t)l * 1024 * 1024 * 2, 2048u);
            EpiOut E{l == 0 ? a.x : (const float*)a.out, a.out, (const float*)(ws + WS_MOD) + (size_t)l * 8 * 6144 + 2048};
            pg8::gemm_phase<EpiOut, pg8::DenseOrder, true>(C.lds, C.tid, g, S, E);
        }
        SEAM(pb + 5); TEND(pb + 5);
        TBEG(pb + 6);
        if (IN(pb + 6)) REPEAT(6) { FRESH(); LOADA(); norm2_router_phase(a, C, l); }
        SEAM(pb + 6); TEND(pb + 6);
        TBEG(pb + 7);
        if (IN(pb + 7)) REPEAT(7) { FRESH(); LOADA(); moe_scatter_phase(a, C); }
        SEAM(pb + 7); TEND(pb + 7);
        TBEG(pb + 8);
        if (IN(pb + 8)) REPEAT(8) { FRESH(); LOADA(); unsigned char* ws = a.ws;
            const int* TILEE = (const int*)(ws + WS_TILEE); const int ntl = TILEE[0];
            MoeOrder S; S.G = C.G; S.c = C.vcu; S.nu = ntl * 4; S.A = (const char*)(ws + WS_XS); S.B = (const char*)(ws + WS_E13T); S.tA = (size_t)256 * 1024; S.tB = (size_t)256 * 1024; S.eB = (size_t)1024 * 1024;
#pragma unroll
            for (int i = 0; i < 8; ++i) { const int L = i * C.G + C.vcu; S.ex[i] = (L < S.nu) ? TILEE[16 + (L >> 2)] : 0; }
            pg8::Gemm g{1024u, 1024u, 128u, 1024, 0u, 0u, 0, (const int*)(ws + WS_TOKL), (const char*)(ws + WS_H2), 0, 0};
            EpiMoe1 E{(unsigned char*)(ws + WS_ACT), 1.0f / 2048.0f};
            pg8::gemm_phase<EpiMoe1, MoeOrder, true, false, true, true>(C.lds, C.tid, g, S, E);
        }
        SEAM(pb + 8); TEND(pb + 8);
        TBEG(pb + 9);
        if (IN(pb + 9)) REPEAT(9) { FRESH(); LOADA(); unsigned char* ws = a.ws;
            const int* TILEE = (const int*)(ws + WS_TILEE); const int ntl = TILEE[0];
            MoeOrder S; S.G = C.G; S.c = C.vcu; S.nu = ntl * 4; S.A = (const char*)(ws + WS_ACT); S.B = (const char*)(ws + WS_E2T); S.tA = (size_t)256 * 512; S.tB = (size_t)256 * 512; S.eB = (size_t)1024 * 512;
#pragma unroll
            for (int i = 0; i < 8; ++i) { const int L = i * C.G + C.vcu; S.ex[i] = (L < S.nu) ? TILEE[16 + (L >> 2)] : 0; }
            pg8::Gemm g{512u, 512u, 128u, 512};
            EpiPlain E{(bf16_t*)(ws + WS_XS), 1024, 1.0f / 1024.0f};
            pg8::gemm_phase<EpiPlain, MoeOrder, true, false, false, true>(C.lds, C.tid, g, S, E);
        }
        SEAM(pb + 9); TEND(pb + 9);
    }
    TBEG(21);
    if (IN(21)) { FRESH(); LOADA(); final_phase(a, C); }
    TEND(21);
    if ((TMASK != 0u || TNSA != 0) && blockIdx.x == 0 && wave0_ == 0 && lane_id_fresh() == 0) { const unsigned long long d_ = ((unsigned long long)MISC[23] << 32) | MISC[22]; const unsigned long long t0_ = __builtin_amdgcn_s_memrealtime();
        while (__builtin_amdgcn_s_memrealtime() - t0_ < TAMP * d_) __builtin_amdgcn_s_sleep(8); }
#undef IN
#undef SEAM
}

#ifndef ONE_LAUNCH
#define ONE_LAUNCH 1
#endif
extern "C" void kernel_launch(void* const* d_in, const int* in_sizes, int n_in, void* d_out, int out_size, void* d_ws, size_t ws_size, hipStream_t stream) {
    static int grid = 0;
    if (grid == 0) {
        if (n_in != 22 || out_size != T * DM || ws_size < WS_END) { fprintf(stderr, "kernel_launch: unexpected problem (n_in %d out %d ws %zu)\n", n_in, out_size, ws_size); grid = -1; return; }
        int dev = 0, cus = 0;
        if (hipGetDevice(&dev) != hipSuccess || hipDeviceGetAttribute(&cus, hipDeviceAttributeMultiprocessorCount, dev) != hipSuccess) { grid = -1; return; }
        if (hipFuncSetAttribute((const void*)fwd_kernel, hipFuncAttributeMaxDynamicSharedMemorySize, LDS_BYTES) != hipSuccess) { fprintf(stderr, "kernel_launch: hipFuncSetAttribute failed\n"); grid = -1; return; }
        int per_cu = 0;
        if (hipOccupancyMaxActiveBlocksPerMultiprocessor(&per_cu, (const void*)fwd_kernel, NTHR, LDS_BYTES) != hipSuccess || per_cu < 1) { fprintf(stderr, "kernel_launch: occupancy query reports %d\n", per_cu); }
        (void)hipGetLastError();
        grid = cus;
    }
    if (grid < 0) return;
    (void)hipMemsetAsync((char*)d_ws + WS_CTL, 0, CTL_ZERO_BYTES, stream);
    Args a{};
    a.x = (const float*)d_in[0]; a.c = (const float*)d_in[1]; a.rel_bias = (const float*)d_in[2]; a.ada_w = (const float*)d_in[3]; a.ada_b = (const float*)d_in[4];
    a.norm1 = (const float*)d_in[5]; a.norm2 = (const float*)d_in[6]; a.w_in = (const float*)d_in[7]; a.cmp_pos = (const float*)d_in[8]; a.cmp_w1 = (const float*)d_in[9];
    a.cmp_w2 = (const float*)d_in[10]; a.w_up_nsa = (const float*)d_in[11]; a.w_up_dil = (const float*)d_in[12]; a.w_o = (const float*)d_in[13];
    a.router_wg = (const float*)d_in[14]; a.router_bg = (const float*)d_in[15]; a.router_we = (const float*)d_in[16]; a.router_be = (const float*)d_in[17];
    a.exp_w1 = (const float*)d_in[18]; a.exp_w3 = (const float*)d_in[19]; a.exp_w2 = (const float*)d_in[20]; a.norm_f = (const float*)d_in[21];
    a.out = (float*)d_out; a.ws = (unsigned char*)d_ws; a.pad = 0;
#if ONE_LAUNCH
    a.ph_lo = 0; a.ph_hi = NPHASE; a.use_bar = 1;
    hipLaunchKernelGGL(fwd_kernel, dim3(grid), dim3(NTHR), LDS_BYTES, stream, a);
#else
    for (int p = 0; p < NPHASE; ++p) { a.ph_lo = p; a.ph_hi = p + 1; a.use_bar = 0;
        hipLaunchKernelGGL(fwd_kernel, dim3(grid), dim3(NTHR), LDS_BYTES, stream, a); }
#endif
}
```

```cpp
#include <hip/hip_runtime.h>
#include <cstdint>
#include <cstdio>

#define GAS __attribute__((address_space(1)))
#define LAS __attribute__((address_space(3)))
typedef unsigned short bf16_t;
typedef short bf16x8 __attribute__((ext_vector_type(8)));
typedef short s16x4 __attribute__((ext_vector_type(4)));
typedef float f32x4 __attribute__((ext_vector_type(4)));
typedef float f32x2 __attribute__((ext_vector_type(2)));
typedef float f32x16 __attribute__((ext_vector_type(16)));
typedef unsigned u32x4 __attribute__((ext_vector_type(4)));
typedef unsigned u32x2 __attribute__((ext_vector_type(2)));
typedef __bf16 bf16x2_t __attribute__((ext_vector_type(2)));

constexpr int NB = 8, SEQ = 4096, DM = 1024, T = NB * SEQ;
constexpr int LDQ = 3584;
constexpr int NIN = 5888;
constexpr int INW = 5656;
constexpr float LOG2E = 1.4426950408889634f;
constexpr float C2 = 0.125f * LOG2E;
constexpr int NWAVES = 8, NTHR = 512;
constexpr float RMS_EPS = 1e-6f;
constexpr int NPHASE = 22;
#ifndef ABL
#define ABL 0
#endif
#ifndef REP_MASK
#define REP_MASK 0u
#endif
#ifndef TMASK
#define TMASK 0u
#endif
#define TAMP 8ull
#ifndef TNSA
#define TNSA 0
#endif
#define REPEAT(k) _Pragma("clang loop unroll(disable)") for (int rep_ = 0; rep_ < (int)((REP_MASK >> (k)) & 1u) + 1; ++rep_)

constexpr size_t MiB = 1u << 20;
constexpr size_t WS_CTL = 0, CTL_ZERO_BYTES = MiB;
constexpr size_t WS_MOD = 1 * MiB;
constexpr size_t WS_CB1 = WS_MOD + 400 * 1024;
constexpr size_t WS_CW2T = WS_MOD + 512 * 1024;
constexpr size_t WS_CNTBLK = WS_MOD + 768 * 1024;
constexpr size_t WS_TILEE = WS_MOD + 832 * 1024;
constexpr size_t WS_WINT = 4 * MiB;
constexpr size_t WS_CW1T = 27 * MiB;
constexpr size_t WS_WUNT = 31 * MiB;
constexpr size_t WS_WUDT = 33 * MiB;
constexpr size_t WS_WOT = 34 * MiB;
constexpr size_t WS_E13T = 38 * MiB;
constexpr size_t WS_E2T = 102 * MiB;
constexpr size_t WS_A = 134 * MiB;
constexpr size_t WS_XS = WS_A;
constexpr size_t WS_ACT = WS_A + 144 * MiB;
constexpr size_t WS_MERGED = WS_A;
constexpr size_t WS_MG = 359 * MiB;
constexpr size_t WS_H2 = WS_MG;
constexpr size_t WS_REC = WS_MG + 64 * MiB;
constexpr size_t WS_DEST = WS_MG + 65 * MiB;
constexpr size_t WS_TOKL = WS_MG + 66 * MiB;
constexpr size_t WS_B = 487 * MiB;
constexpr size_t WS_H = WS_B;
constexpr size_t WS_ONSA = WS_B;
constexpr size_t WS_ODP = WS_B + 32 * MiB;
constexpr size_t WS_LSE = WS_B + 80 * MiB;
constexpr size_t WS_ODIL = WS_B + 82 * MiB;
constexpr size_t WS_GN = WS_B + 98 * MiB;
constexpr size_t WS_KC = WS_B + 102 * MiB;
constexpr size_t WS_HID = WS_B + 103 * MiB;
constexpr size_t WS_END = WS_B + 107 * MiB;

constexpr int CW_TMO = 0, CW_BAR = 4096, CW_Q = 8192;

constexpr int LDS_MISC = 158784;
constexpr int LDS_BYTES = 158784 + 2048;

__device__ __forceinline__ unsigned cvt_pk_bf16(float lo, float hi) { f32x2 v = {lo, hi}; bf16x2_t b = __builtin_convertvector(v, bf16x2_t); return __builtin_bit_cast(unsigned, b); }
__device__ __forceinline__ float bf_lo(unsigned w) { return __uint_as_float(w << 16); }
__device__ __forceinline__ float bf_hi(unsigned w) { return __uint_as_float(w & 0xffff0000u); }
__device__ __forceinline__ float sigmoidf_(float x) { return __builtin_amdgcn_rcpf(1.0f + __builtin_amdgcn_exp2f(-x * LOG2E)); }
__device__ __forceinline__ int lane_id_fresh() { unsigned ones = ~0u; asm volatile("" : "+s"(ones)); return (int)__builtin_amdgcn_mbcnt_hi(ones, __builtin_amdgcn_mbcnt_lo(ones, 0u)); }
template <int X> __device__ __forceinline__ float swz_xor_f(float v) { return __int_as_float(__builtin_amdgcn_ds_swizzle(__float_as_int(v), (X << 10) | 0x1f)); }
template <int X> __device__ __forceinline__ unsigned swz_xor_u(unsigned v) { return (unsigned)__builtin_amdgcn_ds_swizzle((int)v, (X << 10) | 0x1f); }
__device__ __forceinline__ float wave_sum(float v) {
    v += swz_xor_f<1>(v); v += swz_xor_f<2>(v); v += swz_xor_f<4>(v); v += swz_xor_f<8>(v); v += swz_xor_f<16>(v);
    auto rr = __builtin_amdgcn_permlane32_swap(__float_as_uint(v), __float_as_uint(v), false, false);
    return __uint_as_float(rr[0]) + __uint_as_float(rr[1]);
}
__device__ __forceinline__ int bperm_i(int srclane, int v) { return __builtin_amdgcn_ds_bpermute(srclane << 2, v); }
#define LDS_WAIT() asm volatile("s_waitcnt lgkmcnt(0)" ::: "memory")
#define VM_WAIT() asm volatile("s_waitcnt vmcnt(0)" ::: "memory")

#define XB_TMO      128
#define XB_XCNT(j)  (256  + 64 * (j))
#define XB_XSUB(j)  (1280 + 64 * (j))
#define XB_XGEN(j)  (2304 + 64 * (j))
#define XB_TOP      3328
#define XB_TOPGEN   3392
#define XCD_BAR_WORDS 3456
#define XB_SPIN_CAP (1u << 20)
__device__ __forceinline__ unsigned xb_ld(unsigned* p)              { return __hip_atomic_load(p, __ATOMIC_RELAXED, __HIP_MEMORY_SCOPE_AGENT); }
__device__ __forceinline__ unsigned xb_add(unsigned* p, unsigned v) { return __hip_atomic_fetch_add(p, v, __ATOMIC_RELAXED, __HIP_MEMORY_SCOPE_AGENT); }
__device__ __forceinline__ unsigned xb_xcc_id() { return (unsigned)__builtin_amdgcn_s_getreg((3 << 11) | 20) & 0xFu; }
#define XB_SPIN(cond, bar) do { unsigned _sp = 0; while (cond) { __builtin_amdgcn_s_sleep(1); \
    if ((++_sp & 255u) == 0u) { if (xb_ld(&(bar)[XB_TMO])) break; if (_sp > XB_SPIN_CAP) { atomicAdd(&(bar)[XB_TMO], 1u); break; } } } } while (0)
struct XcdBarrier { unsigned* bar; unsigned x; volatile LAS unsigned* st; };
__device__ __forceinline__ XcdBarrier xcd_barrier_post(unsigned* bar, volatile LAS unsigned* st) {
    XcdBarrier b; b.bar = bar; b.x = xb_xcc_id(); b.st = st;
    if (threadIdx.x == 0) (void)xb_add(&bar[XB_XCNT(b.x)], 1u);
    return b;
}
__device__ __forceinline__ void xcd_barrier_complete(unsigned* bar, unsigned x, unsigned& nloc, unsigned& nx) {
    const unsigned G = gridDim.x * gridDim.y * gridDim.z;
    unsigned sum, cnt, mine, sp = 0u;
    for (;;) {
        sum = 0u; cnt = 0u; mine = 0u;
#pragma unroll
        for (unsigned j = 0; j < 16; ++j) { const unsigned c = xb_ld(&bar[XB_XCNT(j)]); sum += c; cnt += (c > 0u) ? 1u : 0u; mine = (j == x) ? c : mine; }
        if (sum == G) break;
        __builtin_amdgcn_s_sleep(1);
        if ((++sp & 255u) == 0u) { if (xb_ld(&bar[XB_TMO])) break; if (sp > XB_SPIN_CAP) { atomicAdd(&bar[XB_TMO], 1u); break; } }
    }
    nloc = mine > 0u ? mine : 1u; nx = cnt > 0u ? cnt : 1u;
}
__device__ __forceinline__ void xcd_barrier(const XcdBarrier& b, const bool leader_thread) {
    asm volatile("s_waitcnt vmcnt(0)" ::: "memory");
    __syncthreads();
    if (leader_thread) {
        unsigned* bar = b.bar;
        __builtin_amdgcn_s_waitcnt(0);
        unsigned nloc = b.st[0], nx = b.st[1];
        if (nloc == 0u) { xcd_barrier_complete(bar, b.x, nloc, nx); b.st[0] = nloc; b.st[1] = nx; }
        const unsigned old = xb_add(&bar[XB_XSUB(b.x)], 1u);
        const unsigned gen = old / nloc;
        if (old + 1u == (gen + 1u) * nloc) {
            __builtin_amdgcn_fence(__ATOMIC_RELEASE, "agent");
            asm volatile("s_waitcnt vmcnt(0)" ::: "memory");
            const unsigned og = xb_add(&bar[XB_TOP], 1u);
            const unsigned tg = og / nx;
            if (og + 1u == (tg + 1u) * nx) xb_add(&bar[XB_TOPGEN], 1u);
            else XB_SPIN(xb_ld(&bar[XB_TOPGEN]) == tg, bar);
            __builtin_amdgcn_fence(__ATOMIC_ACQUIRE, "agent");
            xb_add(&bar[XB_XGEN(b.x)], 1u);
            asm volatile("s_waitcnt vmcnt(0)" ::: "memory");
        } else {
            XB_SPIN(xb_ld(&bar[XB_XGEN(b.x)]) == gen, bar);
            __builtin_amdgcn_fence(__ATOMIC_ACQUIRE, "agent");
            asm volatile("s_waitcnt vmcnt(0)" ::: "memory");
        }
    }
    __syncthreads();
}

namespace pg8 {
constexpr int BM = 256, BK = 64, HALF = 128, HTB = HALF * BK * 2, STAGE_BYTES = 8 * HTB;
__device__ __forceinline__ int lds_byte(int r, int c) { const int st = (r >> 4) * 2 + (c >> 5), rr = r & 15, cc = c & 31, ob = rr * 64 + cc * 2; return st * 1024 + (ob ^ (((ob >> 9) & 1) << 5)); }
__device__ __forceinline__ void stage_rc(int b, int& R, int& C) { const int st = b / 1024, sb = b % 1024, swz = sb ^ (((sb >> 9) & 1) << 5); R = (st >> 1) * 16 + swz / 64; C = (st & 1) * 32 + (swz % 64) / 2; }
__device__ __forceinline__ int perm32(int rho) { const int n = rho >> 4, i = rho & 15; return 8 * (i >> 2) + 4 * n + (i & 3); }

struct Unit { const char* A; const char* B; int pm, pn; const char* A2; const char* B2; };
struct Gemm { unsigned lda, ldb, kstepA; int K; unsigned lda2, ldb2; int K2; const int* tokl; const char* Abase; int sc_w, sc_a; };

template <class Epi, class Sched, bool ALIGN_EPI, bool SEG2 = false, bool GATHER = false, bool FP8 = false>
__device__ __forceinline__ void gemm_phase(LAS unsigned char* lds, const int tid, const Gemm g, const Sched& S, const Epi& E) {
    const int wid = __builtin_amdgcn_readfirstlane(tid >> 6), lane = tid & 63, wr = wid >> 2, wc = wid & 3, fr = lane & 15, fq = lane >> 4;
    const int nt0 = g.K / (FP8 ? 2 * BK : BK); const int nt = nt0 + (SEG2 ? g.K2 / BK : 0);
    unsigned voffA[2], voffB[2], voffA2[2], voffB2[2]; int Rrow[2]; unsigned Cb[2];
#pragma unroll
    for (int i = 0; i < 2; ++i) { int R, C; stage_rc(tid * 16 + i * 8192, R, C); Rrow[i] = R; Cb[i] = (unsigned)C * 2u; const int Rb = Epi::PERM ? ((R & ~31) + perm32(R & 31)) : R;
        voffA[i] = (unsigned)R * g.lda + (unsigned)C * 2u; voffB[i] = (unsigned)Rb * g.ldb + (unsigned)C * 2u;
        voffA2[i] = SEG2 ? (unsigned)R * g.lda2 + (unsigned)C * 2u : 0u; voffB2[i] = SEG2 ? (unsigned)Rb * g.ldb2 + (unsigned)C * 2u : 0u; }
    const size_t kstepA = (size_t)g.kstepA, kstepB = (size_t)(BK * 2);
    const size_t hstepA = (size_t)HALF * g.lda, hstepB = (size_t)HALF * g.ldb;
    const size_t hstepA2 = SEG2 ? (size_t)HALF * g.lda2 : 0, hstepB2 = SEG2 ? (size_t)HALF * g.ldb2 : 0;
    const unsigned ldsw = (unsigned)wid * 1024u;
    const int aoff = lds_byte(wr * 64 + fr, FP8 ? fq * 16 : fq * 8), boff = lds_byte(wc * 32 + fr, FP8 ? fq * 16 : fq * 8);
#define PG8_SA(b, h) (((b) * 2 + (h)) * HTB)
#define PG8_SB(b, h) ((4 + (b) * 2 + (h)) * HTB)
#define PG8_STAGE(bufoff, gbase, voff) do { _Pragma("unroll") for (int _i = 0; _i < 2; ++_i) \
        __builtin_amdgcn_global_load_lds((const unsigned*)((const char*)(gbase) + (voff)[_i]), (LAS unsigned*)(lds + (bufoff) + ldsw + _i * 8192), 16, 0, 0); } while (0)
#define PG8_STAGE2(bufoff, gbase, sel, v0, v1) do { _Pragma("unroll") for (int _i = 0; _i < 2; ++_i) \
        __builtin_amdgcn_global_load_lds((const unsigned*)((const char*)(gbase) + ((sel) ? (v1)[_i] : (v0)[_i])), (LAS unsigned*)(lds + (bufoff) + ldsw + _i * 8192), 16, 0, 0); } while (0)
#define PG8_LDA(dst, b, h) do { if constexpr (FP8) { _Pragma("unroll") for (int m = 0; m < 4; ++m) dst##8[m] = *(const LAS v8i_*)(lds + PG8_SA(b, h) + aoff + m * 2048); } \
        else { _Pragma("unroll") for (int m = 0; m < 4; ++m) _Pragma("unroll") for (int k = 0; k < 2; ++k) dst[m][k] = *(const LAS bf16x8*)(lds + PG8_SA(b, h) + aoff + m * 2048 + k * 1024); } } while (0)
#define PG8_LDB(dst, b, h) do { if constexpr (FP8) { _Pragma("unroll") for (int n = 0; n < 2; ++n) dst##8[n] = *(const LAS v8i_*)(lds + PG8_SB(b, h) + boff + n * 2048); } \
        else { _Pragma("unroll") for (int n = 0; n < 2; ++n) _Pragma("unroll") for (int k = 0; k < 2; ++k) dst[n][k] = *(const LAS bf16x8*)(lds + PG8_SB(b, h) + boff + n * 2048 + k * 1024); } } while (0)
#define PG8_MMA(ai, bj, At, Bt) do { __builtin_amdgcn_s_setprio(1); _Pragma("unroll") for (int m = 0; m < 4; ++m) _Pragma("unroll") for (int n = 0; n < 2; ++n) { \
        if constexpr (FP8) { asm volatile("v_mfma_f32_16x16x128_f8f6f4 %0, %1, %2, %0" : "+v"(acc[ai][bj][m][n]) : "v"(Bt##8[n]), "v"(At##8[m])); }     \
        else { _Pragma("unroll") for (int k = 0; k < 2; ++k) acc[ai][bj][m][n] = __builtin_amdgcn_mfma_f32_16x16x32_bf16(Bt[n][k], At[m][k], acc[ai][bj][m][n], 0, 0, 0); } } \
        __builtin_amdgcn_s_setprio(0); } while (0)
#define PG8_WAIT_V(n) asm volatile("s_waitcnt vmcnt(" #n ")" ::: "memory")
#define PG8_WAIT_L(n) asm volatile("s_waitcnt lgkmcnt(" #n ")" ::: "memory")
#define PG8_BAR __builtin_amdgcn_s_barrier()
#define PG8_SCHED __builtin_amdgcn_sched_barrier(0)
    Unit cur, nxt; int ui = 0;
    if (!S.next(0, cur)) return;
    f32x4 acc[2][2][4][2];
#pragma unroll
    for (int a = 0; a < 2; ++a)
#pragma unroll
        for (int b = 0; b < 2; ++b)
#pragma unroll
            for (int m = 0; m < 4; ++m)
#pragma unroll
                for (int n = 0; n < 2; ++n) acc[a][b][m][n] = (f32x4){0.f, 0.f, 0.f, 0.f};
    typedef int v8i_ __attribute__((ext_vector_type(8)));
    bf16x8 At[4][2], B0[2][2], B1[2][2]; v8i_ At8[4], B08[2], B18[2];
    const char* cA = GATHER ? g.Abase : cur.A; const char* cB = cur.B;
    unsigned vC0[2], vC1[2], vN0[2], vN1[2];
#define PG8_GLOAD(U, d0, d1) do { _Pragma("unroll") for (int _i = 0; _i < 2; ++_i) { \
        d0[_i] = (unsigned)g.tokl[(U).pm * 256 + Rrow[_i]] * g.lda + Cb[_i]; d1[_i] = (unsigned)g.tokl[(U).pm * 256 + 128 + Rrow[_i]] * g.lda + Cb[_i]; } } while (0)
    if constexpr (GATHER) { PG8_GLOAD(cur, vC0, vC1); }
    if constexpr (GATHER) {
        PG8_STAGE(PG8_SB(0, 0), cB, voffB); PG8_STAGE(PG8_SB(0, 1), cB + hstepB, voffB); PG8_STAGE(PG8_SA(0, 0), cA, vC0); PG8_STAGE(PG8_SA(0, 1), cA, vC1);
        if (wr == 1) PG8_BAR;
        PG8_WAIT_V(2); PG8_BAR;
        PG8_STAGE(PG8_SB(1, 0), cB + kstepB, voffB); PG8_STAGE(PG8_SA(1, 0), cA + kstepA, vC0); PG8_STAGE(PG8_SB(1, 1), cB + hstepB + kstepB, voffB);
        PG8_WAIT_V(6); PG8_BAR;
    } else {
    PG8_STAGE(PG8_SB(0, 0), cB, voffB); PG8_STAGE(PG8_SB(0, 1), cB + hstepB, voffB); PG8_STAGE(PG8_SA(0, 0), cA, voffA); PG8_STAGE(PG8_SA(0, 1), cA + hstepA, voffA);
    if (wr == 1) PG8_BAR;
    PG8_WAIT_V(2); PG8_BAR;
    PG8_STAGE(PG8_SB(1, 0), cB + kstepB, voffB); PG8_STAGE(PG8_SA(1, 0), cA + kstepA, voffA); PG8_STAGE(PG8_SB(1, 1), cB + hstepB + kstepB, voffB);
    PG8_WAIT_V(6); PG8_BAR;
    }
    for (;;) {
        const bool has_next = S.next(ui + 1, nxt);
        const char* nA = GATHER ? cA : (has_next ? nxt.A : cA); const char* nB = has_next ? nxt.B : cB;
        if constexpr (GATHER) { if (has_next) { PG8_GLOAD(nxt, vN0, vN1); } else { vN0[0] = vC0[0]; vN0[1] = vC0[1]; vN1[0] = vC1[0]; vN1[1] = vC1[1]; } }
#pragma clang loop unroll(disable)
        for (int t = 0; t < nt; t += 2) {
            const bool last = (t == nt - 2);
            if constexpr (SEG2) {
                const bool s1 = (t >= nt0);
                const bool s2 = !last && (t + 2 >= nt0);
                if (t == nt0) E.mid(acc, cur, wr, wc, fr, fq);
                const char* a1 = s1 ? cur.A2 + (size_t)(t + 1 - nt0) * kstepB : cA + (size_t)(t + 1) * kstepA; const size_t h1 = s1 ? hstepA2 : hstepA;
                const char* a2 = last ? nA : (s2 ? cur.A2 + (size_t)(t + 2 - nt0) * kstepB : cA + (size_t)(t + 2) * kstepA);
                const char* b2 = last ? nB : (s2 ? cur.B2 + (size_t)(t + 2 - nt0) * kstepB : cB + (size_t)(t + 2) * kstepB);
                const char* a3 = a2 + (s2 ? kstepB : kstepA); const char* b3 = b2 + kstepB;
                const size_t hA2 = s2 ? hstepA2 : hstepA, hB2 = s2 ? hstepB2 : hstepB;
                PG8_LDB(B0, 0, 0); PG8_LDB(B1, 0, 1); PG8_SCHED; PG8_LDA(At, 0, 0); PG8_STAGE2(PG8_SA(1, 1), a1 + h1, s1, voffA, voffA2);
                PG8_WAIT_V(8); PG8_WAIT_L(0); PG8_BAR; PG8_MMA(0, 0, At, B0); PG8_MMA(0, 1, At, B1); PG8_BAR; PG8_SCHED;
                PG8_LDA(At, 0, 1); PG8_STAGE2(PG8_SB(0, 0), b2, s2, voffB, voffB2); PG8_STAGE2(PG8_SB(0, 1), b2 + hB2, s2, voffB, voffB2); PG8_STAGE2(PG8_SA(0, 0), a2, s2, voffA, voffA2);
                PG8_WAIT_V(8); PG8_WAIT_L(0); PG8_BAR; PG8_MMA(1, 0, At, B0); PG8_MMA(1, 1, At, B1); PG8_BAR; PG8_SCHED;
                PG8_LDB(B0, 1, 0); PG8_LDB(B1, 1, 1); PG8_SCHED; PG8_LDA(At, 1, 0); PG8_STAGE2(PG8_SA(0, 1), a2 + hA2, s2, voffA, voffA2);
                PG8_WAIT_V(8); PG8_WAIT_L(0); PG8_BAR; PG8_MMA(0, 0, At, B0); PG8_MMA(0, 1, At, B1); PG8_BAR; PG8_SCHED;
                PG8_LDA(At, 1, 1); PG8_STAGE2(PG8_SB(1, 0), b3, s2, voffB, voffB2); PG8_STAGE2(PG8_SB(1, 1), b3 + hB2, s2, voffB, voffB2); PG8_STAGE2(PG8_SA(1, 0), a3, s2, voffA, voffA2);
                PG8_WAIT_V(8); PG8_WAIT_L(0); PG8_BAR; PG8_MMA(1, 0, At, B0); PG8_MMA(1, 1, At, B1); PG8_BAR; PG8_SCHED;
            } else if constexpr (GATHER) {
            const char* a1 = cA + (size_t)(t + 1) * kstepA;
            const char* a2 = last ? cA : cA + (size_t)(t + 2) * kstepA; const char* b2 = last ? nB : cB + (size_t)(t + 2) * kstepB;
            const char* a3 = a2 + kstepA; const char* b3 = b2 + kstepB;
            unsigned w0[2], w1[2]; w0[0] = last ? vN0[0] : vC0[0]; w0[1] = last ? vN0[1] : vC0[1]; w1[0] = last ? vN1[0] : vC1[0]; w1[1] = last ? vN1[1] : vC1[1];
            PG8_LDB(B0, 0, 0); PG8_LDB(B1, 0, 1); PG8_SCHED; PG8_LDA(At, 0, 0); PG8_STAGE(PG8_SA(1, 1), a1, vC1);
            PG8_WAIT_V(8); PG8_WAIT_L(0); PG8_BAR; PG8_MMA(0, 0, At, B0); PG8_MMA(0, 1, At, B1); PG8_BAR; PG8_SCHED;
            PG8_LDA(At, 0, 1); PG8_STAGE(PG8_SB(0, 0), b2, voffB); PG8_STAGE(PG8_SB(0, 1), b2 + hstepB, voffB); PG8_STAGE(PG8_SA(0, 0), a2, w0);
            PG8_WAIT_V(8); PG8_WAIT_L(0); PG8_BAR; PG8_MMA(1, 0, At, B0); PG8_MMA(1, 1, At, B1); PG8_BAR; PG8_SCHED;
            PG8_LDB(B0, 1, 0); PG8_LDB(B1, 1, 1); PG8_SCHED; PG8_LDA(At, 1, 0); PG8_STAGE(PG8_SA(0, 1), a2, w1);
            PG8_WAIT_V(8); PG8_WAIT_L(0); PG8_BAR; PG8_MMA(0, 0, At, B0); PG8_MMA(0, 1, At, B1); PG8_BAR; PG8_SCHED;
            PG8_LDA(At, 1, 1); PG8_STAGE(PG8_SB(1, 0), b3, voffB); PG8_STAGE(PG8_SB(1, 1), b3 + hstepB, voffB); PG8_STAGE(PG8_SA(1, 0), a3, w0);
            PG8_WAIT_V(8); PG8_WAIT_L(0); PG8_BAR; PG8_MMA(1, 0, At, B0); PG8_MMA(1, 1, At, B1); PG8_BAR; PG8_SCHED;
            } else {
            const char* a1 = cA + (size_t)(t + 1) * kstepA;
            const char* a2 = last ? nA : cA + (size_t)(t + 2) * kstepA; const char* b2 = last ? nB : cB + (size_t)(t + 2) * kstepB;
            const char* a3 = a2 + kstepA; const char* b3 = b2 + kstepB;
            PG8_LDB(B0, 0, 0); PG8_LDB(B1, 0, 1); PG8_SCHED; PG8_LDA(At, 0, 0); PG8_STAGE(PG8_SA(1, 1), a1 + hstepA, voffA);
            PG8_WAIT_V(8); PG8_WAIT_L(0); PG8_BAR; PG8_MMA(0, 0, At, B0); PG8_MMA(0, 1, At, B1); PG8_BAR; PG8_SCHED;
            PG8_LDA(At, 0, 1); PG8_STAGE(PG8_SB(0, 0), b2, voffB); PG8_STAGE(PG8_SB(0, 1), b2 + hstepB, voffB); PG8_STAGE(PG8_SA(0, 0), a2, voffA);
            PG8_WAIT_V(8); PG8_WAIT_L(0); PG8_BAR; PG8_MMA(1, 0, At, B0); PG8_MMA(1, 1, At, B1); PG8_BAR; PG8_SCHED;
            PG8_LDB(B0, 1, 0); PG8_LDB(B1, 1, 1); PG8_SCHED; PG8_LDA(At, 1, 0); PG8_STAGE(PG8_SA(0, 1), a2 + hstepA, voffA);
            PG8_WAIT_V(8); PG8_WAIT_L(0); PG8_BAR; PG8_MMA(0, 0, At, B0); PG8_MMA(0, 1, At, B1); PG8_BAR; PG8_SCHED;
            PG8_LDA(At, 1, 1); PG8_STAGE(PG8_SB(1, 0), b3, voffB); PG8_STAGE(PG8_SB(1, 1), b3 + hstepB, voffB); PG8_STAGE(PG8_SA(1, 0), a3, voffA);
            PG8_WAIT_V(8); PG8_WAIT_L(0); PG8_BAR; PG8_MMA(1, 0, At, B0); PG8_MMA(1, 1, At, B1); PG8_BAR; PG8_SCHED;
            }
        }
        if constexpr (ALIGN_EPI) { if (wr == 0) PG8_BAR; }
        if constexpr (FP8) { asm volatile("s_nop 15\n\ts_nop 15" ::: "memory"); }
        if constexpr (!Epi::AFTER_DRAIN) { int fr_ = fr, fq_ = fq; asm volatile("" : "+v"(fr_), "+v"(fq_));
            E(acc, cur, wr, wc, fr_, fq_); }
        if (!has_next) break;
#pragma unroll
        for (int a = 0; a < 2; ++a)
#pragma unroll
            for (int b = 0; b < 2; ++b)
#pragma unroll
                for (int m = 0; m < 4; ++m)
#pragma unroll
                    for (int n = 0; n < 2; ++n) acc[a][b][m][n] = (f32x4){0.f, 0.f, 0.f, 0.f};
        cur = nxt; cA = nA; cB = nB; ++ui;
        if constexpr (GATHER) { vC0[0] = vN0[0]; vC0[1] = vN0[1]; vC1[0] = vN1[0]; vC1[1] = vN1[1]; }
        if constexpr (ALIGN_EPI) { if (wr == 1) PG8_BAR; }
    }
    PG8_WAIT_V(0);
    if constexpr (!ALIGN_EPI) { if (wr == 0) PG8_BAR; }
    PG8_BAR;
    if constexpr (Epi::AFTER_DRAIN) { E.fused(acc, cur, wr, wc, fr, fq, wid, lane); }
#undef PG8_SA
#undef PG8_SB
#undef PG8_STAGE
#undef PG8_STAGE2
#undef PG8_GLOAD
#undef PG8_LDA
#undef PG8_LDB
#undef PG8_MMA
#undef PG8_WAIT_V
#undef PG8_WAIT_L
#undef PG8_BAR
#undef PG8_SCHED
}

struct DenseOrder {
    int nM, nN, nwg, G, c; const char* A; const char* B; size_t tA, tB; const char* A2 = nullptr; const char* B2 = nullptr; size_t tA2 = 0, tB2 = 0;
    __device__ __forceinline__ void init(int M, int N, int G_, int c_, const void* A_, unsigned lda, const void* B_, unsigned ldb) {
        nM = M / BM; nN = N / BM; nwg = nM * nN; G = G_; c = c_; A = (const char*)A_; B = (const char*)B_; tA = (size_t)BM * lda; tB = (size_t)BM * ldb; }
    __device__ __forceinline__ bool next(int i, Unit& u) const {
        const long L = (long)i * G + c; if (L >= nwg) return false;
        int wgid = (int)L; { const int q = nwg / 8, r = nwg % 8, xcd = wgid % 8, off = wgid / 8; wgid = (xcd < r ? xcd * (q + 1) : r * (q + 1) + (xcd - r) * q) + off; }
        const int nig = 8 * nN, gid = wgid / nig, fm = gid * 8, gsz = (nM - fm) < 8 ? (nM - fm) : 8;
        u.pm = fm + ((wgid % nig) % gsz); u.pn = (wgid % nig) / gsz;
        u.A = A + (size_t)u.pm * tA; u.B = B + (size_t)u.pn * tB; u.A2 = A2 + (size_t)u.pm * tA2; u.B2 = B2 + (size_t)u.pn * tB2; return true;
    }
};
}

struct Args {
    const float* x; const float* c; const float* rel_bias; const float* ada_w; const float* ada_b; const float* norm1; const float* norm2; const float* w_in;
    const float* cmp_pos; const float* cmp_w1; const float* cmp_w2; const float* w_up_nsa; const float* w_up_dil; const float* w_o;
    const float* router_wg; const float* router_bg; const float* router_we; const float* router_be; const float* exp_w1; const float* exp_w3; const float* exp_w2; const float* norm_f;
    float* out; unsigned char* ws; int ph_lo, ph_hi, use_bar, pad;
};

typedef f32x4 AccT[2][2][4][2];
__device__ __forceinline__ unsigned q8(float x) { return (unsigned)(sigmoidf_(x) * 255.0f + 0.5f); }
struct EpiInProj {
    static constexpr bool PERM = true, AFTER_DRAIN = false;
    bf16_t* QKV; unsigned char* MG; float* GN; float os;
    __device__ __forceinline__ void operator()(const AccT& acc, const pg8::Unit& u, int wr, int wc, int fr, int fq) const {
        const int pn = u.pn; const int row0 = u.pm * 256 + wr * 64 + fr;
        if (pn < 14) {
            const float sc = ((pn < 2 || (pn >= 5 && pn < 8)) ? C2 : 1.0f) * os;
            const int col0 = pn * 256 + wc * 32 + 8 * fq;
#pragma unroll
            for (int ai = 0; ai < 2; ++ai)
#pragma unroll
                for (int m = 0; m < 4; ++m) { bf16_t* rowp = QKV + (size_t)(row0 + ai * 128 + m * 16) * LDQ + col0;
#pragma unroll
                    for (int bj = 0; bj < 2; ++bj) { const f32x4 v0 = acc[ai][bj][m][0] * sc, v1 = acc[ai][bj][m][1] * sc; u32x4 w;
                        w.x = cvt_pk_bf16(v0[0], v0[1]); w.y = cvt_pk_bf16(v0[2], v0[3]); w.z = cvt_pk_bf16(v1[0], v1[1]); w.w = cvt_pk_bf16(v1[2], v1[3]);
                        *(u32x4*)(rowp + bj * 128) = w; } }
        } else if (pn < 22) {
            const int col0 = (pn - 14) * 256 + wc * 32 + 8 * fq;
#pragma unroll
            for (int ai = 0; ai < 2; ++ai)
#pragma unroll
                for (int m = 0; m < 4; ++m) { unsigned char* rowp = MG + (size_t)(row0 + ai * 128 + m * 16) * 2048 + col0;
#pragma unroll
                    for (int bj = 0; bj < 2; ++bj) { const f32x4 v0 = acc[ai][bj][m][0] * os, v1 = acc[ai][bj][m][1] * os; u32x2 w;
                        w.x = q8(v0[0]) | (q8(v0[1]) << 8) | (q8(v0[2]) << 16) | (q8(v0[3]) << 24); w.y = q8(v1[0]) | (q8(v1[1]) << 8) | (q8(v1[2]) << 16) | (q8(v1[3]) << 24);
                        *(u32x2*)(rowp + bj * 128) = w; } }
        } else {
            if (wc == 0 && fq < 3) {
#pragma unroll
                for (int ai = 0; ai < 2; ++ai)
#pragma unroll
                    for (int m = 0; m < 4; ++m) { float* rowp = GN + (size_t)(row0 + ai * 128 + m * 16) * 32 + 8 * fq;
                        const f32x4 v0 = acc[ai][0][m][0] * os, v1 = acc[ai][0][m][1] * os;
                        *(f32x4*)(rowp) = (f32x4){sigmoidf_(v0[0]), sigmoidf_(v0[1]), sigmoidf_(v0[2]), sigmoidf_(v0[3])};
                        *(f32x4*)(rowp + 4) = (f32x4){sigmoidf_(v1[0]), sigmoidf_(v1[1]), sigmoidf_(v1[2]), sigmoidf_(v1[3])}; }
            }
        }
    }
};
template <int PASS> struct EpiUp {
    static constexpr bool PERM = true, AFTER_DRAIN = false;
    bf16_t* MERGED; const bf16_t* MG;
    __device__ __forceinline__ void operator()(const AccT& acc, const pg8::Unit& u, int wr, int wc, int fr, int fq) const {
        const int row0 = u.pm * 256 + wr * 64 + fr; const int col0 = u.pn * 256 + wc * 32 + 8 * fq;
#pragma unroll
        for (int ai = 0; ai < 2; ++ai)
#pragma unroll
            for (int m = 0; m < 4; ++m) { const size_t row = (size_t)(row0 + ai * 128 + m * 16);
#pragma unroll
                for (int bj = 0; bj < 2; ++bj) {
                    const u32x4 gw = *(const u32x4*)(MG + row * 2048 + PASS * 1024 + col0 + bj * 128);
                    bf16_t* op = MERGED + row * 1024 + col0 + bj * 128;
                    const f32x4 v0 = acc[ai][bj][m][0], v1 = acc[ai][bj][m][1];
                    float r[8] = {v0[0] * bf_lo(gw.x), v0[1] * bf_hi(gw.x), v0[2] * bf_lo(gw.y), v0[3] * bf_hi(gw.y), v1[0] * bf_lo(gw.z), v1[1] * bf_hi(gw.z), v1[2] * bf_lo(gw.w), v1[3] * bf_hi(gw.w)};
                    if (PASS == 1) { const u32x4 ow = *(const u32x4*)op;
                        r[0] += bf_lo(ow.x); r[1] += bf_hi(ow.x); r[2] += bf_lo(ow.y); r[3] += bf_hi(ow.y); r[4] += bf_lo(ow.z); r[5] += bf_hi(ow.z); r[6] += bf_lo(ow.w); r[7] += bf_hi(ow.w); }
                    u32x4 w; w.x = cvt_pk_bf16(r[0], r[1]); w.y = cvt_pk_bf16(r[2], r[3]); w.z = cvt_pk_bf16(r[4], r[5]); w.w = cvt_pk_bf16(r[6], r[7]);
                    *(u32x4*)op = w; }
                asm volatile("" ::: "memory"); }
    }
};
struct EpiUpFused {
    static constexpr bool PERM = true, AFTER_DRAIN = false;
    bf16_t* MERGED; const unsigned char* MG;
    __device__ __forceinline__ void mid(AccT& acc, const pg8::Unit& u, int wr, int wc, int fr, int fq) const {
        const int row0 = u.pm * 256 + wr * 64 + fr; const int col0 = u.pn * 256 + wc * 32 + 8 * fq;
#pragma unroll
        for (int ai = 0; ai < 2; ++ai)
#pragma unroll
            for (int m = 0; m < 4; ++m) { const size_t row = (size_t)(row0 + ai * 128 + m * 16);
#pragma unroll
                for (int bj = 0; bj < 2; ++bj) {
                    const u32x2 g0 = *(const u32x2*)(MG + row * 2048 + col0 + bj * 128), g1 = *(const u32x2*)(MG + row * 2048 + 1024 + col0 + bj * 128);
                    f32x4& v0 = acc[ai][bj][m][0]; f32x4& v1 = acc[ai][bj][m][1];
#pragma unroll
                    for (int j = 0; j < 4; ++j) { const float a0 = (float)((g0.x >> (8 * j)) & 255u), b0 = (float)((g1.x >> (8 * j)) & 255u), a1 = (float)((g0.y >> (8 * j)) & 255u), b1 = (float)((g1.y >> (8 * j)) & 255u);
                        v0[j] *= a0 * __builtin_amdgcn_rcpf(__builtin_fmaxf(b0, 0.5f)); v1[j] *= a1 * __builtin_amdgcn_rcpf(__builtin_fmaxf(b1, 0.5f)); } }
                asm volatile("" ::: "memory"); }
    }
    __device__ __forceinline__ void operator()(const AccT& acc, const pg8::Unit& u, int wr, int wc, int fr, int fq) const {
        const int row0 = u.pm * 256 + wr * 64 + fr; const int col0 = u.pn * 256 + wc * 32 + 8 * fq;
#pragma unroll
        for (int ai = 0; ai < 2; ++ai)
#pragma unroll
            for (int m = 0; m < 4; ++m) { const size_t row = (size_t)(row0 + ai * 128 + m * 16);
#pragma unroll
                for (int bj = 0; bj < 2; ++bj) {
                    const u32x2 g1 = *(const u32x2*)(MG + row * 2048 + 1024 + col0 + bj * 128);
                    const f32x4 v0 = acc[ai][bj][m][0], v1 = acc[ai][bj][m][1]; float r[8];
#pragma unroll
                    for (int j = 0; j < 4; ++j) { r[j] = v0[j] * (__builtin_fmaxf((float)((g1.x >> (8 * j)) & 255u), 0.5f) * (1.0f / 255.0f)); r[4 + j] = v1[j] * (__builtin_fmaxf((float)((g1.y >> (8 * j)) & 255u), 0.5f) * (1.0f / 255.0f)); }
                    u32x4 w; w.x = cvt_pk_bf16(r[0], r[1]); w.y = cvt_pk_bf16(r[2], r[3]); w.z = cvt_pk_bf16(r[4], r[5]); w.w = cvt_pk_bf16(r[6], r[7]);
                    *(u32x4*)(MERGED + row * 1024 + col0 + bj * 128) = w; }
                asm volatile("" ::: "memory"); }
    }
};
struct EpiOut {
    static constexpr bool PERM = true, AFTER_DRAIN = false;
    const float* xin; float* xout; const float* g1;
    __device__ __forceinline__ void operator()(const AccT& acc, const pg8::Unit& u, int wr, int wc, int fr, int fq) const {
        const int row0 = u.pm * 256 + wr * 64 + fr; const int col0 = u.pn * 256 + wc * 32 + 8 * fq; const int b = u.pm >> 4;
        f32x4 gv[2][2];
#pragma unroll
        for (int bj = 0; bj < 2; ++bj)
#pragma unroll
            for (int n = 0; n < 2; ++n) gv[bj][n] = *(const f32x4*)(g1 + (size_t)b * 6144 + col0 + bj * 128 + 4 * n);
#pragma unroll
        for (int ai = 0; ai < 2; ++ai)
#pragma unroll
            for (int m = 0; m < 4; ++m) { const size_t off = (size_t)(row0 + ai * 128 + m * 16) * 1024 + col0;
#pragma unroll
                for (int bj = 0; bj < 2; ++bj)
#pragma unroll
                    for (int n = 0; n < 2; ++n) { const f32x4 xv = *(const f32x4*)(xin + off + bj * 128 + 4 * n);
                        *(f32x4*)(xout + off + bj * 128 + 4 * n) = (ABL == 7) ? xv : xv + gv[bj][n] * acc[ai][bj][m][n]; }
                asm volatile("" ::: "memory"); }
    }
};
struct EpiMoe1 {
    static constexpr bool PERM = true, AFTER_DRAIN = false;
    unsigned char* ACT; float os;
    __device__ __forceinline__ void operator()(const AccT& acc, const pg8::Unit& u, int wr, int wc, int fr, int fq) const {
        const int row0 = u.pm * 256 + wr * 64 + fr; const int col0 = u.pn * 128 + wc * 32 + 8 * fq;
#pragma unroll
        for (int ai = 0; ai < 2; ++ai)
#pragma unroll
            for (int m = 0; m < 4; ++m) { unsigned char* op = ACT + (size_t)(row0 + ai * 128 + m * 16) * 512 + col0; float r[8];
#pragma unroll
                for (int n = 0; n < 2; ++n)
#pragma unroll
                    for (int j = 0; j < 4; ++j) { const float a = acc[ai][0][m][n][j] * os, bb = acc[ai][1][m][n][j] * os; r[n * 4 + j] = a * sigmoidf_(a) * bb * 4.0f; }
                u32x2 w; w.x = (unsigned)__builtin_amdgcn_cvt_pk_fp8_f32(r[0], r[1], 0, false); w.x = (unsigned)__builtin_amdgcn_cvt_pk_fp8_f32(r[2], r[3], (int)w.x, true);
                w.y = (unsigned)__builtin_amdgcn_cvt_pk_fp8_f32(r[4], r[5], 0, false); w.y = (unsigned)__builtin_amdgcn_cvt_pk_fp8_f32(r[6], r[7], (int)w.y, true);
                *(u32x2*)op = w; }
    }
};
struct EpiPlain {
    static constexpr bool PERM = true, AFTER_DRAIN = false;
    bf16_t* O; int ldc; float os;
    __device__ __forceinline__ void operator()(const AccT& acc, const pg8::Unit& u, int wr, int wc, int fr, int fq) const {
        const int row0 = u.pm * 256 + wr * 64 + fr; const int col0 = u.pn * 256 + wc * 32 + 8 * fq;
#pragma unroll
        for (int ai = 0; ai < 2; ++ai)
#pragma unroll
            for (int m = 0; m < 4; ++m) { bf16_t* rowp = O + (size_t)(row0 + ai * 128 + m * 16) * ldc + col0;
#pragma unroll
                for (int bj = 0; bj < 2; ++bj) { const f32x4 v0 = acc[ai][bj][m][0] * os, v1 = acc[ai][bj][m][1] * os; u32x4 w;
                    w.x = cvt_pk_bf16(v0[0], v0[1]); w.y = cvt_pk_bf16(v0[2], v0[3]); w.z = cvt_pk_bf16(v1[0], v1[1]); w.w = cvt_pk_bf16(v1[2], v1[3]);
                    *(u32x4*)(rowp + bj * 128) = w; } }
    }
};
__device__ __forceinline__ int crow(int r, int hi) { return (r & 3) + 8 * (r >> 2) + 4 * hi; }
__device__ __forceinline__ float gelu_tanh(float x) { const float u2 = 2.0f * 0.7978845608028654f * (x + 0.044715f * x * x * x); return x * __builtin_amdgcn_rcpf(1.0f + __builtin_amdgcn_exp2f(-u2 * LOG2E)); }
struct EpiCmp {
    static constexpr bool PERM = true, AFTER_DRAIN = true;
    bf16_t* HID; const float* CB1; const bf16_t* CW2T; bf16_t* KC;
    __device__ __forceinline__ void fused(const AccT& acc, const pg8::Unit& u, int wr, int wc, int fr, int fq, int wid, int lane) const {
        const int kv = u.pm >> 4; const int row0 = u.pm * 256 + wr * 64 + fr; const int col0 = wc * 32 + 8 * fq;
        const float* bias = CB1 + kv * 256;
        f32x4 bv[2][2];
#pragma unroll
        for (int bj = 0; bj < 2; ++bj)
#pragma unroll
            for (int n = 0; n < 2; ++n) bv[bj][n] = *(const f32x4*)(bias + col0 + bj * 128 + 4 * n);
#pragma unroll
        for (int ai = 0; ai < 2; ++ai)
#pragma unroll
            for (int m = 0; m < 4; ++m) { bf16_t* rowp = HID + (size_t)(row0 + ai * 128 + m * 16) * 256 + col0;
#pragma unroll
                for (int bj = 0; bj < 2; ++bj) { const f32x4 v0 = acc[ai][bj][m][0] + bv[bj][0], v1 = acc[ai][bj][m][1] + bv[bj][1]; u32x4 w;
                    w.x = cvt_pk_bf16(gelu_tanh(v0[0]), gelu_tanh(v0[1])); w.y = cvt_pk_bf16(gelu_tanh(v0[2]), gelu_tanh(v0[3]));
                    w.z = cvt_pk_bf16(gelu_tanh(v1[0]), gelu_tanh(v1[1])); w.w = cvt_pk_bf16(gelu_tanh(v1[2]), gelu_tanh(v1[3]));
                    *(u32x4*)(rowp + bj * 128) = w; } }
        VM_WAIT(); __syncthreads();
        const int r32 = lane & 31, hi = lane >> 5;
        const bf16_t* ap = HID + (size_t)(u.pm * 256 + 32 * wid + r32) * 256 + hi * 8;
        const bf16_t* bp = CW2T + (size_t)kv * 64 * 256 + (size_t)r32 * 256 + hi * 8;
        f32x16 o0 = {}, o1 = {};
#pragma unroll 4
        for (int ks = 0; ks < 16; ++ks) {
            const bf16x8 a = *(const bf16x8*)(ap + ks * 16);
            const bf16x8 b0 = *(const bf16x8*)(bp + ks * 16), b1 = *(const bf16x8*)(bp + 32 * 256 + ks * 16);
            o0 = __builtin_amdgcn_mfma_f32_32x32x16_bf16(a, b0, o0, 0, 0, 0);
            o1 = __builtin_amdgcn_mfma_f32_32x32x16_bf16(a, b1, o1, 0, 0, 0);
        }
        bf16_t* kc = KC + (size_t)u.pm * 256 * 64;
#pragma unroll
        for (int r = 0; r < 16; ++r) { const int c = 32 * wid + crow(r, hi); const bool pad = (c == 255);
            kc[(size_t)c * 64 + r32] = pad ? (bf16_t)0 : (bf16_t)(cvt_pk_bf16(o0[r], 0.f) & 0xffffu);
            kc[(size_t)c * 64 + 32 + r32] = pad ? (bf16_t)0 : (bf16_t)(cvt_pk_bf16(o1[r], 0.f) & 0xffffu); }
    }
};

namespace att {
constexpr int L_KR = 0;
constexpr int L_VR = 24576;
constexpr int L_WSF = 49152;
constexpr int L_BKT = 51200;
constexpr int L_BKC = 55296;
constexpr int L_TBH = 64000;
constexpr int L_GSH = 64576;
constexpr int L_SEL = 67648;
constexpr int L_OTA = 68672;
constexpr int L_IMP = 101440;
constexpr int L_LUT = 117824;
constexpr int L_END = L_LUT + 40960;
static_assert(L_END <= LDS_MISC, "attention LDS map");

__device__ __forceinline__ void glds16(const void* gsrc, unsigned lds_dst) { unsigned keep;
    asm volatile("s_mov_b32 %0, m0\n\ts_mov_b32 m0, %2\n\ts_nop 0\n\tglobal_load_lds_dwordx4 %1, off\n\ts_mov_b32 m0, %0" : "=&s"(keep) : "v"(gsrc), "s"(lds_dst) : "memory"); }
__device__ __forceinline__ int bucket_of(int d) {
    if (d < 16) return d;
    int b = 16;
    b += (d >= 22); b += (d >= 30); b += (d >= 40); b += (d >= 54); b += (d >= 73); b += (d >= 99); b += (d >= 134); b += (d >= 182);
    b += (d >= 246); b += (d >= 332); b += (d >= 450); b += (d >= 609); b += (d >= 825); b += (d >= 1117); b += (d >= 1513);
    return b;
}
__device__ __forceinline__ void qkt(f32x16& p0, f32x16& p1, const LAS unsigned char* Kslot, const bf16x8 (&qr)[4], int r32, int hi) {
    const LAS unsigned char* kb = Kslot + hi * 1024 + r32 * 16;
    p0 = (f32x16){}; p1 = (f32x16){};
#pragma unroll
    for (int d0 = 0; d0 < 4; ++d0) {
        const bf16x8 b0 = *(const LAS bf16x8*)(kb + d0 * 2048);
        const bf16x8 b1 = *(const LAS bf16x8*)(kb + d0 * 2048 + 512);
        p0 = __builtin_amdgcn_mfma_f32_32x32x16_bf16(b0, qr[d0], p0, 0, 0, 0);
        p1 = __builtin_amdgcn_mfma_f32_32x32x16_bf16(b1, qr[d0], p1, 0, 0, 0);
    }
}
__device__ __forceinline__ void pv(f32x16 (&o)[2], int vb, bf16x8 pa0, bf16x8 pa1, bf16x8 pa2, bf16x8 pa3) {
#pragma unroll
    for (int d0 = 0; d0 < 2; ++d0) { s16x4 lo[4], hi[4];
#pragma unroll
        for (int ks = 0; ks < 4; ++ks) {
            asm volatile("ds_read_b64_tr_b16 %0,%1 offset:%c2" : "=&v"(lo[ks]) : "v"(vb), "i"(d0 * 4096 + ks * 1024) : "memory");
            asm volatile("ds_read_b64_tr_b16 %0,%1 offset:%c2" : "=&v"(hi[ks]) : "v"(vb), "i"(d0 * 4096 + ks * 1024 + 512) : "memory"); }
        asm volatile("s_waitcnt lgkmcnt(0)" ::: "memory"); __builtin_amdgcn_sched_barrier(0);
#define PK(k) (bf16x8){lo[k][0], lo[k][1], lo[k][2], lo[k][3], hi[k][0], hi[k][1], hi[k][2], hi[k][3]}
        o[d0] = __builtin_amdgcn_mfma_f32_32x32x16_bf16(pa0, PK(0), o[d0], 0, 0, 0);
        o[d0] = __builtin_amdgcn_mfma_f32_32x32x16_bf16(pa1, PK(1), o[d0], 0, 0, 0);
        o[d0] = __builtin_amdgcn_mfma_f32_32x32x16_bf16(pa2, PK(2), o[d0], 0, 0, 0);
        o[d0] = __builtin_amdgcn_mfma_f32_32x32x16_bf16(pa3, PK(3), o[d0], 0, 0, 0);
#undef PK
    }
}
__device__ __forceinline__ float xhalf_max(float v) { auto rr = __builtin_amdgcn_permlane32_swap(__float_as_uint(v), __float_as_uint(v), false, false); return __builtin_fmaxf(__uint_as_float(rr[0]), __uint_as_float(rr[1])); }
__device__ __forceinline__ float xhalf_sum(float v) { auto rr = __builtin_amdgcn_permlane32_swap(__float_as_uint(v), __float_as_uint(v), false, false); return __uint_as_float(rr[0]) + __uint_as_float(rr[1]); }

#define ATT_PACK(p0, p1, pw0, pw1, pw2, pw3) do { \
    pw0 = (u32x4){cvt_pk_bf16(p0[0], p0[1]), cvt_pk_bf16(p0[2], p0[3]), cvt_pk_bf16(p0[4], p0[5]), cvt_pk_bf16(p0[6], p0[7])}; \
    pw1 = (u32x4){cvt_pk_bf16(p0[8], p0[9]), cvt_pk_bf16(p0[10], p0[11]), cvt_pk_bf16(p0[12], p0[13]), cvt_pk_bf16(p0[14], p0[15])}; \
    pw2 = (u32x4){cvt_pk_bf16(p1[0], p1[1]), cvt_pk_bf16(p1[2], p1[3]), cvt_pk_bf16(p1[4], p1[5]), cvt_pk_bf16(p1[6], p1[7])}; \
    pw3 = (u32x4){cvt_pk_bf16(p1[8], p1[9]), cvt_pk_bf16(p1[10], p1[11]), cvt_pk_bf16(p1[12], p1[13]), cvt_pk_bf16(p1[14], p1[15])}; } while (0)

__device__ __forceinline__ void stage_rows(LAS unsigned char* lds, int wid, int lane, const f32x16 (&ot)[2]) {
    const int r32 = lane & 31, hi = lane >> 5;
    LAS bf16_t* stg = (LAS bf16_t*)(lds + L_OTA) + wid * 2048;
#pragma unroll
    for (int r = 0; r < 16; ++r) { const int orow = crow(r, hi);
#pragma unroll
        for (int d0 = 0; d0 < 2; ++d0) stg[orow * 64 + d0 * 32 + r32] = (bf16_t)(cvt_pk_bf16(ot[d0][r], 0.f) & 0xffffu); }
    LDS_WAIT();
}
struct StreamP { const bf16_t* Kb; const bf16_t* Vb; long pitch; int NT; const LAS unsigned char* tl; unsigned long long lanesel; int uq; const LAS float* lut; int xtop; int dclamp; };
typedef const LAS unsigned char* lds_cptr;
typedef short v4i16_t __attribute__((ext_vector_type(4)));
__device__ __forceinline__ void kload8(bf16x8* kf, lds_cptr kp) {
    kf[0] = *(const LAS bf16x8*)(kp);        kf[1] = *(const LAS bf16x8*)(kp + 512);
    kf[2] = *(const LAS bf16x8*)(kp + 2048); kf[3] = *(const LAS bf16x8*)(kp + 2560);
    kf[4] = *(const LAS bf16x8*)(kp + 4096); kf[5] = *(const LAS bf16x8*)(kp + 4608);
    kf[6] = *(const LAS bf16x8*)(kp + 6144); kf[7] = *(const LAS bf16x8*)(kp + 6656);
}
__device__ __forceinline__ void kload2(bf16x8* kf, lds_cptr kp, int j) { kf[2 * j] = *(const LAS bf16x8*)(kp + j * 2048); kf[2 * j + 1] = *(const LAS bf16x8*)(kp + j * 2048 + 512); }
__device__ __forceinline__ s16x4 vtr(lds_cptr p) { return __builtin_bit_cast(s16x4, __builtin_amdgcn_ds_read_tr16_b64_v4i16((LAS v4i16_t*)p)); }
constexpr int SLOTB = 8192;
#define ST_WAIT_BAR(N) asm volatile("s_waitcnt vmcnt(" #N ") lgkmcnt(0)\n\ts_barrier" ::: "memory")
template <int THRL>
__device__ __forceinline__ void attn_stream(LAS unsigned char* lds, const int wid, const int lane, const bf16x8 (&qr)[4], const StreamP S, float& mhat_o, float& l_o, f32x16 (&o)[2]) {
    const int r32 = lane & 31, hi = lane >> 5;
    const unsigned lds0 = (unsigned)(uintptr_t)lds;
    LAS float* wsf = (LAS float*)(lds + L_WSF) + wid * 64;
    const int NT = S.NT;
    const bf16_t* ksrc = S.Kb + (long)lane * S.pitch + wid * 8;
    const bf16_t* vsrc = S.Vb + (long)(16 * (wid & 3) + (lane >> 2)) * S.pitch + (wid >> 2) * 32 + (lane & 3) * 8;
    const unsigned kdst = lds0 + L_KR + wid * 1024, vdst = lds0 + L_VR + wid * 1024;
    const int tlv = (lane < NT) ? (int)S.tl[lane] : 0x80;
#define TLRAW(k) ((int)__builtin_amdgcn_readlane(tlv, __builtin_amdgcn_readfirstlane(k)))
#define DMA_K(k, slot) do { const int tr_ = TLRAW(k) & 63; glds16(ksrc + (long)tr_ * 64 * S.pitch, (unsigned)__builtin_amdgcn_readfirstlane(kdst + (slot))); } while (0)
#define DMA_V(k, slot) do { const int tr_ = TLRAW(k) & 63; glds16(vsrc + (long)tr_ * 64 * S.pitch, (unsigned)__builtin_amdgcn_readfirstlane(vdst + (slot))); } while (0)
    const lds_cptr kp0 = (lds_cptr)lds + L_KR + hi * 1024 + r32 * 16;
    const lds_cptr vp0 = (lds_cptr)lds + L_VR + ((lane >> 4) & 1) * 32 + (lane & 3) * 8 + (4 * hi + ((lane & 15) >> 2)) * 64;
    const int vb0 = (int)(lds0 + L_VR) + ((lane >> 4) & 1) * 32 + (lane & 3) * 8 + (4 * hi + ((lane & 15) >> 2)) * 64;
    bf16x8 kf[8];
#define LOFF(r) (((r) & 3) + 8 * ((r) >> 2))
#define LUTPTR(k, lp) do { const int raw_ = TLRAW(k); const int tj_ = raw_ & 63; int d0_ = S.uq - 64 * tj_ - 4 * hi; d0_ = d0_ < S.dclamp ? d0_ : S.dclamp; \
        const bool ok_ = (raw_ < 128) && (((S.lanesel >> tj_) & 1ull) != 0ull); lp = S.lut + (ok_ ? S.xtop - d0_ : S.xtop + 64); } while (0)
#define LUTLOAD(C0, C1, k) do { const int raw_ = TLRAW(k); const int tj_ = raw_ & 63; int d0_ = S.uq - 64 * tj_ - 4 * hi; d0_ = d0_ < S.dclamp ? d0_ : S.dclamp; \
        const bool ok_ = (raw_ < 128) && (((S.lanesel >> tj_) & 1ull) != 0ull); const LAS float* lp_ = S.lut + (ok_ ? S.xtop - d0_ : S.xtop + 64); \
        _Pragma("unroll") for (int r = 0; r < 16; ++r) { C0[r] = lp_[(r & 3) + 8 * (r >> 2)]; C1[r] = lp_[(r & 3) + 8 * (r >> 2) + 32]; } } while (0)
#define SBAR() __builtin_amdgcn_sched_barrier(0)
#define PIN(x) asm volatile("" : "+v"(x))
#define PKW(P, B) cvt_pk_bf16(P[B], P[B + 1])
#define PAF(k) __builtin_bit_cast(bf16x8, pw##k)
#define VFR(i) (bf16x8){vlo[i][0], vlo[i][1], vlo[i][2], vlo[i][3], vhi[i][0], vhi[i][1], vhi[i][2], vhi[i][3]}
#define MX3(a, b, c) __builtin_fmaxf(__builtin_fmaxf((a), (b)), (c))
#define MFMA32(a, b, c) __builtin_amdgcn_mfma_f32_32x32x16_bf16(a, b, c, 0, 0, 0)
#define GAPA(MF, A0, A1, A2, A3, W0, W1, PW) do { MF; sacc += A0; sacc += A1; sacc += A2; sacc += A3; PIN(sacc); W0; W1; PIN(PW); SBAR(); } while (0)
#define EX(v) __builtin_amdgcn_exp2f(v)
#define GAPB(MF, X, B, GN, PL, PO) do { MF; X[B] = EX(X[B]); X[B + 1] = EX(X[B + 1]); X[B + 2] = EX(X[B + 2]); X[B + 3] = EX(X[B + 3]); PIN(X); \
        if (GN) { PL[B] = lpn_[LOFF(B) + PO]; PL[B + 1] = lpn_[LOFF(B + 1) + PO]; PL[B + 2] = lpn_[LOFF(B + 2) + PO]; PL[B + 3] = lpn_[LOFF(B + 3) + PO]; } SBAR(); } while (0)
#define VRD(i) do { vlo[i] = vtr(vp_ + (((i) >> 2) * 4096 + ((i) & 3) * 1024)); vhi[i] = vtr(vp_ + (((i) >> 2) * 4096 + ((i) & 3) * 1024 + 512)); } while (0)
#define KRD(G, j) do { if (G) { kload2(kf, kp0 + sl_next, j); SBAR(); } } while (0)
#define ROT() do { sl_prev = sl_cur; sl_cur = sl_next; sl_next = (sl_next == 2 * SLOTB) ? 0 : sl_next + SLOTB; } while (0)
#define RESC() do { if (resc) { LDS_WAIT(); _Pragma("unroll") for (int d_ = 0; d_ < 2; ++d_) _Pragma("unroll") for (int r = 0; r < 16; ++r) o[d_][r] *= wsf[crow(r, hi)]; } } while (0)
#define ENDW(tt) do { if ((tt) + 3 < NT) { ST_WAIT_BAR(2); } else if ((tt) + 2 < NT) { ST_WAIT_BAR(1); } else { ST_WAIT_BAR(0); } } while (0)
#define STEP(C0, C1, P0, P1, t, GK, GV, GL, GN) do { SBAR(); \
    const lds_cptr vp_ = vp0 + sl_prev; const LAS float* lpn_ = S.lut; if (GN) { LUTPTR((t) + 1, lpn_); } \
    VRD(0); SBAR(); float sacc = (P0[0] + P0[1]); \
    GAPA(C0 = MFMA32(kf[0], qr[0], C0), P0[2], P0[3], P0[4], P0[5],     pw0[0] = PKW(P0, 0), pw0[1] = PKW(P0, 2), pw0); \
    VRD(4); SBAR(); GAPA(C1 = MFMA32(kf[1], qr[0], C1), P0[6], P0[7], P0[8], P0[9],     pw0[2] = PKW(P0, 4), pw0[3] = PKW(P0, 6), pw0); \
    VRD(1); SBAR(); GAPA(C0 = MFMA32(kf[2], qr[1], C0), P0[10], P0[11], P0[12], P0[13], pw1[0] = PKW(P0, 8), pw1[1] = PKW(P0, 10), pw1); \
    VRD(5); SBAR(); GAPA(C1 = MFMA32(kf[3], qr[1], C1), P0[14], P0[15], P1[0], P1[1],   pw1[2] = PKW(P0, 12), pw1[3] = PKW(P0, 14), pw1); \
    VRD(2); SBAR(); GAPA(C0 = MFMA32(kf[4], qr[2], C0), P1[2], P1[3], P1[4], P1[5],     pw2[0] = PKW(P1, 0), pw2[1] = PKW(P1, 2), pw2); \
    VRD(6); SBAR(); GAPA(C1 = MFMA32(kf[5], qr[2], C1), P1[6], P1[7], P1[8], P1[9],     pw2[2] = PKW(P1, 4), pw2[3] = PKW(P1, 6), pw2); \
    VRD(3); SBAR(); GAPA(C0 = MFMA32(kf[6], qr[3], C0), P1[10], P1[11], P1[12], P1[13], pw3[0] = PKW(P1, 8), pw3[1] = PKW(P1, 10), pw3); \
    VRD(7); SBAR(); GAPA(C1 = MFMA32(kf[7], qr[3], C1), P1[14], P1[15], 0.f, 0.f,       pw3[2] = PKW(P1, 12), pw3[3] = PKW(P1, 14), pw3); \
    l_reg += sacc; \
    if (GK) { DMA_K((t) + 3, sl_cur); } if (GV) { DMA_V((t) + 1, sl_next); } \
    { _Pragma("unroll") for (int r = 0; r < 16; ++r) { C0[r] -= mhat; C1[r] -= mhat; } \
      float a_ = MX3(C0[0], C0[1], C1[0]), b_ = MX3(C0[2], C0[3], C1[1]); a_ = MX3(a_, C1[2], C1[3]); \
      _Pragma("unroll") for (int r = 4; r < 16; r += 4) { a_ = MX3(a_, C0[r], C0[r + 1]); b_ = MX3(b_, C0[r + 2], C0[r + 3]); a_ = MX3(a_, C1[r], C1[r + 1]); b_ = MX3(b_, C1[r + 2], C1[r + 3]); } \
      float rm = xhalf_max(__builtin_fmaxf(a_, b_)); \
      resc = false; \
      if (__builtin_expect(__any(rm > (float)THRL), 0)) { const float dl = __builtin_fmaxf(rm, 0.f); mhat += dl; \
        _Pragma("unroll") for (int r = 0; r < 16; ++r) { C0[r] -= dl; C1[r] -= dl; } \
        const float f = __builtin_amdgcn_exp2f(-dl); l_reg *= f; if (hi == 0) wsf[r32] = f; resc = true; } } \
    SBAR(); \
    GAPB(o[0] = MFMA32(PAF(0), VFR(0), o[0]), C0, 0, GN, P0, 0); \
    GAPB(o[1] = MFMA32(PAF(0), VFR(4), o[1]), C0, 4, GN, P0, 0); \
    KRD(GL, 0); GAPB(o[0] = MFMA32(PAF(1), VFR(1), o[0]), C0, 8, GN, P0, 0); \
    KRD(GL, 1); GAPB(o[1] = MFMA32(PAF(1), VFR(5), o[1]), C0, 12, GN, P0, 0); \
    KRD(GL, 2); GAPB(o[0] = MFMA32(PAF(2), VFR(2), o[0]), C1, 0, GN, P1, 32); \
    KRD(GL, 3); GAPB(o[1] = MFMA32(PAF(2), VFR(6), o[1]), C1, 4, GN, P1, 32); \
    GAPB(o[0] = MFMA32(PAF(3), VFR(3), o[0]), C1, 8, GN, P1, 32); \
    GAPB(o[1] = MFMA32(PAF(3), VFR(7), o[1]), C1, 12, GN, P1, 32); \
    } while (0)
    float mhat = 0.f, l_reg = 0.f; bool resc = false;
    o[0] = (f32x16){}; o[1] = (f32x16){};
    f32x16 pA0, pA1, pB0, pB1;
    int sl_prev = 0, sl_cur = 0, sl_next = SLOTB;
    DMA_K(0, 0); DMA_V(0, 0); DMA_K(1, SLOTB); DMA_K(2, 2 * SLOTB);
    LUTLOAD(pA0, pA1, 0);
    ST_WAIT_BAR(3);
    { const lds_cptr kb = kp0;
#pragma unroll
      for (int d0 = 0; d0 < 4; ++d0) { const bf16x8 b0 = *(const LAS bf16x8*)(kb + d0 * 2048); const bf16x8 b1 = *(const LAS bf16x8*)(kb + d0 * 2048 + 512);
          pA0 = MFMA32(b0, qr[d0], pA0); pA1 = MFMA32(b1, qr[d0], pA1); }
      float rm = pA0[0];
#pragma unroll
      for (int r = 1; r < 16; ++r) rm = __builtin_fmaxf(rm, pA0[r]);
#pragma unroll
      for (int r = 0; r < 16; ++r) rm = __builtin_fmaxf(rm, pA1[r]);
      rm = xhalf_max(rm);
      mhat = (rm == -INFINITY) ? 0.f : rm;
#pragma unroll
      for (int r = 0; r < 16; ++r) { pA0[r] = EX(pA0[r] - mhat); pA1[r] = EX(pA1[r] - mhat); } }
    ST_WAIT_BAR(0);
    DMA_K(3, 0); DMA_V(1, SLOTB);
    ROT();
    kload8(kf, kp0 + sl_cur);
    LUTLOAD(pB0, pB1, 1);
    ST_WAIT_BAR(2);
    s16x4 vlo[8], vhi[8]; u32x4 pw0, pw1, pw2, pw3;
    int t = 1;
    for (; t + 5 < NT; t += 2) {
        STEP(pB0, pB1, pA0, pA1, t, true, true, true, true);     ST_WAIT_BAR(2); RESC(); ROT();
        STEP(pA0, pA1, pB0, pB1, t + 1, true, true, true, true); ST_WAIT_BAR(2); RESC(); ROT();
    }
    for (; t + 1 < NT; t += 2) {
        STEP(pB0, pB1, pA0, pA1, t, (t + 3 < NT), (t + 1 < NT), (t + 1 < NT), true);       ENDW(t);     RESC(); ROT();
        STEP(pA0, pA1, pB0, pB1, t + 1, (t + 4 < NT), (t + 2 < NT), (t + 2 < NT), true);   ENDW(t + 1); RESC(); ROT();
    }
    STEP(pB0, pB1, pA0, pA1, NT - 1, false, false, false, false); RESC();
    { float sacc = pB0[0] + pB0[1];
#pragma unroll
      for (int r = 2; r < 16; ++r) sacc += pB0[r];
#pragma unroll
      for (int r = 0; r < 16; ++r) sacc += pB1[r];
      l_reg += sacc;
      ATT_PACK(pB0, pB1, pw0, pw1, pw2, pw3);
      SBAR(); pv(o, vb0 + sl_cur, PAF(0), PAF(1), PAF(2), PAF(3)); }
    asm volatile("s_waitcnt lgkmcnt(0)\n\ts_barrier" ::: "memory");
    mhat_o = mhat; l_o = l_reg;
#undef TLRAW
#undef DMA_K
#undef DMA_V
#undef LUTLOAD
#undef LUTPTR
#undef LOFF
#undef SBAR
#undef PIN
#undef PKW
#undef PAF
#undef VFR
#undef MX3
#undef MFMA32
#undef GAPA
#undef EX
#undef GAPB
#undef VRD
#undef KRD
#undef ROT
#undef RESC
#undef ENDW
#undef STEP
}
__device__ __forceinline__ void cmp_scores(f32x16& s0, f32x16& s1, LAS unsigned char* lds, const LAS unsigned char* bkc, const LAS unsigned char* tb, const bf16x8 (&qr)[4], const int k, const int r32, const int hi) {
#pragma unroll
    for (int r = 0; r < 16; ++r) { const int off = 16 * ((r & 3) + 8 * (r >> 2));
        s0[r] = *(const LAS float*)(tb + bkc[1024 * k + off]); s1[r] = *(const LAS float*)(tb + bkc[1024 * k + off + 512]); }
    const LAS unsigned char* kb = lds + k * 8192 + hi * 1024 + r32 * 16;
#pragma unroll
    for (int d0 = 0; d0 < 4; ++d0) { const bf16x8 b0 = *(const LAS bf16x8*)(kb + d0 * 2048); const bf16x8 b1 = *(const LAS bf16x8*)(kb + d0 * 2048 + 512);
        s0 = __builtin_amdgcn_mfma_f32_32x32x16_bf16(b0, qr[d0], s0, 0, 0, 0); s1 = __builtin_amdgcn_mfma_f32_32x32x16_bf16(b1, qr[d0], s1, 0, 0, 0); }
}
__device__ __forceinline__ float xhalf_other(float v, int hi) { auto rr = __builtin_amdgcn_permlane32_swap(__float_as_uint(v), __float_as_uint(v), false, false); return __uint_as_float(hi ? rr[0] : rr[1]); }
__device__ __forceinline__ void cmp_issue(LAS unsigned char* lds, const int wid, const int lane, const bf16_t* Kb, const bf16_t* Vb, const int nt) {
    const unsigned lds0 = (unsigned)(uintptr_t)lds;
    { const bf16_t* ksrc = Kb + (long)lane * 64 + wid * 8; const bf16_t* vsrc = Vb + (long)(16 * (wid & 3) + (lane >> 2)) * 64 + (wid >> 2) * 32 + (lane & 3) * 8;
      for (int k = 0; k < nt; ++k) { glds16(ksrc + (long)k * 4096, (unsigned)__builtin_amdgcn_readfirstlane(lds0 + k * 8192 + wid * 1024));
                                     glds16(vsrc + (long)k * 4096, (unsigned)__builtin_amdgcn_readfirstlane(lds0 + L_OTA + k * 8192 + wid * 1024)); } }
}
__device__ __forceinline__ void cmp_branch(LAS unsigned char* lds, const int wid, const int lane, const bf16x8 (&qr)[4], const int nt, const int t, f32x16 (&o)[2]) {
    const int r32 = lane & 31, hi = lane >> 5, g = wid >> 1, tq = (wid & 1) * 32 + r32;
    const unsigned lds0 = (unsigned)(uintptr_t)lds;
    const LAS unsigned char* bkc = lds + L_BKC + (4126 - t + 64 * hi);
    const LAS unsigned char* tb = lds + L_TBH + g * 144;
    asm volatile("s_waitcnt vmcnt(0) lgkmcnt(0)\n\ts_barrier" ::: "memory");
    float m = -INFINITY, l = 0.f;
#pragma clang loop unroll(disable)
    for (int k = 0; k < nt; ++k) { f32x16 s0, s1; cmp_scores(s0, s1, lds, bkc, tb, qr, k, r32, hi);
        float rm = s0[0];
#pragma unroll
        for (int r = 1; r < 16; ++r) rm = __builtin_fmaxf(rm, s0[r]);
#pragma unroll
        for (int r = 0; r < 16; ++r) rm = __builtin_fmaxf(rm, s1[r]);
        rm = xhalf_max(rm);
        const float mn = __builtin_fmaxf(m, rm), ms = (mn == -INFINITY) ? 0.f : mn;
        float ps = 0.f;
#pragma unroll
        for (int r = 0; r < 16; ++r) ps += __builtin_amdgcn_exp2f(s0[r] - ms) + __builtin_amdgcn_exp2f(s1[r] - ms);
        l = l * __builtin_amdgcn_exp2f(m - ms) + ps; m = mn; }
    l = xhalf_sum(l);
    const float msafe = (m == -INFINITY) ? 0.f : m, inv = l > 0.f ? 1.0f / l : 0.f;
    float I[4][8]; float pc7 = 0.f;
    o[0] = (f32x16){}; o[1] = (f32x16){};
    const int vb0 = (int)(lds0 + L_OTA) + ((lane >> 4) & 1) * 32 + (lane & 3) * 8 + (4 * hi + ((lane & 15) >> 2)) * 64;
#pragma unroll
    for (int k = 0; k < 4; ++k) {
        if (k < nt) { f32x16 s0, s1; cmp_scores(s0, s1, lds, bkc, tb, qr, k, r32, hi);
#pragma unroll
            for (int r = 0; r < 16; ++r) { s0[r] = __builtin_amdgcn_exp2f(s0[r] - msafe) * inv; s1[r] = __builtin_amdgcn_exp2f(s1[r] - msafe) * inv; }
            float pc[8];
#pragma unroll
            for (int q = 0; q < 4; ++q) { I[k][q] = 2.0f * (s0[4 * q] + s0[4 * q + 1] + s0[4 * q + 2]) + s0[4 * q + 3]; I[k][4 + q] = 2.0f * (s1[4 * q] + s1[4 * q + 1] + s1[4 * q + 2]) + s1[4 * q + 3];
                pc[q] = xhalf_other(s0[4 * q + 3], hi); pc[4 + q] = xhalf_other(s1[4 * q + 3], hi); }
#pragma unroll
            for (int j = 0; j < 8; ++j) I[k][j] += hi ? pc[j] : (j > 0 ? pc[j - 1] : pc7);
            pc7 = pc[7];
            u32x4 pw0, pw1, pw2, pw3; ATT_PACK(s0, s1, pw0, pw1, pw2, pw3);
            pv(o, vb0 + k * 8192, __builtin_bit_cast(bf16x8, pw0), __builtin_bit_cast(bf16x8, pw1), __builtin_bit_cast(bf16x8, pw2), __builtin_bit_cast(bf16x8, pw3));
        } else {
#pragma unroll
            for (int j = 0; j < 8; ++j) I[k][j] = 0.f;
        }
    }
    LAS float* imp = (LAS float*)(lds + L_IMP) + tq * 64 + hi;
#pragma unroll 1
    for (int gi = 0; gi < 4; ++gi) {
        if (g == gi) {
#pragma unroll
            for (int k = 0; k < 4; ++k) if (k < nt) {
#pragma unroll
                for (int j = 0; j < 8; ++j) __builtin_amdgcn_ds_faddf(imp + 16 * k + 2 * j, I[k][j], 0, 0, false);
            }
        }
        asm volatile("s_waitcnt lgkmcnt(0)\n\ts_barrier" ::: "memory");
    }
}
}

struct Ctx { int tid, lane, wave, vcu, G, bx; LAS unsigned char* lds; };

struct TrD { const float* src; size_t ldw; int nvalid; bf16_t* dst; size_t ldk; float fp8s; };
__device__ __forceinline__ void tr_load(const TrD& d, float (&v)[32], int lane) {
    const int n = lane & 31; const float* src = d.src + (size_t)(lane >> 5) * d.ldw + n;
#pragma unroll
    for (int i = 0; i < 32; ++i) v[i] = (n < d.nvalid) ? src[(size_t)(2 * i) * d.ldw] : 0.f;
}
__device__ __forceinline__ void tr_store(const TrD& d, const float (&v)[32], LAS float* scr, int lane) {
    const int n = lane & 31;
#pragma unroll
    for (int i = 0; i < 32; ++i) scr[(2 * i + (lane >> 5)) * 33 + n] = v[i];
    LDS_WAIT(); asm volatile("" ::: "memory");
    const int c = lane & 7;
#pragma unroll
    for (int j = 0; j < 4; ++j) { const int nn = (lane >> 3) + 8 * j; const LAS float* s = scr + (8 * c) * 33 + nn;
        if (d.fp8s != 0.f) { const float f = d.fp8s; u32x2 o;
            o.x = (unsigned)__builtin_amdgcn_cvt_pk_fp8_f32(s[0 * 33] * f, s[1 * 33] * f, 0, false); o.x = (unsigned)__builtin_amdgcn_cvt_pk_fp8_f32(s[2 * 33] * f, s[3 * 33] * f, (int)o.x, true);
            o.y = (unsigned)__builtin_amdgcn_cvt_pk_fp8_f32(s[4 * 33] * f, s[5 * 33] * f, 0, false); o.y = (unsigned)__builtin_amdgcn_cvt_pk_fp8_f32(s[6 * 33] * f, s[7 * 33] * f, (int)o.y, true);
            *(u32x2*)((unsigned char*)d.dst + (size_t)nn * d.ldk + 8 * c) = o;
        } else {
        u32x4 o; o.x = cvt_pk_bf16(s[0 * 33], s[1 * 33]); o.y = cvt_pk_bf16(s[2 * 33], s[3 * 33]); o.z = cvt_pk_bf16(s[4 * 33], s[5 * 33]); o.w = cvt_pk_bf16(s[6 * 33], s[7 * 33]);
        *(u32x4*)(d.dst + (size_t)nn * d.ldk + 8 * c) = o; } }
    LDS_WAIT(); asm volatile("" ::: "memory");
}
__device__ __forceinline__ TrD mk_trd(const float* W, size_t ldw, int srccol, int nvalid, bf16_t* WT, size_t ldk, int dstrow, int k0) {
    TrD d; d.src = W + (size_t)k0 * ldw + srccol; d.ldw = ldw; d.nvalid = nvalid; d.dst = WT + (size_t)dstrow * ldk + k0; d.ldk = ldk; d.fp8s = 0.f; return d; }
__device__ __forceinline__ TrD mk_trd8(const float* W, size_t ldw, int srccol, int nvalid, unsigned char* WT8, size_t ldk, int dstrow, int k0, float scale) {
    TrD d; d.src = W + (size_t)k0 * ldw + srccol; d.ldw = ldw; d.nvalid = nvalid; d.dst = (bf16_t*)(WT8 + (size_t)dstrow * ldk + k0); d.ldk = ldk; d.fp8s = scale; return d; }
__device__ __forceinline__ TrD dec_small(const Args& a, int it) {
    constexpr int I_WIN = 184 * 16, I_CW1 = 2 * 8 * 32, I_WUN = 32 * 8, I_WUD = 32 * 4, I_WO = 32 * 16, I_CW2 = 2 * 2 * 4;
    constexpr int PER = I_WIN + I_CW1 + I_WUN + I_WUD + I_WO + I_CW2;
    unsigned char* ws = a.ws;
    const int l = it / PER; int r = it % PER;
    if (r < I_WIN) { const int nb = r / 16, kb = r % 16; const int nd = 32 * nb; int src, nv = 32;
        if (nd < 1280) src = nd; else if (nd < 5632) src = nd + 24; else if (nd == 5632) { src = 1280; nv = 24; } else { src = 0; nv = 0; }
        return mk_trd8(a.w_in + (size_t)l * DM * INW, INW, src, nv, (unsigned char*)(ws + WS_WINT) + (size_t)l * NIN * DM, DM, nd, 64 * kb, 256.0f); }
    r -= I_WIN;
    if (r < I_CW1) { const int kv = r / 256, q = r % 256, nb = q / 32, kb = q % 32;
        return mk_trd(a.cmp_w1 + (size_t)(l * 2 + kv) * 2048 * 256, 256, 32 * nb, 32, (bf16_t*)(ws + WS_CW1T) + (size_t)(l * 2 + kv) * 256 * 2048, 2048, 32 * nb, 64 * kb); }
    r -= I_CW1;
    if (r < I_WUN) { const int nb = r / 8, kb = r % 8;
        return mk_trd(a.w_up_nsa + (size_t)l * 512 * 1024, 1024, 32 * nb, 32, (bf16_t*)(ws + WS_WUNT) + (size_t)l * 1024 * 512, 512, 32 * nb, 64 * kb); }
    r -= I_WUN;
    if (r < I_WUD) { const int nb = r / 4, kb = r % 4;
        return mk_trd(a.w_up_dil + (size_t)l * 256 * 1024, 1024, 32 * nb, 32, (bf16_t*)(ws + WS_WUDT) + (size_t)l * 1024 * 256, 256, 32 * nb, 64 * kb); }
    r -= I_WUD;
    if (r < I_WO) { const int nb = r / 16, kb = r % 16;
        return mk_trd(a.w_o + (size_t)l * 1024 * 1024, 1024, 32 * nb, 32, (bf16_t*)(ws + WS_WOT) + (size_t)l * 1024 * 1024, 1024, 32 * nb, 64 * kb); }
    r -= I_WO;
    { const int kv = r / 8, q = r % 8, nb = q / 4, kb = q % 4;
        return mk_trd(a.cmp_w2 + (size_t)(l * 2 + kv) * 256 * 64, 64, 32 * nb, 32, (bf16_t*)(ws + WS_CW2T) + (size_t)(l * 2 + kv) * 64 * 256, 256, 32 * nb, 64 * kb); }
}
__device__ __forceinline__ TrD dec_expert(const Args& a, int l, int it) {
    constexpr int I_13 = 32 * 16, I_2 = 32 * 8, PER = I_13 + I_2;
    unsigned char* ws = a.ws;
    const int e = it / PER; int r = it % PER;
    if (r < I_13) { const int nb = r / 16, kb = r % 16; const int r0 = 32 * nb, pn = r0 >> 8, bj = (r0 >> 7) & 1, j0 = r0 & 127;
        const float* src = (bj ? a.exp_w3 : a.exp_w1) + (size_t)(l * 32 + e) * 1024 * 512;
        return mk_trd8(src, 512, pn * 128 + j0, 32, (unsigned char*)(ws + WS_E13T) + (size_t)e * 1024 * 1024, 1024, r0, 64 * kb, 256.0f); }
    r -= I_13;
    { const int nb = r / 8, kb = r % 8;
        return mk_trd8(a.exp_w2 + (size_t)(l * 32 + e) * 512 * 1024, 1024, 32 * nb, 32, (unsigned char*)(ws + WS_E2T) + (size_t)e * 1024 * 512, 512, 32 * nb, 64 * kb, 256.0f); }
}
template <int KIND> __device__ __forceinline__ void conv_items(const Args& a, const Ctx& C, int l, int first, int nitems, LAS float* scr) {
    const int NGW = C.G * NWAVES;
    float va[32], vb[32]; TrD d0, d1;
    int it = first;
    if (it >= nitems) return;
    d0 = KIND ? dec_expert(a, l, it) : dec_small(a, it); tr_load(d0, va, C.lane);
    for (;;) {
        const int itn = it + NGW; const bool hn = itn < nitems;
        if (hn) { d1 = KIND ? dec_expert(a, l, itn) : dec_small(a, itn); tr_load(d1, vb, C.lane); }
        tr_store(d0, va, scr, C.lane);
        if (!hn) break;
        const int itnn = itn + NGW; const bool hnn = itnn < nitems;
        if (hnn) { d0 = KIND ? dec_expert(a, l, itnn) : dec_small(a, itnn); tr_load(d0, va, C.lane); }
        tr_store(d1, vb, scr, C.lane);
        if (!hnn) break;
        it = itnn;
    }
}
__device__ __forceinline__ void conv_small(const Args& a, const Ctx& C) { conv_items<0>(a, C, 0, C.vcu * NWAVES + C.wave, 2 * 4368, (LAS float*)(C.lds + C.wave * 16384)); }
__device__ __forceinline__ void conv_experts_slice(const Args& a, const Ctx& C, int l, int q) {
    const int NGW = C.G * NWAVES; const int per = 3 * NGW;
    LAS float* scr = (LAS float*)(C.lds + (C.wave < 5 ? C.wave * 8448 : att::L_OTA + (C.wave - 5) * 8448));
    const int lo = q * per, hi = (q == 3) ? 32 * 768 : ((q + 1) * per < 32 * 768 ? (q + 1) * per : 32 * 768);
    if (lo < hi) conv_items<1>(a, C, l, lo + C.vcu * NWAVES + C.wave, hi, scr);
}
__device__ __forceinline__ void prologue_vectors(const Args& a, const Ctx& C) {
    LAS float* sl = (LAS float*)(C.lds);
    LAS float* part = (LAS float*)(C.lds + 32768);
    for (int i = C.tid; i < 8 * 1024; i += NTHR) { const float v = a.c[i]; sl[i] = v * sigmoidf_(v); }
    __syncthreads();
    float* MOD = (float*)(a.ws + WS_MOD); float* CB1 = (float*)(a.ws + WS_CB1);
    for (int it = C.vcu; it < 192 + 16; it += C.G) {
        float acc[8];
#pragma unroll
        for (int b = 0; b < 8; ++b) acc[b] = 0.f;
        if (it < 192) { const int l = it / 96, col = (it % 96) * 64 + C.lane;
            const float* w = a.ada_w + (size_t)l * 1024 * 6144 + col;
            for (int k0 = 128 * C.wave; k0 < 128 * C.wave + 128; k0 += 32) { float wv[32];
#pragma unroll
                for (int j = 0; j < 32; ++j) wv[j] = w[(size_t)(k0 + j) * 6144];
#pragma unroll
                for (int j = 0; j < 32; ++j)
#pragma unroll
                    for (int b = 0; b < 8; ++b) acc[b] += sl[b * 1024 + k0 + j] * wv[j]; }
        } else { const int q = it - 192, lk = q / 4, col = (q % 4) * 64 + C.lane;
            const float* w = a.cmp_w1 + (size_t)lk * 2048 * 256 + col; const float* pos = a.cmp_pos + (size_t)lk * 2048;
            for (int k0 = 256 * C.wave; k0 < 256 * C.wave + 256; k0 += 32) { float wv[32];
#pragma unroll
                for (int j = 0; j < 32; ++j) wv[j] = w[(size_t)(k0 + j) * 256];
#pragma unroll
                for (int j = 0; j < 32; ++j) acc[0] += pos[k0 + j] * wv[j]; }
        }
        __syncthreads();
#pragma unroll
        for (int b = 0; b < 8; ++b) part[(C.wave * 8 + b) * 64 + C.lane] = acc[b];
        __syncthreads();
        if (C.wave == 0) {
            float tot[8];
#pragma unroll
            for (int b = 0; b < 8; ++b) { float t2 = 0.f;
#pragma unroll
                for (int w = 0; w < 8; ++w) t2 += part[(w * 8 + b) * 64 + C.lane];
                tot[b] = t2; }
            if (it < 192) { const int l = it / 96, col = (it % 96) * 64 + C.lane; const float bias = a.ada_b[l * 6144 + col];
#pragma unroll
                for (int b = 0; b < 8; ++b) MOD[(size_t)(l * 8 + b) * 6144 + col] = tot[b] + bias;
            } else { const int q = it - 192, lk = q / 4, col = (q % 4) * 64 + C.lane; CB1[lk * 256 + col] = tot[0]; }
        }
    }
    __syncthreads();
}

struct RowX { f32x4 v[4]; };
struct RowY { u32x2 y0[4], y1[4]; };
template <int KIND> __device__ __forceinline__ void ld_x(const Args& a, int row, int lane, RowX& X) {
    const float* xr = (KIND == 0 ? a.x : (const float*)a.out) + (size_t)row * 1024;
#pragma unroll
    for (int j = 0; j < 4; ++j) X.v[j] = *((const f32x4*)xr + lane + 64 * j);
}
__device__ __forceinline__ void ld_y(const Args& a, const u32x4& rec, int lane, RowY& Y) {
    const bf16_t* Yb = (const bf16_t*)(a.ws + WS_XS);
    const u32x2* y0 = (const u32x2*)(Yb + (size_t)rec.x * 1024) + lane; const u32x2* y1 = (const u32x2*)(Yb + (size_t)rec.y * 1024) + lane;
#pragma unroll
    for (int j = 0; j < 4; ++j) { Y.y0[j] = y0[64 * j]; Y.y1[j] = y1[64 * j]; }
}
struct ColV { f32x4 A[4], B[4], G2[4]; };
template <int KIND> __device__ __forceinline__ void row_finish(const Args& a, int row, int lane, RowX& X, const RowY& Y, const u32x4& rec, const ColV& V) {
    if (KIND != 0) {
        const float w0 = (ABL == 6) ? 0.f : __uint_as_float(rec.z), w1 = (ABL == 6) ? 0.f : __uint_as_float(rec.w);
#pragma unroll
        for (int j = 0; j < 4; ++j) { const u32x2 p = Y.y0[j], q = Y.y1[j]; const f32x4 gg = V.G2[j];
            X.v[j][0] += gg[0] * (w0 * bf_lo(p.x) + w1 * bf_lo(q.x)); X.v[j][1] += gg[1] * (w0 * bf_hi(p.x) + w1 * bf_hi(q.x));
            X.v[j][2] += gg[2] * (w0 * bf_lo(p.y) + w1 * bf_lo(q.y)); X.v[j][3] += gg[3] * (w0 * bf_hi(p.y) + w1 * bf_hi(q.y)); } }
    if (KIND == 1) {
#pragma unroll
        for (int j = 0; j < 4; ++j) *((f32x4*)(a.out + (size_t)row * 1024) + lane + 64 * j) = X.v[j]; }
    float ss = 0.f;
#pragma unroll
    for (int j = 0; j < 4; ++j) ss += (X.v[j][0] * X.v[j][0] + X.v[j][1] * X.v[j][1]) + (X.v[j][2] * X.v[j][2] + X.v[j][3] * X.v[j][3]);
    const float rstd = 1.0f / sqrtf(wave_sum(ss) * (1.0f / 1024.0f) + RMS_EPS);
    if (KIND == 2) {
#pragma unroll
        for (int j = 0; j < 4; ++j) *((f32x4*)(a.out + (size_t)row * 1024) + lane + 64 * j) = X.v[j] * rstd * V.A[j];
    } else { unsigned char* H = a.ws + WS_H;
#pragma unroll
        for (int j = 0; j < 4; ++j) { const f32x4 h = (X.v[j] * rstd * V.A[j] + V.B[j]) * 8.0f; unsigned w = (unsigned)__builtin_amdgcn_cvt_pk_fp8_f32(h[0], h[1], 0, false); w = (unsigned)__builtin_amdgcn_cvt_pk_fp8_f32(h[2], h[3], (int)w, true);
            *((unsigned*)(H + (size_t)row * 1024) + lane + 64 * j) = w; } }
}
template <int KIND> __device__ __forceinline__ void norm_rows(const Args& a, const Ctx& C, int l) {
    const int gw = C.vcu * NWAVES + C.wave, NGW = C.G * NWAVES, lane = C.lane;
    const int RPW = (T + NGW - 1) / NGW;
    const int rbeg = gw * RPW, rend = (rbeg + RPW < T) ? rbeg + RPW : T;
    if (rbeg >= T) return;
    const unsigned char* DEST = a.ws + WS_DEST; const float* MOD = (const float*)(a.ws + WS_MOD);
    RowX xa, xb; RowY ya, yb; u32x4 r0 = {}, r1 = {}, r2 = {};
    if (KIND != 0) { r0 = *(const u32x4*)(DEST + (size_t)rbeg * 16); if (rbeg + 1 < rend) r1 = *(const u32x4*)(DEST + (size_t)(rbeg + 1) * 16); }
    ld_x<KIND>(a, rbeg, lane, xa); if (KIND != 0) ld_y(a, r0, lane, ya);
    ColV V; int vb = -1;
    for (int row = rbeg; ; ) {
        const int rn = row + 1, rnn = row + 2; const bool hn = rn < rend;
        if (hn) { ld_x<KIND>(a, rn, lane, xb); if (KIND != 0) { ld_y(a, r1, lane, yb); if (rnn < rend) r2 = *(const u32x4*)(DEST + (size_t)rnn * 16); } }
        if ((row >> 12) != vb) { vb = row >> 12;
#pragma unroll
            for (int j = 0; j < 4; ++j) {
                if (KIND == 2) { V.A[j] = *((const f32x4*)a.norm_f + lane + 64 * j); V.B[j] = (f32x4){0.f, 0.f, 0.f, 0.f}; }
                else { const float* mb = MOD + (size_t)(l * 8 + vb) * 6144; const f32x4 g = *((const f32x4*)(a.norm1 + l * 1024) + lane + 64 * j), sc = *((const f32x4*)(mb + 1024) + lane + 64 * j);
                    V.A[j] = g * (sc + 1.0f); V.B[j] = *((const f32x4*)mb + lane + 64 * j); }
                if (KIND != 0) V.G2[j] = *((const f32x4*)(MOD + (size_t)((KIND == 1 ? 0 : 1) * 8 + vb) * 6144 + 5120) + lane + 64 * j); } }
        row_finish<KIND>(a, row, lane, xa, ya, r0, V);
        if (!hn) break;
        const bool hnn = rnn < rend;
        r0 = r1; r1 = r2;
        if (hnn) { ld_x<KIND>(a, rnn, lane, xa); if (KIND != 0) { ld_y(a, r1, lane, ya); if (rnn + 1 < rend) r2 = *(const u32x4*)(DEST + (size_t)(rnn + 1) * 16); } }
        if ((rn >> 12) != vb) { vb = rn >> 12;
#pragma unroll
            for (int j = 0; j < 4; ++j) {
                if (KIND == 2) { V.A[j] = *((const f32x4*)a.norm_f + lane + 64 * j); V.B[j] = (f32x4){0.f, 0.f, 0.f, 0.f}; }
                else { const float* mb = MOD + (size_t)(l * 8 + vb) * 6144; const f32x4 g = *((const f32x4*)(a.norm1 + l * 1024) + lane + 64 * j), sc = *((const f32x4*)(mb + 1024) + lane + 64 * j);
                    V.A[j] = g * (sc + 1.0f); V.B[j] = *((const f32x4*)mb + lane + 64 * j); }
                if (KIND != 0) V.G2[j] = *((const f32x4*)(MOD + (size_t)((KIND == 1 ? 0 : 1) * 8 + vb) * 6144 + 5120) + lane + 64 * j); } }
        row_finish<KIND>(a, rn, lane, xb, yb, r0, V);
        if (!hnn) break;
        r0 = r1; r1 = r2;
        row = rnn;
    }
}
__device__ __forceinline__ void norm1_phase(const Args& a, const Ctx& C, int l) { if (l == 0) norm_rows<0>(a, C, 0); else norm_rows<1>(a, C, 1); }
__device__ __forceinline__ void final_phase(const Args& a, const Ctx& C) { norm_rows<2>(a, C, 0); }
typedef float f32x4v __attribute__((ext_vector_type(4)));
__device__ __forceinline__ void norm2_router_phase(const Args& a, const Ctx& C, int l) {
    constexpr int RP = 2064;
    LAS unsigned char* HH = C.lds; LAS unsigned char* HL = C.lds + 16 * RP;
    LAS float* PART = (LAS float*)(C.lds + 2 * 16 * RP);
    LAS float* LOGI = PART + 8 * 16 * 48;
    LAS int* wcnt = (LAS int*)(C.lds + LDS_MISC + 256);
    const float* wg = a.router_wg + (size_t)l * 1024 * 4; const float* we = a.router_we + (size_t)l * 1024 * 32;
    const int lane = C.lane, wave = C.wave, fr = lane & 15, fq = lane >> 4;
    bf16x8 Wh[4][3], Wl[4][3];
#pragma unroll
    for (int ks = 0; ks < 4; ++ks)
#pragma unroll
        for (int ct = 0; ct < 3; ++ct) { const int cc = 16 * ct + fr; const int k0 = 128 * wave + 32 * ks + 8 * fq; unsigned hw[4], lw[4];
#pragma unroll
            for (int i = 0; i < 8; i += 2) { float v0 = 0.f, v1 = 0.f;
                if (cc < 4) { v0 = wg[(size_t)(k0 + i) * 4 + cc]; v1 = wg[(size_t)(k0 + i + 1) * 4 + cc]; }
                else if (cc < 36) { v0 = we[(size_t)(k0 + i) * 32 + cc - 4]; v1 = we[(size_t)(k0 + i + 1) * 32 + cc - 4]; }
                const unsigned hp = cvt_pk_bf16(v0, v1); hw[i >> 1] = hp; lw[i >> 1] = cvt_pk_bf16(v0 - bf_lo(hp), v1 - bf_hi(hp)); }
            Wh[ks][ct] = __builtin_bit_cast(bf16x8, (u32x4){hw[0], hw[1], hw[2], hw[3]}); Wl[ks][ct] = __builtin_bit_cast(bf16x8, (u32x4){lw[0], lw[1], lw[2], lw[3]}); }
    const float* MOD = (const float*)(a.ws + WS_MOD); bf16_t* H2 = (bf16_t*)(a.ws + WS_H2);
    const float* nw = a.norm2 + l * 1024; const float* bg = a.router_bg + l * 4; const float* be = a.router_be + l * 32;
    int* CNTBLK = (int*)(a.ws + WS_CNTBLK);
    for (int ch = C.vcu; ch < T / 128; ch += C.G) {
        int my_e0 = 0, my_e1 = 0; float my_w0 = 0.f, my_w1 = 0.f;
#pragma clang loop unroll(disable)
        for (int gi = 0; gi < 8; ++gi) {
            { const int row0 = ch * 128 + gi * 16 + 2 * wave; const int b = row0 >> 12;
              f32x4 v[2][4];
#pragma unroll
              for (int rr = 0; rr < 2; ++rr)
#pragma unroll
                  for (int q = 0; q < 4; ++q) v[rr][q] = *((const f32x4*)(a.out + (size_t)(row0 + rr) * 1024) + lane + 64 * q);
              const float* mb = MOD + (size_t)(l * 8 + b) * 6144 + 3072;
#pragma unroll
              for (int rr = 0; rr < 2; ++rr) { float ss = 0.f;
#pragma unroll
                  for (int q = 0; q < 4; ++q) ss += (v[rr][q][0] * v[rr][q][0] + v[rr][q][1] * v[rr][q][1]) + (v[rr][q][2] * v[rr][q][2] + v[rr][q][3] * v[rr][q][3]);
                  const float rstd = 1.0f / sqrtf(wave_sum(ss) * (1.0f / 1024.0f) + RMS_EPS);
#pragma unroll
                  for (int q = 0; q < 4; ++q) { const f32x4 g = *((const f32x4*)nw + lane + 64 * q), sh = *((const f32x4*)mb + lane + 64 * q), sc = *((const f32x4*)(mb + 1024) + lane + 64 * q);
                      const f32x4 h = v[rr][q] * rstd * g * (sc + 1.0f) + sh;
                      u32x2 hw; hw.x = cvt_pk_bf16(h[0], h[1]); hw.y = cvt_pk_bf16(h[2], h[3]);
                      u32x2 lw; lw.x = cvt_pk_bf16(h[0] - bf_lo(hw.x), h[1] - bf_hi(hw.x)); lw.y = cvt_pk_bf16(h[2] - bf_lo(hw.y), h[3] - bf_hi(hw.y));
                      { unsigned w8 = (unsigned)__builtin_amdgcn_cvt_pk_fp8_f32(h[0] * 8.0f, h[1] * 8.0f, 0, false); w8 = (unsigned)__builtin_amdgcn_cvt_pk_fp8_f32(h[2] * 8.0f, h[3] * 8.0f, (int)w8, true);
                        *((unsigned*)((unsigned char*)H2 + (size_t)(row0 + rr) * 1024) + lane + 64 * q) = w8; }
                      *(LAS u32x2*)(HH + (2 * wave + rr) * RP + (4 * lane + 256 * q) * 2) = hw; *(LAS u32x2*)(HL + (2 * wave + rr) * RP + (4 * lane + 256 * q) * 2) = lw; } }
            }
            __syncthreads();
            { f32x4v acc[3]; acc[0] = (f32x4v){0.f, 0.f, 0.f, 0.f}; acc[1] = acc[0]; acc[2] = acc[0];
#pragma unroll
              for (int ks = 0; ks < 4; ++ks) { const int ko = (128 * wave + 32 * ks + 8 * fq) * 2;
                  const bf16x8 ah = *(const LAS bf16x8*)(HH + fr * RP + ko), al = *(const LAS bf16x8*)(HL + fr * RP + ko);
#pragma unroll
                  for (int ct = 0; ct < 3; ++ct) { acc[ct] = __builtin_amdgcn_mfma_f32_16x16x32_bf16(Wh[ks][ct], ah, acc[ct], 0, 0, 0);
                      acc[ct] = __builtin_amdgcn_mfma_f32_16x16x32_bf16(Wh[ks][ct], al, acc[ct], 0, 0, 0); acc[ct] = __builtin_amdgcn_mfma_f32_16x16x32_bf16(Wl[ks][ct], ah, acc[ct], 0, 0, 0); } }
#pragma unroll
              for (int ct = 0; ct < 3; ++ct) *(LAS f32x4v*)(PART + (wave * 16 + fr) * 48 + 16 * ct + 4 * fq) = acc[ct]; }
            __syncthreads();
            { const int row = C.tid >> 5, c = C.tid & 31;
              { float sacc = 0.f;
#pragma unroll
                for (int w = 0; w < 8; ++w) sacc += PART[(w * 16 + row) * 48 + c];
                LOGI[row * 48 + c] = sacc + (c < 4 ? bg[c] : be[c - 4]); }
              if (c < 4) { float sacc = 0.f;
#pragma unroll
                for (int w = 0; w < 8; ++w) sacc += PART[(w * 16 + row) * 48 + 32 + c];
                LOGI[row * 48 + 32 + c] = sacc + be[28 + c]; } }
            __syncthreads();
            if (wave == gi && lane < 16) { const LAS float* lg = LOGI + lane * 48;
                int grp = 0; float gmax = lg[0];
#pragma unroll
                for (int c = 1; c < 4; ++c) if (lg[c] > gmax) { gmax = lg[c]; grp = c; }
                float gs = 0.f;
#pragma unroll
                for (int c = 0; c < 4; ++c) gs += __builtin_amdgcn_exp2f((lg[c] - gmax) * LOG2E);
                const float pgrp = 1.0f / gs;
                float le[8];
#pragma unroll
                for (int e = 0; e < 8; ++e) le[e] = lg[4 + grp * 8 + e];
                int i0 = 0; float v0 = le[0];
#pragma unroll
                for (int e = 1; e < 8; ++e) if (le[e] > v0) { v0 = le[e]; i0 = e; }
                int i1 = -1; float v1 = -INFINITY;
#pragma unroll
                for (int e = 0; e < 8; ++e) if (e != i0 && le[e] > v1) { v1 = le[e]; i1 = e; }
                const float ex = __builtin_amdgcn_exp2f((v1 - v0) * LOG2E);
                my_e0 = grp * 8 + i0; my_e1 = grp * 8 + i1; my_w0 = pgrp / (1.0f + ex); my_w1 = pgrp * ex / (1.0f + ex); }
        }
        const int ea = bperm_i(C.lane >> 1, my_e0), eb = bperm_i(C.lane >> 1, my_e1);
        const int es = (C.lane < 32) ? ((C.lane & 1) ? eb : ea) : -1;
        int rank = 0, cnt = 0;
#pragma unroll
        for (int s2 = 0; s2 < 32; ++s2) { const int v = __builtin_amdgcn_readlane(es, s2); rank += (v == es && s2 < C.lane) ? 1 : 0; cnt += (v == C.lane) ? 1 : 0; }
        __syncthreads();
        if (C.lane < 32) wcnt[C.wave * 32 + C.lane] = cnt;
        __syncthreads();
        int lrank = rank;
        if (C.lane < 32) { for (int w = 0; w < C.wave; ++w) lrank += wcnt[w * 32 + es]; }
        if (C.wave == 0 && C.lane < 32) { int tot = 0;
#pragma unroll
            for (int w = 0; w < 8; ++w) tot += wcnt[w * 32 + C.lane];
            CNTBLK[ch * 32 + C.lane] = tot; }
        const int lr0 = bperm_i((2 * C.lane) & 63, lrank), lr1 = bperm_i((2 * C.lane + 1) & 63, lrank);
        if (C.lane < 16) { const int row = ch * 128 + C.wave * 16 + C.lane;
            u32x4 rec; rec.x = (unsigned)my_e0 | ((unsigned)my_e1 << 8); rec.y = (unsigned)lr0 | ((unsigned)lr1 << 16); rec.z = __float_as_uint(my_w0); rec.w = __float_as_uint(my_w1);
            *(u32x4*)(a.ws + WS_REC + (size_t)row * 16) = rec; }
    }
}
__device__ __forceinline__ void moe_scatter_phase(const Args& a, const Ctx& C) {
    LAS int* part_lt = (LAS int*)(C.lds);
    LAS int* part_all = part_lt + 512;
    LAS int* base = part_all + 512;
    LAS int* tot = base + 32;
    LAS int* pst = tot + 32;
    const int* CNTBLK = (const int*)(a.ws + WS_CNTBLK);
    int* TILEE = (int*)(a.ws + WS_TILEE);
    int* TOKL = (int*)(a.ws + WS_TOKL);
    for (int ch = C.vcu; ch < T / 128; ch += C.G) {
        __syncthreads();
        { const int e = C.tid & 31, p = C.tid >> 5; int slt = 0, sall = 0;
            for (int c = p; c < T / 128; c += 16) { const int v = CNTBLK[c * 32 + e]; sall += v; slt += (c < ch) ? v : 0; }
            part_lt[p * 32 + e] = slt; part_all[p * 32 + e] = sall; }
        __syncthreads();
        if (C.tid < 32) { int b = 0, t2 = 0;
#pragma unroll
            for (int p = 0; p < 16; ++p) { b += part_lt[p * 32 + C.tid]; t2 += part_all[p * 32 + C.tid]; }
            base[C.tid] = b; tot[C.tid] = t2; }
        __syncthreads();
        if (C.tid < 32) { int ps = 0; for (int e = 0; e < C.tid; ++e) ps += (tot[e] + 255) & ~255; pst[C.tid] = ps;
            if (ch == 0) { const int nt = (tot[C.tid] + 255) >> 8; const int t0 = ps >> 8; for (int m = 0; m < nt; ++m) TILEE[16 + t0 + m] = C.tid; if (C.tid == 31) TILEE[0] = t0 + nt; } }
        __syncthreads();
        int d0 = 0, d1 = 0;
        if (C.lane < 16) { const int row = ch * 128 + C.wave * 16 + C.lane;
            const u32x4 rec = *(const u32x4*)(a.ws + WS_REC + (size_t)row * 16);
            const int e0 = rec.x & 255, e1 = (rec.x >> 8) & 255;
            d0 = pst[e0] + base[e0] + (int)(rec.y & 0xffffu); d1 = pst[e1] + base[e1] + (int)(rec.y >> 16);
            u32x4 o; o.x = (unsigned)d0; o.y = (unsigned)d1; o.z = rec.z; o.w = rec.w;
            *(u32x4*)(a.ws + WS_DEST + (size_t)row * 16) = o; }
        if (C.lane < 16) { const int row = ch * 128 + C.wave * 16 + C.lane; TOKL[d0] = row; TOKL[d1] = row; }
        if (ch == 0) {
            for (int e = 0; e < 32; ++e) { const int lo = pst[e] + tot[e], hi = pst[e] + ((tot[e] + 255) & ~255);
                for (int k = lo + C.tid; k < hi; k += NTHR) TOKL[k] = 0; } }
    }
}
struct MoeOrder {
    int G, c, nu; int ex[8]; const char* A; const char* B; size_t tA, tB, eB;
    __device__ __forceinline__ bool next(int i, pg8::Unit& u) const {
        const int L = i * G + c; if (i >= 8 || L >= nu) return false;
        const int e = i == 0 ? ex[0] : i == 1 ? ex[1] : i == 2 ? ex[2] : i == 3 ? ex[3] : i == 4 ? ex[4] : i == 5 ? ex[5] : i == 6 ? ex[6] : ex[7];
        u.pm = L >> 2; u.pn = L & 3; u.A = A + (size_t)u.pm * tA; u.B = B + (size_t)e * eB + (size_t)u.pn * tB; return true;
    }
};

__device__ __forceinline__ void dil_unit(const Args& a, const Ctx& C, int du) {
    using namespace att;
    LAS unsigned char* lds = C.lds;
    const int x = du & 15; int r = du >> 4; const int h = r & 3; r >>= 2; const int grp = r % 3, b = r / 3;
    const int dsh = 2 * grp, d = 1 << dsh; const int nub = 16 >> dsh; const int res = x / nub, ub = x % nub;
    const int wid = C.wave, lane = C.lane, r32 = lane & 31, hi = lane >> 5;
    LAS float* lut = (LAS float*)(lds + L_LUT);
    LAS unsigned char* tl = lds + L_SEL + 768;
    __syncthreads();
    for (int e = C.tid; e < 704; e += NTHR) { const int m = 384 - e; float v = -INFINITY;
        if (m >= 0 && m <= 128) { int di = m << dsh; di = di > 4095 ? 4095 : di; v = a.rel_bias[(int)lds[L_BKT + di] * 20 + 8 + grp * 4 + h] * LOG2E; }
        lut[e] = v; }
    if (C.tid < 6) { const int kt = 4 * ub - 2 + C.tid; tl[C.tid] = (unsigned char)(kt < 0 ? 0x80 : kt); }
    const bf16_t* QKV = (const bf16_t*)(a.ws + WS_A);
    const int u = 256 * ub + 32 * wid + r32; const size_t tokq = (size_t)b * SEQ + (size_t)u * d + res;
    const bf16_t* qp = QKV + tokq * LDQ + 1280 + grp * 256 + h * 64;
    bf16x8 qr[4];
#pragma unroll
    for (int d0 = 0; d0 < 4; ++d0) qr[d0] = *(const bf16x8*)(qp + d0 * 16 + hi * 8);
    __syncthreads();
    StreamP S; S.Kb = QKV + ((size_t)b * SEQ + res) * LDQ + 1280 + 768 + grp * 256 + h * 64; S.Vb = S.Kb + 768; S.pitch = (long)d * LDQ;
    S.NT = 6; S.tl = tl; S.lanesel = ~0ull; S.uq = u; S.lut = lut; S.xtop = 384; S.dclamp = 1 << 30;
    float m = 0.f, l = 0.f; f32x16 o[2];
    attn_stream<8>(lds, wid, lane, qr, S, m, l, o);
    l = xhalf_sum(l);
    LAS float* wsf = (LAS float*)(lds + L_WSF) + wid * 64;
    if (hi == 0) { wsf[r32] = l > 0.f ? 1.0f / l : 0.f; ((float*)(a.ws + WS_LSE))[((size_t)grp * T + tokq) * 4 + h] = m + __builtin_amdgcn_logf(l); }
    LDS_WAIT();
#pragma unroll
    for (int rr = 0; rr < 16; ++rr) { const float f = wsf[crow(rr, hi)]; o[0][rr] *= f; o[1][rr] *= f; }
    stage_rows(lds, wid, lane, o);
    bf16_t* ODP = (bf16_t*)(a.ws + WS_ODP) + (size_t)grp * T * 256;
    const LAS bf16_t* stg = (const LAS bf16_t*)(lds + L_OTA) + wid * 2048;
#pragma unroll
    for (int i = 0; i < 4; ++i) { const int row = i * 8 + (lane >> 3), chn = lane & 7; const u32x4 v = *(const LAS u32x4*)(stg + row * 64 + chn * 8);
        const size_t tok = (size_t)b * SEQ + (size_t)(256 * ub + 32 * wid + row) * d + res;
        *(u32x4*)(ODP + tok * 256 + h * 64 + chn * 8) = v; }
}
__device__ __forceinline__ void dil_combine(const Args& a, const Ctx& C) {
    const float* LSE = (const float*)(a.ws + WS_LSE); const bf16_t* ODP = (const bf16_t*)(a.ws + WS_ODP); bf16_t* ODIL = (bf16_t*)(a.ws + WS_ODIL);
    const int gt = C.vcu * NTHR + C.tid, NT = C.G * NTHR;
    for (int idx = gt; idx < T * 32; idx += NT) {
        const int tok = idx >> 5, h = (idx >> 3) & 3, chn = idx & 7;
        const float l0 = LSE[((size_t)0 * T + tok) * 4 + h], l1 = LSE[((size_t)1 * T + tok) * 4 + h], l2 = LSE[((size_t)2 * T + tok) * 4 + h];
        const float mx = __builtin_fmaxf(l0, __builtin_fmaxf(l1, l2));
        float w0 = __builtin_amdgcn_exp2f(l0 - mx), w1 = __builtin_amdgcn_exp2f(l1 - mx), w2 = __builtin_amdgcn_exp2f(l2 - mx);
        const float inv = 1.0f / (w0 + w1 + w2); w0 *= inv; w1 *= inv; w2 *= inv;
        const size_t off = (size_t)tok * 256 + h * 64 + chn * 8;
        const u32x4 a0 = *(const u32x4*)(ODP + off), a1 = *(const u32x4*)(ODP + (size_t)T * 256 + off), a2 = *(const u32x4*)(ODP + (size_t)2 * T * 256 + off);
        u32x4 o;
        o.x = cvt_pk_bf16(w0 * bf_lo(a0.x) + w1 * bf_lo(a1.x) + w2 * bf_lo(a2.x), w0 * bf_hi(a0.x) + w1 * bf_hi(a1.x) + w2 * bf_hi(a2.x));
        o.y = cvt_pk_bf16(w0 * bf_lo(a0.y) + w1 * bf_lo(a1.y) + w2 * bf_lo(a2.y), w0 * bf_hi(a0.y) + w1 * bf_hi(a1.y) + w2 * bf_hi(a2.y));
        o.z = cvt_pk_bf16(w0 * bf_lo(a0.z) + w1 * bf_lo(a1.z) + w2 * bf_lo(a2.z), w0 * bf_hi(a0.z) + w1 * bf_hi(a1.z) + w2 * bf_hi(a2.z));
        o.w = cvt_pk_bf16(w0 * bf_lo(a0.w) + w1 * bf_lo(a1.w) + w2 * bf_lo(a2.w), w0 * bf_hi(a0.w) + w1 * bf_hi(a1.w) + w2 * bf_hi(a2.w));
        if (ABL == 4) o = (u32x4){0u, 0u, 0u, 0u};
        *(u32x4*)(ODIL + off) = o;
    }
}
template <bool INIT>
__device__ __forceinline__ void ota_update(LAS bf16_t* ota  , const LAS float* frow, int hi, const f32x16 (&o)[2]) {
#pragma unroll
    for (int r = 0; r < 16; ++r) { const int row = crow(r, hi); const float f = frow[row];
        float v0 = f * o[0][r], v1 = f * o[1][r];
        if (!INIT) { v0 += __uint_as_float((unsigned)ota[row * 64] << 16); v1 += __uint_as_float((unsigned)ota[row * 64 + 32] << 16); }
        ota[row * 64] = (bf16_t)(cvt_pk_bf16(v0, 0.f) & 0xffffu); ota[row * 64 + 32] = (bf16_t)(cvt_pk_bf16(v1, 0.f) & 0xffffu); }
}
#define NSA_T0(which) do { if (TNSA == (which) && blockIdx.x == 0 && wid == 0 && lane_id_fresh() == 0) { volatile LAS unsigned* M_ = (volatile LAS unsigned*)(lds + LDS_MISC); const unsigned long long t_ = __builtin_amdgcn_s_memrealtime(); M_[20] = (unsigned)t_; M_[21] = (unsigned)(t_ >> 32); } } while (0)
#define NSA_T1(which) do { if (TNSA == (which) && blockIdx.x == 0 && wid == 0 && lane_id_fresh() == 0) { volatile LAS unsigned* M_ = (volatile LAS unsigned*)(lds + LDS_MISC); const unsigned long long t_ = __builtin_amdgcn_s_memrealtime(); const unsigned long long t0_ = ((unsigned long long)M_[21] << 32) | M_[20]; \
        const unsigned long long d_ = (((unsigned long long)M_[23] << 32) | M_[22]) + (t_ - t0_); M_[22] = (unsigned)d_; M_[23] = (unsigned)(d_ >> 32); } } while (0)
#define NSA_SECT() const int lane = lane_id_fresh(); const int tid = wid * 64 + lane; const int r32 = lane & 31, hi = lane >> 5; (void)tid; (void)r32; (void)hi
__device__ __forceinline__ void nsa_unit(const Args& a, const Ctx& C, int b, int hk, int i) {
    using namespace att;
    LAS unsigned char* lds = C.lds;
    const int wid = C.wave; const int g = wid >> 1;
    const bf16_t* QKV = (const bf16_t*)(a.ws + WS_A);
    bf16x8 qr[4];
    f32x16 o[2];
    __syncthreads();
    NSA_T0(2);
    { NSA_SECT();
        const int tq = (wid & 1) * 32 + r32, t = 64 * i + tq; const size_t tok = (size_t)b * SEQ + t;
        LAS float* imp = (LAS float*)(lds + L_IMP); LAS float* gsh = (LAS float*)(lds + L_GSH) + wid * 96; LAS unsigned* selw = (LAS unsigned*)(lds + L_SEL);
        const bf16_t* KC = (const bf16_t*)(a.ws + WS_KC); const int nt = (4 * i + 2) / 64 + 1;
        cmp_issue(lds, wid, lane, KC + (size_t)((0 * 8 + b) * 2 + hk) * 256 * 64, KC + (size_t)((1 * 8 + b) * 2 + hk) * 256 * 64, nt);
        const bf16_t* qp = QKV + tok * LDQ + hk * 256 + g * 64;
#pragma unroll
        for (int d0 = 0; d0 < 4; ++d0) qr[d0] = *(const bf16x8*)(qp + d0 * 16 + hi * 8);
        float g0 = 0.f, g1 = 0.f, g2 = 0.f;
        if (hi == 0) { const float* gn = (const float*)(a.ws + WS_GN) + tok * 32 + hk * 4 + g; g0 = gn[0]; g1 = gn[8]; g2 = gn[16]; }
        for (int e = tid; e < 64 * 64; e += NTHR) imp[e] = 0.f;
        if (tid < 2) selw[128 + tid] = 0u;
        if (hi == 0) { gsh[r32] = (ABL == 1) ? 0.f : g0; gsh[32 + r32] = (ABL == 2) ? 0.f : g1; gsh[64 + r32] = (ABL == 3) ? 0.f : g2; }
        cmp_branch(lds, wid, lane, qr, nt, t, o);
        ota_update<true>((LAS bf16_t*)(lds + L_OTA) + wid * 2048 + r32, gsh, hi, o);
    }
    __syncthreads();
    NSA_T1(2);
    { NSA_SECT();
        LAS float* impP = (LAS float*)(lds + L_IMP); LAS unsigned* selw = (LAS unsigned*)(lds + L_SEL);
        const int q = tid >> 3, part = tid & 7;
        const int ncand = i - 2 > 0 ? i - 2 : 0; const int nforced = i + 1 < 3 ? i + 1 : 3; const int krem = 16 - nforced;
        unsigned bits = 0u;
        if (ncand > krem && ABL != 5) {
            float vn[8]; int cn[8];
#pragma unroll
            for (int e = 0; e < 8; ++e) { vn[e] = impP[q * 64 + part * 8 + e]; cn[e] = 0; }
#pragma unroll 4
            for (int mm = 1; mm <= i - 2; ++mm) { const float xv = impP[q * 64 + mm];
#pragma unroll
                for (int e = 0; e < 8; ++e) { const int n = part * 8 + e; cn[e] += (xv > vn[e] || (xv == vn[e] && mm < n)) ? 1 : 0; } }
#pragma unroll
            for (int e = 0; e < 8; ++e) { const int n = part * 8 + e; if (n >= 1 && n <= i - 2 && cn[e] < krem) bits |= 1u << e; }
        } else {
#pragma unroll
            for (int e = 0; e < 8; ++e) { const int n = part * 8 + e; if (n >= 1 && n <= i - 2) bits |= 1u << e; }
        }
#pragma unroll
        for (int e = 0; e < 8; ++e) { const int n = part * 8 + e; if (n == 0 || n == i || n == i - 1) bits |= 1u << e; }
        unsigned lo = part < 4 ? bits << (8 * part) : 0u, hi2 = part >= 4 ? bits << (8 * (part - 4)) : 0u;
        lo |= swz_xor_u<1>(lo); hi2 |= swz_xor_u<1>(hi2); lo |= swz_xor_u<2>(lo); hi2 |= swz_xor_u<2>(hi2); lo |= swz_xor_u<4>(lo); hi2 |= swz_xor_u<4>(hi2);
        if (part == 0) { selw[2 * q] = lo; selw[2 * q + 1] = hi2; atomicOr((unsigned*)&selw[128], lo); atomicOr((unsigned*)&selw[129], hi2); }
    }
    __syncthreads();
    int NTS, NTW;
    { NSA_SECT();
        LAS unsigned* selw = (LAS unsigned*)(lds + L_SEL);
        LAS unsigned char* tls = lds + L_SEL + 768; LAS unsigned char* tlw = lds + L_SEL + 848;
        const unsigned long long uni = ((unsigned long long)(unsigned)__builtin_amdgcn_readfirstlane((int)selw[129]) << 32) | (unsigned)__builtin_amdgcn_readfirstlane((int)selw[128]);
        const int nsel = __builtin_popcountll(uni); const int nts = (nsel + 1) & ~1; NTS = nts < 4 ? 4 : nts;
        const int jlo = i - 8 < 0 ? 0 : i - 8; const int nwin = i - jlo + 1; const int ntw = (nwin + 1) & ~1; NTW = ntw < 4 ? 4 : ntw;
        if (tid < 64) { if ((uni >> tid) & 1ull) tls[__builtin_popcountll(uni & ((1ull << tid) - 1ull))] = (unsigned char)tid; }
        else if (tid < 72) { const int k = nsel + (tid - 64); if (k < NTS) tls[k] = 0x80; }
        else if (tid < 88) { const int k = tid - 72; if (k < NTW) tlw[k] = (unsigned char)(k < nwin ? jlo + k : 0x80); }
    }
    __syncthreads();
    NSA_T0(1);
#pragma clang loop unroll(disable)
    for (int br = 0; br < 2; ++br) {
        float m = 0.f, l = 0.f;
        { NSA_SECT();
            const int tq = (wid & 1) * 32 + r32, t = 64 * i + tq;
            LAS unsigned* selw = (LAS unsigned*)(lds + L_SEL); LAS float* lut = (LAS float*)(lds + L_LUT);
            StreamP S; S.Kb = QKV + (size_t)b * SEQ * LDQ + 512 + 256 + br * 256 + hk * 64; S.Vb = S.Kb + 128; S.pitch = LDQ;
            S.NT = br ? NTW : NTS; S.tl = lds + L_SEL + (br ? 848 : 768); S.uq = t;
            S.lanesel = br ? ~0ull : (((unsigned long long)selw[2 * tq + 1] << 32) | selw[2 * tq]);
            S.lut = br ? lut + 7168 + g * 768 : lut + g * 1792; S.xtop = br ? 640 : 1636; S.dclamp = br ? (1 << 30) : 1636;
            attn_stream<8>(lds, wid, lane, qr, S, m, l, o);
        }
        { NSA_SECT();
            LAS float* gsh = (LAS float*)(lds + L_GSH) + wid * 96; LAS float* wsf = (LAS float*)(lds + L_WSF) + wid * 64;
            l = xhalf_sum(l);
            LDS_WAIT();
            if (hi == 0) wsf[r32] = (l > 0.f ? 1.0f / l : 0.f) * gsh[32 + br * 32 + r32];
            LDS_WAIT();
            ota_update<false>((LAS bf16_t*)(lds + L_OTA) + wid * 2048 + r32, wsf, hi, o);
        }
    }
    NSA_T1(1);
    { NSA_SECT();
        LDS_WAIT();
        bf16_t* ONSA = (bf16_t*)(a.ws + WS_ONSA);
        const LAS bf16_t* stg = (const LAS bf16_t*)(lds + L_OTA) + wid * 2048;
#pragma unroll
        for (int k = 0; k < 4; ++k) { const int row = k * 8 + (lane >> 3), chn = lane & 7; const u32x4 v = *(const LAS u32x4*)(stg + row * 64 + chn * 8);
            const size_t tk = (size_t)b * SEQ + 64 * i + (wid & 1) * 32 + row;
            *(u32x4*)(ONSA + tk * 512 + hk * 256 + g * 64 + chn * 8) = v; }
    }
}
__device__ __forceinline__ void build_bkt(const Ctx& C) {
    LAS unsigned char* bkt = C.lds + att::L_BKT; LAS unsigned char* bkc = C.lds + att::L_BKC;
    for (int d = C.tid; d < 4096; d += NTHR) bkt[d] = (unsigned char)att::bucket_of(d);
    for (int x = C.tid; x < 8704; x += NTHR) { const int dist = 4095 - x; bkc[x] = (unsigned char)(dist < 0 ? 128 : 4 * att::bucket_of(dist)); }
    __syncthreads();
}
__device__ __forceinline__ void build_nsa_tables(const Args& a, const Ctx& C, int hk) {
    using namespace att;
    LAS float* tbh = (LAS float*)(C.lds + L_TBH); LAS float* lut = (LAS float*)(C.lds + L_LUT);
    __syncthreads();
    if (C.tid < 144) { const int gg = C.tid / 36, bk = C.tid % 36; tbh[C.tid] = bk < 32 ? a.rel_bias[bk * 20 + hk * 4 + gg] * LOG2E : -INFINITY; }
    __syncthreads();
    for (int e = C.tid; e < 4 * 1792; e += NTHR) { const int gg = e / 1792, xx = e % 1792; const int dist = 1636 - xx;
        lut[e] = dist < 0 ? -INFINITY : tbh[gg * 36 + (int)C.lds[L_BKT + dist]]; }
    for (int e = C.tid; e < 4 * 768; e += NTHR) { const int gg = e / 768, xx = e % 768; const int dist = 640 - xx;
        lut[7168 + e] = (dist < 0 || dist > 512) ? -INFINITY : tbh[gg * 36 + (int)C.lds[L_BKT + dist]]; }
    __syncthreads();
}

typedef const Args __attribute__((address_space(4)))* CArgsP;
__device__ __forceinline__ Args load_args() {
#if defined(__HIP_DEVICE_COMPILE__)
    CArgsP p = (CArgsP)__builtin_amdgcn_kernarg_segment_ptr(); asm volatile("" : "+s"(p)); Args a;
    a.x = p->x; a.c = p->c; a.rel_bias = p->rel_bias; a.ada_w = p->ada_w; a.ada_b = p->ada_b; a.norm1 = p->norm1; a.norm2 = p->norm2; a.w_in = p->w_in;
    a.cmp_pos = p->cmp_pos; a.cmp_w1 = p->cmp_w1; a.cmp_w2 = p->cmp_w2; a.w_up_nsa = p->w_up_nsa; a.w_up_dil = p->w_up_dil; a.w_o = p->w_o;
    a.router_wg = p->router_wg; a.router_bg = p->router_bg; a.router_we = p->router_we; a.router_be = p->router_be; a.exp_w1 = p->exp_w1; a.exp_w3 = p->exp_w3; a.exp_w2 = p->exp_w2; a.norm_f = p->norm_f;
    a.out = p->out; a.ws = p->ws; a.ph_lo = p->ph_lo; a.ph_hi = p->ph_hi; a.use_bar = p->use_bar; a.pad = 0;
    return a;
#else
    return Args{};
#endif
}
#define LOADA() const Args a = load_args()
__global__ void __launch_bounds__(NTHR, 2) fwd_kernel(Args a_) {
    extern __shared__ __attribute__((aligned(16))) unsigned char lds_raw[];
    LAS unsigned char* const lds_base = (LAS unsigned char*)lds_raw;
    const int wave0_ = __builtin_amdgcn_readfirstlane((int)threadIdx.x >> 6);
#define FRESH() Ctx C; { int w_ = wave0_; asm volatile("" : "+s"(w_)); int t_ = lane_id_fresh(); asm volatile("" : "+v"(t_)); t_ += w_ * 64; int g_ = gridDim.x, b_ = blockIdx.x; asm volatile("" : "+s"(g_), "+s"(b_)); \
        C.lds = lds_base; C.tid = t_; C.lane = t_ & 63; C.wave = w_; C.G = g_; C.bx = b_; C.vcu = (g_ % 8 == 0) ? (b_ % 8) * (g_ / 8) + b_ / 8 : b_; }
    volatile LAS unsigned* MISC = (volatile LAS unsigned*)(lds_base + LDS_MISC);
    if (threadIdx.x < 64) MISC[threadIdx.x] = 0u;
    __syncthreads();
    unsigned* ctl = (unsigned*)(a_.ws + WS_CTL);
    XcdBarrier bar; bar.bar = ctl + CW_BAR; bar.x = 0; bar.st = nullptr;
    if (a_.use_bar) bar = xcd_barrier_post(ctl + CW_BAR, MISC + 8);
    const int lo = a_.ph_lo, hi = a_.ph_hi;
#ifndef PH_MASK
#define PH_MASK 0xFFFFFFFFu
#endif
#define IN(k) (((PH_MASK >> ((k) == 0 ? 10 : (k) == 21 ? 11 : (((k) - 1) % 10))) & 1u) && lo <= (k) && (k) < hi)
#define TIMED(k) ((TMASK >> (k)) & 1u)
#define TBEG(k) do { if (TMASK != 0u && TIMED(k) && blockIdx.x == 0 && wave0_ == 0 && lane_id_fresh() == 0) { const unsigned long long t_ = __builtin_amdgcn_s_memrealtime(); MISC[20] = (unsigned)t_; MISC[21] = (unsigned)(t_ >> 32); } } while (0)
#define TEND(k) do { if (TMASK != 0u && TIMED(k) && blockIdx.x == 0 && wave0_ == 0 && lane_id_fresh() == 0) { const unsigned long long t_ = __builtin_amdgcn_s_memrealtime(); const unsigned long long t0_ = ((unsigned long long)MISC[21] << 32) | MISC[20]; \
        const unsigned long long d_ = (((unsigned long long)MISC[23] << 32) | MISC[22]) + (t_ - t0_); MISC[22] = (unsigned)d_; MISC[23] = (unsigned)(d_ >> 32); } } while (0)
#define SEAM(k) do { if (IN(k) && IN((k) + 1)) { XcdBarrier b2_ = bar; asm volatile("" : "+s"(b2_.bar)); int w2_ = wave0_; asm volatile("" : "+s"(w2_)); xcd_barrier(b2_, w2_ == 0 && lane_id_fresh() == 0); } } while (0)
    TBEG(0);
    if (IN(0)) REPEAT(10) { __syncthreads(); FRESH(); LOADA(); prologue_vectors(a, C); conv_small(a, C); }
    SEAM(0); TEND(0);
    _Pragma("unroll") for (int l = 0; l < 2; ++l) {
        const int pb = 1 + 10 * l;
        TBEG(pb + 0);
        if (IN(pb + 0)) REPEAT(0) { FRESH(); LOADA(); norm1_phase(a, C, l); }
        SEAM(pb + 0); TEND(pb + 0);
        TBEG(pb + 1);
        if (IN(pb + 1)) REPEAT(1) { FRESH(); LOADA(); unsigned char* ws = a.ws;
            pg8::Gemm g{1024u, 1024u, 128u, 1024, 0u, 0u, 0, nullptr, nullptr, 0x77777777, 0x7c7c7c7c};
            pg8::DenseOrder S; S.init(T, NIN, C.G, C.bx, ws + WS_H, 1024u, ws + WS_WINT + (size_t)l * NIN * DM, 1024u);
            EpiInProj E{(bf16_t*)(ws + WS_A), (unsigned char*)(ws + WS_MG), (float*)(ws + WS_GN), 1.0f / 2048.0f};
            pg8::gemm_phase<EpiInProj, pg8::DenseOrder, true, false, false, true>(C.lds, C.tid, g, S, E);
        }
        SEAM(pb + 1); TEND(pb + 1);
        TBEG(pb + 2);
        if (IN(pb + 2)) REPEAT(2) { FRESH(); LOADA(); unsigned char* ws = a.ws;
            struct CmpOrder { int c; const char* A; const char* B;
                __device__ __forceinline__ bool next(int i, pg8::Unit& u) const { if (i > 0 || c >= 32) return false; const int kv = c >> 4, b = (c >> 1) & 7, hk = c & 1;
                    u.pm = c; u.pn = 0; u.A = A + ((size_t)b * SEQ * LDQ + 512 + kv * 128 + hk * 64) * 2; u.B = B + (size_t)kv * 256 * 2048 * 2; return true; } };
            pg8::Gemm g{(unsigned)(16 * LDQ * 2), 4096u, (unsigned)(LDQ * 2), 2048};
            CmpOrder S{C.vcu, (const char*)(ws + WS_A), (const char*)(ws + WS_CW1T + (size_t)l * 2 * 256 * 2048 * 2)};
            EpiCmp E{(bf16_t*)(ws + WS_HID), (const float*)(ws + WS_CB1) + l * 512, (const bf16_t*)(ws + WS_CW2T) + (size_t)l * 2 * 64 * 256, (bf16_t*)(ws + WS_KC)};
            pg8::gemm_phase<EpiCmp, CmpOrder, false>(C.lds, C.tid, g, S, E);
            __syncthreads();
            build_bkt(C);
            for (;;) { __syncthreads();
                if (C.tid == 0) *(volatile LAS int*)(C.lds + LDS_MISC + 512) = (int)__hip_atomic_fetch_add((unsigned*)(ws + WS_CTL) + CW_Q + l, 1u, __ATOMIC_RELAXED, __HIP_MEMORY_SCOPE_AGENT);
                __syncthreads();
                const int du = __builtin_amdgcn_readfirstlane(*(volatile LAS int*)(C.lds + LDS_MISC + 512));
                if (du >= 1536) break;
                dil_unit(a, C, du); }
        }
        SEAM(pb + 2); TEND(pb + 2);
        TBEG(pb + 3);
        if (IN(pb + 3)) REPEAT(3) { FRESH(); LOADA();
            dil_combine(a, C);
            build_bkt(C);
            int cur_hk = -1;
            for (int v = C.vcu; v < 256; v += C.G) { const int b = v >> 5, hk = (v >> 4) & 1, s = v & 15;
                if (hk != cur_hk) { build_nsa_tables(a, C, hk); cur_hk = hk; }
                for (int k = 0; k < 4; ++k) { const int qi = (k == 0) ? s : (k == 1) ? 31 - s : (k == 2) ? 32 + s : 63 - s; nsa_unit(a, C, b, hk, qi);
                    __syncthreads(); if (v < C.G) conv_experts_slice(a, C, l, k); } }
            if (C.vcu >= 256) { for (int q = 0; q < 4; ++q) conv_experts_slice(a, C, l, q); }
            __syncthreads();
        }
        SEAM(pb + 3); TEND(pb + 3);
        TBEG(pb + 4);
        if (IN(pb + 4)) REPEAT(4) { FRESH(); LOADA(); unsigned char* ws = a.ws;
            pg8::Gemm g{1024u, 1024u, 128u, 512, 512u, 512u, 256}; pg8::DenseOrder S; S.init(T, 1024, C.G, C.bx, ws + WS_ONSA, 1024u, ws + WS_WUNT + (size_t)l * 1024 * 512 * 2, 1024u);
            S.A2 = (const char*)(ws + WS_ODIL); S.B2 = (const char*)(ws + WS_WUDT + (size_t)l * 1024 * 256 * 2); S.tA2 = (size_t)256 * 512; S.tB2 = (size_t)256 * 512;
            EpiUpFused E{(bf16_t*)(ws + WS_MERGED), (const unsigned char*)(ws + WS_MG)};
            pg8::gemm_phase<EpiUpFused, pg8::DenseOrder, true, true>(C.lds, C.tid, g, S, E);
        }
        SEAM(pb + 4); TEND(pb + 4);
        TBEG(pb + 5);
        if (IN(pb + 5)) REPEAT(5) { FRESH(); LOADA(); unsigned char* ws = a.ws;
            pg8::Gemm g{2048u, 2048u, 128u, 1024}; pg8::DenseOrder S; S.init(T, 1024, C.G, C.bx, ws + WS_MERGED, 2048u, ws + WS_WOT + (size_t)l * 1024 * 1024 * 2, 2048u);
            EpiOut E{l == 0 ? a.x : (const float*)a.out, a.out, (const float*)(ws + WS_MOD) + (size_t)l * 8 * 6144 + 2048};
            pg8::gemm_phase<EpiOut, pg8::DenseOrder, true>(C.lds, C.tid, g, S, E);
        }
        SEAM(pb + 5); TEND(pb + 5);
        TBEG(pb + 6);
        if (IN(pb + 6)) REPEAT(6) { FRESH(); LOADA(); norm2_router_phase(a, C, l); }
        SEAM(pb + 6); TEND(pb + 6);
        TBEG(pb + 7);
        if (IN(pb + 7)) REPEAT(7) { FRESH(); LOADA(); moe_scatter_phase(a, C); }
        SEAM(pb + 7); TEND(pb + 7);
        TBEG(pb + 8);
        if (IN(pb + 8)) REPEAT(8) { FRESH(); LOADA(); unsigned char* ws = a.ws;
            const int* TILEE = (const int*)(ws + WS_TILEE); const int ntl = TILEE[0];
            MoeOrder S; S.G = C.G; S.c = C.vcu; S.nu = ntl * 4; S.A = (const char*)(ws + WS_XS); S.B = (const char*)(ws + WS_E13T); S.tA = (size_t)256 * 1024; S.tB = (size_t)256 * 1024; S.eB = (size_t)1024 * 1024;
#pragma unroll
            for (int i = 0; i < 8; ++i) { const int L = i * C.G + C.vcu; S.ex[i] = (L < S.nu) ? TILEE[16 + (L >> 2)] : 0; }
            pg8::Gemm g{1024u, 1024u, 128u, 1024, 0u, 0u, 0, (const int*)(ws + WS_TOKL), (const char*)(ws + WS_H2), 0, 0};
            EpiMoe1 E{(unsigned char*)(ws + WS_ACT), 1.0f / 2048.0f};
            pg8::gemm_phase<EpiMoe1, MoeOrder, true, false, true, true>(C.lds, C.tid, g, S, E);
        }
        SEAM(pb + 8); TEND(pb + 8);
        TBEG(pb + 9);
        if (IN(pb + 9)) REPEAT(9) { FRESH(); LOADA(); unsigned char* ws = a.ws;
            const int* TILEE = (const int*)(ws + WS_TILEE); const int ntl = TILEE[0];
            MoeOrder S; S.G = C.G; S.c = C.vcu; S.nu = ntl * 4; S.A = (const char*)(ws + WS_ACT); S.B = (const char*)(ws + WS_E2T); S.tA = (size_t)256 * 512; S.tB = (size_t)256 * 512; S.eB = (size_t)1024 * 512;
#pragma unroll
            for (int i = 0; i < 8; ++i) { const int L = i * C.G + C.vcu; S.ex[i] = (L < S.nu) ? TILEE[16 + (L >> 2)] : 0; }
            pg8::Gemm g{512u, 512u, 128u, 512};
            EpiPlain E{(bf16_t*)(ws + WS_XS), 1024, 1.0f / 1024.0f};
            pg8::gemm_phase<EpiPlain, MoeOrder, true, false, false, true>(C.lds, C.tid, g, S, E);
        }
        SEAM(pb + 9); TEND(pb + 9);
    }
    TBEG(21);
    if (IN(21)) { FRESH(); LOADA(); final_phase(a, C); }
    TEND(21);
    if ((TMASK != 0u || TNSA != 0) && blockIdx.x == 0 && wave0_ == 0 && lane_id_fresh() == 0) { const unsigned long long d_ = ((unsigned long long)MISC[23] << 32) | MISC[22]; const unsigned long long t0_ = __builtin_amdgcn_s_memrealtime();
        while (__builtin_amdgcn_s_memrealtime() - t0_ < TAMP * d_) __builtin_amdgcn_s_sleep(8); }
#undef IN
#undef SEAM
}

#ifndef ONE_LAUNCH
#define ONE_LAUNCH 1
#endif
extern "C" void kernel_launch(void* const* d_in, const int* in_sizes, int n_in, void* d_out, int out_size, void* d_ws, size_t ws_size, hipStream_t stream) {
    static int grid = 0;
    if (grid == 0) {
        if (n_in != 22 || out_size != T * DM || ws_size < WS_END) { fprintf(stderr, "kernel_launch: unexpected problem (n_in %d out %d ws %zu)\n", n_in, out_size, ws_size); grid = -1; return; }
        int dev = 0, cus = 0;
        if (hipGetDevice(&dev) != hipSuccess || hipDeviceGetAttribute(&cus, hipDeviceAttributeMultiprocessorCount, dev) != hipSuccess) { grid = -1; return; }
        if (hipFuncSetAttribute((const void*)fwd_kernel, hipFuncAttributeMaxDynamicSharedMemorySize, LDS_BYTES) != hipSuccess) { fprintf(stderr, "kernel_launch: hipFuncSetAttribute failed\n"); grid = -1; return; }
        int per_cu = 0;
        if (hipOccupancyMaxActiveBlocksPerMultiprocessor(&per_cu, (const void*)fwd_kernel, NTHR, LDS_BYTES) != hipSuccess || per_cu < 1) { fprintf(stderr, "kernel_launch: occupancy query reports %d\n", per_cu); }
        (void)hipGetLastError();
        grid = cus;
    }
    if (grid < 0) return;
    (void)hipMemsetAsync((char*)d_ws + WS_CTL, 0, CTL_ZERO_BYTES, stream);
    Args a{};
    a.x = (const float*)d_in[0]; a.c = (const float*)d_in[1]; a.rel_bias = (const float*)d_in[2]; a.ada_w = (const float*)d_in[3]; a.ada_b = (const float*)d_in[4];
    a.norm1 = (const float*)d_in[5]; a.norm2 = (const float*)d_in[6]; a.w_in = (const float*)d_in[7]; a.cmp_pos = (const float*)d_in[8]; a.cmp_w1 = (const float*)d_in[9];
    a.cmp_w2 = (const float*)d_in[10]; a.w_up_nsa = (const float*)d_in[11]; a.w_up_dil = (const float*)d_in[12]; a.w_o = (const float*)d_in[13];
    a.router_wg = (const float*)d_in[14]; a.router_bg = (const float*)d_in[15]; a.router_we = (const float*)d_in[16]; a.router_be = (const float*)d_in[17];
    a.exp_w1 = (const float*)d_in[18]; a.exp_w3 = (const float*)d_in[19]; a.exp_w2 = (const float*)d_in[20]; a.norm_f = (const float*)d_in[21];
    a.out = (float*)d_out; a.ws = (unsigned char*)d_ws; a.pad = 0;
#if ONE_LAUNCH
    a.ph_lo = 0; a.ph_hi = NPHASE; a.use_bar = 1;
    hipLaunchKernelGGL(fwd_kernel, dim3(grid), dim3(NTHR), LDS_BYTES, stream, a);
#else
    for (int p = 0; p < NPHASE; ++p) { a.ph_lo = p; a.ph_hi = p + 1; a.use_bar = 0;
        hipLaunchKernelGGL(fwd_kernel, dim3(grid), dim3(NTHR), LDS_BYTES, stream, a); }
#endif
}
```

```cpp
#include <hip/hip_runtime.h>
#include <cstdint>
#include <cstdio>

#define GAS __attribute__((address_space(1)))
#define LAS __attribute__((address_space(3)))
typedef unsigned short bf16_t;
typedef short bf16x8 __attribute__((ext_vector_type(8)));
typedef short s16x4 __attribute__((ext_vector_type(4)));
typedef float f32x4 __attribute__((ext_vector_type(4)));
typedef float f32x2 __attribute__((ext_vector_type(2)));
typedef float f32x16 __attribute__((ext_vector_type(16)));
typedef unsigned u32x4 __attribute__((ext_vector_type(4)));
typedef unsigned u32x2 __attribute__((ext_vector_type(2)));
typedef __bf16 bf16x2_t __attribute__((ext_vector_type(2)));

constexpr int NB = 8, SEQ = 4096, DM = 1024, T = NB * SEQ;
constexpr int LDQ = 3584;
constexpr int NIN = 5888;
constexpr int INW = 5656;
constexpr float LOG2E = 1.4426950408889634f;
constexpr float C2 = 0.125f * LOG2E;
constexpr int NWAVES = 8, NTHR = 512;
constexpr float RMS_EPS = 1e-6f;
constexpr int NPHASE = 22;
#ifndef ABL
#define ABL 0
#endif
#ifndef REP_MASK
#define REP_MASK 0u
#endif
#ifndef TMASK
#define TMASK 0u
#endif
#define TAMP 8ull
#ifndef TNSA
#define TNSA 0
#endif
#define REPEAT(k) _Pragma("clang loop unroll(disable)") for (int rep_ = 0; rep_ < (int)((REP_MASK >> (k)) & 1u) + 1; ++rep_)

constexpr size_t MiB = 1u << 20;
constexpr size_t WS_CTL = 0, CTL_ZERO_BYTES = MiB;
constexpr size_t WS_MOD = 1 * MiB;
constexpr size_t WS_CB1 = WS_MOD + 400 * 1024;
constexpr size_t WS_CW2T = WS_MOD + 512 * 1024;
constexpr size_t WS_CNTBLK = WS_MOD + 768 * 1024;
constexpr size_t WS_TILEE = WS_MOD + 832 * 1024;
constexpr size_t WS_WINT = 4 * MiB;
constexpr size_t WS_CW1T = 27 * MiB;
constexpr size_t WS_WUNT = 31 * MiB;
constexpr size_t WS_WUDT = 33 * MiB;
constexpr size_t WS_WOT = 34 * MiB;
constexpr size_t WS_E13T = 38 * MiB;
constexpr size_t WS_E2T = 102 * MiB;
constexpr size_t WS_A = 134 * MiB;
constexpr size_t WS_XS = WS_A;
constexpr size_t WS_ACT = WS_A + 144 * MiB;
constexpr size_t WS_MERGED = WS_A;
constexpr size_t WS_MG = 359 * MiB;
constexpr size_t WS_H2 = WS_MG;
constexpr size_t WS_REC = WS_MG + 64 * MiB;
constexpr size_t WS_DEST = WS_MG + 65 * MiB;
constexpr size_t WS_TOKL = WS_MG + 66 * MiB;
constexpr size_t WS_B = 487 * MiB;
constexpr size_t WS_H = WS_B;
constexpr size_t WS_ONSA = WS_B;
constexpr size_t WS_ODP = WS_B + 32 * MiB;
constexpr size_t WS_LSE = WS_B + 80 * MiB;
constexpr size_t WS_ODIL = WS_B + 82 * MiB;
constexpr size_t WS_GN = WS_B + 98 * MiB;
constexpr size_t WS_KC = WS_B + 102 * MiB;
constexpr size_t WS_HID = WS_B + 103 * MiB;
constexpr size_t WS_END = WS_B + 107 * MiB;

constexpr int CW_TMO = 0, CW_BAR = 4096, CW_Q = 8192;

constexpr int LDS_MISC = 158784;
constexpr int LDS_BYTES = 158784 + 2048;

__device__ __forceinline__ unsigned cvt_pk_bf16(float lo, float hi) { f32x2 v = {lo, hi}; bf16x2_t b = __builtin_convertvector(v, bf16x2_t); return __builtin_bit_cast(unsigned, b); }
__device__ __forceinline__ float bf_lo(unsigned w) { return __uint_as_float(w << 16); }
__device__ __forceinline__ float bf_hi(unsigned w) { return __uint_as_float(w & 0xffff0000u); }
__device__ __forceinline__ float sigmoidf_(float x) { return __builtin_amdgcn_rcpf(1.0f + __builtin_amdgcn_exp2f(-x * LOG2E)); }
__device__ __forceinline__ int lane_id_fresh() { unsigned ones = ~0u; asm volatile("" : "+s"(ones)); return (int)__builtin_amdgcn_mbcnt_hi(ones, __builtin_amdgcn_mbcnt_lo(ones, 0u)); }
template <int X> __device__ __forceinline__ float swz_xor_f(float v) { return __int_as_float(__builtin_amdgcn_ds_swizzle(__float_as_int(v), (X << 10) | 0x1f)); }
template <int X> __device__ __forceinline__ unsigned swz_xor_u(unsigned v) { return (unsigned)__builtin_amdgcn_ds_swizzle((int)v, (X << 10) | 0x1f); }
__device__ __forceinline__ float wave_sum(float v) {
    v += swz_xor_f<1>(v); v += swz_xor_f<2>(v); v += swz_xor_f<4>(v); v += swz_xor_f<8>(v); v += swz_xor_f<16>(v);
    auto rr = __builtin_amdgcn_permlane32_swap(__float_as_uint(v), __float_as_uint(v), false, false);
    return __uint_as_float(rr[0]) + __uint_as_float(rr[1]);
}
__device__ __forceinline__ int bperm_i(int srclane, int v) { return __builtin_amdgcn_ds_bpermute(srclane << 2, v); }
#define LDS_WAIT() asm volatile("s_waitcnt lgkmcnt(0)" ::: "memory")
#define VM_WAIT() asm volatile("s_waitcnt vmcnt(0)" ::: "memory")

#define XB_TMO      128
#define XB_XCNT(j)  (256  + 64 * (j))
#define XB_XSUB(j)  (1280 + 64 * (j))
#define XB_XGEN(j)  (2304 + 64 * (j))
#define XB_TOP      3328
#define XB_TOPGEN   3392
#define XCD_BAR_WORDS 3456
#define XB_SPIN_CAP (1u << 20)
__device__ __forceinline__ unsigned xb_ld(unsigned* p)              { return __hip_atomic_load(p, __ATOMIC_RELAXED, __HIP_MEMORY_SCOPE_AGENT); }
__device__ __forceinline__ unsigned xb_add(unsigned* p, unsigned v) { return __hip_atomic_fetch_add(p, v, __ATOMIC_RELAXED, __HIP_MEMORY_SCOPE_AGENT); }
__device__ __forceinline__ unsigned xb_xcc_id() { return (unsigned)__builtin_amdgcn_s_getreg((3 << 11) | 20) & 0xFu; }
#define XB_SPIN(cond, bar) do { unsigned _sp = 0; while (cond) { __builtin_amdgcn_s_sleep(1); \
    if ((++_sp & 255u) == 0u) { if (xb_ld(&(bar)[XB_TMO])) break; if (_sp > XB_SPIN_CAP) { atomicAdd(&(bar)[XB_TMO], 1u); break; } } } } while (0)
struct XcdBarrier { unsigned* bar; unsigned x; volatile LAS unsigned* st; };
__device__ __forceinline__ XcdBarrier xcd_barrier_post(unsigned* bar, volatile LAS unsigned* st) {
    XcdBarrier b; b.bar = bar; b.x = xb_xcc_id(); b.st = st;
    if (threadIdx.x == 0) (void)xb_add(&bar[XB_XCNT(b.x)], 1u);
    return b;
}
__device__ __forceinline__ void xcd_barrier_complete(unsigned* bar, unsigned x, unsigned& nloc, unsigned& nx) {
    const unsigned G = gridDim.x * gridDim.y * gridDim.z;
    unsigned sum, cnt, mine, sp = 0u;
    for (;;) {
        sum = 0u; cnt = 0u; mine = 0u;
#pragma unroll
        for (unsigned j = 0; j < 16; ++j) { const unsigned c = xb_ld(&bar[XB_XCNT(j)]); sum += c; cnt += (c > 0u) ? 1u : 0u; mine = (j == x) ? c : mine; }
        if (sum == G) break;
        __builtin_amdgcn_s_sleep(1);
        if ((++sp & 255u) == 0u) { if (xb_ld(&bar[XB_TMO])) break; if (sp > XB_SPIN_CAP) { atomicAdd(&bar[XB_TMO], 1u); break; } }
    }
    nloc = mine > 0u ? mine : 1u; nx = cnt > 0u ? cnt : 1u;
}
__device__ __forceinline__ void xcd_barrier(const XcdBarrier& b, const bool leader_thread) {
    asm volatile("s_waitcnt vmcnt(0)" ::: "memory");
    __syncthreads();
    if (leader_thread) {
        unsigned* bar = b.bar;
        __builtin_amdgcn_s_waitcnt(0);
        unsigned nloc = b.st[0], nx = b.st[1];
        if (nloc == 0u) { xcd_barrier_complete(bar, b.x, nloc, nx); b.st[0] = nloc; b.st[1] = nx; }
        const unsigned old = xb_add(&bar[XB_XSUB(b.x)], 1u);
        const unsigned gen = old / nloc;
        if (old + 1u == (gen + 1u) * nloc) {
            __builtin_amdgcn_fence(__ATOMIC_RELEASE, "agent");
            asm volatile("s_waitcnt vmcnt(0)" ::: "memory");
            const unsigned og = xb_add(&bar[XB_TOP], 1u);
            const unsigned tg = og / nx;
            if (og + 1u == (tg + 1u) * nx) xb_add(&bar[XB_TOPGEN], 1u);
            else XB_SPIN(xb_ld(&bar[XB_TOPGEN]) == tg, bar);
            __builtin_amdgcn_fence(__ATOMIC_ACQUIRE, "agent");
            xb_add(&bar[XB_XGEN(b.x)], 1u);
            asm volatile("s_waitcnt vmcnt(0)" ::: "memory");
        } else {
            XB_SPIN(xb_ld(&bar[XB_XGEN(b.x)]) == gen, bar);
            __builtin_amdgcn_fence(__ATOMIC_ACQUIRE, "agent");
            asm volatile("s_waitcnt vmcnt(0)" ::: "memory");
        }
    }
    __syncthreads();
}

namespace pg8 {
constexpr int BM = 256, BK = 64, HALF = 128, HTB = HALF * BK * 2, STAGE_BYTES = 8 * HTB;
__device__ __forceinline__ int lds_byte(int r, int c) { const int st = (r >> 4) * 2 + (c >> 5), rr = r & 15, cc = c & 31, ob = rr * 64 + cc * 2; return st * 1024 + (ob ^ (((ob >> 9) & 1) << 5)); }
__device__ __forceinline__ void stage_rc(int b, int& R, int& C) { const int st = b / 1024, sb = b % 1024, swz = sb ^ (((sb >> 9) & 1) << 5); R = (st >> 1) * 16 + swz / 64; C = (st & 1) * 32 + (swz % 64) / 2; }
__device__ __forceinline__ int perm32(int rho) { const int n = rho >> 4, i = rho & 15; return 8 * (i >> 2) + 4 * n + (i & 3); }

struct Unit { const char* A; const char* B; int pm, pn; const char* A2; const char* B2; };
struct Gemm { unsigned lda, ldb, kstepA; int K; unsigned lda2, ldb2; int K2; const int* tokl; const char* Abase; int sc_w, sc_a; };

template <class Epi, class Sched, bool ALIGN_EPI, bool SEG2 = false, bool GATHER = false, bool FP8 = false>
__device__ __forceinline__ void gemm_phase(LAS unsigned char* lds, const int tid, const Gemm g, const Sched& S, const Epi& E) {
    const int wid = __builtin_amdgcn_readfirstlane(tid >> 6), lane = tid & 63, wr = wid >> 2, wc = wid & 3, fr = lane & 15, fq = lane >> 4;
    const int nt0 = g.K / (FP8 ? 2 * BK : BK); const int nt = nt0 + (SEG2 ? g.K2 / BK : 0);
    unsigned voffA[2], voffB[2], voffA2[2], voffB2[2]; int Rrow[2]; unsigned Cb[2];
#pragma unroll
    for (int i = 0; i < 2; ++i) { int R, C; stage_rc(tid * 16 + i * 8192, R, C); Rrow[i] = R; Cb[i] = (unsigned)C * 2u; const int Rb = Epi::PERM ? ((R & ~31) + perm32(R & 31)) : R;
        voffA[i] = (unsigned)R * g.lda + (unsigned)C * 2u; voffB[i] = (unsigned)Rb * g.ldb + (unsigned)C * 2u;
        voffA2[i] = SEG2 ? (unsigned)R * g.lda2 + (unsigned)C * 2u : 0u; voffB2[i] = SEG2 ? (unsigned)Rb * g.ldb2 + (unsigned)C * 2u : 0u; }
    const size_t kstepA = (size_t)g.kstepA, kstepB = (size_t)(BK * 2);
    const size_t hstepA = (size_t)HALF * g.lda, hstepB = (size_t)HALF * g.ldb;
    const size_t hstepA2 = SEG2 ? (size_t)HALF * g.lda2 : 0, hstepB2 = SEG2 ? (size_t)HALF * g.ldb2 : 0;
    const unsigned ldsw = (unsigned)wid * 1024u;
    const int aoff = lds_byte(wr * 64 + fr, FP8 ? fq * 16 : fq * 8), boff = lds_byte(wc * 32 + fr, FP8 ? fq * 16 : fq * 8);
#define PG8_SA(b, h) (((b) * 2 + (h)) * HTB)
#define PG8_SB(b, h) ((4 + (b) * 2 + (h)) * HTB)
#define PG8_STAGE(bufoff, gbase, voff) do { _Pragma("unroll") for (int _i = 0; _i < 2; ++_i) \
        __builtin_amdgcn_global_load_lds((const unsigned*)((const char*)(gbase) + (voff)[_i]), (LAS unsigned*)(lds + (bufoff) + ldsw + _i * 8192), 16, 0, 0); } while (0)
#define PG8_STAGE2(bufoff, gbase, sel, v0, v1) do { _Pragma("unroll") for (int _i = 0; _i < 2; ++_i) \
        __builtin_amdgcn_global_load_lds((const unsigned*)((const char*)(gbase) + ((sel) ? (v1)[_i] : (v0)[_i])), (LAS unsigned*)(lds + (bufoff) + ldsw + _i * 8192), 16, 0, 0); } while (0)
#define PG8_LDA(dst, b, h) do { if constexpr (FP8) { _Pragma("unroll") for (int m = 0; m < 4; ++m) dst##8[m] = *(const LAS v8i_*)(lds + PG8_SA(b, h) + aoff + m * 2048); } \
        else { _Pragma("unroll") for (int m = 0; m < 4; ++m) _Pragma("unroll") for (int k = 0; k < 2; ++k) dst[m][k] = *(const LAS bf16x8*)(lds + PG8_SA(b, h) + aoff + m * 2048 + k * 1024); } } while (0)
#define PG8_LDB(dst, b, h) do { if constexpr (FP8) { _Pragma("unroll") for (int n = 0; n < 2; ++n) dst##8[n] = *(const LAS v8i_*)(lds + PG8_SB(b, h) + boff + n * 2048); } \
        else { _Pragma("unroll") for (int n = 0; n < 2; ++n) _Pragma("unroll") for (int k = 0; k < 2; ++k) dst[n][k] = *(const LAS bf16x8*)(lds + PG8_SB(b, h) + boff + n * 2048 + k * 1024); } } while (0)
#define PG8_MMA(ai, bj, At, Bt) do { __builtin_amdgcn_s_setprio(1); _Pragma("unroll") for (int m = 0; m < 4; ++m) _Pragma("unroll") for (int n = 0; n < 2; ++n) { \
        if constexpr (FP8) { asm volatile("v_mfma_f32_16x16x128_f8f6f4 %0, %1, %2, %0" : "+v"(acc[ai][bj][m][n]) : "v"(Bt##8[n]), "v"(At##8[m])); }     \
        else { _Pragma("unroll") for (int k = 0; k < 2; ++k) acc[ai][bj][m][n] = __builtin_amdgcn_mfma_f32_16x16x32_bf16(Bt[n][k], At[m][k], acc[ai][bj][m][n], 0, 0, 0); } } \
        __builtin_amdgcn_s_setprio(0); } while (0)
#define PG8_WAIT_V(n) asm volatile("s_waitcnt vmcnt(" #n ")" ::: "memory")
#define PG8_WAIT_L(n) asm volatile("s_waitcnt lgkmcnt(" #n ")" ::: "memory")
#define PG8_BAR __builtin_amdgcn_s_barrier()
#define PG8_SCHED __builtin_amdgcn_sched_barrier(0)
    Unit cur, nxt; int ui = 0;
    if (!S.next(0, cur)) return;
    f32x4 acc[2][2][4][2];
#pragma unroll
    for (int a = 0; a < 2; ++a)
#pragma unroll
        for (int b = 0; b < 2; ++b)
#pragma unroll
            for (int m = 0; m < 4; ++m)
#pragma unroll
                for (int n = 0; n < 2; ++n) acc[a][b][m][n] = (f32x4){0.f, 0.f, 0.f, 0.f};
    typedef int v8i_ __attribute__((ext_vector_type(8)));
    bf16x8 At[4][2], B0[2][2], B1[2][2]; v8i_ At8[4], B08[2], B18[2];
    const char* cA = GATHER ? g.Abase : cur.A; const char* cB = cur.B;
    unsigned vC0[2], vC1[2], vN0[2], vN1[2];
#define PG8_GLOAD(U, d0, d1) do { _Pragma("unroll") for (int _i = 0; _i < 2; ++_i) { \
        d0[_i] = (unsigned)g.tokl[(U).pm * 256 + Rrow[_i]] * g.lda + Cb[_i]; d1[_i] = (unsigned)g.tokl[(U).pm * 256 + 128 + Rrow[_i]] * g.lda + Cb[_i]; } } while (0)
    if constexpr (GATHER) { PG8_GLOAD(cur, vC0, vC1); }
    if constexpr (GATHER) {
        PG8_STAGE(PG8_SB(0, 0), cB, voffB); PG8_STAGE(PG8_SB(0, 1), cB + hstepB, voffB); PG8_STAGE(PG8_SA(0, 0), cA, vC0); PG8_STAGE(PG8_SA(0, 1), cA, vC1);
        if (wr == 1) PG8_BAR;
        PG8_WAIT_V(2); PG8_BAR;
        PG8_STAGE(PG8_SB(1, 0), cB + kstepB, voffB); PG8_STAGE(PG8_SA(1, 0), cA + kstepA, vC0); PG8_STAGE(PG8_SB(1, 1), cB + hstepB + kstepB, voffB);
        PG8_WAIT_V(6); PG8_BAR;
    } else {
    PG8_STAGE(PG8_SB(0, 0), cB, voffB); PG8_STAGE(PG8_SB(0, 1), cB + hstepB, voffB); PG8_STAGE(PG8_SA(0, 0), cA, voffA); PG8_STAGE(PG8_SA(0, 1), cA + hstepA, voffA);
    if (wr == 1) PG8_BAR;
    PG8_WAIT_V(2); PG8_BAR;
    PG8_STAGE(PG8_SB(1, 0), cB + kstepB, voffB); PG8_STAGE(PG8_SA(1, 0), cA + kstepA, voffA); PG8_STAGE(PG8_SB(1, 1), cB + hstepB + kstepB, voffB);
    PG8_WAIT_V(6); PG8_BAR;
    }
    for (;;) {
        const bool has_next = S.next(ui + 1, nxt);
        const char* nA = GATHER ? cA : (has_next ? nxt.A : cA); const char* nB = has_next ? nxt.B : cB;
        if constexpr (GATHER) { if (has_next) { PG8_GLOAD(nxt, vN0, vN1); } else { vN0[0] = vC0[0]; vN0[1] = vC0[1]; vN1[0] = vC1[0]; vN1[1] = vC1[1]; } }
#pragma clang loop unroll(disable)
        for (int t = 0; t < nt; t += 2) {
            const bool last = (t == nt - 2);
            if constexpr (SEG2) {
                const bool s1 = (t >= nt0);
                const bool s2 = !last && (t + 2 >= nt0);
                if (t == nt0) E.mid(acc, cur, wr, wc, fr, fq);
                const char* a1 = s1 ? cur.A2 + (size_t)(t + 1 - nt0) * kstepB : cA + (size_t)(t + 1) * kstepA; const size_t h1 = s1 ? hstepA2 : hstepA;
                const char* a2 = last ? nA : (s2 ? cur.A2 + (size_t)(t + 2 - nt0) * kstepB : cA + (size_t)(t + 2) * kstepA);
                const char* b2 = last ? nB : (s2 ? cur.B2 + (size_t)(t + 2 - nt0) * kstepB : cB + (size_t)(t + 2) * kstepB);
                const char* a3 = a2 + (s2 ? kstepB : kstepA); const char* b3 = b2 + kstepB;
                const size_t hA2 = s2 ? hstepA2 : hstepA, hB2 = s2 ? hstepB2 : hstepB;
                PG8_LDB(B0, 0, 0); PG8_LDB(B1, 0, 1); PG8_SCHED; PG8_LDA(At, 0, 0); PG8_STAGE2(PG8_SA(1, 1), a1 + h1, s1, voffA, voffA2);
                PG8_WAIT_V(8); PG8_WAIT_L(0); PG8_BAR; PG8_MMA(0, 0, At, B0); PG8_MMA(0, 1, At, B1); PG8_BAR; PG8_SCHED;
                PG8_LDA(At, 0, 1); PG8_STAGE2(PG8_SB(0, 0), b2, s2, voffB, voffB2); PG8_STAGE2(PG8_SB(0, 1), b2 + hB2, s2, voffB, voffB2); PG8_STAGE2(PG8_SA(0, 0), a2, s2, voffA, voffA2);
                PG8_WAIT_V(8); PG8_WAIT_L(0); PG8_BAR; PG8_MMA(1, 0, At, B0); PG8_MMA(1, 1, At, B1); PG8_BAR; PG8_SCHED;
                PG8_LDB(B0, 1, 0); PG8_LDB(B1, 1, 1); PG8_SCHED; PG8_LDA(At, 1, 0); PG8_STAGE2(PG8_SA(0, 1), a2 + hA2, s2, voffA, voffA2);
                PG8_WAIT_V(8); PG8_WAIT_L(0); PG8_BAR; PG8_MMA(0, 0, At, B0); PG8_MMA(0, 1, At, B1); PG8_BAR; PG8_SCHED;
                PG8_LDA(At, 1, 1); PG8_STAGE2(PG8_SB(1, 0), b3, s2, voffB, voffB2); PG8_STAGE2(PG8_SB(1, 1), b3 + hB2, s2, voffB, voffB2); PG8_STAGE2(PG8_SA(1, 0), a3, s2, voffA, voffA2);
                PG8_WAIT_V(8); PG8_WAIT_L(0); PG8_BAR; PG8_MMA(1, 0, At, B0); PG8_MMA(1, 1, At, B1); PG8_BAR; PG8_SCHED;
            } else if constexpr (GATHER) {
            const char* a1 = cA + (size_t)(t + 1) * kstepA;
            const char* a2 = last ? cA : cA + (size_t)(t + 2) * kstepA; const char* b2 = last ? nB : cB + (size_t)(t + 2) * kstepB;
            const char* a3 = a2 + kstepA; const char* b3 = b2 + kstepB;
            unsigned w0[2], w1[2]; w0[0] = last ? vN0[0] : vC0[0]; w0[1] = last ? vN0[1] : vC0[1]; w1[0] = last ? vN1[0] : vC1[0]; w1[1] = last ? vN1[1] : vC1[1];
            PG8_LDB(B0, 0, 0); PG8_LDB(B1, 0, 1); PG8_SCHED; PG8_LDA(At, 0, 0); PG8_STAGE(PG8_SA(1, 1), a1, vC1);
            PG8_WAIT_V(8); PG8_WAIT_L(0); PG8_BAR; PG8_MMA(0, 0, At, B0); PG8_MMA(0, 1, At, B1); PG8_BAR; PG8_SCHED;
            PG8_LDA(At, 0, 1); PG8_STAGE(PG8_SB(0, 0), b2, voffB); PG8_STAGE(PG8_SB(0, 1), b2 + hstepB, voffB); PG8_STAGE(PG8_SA(0, 0), a2, w0);
            PG8_WAIT_V(8); PG8_WAIT_L(0); PG8_BAR; PG8_MMA(1, 0, At, B0); PG8_MMA(1, 1, At, B1); PG8_BAR; PG8_SCHED;
            PG8_LDB(B0, 1, 0); PG8_LDB(B1, 1, 1); PG8_SCHED; PG8_LDA(At, 1, 0); PG8_STAGE(PG8_SA(0, 1), a2, w1);
            PG8_WAIT_V(8); PG8_WAIT_L(0); PG8_BAR; PG8_MMA(0, 0, At, B0); PG8_MMA(0, 1, At, B1); PG8_BAR; PG8_SCHED;
            PG8_LDA(At, 1, 1); PG8_STAGE(PG8_SB(1, 0), b3, voffB); PG8_STAGE(PG8_SB(1, 1), b3 + hstepB, voffB); PG8_STAGE(PG8_SA(1, 0), a3, w0);
            PG8_WAIT_V(8); PG8_WAIT_L(0); PG8_BAR; PG8_MMA(1, 0, At, B0); PG8_MMA(1, 1, At, B1); PG8_BAR; PG8_SCHED;
            } else {
            const char* a1 = cA + (size_t)(t + 1) * kstepA;
            const char* a2 = last ? nA : cA + (size_t)(t + 2) * kstepA; const char* b2 = last ? nB : cB + (size_t)(t + 2) * kstepB;
            const char* a3 = a2 + kstepA; const char* b3 = b2 + kstepB;
            PG8_LDB(B0, 0, 0); PG8_LDB(B1, 0, 1); PG8_SCHED; PG8_LDA(At, 0, 0); PG8_STAGE(PG8_SA(1, 1), a1 + hstepA, voffA);
            PG8_WAIT_V(8); PG8_WAIT_L(0); PG8_BAR; PG8_MMA(0, 0, At, B0); PG8_MMA(0, 1, At, B1); PG8_BAR; PG8_SCHED;
            PG8_LDA(At, 0, 1); PG8_STAGE(PG8_SB(0, 0), b2, voffB); PG8_STAGE(PG8_SB(0, 1), b2 + hstepB, voffB); PG8_STAGE(PG8_SA(0, 0), a2, voffA);
            PG8_WAIT_V(8); PG8_WAIT_L(0); PG8_BAR; PG8_MMA(1, 0, At, B0); PG8_MMA(1, 1, At, B1); PG8_BAR; PG8_SCHED;
            PG8_LDB(B0, 1, 0); PG8_LDB(B1, 1, 1); PG8_SCHED; PG8_LDA(At, 1, 0); PG8_STAGE(PG8_SA(0, 1), a2 + hstepA, voffA);
            PG8_WAIT_V(8); PG8_WAIT_L(0); PG8_BAR; PG8_MMA(0, 0, At, B0); PG8_MMA(0, 1, At, B1); PG8_BAR; PG8_SCHED;
            PG8_LDA(At, 1, 1); PG8_STAGE(PG8_SB(1, 0), b3, voffB); PG8_STAGE(PG8_SB(1, 1), b3 + hstepB, voffB); PG8_STAGE(PG8_SA(1, 0), a3, voffA);
            PG8_WAIT_V(8); PG8_WAIT_L(0); PG8_BAR; PG8_MMA(1, 0, At, B0); PG8_MMA(1, 1, At, B1); PG8_BAR; PG8_SCHED;
            }
        }
        if constexpr (ALIGN_EPI) { if (wr == 0) PG8_BAR; }
        if constexpr (FP8) { asm volatile("s_nop 15\n\ts_nop 15" ::: "memory"); }
        if constexpr (!Epi::AFTER_DRAIN) { int fr_ = fr, fq_ = fq; asm volatile("" : "+v"(fr_), "+v"(fq_));
            E(acc, cur, wr, wc, fr_, fq_); }
        if (!has_next) break;
#pragma unroll
        for (int a = 0; a < 2; ++a)
#pragma unroll
            for (int b = 0; b < 2; ++b)
#pragma unroll
                for (int m = 0; m < 4; ++m)
#pragma unroll
                    for (int n = 0; n < 2; ++n) acc[a][b][m][n] = (f32x4){0.f, 0.f, 0.f, 0.f};
        cur = nxt; cA = nA; cB = nB; ++ui;
        if constexpr (GATHER) { vC0[0] = vN0[0]; vC0[1] = vN0[1]; vC1[0] = vN1[0]; vC1[1] = vN1[1]; }
        if constexpr (ALIGN_EPI) { if (wr == 1) PG8_BAR; }
    }
    PG8_WAIT_V(0);
    if constexpr (!ALIGN_EPI) { if (wr == 0) PG8_BAR; }
    PG8_BAR;
    if constexpr (Epi::AFTER_DRAIN) { E.fused(acc, cur, wr, wc, fr, fq, wid, lane); }
#undef PG8_SA
#undef PG8_SB
#undef PG8_STAGE
#undef PG8_STAGE2
#undef PG8_GLOAD
#undef PG8_LDA
#undef PG8_LDB
#undef PG8_MMA
#undef PG8_WAIT_V
#undef PG8_WAIT_L
#undef PG8_BAR
#undef PG8_SCHED
}

struct DenseOrder {
    int nM, nN, nwg, G, c; const char* A; const char* B; size_t tA, tB; const char* A2 = nullptr; const char* B2 = nullptr; size_t tA2 = 0, tB2 = 0;
    __device__ __forceinline__ void init(int M, int N, int G_, int c_, const void* A_, unsigned lda, const void* B_, unsigned ldb) {
        nM = M / BM; nN = N / BM; nwg = nM * nN; G = G_; c = c_; A = (const char*)A_; B = (const char*)B_; tA = (size_t)BM * lda; tB = (size_t)BM * ldb; }
    __device__ __forceinline__ bool next(int i, Unit& u) const {
        const long L = (long)i * G + c; if (L >= nwg) return false;
        int wgid = (int)L; { const int q = nwg / 8, r = nwg % 8, xcd = wgid % 8, off = wgid / 8; wgid = (xcd < r ? xcd * (q + 1) : r * (q + 1) + (xcd - r) * q) + off; }
        const int nig = 8 * nN, gid = wgid / nig, fm = gid * 8, gsz = (nM - fm) < 8 ? (nM - fm) : 8;
        u.pm = fm + ((wgid % nig) % gsz); u.pn = (wgid % nig) / gsz;
        u.A = A + (size_t)u.pm * tA; u.B = B + (size_t)u.pn * tB; u.A2 = A2 + (size_t)u.pm * tA2; u.B2 = B2 + (size_t)u.pn * tB2; return true;
    }
};
}

struct Args {
    const float* x; const float* c; const float* rel_bias; const float* ada_w; const float* ada_b; const float* norm1; const float* norm2; const float* w_in;
    const float* cmp_pos; const float* cmp_w1; const float* cmp_w2; const float* w_up_nsa; const float* w_up_dil; const float* w_o;
    const float* router_wg; const float* router_bg; const float* router_we; const float* router_be; const float* exp_w1; const float* exp_w3; const float* exp_w2; const float* norm_f;
    float* out; unsigned char* ws; int ph_lo, ph_hi, use_bar, pad;
};

typedef f32x4 AccT[2][2][4][2];
__device__ __forceinline__ unsigned q8(float x) { return (unsigned)(sigmoidf_(x) * 255.0f + 0.5f); }
struct EpiInProj {
    static constexpr bool PERM = true, AFTER_DRAIN = false;
    bf16_t* QKV; unsigned char* MG; float* GN; float os;
    __device__ __forceinline__ void operator()(const AccT& acc, const pg8::Unit& u, int wr, int wc, int fr, int fq) const {
        const int pn = u.pn; const int row0 = u.pm * 256 + wr * 64 + fr;
        if (pn < 14) {
            const float sc = ((pn < 2 || (pn >= 5 && pn < 8)) ? C2 : 1.0f) * os;
            const int col0 = pn * 256 + wc * 32 + 8 * fq;
#pragma unroll
            for (int ai = 0; ai < 2; ++ai)
#pragma unroll
                for (int m = 0; m < 4; ++m) { bf16_t* rowp = QKV + (size_t)(row0 + ai * 128 + m * 16) * LDQ + col0;
#pragma unroll
                    for (int bj = 0; bj < 2; ++bj) { const f32x4 v0 = acc[ai][bj][m][0] * sc, v1 = acc[ai][bj][m][1] * sc; u32x4 w;
                        w.x = cvt_pk_bf16(v0[0], v0[1]); w.y = cvt_pk_bf16(v0[2], v0[3]); w.z = cvt_pk_bf16(v1[0], v1[1]); w.w = cvt_pk_bf16(v1[2], v1[3]);
                        *(u32x4*)(rowp + bj * 128) = w; } }
        } else if (pn < 22) {
            const int col0 = (pn - 14) * 256 + wc * 32 + 8 * fq;
#pragma unroll
            for (int ai = 0; ai < 2; ++ai)
#pragma unroll
                for (int m = 0; m < 4; ++m) { unsigned char* rowp = MG + (size_t)(row0 + ai * 128 + m * 16) * 2048 + col0;
#pragma unroll
                    for (int bj = 0; bj < 2; ++bj) { const f32x4 v0 = acc[ai][bj][m][0] * os, v1 = acc[ai][bj][m][1] * os; u32x2 w;
                        w.x = q8(v0[0]) | (q8(v0[1]) << 8) | (q8(v0[2]) << 16) | (q8(v0[3]) << 24); w.y = q8(v1[0]) | (q8(v1[1]) << 8) | (q8(v1[2]) << 16) | (q8(v1[3]) << 24);
                        *(u32x2*)(rowp + bj * 128) = w; } }
        } else {
            if (wc == 0 && fq < 3) {
#pragma unroll
                for (int ai = 0; ai < 2; ++ai)
#pragma unroll
                    for (int m = 0; m < 4; ++m) { float* rowp = GN + (size_t)(row0 + ai * 128 + m * 16) * 32 + 8 * fq;
                        const f32x4 v0 = acc[ai][0][m][0] * os, v1 = acc[ai][0][m][1] * os;
                        *(f32x4*)(rowp) = (f32x4){sigmoidf_(v0[0]), sigmoidf_(v0[1]), sigmoidf_(v0[2]), sigmoidf_(v0[3])};
                        *(f32x4*)(rowp + 4) = (f32x4){sigmoidf_(v1[0]), sigmoidf_(v1[1]), sigmoidf_(v1[2]), sigmoidf_(v1[3])}; }
            }
        }
    }
};
template <int PASS> struct EpiUp {
    static constexpr bool PERM = true, AFTER_DRAIN = false;
    bf16_t* MERGED; const bf16_t* MG;
    __device__ __forceinline__ void operator()(const AccT& acc, const pg8::Unit& u, int wr, int wc, int fr, int fq) const {
        const int row0 = u.pm * 256 + wr * 64 + fr; const int col0 = u.pn * 256 + wc * 32 + 8 * fq;
#pragma unroll
        for (int ai = 0; ai < 2; ++ai)
#pragma unroll
            for (int m = 0; m < 4; ++m) { const size_t row = (size_t)(row0 + ai * 128 + m * 16);
#pragma unroll
                for (int bj = 0; bj < 2; ++bj) {
                    const u32x4 gw = *(const u32x4*)(MG + row * 2048 + PASS * 1024 + col0 + bj * 128);
                    bf16_t* op = MERGED + row * 1024 + col0 + bj * 128;
                    const f32x4 v0 = acc[ai][bj][m][0], v1 = acc[ai][bj][m][1];
                    float r[8] = {v0[0] * bf_lo(gw.x), v0[1] * bf_hi(gw.x), v0[2] * bf_lo(gw.y), v0[3] * bf_hi(gw.y), v1[0] * bf_lo(gw.z), v1[1] * bf_hi(gw.z), v1[2] * bf_lo(gw.w), v1[3] * bf_hi(gw.w)};
                    if (PASS == 1) { const u32x4 ow = *(const u32x4*)op;
                        r[0] += bf_lo(ow.x); r[1] += bf_hi(ow.x); r[2] += bf_lo(ow.y); r[3] += bf_hi(ow.y); r[4] += bf_lo(ow.z); r[5] += bf_hi(ow.z); r[6] += bf_lo(ow.w); r[7] += bf_hi(ow.w); }
                    u32x4 w; w.x = cvt_pk_bf16(r[0], r[1]); w.y = cvt_pk_bf16(r[2], r[3]); w.z = cvt_pk_bf16(r[4], r[5]); w.w = cvt_pk_bf16(r[6], r[7]);
                    *(u32x4*)op = w; }
                asm volatile("" ::: "memory"); }
    }
};
struct EpiUpFused {
    static constexpr bool PERM = true, AFTER_DRAIN = false;
    bf16_t* MERGED; const unsigned char* MG;
    __device__ __forceinline__ void mid(AccT& acc, const pg8::Unit& u, int wr, int wc, int fr, int fq) const {
        const int row0 = u.pm * 256 + wr * 64 + fr; const int col0 = u.pn * 256 + wc * 32 + 8 * fq;
#pragma unroll
        for (int ai = 0; ai < 2; ++ai)
#pragma unroll
            for (int m = 0; m < 4; ++m) { const size_t row = (size_t)(row0 + ai * 128 + m * 16);
#pragma unroll
                for (int bj = 0; bj < 2; ++bj) {
                    const u32x2 g0 = *(const u32x2*)(MG + row * 2048 + col0 + bj * 128), g1 = *(const u32x2*)(MG + row * 2048 + 1024 + col0 + bj * 128);
                    f32x4& v0 = acc[ai][bj][m][0]; f32x4& v1 = acc[ai][bj][m][1];
#pragma unroll
                    for (int j = 0; j < 4; ++j) { const float a0 = (float)((g0.x >> (8 * j)) & 255u), b0 = (float)((g1.x >> (8 * j)) & 255u), a1 = (float)((g0.y >> (8 * j)) & 255u), b1 = (float)((g1.y >> (8 * j)) & 255u);
                        v0[j] *= a0 * __builtin_amdgcn_rcpf(__builtin_fmaxf(b0, 0.5f)); v1[j] *= a1 * __builtin_amdgcn_rcpf(__builtin_fmaxf(b1, 0.5f)); } }
                asm volatile("" ::: "memory"); }
    }
    __device__ __forceinline__ void operator()(const AccT& acc, const pg8::Unit& u, int wr, int wc, int fr, int fq) const {
        const int row0 = u.pm * 256 + wr * 64 + fr; const int col0 = u.pn * 256 + wc * 32 + 8 * fq;
#pragma unroll
        for (int ai = 0; ai < 2; ++ai)
#pragma unroll
            for (int m = 0; m < 4; ++m) { const size_t row = (size_t)(row0 + ai * 128 + m * 16);
#pragma unroll
                for (int bj = 0; bj < 2; ++bj) {
                    const u32x2 g1 = *(const u32x2*)(MG + row * 2048 + 1024 + col0 + bj * 128);
                    const f32x4 v0 = acc[ai][bj][m][0], v1 = acc[ai][bj][m][1]; float r[8];
#pragma unroll
                    for (int j = 0; j < 4; ++j) { r[j] = v0[j] * (__builtin_fmaxf((float)((g1.x >> (8 * j)) & 255u), 0.5f) * (1.0f / 255.0f)); r[4 + j] = v1[j] * (__builtin_fmaxf((float)((g1.y >> (8 * j)) & 255u), 0.5f) * (1.0f / 255.0f)); }
                    u32x4 w; w.x = cvt_pk_bf16(r[0], r[1]); w.y = cvt_pk_bf16(r[2], r[3]); w.z = cvt_pk_bf16(r[4], r[5]); w.w = cvt_pk_bf16(r[6], r[7]);
                    *(u32x4*)(MERGED + row * 1024 + col0 + bj * 128) = w; }
                asm volatile("" ::: "memory"); }
    }
};
struct EpiOut {
    static constexpr bool PERM = true, AFTER_DRAIN = false;
    const float* xin; float* xout; const float* g1;
    __device__ __forceinline__ void operator()(const AccT& acc, const pg8::Unit& u, int wr, int wc, int fr, int fq) const {
        const int row0 = u.pm * 256 + wr * 64 + fr; const int col0 = u.pn * 256 + wc * 32 + 8 * fq; const int b = u.pm >> 4;
        f32x4 gv[2][2];
#pragma unroll
        for (int bj = 0; bj < 2; ++bj)
#pragma unroll
            for (int n = 0; n < 2; ++n) gv[bj][n] = *(const f32x4*)(g1 + (size_t)b * 6144 + col0 + bj * 128 + 4 * n);
#pragma unroll
        for (int ai = 0; ai < 2; ++ai)
#pragma unroll
            for (int m = 0; m < 4; ++m) { const size_t off = (size_t)(row0 + ai * 128 + m * 16) * 1024 + col0;
#pragma unroll
                for (int bj = 0; bj < 2; ++bj)
#pragma unroll
                    for (int n = 0; n < 2; ++n) { const f32x4 xv = *(const f32x4*)(xin + off + bj * 128 + 4 * n);
                        *(f32x4*)(xout + off + bj * 128 + 4 * n) = (ABL == 7) ? xv : xv + gv[bj][n] * acc[ai][bj][m][n]; }
                asm volatile("" ::: "memory"); }
    }
};
struct EpiMoe1 {
    static constexpr bool PERM = true, AFTER_DRAIN = false;
    unsigned char* ACT; float os;
    __device__ __forceinline__ void operator()(const AccT& acc, const pg8::Unit& u, int wr, int wc, int fr, int fq) const {
        const int row0 = u.pm * 256 + wr * 64 + fr; const int col0 = u.pn * 128 + wc * 32 + 8 * fq;
#pragma unroll
        for (int ai = 0; ai < 2; ++ai)
#pragma unroll
            for (int m = 0; m < 4; ++m) { unsigned char* op = ACT + (size_t)(row0 + ai * 128 + m * 16) * 512 + col0; float r[8];
#pragma unroll
                for (int n = 0; n < 2; ++n)
#pragma unroll
                    for (int j = 0; j < 4; ++j) { const float a = acc[ai][0][m][n][j] * os, bb = acc[ai][1][m][n][j] * os; r[n * 4 + j] = a * sigmoidf_(a) * bb * 4.0f; }
                u32x2 w; w.x = (unsigned)__builtin_amdgcn_cvt_pk_fp8_f32(r[0], r[1], 0, false); w.x = (unsigned)__builtin_amdgcn_cvt_pk_fp8_f32(r[2], r[3], (int)w.x, true);
                w.y = (unsigned)__builtin_amdgcn_cvt_pk_fp8_f32(r[4], r[5], 0, false); w.y = (unsigned)__builtin_amdgcn_cvt_pk_fp8_f32(r[6], r[7], (int)w.y, true);
                *(u32x2*)op = w; }
    }
};
struct EpiPlain {
    static constexpr bool PERM = true, AFTER_DRAIN = false;
    bf16_t* O; int ldc; float os;
    __device__ __forceinline__ void operator()(const AccT& acc, const pg8::Unit& u, int wr, int wc, int fr, int fq) const {
        const int row0 = u.pm * 256 + wr * 64 + fr; const int col0 = u.pn * 256 + wc * 32 + 8 * fq;
#pragma unroll
        for (int ai = 0; ai < 2; ++ai)
#pragma unroll
            for (int m = 0; m < 4; ++m) { bf16_t* rowp = O + (size_t)(row0 + ai * 128 + m * 16) * ldc + col0;
#pragma unroll
                for (int bj = 0; bj < 2; ++bj) { const f32x4 v0 = acc[ai][bj][m][0] * os, v1 = acc[ai][bj][m][1] * os; u32x4 w;
                    w.x = cvt_pk_bf16(v0[0], v0[1]); w.y = cvt_pk_bf16(v0[2], v0[3]); w.z = cvt_pk_bf16(v1[0], v1[1]); w.w = cvt_pk_bf16(v1[2], v1[3]);
                    *(u32x4*)(rowp + bj * 128) = w; } }
    }
};
__device__ __forceinline__ int crow(int r, int hi) { return (r & 3) + 8 * (r >> 2) + 4 * hi; }
__device__ __forceinline__ float gelu_tanh(float x) { const float u2 = 2.0f * 0.7978845608028654f * (x + 0.044715f * x * x * x); return x * __builtin_amdgcn_rcpf(1.0f + __builtin_amdgcn_exp2f(-u2 * LOG2E)); }
struct EpiCmp {
    static constexpr bool PERM = true, AFTER_DRAIN = true;
    bf16_t* HID; const float* CB1; const bf16_t* CW2T; bf16_t* KC;
    __device__ __forceinline__ void fused(const AccT& acc, const pg8::Unit& u, int wr, int wc, int fr, int fq, int wid, int lane) const {
        const int kv = u.pm >> 4; const int row0 = u.pm * 256 + wr * 64 + fr; const int col0 = wc * 32 + 8 * fq;
        const float* bias = CB1 + kv * 256;
        f32x4 bv[2][2];
#pragma unroll
        for (int bj = 0; bj < 2; ++bj)
#pragma unroll
            for (int n = 0; n < 2; ++n) bv[bj][n] = *(const f32x4*)(bias + col0 + bj * 128 + 4 * n);
#pragma unroll
        for (int ai = 0; ai < 2; ++ai)
#pragma unroll
            for (int m = 0; m < 4; ++m) { bf16_t* rowp = HID + (size_t)(row0 + ai * 128 + m * 16) * 256 + col0;
#pragma unroll
                for (int bj = 0; bj < 2; ++bj) { const f32x4 v0 = acc[ai][bj][m][0] + bv[bj][0], v1 = acc[ai][bj][m][1] + bv[bj][1]; u32x4 w;
                    w.x = cvt_pk_bf16(gelu_tanh(v0[0]), gelu_tanh(v0[1])); w.y = cvt_pk_bf16(gelu_tanh(v0[2]), gelu_tanh(v0[3]));
                    w.z = cvt_pk_bf16(gelu_tanh(v1[0]), gelu_tanh(v1[1])); w.w = cvt_pk_bf16(gelu_tanh(v1[2]), gelu_tanh(v1[3]));
                    *(u32x4*)(rowp + bj * 128) = w; } }
        VM_WAIT(); __syncthreads();
        const int r32 = lane & 31, hi = lane >> 5;
        const bf16_t* ap = HID + (size_t)(u.pm * 256 + 32 * wid + r32) * 256 + hi * 8;
        const bf16_t* bp = CW2T + (size_t)kv * 64 * 256 + (size_t)r32 * 256 + hi * 8;
        f32x16 o0 = {}, o1 = {};
#pragma unroll 4
        for (int ks = 0; ks < 16; ++ks) {
            const bf16x8 a = *(const bf16x8*)(ap + ks * 16);
            const bf16x8 b0 = *(const bf16x8*)(bp + ks * 16), b1 = *(const bf16x8*)(bp + 32 * 256 + ks * 16);
            o0 = __builtin_amdgcn_mfma_f32_32x32x16_bf16(a, b0, o0, 0, 0, 0);
            o1 = __builtin_amdgcn_mfma_f32_32x32x16_bf16(a, b1, o1, 0, 0, 0);
        }
        bf16_t* kc = KC + (size_t)u.pm * 256 * 64;
#pragma unroll
        for (int r = 0; r < 16; ++r) { const int c = 32 * wid + crow(r, hi); const bool pad = (c == 255);
            kc[(size_t)c * 64 + r32] = pad ? (bf16_t)0 : (bf16_t)(cvt_pk_bf16(o0[r], 0.f) & 0xffffu);
            kc[(size_t)c * 64 + 32 + r32] = pad ? (bf16_t)0 : (bf16_t)(cvt_pk_bf16(o1[r], 0.f) & 0xffffu); }
    }
};

namespace att {
constexpr int L_KR = 0;
constexpr int L_VR = 24576;
constexpr int L_WSF = 49152;
constexpr int L_BKT = 51200;
constexpr int L_BKC = 55296;
constexpr int L_TBH = 64000;
constexpr int L_GSH = 64576;
constexpr int L_SEL = 67648;
constexpr int L_OTA = 68672;
constexpr int L_IMP = 101440;
constexpr int L_LUT = 117824;
constexpr int L_END = L_LUT + 40960;
static_assert(L_END <= LDS_MISC, "attention LDS map");

__device__ __forceinline__ void glds16(const void* gsrc, unsigned lds_dst) { unsigned keep;
    asm volatile("s_mov_b32 %0, m0\n\ts_mov_b32 m0, %2\n\ts_nop 0\n\tglobal_load_lds_dwordx4 %1, off\n\ts_mov_b32 m0, %0" : "=&s"(keep) : "v"(gsrc), "s"(lds_dst) : "memory"); }
__device__ __forceinline__ int bucket_of(int d) {
    if (d < 16) return d;
    int b = 16;
    b += (d >= 22); b += (d >= 30); b += (d >= 40); b += (d >= 54); b += (d >= 73); b += (d >= 99); b += (d >= 134); b += (d >= 182);
    b += (d >= 246); b += (d >= 332); b += (d >= 450); b += (d >= 609); b += (d >= 825); b += (d >= 1117); b += (d >= 1513);
    return b;
}
__device__ __forceinline__ void qkt(f32x16& p0, f32x16& p1, const LAS unsigned char* Kslot, const bf16x8 (&qr)[4], int r32, int hi) {
    const LAS unsigned char* kb = Kslot + hi * 1024 + r32 * 16;
    p0 = (f32x16){}; p1 = (f32x16){};
#pragma unroll
    for (int d0 = 0; d0 < 4; ++d0) {
        const bf16x8 b0 = *(const LAS bf16x8*)(kb + d0 * 2048);
        const bf16x8 b1 = *(const LAS bf16x8*)(kb + d0 * 2048 + 512);
        p0 = __builtin_amdgcn_mfma_f32_32x32x16_bf16(b0, qr[d0], p0, 0, 0, 0);
        p1 = __builtin_amdgcn_mfma_f32_32x32x16_bf16(b1, qr[d0], p1, 0, 0, 0);
    }
}
__device__ __forceinline__ void pv(f32x16 (&o)[2], int vb, bf16x8 pa0, bf16x8 pa1, bf16x8 pa2, bf16x8 pa3) {
#pragma unroll
    for (int d0 = 0; d0 < 2; ++d0) { s16x4 lo[4], hi[4];
#pragma unroll
        for (int ks = 0; ks < 4; ++ks) {
            asm volatile("ds_read_b64_tr_b16 %0,%1 offset:%c2" : "=&v"(lo[ks]) : "v"(vb), "i"(d0 * 4096 + ks * 1024) : "memory");
            asm volatile("ds_read_b64_tr_b16 %0,%1 offset:%c2" : "=&v"(hi[ks]) : "v"(vb), "i"(d0 * 4096 + ks * 1024 + 512) : "memory"); }
        asm volatile("s_waitcnt lgkmcnt(0)" ::: "memory"); __builtin_amdgcn_sched_barrier(0);
#define PK(k) (bf16x8){lo[k][0], lo[k][1], lo[k][2], lo[k][3], hi[k][0], hi[k][1], hi[k][2], hi[k][3]}
        o[d0] = __builtin_amdgcn_mfma_f32_32x32x16_bf16(pa0, PK(0), o[d0], 0, 0, 0);
        o[d0] = __builtin_amdgcn_mfma_f32_32x32x16_bf16(pa1, PK(1), o[d0], 0, 0, 0);
        o[d0] = __builtin_amdgcn_mfma_f32_32x32x16_bf16(pa2, PK(2), o[d0], 0, 0, 0);
        o[d0] = __builtin_amdgcn_mfma_f32_32x32x16_bf16(pa3, PK(3), o[d0], 0, 0, 0);
#undef PK
    }
}
__device__ __forceinline__ float xhalf_max(float v) { auto rr = __builtin_amdgcn_permlane32_swap(__float_as_uint(v), __float_as_uint(v), false, false); return __builtin_fmaxf(__uint_as_float(rr[0]), __uint_as_float(rr[1])); }
__device__ __forceinline__ float xhalf_sum(float v) { auto rr = __builtin_amdgcn_permlane32_swap(__float_as_uint(v), __float_as_uint(v), false, false); return __uint_as_float(rr[0]) + __uint_as_float(rr[1]); }

#define ATT_PACK(p0, p1, pw0, pw1, pw2, pw3) do { \
    pw0 = (u32x4){cvt_pk_bf16(p0[0], p0[1]), cvt_pk_bf16(p0[2], p0[3]), cvt_pk_bf16(p0[4], p0[5]), cvt_pk_bf16(p0[6], p0[7])}; \
    pw1 = (u32x4){cvt_pk_bf16(p0[8], p0[9]), cvt_pk_bf16(p0[10], p0[11]), cvt_pk_bf16(p0[12], p0[13]), cvt_pk_bf16(p0[14], p0[15])}; \
    pw2 = (u32x4){cvt_pk_bf16(p1[0], p1[1]), cvt_pk_bf16(p1[2], p1[3]), cvt_pk_bf16(p1[4], p1[5]), cvt_pk_bf16(p1[6], p1[7])}; \
    pw3 = (u32x4){cvt_pk_bf16(p1[8], p1[9]), cvt_pk_bf16(p1[10], p1[11]), cvt_pk_bf16(p1[12], p1[13]), cvt_pk_bf16(p1[14], p1[15])}; } while (0)

__device__ __forceinline__ void stage_rows(LAS unsigned char* lds, int wid, int lane, const f32x16 (&ot)[2]) {
    const int r32 = lane & 31, hi = lane >> 5;
    LAS bf16_t* stg = (LAS bf16_t*)(lds + L_OTA) + wid * 2048;
#pragma unroll
    for (int r = 0; r < 16; ++r) { const int orow = crow(r, hi);
#pragma unroll
        for (int d0 = 0; d0 < 2; ++d0) stg[orow * 64 + d0 * 32 + r32] = (bf16_t)(cvt_pk_bf16(ot[d0][r], 0.f) & 0xffffu); }
    LDS_WAIT();
}
struct StreamP { const bf16_t* Kb; const bf16_t* Vb; long pitch; int NT; const LAS unsigned char* tl; unsigned long long lanesel; int uq; const LAS float* lut; int xtop; int dclamp; };
typedef const LAS unsigned char* lds_cptr;
typedef short v4i16_t __attribute__((ext_vector_type(4)));
__device__ __forceinline__ void kload8(bf16x8* kf, lds_cptr kp) {
    kf[0] = *(const LAS bf16x8*)(kp);        kf[1] = *(const LAS bf16x8*)(kp + 512);
    kf[2] = *(const LAS bf16x8*)(kp + 2048); kf[3] = *(const LAS bf16x8*)(kp + 2560);
    kf[4] = *(const LAS bf16x8*)(kp + 4096); kf[5] = *(const LAS bf16x8*)(kp + 4608);
    kf[6] = *(const LAS bf16x8*)(kp + 6144); kf[7] = *(const LAS bf16x8*)(kp + 6656);
}
__device__ __forceinline__ void kload2(bf16x8* kf, lds_cptr kp, int j) { kf[2 * j] = *(const LAS bf16x8*)(kp + j * 2048); kf[2 * j + 1] = *(const LAS bf16x8*)(kp + j * 2048 + 512); }
__device__ __forceinline__ s16x4 vtr(lds_cptr p) { return __builtin_bit_cast(s16x4, __builtin_amdgcn_ds_read_tr16_b64_v4i16((LAS v4i16_t*)p)); }
constexpr int SLOTB = 8192;
#define ST_WAIT_BAR(N) asm volatile("s_waitcnt vmcnt(" #N ") lgkmcnt(0)\n\ts_barrier" ::: "memory")
template <int THRL>
__device__ __forceinline__ void attn_stream(LAS unsigned char* lds, const int wid, const int lane, const bf16x8 (&qr)[4], const StreamP S, float& mhat_o, float& l_o, f32x16 (&o)[2]) {
    const int r32 = lane & 31, hi = lane >> 5;
    const unsigned lds0 = (unsigned)(uintptr_t)lds;
    LAS float* wsf = (LAS float*)(lds + L_WSF) + wid * 64;
    const int NT = S.NT;
    const bf16_t* ksrc = S.Kb + (long)lane * S.pitch + wid * 8;
    const bf16_t* vsrc = S.Vb + (long)(16 * (wid & 3) + (lane >> 2)) * S.pitch + (wid >> 2) * 32 + (lane & 3) * 8;
    const unsigned kdst = lds0 + L_KR + wid * 1024, vdst = lds0 + L_VR + wid * 1024;
    const int tlv = (lane < NT) ? (int)S.tl[lane] : 0x80;
#define TLRAW(k) ((int)__builtin_amdgcn_readlane(tlv, __builtin_amdgcn_readfirstlane(k)))
#define DMA_K(k, slot) do { const int tr_ = TLRAW(k) & 63; glds16(ksrc + (long)tr_ * 64 * S.pitch, (unsigned)__builtin_amdgcn_readfirstlane(kdst + (slot))); } while (0)
#define DMA_V(k, slot) do { const int tr_ = TLRAW(k) & 63; glds16(vsrc + (long)tr_ * 64 * S.pitch, (unsigned)__builtin_amdgcn_readfirstlane(vdst + (slot))); } while (0)
    const lds_cptr kp0 = (lds_cptr)lds + L_KR + hi * 1024 + r32 * 16;
    const lds_cptr vp0 = (lds_cptr)lds + L_VR + ((lane >> 4) & 1) * 32 + (lane & 3) * 8 + (4 * hi + ((lane & 15) >> 2)) * 64;
    const int vb0 = (int)(lds0 + L_VR) + ((lane >> 4) & 1) * 32 + (lane & 3) * 8 + (4 * hi + ((lane & 15) >> 2)) * 64;
    bf16x8 kf[8];
#define LOFF(r) (((r) & 3) + 8 * ((r) >> 2))
#define LUTPTR(k, lp) do { const int raw_ = TLRAW(k); const int tj_ = raw_ & 63; int d0_ = S.uq - 64 * tj_ - 4 * hi; d0_ = d0_ < S.dclamp ? d0_ : S.dclamp; \
        const bool ok_ = (raw_ < 128) && (((S.lanesel >> tj_) & 1ull) != 0ull); lp = S.lut + (ok_ ? S.xtop - d0_ : S.xtop + 64); } while (0)
#define LUTLOAD(C0, C1, k) do { const int raw_ = TLRAW(k); const int tj_ = raw_ & 63; int d0_ = S.uq - 64 * tj_ - 4 * hi; d0_ = d0_ < S.dclamp ? d0_ : S.dclamp; \
        const bool ok_ = (raw_ < 128) && (((S.lanesel >> tj_) & 1ull) != 0ull); const LAS float* lp_ = S.lut + (ok_ ? S.xtop - d0_ : S.xtop + 64); \
        _Pragma("unroll") for (int r = 0; r < 16; ++r) { C0[r] = lp_[(r & 3) + 8 * (r >> 2)]; C1[r] = lp_[(r & 3) + 8 * (r >> 2) + 32]; } } while (0)
#define SBAR() __builtin_amdgcn_sched_barrier(0)
#define PIN(x) asm volatile("" : "+v"(x))
#define PKW(P, B) cvt_pk_bf16(P[B], P[B + 1])
#define PAF(k) __builtin_bit_cast(bf16x8, pw##k)
#define VFR(i) (bf16x8){vlo[i][0], vlo[i][1], vlo[i][2], vlo[i][3], vhi[i][0], vhi[i][1], vhi[i][2], vhi[i][3]}
#define MX3(a, b, c) __builtin_fmaxf(__builtin_fmaxf((a), (b)), (c))
#define MFMA32(a, b, c) __builtin_amdgcn_mfma_f32_32x32x16_bf16(a, b, c, 0, 0, 0)
#define GAPA(MF, A0, A1, A2, A3, W0, W1, PW) do { MF; sacc += A0; sacc += A1; sacc += A2; sacc += A3; PIN(sacc); W0; W1; PIN(PW); SBAR(); } while (0)
#define EX(v) __builtin_amdgcn_exp2f(v)
#define GAPB(MF, X, B, GN, PL, PO) do { MF; X[B] = EX(X[B]); X[B + 1] = EX(X[B + 1]); X[B + 2] = EX(X[B + 2]); X[B + 3] = EX(X[B + 3]); PIN(X); \
        if (GN) { PL[B] = lpn_[LOFF(B) + PO]; PL[B + 1] = lpn_[LOFF(B + 1) + PO]; PL[B + 2] = lpn_[LOFF(B + 2) + PO]; PL[B + 3] = lpn_[LOFF(B + 3) + PO]; } SBAR(); } while (0)
#define VRD(i) do { vlo[i] = vtr(vp_ + (((i) >> 2) * 4096 + ((i) & 3) * 1024)); vhi[i] = vtr(vp_ + (((i) >> 2) * 4096 + ((i) & 3) * 1024 + 512)); } while (0)
#define KRD(G, j) do { if (G) { kload2(kf, kp0 + sl_next, j); SBAR(); } } while (0)
#define ROT() do { sl_prev = sl_cur; sl_cur = sl_next; sl_next = (sl_next == 2 * SLOTB) ? 0 : sl_next + SLOTB; } while (0)
#define RESC() do { if (resc) { LDS_WAIT(); _Pragma("unroll") for (int d_ = 0; d_ < 2; ++d_) _Pragma("unroll") for (int r = 0; r < 16; ++r) o[d_][r] *= wsf[crow(r, hi)]; } } while (0)
#define ENDW(tt) do { if ((tt) + 3 < NT) { ST_WAIT_BAR(2); } else if ((tt) + 2 < NT) { ST_WAIT_BAR(1); } else { ST_WAIT_BAR(0); } } while (0)
#define STEP(C0, C1, P0, P1, t, GK, GV, GL, GN) do { SBAR(); \
    const lds_cptr vp_ = vp0 + sl_prev; const LAS float* lpn_ = S.lut; if (GN) { LUTPTR((t) + 1, lpn_); } \
    VRD(0); SBAR(); float sacc = (P0[0] + P0[1]); \
    GAPA(C0 = MFMA32(kf[0], qr[0], C0), P0[2], P0[3], P0[4], P0[5],     pw0[0] = PKW(P0, 0), pw0[1] = PKW(P0, 2), pw0); \
    VRD(4); SBAR(); GAPA(C1 = MFMA32(kf[1], qr[0], C1), P0[6], P0[7], P0[8], P0[9],     pw0[2] = PKW(P0, 4), pw0[3] = PKW(P0, 6), pw0); \
    VRD(1); SBAR(); GAPA(C0 = MFMA32(kf[2], qr[1], C0), P0[10], P0[11], P0[12], P0[13], pw1[0] = PKW(P0, 8), pw1[1] = PKW(P0, 10), pw1); \
    VRD(5); SBAR(); GAPA(C1 = MFMA32(kf[3], qr[1], C1), P0[14], P0[15], P1[0], P1[1],   pw1[2] = PKW(P0, 12), pw1[3] = PKW(P0, 14), pw1); \
    VRD(2); SBAR(); GAPA(C0 = MFMA32(kf[4], qr[2], C0), P1[2], P1[3], P1[4], P1[5],     pw2[0] = PKW(P1, 0), pw2[1] = PKW(P1, 2), pw2); \
    VRD(6); SBAR(); GAPA(C1 = MFMA32(kf[5], qr[2], C1), P1[6], P1[7], P1[8], P1[9],     pw2[2] = PKW(P1, 4), pw2[3] = PKW(P1, 6), pw2); \
    VRD(3); SBAR(); GAPA(C0 = MFMA32(kf[6], qr[3], C0), P1[10], P1[11], P1[12], P1[13], pw3[0] = PKW(P1, 8), pw3[1] = PKW(P1, 10), pw3); \
    VRD(7); SBAR(); GAPA(C1 = MFMA32(kf[7], qr[3], C1), P1[14], P1[15], 0.f, 0.f,       pw3[2] = PKW(P1, 12), pw3[3] = PKW(P1, 14), pw3); \
    l_reg += sacc; \
    if (GK) { DMA_K((t) + 3, sl_cur); } if (GV) { DMA_V((t) + 1, sl_next); } \
    { _Pragma("unroll") for (int r = 0; r < 16; ++r) { C0[r] -= mhat; C1[r] -= mhat; } \
      float a_ = MX3(C0[0], C0[1], C1[0]), b_ = MX3(C0[2], C0[3], C1[1]); a_ = MX3(a_, C1[2], C1[3]); \
      _Pragma("unroll") for (int r = 4; r < 16; r += 4) { a_ = MX3(a_, C0[r], C0[r + 1]); b_ = MX3(b_, C0[r + 2], C0[r + 3]); a_ = MX3(a_, C1[r], C1[r + 1]); b_ = MX3(b_, C1[r + 2], C1[r + 3]); } \
      float rm = xhalf_max(__builtin_fmaxf(a_, b_)); \
      resc = false; \
      if (__builtin_expect(__any(rm > (float)THRL), 0)) { const float dl = __builtin_fmaxf(rm, 0.f); mhat += dl; \
        _Pragma("unroll") for (int r = 0; r < 16; ++r) { C0[r] -= dl; C1[r] -= dl; } \
        const float f = __builtin_amdgcn_exp2f(-dl); l_reg *= f; if (hi == 0) wsf[r32] = f; resc = true; } } \
    SBAR(); \
    GAPB(o[0] = MFMA32(PAF(0), VFR(0), o[0]), C0, 0, GN, P0, 0); \
    GAPB(o[1] = MFMA32(PAF(0), VFR(4), o[1]), C0, 4, GN, P0, 0); \
    KRD(GL, 0); GAPB(o[0] = MFMA32(PAF(1), VFR(1), o[0]), C0, 8, GN, P0, 0); \
    KRD(GL, 1); GAPB(o[1] = MFMA32(PAF(1), VFR(5), o[1]), C0, 12, GN, P0, 0); \
    KRD(GL, 2); GAPB(o[0] = MFMA32(PAF(2), VFR(2), o[0]), C1, 0, GN, P1, 32); \
    KRD(GL, 3); GAPB(o[1] = MFMA32(PAF(2), VFR(6), o[1]), C1, 4, GN, P1, 32); \
    GAPB(o[0] = MFMA32(PAF(3), VFR(3), o[0]), C1, 8, GN, P1, 32); \
    GAPB(o[1] = MFMA32(PAF(3), VFR(7), o[1]), C1, 12, GN, P1, 32); \
    } while (0)
    float mhat = 0.f, l_reg = 0.f; bool resc = false;
    o[0] = (f32x16){}; o[1] = (f32x16){};
    f32x16 pA0, pA1, pB0, pB1;
    int sl_prev = 0, sl_cur = 0, sl_next = SLOTB;
    DMA_K(0, 0); DMA_V(0, 0); DMA_K(1, SLOTB); DMA_K(2, 2 * SLOTB);
    LUTLOAD(pA0, pA1, 0);
    ST_WAIT_BAR(3);
    { const lds_cptr kb = kp0;
#pragma unroll
      for (int d0 = 0; d0 < 4; ++d0) { const bf16x8 b0 = *(const LAS bf16x8*)(kb + d0 * 2048); const bf16x8 b1 = *(const LAS bf16x8*)(kb + d0 * 2048 + 512);
          pA0 = MFMA32(b0, qr[d0], pA0); pA1 = MFMA32(b1, qr[d0], pA1); }
      float rm = pA0[0];
#pragma unroll
      for (int r = 1; r < 16; ++r) rm = __builtin_fmaxf(rm, pA0[r]);
#pragma unroll
      for (int r = 0; r < 16; ++r) rm = __builtin_fmaxf(rm, pA1[r]);
      rm = xhalf_max(rm);
      mhat = (rm == -INFINITY) ? 0.f : rm;
#pragma unroll
      for (int r = 0; r < 16; ++r) { pA0[r] = EX(pA0[r] - mhat); pA1[r] = EX(pA1[r] - mhat); } }
    ST_WAIT_BAR(0);
    DMA_K(3, 0); DMA_V(1, SLOTB);
    ROT();
    kload8(kf, kp0 + sl_cur);
    LUTLOAD(pB0, pB1, 1);
    ST_WAIT_BAR(2);
    s16x4 vlo[8], vhi[8]; u32x4 pw0, pw1, pw2, pw3;
    int t = 1;
    for (; t + 5 < NT; t += 2) {
        STEP(pB0, pB1, pA0, pA1, t, true, true, true, true);     ST_WAIT_BAR(2); RESC(); ROT();
        STEP(pA0, pA1, pB0, pB1, t + 1, true, true, true, true); ST_WAIT_BAR(2); RESC(); ROT();
    }
    for (; t + 1 < NT; t += 2) {
        STEP(pB0, pB1, pA0, pA1, t, (t + 3 < NT), (t + 1 < NT), (t + 1 < NT), true);       ENDW(t);     RESC(); ROT();
        STEP(pA0, pA1, pB0, pB1, t + 1, (t + 4 < NT), (t + 2 < NT), (t + 2 < NT), true);   ENDW(t + 1); RESC(); ROT();
    }
    STEP(pB0, pB1, pA0, pA1, NT - 1, false, false, false, false); RESC();
    { float sacc = pB0[0] + pB0[1];
#pragma unroll
      for (int r = 2; r < 16; ++r) sacc += pB0[r];
#pragma unroll
      for (int r = 0; r < 16; ++r) sacc += pB1[r];
      l_reg += sacc;
      ATT_PACK(pB0, pB1, pw0, pw1, pw2, pw3);
      SBAR(); pv(o, vb0 + sl_cur, PAF(0), PAF(1), PAF(2), PAF(3)); }
    asm volatile("s_waitcnt lgkmcnt(0)\n\ts_barrier" ::: "memory");
    mhat_o = mhat; l_o = l_reg;
#undef TLRAW
#undef DMA_K
#undef DMA_V
#undef LUTLOAD
#undef LUTPTR
#undef LOFF
#undef SBAR
#undef PIN
#undef PKW
#undef PAF
#undef VFR
#undef MX3
#undef MFMA32
#undef GAPA
#undef EX
#undef GAPB
#undef VRD
#undef KRD
#undef ROT
#undef RESC
#undef ENDW
#undef STEP
}
__device__ __forceinline__ void cmp_scores(f32x16& s0, f32x16& s1, LAS unsigned char* lds, const LAS unsigned char* bkc, const LAS unsigned char* tb, const bf16x8 (&qr)[4], const int k, const int r32, const int hi) {
#pragma unroll
    for (int r = 0; r < 16; ++r) { const int off = 16 * ((r & 3) + 8 * (r >> 2));
        s0[r] = *(const LAS float*)(tb + bkc[1024 * k + off]); s1[r] = *(const LAS float*)(tb + bkc[1024 * k + off + 512]); }
    const LAS unsigned char* kb = lds + k * 8192 + hi * 1024 + r32 * 16;
#pragma unroll
    for (int d0 = 0; d0 < 4; ++d0) { const bf16x8 b0 = *(const LAS bf16x8*)(kb + d0 * 2048); const bf16x8 b1 = *(const LAS bf16x8*)(kb + d0 * 2048 + 512);
        s0 = __builtin_amdgcn_mfma_f32_32x32x16_bf16(b0, qr[d0], s0, 0, 0, 0); s1 = __builtin_amdgcn_mfma_f32_32x32x16_bf16(b1, qr[d0], s1, 0, 0, 0); }
}
__device__ __forceinline__ float xhalf_other(float v, int hi) { auto rr = __builtin_amdgcn_permlane32_swap(__float_as_uint(v), __float_as_uint(v), false, false); return __uint_as_float(hi ? rr[0] : rr[1]); }
__device__ __forceinline__ void cmp_issue(LAS unsigned char* lds, const int wid, const int lane, const bf16_t* Kb, const bf16_t* Vb, const int nt) {
    const unsigned lds0 = (unsigned)(uintptr_t)lds;
    { const bf16_t* ksrc = Kb + (long)lane * 64 + wid * 8; const bf16_t* vsrc = Vb + (long)(16 * (wid & 3) + (lane >> 2)) * 64 + (wid >> 2) * 32 + (lane & 3) * 8;
      for (int k = 0; k < nt; ++k) { glds16(ksrc + (long)k * 4096, (unsigned)__builtin_amdgcn_readfirstlane(lds0 + k * 8192 + wid * 1024));
                                     glds16(vsrc + (long)k * 4096, (unsigned)__builtin_amdgcn_readfirstlane(lds0 + L_OTA + k * 8192 + wid * 1024)); } }
}
__device__ __forceinline__ void cmp_branch(LAS unsigned char* lds, const int wid, const int lane, const bf16x8 (&qr)[4], const int nt, const int t, f32x16 (&o)[2]) {
    const int r32 = lane & 31, hi = lane >> 5, g = wid >> 1, tq = (wid & 1) * 32 + r32;
    const unsigned lds0 = (unsigned)(uintptr_t)lds;
    const LAS unsigned char* bkc = lds + L_BKC + (4126 - t + 64 * hi);
    const LAS unsigned char* tb = lds + L_TBH + g * 144;
    asm volatile("s_waitcnt vmcnt(0) lgkmcnt(0)\n\ts_barrier" ::: "memory");
    float m = -INFINITY, l = 0.f;
#pragma clang loop unroll(disable)
    for (int k = 0; k < nt; ++k) { f32x16 s0, s1; cmp_scores(s0, s1, lds, bkc, tb, qr, k, r32, hi);
        float rm = s0[0];
#pragma unroll
        for (int r = 1; r < 16; ++r) rm = __builtin_fmaxf(rm, s0[r]);
#pragma unroll
        for (int r = 0; r < 16; ++r) rm = __builtin_fmaxf(rm, s1[r]);
        rm = xhalf_max(rm);
        const float mn = __builtin_fmaxf(m, rm), ms = (mn == -INFINITY) ? 0.f : mn;
        float ps = 0.f;
#pragma unroll
        for (int r = 0; r < 16; ++r) ps += __builtin_amdgcn_exp2f(s0[r] - ms) + __builtin_amdgcn_exp2f(s1[r] - ms);
        l = l * __builtin_amdgcn_exp2f(m - ms) + ps; m = mn; }
    l = xhalf_sum(l);
    const float msafe = (m == -INFINITY) ? 0.f : m, inv = l > 0.f ? 1.0f / l : 0.f;
    float I[4][8]; float pc7 = 0.f;
    o[0] = (f32x16){}; o[1] = (f32x16){};
    const int vb0 = (int)(lds0 + L_OTA) + ((lane >> 4) & 1) * 32 + (lane & 3) * 8 + (4 * hi + ((lane & 15) >> 2)) * 64;
#pragma unroll
    for (int k = 0; k < 4; ++k) {
        if (k < nt) { f32x16 s0, s1; cmp_scores(s0, s1, lds, bkc, tb, qr, k, r32, hi);
#pragma unroll
            for (int r = 0; r < 16; ++r) { s0[r] = __builtin_amdgcn_exp2f(s0[r] - msafe) * inv; s1[r] = __builtin_amdgcn_exp2f(s1[r] - msafe) * inv; }
            float pc[8];
#pragma unroll
            for (int q = 0; q < 4; ++q) { I[k][q] = 2.0f * (s0[4 * q] + s0[4 * q + 1] + s0[4 * q + 2]) + s0[4 * q + 3]; I[k][4 + q] = 2.0f * (s1[4 * q] + s1[4 * q + 1] + s1[4 * q + 2]) + s1[4 * q + 3];
                pc[q] = xhalf_other(s0[4 * q + 3], hi); pc[4 + q] = xhalf_other(s1[4 * q + 3], hi); }
#pragma unroll
            for (int j = 0; j < 8; ++j) I[k][j] += hi ? pc[j] : (j > 0 ? pc[j - 1] : pc7);
            pc7 = pc[7];
            u32x4 pw0, pw1, pw2, pw3; ATT_PACK(s0, s1, pw0, pw1, pw2, pw3);
            pv(o, vb0 + k * 8192, __builtin_bit_cast(bf16x8, pw0), __builtin_bit_cast(bf16x8, pw1), __builtin_bit_cast(bf16x8, pw2), __builtin_bit_cast(bf16x8, pw3));
        } else {
#pragma unroll
            for (int j = 0; j < 8; ++j) I[k][j] = 0.f;
        }
    }
    LAS float* imp = (LAS float*)(lds + L_IMP) + tq * 64 + hi;
#pragma unroll 1
    for (int gi = 0; gi < 4; ++gi) {
        if (g == gi) {
#pragma unroll
            for (int k = 0; k < 4; ++k) if (k < nt) {
#pragma unroll
                for (int j = 0; j < 8; ++j) __builtin_amdgcn_ds_faddf(imp + 16 * k + 2 * j, I[k][j], 0, 0, false);
            }
        }
        asm volatile("s_waitcnt lgkmcnt(0)\n\ts_barrier" ::: "memory");
    }
}
}

struct Ctx { int tid, lane, wave, vcu, G, bx; LAS unsigned char* lds; };

struct TrD { const float* src; size_t ldw; int nvalid; bf16_t* dst; size_t ldk; float fp8s; };
__device__ __forceinline__ void tr_load(const TrD& d, float (&v)[32], int lane) {
    const int n = lane & 31; const float* src = d.src + (size_t)(lane >> 5) * d.ldw + n;
#pragma unroll
    for (int i = 0; i < 32; ++i) v[i] = (n < d.nvalid) ? src[(size_t)(2 * i) * d.ldw] : 0.f;
}
__device__ __forceinline__ void tr_store(const TrD& d, const float (&v)[32], LAS float* scr, int lane) {
    const int n = lane & 31;
#pragma unroll
    for (int i = 0; i < 32; ++i) scr[(2 * i + (lane >> 5)) * 33 + n] = v[i];
    LDS_WAIT(); asm volatile("" ::: "memory");
    const int c = lane & 7;
#pragma unroll
    for (int j = 0; j < 4; ++j) { const int nn = (lane >> 3) + 8 * j; const LAS float* s = scr + (8 * c) * 33 + nn;
        if (d.fp8s != 0.f) { const float f = d.fp8s; u32x2 o;
            o.x = (unsigned)__builtin_amdgcn_cvt_pk_fp8_f32(s[0 * 33] * f, s[1 * 33] * f, 0, false); o.x = (unsigned)__builtin_amdgcn_cvt_pk_fp8_f32(s[2 * 33] * f, s[3 * 33] * f, (int)o.x, true);
            o.y = (unsigned)__builtin_amdgcn_cvt_pk_fp8_f32(s[4 * 33] * f, s[5 * 33] * f, 0, false); o.y = (unsigned)__builtin_amdgcn_cvt_pk_fp8_f32(s[6 * 33] * f, s[7 * 33] * f, (int)o.y, true);
            *(u32x2*)((unsigned char*)d.dst + (size_t)nn * d.ldk + 8 * c) = o;
        } else {
        u32x4 o; o.x = cvt_pk_bf16(s[0 * 33], s[1 * 33]); o.y = cvt_pk_bf16(s[2 * 33], s[3 * 33]); o.z = cvt_pk_bf16(s[4 * 33], s[5 * 33]); o.w = cvt_pk_bf16(s[6 * 33], s[7 * 33]);
        *(u32x4*)(d.dst + (size_t)nn * d.ldk + 8 * c) = o; } }
    LDS_WAIT(); asm volatile("" ::: "memory");
}
__device__ __forceinline__ TrD mk_trd(const float* W, size_t ldw, int srccol, int nvalid, bf16_t* WT, size_t ldk, int dstrow, int k0) {
    TrD d; d.src = W + (size_t)k0 * ldw + srccol; d.ldw = ldw; d.nvalid = nvalid; d.dst = WT + (size_t)dstrow * ldk + k0; d.ldk = ldk; d.fp8s = 0.f; return d; }
__device__ __forceinline__ TrD mk_trd8(const float* W, size_t ldw, int srccol, int nvalid, unsigned char* WT8, size_t ldk, int dstrow, int k0, float scale) {
    TrD d; d.src = W + (size_t)k0 * ldw + srccol; d.ldw = ldw; d.nvalid = nvalid; d.dst = (bf16_t*)(WT8 + (size_t)dstrow * ldk + k0); d.ldk = ldk; d.fp8s = scale; return d; }
__device__ __forceinline__ TrD dec_small(const Args& a, int it) {
    constexpr int I_WIN = 184 * 16, I_CW1 = 2 * 8 * 32, I_WUN = 32 * 8, I_WUD = 32 * 4, I_WO = 32 * 16, I_CW2 = 2 * 2 * 4;
    constexpr int PER = I_WIN + I_CW1 + I_WUN + I_WUD + I_WO + I_CW2;
    unsigned char* ws = a.ws;
    const int l = it / PER; int r = it % PER;
    if (r < I_WIN) { const int nb = r / 16, kb = r % 16; const int nd = 32 * nb; int src, nv = 32;
        if (nd < 1280) src = nd; else if (nd < 5632) src = nd + 24; else if (nd == 5632) { src = 1280; nv = 24; } else { src = 0; nv = 0; }
        return mk_trd8(a.w_in + (size_t)l * DM * INW, INW, src, nv, (unsigned char*)(ws + WS_WINT) + (size_t)l * NIN * DM, DM, nd, 64 * kb, 256.0f); }
    r -= I_WIN;
    if (r < I_CW1) { const int kv = r / 256, q = r % 256, nb = q / 32, kb = q % 32;
        return mk_trd(a.cmp_w1 + (size_t)(l * 2 + kv) * 2048 * 256, 256, 32 * nb, 32, (bf16_t*)(ws + WS_CW1T) + (size_t)(l * 2 + kv) * 256 * 2048, 2048, 32 * nb, 64 * kb); }
    r -= I_CW1;
    if (r < I_WUN) { const int nb = r / 8, kb = r % 8;
        return mk_trd(a.w_up_nsa + (size_t)l * 512 * 1024, 1024, 32 * nb, 32, (bf16_t*)(ws + WS_WUNT) + (size_t)l * 1024 * 512, 512, 32 * nb, 64 * kb); }
    r -= I_WUN;
    if (r < I_WUD) { const int nb = r / 4, kb = r % 4;
        return mk_trd(a.w_up_dil + (size_t)l * 256 * 1024, 1024, 32 * nb, 32, (bf16_t*)(ws + WS_WUDT) + (size_t)l * 1024 * 256, 256, 32 * nb, 64 * kb); }
    r -= I_WUD;
    if (r < I_WO) { const int nb = r / 16, kb = r % 16;
        return mk_trd(a.w_o + (size_t)l * 1024 * 1024, 1024, 32 * nb, 32, (bf16_t*)(ws + WS_WOT) + (size_t)l * 1024 * 1024, 1024, 32 * nb, 64 * kb); }
    r -= I_WO;
    { const int kv = r / 8, q = r % 8, nb = q / 4, kb = q % 4;
        return mk_trd(a.cmp_w2 + (size_t)(l * 2 + kv) * 256 * 64, 64, 32 * nb, 32, (bf16_t*)(ws + WS_CW2T) + (size_t)(l * 2 + kv) * 64 * 256, 256, 32 * nb, 64 * kb); }
}
__device__ __forceinline__ TrD dec_expert(const Args& a, int l, int it) {
    constexpr int I_13 = 32 * 16, I_2 = 32 * 8, PER = I_13 + I_2;
    unsigned char* ws = a.ws;
    const int e = it / PER; int r = it % PER;
    if (r < I_13) { const int nb = r / 16, kb = r % 16; const int r0 = 32 * nb, pn = r0 >> 8, bj = (r0 >> 7) & 1, j0 = r0 & 127;
        const float* src = (bj ? a.exp_w3 : a.exp_w1) + (size_t)(l * 32 + e) * 1024 * 512;
        return mk_trd8(src, 512, pn * 128 + j0, 32, (unsigned char*)(ws + WS_E13T) + (size_t)e * 1024 * 1024, 1024, r0, 64 * kb, 256.0f); }
    r -= I_13;
    { const int nb = r / 8, kb = r % 8;
        return mk_trd8(a.exp_w2 + (size_t)(l * 32 + e) * 512 * 1024, 1024, 32 * nb, 32, (unsigned char*)(ws + WS_E2T) + (size_t)e * 1024 * 512, 512, 32 * nb, 64 * kb, 256.0f); }
}
template <int KIND> __device__ __forceinline__ void conv_items(const Args& a, const Ctx& C, int l, int first, int nitems, LAS float* scr) {
    const int NGW = C.G * NWAVES;
    float va[32], vb[32]; TrD d0, d1;
    int it = first;
    if (it >= nitems) return;
    d0 = KIND ? dec_expert(a, l, it) : dec_small(a, it); tr_load(d0, va, C.lane);
    for (;;) {
        const int itn = it + NGW; const bool hn = itn < nitems;
        if (hn) { d1 = KIND ? dec_expert(a, l, itn) : dec_small(a, itn); tr_load(d1, vb, C.lane); }
        tr_store(d0, va, scr, C.lane);
        if (!hn) break;
        const int itnn = itn + NGW; const bool hnn = itnn < nitems;
        if (hnn) { d0 = KIND ? dec_expert(a, l, itnn) : dec_small(a, itnn); tr_load(d0, va, C.lane); }
        tr_store(d1, vb, scr, C.lane);
        if (!hnn) break;
        it = itnn;
    }
}
__device__ __forceinline__ void conv_small(const Args& a, const Ctx& C) { conv_items<0>(a, C, 0, C.vcu * NWAVES + C.wave, 2 * 4368, (LAS float*)(C.lds + C.wave * 16384)); }
__device__ __forceinline__ void conv_experts_slice(const Args& a, const Ctx& C, int l, int q) {
    const int NGW = C.G * NWAVES; const int per = 3 * NGW;
    LAS float* scr = (LAS float*)(C.lds + (C.wave < 5 ? C.wave * 8448 : att::L_OTA + (C.wave - 5) * 8448));
    const int lo = q * per, hi = (q == 3) ? 32 * 768 : ((q + 1) * per < 32 * 768 ? (q + 1) * per : 32 * 768);
    if (lo < hi) conv_items<1>(a, C, l, lo + C.vcu * NWAVES + C.wave, hi, scr);
}
__device__ __forceinline__ void prologue_vectors(const Args& a, const Ctx& C) {
    LAS float* sl = (LAS float*)(C.lds);
    LAS float* part = (LAS float*)(C.lds + 32768);
    for (int i = C.tid; i < 8 * 1024; i += NTHR) { const float v = a.c[i]; sl[i] = v * sigmoidf_(v); }
    __syncthreads();
    float* MOD = (float*)(a.ws + WS_MOD); float* CB1 = (float*)(a.ws + WS_CB1);
    for (int it = C.vcu; it < 192 + 16; it += C.G) {
        float acc[8];
#pragma unroll
        for (int b = 0; b < 8; ++b) acc[b] = 0.f;
        if (it < 192) { const int l = it / 96, col = (it % 96) * 64 + C.lane;
            const float* w = a.ada_w + (size_t)l * 1024 * 6144 + col;
            for (int k0 = 128 * C.wave; k0 < 128 * C.wave + 128; k0 += 32) { float wv[32];
#pragma unroll
                for (int j = 0; j < 32; ++j) wv[j] = w[(size_t)(k0 + j) * 6144];
#pragma unroll
                for (int j = 0; j < 32; ++j)
#pragma unroll
                    for (int b = 0; b < 8; ++b) acc[b] += sl[b * 1024 + k0 + j] * wv[j]; }
        } else { const int q = it - 192, lk = q / 4, col = (q % 4) * 64 + C.lane;
            const float* w = a.cmp_w1 + (size_t)lk * 2048 * 256 + col; const float* pos = a.cmp_pos + (size_t)lk * 2048;
            for (int k0 = 256 * C.wave; k0 < 256 * C.wave + 256; k0 += 32) { float wv[32];
#pragma unroll
                for (int j = 0; j < 32; ++j) wv[j] = w[(size_t)(k0 + j) * 256];
#pragma unroll
                for (int j = 0; j < 32; ++j) acc[0] += pos[k0 + j] * wv[j]; }
        }
        __syncthreads();
#pragma unroll
        for (int b = 0; b < 8; ++b) part[(C.wave * 8 + b) * 64 + C.lane] = acc[b];
        __syncthreads();
        if (C.wave == 0) {
            float tot[8];
#pragma unroll
            for (int b = 0; b < 8; ++b) { float t2 = 0.f;
#pragma unroll
                for (int w = 0; w < 8; ++w) t2 += part[(w * 8 + b) * 64 + C.lane];
                tot[b] = t2; }
            if (it < 192) { const int l = it / 96, col = (it % 96) * 64 + C.lane; const float bias = a.ada_b[l * 6144 + col];
#pragma unroll
                for (int b = 0; b < 8; ++b) MOD[(size_t)(l * 8 + b) * 6144 + col] = tot[b] + bias;
            } else { const int q = it - 192, lk = q / 4, col = (q % 4) * 64 + C.lane; CB1[lk * 256 + col] = tot[0]; }
        }
    }
    __syncthreads();
}

struct RowX { f32x4 v[4]; };
struct RowY { u32x2 y0[4], y1[4]; };
template <int KIND> __device__ __forceinline__ void ld_x(const Args& a, int row, int lane, RowX& X) {
    const float* xr = (KIND == 0 ? a.x : (const float*)a.out) + (size_t)row * 1024;
#pragma unroll
    for (int j = 0; j < 4; ++j) X.v[j] = *((const f32x4*)xr + lane + 64 * j);
}
__device__ __forceinline__ void ld_y(const Args& a, const u32x4& rec, int lane, RowY& Y) {
    const bf16_t* Yb = (const bf16_t*)(a.ws + WS_XS);
    const u32x2* y0 = (const u32x2*)(Yb + (size_t)rec.x * 1024) + lane; const u32x2* y1 = (const u32x2*)(Yb + (size_t)rec.y * 1024) + lane;
#pragma unroll
    for (int j = 0; j < 4; ++j) { Y.y0[j] = y0[64 * j]; Y.y1[j] = y1[64 * j]; }
}
struct ColV { f32x4 A[4], B[4], G2[4]; };
template <int KIND> __device__ __forceinline__ void row_finish(const Args& a, int row, int lane, RowX& X, const RowY& Y, const u32x4& rec, const ColV& V) {
    if (KIND != 0) {
        const float w0 = (ABL == 6) ? 0.f : __uint_as_float(rec.z), w1 = (ABL == 6) ? 0.f : __uint_as_float(rec.w);
#pragma unroll
        for (int j = 0; j < 4; ++j) { const u32x2 p = Y.y0[j], q = Y.y1[j]; const f32x4 gg = V.G2[j];
            X.v[j][0] += gg[0] * (w0 * bf_lo(p.x) + w1 * bf_lo(q.x)); X.v[j][1] += gg[1] * (w0 * bf_hi(p.x) + w1 * bf_hi(q.x));
            X.v[j][2] += gg[2] * (w0 * bf_lo(p.y) + w1 * bf_lo(q.y)); X.v[j][3] += gg[3] * (w0 * bf_hi(p.y) + w1 * bf_hi(q.y)); } }
    if (KIND == 1) {
#pragma unroll
        for (int j = 0; j < 4; ++j) *((f32x4*)(a.out + (size_t)row * 1024) + lane + 64 * j) = X.v[j]; }
    float ss = 0.f;
#pragma unroll
    for (int j = 0; j < 4; ++j) ss += (X.v[j][0] * X.v[j][0] + X.v[j][1] * X.v[j][1]) + (X.v[j][2] * X.v[j][2] + X.v[j][3] * X.v[j][3]);
    const float rstd = 1.0f / sqrtf(wave_sum(ss) * (1.0f / 1024.0f) + RMS_EPS);
    if (KIND == 2) {
#pragma unroll
        for (int j = 0; j < 4; ++j) *((f32x4*)(a.out + (size_t)row * 1024) + lane + 64 * j) = X.v[j] * rstd * V.A[j];
    } else { unsigned char* H = a.ws + WS_H;
#pragma unroll
        for (int j = 0; j < 4; ++j) { const f32x4 h = (X.v[j] * rstd * V.A[j] + V.B[j]) * 8.0f; unsigned w = (unsigned)__builtin_amdgcn_cvt_pk_fp8_f32(h[0], h[1], 0, false); w = (unsigned)__builtin_amdgcn_cvt_pk_fp8_f32(h[2], h[3], (int)w, true);
            *((unsigned*)(H + (size_t)row * 1024) + lane + 64 * j) = w; } }
}
template <int KIND> __device__ __forceinline__ void norm_rows(const Args& a, const Ctx& C, int l) {
    const int gw = C.vcu * NWAVES + C.wave, NGW = C.G * NWAVES, lane = C.lane;
    const int RPW = (T + NGW - 1) / NGW;
    const int rbeg = gw * RPW, rend = (rbeg + RPW < T) ? rbeg + RPW : T;
    if (rbeg >= T) return;
    const unsigned char* DEST = a.ws + WS_DEST; const float* MOD = (const float*)(a.ws + WS_MOD);
    RowX xa, xb; RowY ya, yb; u32x4 r0 = {}, r1 = {}, r2 = {};
    if (KIND != 0) { r0 = *(const u32x4*)(DEST + (size_t)rbeg * 16); if (rbeg + 1 < rend) r1 = *(const u32x4*)(DEST + (size_t)(rbeg + 1) * 16); }
    ld_x<KIND>(a, rbeg, lane, xa); if (KIND != 0) ld_y(a, r0, lane, ya);
    ColV V; int vb = -1;
    for (int row = rbeg; ; ) {
        const int rn = row + 1, rnn = row + 2; const bool hn = rn < rend;
        if (hn) { ld_x<KIND>(a, rn, lane, xb); if (KIND != 0) { ld_y(a, r1, lane, yb); if (rnn < rend) r2 = *(const u32x4*)(DEST + (size_t)rnn * 16); } }
        if ((row >> 12) != vb) { vb = row >> 12;
#pragma unroll
            for (int j = 0; j < 4; ++j) {
                if (KIND == 2) { V.A[j] = *((const f32x4*)a.norm_f + lane + 64 * j); V.B[j] = (f32x4){0.f, 0.f, 0.f, 0.f}; }
                else { const float* mb = MOD + (size_t)(l * 8 + vb) * 6144; const f32x4 g = *((const f32x4*)(a.norm1 + l * 1024) + lane + 64 * j), sc = *((const f32x4*)(mb + 1024) + lane + 64 * j);
                    V.A[j] = g * (sc + 1.0f); V.B[j] = *((const f32x4*)mb + lane + 64 * j); }
                if (KIND != 0) V.G2[j] = *((const f32x4*)(MOD + (size_t)((KIND == 1 ? 0 : 1) * 8 + vb) * 6144 + 5120) + lane + 64 * j); } }
        row_finish<KIND>(a, row, lane, xa, ya, r0, V);
        if (!hn) break;
        const bool hnn = rnn < rend;
        r0 = r1; r1 = r2;
        if (hnn) { ld_x<KIND>(a, rnn, lane, xa); if (KIND != 0) { ld_y(a, r1, lane, ya); if (rnn + 1 < rend) r2 = *(const u32x4*)(DEST + (size_t)(rnn + 1) * 16); } }
        if ((rn >> 12) != vb) { vb = rn >> 12;
#pragma unroll
            for (int j = 0; j < 4; ++j) {
                if (KIND == 2) { V.A[j] = *((const f32x4*)a.norm_f + lane + 64 * j); V.B[j] = (f32x4){0.f, 0.f, 0.f, 0.f}; }
                else { const float* mb = MOD + (size_t)(l * 8 + vb) * 6144; const f32x4 g = *((const f32x4*)(a.norm1 + l * 1024) + lane + 64 * j), sc = *((const f32x4*)(mb + 1024) + lane + 64 * j);
                    V.A[j] = g * (sc + 1.0f); V.B[j] = *((const f32x4*)mb + lane + 64 * j); }
                if (KIND != 0) V.G2[j] = *((const f32x4*)(MOD + (size_t)((KIND == 1 ? 0 : 1) * 8 + vb) * 6144 + 5120) + lane + 64 * j); } }
        row_finish<KIND>(a, rn, lane, xb, yb, r0, V);
        if (!hnn) break;
        r0 = r1; r1 = r2;
        row = rnn;
    }
}
__device__ __forceinline__ void norm1_phase(const Args& a, const Ctx& C, int l) { if (l == 0) norm_rows<0>(a, C, 0); else norm_rows<1>(a, C, 1); }
__device__ __forceinline__ void final_phase(const Args& a, const Ctx& C) { norm_rows<2>(a, C, 0); }
typedef float f32x4v __attribute__((ext_vector_type(4)));
__device__ __forceinline__ void norm2_router_phase(const Args& a, const Ctx& C, int l) {
    constexpr int RP = 2064;
    LAS unsigned char* HH = C.lds; LAS unsigned char* HL = C.lds + 16 * RP;
    LAS float* PART = (LAS float*)(C.lds + 2 * 16 * RP);
    LAS float* LOGI = PART + 8 * 16 * 48;
    LAS int* wcnt = (LAS int*)(C.lds + LDS_MISC + 256);
    const float* wg = a.router_wg + (size_t)l * 1024 * 4; const float* we = a.router_we + (size_t)l * 1024 * 32;
    const int lane = C.lane, wave = C.wave, fr = lane & 15, fq = lane >> 4;
    bf16x8 Wh[4][3], Wl[4][3];
#pragma unroll
    for (int ks = 0; ks < 4; ++ks)
#pragma unroll
        for (int ct = 0; ct < 3; ++ct) { const int cc = 16 * ct + fr; const int k0 = 128 * wave + 32 * ks + 8 * fq; unsigned hw[4], lw[4];
#pragma unroll
            for (int i = 0; i < 8; i += 2) { float v0 = 0.f, v1 = 0.f;
                if (cc < 4) { v0 = wg[(size_t)(k0 + i) * 4 + cc]; v1 = wg[(size_t)(k0 + i + 1) * 4 + cc]; }
                else if (cc < 36) { v0 = we[(size_t)(k0 + i) * 32 + cc - 4]; v1 = we[(size_t)(k0 + i + 1) * 32 + cc - 4]; }
                const unsigned hp = cvt_pk_bf16(v0, v1); hw[i >> 1] = hp; lw[i >> 1] = cvt_pk_bf16(v0 - bf_lo(hp), v1 - bf_hi(hp)); }
            Wh[ks][ct] = __builtin_bit_cast(bf16x8, (u32x4){hw[0], hw[1], hw[2], hw[3]}); Wl[ks][ct] = __builtin_bit_cast(bf16x8, (u32x4){lw[0], lw[1], lw[2], lw[3]}); }
    const float* MOD = (const float*)(a.ws + WS_MOD); bf16_t* H2 = (bf16_t*)(a.ws + WS_H2);
    const float* nw = a.norm2 + l * 1024; const float* bg = a.router_bg + l * 4; const float* be = a.router_be + l * 32;
    int* CNTBLK = (int*)(a.ws + WS_CNTBLK);
    for (int ch = C.vcu; ch < T / 128; ch += C.G) {
        int my_e0 = 0, my_e1 = 0; float my_w0 = 0.f, my_w1 = 0.f;
        f32x4 VA[4], VB[4];
        { const float* mb = MOD + (size_t)(l * 8 + ((ch * 128) >> 12)) * 6144 + 3072;
#pragma unroll
          for (int q = 0; q < 4; ++q) { const f32x4 g = *((const f32x4*)nw + lane + 64 * q), sc = *((const f32x4*)(mb + 1024) + lane + 64 * q); VA[q] = g * (sc + 1.0f); VB[q] = *((const f32x4*)mb + lane + 64 * q); } }
#pragma clang loop unroll(disable)
        for (int gi = 0; gi < 8; ++gi) {
            { const int row0 = ch * 128 + gi * 16 + 2 * wave;
              f32x4 v[2][4];
#pragma unroll
              for (int rr = 0; rr < 2; ++rr)
#pragma unroll
                  for (int q = 0; q < 4; ++q) v[rr][q] = *((const f32x4*)(a.out + (size_t)(row0 + rr) * 1024) + lane + 64 * q);
#pragma unroll
              for (int rr = 0; rr < 2; ++rr) { float ss = 0.f;
#pragma unroll
                  for (int q = 0; q < 4; ++q) ss += (v[rr][q][0] * v[rr][q][0] + v[rr][q][1] * v[rr][q][1]) + (v[rr][q][2] * v[rr][q][2] + v[rr][q][3] * v[rr][q][3]);
                  const float rstd = 1.0f / sqrtf(wave_sum(ss) * (1.0f / 1024.0f) + RMS_EPS);
#pragma unroll
                  for (int q = 0; q < 4; ++q) {
                      const f32x4 h = v[rr][q] * rstd * VA[q] + VB[q];
                      u32x2 hw; hw.x = cvt_pk_bf16(h[0], h[1]); hw.y = cvt_pk_bf16(h[2], h[3]);
                      u32x2 lw; lw.x = cvt_pk_bf16(h[0] - bf_lo(hw.x), h[1] - bf_hi(hw.x)); lw.y = cvt_pk_bf16(h[2] - bf_lo(hw.y), h[3] - bf_hi(hw.y));
                      { unsigned w8 = (unsigned)__builtin_amdgcn_cvt_pk_fp8_f32(h[0] * 8.0f, h[1] * 8.0f, 0, false); w8 = (unsigned)__builtin_amdgcn_cvt_pk_fp8_f32(h[2] * 8.0f, h[3] * 8.0f, (int)w8, true);
                        *((unsigned*)((unsigned char*)H2 + (size_t)(row0 + rr) * 1024) + lane + 64 * q) = w8; }
                      *(LAS u32x2*)(HH + (2 * wave + rr) * RP + (4 * lane + 256 * q) * 2) = hw; *(LAS u32x2*)(HL + (2 * wave + rr) * RP + (4 * lane + 256 * q) * 2) = lw; } }
            }
            __syncthreads();
            { f32x4v acc[3]; acc[0] = (f32x4v){0.f, 0.f, 0.f, 0.f}; acc[1] = acc[0]; acc[2] = acc[0];
#pragma unroll
              for (int ks = 0; ks < 4; ++ks) { const int ko = (128 * wave + 32 * ks + 8 * fq) * 2;
                  const bf16x8 ah = *(const LAS bf16x8*)(HH + fr * RP + ko), al = *(const LAS bf16x8*)(HL + fr * RP + ko);
#pragma unroll
                  for (int ct = 0; ct < 3; ++ct) { acc[ct] = __builtin_amdgcn_mfma_f32_16x16x32_bf16(Wh[ks][ct], ah, acc[ct], 0, 0, 0);
                      acc[ct] = __builtin_amdgcn_mfma_f32_16x16x32_bf16(Wh[ks][ct], al, acc[ct], 0, 0, 0); acc[ct] = __builtin_amdgcn_mfma_f32_16x16x32_bf16(Wl[ks][ct], ah, acc[ct], 0, 0, 0); } }
#pragma unroll
              for (int ct = 0; ct < 3; ++ct) *(LAS f32x4v*)(PART + (wave * 16 + fr) * 48 + 16 * ct + 4 * fq) = acc[ct]; }
            __syncthreads();
            { const int row = C.tid >> 5, c = C.tid & 31;
              { float sacc = 0.f;
#pragma unroll
                for (int w = 0; w < 8; ++w) sacc += PART[(w * 16 + row) * 48 + c];
                LOGI[row * 48 + c] = sacc + (c < 4 ? bg[c] : be[c - 4]); }
              if (c < 4) { float sacc = 0.f;
#pragma unroll
                for (int w = 0; w < 8; ++w) sacc += PART[(w * 16 + row) * 48 + 32 + c];
                LOGI[row * 48 + 32 + c] = sacc + be[28 + c]; } }
            __syncthreads();
            if (wave == gi && lane < 16) { const LAS float* lg = LOGI + lane * 48;
                int grp = 0; float gmax = lg[0];
#pragma unroll
                for (int c = 1; c < 4; ++c) if (lg[c] > gmax) { gmax = lg[c]; grp = c; }
                float gs = 0.f;
#pragma unroll
                for (int c = 0; c < 4; ++c) gs += __builtin_amdgcn_exp2f((lg[c] - gmax) * LOG2E);
                const float pgrp = 1.0f / gs;
                float le[8];
#pragma unroll
                for (int e = 0; e < 8; ++e) le[e] = lg[4 + grp * 8 + e];
                int i0 = 0; float v0 = le[0];
#pragma unroll
                for (int e = 1; e < 8; ++e) if (le[e] > v0) { v0 = le[e]; i0 = e; }
                int i1 = -1; float v1 = -INFINITY;
#pragma unroll
                for (int e = 0; e < 8; ++e) if (e != i0 && le[e] > v1) { v1 = le[e]; i1 = e; }
                const float ex = __builtin_amdgcn_exp2f((v1 - v0) * LOG2E);
                my_e0 = grp * 8 + i0; my_e1 = grp * 8 + i1; my_w0 = pgrp / (1.0f + ex); my_w1 = pgrp * ex / (1.0f + ex); }
        }
        const int ea = bperm_i(C.lane >> 1, my_e0), eb = bperm_i(C.lane >> 1, my_e1);
        const int es = (C.lane < 32) ? ((C.lane & 1) ? eb : ea) : -1;
        int rank = 0, cnt = 0;
#pragma unroll
        for (int s2 = 0; s2 < 32; ++s2) { const int v = __builtin_amdgcn_readlane(es, s2); rank += (v == es && s2 < C.lane) ? 1 : 0; cnt += (v == C.lane) ? 1 : 0; }
        __syncthreads();
        if (C.lane < 32) wcnt[C.wave * 32 + C.lane] = cnt;
        __syncthreads();
        int lrank = rank;
        if (C.lane < 32) { for (int w = 0; w < C.wave; ++w) lrank += wcnt[w * 32 + es]; }
        if (C.wave == 0 && C.lane < 32) { int tot = 0;
#pragma unroll
            for (int w = 0; w < 8; ++w) tot += wcnt[w * 32 + C.lane];
            CNTBLK[ch * 32 + C.lane] = tot; }
        const int lr0 = bperm_i((2 * C.lane) & 63, lrank), lr1 = bperm_i((2 * C.lane + 1) & 63, lrank);
        if (C.lane < 16) { const int row = ch * 128 + C.wave * 16 + C.lane;
            u32x4 rec; rec.x = (unsigned)my_e0 | ((unsigned)my_e1 << 8); rec.y = (unsigned)lr0 | ((unsigned)lr1 << 16); rec.z = __float_as_uint(my_w0); rec.w = __float_as_uint(my_w1);
            *(u32x4*)(a.ws + WS_REC + (size_t)row * 16) = rec; }
    }
}
__device__ __forceinline__ void moe_scatter_phase(const Args& a, const Ctx& C) {
    LAS int* part_lt = (LAS int*)(C.lds);
    LAS int* part_all = part_lt + 512;
    LAS int* base = part_all + 512;
    LAS int* tot = base + 32;
    LAS int* pst = tot + 32;
    const int* CNTBLK = (const int*)(a.ws + WS_CNTBLK);
    int* TILEE = (int*)(a.ws + WS_TILEE);
    int* TOKL = (int*)(a.ws + WS_TOKL);
    for (int ch = C.vcu; ch < T / 128; ch += C.G) {
        __syncthreads();
        { const int e = C.tid & 31, p = C.tid >> 5; int slt = 0, sall = 0;
            for (int c = p; c < T / 128; c += 16) { const int v = CNTBLK[c * 32 + e]; sall += v; slt += (c < ch) ? v : 0; }
            part_lt[p * 32 + e] = slt; part_all[p * 32 + e] = sall; }
        __syncthreads();
        if (C.tid < 32) { int b = 0, t2 = 0;
#pragma unroll
            for (int p = 0; p < 16; ++p) { b += part_lt[p * 32 + C.tid]; t2 += part_all[p * 32 + C.tid]; }
            base[C.tid] = b; tot[C.tid] = t2; }
        __syncthreads();
        if (C.tid < 32) { int ps = 0; for (int e = 0; e < C.tid; ++e) ps += (tot[e] + 255) & ~255; pst[C.tid] = ps;
            if (ch == 0) { const int nt = (tot[C.tid] + 255) >> 8; const int t0 = ps >> 8; for (int m = 0; m < nt; ++m) TILEE[16 + t0 + m] = C.tid; if (C.tid == 31) TILEE[0] = t0 + nt; } }
        __syncthreads();
        int d0 = 0, d1 = 0;
        if (C.lane < 16) { const int row = ch * 128 + C.wave * 16 + C.lane;
            const u32x4 rec = *(const u32x4*)(a.ws + WS_REC + (size_t)row * 16);
            const int e0 = rec.x & 255, e1 = (rec.x >> 8) & 255;
            d0 = pst[e0] + base[e0] + (int)(rec.y & 0xffffu); d1 = pst[e1] + base[e1] + (int)(rec.y >> 16);
            u32x4 o; o.x = (unsigned)d0; o.y = (unsigned)d1; o.z = rec.z; o.w = rec.w;
            *(u32x4*)(a.ws + WS_DEST + (size_t)row * 16) = o; }
        if (C.lane < 16) { const int row = ch * 128 + C.wave * 16 + C.lane; TOKL[d0] = row; TOKL[d1] = row; }
        if (ch == 0) {
            for (int e = 0; e < 32; ++e) { const int lo = pst[e] + tot[e], hi = pst[e] + ((tot[e] + 255) & ~255);
                for (int k = lo + C.tid; k < hi; k += NTHR) TOKL[k] = 0; } }
    }
}
struct MoeOrder {
    int G, c, nu; int ex[8]; const char* A; const char* B; size_t tA, tB, eB;
    __device__ __forceinline__ bool next(int i, pg8::Unit& u) const {
        const int L = i * G + c; if (i >= 8 || L >= nu) return false;
        const int e = i == 0 ? ex[0] : i == 1 ? ex[1] : i == 2 ? ex[2] : i == 3 ? ex[3] : i == 4 ? ex[4] : i == 5 ? ex[5] : i == 6 ? ex[6] : ex[7];
        u.pm = L >> 2; u.pn = L & 3; u.A = A + (size_t)u.pm * tA; u.B = B + (size_t)e * eB + (size_t)u.pn * tB; return true;
    }
};

__device__ __forceinline__ void dil_unit(const Args& a, const Ctx& C, int du) {
    using namespace att;
    LAS unsigned char* lds = C.lds;
    const int x = du & 15; int r = du >> 4; const int h = r & 3; r >>= 2; const int grp = r % 3, b = r / 3;
    const int dsh = 2 * grp, d = 1 << dsh; const int nub = 16 >> dsh; const int res = x / nub, ub = x % nub;
    const int wid = C.wave, lane = C.lane, r32 = lane & 31, hi = lane >> 5;
    LAS float* lut = (LAS float*)(lds + L_LUT);
    LAS unsigned char* tl = lds + L_SEL + 768;
    __syncthreads();
    for (int e = C.tid; e < 704; e += NTHR) { const int m = 384 - e; float v = -INFINITY;
        if (m >= 0 && m <= 128) { int di = m << dsh; di = di > 4095 ? 4095 : di; v = a.rel_bias[(int)lds[L_BKT + di] * 20 + 8 + grp * 4 + h] * LOG2E; }
        lut[e] = v; }
    if (C.tid < 6) { const int kt = 4 * ub - 2 + C.tid; tl[C.tid] = (unsigned char)(kt < 0 ? 0x80 : kt); }
    const bf16_t* QKV = (const bf16_t*)(a.ws + WS_A);
    const int u = 256 * ub + 32 * wid + r32; const size_t tokq = (size_t)b * SEQ + (size_t)u * d + res;
    const bf16_t* qp = QKV + tokq * LDQ + 1280 + grp * 256 + h * 64;
    bf16x8 qr[4];
#pragma unroll
    for (int d0 = 0; d0 < 4; ++d0) qr[d0] = *(const bf16x8*)(qp + d0 * 16 + hi * 8);
    __syncthreads();
    StreamP S; S.Kb = QKV + ((size_t)b * SEQ + res) * LDQ + 1280 + 768 + grp * 256 + h * 64; S.Vb = S.Kb + 768; S.pitch = (long)d * LDQ;
    S.NT = 6; S.tl = tl; S.lanesel = ~0ull; S.uq = u; S.lut = lut; S.xtop = 384; S.dclamp = 1 << 30;
    float m = 0.f, l = 0.f; f32x16 o[2];
    attn_stream<8>(lds, wid, lane, qr, S, m, l, o);
    l = xhalf_sum(l);
    LAS float* wsf = (LAS float*)(lds + L_WSF) + wid * 64;
    if (hi == 0) { wsf[r32] = l > 0.f ? 1.0f / l : 0.f; ((float*)(a.ws + WS_LSE))[((size_t)grp * T + tokq) * 4 + h] = m + __builtin_amdgcn_logf(l); }
    LDS_WAIT();
#pragma unroll
    for (int rr = 0; rr < 16; ++rr) { const float f = wsf[crow(rr, hi)]; o[0][rr] *= f; o[1][rr] *= f; }
    stage_rows(lds, wid, lane, o);
    bf16_t* ODP = (bf16_t*)(a.ws + WS_ODP) + (size_t)grp * T * 256;
    const LAS bf16_t* stg = (const LAS bf16_t*)(lds + L_OTA) + wid * 2048;
#pragma unroll
    for (int i = 0; i < 4; ++i) { const int row = i * 8 + (lane >> 3), chn = lane & 7; const u32x4 v = *(const LAS u32x4*)(stg + row * 64 + chn * 8);
        const size_t tok = (size_t)b * SEQ + (size_t)(256 * ub + 32 * wid + row) * d + res;
        *(u32x4*)(ODP + tok * 256 + h * 64 + chn * 8) = v; }
}
__device__ __forceinline__ void dil_combine(const Args& a, const Ctx& C) {
    const float* LSE = (const float*)(a.ws + WS_LSE); const bf16_t* ODP = (const bf16_t*)(a.ws + WS_ODP); bf16_t* ODIL = (bf16_t*)(a.ws + WS_ODIL);
    const int gt = C.vcu * NTHR + C.tid, NT = C.G * NTHR;
    for (int idx = gt; idx < T * 32; idx += NT) {
        const int tok = idx >> 5, h = (idx >> 3) & 3, chn = idx & 7;
        const float l0 = LSE[((size_t)0 * T + tok) * 4 + h], l1 = LSE[((size_t)1 * T + tok) * 4 + h], l2 = LSE[((size_t)2 * T + tok) * 4 + h];
        const float mx = __builtin_fmaxf(l0, __builtin_fmaxf(l1, l2));
        float w0 = __builtin_amdgcn_exp2f(l0 - mx), w1 = __builtin_amdgcn_exp2f(l1 - mx), w2 = __builtin_amdgcn_exp2f(l2 - mx);
        const float inv = 1.0f / (w0 + w1 + w2); w0 *= inv; w1 *= inv; w2 *= inv;
        const size_t off = (size_t)tok * 256 + h * 64 + chn * 8;
        const u32x4 a0 = *(const u32x4*)(ODP + off), a1 = *(const u32x4*)(ODP + (size_t)T * 256 + off), a2 = *(const u32x4*)(ODP + (size_t)2 * T * 256 + off);
        u32x4 o;
        o.x = cvt_pk_bf16(w0 * bf_lo(a0.x) + w1 * bf_lo(a1.x) + w2 * bf_lo(a2.x), w0 * bf_hi(a0.x) + w1 * bf_hi(a1.x) + w2 * bf_hi(a2.x));
        o.y = cvt_pk_bf16(w0 * bf_lo(a0.y) + w1 * bf_lo(a1.y) + w2 * bf_lo(a2.y), w0 * bf_hi(a0.y) + w1 * bf_hi(a1.y) + w2 * bf_hi(a2.y));
        o.z = cvt_pk_bf16(w0 * bf_lo(a0.z) + w1 * bf_lo(a1.z) + w2 * bf_lo(a2.z), w0 * bf_hi(a0.z) + w1 * bf_hi(a1.z) + w2 * bf_hi(a2.z));
        o.w = cvt_pk_bf16(w0 * bf_lo(a0.w) + w1 * bf_lo(a1.w) + w2 * bf_lo(a2.w), w0 * bf_hi(a0.w) + w1 * bf_hi(a1.w) + w2 * bf_hi(a2.w));
        if (ABL == 4) o = (u32x4){0u, 0u, 0u, 0u};
        *(u32x4*)(ODIL + off) = o;
    }
}
template <bool INIT>
__device__ __forceinline__ void ota_update(LAS bf16_t* ota  , const LAS float* frow, int hi, const f32x16 (&o)[2]) {
#pragma unroll
    for (int r = 0; r < 16; ++r) { const int row = crow(r, hi); const float f = frow[row];
        float v0 = f * o[0][r], v1 = f * o[1][r];
        if (!INIT) { v0 += __uint_as_float((unsigned)ota[row * 64] << 16); v1 += __uint_as_float((unsigned)ota[row * 64 + 32] << 16); }
        ota[row * 64] = (bf16_t)(cvt_pk_bf16(v0, 0.f) & 0xffffu); ota[row * 64 + 32] = (bf16_t)(cvt_pk_bf16(v1, 0.f) & 0xffffu); }
}
#define NSA_T0(which) do { if (TNSA == (which) && blockIdx.x == 0 && wid == 0 && lane_id_fresh() == 0) { volatile LAS unsigned* M_ = (volatile LAS unsigned*)(lds + LDS_MISC); const unsigned long long t_ = __builtin_amdgcn_s_memrealtime(); M_[20] = (unsigned)t_; M_[21] = (unsigned)(t_ >> 32); } } while (0)
#define NSA_T1(which) do { if (TNSA == (which) && blockIdx.x == 0 && wid == 0 && lane_id_fresh() == 0) { volatile LAS unsigned* M_ = (volatile LAS unsigned*)(lds + LDS_MISC); const unsigned long long t_ = __builtin_amdgcn_s_memrealtime(); const unsigned long long t0_ = ((unsigned long long)M_[21] << 32) | M_[20]; \
        const unsigned long long d_ = (((unsigned long long)M_[23] << 32) | M_[22]) + (t_ - t0_); M_[22] = (unsigned)d_; M_[23] = (unsigned)(d_ >> 32); } } while (0)
#define NSA_SECT() const int lane = lane_id_fresh(); const int tid = wid * 64 + lane; const int r32 = lane & 31, hi = lane >> 5; (void)tid; (void)r32; (void)hi
__device__ __forceinline__ void nsa_unit(const Args& a, const Ctx& C, int b, int hk, int i) {
    using namespace att;
    LAS unsigned char* lds = C.lds;
    const int wid = C.wave; const int g = wid >> 1;
    const bf16_t* QKV = (const bf16_t*)(a.ws + WS_A);
    bf16x8 qr[4];
    f32x16 o[2];
    __syncthreads();
    NSA_T0(2);
    { NSA_SECT();
        const int tq = (wid & 1) * 32 + r32, t = 64 * i + tq; const size_t tok = (size_t)b * SEQ + t;
        LAS float* imp = (LAS float*)(lds + L_IMP); LAS float* gsh = (LAS float*)(lds + L_GSH) + wid * 96; LAS unsigned* selw = (LAS unsigned*)(lds + L_SEL);
        const bf16_t* KC = (const bf16_t*)(a.ws + WS_KC); const int nt = (4 * i + 2) / 64 + 1;
        cmp_issue(lds, wid, lane, KC + (size_t)((0 * 8 + b) * 2 + hk) * 256 * 64, KC + (size_t)((1 * 8 + b) * 2 + hk) * 256 * 64, nt);
        const bf16_t* qp = QKV + tok * LDQ + hk * 256 + g * 64;
#pragma unroll
        for (int d0 = 0; d0 < 4; ++d0) qr[d0] = *(const bf16x8*)(qp + d0 * 16 + hi * 8);
        float g0 = 0.f, g1 = 0.f, g2 = 0.f;
        if (hi == 0) { const float* gn = (const float*)(a.ws + WS_GN) + tok * 32 + hk * 4 + g; g0 = gn[0]; g1 = gn[8]; g2 = gn[16]; }
        for (int e = tid; e < 64 * 64; e += NTHR) imp[e] = 0.f;
        if (tid < 2) selw[128 + tid] = 0u;
        if (hi == 0) { gsh[r32] = (ABL == 1) ? 0.f : g0; gsh[32 + r32] = (ABL == 2) ? 0.f : g1; gsh[64 + r32] = (ABL == 3) ? 0.f : g2; }
        cmp_branch(lds, wid, lane, qr, nt, t, o);
        ota_update<true>((LAS bf16_t*)(lds + L_OTA) + wid * 2048 + r32, gsh, hi, o);
    }
    __syncthreads();
    NSA_T1(2);
    { NSA_SECT();
        LAS float* impP = (LAS float*)(lds + L_IMP); LAS unsigned* selw = (LAS unsigned*)(lds + L_SEL);
        const int q = tid >> 3, part = tid & 7;
        const int ncand = i - 2 > 0 ? i - 2 : 0; const int nforced = i + 1 < 3 ? i + 1 : 3; const int krem = 16 - nforced;
        unsigned bits = 0u;
        if (ncand > krem && ABL != 5) {
            float vn[8]; int cn[8];
#pragma unroll
            for (int e = 0; e < 8; ++e) { vn[e] = impP[q * 64 + part * 8 + e]; cn[e] = 0; }
#pragma unroll 4
            for (int mm = 1; mm <= i - 2; ++mm) { const float xv = impP[q * 64 + mm];
#pragma unroll
                for (int e = 0; e < 8; ++e) { const int n = part * 8 + e; cn[e] += (xv > vn[e] || (xv == vn[e] && mm < n)) ? 1 : 0; } }
#pragma unroll
            for (int e = 0; e < 8; ++e) { const int n = part * 8 + e; if (n >= 1 && n <= i - 2 && cn[e] < krem) bits |= 1u << e; }
        } else {
#pragma unroll
            for (int e = 0; e < 8; ++e) { const int n = part * 8 + e; if (n >= 1 && n <= i - 2) bits |= 1u << e; }
        }
#pragma unroll
        for (int e = 0; e < 8; ++e) { const int n = part * 8 + e; if (n == 0 || n == i || n == i - 1) bits |= 1u << e; }
        unsigned lo = part < 4 ? bits << (8 * part) : 0u, hi2 = part >= 4 ? bits << (8 * (part - 4)) : 0u;
        lo |= swz_xor_u<1>(lo); hi2 |= swz_xor_u<1>(hi2); lo |= swz_xor_u<2>(lo); hi2 |= swz_xor_u<2>(hi2); lo |= swz_xor_u<4>(lo); hi2 |= swz_xor_u<4>(hi2);
        if (part == 0) { selw[2 * q] = lo; selw[2 * q + 1] = hi2; atomicOr((unsigned*)&selw[128], lo); atomicOr((unsigned*)&selw[129], hi2); }
    }
    __syncthreads();
    int NTS, NTW;
    { NSA_SECT();
        LAS unsigned* selw = (LAS unsigned*)(lds + L_SEL);
        LAS unsigned char* tls = lds + L_SEL + 768; LAS unsigned char* tlw = lds + L_SEL + 848;
        const unsigned long long uni = ((unsigned long long)(unsigned)__builtin_amdgcn_readfirstlane((int)selw[129]) << 32) | (unsigned)__builtin_amdgcn_readfirstlane((int)selw[128]);
        const int nsel = __builtin_popcountll(uni); const int nts = (nsel + 1) & ~1; NTS = nts < 4 ? 4 : nts;
        const int jlo = i - 8 < 0 ? 0 : i - 8; const int nwin = i - jlo + 1; const int ntw = (nwin + 1) & ~1; NTW = ntw < 4 ? 4 : ntw;
        if (tid < 64) { if ((uni >> tid) & 1ull) tls[__builtin_popcountll(uni & ((1ull << tid) - 1ull))] = (unsigned char)tid; }
        else if (tid < 72) { const int k = nsel + (tid - 64); if (k < NTS) tls[k] = 0x80; }
        else if (tid < 88) { const int k = tid - 72; if (k < NTW) tlw[k] = (unsigned char)(k < nwin ? jlo + k : 0x80); }
    }
    __syncthreads();
    NSA_T0(1);
#pragma clang loop unroll(disable)
    for (int br = 0; br < 2; ++br) {
        float m = 0.f, l = 0.f;
        { NSA_SECT();
            const int tq = (wid & 1) * 32 + r32, t = 64 * i + tq;
            LAS unsigned* selw = (LAS unsigned*)(lds + L_SEL); LAS float* lut = (LAS float*)(lds + L_LUT);
            StreamP S; S.Kb = QKV + (size_t)b * SEQ * LDQ + 512 + 256 + br * 256 + hk * 64; S.Vb = S.Kb + 128; S.pitch = LDQ;
            S.NT = br ? NTW : NTS; S.tl = lds + L_SEL + (br ? 848 : 768); S.uq = t;
            S.lanesel = br ? ~0ull : (((unsigned long long)selw[2 * tq + 1] << 32) | selw[2 * tq]);
            S.lut = br ? lut + 7168 + g * 768 : lut + g * 1792; S.xtop = br ? 640 : 1636; S.dclamp = br ? (1 << 30) : 1636;
            attn_stream<8>(lds, wid, lane, qr, S, m, l, o);
        }
        { NSA_SECT();
            LAS float* gsh = (LAS float*)(lds + L_GSH) + wid * 96; LAS float* wsf = (LAS float*)(lds + L_WSF) + wid * 64;
            l = xhalf_sum(l);
            LDS_WAIT();
            if (hi == 0) wsf[r32] = (l > 0.f ? 1.0f / l : 0.f) * gsh[32 + br * 32 + r32];
            LDS_WAIT();
            ota_update<false>((LAS bf16_t*)(lds + L_OTA) + wid * 2048 + r32, wsf, hi, o);
        }
    }
    NSA_T1(1);
    { NSA_SECT();
        LDS_WAIT();
        bf16_t* ONSA = (bf16_t*)(a.ws + WS_ONSA);
        const LAS bf16_t* stg = (const LAS bf16_t*)(lds + L_OTA) + wid * 2048;
#pragma unroll
        for (int k = 0; k < 4; ++k) { const int row = k * 8 + (lane >> 3), chn = lane & 7; const u32x4 v = *(const LAS u32x4*)(stg + row * 64 + chn * 8);
            const size_t tk = (size_t)b * SEQ + 64 * i + (wid & 1) * 32 + row;
            *(u32x4*)(ONSA + tk * 512 + hk * 256 + g * 64 + chn * 8) = v; }
    }
}
__device__ __forceinline__ void build_bkt(const Ctx& C) {
    LAS unsigned char* bkt = C.lds + att::L_BKT; LAS unsigned char* bkc = C.lds + att::L_BKC;
    for (int d = C.tid; d < 4096; d += NTHR) bkt[d] = (unsigned char)att::bucket_of(d);
    for (int x = C.tid; x < 8704; x += NTHR) { const int dist = 4095 - x; bkc[x] = (unsigned char)(dist < 0 ? 128 : 4 * att::bucket_of(dist)); }
    __syncthreads();
}
__device__ __forceinline__ void build_nsa_tables(const Args& a, const Ctx& C, int hk) {
    using namespace att;
    LAS float* tbh = (LAS float*)(C.lds + L_TBH); LAS float* lut = (LAS float*)(C.lds + L_LUT);
    __syncthreads();
    if (C.tid < 144) { const int gg = C.tid / 36, bk = C.tid % 36; tbh[C.tid] = bk < 32 ? a.rel_bias[bk * 20 + hk * 4 + gg] * LOG2E : -INFINITY; }
    __syncthreads();
    for (int e = C.tid; e < 4 * 1792; e += NTHR) { const int gg = e / 1792, xx = e % 1792; const int dist = 1636 - xx;
        lut[e] = dist < 0 ? -INFINITY : tbh[gg * 36 + (int)C.lds[L_BKT + dist]]; }
    for (int e = C.tid; e < 4 * 768; e += NTHR) { const int gg = e / 768, xx = e % 768; const int dist = 640 - xx;
        lut[7168 + e] = (dist < 0 || dist > 512) ? -INFINITY : tbh[gg * 36 + (int)C.lds[L_BKT + dist]]; }
    __syncthreads();
}

typedef const Args __attribute__((address_space(4)))* CArgsP;
__device__ __forceinline__ Args load_args() {
#if defined(__HIP_DEVICE_COMPILE__)
    CArgsP p = (CArgsP)__builtin_amdgcn_kernarg_segment_ptr(); asm volatile("" : "+s"(p)); Args a;
    a.x = p->x; a.c = p->c; a.rel_bias = p->rel_bias; a.ada_w = p->ada_w; a.ada_b = p->ada_b; a.norm1 = p->norm1; a.norm2 = p->norm2; a.w_in = p->w_in;
    a.cmp_pos = p->cmp_pos; a.cmp_w1 = p->cmp_w1; a.cmp_w2 = p->cmp_w2; a.w_up_nsa = p->w_up_nsa; a.w_up_dil = p->w_up_dil; a.w_o = p->w_o;
    a.router_wg = p->router_wg; a.router_bg = p->router_bg; a.router_we = p->router_we; a.router_be = p->router_be; a.exp_w1 = p->exp_w1; a.exp_w3 = p->exp_w3; a.exp_w2 = p->exp_w2; a.norm_f = p->norm_f;
    a.out = p->out; a.ws = p->ws; a.ph_lo = p->ph_lo; a.ph_hi = p->ph_hi; a.use_bar = p->use_bar; a.pad = 0;
    return a;
#else
    return Args{};
#endif
}
#define LOADA() const Args a = load_args()
__global__ void __launch_bounds__(NTHR, 2) fwd_kernel(Args a_) {
    extern __shared__ __attribute__((aligned(16))) unsigned char lds_raw[];
    LAS unsigned char* const lds_base = (LAS unsigned char*)lds_raw;
    const int wave0_ = __builtin_amdgcn_readfirstlane((int)threadIdx.x >> 6);
#define FRESH() Ctx C; { int w_ = wave0_; asm volatile("" : "+s"(w_)); int t_ = lane_id_fresh(); asm volatile("" : "+v"(t_)); t_ += w_ * 64; int g_ = gridDim.x, b_ = blockIdx.x; asm volatile("" : "+s"(g_), "+s"(b_)); \
        C.lds = lds_base; C.tid = t_; C.lane = t_ & 63; C.wave = w_; C.G = g_; C.bx = b_; C.vcu = (g_ % 8 == 0) ? (b_ % 8) * (g_ / 8) + b_ / 8 : b_; }
    volatile LAS unsigned* MISC = (volatile LAS unsigned*)(lds_base + LDS_MISC);
    if (threadIdx.x < 64) MISC[threadIdx.x] = 0u;
    __syncthreads();
    unsigned* ctl = (unsigned*)(a_.ws + WS_CTL);
    XcdBarrier bar; bar.bar = ctl + CW_BAR; bar.x = 0; bar.st = nullptr;
    if (a_.use_bar) bar = xcd_barrier_post(ctl + CW_BAR, MISC + 8);
    const int lo = a_.ph_lo, hi = a_.ph_hi;
#ifndef PH_MASK
#define PH_MASK 0xFFFFFFFFu
#endif
#define IN(k) (((PH_MASK >> ((k) == 0 ? 10 : (k) == 21 ? 11 : (((k) - 1) % 10))) & 1u) && lo <= (k) && (k) < hi)
#define TIMED(k) ((TMASK >> (k)) & 1u)
#define TBEG(k) do { if (TMASK != 0u && TIMED(k) && blockIdx.x == 0 && wave0_ == 0 && lane_id_fresh() == 0) { const unsigned long long t_ = __builtin_amdgcn_s_memrealtime(); MISC[20] = (unsigned)t_; MISC[21] = (unsigned)(t_ >> 32); } } while (0)
#define TEND(k) do { if (TMASK != 0u && TIMED(k) && blockIdx.x == 0 && wave0_ == 0 && lane_id_fresh() == 0) { const unsigned long long t_ = __builtin_amdgcn_s_memrealtime(); const unsigned long long t0_ = ((unsigned long long)MISC[21] << 32) | MISC[20]; \
        const unsigned long long d_ = (((unsigned long long)MISC[23] << 32) | MISC[22]) + (t_ - t0_); MISC[22] = (unsigned)d_; MISC[23] = (unsigned)(d_ >> 32); } } while (0)
#define SEAM(k) do { if (IN(k) && IN((k) + 1)) { XcdBarrier b2_ = bar; asm volatile("" : "+s"(b2_.bar)); int w2_ = wave0_; asm volatile("" : "+s"(w2_)); xcd_barrier(b2_, w2_ == 0 && lane_id_fresh() == 0); } } while (0)
    TBEG(0);
    if (IN(0)) REPEAT(10) { __syncthreads(); FRESH(); LOADA(); prologue_vectors(a, C); conv_small(a, C); }
    SEAM(0); TEND(0);
    _Pragma("unroll") for (int l = 0; l < 2; ++l) {
        const int pb = 1 + 10 * l;
        TBEG(pb + 0);
        if (IN(pb + 0)) REPEAT(0) { FRESH(); LOADA(); norm1_phase(a, C, l); }
        SEAM(pb + 0); TEND(pb + 0);
        TBEG(pb + 1);
        if (IN(pb + 1)) REPEAT(1) { FRESH(); LOADA(); unsigned char* ws = a.ws;
            pg8::Gemm g{1024u, 1024u, 128u, 1024, 0u, 0u, 0, nullptr, nullptr, 0x77777777, 0x7c7c7c7c};
            pg8::DenseOrder S; S.init(T, NIN, C.G, C.bx, ws + WS_H, 1024u, ws + WS_WINT + (size_t)l * NIN * DM, 1024u);
            EpiInProj E{(bf16_t*)(ws + WS_A), (unsigned char*)(ws + WS_MG), (float*)(ws + WS_GN), 1.0f / 2048.0f};
            pg8::gemm_phase<EpiInProj, pg8::DenseOrder, true, false, false, true>(C.lds, C.tid, g, S, E);
        }
        SEAM(pb + 1); TEND(pb + 1);
        TBEG(pb + 2);
        if (IN(pb + 2)) REPEAT(2) { FRESH(); LOADA(); unsigned char* ws = a.ws;
            struct CmpOrder { int c; const char* A; const char* B;
                __device__ __forceinline__ bool next(int i, pg8::Unit& u) const { if (i > 0 || c >= 32) return false; const int kv = c >> 4, b = (c >> 1) & 7, hk = c & 1;
                    u.pm = c; u.pn = 0; u.A = A + ((size_t)b * SEQ * LDQ + 512 + kv * 128 + hk * 64) * 2; u.B = B + (size_t)kv * 256 * 2048 * 2; return true; } };
            pg8::Gemm g{(unsigned)(16 * LDQ * 2), 4096u, (unsigned)(LDQ * 2), 2048};
            CmpOrder S{C.vcu, (const char*)(ws + WS_A), (const char*)(ws + WS_CW1T + (size_t)l * 2 * 256 * 2048 * 2)};
            EpiCmp E{(bf16_t*)(ws + WS_HID), (const float*)(ws + WS_CB1) + l * 512, (const bf16_t*)(ws + WS_CW2T) + (size_t)l * 2 * 64 * 256, (bf16_t*)(ws + WS_KC)};
            pg8::gemm_phase<EpiCmp, CmpOrder, false>(C.lds, C.tid, g, S, E);
            __syncthreads();
            build_bkt(C);
            for (;;) { __syncthreads();
                if (C.tid == 0) *(volatile LAS int*)(C.lds + LDS_MISC + 512) = (int)__hip_atomic_fetch_add((unsigned*)(ws + WS_CTL) + CW_Q + l, 1u, __ATOMIC_RELAXED, __HIP_MEMORY_SCOPE_AGENT);
                __syncthreads();
                const int du = __builtin_amdgcn_readfirstlane(*(volatile LAS int*)(C.lds + LDS_MISC + 512));
                if (du >= 1536) break;
                dil_unit(a, C, du); }
        }
        SEAM(pb + 2); TEND(pb + 2);
        TBEG(pb + 3);
        if (IN(pb + 3)) REPEAT(3) { FRESH(); LOADA();
            dil_combine(a, C);
            build_bkt(C);
            int cur_hk = -1;
            for (int v = C.vcu; v < 256; v += C.G) { const int b = v >> 5, hk = (v >> 4) & 1, s = v & 15;
                if (hk != cur_hk) { build_nsa_tables(a, C, hk); cur_hk = hk; }
                for (int k = 0; k < 4; ++k) { const int qi = (k == 0) ? s : (k == 1) ? 31 - s : (k == 2) ? 32 + s : 63 - s; nsa_unit(a, C, b, hk, qi);
                    __syncthreads(); if (v < C.G) conv_experts_slice(a, C, l, k); } }
            if (C.vcu >= 256) { for (int q = 0; q < 4; ++q) conv_experts_slice(a, C, l, q); }
            __syncthreads();
        }
        SEAM(pb + 3); TEND(pb + 3);
        TBEG(pb + 4);
        if (IN(pb + 4)) REPEAT(4) { FRESH(); LOADA(); unsigned char* ws = a.ws;
            pg8::Gemm g{1024u, 1024u, 128u, 512, 512u, 512u, 256}; pg8::DenseOrder S; S.init(T, 1024, C.G, C.bx, ws + WS_ONSA, 1024u, ws + WS_WUNT + (size_t)l * 1024 * 512 * 2, 1024u);
            S.A2 = (const char*)(ws + WS_ODIL); S.B2 = (const char*)(ws + WS_WUDT + (size_t)l * 1024 * 256 * 2); S.tA2 = (size_t)256 * 512; S.tB2 = (size_t)256 * 512;
            EpiUpFused E{(bf16_t*)(ws + WS_MERGED), (const unsigned char*)(ws + WS_MG)};
            pg8::gemm_phase<EpiUpFused, pg8::DenseOrder, true, true>(C.lds, C.tid, g, S, E);
        }
        SEAM(pb + 4); TEND(pb + 4);
        TBEG(pb + 5);
        if (IN(pb + 5)) REPEAT(5) { FRESH(); LOADA(); unsigned char* ws = a.ws;
            pg8::Gemm g{2048u, 2048u, 128u, 1024}; pg8::DenseOrder S; S.init(T, 1024, C.G, C.bx, ws + WS_MERGED, 2048u, ws + WS_WOT + (size_t)l * 1024 * 1024 * 2, 2048u);
            EpiOut E{l == 0 ? a.x : (const float*)a.out, a.out, (const float*)(ws + WS_MOD) + (size_t)l * 8 * 6144 + 2048};
            pg8::gemm_phase<EpiOut, pg8::DenseOrder, true>(C.lds, C.tid, g, S, E);
        }
        SEAM(pb + 5); TEND(pb + 5);
        TBEG(pb + 6);
        if (IN(pb + 6)) REPEAT(6) { FRESH(); LOADA(); norm2_router_phase(a, C, l); }
        SEAM(pb + 6); TEND(pb + 6);
        TBEG(pb + 7);
        if (IN(pb + 7)) REPEAT(7) { FRESH(); LOADA(); moe_scatter_phase(a, C); }
        SEAM(pb + 7); TEND(pb + 7);
        TBEG(pb + 8);
        if (IN(pb + 8)) REPEAT(8) { FRESH(); LOADA(); unsigned char* ws = a.ws;
            const int* TILEE = (const int*)(ws + WS_TILEE); const int ntl = TILEE[0];
            MoeOrder S; S.G = C.G; S.c = C.vcu; S.nu = ntl * 4; S.A = (const char*)(ws + WS_XS); S.B = (const char*)(ws + WS_E13T); S.tA = (size_t)256 * 1024; S.tB = (size_t)256 * 1024; S.eB = (size_t)1024 * 1024;
#pragma unroll
            for (int i = 0; i < 8; ++i) { const int L = i * C.G + C.vcu; S.ex[i] = (L < S.nu) ? TILEE[16 + (L >> 2)] : 0; }
            pg8::Gemm g{1024u, 1024u, 128u, 1024, 0u, 0u, 0, (const int*)(ws + WS_TOKL), (const char*)(ws + WS_H2), 0, 0};
            EpiMoe1 E{(unsigned char*)(ws + WS_ACT), 1.0f / 2048.0f};
            pg8::gemm_phase<EpiMoe1, MoeOrder, true, false, true, true>(C.lds, C.tid, g, S, E);
        }
        SEAM(pb + 8); TEND(pb + 8);
        TBEG(pb + 9);
        if (IN(pb + 9)) REPEAT(9) { FRESH(); LOADA(); unsigned char* ws = a.ws;
            const int* TILEE = (const int*)(ws + WS_TILEE); const int ntl = TILEE[0];
            MoeOrder S; S.G = C.G; S.c = C.vcu; S.nu = ntl * 4; S.A = (const char*)(ws + WS_ACT); S.B = (const char*)(ws + WS_E2T); S.tA = (size_t)256 * 512; S.tB = (size_t)256 * 512; S.eB = (size_t)1024 * 512;
#pragma unroll
            for (int i = 0; i < 8; ++i) { const int L = i * C.G + C.vcu; S.ex[i] = (L < S.nu) ? TILEE[16 + (L >> 2)] : 0; }
            pg8::Gemm g{512u, 512u, 128u, 512};
            EpiPlain E{(bf16_t*)(ws + WS_XS), 1024, 1.0f / 1024.0f};
            pg8::gemm_phase<EpiPlain, MoeOrder, true, false, false, true>(C.lds, C.tid, g, S, E);
        }
        SEAM(pb + 9); TEND(pb + 9);
    }
    TBEG(21);
    if (IN(21)) { FRESH(); LOADA(); final_phase(a, C); }
    TEND(21);
    if ((TMASK != 0u || TNSA != 0) && blockIdx.x == 0 && wave0_ == 0 && lane_id_fresh() == 0) { const unsigned long long d_ = ((unsigned long long)MISC[23] << 32) | MISC[22]; const unsigned long long t0_ = __builtin_amdgcn_s_memrealtime();
        while (__builtin_amdgcn_s_memrealtime() - t0_ < TAMP * d_) __builtin_amdgcn_s_sleep(8); }
#undef IN
#undef SEAM
}

#ifndef ONE_LAUNCH
#define ONE_LAUNCH 1
#endif
extern "C" void kernel_launch(void* const* d_in, const int* in_sizes, int n_in, void* d_out, int out_size, void* d_ws, size_t ws_size, hipStream_t stream) {
    static int grid = 0;
    if (grid == 0) {
        if (n_in != 22 || out_size != T * DM || ws_size < WS_END) { fprintf(stderr, "kernel_launch: unexpected problem (n_in %d out %d ws %zu)\n", n_in, out_size, ws_size); grid = -1; return; }
        int dev = 0, cus = 0;
        if (hipGetDevice(&dev) != hipSuccess || hipDeviceGetAttribute(&cus, hipDeviceAttributeMultiprocessorCount, dev) != hipSuccess) { grid = -1; return; }
        if (hipFuncSetAttribute((const void*)fwd_kernel, hipFuncAttributeMaxDynamicSharedMemorySize, LDS_BYTES) != hipSuccess) { fprintf(stderr, "kernel_launch: hipFuncSetAttribute failed\n"); grid = -1; return; }
        int per_cu = 0;
        if (hipOccupancyMaxActiveBlocksPerMultiprocessor(&per_cu, (const void*)fwd_kernel, NTHR, LDS_BYTES) != hipSuccess || per_cu < 1) { fprintf(stderr, "kernel_launch: occupancy query reports %d\n", per_cu); }
        (void)hipGetLastError();
        grid = cus;
    }
    if (grid < 0) return;
    (void)hipMemsetAsync((char*)d_ws + WS_CTL, 0, CTL_ZERO_BYTES, stream);
    Args a{};
    a.x = (const float*)d_in[0]; a.c = (const float*)d_in[1]; a.rel_bias = (const float*)d_in[2]; a.ada_w = (const float*)d_in[3]; a.ada_b = (const float*)d_in[4];
    a.norm1 = (const float*)d_in[5]; a.norm2 = (const float*)d_in[6]; a.w_in = (const float*)d_in[7]; a.cmp_pos = (const float*)d_in[8]; a.cmp_w1 = (const float*)d_in[9];
    a.cmp_w2 = (const float*)d_in[10]; a.w_up_nsa = (const float*)d_in[11]; a.w_up_dil = (const float*)d_in[12]; a.w_o = (const float*)d_in[13];
    a.router_wg = (const float*)d_in[14]; a.router_bg = (const float*)d_in[15]; a.router_we = (const float*)d_in[16]; a.router_be = (const float*)d_in[17];
    a.exp_w1 = (const float*)d_in[18]; a.exp_w3 = (const float*)d_in[19]; a.exp_w2 = (const float*)d_in[20]; a.norm_f = (const float*)d_in[21];
    a.out = (float*)d_out; a.ws = (unsigned char*)d_ws; a.pad = 0;
#if ONE_LAUNCH
    a.ph_lo = 0; a.ph_hi = NPHASE; a.use_bar = 1;
    hipLaunchKernelGGL(fwd_kernel, dim3(grid), dim3(NTHR), LDS_BYTES, stream, a);
#else
    for (int p = 0; p < NPHASE; ++p) { a.ph_lo = p; a.ph_hi = p + 1; a.use_bar = 0;
        hipLaunchKernelGGL(fwd_kernel, dim3(grid), dim3(NTHR), LDS_BYTES, stream, a); }
#endif
}
```
